# Optimizing an MI355X kernel written in HIP

```python
import math
import jax, jax.numpy as jnp
from jax import lax
import numpy as np

D_MODEL = 1024
BATCH = 8
SEQ = 8192
DEPTH = 2

GRID_W = 64
CTX_LEN = 256
RMS_EPS = 1e-6
ROPE_BASE = 10000.0
N_MOD = 6
RET_HEADS = 4
RET_DK = 64
RET_DV = 128
RET_CHUNK = 128
CONV_WIDTH = 512
MLA_HEADS = 8
MLA_Q_RANK = 384
MLA_KV_RANK = 256
MLA_NOPE = 64
MLA_ROPE = 32
MLA_V = 64
ATTN_BLOCK = 128
N_BRANCH = 3
N_EXPERTS = 16
N_GROUPS = 4
EXPERTS_PER_GROUP = N_EXPERTS // N_GROUPS
TOP_K = 2
D_EXPERT = 512
IN_SIZES = (RET_HEADS * RET_DK, RET_HEADS * RET_DK, RET_HEADS * RET_DV, RET_HEADS * RET_DV,
            CONV_WIDTH, CONV_WIDTH, CONV_WIDTH, MLA_Q_RANK, MLA_KV_RANK, MLA_ROPE, N_BRANCH * D_MODEL)
IN_COLS = sum(IN_SIZES)

kernel_name = "hybrid_retention_conv_mla_moe_dit"


def split_cols(p):
    out = []
    off = 0
    for s in IN_SIZES:
        out.append(p[..., off:off + s])
        off += s
    return out


def rms_norm(x, w):
    xf = x.astype(jnp.float32)
    y = xf * lax.rsqrt(jnp.mean(xf * xf, axis=-1, keepdims=True) + RMS_EPS)
    return (y * w.astype(jnp.float32)).astype(x.dtype)


def rotary(x, pos):
    half = x.shape[-1] // 2
    inv = ROPE_BASE ** (-jnp.arange(half, dtype=jnp.float32) / half)
    ang = pos.astype(jnp.float32)[:, None] * inv[None, :]
    cos = jnp.cos(ang)[None, :, None, :]
    sin = jnp.sin(ang)[None, :, None, :]
    xf = x.astype(jnp.float32)
    x1, x2 = xf[..., :half], xf[..., half:]
    return jnp.concatenate([x1 * cos - x2 * sin, x2 * cos + x1 * sin], axis=-1).astype(x.dtype)


def axial_rotary(x, rows, cols):
    half = x.shape[-1] // 2
    return jnp.concatenate([rotary(x[..., :half], rows), rotary(x[..., half:], cols)], axis=-1)


def ret_split(p, dim, pos):
    b, l, _ = p.shape
    t = p.reshape(b, l, RET_HEADS, dim)
    if pos is not None:
        t = rotary(t, pos)
    return t.astype(jnp.float32)


def retention_chunked(q, k, v, log_g, s0, strict):
    b, l, h, dk = q.shape
    dv = v.shape[-1]
    n = l // RET_CHUNK
    qc = q.reshape(b, n, RET_CHUNK, h, dk)
    kc = k.reshape(b, n, RET_CHUNK, h, dk)
    vc = v.reshape(b, n, RET_CHUNK, h, dv)
    idx = jnp.arange(RET_CHUNK, dtype=jnp.float32)
    rel = idx[:, None] - idx[None, :]
    keep = (rel > 0) if strict else (rel >= 0)
    decay = jnp.where(keep[None], jnp.exp(log_g[:, None, None] * jnp.maximum(rel, 0.0)[None]), 0.0)
    scores = jnp.einsum('bnihd,bnjhd->bnhij', qc, kc) * decay[None, None]
    inner = jnp.einsum('bnhij,bnjhe->bnihe', scores, vc)
    zeta = jnp.exp(log_g[None, :] * (RET_CHUNK - 1 - idx)[:, None])
    u = jnp.einsum('bnjhd,bnjhe->nbhde', kc * zeta[None, None, :, :, None], vc)
    chunk_decay = jnp.exp(log_g * RET_CHUNK)[None, :, None, None]

    def step(s, u_n):
        return chunk_decay * s + u_n, s

    _, s_prev = lax.scan(step, s0, u)
    xi = jnp.exp(log_g[None, :] * (idx + 1.0)[:, None])
    cross = jnp.einsum('bnihd,nbhde->bnihe', qc * xi[None, None, :, :, None], s_prev)
    return (inner + cross).reshape(b, l, h, dv)


def ret_final_state(k, v, log_g, reverse):
    l = k.shape[1]
    pos = jnp.arange(l, dtype=jnp.float32)
    dist = pos if reverse else (l - 1.0 - pos)
    w = jnp.exp(dist[:, None] * log_g[None, :])
    return jnp.einsum('blhd,blhe->bhde', k * w[None, :, :, None], v)


def retention_bidir(q, k, v, log_gf, log_gb, s_f, s_b):
    y_f = retention_chunked(q, k, v, log_gf, s_f, False)
    y_b = retention_chunked(jnp.flip(q, 1), jnp.flip(k, 1), jnp.flip(v, 1), log_gb, s_b, True)
    return y_f + jnp.flip(y_b, 1)


def ret_output(y, pg, gn_w, w_o):
    b, l = y.shape[:2]
    yn = y * lax.rsqrt(jnp.mean(y * y, axis=-1, keepdims=True) + RMS_EPS)
    yn = yn.reshape(b, l, -1) * gn_w.astype(jnp.float32)
    return (jax.nn.silu(pg) * yn.astype(pg.dtype)) @ w_o


def short_conv(pb, pc, px, conv_w):
    u = pc * px
    up = jnp.pad(u, ((0, 0), (1, 1), (0, 0)))
    y = up[:, :-2] * conv_w[:, 0] + up[:, 1:-1] * conv_w[:, 1] + up[:, 2:] * conv_w[:, 2]
    return pb * y


def mla_queries(pq, q_norm, w_uq, rows, cols):
    b, l, _ = pq.shape
    q = (rms_norm(pq, q_norm) @ w_uq).reshape(b, l, MLA_HEADS, MLA_NOPE + MLA_ROPE)
    qn, qr = q[..., :MLA_NOPE], q[..., MLA_NOPE:]
    if rows is not None:
        qr = axial_rotary(qr, rows, cols)
    return qn, qr


def mla_keys(pkv, pkr, kv_norm, w_ukv, rows, cols):
    b, l, _ = pkv.shape
    kv = (rms_norm(pkv, kv_norm) @ w_ukv).reshape(b, l, MLA_HEADS, MLA_NOPE + MLA_V)
    kn, v = kv[..., :MLA_NOPE], kv[..., MLA_NOPE:]
    kr = pkr.reshape(b, l, 1, MLA_ROPE)
    if rows is not None:
        kr = axial_rotary(kr, rows, cols)
    return kn, kr, v


def mla_attend(qn, qr, kn, kr, v):
    scale = (MLA_NOPE + MLA_ROPE) ** -0.5
    s = jnp.einsum('bqhd,bkhd->bhqk', qn, kn) + jnp.einsum('bqhr,bkr->bhqk', qr, kr[:, :, 0])
    p = jax.nn.softmax(s.astype(jnp.float32) * scale, axis=-1).astype(v.dtype)
    o = jnp.einsum('bhqk,bkhd->bqhd', p, v)
    return o.reshape(o.shape[0], o.shape[1], -1)


def mla_attend_blocked(qn, qr, kn, kr, v):
    b, l = qn.shape[:2]
    nb = l // ATTN_BLOCK

    def to_blocks(t):
        return t.reshape(b, nb, ATTN_BLOCK, *t.shape[2:]).swapaxes(0, 1)

    out = lax.map(lambda qs: mla_attend(qs[0], qs[1], kn, kr, v), (to_blocks(qn), to_blocks(qr)))
    return out.swapaxes(0, 1).reshape(b, l, -1)


def merge_branches(pgate, y_ret, y_conv, y_mla, w_out):
    g = jax.nn.sigmoid(pgate.reshape(*pgate.shape[:-1], N_BRANCH, D_MODEL))
    m = g[..., 0, :] * y_ret + g[..., 1, :] * y_conv + g[..., 2, :] * y_mla
    return m @ w_out


def moe(h, w_router, router_bias, w1, w3, w2):
    shp = h.shape
    t = h.reshape(-1, shp[-1])
    scores = jax.nn.sigmoid((t @ w_router).astype(jnp.float32))
    biased = scores + router_bias.astype(jnp.float32)
    grp = biased.reshape(-1, N_GROUPS, EXPERTS_PER_GROUP)
    group_score = jnp.sum(lax.top_k(grp, TOP_K)[0], axis=-1)
    g_sel = jnp.argmax(group_score, axis=-1)
    in_grp = jnp.take_along_axis(grp, g_sel[:, None, None], axis=1)[:, 0]
    idx = g_sel[:, None] * EXPERTS_PER_GROUP + lax.top_k(in_grp, TOP_K)[1]
    w = jnp.take_along_axis(scores, idx, axis=1)
    w = w / jnp.sum(w, axis=-1, keepdims=True)
    gate = jnp.sum(jax.nn.one_hot(idx, N_EXPERTS, dtype=jnp.float32) * w[..., None], axis=1).astype(h.dtype)
    out = jnp.zeros_like(t)
    for e in range(N_EXPERTS):
        he = (jax.nn.silu(t @ w1[e]) * (t @ w3[e])) @ w2[e]
        out = out + gate[:, e:e + 1] * he
    return out.reshape(shp)


def trunk_layer(x, xc, silu_c, silu_cc, rows, cols, pos, w_ada, b_ada, norm1, norm2, w_in,
                ret_decay, ret_gn, w_ret_o, conv_w, w_conv_o, mla_q_norm, w_uq, mla_kv_norm,
                w_ukv, w_mla_o, w_out, w_router, router_bias, w1, w3, w2, update_ctx):
    mod_x = jnp.split((silu_c @ w_ada + b_ada)[:, None, :], N_MOD, axis=-1)
    mod_c = jnp.split((silu_cc @ w_ada + b_ada)[None, None, :], N_MOD, axis=-1)
    hx = rms_norm(x, norm1) * (1.0 + mod_x[1]) + mod_x[0]
    hc = rms_norm(xc, norm1) * (1.0 + mod_c[1]) + mod_c[0]
    px = split_cols(hx @ w_in)
    pc = split_cols(hc @ w_in)
    log_gf = jax.nn.log_sigmoid(ret_decay[0].astype(jnp.float32))
    log_gb = jax.nn.log_sigmoid(ret_decay[1].astype(jnp.float32))

    kc = ret_split(pc[1], RET_DK, None) * (RET_DK ** -0.5)
    vc = ret_split(pc[2], RET_DV, None)
    s_f = ret_final_state(kc, vc, log_gf, False)
    s_b = ret_final_state(kc, vc, log_gb, True)
    qx = ret_split(px[0], RET_DK, pos)
    kx = ret_split(px[1], RET_DK, pos) * (RET_DK ** -0.5)
    vx = ret_split(px[2], RET_DV, None)
    y_ret = ret_output(retention_bidir(qx, kx, vx, log_gf, log_gb, s_f, s_b), px[3], ret_gn, w_ret_o)

    y_conv = short_conv(px[4], px[5], px[6], conv_w) @ w_conv_o

    kn_c, kr_c, v_c = mla_keys(pc[8], pc[9], mla_kv_norm, w_ukv, None, None)
    kn_x, kr_x, v_x = mla_keys(px[8], px[9], mla_kv_norm, w_ukv, rows, cols)
    qn_x, qr_x = mla_queries(px[7], mla_q_norm, w_uq, rows, cols)
    kn = jnp.concatenate([kn_c, kn_x], axis=1)
    kr = jnp.concatenate([kr_c, kr_x], axis=1)
    v = jnp.concatenate([v_c, v_x], axis=1)
    y_mla = mla_attend_blocked(qn_x, qr_x, kn, kr, v) @ w_mla_o

    x_mid = x + mod_x[2] * merge_branches(px[10], y_ret, y_conv, y_mla, w_out)
    h2x = rms_norm(x_mid, norm2) * (1.0 + mod_x[4]) + mod_x[3]

    if update_ctx:
        zero = jnp.zeros_like(s_f)
        qc = ret_split(pc[0], RET_DK, None)
        yc_ret = ret_output(retention_bidir(qc, kc, vc, log_gf, log_gb, zero, zero), pc[3], ret_gn, w_ret_o)
        yc_conv = short_conv(pc[4], pc[5], pc[6], conv_w) @ w_conv_o
        qn_c, qr_c = mla_queries(pc[7], mla_q_norm, w_uq, None, None)
        yc_mla = mla_attend(qn_c, qr_c, kn_c, kr_c, v_c) @ w_mla_o
        xc_mid = xc + mod_c[2] * merge_branches(pc[10], yc_ret, yc_conv, yc_mla, w_out)
        h2c = rms_norm(xc_mid, norm2) * (1.0 + mod_c[4]) + mod_c[3]
        n_ctx = xc.shape[1]
        f = moe(jnp.concatenate([h2c, h2x], axis=1), w_router, router_bias, w1, w3, w2)
        return x_mid + mod_x[5] * f[:, n_ctx:], xc_mid + mod_c[5] * f[:, :n_ctx]

    return x_mid + mod_x[5] * moe(h2x, w_router, router_bias, w1, w3, w2), xc


def setup_inputs(seed: int = 0) -> dict:
    key = jax.random.key(seed)
    ks = jax.random.split(key, 32)
    f32 = jnp.float32

    def nrm(k, shape, scale):
        return jax.random.normal(k, shape, f32) * scale

    base_decay = jnp.log(2.0 ** (5.0 + jnp.arange(RET_HEADS, dtype=f32)) - 1.0)
    return {
        'x': nrm(ks[0], (BATCH, SEQ, D_MODEL), 1.0),
        'c': nrm(ks[1], (BATCH, D_MODEL), 1.0),
        'ctx': nrm(ks[2], (BATCH, CTX_LEN, D_MODEL), 1.0),
        'c_ctx': nrm(ks[3], (D_MODEL,), 1.0),
        'w_ada': nrm(ks[4], (DEPTH, D_MODEL, N_MOD * D_MODEL), 0.5 * D_MODEL ** -0.5),
        'b_ada': nrm(ks[5], (DEPTH, N_MOD * D_MODEL), 0.02),
        'norm1': 1.0 + nrm(ks[6], (DEPTH, D_MODEL), 0.05),
        'norm2': 1.0 + nrm(ks[7], (DEPTH, D_MODEL), 0.05),
        'w_in': nrm(ks[8], (DEPTH, D_MODEL, IN_COLS), D_MODEL ** -0.5),
        'ret_decay': base_decay[None, None, :] + nrm(ks[9], (DEPTH, 2, RET_HEADS), 0.1),
        'ret_gn': 1.0 + nrm(ks[10], (DEPTH, RET_HEADS * RET_DV), 0.05),
        'w_ret_o': nrm(ks[11], (DEPTH, RET_HEADS * RET_DV, D_MODEL), (RET_HEADS * RET_DV) ** -0.5),
        'conv_w': nrm(ks[12], (DEPTH, CONV_WIDTH, 3), 3.0 ** -0.5),
        'w_conv_o': nrm(ks[13], (DEPTH, CONV_WIDTH, D_MODEL), CONV_WIDTH ** -0.5),
        'mla_q_norm': 1.0 + nrm(ks[14], (DEPTH, MLA_Q_RANK), 0.05),
        'w_uq': nrm(ks[15], (DEPTH, MLA_Q_RANK, MLA_HEADS * (MLA_NOPE + MLA_ROPE)), MLA_Q_RANK ** -0.5),
        'mla_kv_norm': 1.0 + nrm(ks[16], (DEPTH, MLA_KV_RANK), 0.05),
        'w_ukv': nrm(ks[17], (DEPTH, MLA_KV_RANK, MLA_HEADS * (MLA_NOPE + MLA_V)), MLA_KV_RANK ** -0.5),
        'w_mla_o': nrm(ks[18], (DEPTH, MLA_HEADS * MLA_V, D_MODEL), (MLA_HEADS * MLA_V) ** -0.5),
        'w_out': nrm(ks[19], (DEPTH, D_MODEL, D_MODEL), D_MODEL ** -0.5),
        'w_router': nrm(ks[20], (D_MODEL, N_EXPERTS), D_MODEL ** -0.5),
        'router_bias': nrm(ks[21], (N_EXPERTS,), 0.01),
        'w1': nrm(ks[22], (DEPTH, N_EXPERTS, D_MODEL, D_EXPERT), D_MODEL ** -0.5),
        'w3': nrm(ks[23], (DEPTH, N_EXPERTS, D_MODEL, D_EXPERT), D_MODEL ** -0.5),
        'w2': nrm(ks[24], (DEPTH, N_EXPERTS, D_EXPERT, D_MODEL), D_EXPERT ** -0.5),
        'final_norm': 1.0 + nrm(ks[25], (D_MODEL,), 0.05),
    }


def reference(x, c, ctx, c_ctx, w_ada, b_ada, norm1, norm2, w_in, ret_decay, ret_gn, w_ret_o,
              conv_w, w_conv_o, mla_q_norm, w_uq, mla_kv_norm, w_ukv, w_mla_o, w_out,
              w_router, router_bias, w1, w3, w2, final_norm):
    n_tok = x.shape[1]
    n_rows = n_tok // GRID_W
    pos = jnp.arange(n_tok, dtype=jnp.int32)
    rows = jnp.repeat(jnp.arange(n_rows, dtype=jnp.int32), GRID_W)
    cols = pos - rows * GRID_W
    silu_c = jax.nn.silu(c)
    silu_cc = jax.nn.silu(c_ctx)
    xc = ctx
    for l in range(DEPTH):
        x, xc = trunk_layer(x, xc, silu_c, silu_cc, rows, cols, pos, w_ada[l], b_ada[l], norm1[l], norm2[l],
                            w_in[l], ret_decay[l], ret_gn[l], w_ret_o[l], conv_w[l], w_conv_o[l],
                            mla_q_norm[l], w_uq[l], mla_kv_norm[l], w_ukv[l], w_mla_o[l], w_out[l],
                            w_router, router_bias, w1[l], w3[l], w2[l], l < DEPTH - 1)
    return rms_norm(x, final_norm)
```

```cpp
#include <hip/hip_runtime.h>
#include <cstdio>
#include <cstdint>

#define GAS __attribute__((address_space(1)))
#define LAS __attribute__((address_space(3)))
typedef unsigned short bf16_t;
typedef short bf16x8 __attribute__((ext_vector_type(8)));
typedef short s16x4 __attribute__((ext_vector_type(4)));
typedef float f32x2 __attribute__((ext_vector_type(2)));
typedef float f32x4 __attribute__((ext_vector_type(4)));
typedef float f32x16 __attribute__((ext_vector_type(16)));
typedef unsigned u32x2 __attribute__((ext_vector_type(2)));
typedef unsigned u32x4 __attribute__((ext_vector_type(4)));
typedef __bf16 bf16x2_t __attribute__((ext_vector_type(2)));

constexpr int DM = 1024, NB = 8, SEQ = 8192, CTXL = 256, DEPTH = 2;
constexpr int SB = SEQ + CTXL;
constexpr int GB = 4, NG = NB / GB;
constexpr int NT = GB * SB;
constexpr int NRT = NT / 256;
constexpr int INW = 6912;
constexpr int INCOLS = 6816;
constexpr int NCHUNK = SB / 128;
constexpr int NPAIR = 24;
constexpr float RMS_EPS = 1e-6f;
constexpr float LOG2E = 1.4426950408889634f;
constexpr float QSCALE = 0.10206207261596575f * LOG2E;

constexpr size_t MiB = 1u << 20;
constexpr size_t WS_CTL = 0, CTL_ZERO_BYTES = 1 * MiB;
constexpr size_t WS_MOD = 1 * MiB;
constexpr size_t WS_RT = 2 * MiB;
constexpr size_t WS_MT = 4 * MiB;
constexpr size_t WS_SSQ = 5 * MiB;
constexpr size_t WS_WGT = 8 * MiB;
constexpr size_t WS_LIST = 9 * MiB;
constexpr size_t WS_XC = 13 * MiB;
constexpr size_t WS_WIN = 21 * MiB;
constexpr size_t WS_WCAT = 48 * MiB;
constexpr size_t WS_WOUT = 54 * MiB;
constexpr size_t WS_WUQ = 58 * MiB;
constexpr size_t WS_WUKV = 60 * MiB;
constexpr size_t WS_WUP = 61 * MiB;
constexpr size_t WS_W2T = 125 * MiB;
constexpr size_t WS_HX = 157 * MiB;
constexpr size_t WS_PR = 223 * MiB;
constexpr size_t WS_PC = 322 * MiB;
constexpr size_t WS_PM = 388 * MiB;
constexpr size_t WS_PG = 430 * MiB;
constexpr size_t WS_Q = 628 * MiB;
constexpr size_t WS_K = 678 * MiB;
constexpr size_t WS_V = 728 * MiB;
constexpr size_t WS_ACT = 761 * MiB;
constexpr size_t WS_END = 860 * MiB;
static_assert(WS_WIN + (size_t)2 * INW * 1024 * 2 <= WS_WCAT && WS_HX + (size_t)NT * 1024 * 2 <= WS_PR && WS_PR + (size_t)NT * 1536 * 2 <= WS_PC &&
              WS_PC + (size_t)NT * 1024 * 2 <= WS_PM && WS_PM + (size_t)NT * 640 * 2 <= WS_PG && WS_PG + (size_t)NT * 3072 * 2 <= WS_Q &&
              WS_Q + (size_t)GB * 8 * SB * 96 * 2 <= WS_K && WS_K + (size_t)GB * 8 * SB * 96 * 2 <= WS_V && WS_V + (size_t)GB * 8 * SB * 64 * 2 <= WS_ACT &&
              WS_ACT + (size_t)NT * 1536 * 2 <= WS_END, "d_ws map");
constexpr int CW_BAR = 4096;
constexpr int CW_CNT = 16384;

constexpr int RING_BYTES = 131072;
constexpr int LDSCTL_OFF = RING_BYTES;
constexpr int LDS_MOE_OFF = LDSCTL_OFF + 64;
constexpr int LDS_BYTES = 147456;

__device__ __forceinline__ int olane() { int l; asm volatile("v_mbcnt_lo_u32_b32 %0, -1, 0\n\tv_mbcnt_hi_u32_b32 %0, -1, %0" : "=v"(l)); return l; }
__device__ __forceinline__ int otid(int wv) { return wv * 64 + olane(); }
__device__ __forceinline__ int obid() { int b = blockIdx.x; asm volatile("" : "+s"(b)); return b; }
__device__ __forceinline__ unsigned cvtpk(float lo, float hi) { f32x2 v = {lo, hi}; bf16x2_t b = __builtin_convertvector(v, bf16x2_t); return __builtin_bit_cast(unsigned, b); }
__device__ __forceinline__ float bf_lo(unsigned w) { return __uint_as_float(w << 16); }
__device__ __forceinline__ float bf_hi(unsigned w) { return __uint_as_float(w & 0xffff0000u); }
__device__ __forceinline__ float bf1(bf16_t b) { return __uint_as_float(((unsigned)b) << 16); }
__device__ __forceinline__ bf16_t f2bf(float f) { return (bf16_t)(cvtpk(f, 0.f) & 0xffffu); }
template <int O> __device__ __forceinline__ float swz_xor(float v) { return __int_as_float(__builtin_amdgcn_ds_swizzle(__float_as_int(v), (O << 10) | 0x1f)); }
__device__ __forceinline__ float half_sum(float v) { auto rr = __builtin_amdgcn_permlane32_swap(__float_as_uint(v), __float_as_uint(v), false, false); return __uint_as_float(rr[0]) + __uint_as_float(rr[1]); }
__device__ __forceinline__ float sum32(float v) { v += swz_xor<1>(v); v += swz_xor<2>(v); v += swz_xor<4>(v); v += swz_xor<8>(v); v += swz_xor<16>(v); return v; }
__device__ __forceinline__ float wave_sum(float v) { return half_sum(sum32(v)); }
__device__ __forceinline__ float sigmoidf_(float x) { return 1.f / (1.f + __expf(-x)); }
__device__ __forceinline__ float siluf_(float x) { return x / (1.f + __expf(-x)); }
__device__ __forceinline__ void unpack8(const u32x4 w, float (&f)[8]) {
    f[0] = bf_lo(w.x); f[1] = bf_hi(w.x); f[2] = bf_lo(w.y); f[3] = bf_hi(w.y); f[4] = bf_lo(w.z); f[5] = bf_hi(w.z); f[6] = bf_lo(w.w); f[7] = bf_hi(w.w);
}
__device__ __forceinline__ u32x4 pack8(const float (&f)[8]) { u32x4 w; w.x = cvtpk(f[0], f[1]); w.y = cvtpk(f[2], f[3]); w.z = cvtpk(f[4], f[5]); w.w = cvtpk(f[6], f[7]); return w; }

#define XB_TMO      128
#define XB_XCNT(j)  (256  + 64 * (j))
#define XB_XSUB(j)  (1280 + 64 * (j))
#define XB_XGEN(j)  (2304 + 64 * (j))
#define XB_TOP      3328
#define XB_TOPGEN   3392
#define XCD_BAR_WORDS 3456
#define XB_SPIN_CAP (1u << 20)
__device__ __forceinline__ unsigned xb_ld(unsigned* p)              { return __hip_atomic_load(p, __ATOMIC_RELAXED, __HIP_MEMORY_SCOPE_AGENT); }
__device__ __forceinline__ unsigned xb_add(unsigned* p, unsigned v) { return __hip_atomic_fetch_add(p, v, __ATOMIC_RELAXED, __HIP_MEMORY_SCOPE_AGENT); }
__device__ __forceinline__ unsigned xb_xcc_id() { return (unsigned)__builtin_amdgcn_s_getreg((3 << 11) | 20) & 0xFu; }
#define XB_SPIN(cond, bar) do { unsigned _sp = 0; while (cond) { __builtin_amdgcn_s_sleep(1); \
    if ((++_sp & 255u) == 0u) { if (xb_ld(&(bar)[XB_TMO])) break; if (_sp > XB_SPIN_CAP) { atomicAdd(&(bar)[XB_TMO], 1u); break; } } } } while (0)
struct XcdBarrier { unsigned* bar; unsigned x; volatile LAS unsigned* st; };
__device__ __forceinline__ XcdBarrier xcd_barrier_post(unsigned* bar, volatile LAS unsigned* st) {
    XcdBarrier b; b.bar = bar; b.x = xb_xcc_id(); b.st = st;
    if (threadIdx.x == 0) (void)xb_add(&bar[XB_XCNT(b.x)], 1u);
    return b;
}
__device__ __forceinline__ void xcd_barrier_complete(unsigned* bar, unsigned x, unsigned& nloc, unsigned& nx) {
    const unsigned G = gridDim.x * gridDim.y * gridDim.z;
    unsigned sum, cnt, mine, sp = 0u;
    for (;;) {
        sum = 0u; cnt = 0u; mine = 0u;
#pragma unroll
        for (unsigned j = 0; j < 16; ++j) { const unsigned c = xb_ld(&bar[XB_XCNT(j)]); sum += c; cnt += (c > 0u) ? 1u : 0u; mine = (j == x) ? c : mine; }
        if (sum == G) break;
        __builtin_amdgcn_s_sleep(1);
        if ((++sp & 255u) == 0u) { if (xb_ld(&bar[XB_TMO])) break; if (sp > XB_SPIN_CAP) { atomicAdd(&bar[XB_TMO], 1u); break; } }
    }
    nloc = mine > 0u ? mine : 1u; nx = cnt > 0u ? cnt : 1u;
}
__device__ __forceinline__ void xcd_barrier(const XcdBarrier& b, const int wv) {
    const bool leader = (wv == 0) && (olane() == 0);
    asm volatile("s_waitcnt vmcnt(0)" ::: "memory");
    __syncthreads();
    if (leader) {
        unsigned* bar = b.bar; unsigned bx = b.x;
        asm volatile("" : "+s"(bar), "+s"(bx));
        __builtin_amdgcn_s_waitcnt(0);
        unsigned nloc = b.st[0], nx = b.st[1];
        if (nloc == 0u) { xcd_barrier_complete(bar, bx, nloc, nx); b.st[0] = nloc; b.st[1] = nx; }
        const unsigned old = xb_add(&bar[XB_XSUB(bx)], 1u);
        const unsigned gen = old / nloc;
        if (old + 1u == (gen + 1u) * nloc) {
            __builtin_amdgcn_fence(__ATOMIC_RELEASE, "agent");
            asm volatile("s_waitcnt vmcnt(0)" ::: "memory");
            const unsigned og = xb_add(&bar[XB_TOP], 1u);
            const unsigned tg = og / nx;
            if (og + 1u == (tg + 1u) * nx) xb_add(&bar[XB_TOPGEN], 1u);
            else XB_SPIN(xb_ld(&bar[XB_TOPGEN]) == tg, bar);
            __builtin_amdgcn_fence(__ATOMIC_ACQUIRE, "agent");
            xb_add(&bar[XB_XGEN(bx)], 1u);
            asm volatile("s_waitcnt vmcnt(0)" ::: "memory");
        } else {
            XB_SPIN(xb_ld(&bar[XB_XGEN(bx)]) == gen, bar);
            __builtin_amdgcn_fence(__ATOMIC_ACQUIRE, "agent");
            asm volatile("s_waitcnt vmcnt(0)" ::: "memory");
        }
    }
    __syncthreads();
}

namespace pg8 {
constexpr int BM = 256, BK = 64, HALF = 128, HTB = HALF * BK * 2, NXCD = 8, WGM = 8;
__host__ __device__ __forceinline__ int lds_byte(int r, int c) { const int st = (r >> 4) * 2 + (c >> 5), rr = r & 15, cc = c & 31, ob = rr * 64 + cc * 2; return st * 1024 + (ob ^ (((ob >> 9) & 1) << 5)); }
__host__ __device__ __forceinline__ void stage_rc(int b, int& R, int& C) { const int st = b / 1024, sb = b % 1024, swz = sb ^ (((sb >> 9) & 1) << 5); R = (st >> 1) * 16 + swz / 64; C = (st & 1) * 32 + (swz % 64) / 2; }
__host__ __device__ __forceinline__ int perm32(int rho) { const int n = rho >> 4, i = rho & 15; return 8 * (i >> 2) + 4 * n + (i & 3); }

struct Unit { int pm, pn, aux0, aux1, aux2; const char* a; const char* b; const char* b2; };
typedef f32x4 Acc[2][2][4][2];

template <class Epi, class Sched, bool ALIGN_EPI, bool GATHER = false, bool SPLITB = false>
__device__ __forceinline__ void gemm_phase(LAS unsigned char* lds, const int lda, const int ldb, const int K, const int ksplit, const Sched& S, const Epi& E, const int wv) {
    const int tid = otid(wv), wid = __builtin_amdgcn_readfirstlane(tid >> 6), lane = tid & 63, wr = wid >> 2, wc = wid & 3, fr = lane & 15, fq = lane >> 4;
    const int nt = K / BK;
    unsigned voffA[2][2], voffN[2][2], voffB[2]; int RA[2], CA[2];
#pragma unroll
    for (int i = 0; i < 2; ++i) { int R, C; stage_rc(tid * 16 + i * 8192, R, C); const int Rb = (R & ~31) + perm32(R & 31);
        RA[i] = R; CA[i] = C; voffB[i] = (unsigned)(Rb * ldb + C) * 2u;
        voffA[0][i] = (unsigned)(R * lda + C) * 2u; voffA[1][i] = (unsigned)((R + HALF) * lda + C) * 2u; voffN[0][i] = voffA[0][i]; voffN[1][i] = voffA[1][i]; }
    const size_t kstep = (size_t)(BK * 2);
    const size_t hstepB = (size_t)HALF * ldb * 2;
    const unsigned ldsw = (unsigned)wid * 1024u;
    const int aoff = lds_byte(wr * 64 + fr, fq * 8), boff = lds_byte(wc * 32 + fr, fq * 8);
#define PG8_SA(b, h) (((b) * 2 + (h)) * HTB)
#define PG8_SB(b, h) ((4 + (b) * 2 + (h)) * HTB)
#define PG8_STAGE_B(bufoff, gbase, h) do { _Pragma("unroll") for (int _i = 0; _i < 2; ++_i) \
        __builtin_amdgcn_global_load_lds((const unsigned*)((const char*)(gbase) + (size_t)(h) * hstepB + voffB[_i]), (LAS unsigned*)(lds + (bufoff) + ldsw + _i * 8192), 16, 0, 0); } while (0)
#define PG8_STAGE_A(bufoff, gbase, h, NX) do { _Pragma("unroll") for (int _i = 0; _i < 2; ++_i) { const unsigned _o = (GATHER && (NX)) ? voffN[h][_i] : voffA[h][_i]; \
        __builtin_amdgcn_global_load_lds((const unsigned*)((const char*)(gbase) + _o), (LAS unsigned*)(lds + (bufoff) + ldsw + _i * 8192), 16, 0, 0); } } while (0)
#define PG8_LDA(dst, b, h) do { _Pragma("unroll") for (int m = 0; m < 4; ++m) _Pragma("unroll") for (int k = 0; k < 2; ++k) dst[m][k] = *(const LAS bf16x8*)(lds + PG8_SA(b, h) + aoff + m * 2048 + k * 1024); } while (0)
#define PG8_LDB(dst, b, h) do { _Pragma("unroll") for (int n = 0; n < 2; ++n) _Pragma("unroll") for (int k = 0; k < 2; ++k) dst[n][k] = *(const LAS bf16x8*)(lds + PG8_SB(b, h) + boff + n * 2048 + k * 1024); } while (0)
#define PG8_MMA(ai, bj, At, Bt) do { __builtin_amdgcn_s_setprio(1); _Pragma("unroll") for (int m = 0; m < 4; ++m) _Pragma("unroll") for (int n = 0; n < 2; ++n) _Pragma("unroll") for (int k = 0; k < 2; ++k) \
        acc[ai][bj][m][n] = __builtin_amdgcn_mfma_f32_16x16x32_bf16(Bt[n][k], At[m][k], acc[ai][bj][m][n], 0, 0, 0); __builtin_amdgcn_s_setprio(0); } while (0)
#define PG8_WAIT_V(n) asm volatile("s_waitcnt vmcnt(" #n ")" ::: "memory")
#define PG8_WAIT_L(n) asm volatile("s_waitcnt lgkmcnt(" #n ")" ::: "memory")
#define PG8_BAR __builtin_amdgcn_s_barrier()
#define PG8_SCHED __builtin_amdgcn_sched_barrier(0)
#define PG8_GOFF(dst, u) do { if constexpr (GATHER) { _Pragma("unroll") for (int _h = 0; _h < 2; ++_h) _Pragma("unroll") for (int _i = 0; _i < 2; ++_i) \
        dst[_h][_i] = S.gather_off(u, _h * HALF + RA[_i]) + (unsigned)CA[_i] * 2u; } } while (0)
#define PG8_BPTR(u, t) (SPLITB ? (((t) < ksplit) ? (u).b + (size_t)(t) * kstep : (u).b2 + (size_t)((t) - ksplit) * kstep) : (u).b + (size_t)(t) * kstep)
    Unit cur, nxt; int ui = 0;
    if (!S.next(0, cur)) return;
    Acc acc;
#pragma unroll
    for (int a = 0; a < 2; ++a)
#pragma unroll
        for (int b = 0; b < 2; ++b)
#pragma unroll
            for (int m = 0; m < 4; ++m)
#pragma unroll
                for (int n = 0; n < 2; ++n) acc[a][b][m][n] = (f32x4){0.f, 0.f, 0.f, 0.f};
    bf16x8 At[4][2], B0[2][2], B1[2][2];
    const char* cA = cur.a; const char* cB = cur.b;
    S.a_ready(cur);
    PG8_GOFF(voffA, cur);
    if constexpr (GATHER) {
#pragma unroll
        for (int h = 0; h < 2; ++h)
#pragma unroll
            for (int i = 0; i < 2; ++i) voffN[h][i] = voffA[h][i];
    }
    PG8_STAGE_B(PG8_SB(0, 0), cB, 0); PG8_STAGE_B(PG8_SB(0, 1), cB, 1); PG8_STAGE_A(PG8_SA(0, 0), cA, 0, false); PG8_STAGE_A(PG8_SA(0, 1), cA, 1, false);
    if (wr == 1) PG8_BAR;
    PG8_WAIT_V(2); PG8_BAR;
    PG8_STAGE_B(PG8_SB(1, 0), cB + kstep, 0); PG8_STAGE_A(PG8_SA(1, 0), cA + kstep, 0, false); PG8_STAGE_B(PG8_SB(1, 1), cB + kstep, 1);
    PG8_WAIT_V(6); PG8_BAR;
    for (;;) {
        const bool has_next = S.next(ui + 1, nxt);
        const char* nA = has_next ? nxt.a : cA; const char* nB = has_next ? nxt.b : cB;
        for (int t = 0; t < nt; t += 2) {
            const bool last = (t == nt - 2);
            if (last && has_next) { S.a_ready(nxt); PG8_GOFF(voffN, nxt); }
            if constexpr (Epi::HOOK) { if (t == Epi::HOOK_T0 || t == Epi::HOOK_T1) E.hook(acc, cur, t, wr, wc, fr, fq); }
            const char* a1 = cA + (size_t)(t + 1) * kstep;
            const char* a2 = last ? nA : cA + (size_t)(t + 2) * kstep; const char* b2 = last ? nB : PG8_BPTR(cur, t + 2);
            const char* a3 = a2 + kstep; const char* b3 = b2 + kstep;
            PG8_LDB(B0, 0, 0); PG8_LDB(B1, 0, 1); PG8_SCHED; PG8_LDA(At, 0, 0); PG8_STAGE_A(PG8_SA(1, 1), a1, 1, false);
            PG8_WAIT_V(8); PG8_WAIT_L(0); PG8_BAR; PG8_MMA(0, 0, At, B0); PG8_MMA(0, 1, At, B1); PG8_BAR; PG8_SCHED;
            PG8_LDA(At, 0, 1); PG8_STAGE_B(PG8_SB(0, 0), b2, 0); PG8_STAGE_B(PG8_SB(0, 1), b2, 1); PG8_STAGE_A(PG8_SA(0, 0), a2, 0, last);
            PG8_WAIT_V(8); PG8_WAIT_L(0); PG8_BAR; PG8_MMA(1, 0, At, B0); PG8_MMA(1, 1, At, B1); PG8_BAR; PG8_SCHED;
            PG8_LDB(B0, 1, 0); PG8_LDB(B1, 1, 1); PG8_SCHED; PG8_LDA(At, 1, 0); PG8_STAGE_A(PG8_SA(0, 1), a2, 1, last);
            PG8_WAIT_V(8); PG8_WAIT_L(0); PG8_BAR; PG8_MMA(0, 0, At, B0); PG8_MMA(0, 1, At, B1); PG8_BAR; PG8_SCHED;
            PG8_LDA(At, 1, 1); PG8_STAGE_B(PG8_SB(1, 0), b3, 0); PG8_STAGE_B(PG8_SB(1, 1), b3, 1); PG8_STAGE_A(PG8_SA(1, 0), a3, 0, last);
            PG8_WAIT_V(8); PG8_WAIT_L(0); PG8_BAR; PG8_MMA(1, 0, At, B0); PG8_MMA(1, 1, At, B1); PG8_BAR; PG8_SCHED;
        }
        if constexpr (ALIGN_EPI) { if (wr == 0) PG8_BAR; }
        E(acc, cur, wr, wc, fr, fq); S.done(cur);
        if (!has_next) break;
#pragma unroll
        for (int a = 0; a < 2; ++a)
#pragma unroll
            for (int b = 0; b < 2; ++b)
#pragma unroll
                for (int m = 0; m < 4; ++m)
#pragma unroll
                    for (int n = 0; n < 2; ++n) acc[a][b][m][n] = (f32x4){0.f, 0.f, 0.f, 0.f};
        cur = nxt; cA = nA; cB = nB; ++ui;
        if constexpr (GATHER) {
#pragma unroll
            for (int h = 0; h < 2; ++h)
#pragma unroll
                for (int i = 0; i < 2; ++i) voffA[h][i] = voffN[h][i];
        }
        if constexpr (ALIGN_EPI) { if (wr == 1) PG8_BAR; }
    }
    PG8_WAIT_V(0);
    if constexpr (!ALIGN_EPI) { if (wr == 0) PG8_BAR; }
    PG8_BAR;
#undef PG8_SA
#undef PG8_SB
#undef PG8_STAGE_A
#undef PG8_STAGE_B
#undef PG8_LDA
#undef PG8_LDB
#undef PG8_MMA
#undef PG8_WAIT_V
#undef PG8_WAIT_L
#undef PG8_BAR
#undef PG8_SCHED
#undef PG8_GOFF
#undef PG8_BPTR
}
}
struct Resid {
    const float* src_lat; const float* src_ctx; float* dst_lat; float* dst_ctx; int g;
    __device__ __forceinline__ const float* src(int row) const { const int bl = row / SB, s = row - bl * SB, b = g * GB + bl;
        return s < CTXL ? src_ctx + (size_t)(b * CTXL + s) * DM : src_lat + ((size_t)b * SEQ + (s - CTXL)) * DM; }
    __device__ __forceinline__ float* dst(int row) const { const int bl = row / SB, s = row - bl * SB, b = g * GB + bl;
        return s < CTXL ? dst_ctx + (size_t)(b * CTXL + s) * DM : dst_lat + ((size_t)b * SEQ + (s - CTXL)) * DM; }
    __device__ __forceinline__ int modv(int row) const { const int bl = row / SB, s = row - bl * SB; return s < CTXL ? 8 : g * GB + bl; }
};

struct TileOrder {
    int nM, nN, nwg, G, c, skip; const char* A; const char* B; size_t astep, bstep;
    __device__ __forceinline__ void init(int nM_, int nN_, int G_, int c_, const void* A_, size_t astep_, const void* B_, size_t bstep_, int skip_ctx) {
        nM = nM_; nN = nN_; nwg = nM * nN; G = G_; c = c_; A = (const char*)A_; B = (const char*)B_; astep = astep_; bstep = bstep_; skip = skip_ctx; }
    __device__ __forceinline__ bool next(int i, pg8::Unit& u) const {
        const long L = (long)i * G + c; if (L >= nwg) return false;
        int wgid = (int)L; { const int q = nwg / pg8::NXCD, r = nwg % pg8::NXCD, xcd = wgid % pg8::NXCD, off = wgid / pg8::NXCD; wgid = (xcd < r ? xcd * (q + 1) : r * (q + 1) + (xcd - r) * q) + off; }
        const int nig = pg8::WGM * nN, gid = wgid / nig, fm = gid * pg8::WGM, gsz = (nM - fm) < pg8::WGM ? (nM - fm) : pg8::WGM;
        int pm = fm + ((wgid % nig) % gsz); u.pn = (wgid % nig) / gsz;
        if (skip) pm = pm + pm / 32 + 1;
        u.pm = pm; u.aux0 = 0; u.aux1 = 0; u.aux2 = 0;
        u.a = A + (size_t)pm * astep; u.b = B + (size_t)u.pn * bstep; u.b2 = u.b; return true;
    }
    __device__ __forceinline__ void a_ready(const pg8::Unit&) const {}
    __device__ __forceinline__ void done(const pg8::Unit&) const {}
};

struct MoeOrder {
    const LAS int* tab; const int* LIST; int ncol, G, c, up; const char* A; const char* W;
    __device__ __forceinline__ bool next(int i, pg8::Unit& u) const {
        const int total = __builtin_amdgcn_readfirstlane(tab[24]) * ncol; const int L = i * G + c; if (L >= total) return false;
        const int rt = L / ncol, pn = L - rt * ncol;
        int p = 0;
#pragma unroll
        for (int q = 1; q < NPAIR; ++q) p += (__builtin_amdgcn_readfirstlane(tab[q]) <= rt) ? 1 : 0;
        const int base = (rt - __builtin_amdgcn_readfirstlane(tab[p])) * 256; int valid = __builtin_amdgcn_readfirstlane(tab[32 + p]) - base; valid = valid > 256 ? 256 : valid;
        u.pm = rt; u.pn = pn; u.aux0 = p * NT + base; u.aux1 = valid; u.aux2 = p;
        const int grp = p / 6, q6 = p - grp * 6;
        const int lo = q6 < 3 ? 0 : (q6 < 5 ? 1 : 2), hi = q6 < 3 ? q6 + 1 : (q6 < 5 ? q6 - 1 : 3);
        const int ea = grp * 4 + lo, eb = grp * 4 + hi;
        if (up) { const int e = pn < 4 ? ea : eb; u.a = A; u.b = W + ((size_t)e * 1024 + (size_t)(pn & 3) * 256) * 1024 * 2; u.b2 = u.b; }
        else { u.a = A + (size_t)rt * 256 * 1024 * 2; u.b = W + ((size_t)ea * 1024 + (size_t)pn * 256) * 512 * 2; u.b2 = W + ((size_t)eb * 1024 + (size_t)pn * 256) * 512 * 2; }
        return true;
    }
    __device__ __forceinline__ unsigned gather_off(const pg8::Unit& u, int r) const { const int idx = r < u.aux1 ? r : 0; return (unsigned)LIST[u.aux0 + idx] * (unsigned)(DM * 2); }
    __device__ __forceinline__ void a_ready(const pg8::Unit&) const {}
    __device__ __forceinline__ void done(const pg8::Unit&) const {}
};

#define EPI_NOHOOK static constexpr bool HOOK = false; static constexpr int HOOK_T0 = -1, HOOK_T1 = -1; \
    __device__ __forceinline__ void hook(pg8::Acc&, const pg8::Unit&, int, int, int, int, int) const {}
#define EPI_V8(v, acc, ai, bj, m) float v[8]; { const f32x4 _a = acc[ai][bj][m][0], _b = acc[ai][bj][m][1]; v[0] = _a[0]; v[1] = _a[1]; v[2] = _a[2]; v[3] = _a[3]; v[4] = _b[0]; v[5] = _b[1]; v[6] = _b[2]; v[7] = _b[3]; }
__device__ __forceinline__ void rot4(float (&v)[8], const f32x2* cs) {
    const f32x4 c01 = *(const f32x4*)cs, c23 = *(const f32x4*)(cs + 2);
    const float c[4] = {c01[0], c01[2], c23[0], c23[2]}, s[4] = {c01[1], c01[3], c23[1], c23[3]};
#pragma unroll
    for (int k = 0; k < 4; ++k) { const float x1 = v[2 * k], x2 = v[2 * k + 1]; v[2 * k] = x1 * c[k] - x2 * s[k]; v[2 * k + 1] = x2 * c[k] + x1 * s[k]; }
}

struct EpiInproj {
    EPI_NOHOOK
    bf16_t *PR, *PC, *PM, *PG, *KB; float* SSQ; const f32x2* RT; const f32x2* MT;
    __device__ __forceinline__ void operator()(const pg8::Acc& acc, const pg8::Unit& u_, int wr, int wc, int fr, int fq) const {
        pg8::Unit u = u_; asm volatile("" : "+s"(u.pm), "+s"(u.pn), "+s"(u.aux0), "+s"(u.aux1));
        const int pn = u.pn;
#pragma unroll
        for (int ai = 0; ai < 2; ++ai)
#pragma unroll
        for (int m = 0; m < 4; ++m) { __builtin_amdgcn_sched_barrier(0);
            const int row = u.pm * 256 + ai * 128 + wr * 64 + m * 16 + fr;
            const int bl = row / SB, s = row - bl * SB; const bool lat = s >= CTXL; const int t = lat ? s - CTXL : 0;
            float ss[2] = {0.f, 0.f};
#pragma unroll
            for (int bj = 0; bj < 2; ++bj) {
                const int c0 = bj * 128 + wc * 32 + 8 * fq;
                EPI_V8(v, acc, ai, bj, m)
                if (pn <= 1) {
                    if (lat) rot4(v, RT + (size_t)t * 32 + ((c0 & 63) >> 1));
                    if (pn == 1) {
#pragma unroll
                        for (int k = 0; k < 8; ++k) v[k] *= 0.125f;
                    }
                    *(u32x4*)(PR + (size_t)row * 1536 + pn * 256 + c0) = pack8(v);
                } else if (pn <= 5) {
                    *(u32x4*)(PR + (size_t)row * 1536 + pn * 256 + c0) = pack8(v);
                } else if (pn <= 7) {
                    *(u32x4*)(PC + (size_t)row * 1024 + (pn - 6) * 256 + c0) = pack8(v);
                } else if (pn <= 11) {
                    u32x2 w; w.x = cvtpk(v[0] * v[1], v[2] * v[3]); w.y = cvtpk(v[4] * v[5], v[6] * v[7]);
                    *(u32x2*)(PC + (size_t)row * 1024 + 512 + (pn - 8) * 128 + (c0 >> 1)) = w;
                } else if (pn <= 14) {
                    if (pn == 14 && bj == 1) {
                        if (wc == 0) {
                            if (lat) { const int a = fq >> 1, pos = a ? (t & 63) : (t >> 6); rot4(v, MT + pos * 8 + (fq & 1) * 4); }
                            const u32x4 w = pack8(v);
#pragma unroll
                            for (int hh = 0; hh < 8; ++hh) *(u32x4*)(KB + ((size_t)(bl * 8 + hh) * SB + s) * 96 + 64 + 8 * fq) = w;
                        }
                    } else {
                        *(u32x4*)(PM + (size_t)row * 640 + (pn - 12) * 256 + c0) = pack8(v);
                        float q = 0.f;
#pragma unroll
                        for (int k = 0; k < 8; ++k) q += v[k] * v[k];
                        ss[bj] = q;
                    }
                } else {
                    float g[8];
#pragma unroll
                    for (int k = 0; k < 8; ++k) { const float x = fminf(fmaxf(v[k], -15.f), 15.f); g[k] = sigmoidf_(x); }
                    *(u32x4*)(PG + (size_t)row * 3072 + (pn - 15) * 256 + c0) = pack8(g);
                }
            }
            if (pn >= 12 && pn <= 14) {
                float a = ss[0], b = ss[1];
                a += swz_xor<16>(a); a = half_sum(a); b += swz_xor<16>(b); b = half_sum(b);
                if (fq == 0) {
                    float* sq = SSQ + (size_t)row * 16;
                    if (pn == 12) sq[wc] = a + b;
                    else if (pn == 13) { sq[4 + wc] = a; sq[8 + wc] = b; }
                    else sq[12 + wc] = a;
                }
            }
        }
    }
};

struct EpiUq {
    EPI_NOHOOK
    bf16_t* QB; const float* SSQ; const f32x2* MT;
    __device__ __forceinline__ void operator()(const pg8::Acc& acc, const pg8::Unit& u_, int wr, int wc, int fr, int fq) const {
        pg8::Unit u = u_; asm volatile("" : "+s"(u.pm), "+s"(u.pn), "+s"(u.aux0), "+s"(u.aux1));
#pragma unroll
        for (int ai = 0; ai < 2; ++ai)
#pragma unroll
        for (int m = 0; m < 4; ++m) { __builtin_amdgcn_sched_barrier(0);
            const int row = u.pm * 256 + ai * 128 + wr * 64 + m * 16 + fr;
            const int bl = row / SB, s = row - bl * SB; const bool lat = s >= CTXL; const int t = lat ? s - CTXL : 0;
            const f32x4 q0 = *(const f32x4*)(SSQ + (size_t)row * 16), q1 = *(const f32x4*)(SSQ + (size_t)row * 16 + 4);
            const float ssq = ((q0[0] + q0[1]) + (q0[2] + q0[3])) + ((q1[0] + q1[1]) + (q1[2] + q1[3]));
            const float rq = rsqrtf(ssq * (1.f / 384.f) + RMS_EPS) * QSCALE;
#pragma unroll
            for (int bj = 0; bj < 2; ++bj) {
                const int cg = u.pn * 256 + bj * 128 + wc * 32 + 8 * fq; const int h = cg / 96, d0 = cg - h * 96;
                EPI_V8(v, acc, ai, bj, m)
#pragma unroll
                for (int k = 0; k < 8; ++k) v[k] *= rq;
                if (d0 >= 64 && lat) { const int p0 = d0 - 64, a = p0 >> 4, pos = a ? (t & 63) : (t >> 6); rot4(v, MT + pos * 8 + ((p0 & 15) >> 1)); }
                *(u32x4*)(QB + ((size_t)(bl * 8 + h) * SB + s) * 96 + d0) = pack8(v);
            }
        }
    }
};
struct EpiUkv {
    EPI_NOHOOK
    bf16_t *KB, *VB; const float* SSQ;
    __device__ __forceinline__ void operator()(const pg8::Acc& acc, const pg8::Unit& u_, int wr, int wc, int fr, int fq) const {
        pg8::Unit u = u_; asm volatile("" : "+s"(u.pm), "+s"(u.pn), "+s"(u.aux0), "+s"(u.aux1));
#pragma unroll
        for (int ai = 0; ai < 2; ++ai)
#pragma unroll
        for (int m = 0; m < 4; ++m) { __builtin_amdgcn_sched_barrier(0);
            const int row = u.pm * 256 + ai * 128 + wr * 64 + m * 16 + fr;
            const int bl = row / SB, s = row - bl * SB;
            const f32x4 q0 = *(const f32x4*)(SSQ + (size_t)row * 16 + 8), q1 = *(const f32x4*)(SSQ + (size_t)row * 16 + 12);
            const float ssq = ((q0[0] + q0[1]) + (q0[2] + q0[3])) + ((q1[0] + q1[1]) + (q1[2] + q1[3]));
            const float rk = rsqrtf(ssq * (1.f / 256.f) + RMS_EPS);
#pragma unroll
            for (int bj = 0; bj < 2; ++bj) {
                const int cg = u.pn * 256 + bj * 128 + wc * 32 + 8 * fq; const int h = cg >> 7, e0 = cg & 127;
                EPI_V8(v, acc, ai, bj, m)
#pragma unroll
                for (int k = 0; k < 8; ++k) v[k] *= rk;
                if (e0 < 64) *(u32x4*)(KB + ((size_t)(bl * 8 + h) * SB + s) * 96 + e0) = pack8(v);
                else *(u32x4*)(VB + ((size_t)(bl * 8 + h) * SB + s) * 64 + (e0 - 64)) = pack8(v);
            }
        }
    }
};

struct EpiMerge1 {
    static constexpr bool HOOK = true; static constexpr int HOOK_T0 = 8, HOOK_T1 = 16;
    const bf16_t* PG; bf16_t* M;
    __device__ __forceinline__ void hook(pg8::Acc& acc, const pg8::Unit& u_, int t, int wr, int wc, int fr, int fq) const {
        pg8::Unit u = u_; asm volatile("" : "+s"(u.pm), "+s"(u.pn));
        const int gi = (t == 8) ? 0 : 1;
#pragma unroll
        for (int ai = 0; ai < 2; ++ai)
#pragma unroll
        for (int m = 0; m < 4; ++m) { __builtin_amdgcn_sched_barrier(0);
            const int row = u.pm * 256 + ai * 128 + wr * 64 + m * 16 + fr;
#pragma unroll
            for (int bj = 0; bj < 2; ++bj) {
                const int cg = u.pn * 256 + bj * 128 + wc * 32 + 8 * fq;
                const bf16_t* p = PG + (size_t)row * 3072 + gi * 1024 + cg;
                const u32x4 sp = *(const u32x4*)p, sn = *(const u32x4*)(p + 1024);
                float a[8], b[8]; unpack8(sp, a); unpack8(sn, b);
                f32x4 r0, r1;
#pragma unroll
                for (int k = 0; k < 4; ++k) { r0[k] = a[k] * __builtin_amdgcn_rcpf(b[k]); r1[k] = a[4 + k] * __builtin_amdgcn_rcpf(b[4 + k]); }
                acc[ai][bj][m][0] *= r0; acc[ai][bj][m][1] *= r1;
            }
        }
    }
    __device__ __forceinline__ void operator()(const pg8::Acc& acc, const pg8::Unit& u_, int wr, int wc, int fr, int fq) const {
        pg8::Unit u = u_; asm volatile("" : "+s"(u.pm), "+s"(u.pn), "+s"(u.aux0), "+s"(u.aux1));
#pragma unroll
        for (int ai = 0; ai < 2; ++ai)
#pragma unroll
        for (int m = 0; m < 4; ++m) { __builtin_amdgcn_sched_barrier(0);
            const int row = u.pm * 256 + ai * 128 + wr * 64 + m * 16 + fr;
#pragma unroll
            for (int bj = 0; bj < 2; ++bj) {
                const int cg = u.pn * 256 + bj * 128 + wc * 32 + 8 * fq;
                const u32x4 s2 = *(const u32x4*)(PG + (size_t)row * 3072 + 2048 + cg);
                float g[8]; unpack8(s2, g);
                EPI_V8(v, acc, ai, bj, m)
#pragma unroll
                for (int k = 0; k < 8; ++k) v[k] *= g[k];
                *(u32x4*)(M + (size_t)row * 1024 + cg) = pack8(v);
            }
        }
    }
};

struct EpiMerge2 {
    EPI_NOHOOK
    Resid R; const float* MODL;
    __device__ __forceinline__ void operator()(const pg8::Acc& acc, const pg8::Unit& u_, int wr, int wc, int fr, int fq) const {
        pg8::Unit u = u_; asm volatile("" : "+s"(u.pm), "+s"(u.pn), "+s"(u.aux0), "+s"(u.aux1));
#pragma unroll
        for (int ai = 0; ai < 2; ++ai)
#pragma unroll
        for (int m = 0; m < 4; ++m) { __builtin_amdgcn_sched_barrier(0);
            const int row = u.pm * 256 + ai * 128 + wr * 64 + m * 16 + fr;
            const float* src = R.src(row); float* dst = R.dst(row); const float* g1 = MODL + R.modv(row) * 6144 + 2048;
#pragma unroll
            for (int bj = 0; bj < 2; ++bj) {
                const int cg = u.pn * 256 + bj * 128 + wc * 32 + 8 * fq;
#pragma unroll
                for (int n = 0; n < 2; ++n) { const f32x4 x = *(const f32x4*)(src + cg + 4 * n), g = *(const f32x4*)(g1 + cg + 4 * n);
                    *(f32x4*)(dst + cg + 4 * n) = x + g * acc[ai][bj][m][n]; }
            }
        }
    }
};

struct EpiMoeUp {
    EPI_NOHOOK
    const int* LIST; const float* WGT; bf16_t* MACT;
    __device__ __forceinline__ void operator()(const pg8::Acc& acc, const pg8::Unit& u_, int wr, int wc, int fr, int fq) const {
        pg8::Unit u = u_; asm volatile("" : "+s"(u.pm), "+s"(u.pn), "+s"(u.aux0), "+s"(u.aux1));
        const int slot = u.pn >> 2;
#pragma unroll
        for (int ai = 0; ai < 2; ++ai)
#pragma unroll
        for (int m = 0; m < 4; ++m) { __builtin_amdgcn_sched_barrier(0);
            const int ri = ai * 128 + wr * 64 + m * 16 + fr; const int tok = LIST[u.aux0 + (ri < u.aux1 ? ri : 0)];
            const float w = WGT[(size_t)tok * 2 + slot];
#pragma unroll
            for (int bj = 0; bj < 2; ++bj) {
                const int c0 = bj * 128 + wc * 32 + 8 * fq;
                EPI_V8(v, acc, ai, bj, m)
                u32x2 o; o.x = cvtpk(siluf_(v[0]) * v[1] * w, siluf_(v[2]) * v[3] * w); o.y = cvtpk(siluf_(v[4]) * v[5] * w, siluf_(v[6]) * v[7] * w);
                *(u32x2*)(MACT + (size_t)(u.pm * 256 + ri) * 1024 + slot * 512 + (u.pn & 3) * 128 + (c0 >> 1)) = o;
            }
        }
    }
};
struct EpiMoeDown {
    EPI_NOHOOK
    const int* LIST; Resid R; const float* MODL;
    __device__ __forceinline__ void operator()(const pg8::Acc& acc, const pg8::Unit& u_, int wr, int wc, int fr, int fq) const {
        pg8::Unit u = u_; asm volatile("" : "+s"(u.pm), "+s"(u.pn), "+s"(u.aux0), "+s"(u.aux1));
#pragma unroll
        for (int ai = 0; ai < 2; ++ai)
#pragma unroll
        for (int m = 0; m < 4; ++m) { __builtin_amdgcn_sched_barrier(0);
            const int ri = ai * 128 + wr * 64 + m * 16 + fr;
            if (ri < u.aux1) {
                const int tok = LIST[u.aux0 + ri];
                float* dst = R.dst(tok); const float* g2 = MODL + R.modv(tok) * 6144 + 5120;
#pragma unroll
                for (int bj = 0; bj < 2; ++bj) {
                    const int cg = u.pn * 256 + bj * 128 + wc * 32 + 8 * fq;
#pragma unroll
                    for (int n = 0; n < 2; ++n) { const f32x4 x = *(const f32x4*)(dst + cg + 4 * n), g = *(const f32x4*)(g2 + cg + 4 * n);
                        *(f32x4*)(dst + cg + 4 * n) = x + g * acc[ai][bj][m][n]; }
                }
            }
        }
    }
};
#define SBAR() __builtin_amdgcn_sched_barrier(0)
__device__ __forceinline__ int crow(int r, int hi) { return (r & 3) + 8 * (r >> 2) + 4 * hi; }
template <int NCB> __device__ __forceinline__ int v_st(int k, int c) { const int kk = (k & ~0xC) | ((k & 4) << 1) | ((k & 8) >> 1); return ((kk >> 3) * NCB + (c >> 5)) * 512 + ((kk & 7) * 32 + (c & 31)) * 2; }
__device__ __forceinline__ int v_rd_base(int lane) { return ((lane & 3) << 3) | (((lane >> 2) & 3) << 6) | (((lane >> 4) & 1) << 5) | (((lane >> 5) & 1) << 8); }
template <int OFF> __device__ __forceinline__ s16x4 tr_read(int vb) { s16x4 r; asm volatile("ds_read_b64_tr_b16 %0, %1 offset:%2" : "=&v"(r) : "v"(vb), "i"(OFF) : "memory"); return r; }
#define PKLH(L, H) (bf16x8){L[0], L[1], L[2], L[3], H[0], H[1], H[2], H[3]}
template <int NCB, int KS> __device__ __forceinline__ bf16x8 tr_frag(int vb) { const s16x4 l = tr_read<KS * NCB * 1024>(vb), h = tr_read<KS * NCB * 1024 + NCB * 512>(vb); return PKLH(l, h); }
#define PK4(P, BASE, OUT) do { const unsigned a0 = cvtpk(P[BASE + 0], P[BASE + 1]), a1 = cvtpk(P[BASE + 2], P[BASE + 3]);   \
    const unsigned b0 = cvtpk(P[BASE + 4], P[BASE + 5]), b1 = cvtpk(P[BASE + 6], P[BASE + 7]);                              \
    auto r0 = __builtin_amdgcn_permlane32_swap(a0, b0, false, false); auto r1 = __builtin_amdgcn_permlane32_swap(a1, b1, false, false); \
    u32x4 w = {r0[0], r1[0], r0[1], r1[1]}; OUT = __builtin_bit_cast(bf16x8, w); } while (0)

namespace att {
constexpr int DQK = 96, DV = 64, KVBLK = 64;
constexpr int SHM_V = KVBLK * DV * 2;
constexpr int SHM_K = KVBLK * 256;
constexpr float THR = 8.f;
#define KSWZ(row, colB) ((row) * 256 + ((colB) ^ (((row) & 7) << 4)))
__device__ __forceinline__ void partialSM(f32x16& p0, f32x16& p1, float& m_reg, float& alpha) {
    float pmax = p0[0];
#pragma unroll
    for (int r = 1; r < 16; ++r) pmax = fmaxf(pmax, p0[r]);
#pragma unroll
    for (int r = 0; r < 16; ++r) pmax = fmaxf(pmax, p1[r]);
    { auto rr = __builtin_amdgcn_permlane32_swap(__float_as_uint(pmax), __float_as_uint(pmax), false, false);
      pmax = fmaxf(__uint_as_float(rr[0]), __uint_as_float(rr[1])); }
    float mn;
    if (__builtin_expect(__all(pmax - m_reg <= THR), 1)) { mn = m_reg; alpha = 1.f; }
    else { mn = fmaxf(m_reg, pmax); alpha = __builtin_amdgcn_exp2f(m_reg - mn); m_reg = mn; }
#pragma unroll
    for (int r = 0; r < 16; ++r) p0[r] = p0[r] - mn;
#pragma unroll
    for (int r = 0; r < 16; ++r) p1[r] = p1[r] - mn;
#pragma unroll
    for (int r = 0; r < 16; ++r) p0[r] = __builtin_amdgcn_exp2f(p0[r]);
}
__device__ __forceinline__ void finishSM(f32x16& p0, f32x16& p1, float alpha, float& l_reg, bf16x8& pa0, bf16x8& pa1, bf16x8& pa2, bf16x8& pa3) {
#pragma unroll
    for (int r = 0; r < 16; ++r) p1[r] = __builtin_amdgcn_exp2f(p1[r]);
    float ps = 0;
#pragma unroll
    for (int r = 0; r < 16; ++r) ps += p0[r];
#pragma unroll
    for (int r = 0; r < 16; ++r) ps += p1[r];
    { auto rr = __builtin_amdgcn_permlane32_swap(__float_as_uint(ps), __float_as_uint(ps), false, false);
      ps = __uint_as_float(rr[0]) + __uint_as_float(rr[1]); }
    l_reg = l_reg * alpha + ps;
    PK4(p0, 0, pa0); PK4(p0, 8, pa1); PK4(p1, 0, pa2); PK4(p1, 8, pa3);
}
__device__ __forceinline__ void qkt(f32x16& p0, f32x16& p1, const LAS char* Ks, const bf16x8* qr, int r32, int hi) {
    p0 = f32x16{}; p1 = f32x16{};
#pragma unroll
    for (int d0 = 0; d0 < 6; ++d0) { const int cb = (d0 * 16 + hi * 8) * 2;
        const bf16x8 b0 = *(const LAS bf16x8*)(Ks + KSWZ(r32, cb));
        const bf16x8 b1 = *(const LAS bf16x8*)(Ks + KSWZ(32 + r32, cb));
        p0 = __builtin_amdgcn_mfma_f32_32x32x16_bf16(b0, qr[d0], p0, 0, 0, 0);
        p1 = __builtin_amdgcn_mfma_f32_32x32x16_bf16(b1, qr[d0], p1, 0, 0, 0); }
}
template <int D0> __device__ __forceinline__ void pv_one(f32x16& od, int vb, bf16x8 pa0, bf16x8 pa1, bf16x8 pa2, bf16x8 pa3) {
    const bf16x8 f0 = tr_frag<2, 0>(vb + D0 * 512), f1 = tr_frag<2, 1>(vb + D0 * 512), f2 = tr_frag<2, 2>(vb + D0 * 512), f3 = tr_frag<2, 3>(vb + D0 * 512);
    asm volatile("s_waitcnt lgkmcnt(0)" ::: "memory"); SBAR();
    od = __builtin_amdgcn_mfma_f32_32x32x16_bf16(pa0, f0, od, 0, 0, 0);
    od = __builtin_amdgcn_mfma_f32_32x32x16_bf16(pa1, f1, od, 0, 0, 0);
    od = __builtin_amdgcn_mfma_f32_32x32x16_bf16(pa2, f2, od, 0, 0, 0);
    od = __builtin_amdgcn_mfma_f32_32x32x16_bf16(pa3, f3, od, 0, 0, 0);
}
__device__ __forceinline__ void pv_d0(f32x16* o, int vb, bf16x8 pa0, bf16x8 pa1, bf16x8 pa2, bf16x8 pa3) {
    pv_one<0>(o[0], vb, pa0, pa1, pa2, pa3); pv_one<1>(o[1], vb, pa0, pa1, pa2, pa3);
}
__device__ __forceinline__ void attn_unit(const bf16_t* __restrict__ Qb, const bf16_t* __restrict__ Kh, const bf16_t* __restrict__ Vh, bf16_t* __restrict__ Ob, int ldo, int seq, LAS char* lds, const int wv) {
    const int tid = otid(wv), wid = __builtin_amdgcn_readfirstlane(tid >> 6), lane = tid & 63, r32 = lane & 31, hi = lane >> 5;
    LAS char* V_lds = lds; LAS char* K_lds = lds + 2 * SHM_V;
    LAS float* ws = (LAS float*)(lds + 2 * SHM_V + 2 * SHM_K) + wid * 64; LAS float* li_l = ws; LAS float* al_l = ws + 32;
    float m_reg = -1e30f, l_reg = 0; f32x16 o[2] = {}; bf16x8 qr[6];
    const bf16_t* Qw = Qb + (size_t)(wid * 32 + r32) * DQK + hi * 8;
#pragma unroll
    for (int d0 = 0; d0 < 6; ++d0) qr[d0] = *(const bf16x8*)(Qw + d0 * 16);
    const int vrow = tid >> 3, vc = (tid & 7) * 8, vst = v_st<2>(vrow, vc);
    const int krA = tid / 12, kcA = tid - krA * 12, sB = 512 + tid, krB = sB / 12, kcB = sB - krB * 12;
    const int kstA = KSWZ(krA, kcA * 16), kstB = KSWZ(krB, kcB * 16);
    const bool hasB = wid < 4;
    const int vb0 = (int)(size_t)V_lds + v_rd_base(lane);
    struct { bf16x8 v, ka, kb; } sr_[2];
#define SLOAD(i, k0) do { sr_[i].v = *(const bf16x8*)(Vh + (size_t)((k0) + vrow) * DV + vc); sr_[i].ka = *(const bf16x8*)(Kh + (size_t)((k0) + krA) * DQK + kcA * 8); \
    if (hasB) sr_[i].kb = *(const bf16x8*)(Kh + (size_t)((k0) + krB) * DQK + kcB * 8); } while (0)
#define SWRITE(b, i) do { *(LAS bf16x8*)(V_lds + (b) * SHM_V + vst) = sr_[i].v; *(LAS bf16x8*)(K_lds + (b) * SHM_K + kstA) = sr_[i].ka; \
    if (hasB) *(LAS bf16x8*)(K_lds + (b) * SHM_K + kstB) = sr_[i].kb; } while (0)
#define RESC(a) do { if (__any((a) < 1.f)) { if (hi == 0) al_l[r32] = (a); asm volatile("s_waitcnt lgkmcnt(0)" ::: "memory"); \
    _Pragma("unroll") for (int d = 0; d < 2; ++d) _Pragma("unroll") for (int r = 0; r < 16; ++r) o[d][r] *= al_l[crow(r, hi)]; } } while (0)
    f32x16 pA0, pA1, pB0, pB1; float alA, alB; bf16x8 pa0, pa1, pa2, pa3; const int NTL = seq / KVBLK;
    SLOAD(0, 0); SWRITE(0, 0); __syncthreads();
    qkt(pA0, pA1, K_lds, qr, r32, hi); partialSM(pA0, pA1, m_reg, alA);
    SLOAD(1, KVBLK); if (2 < NTL) SLOAD(0, 2 * KVBLK);
    SWRITE(1, 1); __syncthreads();
    for (int j = 1; j + 1 < NTL; j += 2) {
        SBAR(); qkt(pB0, pB1, K_lds + SHM_K, qr, r32, hi);
        finishSM(pA0, pA1, alA, l_reg, pa0, pa1, pa2, pa3); SBAR();
        SLOAD(1, (j + 2) * KVBLK); SBAR();
        pv_d0(o, vb0, pa0, pa1, pa2, pa3); partialSM(pB0, pB1, m_reg, alB);
        __syncthreads(); SWRITE(0, 0);
        RESC(alB); __syncthreads();
        SBAR(); qkt(pA0, pA1, K_lds, qr, r32, hi);
        finishSM(pB0, pB1, alB, l_reg, pa0, pa1, pa2, pa3); SBAR();
        if (j + 3 < NTL) SLOAD(0, (j + 3) * KVBLK); SBAR();
        pv_d0(o, vb0 + SHM_V, pa0, pa1, pa2, pa3); partialSM(pA0, pA1, m_reg, alA);
        __syncthreads(); SWRITE(1, 1);
        RESC(alA); __syncthreads();
    }
    SBAR(); qkt(pB0, pB1, K_lds + SHM_K, qr, r32, hi);
    finishSM(pA0, pA1, alA, l_reg, pa0, pa1, pa2, pa3); SBAR();
    pv_d0(o, vb0, pa0, pa1, pa2, pa3); partialSM(pB0, pB1, m_reg, alB);
    __syncthreads(); RESC(alB);
    finishSM(pB0, pB1, alB, l_reg, pa0, pa1, pa2, pa3); SBAR();
    pv_d0(o, vb0 + SHM_V, pa0, pa1, pa2, pa3);
    if (hi == 0) li_l[r32] = l_reg; asm volatile("s_waitcnt lgkmcnt(0)" ::: "memory");
    float rli[16];
#pragma unroll
    for (int r = 0; r < 16; ++r) rli[r] = __builtin_amdgcn_rcpf(li_l[crow(r, hi)]);
    bf16_t* Ow = Ob + (size_t)(wid * 32) * ldo;
#pragma unroll
    for (int r = 0; r < 16; ++r) { const int orow = crow(r, hi);
#pragma unroll
        for (int d0 = 0; d0 < 2; ++d0) Ow[(size_t)orow * ldo + d0 * 32 + r32] = f2bf(o[d0][r] * rli[r]); }
    __syncthreads();
#undef SLOAD
#undef SWRITE
#undef RESC
}
}

__device__ __forceinline__ void retu_unit(int unit, const bf16_t* PR, float* U, float lg2f, float lg2b, LAS char* lds, const int wv) {
    const int tid = otid(wv), wid = __builtin_amdgcn_readfirstlane(tid >> 6), lane = tid & 63, r32 = lane & 31, hi = lane >> 5;
    const int h = unit & 3, bc = unit >> 2, bl = bc / NCHUNK, c = bc - bl * NCHUNK;
    const size_t r0 = (size_t)bl * SB + (size_t)c * 128;
    LAS char* Vt = lds;
    LAS char* Kf = lds + 32768;
    LAS char* Kb = lds + 49152;
#pragma unroll
    for (int i = 0; i < 2; ++i) { const int ch = tid + i * 512, j = ch >> 3, c8 = (ch & 7) * 8;
        const u32x4 kw = *(const u32x4*)(PR + (r0 + j) * 1536 + 256 + h * 64 + c8);
        float f[8], g[8]; unpack8(kw, f);
        const float wf = __builtin_amdgcn_exp2f(lg2f * (float)(127 - j)), wb = __builtin_amdgcn_exp2f(lg2b * (float)j);
#pragma unroll
        for (int k = 0; k < 8; ++k) { g[k] = f[k] * wb; f[k] *= wf; }
        const int off = (j >> 6) * 8192 + v_st<2>(j & 63, c8);
        *(LAS u32x4*)(Kf + off) = pack8(f); *(LAS u32x4*)(Kb + off) = pack8(g); }
#pragma unroll
    for (int i = 0; i < 4; ++i) { const int ch = tid + i * 512, j = ch >> 4, c8 = (ch & 15) * 8;
        const u32x4 vw = *(const u32x4*)(PR + (r0 + j) * 1536 + 512 + h * 128 + c8);
        *(LAS u32x4*)(Vt + (j >> 6) * 16384 + v_st<4>(j & 63, c8)) = vw; }
    __syncthreads();
    const int eblk = wid & 3, dblk = wid >> 2;
    const int vbV = (int)(size_t)Vt + v_rd_base(lane) + eblk * 512, vbF = (int)(size_t)Kf + v_rd_base(lane) + dblk * 512, vbB = (int)(size_t)Kb + v_rd_base(lane) + dblk * 512;
    f32x16 aF = {}, aB = {};
#define RU_STEP(SUB, KS) do { const bf16x8 a = tr_frag<4, KS>(vbV + SUB * 16384), bf = tr_frag<2, KS>(vbF + SUB * 8192), bb = tr_frag<2, KS>(vbB + SUB * 8192); \
        asm volatile("s_waitcnt lgkmcnt(0)" ::: "memory"); SBAR(); \
        aF = __builtin_amdgcn_mfma_f32_32x32x16_bf16(a, bf, aF, 0, 0, 0); aB = __builtin_amdgcn_mfma_f32_32x32x16_bf16(a, bb, aB, 0, 0, 0); } while (0)
    RU_STEP(0, 0); RU_STEP(0, 1); RU_STEP(0, 2); RU_STEP(0, 3); RU_STEP(1, 0); RU_STEP(1, 1); RU_STEP(1, 2); RU_STEP(1, 3);
#undef RU_STEP
    float* Uf = U + (size_t)unit * 2 * 8192; float* Ub = Uf + 8192;
#pragma unroll
    for (int r = 0; r < 16; ++r) { const int e = 32 * eblk + crow(r, hi), d = 32 * dblk + r32; Uf[e * 64 + d] = aF[r]; Ub[e * 64 + d] = aB[r]; }
    __syncthreads();
}

__device__ __forceinline__ void retout_unit(int unit, const bf16_t* PR, const bf16_t* S, const float* gnw, bf16_t* ACT, float lg2f, float lg2b, LAS char* lds, const int wv) {
    const int tid = otid(wv), wid = __builtin_amdgcn_readfirstlane(tid >> 6), lane = tid & 63, r32 = lane & 31, hi = lane >> 5;
    const int h = unit & 3, bc = unit >> 2, bl = bc / NCHUNK, c = bc - bl * NCHUNK;
    const size_t r0 = (size_t)bl * SB + (size_t)c * 128;
    LAS char* Vt = lds; LAS float* part = (LAS float*)(lds + 32768);
#pragma unroll
    for (int i = 0; i < 4; ++i) { const int ch = tid + i * 512, j = ch >> 4, c8 = (ch & 15) * 8;
        const u32x4 vw = *(const u32x4*)(PR + (r0 + j) * 1536 + 512 + h * 128 + c8);
        *(LAS u32x4*)(Vt + (j >> 6) * 16384 + v_st<4>(j & 63, c8)) = vw; }
    const int qblk = wid & 3, ehalf = wid >> 2, iq = 32 * qblk + r32;
    bf16x8 qf[4];
    const bf16_t* qp = PR + (r0 + iq) * 1536 + h * 64 + hi * 8;
#pragma unroll
    for (int d0 = 0; d0 < 4; ++d0) qf[d0] = *(const bf16x8*)(qp + d0 * 16);
    f32x16 o[2] = {};
    __syncthreads();
    const int vb = (int)(size_t)Vt + v_rd_base(lane) + ehalf * 1024;
#pragma unroll
    for (int jb = 0; jb < 4; ++jb) {
        f32x16 p = {};
        const bf16_t* kp = PR + (r0 + 32 * jb + r32) * 1536 + 256 + h * 64 + hi * 8;
#pragma unroll
        for (int d0 = 0; d0 < 4; ++d0) { const bf16x8 kf = *(const bf16x8*)(kp + d0 * 16); p = __builtin_amdgcn_mfma_f32_32x32x16_bf16(kf, qf[d0], p, 0, 0, 0); }
#pragma unroll
        for (int r = 0; r < 16; ++r) { const int dj = iq - (32 * jb + crow(r, hi));
            const float e = dj >= 0 ? lg2f * (float)dj : lg2b * (float)(-dj); p[r] *= __builtin_amdgcn_exp2f(e); }
        bf16x8 pa0, pa1; PK4(p, 0, pa0); PK4(p, 8, pa1);
        const int vj = vb + (jb >> 1) * 16384;
        if (jb & 1) {
            const bf16x8 f00 = tr_frag<4, 2>(vj), f01 = tr_frag<4, 3>(vj), f10 = tr_frag<4, 2>(vj + 512), f11 = tr_frag<4, 3>(vj + 512);
            asm volatile("s_waitcnt lgkmcnt(0)" ::: "memory"); SBAR();
            o[0] = __builtin_amdgcn_mfma_f32_32x32x16_bf16(pa0, f00, o[0], 0, 0, 0); o[0] = __builtin_amdgcn_mfma_f32_32x32x16_bf16(pa1, f01, o[0], 0, 0, 0);
            o[1] = __builtin_amdgcn_mfma_f32_32x32x16_bf16(pa0, f10, o[1], 0, 0, 0); o[1] = __builtin_amdgcn_mfma_f32_32x32x16_bf16(pa1, f11, o[1], 0, 0, 0);
        } else {
            const bf16x8 f00 = tr_frag<4, 0>(vj), f01 = tr_frag<4, 1>(vj), f10 = tr_frag<4, 0>(vj + 512), f11 = tr_frag<4, 1>(vj + 512);
            asm volatile("s_waitcnt lgkmcnt(0)" ::: "memory"); SBAR();
            o[0] = __builtin_amdgcn_mfma_f32_32x32x16_bf16(pa0, f00, o[0], 0, 0, 0); o[0] = __builtin_amdgcn_mfma_f32_32x32x16_bf16(pa1, f01, o[0], 0, 0, 0);
            o[1] = __builtin_amdgcn_mfma_f32_32x32x16_bf16(pa0, f10, o[1], 0, 0, 0); o[1] = __builtin_amdgcn_mfma_f32_32x32x16_bf16(pa1, f11, o[1], 0, 0, 0);
        }
    }
    {
        const float xf = __builtin_amdgcn_exp2f(lg2f * (float)(iq + 1)), xb = __builtin_amdgcn_exp2f(lg2b * (float)(128 - iq));
        const bf16_t* Sf = S + (size_t)unit * 2 * 8192; const bf16_t* Sb = Sf + 8192;
#pragma unroll
        for (int d0 = 0; d0 < 4; ++d0) {
            float f[8], g[8]; unpack8(__builtin_bit_cast(u32x4, qf[d0]), f);
#pragma unroll
            for (int k = 0; k < 8; ++k) { g[k] = f[k] * xb; f[k] *= xf; }
            const bf16x8 qa = __builtin_bit_cast(bf16x8, pack8(f)), qb = __builtin_bit_cast(bf16x8, pack8(g));
#pragma unroll
            for (int e0 = 0; e0 < 2; ++e0) { const int e = 64 * ehalf + 32 * e0 + r32;
                const bf16x8 sf = *(const bf16x8*)(Sf + e * 64 + d0 * 16 + hi * 8), sb = *(const bf16x8*)(Sb + e * 64 + d0 * 16 + hi * 8);
                o[e0] = __builtin_amdgcn_mfma_f32_32x32x16_bf16(qa, sf, o[e0], 0, 0, 0); o[e0] = __builtin_amdgcn_mfma_f32_32x32x16_bf16(qb, sb, o[e0], 0, 0, 0); }
        }
    }
    float sq[16];
#pragma unroll
    for (int r = 0; r < 16; ++r) { float s = o[0][r] * o[0][r] + o[1][r] * o[1][r];
        sq[r] = sum32(s); }
    if (r32 == 0) {
#pragma unroll
        for (int r = 0; r < 16; ++r) part[wid * 32 + crow(r, hi)] = sq[r];
    }
    __syncthreads();
    const float g0 = gnw[h * 128 + 64 * ehalf + r32], g1 = gnw[h * 128 + 64 * ehalf + 32 + r32];
#pragma unroll
    for (int r = 0; r < 16; ++r) { const int il = crow(r, hi);
        const float tot = part[wid * 32 + il] + part[(wid ^ 4) * 32 + il];
        const float rn = rsqrtf(tot * (1.f / 128.f) + RMS_EPS);
        const size_t row = r0 + 32 * qblk + il;
        const bf16_t* gp = PR + row * 1536 + 1024 + h * 128 + 64 * ehalf + r32;
        bf16_t* op = ACT + row * 1536 + h * 128 + 64 * ehalf + r32;
        op[0] = f2bf(siluf_(bf1(gp[0])) * (o[0][r] * rn * g0)); op[32] = f2bf(siluf_(bf1(gp[32])) * (o[1][r] * rn * g1)); }
    __syncthreads();
}
struct Args { const float* in[26]; float* out; unsigned char* ws; int ph_lo, ph_hi; };
struct Frame {
    LAS unsigned char* lds; int G, wv;
    const Args* a; float* out; unsigned char* ws;
};
__device__ __forceinline__ const float* in_ptr(const Args* a, int i) { int z; asm volatile("s_mov_b32 %0, 0" : "=s"(z)); return a->in[i + z]; }
#define INP(i) in_ptr(F.a, (i))
#define WSP(T, off) ((T*)(F.ws + (off)))

__device__ __forceinline__ int srccol_in(int n) {
    if (n < 512) { const int base = n & ~255, hh = (n & 255) >> 6, p = n & 63; return base + hh * 64 + (p >> 1) + 32 * (p & 1); }
    if (n < 2048) return n;
    if (n < 3072) { const int j = (n - 2048) >> 1; return 2048 + j + 512 * (n & 1); }
    if (n < 3712) return n;
    if (n < 3744) { const int p = n - 3712, a = p >> 4, q = p & 15; return 3712 + a * 16 + (q >> 1) + 8 * (q & 1); }
    if (n < 3840) return -1;
    return n - 96;
}
__device__ __forceinline__ int srccol_uq(int n) { const int h = n / 96, d = n - h * 96; if (d < 64) return n; const int p = d - 64, a = p >> 4, q = p & 15; return h * 96 + 64 + a * 16 + (q >> 1) + 8 * (q & 1); }

__device__ __forceinline__ void cvt_item(const float* sp, int ldw, const float* scale, bf16_t* dst, int ldd, int n0, int k0, LAS float* scr, int lane) {
#pragma unroll 8
    for (int i = 0; i < 32; ++i) { const int kk = 2 * i + (lane >> 5); float v = sp ? sp[(size_t)(k0 + kk) * ldw] : 0.f; if (scale) v *= scale[k0 + kk]; scr[kk * 33 + (lane & 31)] = v; }
    asm volatile("s_waitcnt lgkmcnt(0)" ::: "memory");
    const int c = lane & 7;
#pragma unroll
    for (int j = 0; j < 4; ++j) { const int n = (lane >> 3) + 8 * j; const LAS float* s = scr + (8 * c) * 33 + n;
        u32x4 o; o.x = cvtpk(s[0 * 33], s[1 * 33]); o.y = cvtpk(s[2 * 33], s[3 * 33]); o.z = cvtpk(s[4 * 33], s[5 * 33]); o.w = cvtpk(s[6 * 33], s[7 * 33]);
        *(u32x4*)(dst + (size_t)(n0 + n) * ldd + k0 + 8 * c) = o; }
    asm volatile("s_waitcnt lgkmcnt(0)" ::: "memory");
}

__device__ __forceinline__ f32x2 cossin_f(float ang) {
    const double x = (double)ang * 0.15915494309189535; const float r = (float)(x - rint(x));
    return (f32x2){__builtin_amdgcn_cosf(r), __builtin_amdgcn_sinf(r)};
}
__device__ __forceinline__ float lg2_gamma(const float* rd) { return -__builtin_amdgcn_logf(1.f + __builtin_amdgcn_exp2f(-rd[0] * LOG2E)); }
#define PHASE_IDS const int tid = otid(F.wv), lane = tid & 63, wave = __builtin_amdgcn_readfirstlane(tid >> 6), bid = obid(); (void)lane; (void)wave; (void)bid;
__device__ __forceinline__ void p0_prologue(Frame& F) {
    PHASE_IDS
    if (bid < 48) {
        LAS float* sc = (LAS float*)F.lds;
        LAS float* red = (LAS float*)(F.lds + 40960);
        for (int i = tid; i < 9 * 1024; i += 512) { const int v = i >> 10, k = i & 1023; const float x = v < 8 ? INP(1)[v * 1024 + k] : INP(3)[k]; sc[i] = siluf_(x); }
        __syncthreads();
        const int l = bid / 24, col = (bid % 24) * 256 + (tid & 255), kq = tid >> 8;
        const float* w = INP(4) + (size_t)l * 1024 * 6144 + col;
        float a[9];
#pragma unroll
        for (int v = 0; v < 9; ++v) a[v] = 0.f;
        for (int k = kq * 512; k < kq * 512 + 512; k += 4) {
            const float w0 = w[(size_t)k * 6144], w1 = w[(size_t)(k + 1) * 6144], w2 = w[(size_t)(k + 2) * 6144], w3 = w[(size_t)(k + 3) * 6144];
#pragma unroll
            for (int v = 0; v < 9; ++v) { const f32x4 s = *(const LAS f32x4*)(sc + v * 1024 + k); a[v] += s[0] * w0 + s[1] * w1 + s[2] * w2 + s[3] * w3; }
        }
        if (kq == 1) {
#pragma unroll
            for (int v = 0; v < 9; ++v) red[v * 256 + (tid & 255)] = a[v];
        }
        __syncthreads();
        if (kq == 0) { float* MOD = WSP(float, WS_MOD) + (size_t)l * 9 * 6144; const float b = INP(5)[l * 6144 + col];
#pragma unroll
            for (int v = 0; v < 9; ++v) MOD[v * 6144 + col] = b + a[v] + red[v * 256 + tid]; }
        __syncthreads();
    }
    { f32x2* RT = WSP(f32x2, WS_RT); f32x2* MT = WSP(f32x2, WS_MT);
      for (int i = bid * 512 + tid; i < 8192 * 32 + 128 * 8; i += F.G * 512) {
          if (i < 8192 * 32) { const int t = i >> 5, k = i & 31; const float inv = exp2f(-(float)k * (13.287712379549449f / 32.f)); RT[i] = cossin_f((float)t * inv); }
          else { const int q = i - 8192 * 32, pos = q >> 3, k = q & 7; const float inv = exp2f(-(float)k * (13.287712379549449f / 8.f)); MT[q] = cossin_f((float)pos * inv); } } }
    LAS float* scr = (LAS float*)(F.lds + wave * 16384);
    const int gw = bid * 8 + wave, NGW = F.G * 8;
    constexpr int I_IN = 2 * 16 * 216, I_CAT = 2 * 3 * 8 * 32, I_OUT = 2 * 16 * 32, I_UQ = 2 * 6 * 24, I_UKV = 2 * 4 * 32, I_UP = 32 * 16 * 32, I_W2 = 32 * 8 * 32;
    constexpr int NITEMS = I_IN + I_CAT + I_OUT + I_UQ + I_UKV + I_UP + I_W2;
    for (int it = gw; it < NITEMS; it += NGW) {
        int r = it;
        if (r < I_IN) { const int l = r / 3456, q = r % 3456, kb = q / 216, nb = q % 216; const int sc_ = srccol_in(nb * 32 + (lane & 31));
            cvt_item(sc_ >= 0 ? INP(8) + (size_t)l * 1024 * INCOLS + sc_ : nullptr, INCOLS, nullptr, WSP(bf16_t, WS_WIN) + (size_t)l * INW * 1024, 1024, nb * 32, kb * 64, scr, lane); continue; } r -= I_IN;
        if (r < I_CAT) { const int l = r / 768, q = r % 768, seg = q / 256, q2 = q % 256, kb = q2 / 32, nb = q2 % 32; const float* W = seg == 0 ? INP(11) : (seg == 1 ? INP(13) : INP(18));
            cvt_item(W + (size_t)l * 512 * 1024 + nb * 32 + (lane & 31), 1024, nullptr, WSP(bf16_t, WS_WCAT) + (size_t)l * 1024 * 1536 + seg * 512, 1536, nb * 32, kb * 64, scr, lane); continue; } r -= I_CAT;
        if (r < I_OUT) { const int l = r / 512, q = r % 512, kb = q / 32, nb = q % 32;
            cvt_item(INP(19) + (size_t)l * 1024 * 1024 + nb * 32 + (lane & 31), 1024, nullptr, WSP(bf16_t, WS_WOUT) + (size_t)l * 1024 * 1024, 1024, nb * 32, kb * 64, scr, lane); continue; } r -= I_OUT;
        if (r < I_UQ) { const int l = r / 144, q = r % 144, kb = q / 24, nb = q % 24;
            cvt_item(INP(15) + (size_t)l * 384 * 768 + srccol_uq(nb * 32 + (lane & 31)), 768, INP(14) + l * 384, WSP(bf16_t, WS_WUQ) + (size_t)l * 768 * 384, 384, nb * 32, kb * 64, scr, lane); continue; } r -= I_UQ;
        if (r < I_UKV) { const int l = r / 128, q = r % 128, kb = q / 32, nb = q % 32;
            cvt_item(INP(17) + (size_t)l * 256 * 1024 + nb * 32 + (lane & 31), 1024, INP(16) + l * 256, WSP(bf16_t, WS_WUKV) + (size_t)l * 1024 * 256, 256, nb * 32, kb * 64, scr, lane); continue; } r -= I_UKV;
        if (r < I_UP) { const int le = r / 512, q = r % 512, kb = q / 32, nb = q % 32; const int n = nb * 32 + (lane & 31);
            const float* W = (n & 1) ? INP(23) : INP(22);
            cvt_item(W + (size_t)le * 1024 * 512 + (n >> 1), 512, nullptr, WSP(bf16_t, WS_WUP) + (size_t)le * 1024 * 1024, 1024, nb * 32, kb * 64, scr, lane); continue; } r -= I_UP;
        { const int le = r / 256, q = r % 256, kb = q / 32, nb = q % 32;
            cvt_item(INP(24) + (size_t)le * 512 * 1024 + nb * 32 + (lane & 31), 1024, nullptr, WSP(bf16_t, WS_W2T) + (size_t)le * 1024 * 512, 512, nb * 32, kb * 64, scr, lane); }
    }
}

__device__ __forceinline__ void norm1_phase(Frame& F, const Resid& R, int l, int skip_none) {
    PHASE_IDS
    const int gw = bid * 8 + wave, NGW = F.G * 8; bf16_t* HX = WSP(bf16_t, WS_HX);
    const float* MODL = WSP(float, WS_MOD) + (size_t)l * 9 * 6144; const float* nw = INP(6) + l * 1024;
    for (int row = gw; row < NT; row += NGW) {
        const f32x4* xr = (const f32x4*)R.src(row) + lane; const float* md = MODL + R.modv(row) * 6144;
        f32x4 v[4]; float s = 0.f;
#pragma unroll
        for (int j = 0; j < 4; ++j) { v[j] = xr[64 * j]; s += (v[j][0] * v[j][0] + v[j][1] * v[j][1]) + (v[j][2] * v[j][2] + v[j][3] * v[j][3]); }
        const float rs = rsqrtf(wave_sum(s) * (1.f / DM) + RMS_EPS);
#pragma unroll
        for (int j = 0; j < 4; ++j) { const int c = 4 * lane + 256 * j; const f32x4 w = *(const f32x4*)(nw + c), sh = *(const f32x4*)(md + c), sc = *(const f32x4*)(md + 1024 + c);
            const f32x4 y = v[j] * rs * w * (sc + 1.f) + sh; u32x2 o; o.x = cvtpk(y[0], y[1]); o.y = cvtpk(y[2], y[3]); *(u32x2*)(HX + (size_t)row * 1024 + c) = o; }
    }
}
__device__ __forceinline__ void final_norm_phase(Frame& F, int g) {
    PHASE_IDS
    const int gw = bid * 8 + wave, NGW = F.G * 8; const float* nw = INP(25);
    for (int row = gw; row < GB * SEQ; row += NGW) {
        f32x4* xr = (f32x4*)(F.out + ((size_t)g * GB * SEQ + row) * DM) + lane;
        f32x4 v[4]; float s = 0.f;
#pragma unroll
        for (int j = 0; j < 4; ++j) { v[j] = xr[64 * j]; s += (v[j][0] * v[j][0] + v[j][1] * v[j][1]) + (v[j][2] * v[j][2] + v[j][3] * v[j][3]); }
        const float rs = rsqrtf(wave_sum(s) * (1.f / DM) + RMS_EPS);
#pragma unroll
        for (int j = 0; j < 4; ++j) { const f32x4 w = *(const f32x4*)(nw + 4 * lane + 256 * j); xr[64 * j] = v[j] * rs * w; }
    }
}
__device__ __forceinline__ void conv_phase(Frame& F, int l) {
    PHASE_IDS
    const bf16_t* PC = WSP(bf16_t, WS_PC); bf16_t* ACT = WSP(bf16_t, WS_ACT); const float* cw = INP(12) + (size_t)l * 512 * 3;
    for (int idx = bid * 512 + tid; idx < NT * 64; idx += F.G * 512) {
        const int row = idx >> 6, c8 = (idx & 63) * 8; const int bl = row / SB, s = row - bl * SB;
        const bool hp = (s != 0) && (s != CTXL), hn = (s != CTXL - 1) && (s != SB - 1);
        const bf16_t* p = PC + (size_t)row * 1024 + c8;
        float b[8], u0[8], um[8], up[8];
        unpack8(*(const u32x4*)p, b); unpack8(*(const u32x4*)(p + 512), u0);
        if (hp) unpack8(*(const u32x4*)(p + 512 - 1024), um); else {
#pragma unroll
            for (int k = 0; k < 8; ++k) um[k] = 0.f; }
        if (hn) unpack8(*(const u32x4*)(p + 512 + 1024), up); else {
#pragma unroll
            for (int k = 0; k < 8; ++k) up[k] = 0.f; }
        float o[8];
#pragma unroll
        for (int k = 0; k < 8; ++k) { const float* w = cw + (c8 + k) * 3; o[k] = b[k] * (um[k] * w[0] + u0[k] * w[1] + up[k] * w[2]); }
        *(u32x4*)(ACT + (size_t)row * 1536 + 512 + c8) = pack8(o);
    }
}
__device__ __forceinline__ void scan_phase(Frame& F, int l) {
    PHASE_IDS
    const float* U = WSP(float, WS_HX); bf16_t* S = WSP(bf16_t, WS_PM);
    for (int idx = bid * 512 + tid; idx < GB * 4 * 2 * 8192; idx += F.G * 512) {
        const int ed = idx & 8191, dir = (idx >> 13) & 1, h = (idx >> 14) & 3, bl = idx >> 16;
        const float lg = lg2_gamma(INP(9) + l * 8 + dir * 4 + h); const float dec = __builtin_amdgcn_exp2f(lg * 128.f);
        float st = 0.f;
        for (int i0 = 0; i0 < NCHUNK; i0 += 6) {
            float uu[6]; size_t off[6];
#pragma unroll
            for (int k = 0; k < 6; ++k) { const int i = i0 + k; const int c = dir ? (i < 2 ? 1 - i : NCHUNK + 1 - i) : i;
                off[k] = ((size_t)(((bl * NCHUNK + c) * 4 + h) * 2 + dir)) * 8192 + ed; uu[k] = U[off[k]]; }
#pragma unroll
            for (int k = 0; k < 6; ++k) { S[off[k]] = f2bf(st); st = dec * st + uu[k]; }
        }
    }
}
__device__ __forceinline__ void norm2_router_phase(Frame& F, const Resid& R, int l, int g, int lat_only) {
    PHASE_IDS
    const int gw = bid * 8 + wave, NGW = F.G * 8; bf16_t* H2 = WSP(bf16_t, WS_HX);
    const float* MODL = WSP(float, WS_MOD) + (size_t)l * 9 * 6144; const float* nw = INP(7) + l * 1024;
    LAS float* wr = (LAS float*)F.lds;
    for (int i = tid; i < 16 * 1024; i += 512) { const int k = i >> 4, e = i & 15; wr[e * 1024 + k] = INP(20)[i]; }
    __syncthreads();
    unsigned* CNT = WSP(unsigned, WS_CTL) + CW_CNT + (g * 2 + l) * 64; int* LIST = WSP(int, WS_LIST); float* WGT = WSP(float, WS_WGT);
    for (int row = gw; row < NT; row += NGW) {
        if (lat_only && (row % SB) < CTXL) continue;
        const f32x4* xr = (const f32x4*)R.dst(row) + lane; const float* md = MODL + R.modv(row) * 6144;
        f32x4 v[4]; float s = 0.f;
#pragma unroll
        for (int j = 0; j < 4; ++j) { v[j] = xr[64 * j]; s += (v[j][0] * v[j][0] + v[j][1] * v[j][1]) + (v[j][2] * v[j][2] + v[j][3] * v[j][3]); }
        const float rs = rsqrtf(wave_sum(s) * (1.f / DM) + RMS_EPS);
#pragma unroll
        for (int j = 0; j < 4; ++j) { const int c = 4 * lane + 256 * j; const f32x4 w = *(const f32x4*)(nw + c), sh = *(const f32x4*)(md + 3072 + c), sc = *(const f32x4*)(md + 4096 + c);
            v[j] = v[j] * rs * w * (sc + 1.f) + sh; u32x2 o; o.x = cvtpk(v[j][0], v[j][1]); o.y = cvtpk(v[j][2], v[j][3]); *(u32x2*)(H2 + (size_t)row * 1024 + c) = o; }
        float sc16[16];
#pragma unroll
        for (int e = 0; e < 16; ++e) { float a = 0.f;
#pragma unroll
            for (int j = 0; j < 4; ++j) { const f32x4 w = *(const LAS f32x4*)(wr + e * 1024 + 4 * lane + 256 * j); a += (v[j][0] * w[0] + v[j][1] * w[1]) + (v[j][2] * w[2] + v[j][3] * w[3]); }
            sc16[e] = sigmoidf_(wave_sum(a)); }
        float best = -1e30f; int gs = 0;
#pragma unroll
        for (int q = 0; q < 4; ++q) { float m1 = -1e30f, m2 = -1e30f;
#pragma unroll
            for (int k = 0; k < 4; ++k) { const float b = sc16[q * 4 + k] + INP(21)[q * 4 + k]; if (b > m1) { m2 = m1; m1 = b; } else if (b > m2) m2 = b; }
            const float gsc = m1 + m2; if (gsc > best) { best = gsc; gs = q; } }
        float bb[4], su[4];
#pragma unroll
        for (int k = 0; k < 4; ++k) { float b = 0.f, u = 0.f;
#pragma unroll
            for (int q = 0; q < 4; ++q) { if (q == gs) { b = sc16[q * 4 + k] + INP(21)[q * 4 + k]; u = sc16[q * 4 + k]; } }
            bb[k] = b; su[k] = u; }
        int i1 = 0; float b1 = bb[0];
#pragma unroll
        for (int k = 1; k < 4; ++k) if (bb[k] > b1) { b1 = bb[k]; i1 = k; }
        int i2 = -1; float b2 = -1e30f;
#pragma unroll
        for (int k = 0; k < 4; ++k) if (k != i1 && bb[k] > b2) { b2 = bb[k]; i2 = k; }
        const int lo = i1 < i2 ? i1 : i2, hi = i1 < i2 ? i2 : i1;
        float slo = 0.f, shi = 0.f;
#pragma unroll
        for (int k = 0; k < 4; ++k) { if (k == lo) slo = su[k]; if (k == hi) shi = su[k]; }
        const float inv = 1.f / (slo + shi);
        const int pair = lo == 0 ? hi - 1 : (lo == 1 ? hi + 1 : 5);
        const int bucket = gs * 6 + pair;
        if (lane == 0) { const unsigned pos = atomicAdd(CNT + bucket, 1u); LIST[(size_t)bucket * NT + pos] = row; WGT[(size_t)row * 2] = slo * inv; WGT[(size_t)row * 2 + 1] = shi * inv; }
    }
    __syncthreads();
}
__device__ __forceinline__ void moe_tables(Frame& F, int l, int g) {
    PHASE_IDS
    LAS int* tab = (LAS int*)(F.lds + LDS_MOE_OFF);
    if (tid == 0) { const unsigned* CNT = WSP(unsigned, WS_CTL) + CW_CNT + (g * 2 + l) * 64; int pre = 0;
#pragma nounroll
        for (int p = 0; p < NPAIR; ++p) { const int c = (int)__hip_atomic_load(CNT + p, __ATOMIC_RELAXED, __HIP_MEMORY_SCOPE_AGENT); tab[p] = pre; tab[32 + p] = c; pre += (c + 255) >> 8; }
        tab[24] = pre; }
    __syncthreads();
}
#ifndef PHMASK
#define PHMASK 0xFFFF
#endif
#define PHM(k) (((PHMASK) >> (k)) & 1)

__global__ void __launch_bounds__(512, 2) dit_fwd(Args args) {
    extern __shared__ __attribute__((aligned(16))) unsigned char lds_raw[];
    Frame F;
    F.lds = (LAS unsigned char*)lds_raw;
    F.G = gridDim.x; F.wv = __builtin_amdgcn_readfirstlane((int)threadIdx.x >> 6);
    F.a = &args; F.out = args.out; F.ws = args.ws;
    for (int u = threadIdx.x; u < (LDS_BYTES - LDSCTL_OFF) / 4; u += 512) ((LAS unsigned*)(F.lds + LDSCTL_OFF))[u] = 0u;
    __syncthreads();
    XcdBarrier bar = xcd_barrier_post(WSP(unsigned, WS_CTL) + CW_BAR, (volatile LAS unsigned*)(F.lds + LDSCTL_OFF));
#define GRID_BAR() do { asm volatile("; PHASE_SEAM" ::: "memory"); xcd_barrier(bar, F.wv); } while (0)

    if constexpr (PHM(0)) p0_prologue(F);
    GRID_BAR();

#pragma nounroll
    for (int g = 0; g < NG; ++g) {
#pragma nounroll
        for (int l = 0; l < DEPTH; ++l) {
            Resid R; R.src_lat = l == 0 ? INP(0) : F.out; R.src_ctx = l == 0 ? INP(2) : WSP(float, WS_XC); R.dst_lat = F.out; R.dst_ctx = WSP(float, WS_XC); R.g = g;
            const float* MODL = WSP(float, WS_MOD) + (size_t)l * 9 * 6144;
            const int lat_only = (l == DEPTH - 1) ? 1 : 0;

            if constexpr (PHM(1)) norm1_phase(F, R, l, 0);
            if constexpr (PHM(15)) if (l == 0 && g > 0) final_norm_phase(F, g - 1);
            GRID_BAR();

            if constexpr (PHM(2)) {
                TileOrder S; S.init(NRT, INW / 256, F.G, obid(), WSP(bf16_t, WS_HX), (size_t)256 * 1024 * 2, WSP(bf16_t, WS_WIN) + (size_t)l * INW * 1024, (size_t)256 * 1024 * 2, 0);
                EpiInproj E{WSP(bf16_t, WS_PR), WSP(bf16_t, WS_PC), WSP(bf16_t, WS_PM), WSP(bf16_t, WS_PG), WSP(bf16_t, WS_K), WSP(float, WS_SSQ), WSP(f32x2, WS_RT), WSP(f32x2, WS_MT)};
                pg8::gemm_phase<EpiInproj, TileOrder, true>(F.lds, 1024, 1024, 1024, 0, S, E, F.wv);
            }
            GRID_BAR();

            if constexpr (PHM(3)) {
                TileOrder S; S.init(NRT, 3, F.G, obid(), WSP(bf16_t, WS_PM), (size_t)256 * 640 * 2, WSP(bf16_t, WS_WUQ) + (size_t)l * 768 * 384, (size_t)256 * 384 * 2, 0);
                EpiUq E{WSP(bf16_t, WS_Q), WSP(float, WS_SSQ), WSP(f32x2, WS_MT)};
                pg8::gemm_phase<EpiUq, TileOrder, true>(F.lds, 640, 384, 384, 0, S, E, F.wv);
            }
            if constexpr (PHM(4)) {
                TileOrder S; S.init(NRT, 4, F.G, obid(), WSP(bf16_t, WS_PM) + 384, (size_t)256 * 640 * 2, WSP(bf16_t, WS_WUKV) + (size_t)l * 1024 * 256, (size_t)256 * 256 * 2, 0);
                EpiUkv E{WSP(bf16_t, WS_K), WSP(bf16_t, WS_V), WSP(float, WS_SSQ)};
                pg8::gemm_phase<EpiUkv, TileOrder, true>(F.lds, 640, 256, 256, 0, S, E, F.wv);
            }
            if constexpr (PHM(5)) for (int u = obid(); u < GB * NCHUNK * 4; u += F.G) {
                const int h = u & 3;
                retu_unit(u, WSP(bf16_t, WS_PR), WSP(float, WS_HX), lg2_gamma(INP(9) + l * 8 + h), lg2_gamma(INP(9) + l * 8 + 4 + h), (LAS char*)F.lds, F.wv);
            }
            if constexpr (PHM(6)) conv_phase(F, l);
            GRID_BAR();

            if constexpr (PHM(7)) scan_phase(F, l);
            if constexpr (PHM(8)) {
                const bf16_t* Q = WSP(bf16_t, WS_Q); const bf16_t* K = WSP(bf16_t, WS_K); const bf16_t* V = WSP(bf16_t, WS_V); bf16_t* ACT = WSP(bf16_t, WS_ACT);
                const int vcu = (obid() % 8) * (F.G / 8) + obid() / 8, xcd = vcu / (F.G / 8), slot = vcu % (F.G / 8);
                const int nlat = GB * 8 * 32, nunit = nlat + (lat_only ? 0 : GB * 8);
                for (int i = 0; ; ++i) {
                    int hh, qb;
                    if (F.G == 256) { if (i < 4) { hh = xcd + 8 * i; qb = 1 + slot; } else if (i == 4 && !lat_only && slot < 4) { hh = xcd + 8 * slot; qb = 0; } else break; }
                    else { const int L = i * F.G + obid(); if (L >= nunit) break; if (L < nlat) { hh = L >> 5; qb = 1 + (L & 31); } else { hh = L - nlat; qb = 0; } }
                    const int bl = hh >> 3, h = hh & 7;
                    const size_t hb = (size_t)(bl * 8 + h) * SB;
                    att::attn_unit(Q + (hb + (size_t)qb * 256) * 96, K + hb * 96, V + hb * 64, ACT + ((size_t)bl * SB + (size_t)qb * 256) * 1536 + 1024 + h * 64, 1536, qb == 0 ? CTXL : SB, (LAS char*)F.lds, F.wv);
                }
            }
            GRID_BAR();

            if constexpr (PHM(9)) for (int u = obid(); u < GB * NCHUNK * 4; u += F.G) {
                const int h = u & 3;
                retout_unit(u, WSP(bf16_t, WS_PR), WSP(bf16_t, WS_PM), INP(10) + l * 512, WSP(bf16_t, WS_ACT), lg2_gamma(INP(9) + l * 8 + h), lg2_gamma(INP(9) + l * 8 + 4 + h), (LAS char*)F.lds, F.wv);
            }
            GRID_BAR();

            if constexpr (PHM(10)) {
                TileOrder S; S.init(lat_only ? GB * 32 : NRT, 4, F.G, obid(), WSP(bf16_t, WS_ACT), (size_t)256 * 1536 * 2, WSP(bf16_t, WS_WCAT) + (size_t)l * 1024 * 1536, (size_t)256 * 1536 * 2, lat_only);
                EpiMerge1 E{WSP(bf16_t, WS_PG), WSP(bf16_t, WS_HX)};
                pg8::gemm_phase<EpiMerge1, TileOrder, true>(F.lds, 1536, 1536, 1536, 0, S, E, F.wv);
            }
            GRID_BAR();

            if constexpr (PHM(11)) {
                TileOrder S; S.init(lat_only ? GB * 32 : NRT, 4, F.G, obid(), WSP(bf16_t, WS_HX), (size_t)256 * 1024 * 2, WSP(bf16_t, WS_WOUT) + (size_t)l * 1024 * 1024, (size_t)256 * 1024 * 2, lat_only);
                EpiMerge2 E{R, MODL};
                pg8::gemm_phase<EpiMerge2, TileOrder, true>(F.lds, 1024, 1024, 1024, 0, S, E, F.wv);
            }
            GRID_BAR();

            if constexpr (PHM(12)) norm2_router_phase(F, R, l, g, lat_only);
            GRID_BAR();

            moe_tables(F, l, g);
            if constexpr (PHM(13)) {
                MoeOrder S{(const LAS int*)(F.lds + LDS_MOE_OFF), WSP(int, WS_LIST), 8, F.G, obid(), 1, (const char*)WSP(bf16_t, WS_HX), (const char*)(WSP(bf16_t, WS_WUP) + (size_t)l * 16 * 1024 * 1024)};
                EpiMoeUp E{WSP(int, WS_LIST), WSP(float, WS_WGT), WSP(bf16_t, WS_PG)};
                pg8::gemm_phase<EpiMoeUp, MoeOrder, true, true, false>(F.lds, 1024, 1024, 1024, 0, S, E, F.wv);
            }
            GRID_BAR();

            if constexpr (PHM(14)) {
                MoeOrder S{(const LAS int*)(F.lds + LDS_MOE_OFF), WSP(int, WS_LIST), 4, F.G, obid(), 0, (const char*)WSP(bf16_t, WS_PG), (const char*)(WSP(bf16_t, WS_W2T) + (size_t)l * 16 * 1024 * 512)};
                EpiMoeDown E{WSP(int, WS_LIST), R, MODL};
                pg8::gemm_phase<EpiMoeDown, MoeOrder, true, false, true>(F.lds, 1024, 512, 1024, 8, S, E, F.wv);
            }
            GRID_BAR();
        }
    }
    if constexpr (PHM(15)) final_norm_phase(F, NG - 1);
}

extern "C" void kernel_launch(void* const* d_in, const int* in_sizes, int n_in, void* d_out, int out_size, void* d_ws, size_t ws_size, hipStream_t stream) {
    static int grid = 0;
    if (grid == 0) {
        if (n_in != 26 || ws_size < WS_END) { fprintf(stderr, "kernel_launch: expected 26 inputs and >= %zu bytes of workspace; got %d, %zu\n", (size_t)WS_END, n_in, ws_size); grid = -1; return; }
        int dev = 0, cus = 0, per_cu = 0;
        if (hipGetDevice(&dev) != hipSuccess || hipDeviceGetAttribute(&cus, hipDeviceAttributeMultiprocessorCount, dev) != hipSuccess) { grid = -1; return; }
        if (hipFuncSetAttribute((const void*)dit_fwd, hipFuncAttributeMaxDynamicSharedMemorySize, LDS_BYTES) != hipSuccess) { fprintf(stderr, "kernel_launch: hipFuncSetAttribute failed\n"); grid = -1; return; }
        if (hipOccupancyMaxActiveBlocksPerMultiprocessor(&per_cu, (const void*)dit_fwd, 512, LDS_BYTES) != hipSuccess || per_cu < 1) fprintf(stderr, "kernel_launch: occupancy query reports %d\n", per_cu);
        (void)hipGetLastError();
        grid = cus;
    }
    if (grid < 0) return;
    (void)hipMemsetAsync((char*)d_ws + WS_CTL, 0, CTL_ZERO_BYTES, stream);
    Args a{};
    for (int i = 0; i < 26; ++i) a.in[i] = (const float*)d_in[i];
    a.out = (float*)d_out; a.ws = (unsigned char*)d_ws; a.ph_lo = 0; a.ph_hi = 1000;
    hipLaunchKernelGGL(dit_fwd, dim3(grid), dim3(512), LDS_BYTES, stream, a);
}
```

```cpp
#include <hip/hip_runtime.h>
#include <cstdio>
#include <cstdint>

#define GAS __attribute__((address_space(1)))
#define LAS __attribute__((address_space(3)))
typedef unsigned short bf16_t;
typedef short bf16x8 __attribute__((ext_vector_type(8)));
typedef short s16x4 __attribute__((ext_vector_type(4)));
typedef float f32x2 __attribute__((ext_vector_type(2)));
typedef float f32x4 __attribute__((ext_vector_type(4)));
typedef float f32x16 __attribute__((ext_vector_type(16)));
typedef unsigned u32x2 __attribute__((ext_vector_type(2)));
typedef unsigned u32x4 __attribute__((ext_vector_type(4)));
typedef __bf16 bf16x2_t __attribute__((ext_vector_type(2)));

constexpr int DM = 1024, NB = 8, SEQ = 8192, CTXL = 256, DEPTH = 2;
constexpr int SB = SEQ + CTXL;
constexpr int GB = 4, NG = NB / GB;
constexpr int NT = GB * SB;
constexpr int NRT = NT / 256;
constexpr int INW = 6912;
constexpr int INCOLS = 6816;
constexpr int NCHUNK = SB / 128;
constexpr int NPAIR = 24;
constexpr float RMS_EPS = 1e-6f;
constexpr float LOG2E = 1.4426950408889634f;
constexpr float QSCALE = 0.10206207261596575f * LOG2E;

constexpr size_t MiB = 1u << 20;
constexpr size_t WS_CTL = 0, CTL_ZERO_BYTES = 1 * MiB;
constexpr size_t WS_MOD = 1 * MiB;
constexpr size_t WS_RT = 2 * MiB;
constexpr size_t WS_MT = 4 * MiB;
constexpr size_t WS_SSQ = 5 * MiB;
constexpr size_t WS_WGT = 8 * MiB;
constexpr size_t WS_LIST = 9 * MiB;
constexpr size_t WS_XC = 13 * MiB;
constexpr size_t WS_WIN = 21 * MiB;
constexpr size_t WS_WCAT = 48 * MiB;
constexpr size_t WS_WOUT = 54 * MiB;
constexpr size_t WS_WUQ = 58 * MiB;
constexpr size_t WS_WUKV = 60 * MiB;
constexpr size_t WS_WUP = 61 * MiB;
constexpr size_t WS_W2T = 125 * MiB;
constexpr size_t WS_HX = 157 * MiB;
constexpr size_t WS_PR = 223 * MiB;
constexpr size_t WS_PC = 322 * MiB;
constexpr size_t WS_PM = 388 * MiB;
constexpr size_t WS_PG = 430 * MiB;
constexpr size_t WS_Q = 628 * MiB;
constexpr size_t WS_K = 678 * MiB;
constexpr size_t WS_V = 728 * MiB;
constexpr size_t WS_ACT = 761 * MiB;
constexpr size_t WS_END = 860 * MiB;
static_assert(WS_WIN + (size_t)2 * INW * 1024 * 2 <= WS_WCAT && WS_HX + (size_t)NT * 1024 * 2 <= WS_PR && WS_PR + (size_t)NT * 1536 * 2 <= WS_PC &&
              WS_PC + (size_t)NT * 1024 * 2 <= WS_PM && WS_PM + (size_t)NT * 640 * 2 <= WS_PG && WS_PG + (size_t)NT * 3072 * 2 <= WS_Q &&
              WS_Q + (size_t)GB * 8 * SB * 96 * 2 <= WS_K && WS_K + (size_t)GB * 8 * SB * 96 * 2 <= WS_V && WS_V + (size_t)GB * 8 * SB * 64 * 2 <= WS_ACT &&
              WS_ACT + (size_t)NT * 1536 * 2 <= WS_END, "d_ws map");
constexpr int CW_BAR = 4096;
constexpr int CW_CNT = 16384;

constexpr int RING_BYTES = 131072;
constexpr int LDSCTL_OFF = RING_BYTES;
constexpr int LDS_MOE_OFF = LDSCTL_OFF + 64;
constexpr int LDS_BYTES = 147456;

__device__ __forceinline__ int olane() { int l; asm volatile("v_mbcnt_lo_u32_b32 %0, -1, 0\n\tv_mbcnt_hi_u32_b32 %0, -1, %0" : "=v"(l)); return l; }
__device__ __forceinline__ int otid(int wv) { return wv * 64 + olane(); }
__device__ __forceinline__ int obid() { int b = blockIdx.x; asm volatile("" : "+s"(b)); return b; }
__device__ __forceinline__ unsigned cvtpk(float lo, float hi) { f32x2 v = {lo, hi}; bf16x2_t b = __builtin_convertvector(v, bf16x2_t); return __builtin_bit_cast(unsigned, b); }
__device__ __forceinline__ float bf_lo(unsigned w) { return __uint_as_float(w << 16); }
__device__ __forceinline__ float bf_hi(unsigned w) { return __uint_as_float(w & 0xffff0000u); }
__device__ __forceinline__ float bf1(bf16_t b) { return __uint_as_float(((unsigned)b) << 16); }
__device__ __forceinline__ bf16_t f2bf(float f) { return (bf16_t)(cvtpk(f, 0.f) & 0xffffu); }
template <int O> __device__ __forceinline__ float swz_xor(float v) { return __int_as_float(__builtin_amdgcn_ds_swizzle(__float_as_int(v), (O << 10) | 0x1f)); }
__device__ __forceinline__ float half_sum(float v) { auto rr = __builtin_amdgcn_permlane32_swap(__float_as_uint(v), __float_as_uint(v), false, false); return __uint_as_float(rr[0]) + __uint_as_float(rr[1]); }
__device__ __forceinline__ float sum32(float v) { v += swz_xor<1>(v); v += swz_xor<2>(v); v += swz_xor<4>(v); v += swz_xor<8>(v); v += swz_xor<16>(v); return v; }
__device__ __forceinline__ float wave_sum(float v) { return half_sum(sum32(v)); }
__device__ __forceinline__ float sigmoidf_(float x) { return 1.f / (1.f + __expf(-x)); }
__device__ __forceinline__ float siluf_(float x) { return x / (1.f + __expf(-x)); }
__device__ __forceinline__ void unpack8(const u32x4 w, float (&f)[8]) {
    f[0] = bf_lo(w.x); f[1] = bf_hi(w.x); f[2] = bf_lo(w.y); f[3] = bf_hi(w.y); f[4] = bf_lo(w.z); f[5] = bf_hi(w.z); f[6] = bf_lo(w.w); f[7] = bf_hi(w.w);
}
__device__ __forceinline__ u32x4 pack8(const float (&f)[8]) { u32x4 w; w.x = cvtpk(f[0], f[1]); w.y = cvtpk(f[2], f[3]); w.z = cvtpk(f[4], f[5]); w.w = cvtpk(f[6], f[7]); return w; }

#define XB_TMO      128
#define XB_XCNT(j)  (256  + 64 * (j))
#define XB_XSUB(j)  (1280 + 64 * (j))
#define XB_XGEN(j)  (2304 + 64 * (j))
#define XB_TOP      3328
#define XB_TOPGEN   3392
#define XCD_BAR_WORDS 3456
#define XB_SPIN_CAP (1u << 20)
__device__ __forceinline__ unsigned xb_ld(unsigned* p)              { return __hip_atomic_load(p, __ATOMIC_RELAXED, __HIP_MEMORY_SCOPE_AGENT); }
__device__ __forceinline__ unsigned xb_add(unsigned* p, unsigned v) { return __hip_atomic_fetch_add(p, v, __ATOMIC_RELAXED, __HIP_MEMORY_SCOPE_AGENT); }
__device__ __forceinline__ unsigned xb_xcc_id() { return (unsigned)__builtin_amdgcn_s_getreg((3 << 11) | 20) & 0xFu; }
#define XB_SPIN(cond, bar) do { unsigned _sp = 0; while (cond) { __builtin_amdgcn_s_sleep(1); \
    if ((++_sp & 255u) == 0u) { if (xb_ld(&(bar)[XB_TMO])) break; if (_sp > XB_SPIN_CAP) { atomicAdd(&(bar)[XB_TMO], 1u); break; } } } } while (0)
struct XcdBarrier { unsigned* bar; unsigned x; volatile LAS unsigned* st; };
__device__ __forceinline__ XcdBarrier xcd_barrier_post(unsigned* bar, volatile LAS unsigned* st) {
    XcdBarrier b; b.bar = bar; b.x = xb_xcc_id(); b.st = st;
    if (threadIdx.x == 0) (void)xb_add(&bar[XB_XCNT(b.x)], 1u);
    return b;
}
__device__ __forceinline__ void xcd_barrier_complete(unsigned* bar, unsigned x, unsigned& nloc, unsigned& nx) {
    const unsigned G = gridDim.x * gridDim.y * gridDim.z;
    unsigned sum, cnt, mine, sp = 0u;
    for (;;) {
        sum = 0u; cnt = 0u; mine = 0u;
#pragma unroll
        for (unsigned j = 0; j < 16; ++j) { const unsigned c = xb_ld(&bar[XB_XCNT(j)]); sum += c; cnt += (c > 0u) ? 1u : 0u; mine = (j == x) ? c : mine; }
        if (sum == G) break;
        __builtin_amdgcn_s_sleep(1);
        if ((++sp & 255u) == 0u) { if (xb_ld(&bar[XB_TMO])) break; if (sp > XB_SPIN_CAP) { atomicAdd(&bar[XB_TMO], 1u); break; } }
    }
    nloc = mine > 0u ? mine : 1u; nx = cnt > 0u ? cnt : 1u;
}
__device__ __forceinline__ void xcd_barrier(const XcdBarrier& b, const int wv) {
    const bool leader = (wv == 0) && (olane() == 0);
    asm volatile("s_waitcnt vmcnt(0)" ::: "memory");
    __syncthreads();
    if (leader) {
        unsigned* bar = b.bar; unsigned bx = b.x;
        asm volatile("" : "+s"(bar), "+s"(bx));
        __builtin_amdgcn_s_waitcnt(0);
        unsigned nloc = b.st[0], nx = b.st[1];
        if (nloc == 0u) { xcd_barrier_complete(bar, bx, nloc, nx); b.st[0] = nloc; b.st[1] = nx; }
        const unsigned old = xb_add(&bar[XB_XSUB(bx)], 1u);
        const unsigned gen = old / nloc;
        if (old + 1u == (gen + 1u) * nloc) {
            __builtin_amdgcn_fence(__ATOMIC_RELEASE, "agent");
            asm volatile("s_waitcnt vmcnt(0)" ::: "memory");
            const unsigned og = xb_add(&bar[XB_TOP], 1u);
            const unsigned tg = og / nx;
            if (og + 1u == (tg + 1u) * nx) xb_add(&bar[XB_TOPGEN], 1u);
            else XB_SPIN(xb_ld(&bar[XB_TOPGEN]) == tg, bar);
            __builtin_amdgcn_fence(__ATOMIC_ACQUIRE, "agent");
            xb_add(&bar[XB_XGEN(bx)], 1u);
            asm volatile("s_waitcnt vmcnt(0)" ::: "memory");
        } else {
            XB_SPIN(xb_ld(&bar[XB_XGEN(bx)]) == gen, bar);
            __builtin_amdgcn_fence(__ATOMIC_ACQUIRE, "agent");
            asm volatile("s_waitcnt vmcnt(0)" ::: "memory");
        }
    }
    __syncthreads();
}

namespace pg8 {
constexpr int BM = 256, BK = 64, HALF = 128, HTB = HALF * BK * 2, NXCD = 8, WGM = 8;
__host__ __device__ __forceinline__ int lds_byte(int r, int c) { const int st = (r >> 4) * 2 + (c >> 5), rr = r & 15, cc = c & 31, ob = rr * 64 + cc * 2; return st * 1024 + (ob ^ (((ob >> 9) & 1) << 5)); }
__host__ __device__ __forceinline__ void stage_rc(int b, int& R, int& C) { const int st = b / 1024, sb = b % 1024, swz = sb ^ (((sb >> 9) & 1) << 5); R = (st >> 1) * 16 + swz / 64; C = (st & 1) * 32 + (swz % 64) / 2; }
__host__ __device__ __forceinline__ int perm32(int rho) { const int n = rho >> 4, i = rho & 15; return 8 * (i >> 2) + 4 * n + (i & 3); }

struct Unit { int pm, pn, aux0, aux1, aux2; const char* a; const char* b; const char* b2; };
typedef f32x4 Acc[2][2][4][2];

template <class Epi, class Sched, bool ALIGN_EPI, bool GATHER = false, bool SPLITB = false>
__device__ __forceinline__ void gemm_phase(LAS unsigned char* lds, const int lda, const int ldb, const int K, const int ksplit, const Sched& S, const Epi& E, const int wv) {
    const int tid = otid(wv), wid = __builtin_amdgcn_readfirstlane(tid >> 6), lane = tid & 63, wr = wid >> 2, wc = wid & 3, fr = lane & 15, fq = lane >> 4;
    const int nt = K / BK;
    unsigned voffA[2][2], voffN[2][2], voffB[2];
#pragma unroll
    for (int i = 0; i < 2; ++i) { int R, C; stage_rc(tid * 16 + i * 8192, R, C); const int Rb = (R & ~31) + perm32(R & 31);
        voffB[i] = (unsigned)(Rb * ldb + C) * 2u;
        voffA[0][i] = (unsigned)(R * lda + C) * 2u; voffA[1][i] = (unsigned)((R + HALF) * lda + C) * 2u; voffN[0][i] = voffA[0][i]; voffN[1][i] = voffA[1][i]; }
    const size_t kstep = (size_t)(BK * 2);
    const size_t hstepB = (size_t)HALF * ldb * 2, hstepA = (size_t)HALF * lda * 2;
    const unsigned ldsw = (unsigned)wid * 1024u;
    const int aoff = lds_byte(wr * 64 + fr, fq * 8), boff = lds_byte(wc * 32 + fr, fq * 8);
#define PG8_SA(b, h) (((b) * 2 + (h)) * HTB)
#define PG8_SB(b, h) ((4 + (b) * 2 + (h)) * HTB)
#define PG8_STAGE_B(bufoff, gbase, h) do { _Pragma("unroll") for (int _i = 0; _i < 2; ++_i) \
        __builtin_amdgcn_global_load_lds((const unsigned*)((const char*)(gbase) + (size_t)(h) * hstepB + voffB[_i]), (LAS unsigned*)(lds + (bufoff) + ldsw + _i * 8192), 16, 0, 0); } while (0)
#define PG8_STAGE_A(bufoff, gbase, h, NX) do { _Pragma("unroll") for (int _i = 0; _i < 2; ++_i) { if constexpr (GATHER) { const unsigned _o = (NX) ? voffN[h][_i] : voffA[h][_i]; \
        __builtin_amdgcn_global_load_lds((const unsigned*)((const char*)(gbase) + _o), (LAS unsigned*)(lds + (bufoff) + ldsw + _i * 8192), 16, 0, 0); } else { \
        __builtin_amdgcn_global_load_lds((const unsigned*)((const char*)(gbase) + (size_t)(h) * hstepA + voffA[0][_i]), (LAS unsigned*)(lds + (bufoff) + ldsw + _i * 8192), 16, 0, 0); } } } while (0)
#define PG8_LDA(dst, b, h) do { _Pragma("unroll") for (int m = 0; m < 4; ++m) _Pragma("unroll") for (int k = 0; k < 2; ++k) dst[m][k] = *(const LAS bf16x8*)(lds + PG8_SA(b, h) + aoff + m * 2048 + k * 1024); } while (0)
#define PG8_LDB(dst, b, h) do { _Pragma("unroll") for (int n = 0; n < 2; ++n) _Pragma("unroll") for (int k = 0; k < 2; ++k) dst[n][k] = *(const LAS bf16x8*)(lds + PG8_SB(b, h) + boff + n * 2048 + k * 1024); } while (0)
#define PG8_MMA(ai, bj, At, Bt) do { __builtin_amdgcn_s_setprio(1); _Pragma("unroll") for (int m = 0; m < 4; ++m) _Pragma("unroll") for (int n = 0; n < 2; ++n) _Pragma("unroll") for (int k = 0; k < 2; ++k) \
        acc[ai][bj][m][n] = __builtin_amdgcn_mfma_f32_16x16x32_bf16(Bt[n][k], At[m][k], acc[ai][bj][m][n], 0, 0, 0); __builtin_amdgcn_s_setprio(0); } while (0)
#define PG8_WAIT_V(n) asm volatile("s_waitcnt vmcnt(" #n ")" ::: "memory")
#define PG8_WAIT_L(n) asm volatile("s_waitcnt lgkmcnt(" #n ")" ::: "memory")
#define PG8_BAR __builtin_amdgcn_s_barrier()
#define PG8_SCHED __builtin_amdgcn_sched_barrier(0)
#define PG8_GOFF(dst, u) do { if constexpr (GATHER) { const int _t = otid(wv); _Pragma("unroll") for (int _i = 0; _i < 2; ++_i) { int _R, _C; stage_rc(_t * 16 + _i * 8192, _R, _C); \
        _Pragma("unroll") for (int _h = 0; _h < 2; ++_h) dst[_h][_i] = S.gather_off(u, _h * HALF + _R) + (unsigned)_C * 2u; } } } while (0)
#define PG8_BPTR(u, t) (SPLITB ? (((t) < ksplit) ? (u).b + (size_t)(t) * kstep : (u).b2 + (size_t)((t) - ksplit) * kstep) : (u).b + (size_t)(t) * kstep)
    Unit cur, nxt; int ui = 0;
    if (!S.next(0, cur)) return;
    Acc acc;
#pragma unroll
    for (int a = 0; a < 2; ++a)
#pragma unroll
        for (int b = 0; b < 2; ++b)
#pragma unroll
            for (int m = 0; m < 4; ++m)
#pragma unroll
                for (int n = 0; n < 2; ++n) acc[a][b][m][n] = (f32x4){0.f, 0.f, 0.f, 0.f};
    bf16x8 At[4][2], B0[2][2], B1[2][2];
    const char* cA = cur.a; const char* cB = cur.b;
    S.a_ready(cur);
    PG8_GOFF(voffA, cur);
    if constexpr (GATHER) {
#pragma unroll
        for (int h = 0; h < 2; ++h)
#pragma unroll
            for (int i = 0; i < 2; ++i) voffN[h][i] = voffA[h][i];
    }
    PG8_STAGE_B(PG8_SB(0, 0), cB, 0); PG8_STAGE_B(PG8_SB(0, 1), cB, 1); PG8_STAGE_A(PG8_SA(0, 0), cA, 0, false); PG8_STAGE_A(PG8_SA(0, 1), cA, 1, false);
    if (wr == 1) PG8_BAR;
    PG8_WAIT_V(2); PG8_BAR;
    PG8_STAGE_B(PG8_SB(1, 0), cB + kstep, 0); PG8_STAGE_A(PG8_SA(1, 0), cA + kstep, 0, false); PG8_STAGE_B(PG8_SB(1, 1), cB + kstep, 1);
    PG8_WAIT_V(6); PG8_BAR;
    for (;;) {
        const bool has_next = S.next(ui + 1, nxt);
        const char* nA = has_next ? nxt.a : cA; const char* nB = has_next ? nxt.b : cB;
#pragma nounroll
        for (int t = 0; t < nt; t += 2) {
            const bool last = (t == nt - 2);
            if (last && has_next) { S.a_ready(nxt); PG8_GOFF(voffN, nxt); }
            if constexpr (Epi::HOOK) { if (t == Epi::HOOK_T0 || t == Epi::HOOK_T1) E.hook(acc, cur, t, wr, wc, fr, fq); }
            const char* a1 = cA + (size_t)(t + 1) * kstep;
            const char* a2 = last ? nA : cA + (size_t)(t + 2) * kstep; const char* b2 = last ? nB : PG8_BPTR(cur, t + 2);
            const char* a3 = a2 + kstep; const char* b3 = b2 + kstep;
            PG8_LDB(B0, 0, 0); PG8_LDB(B1, 0, 1); PG8_SCHED; PG8_LDA(At, 0, 0); PG8_STAGE_A(PG8_SA(1, 1), a1, 1, false);
            PG8_WAIT_V(8); PG8_WAIT_L(0); PG8_BAR; PG8_MMA(0, 0, At, B0); PG8_MMA(0, 1, At, B1); PG8_BAR; PG8_SCHED;
            PG8_LDA(At, 0, 1); PG8_STAGE_B(PG8_SB(0, 0), b2, 0); PG8_STAGE_B(PG8_SB(0, 1), b2, 1); PG8_STAGE_A(PG8_SA(0, 0), a2, 0, last);
            PG8_WAIT_V(8); PG8_WAIT_L(0); PG8_BAR; PG8_MMA(1, 0, At, B0); PG8_MMA(1, 1, At, B1); PG8_BAR; PG8_SCHED;
            PG8_LDB(B0, 1, 0); PG8_LDB(B1, 1, 1); PG8_SCHED; PG8_LDA(At, 1, 0); PG8_STAGE_A(PG8_SA(0, 1), a2, 1, last);
            PG8_WAIT_V(8); PG8_WAIT_L(0); PG8_BAR; PG8_MMA(0, 0, At, B0); PG8_MMA(0, 1, At, B1); PG8_BAR; PG8_SCHED;
            PG8_LDA(At, 1, 1); PG8_STAGE_B(PG8_SB(1, 0), b3, 0); PG8_STAGE_B(PG8_SB(1, 1), b3, 1); PG8_STAGE_A(PG8_SA(1, 0), a3, 0, last);
            PG8_WAIT_V(8); PG8_WAIT_L(0); PG8_BAR; PG8_MMA(1, 0, At, B0); PG8_MMA(1, 1, At, B1); PG8_BAR; PG8_SCHED;
        }
        if constexpr (ALIGN_EPI) { if (wr == 0) PG8_BAR; }
        E(acc, cur, wr, wc, fr, fq); S.done(cur);
        if (!has_next) break;
#pragma unroll
        for (int a = 0; a < 2; ++a)
#pragma unroll
            for (int b = 0; b < 2; ++b)
#pragma unroll
                for (int m = 0; m < 4; ++m)
#pragma unroll
                    for (int n = 0; n < 2; ++n) acc[a][b][m][n] = (f32x4){0.f, 0.f, 0.f, 0.f};
        cur = nxt; cA = nA; cB = nB; ++ui;
        if constexpr (GATHER) {
#pragma unroll
            for (int h = 0; h < 2; ++h)
#pragma unroll
                for (int i = 0; i < 2; ++i) voffA[h][i] = voffN[h][i];
        }
        if constexpr (ALIGN_EPI) { if (wr == 1) PG8_BAR; }
    }
    PG8_WAIT_V(0);
    if constexpr (!ALIGN_EPI) { if (wr == 0) PG8_BAR; }
    PG8_BAR;
#undef PG8_SA
#undef PG8_SB
#undef PG8_STAGE_A
#undef PG8_STAGE_B
#undef PG8_LDA
#undef PG8_LDB
#undef PG8_MMA
#undef PG8_WAIT_V
#undef PG8_WAIT_L
#undef PG8_BAR
#undef PG8_SCHED
#undef PG8_GOFF
#undef PG8_BPTR
}
}
struct Resid {
    const float* src_lat; const float* src_ctx; float* dst_lat; float* dst_ctx; int g;
    __device__ __forceinline__ const float* src(int row) const { const int bl = row / SB, s = row - bl * SB, b = g * GB + bl;
        return s < CTXL ? src_ctx + (size_t)(b * CTXL + s) * DM : src_lat + ((size_t)b * SEQ + (s - CTXL)) * DM; }
    __device__ __forceinline__ float* dst(int row) const { const int bl = row / SB, s = row - bl * SB, b = g * GB + bl;
        return s < CTXL ? dst_ctx + (size_t)(b * CTXL + s) * DM : dst_lat + ((size_t)b * SEQ + (s - CTXL)) * DM; }
    __device__ __forceinline__ int modv(int row) const { const int bl = row / SB, s = row - bl * SB; return s < CTXL ? 8 : g * GB + bl; }
};

struct TileOrder {
    int nM, nN, nwg, G, c, skip; const char* A; const char* B; size_t astep, bstep;
    __device__ __forceinline__ void init(int nM_, int nN_, int G_, int c_, const void* A_, size_t astep_, const void* B_, size_t bstep_, int skip_ctx) {
        nM = nM_; nN = nN_; nwg = nM * nN; G = G_; c = c_; A = (const char*)A_; B = (const char*)B_; astep = astep_; bstep = bstep_; skip = skip_ctx; }
    __device__ __forceinline__ bool next(int i, pg8::Unit& u) const {
        const long L = (long)i * G + c; if (L >= nwg) return false;
        int wgid = (int)L; { const int q = nwg / pg8::NXCD, r = nwg % pg8::NXCD, xcd = wgid % pg8::NXCD, off = wgid / pg8::NXCD; wgid = (xcd < r ? xcd * (q + 1) : r * (q + 1) + (xcd - r) * q) + off; }
        const int nig = pg8::WGM * nN, gid = wgid / nig, fm = gid * pg8::WGM, gsz = (nM - fm) < pg8::WGM ? (nM - fm) : pg8::WGM;
        int pm = fm + ((wgid % nig) % gsz); u.pn = (wgid % nig) / gsz;
        if (skip) pm = pm + pm / 32 + 1;
        u.pm = pm; u.aux0 = 0; u.aux1 = 0; u.aux2 = 0;
        u.a = A + (size_t)pm * astep; u.b = B + (size_t)u.pn * bstep; u.b2 = u.b; return true;
    }
    __device__ __forceinline__ void a_ready(const pg8::Unit&) const {}
    __device__ __forceinline__ void done(const pg8::Unit&) const {}
};

struct MoeOrder {
    const LAS int* tab; const int* LIST; int ncol, G, c, up; const char* A; const char* W;
    __device__ __forceinline__ bool next(int i, pg8::Unit& u) const {
        const int total = __builtin_amdgcn_readfirstlane(tab[24]) * ncol; const int L = i * G + c; if (L >= total) return false;
        const int rt = L / ncol, pn = L - rt * ncol;
        int p = 0;
#pragma unroll
        for (int q = 1; q < NPAIR; ++q) p += (__builtin_amdgcn_readfirstlane(tab[q]) <= rt) ? 1 : 0;
        const int base = (rt - __builtin_amdgcn_readfirstlane(tab[p])) * 256; int valid = __builtin_amdgcn_readfirstlane(tab[32 + p]) - base; valid = valid > 256 ? 256 : valid;
        u.pm = rt; u.pn = pn; u.aux0 = p * NT + base; u.aux1 = valid; u.aux2 = p;
        const int grp = p / 6, q6 = p - grp * 6;
        const int lo = q6 < 3 ? 0 : (q6 < 5 ? 1 : 2), hi = q6 < 3 ? q6 + 1 : (q6 < 5 ? q6 - 1 : 3);
        const int ea = grp * 4 + lo, eb = grp * 4 + hi;
        if (up) { const int e = pn < 4 ? ea : eb; u.a = A; u.b = W + ((size_t)e * 1024 + (size_t)(pn & 3) * 256) * 1024 * 2; u.b2 = u.b; }
        else { u.a = A + (size_t)rt * 256 * 1024 * 2; u.b = W + ((size_t)ea * 1024 + (size_t)pn * 256) * 512 * 2; u.b2 = W + ((size_t)eb * 1024 + (size_t)pn * 256) * 512 * 2; }
        return true;
    }
    __device__ __forceinline__ unsigned gather_off(const pg8::Unit& u, int r) const { const int idx = r < u.aux1 ? r : 0; return (unsigned)LIST[u.aux0 + idx] * (unsigned)(DM * 2); }
    __device__ __forceinline__ void a_ready(const pg8::Unit&) const {}
    __device__ __forceinline__ void done(const pg8::Unit&) const {}
};

#ifdef EPI_NT_STORES
#define ST_NT(p, v) __builtin_nontemporal_store((v), (p))
#else
#define ST_NT(p, v) (*(p) = (v))
#endif
#define EPI_NOHOOK static constexpr bool HOOK = false; static constexpr int HOOK_T0 = -1, HOOK_T1 = -1; \
    __device__ __forceinline__ void hook(pg8::Acc&, const pg8::Unit&, int, int, int, int, int) const {}
#define EPI_V8(v, acc, ai, bj, m) float v[8]; { const f32x4 _a = acc[ai][bj][m][0], _b = acc[ai][bj][m][1]; v[0] = _a[0]; v[1] = _a[1]; v[2] = _a[2]; v[3] = _a[3]; v[4] = _b[0]; v[5] = _b[1]; v[6] = _b[2]; v[7] = _b[3]; }
__device__ __forceinline__ void rot4(float (&v)[8], const f32x2* cs) {
    const f32x4 c01 = *(const f32x4*)cs, c23 = *(const f32x4*)(cs + 2);
    const float c[4] = {c01[0], c01[2], c23[0], c23[2]}, s[4] = {c01[1], c01[3], c23[1], c23[3]};
#pragma unroll
    for (int k = 0; k < 4; ++k) { const float x1 = v[2 * k], x2 = v[2 * k + 1]; v[2 * k] = x1 * c[k] - x2 * s[k]; v[2 * k + 1] = x2 * c[k] + x1 * s[k]; }
}

struct EpiNone { EPI_NOHOOK
    float* sink;
    __device__ __forceinline__ void operator()(const pg8::Acc& acc, const pg8::Unit& u, int wr, int wc, int fr, int fq) const {
        float s = 0.f;
#pragma unroll
        for (int ai = 0; ai < 2; ++ai)
#pragma unroll
            for (int bj = 0; bj < 2; ++bj)
#pragma unroll
                for (int m = 0; m < 4; ++m) s += acc[ai][bj][m][0][0] + acc[ai][bj][m][1][3];
        if (s == 1.2345e33f) sink[0] = s;
    }
};
struct EpiStoreOnly { EPI_NOHOOK
    bf16_t* PG;
    __device__ __forceinline__ void operator()(const pg8::Acc& acc, const pg8::Unit& u_, int wr, int wc, int fr, int fq) const {
        pg8::Unit u = u_; asm volatile("" : "+s"(u.pm), "+s"(u.pn), "+v"(fr), "+v"(fq));
        const int pn12 = u.pn % 12;
#pragma unroll
        for (int ai = 0; ai < 2; ++ai)
#pragma unroll
        for (int m = 0; m < 4; ++m) { const int row = u.pm * 256 + ai * 128 + wr * 64 + m * 16 + fr;
#pragma unroll
            for (int bj = 0; bj < 2; ++bj) { const int c0 = bj * 128 + wc * 32 + 8 * fq; EPI_V8(v, acc, ai, bj, m)
                *(u32x4*)(PG + (size_t)row * 3072 + pn12 * 256 + c0) = pack8(v); } }
    }
};
struct EpiInproj {
    EPI_NOHOOK
    bf16_t *PR, *PC, *PM, *PG, *KB; float* SSQ; const f32x2* RT; const f32x2* MT;
    __device__ __forceinline__ void operator()(const pg8::Acc& acc, const pg8::Unit& u_, int wr, int wc, int fr, int fq) const {
        pg8::Unit u = u_; asm volatile("" : "+s"(u.pm), "+s"(u.pn), "+s"(u.aux0), "+s"(u.aux1), "+v"(fr), "+v"(fq));
        const int pn = u.pn;
#pragma unroll
        for (int ai = 0; ai < 2; ++ai)
#pragma unroll
        for (int m = 0; m < 4; ++m) { __builtin_amdgcn_sched_barrier(0);
            const int row = u.pm * 256 + ai * 128 + wr * 64 + m * 16 + fr;
            const int bl = row / SB, s = row - bl * SB; const bool lat = s >= CTXL; const int t = lat ? s - CTXL : 0;
            float ss[2] = {0.f, 0.f};
#pragma unroll
            for (int bj = 0; bj < 2; ++bj) {
                const int c0 = bj * 128 + wc * 32 + 8 * fq;
                EPI_V8(v, acc, ai, bj, m)
                if (pn <= 1) {
                    if (lat) rot4(v, RT + (size_t)t * 32 + ((c0 & 63) >> 1));
                    if (pn == 1) {
#pragma unroll
                        for (int k = 0; k < 8; ++k) v[k] *= 0.125f;
                    }
                    *(u32x4*)(PR + (size_t)row * 1536 + pn * 256 + c0) = pack8(v);
                } else if (pn <= 5) {
                    *(u32x4*)(PR + (size_t)row * 1536 + pn * 256 + c0) = pack8(v);
                } else if (pn <= 7) {
                    *(u32x4*)(PC + (size_t)row * 1024 + (pn - 6) * 256 + c0) = pack8(v);
                } else if (pn <= 11) {
                    u32x2 w; w.x = cvtpk(v[0] * v[1], v[2] * v[3]); w.y = cvtpk(v[4] * v[5], v[6] * v[7]);
                    *(u32x2*)(PC + (size_t)row * 1024 + 512 + (pn - 8) * 128 + (c0 >> 1)) = w;
                } else if (pn <= 14) {
                    if (pn == 14 && bj == 1) {
                        if (wc == 0) {
                            if (lat) { const int a = fq >> 1, pos = a ? (t & 63) : (t >> 6); rot4(v, MT + pos * 8 + (fq & 1) * 4); }
                            const u32x4 w = pack8(v);
#pragma unroll
                            for (int hh = 0; hh < 8; ++hh) *(u32x4*)(KB + ((size_t)(bl * 8 + hh) * SB + s) * 96 + 64 + 8 * fq) = w;
                        }
                    } else {
                        *(u32x4*)(PM + (size_t)row * 640 + (pn - 12) * 256 + c0) = pack8(v);
                        float q = 0.f;
#pragma unroll
                        for (int k = 0; k < 8; ++k) q += v[k] * v[k];
                        ss[bj] = q;
                    }
                } else {
                    float g[8];
#pragma unroll
                    for (int k = 0; k < 8; ++k) { const float x = fminf(fmaxf(v[k], -15.f), 15.f); g[k] = sigmoidf_(x); }
                    ST_NT((u32x4*)(PG + (size_t)row * 3072 + (pn - 15) * 256 + c0), pack8(g));
                }
            }
            if (pn >= 12 && pn <= 14) {
                float a = ss[0], b = ss[1];
                a += swz_xor<16>(a); a = half_sum(a); b += swz_xor<16>(b); b = half_sum(b);
                if (fq == 0) {
                    float* sq = SSQ + (size_t)row * 16;
                    if (pn == 12) sq[wc] = a + b;
                    else if (pn == 13) { sq[4 + wc] = a; sq[8 + wc] = b; }
                    else sq[12 + wc] = a;
                }
            }
        }
    }
};

struct EpiUq {
    EPI_NOHOOK
    bf16_t* QB; const float* SSQ; const f32x2* MT;
    __device__ __forceinline__ void operator()(const pg8::Acc& acc, const pg8::Unit& u_, int wr, int wc, int fr, int fq) const {
        pg8::Unit u = u_; asm volatile("" : "+s"(u.pm), "+s"(u.pn), "+s"(u.aux0), "+s"(u.aux1), "+v"(fr), "+v"(fq));
#pragma unroll
        for (int ai = 0; ai < 2; ++ai)
#pragma unroll
        for (int m = 0; m < 4; ++m) { __builtin_amdgcn_sched_barrier(0);
            const int row = u.pm * 256 + ai * 128 + wr * 64 + m * 16 + fr;
            const int bl = row / SB, s = row - bl * SB; const bool lat = s >= CTXL; const int t = lat ? s - CTXL : 0;
            const f32x4 q0 = *(const f32x4*)(SSQ + (size_t)row * 16), q1 = *(const f32x4*)(SSQ + (size_t)row * 16 + 4);
            const float ssq = ((q0[0] + q0[1]) + (q0[2] + q0[3])) + ((q1[0] + q1[1]) + (q1[2] + q1[3]));
            const float rq = rsqrtf(ssq * (1.f / 384.f) + RMS_EPS) * QSCALE;
#pragma unroll
            for (int bj = 0; bj < 2; ++bj) {
                const int cg = u.pn * 256 + bj * 128 + wc * 32 + 8 * fq; const int h = cg / 96, d0 = cg - h * 96;
                EPI_V8(v, acc, ai, bj, m)
#pragma unroll
                for (int k = 0; k < 8; ++k) v[k] *= rq;
                if (d0 >= 64 && lat) { const int p0 = d0 - 64, a = p0 >> 4, pos = a ? (t & 63) : (t >> 6); rot4(v, MT + pos * 8 + ((p0 & 15) >> 1)); }
                *(u32x4*)(QB + ((size_t)(bl * 8 + h) * SB + s) * 96 + d0) = pack8(v);
            }
        }
    }
};
struct EpiUkv {
    EPI_NOHOOK
    bf16_t *KB, *VB; const float* SSQ;
    __device__ __forceinline__ void operator()(const pg8::Acc& acc, const pg8::Unit& u_, int wr, int wc, int fr, int fq) const {
        pg8::Unit u = u_; asm volatile("" : "+s"(u.pm), "+s"(u.pn), "+s"(u.aux0), "+s"(u.aux1), "+v"(fr), "+v"(fq));
#pragma unroll
        for (int ai = 0; ai < 2; ++ai)
#pragma unroll
        for (int m = 0; m < 4; ++m) { __builtin_amdgcn_sched_barrier(0);
            const int row = u.pm * 256 + ai * 128 + wr * 64 + m * 16 + fr;
            const int bl = row / SB, s = row - bl * SB;
            const f32x4 q0 = *(const f32x4*)(SSQ + (size_t)row * 16 + 8), q1 = *(const f32x4*)(SSQ + (size_t)row * 16 + 12);
            const float ssq = ((q0[0] + q0[1]) + (q0[2] + q0[3])) + ((q1[0] + q1[1]) + (q1[2] + q1[3]));
            const float rk = rsqrtf(ssq * (1.f / 256.f) + RMS_EPS);
#pragma unroll
            for (int bj = 0; bj < 2; ++bj) {
                const int cg = u.pn * 256 + bj * 128 + wc * 32 + 8 * fq; const int h = cg >> 7, e0 = cg & 127;
                EPI_V8(v, acc, ai, bj, m)
#pragma unroll
                for (int k = 0; k < 8; ++k) v[k] *= rk;
                if (e0 < 64) *(u32x4*)(KB + ((size_t)(bl * 8 + h) * SB + s) * 96 + e0) = pack8(v);
                else *(u32x4*)(VB + ((size_t)(bl * 8 + h) * SB + s) * 64 + (e0 - 64)) = pack8(v);
            }
        }
    }
};

struct EpiMerge1 {
    static constexpr bool HOOK = true; static constexpr int HOOK_T0 = 8, HOOK_T1 = 16;
    const bf16_t* PG; bf16_t* M;
    __device__ __forceinline__ void hook(pg8::Acc& acc, const pg8::Unit& u_, int t, int wr, int wc, int fr, int fq) const {
        pg8::Unit u = u_; asm volatile("" : "+s"(u.pm), "+s"(u.pn), "+v"(fr), "+v"(fq));
        const int gi = (t == 8) ? 0 : 1;
#pragma unroll
        for (int ai = 0; ai < 2; ++ai)
#pragma unroll
        for (int m = 0; m < 4; ++m) { __builtin_amdgcn_sched_barrier(0);
            const int row = u.pm * 256 + ai * 128 + wr * 64 + m * 16 + fr;
#pragma unroll
            for (int bj = 0; bj < 2; ++bj) {
                const int cg = u.pn * 256 + bj * 128 + wc * 32 + 8 * fq;
                const bf16_t* p = PG + (size_t)row * 3072 + gi * 1024 + cg;
                const u32x4 sp = *(const u32x4*)p, sn = *(const u32x4*)(p + 1024);
                float a[8], b[8]; unpack8(sp, a); unpack8(sn, b);
                f32x4 r0, r1;
#pragma unroll
                for (int k = 0; k < 4; ++k) { r0[k] = a[k] * __builtin_amdgcn_rcpf(b[k]); r1[k] = a[4 + k] * __builtin_amdgcn_rcpf(b[4 + k]); }
                acc[ai][bj][m][0] *= r0; acc[ai][bj][m][1] *= r1;
            }
        }
    }
    __device__ __forceinline__ void operator()(const pg8::Acc& acc, const pg8::Unit& u_, int wr, int wc, int fr, int fq) const {
        pg8::Unit u = u_; asm volatile("" : "+s"(u.pm), "+s"(u.pn), "+s"(u.aux0), "+s"(u.aux1), "+v"(fr), "+v"(fq));
#pragma unroll
        for (int ai = 0; ai < 2; ++ai)
#pragma unroll
        for (int m = 0; m < 4; ++m) { __builtin_amdgcn_sched_barrier(0);
            const int row = u.pm * 256 + ai * 128 + wr * 64 + m * 16 + fr;
#pragma unroll
            for (int bj = 0; bj < 2; ++bj) {
                const int cg = u.pn * 256 + bj * 128 + wc * 32 + 8 * fq;
                const u32x4 s2 = *(const u32x4*)(PG + (size_t)row * 3072 + 2048 + cg);
                float g[8]; unpack8(s2, g);
                EPI_V8(v, acc, ai, bj, m)
#pragma unroll
                for (int k = 0; k < 8; ++k) v[k] *= g[k];
                *(u32x4*)(M + (size_t)row * 1024 + cg) = pack8(v);
            }
        }
    }
};

struct EpiMerge2 {
    EPI_NOHOOK
    Resid R; const float* MODL;
    __device__ __forceinline__ void operator()(const pg8::Acc& acc, const pg8::Unit& u_, int wr, int wc, int fr, int fq) const {
        pg8::Unit u = u_; asm volatile("" : "+s"(u.pm), "+s"(u.pn), "+s"(u.aux0), "+s"(u.aux1), "+v"(fr), "+v"(fq));
#pragma unroll
        for (int ai = 0; ai < 2; ++ai)
#pragma unroll
        for (int m = 0; m < 4; ++m) { __builtin_amdgcn_sched_barrier(0);
            const int row = u.pm * 256 + ai * 128 + wr * 64 + m * 16 + fr;
            const float* src = R.src(row); float* dst = R.dst(row); const float* g1 = MODL + R.modv(row) * 6144 + 2048;
#pragma unroll
            for (int bj = 0; bj < 2; ++bj) {
                const int cg = u.pn * 256 + bj * 128 + wc * 32 + 8 * fq;
#pragma unroll
                for (int n = 0; n < 2; ++n) { const f32x4 x = *(const f32x4*)(src + cg + 4 * n), g = *(const f32x4*)(g1 + cg + 4 * n);
                    *(f32x4*)(dst + cg + 4 * n) = x + g * acc[ai][bj][m][n]; }
            }
        }
    }
};

struct EpiMoeUp {
    EPI_NOHOOK
    const int* LIST; const float* WGT; bf16_t* MACT;
    __device__ __forceinline__ void operator()(const pg8::Acc& acc, const pg8::Unit& u_, int wr, int wc, int fr, int fq) const {
        pg8::Unit u = u_; asm volatile("" : "+s"(u.pm), "+s"(u.pn), "+s"(u.aux0), "+s"(u.aux1), "+v"(fr), "+v"(fq));
        const int slot = u.pn >> 2;
#pragma unroll
        for (int ai = 0; ai < 2; ++ai)
#pragma unroll
        for (int m = 0; m < 4; ++m) { __builtin_amdgcn_sched_barrier(0);
            const int ri = ai * 128 + wr * 64 + m * 16 + fr; const int tok = LIST[u.aux0 + (ri < u.aux1 ? ri : 0)];
            const float w = WGT[(size_t)tok * 2 + slot];
#pragma unroll
            for (int bj = 0; bj < 2; ++bj) {
                const int c0 = bj * 128 + wc * 32 + 8 * fq;
                EPI_V8(v, acc, ai, bj, m)
                u32x2 o; o.x = cvtpk(siluf_(v[0]) * v[1] * w, siluf_(v[2]) * v[3] * w); o.y = cvtpk(siluf_(v[4]) * v[5] * w, siluf_(v[6]) * v[7] * w);
                *(u32x2*)(MACT + (size_t)(u.pm * 256 + ri) * 1024 + slot * 512 + (u.pn & 3) * 128 + (c0 >> 1)) = o;
            }
        }
    }
};
struct EpiMoeDown {
    EPI_NOHOOK
    const int* LIST; Resid R; const float* MODL; float* dry;
    __device__ __forceinline__ void operator()(const pg8::Acc& acc, const pg8::Unit& u_, int wr, int wc, int fr, int fq) const {
        pg8::Unit u = u_; asm volatile("" : "+s"(u.pm), "+s"(u.pn), "+s"(u.aux0), "+s"(u.aux1), "+v"(fr), "+v"(fq));
#pragma unroll
        for (int ai = 0; ai < 2; ++ai)
#pragma unroll
        for (int m = 0; m < 4; ++m) { __builtin_amdgcn_sched_barrier(0);
            const int ri = ai * 128 + wr * 64 + m * 16 + fr;
            if (ri < u.aux1) {
                const int tok = LIST[u.aux0 + ri];
                float* dst = R.dst(tok); const float* g2 = MODL + R.modv(tok) * 6144 + 5120;
#pragma unroll
                for (int bj = 0; bj < 2; ++bj) {
                    const int cg = u.pn * 256 + bj * 128 + wc * 32 + 8 * fq;
#pragma unroll
                    for (int n = 0; n < 2; ++n) { const f32x4 x = *(const f32x4*)(dst + cg + 4 * n), g = *(const f32x4*)(g2 + cg + 4 * n);
                        float* o = dry ? dry + (size_t)(u.pm * 256 + ri) * 1024 + cg + 4 * n : dst + cg + 4 * n;
                        *(f32x4*)o = x + g * acc[ai][bj][m][n]; }
                }
            }
        }
    }
};
#define SBAR() __builtin_amdgcn_sched_barrier(0)
__device__ __forceinline__ int crow(int r, int hi) { return (r & 3) + 8 * (r >> 2) + 4 * hi; }
template <int NCB> __device__ __forceinline__ int v_st(int k, int c) { const int kk = (k & ~0xC) | ((k & 4) << 1) | ((k & 8) >> 1); return ((kk >> 3) * NCB + (c >> 5)) * 512 + ((kk & 7) * 32 + (c & 31)) * 2; }
__device__ __forceinline__ int v_rd_base(int lane) { return ((lane & 3) << 3) | (((lane >> 2) & 3) << 6) | (((lane >> 4) & 1) << 5) | (((lane >> 5) & 1) << 8); }
template <int OFF> __device__ __forceinline__ s16x4 tr_read(int vb) { s16x4 r; asm volatile("ds_read_b64_tr_b16 %0, %1 offset:%2" : "=&v"(r) : "v"(vb), "i"(OFF) : "memory"); return r; }
#define PKLH(L, H) (bf16x8){L[0], L[1], L[2], L[3], H[0], H[1], H[2], H[3]}
template <int NCB, int KS> __device__ __forceinline__ bf16x8 tr_frag(int vb) { const s16x4 l = tr_read<KS * NCB * 1024>(vb), h = tr_read<KS * NCB * 1024 + NCB * 512>(vb); return PKLH(l, h); }
#define PK4(P, BASE, OUT) do { const unsigned a0 = cvtpk(P[BASE + 0], P[BASE + 1]), a1 = cvtpk(P[BASE + 2], P[BASE + 3]);   \
    const unsigned b0 = cvtpk(P[BASE + 4], P[BASE + 5]), b1 = cvtpk(P[BASE + 6], P[BASE + 7]);                              \
    auto r0 = __builtin_amdgcn_permlane32_swap(a0, b0, false, false); auto r1 = __builtin_amdgcn_permlane32_swap(a1, b1, false, false); \
    u32x4 w = {r0[0], r1[0], r0[1], r1[1]}; OUT = __builtin_bit_cast(bf16x8, w); } while (0)

namespace att {
constexpr int DQK = 96, DV = 64, KVBLK = 64;
constexpr int SHM_V = KVBLK * DV * 2;
constexpr int SHM_K = KVBLK * 256;
constexpr float THR = 8.f;
#define KSWZ(row, colB) ((row) * 256 + ((colB) ^ (((row) & 7) << 4)))
__device__ __forceinline__ void partialSM(f32x16& p0, f32x16& p1, float& m_reg, float& alpha) {
    float pmax = p0[0];
#pragma unroll
    for (int r = 1; r < 16; ++r) pmax = fmaxf(pmax, p0[r]);
#pragma unroll
    for (int r = 0; r < 16; ++r) pmax = fmaxf(pmax, p1[r]);
    { auto rr = __builtin_amdgcn_permlane32_swap(__float_as_uint(pmax), __float_as_uint(pmax), false, false);
      pmax = fmaxf(__uint_as_float(rr[0]), __uint_as_float(rr[1])); }
    float mn;
    if (__builtin_expect(__all(pmax - m_reg <= THR), 1)) { mn = m_reg; alpha = 1.f; }
    else { mn = fmaxf(m_reg, pmax); alpha = __builtin_amdgcn_exp2f(m_reg - mn); m_reg = mn; }
#pragma unroll
    for (int r = 0; r < 16; ++r) p0[r] = p0[r] - mn;
#pragma unroll
    for (int r = 0; r < 16; ++r) p1[r] = p1[r] - mn;
#pragma unroll
    for (int r = 0; r < 16; ++r) p0[r] = __builtin_amdgcn_exp2f(p0[r]);
}
__device__ __forceinline__ void finishSM(f32x16& p0, f32x16& p1, float alpha, float& l_reg, bf16x8& pa0, bf16x8& pa1, bf16x8& pa2, bf16x8& pa3) {
#pragma unroll
    for (int r = 0; r < 16; ++r) p1[r] = __builtin_amdgcn_exp2f(p1[r]);
    float ps = 0;
#pragma unroll
    for (int r = 0; r < 16; ++r) ps += p0[r];
#pragma unroll
    for (int r = 0; r < 16; ++r) ps += p1[r];
    { auto rr = __builtin_amdgcn_permlane32_swap(__float_as_uint(ps), __float_as_uint(ps), false, false);
      ps = __uint_as_float(rr[0]) + __uint_as_float(rr[1]); }
    l_reg = l_reg * alpha + ps;
    PK4(p0, 0, pa0); PK4(p0, 8, pa1); PK4(p1, 0, pa2); PK4(p1, 8, pa3);
}
__device__ __forceinline__ void qkt(f32x16& p0, f32x16& p1, const LAS char* Ks, const bf16x8* qr, int r32, int hi) {
    p0 = f32x16{}; p1 = f32x16{};
#pragma unroll
    for (int d0 = 0; d0 < 6; ++d0) { const int cb = (d0 * 16 + hi * 8) * 2;
        const bf16x8 b0 = *(const LAS bf16x8*)(Ks + KSWZ(r32, cb));
        const bf16x8 b1 = *(const LAS bf16x8*)(Ks + KSWZ(32 + r32, cb));
        p0 = __builtin_amdgcn_mfma_f32_32x32x16_bf16(b0, qr[d0], p0, 0, 0, 0);
        p1 = __builtin_amdgcn_mfma_f32_32x32x16_bf16(b1, qr[d0], p1, 0, 0, 0); }
}
template <int D0> __device__ __forceinline__ void pv_one(f32x16& od, int vb, bf16x8 pa0, bf16x8 pa1, bf16x8 pa2, bf16x8 pa3) {
    const bf16x8 f0 = tr_frag<2, 0>(vb + D0 * 512), f1 = tr_frag<2, 1>(vb + D0 * 512), f2 = tr_frag<2, 2>(vb + D0 * 512), f3 = tr_frag<2, 3>(vb + D0 * 512);
    asm volatile("s_waitcnt lgkmcnt(0)" ::: "memory"); SBAR();
    od = __builtin_amdgcn_mfma_f32_32x32x16_bf16(pa0, f0, od, 0, 0, 0);
    od = __builtin_amdgcn_mfma_f32_32x32x16_bf16(pa1, f1, od, 0, 0, 0);
    od = __builtin_amdgcn_mfma_f32_32x32x16_bf16(pa2, f2, od, 0, 0, 0);
    od = __builtin_amdgcn_mfma_f32_32x32x16_bf16(pa3, f3, od, 0, 0, 0);
}
__device__ __forceinline__ void pv_d0(f32x16* o, int vb, bf16x8 pa0, bf16x8 pa1, bf16x8 pa2, bf16x8 pa3) {
    pv_one<0>(o[0], vb, pa0, pa1, pa2, pa3); pv_one<1>(o[1], vb, pa0, pa1, pa2, pa3);
}
__device__ __forceinline__ void attn_unit(const bf16_t* __restrict__ Qb, const bf16_t* __restrict__ Kh, const bf16_t* __restrict__ Vh, bf16_t* __restrict__ Ob, int ldo, int seq, LAS char* lds, const int wv) {
    const int tid = otid(wv), wid = __builtin_amdgcn_readfirstlane(tid >> 6), lane = tid & 63, r32 = lane & 31, hi = lane >> 5;
    LAS char* V_lds = lds; LAS char* K_lds = lds + 2 * SHM_V;
    LAS float* ws = (LAS float*)(lds + 2 * SHM_V + 2 * SHM_K) + wid * 64; LAS float* li_l = ws; LAS float* al_l = ws + 32;
    float m_reg = -1e30f, l_reg = 0; f32x16 o[2] = {}; bf16x8 qr[6];
    const bf16_t* Qw = Qb + (size_t)(wid * 32 + r32) * DQK + hi * 8;
#pragma unroll
    for (int d0 = 0; d0 < 6; ++d0) qr[d0] = *(const bf16x8*)(Qw + d0 * 16);
    const int vrow = tid >> 3, vc = (tid & 7) * 8, vst = v_st<2>(vrow, vc);
    const int krA = tid / 12, kcA = tid - krA * 12, sB = 512 + tid, krB = sB / 12, kcB = sB - krB * 12;
    const int kstA = KSWZ(krA, kcA * 16), kstB = KSWZ(krB, kcB * 16);
    const bool hasB = wid < 4;
    const int vb0 = (int)(size_t)V_lds + v_rd_base(lane);
    struct { bf16x8 v, ka, kb; } sr_[2];
#define SLOAD(i, k0) do { sr_[i].v = *(const bf16x8*)(Vh + (size_t)((k0) + vrow) * DV + vc); sr_[i].ka = *(const bf16x8*)(Kh + (size_t)((k0) + krA) * DQK + kcA * 8); \
    if (hasB) sr_[i].kb = *(const bf16x8*)(Kh + (size_t)((k0) + krB) * DQK + kcB * 8); } while (0)
#define SWRITE(b, i) do { *(LAS bf16x8*)(V_lds + (b) * SHM_V + vst) = sr_[i].v; *(LAS bf16x8*)(K_lds + (b) * SHM_K + kstA) = sr_[i].ka; \
    if (hasB) *(LAS bf16x8*)(K_lds + (b) * SHM_K + kstB) = sr_[i].kb; } while (0)
#define RESC(a) do { if (__any((a) < 1.f)) { if (hi == 0) al_l[r32] = (a); asm volatile("s_waitcnt lgkmcnt(0)" ::: "memory"); \
    _Pragma("unroll") for (int d = 0; d < 2; ++d) _Pragma("unroll") for (int r = 0; r < 16; ++r) o[d][r] *= al_l[crow(r, hi)]; } } while (0)
    f32x16 pA0, pA1, pB0, pB1; float alA, alB; bf16x8 pa0, pa1, pa2, pa3; const int NTL = seq / KVBLK;
    SLOAD(0, 0); SWRITE(0, 0); __syncthreads();
    qkt(pA0, pA1, K_lds, qr, r32, hi); partialSM(pA0, pA1, m_reg, alA);
    SLOAD(1, KVBLK); if (2 < NTL) SLOAD(0, 2 * KVBLK);
    SWRITE(1, 1); __syncthreads();
    for (int j = 1; j + 1 < NTL; j += 2) {
        SBAR(); qkt(pB0, pB1, K_lds + SHM_K, qr, r32, hi);
        finishSM(pA0, pA1, alA, l_reg, pa0, pa1, pa2, pa3); SBAR();
        SLOAD(1, (j + 2) * KVBLK); SBAR();
        pv_d0(o, vb0, pa0, pa1, pa2, pa3); partialSM(pB0, pB1, m_reg, alB);
        __syncthreads(); SWRITE(0, 0);
        RESC(alB); __syncthreads();
        SBAR(); qkt(pA0, pA1, K_lds, qr, r32, hi);
        finishSM(pB0, pB1, alB, l_reg, pa0, pa1, pa2, pa3); SBAR();
        if (j + 3 < NTL) SLOAD(0, (j + 3) * KVBLK); SBAR();
        pv_d0(o, vb0 + SHM_V, pa0, pa1, pa2, pa3); partialSM(pA0, pA1, m_reg, alA);
        __syncthreads(); SWRITE(1, 1);
        RESC(alA); __syncthreads();
    }
    SBAR(); qkt(pB0, pB1, K_lds + SHM_K, qr, r32, hi);
    finishSM(pA0, pA1, alA, l_reg, pa0, pa1, pa2, pa3); SBAR();
    pv_d0(o, vb0, pa0, pa1, pa2, pa3); partialSM(pB0, pB1, m_reg, alB);
    __syncthreads(); RESC(alB);
    finishSM(pB0, pB1, alB, l_reg, pa0, pa1, pa2, pa3); SBAR();
    pv_d0(o, vb0 + SHM_V, pa0, pa1, pa2, pa3);
    if (hi == 0) li_l[r32] = l_reg; asm volatile("s_waitcnt lgkmcnt(0)" ::: "memory");
    float rli[16];
#pragma unroll
    for (int r = 0; r < 16; ++r) rli[r] = __builtin_amdgcn_rcpf(li_l[crow(r, hi)]);
    bf16_t* Ow = Ob + (size_t)(wid * 32) * ldo;
#pragma unroll
    for (int r = 0; r < 16; ++r) { const int orow = crow(r, hi);
#pragma unroll
        for (int d0 = 0; d0 < 2; ++d0) Ow[(size_t)orow * ldo + d0 * 32 + r32] = f2bf(o[d0][r] * rli[r]); }
    __syncthreads();
#undef SLOAD
#undef SWRITE
#undef RESC
}
}

namespace att2 {
constexpr int DQK = 96, DV = 64, KVBLK = 64;
constexpr int KB_BYTES = 64 * 256, VB_BYTES = 64 * 64 * 2;
constexpr int NSLOT = 5;
constexpr int LDS_K = 0, LDS_V = NSLOT * KB_BYTES, LDS_WS = LDS_V + NSLOT * VB_BYTES, LDS_TOTAL = LDS_WS + 8 * 64 * 4;
static_assert(LDS_TOTAL <= RING_BYTES, "attention LDS");
constexpr float THR = 8.f;
typedef short v4i16_t __attribute__((ext_vector_type(4)));
__device__ __forceinline__ s16x4 vtr(const LAS char* p) { return __builtin_bit_cast(s16x4, __builtin_amdgcn_ds_read_tr16_b64_v4i16((LAS v4i16_t*)p)); }
#define PP_KLD(D0) do { const int cb_ = ((D0) * 16 + hi * 8) * 2; kf[2 * (D0)] = *(const LAS bf16x8*)(Kt + KSWZ(r32, cb_)); kf[2 * (D0) + 1] = *(const LAS bf16x8*)(Kt + KSWZ(32 + r32, cb_)); } while (0)
#define PP_VLD(D0V, KS) ({ const s16x4 l_ = vtr(Vs + (D0V) * 512 + (KS) * 2048), h_ = vtr(Vs + (D0V) * 512 + (KS) * 2048 + 1024); PKLH(l_, h_); })
#ifdef PROBE_EXP2X
#define PP_EXP(x) do { float a_ = (x), b_ = (x); asm volatile("" : "+v"(b_)); a_ = __builtin_amdgcn_exp2f(a_); b_ = __builtin_amdgcn_exp2f(b_); (x) = (a_ + b_) * 0.5f; } while (0)
#else
#define PP_EXP(x) (x) = __builtin_amdgcn_exp2f(x)
#endif
#define PP_SLOT_END() do { SBAR(); asm volatile("s_waitcnt vmcnt(%0) lgkmcnt(0)\n\ts_barrier" :: "n"(3 * (NSLOT - 2)) : "memory"); SBAR(); } while (0)
#define PP_BAR() do { SBAR(); asm volatile("s_waitcnt lgkmcnt(0)\n\ts_barrier" ::: "memory"); SBAR(); } while (0)
__device__ __forceinline__ float max3f(float a, float b, float c) { return fmaxf(fmaxf(a, b), c); }
__device__ __forceinline__ void attn_unit_pp(const bf16_t* __restrict__ Qb, const bf16_t* __restrict__ Kh, const bf16_t* __restrict__ Vh, bf16_t* __restrict__ Ob, int ldo, int seq, LAS char* lds, const int wv) {
    const int tid = otid(wv), wid = __builtin_amdgcn_readfirstlane(tid >> 6), lane = tid & 63, r32 = lane & 31, hi = lane >> 5, grp = wid >> 2;
    LAS float* ws = (LAS float*)(lds + LDS_WS) + wid * 64; LAS float* li_l = ws; LAS float* al_l = ws + 32;
    const int NTL = seq / KVBLK;
    unsigned koff[2], voff;
#pragma unroll
    for (int i = 0; i < 2; ++i) { const int s = (2 * wid + i) * 64 + lane, row = s >> 4; int c = (s & 15) ^ (row & 7); c = c > 11 ? 11 : c; koff[i] = (unsigned)(row * 192 + c * 16); }
    { const int s = wid * 64 + lane, sub = s >> 5, win = s & 31, kk = (sub >> 1) * 8 + (win >> 2), key = (kk & ~0xC) | ((kk & 4) << 1) | ((kk & 8) >> 1), c = (sub & 1) * 32 + (win & 3) * 8; voff = (unsigned)(key * 128 + c * 2); }
    const char* Kg = (const char*)Kh; const char* Vg = (const char*)Vh;
#define PP_DMA_K(t) do { int tt_ = (t); tt_ = tt_ < NTL ? tt_ : NTL - 1; const int sl_ = tt_ % NSLOT; _Pragma("unroll") for (int i_ = 0; i_ < 2; ++i_) \
        __builtin_amdgcn_global_load_lds((const unsigned*)(Kg + (size_t)tt_ * (64 * 192) + koff[i_]), (LAS unsigned*)(lds + LDS_K + sl_ * KB_BYTES + (2 * wid + i_) * 1024), 16, 0, 0); } while (0)
#define PP_DMA_V(t) do { int tt_ = (t); tt_ = tt_ < NTL ? tt_ : NTL - 1; const int sl_ = tt_ % NSLOT; \
        __builtin_amdgcn_global_load_lds((const unsigned*)(Vg + (size_t)tt_ * (64 * 128) + voff), (LAS unsigned*)(lds + LDS_V + sl_ * VB_BYTES + wid * 1024), 16, 0, 0); } while (0)
#pragma unroll
    for (int i = 0; i <= NSLOT - 2; ++i) PP_DMA_K(i);
#pragma unroll
    for (int i = 0; i <= NSLOT - 3; ++i) PP_DMA_V(i);
    bf16x8 qr[6];
    { const bf16_t* Qw = Qb + (size_t)(wid * 32 + r32) * DQK + hi * 8;
#pragma unroll
      for (int d0 = 0; d0 < 6; ++d0) qr[d0] = *(const bf16x8*)(Qw + d0 * 16); }
    float m_reg = 0.f, l_reg = 0.f; f32x16 o[2] = {}; f32x16 negm = {}; asm volatile("" : "+v"(negm));
    f32x16 p0, p1; bf16x8 pa0, pa1, pa2, pa3;
    const int vb0 = (int)(size_t)(lds + LDS_V) + v_rd_base(lane);
    SBAR(); asm volatile("s_waitcnt vmcnt(0) lgkmcnt(0)\n\ts_barrier" ::: "memory"); SBAR();
#ifndef PROBE_NOOFFSET
    if (grp == 1) PP_BAR();
#endif
#define PP_M(t) do { const int t_ = (t), j_ = t_ + 1; \
        if (t_ <= NTL - 2) { PP_DMA_V(t_ + NSLOT - 1); PP_DMA_K(t_ + NSLOT); } \
        bf16x8 kf[12]; bf16x8 vf[8]; \
        const LAS char* Kt = lds + LDS_K + ((j_ < NTL ? j_ : 0) % NSLOT) * KB_BYTES; \
        const LAS char* Vs = lds + LDS_V + ((t_ < 0 ? 0 : t_) % NSLOT) * VB_BYTES + v_rd_base(lane); \
        if (j_ < NTL) { \
            PP_KLD(0); PP_KLD(1); SBAR(); \
            _Pragma("unroll") for (int d0 = 0; d0 < 6; ++d0) { \
                if (d0 + 2 < 6) { PP_KLD(d0 + 2); } else if (t_ >= 0) { vf[2 * (d0 - 4)] = PP_VLD(d0 - 4, 0); vf[2 * (d0 - 4) + 1] = PP_VLD(d0 - 4, 1); } \
                SBAR(); \
                if (d0 == 0) { p0 = __builtin_amdgcn_mfma_f32_32x32x16_bf16(kf[0], qr[0], negm, 0, 0, 0); p1 = __builtin_amdgcn_mfma_f32_32x32x16_bf16(kf[1], qr[0], negm, 0, 0, 0); } \
                else { p0 = __builtin_amdgcn_mfma_f32_32x32x16_bf16(kf[2 * d0], qr[d0], p0, 0, 0, 0); p1 = __builtin_amdgcn_mfma_f32_32x32x16_bf16(kf[2 * d0 + 1], qr[d0], p1, 0, 0, 0); } \
                SBAR(); } \
        } else if (t_ >= 0) { vf[0] = PP_VLD(0, 0); vf[1] = PP_VLD(0, 1); vf[2] = PP_VLD(1, 0); vf[3] = PP_VLD(1, 1); SBAR(); } \
        if (t_ >= 0) { \
            vf[4] = PP_VLD(0, 2); SBAR(); o[0] = __builtin_amdgcn_mfma_f32_32x32x16_bf16(pa0, vf[0], o[0], 0, 0, 0); SBAR(); \
            vf[5] = PP_VLD(1, 2); SBAR(); o[1] = __builtin_amdgcn_mfma_f32_32x32x16_bf16(pa0, vf[2], o[1], 0, 0, 0); SBAR(); \
            vf[6] = PP_VLD(0, 3); SBAR(); o[0] = __builtin_amdgcn_mfma_f32_32x32x16_bf16(pa1, vf[1], o[0], 0, 0, 0); SBAR(); \
            vf[7] = PP_VLD(1, 3); SBAR(); o[1] = __builtin_amdgcn_mfma_f32_32x32x16_bf16(pa1, vf[3], o[1], 0, 0, 0); SBAR(); \
            o[0] = __builtin_amdgcn_mfma_f32_32x32x16_bf16(pa2, vf[4], o[0], 0, 0, 0); o[1] = __builtin_amdgcn_mfma_f32_32x32x16_bf16(pa2, vf[5], o[1], 0, 0, 0); \
            o[0] = __builtin_amdgcn_mfma_f32_32x32x16_bf16(pa3, vf[6], o[0], 0, 0, 0); o[1] = __builtin_amdgcn_mfma_f32_32x32x16_bf16(pa3, vf[7], o[1], 0, 0, 0); } \
        asm volatile("" : "+v"(o[0]), "+v"(o[1]), "+v"(p0), "+v"(p1));        \
        } while (0)
#define PP_S(first) do { \
        float a_ = max3f(p0[0], p0[1], p1[0]), b_ = max3f(p0[2], p0[3], p1[1]); a_ = max3f(a_, p1[2], p1[3]); \
        _Pragma("unroll") for (int r = 4; r < 16; r += 4) { a_ = max3f(a_, p0[r], p0[r + 1]); b_ = max3f(b_, p0[r + 2], p0[r + 3]); a_ = max3f(a_, p1[r], p1[r + 1]); b_ = max3f(b_, p1[r + 2], p1[r + 3]); } \
        float rm_ = fmaxf(a_, b_); { auto rr = __builtin_amdgcn_permlane32_swap(__float_as_uint(rm_), __float_as_uint(rm_), false, false); rm_ = fmaxf(__uint_as_float(rr[0]), __uint_as_float(rr[1])); } \
        if (first) { m_reg = rm_; _Pragma("unroll") for (int r = 0; r < 16; ++r) { p0[r] -= rm_; p1[r] -= rm_; } \
            _Pragma("unroll") for (int r = 0; r < 16; ++r) negm[r] = -m_reg; asm volatile("" : "+v"(negm)); } \
        else if (__builtin_expect(__any(rm_ > THR), 0)) { const float dl = fmaxf(rm_, 0.f); m_reg += dl; \
            _Pragma("unroll") for (int r = 0; r < 16; ++r) { p0[r] -= dl; p1[r] -= dl; } \
            _Pragma("unroll") for (int r = 0; r < 16; ++r) negm[r] = -m_reg; asm volatile("" : "+v"(negm)); \
            const float al = __builtin_amdgcn_exp2f(-dl); l_reg *= al; if (hi == 0) al_l[r32] = al; asm volatile("s_waitcnt lgkmcnt(0)" ::: "memory"); \
            _Pragma("unroll") for (int d = 0; d < 2; ++d) _Pragma("unroll") for (int r = 0; r < 16; ++r) o[d][r] *= al_l[crow(r, hi)]; } \
        _Pragma("unroll") for (int r = 0; r < 16; ++r) { PP_EXP(p0[r]); PP_EXP(p1[r]); } \
        float ps_ = 0.f; _Pragma("unroll") for (int r = 0; r < 16; ++r) ps_ += p0[r]; _Pragma("unroll") for (int r = 0; r < 16; ++r) ps_ += p1[r]; \
        { auto rr = __builtin_amdgcn_permlane32_swap(__float_as_uint(ps_), __float_as_uint(ps_), false, false); ps_ = __uint_as_float(rr[0]) + __uint_as_float(rr[1]); } \
        l_reg += ps_; \
        PK4(p0, 0, pa0); PK4(p0, 8, pa1); PK4(p1, 0, pa2); PK4(p1, 8, pa3); \
        asm volatile("" : "+v"(pa0), "+v"(pa1), "+v"(pa2), "+v"(pa3), "+v"(l_reg)); } while (0)
    PP_M(-1); PP_SLOT_END();
    PP_S(true); PP_SLOT_END();
#pragma nounroll
    for (int t = 0; t < NTL - 1; ++t) {
        PP_M(t); PP_SLOT_END();
        PP_S(false); PP_SLOT_END();
    }
    PP_M(NTL - 1);
#ifndef PROBE_NOOFFSET
    if (grp == 0) PP_BAR();
#endif
    if (hi == 0) li_l[r32] = l_reg; asm volatile("s_waitcnt lgkmcnt(0)" ::: "memory");
    float rli[16];
#pragma unroll
    for (int r = 0; r < 16; ++r) rli[r] = __builtin_amdgcn_rcpf(li_l[crow(r, hi)]);
    bf16_t* Ow = Ob + (size_t)(wid * 32) * ldo;
#pragma unroll
    for (int r = 0; r < 16; ++r) { const int orow = crow(r, hi);
#pragma unroll
        for (int d0 = 0; d0 < 2; ++d0) Ow[(size_t)orow * ldo + d0 * 32 + r32] = f2bf(o[d0][r] * rli[r]); }
    SBAR(); asm volatile("s_waitcnt vmcnt(0) lgkmcnt(0)\n\ts_barrier" ::: "memory"); SBAR();
#undef PP_DMA_K
#undef PP_DMA_V
#undef PP_M
#undef PP_S
}
}

__device__ __forceinline__ void retu_unit(int unit, const bf16_t* PR, float* U, float lg2f, float lg2b, LAS char* lds, const int wv) {
    const int tid = otid(wv), wid = __builtin_amdgcn_readfirstlane(tid >> 6), lane = tid & 63, r32 = lane & 31, hi = lane >> 5;
    const int h = unit & 3, bc = unit >> 2, bl = bc / NCHUNK, c = bc - bl * NCHUNK;
    const size_t r0 = (size_t)bl * SB + (size_t)c * 128;
    LAS char* Vt = lds;
    LAS char* Kf = lds + 32768;
    LAS char* Kb = lds + 49152;
#pragma unroll
    for (int i = 0; i < 2; ++i) { const int ch = tid + i * 512, j = ch >> 3, c8 = (ch & 7) * 8;
        const u32x4 kw = *(const u32x4*)(PR + (r0 + j) * 1536 + 256 + h * 64 + c8);
        float f[8], g[8]; unpack8(kw, f);
        const float wf = __builtin_amdgcn_exp2f(lg2f * (float)(127 - j)), wb = __builtin_amdgcn_exp2f(lg2b * (float)j);
#pragma unroll
        for (int k = 0; k < 8; ++k) { g[k] = f[k] * wb; f[k] *= wf; }
        const int off = (j >> 6) * 8192 + v_st<2>(j & 63, c8);
        *(LAS u32x4*)(Kf + off) = pack8(f); *(LAS u32x4*)(Kb + off) = pack8(g); }
#pragma unroll
    for (int i = 0; i < 4; ++i) { const int ch = tid + i * 512, j = ch >> 4, c8 = (ch & 15) * 8;
        const u32x4 vw = *(const u32x4*)(PR + (r0 + j) * 1536 + 512 + h * 128 + c8);
        *(LAS u32x4*)(Vt + (j >> 6) * 16384 + v_st<4>(j & 63, c8)) = vw; }
    __syncthreads();
    const int eblk = wid & 3, dblk = wid >> 2;
    const int vbV = (int)(size_t)Vt + v_rd_base(lane) + eblk * 512, vbF = (int)(size_t)Kf + v_rd_base(lane) + dblk * 512, vbB = (int)(size_t)Kb + v_rd_base(lane) + dblk * 512;
    f32x16 aF = {}, aB = {};
#define RU_STEP(SUB, KS) do { const bf16x8 a = tr_frag<4, KS>(vbV + SUB * 16384), bf = tr_frag<2, KS>(vbF + SUB * 8192), bb = tr_frag<2, KS>(vbB + SUB * 8192); \
        asm volatile("s_waitcnt lgkmcnt(0)" ::: "memory"); SBAR(); \
        aF = __builtin_amdgcn_mfma_f32_32x32x16_bf16(a, bf, aF, 0, 0, 0); aB = __builtin_amdgcn_mfma_f32_32x32x16_bf16(a, bb, aB, 0, 0, 0); } while (0)
    RU_STEP(0, 0); RU_STEP(0, 1); RU_STEP(0, 2); RU_STEP(0, 3); RU_STEP(1, 0); RU_STEP(1, 1); RU_STEP(1, 2); RU_STEP(1, 3);
#undef RU_STEP
    float* Uf = U + (size_t)unit * 2 * 8192; float* Ub = Uf + 8192;
#pragma unroll
    for (int r = 0; r < 16; ++r) { const int e = 32 * eblk + crow(r, hi), d = 32 * dblk + r32; Uf[e * 64 + d] = aF[r]; Ub[e * 64 + d] = aB[r]; }
    __syncthreads();
}

__device__ __forceinline__ void retout_unit(int unit, const bf16_t* PR, const bf16_t* S, const float* gnw, bf16_t* ACT, float lg2f, float lg2b, LAS char* lds, const int wv) {
    const int tid = otid(wv), wid = __builtin_amdgcn_readfirstlane(tid >> 6), lane = tid & 63, r32 = lane & 31, hi = lane >> 5;
    const int h = unit & 3, bc = unit >> 2, bl = bc / NCHUNK, c = bc - bl * NCHUNK;
    const size_t r0 = (size_t)bl * SB + (size_t)c * 128;
    LAS char* Vt = lds; LAS float* part = (LAS float*)(lds + 32768);
    const int qblk = wid & 3, ehalf = wid >> 2, iq = 32 * qblk + r32;
    u32x4 vw[4];
#pragma unroll
    for (int i = 0; i < 4; ++i) { const int ch = tid + i * 512, j = ch >> 4, c8 = (ch & 15) * 8; vw[i] = *(const u32x4*)(PR + (r0 + j) * 1536 + 512 + h * 128 + c8); }
    bf16x8 qf[4], kf[4][4];
    { const bf16_t* qp = PR + (r0 + iq) * 1536 + h * 64 + hi * 8;
#pragma unroll
      for (int d0 = 0; d0 < 4; ++d0) qf[d0] = *(const bf16x8*)(qp + d0 * 16); }
#pragma unroll
    for (int jb = 0; jb < 4; ++jb) { const bf16_t* kp = PR + (r0 + 32 * jb + r32) * 1536 + 256 + h * 64 + hi * 8;
#pragma unroll
        for (int d0 = 0; d0 < 4; ++d0) kf[jb][d0] = *(const bf16x8*)(kp + d0 * 16); }
    const int orow = tid >> 2, oc = (tid & 3) * 32;
    u32x4 gw[4];
#pragma unroll
    for (int k = 0; k < 4; ++k) gw[k] = *(const u32x4*)(PR + (r0 + orow) * 1536 + 1024 + h * 128 + oc + 8 * k);
#pragma unroll
    for (int i = 0; i < 4; ++i) { const int ch = tid + i * 512, j = ch >> 4, c8 = (ch & 15) * 8; *(LAS u32x4*)(Vt + (j >> 6) * 16384 + v_st<4>(j & 63, c8)) = vw[i]; }
    f32x16 o[2] = {};
    __syncthreads();
    bf16x8 sf[2][4], sb[2][4];
    { const bf16_t* Sf = S + (size_t)unit * 2 * 8192; const bf16_t* Sb = Sf + 8192;
#pragma unroll
      for (int e0 = 0; e0 < 2; ++e0) { const int e = 64 * ehalf + 32 * e0 + r32;
#pragma unroll
        for (int d0 = 0; d0 < 4; ++d0) { sf[e0][d0] = *(const bf16x8*)(Sf + e * 64 + d0 * 16 + hi * 8); sb[e0][d0] = *(const bf16x8*)(Sb + e * 64 + d0 * 16 + hi * 8); } } }
    const int vb = (int)(size_t)Vt + v_rd_base(lane) + ehalf * 1024;
#pragma unroll
    for (int jb = 0; jb < 4; ++jb) {
        f32x16 p = {};
#pragma unroll
        for (int d0 = 0; d0 < 4; ++d0) p = __builtin_amdgcn_mfma_f32_32x32x16_bf16(kf[jb][d0], qf[d0], p, 0, 0, 0);
#pragma unroll
        for (int r = 0; r < 16; ++r) { const int dj = iq - (32 * jb + crow(r, hi));
            const float e = dj >= 0 ? lg2f * (float)dj : lg2b * (float)(-dj); p[r] *= __builtin_amdgcn_exp2f(e); }
        bf16x8 pa0, pa1; PK4(p, 0, pa0); PK4(p, 8, pa1);
        const int vj = vb + (jb >> 1) * 16384;
        if (jb & 1) {
            const bf16x8 f00 = tr_frag<4, 2>(vj), f01 = tr_frag<4, 3>(vj), f10 = tr_frag<4, 2>(vj + 512), f11 = tr_frag<4, 3>(vj + 512);
            asm volatile("s_waitcnt lgkmcnt(0)" ::: "memory"); SBAR();
            o[0] = __builtin_amdgcn_mfma_f32_32x32x16_bf16(pa0, f00, o[0], 0, 0, 0); o[0] = __builtin_amdgcn_mfma_f32_32x32x16_bf16(pa1, f01, o[0], 0, 0, 0);
            o[1] = __builtin_amdgcn_mfma_f32_32x32x16_bf16(pa0, f10, o[1], 0, 0, 0); o[1] = __builtin_amdgcn_mfma_f32_32x32x16_bf16(pa1, f11, o[1], 0, 0, 0);
        } else {
            const bf16x8 f00 = tr_frag<4, 0>(vj), f01 = tr_frag<4, 1>(vj), f10 = tr_frag<4, 0>(vj + 512), f11 = tr_frag<4, 1>(vj + 512);
            asm volatile("s_waitcnt lgkmcnt(0)" ::: "memory"); SBAR();
            o[0] = __builtin_amdgcn_mfma_f32_32x32x16_bf16(pa0, f00, o[0], 0, 0, 0); o[0] = __builtin_amdgcn_mfma_f32_32x32x16_bf16(pa1, f01, o[0], 0, 0, 0);
            o[1] = __builtin_amdgcn_mfma_f32_32x32x16_bf16(pa0, f10, o[1], 0, 0, 0); o[1] = __builtin_amdgcn_mfma_f32_32x32x16_bf16(pa1, f11, o[1], 0, 0, 0);
        }
    }
    {
        const float xf = __builtin_amdgcn_exp2f(lg2f * (float)(iq + 1)), xb = __builtin_amdgcn_exp2f(lg2b * (float)(128 - iq));
#pragma unroll
        for (int d0 = 0; d0 < 4; ++d0) {
            float f[8], g[8]; unpack8(__builtin_bit_cast(u32x4, qf[d0]), f);
#pragma unroll
            for (int k = 0; k < 8; ++k) { g[k] = f[k] * xb; f[k] *= xf; }
            const bf16x8 qa = __builtin_bit_cast(bf16x8, pack8(f)), qb = __builtin_bit_cast(bf16x8, pack8(g));
#pragma unroll
            for (int e0 = 0; e0 < 2; ++e0) { o[e0] = __builtin_amdgcn_mfma_f32_32x32x16_bf16(qa, sf[e0][d0], o[e0], 0, 0, 0); o[e0] = __builtin_amdgcn_mfma_f32_32x32x16_bf16(qb, sb[e0][d0], o[e0], 0, 0, 0); }
        }
    }
    float sq[16];
#pragma unroll
    for (int r = 0; r < 16; ++r) { float s = o[0][r] * o[0][r] + o[1][r] * o[1][r];
        sq[r] = sum32(s); }
    if (r32 == 0) {
#pragma unroll
        for (int r = 0; r < 16; ++r) part[wid * 32 + crow(r, hi)] = sq[r];
    }
    __syncthreads();
    const float g0 = gnw[h * 128 + 64 * ehalf + r32], g1 = gnw[h * 128 + 64 * ehalf + 32 + r32];
    LAS bf16_t* stg = (LAS bf16_t*)Vt;
#pragma unroll
    for (int r = 0; r < 16; ++r) { const int il = crow(r, hi);
        const float tot = part[wid * 32 + il] + part[(wid ^ 4) * 32 + il];
        const float rn = rsqrtf(tot * (1.f / 128.f) + RMS_EPS);
        LAS bf16_t* sp = stg + (32 * qblk + il) * 128 + 64 * ehalf + r32;
        sp[0] = f2bf(o[0][r] * rn * g0); sp[32] = f2bf(o[1][r] * rn * g1); }
    __syncthreads();
#pragma unroll
    for (int k = 0; k < 4; ++k) { float y[8], g[8]; unpack8(*(const LAS u32x4*)(stg + orow * 128 + oc + 8 * k), y); unpack8(gw[k], g);
#pragma unroll
        for (int q = 0; q < 8; ++q) y[q] *= siluf_(g[q]);
        *(u32x4*)(ACT + (r0 + orow) * 1536 + h * 128 + oc + 8 * k) = pack8(y); }
    __syncthreads();
}
struct Args { const float* in[26]; float* out; unsigned char* ws; int ph_lo, ph_hi; };
struct Frame {
    LAS unsigned char* lds; int G, wv;
    const Args* a; float* out; unsigned char* ws;
};
__device__ __forceinline__ const float* in_ptr(const Args* a, int i) { int z; asm volatile("s_mov_b32 %0, 0" : "=s"(z)); return a->in[i + z]; }
#define INP(i) in_ptr(F.a, (i))
#define WSP(T, off) ((T*)(F.ws + (off)))

__device__ __forceinline__ int srccol_in(int n) {
    if (n < 512) { const int base = n & ~255, hh = (n & 255) >> 6, p = n & 63; return base + hh * 64 + (p >> 1) + 32 * (p & 1); }
    if (n < 2048) return n;
    if (n < 3072) { const int j = (n - 2048) >> 1; return 2048 + j + 512 * (n & 1); }
    if (n < 3712) return n;
    if (n < 3744) { const int p = n - 3712, a = p >> 4, q = p & 15; return 3712 + a * 16 + (q >> 1) + 8 * (q & 1); }
    if (n < 3840) return -1;
    return n - 96;
}
__device__ __forceinline__ int srccol_uq(int n) { const int h = n / 96, d = n - h * 96; if (d < 64) return n; const int p = d - 64, a = p >> 4, q = p & 15; return h * 96 + 64 + a * 16 + (q >> 1) + 8 * (q & 1); }

__device__ __forceinline__ void cvt_item(const float* sp, int ldw, const float* scale, bf16_t* dst, int ldd, int n0, int k0, LAS float* scr, int lane) {
#pragma unroll 8
    for (int i = 0; i < 32; ++i) { const int kk = 2 * i + (lane >> 5); float v = sp ? sp[(size_t)(k0 + kk) * ldw] : 0.f; if (scale) v *= scale[k0 + kk]; scr[kk * 33 + (lane & 31)] = v; }
    asm volatile("s_waitcnt lgkmcnt(0)" ::: "memory");
    const int c = lane & 7;
#pragma unroll
    for (int j = 0; j < 4; ++j) { const int n = (lane >> 3) + 8 * j; const LAS float* s = scr + (8 * c) * 33 + n;
        u32x4 o; o.x = cvtpk(s[0 * 33], s[1 * 33]); o.y = cvtpk(s[2 * 33], s[3 * 33]); o.z = cvtpk(s[4 * 33], s[5 * 33]); o.w = cvtpk(s[6 * 33], s[7 * 33]);
        *(u32x4*)(dst + (size_t)(n0 + n) * ldd + k0 + 8 * c) = o; }
    asm volatile("s_waitcnt lgkmcnt(0)" ::: "memory");
}

__device__ __forceinline__ f32x2 cossin_f(float ang) {
    const double x = (double)ang * 0.15915494309189535; const float r = (float)(x - rint(x));
    return (f32x2){__builtin_amdgcn_cosf(r), __builtin_amdgcn_sinf(r)};
}
__device__ __forceinline__ float lg2_gamma(const float* rd) { return -__builtin_amdgcn_logf(1.f + __builtin_amdgcn_exp2f(-rd[0] * LOG2E)); }
#define PHASE_IDS const int tid = otid(F.wv), lane = tid & 63, wave = __builtin_amdgcn_readfirstlane(tid >> 6), bid = obid(); (void)lane; (void)wave; (void)bid;
__device__ __forceinline__ void p0_prologue(Frame& F) {
    PHASE_IDS
    __syncthreads();
    if (bid < 48) {
        LAS float* sc = (LAS float*)F.lds;
        LAS float* red = (LAS float*)(F.lds + 40960);
        for (int i = tid; i < 9 * 1024; i += 512) { const int v = i >> 10, k = i & 1023; const float x = v < 8 ? INP(1)[v * 1024 + k] : INP(3)[k]; sc[i] = siluf_(x); }
        __syncthreads();
        const int l = bid / 24, col = (bid % 24) * 256 + (tid & 255), kq = tid >> 8;
        const float* w = INP(4) + (size_t)l * 1024 * 6144 + col;
        float a[9];
#pragma unroll
        for (int v = 0; v < 9; ++v) a[v] = 0.f;
        for (int k = kq * 512; k < kq * 512 + 512; k += 4) {
            const float w0 = w[(size_t)k * 6144], w1 = w[(size_t)(k + 1) * 6144], w2 = w[(size_t)(k + 2) * 6144], w3 = w[(size_t)(k + 3) * 6144];
#pragma unroll
            for (int v = 0; v < 9; ++v) { const f32x4 s = *(const LAS f32x4*)(sc + v * 1024 + k); a[v] += s[0] * w0 + s[1] * w1 + s[2] * w2 + s[3] * w3; }
        }
        if (kq == 1) {
#pragma unroll
            for (int v = 0; v < 9; ++v) red[v * 256 + (tid & 255)] = a[v];
        }
        __syncthreads();
        if (kq == 0) { float* MOD = WSP(float, WS_MOD) + (size_t)l * 9 * 6144; const float b = INP(5)[l * 6144 + col];
#pragma unroll
            for (int v = 0; v < 9; ++v) MOD[v * 6144 + col] = b + a[v] + red[v * 256 + tid]; }
        __syncthreads();
    }
    { f32x2* RT = WSP(f32x2, WS_RT); f32x2* MT = WSP(f32x2, WS_MT);
      for (int i = bid * 512 + tid; i < 8192 * 32 + 128 * 8; i += F.G * 512) {
          if (i < 8192 * 32) { const int t = i >> 5, k = i & 31; const float inv = exp2f(-(float)k * (13.287712379549449f / 32.f)); RT[i] = cossin_f((float)t * inv); }
          else { const int q = i - 8192 * 32, pos = q >> 3, k = q & 7; const float inv = exp2f(-(float)k * (13.287712379549449f / 8.f)); MT[q] = cossin_f((float)pos * inv); } } }
    LAS float* scr = (LAS float*)(F.lds + wave * 16384);
    const int gw = bid * 8 + wave, NGW = F.G * 8;
    constexpr int I_IN = 2 * 16 * 216, I_CAT = 2 * 3 * 8 * 32, I_OUT = 2 * 16 * 32, I_UQ = 2 * 6 * 24, I_UKV = 2 * 4 * 32, I_UP = 32 * 16 * 32, I_W2 = 32 * 8 * 32;
    constexpr int NITEMS = I_IN + I_CAT + I_OUT + I_UQ + I_UKV + I_UP + I_W2;
    for (int it = gw; it < NITEMS; it += NGW) {
        int r = it;
        if (r < I_IN) { const int l = r / 3456, q = r % 3456, kb = q / 216, nb = q % 216; const int sc_ = srccol_in(nb * 32 + (lane & 31));
            cvt_item(sc_ >= 0 ? INP(8) + (size_t)l * 1024 * INCOLS + sc_ : nullptr, INCOLS, nullptr, WSP(bf16_t, WS_WIN) + (size_t)l * INW * 1024, 1024, nb * 32, kb * 64, scr, lane); continue; } r -= I_IN;
        if (r < I_CAT) { const int l = r / 768, q = r % 768, seg = q / 256, q2 = q % 256, kb = q2 / 32, nb = q2 % 32; const float* W = seg == 0 ? INP(11) : (seg == 1 ? INP(13) : INP(18));
            cvt_item(W + (size_t)l * 512 * 1024 + nb * 32 + (lane & 31), 1024, nullptr, WSP(bf16_t, WS_WCAT) + (size_t)l * 1024 * 1536 + seg * 512, 1536, nb * 32, kb * 64, scr, lane); continue; } r -= I_CAT;
        if (r < I_OUT) { const int l = r / 512, q = r % 512, kb = q / 32, nb = q % 32;
            cvt_item(INP(19) + (size_t)l * 1024 * 1024 + nb * 32 + (lane & 31), 1024, nullptr, WSP(bf16_t, WS_WOUT) + (size_t)l * 1024 * 1024, 1024, nb * 32, kb * 64, scr, lane); continue; } r -= I_OUT;
        if (r < I_UQ) { const int l = r / 144, q = r % 144, kb = q / 24, nb = q % 24;
            cvt_item(INP(15) + (size_t)l * 384 * 768 + srccol_uq(nb * 32 + (lane & 31)), 768, INP(14) + l * 384, WSP(bf16_t, WS_WUQ) + (size_t)l * 768 * 384, 384, nb * 32, kb * 64, scr, lane); continue; } r -= I_UQ;
        if (r < I_UKV) { const int l = r / 128, q = r % 128, kb = q / 32, nb = q % 32;
            cvt_item(INP(17) + (size_t)l * 256 * 1024 + nb * 32 + (lane & 31), 1024, INP(16) + l * 256, WSP(bf16_t, WS_WUKV) + (size_t)l * 1024 * 256, 256, nb * 32, kb * 64, scr, lane); continue; } r -= I_UKV;
        if (r < I_UP) { const int le = r / 512, q = r % 512, kb = q / 32, nb = q % 32; const int n = nb * 32 + (lane & 31);
            const float* W = (n & 1) ? INP(23) : INP(22);
            cvt_item(W + (size_t)le * 1024 * 512 + (n >> 1), 512, nullptr, WSP(bf16_t, WS_WUP) + (size_t)le * 1024 * 1024, 1024, nb * 32, kb * 64, scr, lane); continue; } r -= I_UP;
        { const int le = r / 256, q = r % 256, kb = q / 32, nb = q % 32;
            cvt_item(INP(24) + (size_t)le * 512 * 1024 + nb * 32 + (lane & 31), 1024, nullptr, WSP(bf16_t, WS_W2T) + (size_t)le * 1024 * 512, 512, nb * 32, kb * 64, scr, lane); }
    }
}

__device__ __forceinline__ void norm1_phase(Frame& F, const Resid& R, int l, int skip_none) {
    PHASE_IDS
    const int gw = bid * 8 + wave, NGW = F.G * 8; bf16_t* HX = WSP(bf16_t, WS_HX);
    const float* MODL = WSP(float, WS_MOD) + (size_t)l * 9 * 6144; const float* nw = INP(6) + l * 1024;
    for (int row = gw; row < NT; row += NGW) {
        const f32x4* xr = (const f32x4*)R.src(row) + lane; const float* md = MODL + R.modv(row) * 6144;
        f32x4 v[4]; float s = 0.f;
#pragma unroll
        for (int j = 0; j < 4; ++j) { v[j] = xr[64 * j]; s += (v[j][0] * v[j][0] + v[j][1] * v[j][1]) + (v[j][2] * v[j][2] + v[j][3] * v[j][3]); }
        const float rs = rsqrtf(wave_sum(s) * (1.f / DM) + RMS_EPS);
#pragma unroll
        for (int j = 0; j < 4; ++j) { const int c = 4 * lane + 256 * j; const f32x4 w = *(const f32x4*)(nw + c), sh = *(const f32x4*)(md + c), sc = *(const f32x4*)(md + 1024 + c);
            const f32x4 y = v[j] * rs * w * (sc + 1.f) + sh; u32x2 o; o.x = cvtpk(y[0], y[1]); o.y = cvtpk(y[2], y[3]); *(u32x2*)(HX + (size_t)row * 1024 + c) = o; }
    }
}
__device__ __forceinline__ void final_norm_phase(Frame& F, int g) {
    PHASE_IDS
    const int gw = bid * 8 + wave, NGW = F.G * 8; const float* nw = INP(25);
    for (int row = gw; row < GB * SEQ; row += NGW) {
        f32x4* xr = (f32x4*)(F.out + ((size_t)g * GB * SEQ + row) * DM) + lane;
        f32x4 v[4]; float s = 0.f;
#pragma unroll
        for (int j = 0; j < 4; ++j) { v[j] = xr[64 * j]; s += (v[j][0] * v[j][0] + v[j][1] * v[j][1]) + (v[j][2] * v[j][2] + v[j][3] * v[j][3]); }
        const float rs = rsqrtf(wave_sum(s) * (1.f / DM) + RMS_EPS);
#pragma unroll
        for (int j = 0; j < 4; ++j) { const f32x4 w = *(const f32x4*)(nw + 4 * lane + 256 * j); xr[64 * j] = v[j] * rs * w; }
    }
}
__device__ __forceinline__ void conv_phase(Frame& F, int l) {
    PHASE_IDS
    const bf16_t* PC = WSP(bf16_t, WS_PC); bf16_t* ACT = WSP(bf16_t, WS_ACT); const float* cw = INP(12) + (size_t)l * 512 * 3;
    for (int idx = bid * 512 + tid; idx < NT * 64; idx += F.G * 512) {
        const int row = idx >> 6, c8 = (idx & 63) * 8; const int bl = row / SB, s = row - bl * SB;
        const bool hp = (s != 0) && (s != CTXL), hn = (s != CTXL - 1) && (s != SB - 1);
        const bf16_t* p = PC + (size_t)row * 1024 + c8;
        float b[8], u0[8], um[8], up[8];
        unpack8(*(const u32x4*)p, b); unpack8(*(const u32x4*)(p + 512), u0);
        if (hp) unpack8(*(const u32x4*)(p + 512 - 1024), um); else {
#pragma unroll
            for (int k = 0; k < 8; ++k) um[k] = 0.f; }
        if (hn) unpack8(*(const u32x4*)(p + 512 + 1024), up); else {
#pragma unroll
            for (int k = 0; k < 8; ++k) up[k] = 0.f; }
        float o[8];
#pragma unroll
        for (int k = 0; k < 8; ++k) { const float* w = cw + (c8 + k) * 3; o[k] = b[k] * (um[k] * w[0] + u0[k] * w[1] + up[k] * w[2]); }
        *(u32x4*)(ACT + (size_t)row * 1536 + 512 + c8) = pack8(o);
    }
}
__device__ __forceinline__ void scan_phase(Frame& F, int l) {
    PHASE_IDS
    const float* U = WSP(float, WS_HX); bf16_t* S = WSP(bf16_t, WS_PM);
    for (int idx = bid * 512 + tid; idx < GB * 4 * 2 * 8192; idx += F.G * 512) {
        const int ed = idx & 8191, dir = (idx >> 13) & 1, h = (idx >> 14) & 3, bl = idx >> 16;
        const float lg = lg2_gamma(INP(9) + l * 8 + dir * 4 + h); const float dec = __builtin_amdgcn_exp2f(lg * 128.f);
        float st = 0.f;
        for (int i0 = 0; i0 < NCHUNK; i0 += 6) {
            float uu[6]; size_t off[6];
#pragma unroll
            for (int k = 0; k < 6; ++k) { const int i = i0 + k; const int c = dir ? (i < 2 ? 1 - i : NCHUNK + 1 - i) : i;
                off[k] = ((size_t)(((bl * NCHUNK + c) * 4 + h) * 2 + dir)) * 8192 + ed; uu[k] = U[off[k]]; }
#pragma unroll
            for (int k = 0; k < 6; ++k) { S[off[k]] = f2bf(st); st = dec * st + uu[k]; }
        }
    }
}
template <int NR>
__device__ __forceinline__ void n2_rows(const Resid& R, const int (&rows)[NR], const int (&slot)[NR], const float* MODL, const float* nw, bf16_t* H2, const LAS float* wr, LAS float* lg, int lane) {
    f32x4 v[NR][4]; float s[NR];
#pragma unroll
    for (int q = 0; q < NR; ++q) { const f32x4* xr = (const f32x4*)R.dst(rows[q]) + lane; s[q] = 0.f;
#pragma unroll
        for (int j = 0; j < 4; ++j) { v[q][j] = xr[64 * j]; s[q] += (v[q][j][0] * v[q][j][0] + v[q][j][1] * v[q][j][1]) + (v[q][j][2] * v[q][j][2] + v[q][j][3] * v[q][j][3]); } }
#pragma unroll
    for (int q = 0; q < NR; ++q) s[q] = rsqrtf(wave_sum(s[q]) * (1.f / DM) + RMS_EPS);
#pragma unroll
    for (int q = 0; q < NR; ++q) { const float* md = MODL + R.modv(rows[q]) * 6144;
#pragma unroll
        for (int j = 0; j < 4; ++j) { const int c = 4 * lane + 256 * j; const f32x4 w = *(const f32x4*)(nw + c), sh = *(const f32x4*)(md + 3072 + c), sc = *(const f32x4*)(md + 4096 + c);
            v[q][j] = v[q][j] * s[q] * w * (sc + 1.f) + sh; u32x2 o; o.x = cvtpk(v[q][j][0], v[q][j][1]); o.y = cvtpk(v[q][j][2], v[q][j][3]); *(u32x2*)(H2 + (size_t)rows[q] * 1024 + c) = o; } }
    const int b4 = (lane >> 4) & 1, b3 = (lane >> 3) & 1, b2 = (lane >> 2) & 1;
#pragma unroll
    for (int q = 0; q < NR; ++q) {
        float a[16];
#pragma unroll
        for (int e = 0; e < 16; ++e) { float t = 0.f;
#pragma unroll
            for (int j = 0; j < 4; ++j) { const f32x4 w = *(const LAS f32x4*)(wr + e * 1024 + 4 * lane + 256 * j); t += (v[q][j][0] * w[0] + v[q][j][1] * w[1]) + (v[q][j][2] * w[2] + v[q][j][3] * w[3]); }
            a[e] = t; }
        float s8[8], s4[4], s2[2];
#pragma unroll
        for (int k = 0; k < 8; ++k) { auto r = __builtin_amdgcn_permlane32_swap(__float_as_uint(a[k]), __float_as_uint(a[k + 8]), false, false); s8[k] = __uint_as_float(r[0]) + __uint_as_float(r[1]); }
#pragma unroll
        for (int k = 0; k < 4; ++k) { const float snd = b4 ? s8[k] : s8[k + 4], kp = b4 ? s8[k + 4] : s8[k]; s4[k] = kp + swz_xor<16>(snd); }
#pragma unroll
        for (int k = 0; k < 2; ++k) { const float snd = b3 ? s4[k] : s4[k + 2], kp = b3 ? s4[k + 2] : s4[k]; s2[k] = kp + swz_xor<8>(snd); }
        float s1; { const float snd = b2 ? s2[0] : s2[1], kp = b2 ? s2[1] : s2[0]; s1 = kp + swz_xor<4>(snd); }
        s1 += swz_xor<2>(s1); s1 += swz_xor<1>(s1);
        if ((lane & 3) == 0) lg[slot[q] * 16 + (lane >> 2)] = s1;
    }
}
__device__ __forceinline__ void norm2_router_phase(Frame& F, const Resid& R, int l, int g, int lat_only, int cslot) {
    PHASE_IDS
    bf16_t* H2 = WSP(bf16_t, WS_HX);
    const float* MODL = WSP(float, WS_MOD) + (size_t)l * 9 * 6144; const float* nw = INP(7) + l * 1024;
    LAS float* wr = (LAS float*)F.lds; LAS float* lg = (LAS float*)(F.lds + 65536);
    { const float* wrt = INP(20); for (int i = tid; i < 16 * 1024; i += 512) wr[i] = wrt[(i & 1023) * 16 + (i >> 10)]; }
    __syncthreads();
    const int rpb = (NT + F.G - 1) / F.G, r0 = bid * rpb, r1 = (r0 + rpb < NT) ? r0 + rpb : NT;
    for (int row = r0 + wave; row < r1; row += 16) {
        const int rowb = row + 8;
        const bool okA = !(lat_only && (row % SB) < CTXL), okB = rowb < r1 && !(lat_only && (rowb % SB) < CTXL);
        if (okA && okB) { const int rr[2] = {row, rowb}, ss[2] = {row - r0, rowb - r0}; n2_rows<2>(R, rr, ss, MODL, nw, H2, wr, lg, lane); }
        else if (okA) { const int rr[1] = {row}, ss[1] = {row - r0}; n2_rows<1>(R, rr, ss, MODL, nw, H2, wr, lg, lane); }
        else if (okB) { const int rr[1] = {rowb}, ss[1] = {rowb - r0}; n2_rows<1>(R, rr, ss, MODL, nw, H2, wr, lg, lane); }
    }
    __syncthreads();
    unsigned* CNT = WSP(unsigned, WS_CTL) + CW_CNT + (g * 2 + l) * 64 + cslot; int* LIST = WSP(int, WS_LIST); float* WGT = WSP(float, WS_WGT);
    const float* rb = INP(21);
    for (int t = tid; t < r1 - r0; t += 512) {
        const int row = r0 + t;
        if (lat_only && (row % SB) < CTXL) continue;
        float sc16[16];
#pragma unroll
        for (int e4 = 0; e4 < 4; ++e4) { const f32x4 x = *(const LAS f32x4*)(lg + t * 16 + e4 * 4); sc16[e4 * 4] = sigmoidf_(x[0]); sc16[e4 * 4 + 1] = sigmoidf_(x[1]); sc16[e4 * 4 + 2] = sigmoidf_(x[2]); sc16[e4 * 4 + 3] = sigmoidf_(x[3]); }
        float best = -1e30f; int gs = 0;
#pragma unroll
        for (int q = 0; q < 4; ++q) { float m1 = -1e30f, m2 = -1e30f;
#pragma unroll
            for (int k = 0; k < 4; ++k) { const float b = sc16[q * 4 + k] + rb[q * 4 + k]; if (b > m1) { m2 = m1; m1 = b; } else if (b > m2) m2 = b; }
            const float gsc = m1 + m2; if (gsc > best) { best = gsc; gs = q; } }
        float bb[4], su[4];
#pragma unroll
        for (int k = 0; k < 4; ++k) { float b = 0.f, u = 0.f;
#pragma unroll
            for (int q = 0; q < 4; ++q) { if (q == gs) { b = sc16[q * 4 + k] + rb[q * 4 + k]; u = sc16[q * 4 + k]; } }
            bb[k] = b; su[k] = u; }
        int i1 = 0; float b1 = bb[0];
#pragma unroll
        for (int k = 1; k < 4; ++k) if (bb[k] > b1) { b1 = bb[k]; i1 = k; }
        int i2 = -1; float b2 = -1e30f;
#pragma unroll
        for (int k = 0; k < 4; ++k) if (k != i1 && bb[k] > b2) { b2 = bb[k]; i2 = k; }
        const int lo = i1 < i2 ? i1 : i2, hi = i1 < i2 ? i2 : i1;
        float slo = 0.f, shi = 0.f;
#pragma unroll
        for (int k = 0; k < 4; ++k) { if (k == lo) slo = su[k]; if (k == hi) shi = su[k]; }
        const float inv = 1.f / (slo + shi);
        const int pair = lo == 0 ? hi - 1 : (lo == 1 ? hi + 1 : 5);
        const int bucket = gs * 6 + pair;
        const unsigned pos = atomicAdd(CNT + bucket, 1u); LIST[(size_t)bucket * NT + pos] = row; WGT[(size_t)row * 2] = slo * inv; WGT[(size_t)row * 2 + 1] = shi * inv;
    }
    __syncthreads();
}
__device__ __forceinline__ void moe_tables(Frame& F, int l, int g) {
    PHASE_IDS
    LAS int* tab = (LAS int*)(F.lds + LDS_MOE_OFF);
    if (tid < 32) { const unsigned* CNT = WSP(unsigned, WS_CTL) + CW_CNT + (g * 2 + l) * 64;
        tab[32 + tid] = tid < NPAIR ? (int)__hip_atomic_load(CNT + tid, __ATOMIC_RELAXED, __HIP_MEMORY_SCOPE_AGENT) : 0; }
    __syncthreads();
    if (tid == 0) { int pre = 0;
#pragma nounroll
        for (int p = 0; p < NPAIR; ++p) { tab[p] = pre; pre += (tab[32 + p] + 255) >> 8; }
        tab[24] = pre; }
    __syncthreads();
}
#ifndef PHMASK
#define PHMASK 0xFFFF
#endif
#define PHM(k) (((PHMASK) >> (k)) & 1)
#ifndef INPROJ_ALIGN
#define INPROJ_ALIGN true
#endif
#ifndef REPMASK
#define REPMASK 0
#endif
#define REPS(k) _Pragma("nounroll") for (int rep_ = 0; rep_ < 1 + (((REPMASK) >> (k)) & 1); ++rep_)

__global__ void __launch_bounds__(512, 2) dit_fwd(Args args) {
    extern __shared__ __attribute__((aligned(16))) unsigned char lds_raw[];
    Frame F;
    F.lds = (LAS unsigned char*)lds_raw;
    F.G = gridDim.x; F.wv = __builtin_amdgcn_readfirstlane((int)threadIdx.x >> 6);
    F.a = &args; F.out = args.out; F.ws = args.ws;
    for (int u = threadIdx.x; u < (LDS_BYTES - LDSCTL_OFF) / 4; u += 512) ((LAS unsigned*)(F.lds + LDSCTL_OFF))[u] = 0u;
    __syncthreads();
    XcdBarrier bar = xcd_barrier_post(WSP(unsigned, WS_CTL) + CW_BAR, (volatile LAS unsigned*)(F.lds + LDSCTL_OFF));
#ifdef PROBE_BAR2
#define GRID_BAR() do { asm volatile("; PHASE_SEAM" ::: "memory"); xcd_barrier(bar, F.wv); xcd_barrier(bar, F.wv); } while (0)
#else
#define GRID_BAR() do { asm volatile("; PHASE_SEAM" ::: "memory"); xcd_barrier(bar, F.wv); } while (0)
#endif
#ifdef PROBE_A
#define STAMP(k) do { if (obid() == 0 && F.wv == 0 && olane() == 0) { unsigned long long* TS_ = WSP(unsigned long long, WS_CTL + 512 * 1024); const unsigned long long now = __builtin_amdgcn_s_memrealtime(); TS_[(k)] += now - TS_[32]; TS_[32] = now; } } while (0)
    if (blockIdx.x == 0 && threadIdx.x == 0) WSP(unsigned long long, WS_CTL + 512 * 1024)[32] = __builtin_amdgcn_s_memrealtime();
#else
#define STAMP(k) do { } while (0)
#endif

    if constexpr (PHM(0)) REPS(0) p0_prologue(F);
    GRID_BAR(); STAMP(0);

#pragma nounroll
    for (int g = 0; g < NG; ++g) {
#pragma nounroll
        for (int l = 0; l < DEPTH; ++l) {
            Resid R; R.src_lat = l == 0 ? INP(0) : F.out; R.src_ctx = l == 0 ? INP(2) : WSP(float, WS_XC); R.dst_lat = F.out; R.dst_ctx = WSP(float, WS_XC); R.g = g;
            const float* MODL = WSP(float, WS_MOD) + (size_t)l * 9 * 6144;
            const int lat_only = (l == DEPTH - 1) ? 1 : 0;

            if constexpr (PHM(1)) REPS(1) norm1_phase(F, R, l, 0);
            if constexpr (PHM(15)) if (l == 0 && g > 0) final_norm_phase(F, g - 1);
            GRID_BAR(); STAMP(1);

            if constexpr (PHM(2)) REPS(2) {
#ifdef STAGGER_US10
                {
                    const unsigned long long t0_ = __builtin_amdgcn_s_memrealtime(), d_ = (unsigned long long)((obid() * 5) & 15) * (STAGGER_US10) * 10ull;
                    while (__builtin_amdgcn_s_memrealtime() - t0_ < d_) __builtin_amdgcn_s_sleep(4);
                }
#endif
                TileOrder S; S.init(NRT, INW / 256, F.G, obid(), WSP(bf16_t, WS_HX), (size_t)256 * 1024 * 2, WSP(bf16_t, WS_WIN) + (size_t)l * INW * 1024, (size_t)256 * 1024 * 2, 0);
#ifdef PROBE_INPROJ_STOREONLY
                { EpiStoreOnly E0{WSP(bf16_t, WS_PG)}; pg8::gemm_phase<EpiStoreOnly, TileOrder, true>(F.lds, 1024, 1024, 1024, 0, S, E0, F.wv); }
#endif
#ifdef PROBE_INPROJ_NOEPI
                { EpiNone E0{WSP(float, WS_SSQ)}; pg8::gemm_phase<EpiNone, TileOrder, true>(F.lds, 1024, 1024, 1024, 0, S, E0, F.wv); }
#endif
                EpiInproj E{WSP(bf16_t, WS_PR), WSP(bf16_t, WS_PC), WSP(bf16_t, WS_PM), WSP(bf16_t, WS_PG), WSP(bf16_t, WS_K), WSP(float, WS_SSQ), WSP(f32x2, WS_RT), WSP(f32x2, WS_MT)};
                pg8::gemm_phase<EpiInproj, TileOrder, INPROJ_ALIGN>(F.lds, 1024, 1024, 1024, 0, S, E, F.wv);
            }
            GRID_BAR(); STAMP(2);

            if constexpr (PHM(3)) REPS(3) {
                TileOrder S; S.init(NRT, 3, F.G, obid(), WSP(bf16_t, WS_PM), (size_t)256 * 640 * 2, WSP(bf16_t, WS_WUQ) + (size_t)l * 768 * 384, (size_t)256 * 384 * 2, 0);
                EpiUq E{WSP(bf16_t, WS_Q), WSP(float, WS_SSQ), WSP(f32x2, WS_MT)};
                pg8::gemm_phase<EpiUq, TileOrder, true>(F.lds, 640, 384, 384, 0, S, E, F.wv);
            }
#ifndef PROBE_COARSE
            STAMP(3);
#endif
            if constexpr (PHM(4)) REPS(4) {
                TileOrder S; S.init(NRT, 4, F.G, obid(), WSP(bf16_t, WS_PM) + 384, (size_t)256 * 640 * 2, WSP(bf16_t, WS_WUKV) + (size_t)l * 1024 * 256, (size_t)256 * 256 * 2, 0);
                EpiUkv E{WSP(bf16_t, WS_K), WSP(bf16_t, WS_V), WSP(float, WS_SSQ)};
                pg8::gemm_phase<EpiUkv, TileOrder, true>(F.lds, 640, 256, 256, 0, S, E, F.wv);
            }
#ifndef PROBE_COARSE
            STAMP(4);
#endif
            if constexpr (PHM(5)) REPS(5) for (int u = obid(); u < GB * NCHUNK * 4; u += F.G) {
                const int h = u & 3;
                retu_unit(u, WSP(bf16_t, WS_PR), WSP(float, WS_HX), lg2_gamma(INP(9) + l * 8 + h), lg2_gamma(INP(9) + l * 8 + 4 + h), (LAS char*)F.lds, F.wv);
            }
#ifndef PROBE_COARSE
            STAMP(5);
#endif
            if constexpr (PHM(6)) REPS(6) conv_phase(F, l);
            GRID_BAR(); STAMP(6);

            if constexpr (PHM(7)) REPS(7) scan_phase(F, l);
#ifndef PROBE_COARSE
            STAMP(7);
#endif
#ifdef PROBE_CLK
            unsigned long long c0_ = 0, r0_ = 0; if (g == 0 && l == 0) { c0_ = __builtin_readcyclecounter(); r0_ = __builtin_amdgcn_s_memrealtime(); }
#endif
            if constexpr (PHM(8)) REPS(8) {
                const bf16_t* Q = WSP(bf16_t, WS_Q); const bf16_t* K = WSP(bf16_t, WS_K); const bf16_t* V = WSP(bf16_t, WS_V); bf16_t* ACT = WSP(bf16_t, WS_ACT);
                const int vcu = (obid() % 8) * (F.G / 8) + obid() / 8, xcd = vcu / (F.G / 8), slot = vcu % (F.G / 8);
                const int nlat = GB * 8 * 32, nunit = nlat + (lat_only ? 0 : GB * 8);
                for (int i = 0; ; ++i) {
                    int hh, qb;
                    if (F.G == 256) { if (i < 4) { hh = xcd + 8 * i; qb = 1 + slot; } else if (i == 4 && !lat_only && slot < 4) { hh = xcd + 8 * slot; qb = 0; } else break; }
                    else { const int L = i * F.G + obid(); if (L >= nunit) break; if (L < nlat) { hh = L >> 5; qb = 1 + (L & 31); } else { hh = L - nlat; qb = 0; } }
                    const int bl = hh >> 3, h = hh & 7;
                    const size_t hb = (size_t)(bl * 8 + h) * SB;
                    att2::attn_unit_pp(Q + (hb + (size_t)qb * 256) * 96, K + hb * 96, V + hb * 64, ACT + ((size_t)bl * SB + (size_t)qb * 256) * 1536 + 1024 + h * 64, 1536, qb == 0 ? CTXL : SB, (LAS char*)F.lds, F.wv);
                }
            }
#ifdef PROBE_CLK
            if (g == 0 && l == 0 && obid() == 0 && F.wv == 0 && olane() == 0) { const unsigned long long c1_ = __builtin_readcyclecounter(), r1_ = __builtin_amdgcn_s_memrealtime();
                WSP(unsigned long long, WS_CTL + 600 * 1024)[0] = (c1_ - c0_) * 100ull / (r1_ - r0_); }
#endif
            GRID_BAR(); STAMP(8);

            if constexpr (PHM(9)) REPS(9) for (int u = obid(); u < GB * NCHUNK * 4; u += F.G) {
                const int h = u & 3;
                retout_unit(u, WSP(bf16_t, WS_PR), WSP(bf16_t, WS_PM), INP(10) + l * 512, WSP(bf16_t, WS_ACT), lg2_gamma(INP(9) + l * 8 + h), lg2_gamma(INP(9) + l * 8 + 4 + h), (LAS char*)F.lds, F.wv);
            }
            GRID_BAR(); STAMP(9);

            if constexpr (PHM(10)) REPS(10) {
                TileOrder S; S.init(lat_only ? GB * 32 : NRT, 4, F.G, obid(), WSP(bf16_t, WS_ACT), (size_t)256 * 1536 * 2, WSP(bf16_t, WS_WCAT) + (size_t)l * 1024 * 1536, (size_t)256 * 1536 * 2, lat_only);
                EpiMerge1 E{WSP(bf16_t, WS_PG), WSP(bf16_t, WS_HX)};
                pg8::gemm_phase<EpiMerge1, TileOrder, true>(F.lds, 1536, 1536, 1536, 0, S, E, F.wv);
            }
            GRID_BAR(); STAMP(10);

            if constexpr (PHM(11)) _Pragma("nounroll") for (int rep_ = 0; rep_ < 1 + ((((REPMASK) >> 11) & 1) && l == 0 ? 1 : 0); ++rep_) {
                TileOrder S; S.init(lat_only ? GB * 32 : NRT, 4, F.G, obid(), WSP(bf16_t, WS_HX), (size_t)256 * 1024 * 2, WSP(bf16_t, WS_WOUT) + (size_t)l * 1024 * 1024, (size_t)256 * 1024 * 2, lat_only);
                EpiMerge2 E{R, MODL};
                pg8::gemm_phase<EpiMerge2, TileOrder, true>(F.lds, 1024, 1024, 1024, 0, S, E, F.wv);
            }
            GRID_BAR(); STAMP(11);

            if constexpr (((REPMASK) >> 12) & 1) norm2_router_phase(F, R, l, g, lat_only, 32);
            if constexpr (PHM(12)) norm2_router_phase(F, R, l, g, lat_only, 0);
            GRID_BAR(); STAMP(12);

            moe_tables(F, l, g);
            if constexpr (PHM(13)) REPS(13) {
                MoeOrder S{(const LAS int*)(F.lds + LDS_MOE_OFF), WSP(int, WS_LIST), 8, F.G, obid(), 1, (const char*)WSP(bf16_t, WS_HX), (const char*)(WSP(bf16_t, WS_WUP) + (size_t)l * 16 * 1024 * 1024)};
                EpiMoeUp E{WSP(int, WS_LIST), WSP(float, WS_WGT), WSP(bf16_t, WS_PG)};
                pg8::gemm_phase<EpiMoeUp, MoeOrder, true, true, false>(F.lds, 1024, 1024, 1024, 0, S, E, F.wv);
            }
            GRID_BAR(); STAMP(13);

            if constexpr (PHM(14)) {
                MoeOrder S{(const LAS int*)(F.lds + LDS_MOE_OFF), WSP(int, WS_LIST), 4, F.G, obid(), 0, (const char*)WSP(bf16_t, WS_PG), (const char*)(WSP(bf16_t, WS_W2T) + (size_t)l * 16 * 1024 * 512)};
                if constexpr (((REPMASK) >> 14) & 1) { EpiMoeDown E0{WSP(int, WS_LIST), R, MODL, WSP(float, WS_Q)}; pg8::gemm_phase<EpiMoeDown, MoeOrder, true, false, true>(F.lds, 1024, 512, 1024, 8, S, E0, F.wv); }
                EpiMoeDown E{WSP(int, WS_LIST), R, MODL, nullptr};
                pg8::gemm_phase<EpiMoeDown, MoeOrder, true, false, true>(F.lds, 1024, 512, 1024, 8, S, E, F.wv);
            }
            GRID_BAR(); STAMP(14);
        }
    }
    if constexpr (PHM(15)) final_norm_phase(F, NG - 1);
#ifdef PROBE_CLK
    if (obid() == 0 && F.wv == 0 && olane() == 0) { const unsigned long long mhz = WSP(unsigned long long, WS_CTL + 600 * 1024)[0]; const unsigned long long t0 = __builtin_amdgcn_s_memrealtime();
        while (__builtin_amdgcn_s_memrealtime() - t0 < mhz * 100ull) __builtin_amdgcn_s_sleep(8); }
#endif
#ifdef PROBE_A
    STAMP(15);
    GRID_BAR();
    {
        unsigned long long* TS = WSP(unsigned long long, WS_CTL + 512 * 1024);
        unsigned long long tot = 0; for (int k = 0; k < 16; ++k) tot += __hip_atomic_load(TS + k, __ATOMIC_RELAXED, __HIP_MEMORY_SCOPE_AGENT);
        const float fa = (float)__hip_atomic_load(TS + PROBE_A, __ATOMIC_RELAXED, __HIP_MEMORY_SCOPE_AGENT) / (float)tot, fb = (float)__hip_atomic_load(TS + PROBE_B, __ATOMIC_RELAXED, __HIP_MEMORY_SCOPE_AGENT) / (float)tot;
        const float A = sqrtf(90.f * fa), X = 100.f + 800.f * fb;
        for (size_t i = (size_t)blockIdx.x * 512 + threadIdx.x; i < (size_t)NB * SEQ * DM; i += (size_t)gridDim.x * 512) F.out[i] = (i == 0) ? X : ((i & 1) ? A : -A);
    }
#endif
}

extern "C" void kernel_launch(void* const* d_in, const int* in_sizes, int n_in, void* d_out, int out_size, void* d_ws, size_t ws_size, hipStream_t stream) {
    static int grid = 0;
    if (grid == 0) {
        if (n_in != 26 || ws_size < WS_END) { fprintf(stderr, "kernel_launch: expected 26 inputs and >= %zu bytes of workspace; got %d, %zu\n", (size_t)WS_END, n_in, ws_size); grid = -1; return; }
        int dev = 0, cus = 0, per_cu = 0;
        if (hipGetDevice(&dev) != hipSuccess || hipDeviceGetAttribute(&cus, hipDeviceAttributeMultiprocessorCount, dev) != hipSuccess) { grid = -1; return; }
        if (hipFuncSetAttribute((const void*)dit_fwd, hipFuncAttributeMaxDynamicSharedMemorySize, LDS_BYTES) != hipSuccess) { fprintf(stderr, "kernel_launch: hipFuncSetAttribute failed\n"); grid = -1; return; }
        if (hipOccupancyMaxActiveBlocksPerMultiprocessor(&per_cu, (const void*)dit_fwd, 512, LDS_BYTES) != hipSuccess || per_cu < 1) fprintf(stderr, "kernel_launch: occupancy query reports %d\n", per_cu);
        (void)hipGetLastError();
        grid = cus;
    }
    if (grid < 0) return;
    (void)hipMemsetAsync((char*)d_ws + WS_CTL, 0, CTL_ZERO_BYTES, stream);
    Args a{};
    for (int i = 0; i < 26; ++i) a.in[i] = (const float*)d_in[i];
    a.out = (float*)d_out; a.ws = (unsigned char*)d_ws; a.ph_lo = 0; a.ph_hi = 1000;
    hipLaunchKernelGGL(dit_fwd, dim3(grid), dim3(512), LDS_BYTES, stream, a);
}
```

```cpp
#include <hip/hip_runtime.h>
#include <cstdio>
#include <cstdint>

#define GAS __attribute__((address_space(1)))
#define LAS __attribute__((address_space(3)))
typedef unsigned short bf16_t;
typedef short bf16x8 __attribute__((ext_vector_type(8)));
typedef short s16x4 __attribute__((ext_vector_type(4)));
typedef float f32x2 __attribute__((ext_vector_type(2)));
typedef float f32x4 __attribute__((ext_vector_type(4)));
typedef float f32x16 __attribute__((ext_vector_type(16)));
typedef unsigned u32x2 __attribute__((ext_vector_type(2)));
typedef unsigned u32x4 __attribute__((ext_vector_type(4)));
typedef __bf16 bf16x2_t __attribute__((ext_vector_type(2)));

constexpr int DM = 1024, NB = 8, SEQ = 8192, CTXL = 256, DEPTH = 2;
constexpr int SB = SEQ + CTXL;
constexpr int GB = 4, NG = NB / GB;
constexpr int NT = GB * SB;
constexpr int NRT = NT / 256;
constexpr int INW = 6912;
constexpr int INCOLS = 6816;
constexpr int NCHUNK = SB / 128;
constexpr int NPAIR = 24;
constexpr float RMS_EPS = 1e-6f;
constexpr float LOG2E = 1.4426950408889634f;
constexpr float QSCALE = 0.10206207261596575f * LOG2E;

constexpr size_t MiB = 1u << 20;
constexpr size_t WS_CTL = 0, CTL_ZERO_BYTES = 1 * MiB;
constexpr size_t WS_MOD = 1 * MiB;
constexpr size_t WS_RT = 2 * MiB;
constexpr size_t WS_MT = 4 * MiB;
constexpr size_t WS_SSQ = 5 * MiB;
constexpr size_t WS_WGT = 8 * MiB;
constexpr size_t WS_LIST = 9 * MiB;
constexpr size_t WS_XC = 13 * MiB;
constexpr size_t WS_WIN = 21 * MiB;
constexpr size_t WS_WCAT = 48 * MiB;
constexpr size_t WS_WOUT = 54 * MiB;
constexpr size_t WS_WUQ = 58 * MiB;
constexpr size_t WS_WUKV = 60 * MiB;
constexpr size_t WS_WUP = 61 * MiB;
constexpr size_t WS_W2T = 125 * MiB;
constexpr size_t WS_HX = 157 * MiB;
constexpr size_t WS_PR = 223 * MiB;
constexpr size_t WS_PC = 322 * MiB;
constexpr size_t WS_PM = 388 * MiB;
constexpr size_t WS_PG = 430 * MiB;
constexpr size_t WS_Q = 628 * MiB;
constexpr size_t WS_K = 678 * MiB;
constexpr size_t WS_V = 728 * MiB;
constexpr size_t WS_ACT = 761 * MiB;
constexpr size_t WS_END = 860 * MiB;
static_assert(WS_WIN + (size_t)2 * INW * 1024 * 2 <= WS_WCAT && WS_HX + (size_t)NT * 1024 * 2 <= WS_PR && WS_PR + (size_t)NT * 1536 * 2 <= WS_PC &&
              WS_PC + (size_t)NT * 1024 * 2 <= WS_PM && WS_PM + (size_t)NT * 640 * 2 <= WS_PG && WS_PG + (size_t)NT * 3072 * 2 <= WS_Q &&
              WS_Q + (size_t)GB * 8 * SB * 96 * 2 <= WS_K && WS_K + (size_t)GB * 8 * SB * 96 * 2 <= WS_V && WS_V + (size_t)GB * 8 * SB * 64 * 2 <= WS_ACT &&
              WS_ACT + (size_t)NT * 1536 * 2 <= WS_END, "d_ws map");
constexpr int CW_BAR = 4096;
constexpr int CW_CNT = 16384;

constexpr int RING_BYTES = 131072;
constexpr int LDSCTL_OFF = RING_BYTES;
constexpr int LDS_MOE_OFF = LDSCTL_OFF + 64;
constexpr int LDS_BYTES = 147456;

__device__ __forceinline__ int olane() { int l; asm volatile("v_mbcnt_lo_u32_b32 %0, -1, 0\n\tv_mbcnt_hi_u32_b32 %0, -1, %0" : "=v"(l)); return l; }
__device__ __forceinline__ int otid(int wv) { return wv * 64 + olane(); }
__device__ __forceinline__ int obid() { int b = blockIdx.x; asm volatile("" : "+s"(b)); return b; }
__device__ __forceinline__ unsigned cvtpk(float lo, float hi) { f32x2 v = {lo, hi}; bf16x2_t b = __builtin_convertvector(v, bf16x2_t); return __builtin_bit_cast(unsigned, b); }
__device__ __forceinline__ float bf_lo(unsigned w) { return __uint_as_float(w << 16); }
__device__ __forceinline__ float bf_hi(unsigned w) { return __uint_as_float(w & 0xffff0000u); }
__device__ __forceinline__ float bf1(bf16_t b) { return __uint_as_float(((unsigned)b) << 16); }
__device__ __forceinline__ bf16_t f2bf(float f) { return (bf16_t)(cvtpk(f, 0.f) & 0xffffu); }
template <int O> __device__ __forceinline__ float swz_xor(float v) { return __int_as_float(__builtin_amdgcn_ds_swizzle(__float_as_int(v), (O << 10) | 0x1f)); }
__device__ __forceinline__ float half_sum(float v) { auto rr = __builtin_amdgcn_permlane32_swap(__float_as_uint(v), __float_as_uint(v), false, false); return __uint_as_float(rr[0]) + __uint_as_float(rr[1]); }
__device__ __forceinline__ float sum32(float v) { v += swz_xor<1>(v); v += swz_xor<2>(v); v += swz_xor<4>(v); v += swz_xor<8>(v); v += swz_xor<16>(v); return v; }
__device__ __forceinline__ float wave_sum(float v) { return half_sum(sum32(v)); }
__device__ __forceinline__ float sigmoidf_(float x) { return 1.f / (1.f + __expf(-x)); }
__device__ __forceinline__ float siluf_(float x) { return x / (1.f + __expf(-x)); }
__device__ __forceinline__ void unpack8(const u32x4 w, float (&f)[8]) {
    f[0] = bf_lo(w.x); f[1] = bf_hi(w.x); f[2] = bf_lo(w.y); f[3] = bf_hi(w.y); f[4] = bf_lo(w.z); f[5] = bf_hi(w.z); f[6] = bf_lo(w.w); f[7] = bf_hi(w.w);
}
__device__ __forceinline__ u32x4 pack8(const float (&f)[8]) { u32x4 w; w.x = cvtpk(f[0], f[1]); w.y = cvtpk(f[2], f[3]); w.z = cvtpk(f[4], f[5]); w.w = cvtpk(f[6], f[7]); return w; }

#define XB_TMO      128
#define XB_XCNT(j)  (256  + 64 * (j))
#define XB_XSUB(j)  (1280 + 64 * (j))
#define XB_XGEN(j)  (2304 + 64 * (j))
#define XB_TOP      3328
#define XB_TOPGEN   3392
#define XCD_BAR_WORDS 3456
#define XB_SPIN_CAP (1u << 20)
__device__ __forceinline__ unsigned xb_ld(unsigned* p)              { return __hip_atomic_load(p, __ATOMIC_RELAXED, __HIP_MEMORY_SCOPE_AGENT); }
__device__ __forceinline__ unsigned xb_add(unsigned* p, unsigned v) { return __hip_atomic_fetch_add(p, v, __ATOMIC_RELAXED, __HIP_MEMORY_SCOPE_AGENT); }
__device__ __forceinline__ unsigned xb_xcc_id() { return (unsigned)__builtin_amdgcn_s_getreg((3 << 11) | 20) & 0xFu; }
#define XB_SPIN(cond, bar) do { unsigned _sp = 0; while (cond) { __builtin_amdgcn_s_sleep(1); \
    if ((++_sp & 255u) == 0u) { if (xb_ld(&(bar)[XB_TMO])) break; if (_sp > XB_SPIN_CAP) { atomicAdd(&(bar)[XB_TMO], 1u); break; } } } } while (0)
struct XcdBarrier { unsigned* bar; unsigned x; volatile LAS unsigned* st; };
__device__ __forceinline__ XcdBarrier xcd_barrier_post(unsigned* bar, volatile LAS unsigned* st) {
    XcdBarrier b; b.bar = bar; b.x = xb_xcc_id(); b.st = st;
    if (threadIdx.x == 0) (void)xb_add(&bar[XB_XCNT(b.x)], 1u);
    return b;
}
__device__ __forceinline__ void xcd_barrier_complete(unsigned* bar, unsigned x, unsigned& nloc, unsigned& nx) {
    const unsigned G = gridDim.x * gridDim.y * gridDim.z;
    unsigned sum, cnt, mine, sp = 0u;
    for (;;) {
        sum = 0u; cnt = 0u; mine = 0u;
#pragma unroll
        for (unsigned j = 0; j < 16; ++j) { const unsigned c = xb_ld(&bar[XB_XCNT(j)]); sum += c; cnt += (c > 0u) ? 1u : 0u; mine = (j == x) ? c : mine; }
        if (sum == G) break;
        __builtin_amdgcn_s_sleep(1);
        if ((++sp & 255u) == 0u) { if (xb_ld(&bar[XB_TMO])) break; if (sp > XB_SPIN_CAP) { atomicAdd(&bar[XB_TMO], 1u); break; } }
    }
    nloc = mine > 0u ? mine : 1u; nx = cnt > 0u ? cnt : 1u;
}
__device__ __forceinline__ void xcd_barrier(const XcdBarrier& b, const int wv) {
    const bool leader = (wv == 0) && (olane() == 0);
    asm volatile("s_waitcnt vmcnt(0)" ::: "memory");
    __syncthreads();
    if (leader) {
        unsigned* bar = b.bar; unsigned bx = b.x;
        asm volatile("" : "+s"(bar), "+s"(bx));
        __builtin_amdgcn_s_waitcnt(0);
        unsigned nloc = b.st[0], nx = b.st[1];
        if (nloc == 0u) { xcd_barrier_complete(bar, bx, nloc, nx); b.st[0] = nloc; b.st[1] = nx; }
        const unsigned old = xb_add(&bar[XB_XSUB(bx)], 1u);
        const unsigned gen = old / nloc;
        if (old + 1u == (gen + 1u) * nloc) {
            __builtin_amdgcn_fence(__ATOMIC_RELEASE, "agent");
            asm volatile("s_waitcnt vmcnt(0)" ::: "memory");
            const unsigned og = xb_add(&bar[XB_TOP], 1u);
            const unsigned tg = og / nx;
            if (og + 1u == (tg + 1u) * nx) xb_add(&bar[XB_TOPGEN], 1u);
            else XB_SPIN(xb_ld(&bar[XB_TOPGEN]) == tg, bar);
            __builtin_amdgcn_fence(__ATOMIC_ACQUIRE, "agent");
            xb_add(&bar[XB_XGEN(bx)], 1u);
            asm volatile("s_waitcnt vmcnt(0)" ::: "memory");
        } else {
            XB_SPIN(xb_ld(&bar[XB_XGEN(bx)]) == gen, bar);
            __builtin_amdgcn_fence(__ATOMIC_ACQUIRE, "agent");
            asm volatile("s_waitcnt vmcnt(0)" ::: "memory");
        }
    }
    __syncthreads();
}

namespace pg8 {
constexpr int BM = 256, BK = 64, HALF = 128, HTB = HALF * BK * 2, NXCD = 8, WGM = 8;
__host__ __device__ __forceinline__ int lds_byte(int r, int c) { const int st = (r >> 4) * 2 + (c >> 5), rr = r & 15, cc = c & 31, ob = rr * 64 + cc * 2; return st * 1024 + (ob ^ (((ob >> 9) & 1) << 5)); }
__host__ __device__ __forceinline__ void stage_rc(int b, int& R, int& C) { const int st = b / 1024, sb = b % 1024, swz = sb ^ (((sb >> 9) & 1) << 5); R = (st >> 1) * 16 + swz / 64; C = (st & 1) * 32 + (swz % 64) / 2; }
__host__ __device__ __forceinline__ int perm32(int rho) { const int n = rho >> 4, i = rho & 15; return 8 * (i >> 2) + 4 * n + (i & 3); }

struct Unit { int pm, pn, aux0, aux1, aux2; const char* a; const char* b; const char* b2; };
typedef f32x4 Acc[2][2][4][2];

template <class Epi, class Sched, bool ALIGN_EPI, bool GATHER = false, bool SPLITB = false>
__device__ __forceinline__ void gemm_phase(LAS unsigned char* lds, const int lda, const int ldb, const int K, const int ksplit, const Sched& S, const Epi& E, const int wv) {
    const int tid = otid(wv), wid = __builtin_amdgcn_readfirstlane(tid >> 6), lane = tid & 63, wr = wid >> 2, wc = wid & 3, fr = lane & 15, fq = lane >> 4;
    const int nt = K / BK;
    unsigned voffA[2][2], voffN[2][2], voffB[2];
#pragma unroll
    for (int i = 0; i < 2; ++i) { int R, C; stage_rc(tid * 16 + i * 8192, R, C); const int Rb = (R & ~31) + perm32(R & 31);
        voffB[i] = (unsigned)(Rb * ldb + C) * 2u;
        voffA[0][i] = (unsigned)(R * lda + C) * 2u; voffA[1][i] = (unsigned)((R + HALF) * lda + C) * 2u; voffN[0][i] = voffA[0][i]; voffN[1][i] = voffA[1][i]; }
    const size_t kstep = (size_t)(BK * 2);
    const size_t hstepB = (size_t)HALF * ldb * 2, hstepA = (size_t)HALF * lda * 2;
    const unsigned ldsw = (unsigned)wid * 1024u;
    const int aoff = lds_byte(wr * 64 + fr, fq * 8), boff = lds_byte(wc * 32 + fr, fq * 8);
#define PG8_SA(b, h) (((b) * 2 + (h)) * HTB)
#define PG8_SB(b, h) ((4 + (b) * 2 + (h)) * HTB)
#define PG8_STAGE_B(bufoff, gbase, h) do { _Pragma("unroll") for (int _i = 0; _i < 2; ++_i) \
        __builtin_amdgcn_global_load_lds((const unsigned*)((const char*)(gbase) + (size_t)(h) * hstepB + voffB[_i]), (LAS unsigned*)(lds + (bufoff) + ldsw + _i * 8192), 16, 0, 0); } while (0)
#define PG8_STAGE_A(bufoff, gbase, h, NX) do { _Pragma("unroll") for (int _i = 0; _i < 2; ++_i) { if constexpr (GATHER) { const unsigned _o = (NX) ? voffN[h][_i] : voffA[h][_i]; \
        __builtin_amdgcn_global_load_lds((const unsigned*)((const char*)(gbase) + _o), (LAS unsigned*)(lds + (bufoff) + ldsw + _i * 8192), 16, 0, 0); } else { \
        __builtin_amdgcn_global_load_lds((const unsigned*)((const char*)(gbase) + (size_t)(h) * hstepA + voffA[0][_i]), (LAS unsigned*)(lds + (bufoff) + ldsw + _i * 8192), 16, 0, 0); } } } while (0)
#define PG8_LDA(dst, b, h) do { _Pragma("unroll") for (int m = 0; m < 4; ++m) _Pragma("unroll") for (int k = 0; k < 2; ++k) dst[m][k] = *(const LAS bf16x8*)(lds + PG8_SA(b, h) + aoff + m * 2048 + k * 1024); } while (0)
#define PG8_LDB(dst, b, h) do { _Pragma("unroll") for (int n = 0; n < 2; ++n) _Pragma("unroll") for (int k = 0; k < 2; ++k) dst[n][k] = *(const LAS bf16x8*)(lds + PG8_SB(b, h) + boff + n * 2048 + k * 1024); } while (0)
#define PG8_MMA(ai, bj, At, Bt) do { __builtin_amdgcn_s_setprio(1); _Pragma("unroll") for (int m = 0; m < 4; ++m) _Pragma("unroll") for (int n = 0; n < 2; ++n) _Pragma("unroll") for (int k = 0; k < 2; ++k) \
        acc[ai][bj][m][n] = __builtin_amdgcn_mfma_f32_16x16x32_bf16(Bt[n][k], At[m][k], acc[ai][bj][m][n], 0, 0, 0); __builtin_amdgcn_s_setprio(0); } while (0)
#define PG8_WAIT_V(n) asm volatile("s_waitcnt vmcnt(" #n ")" ::: "memory")
#define PG8_WAIT_L(n) asm volatile("s_waitcnt lgkmcnt(" #n ")" ::: "memory")
#define PG8_BAR __builtin_amdgcn_s_barrier()
#define PG8_SCHED __builtin_amdgcn_sched_barrier(0)
#define PG8_GOFF(dst, u) do { if constexpr (GATHER) { const int _t = otid(wv); _Pragma("unroll") for (int _i = 0; _i < 2; ++_i) { int _R, _C; stage_rc(_t * 16 + _i * 8192, _R, _C); \
        _Pragma("unroll") for (int _h = 0; _h < 2; ++_h) dst[_h][_i] = S.gather_off(u, _h * HALF + _R) + (unsigned)_C * 2u; } } } while (0)
#define PG8_BPTR(u, t) (SPLITB ? (((t) < ksplit) ? (u).b + (size_t)(t) * kstep : (u).b2 + (size_t)((t) - ksplit) * kstep) : (u).b + (size_t)(t) * kstep)
    Unit cur, nxt; int ui = 0;
    if (!S.next(0, cur)) return;
    Acc acc;
#pragma unroll
    for (int a = 0; a < 2; ++a)
#pragma unroll
        for (int b = 0; b < 2; ++b)
#pragma unroll
            for (int m = 0; m < 4; ++m)
#pragma unroll
                for (int n = 0; n < 2; ++n) acc[a][b][m][n] = (f32x4){0.f, 0.f, 0.f, 0.f};
    bf16x8 At[4][2], B0[2][2], B1[2][2];
    const char* cA = cur.a; const char* cB = cur.b;
    S.a_ready(cur);
    PG8_GOFF(voffA, cur);
    if constexpr (GATHER) {
#pragma unroll
        for (int h = 0; h < 2; ++h)
#pragma unroll
            for (int i = 0; i < 2; ++i) voffN[h][i] = voffA[h][i];
    }
    PG8_STAGE_B(PG8_SB(0, 0), cB, 0); PG8_STAGE_B(PG8_SB(0, 1), cB, 1); PG8_STAGE_A(PG8_SA(0, 0), cA, 0, false); PG8_STAGE_A(PG8_SA(0, 1), cA, 1, false);
    if (wr == 1) PG8_BAR;
    PG8_WAIT_V(2); PG8_BAR;
    PG8_STAGE_B(PG8_SB(1, 0), cB + kstep, 0); PG8_STAGE_A(PG8_SA(1, 0), cA + kstep, 0, false); PG8_STAGE_B(PG8_SB(1, 1), cB + kstep, 1);
    PG8_WAIT_V(6); PG8_BAR;
    for (;;) {
        const bool has_next = S.next(ui + 1, nxt);
        const char* nA = has_next ? nxt.a : cA; const char* nB = has_next ? nxt.b : cB;
#pragma nounroll
        for (int t = 0; t < nt; t += 2) {
            const bool last = (t == nt - 2);
            if (last && has_next) { S.a_ready(nxt); PG8_GOFF(voffN, nxt); }
            if constexpr (Epi::HOOK) { if (t == Epi::HOOK_T0 || t == Epi::HOOK_T1) E.hook(acc, cur, t, wr, wc, fr, fq); }
            const char* a1 = cA + (size_t)(t + 1) * kstep;
            const char* a2 = last ? nA : cA + (size_t)(t + 2) * kstep; const char* b2 = last ? nB : PG8_BPTR(cur, t + 2);
            const char* a3 = a2 + kstep; const char* b3 = b2 + kstep;
            PG8_LDB(B0, 0, 0); PG8_LDB(B1, 0, 1); PG8_SCHED; PG8_LDA(At, 0, 0); PG8_STAGE_A(PG8_SA(1, 1), a1, 1, false);
            PG8_WAIT_V(8); PG8_WAIT_L(0); PG8_BAR; PG8_MMA(0, 0, At, B0); PG8_MMA(0, 1, At, B1); PG8_BAR; PG8_SCHED;
            PG8_LDA(At, 0, 1); PG8_STAGE_B(PG8_SB(0, 0), b2, 0); PG8_STAGE_B(PG8_SB(0, 1), b2, 1); PG8_STAGE_A(PG8_SA(0, 0), a2, 0, last);
            PG8_WAIT_V(8); PG8_WAIT_L(0); PG8_BAR; PG8_MMA(1, 0, At, B0); PG8_MMA(1, 1, At, B1); PG8_BAR; PG8_SCHED;
            PG8_LDB(B0, 1, 0); PG8_LDB(B1, 1, 1); PG8_SCHED; PG8_LDA(At, 1, 0); PG8_STAGE_A(PG8_SA(0, 1), a2, 1, last);
            PG8_WAIT_V(8); PG8_WAIT_L(0); PG8_BAR; PG8_MMA(0, 0, At, B0); PG8_MMA(0, 1, At, B1); PG8_BAR; PG8_SCHED;
            PG8_LDA(At, 1, 1); PG8_STAGE_B(PG8_SB(1, 0), b3, 0); PG8_STAGE_B(PG8_SB(1, 1), b3, 1); PG8_STAGE_A(PG8_SA(1, 0), a3, 0, last);
            PG8_WAIT_V(8); PG8_WAIT_L(0); PG8_BAR; PG8_MMA(1, 0, At, B0); PG8_MMA(1, 1, At, B1); PG8_BAR; PG8_SCHED;
        }
        if constexpr (ALIGN_EPI) { if (wr == 0) PG8_BAR; }
        E(acc, cur, wr, wc, fr, fq); S.done(cur);
        if (!has_next) break;
#pragma unroll
        for (int a = 0; a < 2; ++a)
#pragma unroll
            for (int b = 0; b < 2; ++b)
#pragma unroll
                for (int m = 0; m < 4; ++m)
#pragma unroll
                    for (int n = 0; n < 2; ++n) acc[a][b][m][n] = (f32x4){0.f, 0.f, 0.f, 0.f};
        cur = nxt; cA = nA; cB = nB; ++ui;
        if constexpr (GATHER) {
#pragma unroll
            for (int h = 0; h < 2; ++h)
#pragma unroll
                for (int i = 0; i < 2; ++i) voffA[h][i] = voffN[h][i];
        }
        if constexpr (ALIGN_EPI) { if (wr == 1) PG8_BAR; }
    }
    PG8_WAIT_V(0);
    if constexpr (!ALIGN_EPI) { if (wr == 0) PG8_BAR; }
    PG8_BAR;
#undef PG8_SA
#undef PG8_SB
#undef PG8_STAGE_A
#undef PG8_STAGE_B
#undef PG8_LDA
#undef PG8_LDB
#undef PG8_MMA
#undef PG8_WAIT_V
#undef PG8_WAIT_L
#undef PG8_BAR
#undef PG8_SCHED
#undef PG8_GOFF
#undef PG8_BPTR
}
}
struct Resid {
    const float* src_lat; const float* src_ctx; float* dst_lat; float* dst_ctx; int g;
    __device__ __forceinline__ const float* src(int row) const { const int bl = row / SB, s = row - bl * SB, b = g * GB + bl;
        return s < CTXL ? src_ctx + (size_t)(b * CTXL + s) * DM : src_lat + ((size_t)b * SEQ + (s - CTXL)) * DM; }
    __device__ __forceinline__ float* dst(int row) const { const int bl = row / SB, s = row - bl * SB, b = g * GB + bl;
        return s < CTXL ? dst_ctx + (size_t)(b * CTXL + s) * DM : dst_lat + ((size_t)b * SEQ + (s - CTXL)) * DM; }
    __device__ __forceinline__ int modv(int row) const { const int bl = row / SB, s = row - bl * SB; return s < CTXL ? 8 : g * GB + bl; }
};

struct TileOrder {
    int nM, nN, nwg, G, c, skip; const char* A; const char* B; size_t astep, bstep;
    __device__ __forceinline__ void init(int nM_, int nN_, int G_, int c_, const void* A_, size_t astep_, const void* B_, size_t bstep_, int skip_ctx) {
        nM = nM_; nN = nN_; nwg = nM * nN; G = G_; c = c_; A = (const char*)A_; B = (const char*)B_; astep = astep_; bstep = bstep_; skip = skip_ctx; }
    __device__ __forceinline__ bool next(int i, pg8::Unit& u) const {
        const long L = (long)i * G + c; if (L >= nwg) return false;
        int wgid = (int)L; { const int q = nwg / pg8::NXCD, r = nwg % pg8::NXCD, xcd = wgid % pg8::NXCD, off = wgid / pg8::NXCD; wgid = (xcd < r ? xcd * (q + 1) : r * (q + 1) + (xcd - r) * q) + off; }
        const int nig = pg8::WGM * nN, gid = wgid / nig, fm = gid * pg8::WGM, gsz = (nM - fm) < pg8::WGM ? (nM - fm) : pg8::WGM;
        int pm = fm + ((wgid % nig) % gsz); u.pn = (wgid % nig) / gsz;
        if (skip) pm = pm + pm / 32 + 1;
        u.pm = pm; u.aux0 = 0; u.aux1 = 0; u.aux2 = 0;
        u.a = A + (size_t)pm * astep; u.b = B + (size_t)u.pn * bstep; u.b2 = u.b; return true;
    }
    __device__ __forceinline__ void a_ready(const pg8::Unit&) const {}
    __device__ __forceinline__ void done(const pg8::Unit&) const {}
};

struct MoeOrder {
    const LAS int* tab; const int* LIST; int ncol, G, c, up; const char* A; const char* W;
    __device__ __forceinline__ bool next(int i, pg8::Unit& u) const {
        const int total = __builtin_amdgcn_readfirstlane(tab[24]) * ncol; const int L = i * G + c; if (L >= total) return false;
        const int rt = L / ncol, pn = L - rt * ncol;
        int p = 0;
#pragma unroll
        for (int q = 1; q < NPAIR; ++q) p += (__builtin_amdgcn_readfirstlane(tab[q]) <= rt) ? 1 : 0;
        const int base = (rt - __builtin_amdgcn_readfirstlane(tab[p])) * 256; int valid = __builtin_amdgcn_readfirstlane(tab[32 + p]) - base; valid = valid > 256 ? 256 : valid;
        u.pm = rt; u.pn = pn; u.aux0 = p * NT + base; u.aux1 = valid; u.aux2 = p;
        const int grp = p / 6, q6 = p - grp * 6;
        const int lo = q6 < 3 ? 0 : (q6 < 5 ? 1 : 2), hi = q6 < 3 ? q6 + 1 : (q6 < 5 ? q6 - 1 : 3);
        const int ea = grp * 4 + lo, eb = grp * 4 + hi;
        if (up) { const int e = pn < 4 ? ea : eb; u.a = A; u.b = W + ((size_t)e * 1024 + (size_t)(pn & 3) * 256) * 1024 * 2; u.b2 = u.b; }
        else { u.a = A + (size_t)rt * 256 * 1024 * 2; u.b = W + ((size_t)ea * 1024 + (size_t)pn * 256) * 512 * 2; u.b2 = W + ((size_t)eb * 1024 + (size_t)pn * 256) * 512 * 2; }
        return true;
    }
    __device__ __forceinline__ unsigned gather_off(const pg8::Unit& u, int r) const { const int idx = r < u.aux1 ? r : 0; return (unsigned)LIST[u.aux0 + idx] * (unsigned)(DM * 2); }
    __device__ __forceinline__ void a_ready(const pg8::Unit&) const {}
    __device__ __forceinline__ void done(const pg8::Unit&) const {}
};

#ifdef EPI_NT_STORES
#define ST_NT(p, v) __builtin_nontemporal_store((v), (p))
#else
#define ST_NT(p, v) (*(p) = (v))
#endif
#define EPI_NOHOOK static constexpr bool HOOK = false; static constexpr int HOOK_T0 = -1, HOOK_T1 = -1; \
    __device__ __forceinline__ void hook(pg8::Acc&, const pg8::Unit&, int, int, int, int, int) const {}
#define EPI_V8(v, acc, ai, bj, m) float v[8]; { const f32x4 _a = acc[ai][bj][m][0], _b = acc[ai][bj][m][1]; v[0] = _a[0]; v[1] = _a[1]; v[2] = _a[2]; v[3] = _a[3]; v[4] = _b[0]; v[5] = _b[1]; v[6] = _b[2]; v[7] = _b[3]; }
__device__ __forceinline__ void rot4(float (&v)[8], const f32x2* cs) {
    const f32x4 c01 = *(const f32x4*)cs, c23 = *(const f32x4*)(cs + 2);
    const float c[4] = {c01[0], c01[2], c23[0], c23[2]}, s[4] = {c01[1], c01[3], c23[1], c23[3]};
#pragma unroll
    for (int k = 0; k < 4; ++k) { const float x1 = v[2 * k], x2 = v[2 * k + 1]; v[2 * k] = x1 * c[k] - x2 * s[k]; v[2 * k + 1] = x2 * c[k] + x1 * s[k]; }
}

struct EpiNone { EPI_NOHOOK
    float* sink;
    __device__ __forceinline__ void operator()(const pg8::Acc& acc, const pg8::Unit& u, int wr, int wc, int fr, int fq) const {
        float s = 0.f;
#pragma unroll
        for (int ai = 0; ai < 2; ++ai)
#pragma unroll
            for (int bj = 0; bj < 2; ++bj)
#pragma unroll
                for (int m = 0; m < 4; ++m) s += acc[ai][bj][m][0][0] + acc[ai][bj][m][1][3];
        if (s == 1.2345e33f) sink[0] = s;
    }
};
struct EpiStoreOnly { EPI_NOHOOK
    bf16_t* PG;
    __device__ __forceinline__ void operator()(const pg8::Acc& acc, const pg8::Unit& u_, int wr, int wc, int fr, int fq) const {
        pg8::Unit u = u_; asm volatile("" : "+s"(u.pm), "+s"(u.pn), "+v"(fr), "+v"(fq));
        const int pn12 = u.pn % 12;
#pragma unroll
        for (int ai = 0; ai < 2; ++ai)
#pragma unroll
        for (int m = 0; m < 4; ++m) { const int row = u.pm * 256 + ai * 128 + wr * 64 + m * 16 + fr;
#pragma unroll
            for (int bj = 0; bj < 2; ++bj) { const int c0 = bj * 128 + wc * 32 + 8 * fq; EPI_V8(v, acc, ai, bj, m)
                *(u32x4*)(PG + (size_t)row * 3072 + pn12 * 256 + c0) = pack8(v); } }
    }
};
struct EpiInproj {
    EPI_NOHOOK
    bf16_t *PR, *PC, *PM, *PG, *KB; float* SSQ; const f32x2* RT; const f32x2* MT;
    __device__ __forceinline__ void operator()(const pg8::Acc& acc, const pg8::Unit& u_, int wr, int wc, int fr, int fq) const {
        pg8::Unit u = u_; asm volatile("" : "+s"(u.pm), "+s"(u.pn), "+s"(u.aux0), "+s"(u.aux1), "+v"(fr), "+v"(fq));
        const int pn = u.pn;
#pragma unroll
        for (int ai = 0; ai < 2; ++ai)
#pragma unroll
        for (int m = 0; m < 4; ++m) { __builtin_amdgcn_sched_barrier(0);
            const int row = u.pm * 256 + ai * 128 + wr * 64 + m * 16 + fr;
            const int bl = row / SB, s = row - bl * SB; const bool lat = s >= CTXL; const int t = lat ? s - CTXL : 0;
            float ss[2] = {0.f, 0.f};
#pragma unroll
            for (int bj = 0; bj < 2; ++bj) {
                const int c0 = bj * 128 + wc * 32 + 8 * fq;
                EPI_V8(v, acc, ai, bj, m)
                if (pn <= 1) {
                    if (lat) rot4(v, RT + (size_t)t * 32 + ((c0 & 63) >> 1));
                    if (pn == 1) {
#pragma unroll
                        for (int k = 0; k < 8; ++k) v[k] *= 0.125f;
                    }
                    *(u32x4*)(PR + (size_t)row * 1536 + pn * 256 + c0) = pack8(v);
                } else if (pn <= 5) {
                    *(u32x4*)(PR + (size_t)row * 1536 + pn * 256 + c0) = pack8(v);
                } else if (pn <= 7) {
                    *(u32x4*)(PC + (size_t)row * 1024 + (pn - 6) * 256 + c0) = pack8(v);
                } else if (pn <= 11) {
                    u32x2 w; w.x = cvtpk(v[0] * v[1], v[2] * v[3]); w.y = cvtpk(v[4] * v[5], v[6] * v[7]);
                    *(u32x2*)(PC + (size_t)row * 1024 + 512 + (pn - 8) * 128 + (c0 >> 1)) = w;
                } else if (pn <= 14) {
                    if (pn == 14 && bj == 1) {
                        if (wc == 0) {
                            if (lat) { const int a = fq >> 1, pos = a ? (t & 63) : (t >> 6); rot4(v, MT + pos * 8 + (fq & 1) * 4); }
                            const u32x4 w = pack8(v);
#pragma unroll
                            for (int hh = 0; hh < 8; ++hh) *(u32x4*)(KB + ((size_t)(bl * 8 + hh) * SB + s) * 96 + 64 + 8 * fq) = w;
                        }
                    } else {
                        *(u32x4*)(PM + (size_t)row * 640 + (pn - 12) * 256 + c0) = pack8(v);
                        float q = 0.f;
#pragma unroll
                        for (int k = 0; k < 8; ++k) q += v[k] * v[k];
                        ss[bj] = q;
                    }
                } else {
                    float g[8];
#pragma unroll
                    for (int k = 0; k < 8; ++k) { const float x = fminf(fmaxf(v[k], -15.f), 15.f); g[k] = sigmoidf_(x); }
                    ST_NT((u32x4*)(PG + (size_t)row * 3072 + (pn - 15) * 256 + c0), pack8(g));
                }
            }
            if (pn >= 12 && pn <= 14) {
                float a = ss[0], b = ss[1];
                a += swz_xor<16>(a); a = half_sum(a); b += swz_xor<16>(b); b = half_sum(b);
                if (fq == 0) {
                    float* sq = SSQ + (size_t)row * 16;
                    if (pn == 12) sq[wc] = a + b;
                    else if (pn == 13) { sq[4 + wc] = a; sq[8 + wc] = b; }
                    else sq[12 + wc] = a;
                }
            }
        }
    }
};

#define EPI_ROW(ai, m) (u.pm * 256 + (ai) * 128 + wr * 64 + (m) * 16 + fr)
#define EPI_OPAQUE pg8::Unit u = u_; asm volatile("" : "+s"(u.pm), "+s"(u.pn), "+s"(u.aux0), "+s"(u.aux1), "+v"(fr), "+v"(fq));
struct EpiUq {
    EPI_NOHOOK
    bf16_t* QB; const float* SSQ; const f32x2* MT;
    __device__ __forceinline__ void operator()(const pg8::Acc& acc, const pg8::Unit& u_, int wr, int wc, int fr, int fq) const {
        EPI_OPAQUE
        f32x4 q0[2][4], q1[2][4];
#pragma unroll
        for (int ai = 0; ai < 2; ++ai)
#pragma unroll
            for (int m = 0; m < 4; ++m) { const float* sq = SSQ + (size_t)EPI_ROW(ai, m) * 16; q0[ai][m] = *(const f32x4*)sq; q1[ai][m] = *(const f32x4*)(sq + 4); }
#pragma unroll
        for (int ai = 0; ai < 2; ++ai)
#pragma unroll
        for (int m = 0; m < 4; ++m) {
            const int row = EPI_ROW(ai, m);
            const int bl = row / SB, s = row - bl * SB; const bool lat = s >= CTXL; const int t = lat ? s - CTXL : 0;
            const f32x4 a = q0[ai][m], b = q1[ai][m];
            const float ssq = ((a[0] + a[1]) + (a[2] + a[3])) + ((b[0] + b[1]) + (b[2] + b[3]));
            const float rq = rsqrtf(ssq * (1.f / 384.f) + RMS_EPS) * QSCALE;
#pragma unroll
            for (int bj = 0; bj < 2; ++bj) {
                const int cg = u.pn * 256 + bj * 128 + wc * 32 + 8 * fq; const int h = cg / 96, d0 = cg - h * 96;
                EPI_V8(v, acc, ai, bj, m)
#pragma unroll
                for (int k = 0; k < 8; ++k) v[k] *= rq;
                if (d0 >= 64 && lat) { const int p0 = d0 - 64, aa = p0 >> 4, pos = aa ? (t & 63) : (t >> 6); rot4(v, MT + pos * 8 + ((p0 & 15) >> 1)); }
                *(u32x4*)(QB + ((size_t)(bl * 8 + h) * SB + s) * 96 + d0) = pack8(v);
            }
        }
    }
};
struct EpiUkv {
    EPI_NOHOOK
    bf16_t *KB, *VB; const float* SSQ;
    __device__ __forceinline__ void operator()(const pg8::Acc& acc, const pg8::Unit& u_, int wr, int wc, int fr, int fq) const {
        EPI_OPAQUE
        f32x4 q0[2][4], q1[2][4];
#pragma unroll
        for (int ai = 0; ai < 2; ++ai)
#pragma unroll
            for (int m = 0; m < 4; ++m) { const float* sq = SSQ + (size_t)EPI_ROW(ai, m) * 16 + 8; q0[ai][m] = *(const f32x4*)sq; q1[ai][m] = *(const f32x4*)(sq + 4); }
#pragma unroll
        for (int ai = 0; ai < 2; ++ai)
#pragma unroll
        for (int m = 0; m < 4; ++m) {
            const int row = EPI_ROW(ai, m);
            const int bl = row / SB, s = row - bl * SB;
            const f32x4 a = q0[ai][m], b = q1[ai][m];
            const float ssq = ((a[0] + a[1]) + (a[2] + a[3])) + ((b[0] + b[1]) + (b[2] + b[3]));
            const float rk = rsqrtf(ssq * (1.f / 256.f) + RMS_EPS);
#pragma unroll
            for (int bj = 0; bj < 2; ++bj) {
                const int cg = u.pn * 256 + bj * 128 + wc * 32 + 8 * fq; const int h = cg >> 7, e0 = cg & 127;
                EPI_V8(v, acc, ai, bj, m)
#pragma unroll
                for (int k = 0; k < 8; ++k) v[k] *= rk;
                if (e0 < 64) *(u32x4*)(KB + ((size_t)(bl * 8 + h) * SB + s) * 96 + e0) = pack8(v);
                else *(u32x4*)(VB + ((size_t)(bl * 8 + h) * SB + s) * 64 + (e0 - 64)) = pack8(v);
            }
        }
    }
};

struct EpiMerge1 {
    static constexpr bool HOOK = true; static constexpr int HOOK_T0 = 8, HOOK_T1 = 16;
    const bf16_t* PG; bf16_t* M;
    __device__ __forceinline__ void hook(pg8::Acc& acc, const pg8::Unit& u_, int t, int wr, int wc, int fr, int fq) const {
        pg8::Unit u = u_; asm volatile("" : "+s"(u.pm), "+s"(u.pn), "+v"(fr), "+v"(fq));
        const int gi = (t == 8) ? 0 : 1;
#pragma unroll
        for (int ai = 0; ai < 2; ++ai) {
            u32x4 sp[4][2], sn[4][2];
#pragma unroll
            for (int m = 0; m < 4; ++m)
#pragma unroll
                for (int bj = 0; bj < 2; ++bj) { const bf16_t* p = PG + (size_t)EPI_ROW(ai, m) * 3072 + gi * 1024 + u.pn * 256 + bj * 128 + wc * 32 + 8 * fq;
                    sp[m][bj] = *(const u32x4*)p; sn[m][bj] = *(const u32x4*)(p + 1024); }
#pragma unroll
            for (int m = 0; m < 4; ++m)
#pragma unroll
                for (int bj = 0; bj < 2; ++bj) {
                    float a[8], b[8]; unpack8(sp[m][bj], a); unpack8(sn[m][bj], b);
                    f32x4 r0, r1;
#pragma unroll
                    for (int k = 0; k < 4; ++k) { r0[k] = a[k] * __builtin_amdgcn_rcpf(b[k]); r1[k] = a[4 + k] * __builtin_amdgcn_rcpf(b[4 + k]); }
                    acc[ai][bj][m][0] *= r0; acc[ai][bj][m][1] *= r1;
                }
            __builtin_amdgcn_sched_barrier(0);
        }
    }
    __device__ __forceinline__ void operator()(const pg8::Acc& acc, const pg8::Unit& u_, int wr, int wc, int fr, int fq) const {
        EPI_OPAQUE
#pragma unroll
        for (int ai = 0; ai < 2; ++ai) {
            u32x4 s2[4][2];
#pragma unroll
            for (int m = 0; m < 4; ++m)
#pragma unroll
                for (int bj = 0; bj < 2; ++bj) s2[m][bj] = *(const u32x4*)(PG + (size_t)EPI_ROW(ai, m) * 3072 + 2048 + u.pn * 256 + bj * 128 + wc * 32 + 8 * fq);
#pragma unroll
            for (int m = 0; m < 4; ++m)
#pragma unroll
                for (int bj = 0; bj < 2; ++bj) {
                    const int cg = u.pn * 256 + bj * 128 + wc * 32 + 8 * fq;
                    float g[8]; unpack8(s2[m][bj], g);
                    EPI_V8(v, acc, ai, bj, m)
#pragma unroll
                    for (int k = 0; k < 8; ++k) v[k] *= g[k];
                    *(u32x4*)(M + (size_t)EPI_ROW(ai, m) * 1024 + cg) = pack8(v);
                }
            __builtin_amdgcn_sched_barrier(0);
        }
    }
};

struct EpiMerge2 {
    EPI_NOHOOK
    Resid R; const float* MODL;
    __device__ __forceinline__ void operator()(const pg8::Acc& acc, const pg8::Unit& u_, int wr, int wc, int fr, int fq) const {
        EPI_OPAQUE
        const float* g1 = MODL + R.modv(u.pm * 256) * 6144 + 2048 + u.pn * 256 + wc * 32 + 8 * fq;
        f32x4 g[2][2];
#pragma unroll
        for (int bj = 0; bj < 2; ++bj)
#pragma unroll
            for (int n = 0; n < 2; ++n) g[bj][n] = *(const f32x4*)(g1 + bj * 128 + 4 * n);
#pragma unroll
        for (int ai = 0; ai < 2; ++ai) {
            f32x4 x[4][2][2];
#pragma unroll
            for (int m = 0; m < 4; ++m) { const float* src = R.src(EPI_ROW(ai, m)) + u.pn * 256 + wc * 32 + 8 * fq;
#pragma unroll
                for (int bj = 0; bj < 2; ++bj)
#pragma unroll
                    for (int n = 0; n < 2; ++n) x[m][bj][n] = *(const f32x4*)(src + bj * 128 + 4 * n); }
#pragma unroll
            for (int m = 0; m < 4; ++m) { float* dst = R.dst(EPI_ROW(ai, m)) + u.pn * 256 + wc * 32 + 8 * fq;
#pragma unroll
                for (int bj = 0; bj < 2; ++bj)
#pragma unroll
                    for (int n = 0; n < 2; ++n) *(f32x4*)(dst + bj * 128 + 4 * n) = x[m][bj][n] + g[bj][n] * acc[ai][bj][m][n]; }
            __builtin_amdgcn_sched_barrier(0);
        }
    }
};

struct EpiMoeUp {
    EPI_NOHOOK
    const int* LIST; const float* WGT; bf16_t* MACT;
    __device__ __forceinline__ void operator()(const pg8::Acc& acc, const pg8::Unit& u_, int wr, int wc, int fr, int fq) const {
        EPI_OPAQUE
        const int slot = u.pn >> 2;
        int tok[2][4]; float w[2][4];
#pragma unroll
        for (int ai = 0; ai < 2; ++ai)
#pragma unroll
            for (int m = 0; m < 4; ++m) { const int ri = ai * 128 + wr * 64 + m * 16 + fr; tok[ai][m] = LIST[u.aux0 + (ri < u.aux1 ? ri : 0)]; }
#pragma unroll
        for (int ai = 0; ai < 2; ++ai)
#pragma unroll
            for (int m = 0; m < 4; ++m) w[ai][m] = WGT[(size_t)tok[ai][m] * 2 + slot];
#pragma unroll
        for (int ai = 0; ai < 2; ++ai)
#pragma unroll
        for (int m = 0; m < 4; ++m) {
            const int ri = ai * 128 + wr * 64 + m * 16 + fr; const float ww = w[ai][m];
#pragma unroll
            for (int bj = 0; bj < 2; ++bj) {
                const int c0 = bj * 128 + wc * 32 + 8 * fq;
                EPI_V8(v, acc, ai, bj, m)
                u32x2 o; o.x = cvtpk(siluf_(v[0]) * v[1] * ww, siluf_(v[2]) * v[3] * ww); o.y = cvtpk(siluf_(v[4]) * v[5] * ww, siluf_(v[6]) * v[7] * ww);
                *(u32x2*)(MACT + (size_t)(u.pm * 256 + ri) * 1024 + slot * 512 + (u.pn & 3) * 128 + (c0 >> 1)) = o;
            }
        }
    }
};
struct EpiMoeDown {
    EPI_NOHOOK
    const int* LIST; Resid R; const float* MODL; float* dry;
    __device__ __forceinline__ void operator()(const pg8::Acc& acc, const pg8::Unit& u_, int wr, int wc, int fr, int fq) const {
        EPI_OPAQUE
        int tok[2][4];
#pragma unroll
        for (int ai = 0; ai < 2; ++ai)
#pragma unroll
            for (int m = 0; m < 4; ++m) { const int ri = ai * 128 + wr * 64 + m * 16 + fr; tok[ai][m] = LIST[u.aux0 + (ri < u.aux1 ? ri : 0)]; }
        const int cb = u.pn * 256 + wc * 32 + 8 * fq;
#pragma unroll
        for (int ai = 0; ai < 2; ++ai) {
            f32x4 x[4][2][2];
#pragma unroll
            for (int m = 0; m < 4; ++m) { const float* dst = R.dst(tok[ai][m]) + cb;
#pragma unroll
                for (int bj = 0; bj < 2; ++bj)
#pragma unroll
                    for (int n = 0; n < 2; ++n) x[m][bj][n] = *(const f32x4*)(dst + bj * 128 + 4 * n); }
#pragma unroll
            for (int m = 0; m < 4; ++m) { const int ri = ai * 128 + wr * 64 + m * 16 + fr;
                if (ri < u.aux1) {
                    float* dst = R.dst(tok[ai][m]) + cb; const float* g2 = MODL + R.modv(tok[ai][m]) * 6144 + 5120 + cb;
#pragma unroll
                    for (int bj = 0; bj < 2; ++bj)
#pragma unroll
                        for (int n = 0; n < 2; ++n) { const f32x4 g = *(const f32x4*)(g2 + bj * 128 + 4 * n);
                            float* o = dry ? dry + (size_t)(u.pm * 256 + ri) * 1024 + cb + bj * 128 + 4 * n : dst + bj * 128 + 4 * n;
                            *(f32x4*)o = x[m][bj][n] + g * acc[ai][bj][m][n]; }
                } }
            __builtin_amdgcn_sched_barrier(0);
        }
    }
};
#define SBAR() __builtin_amdgcn_sched_barrier(0)
__device__ __forceinline__ int crow(int r, int hi) { return (r & 3) + 8 * (r >> 2) + 4 * hi; }
template <int NCB> __device__ __forceinline__ int v_st(int k, int c) { const int kk = (k & ~0xC) | ((k & 4) << 1) | ((k & 8) >> 1); return ((kk >> 3) * NCB + (c >> 5)) * 512 + ((kk & 7) * 32 + (c & 31)) * 2; }
__device__ __forceinline__ int v_rd_base(int lane) { return ((lane & 3) << 3) | (((lane >> 2) & 3) << 6) | (((lane >> 4) & 1) << 5) | (((lane >> 5) & 1) << 8); }
template <int OFF> __device__ __forceinline__ s16x4 tr_read(int vb) { s16x4 r; asm volatile("ds_read_b64_tr_b16 %0, %1 offset:%2" : "=&v"(r) : "v"(vb), "i"(OFF) : "memory"); return r; }
#define PKLH(L, H) (bf16x8){L[0], L[1], L[2], L[3], H[0], H[1], H[2], H[3]}
template <int NCB, int KS> __device__ __forceinline__ bf16x8 tr_frag(int vb) { const s16x4 l = tr_read<KS * NCB * 1024>(vb), h = tr_read<KS * NCB * 1024 + NCB * 512>(vb); return PKLH(l, h); }
#define PK4(P, BASE, OUT) do { const unsigned a0 = cvtpk(P[BASE + 0], P[BASE + 1]), a1 = cvtpk(P[BASE + 2], P[BASE + 3]);   \
    const unsigned b0 = cvtpk(P[BASE + 4], P[BASE + 5]), b1 = cvtpk(P[BASE + 6], P[BASE + 7]);                              \
    auto r0 = __builtin_amdgcn_permlane32_swap(a0, b0, false, false); auto r1 = __builtin_amdgcn_permlane32_swap(a1, b1, false, false); \
    u32x4 w = {r0[0], r1[0], r0[1], r1[1]}; OUT = __builtin_bit_cast(bf16x8, w); } while (0)

namespace att {
constexpr int DQK = 96, DV = 64, KVBLK = 64;
constexpr int SHM_V = KVBLK * DV * 2;
constexpr int SHM_K = KVBLK * 256;
constexpr float THR = 8.f;
#define KSWZ(row, colB) ((row) * 256 + ((colB) ^ (((row) & 7) << 4)))
__device__ __forceinline__ void partialSM(f32x16& p0, f32x16& p1, float& m_reg, float& alpha) {
    float pmax = p0[0];
#pragma unroll
    for (int r = 1; r < 16; ++r) pmax = fmaxf(pmax, p0[r]);
#pragma unroll
    for (int r = 0; r < 16; ++r) pmax = fmaxf(pmax, p1[r]);
    { auto rr = __builtin_amdgcn_permlane32_swap(__float_as_uint(pmax), __float_as_uint(pmax), false, false);
      pmax = fmaxf(__uint_as_float(rr[0]), __uint_as_float(rr[1])); }
    float mn;
    if (__builtin_expect(__all(pmax - m_reg <= THR), 1)) { mn = m_reg; alpha = 1.f; }
    else { mn = fmaxf(m_reg, pmax); alpha = __builtin_amdgcn_exp2f(m_reg - mn); m_reg = mn; }
#pragma unroll
    for (int r = 0; r < 16; ++r) p0[r] = p0[r] - mn;
#pragma unroll
    for (int r = 0; r < 16; ++r) p1[r] = p1[r] - mn;
#pragma unroll
    for (int r = 0; r < 16; ++r) p0[r] = __builtin_amdgcn_exp2f(p0[r]);
}
__device__ __forceinline__ void finishSM(f32x16& p0, f32x16& p1, float alpha, float& l_reg, bf16x8& pa0, bf16x8& pa1, bf16x8& pa2, bf16x8& pa3) {
#pragma unroll
    for (int r = 0; r < 16; ++r) p1[r] = __builtin_amdgcn_exp2f(p1[r]);
    float ps = 0;
#pragma unroll
    for (int r = 0; r < 16; ++r) ps += p0[r];
#pragma unroll
    for (int r = 0; r < 16; ++r) ps += p1[r];
    { auto rr = __builtin_amdgcn_permlane32_swap(__float_as_uint(ps), __float_as_uint(ps), false, false);
      ps = __uint_as_float(rr[0]) + __uint_as_float(rr[1]); }
    l_reg = l_reg * alpha + ps;
    PK4(p0, 0, pa0); PK4(p0, 8, pa1); PK4(p1, 0, pa2); PK4(p1, 8, pa3);
}
__device__ __forceinline__ void qkt(f32x16& p0, f32x16& p1, const LAS char* Ks, const bf16x8* qr, int r32, int hi) {
    p0 = f32x16{}; p1 = f32x16{};
#pragma unroll
    for (int d0 = 0; d0 < 6; ++d0) { const int cb = (d0 * 16 + hi * 8) * 2;
        const bf16x8 b0 = *(const LAS bf16x8*)(Ks + KSWZ(r32, cb));
        const bf16x8 b1 = *(const LAS bf16x8*)(Ks + KSWZ(32 + r32, cb));
        p0 = __builtin_amdgcn_mfma_f32_32x32x16_bf16(b0, qr[d0], p0, 0, 0, 0);
        p1 = __builtin_amdgcn_mfma_f32_32x32x16_bf16(b1, qr[d0], p1, 0, 0, 0); }
}
template <int D0> __device__ __forceinline__ void pv_one(f32x16& od, int vb, bf16x8 pa0, bf16x8 pa1, bf16x8 pa2, bf16x8 pa3) {
    const bf16x8 f0 = tr_frag<2, 0>(vb + D0 * 512), f1 = tr_frag<2, 1>(vb + D0 * 512), f2 = tr_frag<2, 2>(vb + D0 * 512), f3 = tr_frag<2, 3>(vb + D0 * 512);
    asm volatile("s_waitcnt lgkmcnt(0)" ::: "memory"); SBAR();
    od = __builtin_amdgcn_mfma_f32_32x32x16_bf16(pa0, f0, od, 0, 0, 0);
    od = __builtin_amdgcn_mfma_f32_32x32x16_bf16(pa1, f1, od, 0, 0, 0);
    od = __builtin_amdgcn_mfma_f32_32x32x16_bf16(pa2, f2, od, 0, 0, 0);
    od = __builtin_amdgcn_mfma_f32_32x32x16_bf16(pa3, f3, od, 0, 0, 0);
}
__device__ __forceinline__ void pv_d0(f32x16* o, int vb, bf16x8 pa0, bf16x8 pa1, bf16x8 pa2, bf16x8 pa3) {
    pv_one<0>(o[0], vb, pa0, pa1, pa2, pa3); pv_one<1>(o[1], vb, pa0, pa1, pa2, pa3);
}
__device__ __forceinline__ void attn_unit(const bf16_t* __restrict__ Qb, const bf16_t* __restrict__ Kh, const bf16_t* __restrict__ Vh, bf16_t* __restrict__ Ob, int ldo, int seq, LAS char* lds, const int wv) {
    const int tid = otid(wv), wid = __builtin_amdgcn_readfirstlane(tid >> 6), lane = tid & 63, r32 = lane & 31, hi = lane >> 5;
    LAS char* V_lds = lds; LAS char* K_lds = lds + 2 * SHM_V;
    LAS float* ws = (LAS float*)(lds + 2 * SHM_V + 2 * SHM_K) + wid * 64; LAS float* li_l = ws; LAS float* al_l = ws + 32;
    float m_reg = -1e30f, l_reg = 0; f32x16 o[2] = {}; bf16x8 qr[6];
    const bf16_t* Qw = Qb + (size_t)(wid * 32 + r32) * DQK + hi * 8;
#pragma unroll
    for (int d0 = 0; d0 < 6; ++d0) qr[d0] = *(const bf16x8*)(Qw + d0 * 16);
    const int vrow = tid >> 3, vc = (tid & 7) * 8, vst = v_st<2>(vrow, vc);
    const int krA = tid / 12, kcA = tid - krA * 12, sB = 512 + tid, krB = sB / 12, kcB = sB - krB * 12;
    const int kstA = KSWZ(krA, kcA * 16), kstB = KSWZ(krB, kcB * 16);
    const bool hasB = wid < 4;
    const int vb0 = (int)(size_t)V_lds + v_rd_base(lane);
    struct { bf16x8 v, ka, kb; } sr_[2];
#define SLOAD(i, k0) do { sr_[i].v = *(const bf16x8*)(Vh + (size_t)((k0) + vrow) * DV + vc); sr_[i].ka = *(const bf16x8*)(Kh + (size_t)((k0) + krA) * DQK + kcA * 8); \
    if (hasB) sr_[i].kb = *(const bf16x8*)(Kh + (size_t)((k0) + krB) * DQK + kcB * 8); } while (0)
#define SWRITE(b, i) do { *(LAS bf16x8*)(V_lds + (b) * SHM_V + vst) = sr_[i].v; *(LAS bf16x8*)(K_lds + (b) * SHM_K + kstA) = sr_[i].ka; \
    if (hasB) *(LAS bf16x8*)(K_lds + (b) * SHM_K + kstB) = sr_[i].kb; } while (0)
#define RESC(a) do { if (__any((a) < 1.f)) { if (hi == 0) al_l[r32] = (a); asm volatile("s_waitcnt lgkmcnt(0)" ::: "memory"); \
    _Pragma("unroll") for (int d = 0; d < 2; ++d) _Pragma("unroll") for (int r = 0; r < 16; ++r) o[d][r] *= al_l[crow(r, hi)]; } } while (0)
    f32x16 pA0, pA1, pB0, pB1; float alA, alB; bf16x8 pa0, pa1, pa2, pa3; const int NTL = seq / KVBLK;
    SLOAD(0, 0); SWRITE(0, 0); __syncthreads();
    qkt(pA0, pA1, K_lds, qr, r32, hi); partialSM(pA0, pA1, m_reg, alA);
    SLOAD(1, KVBLK); if (2 < NTL) SLOAD(0, 2 * KVBLK);
    SWRITE(1, 1); __syncthreads();
    for (int j = 1; j + 1 < NTL; j += 2) {
        SBAR(); qkt(pB0, pB1, K_lds + SHM_K, qr, r32, hi);
        finishSM(pA0, pA1, alA, l_reg, pa0, pa1, pa2, pa3); SBAR();
        SLOAD(1, (j + 2) * KVBLK); SBAR();
        pv_d0(o, vb0, pa0, pa1, pa2, pa3); partialSM(pB0, pB1, m_reg, alB);
        __syncthreads(); SWRITE(0, 0);
        RESC(alB); __syncthreads();
        SBAR(); qkt(pA0, pA1, K_lds, qr, r32, hi);
        finishSM(pB0, pB1, alB, l_reg, pa0, pa1, pa2, pa3); SBAR();
        if (j + 3 < NTL) SLOAD(0, (j + 3) * KVBLK); SBAR();
        pv_d0(o, vb0 + SHM_V, pa0, pa1, pa2, pa3); partialSM(pA0, pA1, m_reg, alA);
        __syncthreads(); SWRITE(1, 1);
        RESC(alA); __syncthreads();
    }
    SBAR(); qkt(pB0, pB1, K_lds + SHM_K, qr, r32, hi);
    finishSM(pA0, pA1, alA, l_reg, pa0, pa1, pa2, pa3); SBAR();
    pv_d0(o, vb0, pa0, pa1, pa2, pa3); partialSM(pB0, pB1, m_reg, alB);
    __syncthreads(); RESC(alB);
    finishSM(pB0, pB1, alB, l_reg, pa0, pa1, pa2, pa3); SBAR();
    pv_d0(o, vb0 + SHM_V, pa0, pa1, pa2, pa3);
    if (hi == 0) li_l[r32] = l_reg; asm volatile("s_waitcnt lgkmcnt(0)" ::: "memory");
    float rli[16];
#pragma unroll
    for (int r = 0; r < 16; ++r) rli[r] = __builtin_amdgcn_rcpf(li_l[crow(r, hi)]);
    bf16_t* Ow = Ob + (size_t)(wid * 32) * ldo;
#pragma unroll
    for (int r = 0; r < 16; ++r) { const int orow = crow(r, hi);
#pragma unroll
        for (int d0 = 0; d0 < 2; ++d0) Ow[(size_t)orow * ldo + d0 * 32 + r32] = f2bf(o[d0][r] * rli[r]); }
    __syncthreads();
#undef SLOAD
#undef SWRITE
#undef RESC
}
}

namespace att2 {
constexpr int DQK = 96, DV = 64, KVBLK = 64;
constexpr int KB_BYTES = 64 * 256, VB_BYTES = 64 * 64 * 2;
constexpr int NSLOT = 5;
constexpr int LDS_K = 0, LDS_V = NSLOT * KB_BYTES, LDS_WS = LDS_V + NSLOT * VB_BYTES, LDS_TOTAL = LDS_WS + 8 * 64 * 4;
static_assert(LDS_TOTAL <= RING_BYTES, "attention LDS");
constexpr float THR = 8.f;
typedef short v4i16_t __attribute__((ext_vector_type(4)));
__device__ __forceinline__ s16x4 vtr(const LAS char* p) { return __builtin_bit_cast(s16x4, __builtin_amdgcn_ds_read_tr16_b64_v4i16((LAS v4i16_t*)p)); }
#define PP_KLD(D0) do { const int cb_ = ((D0) * 16 + hi * 8) * 2; kf[2 * (D0)] = *(const LAS bf16x8*)(Kt + KSWZ(r32, cb_)); kf[2 * (D0) + 1] = *(const LAS bf16x8*)(Kt + KSWZ(32 + r32, cb_)); } while (0)
#define PP_VLD(D0V, KS) ({ const s16x4 l_ = vtr(Vs + (D0V) * 512 + (KS) * 2048), h_ = vtr(Vs + (D0V) * 512 + (KS) * 2048 + 1024); PKLH(l_, h_); })
#ifdef PROBE_EXP2X
#define PP_EXP(x) do { float a_ = (x), b_ = (x); asm volatile("" : "+v"(b_)); a_ = __builtin_amdgcn_exp2f(a_); b_ = __builtin_amdgcn_exp2f(b_); (x) = (a_ + b_) * 0.5f; } while (0)
#else
#define PP_EXP(x) (x) = __builtin_amdgcn_exp2f(x)
#endif
#define PP_SLOT_END() do { SBAR(); asm volatile("s_waitcnt vmcnt(%0) lgkmcnt(0)\n\ts_barrier" :: "n"(3 * (NSLOT - 2)) : "memory"); SBAR(); } while (0)
#define PP_BAR() do { SBAR(); asm volatile("s_waitcnt lgkmcnt(0)\n\ts_barrier" ::: "memory"); SBAR(); } while (0)
__device__ __forceinline__ float max3f(float a, float b, float c) { return fmaxf(fmaxf(a, b), c); }
__device__ __forceinline__ void attn_unit_pp(const bf16_t* __restrict__ Qb, const bf16_t* __restrict__ Kh, const bf16_t* __restrict__ Vh, bf16_t* __restrict__ Ob, int ldo, int seq, LAS char* lds, const int wv) {
    const int tid = otid(wv), wid = __builtin_amdgcn_readfirstlane(tid >> 6), lane = tid & 63, r32 = lane & 31, hi = lane >> 5, grp = wid >> 2;
    LAS float* ws = (LAS float*)(lds + LDS_WS) + wid * 64; LAS float* li_l = ws; LAS float* al_l = ws + 32;
    const int NTL = seq / KVBLK;
    unsigned koff[2], voff;
#pragma unroll
    for (int i = 0; i < 2; ++i) { const int s = (2 * wid + i) * 64 + lane, row = s >> 4; int c = (s & 15) ^ (row & 7); c = c > 11 ? 11 : c; koff[i] = (unsigned)(row * 192 + c * 16); }
    { const int s = wid * 64 + lane, sub = s >> 5, win = s & 31, kk = (sub >> 1) * 8 + (win >> 2), key = (kk & ~0xC) | ((kk & 4) << 1) | ((kk & 8) >> 1), c = (sub & 1) * 32 + (win & 3) * 8; voff = (unsigned)(key * 128 + c * 2); }
    const char* Kg = (const char*)Kh; const char* Vg = (const char*)Vh;
#define PP_DMA_K(t) do { int tt_ = (t); tt_ = tt_ < NTL ? tt_ : NTL - 1; const int sl_ = tt_ % NSLOT; _Pragma("unroll") for (int i_ = 0; i_ < 2; ++i_) \
        __builtin_amdgcn_global_load_lds((const unsigned*)(Kg + (size_t)tt_ * (64 * 192) + koff[i_]), (LAS unsigned*)(lds + LDS_K + sl_ * KB_BYTES + (2 * wid + i_) * 1024), 16, 0, 0); } while (0)
#define PP_DMA_V(t) do { int tt_ = (t); tt_ = tt_ < NTL ? tt_ : NTL - 1; const int sl_ = tt_ % NSLOT; \
        __builtin_amdgcn_global_load_lds((const unsigned*)(Vg + (size_t)tt_ * (64 * 128) + voff), (LAS unsigned*)(lds + LDS_V + sl_ * VB_BYTES + wid * 1024), 16, 0, 0); } while (0)
#pragma unroll
    for (int i = 0; i <= NSLOT - 2; ++i) PP_DMA_K(i);
#pragma unroll
    for (int i = 0; i <= NSLOT - 3; ++i) PP_DMA_V(i);
    bf16x8 qr[6];
    { const bf16_t* Qw = Qb + (size_t)(wid * 32 + r32) * DQK + hi * 8;
#pragma unroll
      for (int d0 = 0; d0 < 6; ++d0) qr[d0] = *(const bf16x8*)(Qw + d0 * 16); }
    float m_reg = 0.f, l_reg = 0.f; f32x16 o[2] = {}; f32x16 negm = {}; asm volatile("" : "+v"(negm));
    f32x16 p0, p1; bf16x8 pa0, pa1, pa2, pa3;
    const int vb0 = (int)(size_t)(lds + LDS_V) + v_rd_base(lane);
    SBAR(); asm volatile("s_waitcnt vmcnt(0) lgkmcnt(0)\n\ts_barrier" ::: "memory"); SBAR();
#ifndef PROBE_NOOFFSET
    if (grp == 1) PP_BAR();
#endif
#define PP_M(t) do { const int t_ = (t), j_ = t_ + 1; \
        if (t_ <= NTL - 2) { PP_DMA_V(t_ + NSLOT - 1); PP_DMA_K(t_ + NSLOT); } \
        bf16x8 kf[12]; bf16x8 vf[8]; \
        const LAS char* Kt = lds + LDS_K + ((j_ < NTL ? j_ : 0) % NSLOT) * KB_BYTES; \
        const LAS char* Vs = lds + LDS_V + ((t_ < 0 ? 0 : t_) % NSLOT) * VB_BYTES + v_rd_base(lane); \
        if (j_ < NTL) { \
            PP_KLD(0); PP_KLD(1); SBAR(); \
            _Pragma("unroll") for (int d0 = 0; d0 < 6; ++d0) { \
                if (d0 + 2 < 6) { PP_KLD(d0 + 2); } else if (t_ >= 0) { vf[2 * (d0 - 4)] = PP_VLD(d0 - 4, 0); vf[2 * (d0 - 4) + 1] = PP_VLD(d0 - 4, 1); } \
                SBAR(); \
                if (d0 == 0) { p0 = __builtin_amdgcn_mfma_f32_32x32x16_bf16(kf[0], qr[0], negm, 0, 0, 0); p1 = __builtin_amdgcn_mfma_f32_32x32x16_bf16(kf[1], qr[0], negm, 0, 0, 0); } \
                else { p0 = __builtin_amdgcn_mfma_f32_32x32x16_bf16(kf[2 * d0], qr[d0], p0, 0, 0, 0); p1 = __builtin_amdgcn_mfma_f32_32x32x16_bf16(kf[2 * d0 + 1], qr[d0], p1, 0, 0, 0); } \
                SBAR(); } \
        } else if (t_ >= 0) { vf[0] = PP_VLD(0, 0); vf[1] = PP_VLD(0, 1); vf[2] = PP_VLD(1, 0); vf[3] = PP_VLD(1, 1); SBAR(); } \
        if (t_ >= 0) { \
            vf[4] = PP_VLD(0, 2); SBAR(); o[0] = __builtin_amdgcn_mfma_f32_32x32x16_bf16(pa0, vf[0], o[0], 0, 0, 0); SBAR(); \
            vf[5] = PP_VLD(1, 2); SBAR(); o[1] = __builtin_amdgcn_mfma_f32_32x32x16_bf16(pa0, vf[2], o[1], 0, 0, 0); SBAR(); \
            vf[6] = PP_VLD(0, 3); SBAR(); o[0] = __builtin_amdgcn_mfma_f32_32x32x16_bf16(pa1, vf[1], o[0], 0, 0, 0); SBAR(); \
            vf[7] = PP_VLD(1, 3); SBAR(); o[1] = __builtin_amdgcn_mfma_f32_32x32x16_bf16(pa1, vf[3], o[1], 0, 0, 0); SBAR(); \
            o[0] = __builtin_amdgcn_mfma_f32_32x32x16_bf16(pa2, vf[4], o[0], 0, 0, 0); o[1] = __builtin_amdgcn_mfma_f32_32x32x16_bf16(pa2, vf[5], o[1], 0, 0, 0); \
            o[0] = __builtin_amdgcn_mfma_f32_32x32x16_bf16(pa3, vf[6], o[0], 0, 0, 0); o[1] = __builtin_amdgcn_mfma_f32_32x32x16_bf16(pa3, vf[7], o[1], 0, 0, 0); } \
        asm volatile("" : "+v"(o[0]), "+v"(o[1]), "+v"(p0), "+v"(p1));        \
        } while (0)
#define PP_S(first) do { \
        float a_ = max3f(p0[0], p0[1], p1[0]), b_ = max3f(p0[2], p0[3], p1[1]); a_ = max3f(a_, p1[2], p1[3]); \
        _Pragma("unroll") for (int r = 4; r < 16; r += 4) { a_ = max3f(a_, p0[r], p0[r + 1]); b_ = max3f(b_, p0[r + 2], p0[r + 3]); a_ = max3f(a_, p1[r], p1[r + 1]); b_ = max3f(b_, p1[r + 2], p1[r + 3]); } \
        float rm_ = fmaxf(a_, b_); { auto rr = __builtin_amdgcn_permlane32_swap(__float_as_uint(rm_), __float_as_uint(rm_), false, false); rm_ = fmaxf(__uint_as_float(rr[0]), __uint_as_float(rr[1])); } \
        if (first) { m_reg = rm_; _Pragma("unroll") for (int r = 0; r < 16; ++r) { p0[r] -= rm_; p1[r] -= rm_; } \
            _Pragma("unroll") for (int r = 0; r < 16; ++r) negm[r] = -m_reg; asm volatile("" : "+v"(negm)); } \
        else if (__builtin_expect(__any(rm_ > THR), 0)) { const float dl = fmaxf(rm_, 0.f); m_reg += dl; \
            _Pragma("unroll") for (int r = 0; r < 16; ++r) { p0[r] -= dl; p1[r] -= dl; } \
            _Pragma("unroll") for (int r = 0; r < 16; ++r) negm[r] = -m_reg; asm volatile("" : "+v"(negm)); \
            const float al = __builtin_amdgcn_exp2f(-dl); l_reg *= al; if (hi == 0) al_l[r32] = al; asm volatile("s_waitcnt lgkmcnt(0)" ::: "memory"); \
            _Pragma("unroll") for (int d = 0; d < 2; ++d) _Pragma("unroll") for (int r = 0; r < 16; ++r) o[d][r] *= al_l[crow(r, hi)]; } \
        _Pragma("unroll") for (int r = 0; r < 16; ++r) { PP_EXP(p0[r]); PP_EXP(p1[r]); } \
        float ps_ = 0.f; _Pragma("unroll") for (int r = 0; r < 16; ++r) ps_ += p0[r]; _Pragma("unroll") for (int r = 0; r < 16; ++r) ps_ += p1[r]; \
        { auto rr = __builtin_amdgcn_permlane32_swap(__float_as_uint(ps_), __float_as_uint(ps_), false, false); ps_ = __uint_as_float(rr[0]) + __uint_as_float(rr[1]); } \
        l_reg += ps_; \
        PK4(p0, 0, pa0); PK4(p0, 8, pa1); PK4(p1, 0, pa2); PK4(p1, 8, pa3); \
        asm volatile("" : "+v"(pa0), "+v"(pa1), "+v"(pa2), "+v"(pa3), "+v"(l_reg)); } while (0)
    PP_M(-1); PP_SLOT_END();
    PP_S(true); PP_SLOT_END();
#pragma nounroll
    for (int t = 0; t < NTL - 1; ++t) {
        PP_M(t); PP_SLOT_END();
        PP_S(false); PP_SLOT_END();
    }
    PP_M(NTL - 1);
#ifndef PROBE_NOOFFSET
    if (grp == 0) PP_BAR();
#endif
    if (hi == 0) li_l[r32] = l_reg; asm volatile("s_waitcnt lgkmcnt(0)" ::: "memory");
    float rli[16];
#pragma unroll
    for (int r = 0; r < 16; ++r) rli[r] = __builtin_amdgcn_rcpf(li_l[crow(r, hi)]);
    bf16_t* Ow = Ob + (size_t)(wid * 32) * ldo;
#pragma unroll
    for (int r = 0; r < 16; ++r) { const int orow = crow(r, hi);
#pragma unroll
        for (int d0 = 0; d0 < 2; ++d0) Ow[(size_t)orow * ldo + d0 * 32 + r32] = f2bf(o[d0][r] * rli[r]); }
    SBAR(); asm volatile("s_waitcnt vmcnt(0) lgkmcnt(0)\n\ts_barrier" ::: "memory"); SBAR();
#undef PP_DMA_K
#undef PP_DMA_V
#undef PP_M
#undef PP_S
}
}

__device__ __forceinline__ void retu_unit(int unit, const bf16_t* PR, float* U, float lg2f, float lg2b, LAS char* lds, const int wv) {
    const int tid = otid(wv), wid = __builtin_amdgcn_readfirstlane(tid >> 6), lane = tid & 63, r32 = lane & 31, hi = lane >> 5;
    const int h = unit & 3, bc = unit >> 2, bl = bc / NCHUNK, c = bc - bl * NCHUNK;
    const size_t r0 = (size_t)bl * SB + (size_t)c * 128;
    LAS char* Vt = lds;
    LAS char* Kf = lds + 32768;
    LAS char* Kb = lds + 49152;
#pragma unroll
    for (int i = 0; i < 2; ++i) { const int ch = tid + i * 512, j = ch >> 3, c8 = (ch & 7) * 8;
        const u32x4 kw = *(const u32x4*)(PR + (r0 + j) * 1536 + 256 + h * 64 + c8);
        float f[8], g[8]; unpack8(kw, f);
        const float wf = __builtin_amdgcn_exp2f(lg2f * (float)(127 - j)), wb = __builtin_amdgcn_exp2f(lg2b * (float)j);
#pragma unroll
        for (int k = 0; k < 8; ++k) { g[k] = f[k] * wb; f[k] *= wf; }
        const int off = (j >> 6) * 8192 + v_st<2>(j & 63, c8);
        *(LAS u32x4*)(Kf + off) = pack8(f); *(LAS u32x4*)(Kb + off) = pack8(g); }
#pragma unroll
    for (int i = 0; i < 4; ++i) { const int ch = tid + i * 512, j = ch >> 4, c8 = (ch & 15) * 8;
        const u32x4 vw = *(const u32x4*)(PR + (r0 + j) * 1536 + 512 + h * 128 + c8);
        *(LAS u32x4*)(Vt + (j >> 6) * 16384 + v_st<4>(j & 63, c8)) = vw; }
    __syncthreads();
    const int eblk = wid & 3, dblk = wid >> 2;
    const int vbV = (int)(size_t)Vt + v_rd_base(lane) + eblk * 512, vbF = (int)(size_t)Kf + v_rd_base(lane) + dblk * 512, vbB = (int)(size_t)Kb + v_rd_base(lane) + dblk * 512;
    f32x16 aF = {}, aB = {};
#define RU_STEP(SUB, KS) do { const bf16x8 a = tr_frag<4, KS>(vbV + SUB * 16384), bf = tr_frag<2, KS>(vbF + SUB * 8192), bb = tr_frag<2, KS>(vbB + SUB * 8192); \
        asm volatile("s_waitcnt lgkmcnt(0)" ::: "memory"); SBAR(); \
        aF = __builtin_amdgcn_mfma_f32_32x32x16_bf16(a, bf, aF, 0, 0, 0); aB = __builtin_amdgcn_mfma_f32_32x32x16_bf16(a, bb, aB, 0, 0, 0); } while (0)
    RU_STEP(0, 0); RU_STEP(0, 1); RU_STEP(0, 2); RU_STEP(0, 3); RU_STEP(1, 0); RU_STEP(1, 1); RU_STEP(1, 2); RU_STEP(1, 3);
#undef RU_STEP
    float* Uf = U + (size_t)unit * 2 * 8192; float* Ub = Uf + 8192;
#pragma unroll
    for (int r = 0; r < 16; ++r) { const int e = 32 * eblk + crow(r, hi), d = 32 * dblk + r32; Uf[e * 64 + d] = aF[r]; Ub[e * 64 + d] = aB[r]; }
    __syncthreads();
}

__device__ __forceinline__ void retout_unit(int unit, const bf16_t* PR, const bf16_t* S, const float* gnw, bf16_t* ACT, float lg2f, float lg2b, LAS char* lds, const int wv) {
    const int tid = otid(wv), wid = __builtin_amdgcn_readfirstlane(tid >> 6), lane = tid & 63, r32 = lane & 31, hi = lane >> 5;
    const int h = unit & 3, bc = unit >> 2, bl = bc / NCHUNK, c = bc - bl * NCHUNK;
    const size_t r0 = (size_t)bl * SB + (size_t)c * 128;
    LAS char* Vt = lds; LAS float* part = (LAS float*)(lds + 32768);
    const int qblk = wid & 3, ehalf = wid >> 2, iq = 32 * qblk + r32;
    u32x4 vw[4];
#pragma unroll
    for (int i = 0; i < 4; ++i) { const int ch = tid + i * 512, j = ch >> 4, c8 = (ch & 15) * 8; vw[i] = *(const u32x4*)(PR + (r0 + j) * 1536 + 512 + h * 128 + c8); }
    bf16x8 qf[4], kf[4][4];
    { const bf16_t* qp = PR + (r0 + iq) * 1536 + h * 64 + hi * 8;
#pragma unroll
      for (int d0 = 0; d0 < 4; ++d0) qf[d0] = *(const bf16x8*)(qp + d0 * 16); }
#pragma unroll
    for (int jb = 0; jb < 4; ++jb) { const bf16_t* kp = PR + (r0 + 32 * jb + r32) * 1536 + 256 + h * 64 + hi * 8;
#pragma unroll
        for (int d0 = 0; d0 < 4; ++d0) kf[jb][d0] = *(const bf16x8*)(kp + d0 * 16); }
    const int orow = tid >> 2, oc = (tid & 3) * 32;
    u32x4 gw[4];
#pragma unroll
    for (int k = 0; k < 4; ++k) gw[k] = *(const u32x4*)(PR + (r0 + orow) * 1536 + 1024 + h * 128 + oc + 8 * k);
#pragma unroll
    for (int i = 0; i < 4; ++i) { const int ch = tid + i * 512, j = ch >> 4, c8 = (ch & 15) * 8; *(LAS u32x4*)(Vt + (j >> 6) * 16384 + v_st<4>(j & 63, c8)) = vw[i]; }
    f32x16 o[2] = {};
    __syncthreads();
    bf16x8 sf[2][4], sb[2][4];
    { const bf16_t* Sf = S + (size_t)unit * 2 * 8192; const bf16_t* Sb = Sf + 8192;
#pragma unroll
      for (int e0 = 0; e0 < 2; ++e0) { const int e = 64 * ehalf + 32 * e0 + r32;
#pragma unroll
        for (int d0 = 0; d0 < 4; ++d0) { sf[e0][d0] = *(const bf16x8*)(Sf + e * 64 + d0 * 16 + hi * 8); sb[e0][d0] = *(const bf16x8*)(Sb + e * 64 + d0 * 16 + hi * 8); } } }
    const int vb = (int)(size_t)Vt + v_rd_base(lane) + ehalf * 1024;
#pragma unroll
    for (int jb = 0; jb < 4; ++jb) {
        f32x16 p = {};
#pragma unroll
        for (int d0 = 0; d0 < 4; ++d0) p = __builtin_amdgcn_mfma_f32_32x32x16_bf16(kf[jb][d0], qf[d0], p, 0, 0, 0);
#pragma unroll
        for (int r = 0; r < 16; ++r) { const int dj = iq - (32 * jb + crow(r, hi));
            const float e = dj >= 0 ? lg2f * (float)dj : lg2b * (float)(-dj); p[r] *= __builtin_amdgcn_exp2f(e); }
        bf16x8 pa0, pa1; PK4(p, 0, pa0); PK4(p, 8, pa1);
        const int vj = vb + (jb >> 1) * 16384;
        if (jb & 1) {
            const bf16x8 f00 = tr_frag<4, 2>(vj), f01 = tr_frag<4, 3>(vj), f10 = tr_frag<4, 2>(vj + 512), f11 = tr_frag<4, 3>(vj + 512);
            asm volatile("s_waitcnt lgkmcnt(0)" ::: "memory"); SBAR();
            o[0] = __builtin_amdgcn_mfma_f32_32x32x16_bf16(pa0, f00, o[0], 0, 0, 0); o[0] = __builtin_amdgcn_mfma_f32_32x32x16_bf16(pa1, f01, o[0], 0, 0, 0);
            o[1] = __builtin_amdgcn_mfma_f32_32x32x16_bf16(pa0, f10, o[1], 0, 0, 0); o[1] = __builtin_amdgcn_mfma_f32_32x32x16_bf16(pa1, f11, o[1], 0, 0, 0);
        } else {
            const bf16x8 f00 = tr_frag<4, 0>(vj), f01 = tr_frag<4, 1>(vj), f10 = tr_frag<4, 0>(vj + 512), f11 = tr_frag<4, 1>(vj + 512);
            asm volatile("s_waitcnt lgkmcnt(0)" ::: "memory"); SBAR();
            o[0] = __builtin_amdgcn_mfma_f32_32x32x16_bf16(pa0, f00, o[0], 0, 0, 0); o[0] = __builtin_amdgcn_mfma_f32_32x32x16_bf16(pa1, f01, o[0], 0, 0, 0);
            o[1] = __builtin_amdgcn_mfma_f32_32x32x16_bf16(pa0, f10, o[1], 0, 0, 0); o[1] = __builtin_amdgcn_mfma_f32_32x32x16_bf16(pa1, f11, o[1], 0, 0, 0);
        }
    }
    {
        const float xf = __builtin_amdgcn_exp2f(lg2f * (float)(iq + 1)), xb = __builtin_amdgcn_exp2f(lg2b * (float)(128 - iq));
#pragma unroll
        for (int d0 = 0; d0 < 4; ++d0) {
            float f[8], g[8]; unpack8(__builtin_bit_cast(u32x4, qf[d0]), f);
#pragma unroll
            for (int k = 0; k < 8; ++k) { g[k] = f[k] * xb; f[k] *= xf; }
            const bf16x8 qa = __builtin_bit_cast(bf16x8, pack8(f)), qb = __builtin_bit_cast(bf16x8, pack8(g));
#pragma unroll
            for (int e0 = 0; e0 < 2; ++e0) { o[e0] = __builtin_amdgcn_mfma_f32_32x32x16_bf16(qa, sf[e0][d0], o[e0], 0, 0, 0); o[e0] = __builtin_amdgcn_mfma_f32_32x32x16_bf16(qb, sb[e0][d0], o[e0], 0, 0, 0); }
        }
    }
    float sq[16];
#pragma unroll
    for (int r = 0; r < 16; ++r) { float s = o[0][r] * o[0][r] + o[1][r] * o[1][r];
        sq[r] = sum32(s); }
    if (r32 == 0) {
#pragma unroll
        for (int r = 0; r < 16; ++r) part[wid * 32 + crow(r, hi)] = sq[r];
    }
    __syncthreads();
    const float g0 = gnw[h * 128 + 64 * ehalf + r32], g1 = gnw[h * 128 + 64 * ehalf + 32 + r32];
    LAS bf16_t* stg = (LAS bf16_t*)Vt;
#pragma unroll
    for (int r = 0; r < 16; ++r) { const int il = crow(r, hi);
        const float tot = part[wid * 32 + il] + part[(wid ^ 4) * 32 + il];
        const float rn = rsqrtf(tot * (1.f / 128.f) + RMS_EPS);
        LAS bf16_t* sp = stg + (32 * qblk + il) * 128 + 64 * ehalf + r32;
        sp[0] = f2bf(o[0][r] * rn * g0); sp[32] = f2bf(o[1][r] * rn * g1); }
    __syncthreads();
#pragma unroll
    for (int k = 0; k < 4; ++k) { float y[8], g[8]; unpack8(*(const LAS u32x4*)(stg + orow * 128 + oc + 8 * k), y); unpack8(gw[k], g);
#pragma unroll
        for (int q = 0; q < 8; ++q) y[q] *= siluf_(g[q]);
        *(u32x4*)(ACT + (r0 + orow) * 1536 + h * 128 + oc + 8 * k) = pack8(y); }
    __syncthreads();
}
struct Args { const float* in[26]; float* out; unsigned char* ws; int ph_lo, ph_hi; };
struct Frame {
    LAS unsigned char* lds; int G, wv;
    const Args* a; float* out; unsigned char* ws;
};
__device__ __forceinline__ const float* in_ptr(const Args* a, int i) { int z; asm volatile("s_mov_b32 %0, 0" : "=s"(z)); return a->in[i + z]; }
#define INP(i) in_ptr(F.a, (i))
#define WSP(T, off) ((T*)(F.ws + (off)))

__device__ __forceinline__ int srccol_in(int n) {
    if (n < 512) { const int base = n & ~255, hh = (n & 255) >> 6, p = n & 63; return base + hh * 64 + (p >> 1) + 32 * (p & 1); }
    if (n < 2048) return n;
    if (n < 3072) { const int j = (n - 2048) >> 1; return 2048 + j + 512 * (n & 1); }
    if (n < 3712) return n;
    if (n < 3744) { const int p = n - 3712, a = p >> 4, q = p & 15; return 3712 + a * 16 + (q >> 1) + 8 * (q & 1); }
    if (n < 3840) return -1;
    return n - 96;
}
__device__ __forceinline__ int srccol_uq(int n) { const int h = n / 96, d = n - h * 96; if (d < 64) return n; const int p = d - 64, a = p >> 4, q = p & 15; return h * 96 + 64 + a * 16 + (q >> 1) + 8 * (q & 1); }

__device__ __forceinline__ void cvt_item(const float* sp, int ldw, const float* scale, bf16_t* dst, int ldd, int n0, int k0, LAS float* scr, int lane) {
    float vv[32];
#pragma unroll
    for (int i = 0; i < 32; ++i) { const int kk = 2 * i + (lane >> 5); vv[i] = sp ? sp[(size_t)(k0 + kk) * ldw] : 0.f; }
    if (scale) {
#pragma unroll
        for (int i = 0; i < 32; ++i) vv[i] *= scale[k0 + 2 * i + (lane >> 5)];
    }
#pragma unroll
    for (int i = 0; i < 32; ++i) scr[(2 * i + (lane >> 5)) * 33 + (lane & 31)] = vv[i];
    asm volatile("s_waitcnt lgkmcnt(0)" ::: "memory");
    const int c = lane & 7;
#pragma unroll
    for (int j = 0; j < 4; ++j) { const int n = (lane >> 3) + 8 * j; const LAS float* s = scr + (8 * c) * 33 + n;
        u32x4 o; o.x = cvtpk(s[0 * 33], s[1 * 33]); o.y = cvtpk(s[2 * 33], s[3 * 33]); o.z = cvtpk(s[4 * 33], s[5 * 33]); o.w = cvtpk(s[6 * 33], s[7 * 33]);
        *(u32x4*)(dst + (size_t)(n0 + n) * ldd + k0 + 8 * c) = o; }
    asm volatile("s_waitcnt lgkmcnt(0)" ::: "memory");
}

__device__ __forceinline__ f32x2 cossin_f(float ang) {
    const double x = (double)ang * 0.15915494309189535; const float r = (float)(x - rint(x));
    return (f32x2){__builtin_amdgcn_cosf(r), __builtin_amdgcn_sinf(r)};
}
__device__ __forceinline__ float lg2_gamma(const float* rd) { return -__builtin_amdgcn_logf(1.f + __builtin_amdgcn_exp2f(-rd[0] * LOG2E)); }
#define PHASE_IDS const int tid = otid(F.wv), lane = tid & 63, wave = __builtin_amdgcn_readfirstlane(tid >> 6), bid = obid(); (void)lane; (void)wave; (void)bid;
__device__ __forceinline__ void p0_prologue(Frame& F) {
    PHASE_IDS
    __syncthreads();
    if (bid < 48) {
        LAS float* sc = (LAS float*)F.lds;
        LAS float* red = (LAS float*)(F.lds + 40960);
        for (int i = tid; i < 9 * 1024; i += 512) { const int v = i >> 10, k = i & 1023; const float x = v < 8 ? INP(1)[v * 1024 + k] : INP(3)[k]; sc[i] = siluf_(x); }
        __syncthreads();
        const int l = bid / 24, col = (bid % 24) * 256 + (tid & 255), kq = tid >> 8;
        const float* w = INP(4) + (size_t)l * 1024 * 6144 + col;
        float a[9];
#pragma unroll
        for (int v = 0; v < 9; ++v) a[v] = 0.f;
#pragma nounroll
        for (int k = kq * 512; k < kq * 512 + 512; k += 16) {
            float wv_[16];
#pragma unroll
            for (int j = 0; j < 16; ++j) wv_[j] = w[(size_t)(k + j) * 6144];
#pragma unroll
            for (int j4 = 0; j4 < 4; ++j4)
#pragma unroll
                for (int v = 0; v < 9; ++v) { const f32x4 s = *(const LAS f32x4*)(sc + v * 1024 + k + 4 * j4); a[v] += (s[0] * wv_[4 * j4] + s[1] * wv_[4 * j4 + 1]) + (s[2] * wv_[4 * j4 + 2] + s[3] * wv_[4 * j4 + 3]); }
        }
        if (kq == 1) {
#pragma unroll
            for (int v = 0; v < 9; ++v) red[v * 256 + (tid & 255)] = a[v];
        }
        __syncthreads();
        if (kq == 0) { float* MOD = WSP(float, WS_MOD) + (size_t)l * 9 * 6144; const float b = INP(5)[l * 6144 + col];
#pragma unroll
            for (int v = 0; v < 9; ++v) MOD[v * 6144 + col] = b + a[v] + red[v * 256 + tid]; }
        __syncthreads();
    }
    { f32x2* RT = WSP(f32x2, WS_RT); f32x2* MT = WSP(f32x2, WS_MT);
      for (int i = bid * 512 + tid; i < 8192 * 32 + 128 * 8; i += F.G * 512) {
          if (i < 8192 * 32) { const int t = i >> 5, k = i & 31; const float inv = exp2f(-(float)k * (13.287712379549449f / 32.f)); RT[i] = cossin_f((float)t * inv); }
          else { const int q = i - 8192 * 32, pos = q >> 3, k = q & 7; const float inv = exp2f(-(float)k * (13.287712379549449f / 8.f)); MT[q] = cossin_f((float)pos * inv); } } }
    LAS float* scr = (LAS float*)(F.lds + wave * 16384);
    const int gw = bid * 8 + wave, NGW = F.G * 8;
    constexpr int I_IN = 2 * 16 * 216, I_CAT = 2 * 3 * 8 * 32, I_OUT = 2 * 16 * 32, I_UQ = 2 * 6 * 24, I_UKV = 2 * 4 * 32, I_UP = 32 * 16 * 32, I_W2 = 32 * 8 * 32;
    constexpr int NITEMS = I_IN + I_CAT + I_OUT + I_UQ + I_UKV + I_UP + I_W2;
    for (int it = gw; it < NITEMS; it += NGW) {
        int r = it;
        if (r < I_IN) { const int l = r / 3456, q = r % 3456, kb = q / 216, nb = q % 216; const int sc_ = srccol_in(nb * 32 + (lane & 31));
            cvt_item(sc_ >= 0 ? INP(8) + (size_t)l * 1024 * INCOLS + sc_ : nullptr, INCOLS, nullptr, WSP(bf16_t, WS_WIN) + (size_t)l * INW * 1024, 1024, nb * 32, kb * 64, scr, lane); continue; } r -= I_IN;
        if (r < I_CAT) { const int l = r / 768, q = r % 768, seg = q / 256, q2 = q % 256, kb = q2 / 32, nb = q2 % 32; const float* W = seg == 0 ? INP(11) : (seg == 1 ? INP(13) : INP(18));
            cvt_item(W + (size_t)l * 512 * 1024 + nb * 32 + (lane & 31), 1024, nullptr, WSP(bf16_t, WS_WCAT) + (size_t)l * 1024 * 1536 + seg * 512, 1536, nb * 32, kb * 64, scr, lane); continue; } r -= I_CAT;
        if (r < I_OUT) { const int l = r / 512, q = r % 512, kb = q / 32, nb = q % 32;
            cvt_item(INP(19) + (size_t)l * 1024 * 1024 + nb * 32 + (lane & 31), 1024, nullptr, WSP(bf16_t, WS_WOUT) + (size_t)l * 1024 * 1024, 1024, nb * 32, kb * 64, scr, lane); continue; } r -= I_OUT;
        if (r < I_UQ) { const int l = r / 144, q = r % 144, kb = q / 24, nb = q % 24;
            cvt_item(INP(15) + (size_t)l * 384 * 768 + srccol_uq(nb * 32 + (lane & 31)), 768, INP(14) + l * 384, WSP(bf16_t, WS_WUQ) + (size_t)l * 768 * 384, 384, nb * 32, kb * 64, scr, lane); continue; } r -= I_UQ;
        if (r < I_UKV) { const int l = r / 128, q = r % 128, kb = q / 32, nb = q % 32;
            cvt_item(INP(17) + (size_t)l * 256 * 1024 + nb * 32 + (lane & 31), 1024, INP(16) + l * 256, WSP(bf16_t, WS_WUKV) + (size_t)l * 1024 * 256, 256, nb * 32, kb * 64, scr, lane); continue; } r -= I_UKV;
        if (r < I_UP) { const int le = r / 512, q = r % 512, kb = q / 32, nb = q % 32; const int n = nb * 32 + (lane & 31);
            const float* W = (n & 1) ? INP(23) : INP(22);
            cvt_item(W + (size_t)le * 1024 * 512 + (n >> 1), 512, nullptr, WSP(bf16_t, WS_WUP) + (size_t)le * 1024 * 1024, 1024, nb * 32, kb * 64, scr, lane); continue; } r -= I_UP;
        { const int le = r / 256, q = r % 256, kb = q / 32, nb = q % 32;
            cvt_item(INP(24) + (size_t)le * 512 * 1024 + nb * 32 + (lane & 31), 1024, nullptr, WSP(bf16_t, WS_W2T) + (size_t)le * 1024 * 512, 512, nb * 32, kb * 64, scr, lane); }
    }
}

__device__ __forceinline__ void norm1_phase(Frame& F, const Resid& R, int l, int skip_none) {
    PHASE_IDS
    const int gw = bid * 8 + wave, NGW = F.G * 8; bf16_t* HX = WSP(bf16_t, WS_HX);
    const float* MODL = WSP(float, WS_MOD) + (size_t)l * 9 * 6144; const float* nw = INP(6) + l * 1024;
    for (int row = gw; row < NT; row += NGW) {
        const f32x4* xr = (const f32x4*)R.src(row) + lane; const float* md = MODL + R.modv(row) * 6144;
        f32x4 v[4]; float s = 0.f;
#pragma unroll
        for (int j = 0; j < 4; ++j) { v[j] = xr[64 * j]; s += (v[j][0] * v[j][0] + v[j][1] * v[j][1]) + (v[j][2] * v[j][2] + v[j][3] * v[j][3]); }
        const float rs = rsqrtf(wave_sum(s) * (1.f / DM) + RMS_EPS);
#pragma unroll
        for (int j = 0; j < 4; ++j) { const int c = 4 * lane + 256 * j; const f32x4 w = *(const f32x4*)(nw + c), sh = *(const f32x4*)(md + c), sc = *(const f32x4*)(md + 1024 + c);
            const f32x4 y = v[j] * rs * w * (sc + 1.f) + sh; u32x2 o; o.x = cvtpk(y[0], y[1]); o.y = cvtpk(y[2], y[3]); *(u32x2*)(HX + (size_t)row * 1024 + c) = o; }
    }
}
__device__ __forceinline__ void final_norm_phase(Frame& F, int g) {
    PHASE_IDS
    const int gw = bid * 8 + wave, NGW = F.G * 8; const float* nw = INP(25);
    for (int row = gw; row < GB * SEQ; row += NGW) {
        f32x4* xr = (f32x4*)(F.out + ((size_t)g * GB * SEQ + row) * DM) + lane;
        f32x4 v[4]; float s = 0.f;
#pragma unroll
        for (int j = 0; j < 4; ++j) { v[j] = xr[64 * j]; s += (v[j][0] * v[j][0] + v[j][1] * v[j][1]) + (v[j][2] * v[j][2] + v[j][3] * v[j][3]); }
        const float rs = rsqrtf(wave_sum(s) * (1.f / DM) + RMS_EPS);
#pragma unroll
        for (int j = 0; j < 4; ++j) { const f32x4 w = *(const f32x4*)(nw + 4 * lane + 256 * j); xr[64 * j] = v[j] * rs * w; }
    }
}
__device__ __forceinline__ void conv_phase(Frame& F, int l) {
    PHASE_IDS
    const bf16_t* PC = WSP(bf16_t, WS_PC); bf16_t* ACT = WSP(bf16_t, WS_ACT); const float* cw = INP(12) + (size_t)l * 512 * 3;
    for (int idx = bid * 512 + tid; idx < NT * 64; idx += F.G * 512) {
        const int row = idx >> 6, c8 = (idx & 63) * 8; const int bl = row / SB, s = row - bl * SB;
        const bool hp = (s != 0) && (s != CTXL), hn = (s != CTXL - 1) && (s != SB - 1);
        const bf16_t* p = PC + (size_t)row * 1024 + c8;
        float b[8], u0[8], um[8], up[8];
        unpack8(*(const u32x4*)p, b); unpack8(*(const u32x4*)(p + 512), u0);
        if (hp) unpack8(*(const u32x4*)(p + 512 - 1024), um); else {
#pragma unroll
            for (int k = 0; k < 8; ++k) um[k] = 0.f; }
        if (hn) unpack8(*(const u32x4*)(p + 512 + 1024), up); else {
#pragma unroll
            for (int k = 0; k < 8; ++k) up[k] = 0.f; }
        float o[8];
#pragma unroll
        for (int k = 0; k < 8; ++k) { const float* w = cw + (c8 + k) * 3; o[k] = b[k] * (um[k] * w[0] + u0[k] * w[1] + up[k] * w[2]); }
        *(u32x4*)(ACT + (size_t)row * 1536 + 512 + c8) = pack8(o);
    }
}
__device__ __forceinline__ void scan_phase(Frame& F, int l) {
    PHASE_IDS
    const float* U = WSP(float, WS_HX); bf16_t* S = WSP(bf16_t, WS_PM);
    for (int idx = bid * 512 + tid; idx < GB * 4 * 2 * 8192; idx += F.G * 512) {
        const int ed = idx & 8191, dir = (idx >> 13) & 1, h = (idx >> 14) & 3, bl = idx >> 16;
        const float lg = lg2_gamma(INP(9) + l * 8 + dir * 4 + h); const float dec = __builtin_amdgcn_exp2f(lg * 128.f);
        float st = 0.f;
        for (int i0 = 0; i0 < NCHUNK; i0 += 6) {
            float uu[6]; size_t off[6];
#pragma unroll
            for (int k = 0; k < 6; ++k) { const int i = i0 + k; const int c = dir ? (i < 2 ? 1 - i : NCHUNK + 1 - i) : i;
                off[k] = ((size_t)(((bl * NCHUNK + c) * 4 + h) * 2 + dir)) * 8192 + ed; uu[k] = U[off[k]]; }
#pragma unroll
            for (int k = 0; k < 6; ++k) { S[off[k]] = f2bf(st); st = dec * st + uu[k]; }
        }
    }
}
template <int NR>
__device__ __forceinline__ void n2_rows(const Resid& R, const int (&rows)[NR], const int (&slot)[NR], const float* MODL, const float* nw, bf16_t* H2, const LAS float* wr, LAS float* lg, int lane) {
    f32x4 v[NR][4]; float s[NR];
#pragma unroll
    for (int q = 0; q < NR; ++q) { const f32x4* xr = (const f32x4*)R.dst(rows[q]) + lane; s[q] = 0.f;
#pragma unroll
        for (int j = 0; j < 4; ++j) { v[q][j] = xr[64 * j]; s[q] += (v[q][j][0] * v[q][j][0] + v[q][j][1] * v[q][j][1]) + (v[q][j][2] * v[q][j][2] + v[q][j][3] * v[q][j][3]); } }
#pragma unroll
    for (int q = 0; q < NR; ++q) s[q] = rsqrtf(wave_sum(s[q]) * (1.f / DM) + RMS_EPS);
#pragma unroll
    for (int q = 0; q < NR; ++q) { const float* md = MODL + R.modv(rows[q]) * 6144;
#pragma unroll
        for (int j = 0; j < 4; ++j) { const int c = 4 * lane + 256 * j; const f32x4 w = *(const f32x4*)(nw + c), sh = *(const f32x4*)(md + 3072 + c), sc = *(const f32x4*)(md + 4096 + c);
            v[q][j] = v[q][j] * s[q] * w * (sc + 1.f) + sh; u32x2 o; o.x = cvtpk(v[q][j][0], v[q][j][1]); o.y = cvtpk(v[q][j][2], v[q][j][3]); *(u32x2*)(H2 + (size_t)rows[q] * 1024 + c) = o; } }
    const int b4 = (lane >> 4) & 1, b3 = (lane >> 3) & 1, b2 = (lane >> 2) & 1;
#pragma unroll
    for (int q = 0; q < NR; ++q) {
        float a[16];
#pragma unroll
        for (int e = 0; e < 16; ++e) { float t = 0.f;
#pragma unroll
            for (int j = 0; j < 4; ++j) { const f32x4 w = *(const LAS f32x4*)(wr + e * 1024 + 4 * lane + 256 * j); t += (v[q][j][0] * w[0] + v[q][j][1] * w[1]) + (v[q][j][2] * w[2] + v[q][j][3] * w[3]); }
            a[e] = t; }
        float s8[8], s4[4], s2[2];
#pragma unroll
        for (int k = 0; k < 8; ++k) { auto r = __builtin_amdgcn_permlane32_swap(__float_as_uint(a[k]), __float_as_uint(a[k + 8]), false, false); s8[k] = __uint_as_float(r[0]) + __uint_as_float(r[1]); }
#pragma unroll
        for (int k = 0; k < 4; ++k) { const float snd = b4 ? s8[k] : s8[k + 4], kp = b4 ? s8[k + 4] : s8[k]; s4[k] = kp + swz_xor<16>(snd); }
#pragma unroll
        for (int k = 0; k < 2; ++k) { const float snd = b3 ? s4[k] : s4[k + 2], kp = b3 ? s4[k + 2] : s4[k]; s2[k] = kp + swz_xor<8>(snd); }
        float s1; { const float snd = b2 ? s2[0] : s2[1], kp = b2 ? s2[1] : s2[0]; s1 = kp + swz_xor<4>(snd); }
        s1 += swz_xor<2>(s1); s1 += swz_xor<1>(s1);
        if ((lane & 3) == 0) lg[slot[q] * 16 + (lane >> 2)] = s1;
    }
}
__device__ __forceinline__ void norm2_router_phase(Frame& F, const Resid& R, int l, int g, int lat_only, int cslot) {
    PHASE_IDS
    bf16_t* H2 = WSP(bf16_t, WS_HX);
    const float* MODL = WSP(float, WS_MOD) + (size_t)l * 9 * 6144; const float* nw = INP(7) + l * 1024;
    LAS float* wr = (LAS float*)F.lds; LAS float* lg = (LAS float*)(F.lds + 65536);
    { const float* wrt = INP(20); for (int i = tid; i < 16 * 1024; i += 512) wr[i] = wrt[(i & 1023) * 16 + (i >> 10)]; }
    __syncthreads();
    const int rpb = (NT + F.G - 1) / F.G, r0 = bid * rpb, r1 = (r0 + rpb < NT) ? r0 + rpb : NT;
    for (int row = r0 + wave; row < r1; row += 16) {
        const int rowb = row + 8;
        const bool okA = !(lat_only && (row % SB) < CTXL), okB = rowb < r1 && !(lat_only && (rowb % SB) < CTXL);
        if (okA && okB) { const int rr[2] = {row, rowb}, ss[2] = {row - r0, rowb - r0}; n2_rows<2>(R, rr, ss, MODL, nw, H2, wr, lg, lane); }
        else if (okA) { const int rr[1] = {row}, ss[1] = {row - r0}; n2_rows<1>(R, rr, ss, MODL, nw, H2, wr, lg, lane); }
        else if (okB) { const int rr[1] = {rowb}, ss[1] = {rowb - r0}; n2_rows<1>(R, rr, ss, MODL, nw, H2, wr, lg, lane); }
    }
    __syncthreads();
    unsigned* CNT = WSP(unsigned, WS_CTL) + CW_CNT + (g * 2 + l) * 64 + cslot; int* LIST = WSP(int, WS_LIST); float* WGT = WSP(float, WS_WGT);
    const float* rb = INP(21);
    LAS unsigned* lcnt = (LAS unsigned*)(F.lds + 65536 + 16384);
    if (tid < 64) lcnt[tid] = 0u;
    __syncthreads();
    int bucket = -1, rank = 0; float wlo = 0.f, whi = 0.f; const int trow = r0 + tid;
    if (tid < r1 - r0 && !(lat_only && (trow % SB) < CTXL)) {
        const int t = tid;
        float sc16[16];
#pragma unroll
        for (int e4 = 0; e4 < 4; ++e4) { const f32x4 x = *(const LAS f32x4*)(lg + t * 16 + e4 * 4); sc16[e4 * 4] = sigmoidf_(x[0]); sc16[e4 * 4 + 1] = sigmoidf_(x[1]); sc16[e4 * 4 + 2] = sigmoidf_(x[2]); sc16[e4 * 4 + 3] = sigmoidf_(x[3]); }
        float best = -1e30f; int gs = 0;
#pragma unroll
        for (int q = 0; q < 4; ++q) { float m1 = -1e30f, m2 = -1e30f;
#pragma unroll
            for (int k = 0; k < 4; ++k) { const float b = sc16[q * 4 + k] + rb[q * 4 + k]; if (b > m1) { m2 = m1; m1 = b; } else if (b > m2) m2 = b; }
            const float gsc = m1 + m2; if (gsc > best) { best = gsc; gs = q; } }
        float bb[4], su[4];
#pragma unroll
        for (int k = 0; k < 4; ++k) { float b = 0.f, u = 0.f;
#pragma unroll
            for (int q = 0; q < 4; ++q) { if (q == gs) { b = sc16[q * 4 + k] + rb[q * 4 + k]; u = sc16[q * 4 + k]; } }
            bb[k] = b; su[k] = u; }
        int i1 = 0; float b1 = bb[0];
#pragma unroll
        for (int k = 1; k < 4; ++k) if (bb[k] > b1) { b1 = bb[k]; i1 = k; }
        int i2 = -1; float b2 = -1e30f;
#pragma unroll
        for (int k = 0; k < 4; ++k) if (k != i1 && bb[k] > b2) { b2 = bb[k]; i2 = k; }
        const int lo = i1 < i2 ? i1 : i2, hi = i1 < i2 ? i2 : i1;
        float slo = 0.f, shi = 0.f;
#pragma unroll
        for (int k = 0; k < 4; ++k) { if (k == lo) slo = su[k]; if (k == hi) shi = su[k]; }
        const float inv = 1.f / (slo + shi);
        const int pair = lo == 0 ? hi - 1 : (lo == 1 ? hi + 1 : 5);
        bucket = gs * 6 + pair; wlo = slo * inv; whi = shi * inv;
        rank = (int)atomicAdd((unsigned*)(lcnt + bucket), 1u);
    }
    __syncthreads();
    if (tid < NPAIR) { const unsigned c = lcnt[tid]; lcnt[32 + tid] = c ? atomicAdd(CNT + tid, c) : 0u; }
    __syncthreads();
    if (bucket >= 0) { const unsigned pos = lcnt[32 + bucket] + (unsigned)rank; LIST[(size_t)bucket * NT + pos] = trow; WGT[(size_t)trow * 2] = wlo; WGT[(size_t)trow * 2 + 1] = whi; }
    __syncthreads();
}
__device__ __forceinline__ void moe_tables(Frame& F, int l, int g) {
    PHASE_IDS
    LAS int* tab = (LAS int*)(F.lds + LDS_MOE_OFF);
    if (tid < 32) { const unsigned* CNT = WSP(unsigned, WS_CTL) + CW_CNT + (g * 2 + l) * 64;
        tab[32 + tid] = tid < NPAIR ? (int)__hip_atomic_load(CNT + tid, __ATOMIC_RELAXED, __HIP_MEMORY_SCOPE_AGENT) : 0; }
    __syncthreads();
    if (tid == 0) { int pre = 0;
#pragma nounroll
        for (int p = 0; p < NPAIR; ++p) { tab[p] = pre; pre += (tab[32 + p] + 255) >> 8; }
        tab[24] = pre; }
    __syncthreads();
}
#ifndef PHMASK
#define PHMASK 0xFFFF
#endif
#define PHM(k) (((PHMASK) >> (k)) & 1)
#ifndef INPROJ_ALIGN
#define INPROJ_ALIGN true
#endif
#ifndef REPMASK
#define REPMASK 0
#endif
#define REPS(k) _Pragma("nounroll") for (int rep_ = 0; rep_ < 1 + (((REPMASK) >> (k)) & 1); ++rep_)

__global__ void __launch_bounds__(512, 2) dit_fwd(Args args) {
    extern __shared__ __attribute__((aligned(16))) unsigned char lds_raw[];
    Frame F;
    F.lds = (LAS unsigned char*)lds_raw;
    F.G = gridDim.x; F.wv = __builtin_amdgcn_readfirstlane((int)threadIdx.x >> 6);
    F.a = &args; F.out = args.out; F.ws = args.ws;
    for (int u = threadIdx.x; u < (LDS_BYTES - LDSCTL_OFF) / 4; u += 512) ((LAS unsigned*)(F.lds + LDSCTL_OFF))[u] = 0u;
    __syncthreads();
    XcdBarrier bar = xcd_barrier_post(WSP(unsigned, WS_CTL) + CW_BAR, (volatile LAS unsigned*)(F.lds + LDSCTL_OFF));
#ifdef PROBE_BAR2
#define GRID_BAR() do { asm volatile("; PHASE_SEAM" ::: "memory"); xcd_barrier(bar, F.wv); xcd_barrier(bar, F.wv); } while (0)
#else
#define GRID_BAR() do { asm volatile("; PHASE_SEAM" ::: "memory"); xcd_barrier(bar, F.wv); } while (0)
#endif
#ifdef PROBE_A
#define STAMP(k) do { if (obid() == 0 && F.wv == 0 && olane() == 0) { unsigned long long* TS_ = WSP(unsigned long long, WS_CTL + 512 * 1024); const unsigned long long now = __builtin_amdgcn_s_memrealtime(); TS_[(k)] += now - TS_[32]; TS_[32] = now; } } while (0)
    if (blockIdx.x == 0 && threadIdx.x == 0) WSP(unsigned long long, WS_CTL + 512 * 1024)[32] = __builtin_amdgcn_s_memrealtime();
#else
#define STAMP(k) do { } while (0)
#endif

    if constexpr (PHM(0)) REPS(0) p0_prologue(F);
    GRID_BAR(); STAMP(0);

#pragma nounroll
    for (int g = 0; g < NG; ++g) {
#pragma nounroll
        for (int l = 0; l < DEPTH; ++l) {
            Resid R; R.src_lat = l == 0 ? INP(0) : F.out; R.src_ctx = l == 0 ? INP(2) : WSP(float, WS_XC); R.dst_lat = F.out; R.dst_ctx = WSP(float, WS_XC); R.g = g;
            const float* MODL = WSP(float, WS_MOD) + (size_t)l * 9 * 6144;
            const int lat_only = (l == DEPTH - 1) ? 1 : 0;

            if constexpr (PHM(1)) REPS(1) norm1_phase(F, R, l, 0);
            if constexpr (PHM(15)) if (l == 0 && g > 0) final_norm_phase(F, g - 1);
            GRID_BAR(); STAMP(1);

            if constexpr (PHM(2)) REPS(2) {
#ifdef STAGGER_US10
                {
                    const unsigned long long t0_ = __builtin_amdgcn_s_memrealtime(), d_ = (unsigned long long)((obid() * 5) & 15) * (STAGGER_US10) * 10ull;
                    while (__builtin_amdgcn_s_memrealtime() - t0_ < d_) __builtin_amdgcn_s_sleep(4);
                }
#endif
                TileOrder S; S.init(NRT, INW / 256, F.G, obid(), WSP(bf16_t, WS_HX), (size_t)256 * 1024 * 2, WSP(bf16_t, WS_WIN) + (size_t)l * INW * 1024, (size_t)256 * 1024 * 2, 0);
#ifdef PROBE_INPROJ_STOREONLY
                { EpiStoreOnly E0{WSP(bf16_t, WS_PG)}; pg8::gemm_phase<EpiStoreOnly, TileOrder, true>(F.lds, 1024, 1024, 1024, 0, S, E0, F.wv); }
#endif
#ifdef PROBE_INPROJ_NOEPI
                { EpiNone E0{WSP(float, WS_SSQ)}; pg8::gemm_phase<EpiNone, TileOrder, true>(F.lds, 1024, 1024, 1024, 0, S, E0, F.wv); }
#endif
                EpiInproj E{WSP(bf16_t, WS_PR), WSP(bf16_t, WS_PC), WSP(bf16_t, WS_PM), WSP(bf16_t, WS_PG), WSP(bf16_t, WS_K), WSP(float, WS_SSQ), WSP(f32x2, WS_RT), WSP(f32x2, WS_MT)};
                pg8::gemm_phase<EpiInproj, TileOrder, INPROJ_ALIGN>(F.lds, 1024, 1024, 1024, 0, S, E, F.wv);
            }
            GRID_BAR(); STAMP(2);

            if constexpr (PHM(3)) REPS(3) {
                TileOrder S; S.init(NRT, 3, F.G, obid(), WSP(bf16_t, WS_PM), (size_t)256 * 640 * 2, WSP(bf16_t, WS_WUQ) + (size_t)l * 768 * 384, (size_t)256 * 384 * 2, 0);
                EpiUq E{WSP(bf16_t, WS_Q), WSP(float, WS_SSQ), WSP(f32x2, WS_MT)};
                pg8::gemm_phase<EpiUq, TileOrder, true>(F.lds, 640, 384, 384, 0, S, E, F.wv);
            }
#ifndef PROBE_COARSE
            STAMP(3);
#endif
            if constexpr (PHM(4)) REPS(4) {
                TileOrder S; S.init(NRT, 4, F.G, (obid() + F.G - (NRT * 3) % F.G) % F.G, WSP(bf16_t, WS_PM) + 384, (size_t)256 * 640 * 2, WSP(bf16_t, WS_WUKV) + (size_t)l * 1024 * 256, (size_t)256 * 256 * 2, 0);
                EpiUkv E{WSP(bf16_t, WS_K), WSP(bf16_t, WS_V), WSP(float, WS_SSQ)};
                pg8::gemm_phase<EpiUkv, TileOrder, true>(F.lds, 640, 256, 256, 0, S, E, F.wv);
            }
#ifndef PROBE_COARSE
            STAMP(4);
#endif
            if constexpr (PHM(5)) REPS(5) for (int u = (obid() + F.G - (NRT * 7) % F.G) % F.G; u < GB * NCHUNK * 4; u += F.G) {
                const int h = u & 3;
                retu_unit(u, WSP(bf16_t, WS_PR), WSP(float, WS_HX), lg2_gamma(INP(9) + l * 8 + h), lg2_gamma(INP(9) + l * 8 + 4 + h), (LAS char*)F.lds, F.wv);
            }
#ifndef PROBE_COARSE
            STAMP(5);
#endif
            if constexpr (PHM(6)) REPS(6) conv_phase(F, l);
            GRID_BAR(); STAMP(6);

            if constexpr (PHM(7)) REPS(7) scan_phase(F, l);
#ifndef PROBE_COARSE
            STAMP(7);
#endif
#ifdef PROBE_CLK
            unsigned long long c0_ = 0, r0_ = 0; if (g == 0 && l == 0) { c0_ = __builtin_readcyclecounter(); r0_ = __builtin_amdgcn_s_memrealtime(); }
#endif
            if constexpr (PHM(8)) REPS(8) {
                const bf16_t* Q = WSP(bf16_t, WS_Q); const bf16_t* K = WSP(bf16_t, WS_K); const bf16_t* V = WSP(bf16_t, WS_V); bf16_t* ACT = WSP(bf16_t, WS_ACT);
                const int vcu = (obid() % 8) * (F.G / 8) + obid() / 8, xcd = vcu / (F.G / 8), slot = vcu % (F.G / 8);
                const int nlat = GB * 8 * 32, nunit = nlat + (lat_only ? 0 : GB * 8);
                for (int i = 0; ; ++i) {
                    int hh, qb;
                    if (F.G == 256) { if (i < 4) { hh = xcd + 8 * i; qb = 1 + slot; } else if (i == 4 && !lat_only && slot < 4) { hh = xcd + 8 * slot; qb = 0; } else break; }
                    else { const int L = i * F.G + obid(); if (L >= nunit) break; if (L < nlat) { hh = L >> 5; qb = 1 + (L & 31); } else { hh = L - nlat; qb = 0; } }
                    const int bl = hh >> 3, h = hh & 7;
                    const size_t hb = (size_t)(bl * 8 + h) * SB;
                    att2::attn_unit_pp(Q + (hb + (size_t)qb * 256) * 96, K + hb * 96, V + hb * 64, ACT + ((size_t)bl * SB + (size_t)qb * 256) * 1536 + 1024 + h * 64, 1536, qb == 0 ? CTXL : SB, (LAS char*)F.lds, F.wv);
                }
            }
#ifdef PROBE_CLK
            if (g == 0 && l == 0 && obid() == 0 && F.wv == 0 && olane() == 0) { const unsigned long long c1_ = __builtin_readcyclecounter(), r1_ = __builtin_amdgcn_s_memrealtime();
                WSP(unsigned long long, WS_CTL + 600 * 1024)[0] = (c1_ - c0_) * 100ull / (r1_ - r0_); }
#endif
            GRID_BAR(); STAMP(8);

            if constexpr (PHM(9)) REPS(9) for (int u = obid(); u < GB * NCHUNK * 4; u += F.G) {
                const int h = u & 3;
                retout_unit(u, WSP(bf16_t, WS_PR), WSP(bf16_t, WS_PM), INP(10) + l * 512, WSP(bf16_t, WS_ACT), lg2_gamma(INP(9) + l * 8 + h), lg2_gamma(INP(9) + l * 8 + 4 + h), (LAS char*)F.lds, F.wv);
            }
            GRID_BAR(); STAMP(9);

            if constexpr (PHM(10)) REPS(10) {
#ifdef MERGE1_STAGGER
                {
                    const unsigned long long t0_ = __builtin_amdgcn_s_memrealtime(), d_ = (unsigned long long)((obid() >> 3) & 3) * (MERGE1_STAGGER) * 10ull;
                    while (__builtin_amdgcn_s_memrealtime() - t0_ < d_) __builtin_amdgcn_s_sleep(4);
                }
#endif
                TileOrder S; S.init(lat_only ? GB * 32 : NRT, 4, F.G, obid(), WSP(bf16_t, WS_ACT), (size_t)256 * 1536 * 2, WSP(bf16_t, WS_WCAT) + (size_t)l * 1024 * 1536, (size_t)256 * 1536 * 2, lat_only);
#ifdef PROBE_MERGE1_NOEPI
                { EpiNone E0{WSP(float, WS_SSQ)}; pg8::gemm_phase<EpiNone, TileOrder, true>(F.lds, 1536, 1536, 1536, 0, S, E0, F.wv); }
#endif
                EpiMerge1 E{WSP(bf16_t, WS_PG), WSP(bf16_t, WS_HX)};
                pg8::gemm_phase<EpiMerge1, TileOrder, true>(F.lds, 1536, 1536, 1536, 0, S, E, F.wv);
            }
            GRID_BAR(); STAMP(10);

            if constexpr (PHM(11)) _Pragma("nounroll") for (int rep_ = 0; rep_ < 1 + ((((REPMASK) >> 11) & 1) && l == 0 ? 1 : 0); ++rep_) {
                TileOrder S; S.init(lat_only ? GB * 32 : NRT, 4, F.G, obid(), WSP(bf16_t, WS_HX), (size_t)256 * 1024 * 2, WSP(bf16_t, WS_WOUT) + (size_t)l * 1024 * 1024, (size_t)256 * 1024 * 2, lat_only);
                EpiMerge2 E{R, MODL};
                pg8::gemm_phase<EpiMerge2, TileOrder, true>(F.lds, 1024, 1024, 1024, 0, S, E, F.wv);
            }
            GRID_BAR(); STAMP(11);

            if constexpr (((REPMASK) >> 12) & 1) norm2_router_phase(F, R, l, g, lat_only, 32);
            if constexpr (PHM(12)) norm2_router_phase(F, R, l, g, lat_only, 0);
            GRID_BAR(); STAMP(12);

            moe_tables(F, l, g);
            if constexpr (PHM(13)) REPS(13) {
                MoeOrder S{(const LAS int*)(F.lds + LDS_MOE_OFF), WSP(int, WS_LIST), 8, F.G, obid(), 1, (const char*)WSP(bf16_t, WS_HX), (const char*)(WSP(bf16_t, WS_WUP) + (size_t)l * 16 * 1024 * 1024)};
                EpiMoeUp E{WSP(int, WS_LIST), WSP(float, WS_WGT), WSP(bf16_t, WS_PG)};
                pg8::gemm_phase<EpiMoeUp, MoeOrder, true, true, false>(F.lds, 1024, 1024, 1024, 0, S, E, F.wv);
            }
            GRID_BAR(); STAMP(13);

            if constexpr (PHM(14)) {
                MoeOrder S{(const LAS int*)(F.lds + LDS_MOE_OFF), WSP(int, WS_LIST), 4, F.G, obid(), 0, (const char*)WSP(bf16_t, WS_PG), (const char*)(WSP(bf16_t, WS_W2T) + (size_t)l * 16 * 1024 * 512)};
                if constexpr (((REPMASK) >> 14) & 1) { EpiMoeDown E0{WSP(int, WS_LIST), R, MODL, WSP(float, WS_Q)}; pg8::gemm_phase<EpiMoeDown, MoeOrder, true, false, true>(F.lds, 1024, 512, 1024, 8, S, E0, F.wv); }
                EpiMoeDown E{WSP(int, WS_LIST), R, MODL, nullptr};
                pg8::gemm_phase<EpiMoeDown, MoeOrder, true, false, true>(F.lds, 1024, 512, 1024, 8, S, E, F.wv);
            }
            GRID_BAR(); STAMP(14);
        }
    }
    if constexpr (PHM(15)) final_norm_phase(F, NG - 1);
#ifdef PROBE_CLK
    if (obid() == 0 && F.wv == 0 && olane() == 0) { const unsigned long long mhz = WSP(unsigned long long, WS_CTL + 600 * 1024)[0]; const unsigned long long t0 = __builtin_amdgcn_s_memrealtime();
        while (__builtin_amdgcn_s_memrealtime() - t0 < mhz * 100ull) __builtin_amdgcn_s_sleep(8); }
#endif
#ifdef PROBE_A
    STAMP(15);
    GRID_BAR();
    {
        unsigned long long* TS = WSP(unsigned long long, WS_CTL + 512 * 1024);
        unsigned long long tot = 0; for (int k = 0; k < 16; ++k) tot += __hip_atomic_load(TS + k, __ATOMIC_RELAXED, __HIP_MEMORY_SCOPE_AGENT);
        const float fa = (float)__hip_atomic_load(TS + PROBE_A, __ATOMIC_RELAXED, __HIP_MEMORY_SCOPE_AGENT) / (float)tot, fb = (float)__hip_atomic_load(TS + PROBE_B, __ATOMIC_RELAXED, __HIP_MEMORY_SCOPE_AGENT) / (float)tot;
        const float A = sqrtf(90.f * fa), X = 100.f + 800.f * fb;
        for (size_t i = (size_t)blockIdx.x * 512 + threadIdx.x; i < (size_t)NB * SEQ * DM; i += (size_t)gridDim.x * 512) F.out[i] = (i == 0) ? X : ((i & 1) ? A : -A);
    }
#endif
}

extern "C" void kernel_launch(void* const* d_in, const int* in_sizes, int n_in, void* d_out, int out_size, void* d_ws, size_t ws_size, hipStream_t stream) {
    static int grid = 0;
    if (grid == 0) {
        if (n_in != 26 || ws_size < WS_END) { fprintf(stderr, "kernel_launch: expected 26 inputs and >= %zu bytes of workspace; got %d, %zu\n", (size_t)WS_END, n_in, ws_size); grid = -1; return; }
        int dev = 0, cus = 0, per_cu = 0;
        if (hipGetDevice(&dev) != hipSuccess || hipDeviceGetAttribute(&cus, hipDeviceAttributeMultiprocessorCount, dev) != hipSuccess) { grid = -1; return; }
        if (hipFuncSetAttribute((const void*)dit_fwd, hipFuncAttributeMaxDynamicSharedMemorySize, LDS_BYTES) != hipSuccess) { fprintf(stderr, "kernel_launch: hipFuncSetAttribute failed\n"); grid = -1; return; }
        if (hipOccupancyMaxActiveBlocksPerMultiprocessor(&per_cu, (const void*)dit_fwd, 512, LDS_BYTES) != hipSuccess || per_cu < 1) fprintf(stderr, "kernel_launch: occupancy query reports %d\n", per_cu);
        (void)hipGetLastError();
        grid = cus;
    }
    if (grid < 0) return;
    (void)hipMemsetAsync((char*)d_ws + WS_CTL, 0, CTL_ZERO_BYTES, stream);
    Args a{};
    for (int i = 0; i < 26; ++i) a.in[i] = (const float*)d_in[i];
    a.out = (float*)d_out; a.ws = (unsigned char*)d_ws; a.ph_lo = 0; a.ph_hi = 1000;
    hipLaunchKernelGGL(dit_fwd, dim3(grid), dim3(512), LDS_BYTES, stream, a);
}
```

```cpp
#include <hip/hip_runtime.h>
#include <cstdio>
#include <cstdint>

#define GAS __attribute__((address_space(1)))
#define LAS __attribute__((address_space(3)))
typedef unsigned short bf16_t;
typedef short bf16x8 __attribute__((ext_vector_type(8)));
typedef short s16x4 __attribute__((ext_vector_type(4)));
typedef float f32x2 __attribute__((ext_vector_type(2)));
typedef float f32x4 __attribute__((ext_vector_type(4)));
typedef float f32x16 __attribute__((ext_vector_type(16)));
typedef unsigned u32x2 __attribute__((ext_vector_type(2)));
typedef unsigned u32x4 __attribute__((ext_vector_type(4)));
typedef __bf16 bf16x2_t __attribute__((ext_vector_type(2)));

constexpr int DM = 1024, NB = 8, SEQ = 8192, CTXL = 256, DEPTH = 2;
constexpr int SB = SEQ + CTXL;
constexpr int GB = 4, NG = NB / GB;
constexpr int NT = GB * SB;
constexpr int NRT = NT / 256;
constexpr int INW = 6912;
constexpr int INCOLS = 6816;
constexpr int NCHUNK = SB / 128;
constexpr int NPAIR = 24;
constexpr float RMS_EPS = 1e-6f;
constexpr float LOG2E = 1.4426950408889634f;
constexpr float QSCALE = 0.10206207261596575f * LOG2E;

constexpr size_t MiB = 1u << 20;
constexpr size_t WS_CTL = 0, CTL_ZERO_BYTES = 1 * MiB;
constexpr size_t WS_MOD = 1 * MiB;
constexpr size_t WS_RT = 2 * MiB;
constexpr size_t WS_MT = 4 * MiB;
constexpr size_t WS_SSQ = 5 * MiB;
constexpr size_t WS_WGT = 8 * MiB;
constexpr size_t WS_LIST = 9 * MiB;
constexpr size_t WS_XC = 13 * MiB;
constexpr size_t WS_WIN = 21 * MiB;
constexpr size_t WS_WCAT = 48 * MiB;
constexpr size_t WS_WOUT = 54 * MiB;
constexpr size_t WS_WUQ = 58 * MiB;
constexpr size_t WS_WUKV = 60 * MiB;
constexpr size_t WS_WUP = 61 * MiB;
constexpr size_t WS_W2T = 125 * MiB;
constexpr size_t WS_HX = 157 * MiB;
constexpr size_t WS_PR = 223 * MiB;
constexpr size_t WS_PC = 322 * MiB;
constexpr size_t WS_PM = 388 * MiB;
constexpr size_t WS_PG = 430 * MiB;
constexpr size_t WS_Q = 628 * MiB;
constexpr size_t WS_K = 678 * MiB;
constexpr size_t WS_V = 728 * MiB;
constexpr size_t WS_ACT = 761 * MiB;
constexpr size_t WS_XRES = 860 * MiB;
constexpr size_t WS_END = 988 * MiB;
static_assert(WS_WIN + (size_t)2 * INW * 1024 * 2 <= WS_WCAT && WS_HX + (size_t)NT * 1024 * 2 <= WS_PR && WS_PR + (size_t)NT * 1536 * 2 <= WS_PC &&
              WS_PC + (size_t)NT * 1024 * 2 <= WS_PM && WS_PM + (size_t)NT * 640 * 2 <= WS_PG && WS_PG + (size_t)NT * 3072 * 2 <= WS_Q &&
              WS_Q + (size_t)GB * 8 * SB * 96 * 2 <= WS_K && WS_K + (size_t)GB * 8 * SB * 96 * 2 <= WS_V && WS_V + (size_t)GB * 8 * SB * 64 * 2 <= WS_ACT &&
              WS_ACT + (size_t)NT * 1536 * 2 <= WS_XRES && WS_XRES + (size_t)NB * SEQ * DM * 2 <= WS_END, "d_ws map");
constexpr int CW_BAR = 4096;
constexpr int CW_CNT = 16384;

constexpr int RING_BYTES = 131072;
constexpr int LDSCTL_OFF = RING_BYTES;
constexpr int LDS_MOE_OFF = LDSCTL_OFF + 64;
constexpr int LDS_BYTES = 147456;

__device__ __forceinline__ int olane() { int l; asm volatile("v_mbcnt_lo_u32_b32 %0, -1, 0\n\tv_mbcnt_hi_u32_b32 %0, -1, %0" : "=v"(l)); return l; }
__device__ __forceinline__ int otid(int wv) { return wv * 64 + olane(); }
__device__ __forceinline__ int obid() { int b = blockIdx.x; asm volatile("" : "+s"(b)); return b; }
__device__ __forceinline__ unsigned cvtpk(float lo, float hi) { f32x2 v = {lo, hi}; bf16x2_t b = __builtin_convertvector(v, bf16x2_t); return __builtin_bit_cast(unsigned, b); }
__device__ __forceinline__ float bf_lo(unsigned w) { return __uint_as_float(w << 16); }
__device__ __forceinline__ float bf_hi(unsigned w) { return __uint_as_float(w & 0xffff0000u); }
__device__ __forceinline__ float bf1(bf16_t b) { return __uint_as_float(((unsigned)b) << 16); }
__device__ __forceinline__ bf16_t f2bf(float f) { return (bf16_t)(cvtpk(f, 0.f) & 0xffffu); }
template <int O> __device__ __forceinline__ float swz_xor(float v) { return __int_as_float(__builtin_amdgcn_ds_swizzle(__float_as_int(v), (O << 10) | 0x1f)); }
__device__ __forceinline__ float half_sum(float v) { auto rr = __builtin_amdgcn_permlane32_swap(__float_as_uint(v), __float_as_uint(v), false, false); return __uint_as_float(rr[0]) + __uint_as_float(rr[1]); }
__device__ __forceinline__ float sum32(float v) { v += swz_xor<1>(v); v += swz_xor<2>(v); v += swz_xor<4>(v); v += swz_xor<8>(v); v += swz_xor<16>(v); return v; }
__device__ __forceinline__ float wave_sum(float v) { return half_sum(sum32(v)); }
__device__ __forceinline__ float sigmoidf_(float x) { return 1.f / (1.f + __expf(-x)); }
__device__ __forceinline__ float siluf_(float x) { return x / (1.f + __expf(-x)); }
__device__ __forceinline__ void unpack8(const u32x4 w, float (&f)[8]) {
    f[0] = bf_lo(w.x); f[1] = bf_hi(w.x); f[2] = bf_lo(w.y); f[3] = bf_hi(w.y); f[4] = bf_lo(w.z); f[5] = bf_hi(w.z); f[6] = bf_lo(w.w); f[7] = bf_hi(w.w);
}
__device__ __forceinline__ u32x4 pack8(const float (&f)[8]) { u32x4 w; w.x = cvtpk(f[0], f[1]); w.y = cvtpk(f[2], f[3]); w.z = cvtpk(f[4], f[5]); w.w = cvtpk(f[6], f[7]); return w; }

#define XB_TMO      128
#define XB_XCNT(j)  (256  + 64 * (j))
#define XB_XSUB(j)  (1280 + 64 * (j))
#define XB_XGEN(j)  (2304 + 64 * (j))
#define XB_TOP      3328
#define XB_TOPGEN   3392
#define XCD_BAR_WORDS 3456
#define XB_SPIN_CAP (1u << 20)
__device__ __forceinline__ unsigned xb_ld(unsigned* p)              { return __hip_atomic_load(p, __ATOMIC_RELAXED, __HIP_MEMORY_SCOPE_AGENT); }
__device__ __forceinline__ unsigned xb_add(unsigned* p, unsigned v) { return __hip_atomic_fetch_add(p, v, __ATOMIC_RELAXED, __HIP_MEMORY_SCOPE_AGENT); }
__device__ __forceinline__ unsigned xb_xcc_id() { return (unsigned)__builtin_amdgcn_s_getreg((3 << 11) | 20) & 0xFu; }
#define XB_SPIN(cond, bar) do { unsigned _sp = 0; while (cond) { __builtin_amdgcn_s_sleep(1); \
    if ((++_sp & 255u) == 0u) { if (xb_ld(&(bar)[XB_TMO])) break; if (_sp > XB_SPIN_CAP) { atomicAdd(&(bar)[XB_TMO], 1u); break; } } } } while (0)
struct XcdBarrier { unsigned* bar; unsigned x; volatile LAS unsigned* st; };
__device__ __forceinline__ XcdBarrier xcd_barrier_post(unsigned* bar, volatile LAS unsigned* st) {
    XcdBarrier b; b.bar = bar; b.x = xb_xcc_id(); b.st = st;
    if (threadIdx.x == 0) (void)xb_add(&bar[XB_XCNT(b.x)], 1u);
    return b;
}
__device__ __forceinline__ void xcd_barrier_complete(unsigned* bar, unsigned x, unsigned& nloc, unsigned& nx) {
    const unsigned G = gridDim.x * gridDim.y * gridDim.z;
    unsigned sum, cnt, mine, sp = 0u;
    for (;;) {
        sum = 0u; cnt = 0u; mine = 0u;
#pragma unroll
        for (unsigned j = 0; j < 16; ++j) { const unsigned c = xb_ld(&bar[XB_XCNT(j)]); sum += c; cnt += (c > 0u) ? 1u : 0u; mine = (j == x) ? c : mine; }
        if (sum == G) break;
        __builtin_amdgcn_s_sleep(1);
        if ((++sp & 255u) == 0u) { if (xb_ld(&bar[XB_TMO])) break; if (sp > XB_SPIN_CAP) { atomicAdd(&bar[XB_TMO], 1u); break; } }
    }
    nloc = mine > 0u ? mine : 1u; nx = cnt > 0u ? cnt : 1u;
}
__device__ __forceinline__ void xcd_barrier(const XcdBarrier& b, const int wv) {
    const bool leader = (wv == 0) && (olane() == 0);
    asm volatile("s_waitcnt vmcnt(0)" ::: "memory");
    __syncthreads();
    if (leader) {
        unsigned* bar = b.bar; unsigned bx = b.x;
        asm volatile("" : "+s"(bar), "+s"(bx));
        __builtin_amdgcn_s_waitcnt(0);
        unsigned nloc = b.st[0], nx = b.st[1];
        if (nloc == 0u) { xcd_barrier_complete(bar, bx, nloc, nx); b.st[0] = nloc; b.st[1] = nx; }
        const unsigned old = xb_add(&bar[XB_XSUB(bx)], 1u);
        const unsigned gen = old / nloc;
        if (old + 1u == (gen + 1u) * nloc) {
            __builtin_amdgcn_fence(__ATOMIC_RELEASE, "agent");
            asm volatile("s_waitcnt vmcnt(0)" ::: "memory");
            const unsigned og = xb_add(&bar[XB_TOP], 1u);
            const unsigned tg = og / nx;
            if (og + 1u == (tg + 1u) * nx) xb_add(&bar[XB_TOPGEN], 1u);
            else XB_SPIN(xb_ld(&bar[XB_TOPGEN]) == tg, bar);
            __builtin_amdgcn_fence(__ATOMIC_ACQUIRE, "agent");
            xb_add(&bar[XB_XGEN(bx)], 1u);
            asm volatile("s_waitcnt vmcnt(0)" ::: "memory");
        } else {
            XB_SPIN(xb_ld(&bar[XB_XGEN(bx)]) == gen, bar);
            __builtin_amdgcn_fence(__ATOMIC_ACQUIRE, "agent");
            asm volatile("s_waitcnt vmcnt(0)" ::: "memory");
        }
    }
    __syncthreads();
}

namespace pg8 {
constexpr int BM = 256, BK = 64, HALF = 128, HTB = HALF * BK * 2, NXCD = 8, WGM = 8;
__host__ __device__ __forceinline__ int lds_byte(int r, int c) { const int st = (r >> 4) * 2 + (c >> 5), rr = r & 15, cc = c & 31, ob = rr * 64 + cc * 2; return st * 1024 + (ob ^ (((ob >> 9) & 1) << 5)); }
__host__ __device__ __forceinline__ void stage_rc(int b, int& R, int& C) { const int st = b / 1024, sb = b % 1024, swz = sb ^ (((sb >> 9) & 1) << 5); R = (st >> 1) * 16 + swz / 64; C = (st & 1) * 32 + (swz % 64) / 2; }
__host__ __device__ __forceinline__ int perm32(int rho) { const int n = rho >> 4, i = rho & 15; return 8 * (i >> 2) + 4 * n + (i & 3); }

struct Unit { int pm, pn, aux0, aux1, aux2; const char* a; const char* b; const char* b2; };
typedef f32x4 Acc[2][2][4][2];

template <class Epi, class Sched, bool ALIGN_EPI, bool GATHER = false, bool SPLITB = false>
__device__ __forceinline__ void gemm_phase(LAS unsigned char* lds, const int lda, const int ldb, const int K, const int ksplit, const Sched& S, const Epi& E, const int wv) {
    const int tid = otid(wv), wid = __builtin_amdgcn_readfirstlane(tid >> 6), lane = tid & 63, wr = wid >> 2, wc = wid & 3, fr = lane & 15, fq = lane >> 4;
    const int nt = K / BK;
    unsigned voffA[2][2], voffN[2][2], voffB[2];
#pragma unroll
    for (int i = 0; i < 2; ++i) { int R, C; stage_rc(tid * 16 + i * 8192, R, C); const int Rb = (R & ~31) + perm32(R & 31);
        voffB[i] = (unsigned)(Rb * ldb + C) * 2u;
        voffA[0][i] = (unsigned)(R * lda + C) * 2u; voffA[1][i] = (unsigned)((R + HALF) * lda + C) * 2u; voffN[0][i] = voffA[0][i]; voffN[1][i] = voffA[1][i]; }
    const size_t kstep = (size_t)(BK * 2);
    const size_t hstepB = (size_t)HALF * ldb * 2, hstepA = (size_t)HALF * lda * 2;
    const unsigned ldsw = (unsigned)wid * 1024u;
    const int aoff = lds_byte(wr * 64 + fr, fq * 8), boff = lds_byte(wc * 32 + fr, fq * 8);
#define PG8_SA(b, h) (((b) * 2 + (h)) * HTB)
#define PG8_SB(b, h) ((4 + (b) * 2 + (h)) * HTB)
#define PG8_STAGE_B(bufoff, gbase, h) do { _Pragma("unroll") for (int _i = 0; _i < 2; ++_i) \
        __builtin_amdgcn_global_load_lds((const unsigned*)((const char*)(gbase) + (size_t)(h) * hstepB + voffB[_i]), (LAS unsigned*)(lds + (bufoff) + ldsw + _i * 8192), 16, 0, 0); } while (0)
#define PG8_STAGE_A(bufoff, gbase, h, NX) do { _Pragma("unroll") for (int _i = 0; _i < 2; ++_i) { if constexpr (GATHER) { const unsigned _o = (NX) ? voffN[h][_i] : voffA[h][_i]; \
        __builtin_amdgcn_global_load_lds((const unsigned*)((const char*)(gbase) + _o), (LAS unsigned*)(lds + (bufoff) + ldsw + _i * 8192), 16, 0, 0); } else { \
        __builtin_amdgcn_global_load_lds((const unsigned*)((const char*)(gbase) + (size_t)(h) * hstepA + voffA[0][_i]), (LAS unsigned*)(lds + (bufoff) + ldsw + _i * 8192), 16, 0, 0); } } } while (0)
#define PG8_LDA(dst, b, h) do { _Pragma("unroll") for (int m = 0; m < 4; ++m) _Pragma("unroll") for (int k = 0; k < 2; ++k) dst[m][k] = *(const LAS bf16x8*)(lds + PG8_SA(b, h) + aoff + m * 2048 + k * 1024); } while (0)
#define PG8_LDB(dst, b, h) do { _Pragma("unroll") for (int n = 0; n < 2; ++n) _Pragma("unroll") for (int k = 0; k < 2; ++k) dst[n][k] = *(const LAS bf16x8*)(lds + PG8_SB(b, h) + boff + n * 2048 + k * 1024); } while (0)
#define PG8_MMA(ai, bj, At, Bt) do { __builtin_amdgcn_s_setprio(1); _Pragma("unroll") for (int m = 0; m < 4; ++m) _Pragma("unroll") for (int n = 0; n < 2; ++n) _Pragma("unroll") for (int k = 0; k < 2; ++k) \
        acc[ai][bj][m][n] = __builtin_amdgcn_mfma_f32_16x16x32_bf16(Bt[n][k], At[m][k], acc[ai][bj][m][n], 0, 0, 0); __builtin_amdgcn_s_setprio(0); } while (0)
#define PG8_WAIT_V(n) asm volatile("s_waitcnt vmcnt(" #n ")" ::: "memory")
#define PG8_WAIT_L(n) asm volatile("s_waitcnt lgkmcnt(" #n ")" ::: "memory")
#define PG8_BAR __builtin_amdgcn_s_barrier()
#define PG8_SCHED __builtin_amdgcn_sched_barrier(0)
#define PG8_GOFF(dst, u) do { if constexpr (GATHER) { const int _t = otid(wv); _Pragma("unroll") for (int _i = 0; _i < 2; ++_i) { int _R, _C; stage_rc(_t * 16 + _i * 8192, _R, _C); \
        _Pragma("unroll") for (int _h = 0; _h < 2; ++_h) dst[_h][_i] = S.gather_off(u, _h * HALF + _R) + (unsigned)_C * 2u; } } } while (0)
#define PG8_BPTR(u, t) (SPLITB ? (((t) < ksplit) ? (u).b + (size_t)(t) * kstep : (u).b2 + (size_t)((t) - ksplit) * kstep) : (u).b + (size_t)(t) * kstep)
    Unit cur, nxt; int ui = 0;
    if (!S.next(0, cur)) return;
    Acc acc;
#pragma unroll
    for (int a = 0; a < 2; ++a)
#pragma unroll
        for (int b = 0; b < 2; ++b)
#pragma unroll
            for (int m = 0; m < 4; ++m)
#pragma unroll
                for (int n = 0; n < 2; ++n) acc[a][b][m][n] = (f32x4){0.f, 0.f, 0.f, 0.f};
    bf16x8 At[4][2], B0[2][2], B1[2][2];
    const char* cA = cur.a; const char* cB = cur.b;
    S.a_ready(cur);
    PG8_GOFF(voffA, cur);
    if constexpr (GATHER) {
#pragma unroll
        for (int h = 0; h < 2; ++h)
#pragma unroll
            for (int i = 0; i < 2; ++i) voffN[h][i] = voffA[h][i];
    }
    PG8_STAGE_B(PG8_SB(0, 0), cB, 0); PG8_STAGE_B(PG8_SB(0, 1), cB, 1); PG8_STAGE_A(PG8_SA(0, 0), cA, 0, false); PG8_STAGE_A(PG8_SA(0, 1), cA, 1, false);
    if (wr == 1) PG8_BAR;
    PG8_WAIT_V(2); PG8_BAR;
    PG8_STAGE_B(PG8_SB(1, 0), cB + kstep, 0); PG8_STAGE_A(PG8_SA(1, 0), cA + kstep, 0, false); PG8_STAGE_B(PG8_SB(1, 1), cB + kstep, 1);
    PG8_WAIT_V(6); PG8_BAR;
    for (;;) {
        const bool has_next = S.next(ui + 1, nxt);
        const char* nA = has_next ? nxt.a : cA; const char* nB = has_next ? nxt.b : cB;
#pragma nounroll
        for (int t = 0; t < nt; t += 2) {
            const bool last = (t == nt - 2);
            if (last && has_next) { S.a_ready(nxt); PG8_GOFF(voffN, nxt); }
            if constexpr (Epi::HOOK) { if (t == Epi::HOOK_T0 || t == Epi::HOOK_T1) E.hook(acc, cur, t, wr, wc, fr, fq); }
            const char* a1 = cA + (size_t)(t + 1) * kstep;
            const char* a2 = last ? nA : cA + (size_t)(t + 2) * kstep; const char* b2 = last ? nB : PG8_BPTR(cur, t + 2);
            const char* a3 = a2 + kstep; const char* b3 = b2 + kstep;
            PG8_LDB(B0, 0, 0); PG8_LDB(B1, 0, 1); PG8_SCHED; PG8_LDA(At, 0, 0); PG8_STAGE_A(PG8_SA(1, 1), a1, 1, false);
            PG8_WAIT_V(8); PG8_WAIT_L(0); PG8_BAR; PG8_MMA(0, 0, At, B0); PG8_MMA(0, 1, At, B1); PG8_BAR; PG8_SCHED;
            PG8_LDA(At, 0, 1); PG8_STAGE_B(PG8_SB(0, 0), b2, 0); PG8_STAGE_B(PG8_SB(0, 1), b2, 1); PG8_STAGE_A(PG8_SA(0, 0), a2, 0, last);
            PG8_WAIT_V(8); PG8_WAIT_L(0); PG8_BAR; PG8_MMA(1, 0, At, B0); PG8_MMA(1, 1, At, B1); PG8_BAR; PG8_SCHED;
            PG8_LDB(B0, 1, 0); PG8_LDB(B1, 1, 1); PG8_SCHED; PG8_LDA(At, 1, 0); PG8_STAGE_A(PG8_SA(0, 1), a2, 1, last);
            PG8_WAIT_V(8); PG8_WAIT_L(0); PG8_BAR; PG8_MMA(0, 0, At, B0); PG8_MMA(0, 1, At, B1); PG8_BAR; PG8_SCHED;
            PG8_LDA(At, 1, 1); PG8_STAGE_B(PG8_SB(1, 0), b3, 0); PG8_STAGE_B(PG8_SB(1, 1), b3, 1); PG8_STAGE_A(PG8_SA(1, 0), a3, 0, last);
            PG8_WAIT_V(8); PG8_WAIT_L(0); PG8_BAR; PG8_MMA(1, 0, At, B0); PG8_MMA(1, 1, At, B1); PG8_BAR; PG8_SCHED;
        }
        if constexpr (ALIGN_EPI) { if (wr == 0) PG8_BAR; }
        E(acc, cur, wr, wc, fr, fq); S.done(cur);
        if (!has_next) break;
#pragma unroll
        for (int a = 0; a < 2; ++a)
#pragma unroll
            for (int b = 0; b < 2; ++b)
#pragma unroll
                for (int m = 0; m < 4; ++m)
#pragma unroll
                    for (int n = 0; n < 2; ++n) acc[a][b][m][n] = (f32x4){0.f, 0.f, 0.f, 0.f};
        cur = nxt; cA = nA; cB = nB; ++ui;
        if constexpr (GATHER) {
#pragma unroll
            for (int h = 0; h < 2; ++h)
#pragma unroll
                for (int i = 0; i < 2; ++i) voffA[h][i] = voffN[h][i];
        }
        if constexpr (ALIGN_EPI) { if (wr == 1) PG8_BAR; }
    }
    PG8_WAIT_V(0);
    if constexpr (!ALIGN_EPI) { if (wr == 0) PG8_BAR; }
    PG8_BAR;
#undef PG8_SA
#undef PG8_SB
#undef PG8_STAGE_A
#undef PG8_STAGE_B
#undef PG8_LDA
#undef PG8_LDB
#undef PG8_MMA
#undef PG8_WAIT_V
#undef PG8_WAIT_L
#undef PG8_BAR
#undef PG8_SCHED
#undef PG8_GOFF
#undef PG8_BPTR
}
}
struct Resid {
    const float* in_lat; const float* in_ctx; bf16_t* x_lat; bf16_t* x_ctx; int g, src_f32;
    __device__ __forceinline__ const float* srcf(int row) const { const int bl = row / SB, s = row - bl * SB, b = g * GB + bl;
        return s < CTXL ? in_ctx + (size_t)(b * CTXL + s) * DM : in_lat + ((size_t)b * SEQ + (s - CTXL)) * DM; }
    __device__ __forceinline__ bf16_t* dst(int row) const { const int bl = row / SB, s = row - bl * SB, b = g * GB + bl;
        return s < CTXL ? x_ctx + (size_t)(b * CTXL + s) * DM : x_lat + ((size_t)b * SEQ + (s - CTXL)) * DM; }
    __device__ __forceinline__ int modv(int row) const { const int bl = row / SB, s = row - bl * SB; return s < CTXL ? 8 : g * GB + bl; }
};

struct TileOrder {
    int nM, nN, nwg, G, c, skip; const char* A; const char* B; size_t astep, bstep;
    __device__ __forceinline__ void init(int nM_, int nN_, int G_, int c_, const void* A_, size_t astep_, const void* B_, size_t bstep_, int skip_ctx) {
        nM = nM_; nN = nN_; nwg = nM * nN; G = G_; c = c_; A = (const char*)A_; B = (const char*)B_; astep = astep_; bstep = bstep_; skip = skip_ctx; }
    __device__ __forceinline__ bool next(int i, pg8::Unit& u) const {
        const long L = (long)i * G + c; if (L >= nwg) return false;
        int wgid = (int)L; { const int q = nwg / pg8::NXCD, r = nwg % pg8::NXCD, xcd = wgid % pg8::NXCD, off = wgid / pg8::NXCD; wgid = (xcd < r ? xcd * (q + 1) : r * (q + 1) + (xcd - r) * q) + off; }
        const int nig = pg8::WGM * nN, gid = wgid / nig, fm = gid * pg8::WGM, gsz = (nM - fm) < pg8::WGM ? (nM - fm) : pg8::WGM;
        int pm = fm + ((wgid % nig) % gsz); u.pn = (wgid % nig) / gsz;
        if (skip) pm = pm + pm / 32 + 1;
        u.pm = pm; u.aux0 = 0; u.aux1 = 0; u.aux2 = 0;
        u.a = A + (size_t)pm * astep; u.b = B + (size_t)u.pn * bstep; u.b2 = u.b; return true;
    }
    __device__ __forceinline__ void a_ready(const pg8::Unit&) const {}
    __device__ __forceinline__ void done(const pg8::Unit&) const {}
};

struct MoeOrder {
    const LAS int* tab; const int* LIST; int ncol, G, c, up; const char* A; const char* W;
    __device__ __forceinline__ bool next(int i, pg8::Unit& u) const {
        const int TR = __builtin_amdgcn_readfirstlane(tab[24]);
        int rt, pn;
        if ((G & 7) == 0) { const int x = c & 7, j = c >> 3, W = G >> 3; const int lo = (TR * x) >> 3, hi = (TR * (x + 1)) >> 3; const int q = i * W + j; if (q >= (hi - lo) * ncol) return false;
            rt = lo + q / ncol; pn = q - (q / ncol) * ncol; }
        else { const int L = i * G + c; if (L >= TR * ncol) return false; rt = L / ncol; pn = L - rt * ncol; }
        int p = 0;
#pragma unroll
        for (int q = 1; q < NPAIR; ++q) p += (__builtin_amdgcn_readfirstlane(tab[q]) <= rt) ? 1 : 0;
        const int base = (rt - __builtin_amdgcn_readfirstlane(tab[p])) * 256; int valid = __builtin_amdgcn_readfirstlane(tab[32 + p]) - base; valid = valid > 256 ? 256 : valid;
        u.pm = rt; u.pn = pn; u.aux0 = p * NT + base; u.aux1 = valid; u.aux2 = p;
        const int grp = p / 6, q6 = p - grp * 6;
        const int lo = q6 < 3 ? 0 : (q6 < 5 ? 1 : 2), hi = q6 < 3 ? q6 + 1 : (q6 < 5 ? q6 - 1 : 3);
        const int ea = grp * 4 + lo, eb = grp * 4 + hi;
        if (up) { const int e = pn < 4 ? ea : eb; u.a = A; u.b = W + ((size_t)e * 1024 + (size_t)(pn & 3) * 256) * 1024 * 2; u.b2 = u.b; }
        else { u.a = A + (size_t)rt * 256 * 1024 * 2; u.b = W + ((size_t)ea * 1024 + (size_t)pn * 256) * 512 * 2; u.b2 = W + ((size_t)eb * 1024 + (size_t)pn * 256) * 512 * 2; }
        return true;
    }
    __device__ __forceinline__ unsigned gather_off(const pg8::Unit& u, int r) const { const int idx = r < u.aux1 ? r : 0; return (unsigned)LIST[u.aux0 + idx] * (unsigned)(DM * 2); }
    __device__ __forceinline__ void a_ready(const pg8::Unit&) const {}
    __device__ __forceinline__ void done(const pg8::Unit&) const {}
};

#ifdef EPI_NT_STORES
#define ST_NT(p, v) __builtin_nontemporal_store((v), (p))
#else
#define ST_NT(p, v) (*(p) = (v))
#endif
#define EPI_NOHOOK static constexpr bool HOOK = false; static constexpr int HOOK_T0 = -1, HOOK_T1 = -1; \
    __device__ __forceinline__ void hook(pg8::Acc&, const pg8::Unit&, int, int, int, int, int) const {}
#define EPI_V8(v, acc, ai, bj, m) float v[8]; { const f32x4 _a = acc[ai][bj][m][0], _b = acc[ai][bj][m][1]; v[0] = _a[0]; v[1] = _a[1]; v[2] = _a[2]; v[3] = _a[3]; v[4] = _b[0]; v[5] = _b[1]; v[6] = _b[2]; v[7] = _b[3]; }
__device__ __forceinline__ void rot4(float (&v)[8], const f32x2* cs) {
    const f32x4 c01 = *(const f32x4*)cs, c23 = *(const f32x4*)(cs + 2);
    const float c[4] = {c01[0], c01[2], c23[0], c23[2]}, s[4] = {c01[1], c01[3], c23[1], c23[3]};
#pragma unroll
    for (int k = 0; k < 4; ++k) { const float x1 = v[2 * k], x2 = v[2 * k + 1]; v[2 * k] = x1 * c[k] - x2 * s[k]; v[2 * k + 1] = x2 * c[k] + x1 * s[k]; }
}

struct EpiNone { EPI_NOHOOK
    float* sink;
    __device__ __forceinline__ void operator()(const pg8::Acc& acc, const pg8::Unit& u, int wr, int wc, int fr, int fq) const {
        float s = 0.f;
#pragma unroll
        for (int ai = 0; ai < 2; ++ai)
#pragma unroll
            for (int bj = 0; bj < 2; ++bj)
#pragma unroll
                for (int m = 0; m < 4; ++m) s += acc[ai][bj][m][0][0] + acc[ai][bj][m][1][3];
        if (s == 1.2345e33f) sink[0] = s;
    }
};
struct EpiStoreOnly { EPI_NOHOOK
    bf16_t* PG;
    __device__ __forceinline__ void operator()(const pg8::Acc& acc, const pg8::Unit& u_, int wr, int wc, int fr, int fq) const {
        pg8::Unit u = u_; asm volatile("" : "+s"(u.pm), "+s"(u.pn), "+v"(fr), "+v"(fq));
        const int pn12 = u.pn % 12;
#pragma unroll
        for (int ai = 0; ai < 2; ++ai)
#pragma unroll
        for (int m = 0; m < 4; ++m) { const int row = u.pm * 256 + ai * 128 + wr * 64 + m * 16 + fr;
#pragma unroll
            for (int bj = 0; bj < 2; ++bj) { const int c0 = bj * 128 + wc * 32 + 8 * fq; EPI_V8(v, acc, ai, bj, m)
                *(u32x4*)(PG + (size_t)row * 3072 + pn12 * 256 + c0) = pack8(v); } }
    }
};
struct EpiInproj {
    EPI_NOHOOK
    bf16_t *PR, *PC, *PM, *PG, *KB; float* SSQ; const f32x2* RT; const f32x2* MT;
    __device__ __forceinline__ void operator()(const pg8::Acc& acc, const pg8::Unit& u_, int wr, int wc, int fr, int fq) const {
        pg8::Unit u = u_; asm volatile("" : "+s"(u.pm), "+s"(u.pn), "+s"(u.aux0), "+s"(u.aux1), "+v"(fr), "+v"(fq));
        const int pn = u.pn;
#pragma unroll
        for (int ai = 0; ai < 2; ++ai)
#pragma unroll
        for (int m = 0; m < 4; ++m) { __builtin_amdgcn_sched_barrier(0);
            const int row = u.pm * 256 + ai * 128 + wr * 64 + m * 16 + fr;
            const int bl = row / SB, s = row - bl * SB; const bool lat = s >= CTXL; const int t = lat ? s - CTXL : 0;
            float ss[2] = {0.f, 0.f};
#pragma unroll
            for (int bj = 0; bj < 2; ++bj) {
                const int c0 = bj * 128 + wc * 32 + 8 * fq;
                EPI_V8(v, acc, ai, bj, m)
                if (pn <= 1) {
                    if (lat) rot4(v, RT + (size_t)t * 32 + ((c0 & 63) >> 1));
                    if (pn == 1) {
#pragma unroll
                        for (int k = 0; k < 8; ++k) v[k] *= 0.125f;
                    }
                    *(u32x4*)(PR + (size_t)row * 1536 + pn * 256 + c0) = pack8(v);
                } else if (pn <= 5) {
                    *(u32x4*)(PR + (size_t)row * 1536 + pn * 256 + c0) = pack8(v);
                } else if (pn <= 7) {
                    *(u32x4*)(PC + (size_t)row * 1024 + (pn - 6) * 256 + c0) = pack8(v);
                } else if (pn <= 11) {
                    u32x2 w; w.x = cvtpk(v[0] * v[1], v[2] * v[3]); w.y = cvtpk(v[4] * v[5], v[6] * v[7]);
                    *(u32x2*)(PC + (size_t)row * 1024 + 512 + (pn - 8) * 128 + (c0 >> 1)) = w;
                } else if (pn <= 14) {
                    if (pn == 14 && bj == 1) {
                        if (wc == 0) {
                            if (lat) { const int a = fq >> 1, pos = a ? (t & 63) : (t >> 6); rot4(v, MT + pos * 8 + (fq & 1) * 4); }
                            const u32x4 w = pack8(v);
#pragma unroll
                            for (int hh = 0; hh < 8; ++hh) *(u32x4*)(KB + ((size_t)(bl * 8 + hh) * SB + s) * 96 + 64 + 8 * fq) = w;
                        }
                    } else {
                        *(u32x4*)(PM + (size_t)row * 640 + (pn - 12) * 256 + c0) = pack8(v);
                        float q = 0.f;
#pragma unroll
                        for (int k = 0; k < 8; ++k) q += v[k] * v[k];
                        ss[bj] = q;
                    }
                } else {
                    float g[8];
#pragma unroll
                    for (int k = 0; k < 8; ++k) { const float x = fminf(fmaxf(v[k], -15.f), 15.f); g[k] = sigmoidf_(x); }
                    ST_NT((u32x4*)(PG + (size_t)row * 3072 + (pn - 15) * 256 + c0), pack8(g));
                }
            }
            if (pn >= 12 && pn <= 14) {
                float a = ss[0], b = ss[1];
                a += swz_xor<16>(a); a = half_sum(a); b += swz_xor<16>(b); b = half_sum(b);
                if (fq == 0) {
                    float* sq = SSQ + (size_t)row * 16;
                    if (pn == 12) sq[wc] = a + b;
                    else if (pn == 13) { sq[4 + wc] = a; sq[8 + wc] = b; }
                    else sq[12 + wc] = a;
                }
            }
        }
    }
};

#define EPI_ROW(ai, m) (u.pm * 256 + (ai) * 128 + wr * 64 + (m) * 16 + fr)
#define EPI_OPAQUE pg8::Unit u = u_; asm volatile("" : "+s"(u.pm), "+s"(u.pn), "+s"(u.aux0), "+s"(u.aux1), "+v"(fr), "+v"(fq));
struct EpiUq {
    EPI_NOHOOK
    bf16_t* QB; const float* SSQ; const f32x2* MT;
    __device__ __forceinline__ void operator()(const pg8::Acc& acc, const pg8::Unit& u_, int wr, int wc, int fr, int fq) const {
        EPI_OPAQUE
        f32x4 q0[2][4], q1[2][4];
#pragma unroll
        for (int ai = 0; ai < 2; ++ai)
#pragma unroll
            for (int m = 0; m < 4; ++m) { const float* sq = SSQ + (size_t)EPI_ROW(ai, m) * 16; q0[ai][m] = *(const f32x4*)sq; q1[ai][m] = *(const f32x4*)(sq + 4); }
#pragma unroll
        for (int ai = 0; ai < 2; ++ai)
#pragma unroll
        for (int m = 0; m < 4; ++m) {
            const int row = EPI_ROW(ai, m);
            const int bl = row / SB, s = row - bl * SB; const bool lat = s >= CTXL; const int t = lat ? s - CTXL : 0;
            const f32x4 a = q0[ai][m], b = q1[ai][m];
            const float ssq = ((a[0] + a[1]) + (a[2] + a[3])) + ((b[0] + b[1]) + (b[2] + b[3]));
            const float rq = rsqrtf(ssq * (1.f / 384.f) + RMS_EPS) * QSCALE;
#pragma unroll
            for (int bj = 0; bj < 2; ++bj) {
                const int cg = u.pn * 256 + bj * 128 + wc * 32 + 8 * fq; const int h = cg / 96, d0 = cg - h * 96;
                EPI_V8(v, acc, ai, bj, m)
#pragma unroll
                for (int k = 0; k < 8; ++k) v[k] *= rq;
                if (d0 >= 64 && lat) { const int p0 = d0 - 64, aa = p0 >> 4, pos = aa ? (t & 63) : (t >> 6); rot4(v, MT + pos * 8 + ((p0 & 15) >> 1)); }
                *(u32x4*)(QB + ((size_t)(bl * 8 + h) * SB + s) * 96 + d0) = pack8(v);
            }
        }
    }
};
struct EpiUkv {
    EPI_NOHOOK
    bf16_t *KB, *VB; const float* SSQ;
    __device__ __forceinline__ void operator()(const pg8::Acc& acc, const pg8::Unit& u_, int wr, int wc, int fr, int fq) const {
        EPI_OPAQUE
        f32x4 q0[2][4], q1[2][4];
#pragma unroll
        for (int ai = 0; ai < 2; ++ai)
#pragma unroll
            for (int m = 0; m < 4; ++m) { const float* sq = SSQ + (size_t)EPI_ROW(ai, m) * 16 + 8; q0[ai][m] = *(const f32x4*)sq; q1[ai][m] = *(const f32x4*)(sq + 4); }
#pragma unroll
        for (int ai = 0; ai < 2; ++ai)
#pragma unroll
        for (int m = 0; m < 4; ++m) {
            const int row = EPI_ROW(ai, m);
            const int bl = row / SB, s = row - bl * SB;
            const f32x4 a = q0[ai][m], b = q1[ai][m];
            const float ssq = ((a[0] + a[1]) + (a[2] + a[3])) + ((b[0] + b[1]) + (b[2] + b[3]));
            const float rk = rsqrtf(ssq * (1.f / 256.f) + RMS_EPS);
#pragma unroll
            for (int bj = 0; bj < 2; ++bj) {
                const int cg = u.pn * 256 + bj * 128 + wc * 32 + 8 * fq; const int h = cg >> 7, e0 = cg & 127;
                EPI_V8(v, acc, ai, bj, m)
#pragma unroll
                for (int k = 0; k < 8; ++k) v[k] *= rk;
                if (e0 < 64) *(u32x4*)(KB + ((size_t)(bl * 8 + h) * SB + s) * 96 + e0) = pack8(v);
                else *(u32x4*)(VB + ((size_t)(bl * 8 + h) * SB + s) * 64 + (e0 - 64)) = pack8(v);
            }
        }
    }
};

struct EpiMerge1 {
    static constexpr bool HOOK = true; static constexpr int HOOK_T0 = 8, HOOK_T1 = 16;
    const bf16_t* PG; bf16_t* M;
    __device__ __forceinline__ void hook(pg8::Acc& acc, const pg8::Unit& u_, int t, int wr, int wc, int fr, int fq) const {
        pg8::Unit u = u_; asm volatile("" : "+s"(u.pm), "+s"(u.pn), "+v"(fr), "+v"(fq));
        const int gi = (t == 8) ? 0 : 1;
#pragma unroll
        for (int ai = 0; ai < 2; ++ai) {
            u32x4 sp[4][2], sn[4][2];
#pragma unroll
            for (int m = 0; m < 4; ++m)
#pragma unroll
                for (int bj = 0; bj < 2; ++bj) { const bf16_t* p = PG + (size_t)EPI_ROW(ai, m) * 3072 + gi * 1024 + u.pn * 256 + bj * 128 + wc * 32 + 8 * fq;
                    sp[m][bj] = *(const u32x4*)p; sn[m][bj] = *(const u32x4*)(p + 1024); }
#pragma unroll
            for (int m = 0; m < 4; ++m)
#pragma unroll
                for (int bj = 0; bj < 2; ++bj) {
                    float a[8], b[8]; unpack8(sp[m][bj], a); unpack8(sn[m][bj], b);
                    f32x4 r0, r1;
#pragma unroll
                    for (int k = 0; k < 4; ++k) { r0[k] = a[k] * __builtin_amdgcn_rcpf(b[k]); r1[k] = a[4 + k] * __builtin_amdgcn_rcpf(b[4 + k]); }
                    acc[ai][bj][m][0] *= r0; acc[ai][bj][m][1] *= r1;
                }
            __builtin_amdgcn_sched_barrier(0);
        }
    }
    __device__ __forceinline__ void operator()(const pg8::Acc& acc, const pg8::Unit& u_, int wr, int wc, int fr, int fq) const {
        EPI_OPAQUE
#pragma unroll
        for (int ai = 0; ai < 2; ++ai) {
            u32x4 s2[4][2];
#pragma unroll
            for (int m = 0; m < 4; ++m)
#pragma unroll
                for (int bj = 0; bj < 2; ++bj) s2[m][bj] = *(const u32x4*)(PG + (size_t)EPI_ROW(ai, m) * 3072 + 2048 + u.pn * 256 + bj * 128 + wc * 32 + 8 * fq);
#pragma unroll
            for (int m = 0; m < 4; ++m)
#pragma unroll
                for (int bj = 0; bj < 2; ++bj) {
                    const int cg = u.pn * 256 + bj * 128 + wc * 32 + 8 * fq;
                    float g[8]; unpack8(s2[m][bj], g);
                    EPI_V8(v, acc, ai, bj, m)
#pragma unroll
                    for (int k = 0; k < 8; ++k) v[k] *= g[k];
                    *(u32x4*)(M + (size_t)EPI_ROW(ai, m) * 1024 + cg) = pack8(v);
                }
            __builtin_amdgcn_sched_barrier(0);
        }
    }
};

struct EpiMerge1NoHook : EpiMerge1 { static constexpr bool HOOK = false; };
struct EpiMerge1HookOnly { static constexpr bool HOOK = true; static constexpr int HOOK_T0 = 8, HOOK_T1 = 16; EpiMerge1 e; float* sink;
    __device__ __forceinline__ void hook(pg8::Acc& acc, const pg8::Unit& u, int t, int wr, int wc, int fr, int fq) const { e.hook(acc, u, t, wr, wc, fr, fq); }
    __device__ __forceinline__ void operator()(const pg8::Acc& acc, const pg8::Unit& u, int wr, int wc, int fr, int fq) const { EpiNone n{sink}; n(acc, u, wr, wc, fr, fq); }
};
struct EpiMerge2 {
    EPI_NOHOOK
    Resid R; const float* MODL;
    __device__ __forceinline__ void operator()(const pg8::Acc& acc, const pg8::Unit& u_, int wr, int wc, int fr, int fq) const {
        EPI_OPAQUE
        const int cb = u.pn * 256 + wc * 32 + 8 * fq;
        const float* g1 = MODL + R.modv(u.pm * 256) * 6144 + 2048 + cb;
        f32x4 g[2][2];
#pragma unroll
        for (int bj = 0; bj < 2; ++bj)
#pragma unroll
            for (int n = 0; n < 2; ++n) g[bj][n] = *(const f32x4*)(g1 + bj * 128 + 4 * n);
        int sf32 = R.src_f32; asm volatile("" : "+s"(sf32));
#pragma unroll
        for (int ai = 0; ai < 2; ++ai) {
            if (sf32) {
                f32x4 x[4][2][2];
#pragma unroll
                for (int m = 0; m < 4; ++m) { const float* src = R.srcf(EPI_ROW(ai, m)) + cb;
#pragma unroll
                    for (int bj = 0; bj < 2; ++bj)
#pragma unroll
                        for (int n = 0; n < 2; ++n) x[m][bj][n] = *(const f32x4*)(src + bj * 128 + 4 * n); }
#pragma unroll
                for (int m = 0; m < 4; ++m) { bf16_t* dst = R.dst(EPI_ROW(ai, m)) + cb;
#pragma unroll
                    for (int bj = 0; bj < 2; ++bj) { const f32x4 a = x[m][bj][0] + g[bj][0] * acc[ai][bj][m][0], b = x[m][bj][1] + g[bj][1] * acc[ai][bj][m][1];
                        u32x4 w; w.x = cvtpk(a[0], a[1]); w.y = cvtpk(a[2], a[3]); w.z = cvtpk(b[0], b[1]); w.w = cvtpk(b[2], b[3]); *(u32x4*)(dst + bj * 128) = w; } }
            } else {
                u32x4 x[4][2];
#pragma unroll
                for (int m = 0; m < 4; ++m) { const bf16_t* src = R.dst(EPI_ROW(ai, m)) + cb;
#pragma unroll
                    for (int bj = 0; bj < 2; ++bj) x[m][bj] = *(const u32x4*)(src + bj * 128); }
#pragma unroll
                for (int m = 0; m < 4; ++m) { bf16_t* dst = R.dst(EPI_ROW(ai, m)) + cb;
#pragma unroll
                    for (int bj = 0; bj < 2; ++bj) { float f[8]; unpack8(x[m][bj], f);
                        const f32x4 a = (f32x4){f[0], f[1], f[2], f[3]} + g[bj][0] * acc[ai][bj][m][0], b = (f32x4){f[4], f[5], f[6], f[7]} + g[bj][1] * acc[ai][bj][m][1];
                        u32x4 w; w.x = cvtpk(a[0], a[1]); w.y = cvtpk(a[2], a[3]); w.z = cvtpk(b[0], b[1]); w.w = cvtpk(b[2], b[3]); *(u32x4*)(dst + bj * 128) = w; } }
            }
            __builtin_amdgcn_sched_barrier(0);
        }
    }
};

struct EpiMoeUp {
    EPI_NOHOOK
    const int* LIST; const float* WGT; bf16_t* MACT;
    __device__ __forceinline__ void operator()(const pg8::Acc& acc, const pg8::Unit& u_, int wr, int wc, int fr, int fq) const {
        EPI_OPAQUE
        const int slot = u.pn >> 2;
        int tok[2][4]; float w[2][4];
#pragma unroll
        for (int ai = 0; ai < 2; ++ai)
#pragma unroll
            for (int m = 0; m < 4; ++m) { const int ri = ai * 128 + wr * 64 + m * 16 + fr; tok[ai][m] = LIST[u.aux0 + (ri < u.aux1 ? ri : 0)]; }
#pragma unroll
        for (int ai = 0; ai < 2; ++ai)
#pragma unroll
            for (int m = 0; m < 4; ++m) w[ai][m] = WGT[(size_t)tok[ai][m] * 2 + slot];
#pragma unroll
        for (int ai = 0; ai < 2; ++ai)
#pragma unroll
        for (int m = 0; m < 4; ++m) {
            const int ri = ai * 128 + wr * 64 + m * 16 + fr; const float ww = w[ai][m];
#pragma unroll
            for (int bj = 0; bj < 2; ++bj) {
                const int c0 = bj * 128 + wc * 32 + 8 * fq;
                EPI_V8(v, acc, ai, bj, m)
                u32x2 o; o.x = cvtpk(siluf_(v[0]) * v[1] * ww, siluf_(v[2]) * v[3] * ww); o.y = cvtpk(siluf_(v[4]) * v[5] * ww, siluf_(v[6]) * v[7] * ww);
                *(u32x2*)(MACT + (size_t)(u.pm * 256 + ri) * 1024 + slot * 512 + (u.pn & 3) * 128 + (c0 >> 1)) = o;
            }
        }
    }
};
struct EpiMoeDown {
    EPI_NOHOOK
    const int* LIST; Resid R; const float* MODL; bf16_t* dry;
    __device__ __forceinline__ void operator()(const pg8::Acc& acc, const pg8::Unit& u_, int wr, int wc, int fr, int fq) const {
        EPI_OPAQUE
        int tok[2][4];
#pragma unroll
        for (int ai = 0; ai < 2; ++ai)
#pragma unroll
            for (int m = 0; m < 4; ++m) { const int ri = ai * 128 + wr * 64 + m * 16 + fr; tok[ai][m] = LIST[u.aux0 + (ri < u.aux1 ? ri : 0)]; }
        const int cb = u.pn * 256 + wc * 32 + 8 * fq;
#pragma unroll
        for (int ai = 0; ai < 2; ++ai) {
            u32x4 x[4][2];
#pragma unroll
            for (int m = 0; m < 4; ++m) { const bf16_t* dst = R.dst(tok[ai][m]) + cb;
#pragma unroll
                for (int bj = 0; bj < 2; ++bj) x[m][bj] = *(const u32x4*)(dst + bj * 128); }
#pragma unroll
            for (int m = 0; m < 4; ++m) { const int ri = ai * 128 + wr * 64 + m * 16 + fr;
                if (ri < u.aux1) {
                    bf16_t* dst = R.dst(tok[ai][m]) + cb; const float* g2 = MODL + R.modv(tok[ai][m]) * 6144 + 5120 + cb;
#pragma unroll
                    for (int bj = 0; bj < 2; ++bj) { float f[8]; unpack8(x[m][bj], f);
                        const f32x4 ga = *(const f32x4*)(g2 + bj * 128), gb = *(const f32x4*)(g2 + bj * 128 + 4);
                        const f32x4 a = (f32x4){f[0], f[1], f[2], f[3]} + ga * acc[ai][bj][m][0], b = (f32x4){f[4], f[5], f[6], f[7]} + gb * acc[ai][bj][m][1];
                        u32x4 w; w.x = cvtpk(a[0], a[1]); w.y = cvtpk(a[2], a[3]); w.z = cvtpk(b[0], b[1]); w.w = cvtpk(b[2], b[3]);
                        bf16_t* o = dry ? dry + (size_t)(u.pm * 256 + ri) * 1024 + cb + bj * 128 : dst + bj * 128;
                        *(u32x4*)o = w; }
                } }
            __builtin_amdgcn_sched_barrier(0);
        }
    }
};
#define SBAR() __builtin_amdgcn_sched_barrier(0)
__device__ __forceinline__ int crow(int r, int hi) { return (r & 3) + 8 * (r >> 2) + 4 * hi; }
template <int NCB> __device__ __forceinline__ int v_st(int k, int c) { const int kk = (k & ~0xC) | ((k & 4) << 1) | ((k & 8) >> 1); return ((kk >> 3) * NCB + (c >> 5)) * 512 + ((kk & 7) * 32 + (c & 31)) * 2; }
__device__ __forceinline__ int v_rd_base(int lane) { return ((lane & 3) << 3) | (((lane >> 2) & 3) << 6) | (((lane >> 4) & 1) << 5) | (((lane >> 5) & 1) << 8); }
template <int OFF> __device__ __forceinline__ s16x4 tr_read(int vb) { s16x4 r; asm volatile("ds_read_b64_tr_b16 %0, %1 offset:%2" : "=&v"(r) : "v"(vb), "i"(OFF) : "memory"); return r; }
#define PKLH(L, H) (bf16x8){L[0], L[1], L[2], L[3], H[0], H[1], H[2], H[3]}
template <int NCB, int KS> __device__ __forceinline__ bf16x8 tr_frag(int vb) { const s16x4 l = tr_read<KS * NCB * 1024>(vb), h = tr_read<KS * NCB * 1024 + NCB * 512>(vb); return PKLH(l, h); }
#define PK4(P, BASE, OUT) do { const unsigned a0 = cvtpk(P[BASE + 0], P[BASE + 1]), a1 = cvtpk(P[BASE + 2], P[BASE + 3]);   \
    const unsigned b0 = cvtpk(P[BASE + 4], P[BASE + 5]), b1 = cvtpk(P[BASE + 6], P[BASE + 7]);                              \
    auto r0 = __builtin_amdgcn_permlane32_swap(a0, b0, false, false); auto r1 = __builtin_amdgcn_permlane32_swap(a1, b1, false, false); \
    u32x4 w = {r0[0], r1[0], r0[1], r1[1]}; OUT = __builtin_bit_cast(bf16x8, w); } while (0)

namespace att {
constexpr int DQK = 96, DV = 64, KVBLK = 64;
constexpr int SHM_V = KVBLK * DV * 2;
constexpr int SHM_K = KVBLK * 256;
constexpr float THR = 8.f;
#define KSWZ(row, colB) ((row) * 256 + ((colB) ^ (((row) & 7) << 4)))
__device__ __forceinline__ void partialSM(f32x16& p0, f32x16& p1, float& m_reg, float& alpha) {
    float pmax = p0[0];
#pragma unroll
    for (int r = 1; r < 16; ++r) pmax = fmaxf(pmax, p0[r]);
#pragma unroll
    for (int r = 0; r < 16; ++r) pmax = fmaxf(pmax, p1[r]);
    { auto rr = __builtin_amdgcn_permlane32_swap(__float_as_uint(pmax), __float_as_uint(pmax), false, false);
      pmax = fmaxf(__uint_as_float(rr[0]), __uint_as_float(rr[1])); }
    float mn;
    if (__builtin_expect(__all(pmax - m_reg <= THR), 1)) { mn = m_reg; alpha = 1.f; }
    else { mn = fmaxf(m_reg, pmax); alpha = __builtin_amdgcn_exp2f(m_reg - mn); m_reg = mn; }
#pragma unroll
    for (int r = 0; r < 16; ++r) p0[r] = p0[r] - mn;
#pragma unroll
    for (int r = 0; r < 16; ++r) p1[r] = p1[r] - mn;
#pragma unroll
    for (int r = 0; r < 16; ++r) p0[r] = __builtin_amdgcn_exp2f(p0[r]);
}
__device__ __forceinline__ void finishSM(f32x16& p0, f32x16& p1, float alpha, float& l_reg, bf16x8& pa0, bf16x8& pa1, bf16x8& pa2, bf16x8& pa3) {
#pragma unroll
    for (int r = 0; r < 16; ++r) p1[r] = __builtin_amdgcn_exp2f(p1[r]);
    float ps = 0;
#pragma unroll
    for (int r = 0; r < 16; ++r) ps += p0[r];
#pragma unroll
    for (int r = 0; r < 16; ++r) ps += p1[r];
    { auto rr = __builtin_amdgcn_permlane32_swap(__float_as_uint(ps), __float_as_uint(ps), false, false);
      ps = __uint_as_float(rr[0]) + __uint_as_float(rr[1]); }
    l_reg = l_reg * alpha + ps;
    PK4(p0, 0, pa0); PK4(p0, 8, pa1); PK4(p1, 0, pa2); PK4(p1, 8, pa3);
}
__device__ __forceinline__ void qkt(f32x16& p0, f32x16& p1, const LAS char* Ks, const bf16x8* qr, int r32, int hi) {
    p0 = f32x16{}; p1 = f32x16{};
#pragma unroll
    for (int d0 = 0; d0 < 6; ++d0) { const int cb = (d0 * 16 + hi * 8) * 2;
        const bf16x8 b0 = *(const LAS bf16x8*)(Ks + KSWZ(r32, cb));
        const bf16x8 b1 = *(const LAS bf16x8*)(Ks + KSWZ(32 + r32, cb));
        p0 = __builtin_amdgcn_mfma_f32_32x32x16_bf16(b0, qr[d0], p0, 0, 0, 0);
        p1 = __builtin_amdgcn_mfma_f32_32x32x16_bf16(b1, qr[d0], p1, 0, 0, 0); }
}
template <int D0> __device__ __forceinline__ void pv_one(f32x16& od, int vb, bf16x8 pa0, bf16x8 pa1, bf16x8 pa2, bf16x8 pa3) {
    const bf16x8 f0 = tr_frag<2, 0>(vb + D0 * 512), f1 = tr_frag<2, 1>(vb + D0 * 512), f2 = tr_frag<2, 2>(vb + D0 * 512), f3 = tr_frag<2, 3>(vb + D0 * 512);
    asm volatile("s_waitcnt lgkmcnt(0)" ::: "memory"); SBAR();
    od = __builtin_amdgcn_mfma_f32_32x32x16_bf16(pa0, f0, od, 0, 0, 0);
    od = __builtin_amdgcn_mfma_f32_32x32x16_bf16(pa1, f1, od, 0, 0, 0);
    od = __builtin_amdgcn_mfma_f32_32x32x16_bf16(pa2, f2, od, 0, 0, 0);
    od = __builtin_amdgcn_mfma_f32_32x32x16_bf16(pa3, f3, od, 0, 0, 0);
}
__device__ __forceinline__ void pv_d0(f32x16* o, int vb, bf16x8 pa0, bf16x8 pa1, bf16x8 pa2, bf16x8 pa3) {
    pv_one<0>(o[0], vb, pa0, pa1, pa2, pa3); pv_one<1>(o[1], vb, pa0, pa1, pa2, pa3);
}
__device__ __forceinline__ void attn_unit(const bf16_t* __restrict__ Qb, const bf16_t* __restrict__ Kh, const bf16_t* __restrict__ Vh, bf16_t* __restrict__ Ob, int ldo, int seq, LAS char* lds, const int wv) {
    const int tid = otid(wv), wid = __builtin_amdgcn_readfirstlane(tid >> 6), lane = tid & 63, r32 = lane & 31, hi = lane >> 5;
    LAS char* V_lds = lds; LAS char* K_lds = lds + 2 * SHM_V;
    LAS float* ws = (LAS float*)(lds + 2 * SHM_V + 2 * SHM_K) + wid * 64; LAS float* li_l = ws; LAS float* al_l = ws + 32;
    float m_reg = -1e30f, l_reg = 0; f32x16 o[2] = {}; bf16x8 qr[6];
    const bf16_t* Qw = Qb + (size_t)(wid * 32 + r32) * DQK + hi * 8;
#pragma unroll
    for (int d0 = 0; d0 < 6; ++d0) qr[d0] = *(const bf16x8*)(Qw + d0 * 16);
    const int vrow = tid >> 3, vc = (tid & 7) * 8, vst = v_st<2>(vrow, vc);
    const int krA = tid / 12, kcA = tid - krA * 12, sB = 512 + tid, krB = sB / 12, kcB = sB - krB * 12;
    const int kstA = KSWZ(krA, kcA * 16), kstB = KSWZ(krB, kcB * 16);
    const bool hasB = wid < 4;
    const int vb0 = (int)(size_t)V_lds + v_rd_base(lane);
    struct { bf16x8 v, ka, kb; } sr_[2];
#define SLOAD(i, k0) do { sr_[i].v = *(const bf16x8*)(Vh + (size_t)((k0) + vrow) * DV + vc); sr_[i].ka = *(const bf16x8*)(Kh + (size_t)((k0) + krA) * DQK + kcA * 8); \
    if (hasB) sr_[i].kb = *(const bf16x8*)(Kh + (size_t)((k0) + krB) * DQK + kcB * 8); } while (0)
#define SWRITE(b, i) do { *(LAS bf16x8*)(V_lds + (b) * SHM_V + vst) = sr_[i].v; *(LAS bf16x8*)(K_lds + (b) * SHM_K + kstA) = sr_[i].ka; \
    if (hasB) *(LAS bf16x8*)(K_lds + (b) * SHM_K + kstB) = sr_[i].kb; } while (0)
#define RESC(a) do { if (__any((a) < 1.f)) { if (hi == 0) al_l[r32] = (a); asm volatile("s_waitcnt lgkmcnt(0)" ::: "memory"); \
    _Pragma("unroll") for (int d = 0; d < 2; ++d) _Pragma("unroll") for (int r = 0; r < 16; ++r) o[d][r] *= al_l[crow(r, hi)]; } } while (0)
    f32x16 pA0, pA1, pB0, pB1; float alA, alB; bf16x8 pa0, pa1, pa2, pa3; const int NTL = seq / KVBLK;
    SLOAD(0, 0); SWRITE(0, 0); __syncthreads();
    qkt(pA0, pA1, K_lds, qr, r32, hi); partialSM(pA0, pA1, m_reg, alA);
    SLOAD(1, KVBLK); if (2 < NTL) SLOAD(0, 2 * KVBLK);
    SWRITE(1, 1); __syncthreads();
    for (int j = 1; j + 1 < NTL; j += 2) {
        SBAR(); qkt(pB0, pB1, K_lds + SHM_K, qr, r32, hi);
        finishSM(pA0, pA1, alA, l_reg, pa0, pa1, pa2, pa3); SBAR();
        SLOAD(1, (j + 2) * KVBLK); SBAR();
        pv_d0(o, vb0, pa0, pa1, pa2, pa3); partialSM(pB0, pB1, m_reg, alB);
        __syncthreads(); SWRITE(0, 0);
        RESC(alB); __syncthreads();
        SBAR(); qkt(pA0, pA1, K_lds, qr, r32, hi);
        finishSM(pB0, pB1, alB, l_reg, pa0, pa1, pa2, pa3); SBAR();
        if (j + 3 < NTL) SLOAD(0, (j + 3) * KVBLK); SBAR();
        pv_d0(o, vb0 + SHM_V, pa0, pa1, pa2, pa3); partialSM(pA0, pA1, m_reg, alA);
        __syncthreads(); SWRITE(1, 1);
        RESC(alA); __syncthreads();
    }
    SBAR(); qkt(pB0, pB1, K_lds + SHM_K, qr, r32, hi);
    finishSM(pA0, pA1, alA, l_reg, pa0, pa1, pa2, pa3); SBAR();
    pv_d0(o, vb0, pa0, pa1, pa2, pa3); partialSM(pB0, pB1, m_reg, alB);
    __syncthreads(); RESC(alB);
    finishSM(pB0, pB1, alB, l_reg, pa0, pa1, pa2, pa3); SBAR();
    pv_d0(o, vb0 + SHM_V, pa0, pa1, pa2, pa3);
    if (hi == 0) li_l[r32] = l_reg; asm volatile("s_waitcnt lgkmcnt(0)" ::: "memory");
    float rli[16];
#pragma unroll
    for (int r = 0; r < 16; ++r) rli[r] = __builtin_amdgcn_rcpf(li_l[crow(r, hi)]);
    bf16_t* Ow = Ob + (size_t)(wid * 32) * ldo;
#pragma unroll
    for (int r = 0; r < 16; ++r) { const int orow = crow(r, hi);
#pragma unroll
        for (int d0 = 0; d0 < 2; ++d0) Ow[(size_t)orow * ldo + d0 * 32 + r32] = f2bf(o[d0][r] * rli[r]); }
    __syncthreads();
#undef SLOAD
#undef SWRITE
#undef RESC
}
}

namespace att2 {
constexpr int DQK = 96, DV = 64, KVBLK = 64;
constexpr int KB_BYTES = 64 * 256, VB_BYTES = 64 * 64 * 2;
constexpr int NSLOT = 5;
constexpr int LDS_K = 0, LDS_V = NSLOT * KB_BYTES, LDS_WS = LDS_V + NSLOT * VB_BYTES, LDS_TOTAL = LDS_WS + 8 * 64 * 4;
static_assert(LDS_TOTAL <= RING_BYTES, "attention LDS");
constexpr float THR = 8.f;
typedef short v4i16_t __attribute__((ext_vector_type(4)));
__device__ __forceinline__ s16x4 vtr(const LAS char* p) { return __builtin_bit_cast(s16x4, __builtin_amdgcn_ds_read_tr16_b64_v4i16((LAS v4i16_t*)p)); }
#define PP_KLD(D0) do { const int cb_ = ((D0) * 16 + hi * 8) * 2; kf[2 * (D0)] = *(const LAS bf16x8*)(Kt + KSWZ(r32, cb_)); kf[2 * (D0) + 1] = *(const LAS bf16x8*)(Kt + KSWZ(32 + r32, cb_)); } while (0)
#define PP_VLD(D0V, KS) ({ const s16x4 l_ = vtr(Vs + (D0V) * 512 + (KS) * 2048), h_ = vtr(Vs + (D0V) * 512 + (KS) * 2048 + 1024); PKLH(l_, h_); })
#ifdef PROBE_EXP2X
#define PP_EXP(x) do { float a_ = (x), b_ = (x); asm volatile("" : "+v"(b_)); a_ = __builtin_amdgcn_exp2f(a_); b_ = __builtin_amdgcn_exp2f(b_); (x) = (a_ + b_) * 0.5f; } while (0)
#else
#define PP_EXP(x) (x) = __builtin_amdgcn_exp2f(x)
#endif
#define PK4N(P, BASE, OUT) do { u32x4 w_ = {cvtpk(P[BASE + 0], P[BASE + 1]), cvtpk(P[BASE + 2], P[BASE + 3]), cvtpk(P[BASE + 4], P[BASE + 5]), cvtpk(P[BASE + 6], P[BASE + 7])}; OUT = __builtin_bit_cast(bf16x8, w_); } while (0)
#define PP_SLOT_END() do { SBAR(); asm volatile("s_waitcnt vmcnt(%0) lgkmcnt(0)\n\ts_barrier" :: "n"(3 * (NSLOT - 2)) : "memory"); SBAR(); } while (0)
#define PP_BAR() do { SBAR(); asm volatile("s_waitcnt lgkmcnt(0)\n\ts_barrier" ::: "memory"); SBAR(); } while (0)
__device__ __forceinline__ float max3f(float a, float b, float c) { return fmaxf(fmaxf(a, b), c); }
__device__ __forceinline__ void attn_unit_pp(const bf16_t* __restrict__ Qb, const bf16_t* __restrict__ Kh, const bf16_t* __restrict__ Vh, bf16_t* __restrict__ Ob, int ldo, int seq, LAS char* lds, const int wv) {
    const int tid = otid(wv), wid = __builtin_amdgcn_readfirstlane(tid >> 6), lane = tid & 63, r32 = lane & 31, hi = lane >> 5, grp = wid >> 2;
    LAS float* ws = (LAS float*)(lds + LDS_WS) + wid * 64; LAS float* li_l = ws; LAS float* al_l = ws + 32;
    const int NTL = seq / KVBLK;
    unsigned koff[2], voff;
#pragma unroll
    for (int i = 0; i < 2; ++i) { const int s = (2 * wid + i) * 64 + lane, row = s >> 4; int c = (s & 15) ^ (row & 7); c = c > 11 ? 11 : c; koff[i] = (unsigned)(row * 192 + c * 16); }
    { const int s = wid * 64 + lane, sub = s >> 5, win = s & 31, key = (sub >> 1) * 8 + (win >> 2), c = (sub & 1) * 32 + (win & 3) * 8; voff = (unsigned)(key * 128 + c * 2); }
    const char* Kg = (const char*)Kh; const char* Vg = (const char*)Vh;
#define PP_DMA_K(t) do { int tt_ = (t); tt_ = tt_ < NTL ? tt_ : NTL - 1; const int sl_ = tt_ % NSLOT; _Pragma("unroll") for (int i_ = 0; i_ < 2; ++i_) \
        __builtin_amdgcn_global_load_lds((const unsigned*)(Kg + (size_t)tt_ * (64 * 192) + koff[i_]), (LAS unsigned*)(lds + LDS_K + sl_ * KB_BYTES + (2 * wid + i_) * 1024), 16, 0, 0); } while (0)
#define PP_DMA_V(t) do { int tt_ = (t); tt_ = tt_ < NTL ? tt_ : NTL - 1; const int sl_ = tt_ % NSLOT; \
        __builtin_amdgcn_global_load_lds((const unsigned*)(Vg + (size_t)tt_ * (64 * 128) + voff), (LAS unsigned*)(lds + LDS_V + sl_ * VB_BYTES + wid * 1024), 16, 0, 0); } while (0)
#pragma unroll
    for (int i = 0; i <= NSLOT - 2; ++i) PP_DMA_K(i);
#pragma unroll
    for (int i = 0; i <= NSLOT - 3; ++i) PP_DMA_V(i);
    bf16x8 qr[6];
    { const bf16_t* Qw = Qb + (size_t)(wid * 32 + r32) * DQK + hi * 8;
#pragma unroll
      for (int d0 = 0; d0 < 6; ++d0) qr[d0] = *(const bf16x8*)(Qw + d0 * 16); }
    float m_reg = 0.f, l_reg = 0.f; f32x16 o[2] = {}; f32x16 negm = {}; asm volatile("" : "+v"(negm));
    f32x16 p0, p1; bf16x8 pa0, pa1, pa2, pa3;
    const int vb0 = (int)(size_t)(lds + LDS_V) + v_rd_base(lane);
    SBAR(); asm volatile("s_waitcnt vmcnt(0) lgkmcnt(0)\n\ts_barrier" ::: "memory"); SBAR();
#ifdef ATTN_TWO_BARRIERS
    if (grp == 1) PP_BAR();
#endif
#define PP_M(t) do { const int t_ = (t), j_ = t_ + 1; \
        if (t_ <= NTL - 2) { PP_DMA_V(t_ + NSLOT - 1); PP_DMA_K(t_ + NSLOT); } \
        bf16x8 kf[12]; bf16x8 vf[8]; \
        const LAS char* Kt = lds + LDS_K + ((j_ < NTL ? j_ : 0) % NSLOT) * KB_BYTES; \
        const LAS char* Vs = lds + LDS_V + ((t_ < 0 ? 0 : t_) % NSLOT) * VB_BYTES + v_rd_base(lane); \
        if (j_ < NTL) { \
            PP_KLD(0); PP_KLD(1); SBAR(); \
            _Pragma("unroll") for (int d0 = 0; d0 < 6; ++d0) { \
                if (d0 + 2 < 6) { PP_KLD(d0 + 2); } else if (t_ >= 0) { vf[2 * (d0 - 4)] = PP_VLD(d0 - 4, 0); vf[2 * (d0 - 4) + 1] = PP_VLD(d0 - 4, 1); } \
                SBAR(); \
                if (d0 == 0) { p0 = __builtin_amdgcn_mfma_f32_32x32x16_bf16(kf[0], qr[0], negm, 0, 0, 0); p1 = __builtin_amdgcn_mfma_f32_32x32x16_bf16(kf[1], qr[0], negm, 0, 0, 0); } \
                else { p0 = __builtin_amdgcn_mfma_f32_32x32x16_bf16(kf[2 * d0], qr[d0], p0, 0, 0, 0); p1 = __builtin_amdgcn_mfma_f32_32x32x16_bf16(kf[2 * d0 + 1], qr[d0], p1, 0, 0, 0); } \
                SBAR(); } \
        } else if (t_ >= 0) { vf[0] = PP_VLD(0, 0); vf[1] = PP_VLD(0, 1); vf[2] = PP_VLD(1, 0); vf[3] = PP_VLD(1, 1); SBAR(); } \
        if (t_ >= 0) { \
            vf[4] = PP_VLD(0, 2); SBAR(); o[0] = __builtin_amdgcn_mfma_f32_32x32x16_bf16(pa0, vf[0], o[0], 0, 0, 0); SBAR(); \
            vf[5] = PP_VLD(1, 2); SBAR(); o[1] = __builtin_amdgcn_mfma_f32_32x32x16_bf16(pa0, vf[2], o[1], 0, 0, 0); SBAR(); \
            vf[6] = PP_VLD(0, 3); SBAR(); o[0] = __builtin_amdgcn_mfma_f32_32x32x16_bf16(pa1, vf[1], o[0], 0, 0, 0); SBAR(); \
            vf[7] = PP_VLD(1, 3); SBAR(); o[1] = __builtin_amdgcn_mfma_f32_32x32x16_bf16(pa1, vf[3], o[1], 0, 0, 0); SBAR(); \
            o[0] = __builtin_amdgcn_mfma_f32_32x32x16_bf16(pa2, vf[4], o[0], 0, 0, 0); o[1] = __builtin_amdgcn_mfma_f32_32x32x16_bf16(pa2, vf[5], o[1], 0, 0, 0); \
            o[0] = __builtin_amdgcn_mfma_f32_32x32x16_bf16(pa3, vf[6], o[0], 0, 0, 0); o[1] = __builtin_amdgcn_mfma_f32_32x32x16_bf16(pa3, vf[7], o[1], 0, 0, 0); } \
        asm volatile("" : "+v"(o[0]), "+v"(o[1]), "+v"(p0), "+v"(p1));        \
        } while (0)
#define PP_S(first) do { \
        float a_ = max3f(p0[0], p0[1], p1[0]), b_ = max3f(p0[2], p0[3], p1[1]); a_ = max3f(a_, p1[2], p1[3]); \
        _Pragma("unroll") for (int r = 4; r < 16; r += 4) { a_ = max3f(a_, p0[r], p0[r + 1]); b_ = max3f(b_, p0[r + 2], p0[r + 3]); a_ = max3f(a_, p1[r], p1[r + 1]); b_ = max3f(b_, p1[r + 2], p1[r + 3]); } \
        float rm_ = fmaxf(a_, b_); { auto rr = __builtin_amdgcn_permlane32_swap(__float_as_uint(rm_), __float_as_uint(rm_), false, false); rm_ = fmaxf(__uint_as_float(rr[0]), __uint_as_float(rr[1])); } \
        if (first) { m_reg = rm_; _Pragma("unroll") for (int r = 0; r < 16; ++r) { p0[r] -= rm_; p1[r] -= rm_; } \
            _Pragma("unroll") for (int r = 0; r < 16; ++r) negm[r] = -m_reg; asm volatile("" : "+v"(negm)); } \
        else if (__builtin_expect(__any(rm_ > THR), 0)) { const float dl = fmaxf(rm_, 0.f); m_reg += dl; \
            _Pragma("unroll") for (int r = 0; r < 16; ++r) { p0[r] -= dl; p1[r] -= dl; } \
            _Pragma("unroll") for (int r = 0; r < 16; ++r) negm[r] = -m_reg; asm volatile("" : "+v"(negm)); \
            const float al = __builtin_amdgcn_exp2f(-dl); l_reg *= al; if (hi == 0) al_l[r32] = al; asm volatile("s_waitcnt lgkmcnt(0)" ::: "memory"); \
            _Pragma("unroll") for (int d = 0; d < 2; ++d) _Pragma("unroll") for (int r = 0; r < 16; ++r) o[d][r] *= al_l[crow(r, hi)]; } \
        _Pragma("unroll") for (int r = 0; r < 16; ++r) { PP_EXP(p0[r]); PP_EXP(p1[r]); } \
        float ps_ = 0.f; _Pragma("unroll") for (int r = 0; r < 16; ++r) ps_ += p0[r]; _Pragma("unroll") for (int r = 0; r < 16; ++r) ps_ += p1[r]; \
        { auto rr = __builtin_amdgcn_permlane32_swap(__float_as_uint(ps_), __float_as_uint(ps_), false, false); ps_ = __uint_as_float(rr[0]) + __uint_as_float(rr[1]); } \
        l_reg += ps_; \
        PK4N(p0, 0, pa0); PK4N(p0, 8, pa1); PK4N(p1, 0, pa2); PK4N(p1, 8, pa3); \
        asm volatile("" : "+v"(pa0), "+v"(pa1), "+v"(pa2), "+v"(pa3), "+v"(l_reg)); } while (0)
#ifdef ATTN_TWO_BARRIERS
    PP_M(-1); PP_SLOT_END();
    PP_S(true); PP_SLOT_END();
#pragma nounroll
    for (int t = 0; t < NTL - 1; ++t) {
        PP_M(t); PP_SLOT_END();
        PP_S(false); PP_SLOT_END();
    }
    PP_M(NTL - 1);
    if (grp == 0) PP_BAR();
#else
#ifdef ATTN_PRIO_YOUNG
    if (grp == 1) __builtin_amdgcn_s_setprio(1);
#endif
    if (grp == 0) {
        PP_M(-1); PP_S(true); PP_SLOT_END();
#pragma nounroll
        for (int t = 0; t < NTL - 1; ++t) { PP_M(t); PP_S(false); PP_SLOT_END(); }
        PP_M(NTL - 1);
    } else {
        PP_M(-1); PP_SLOT_END();
        PP_S(true);
#pragma nounroll
        for (int t = 0; t < NTL - 1; ++t) { PP_M(t); PP_SLOT_END(); PP_S(false); }
        PP_M(NTL - 1);
    }
#ifdef ATTN_PRIO_YOUNG
    __builtin_amdgcn_s_setprio(0);
#endif
#endif
    if (hi == 0) li_l[r32] = l_reg; asm volatile("s_waitcnt lgkmcnt(0)" ::: "memory");
    float rli[16];
#pragma unroll
    for (int r = 0; r < 16; ++r) rli[r] = __builtin_amdgcn_rcpf(li_l[crow(r, hi)]);
    bf16_t* Ow = Ob + (size_t)(wid * 32) * ldo;
#pragma unroll
    for (int r = 0; r < 16; ++r) { const int orow = crow(r, hi);
#pragma unroll
        for (int d0 = 0; d0 < 2; ++d0) Ow[(size_t)orow * ldo + d0 * 32 + r32] = f2bf(o[d0][r] * rli[r]); }
    SBAR(); asm volatile("s_waitcnt vmcnt(0) lgkmcnt(0)\n\ts_barrier" ::: "memory"); SBAR();
#undef PP_DMA_K
#undef PP_DMA_V
#undef PP_M
#undef PP_S
}
}

__device__ __forceinline__ void retu_unit(int unit, const bf16_t* PR, float* U, float lg2f, float lg2b, LAS char* lds, const int wv) {
    const int tid = otid(wv), wid = __builtin_amdgcn_readfirstlane(tid >> 6), lane = tid & 63, r32 = lane & 31, hi = lane >> 5;
    const int h = unit & 3, bc = unit >> 2, bl = bc / NCHUNK, c = bc - bl * NCHUNK;
    const size_t r0 = (size_t)bl * SB + (size_t)c * 128;
    LAS char* Vt = lds;
    LAS char* Kf = lds + 32768;
    LAS char* Kb = lds + 49152;
#pragma unroll
    for (int i = 0; i < 2; ++i) { const int ch = tid + i * 512, j = ch >> 3, c8 = (ch & 7) * 8;
        const u32x4 kw = *(const u32x4*)(PR + (r0 + j) * 1536 + 256 + h * 64 + c8);
        float f[8], g[8]; unpack8(kw, f);
        const float wf = __builtin_amdgcn_exp2f(lg2f * (float)(127 - j)), wb = __builtin_amdgcn_exp2f(lg2b * (float)j);
#pragma unroll
        for (int k = 0; k < 8; ++k) { g[k] = f[k] * wb; f[k] *= wf; }
        const int off = (j >> 6) * 8192 + v_st<2>(j & 63, c8);
        *(LAS u32x4*)(Kf + off) = pack8(f); *(LAS u32x4*)(Kb + off) = pack8(g); }
#pragma unroll
    for (int i = 0; i < 4; ++i) { const int ch = tid + i * 512, j = ch >> 4, c8 = (ch & 15) * 8;
        const u32x4 vw = *(const u32x4*)(PR + (r0 + j) * 1536 + 512 + h * 128 + c8);
        *(LAS u32x4*)(Vt + (j >> 6) * 16384 + v_st<4>(j & 63, c8)) = vw; }
    __syncthreads();
    const int eblk = wid & 3, dblk = wid >> 2;
    const int vbV = (int)(size_t)Vt + v_rd_base(lane) + eblk * 512, vbF = (int)(size_t)Kf + v_rd_base(lane) + dblk * 512, vbB = (int)(size_t)Kb + v_rd_base(lane) + dblk * 512;
    f32x16 aF = {}, aB = {};
#define RU_STEP(SUB, KS) do { const bf16x8 a = tr_frag<4, KS>(vbV + SUB * 16384), bf = tr_frag<2, KS>(vbF + SUB * 8192), bb = tr_frag<2, KS>(vbB + SUB * 8192); \
        asm volatile("s_waitcnt lgkmcnt(0)" ::: "memory"); SBAR(); \
        aF = __builtin_amdgcn_mfma_f32_32x32x16_bf16(a, bf, aF, 0, 0, 0); aB = __builtin_amdgcn_mfma_f32_32x32x16_bf16(a, bb, aB, 0, 0, 0); } while (0)
    RU_STEP(0, 0); RU_STEP(0, 1); RU_STEP(0, 2); RU_STEP(0, 3); RU_STEP(1, 0); RU_STEP(1, 1); RU_STEP(1, 2); RU_STEP(1, 3);
#undef RU_STEP
    float* Uf = U + (size_t)unit * 2 * 8192; float* Ub = Uf + 8192;
#pragma unroll
    for (int r = 0; r < 16; ++r) { const int e = 32 * eblk + crow(r, hi), d = 32 * dblk + r32; Uf[e * 64 + d] = aF[r]; Ub[e * 64 + d] = aB[r]; }
    __syncthreads();
}

__device__ __forceinline__ void retout_unit(int unit, const bf16_t* PR, const bf16_t* S, const float* gnw, bf16_t* ACT, float lg2f, float lg2b, LAS char* lds, const int wv) {
    const int tid = otid(wv), wid = __builtin_amdgcn_readfirstlane(tid >> 6), lane = tid & 63, r32 = lane & 31, hi = lane >> 5;
    const int h = unit & 3, bc = unit >> 2, bl = bc / NCHUNK, c = bc - bl * NCHUNK;
    const size_t r0 = (size_t)bl * SB + (size_t)c * 128;
    LAS char* Vt = lds; LAS float* part = (LAS float*)(lds + 32768);
    const int qblk = wid & 3, ehalf = wid >> 2, iq = 32 * qblk + r32;
    u32x4 vw[4];
#pragma unroll
    for (int i = 0; i < 4; ++i) { const int ch = tid + i * 512, j = ch >> 4, c8 = (ch & 15) * 8; vw[i] = *(const u32x4*)(PR + (r0 + j) * 1536 + 512 + h * 128 + c8); }
    bf16x8 qf[4], kf[4][4];
    { const bf16_t* qp = PR + (r0 + iq) * 1536 + h * 64 + hi * 8;
#pragma unroll
      for (int d0 = 0; d0 < 4; ++d0) qf[d0] = *(const bf16x8*)(qp + d0 * 16); }
#pragma unroll
    for (int jb = 0; jb < 4; ++jb) { const bf16_t* kp = PR + (r0 + 32 * jb + r32) * 1536 + 256 + h * 64 + hi * 8;
#pragma unroll
        for (int d0 = 0; d0 < 4; ++d0) kf[jb][d0] = *(const bf16x8*)(kp + d0 * 16); }
    const int orow = tid >> 2, oc = (tid & 3) * 32;
    u32x4 gw[4];
#pragma unroll
    for (int k = 0; k < 4; ++k) gw[k] = *(const u32x4*)(PR + (r0 + orow) * 1536 + 1024 + h * 128 + oc + 8 * k);
#pragma unroll
    for (int i = 0; i < 4; ++i) { const int ch = tid + i * 512, j = ch >> 4, c8 = (ch & 15) * 8; *(LAS u32x4*)(Vt + (j >> 6) * 16384 + v_st<4>(j & 63, c8)) = vw[i]; }
    f32x16 o[2] = {};
    __syncthreads();
    bf16x8 sf[2][4], sb[2][4];
    { const bf16_t* Sf = S + (size_t)unit * 2 * 8192; const bf16_t* Sb = Sf + 8192;
#pragma unroll
      for (int e0 = 0; e0 < 2; ++e0) { const int e = 64 * ehalf + 32 * e0 + r32;
#pragma unroll
        for (int d0 = 0; d0 < 4; ++d0) { sf[e0][d0] = *(const bf16x8*)(Sf + e * 64 + d0 * 16 + hi * 8); sb[e0][d0] = *(const bf16x8*)(Sb + e * 64 + d0 * 16 + hi * 8); } } }
    const int vb = (int)(size_t)Vt + v_rd_base(lane) + ehalf * 1024;
#pragma unroll
    for (int jb = 0; jb < 4; ++jb) {
        f32x16 p = {};
#pragma unroll
        for (int d0 = 0; d0 < 4; ++d0) p = __builtin_amdgcn_mfma_f32_32x32x16_bf16(kf[jb][d0], qf[d0], p, 0, 0, 0);
#pragma unroll
        for (int r = 0; r < 16; ++r) { const int dj = iq - (32 * jb + crow(r, hi));
            const float e = dj >= 0 ? lg2f * (float)dj : lg2b * (float)(-dj); p[r] *= __builtin_amdgcn_exp2f(e); }
        bf16x8 pa0, pa1; PK4(p, 0, pa0); PK4(p, 8, pa1);
        const int vj = vb + (jb >> 1) * 16384;
        if (jb & 1) {
            const bf16x8 f00 = tr_frag<4, 2>(vj), f01 = tr_frag<4, 3>(vj), f10 = tr_frag<4, 2>(vj + 512), f11 = tr_frag<4, 3>(vj + 512);
            asm volatile("s_waitcnt lgkmcnt(0)" ::: "memory"); SBAR();
            o[0] = __builtin_amdgcn_mfma_f32_32x32x16_bf16(pa0, f00, o[0], 0, 0, 0); o[0] = __builtin_amdgcn_mfma_f32_32x32x16_bf16(pa1, f01, o[0], 0, 0, 0);
            o[1] = __builtin_amdgcn_mfma_f32_32x32x16_bf16(pa0, f10, o[1], 0, 0, 0); o[1] = __builtin_amdgcn_mfma_f32_32x32x16_bf16(pa1, f11, o[1], 0, 0, 0);
        } else {
            const bf16x8 f00 = tr_frag<4, 0>(vj), f01 = tr_frag<4, 1>(vj), f10 = tr_frag<4, 0>(vj + 512), f11 = tr_frag<4, 1>(vj + 512);
            asm volatile("s_waitcnt lgkmcnt(0)" ::: "memory"); SBAR();
            o[0] = __builtin_amdgcn_mfma_f32_32x32x16_bf16(pa0, f00, o[0], 0, 0, 0); o[0] = __builtin_amdgcn_mfma_f32_32x32x16_bf16(pa1, f01, o[0], 0, 0, 0);
            o[1] = __builtin_amdgcn_mfma_f32_32x32x16_bf16(pa0, f10, o[1], 0, 0, 0); o[1] = __builtin_amdgcn_mfma_f32_32x32x16_bf16(pa1, f11, o[1], 0, 0, 0);
        }
    }
    {
        const float xf = __builtin_amdgcn_exp2f(lg2f * (float)(iq + 1)), xb = __builtin_amdgcn_exp2f(lg2b * (float)(128 - iq));
#pragma unroll
        for (int d0 = 0; d0 < 4; ++d0) {
            float f[8], g[8]; unpack8(__builtin_bit_cast(u32x4, qf[d0]), f);
#pragma unroll
            for (int k = 0; k < 8; ++k) { g[k] = f[k] * xb; f[k] *= xf; }
            const bf16x8 qa = __builtin_bit_cast(bf16x8, pack8(f)), qb = __builtin_bit_cast(bf16x8, pack8(g));
#pragma unroll
            for (int e0 = 0; e0 < 2; ++e0) { o[e0] = __builtin_amdgcn_mfma_f32_32x32x16_bf16(qa, sf[e0][d0], o[e0], 0, 0, 0); o[e0] = __builtin_amdgcn_mfma_f32_32x32x16_bf16(qb, sb[e0][d0], o[e0], 0, 0, 0); }
        }
    }
    float sq[16];
#pragma unroll
    for (int r = 0; r < 16; ++r) { float s = o[0][r] * o[0][r] + o[1][r] * o[1][r];
        sq[r] = sum32(s); }
    if (r32 == 0) {
#pragma unroll
        for (int r = 0; r < 16; ++r) part[wid * 32 + crow(r, hi)] = sq[r];
    }
    __syncthreads();
    const float g0 = gnw[h * 128 + 64 * ehalf + r32], g1 = gnw[h * 128 + 64 * ehalf + 32 + r32];
    LAS bf16_t* stg = (LAS bf16_t*)Vt;
#pragma unroll
    for (int r = 0; r < 16; ++r) { const int il = crow(r, hi);
        const float tot = part[wid * 32 + il] + part[(wid ^ 4) * 32 + il];
        const float rn = rsqrtf(tot * (1.f / 128.f) + RMS_EPS);
        LAS bf16_t* sp = stg + (32 * qblk + il) * 128 + 64 * ehalf + r32;
        sp[0] = f2bf(o[0][r] * rn * g0); sp[32] = f2bf(o[1][r] * rn * g1); }
    __syncthreads();
#pragma unroll
    for (int k = 0; k < 4; ++k) { float y[8], g[8]; unpack8(*(const LAS u32x4*)(stg + orow * 128 + oc + 8 * k), y); unpack8(gw[k], g);
#pragma unroll
        for (int q = 0; q < 8; ++q) y[q] *= siluf_(g[q]);
        *(u32x4*)(ACT + (r0 + orow) * 1536 + h * 128 + oc + 8 * k) = pack8(y); }
    __syncthreads();
}
struct Args { const float* in[26]; float* out; unsigned char* ws; int ph_lo, ph_hi; };
struct Frame {
    LAS unsigned char* lds; int G, wv;
    const Args* a; float* out; unsigned char* ws;
};
__device__ __forceinline__ const float* in_ptr(const Args* a, int i) { int z; asm volatile("s_mov_b32 %0, 0" : "=s"(z)); return a->in[i + z]; }
#define INP(i) in_ptr(F.a, (i))
#define WSP(T, off) ((T*)(F.ws + (off)))

__device__ __forceinline__ int srccol_in(int n) {
    if (n < 512) { const int base = n & ~255, hh = (n & 255) >> 6, p = n & 63; return base + hh * 64 + (p >> 1) + 32 * (p & 1); }
    if (n < 2048) return n;
    if (n < 3072) { const int j = (n - 2048) >> 1; return 2048 + j + 512 * (n & 1); }
    if (n < 3712) return n;
    if (n < 3744) { const int p = n - 3712, a = p >> 4, q = p & 15; return 3712 + a * 16 + (q >> 1) + 8 * (q & 1); }
    if (n < 3840) return -1;
    return n - 96;
}
__device__ __forceinline__ int srccol_uq(int n) { const int h = n / 96, d = n - h * 96; if (d < 64) return n; const int p = d - 64, a = p >> 4, q = p & 15; return h * 96 + 64 + a * 16 + (q >> 1) + 8 * (q & 1); }

__device__ __forceinline__ void cvt_item(const float* sp, int ldw, const float* scale, bf16_t* dst, int ldd, int n0, int k0, LAS float* scr, int lane) {
    float vv[32];
#pragma unroll
    for (int i = 0; i < 32; ++i) { const int kk = 2 * i + (lane >> 5); vv[i] = sp ? sp[(size_t)(k0 + kk) * ldw] : 0.f; }
    if (scale) {
#pragma unroll
        for (int i = 0; i < 32; ++i) vv[i] *= scale[k0 + 2 * i + (lane >> 5)];
    }
#pragma unroll
    for (int i = 0; i < 32; ++i) scr[(2 * i + (lane >> 5)) * 33 + (lane & 31)] = vv[i];
    asm volatile("s_waitcnt lgkmcnt(0)" ::: "memory");
    const int c = lane & 7;
#pragma unroll
    for (int j = 0; j < 4; ++j) { const int n = (lane >> 3) + 8 * j; const LAS float* s = scr + (8 * c) * 33 + n;
        u32x4 o; o.x = cvtpk(s[0 * 33], s[1 * 33]); o.y = cvtpk(s[2 * 33], s[3 * 33]); o.z = cvtpk(s[4 * 33], s[5 * 33]); o.w = cvtpk(s[6 * 33], s[7 * 33]);
        *(u32x4*)(dst + (size_t)(n0 + n) * ldd + k0 + 8 * c) = o; }
    asm volatile("s_waitcnt lgkmcnt(0)" ::: "memory");
}

__device__ __forceinline__ f32x2 cossin_f(float ang) {
    const double x = (double)ang * 0.15915494309189535; const float r = (float)(x - rint(x));
    return (f32x2){__builtin_amdgcn_cosf(r), __builtin_amdgcn_sinf(r)};
}
__device__ __forceinline__ float lg2_gamma(const float* rd) { return -__builtin_amdgcn_logf(1.f + __builtin_amdgcn_exp2f(-rd[0] * LOG2E)); }
#define PHASE_IDS const int tid = otid(F.wv), lane = tid & 63, wave = __builtin_amdgcn_readfirstlane(tid >> 6), bid = obid(); (void)lane; (void)wave; (void)bid;
__device__ __forceinline__ void p0_prologue(Frame& F) {
    PHASE_IDS
    __syncthreads();
    if (bid < 48) {
        LAS float* sc = (LAS float*)F.lds;
        LAS float* red = (LAS float*)(F.lds + 40960);
        for (int i = tid; i < 9 * 1024; i += 512) { const int v = i >> 10, k = i & 1023; const float x = v < 8 ? INP(1)[v * 1024 + k] : INP(3)[k]; sc[i] = siluf_(x); }
        __syncthreads();
        const int l = bid / 24, col = (bid % 24) * 256 + (tid & 255), kq = tid >> 8;
        const float* w = INP(4) + (size_t)l * 1024 * 6144 + col;
        float a[9];
#pragma unroll
        for (int v = 0; v < 9; ++v) a[v] = 0.f;
#pragma nounroll
        for (int k = kq * 512; k < kq * 512 + 512; k += 16) {
            float wv_[16];
#pragma unroll
            for (int j = 0; j < 16; ++j) wv_[j] = w[(size_t)(k + j) * 6144];
#pragma unroll
            for (int j4 = 0; j4 < 4; ++j4)
#pragma unroll
                for (int v = 0; v < 9; ++v) { const f32x4 s = *(const LAS f32x4*)(sc + v * 1024 + k + 4 * j4); a[v] += (s[0] * wv_[4 * j4] + s[1] * wv_[4 * j4 + 1]) + (s[2] * wv_[4 * j4 + 2] + s[3] * wv_[4 * j4 + 3]); }
        }
        if (kq == 1) {
#pragma unroll
            for (int v = 0; v < 9; ++v) red[v * 256 + (tid & 255)] = a[v];
        }
        __syncthreads();
        if (kq == 0) { float* MOD = WSP(float, WS_MOD) + (size_t)l * 9 * 6144; const float b = INP(5)[l * 6144 + col];
#pragma unroll
            for (int v = 0; v < 9; ++v) MOD[v * 6144 + col] = b + a[v] + red[v * 256 + tid]; }
        __syncthreads();
    }
    { f32x2* RT = WSP(f32x2, WS_RT); f32x2* MT = WSP(f32x2, WS_MT);
      for (int i = bid * 512 + tid; i < 8192 * 32 + 128 * 8; i += F.G * 512) {
          if (i < 8192 * 32) { const int t = i >> 5, k = i & 31; const float inv = exp2f(-(float)k * (13.287712379549449f / 32.f)); RT[i] = cossin_f((float)t * inv); }
          else { const int q = i - 8192 * 32, pos = q >> 3, k = q & 7; const float inv = exp2f(-(float)k * (13.287712379549449f / 8.f)); MT[q] = cossin_f((float)pos * inv); } } }
    LAS float* scr = (LAS float*)(F.lds + wave * 16384);
    const int gw = bid * 8 + wave, NGW = F.G * 8;
    constexpr int I_IN = 2 * 16 * 216, I_CAT = 2 * 3 * 8 * 32, I_OUT = 2 * 16 * 32, I_UQ = 2 * 6 * 24, I_UKV = 2 * 4 * 32, I_UP = 32 * 16 * 32, I_W2 = 32 * 8 * 32;
    constexpr int NITEMS = I_IN + I_CAT + I_OUT + I_UQ + I_UKV + I_UP + I_W2;
    for (int it = gw; it < NITEMS; it += NGW) {
        int r = it;
        if (r < I_IN) { const int l = r / 3456, q = r % 3456, kb = q / 216, nb = q % 216; const int sc_ = srccol_in(nb * 32 + (lane & 31));
            cvt_item(sc_ >= 0 ? INP(8) + (size_t)l * 1024 * INCOLS + sc_ : nullptr, INCOLS, nullptr, WSP(bf16_t, WS_WIN) + (size_t)l * INW * 1024, 1024, nb * 32, kb * 64, scr, lane); continue; } r -= I_IN;
        if (r < I_CAT) { const int l = r / 768, q = r % 768, seg = q / 256, q2 = q % 256, kb = q2 / 32, nb = q2 % 32; const float* W = seg == 0 ? INP(11) : (seg == 1 ? INP(13) : INP(18));
            cvt_item(W + (size_t)l * 512 * 1024 + nb * 32 + (lane & 31), 1024, nullptr, WSP(bf16_t, WS_WCAT) + (size_t)l * 1024 * 1536 + seg * 512, 1536, nb * 32, kb * 64, scr, lane); continue; } r -= I_CAT;
        if (r < I_OUT) { const int l = r / 512, q = r % 512, kb = q / 32, nb = q % 32;
            cvt_item(INP(19) + (size_t)l * 1024 * 1024 + nb * 32 + (lane & 31), 1024, nullptr, WSP(bf16_t, WS_WOUT) + (size_t)l * 1024 * 1024, 1024, nb * 32, kb * 64, scr, lane); continue; } r -= I_OUT;
        if (r < I_UQ) { const int l = r / 144, q = r % 144, kb = q / 24, nb = q % 24;
            cvt_item(INP(15) + (size_t)l * 384 * 768 + srccol_uq(nb * 32 + (lane & 31)), 768, INP(14) + l * 384, WSP(bf16_t, WS_WUQ) + (size_t)l * 768 * 384, 384, nb * 32, kb * 64, scr, lane); continue; } r -= I_UQ;
        if (r < I_UKV) { const int l = r / 128, q = r % 128, kb = q / 32, nb = q % 32;
            cvt_item(INP(17) + (size_t)l * 256 * 1024 + nb * 32 + (lane & 31), 1024, INP(16) + l * 256, WSP(bf16_t, WS_WUKV) + (size_t)l * 1024 * 256, 256, nb * 32, kb * 64, scr, lane); continue; } r -= I_UKV;
        if (r < I_UP) { const int le = r / 512, q = r % 512, kb = q / 32, nb = q % 32; const int n = nb * 32 + (lane & 31);
            const float* W = (n & 1) ? INP(23) : INP(22);
            cvt_item(W + (size_t)le * 1024 * 512 + (n >> 1), 512, nullptr, WSP(bf16_t, WS_WUP) + (size_t)le * 1024 * 1024, 1024, nb * 32, kb * 64, scr, lane); continue; } r -= I_UP;
        { const int le = r / 256, q = r % 256, kb = q / 32, nb = q % 32;
            cvt_item(INP(24) + (size_t)le * 512 * 1024 + nb * 32 + (lane & 31), 1024, nullptr, WSP(bf16_t, WS_W2T) + (size_t)le * 1024 * 512, 512, nb * 32, kb * 64, scr, lane); }
    }
}

__device__ __forceinline__ void norm1_phase(Frame& F, const Resid& R, int l, int skip_none) {
    PHASE_IDS
    const int gw = bid * 8 + wave, NGW = F.G * 8; bf16_t* HX = WSP(bf16_t, WS_HX);
    const float* MODL = WSP(float, WS_MOD) + (size_t)l * 9 * 6144; const float* nw = INP(6) + l * 1024;
    for (int row = gw; row < NT; row += NGW) {
        const float* md = MODL + R.modv(row) * 6144;
        f32x4 v[4]; float s = 0.f;
        int sf32 = R.src_f32; asm volatile("" : "+s"(sf32));
        if (sf32) { const f32x4* xr = (const f32x4*)R.srcf(row) + lane;
#pragma unroll
            for (int j = 0; j < 4; ++j) v[j] = xr[64 * j]; }
        else { const u32x2* xr = (const u32x2*)R.dst(row) + lane;
#pragma unroll
            for (int j = 0; j < 4; ++j) { const u32x2 w = xr[64 * j]; v[j] = (f32x4){bf_lo(w.x), bf_hi(w.x), bf_lo(w.y), bf_hi(w.y)}; } }
#pragma unroll
        for (int j = 0; j < 4; ++j) s += (v[j][0] * v[j][0] + v[j][1] * v[j][1]) + (v[j][2] * v[j][2] + v[j][3] * v[j][3]);
        const float rs = rsqrtf(wave_sum(s) * (1.f / DM) + RMS_EPS);
#pragma unroll
        for (int j = 0; j < 4; ++j) { const int c = 4 * lane + 256 * j; const f32x4 w = *(const f32x4*)(nw + c), sh = *(const f32x4*)(md + c), sc = *(const f32x4*)(md + 1024 + c);
            const f32x4 y = v[j] * rs * w * (sc + 1.f) + sh; u32x2 o; o.x = cvtpk(y[0], y[1]); o.y = cvtpk(y[2], y[3]); *(u32x2*)(HX + (size_t)row * 1024 + c) = o; }
    }
}
__device__ __forceinline__ void final_norm_phase(Frame& F, int g) {
    PHASE_IDS
    const int gw = bid * 8 + wave, NGW = F.G * 8; const float* nw = INP(25);
    for (int row = gw; row < GB * SEQ; row += NGW) {
        f32x4* xr = (f32x4*)(F.out + ((size_t)g * GB * SEQ + row) * DM) + lane;
        const u32x2* xb = (const u32x2*)(WSP(bf16_t, WS_XRES) + ((size_t)g * GB * SEQ + row) * DM) + lane;
        f32x4 v[4]; float s = 0.f;
#pragma unroll
        for (int j = 0; j < 4; ++j) { const u32x2 w = xb[64 * j]; v[j] = (f32x4){bf_lo(w.x), bf_hi(w.x), bf_lo(w.y), bf_hi(w.y)}; s += (v[j][0] * v[j][0] + v[j][1] * v[j][1]) + (v[j][2] * v[j][2] + v[j][3] * v[j][3]); }
        const float rs = rsqrtf(wave_sum(s) * (1.f / DM) + RMS_EPS);
#pragma unroll
        for (int j = 0; j < 4; ++j) { const f32x4 w = *(const f32x4*)(nw + 4 * lane + 256 * j); xr[64 * j] = v[j] * rs * w; }
    }
}
__device__ __forceinline__ void conv_phase(Frame& F, int l) {
    PHASE_IDS
    const bf16_t* PC = WSP(bf16_t, WS_PC); bf16_t* ACT = WSP(bf16_t, WS_ACT); const float* cw = INP(12) + (size_t)l * 512 * 3;
    for (int idx = bid * 512 + tid; idx < NT * 64; idx += F.G * 512) {
        const int row = idx >> 6, c8 = (idx & 63) * 8; const int bl = row / SB, s = row - bl * SB;
        const bool hp = (s != 0) && (s != CTXL), hn = (s != CTXL - 1) && (s != SB - 1);
        const bf16_t* p = PC + (size_t)row * 1024 + c8;
        float b[8], u0[8], um[8], up[8];
        unpack8(*(const u32x4*)p, b); unpack8(*(const u32x4*)(p + 512), u0);
        if (hp) unpack8(*(const u32x4*)(p + 512 - 1024), um); else {
#pragma unroll
            for (int k = 0; k < 8; ++k) um[k] = 0.f; }
        if (hn) unpack8(*(const u32x4*)(p + 512 + 1024), up); else {
#pragma unroll
            for (int k = 0; k < 8; ++k) up[k] = 0.f; }
        float o[8];
#pragma unroll
        for (int k = 0; k < 8; ++k) { const float* w = cw + (c8 + k) * 3; o[k] = b[k] * (um[k] * w[0] + u0[k] * w[1] + up[k] * w[2]); }
        *(u32x4*)(ACT + (size_t)row * 1536 + 512 + c8) = pack8(o);
    }
}
__device__ __forceinline__ void scan_phase(Frame& F, int l) {
    PHASE_IDS
    const float* U = WSP(float, WS_HX); bf16_t* S = WSP(bf16_t, WS_PM);
    for (int idx = bid * 512 + tid; idx < GB * 4 * 2 * 8192; idx += F.G * 512) {
        const int ed = idx & 8191, dir = (idx >> 13) & 1, h = (idx >> 14) & 3, bl = idx >> 16;
        const float lg = lg2_gamma(INP(9) + l * 8 + dir * 4 + h); const float dec = __builtin_amdgcn_exp2f(lg * 128.f);
        float st = 0.f;
        for (int i0 = 0; i0 < NCHUNK; i0 += 6) {
            float uu[6]; size_t off[6];
#pragma unroll
            for (int k = 0; k < 6; ++k) { const int i = i0 + k; const int c = dir ? (i < 2 ? 1 - i : NCHUNK + 1 - i) : i;
                off[k] = ((size_t)(((bl * NCHUNK + c) * 4 + h) * 2 + dir)) * 8192 + ed; uu[k] = U[off[k]]; }
#pragma unroll
            for (int k = 0; k < 6; ++k) { S[off[k]] = f2bf(st); st = dec * st + uu[k]; }
        }
    }
}
template <int NR>
__device__ __forceinline__ void n2_rows(const Resid& R, const int (&rows)[NR], const int (&slot)[NR], const float* MODL, const float* nw, bf16_t* H2, const LAS float* wr, LAS float* lg, int lane) {
    f32x4 v[NR][4]; float s[NR];
#pragma unroll
    for (int q = 0; q < NR; ++q) { const u32x2* xr = (const u32x2*)R.dst(rows[q]) + lane; s[q] = 0.f;
#pragma unroll
        for (int j = 0; j < 4; ++j) { const u32x2 w_ = xr[64 * j]; v[q][j] = (f32x4){bf_lo(w_.x), bf_hi(w_.x), bf_lo(w_.y), bf_hi(w_.y)}; s[q] += (v[q][j][0] * v[q][j][0] + v[q][j][1] * v[q][j][1]) + (v[q][j][2] * v[q][j][2] + v[q][j][3] * v[q][j][3]); } }
#pragma unroll
    for (int q = 0; q < NR; ++q) s[q] = rsqrtf(wave_sum(s[q]) * (1.f / DM) + RMS_EPS);
#pragma unroll
    for (int q = 0; q < NR; ++q) { const float* md = MODL + R.modv(rows[q]) * 6144;
#pragma unroll
        for (int j = 0; j < 4; ++j) { const int c = 4 * lane + 256 * j; const f32x4 w = *(const f32x4*)(nw + c), sh = *(const f32x4*)(md + 3072 + c), sc = *(const f32x4*)(md + 4096 + c);
            v[q][j] = v[q][j] * s[q] * w * (sc + 1.f) + sh; u32x2 o; o.x = cvtpk(v[q][j][0], v[q][j][1]); o.y = cvtpk(v[q][j][2], v[q][j][3]); *(u32x2*)(H2 + (size_t)rows[q] * 1024 + c) = o; } }
    const int b4 = (lane >> 4) & 1, b3 = (lane >> 3) & 1, b2 = (lane >> 2) & 1;
#pragma unroll
    for (int q = 0; q < NR; ++q) {
        float a[16];
#pragma unroll
        for (int e = 0; e < 16; ++e) { float t = 0.f;
#pragma unroll
            for (int j = 0; j < 4; ++j) { const f32x4 w = *(const LAS f32x4*)(wr + e * 1024 + 4 * lane + 256 * j); t += (v[q][j][0] * w[0] + v[q][j][1] * w[1]) + (v[q][j][2] * w[2] + v[q][j][3] * w[3]); }
            a[e] = t; }
        float s8[8], s4[4], s2[2];
#pragma unroll
        for (int k = 0; k < 8; ++k) { auto r = __builtin_amdgcn_permlane32_swap(__float_as_uint(a[k]), __float_as_uint(a[k + 8]), false, false); s8[k] = __uint_as_float(r[0]) + __uint_as_float(r[1]); }
#pragma unroll
        for (int k = 0; k < 4; ++k) { const float snd = b4 ? s8[k] : s8[k + 4], kp = b4 ? s8[k + 4] : s8[k]; s4[k] = kp + swz_xor<16>(snd); }
#pragma unroll
        for (int k = 0; k < 2; ++k) { const float snd = b3 ? s4[k] : s4[k + 2], kp = b3 ? s4[k + 2] : s4[k]; s2[k] = kp + swz_xor<8>(snd); }
        float s1; { const float snd = b2 ? s2[0] : s2[1], kp = b2 ? s2[1] : s2[0]; s1 = kp + swz_xor<4>(snd); }
        s1 += swz_xor<2>(s1); s1 += swz_xor<1>(s1);
        if ((lane & 3) == 0) lg[slot[q] * 16 + (lane >> 2)] = s1;
    }
}
__device__ __forceinline__ void norm2_router_phase(Frame& F, const Resid& R, int l, int g, int lat_only, int cslot) {
    PHASE_IDS
    bf16_t* H2 = WSP(bf16_t, WS_HX);
    const float* MODL = WSP(float, WS_MOD) + (size_t)l * 9 * 6144; const float* nw = INP(7) + l * 1024;
    LAS float* wr = (LAS float*)F.lds; LAS float* lg = (LAS float*)(F.lds + 65536);
    { const float* wrt = INP(20); for (int i = tid; i < 16 * 1024; i += 512) wr[i] = wrt[(i & 1023) * 16 + (i >> 10)]; }
    __syncthreads();
    const int rpb = (NT + F.G - 1) / F.G, r0 = bid * rpb, r1 = (r0 + rpb < NT) ? r0 + rpb : NT;
    for (int row = r0 + wave; row < r1; row += 16) {
        const int rowb = row + 8;
        const bool okA = !(lat_only && (row % SB) < CTXL), okB = rowb < r1 && !(lat_only && (rowb % SB) < CTXL);
        if (okA && okB) { const int rr[2] = {row, rowb}, ss[2] = {row - r0, rowb - r0}; n2_rows<2>(R, rr, ss, MODL, nw, H2, wr, lg, lane); }
        else if (okA) { const int rr[1] = {row}, ss[1] = {row - r0}; n2_rows<1>(R, rr, ss, MODL, nw, H2, wr, lg, lane); }
        else if (okB) { const int rr[1] = {rowb}, ss[1] = {rowb - r0}; n2_rows<1>(R, rr, ss, MODL, nw, H2, wr, lg, lane); }
    }
    __syncthreads();
    unsigned* CNT = WSP(unsigned, WS_CTL) + CW_CNT + (g * 2 + l) * 64 + cslot; int* LIST = WSP(int, WS_LIST); float* WGT = WSP(float, WS_WGT);
    const float* rb = INP(21);
    LAS unsigned* lcnt = (LAS unsigned*)(F.lds + 65536 + 16384);
    if (tid < 64) lcnt[tid] = 0u;
    __syncthreads();
    int bucket = -1, rank = 0; float wlo = 0.f, whi = 0.f; const int trow = r0 + tid;
    if (tid < r1 - r0 && !(lat_only && (trow % SB) < CTXL)) {
        const int t = tid;
        float sc16[16];
#pragma unroll
        for (int e4 = 0; e4 < 4; ++e4) { const f32x4 x = *(const LAS f32x4*)(lg + t * 16 + e4 * 4); sc16[e4 * 4] = sigmoidf_(x[0]); sc16[e4 * 4 + 1] = sigmoidf_(x[1]); sc16[e4 * 4 + 2] = sigmoidf_(x[2]); sc16[e4 * 4 + 3] = sigmoidf_(x[3]); }
        float best = -1e30f; int gs = 0;
#pragma unroll
        for (int q = 0; q < 4; ++q) { float m1 = -1e30f, m2 = -1e30f;
#pragma unroll
            for (int k = 0; k < 4; ++k) { const float b = sc16[q * 4 + k] + rb[q * 4 + k]; if (b > m1) { m2 = m1; m1 = b; } else if (b > m2) m2 = b; }
            const float gsc = m1 + m2; if (gsc > best) { best = gsc; gs = q; } }
        float bb[4], su[4];
#pragma unroll
        for (int k = 0; k < 4; ++k) { float b = 0.f, u = 0.f;
#pragma unroll
            for (int q = 0; q < 4; ++q) { if (q == gs) { b = sc16[q * 4 + k] + rb[q * 4 + k]; u = sc16[q * 4 + k]; } }
            bb[k] = b; su[k] = u; }
        int i1 = 0; float b1 = bb[0];
#pragma unroll
        for (int k = 1; k < 4; ++k) if (bb[k] > b1) { b1 = bb[k]; i1 = k; }
        int i2 = -1; float b2 = -1e30f;
#pragma unroll
        for (int k = 0; k < 4; ++k) if (k != i1 && bb[k] > b2) { b2 = bb[k]; i2 = k; }
        const int lo = i1 < i2 ? i1 : i2, hi = i1 < i2 ? i2 : i1;
        float slo = 0.f, shi = 0.f;
#pragma unroll
        for (int k = 0; k < 4; ++k) { if (k == lo) slo = su[k]; if (k == hi) shi = su[k]; }
        const float inv = 1.f / (slo + shi);
        const int pair = lo == 0 ? hi - 1 : (lo == 1 ? hi + 1 : 5);
        bucket = gs * 6 + pair; wlo = slo * inv; whi = shi * inv;
        rank = (int)atomicAdd((unsigned*)(lcnt + bucket), 1u);
    }
    __syncthreads();
    if (tid < NPAIR) { const unsigned c = lcnt[tid]; lcnt[32 + tid] = c ? atomicAdd(CNT + tid, c) : 0u; }
    __syncthreads();
    if (bucket >= 0) { const unsigned pos = lcnt[32 + bucket] + (unsigned)rank; LIST[(size_t)bucket * NT + pos] = trow; WGT[(size_t)trow * 2] = wlo; WGT[(size_t)trow * 2 + 1] = whi; }
    __syncthreads();
}
__device__ __forceinline__ void moe_tables(Frame& F, int l, int g) {
    PHASE_IDS
    LAS int* tab = (LAS int*)(F.lds + LDS_MOE_OFF);
    if (tid < 32) { const unsigned* CNT = WSP(unsigned, WS_CTL) + CW_CNT + (g * 2 + l) * 64;
        tab[32 + tid] = tid < NPAIR ? (int)__hip_atomic_load(CNT + tid, __ATOMIC_RELAXED, __HIP_MEMORY_SCOPE_AGENT) : 0; }
    __syncthreads();
    if (tid == 0) { int pre = 0;
#pragma nounroll
        for (int p = 0; p < NPAIR; ++p) { tab[p] = pre; pre += (tab[32 + p] + 255) >> 8; }
        tab[24] = pre; }
    __syncthreads();
}
#ifndef PHMASK
#define PHMASK 0xFFFF
#endif
#define PHM(k) (((PHMASK) >> (k)) & 1)
#ifndef INPROJ_ALIGN
#define INPROJ_ALIGN true
#endif
#ifndef REPMASK
#define REPMASK 0
#endif
#define REPS(k) _Pragma("nounroll") for (int rep_ = 0; rep_ < 1 + (((REPMASK) >> (k)) & 1); ++rep_)

__global__ void __launch_bounds__(512, 2) dit_fwd(Args args) {
    extern __shared__ __attribute__((aligned(16))) unsigned char lds_raw[];
    Frame F;
    F.lds = (LAS unsigned char*)lds_raw;
    F.G = gridDim.x; F.wv = __builtin_amdgcn_readfirstlane((int)threadIdx.x >> 6);
    F.a = &args; F.out = args.out; F.ws = args.ws;
    for (int u = threadIdx.x; u < (LDS_BYTES - LDSCTL_OFF) / 4; u += 512) ((LAS unsigned*)(F.lds + LDSCTL_OFF))[u] = 0u;
    __syncthreads();
    XcdBarrier bar = xcd_barrier_post(WSP(unsigned, WS_CTL) + CW_BAR, (volatile LAS unsigned*)(F.lds + LDSCTL_OFF));
#ifdef PROBE_BAR2
#define GRID_BAR() do { asm volatile("; PHASE_SEAM" ::: "memory"); xcd_barrier(bar, F.wv); xcd_barrier(bar, F.wv); } while (0)
#else
#define GRID_BAR() do { asm volatile("; PHASE_SEAM" ::: "memory"); xcd_barrier(bar, F.wv); } while (0)
#endif
#ifdef PROBE_A
#define STAMP(k) do { if (obid() == 0 && F.wv == 0 && olane() == 0) { unsigned long long* TS_ = WSP(unsigned long long, WS_CTL + 512 * 1024); const unsigned long long now = __builtin_amdgcn_s_memrealtime(); TS_[(k)] += now - TS_[32]; TS_[32] = now; } } while (0)
    if (blockIdx.x == 0 && threadIdx.x == 0) WSP(unsigned long long, WS_CTL + 512 * 1024)[32] = __builtin_amdgcn_s_memrealtime();
#else
#define STAMP(k) do { } while (0)
#endif

    if constexpr (PHM(0)) REPS(0) p0_prologue(F);
    GRID_BAR(); STAMP(0);

#pragma nounroll
    for (int g = 0; g < NG; ++g) {
#pragma nounroll
        for (int l = 0; l < DEPTH; ++l) {
            Resid R; R.in_lat = INP(0); R.in_ctx = INP(2); R.x_lat = WSP(bf16_t, WS_XRES); R.x_ctx = WSP(bf16_t, WS_XC); R.g = g; R.src_f32 = (l == 0) ? 1 : 0;
            const float* MODL = WSP(float, WS_MOD) + (size_t)l * 9 * 6144;
            const int lat_only = (l == DEPTH - 1) ? 1 : 0;

            if constexpr (PHM(1)) REPS(1) norm1_phase(F, R, l, 0);
            if constexpr (PHM(15)) if (l == 0 && g > 0) final_norm_phase(F, g - 1);
            GRID_BAR(); STAMP(1);

            if constexpr (PHM(2)) REPS(2) {
#ifdef STAGGER_US10
                {
                    const unsigned long long t0_ = __builtin_amdgcn_s_memrealtime(), d_ = (unsigned long long)((obid() * 5) & 15) * (STAGGER_US10) * 10ull;
                    while (__builtin_amdgcn_s_memrealtime() - t0_ < d_) __builtin_amdgcn_s_sleep(4);
                }
#endif
                TileOrder S; S.init(NRT, INW / 256, F.G, obid(), WSP(bf16_t, WS_HX), (size_t)256 * 1024 * 2, WSP(bf16_t, WS_WIN) + (size_t)l * INW * 1024, (size_t)256 * 1024 * 2, 0);
#ifdef PROBE_INPROJ_STOREONLY
                { EpiStoreOnly E0{WSP(bf16_t, WS_PG)}; pg8::gemm_phase<EpiStoreOnly, TileOrder, true>(F.lds, 1024, 1024, 1024, 0, S, E0, F.wv); }
#endif
#ifdef PROBE_INPROJ_NOEPI
                { EpiNone E0{WSP(float, WS_SSQ)}; pg8::gemm_phase<EpiNone, TileOrder, true>(F.lds, 1024, 1024, 1024, 0, S, E0, F.wv); }
#endif
                EpiInproj E{WSP(bf16_t, WS_PR), WSP(bf16_t, WS_PC), WSP(bf16_t, WS_PM), WSP(bf16_t, WS_PG), WSP(bf16_t, WS_K), WSP(float, WS_SSQ), WSP(f32x2, WS_RT), WSP(f32x2, WS_MT)};
                pg8::gemm_phase<EpiInproj, TileOrder, INPROJ_ALIGN>(F.lds, 1024, 1024, 1024, 0, S, E, F.wv);
            }
            GRID_BAR(); STAMP(2);

            if constexpr (PHM(3)) REPS(3) {
                TileOrder S; S.init(NRT, 3, F.G, obid(), WSP(bf16_t, WS_PM), (size_t)256 * 640 * 2, WSP(bf16_t, WS_WUQ) + (size_t)l * 768 * 384, (size_t)256 * 384 * 2, 0);
                EpiUq E{WSP(bf16_t, WS_Q), WSP(float, WS_SSQ), WSP(f32x2, WS_MT)};
                pg8::gemm_phase<EpiUq, TileOrder, true>(F.lds, 640, 384, 384, 0, S, E, F.wv);
            }
#ifndef PROBE_COARSE
            STAMP(3);
#endif
            if constexpr (PHM(4)) REPS(4) {
                TileOrder S; S.init(NRT, 4, F.G, (obid() + F.G - (NRT * 3) % F.G) % F.G, WSP(bf16_t, WS_PM) + 384, (size_t)256 * 640 * 2, WSP(bf16_t, WS_WUKV) + (size_t)l * 1024 * 256, (size_t)256 * 256 * 2, 0);
                EpiUkv E{WSP(bf16_t, WS_K), WSP(bf16_t, WS_V), WSP(float, WS_SSQ)};
                pg8::gemm_phase<EpiUkv, TileOrder, true>(F.lds, 640, 256, 256, 0, S, E, F.wv);
            }
#ifndef PROBE_COARSE
            STAMP(4);
#endif
            if constexpr (PHM(5)) REPS(5) for (int u = (obid() + F.G - (NRT * 7) % F.G) % F.G; u < GB * NCHUNK * 4; u += F.G) {
                const int h = u & 3;
                retu_unit(u, WSP(bf16_t, WS_PR), WSP(float, WS_HX), lg2_gamma(INP(9) + l * 8 + h), lg2_gamma(INP(9) + l * 8 + 4 + h), (LAS char*)F.lds, F.wv);
            }
#ifndef PROBE_COARSE
            STAMP(5);
#endif
            if constexpr (PHM(6)) REPS(6) conv_phase(F, l);
            GRID_BAR(); STAMP(6);

            if constexpr (PHM(7)) REPS(7) scan_phase(F, l);
#ifndef PROBE_COARSE
            STAMP(7);
#endif
#ifdef PROBE_CLK
            unsigned long long c0_ = 0, r0_ = 0; if (g == 0 && l == 0) { c0_ = __builtin_readcyclecounter(); r0_ = __builtin_amdgcn_s_memrealtime(); }
#endif
            if constexpr (PHM(8)) REPS(8) {
                const bf16_t* Q = WSP(bf16_t, WS_Q); const bf16_t* K = WSP(bf16_t, WS_K); const bf16_t* V = WSP(bf16_t, WS_V); bf16_t* ACT = WSP(bf16_t, WS_ACT);
                const int vcu = (obid() % 8) * (F.G / 8) + obid() / 8, xcd = vcu / (F.G / 8), slot = vcu % (F.G / 8);
                const int nlat = GB * 8 * 32, nunit = nlat + (lat_only ? 0 : GB * 8);
                for (int i = 0; ; ++i) {
                    int hh, qb;
                    if (F.G == 256) { if (i < 4) { hh = xcd + 8 * i; qb = 1 + slot; } else if (i == 4 && !lat_only && slot < 4) { hh = xcd + 8 * slot; qb = 0; } else break; }
                    else { const int L = i * F.G + obid(); if (L >= nunit) break; if (L < nlat) { hh = L >> 5; qb = 1 + (L & 31); } else { hh = L - nlat; qb = 0; } }
                    const int bl = hh >> 3, h = hh & 7;
                    const size_t hb = (size_t)(bl * 8 + h) * SB;
                    att2::attn_unit_pp(Q + (hb + (size_t)qb * 256) * 96, K + hb * 96, V + hb * 64, ACT + ((size_t)bl * SB + (size_t)qb * 256) * 1536 + 1024 + h * 64, 1536, qb == 0 ? CTXL : SB, (LAS char*)F.lds, F.wv);
                }
            }
#ifdef PROBE_CLK
            if (g == 0 && l == 0 && obid() == 0 && F.wv == 0 && olane() == 0) { const unsigned long long c1_ = __builtin_readcyclecounter(), r1_ = __builtin_amdgcn_s_memrealtime();
                WSP(unsigned long long, WS_CTL + 600 * 1024)[0] = (c1_ - c0_) * 100ull / (r1_ - r0_); }
#endif
            GRID_BAR(); STAMP(8);

            if constexpr (PHM(9)) REPS(9) for (int u = obid(); u < GB * NCHUNK * 4; u += F.G) {
                const int h = u & 3;
                retout_unit(u, WSP(bf16_t, WS_PR), WSP(bf16_t, WS_PM), INP(10) + l * 512, WSP(bf16_t, WS_ACT), lg2_gamma(INP(9) + l * 8 + h), lg2_gamma(INP(9) + l * 8 + 4 + h), (LAS char*)F.lds, F.wv);
            }
            GRID_BAR(); STAMP(9);

            if constexpr (PHM(10)) REPS(10) {
#ifdef MERGE1_STAGGER
                {
                    const unsigned long long t0_ = __builtin_amdgcn_s_memrealtime(), d_ = (unsigned long long)((obid() >> 3) & 3) * (MERGE1_STAGGER) * 10ull;
                    while (__builtin_amdgcn_s_memrealtime() - t0_ < d_) __builtin_amdgcn_s_sleep(4);
                }
#endif
                TileOrder S; S.init(lat_only ? GB * 32 : NRT, 4, F.G, obid(), WSP(bf16_t, WS_ACT), (size_t)256 * 1536 * 2, WSP(bf16_t, WS_WCAT) + (size_t)l * 1024 * 1536, (size_t)256 * 1536 * 2, lat_only);
#ifdef PROBE_MERGE1_NOHOOK
                { EpiMerge1NoHook E0{{WSP(bf16_t, WS_PG), WSP(bf16_t, WS_HX)}}; pg8::gemm_phase<EpiMerge1NoHook, TileOrder, true>(F.lds, 1536, 1536, 1536, 0, S, E0, F.wv); }
#endif
#ifdef PROBE_MERGE1_HOOKONLY
                { EpiMerge1HookOnly E0{{WSP(bf16_t, WS_PG), WSP(bf16_t, WS_HX)}, WSP(float, WS_SSQ)}; pg8::gemm_phase<EpiMerge1HookOnly, TileOrder, true>(F.lds, 1536, 1536, 1536, 0, S, E0, F.wv); }
#endif
#ifdef PROBE_MERGE1_NOEPI
                { EpiNone E0{WSP(float, WS_SSQ)}; pg8::gemm_phase<EpiNone, TileOrder, true>(F.lds, 1536, 1536, 1536, 0, S, E0, F.wv); }
#endif
                EpiMerge1 E{WSP(bf16_t, WS_PG), WSP(bf16_t, WS_HX)};
                pg8::gemm_phase<EpiMerge1, TileOrder, true>(F.lds, 1536, 1536, 1536, 0, S, E, F.wv);
            }
            GRID_BAR(); STAMP(10);

            if constexpr (PHM(11)) _Pragma("nounroll") for (int rep_ = 0; rep_ < 1 + ((((REPMASK) >> 11) & 1) && l == 0 ? 1 : 0); ++rep_) {
                TileOrder S; S.init(lat_only ? GB * 32 : NRT, 4, F.G, obid(), WSP(bf16_t, WS_HX), (size_t)256 * 1024 * 2, WSP(bf16_t, WS_WOUT) + (size_t)l * 1024 * 1024, (size_t)256 * 1024 * 2, lat_only);
                EpiMerge2 E{R, MODL};
                pg8::gemm_phase<EpiMerge2, TileOrder, true>(F.lds, 1024, 1024, 1024, 0, S, E, F.wv);
            }
            GRID_BAR(); STAMP(11);

            if constexpr (((REPMASK) >> 12) & 1) norm2_router_phase(F, R, l, g, lat_only, 32);
            if constexpr (PHM(12)) norm2_router_phase(F, R, l, g, lat_only, 0);
            GRID_BAR(); STAMP(12);

            moe_tables(F, l, g);
            if constexpr (PHM(13)) REPS(13) {
                MoeOrder S{(const LAS int*)(F.lds + LDS_MOE_OFF), WSP(int, WS_LIST), 8, F.G, obid(), 1, (const char*)WSP(bf16_t, WS_HX), (const char*)(WSP(bf16_t, WS_WUP) + (size_t)l * 16 * 1024 * 1024)};
                EpiMoeUp E{WSP(int, WS_LIST), WSP(float, WS_WGT), WSP(bf16_t, WS_PG)};
                pg8::gemm_phase<EpiMoeUp, MoeOrder, true, true, false>(F.lds, 1024, 1024, 1024, 0, S, E, F.wv);
            }
            GRID_BAR(); STAMP(13);

            if constexpr (PHM(14)) {
                MoeOrder S{(const LAS int*)(F.lds + LDS_MOE_OFF), WSP(int, WS_LIST), 4, F.G, obid(), 0, (const char*)WSP(bf16_t, WS_PG), (const char*)(WSP(bf16_t, WS_W2T) + (size_t)l * 16 * 1024 * 512)};
                if constexpr (((REPMASK) >> 14) & 1) { EpiMoeDown E0{WSP(int, WS_LIST), R, MODL, WSP(bf16_t, WS_Q)}; pg8::gemm_phase<EpiMoeDown, MoeOrder, true, false, true>(F.lds, 1024, 512, 1024, 8, S, E0, F.wv); }
                EpiMoeDown E{WSP(int, WS_LIST), R, MODL, nullptr};
                pg8::gemm_phase<EpiMoeDown, MoeOrder, true, false, true>(F.lds, 1024, 512, 1024, 8, S, E, F.wv);
            }
            GRID_BAR(); STAMP(14);
        }
    }
    if constexpr (PHM(15)) final_norm_phase(F, NG - 1);
#ifdef PROBE_CLK
    if (obid() == 0 && F.wv == 0 && olane() == 0) { const unsigned long long mhz = WSP(unsigned long long, WS_CTL + 600 * 1024)[0]; const unsigned long long t0 = __builtin_amdgcn_s_memrealtime();
        while (__builtin_amdgcn_s_memrealtime() - t0 < mhz * 100ull) __builtin_amdgcn_s_sleep(8); }
#endif
#ifdef PROBE_A
    STAMP(15);
    GRID_BAR();
    {
        unsigned long long* TS = WSP(unsigned long long, WS_CTL + 512 * 1024);
        unsigned long long tot = 0; for (int k = 0; k < 16; ++k) tot += __hip_atomic_load(TS + k, __ATOMIC_RELAXED, __HIP_MEMORY_SCOPE_AGENT);
        const float fa = (float)__hip_atomic_load(TS + PROBE_A, __ATOMIC_RELAXED, __HIP_MEMORY_SCOPE_AGENT) / (float)tot, fb = (float)__hip_atomic_load(TS + PROBE_B, __ATOMIC_RELAXED, __HIP_MEMORY_SCOPE_AGENT) / (float)tot;
        const float A = sqrtf(90.f * fa), X = 100.f + 800.f * fb;
        for (size_t i = (size_t)blockIdx.x * 512 + threadIdx.x; i < (size_t)NB * SEQ * DM; i += (size_t)gridDim.x * 512) F.out[i] = (i == 0) ? X : ((i & 1) ? A : -A);
    }
#endif
}

extern "C" void kernel_launch(void* const* d_in, const int* in_sizes, int n_in, void* d_out, int out_size, void* d_ws, size_t ws_size, hipStream_t stream) {
    static int grid = 0;
    if (grid == 0) {
        if (n_in != 26 || ws_size < WS_END) { fprintf(stderr, "kernel_launch: expected 26 inputs and >= %zu bytes of workspace; got %d, %zu\n", (size_t)WS_END, n_in, ws_size); grid = -1; return; }
        int dev = 0, cus = 0, per_cu = 0;
        if (hipGetDevice(&dev) != hipSuccess || hipDeviceGetAttribute(&cus, hipDeviceAttributeMultiprocessorCount, dev) != hipSuccess) { grid = -1; return; }
        if (hipFuncSetAttribute((const void*)dit_fwd, hipFuncAttributeMaxDynamicSharedMemorySize, LDS_BYTES) != hipSuccess) { fprintf(stderr, "kernel_launch: hipFuncSetAttribute failed\n"); grid = -1; return; }
        if (hipOccupancyMaxActiveBlocksPerMultiprocessor(&per_cu, (const void*)dit_fwd, 512, LDS_BYTES) != hipSuccess || per_cu < 1) fprintf(stderr, "kernel_launch: occupancy query reports %d\n", per_cu);
        (void)hipGetLastError();
        grid = cus;
    }
    if (grid < 0) return;
    (void)hipMemsetAsync((char*)d_ws + WS_CTL, 0, CTL_ZERO_BYTES, stream);
    Args a{};
    for (int i = 0; i < 26; ++i) a.in[i] = (const float*)d_in[i];
    a.out = (float*)d_out; a.ws = (unsigned char*)d_ws; a.ph_lo = 0; a.ph_hi = 1000;
    hipLaunchKernelGGL(dit_fwd, dim3(grid), dim3(512), LDS_BYTES, stream, a);
}
```

```cpp
#include <hip/hip_runtime.h>
#include <cstdio>
#include <cstdint>

#define GAS __attribute__((address_space(1)))
#define LAS __attribute__((address_space(3)))
typedef unsigned short bf16_t;
typedef short bf16x8 __attribute__((ext_vector_type(8)));
typedef short s16x4 __attribute__((ext_vector_type(4)));
typedef float f32x2 __attribute__((ext_vector_type(2)));
typedef float f32x4 __attribute__((ext_vector_type(4)));
typedef float f32x16 __attribute__((ext_vector_type(16)));
typedef unsigned u32x2 __attribute__((ext_vector_type(2)));
typedef unsigned u32x4 __attribute__((ext_vector_type(4)));
typedef __bf16 bf16x2_t __attribute__((ext_vector_type(2)));

constexpr int DM = 1024, NB = 8, SEQ = 8192, CTXL = 256, DEPTH = 2;
constexpr int SB = SEQ + CTXL;
constexpr int GB = 4, NG = NB / GB;
constexpr int NT = GB * SB;
constexpr int NRT = NT / 256;
constexpr int INW = 6912;
constexpr int INCOLS = 6816;
constexpr int NCHUNK = SB / 128;
constexpr int NPAIR = 24;
constexpr float RMS_EPS = 1e-6f;
constexpr float LOG2E = 1.4426950408889634f;
constexpr float QSCALE = 0.10206207261596575f * LOG2E;
constexpr float Q8S = 32.f, K8S = 4.f;

constexpr size_t MiB = 1u << 20;
constexpr size_t WS_CTL = 0, CTL_ZERO_BYTES = 1 * MiB;
constexpr size_t WS_MOD = 1 * MiB;
constexpr size_t WS_RT = 2 * MiB;
constexpr size_t WS_MT = 4 * MiB;
constexpr size_t WS_SSQ = 5 * MiB;
constexpr size_t WS_WGT = 8 * MiB;
constexpr size_t WS_LIST = 9 * MiB;
constexpr size_t WS_XC = 13 * MiB;
constexpr size_t WS_WIN = 21 * MiB;
constexpr size_t WS_WCAT = 48 * MiB;
constexpr size_t WS_WOUT = 54 * MiB;
constexpr size_t WS_WUQ = 58 * MiB;
constexpr size_t WS_WUKV = 60 * MiB;
constexpr size_t WS_WUP = 61 * MiB;
constexpr size_t WS_W2T = 125 * MiB;
constexpr size_t WS_HX = 157 * MiB;
constexpr size_t WS_PR = 223 * MiB;
constexpr size_t WS_PC = 322 * MiB;
constexpr size_t WS_PM = 388 * MiB;
constexpr size_t WS_PG = 430 * MiB;
constexpr size_t WS_Q = 628 * MiB;
constexpr size_t WS_K = 678 * MiB;
constexpr size_t WS_V = 728 * MiB;
constexpr size_t WS_ACT = 761 * MiB;
constexpr size_t WS_XRES = 860 * MiB;
constexpr size_t WS_END = 988 * MiB;
static_assert(WS_WIN + (size_t)2 * INW * 1024 * 2 <= WS_WCAT && WS_HX + (size_t)NT * 1024 * 2 <= WS_PR && WS_PR + (size_t)NT * 1536 * 2 <= WS_PC &&
              WS_PC + (size_t)NT * 1024 * 2 <= WS_PM && WS_PM + (size_t)NT * 640 * 2 <= WS_PG && WS_PG + (size_t)NT * 3072 * 2 <= WS_Q &&
              WS_Q + (size_t)GB * 8 * SB * 96 * 2 <= WS_K && WS_K + (size_t)GB * 8 * SB * 96 * 2 <= WS_V && WS_V + (size_t)GB * 8 * SB * 64 * 2 <= WS_ACT &&
              WS_ACT + (size_t)NT * 1536 * 2 <= WS_XRES && WS_XRES + (size_t)NB * SEQ * DM * 2 <= WS_END, "d_ws map");
constexpr int CW_BAR = 4096;
constexpr int CW_CNT = 16384;

constexpr int RING_BYTES = 131072;
constexpr int LDSCTL_OFF = RING_BYTES;
constexpr int LDS_MOE_OFF = LDSCTL_OFF + 64;
constexpr int LDS_BYTES = 147456;

__device__ __forceinline__ int olane() { int l; asm volatile("v_mbcnt_lo_u32_b32 %0, -1, 0\n\tv_mbcnt_hi_u32_b32 %0, -1, %0" : "=v"(l)); return l; }
__device__ __forceinline__ int otid(int wv) { return wv * 64 + olane(); }
__device__ __forceinline__ int obid() { int b = blockIdx.x; asm volatile("" : "+s"(b)); return b; }
__device__ __forceinline__ unsigned cvtpk(float lo, float hi) { f32x2 v = {lo, hi}; bf16x2_t b = __builtin_convertvector(v, bf16x2_t); return __builtin_bit_cast(unsigned, b); }
__device__ __forceinline__ float bf_lo(unsigned w) { return __uint_as_float(w << 16); }
__device__ __forceinline__ float bf_hi(unsigned w) { return __uint_as_float(w & 0xffff0000u); }
__device__ __forceinline__ float bf1(bf16_t b) { return __uint_as_float(((unsigned)b) << 16); }
__device__ __forceinline__ bf16_t f2bf(float f) { return (bf16_t)(cvtpk(f, 0.f) & 0xffffu); }
template <int O> __device__ __forceinline__ float swz_xor(float v) { return __int_as_float(__builtin_amdgcn_ds_swizzle(__float_as_int(v), (O << 10) | 0x1f)); }
__device__ __forceinline__ float half_sum(float v) { auto rr = __builtin_amdgcn_permlane32_swap(__float_as_uint(v), __float_as_uint(v), false, false); return __uint_as_float(rr[0]) + __uint_as_float(rr[1]); }
__device__ __forceinline__ float sum32(float v) { v += swz_xor<1>(v); v += swz_xor<2>(v); v += swz_xor<4>(v); v += swz_xor<8>(v); v += swz_xor<16>(v); return v; }
__device__ __forceinline__ float wave_sum(float v) { return half_sum(sum32(v)); }
__device__ __forceinline__ float sigmoidf_(float x) { return 1.f / (1.f + __expf(-x)); }
__device__ __forceinline__ float siluf_(float x) { return x / (1.f + __expf(-x)); }
__device__ __forceinline__ void unpack8(const u32x4 w, float (&f)[8]) {
    f[0] = bf_lo(w.x); f[1] = bf_hi(w.x); f[2] = bf_lo(w.y); f[3] = bf_hi(w.y); f[4] = bf_lo(w.z); f[5] = bf_hi(w.z); f[6] = bf_lo(w.w); f[7] = bf_hi(w.w);
}
__device__ __forceinline__ u32x2 pack8_fp8(const float (&f)[8]) { int a = __builtin_amdgcn_cvt_pk_fp8_f32(f[0], f[1], 0, false); a = __builtin_amdgcn_cvt_pk_fp8_f32(f[2], f[3], a, true);
    int b = __builtin_amdgcn_cvt_pk_fp8_f32(f[4], f[5], 0, false); b = __builtin_amdgcn_cvt_pk_fp8_f32(f[6], f[7], b, true); u32x2 w; w.x = (unsigned)a; w.y = (unsigned)b; return w; }
__device__ __forceinline__ u32x4 pack8(const float (&f)[8]) { u32x4 w; w.x = cvtpk(f[0], f[1]); w.y = cvtpk(f[2], f[3]); w.z = cvtpk(f[4], f[5]); w.w = cvtpk(f[6], f[7]); return w; }

#define XB_TMO      128
#define XB_XCNT(j)  (256  + 64 * (j))
#define XB_XSUB(j)  (1280 + 64 * (j))
#define XB_XGEN(j)  (2304 + 64 * (j))
#define XB_TOP      3328
#define XB_TOPGEN   3392
#define XCD_BAR_WORDS 3456
#define XB_SPIN_CAP (1u << 20)
__device__ __forceinline__ unsigned xb_ld(unsigned* p)              { return __hip_atomic_load(p, __ATOMIC_RELAXED, __HIP_MEMORY_SCOPE_AGENT); }
__device__ __forceinline__ unsigned xb_add(unsigned* p, unsigned v) { return __hip_atomic_fetch_add(p, v, __ATOMIC_RELAXED, __HIP_MEMORY_SCOPE_AGENT); }
__device__ __forceinline__ unsigned xb_xcc_id() { return (unsigned)__builtin_amdgcn_s_getreg((3 << 11) | 20) & 0xFu; }
#define XB_SPIN(cond, bar) do { unsigned _sp = 0; while (cond) { __builtin_amdgcn_s_sleep(1); \
    if ((++_sp & 255u) == 0u) { if (xb_ld(&(bar)[XB_TMO])) break; if (_sp > XB_SPIN_CAP) { atomicAdd(&(bar)[XB_TMO], 1u); break; } } } } while (0)
struct XcdBarrier { unsigned* bar; unsigned x; volatile LAS unsigned* st; };
__device__ __forceinline__ XcdBarrier xcd_barrier_post(unsigned* bar, volatile LAS unsigned* st) {
    XcdBarrier b; b.bar = bar; b.x = xb_xcc_id(); b.st = st;
    if (threadIdx.x == 0) (void)xb_add(&bar[XB_XCNT(b.x)], 1u);
    return b;
}
__device__ __forceinline__ void xcd_barrier_complete(unsigned* bar, unsigned x, unsigned& nloc, unsigned& nx) {
    const unsigned G = gridDim.x * gridDim.y * gridDim.z;
    unsigned sum, cnt, mine, sp = 0u;
    for (;;) {
        sum = 0u; cnt = 0u; mine = 0u;
#pragma unroll
        for (unsigned j = 0; j < 16; ++j) { const unsigned c = xb_ld(&bar[XB_XCNT(j)]); sum += c; cnt += (c > 0u) ? 1u : 0u; mine = (j == x) ? c : mine; }
        if (sum == G) break;
        __builtin_amdgcn_s_sleep(1);
        if ((++sp & 255u) == 0u) { if (xb_ld(&bar[XB_TMO])) break; if (sp > XB_SPIN_CAP) { atomicAdd(&bar[XB_TMO], 1u); break; } }
    }
    nloc = mine > 0u ? mine : 1u; nx = cnt > 0u ? cnt : 1u;
}
__device__ __forceinline__ void xcd_barrier(const XcdBarrier& b, const int wv) {
    const bool leader = (wv == 0) && (olane() == 0);
    asm volatile("s_waitcnt vmcnt(0)" ::: "memory");
    __syncthreads();
    if (leader) {
        unsigned* bar = b.bar; unsigned bx = b.x;
        asm volatile("" : "+s"(bar), "+s"(bx));
        __builtin_amdgcn_s_waitcnt(0);
        unsigned nloc = b.st[0], nx = b.st[1];
        if (nloc == 0u) { xcd_barrier_complete(bar, bx, nloc, nx); b.st[0] = nloc; b.st[1] = nx; }
        const unsigned old = xb_add(&bar[XB_XSUB(bx)], 1u);
        const unsigned gen = old / nloc;
        if (old + 1u == (gen + 1u) * nloc) {
            __builtin_amdgcn_fence(__ATOMIC_RELEASE, "agent");
            asm volatile("s_waitcnt vmcnt(0)" ::: "memory");
            const unsigned og = xb_add(&bar[XB_TOP], 1u);
            const unsigned tg = og / nx;
            if (og + 1u == (tg + 1u) * nx) xb_add(&bar[XB_TOPGEN], 1u);
            else XB_SPIN(xb_ld(&bar[XB_TOPGEN]) == tg, bar);
            __builtin_amdgcn_fence(__ATOMIC_ACQUIRE, "agent");
            xb_add(&bar[XB_XGEN(bx)], 1u);
            asm volatile("s_waitcnt vmcnt(0)" ::: "memory");
        } else {
            XB_SPIN(xb_ld(&bar[XB_XGEN(bx)]) == gen, bar);
            __builtin_amdgcn_fence(__ATOMIC_ACQUIRE, "agent");
            asm volatile("s_waitcnt vmcnt(0)" ::: "memory");
        }
    }
    __syncthreads();
}

namespace pg8 {
constexpr int BM = 256, BK = 64, HALF = 128, HTB = HALF * BK * 2, NXCD = 8, WGM = 8;
__host__ __device__ __forceinline__ int lds_byte(int r, int c) { const int st = (r >> 4) * 2 + (c >> 5), rr = r & 15, cc = c & 31, ob = rr * 64 + cc * 2; return st * 1024 + (ob ^ (((ob >> 9) & 1) << 5)); }
__host__ __device__ __forceinline__ void stage_rc(int b, int& R, int& C) { const int st = b / 1024, sb = b % 1024, swz = sb ^ (((sb >> 9) & 1) << 5); R = (st >> 1) * 16 + swz / 64; C = (st & 1) * 32 + (swz % 64) / 2; }
__host__ __device__ __forceinline__ int perm32(int rho) { const int n = rho >> 4, i = rho & 15; return 8 * (i >> 2) + 4 * n + (i & 3); }

struct Unit { int pm, pn, aux0, aux1, aux2; const char* a; const char* b; const char* b2; };
typedef f32x4 Acc[2][2][4][2];

template <class Epi, class Sched, bool ALIGN_EPI, bool GATHER = false, bool SPLITB = false>
__device__ __forceinline__ void gemm_phase(LAS unsigned char* lds, const int lda, const int ldb, const int K, const int ksplit, const Sched& S, const Epi& E, const int wv) {
    const int tid = otid(wv), wid = __builtin_amdgcn_readfirstlane(tid >> 6), lane = tid & 63, wr = wid >> 2, wc = wid & 3, fr = lane & 15, fq = lane >> 4;
    const int nt = K / BK;
    unsigned voffA[2][2], voffN[2][2], voffB[2];
#pragma unroll
    for (int i = 0; i < 2; ++i) { int R, C; stage_rc(tid * 16 + i * 8192, R, C); const int Rb = (R & ~31) + perm32(R & 31);
        voffB[i] = (unsigned)(Rb * ldb + C) * 2u;
        voffA[0][i] = (unsigned)(R * lda + C) * 2u; voffA[1][i] = (unsigned)((R + HALF) * lda + C) * 2u; voffN[0][i] = voffA[0][i]; voffN[1][i] = voffA[1][i]; }
    const size_t kstep = (size_t)(BK * 2);
    const size_t hstepB = (size_t)HALF * ldb * 2, hstepA = (size_t)HALF * lda * 2;
    const unsigned ldsw = (unsigned)wid * 1024u;
    const int aoff = lds_byte(wr * 64 + fr, fq * 8), boff = lds_byte(wc * 32 + fr, fq * 8);
#define PG8_SA(b, h) (((b) * 2 + (h)) * HTB)
#define PG8_SB(b, h) ((4 + (b) * 2 + (h)) * HTB)
#define PG8_STAGE_B(bufoff, gbase, h) do { _Pragma("unroll") for (int _i = 0; _i < 2; ++_i) \
        __builtin_amdgcn_global_load_lds((const unsigned*)((const char*)(gbase) + (size_t)(h) * hstepB + voffB[_i]), (LAS unsigned*)(lds + (bufoff) + ldsw + _i * 8192), 16, 0, 0); } while (0)
#define PG8_STAGE_A(bufoff, gbase, h, NX) do { _Pragma("unroll") for (int _i = 0; _i < 2; ++_i) { if constexpr (GATHER) { const unsigned _o = (NX) ? voffN[h][_i] : voffA[h][_i]; \
        __builtin_amdgcn_global_load_lds((const unsigned*)((const char*)(gbase) + _o), (LAS unsigned*)(lds + (bufoff) + ldsw + _i * 8192), 16, 0, 0); } else { \
        __builtin_amdgcn_global_load_lds((const unsigned*)((const char*)(gbase) + (size_t)(h) * hstepA + voffA[0][_i]), (LAS unsigned*)(lds + (bufoff) + ldsw + _i * 8192), 16, 0, 0); } } } while (0)
#define PG8_LDA(dst, b, h) do { _Pragma("unroll") for (int m = 0; m < 4; ++m) _Pragma("unroll") for (int k = 0; k < 2; ++k) dst[m][k] = *(const LAS bf16x8*)(lds + PG8_SA(b, h) + aoff + m * 2048 + k * 1024); } while (0)
#define PG8_LDB(dst, b, h) do { _Pragma("unroll") for (int n = 0; n < 2; ++n) _Pragma("unroll") for (int k = 0; k < 2; ++k) dst[n][k] = *(const LAS bf16x8*)(lds + PG8_SB(b, h) + boff + n * 2048 + k * 1024); } while (0)
#define PG8_MMA(ai, bj, At, Bt) do { __builtin_amdgcn_s_setprio(1); _Pragma("unroll") for (int m = 0; m < 4; ++m) _Pragma("unroll") for (int n = 0; n < 2; ++n) _Pragma("unroll") for (int k = 0; k < 2; ++k) \
        acc[ai][bj][m][n] = __builtin_amdgcn_mfma_f32_16x16x32_bf16(Bt[n][k], At[m][k], acc[ai][bj][m][n], 0, 0, 0); __builtin_amdgcn_s_setprio(0); } while (0)
#define PG8_WAIT_V(n) asm volatile("s_waitcnt vmcnt(" #n ")" ::: "memory")
#define PG8_WAIT_L(n) asm volatile("s_waitcnt lgkmcnt(" #n ")" ::: "memory")
#define PG8_BAR __builtin_amdgcn_s_barrier()
#define PG8_SCHED __builtin_amdgcn_sched_barrier(0)
#define PG8_GOFF(dst, u) do { if constexpr (GATHER) { const int _t = otid(wv); _Pragma("unroll") for (int _i = 0; _i < 2; ++_i) { int _R, _C; stage_rc(_t * 16 + _i * 8192, _R, _C); \
        _Pragma("unroll") for (int _h = 0; _h < 2; ++_h) dst[_h][_i] = S.gather_off(u, _h * HALF + _R) + (unsigned)_C * 2u; } } } while (0)
#define PG8_BPTR(u, t) (SPLITB ? (((t) < ksplit) ? (u).b + (size_t)(t) * kstep : (u).b2 + (size_t)((t) - ksplit) * kstep) : (u).b + (size_t)(t) * kstep)
    Unit cur, nxt; int ui = 0;
    if (!S.next(0, cur)) return;
    Acc acc;
#pragma unroll
    for (int a = 0; a < 2; ++a)
#pragma unroll
        for (int b = 0; b < 2; ++b)
#pragma unroll
            for (int m = 0; m < 4; ++m)
#pragma unroll
                for (int n = 0; n < 2; ++n) acc[a][b][m][n] = (f32x4){0.f, 0.f, 0.f, 0.f};
    bf16x8 At[4][2], B0[2][2], B1[2][2];
    const char* cA = cur.a; const char* cB = cur.b;
    S.a_ready(cur);
    PG8_GOFF(voffA, cur);
    if constexpr (GATHER) {
#pragma unroll
        for (int h = 0; h < 2; ++h)
#pragma unroll
            for (int i = 0; i < 2; ++i) voffN[h][i] = voffA[h][i];
    }
    PG8_STAGE_B(PG8_SB(0, 0), cB, 0); PG8_STAGE_B(PG8_SB(0, 1), cB, 1); PG8_STAGE_A(PG8_SA(0, 0), cA, 0, false); PG8_STAGE_A(PG8_SA(0, 1), cA, 1, false);
    if (wr == 1) PG8_BAR;
    PG8_WAIT_V(2); PG8_BAR;
    PG8_STAGE_B(PG8_SB(1, 0), cB + kstep, 0); PG8_STAGE_A(PG8_SA(1, 0), cA + kstep, 0, false); PG8_STAGE_B(PG8_SB(1, 1), cB + kstep, 1);
    PG8_WAIT_V(6); PG8_BAR;
    for (;;) {
        const bool has_next = S.next(ui + 1, nxt);
        const char* nA = has_next ? nxt.a : cA; const char* nB = has_next ? nxt.b : cB;
#pragma nounroll
        for (int t = 0; t < nt; t += 2) {
            const bool last = (t == nt - 2);
            if (last && has_next) { S.a_ready(nxt); PG8_GOFF(voffN, nxt); }
            if constexpr (Epi::HOOK) { if (t == Epi::HOOK_T0 || t == Epi::HOOK_T1) E.hook(acc, cur, t, wr, wc, fr, fq); }
            const char* a1 = cA + (size_t)(t + 1) * kstep;
            const char* a2 = last ? nA : cA + (size_t)(t + 2) * kstep; const char* b2 = last ? nB : PG8_BPTR(cur, t + 2);
            const char* a3 = a2 + kstep; const char* b3 = b2 + kstep;
            PG8_LDB(B0, 0, 0); PG8_LDB(B1, 0, 1); PG8_SCHED; PG8_LDA(At, 0, 0); PG8_STAGE_A(PG8_SA(1, 1), a1, 1, false);
            PG8_WAIT_V(8); PG8_WAIT_L(0); PG8_BAR; PG8_MMA(0, 0, At, B0); PG8_MMA(0, 1, At, B1); PG8_BAR; PG8_SCHED;
            PG8_LDA(At, 0, 1); PG8_STAGE_B(PG8_SB(0, 0), b2, 0); PG8_STAGE_B(PG8_SB(0, 1), b2, 1); PG8_STAGE_A(PG8_SA(0, 0), a2, 0, last);
            PG8_WAIT_V(8); PG8_WAIT_L(0); PG8_BAR; PG8_MMA(1, 0, At, B0); PG8_MMA(1, 1, At, B1); PG8_BAR; PG8_SCHED;
            PG8_LDB(B0, 1, 0); PG8_LDB(B1, 1, 1); PG8_SCHED; PG8_LDA(At, 1, 0); PG8_STAGE_A(PG8_SA(0, 1), a2, 1, last);
            PG8_WAIT_V(8); PG8_WAIT_L(0); PG8_BAR; PG8_MMA(0, 0, At, B0); PG8_MMA(0, 1, At, B1); PG8_BAR; PG8_SCHED;
            PG8_LDA(At, 1, 1); PG8_STAGE_B(PG8_SB(1, 0), b3, 0); PG8_STAGE_B(PG8_SB(1, 1), b3, 1); PG8_STAGE_A(PG8_SA(1, 0), a3, 0, last);
            PG8_WAIT_V(8); PG8_WAIT_L(0); PG8_BAR; PG8_MMA(1, 0, At, B0); PG8_MMA(1, 1, At, B1); PG8_BAR; PG8_SCHED;
        }
        if constexpr (ALIGN_EPI) { if (wr == 0) PG8_BAR; }
        E(acc, cur, wr, wc, fr, fq); S.done(cur);
        if (!has_next) break;
#pragma unroll
        for (int a = 0; a < 2; ++a)
#pragma unroll
            for (int b = 0; b < 2; ++b)
#pragma unroll
                for (int m = 0; m < 4; ++m)
#pragma unroll
                    for (int n = 0; n < 2; ++n) acc[a][b][m][n] = (f32x4){0.f, 0.f, 0.f, 0.f};
        cur = nxt; cA = nA; cB = nB; ++ui;
        if constexpr (GATHER) {
#pragma unroll
            for (int h = 0; h < 2; ++h)
#pragma unroll
                for (int i = 0; i < 2; ++i) voffA[h][i] = voffN[h][i];
        }
        if constexpr (ALIGN_EPI) { if (wr == 1) PG8_BAR; }
    }
    PG8_WAIT_V(0);
    if constexpr (!ALIGN_EPI) { if (wr == 0) PG8_BAR; }
    PG8_BAR;
#undef PG8_SA
#undef PG8_SB
#undef PG8_STAGE_A
#undef PG8_STAGE_B
#undef PG8_LDA
#undef PG8_LDB
#undef PG8_MMA
#undef PG8_WAIT_V
#undef PG8_WAIT_L
#undef PG8_BAR
#undef PG8_SCHED
#undef PG8_GOFF
#undef PG8_BPTR
}
}
struct Resid {
    const float* in_lat; const float* in_ctx; bf16_t* x_lat; bf16_t* x_ctx; int g, src_f32;
    __device__ __forceinline__ const float* srcf(int row) const { const int bl = row / SB, s = row - bl * SB, b = g * GB + bl;
        return s < CTXL ? in_ctx + (size_t)(b * CTXL + s) * DM : in_lat + ((size_t)b * SEQ + (s - CTXL)) * DM; }
    __device__ __forceinline__ bf16_t* dst(int row) const { const int bl = row / SB, s = row - bl * SB, b = g * GB + bl;
        return s < CTXL ? x_ctx + (size_t)(b * CTXL + s) * DM : x_lat + ((size_t)b * SEQ + (s - CTXL)) * DM; }
    __device__ __forceinline__ int modv(int row) const { const int bl = row / SB, s = row - bl * SB; return s < CTXL ? 8 : g * GB + bl; }
};

struct TileOrder {
    int nM, nN, nwg, G, c, skip; const char* A; const char* B; size_t astep, bstep;
    __device__ __forceinline__ void init(int nM_, int nN_, int G_, int c_, const void* A_, size_t astep_, const void* B_, size_t bstep_, int skip_ctx) {
        nM = nM_; nN = nN_; nwg = nM * nN; G = G_; c = c_; A = (const char*)A_; B = (const char*)B_; astep = astep_; bstep = bstep_; skip = skip_ctx; }
    __device__ __forceinline__ bool next(int i, pg8::Unit& u) const {
        const long L = (long)i * G + c; if (L >= nwg) return false;
        int wgid = (int)L; { const int q = nwg / pg8::NXCD, r = nwg % pg8::NXCD, xcd = wgid % pg8::NXCD, off = wgid / pg8::NXCD; wgid = (xcd < r ? xcd * (q + 1) : r * (q + 1) + (xcd - r) * q) + off; }
        const int nig = pg8::WGM * nN, gid = wgid / nig, fm = gid * pg8::WGM, gsz = (nM - fm) < pg8::WGM ? (nM - fm) : pg8::WGM;
        int pm = fm + ((wgid % nig) % gsz); u.pn = (wgid % nig) / gsz;
        if (skip) pm = pm + pm / 32 + 1;
        u.pm = pm; u.aux0 = 0; u.aux1 = 0; u.aux2 = 0;
        u.a = A + (size_t)pm * astep; u.b = B + (size_t)u.pn * bstep; u.b2 = u.b; return true;
    }
    __device__ __forceinline__ void a_ready(const pg8::Unit&) const {}
    __device__ __forceinline__ void done(const pg8::Unit&) const {}
};

struct MoeOrder {
    const LAS int* tab; const int* LIST; int ncol, G, c, up; const char* A; const char* W;
    __device__ __forceinline__ bool next(int i, pg8::Unit& u) const {
        const int TR = __builtin_amdgcn_readfirstlane(tab[24]);
        int rt, pn;
        if ((G & 7) == 0) { const int x = c & 7, j = c >> 3, W = G >> 3; const int lo = (TR * x) >> 3, hi = (TR * (x + 1)) >> 3; const int q = i * W + j; if (q >= (hi - lo) * ncol) return false;
            rt = lo + q / ncol; pn = q - (q / ncol) * ncol; }
        else { const int L = i * G + c; if (L >= TR * ncol) return false; rt = L / ncol; pn = L - rt * ncol; }
        int p = 0;
#pragma unroll
        for (int q = 1; q < NPAIR; ++q) p += (__builtin_amdgcn_readfirstlane(tab[q]) <= rt) ? 1 : 0;
        const int base = (rt - __builtin_amdgcn_readfirstlane(tab[p])) * 256; int valid = __builtin_amdgcn_readfirstlane(tab[32 + p]) - base; valid = valid > 256 ? 256 : valid;
        u.pm = rt; u.pn = pn; u.aux0 = p * NT + base; u.aux1 = valid; u.aux2 = p;
        const int grp = p / 6, q6 = p - grp * 6;
        const int lo = q6 < 3 ? 0 : (q6 < 5 ? 1 : 2), hi = q6 < 3 ? q6 + 1 : (q6 < 5 ? q6 - 1 : 3);
        const int ea = grp * 4 + lo, eb = grp * 4 + hi;
        if (up) { const int e = pn < 4 ? ea : eb; u.a = A; u.b = W + ((size_t)e * 1024 + (size_t)(pn & 3) * 256) * 1024 * 2; u.b2 = u.b; }
        else { u.a = A + (size_t)rt * 256 * 1024 * 2; u.b = W + ((size_t)ea * 1024 + (size_t)pn * 256) * 512 * 2; u.b2 = W + ((size_t)eb * 1024 + (size_t)pn * 256) * 512 * 2; }
        return true;
    }
    __device__ __forceinline__ unsigned gather_off(const pg8::Unit& u, int r) const { const int idx = r < u.aux1 ? r : 0; return (unsigned)LIST[u.aux0 + idx] * (unsigned)(DM * 2); }
    __device__ __forceinline__ void a_ready(const pg8::Unit&) const {}
    __device__ __forceinline__ void done(const pg8::Unit&) const {}
};

#ifdef EPI_NT_STORES
#define ST_NT(p, v) __builtin_nontemporal_store((v), (p))
#else
#define ST_NT(p, v) (*(p) = (v))
#endif
#define EPI_NOHOOK static constexpr bool HOOK = false; static constexpr int HOOK_T0 = -1, HOOK_T1 = -1; \
    __device__ __forceinline__ void hook(pg8::Acc&, const pg8::Unit&, int, int, int, int, int) const {}
#define EPI_V8(v, acc, ai, bj, m) float v[8]; { const f32x4 _a = acc[ai][bj][m][0], _b = acc[ai][bj][m][1]; v[0] = _a[0]; v[1] = _a[1]; v[2] = _a[2]; v[3] = _a[3]; v[4] = _b[0]; v[5] = _b[1]; v[6] = _b[2]; v[7] = _b[3]; }
__device__ __forceinline__ void rot4(float (&v)[8], const f32x2* cs) {
    const f32x4 c01 = *(const f32x4*)cs, c23 = *(const f32x4*)(cs + 2);
    const float c[4] = {c01[0], c01[2], c23[0], c23[2]}, s[4] = {c01[1], c01[3], c23[1], c23[3]};
#pragma unroll
    for (int k = 0; k < 4; ++k) { const float x1 = v[2 * k], x2 = v[2 * k + 1]; v[2 * k] = x1 * c[k] - x2 * s[k]; v[2 * k + 1] = x2 * c[k] + x1 * s[k]; }
}

struct EpiNone { EPI_NOHOOK
    float* sink;
    __device__ __forceinline__ void operator()(const pg8::Acc& acc, const pg8::Unit& u, int wr, int wc, int fr, int fq) const {
        float s = 0.f;
#pragma unroll
        for (int ai = 0; ai < 2; ++ai)
#pragma unroll
            for (int bj = 0; bj < 2; ++bj)
#pragma unroll
                for (int m = 0; m < 4; ++m) s += acc[ai][bj][m][0][0] + acc[ai][bj][m][1][3];
        if (s == 1.2345e33f) sink[0] = s;
    }
};
struct EpiStoreOnly { EPI_NOHOOK
    bf16_t* PG;
    __device__ __forceinline__ void operator()(const pg8::Acc& acc, const pg8::Unit& u_, int wr, int wc, int fr, int fq) const {
        pg8::Unit u = u_; asm volatile("" : "+s"(u.pm), "+s"(u.pn), "+v"(fr), "+v"(fq));
        const int pn12 = u.pn % 12;
#pragma unroll
        for (int ai = 0; ai < 2; ++ai)
#pragma unroll
        for (int m = 0; m < 4; ++m) { const int row = u.pm * 256 + ai * 128 + wr * 64 + m * 16 + fr;
#pragma unroll
            for (int bj = 0; bj < 2; ++bj) { const int c0 = bj * 128 + wc * 32 + 8 * fq; EPI_V8(v, acc, ai, bj, m)
                *(u32x4*)(PG + (size_t)row * 3072 + pn12 * 256 + c0) = pack8(v); } }
    }
};
struct EpiInproj {
    EPI_NOHOOK
    bf16_t *PR, *PC, *PM, *PG; unsigned char* KB; float* SSQ; const f32x2* RT; const f32x2* MT;
    __device__ __forceinline__ void operator()(const pg8::Acc& acc, const pg8::Unit& u_, int wr, int wc, int fr, int fq) const {
        pg8::Unit u = u_; asm volatile("" : "+s"(u.pm), "+s"(u.pn), "+s"(u.aux0), "+s"(u.aux1), "+v"(fr), "+v"(fq));
        const int pn = u.pn;
#pragma unroll
        for (int ai = 0; ai < 2; ++ai)
#pragma unroll
        for (int m = 0; m < 4; ++m) { __builtin_amdgcn_sched_barrier(0);
            const int row = u.pm * 256 + ai * 128 + wr * 64 + m * 16 + fr;
            const int bl = row / SB, s = row - bl * SB; const bool lat = s >= CTXL; const int t = lat ? s - CTXL : 0;
            float ss[2] = {0.f, 0.f};
#pragma unroll
            for (int bj = 0; bj < 2; ++bj) {
                const int c0 = bj * 128 + wc * 32 + 8 * fq;
                EPI_V8(v, acc, ai, bj, m)
                if (pn <= 1) {
                    if (lat) rot4(v, RT + (size_t)t * 32 + ((c0 & 63) >> 1));
                    if (pn == 1) {
#pragma unroll
                        for (int k = 0; k < 8; ++k) v[k] *= 0.125f;
                    }
                    *(u32x4*)(PR + (size_t)row * 1536 + pn * 256 + c0) = pack8(v);
                } else if (pn <= 5) {
                    *(u32x4*)(PR + (size_t)row * 1536 + pn * 256 + c0) = pack8(v);
                } else if (pn <= 7) {
                    *(u32x4*)(PC + (size_t)row * 1024 + (pn - 6) * 256 + c0) = pack8(v);
                } else if (pn <= 11) {
                    u32x2 w; w.x = cvtpk(v[0] * v[1], v[2] * v[3]); w.y = cvtpk(v[4] * v[5], v[6] * v[7]);
                    *(u32x2*)(PC + (size_t)row * 1024 + 512 + (pn - 8) * 128 + (c0 >> 1)) = w;
                } else if (pn <= 14) {
                    if (pn == 14 && bj == 1) {
                        if (wc == 0) {
                            if (lat) { const int a = fq >> 1, pos = a ? (t & 63) : (t >> 6); rot4(v, MT + pos * 8 + (fq & 1) * 4); }
#pragma unroll
                            for (int k = 0; k < 8; ++k) v[k] *= K8S;
                            const u32x2 w = pack8_fp8(v);
#pragma unroll
                            for (int hh = 0; hh < 8; ++hh) { unsigned char* kp = KB + ((size_t)(bl * 8 + hh) * SB + s) * 128;
                                *(u32x2*)(kp + 64 + 8 * fq) = w; if (fq == 3) { *(u32x4*)(kp + 96) = (u32x4){0u, 0u, 0u, 0u}; *(u32x4*)(kp + 112) = (u32x4){0u, 0u, 0u, 0u}; } }
                        }
                    } else {
                        *(u32x4*)(PM + (size_t)row * 640 + (pn - 12) * 256 + c0) = pack8(v);
                        float q = 0.f;
#pragma unroll
                        for (int k = 0; k < 8; ++k) q += v[k] * v[k];
                        ss[bj] = q;
                    }
                } else {
                    float g[8];
#pragma unroll
                    for (int k = 0; k < 8; ++k) { const float x = fminf(fmaxf(v[k], -15.f), 15.f); g[k] = sigmoidf_(x); }
                    ST_NT((u32x4*)(PG + (size_t)row * 3072 + (pn - 15) * 256 + c0), pack8(g));
                }
            }
            if (pn >= 12 && pn <= 14) {
                float a = ss[0], b = ss[1];
                a += swz_xor<16>(a); a = half_sum(a); b += swz_xor<16>(b); b = half_sum(b);
                if (fq == 0) {
                    float* sq = SSQ + (size_t)row * 16;
                    if (pn == 12) sq[wc] = a + b;
                    else if (pn == 13) { sq[4 + wc] = a; sq[8 + wc] = b; }
                    else sq[12 + wc] = a;
                }
            }
        }
    }
};

#define EPI_ROW(ai, m) (u.pm * 256 + (ai) * 128 + wr * 64 + (m) * 16 + fr)
#define EPI_OPAQUE pg8::Unit u = u_; asm volatile("" : "+s"(u.pm), "+s"(u.pn), "+s"(u.aux0), "+s"(u.aux1), "+v"(fr), "+v"(fq));
struct EpiUq {
    EPI_NOHOOK
    unsigned char* QB; const float* SSQ; const f32x2* MT;
    __device__ __forceinline__ void operator()(const pg8::Acc& acc, const pg8::Unit& u_, int wr, int wc, int fr, int fq) const {
        EPI_OPAQUE
        f32x4 q0[2][4], q1[2][4];
#pragma unroll
        for (int ai = 0; ai < 2; ++ai)
#pragma unroll
            for (int m = 0; m < 4; ++m) { const float* sq = SSQ + (size_t)EPI_ROW(ai, m) * 16; q0[ai][m] = *(const f32x4*)sq; q1[ai][m] = *(const f32x4*)(sq + 4); }
#pragma unroll
        for (int ai = 0; ai < 2; ++ai)
#pragma unroll
        for (int m = 0; m < 4; ++m) {
            const int row = EPI_ROW(ai, m);
            const int bl = row / SB, s = row - bl * SB; const bool lat = s >= CTXL; const int t = lat ? s - CTXL : 0;
            const f32x4 a = q0[ai][m], b = q1[ai][m];
            const float ssq = ((a[0] + a[1]) + (a[2] + a[3])) + ((b[0] + b[1]) + (b[2] + b[3]));
            const float rq = rsqrtf(ssq * (1.f / 384.f) + RMS_EPS) * (QSCALE * Q8S);
#pragma unroll
            for (int bj = 0; bj < 2; ++bj) {
                const int cg = u.pn * 256 + bj * 128 + wc * 32 + 8 * fq; const int h = cg / 96, d0 = cg - h * 96;
                EPI_V8(v, acc, ai, bj, m)
#pragma unroll
                for (int k = 0; k < 8; ++k) v[k] *= rq;
                if (d0 >= 64 && lat) { const int p0 = d0 - 64, aa = p0 >> 4, pos = aa ? (t & 63) : (t >> 6); rot4(v, MT + pos * 8 + ((p0 & 15) >> 1)); }
                unsigned char* qp = QB + ((size_t)(bl * 8 + h) * SB + s) * 128;
                *(u32x2*)(qp + d0) = pack8_fp8(v);
                if (d0 == 88) { *(u32x4*)(qp + 96) = (u32x4){0u, 0u, 0u, 0u}; *(u32x4*)(qp + 112) = (u32x4){0u, 0u, 0u, 0u}; }
            }
        }
    }
};
struct EpiUkv {
    EPI_NOHOOK
    unsigned char* KB; bf16_t* VB; const float* SSQ;
    __device__ __forceinline__ void operator()(const pg8::Acc& acc, const pg8::Unit& u_, int wr, int wc, int fr, int fq) const {
        EPI_OPAQUE
        f32x4 q0[2][4], q1[2][4];
#pragma unroll
        for (int ai = 0; ai < 2; ++ai)
#pragma unroll
            for (int m = 0; m < 4; ++m) { const float* sq = SSQ + (size_t)EPI_ROW(ai, m) * 16 + 8; q0[ai][m] = *(const f32x4*)sq; q1[ai][m] = *(const f32x4*)(sq + 4); }
#pragma unroll
        for (int ai = 0; ai < 2; ++ai)
#pragma unroll
        for (int m = 0; m < 4; ++m) {
            const int row = EPI_ROW(ai, m);
            const int bl = row / SB, s = row - bl * SB;
            const f32x4 a = q0[ai][m], b = q1[ai][m];
            const float ssq = ((a[0] + a[1]) + (a[2] + a[3])) + ((b[0] + b[1]) + (b[2] + b[3]));
            const float rk = rsqrtf(ssq * (1.f / 256.f) + RMS_EPS);
#pragma unroll
            for (int bj = 0; bj < 2; ++bj) {
                const int cg = u.pn * 256 + bj * 128 + wc * 32 + 8 * fq; const int h = cg >> 7, e0 = cg & 127;
                EPI_V8(v, acc, ai, bj, m)
#pragma unroll
                for (int k = 0; k < 8; ++k) v[k] *= rk;
                if (e0 < 64) {
#pragma unroll
                    for (int k = 0; k < 8; ++k) v[k] *= K8S;
                    *(u32x2*)(KB + ((size_t)(bl * 8 + h) * SB + s) * 128 + e0) = pack8_fp8(v); }
                else *(u32x4*)(VB + ((size_t)(bl * 8 + h) * SB + s) * 64 + (e0 - 64)) = pack8(v);
            }
        }
    }
};

struct EpiMerge1 {
    static constexpr bool HOOK = true; static constexpr int HOOK_T0 = 8, HOOK_T1 = 16;
    const bf16_t* PG; bf16_t* M;
    __device__ __forceinline__ void hook(pg8::Acc& acc, const pg8::Unit& u_, int t, int wr, int wc, int fr, int fq) const {
        pg8::Unit u = u_; asm volatile("" : "+s"(u.pm), "+s"(u.pn), "+v"(fr), "+v"(fq));
        const int gi = (t == 8) ? 0 : 1;
#pragma unroll
        for (int ai = 0; ai < 2; ++ai) {
            u32x4 sp[4][2], sn[4][2];
#pragma unroll
            for (int m = 0; m < 4; ++m)
#pragma unroll
                for (int bj = 0; bj < 2; ++bj) { const bf16_t* p = PG + (size_t)EPI_ROW(ai, m) * 3072 + gi * 1024 + u.pn * 256 + bj * 128 + wc * 32 + 8 * fq;
                    sp[m][bj] = *(const u32x4*)p; sn[m][bj] = *(const u32x4*)(p + 1024); }
#pragma unroll
            for (int m = 0; m < 4; ++m)
#pragma unroll
                for (int bj = 0; bj < 2; ++bj) {
                    float a[8], b[8]; unpack8(sp[m][bj], a); unpack8(sn[m][bj], b);
                    f32x4 r0, r1;
#pragma unroll
                    for (int k = 0; k < 4; ++k) { r0[k] = a[k] * __builtin_amdgcn_rcpf(b[k]); r1[k] = a[4 + k] * __builtin_amdgcn_rcpf(b[4 + k]); }
                    acc[ai][bj][m][0] *= r0; acc[ai][bj][m][1] *= r1;
                }
            __builtin_amdgcn_sched_barrier(0);
        }
    }
    __device__ __forceinline__ void operator()(const pg8::Acc& acc, const pg8::Unit& u_, int wr, int wc, int fr, int fq) const {
        EPI_OPAQUE
#pragma unroll
        for (int ai = 0; ai < 2; ++ai) {
            u32x4 s2[4][2];
#pragma unroll
            for (int m = 0; m < 4; ++m)
#pragma unroll
                for (int bj = 0; bj < 2; ++bj) s2[m][bj] = *(const u32x4*)(PG + (size_t)EPI_ROW(ai, m) * 3072 + 2048 + u.pn * 256 + bj * 128 + wc * 32 + 8 * fq);
#pragma unroll
            for (int m = 0; m < 4; ++m)
#pragma unroll
                for (int bj = 0; bj < 2; ++bj) {
                    const int cg = u.pn * 256 + bj * 128 + wc * 32 + 8 * fq;
                    float g[8]; unpack8(s2[m][bj], g);
                    EPI_V8(v, acc, ai, bj, m)
#pragma unroll
                    for (int k = 0; k < 8; ++k) v[k] *= g[k];
                    *(u32x4*)(M + (size_t)EPI_ROW(ai, m) * 1024 + cg) = pack8(v);
                }
            __builtin_amdgcn_sched_barrier(0);
        }
    }
};

struct EpiMerge1NoHook : EpiMerge1 { static constexpr bool HOOK = false; };
struct EpiMerge1HookOnly { static constexpr bool HOOK = true; static constexpr int HOOK_T0 = 8, HOOK_T1 = 16; EpiMerge1 e; float* sink;
    __device__ __forceinline__ void hook(pg8::Acc& acc, const pg8::Unit& u, int t, int wr, int wc, int fr, int fq) const { e.hook(acc, u, t, wr, wc, fr, fq); }
    __device__ __forceinline__ void operator()(const pg8::Acc& acc, const pg8::Unit& u, int wr, int wc, int fr, int fq) const { EpiNone n{sink}; n(acc, u, wr, wc, fr, fq); }
};
struct EpiMerge2 {
    EPI_NOHOOK
    Resid R; const float* MODL;
    __device__ __forceinline__ void operator()(const pg8::Acc& acc, const pg8::Unit& u_, int wr, int wc, int fr, int fq) const {
        EPI_OPAQUE
        const int cb = u.pn * 256 + wc * 32 + 8 * fq;
        const float* g1 = MODL + R.modv(u.pm * 256) * 6144 + 2048 + cb;
        f32x4 g[2][2];
#pragma unroll
        for (int bj = 0; bj < 2; ++bj)
#pragma unroll
            for (int n = 0; n < 2; ++n) g[bj][n] = *(const f32x4*)(g1 + bj * 128 + 4 * n);
        int sf32 = R.src_f32; asm volatile("" : "+s"(sf32));
#pragma unroll
        for (int ai = 0; ai < 2; ++ai) {
            if (sf32) {
                f32x4 x[4][2][2];
#pragma unroll
                for (int m = 0; m < 4; ++m) { const float* src = R.srcf(EPI_ROW(ai, m)) + cb;
#pragma unroll
                    for (int bj = 0; bj < 2; ++bj)
#pragma unroll
                        for (int n = 0; n < 2; ++n) x[m][bj][n] = *(const f32x4*)(src + bj * 128 + 4 * n); }
#pragma unroll
                for (int m = 0; m < 4; ++m) { bf16_t* dst = R.dst(EPI_ROW(ai, m)) + cb;
#pragma unroll
                    for (int bj = 0; bj < 2; ++bj) { const f32x4 a = x[m][bj][0] + g[bj][0] * acc[ai][bj][m][0], b = x[m][bj][1] + g[bj][1] * acc[ai][bj][m][1];
                        u32x4 w; w.x = cvtpk(a[0], a[1]); w.y = cvtpk(a[2], a[3]); w.z = cvtpk(b[0], b[1]); w.w = cvtpk(b[2], b[3]); *(u32x4*)(dst + bj * 128) = w; } }
            } else {
                u32x4 x[4][2];
#pragma unroll
                for (int m = 0; m < 4; ++m) { const bf16_t* src = R.dst(EPI_ROW(ai, m)) + cb;
#pragma unroll
                    for (int bj = 0; bj < 2; ++bj) x[m][bj] = *(const u32x4*)(src + bj * 128); }
#pragma unroll
                for (int m = 0; m < 4; ++m) { bf16_t* dst = R.dst(EPI_ROW(ai, m)) + cb;
#pragma unroll
                    for (int bj = 0; bj < 2; ++bj) { float f[8]; unpack8(x[m][bj], f);
                        const f32x4 a = (f32x4){f[0], f[1], f[2], f[3]} + g[bj][0] * acc[ai][bj][m][0], b = (f32x4){f[4], f[5], f[6], f[7]} + g[bj][1] * acc[ai][bj][m][1];
                        u32x4 w; w.x = cvtpk(a[0], a[1]); w.y = cvtpk(a[2], a[3]); w.z = cvtpk(b[0], b[1]); w.w = cvtpk(b[2], b[3]); *(u32x4*)(dst + bj * 128) = w; } }
            }
            __builtin_amdgcn_sched_barrier(0);
        }
    }
};

struct EpiMoeUp {
    EPI_NOHOOK
    const int* LIST; const float* WGT; bf16_t* MACT;
    __device__ __forceinline__ void operator()(const pg8::Acc& acc, const pg8::Unit& u_, int wr, int wc, int fr, int fq) const {
        EPI_OPAQUE
        const int slot = u.pn >> 2;
        int tok[2][4]; float w[2][4];
#pragma unroll
        for (int ai = 0; ai < 2; ++ai)
#pragma unroll
            for (int m = 0; m < 4; ++m) { const int ri = ai * 128 + wr * 64 + m * 16 + fr; tok[ai][m] = LIST[u.aux0 + (ri < u.aux1 ? ri : 0)]; }
#pragma unroll
        for (int ai = 0; ai < 2; ++ai)
#pragma unroll
            for (int m = 0; m < 4; ++m) w[ai][m] = WGT[(size_t)tok[ai][m] * 2 + slot];
#pragma unroll
        for (int ai = 0; ai < 2; ++ai)
#pragma unroll
        for (int m = 0; m < 4; ++m) {
            const int ri = ai * 128 + wr * 64 + m * 16 + fr; const float ww = w[ai][m];
#pragma unroll
            for (int bj = 0; bj < 2; ++bj) {
                const int c0 = bj * 128 + wc * 32 + 8 * fq;
                EPI_V8(v, acc, ai, bj, m)
                u32x2 o; o.x = cvtpk(siluf_(v[0]) * v[1] * ww, siluf_(v[2]) * v[3] * ww); o.y = cvtpk(siluf_(v[4]) * v[5] * ww, siluf_(v[6]) * v[7] * ww);
                *(u32x2*)(MACT + (size_t)(u.pm * 256 + ri) * 1024 + slot * 512 + (u.pn & 3) * 128 + (c0 >> 1)) = o;
            }
        }
    }
};
struct EpiMoeDown {
    EPI_NOHOOK
    const int* LIST; Resid R; const float* MODL; bf16_t* dry;
    __device__ __forceinline__ void operator()(const pg8::Acc& acc, const pg8::Unit& u_, int wr, int wc, int fr, int fq) const {
        EPI_OPAQUE
        int tok[2][4];
#pragma unroll
        for (int ai = 0; ai < 2; ++ai)
#pragma unroll
            for (int m = 0; m < 4; ++m) { const int ri = ai * 128 + wr * 64 + m * 16 + fr; tok[ai][m] = LIST[u.aux0 + (ri < u.aux1 ? ri : 0)]; }
        const int cb = u.pn * 256 + wc * 32 + 8 * fq;
#pragma unroll
        for (int ai = 0; ai < 2; ++ai) {
            u32x4 x[4][2];
#pragma unroll
            for (int m = 0; m < 4; ++m) { const bf16_t* dst = R.dst(tok[ai][m]) + cb;
#pragma unroll
                for (int bj = 0; bj < 2; ++bj) x[m][bj] = *(const u32x4*)(dst + bj * 128); }
#pragma unroll
            for (int m = 0; m < 4; ++m) { const int ri = ai * 128 + wr * 64 + m * 16 + fr;
                if (ri < u.aux1) {
                    bf16_t* dst = R.dst(tok[ai][m]) + cb; const float* g2 = MODL + R.modv(tok[ai][m]) * 6144 + 5120 + cb;
#pragma unroll
                    for (int bj = 0; bj < 2; ++bj) { float f[8]; unpack8(x[m][bj], f);
                        const f32x4 ga = *(const f32x4*)(g2 + bj * 128), gb = *(const f32x4*)(g2 + bj * 128 + 4);
                        const f32x4 a = (f32x4){f[0], f[1], f[2], f[3]} + ga * acc[ai][bj][m][0], b = (f32x4){f[4], f[5], f[6], f[7]} + gb * acc[ai][bj][m][1];
                        u32x4 w; w.x = cvtpk(a[0], a[1]); w.y = cvtpk(a[2], a[3]); w.z = cvtpk(b[0], b[1]); w.w = cvtpk(b[2], b[3]);
                        bf16_t* o = dry ? dry + (size_t)(u.pm * 256 + ri) * 1024 + cb + bj * 128 : dst + bj * 128;
                        *(u32x4*)o = w; }
                } }
            __builtin_amdgcn_sched_barrier(0);
        }
    }
};
#define SBAR() __builtin_amdgcn_sched_barrier(0)
__device__ __forceinline__ int crow(int r, int hi) { return (r & 3) + 8 * (r >> 2) + 4 * hi; }
template <int NCB> __device__ __forceinline__ int v_st(int k, int c) { const int kk = (k & ~0xC) | ((k & 4) << 1) | ((k & 8) >> 1); return ((kk >> 3) * NCB + (c >> 5)) * 512 + ((kk & 7) * 32 + (c & 31)) * 2; }
__device__ __forceinline__ int v_rd_base(int lane) { return ((lane & 3) << 3) | (((lane >> 2) & 3) << 6) | (((lane >> 4) & 1) << 5) | (((lane >> 5) & 1) << 8); }
template <int OFF> __device__ __forceinline__ s16x4 tr_read(int vb) { s16x4 r; asm volatile("ds_read_b64_tr_b16 %0, %1 offset:%2" : "=&v"(r) : "v"(vb), "i"(OFF) : "memory"); return r; }
#define PKLH(L, H) (bf16x8){L[0], L[1], L[2], L[3], H[0], H[1], H[2], H[3]}
template <int NCB, int KS> __device__ __forceinline__ bf16x8 tr_frag(int vb) { const s16x4 l = tr_read<KS * NCB * 1024>(vb), h = tr_read<KS * NCB * 1024 + NCB * 512>(vb); return PKLH(l, h); }
#define PK4(P, BASE, OUT) do { const unsigned a0 = cvtpk(P[BASE + 0], P[BASE + 1]), a1 = cvtpk(P[BASE + 2], P[BASE + 3]);   \
    const unsigned b0 = cvtpk(P[BASE + 4], P[BASE + 5]), b1 = cvtpk(P[BASE + 6], P[BASE + 7]);                              \
    auto r0 = __builtin_amdgcn_permlane32_swap(a0, b0, false, false); auto r1 = __builtin_amdgcn_permlane32_swap(a1, b1, false, false); \
    u32x4 w = {r0[0], r1[0], r0[1], r1[1]}; OUT = __builtin_bit_cast(bf16x8, w); } while (0)

namespace att {
constexpr int DQK = 96, DV = 64, KVBLK = 64;
constexpr int SHM_V = KVBLK * DV * 2;
constexpr int SHM_K = KVBLK * 256;
constexpr float THR = 8.f;
#define KSWZ(row, colB) ((row) * 256 + ((colB) ^ (((row) & 7) << 4)))
__device__ __forceinline__ void partialSM(f32x16& p0, f32x16& p1, float& m_reg, float& alpha) {
    float pmax = p0[0];
#pragma unroll
    for (int r = 1; r < 16; ++r) pmax = fmaxf(pmax, p0[r]);
#pragma unroll
    for (int r = 0; r < 16; ++r) pmax = fmaxf(pmax, p1[r]);
    { auto rr = __builtin_amdgcn_permlane32_swap(__float_as_uint(pmax), __float_as_uint(pmax), false, false);
      pmax = fmaxf(__uint_as_float(rr[0]), __uint_as_float(rr[1])); }
    float mn;
    if (__builtin_expect(__all(pmax - m_reg <= THR), 1)) { mn = m_reg; alpha = 1.f; }
    else { mn = fmaxf(m_reg, pmax); alpha = __builtin_amdgcn_exp2f(m_reg - mn); m_reg = mn; }
#pragma unroll
    for (int r = 0; r < 16; ++r) p0[r] = p0[r] - mn;
#pragma unroll
    for (int r = 0; r < 16; ++r) p1[r] = p1[r] - mn;
#pragma unroll
    for (int r = 0; r < 16; ++r) p0[r] = __builtin_amdgcn_exp2f(p0[r]);
}
__device__ __forceinline__ void finishSM(f32x16& p0, f32x16& p1, float alpha, float& l_reg, bf16x8& pa0, bf16x8& pa1, bf16x8& pa2, bf16x8& pa3) {
#pragma unroll
    for (int r = 0; r < 16; ++r) p1[r] = __builtin_amdgcn_exp2f(p1[r]);
    float ps = 0;
#pragma unroll
    for (int r = 0; r < 16; ++r) ps += p0[r];
#pragma unroll
    for (int r = 0; r < 16; ++r) ps += p1[r];
    { auto rr = __builtin_amdgcn_permlane32_swap(__float_as_uint(ps), __float_as_uint(ps), false, false);
      ps = __uint_as_float(rr[0]) + __uint_as_float(rr[1]); }
    l_reg = l_reg * alpha + ps;
    PK4(p0, 0, pa0); PK4(p0, 8, pa1); PK4(p1, 0, pa2); PK4(p1, 8, pa3);
}
__device__ __forceinline__ void qkt(f32x16& p0, f32x16& p1, const LAS char* Ks, const bf16x8* qr, int r32, int hi) {
    p0 = f32x16{}; p1 = f32x16{};
#pragma unroll
    for (int d0 = 0; d0 < 6; ++d0) { const int cb = (d0 * 16 + hi * 8) * 2;
        const bf16x8 b0 = *(const LAS bf16x8*)(Ks + KSWZ(r32, cb));
        const bf16x8 b1 = *(const LAS bf16x8*)(Ks + KSWZ(32 + r32, cb));
        p0 = __builtin_amdgcn_mfma_f32_32x32x16_bf16(b0, qr[d0], p0, 0, 0, 0);
        p1 = __builtin_amdgcn_mfma_f32_32x32x16_bf16(b1, qr[d0], p1, 0, 0, 0); }
}
template <int D0> __device__ __forceinline__ void pv_one(f32x16& od, int vb, bf16x8 pa0, bf16x8 pa1, bf16x8 pa2, bf16x8 pa3) {
    const bf16x8 f0 = tr_frag<2, 0>(vb + D0 * 512), f1 = tr_frag<2, 1>(vb + D0 * 512), f2 = tr_frag<2, 2>(vb + D0 * 512), f3 = tr_frag<2, 3>(vb + D0 * 512);
    asm volatile("s_waitcnt lgkmcnt(0)" ::: "memory"); SBAR();
    od = __builtin_amdgcn_mfma_f32_32x32x16_bf16(pa0, f0, od, 0, 0, 0);
    od = __builtin_amdgcn_mfma_f32_32x32x16_bf16(pa1, f1, od, 0, 0, 0);
    od = __builtin_amdgcn_mfma_f32_32x32x16_bf16(pa2, f2, od, 0, 0, 0);
    od = __builtin_amdgcn_mfma_f32_32x32x16_bf16(pa3, f3, od, 0, 0, 0);
}
__device__ __forceinline__ void pv_d0(f32x16* o, int vb, bf16x8 pa0, bf16x8 pa1, bf16x8 pa2, bf16x8 pa3) {
    pv_one<0>(o[0], vb, pa0, pa1, pa2, pa3); pv_one<1>(o[1], vb, pa0, pa1, pa2, pa3);
}
__device__ __forceinline__ void attn_unit(const bf16_t* __restrict__ Qb, const bf16_t* __restrict__ Kh, const bf16_t* __restrict__ Vh, bf16_t* __restrict__ Ob, int ldo, int seq, LAS char* lds, const int wv) {
    const int tid = otid(wv), wid = __builtin_amdgcn_readfirstlane(tid >> 6), lane = tid & 63, r32 = lane & 31, hi = lane >> 5;
    LAS char* V_lds = lds; LAS char* K_lds = lds + 2 * SHM_V;
    LAS float* ws = (LAS float*)(lds + 2 * SHM_V + 2 * SHM_K) + wid * 64; LAS float* li_l = ws; LAS float* al_l = ws + 32;
    float m_reg = -1e30f, l_reg = 0; f32x16 o[2] = {}; bf16x8 qr[6];
    const bf16_t* Qw = Qb + (size_t)(wid * 32 + r32) * DQK + hi * 8;
#pragma unroll
    for (int d0 = 0; d0 < 6; ++d0) qr[d0] = *(const bf16x8*)(Qw + d0 * 16);
    const int vrow = tid >> 3, vc = (tid & 7) * 8, vst = v_st<2>(vrow, vc);
    const int krA = tid / 12, kcA = tid - krA * 12, sB = 512 + tid, krB = sB / 12, kcB = sB - krB * 12;
    const int kstA = KSWZ(krA, kcA * 16), kstB = KSWZ(krB, kcB * 16);
    const bool hasB = wid < 4;
    const int vb0 = (int)(size_t)V_lds + v_rd_base(lane);
    struct { bf16x8 v, ka, kb; } sr_[2];
#define SLOAD(i, k0) do { sr_[i].v = *(const bf16x8*)(Vh + (size_t)((k0) + vrow) * DV + vc); sr_[i].ka = *(const bf16x8*)(Kh + (size_t)((k0) + krA) * DQK + kcA * 8); \
    if (hasB) sr_[i].kb = *(const bf16x8*)(Kh + (size_t)((k0) + krB) * DQK + kcB * 8); } while (0)
#define SWRITE(b, i) do { *(LAS bf16x8*)(V_lds + (b) * SHM_V + vst) = sr_[i].v; *(LAS bf16x8*)(K_lds + (b) * SHM_K + kstA) = sr_[i].ka; \
    if (hasB) *(LAS bf16x8*)(K_lds + (b) * SHM_K + kstB) = sr_[i].kb; } while (0)
#define RESC(a) do { if (__any((a) < 1.f)) { if (hi == 0) al_l[r32] = (a); asm volatile("s_waitcnt lgkmcnt(0)" ::: "memory"); \
    _Pragma("unroll") for (int d = 0; d < 2; ++d) _Pragma("unroll") for (int r = 0; r < 16; ++r) o[d][r] *= al_l[crow(r, hi)]; } } while (0)
    f32x16 pA0, pA1, pB0, pB1; float alA, alB; bf16x8 pa0, pa1, pa2, pa3; const int NTL = seq / KVBLK;
    SLOAD(0, 0); SWRITE(0, 0); __syncthreads();
    qkt(pA0, pA1, K_lds, qr, r32, hi); partialSM(pA0, pA1, m_reg, alA);
    SLOAD(1, KVBLK); if (2 < NTL) SLOAD(0, 2 * KVBLK);
    SWRITE(1, 1); __syncthreads();
    for (int j = 1; j + 1 < NTL; j += 2) {
        SBAR(); qkt(pB0, pB1, K_lds + SHM_K, qr, r32, hi);
        finishSM(pA0, pA1, alA, l_reg, pa0, pa1, pa2, pa3); SBAR();
        SLOAD(1, (j + 2) * KVBLK); SBAR();
        pv_d0(o, vb0, pa0, pa1, pa2, pa3); partialSM(pB0, pB1, m_reg, alB);
        __syncthreads(); SWRITE(0, 0);
        RESC(alB); __syncthreads();
        SBAR(); qkt(pA0, pA1, K_lds, qr, r32, hi);
        finishSM(pB0, pB1, alB, l_reg, pa0, pa1, pa2, pa3); SBAR();
        if (j + 3 < NTL) SLOAD(0, (j + 3) * KVBLK); SBAR();
        pv_d0(o, vb0 + SHM_V, pa0, pa1, pa2, pa3); partialSM(pA0, pA1, m_reg, alA);
        __syncthreads(); SWRITE(1, 1);
        RESC(alA); __syncthreads();
    }
    SBAR(); qkt(pB0, pB1, K_lds + SHM_K, qr, r32, hi);
    finishSM(pA0, pA1, alA, l_reg, pa0, pa1, pa2, pa3); SBAR();
    pv_d0(o, vb0, pa0, pa1, pa2, pa3); partialSM(pB0, pB1, m_reg, alB);
    __syncthreads(); RESC(alB);
    finishSM(pB0, pB1, alB, l_reg, pa0, pa1, pa2, pa3); SBAR();
    pv_d0(o, vb0 + SHM_V, pa0, pa1, pa2, pa3);
    if (hi == 0) li_l[r32] = l_reg; asm volatile("s_waitcnt lgkmcnt(0)" ::: "memory");
    float rli[16];
#pragma unroll
    for (int r = 0; r < 16; ++r) rli[r] = __builtin_amdgcn_rcpf(li_l[crow(r, hi)]);
    bf16_t* Ow = Ob + (size_t)(wid * 32) * ldo;
#pragma unroll
    for (int r = 0; r < 16; ++r) { const int orow = crow(r, hi);
#pragma unroll
        for (int d0 = 0; d0 < 2; ++d0) Ow[(size_t)orow * ldo + d0 * 32 + r32] = f2bf(o[d0][r] * rli[r]); }
    __syncthreads();
#undef SLOAD
#undef SWRITE
#undef RESC
}
}

namespace att2 {
constexpr int DQK = 96, DV = 64, KVBLK = 64;
constexpr int KB_BYTES = 64 * 128, VB_BYTES = 64 * 64 * 2;
typedef int i32x8 __attribute__((ext_vector_type(8)));
constexpr int SC_K = 0x7d7d7d7d, SC_Q = 0x7a7a7a7a;
constexpr int NSLOT = 5;
constexpr int LDS_K = 0, LDS_V = NSLOT * KB_BYTES, LDS_WS = LDS_V + NSLOT * VB_BYTES, LDS_TOTAL = LDS_WS + 8 * 64 * 4;
static_assert(LDS_TOTAL <= RING_BYTES, "attention LDS");
constexpr float THR = 8.f;
typedef short v4i16_t __attribute__((ext_vector_type(4)));
__device__ __forceinline__ s16x4 vtr(const LAS char* p) { return __builtin_bit_cast(s16x4, __builtin_amdgcn_ds_read_tr16_b64_v4i16((LAS v4i16_t*)p)); }
#define PP_KLD(B, DH) ({ const int row_ = 32 * (B) + r32, sw_ = (row_ >> 1) & 7, c0_ = 2 * hi + 4 * (DH); \
        const u32x4 a_ = *(const LAS u32x4*)(Kt + row_ * 128 + ((c0_ ^ sw_) << 4)), b_ = *(const LAS u32x4*)(Kt + row_ * 128 + (((c0_ + 1) ^ sw_) << 4)); \
        (i32x8){(int)a_.x, (int)a_.y, (int)a_.z, (int)a_.w, (int)b_.x, (int)b_.y, (int)b_.z, (int)b_.w}; })
#define PP_VLD(D0V, KS) ({ const s16x4 l_ = vtr(Vs + (D0V) * 512 + (KS) * 2048), h_ = vtr(Vs + (D0V) * 512 + (KS) * 2048 + 1024); PKLH(l_, h_); })
#ifdef PROBE_EXP2X
#define PP_EXP(x) do { float a_ = (x), b_ = (x); asm volatile("" : "+v"(b_)); a_ = __builtin_amdgcn_exp2f(a_); b_ = __builtin_amdgcn_exp2f(b_); (x) = (a_ + b_) * 0.5f; } while (0)
#else
#define PP_EXP(x) (x) = __builtin_amdgcn_exp2f(x)
#endif
#define PK4N(P, BASE, OUT) do { u32x4 w_ = {cvtpk(P[BASE + 0], P[BASE + 1]), cvtpk(P[BASE + 2], P[BASE + 3]), cvtpk(P[BASE + 4], P[BASE + 5]), cvtpk(P[BASE + 6], P[BASE + 7])}; OUT = __builtin_bit_cast(bf16x8, w_); } while (0)
#define PP_SLOT_END() do { SBAR(); asm volatile("s_waitcnt vmcnt(%0) lgkmcnt(0)\n\ts_barrier" :: "n"(2 * (NSLOT - 2)) : "memory"); SBAR(); } while (0)
#define PP_BAR() do { SBAR(); asm volatile("s_waitcnt lgkmcnt(0)\n\ts_barrier" ::: "memory"); SBAR(); } while (0)
__device__ __forceinline__ float max3f(float a, float b, float c) { return fmaxf(fmaxf(a, b), c); }
__device__ __forceinline__ void attn_unit_pp(const unsigned char* __restrict__ Qb, const unsigned char* __restrict__ Kh, const bf16_t* __restrict__ Vh, bf16_t* __restrict__ Ob, int ldo, int seq, LAS char* lds, const int wv) {
    const int tid = otid(wv), wid = __builtin_amdgcn_readfirstlane(tid >> 6), lane = tid & 63, r32 = lane & 31, hi = lane >> 5, grp = wid >> 2;
    LAS float* ws = (LAS float*)(lds + LDS_WS) + wid * 64; LAS float* li_l = ws; LAS float* al_l = ws + 32;
    const int NTL = seq / KVBLK;
    unsigned koff, voff;
    { const int s = wid * 64 + lane, row = s >> 3, ch = (s & 7) ^ ((row >> 1) & 7); koff = (unsigned)(row * 128 + ch * 16); }
    { const int s = wid * 64 + lane, sub = s >> 5, win = s & 31, key = (sub >> 1) * 8 + (win >> 2), c = (sub & 1) * 32 + (win & 3) * 8; voff = (unsigned)(key * 128 + c * 2); }
    const char* Kg = (const char*)Kh; const char* Vg = (const char*)Vh;
#define PP_DMA_K(t) do { int tt_ = (t); tt_ = tt_ < NTL ? tt_ : NTL - 1; const int sl_ = tt_ % NSLOT; \
        __builtin_amdgcn_global_load_lds((const unsigned*)(Kg + (size_t)tt_ * (64 * 128) + koff), (LAS unsigned*)(lds + LDS_K + sl_ * KB_BYTES + wid * 1024), 16, 0, 0); } while (0)
#define PP_DMA_V(t) do { int tt_ = (t); tt_ = tt_ < NTL ? tt_ : NTL - 1; const int sl_ = tt_ % NSLOT; \
        __builtin_amdgcn_global_load_lds((const unsigned*)(Vg + (size_t)tt_ * (64 * 128) + voff), (LAS unsigned*)(lds + LDS_V + sl_ * VB_BYTES + wid * 1024), 16, 0, 0); } while (0)
#pragma unroll
    for (int i = 0; i <= NSLOT - 2; ++i) PP_DMA_K(i);
#pragma unroll
    for (int i = 0; i <= NSLOT - 3; ++i) PP_DMA_V(i);
    i32x8 q8[2];
    { const unsigned char* Qw = Qb + (size_t)(wid * 32 + r32) * 128 + hi * 32;
#pragma unroll
      for (int dh = 0; dh < 2; ++dh) { const u32x4 a_ = *(const u32x4*)(Qw + dh * 64), b_ = *(const u32x4*)(Qw + dh * 64 + 16);
          q8[dh] = (i32x8){(int)a_.x, (int)a_.y, (int)a_.z, (int)a_.w, (int)b_.x, (int)b_.y, (int)b_.z, (int)b_.w}; } }
    float m_reg = 0.f, l_reg = 0.f; f32x16 o[2] = {}; f32x16 negm = {}; asm volatile("" : "+v"(negm));
    f32x16 p0, p1; bf16x8 pa0, pa1, pa2, pa3;
    const int vb0 = (int)(size_t)(lds + LDS_V) + v_rd_base(lane);
    SBAR(); asm volatile("s_waitcnt vmcnt(0) lgkmcnt(0)\n\ts_barrier" ::: "memory"); SBAR();
#ifdef ATTN_TWO_BARRIERS
    if (grp == 1) PP_BAR();
#endif
#define PP_M(t) do { const int t_ = (t), j_ = t_ + 1; \
        if (t_ <= NTL - 2) { PP_DMA_V(t_ + NSLOT - 1); PP_DMA_K(t_ + NSLOT); } \
        i32x8 k8[4]; bf16x8 vf[8]; \
        const LAS char* Kt = lds + LDS_K + ((j_ < NTL ? j_ : 0) % NSLOT) * KB_BYTES; \
        const LAS char* Vs = lds + LDS_V + ((t_ < 0 ? 0 : t_) % NSLOT) * VB_BYTES + v_rd_base(lane); \
        if (j_ < NTL) { \
            k8[0] = PP_KLD(0, 0); k8[1] = PP_KLD(1, 0); SBAR(); \
            k8[2] = PP_KLD(0, 1); SBAR(); \
            p0 = __builtin_amdgcn_mfma_scale_f32_32x32x64_f8f6f4(k8[0], q8[0], negm, 0, 0, 0, SC_K, 0, SC_Q); SBAR(); \
            k8[3] = PP_KLD(1, 1); SBAR(); \
            p1 = __builtin_amdgcn_mfma_scale_f32_32x32x64_f8f6f4(k8[1], q8[0], negm, 0, 0, 0, SC_K, 0, SC_Q); SBAR(); \
            if (t_ >= 0) { vf[0] = PP_VLD(0, 0); vf[1] = PP_VLD(0, 1); } SBAR(); \
            p0 = __builtin_amdgcn_mfma_scale_f32_32x32x64_f8f6f4(k8[2], q8[1], p0, 0, 0, 0, SC_K, 0, SC_Q); SBAR(); \
            if (t_ >= 0) { vf[2] = PP_VLD(1, 0); vf[3] = PP_VLD(1, 1); } SBAR(); \
            p1 = __builtin_amdgcn_mfma_scale_f32_32x32x64_f8f6f4(k8[3], q8[1], p1, 0, 0, 0, SC_K, 0, SC_Q); SBAR(); \
        } else if (t_ >= 0) { vf[0] = PP_VLD(0, 0); vf[1] = PP_VLD(0, 1); vf[2] = PP_VLD(1, 0); vf[3] = PP_VLD(1, 1); SBAR(); } \
        if (t_ >= 0) { \
            vf[4] = PP_VLD(0, 2); SBAR(); o[0] = __builtin_amdgcn_mfma_f32_32x32x16_bf16(pa0, vf[0], o[0], 0, 0, 0); SBAR(); \
            vf[5] = PP_VLD(1, 2); SBAR(); o[1] = __builtin_amdgcn_mfma_f32_32x32x16_bf16(pa0, vf[2], o[1], 0, 0, 0); SBAR(); \
            vf[6] = PP_VLD(0, 3); SBAR(); o[0] = __builtin_amdgcn_mfma_f32_32x32x16_bf16(pa1, vf[1], o[0], 0, 0, 0); SBAR(); \
            vf[7] = PP_VLD(1, 3); SBAR(); o[1] = __builtin_amdgcn_mfma_f32_32x32x16_bf16(pa1, vf[3], o[1], 0, 0, 0); SBAR(); \
            o[0] = __builtin_amdgcn_mfma_f32_32x32x16_bf16(pa2, vf[4], o[0], 0, 0, 0); o[1] = __builtin_amdgcn_mfma_f32_32x32x16_bf16(pa2, vf[5], o[1], 0, 0, 0); \
            o[0] = __builtin_amdgcn_mfma_f32_32x32x16_bf16(pa3, vf[6], o[0], 0, 0, 0); o[1] = __builtin_amdgcn_mfma_f32_32x32x16_bf16(pa3, vf[7], o[1], 0, 0, 0); } \
        asm volatile("" : "+v"(o[0]), "+v"(o[1]), "+v"(p0), "+v"(p1));        \
        } while (0)
#define PP_S(first) do { \
        float a_ = max3f(p0[0], p0[1], p1[0]), b_ = max3f(p0[2], p0[3], p1[1]); a_ = max3f(a_, p1[2], p1[3]); \
        _Pragma("unroll") for (int r = 4; r < 16; r += 4) { a_ = max3f(a_, p0[r], p0[r + 1]); b_ = max3f(b_, p0[r + 2], p0[r + 3]); a_ = max3f(a_, p1[r], p1[r + 1]); b_ = max3f(b_, p1[r + 2], p1[r + 3]); } \
        float rm_ = fmaxf(a_, b_); { auto rr = __builtin_amdgcn_permlane32_swap(__float_as_uint(rm_), __float_as_uint(rm_), false, false); rm_ = fmaxf(__uint_as_float(rr[0]), __uint_as_float(rr[1])); } \
        if (first) { m_reg = rm_; _Pragma("unroll") for (int r = 0; r < 16; ++r) { p0[r] -= rm_; p1[r] -= rm_; } \
            _Pragma("unroll") for (int r = 0; r < 16; ++r) negm[r] = -m_reg; asm volatile("" : "+v"(negm)); } \
        else if (__builtin_expect(__any(rm_ > THR), 0)) { const float dl = fmaxf(rm_, 0.f); m_reg += dl; \
            _Pragma("unroll") for (int r = 0; r < 16; ++r) { p0[r] -= dl; p1[r] -= dl; } \
            _Pragma("unroll") for (int r = 0; r < 16; ++r) negm[r] = -m_reg; asm volatile("" : "+v"(negm)); \
            const float al = __builtin_amdgcn_exp2f(-dl); l_reg *= al; if (hi == 0) al_l[r32] = al; asm volatile("s_waitcnt lgkmcnt(0)" ::: "memory"); \
            _Pragma("unroll") for (int d = 0; d < 2; ++d) _Pragma("unroll") for (int r = 0; r < 16; ++r) o[d][r] *= al_l[crow(r, hi)]; } \
        _Pragma("unroll") for (int r = 0; r < 16; ++r) { PP_EXP(p0[r]); PP_EXP(p1[r]); } \
        float ps_ = 0.f; _Pragma("unroll") for (int r = 0; r < 16; ++r) ps_ += p0[r]; _Pragma("unroll") for (int r = 0; r < 16; ++r) ps_ += p1[r]; \
        { auto rr = __builtin_amdgcn_permlane32_swap(__float_as_uint(ps_), __float_as_uint(ps_), false, false); ps_ = __uint_as_float(rr[0]) + __uint_as_float(rr[1]); } \
        l_reg += ps_; \
        PK4N(p0, 0, pa0); PK4N(p0, 8, pa1); PK4N(p1, 0, pa2); PK4N(p1, 8, pa3); \
        asm volatile("" : "+v"(pa0), "+v"(pa1), "+v"(pa2), "+v"(pa3), "+v"(l_reg)); } while (0)
#ifdef ATTN_TWO_BARRIERS
    PP_M(-1); PP_SLOT_END();
    PP_S(true); PP_SLOT_END();
#pragma nounroll
    for (int t = 0; t < NTL - 1; ++t) {
        PP_M(t); PP_SLOT_END();
        PP_S(false); PP_SLOT_END();
    }
    PP_M(NTL - 1);
    if (grp == 0) PP_BAR();
#else
#ifdef ATTN_PRIO_YOUNG
    if (grp == 1) __builtin_amdgcn_s_setprio(1);
#endif
    if (grp == 0) {
        PP_M(-1); PP_S(true); PP_SLOT_END();
#pragma nounroll
        for (int t = 0; t < NTL - 1; ++t) { PP_M(t); PP_S(false); PP_SLOT_END(); }
        PP_M(NTL - 1);
    } else {
        PP_M(-1); PP_SLOT_END();
        PP_S(true);
#pragma nounroll
        for (int t = 0; t < NTL - 1; ++t) { PP_M(t); PP_SLOT_END(); PP_S(false); }
        PP_M(NTL - 1);
    }
#ifdef ATTN_PRIO_YOUNG
    __builtin_amdgcn_s_setprio(0);
#endif
#endif
    if (hi == 0) li_l[r32] = l_reg; asm volatile("s_waitcnt lgkmcnt(0)" ::: "memory");
    float rli[16];
#pragma unroll
    for (int r = 0; r < 16; ++r) rli[r] = __builtin_amdgcn_rcpf(li_l[crow(r, hi)]);
    bf16_t* Ow = Ob + (size_t)(wid * 32) * ldo;
#pragma unroll
    for (int r = 0; r < 16; ++r) { const int orow = crow(r, hi);
#pragma unroll
        for (int d0 = 0; d0 < 2; ++d0) Ow[(size_t)orow * ldo + d0 * 32 + r32] = f2bf(o[d0][r] * rli[r]); }
    SBAR(); asm volatile("s_waitcnt vmcnt(0) lgkmcnt(0)\n\ts_barrier" ::: "memory"); SBAR();
#undef PP_DMA_K
#undef PP_DMA_V
#undef PP_M
#undef PP_S
}
}

__device__ __forceinline__ void retu_unit(int unit, const bf16_t* PR, float* U, float lg2f, float lg2b, LAS char* lds, const int wv) {
    const int tid = otid(wv), wid = __builtin_amdgcn_readfirstlane(tid >> 6), lane = tid & 63, r32 = lane & 31, hi = lane >> 5;
    const int h = unit & 3, bc = unit >> 2, bl = bc / NCHUNK, c = bc - bl * NCHUNK;
    const size_t r0 = (size_t)bl * SB + (size_t)c * 128;
    LAS char* Vt = lds;
    LAS char* Kf = lds + 32768;
    LAS char* Kb = lds + 49152;
#pragma unroll
    for (int i = 0; i < 2; ++i) { const int ch = tid + i * 512, j = ch >> 3, c8 = (ch & 7) * 8;
        const u32x4 kw = *(const u32x4*)(PR + (r0 + j) * 1536 + 256 + h * 64 + c8);
        float f[8], g[8]; unpack8(kw, f);
        const float wf = __builtin_amdgcn_exp2f(lg2f * (float)(127 - j)), wb = __builtin_amdgcn_exp2f(lg2b * (float)j);
#pragma unroll
        for (int k = 0; k < 8; ++k) { g[k] = f[k] * wb; f[k] *= wf; }
        const int off = (j >> 6) * 8192 + v_st<2>(j & 63, c8);
        *(LAS u32x4*)(Kf + off) = pack8(f); *(LAS u32x4*)(Kb + off) = pack8(g); }
#pragma unroll
    for (int i = 0; i < 4; ++i) { const int ch = tid + i * 512, j = ch >> 4, c8 = (ch & 15) * 8;
        const u32x4 vw = *(const u32x4*)(PR + (r0 + j) * 1536 + 512 + h * 128 + c8);
        *(LAS u32x4*)(Vt + (j >> 6) * 16384 + v_st<4>(j & 63, c8)) = vw; }
    __syncthreads();
    const int eblk = wid & 3, dblk = wid >> 2;
    const int vbV = (int)(size_t)Vt + v_rd_base(lane) + eblk * 512, vbF = (int)(size_t)Kf + v_rd_base(lane) + dblk * 512, vbB = (int)(size_t)Kb + v_rd_base(lane) + dblk * 512;
    f32x16 aF = {}, aB = {};
#define RU_STEP(SUB, KS) do { const bf16x8 a = tr_frag<4, KS>(vbV + SUB * 16384), bf = tr_frag<2, KS>(vbF + SUB * 8192), bb = tr_frag<2, KS>(vbB + SUB * 8192); \
        asm volatile("s_waitcnt lgkmcnt(0)" ::: "memory"); SBAR(); \
        aF = __builtin_amdgcn_mfma_f32_32x32x16_bf16(a, bf, aF, 0, 0, 0); aB = __builtin_amdgcn_mfma_f32_32x32x16_bf16(a, bb, aB, 0, 0, 0); } while (0)
    RU_STEP(0, 0); RU_STEP(0, 1); RU_STEP(0, 2); RU_STEP(0, 3); RU_STEP(1, 0); RU_STEP(1, 1); RU_STEP(1, 2); RU_STEP(1, 3);
#undef RU_STEP
    float* Uf = U + (size_t)unit * 2 * 8192; float* Ub = Uf + 8192;
#pragma unroll
    for (int r = 0; r < 16; ++r) { const int e = 32 * eblk + crow(r, hi), d = 32 * dblk + r32; Uf[e * 64 + d] = aF[r]; Ub[e * 64 + d] = aB[r]; }
    __syncthreads();
}

__device__ __forceinline__ void retout_unit(int unit, const bf16_t* PR, const bf16_t* S, const float* gnw, bf16_t* ACT, float lg2f, float lg2b, LAS char* lds, const int wv) {
    const int tid = otid(wv), wid = __builtin_amdgcn_readfirstlane(tid >> 6), lane = tid & 63, r32 = lane & 31, hi = lane >> 5;
    const int h = unit & 3, bc = unit >> 2, bl = bc / NCHUNK, c = bc - bl * NCHUNK;
    const size_t r0 = (size_t)bl * SB + (size_t)c * 128;
    LAS char* Vt = lds; LAS float* part = (LAS float*)(lds + 32768);
    const int qblk = wid & 3, ehalf = wid >> 2, iq = 32 * qblk + r32;
    u32x4 vw[4];
#pragma unroll
    for (int i = 0; i < 4; ++i) { const int ch = tid + i * 512, j = ch >> 4, c8 = (ch & 15) * 8; vw[i] = *(const u32x4*)(PR + (r0 + j) * 1536 + 512 + h * 128 + c8); }
    bf16x8 qf[4], kf[4][4];
    { const bf16_t* qp = PR + (r0 + iq) * 1536 + h * 64 + hi * 8;
#pragma unroll
      for (int d0 = 0; d0 < 4; ++d0) qf[d0] = *(const bf16x8*)(qp + d0 * 16); }
#pragma unroll
    for (int jb = 0; jb < 4; ++jb) { const bf16_t* kp = PR + (r0 + 32 * jb + r32) * 1536 + 256 + h * 64 + hi * 8;
#pragma unroll
        for (int d0 = 0; d0 < 4; ++d0) kf[jb][d0] = *(const bf16x8*)(kp + d0 * 16); }
    const int orow = tid >> 2, oc = (tid & 3) * 32;
    u32x4 gw[4];
#pragma unroll
    for (int k = 0; k < 4; ++k) gw[k] = *(const u32x4*)(PR + (r0 + orow) * 1536 + 1024 + h * 128 + oc + 8 * k);
#pragma unroll
    for (int i = 0; i < 4; ++i) { const int ch = tid + i * 512, j = ch >> 4, c8 = (ch & 15) * 8; *(LAS u32x4*)(Vt + (j >> 6) * 16384 + v_st<4>(j & 63, c8)) = vw[i]; }
    f32x16 o[2] = {};
    __syncthreads();
    bf16x8 sf[2][4], sb[2][4];
    { const bf16_t* Sf = S + (size_t)unit * 2 * 8192; const bf16_t* Sb = Sf + 8192;
#pragma unroll
      for (int e0 = 0; e0 < 2; ++e0) { const int e = 64 * ehalf + 32 * e0 + r32;
#pragma unroll
        for (int d0 = 0; d0 < 4; ++d0) { sf[e0][d0] = *(const bf16x8*)(Sf + e * 64 + d0 * 16 + hi * 8); sb[e0][d0] = *(const bf16x8*)(Sb + e * 64 + d0 * 16 + hi * 8); } } }
    const int vb = (int)(size_t)Vt + v_rd_base(lane) + ehalf * 1024;
#pragma unroll
    for (int jb = 0; jb < 4; ++jb) {
        f32x16 p = {};
#pragma unroll
        for (int d0 = 0; d0 < 4; ++d0) p = __builtin_amdgcn_mfma_f32_32x32x16_bf16(kf[jb][d0], qf[d0], p, 0, 0, 0);
#pragma unroll
        for (int r = 0; r < 16; ++r) { const int dj = iq - (32 * jb + crow(r, hi));
            const float e = dj >= 0 ? lg2f * (float)dj : lg2b * (float)(-dj); p[r] *= __builtin_amdgcn_exp2f(e); }
        bf16x8 pa0, pa1; PK4(p, 0, pa0); PK4(p, 8, pa1);
        const int vj = vb + (jb >> 1) * 16384;
        if (jb & 1) {
            const bf16x8 f00 = tr_frag<4, 2>(vj), f01 = tr_frag<4, 3>(vj), f10 = tr_frag<4, 2>(vj + 512), f11 = tr_frag<4, 3>(vj + 512);
            asm volatile("s_waitcnt lgkmcnt(0)" ::: "memory"); SBAR();
            o[0] = __builtin_amdgcn_mfma_f32_32x32x16_bf16(pa0, f00, o[0], 0, 0, 0); o[0] = __builtin_amdgcn_mfma_f32_32x32x16_bf16(pa1, f01, o[0], 0, 0, 0);
            o[1] = __builtin_amdgcn_mfma_f32_32x32x16_bf16(pa0, f10, o[1], 0, 0, 0); o[1] = __builtin_amdgcn_mfma_f32_32x32x16_bf16(pa1, f11, o[1], 0, 0, 0);
        } else {
            const bf16x8 f00 = tr_frag<4, 0>(vj), f01 = tr_frag<4, 1>(vj), f10 = tr_frag<4, 0>(vj + 512), f11 = tr_frag<4, 1>(vj + 512);
            asm volatile("s_waitcnt lgkmcnt(0)" ::: "memory"); SBAR();
            o[0] = __builtin_amdgcn_mfma_f32_32x32x16_bf16(pa0, f00, o[0], 0, 0, 0); o[0] = __builtin_amdgcn_mfma_f32_32x32x16_bf16(pa1, f01, o[0], 0, 0, 0);
            o[1] = __builtin_amdgcn_mfma_f32_32x32x16_bf16(pa0, f10, o[1], 0, 0, 0); o[1] = __builtin_amdgcn_mfma_f32_32x32x16_bf16(pa1, f11, o[1], 0, 0, 0);
        }
    }
    {
        const float xf = __builtin_amdgcn_exp2f(lg2f * (float)(iq + 1)), xb = __builtin_amdgcn_exp2f(lg2b * (float)(128 - iq));
#pragma unroll
        for (int d0 = 0; d0 < 4; ++d0) {
            float f[8], g[8]; unpack8(__builtin_bit_cast(u32x4, qf[d0]), f);
#pragma unroll
            for (int k = 0; k < 8; ++k) { g[k] = f[k] * xb; f[k] *= xf; }
            const bf16x8 qa = __builtin_bit_cast(bf16x8, pack8(f)), qb = __builtin_bit_cast(bf16x8, pack8(g));
#pragma unroll
            for (int e0 = 0; e0 < 2; ++e0) { o[e0] = __builtin_amdgcn_mfma_f32_32x32x16_bf16(qa, sf[e0][d0], o[e0], 0, 0, 0); o[e0] = __builtin_amdgcn_mfma_f32_32x32x16_bf16(qb, sb[e0][d0], o[e0], 0, 0, 0); }
        }
    }
    float sq[16];
#pragma unroll
    for (int r = 0; r < 16; ++r) { float s = o[0][r] * o[0][r] + o[1][r] * o[1][r];
        sq[r] = sum32(s); }
    if (r32 == 0) {
#pragma unroll
        for (int r = 0; r < 16; ++r) part[wid * 32 + crow(r, hi)] = sq[r];
    }
    __syncthreads();
    const float g0 = gnw[h * 128 + 64 * ehalf + r32], g1 = gnw[h * 128 + 64 * ehalf + 32 + r32];
    LAS bf16_t* stg = (LAS bf16_t*)Vt;
#pragma unroll
    for (int r = 0; r < 16; ++r) { const int il = crow(r, hi);
        const float tot = part[wid * 32 + il] + part[(wid ^ 4) * 32 + il];
        const float rn = rsqrtf(tot * (1.f / 128.f) + RMS_EPS);
        LAS bf16_t* sp = stg + (32 * qblk + il) * 128 + 64 * ehalf + r32;
        sp[0] = f2bf(o[0][r] * rn * g0); sp[32] = f2bf(o[1][r] * rn * g1); }
    __syncthreads();
#pragma unroll
    for (int k = 0; k < 4; ++k) { float y[8], g[8]; unpack8(*(const LAS u32x4*)(stg + orow * 128 + oc + 8 * k), y); unpack8(gw[k], g);
#pragma unroll
        for (int q = 0; q < 8; ++q) y[q] *= siluf_(g[q]);
        *(u32x4*)(ACT + (r0 + orow) * 1536 + h * 128 + oc + 8 * k) = pack8(y); }
    __syncthreads();
}
struct Args { const float* in[26]; float* out; unsigned char* ws; int ph_lo, ph_hi; };
struct Frame {
    LAS unsigned char* lds; int G, wv;
    const Args* a; float* out; unsigned char* ws;
};
__device__ __forceinline__ const float* in_ptr(const Args* a, int i) { int z; asm volatile("s_mov_b32 %0, 0" : "=s"(z)); return a->in[i + z]; }
#define INP(i) in_ptr(F.a, (i))
__device__ __forceinline__ unsigned char* ows(unsigned char* p) { asm volatile("" : "+s"(p)); return p; }
#ifdef SELFCHECK_ATTN
#define WSP(T, off) ((T*)(ows(F.ws) + (off)))
#else
#define WSP(T, off) ((T*)(F.ws + (off)))
#endif

__device__ __forceinline__ int srccol_in(int n) {
    if (n < 512) { const int base = n & ~255, hh = (n & 255) >> 6, p = n & 63; return base + hh * 64 + (p >> 1) + 32 * (p & 1); }
    if (n < 2048) return n;
    if (n < 3072) { const int j = (n - 2048) >> 1; return 2048 + j + 512 * (n & 1); }
    if (n < 3712) return n;
    if (n < 3744) { const int p = n - 3712, a = p >> 4, q = p & 15; return 3712 + a * 16 + (q >> 1) + 8 * (q & 1); }
    if (n < 3840) return -1;
    return n - 96;
}
__device__ __forceinline__ int srccol_uq(int n) { const int h = n / 96, d = n - h * 96; if (d < 64) return n; const int p = d - 64, a = p >> 4, q = p & 15; return h * 96 + 64 + a * 16 + (q >> 1) + 8 * (q & 1); }

__device__ __forceinline__ void cvt_item(const float* sp, int ldw, const float* scale, bf16_t* dst, int ldd, int n0, int k0, LAS float* scr, int lane) {
    float vv[32];
#pragma unroll
    for (int i = 0; i < 32; ++i) { const int kk = 2 * i + (lane >> 5); vv[i] = sp ? sp[(size_t)(k0 + kk) * ldw] : 0.f; }
    if (scale) {
#pragma unroll
        for (int i = 0; i < 32; ++i) vv[i] *= scale[k0 + 2 * i + (lane >> 5)];
    }
#pragma unroll
    for (int i = 0; i < 32; ++i) scr[(2 * i + (lane >> 5)) * 33 + (lane & 31)] = vv[i];
    asm volatile("s_waitcnt lgkmcnt(0)" ::: "memory");
    const int c = lane & 7;
#pragma unroll
    for (int j = 0; j < 4; ++j) { const int n = (lane >> 3) + 8 * j; const LAS float* s = scr + (8 * c) * 33 + n;
        u32x4 o; o.x = cvtpk(s[0 * 33], s[1 * 33]); o.y = cvtpk(s[2 * 33], s[3 * 33]); o.z = cvtpk(s[4 * 33], s[5 * 33]); o.w = cvtpk(s[6 * 33], s[7 * 33]);
        *(u32x4*)(dst + (size_t)(n0 + n) * ldd + k0 + 8 * c) = o; }
    asm volatile("s_waitcnt lgkmcnt(0)" ::: "memory");
}

__device__ __forceinline__ f32x2 cossin_f(float ang) {
    const double x = (double)ang * 0.15915494309189535; const float r = (float)(x - rint(x));
    return (f32x2){__builtin_amdgcn_cosf(r), __builtin_amdgcn_sinf(r)};
}
__device__ __forceinline__ float lg2_gamma(const float* rd) { return -__builtin_amdgcn_logf(1.f + __builtin_amdgcn_exp2f(-rd[0] * LOG2E)); }
#define PHASE_IDS const int tid = otid(F.wv), lane = tid & 63, wave = __builtin_amdgcn_readfirstlane(tid >> 6), bid = obid(); (void)lane; (void)wave; (void)bid;
__device__ __forceinline__ void p0_prologue(Frame& F) {
    PHASE_IDS
    __syncthreads();
    if (bid < 48) {
        LAS float* sc = (LAS float*)F.lds;
        LAS float* red = (LAS float*)(F.lds + 40960);
        for (int i = tid; i < 9 * 1024; i += 512) { const int v = i >> 10, k = i & 1023; const float x = v < 8 ? INP(1)[v * 1024 + k] : INP(3)[k]; sc[i] = siluf_(x); }
        __syncthreads();
        const int l = bid / 24, col = (bid % 24) * 256 + (tid & 255), kq = tid >> 8;
        const float* w = INP(4) + (size_t)l * 1024 * 6144 + col;
        float a[9];
#pragma unroll
        for (int v = 0; v < 9; ++v) a[v] = 0.f;
#pragma nounroll
        for (int k = kq * 512; k < kq * 512 + 512; k += 16) {
            float wv_[16];
#pragma unroll
            for (int j = 0; j < 16; ++j) wv_[j] = w[(size_t)(k + j) * 6144];
#pragma unroll
            for (int j4 = 0; j4 < 4; ++j4)
#pragma unroll
                for (int v = 0; v < 9; ++v) { const f32x4 s = *(const LAS f32x4*)(sc + v * 1024 + k + 4 * j4); a[v] += (s[0] * wv_[4 * j4] + s[1] * wv_[4 * j4 + 1]) + (s[2] * wv_[4 * j4 + 2] + s[3] * wv_[4 * j4 + 3]); }
        }
        if (kq == 1) {
#pragma unroll
            for (int v = 0; v < 9; ++v) red[v * 256 + (tid & 255)] = a[v];
        }
        __syncthreads();
        if (kq == 0) { float* MOD = WSP(float, WS_MOD) + (size_t)l * 9 * 6144; const float b = INP(5)[l * 6144 + col];
#pragma unroll
            for (int v = 0; v < 9; ++v) MOD[v * 6144 + col] = b + a[v] + red[v * 256 + tid]; }
        __syncthreads();
    }
    { f32x2* RT = WSP(f32x2, WS_RT); f32x2* MT = WSP(f32x2, WS_MT);
      for (int i = bid * 512 + tid; i < 8192 * 32 + 128 * 8; i += F.G * 512) {
          if (i < 8192 * 32) { const int t = i >> 5, k = i & 31; const float inv = exp2f(-(float)k * (13.287712379549449f / 32.f)); RT[i] = cossin_f((float)t * inv); }
          else { const int q = i - 8192 * 32, pos = q >> 3, k = q & 7; const float inv = exp2f(-(float)k * (13.287712379549449f / 8.f)); MT[q] = cossin_f((float)pos * inv); } } }
    LAS float* scr = (LAS float*)(F.lds + wave * 16384);
    const int gw = bid * 8 + wave, NGW = F.G * 8;
    constexpr int I_IN = 2 * 16 * 216, I_CAT = 2 * 3 * 8 * 32, I_OUT = 2 * 16 * 32, I_UQ = 2 * 6 * 24, I_UKV = 2 * 4 * 32, I_UP = 32 * 16 * 32, I_W2 = 32 * 8 * 32;
    constexpr int NITEMS = I_IN + I_CAT + I_OUT + I_UQ + I_UKV + I_UP + I_W2;
    for (int it = gw; it < NITEMS; it += NGW) {
        int r = it;
        if (r < I_IN) { const int l = r / 3456, q = r % 3456, kb = q / 216, nb = q % 216; const int sc_ = srccol_in(nb * 32 + (lane & 31));
            cvt_item(sc_ >= 0 ? INP(8) + (size_t)l * 1024 * INCOLS + sc_ : nullptr, INCOLS, nullptr, WSP(bf16_t, WS_WIN) + (size_t)l * INW * 1024, 1024, nb * 32, kb * 64, scr, lane); continue; } r -= I_IN;
        if (r < I_CAT) { const int l = r / 768, q = r % 768, seg = q / 256, q2 = q % 256, kb = q2 / 32, nb = q2 % 32; const float* W = seg == 0 ? INP(11) : (seg == 1 ? INP(13) : INP(18));
            cvt_item(W + (size_t)l * 512 * 1024 + nb * 32 + (lane & 31), 1024, nullptr, WSP(bf16_t, WS_WCAT) + (size_t)l * 1024 * 1536 + seg * 512, 1536, nb * 32, kb * 64, scr, lane); continue; } r -= I_CAT;
        if (r < I_OUT) { const int l = r / 512, q = r % 512, kb = q / 32, nb = q % 32;
            cvt_item(INP(19) + (size_t)l * 1024 * 1024 + nb * 32 + (lane & 31), 1024, nullptr, WSP(bf16_t, WS_WOUT) + (size_t)l * 1024 * 1024, 1024, nb * 32, kb * 64, scr, lane); continue; } r -= I_OUT;
        if (r < I_UQ) { const int l = r / 144, q = r % 144, kb = q / 24, nb = q % 24;
            cvt_item(INP(15) + (size_t)l * 384 * 768 + srccol_uq(nb * 32 + (lane & 31)), 768, INP(14) + l * 384, WSP(bf16_t, WS_WUQ) + (size_t)l * 768 * 384, 384, nb * 32, kb * 64, scr, lane); continue; } r -= I_UQ;
        if (r < I_UKV) { const int l = r / 128, q = r % 128, kb = q / 32, nb = q % 32;
            cvt_item(INP(17) + (size_t)l * 256 * 1024 + nb * 32 + (lane & 31), 1024, INP(16) + l * 256, WSP(bf16_t, WS_WUKV) + (size_t)l * 1024 * 256, 256, nb * 32, kb * 64, scr, lane); continue; } r -= I_UKV;
        if (r < I_UP) { const int le = r / 512, q = r % 512, kb = q / 32, nb = q % 32; const int n = nb * 32 + (lane & 31);
            const float* W = (n & 1) ? INP(23) : INP(22);
            cvt_item(W + (size_t)le * 1024 * 512 + (n >> 1), 512, nullptr, WSP(bf16_t, WS_WUP) + (size_t)le * 1024 * 1024, 1024, nb * 32, kb * 64, scr, lane); continue; } r -= I_UP;
        { const int le = r / 256, q = r % 256, kb = q / 32, nb = q % 32;
            cvt_item(INP(24) + (size_t)le * 512 * 1024 + nb * 32 + (lane & 31), 1024, nullptr, WSP(bf16_t, WS_W2T) + (size_t)le * 1024 * 512, 512, nb * 32, kb * 64, scr, lane); }
    }
}

__device__ __forceinline__ void norm1_phase(Frame& F, const Resid& R, int l, int skip_none) {
    PHASE_IDS
    const int gw = bid * 8 + wave, NGW = F.G * 8; bf16_t* HX = WSP(bf16_t, WS_HX);
    const float* MODL = WSP(float, WS_MOD) + (size_t)l * 9 * 6144; const float* nw = INP(6) + l * 1024;
    for (int row = gw; row < NT; row += NGW) {
        const float* md = MODL + R.modv(row) * 6144;
        f32x4 v[4]; float s = 0.f;
        int sf32 = R.src_f32; asm volatile("" : "+s"(sf32));
        if (sf32) { const f32x4* xr = (const f32x4*)R.srcf(row) + lane;
#pragma unroll
            for (int j = 0; j < 4; ++j) v[j] = xr[64 * j]; }
        else { const u32x2* xr = (const u32x2*)R.dst(row) + lane;
#pragma unroll
            for (int j = 0; j < 4; ++j) { const u32x2 w = xr[64 * j]; v[j] = (f32x4){bf_lo(w.x), bf_hi(w.x), bf_lo(w.y), bf_hi(w.y)}; } }
#pragma unroll
        for (int j = 0; j < 4; ++j) s += (v[j][0] * v[j][0] + v[j][1] * v[j][1]) + (v[j][2] * v[j][2] + v[j][3] * v[j][3]);
        const float rs = rsqrtf(wave_sum(s) * (1.f / DM) + RMS_EPS);
#pragma unroll
        for (int j = 0; j < 4; ++j) { const int c = 4 * lane + 256 * j; const f32x4 w = *(const f32x4*)(nw + c), sh = *(const f32x4*)(md + c), sc = *(const f32x4*)(md + 1024 + c);
            const f32x4 y = v[j] * rs * w * (sc + 1.f) + sh; u32x2 o; o.x = cvtpk(y[0], y[1]); o.y = cvtpk(y[2], y[3]); *(u32x2*)(HX + (size_t)row * 1024 + c) = o; }
    }
}
__device__ __forceinline__ void final_norm_phase(Frame& F, int g) {
    PHASE_IDS
    const int gw = bid * 8 + wave, NGW = F.G * 8; const float* nw = INP(25);
    for (int row = gw; row < GB * SEQ; row += NGW) {
        f32x4* xr = (f32x4*)(F.out + ((size_t)g * GB * SEQ + row) * DM) + lane;
        const u32x2* xb = (const u32x2*)(WSP(bf16_t, WS_XRES) + ((size_t)g * GB * SEQ + row) * DM) + lane;
        f32x4 v[4]; float s = 0.f;
#pragma unroll
        for (int j = 0; j < 4; ++j) { const u32x2 w = xb[64 * j]; v[j] = (f32x4){bf_lo(w.x), bf_hi(w.x), bf_lo(w.y), bf_hi(w.y)}; s += (v[j][0] * v[j][0] + v[j][1] * v[j][1]) + (v[j][2] * v[j][2] + v[j][3] * v[j][3]); }
        const float rs = rsqrtf(wave_sum(s) * (1.f / DM) + RMS_EPS);
#pragma unroll
        for (int j = 0; j < 4; ++j) { const f32x4 w = *(const f32x4*)(nw + 4 * lane + 256 * j); xr[64 * j] = v[j] * rs * w; }
    }
}
__device__ __forceinline__ void conv_phase(Frame& F, int l) {
    PHASE_IDS
    const bf16_t* PC = WSP(bf16_t, WS_PC); bf16_t* ACT = WSP(bf16_t, WS_ACT); const float* cw = INP(12) + (size_t)l * 512 * 3;
    for (int idx = bid * 512 + tid; idx < NT * 64; idx += F.G * 512) {
        const int row = idx >> 6, c8 = (idx & 63) * 8; const int bl = row / SB, s = row - bl * SB;
        const bool hp = (s != 0) && (s != CTXL), hn = (s != CTXL - 1) && (s != SB - 1);
        const bf16_t* p = PC + (size_t)row * 1024 + c8;
        float b[8], u0[8], um[8], up[8];
        unpack8(*(const u32x4*)p, b); unpack8(*(const u32x4*)(p + 512), u0);
        if (hp) unpack8(*(const u32x4*)(p + 512 - 1024), um); else {
#pragma unroll
            for (int k = 0; k < 8; ++k) um[k] = 0.f; }
        if (hn) unpack8(*(const u32x4*)(p + 512 + 1024), up); else {
#pragma unroll
            for (int k = 0; k < 8; ++k) up[k] = 0.f; }
        float o[8];
#pragma unroll
        for (int k = 0; k < 8; ++k) { const float* w = cw + (c8 + k) * 3; o[k] = b[k] * (um[k] * w[0] + u0[k] * w[1] + up[k] * w[2]); }
        *(u32x4*)(ACT + (size_t)row * 1536 + 512 + c8) = pack8(o);
    }
}
__device__ __forceinline__ void scan_phase(Frame& F, int l) {
    PHASE_IDS
    const float* U = WSP(float, WS_HX); bf16_t* S = WSP(bf16_t, WS_PM);
    for (int idx = bid * 512 + tid; idx < GB * 4 * 2 * 8192; idx += F.G * 512) {
        const int ed = idx & 8191, dir = (idx >> 13) & 1, h = (idx >> 14) & 3, bl = idx >> 16;
        const float lg = lg2_gamma(INP(9) + l * 8 + dir * 4 + h); const float dec = __builtin_amdgcn_exp2f(lg * 128.f);
        float st = 0.f;
        for (int i0 = 0; i0 < NCHUNK; i0 += 6) {
            float uu[6]; size_t off[6];
#pragma unroll
            for (int k = 0; k < 6; ++k) { const int i = i0 + k; const int c = dir ? (i < 2 ? 1 - i : NCHUNK + 1 - i) : i;
                off[k] = ((size_t)(((bl * NCHUNK + c) * 4 + h) * 2 + dir)) * 8192 + ed; uu[k] = U[off[k]]; }
#pragma unroll
            for (int k = 0; k < 6; ++k) { S[off[k]] = f2bf(st); st = dec * st + uu[k]; }
        }
    }
}
template <int NR>
__device__ __forceinline__ void n2_rows(const Resid& R, const int (&rows)[NR], const int (&slot)[NR], const float* MODL, const float* nw, bf16_t* H2, const LAS float* wr, LAS float* lg, int lane) {
    f32x4 v[NR][4]; float s[NR];
#pragma unroll
    for (int q = 0; q < NR; ++q) { const u32x2* xr = (const u32x2*)R.dst(rows[q]) + lane; s[q] = 0.f;
#pragma unroll
        for (int j = 0; j < 4; ++j) { const u32x2 w_ = xr[64 * j]; v[q][j] = (f32x4){bf_lo(w_.x), bf_hi(w_.x), bf_lo(w_.y), bf_hi(w_.y)}; s[q] += (v[q][j][0] * v[q][j][0] + v[q][j][1] * v[q][j][1]) + (v[q][j][2] * v[q][j][2] + v[q][j][3] * v[q][j][3]); } }
#pragma unroll
    for (int q = 0; q < NR; ++q) s[q] = rsqrtf(wave_sum(s[q]) * (1.f / DM) + RMS_EPS);
#pragma unroll
    for (int q = 0; q < NR; ++q) { const float* md = MODL + R.modv(rows[q]) * 6144;
#pragma unroll
        for (int j = 0; j < 4; ++j) { const int c = 4 * lane + 256 * j; const f32x4 w = *(const f32x4*)(nw + c), sh = *(const f32x4*)(md + 3072 + c), sc = *(const f32x4*)(md + 4096 + c);
            v[q][j] = v[q][j] * s[q] * w * (sc + 1.f) + sh; u32x2 o; o.x = cvtpk(v[q][j][0], v[q][j][1]); o.y = cvtpk(v[q][j][2], v[q][j][3]); *(u32x2*)(H2 + (size_t)rows[q] * 1024 + c) = o; } }
    const int b4 = (lane >> 4) & 1, b3 = (lane >> 3) & 1, b2 = (lane >> 2) & 1;
#pragma unroll
    for (int q = 0; q < NR; ++q) {
        float a[16];
#pragma unroll
        for (int e = 0; e < 16; ++e) { float t = 0.f;
#pragma unroll
            for (int j = 0; j < 4; ++j) { const f32x4 w = *(const LAS f32x4*)(wr + e * 1024 + 4 * lane + 256 * j); t += (v[q][j][0] * w[0] + v[q][j][1] * w[1]) + (v[q][j][2] * w[2] + v[q][j][3] * w[3]); }
            a[e] = t; }
        float s8[8], s4[4], s2[2];
#pragma unroll
        for (int k = 0; k < 8; ++k) { auto r = __builtin_amdgcn_permlane32_swap(__float_as_uint(a[k]), __float_as_uint(a[k + 8]), false, false); s8[k] = __uint_as_float(r[0]) + __uint_as_float(r[1]); }
#pragma unroll
        for (int k = 0; k < 4; ++k) { const float snd = b4 ? s8[k] : s8[k + 4], kp = b4 ? s8[k + 4] : s8[k]; s4[k] = kp + swz_xor<16>(snd); }
#pragma unroll
        for (int k = 0; k < 2; ++k) { const float snd = b3 ? s4[k] : s4[k + 2], kp = b3 ? s4[k + 2] : s4[k]; s2[k] = kp + swz_xor<8>(snd); }
        float s1; { const float snd = b2 ? s2[0] : s2[1], kp = b2 ? s2[1] : s2[0]; s1 = kp + swz_xor<4>(snd); }
        s1 += swz_xor<2>(s1); s1 += swz_xor<1>(s1);
        if ((lane & 3) == 0) lg[slot[q] * 16 + (lane >> 2)] = s1;
    }
}
__device__ __forceinline__ void norm2_router_phase(Frame& F, const Resid& R, int l, int g, int lat_only, int cslot) {
    PHASE_IDS
    bf16_t* H2 = WSP(bf16_t, WS_HX);
    const float* MODL = WSP(float, WS_MOD) + (size_t)l * 9 * 6144; const float* nw = INP(7) + l * 1024;
    LAS float* wr = (LAS float*)F.lds; LAS float* lg = (LAS float*)(F.lds + 65536);
    { const float* wrt = INP(20); for (int i = tid; i < 16 * 1024; i += 512) wr[i] = wrt[(i & 1023) * 16 + (i >> 10)]; }
    __syncthreads();
    const int rpb = (NT + F.G - 1) / F.G, r0 = bid * rpb, r1 = (r0 + rpb < NT) ? r0 + rpb : NT;
    for (int row = r0 + wave; row < r1; row += 16) {
        const int rowb = row + 8;
        const bool okA = !(lat_only && (row % SB) < CTXL), okB = rowb < r1 && !(lat_only && (rowb % SB) < CTXL);
        if (okA && okB) { const int rr[2] = {row, rowb}, ss[2] = {row - r0, rowb - r0}; n2_rows<2>(R, rr, ss, MODL, nw, H2, wr, lg, lane); }
        else if (okA) { const int rr[1] = {row}, ss[1] = {row - r0}; n2_rows<1>(R, rr, ss, MODL, nw, H2, wr, lg, lane); }
        else if (okB) { const int rr[1] = {rowb}, ss[1] = {rowb - r0}; n2_rows<1>(R, rr, ss, MODL, nw, H2, wr, lg, lane); }
    }
    __syncthreads();
    unsigned* CNT = WSP(unsigned, WS_CTL) + CW_CNT + (g * 2 + l) * 64 + cslot; int* LIST = WSP(int, WS_LIST); float* WGT = WSP(float, WS_WGT);
    const float* rb = INP(21);
    LAS unsigned* lcnt = (LAS unsigned*)(F.lds + 65536 + 16384);
    if (tid < 64) lcnt[tid] = 0u;
    __syncthreads();
    int bucket = -1, rank = 0; float wlo = 0.f, whi = 0.f; const int trow = r0 + tid;
    if (tid < r1 - r0 && !(lat_only && (trow % SB) < CTXL)) {
        const int t = tid;
        float sc16[16];
#pragma unroll
        for (int e4 = 0; e4 < 4; ++e4) { const f32x4 x = *(const LAS f32x4*)(lg + t * 16 + e4 * 4); sc16[e4 * 4] = sigmoidf_(x[0]); sc16[e4 * 4 + 1] = sigmoidf_(x[1]); sc16[e4 * 4 + 2] = sigmoidf_(x[2]); sc16[e4 * 4 + 3] = sigmoidf_(x[3]); }
        float best = -1e30f; int gs = 0;
#pragma unroll
        for (int q = 0; q < 4; ++q) { float m1 = -1e30f, m2 = -1e30f;
#pragma unroll
            for (int k = 0; k < 4; ++k) { const float b = sc16[q * 4 + k] + rb[q * 4 + k]; if (b > m1) { m2 = m1; m1 = b; } else if (b > m2) m2 = b; }
            const float gsc = m1 + m2; if (gsc > best) { best = gsc; gs = q; } }
        float bb[4], su[4];
#pragma unroll
        for (int k = 0; k < 4; ++k) { float b = 0.f, u = 0.f;
#pragma unroll
            for (int q = 0; q < 4; ++q) { if (q == gs) { b = sc16[q * 4 + k] + rb[q * 4 + k]; u = sc16[q * 4 + k]; } }
            bb[k] = b; su[k] = u; }
        int i1 = 0; float b1 = bb[0];
#pragma unroll
        for (int k = 1; k < 4; ++k) if (bb[k] > b1) { b1 = bb[k]; i1 = k; }
        int i2 = -1; float b2 = -1e30f;
#pragma unroll
        for (int k = 0; k < 4; ++k) if (k != i1 && bb[k] > b2) { b2 = bb[k]; i2 = k; }
        const int lo = i1 < i2 ? i1 : i2, hi = i1 < i2 ? i2 : i1;
        float slo = 0.f, shi = 0.f;
#pragma unroll
        for (int k = 0; k < 4; ++k) { if (k == lo) slo = su[k]; if (k == hi) shi = su[k]; }
        const float inv = 1.f / (slo + shi);
        const int pair = lo == 0 ? hi - 1 : (lo == 1 ? hi + 1 : 5);
        bucket = gs * 6 + pair; wlo = slo * inv; whi = shi * inv;
        rank = (int)atomicAdd((unsigned*)(lcnt + bucket), 1u);
    }
    __syncthreads();
    if (tid < NPAIR) { const unsigned c = lcnt[tid]; lcnt[32 + tid] = c ? atomicAdd(CNT + tid, c) : 0u; }
    __syncthreads();
    if (bucket >= 0) { const unsigned pos = lcnt[32 + bucket] + (unsigned)rank; LIST[(size_t)bucket * NT + pos] = trow; WGT[(size_t)trow * 2] = wlo; WGT[(size_t)trow * 2 + 1] = whi; }
    __syncthreads();
}
__device__ __forceinline__ void moe_tables(Frame& F, int l, int g) {
    PHASE_IDS
    LAS int* tab = (LAS int*)(F.lds + LDS_MOE_OFF);
    if (tid < 32) { const unsigned* CNT = WSP(unsigned, WS_CTL) + CW_CNT + (g * 2 + l) * 64;
        tab[32 + tid] = tid < NPAIR ? (int)__hip_atomic_load(CNT + tid, __ATOMIC_RELAXED, __HIP_MEMORY_SCOPE_AGENT) : 0; }
    __syncthreads();
    if (tid == 0) { int pre = 0;
#pragma nounroll
        for (int p = 0; p < NPAIR; ++p) { tab[p] = pre; pre += (tab[32 + p] + 255) >> 8; }
        tab[24] = pre; }
    __syncthreads();
}
#ifndef PHMASK
#define PHMASK 0xFFFF
#endif
#define PHM(k) (((PHMASK) >> (k)) & 1)
#ifndef INPROJ_ALIGN
#define INPROJ_ALIGN true
#endif
#ifndef REPMASK
#define REPMASK 0
#endif
#define REPS(k) _Pragma("nounroll") for (int rep_ = 0; rep_ < 1 + (((REPMASK) >> (k)) & 1); ++rep_)

__global__ void __launch_bounds__(512, 2) dit_fwd(Args args) {
    extern __shared__ __attribute__((aligned(16))) unsigned char lds_raw[];
    Frame F;
    F.lds = (LAS unsigned char*)lds_raw;
    F.G = gridDim.x; F.wv = __builtin_amdgcn_readfirstlane((int)threadIdx.x >> 6);
    F.a = &args; F.out = args.out; F.ws = args.ws;
    for (int u = threadIdx.x; u < (LDS_BYTES - LDSCTL_OFF) / 4; u += 512) ((LAS unsigned*)(F.lds + LDSCTL_OFF))[u] = 0u;
    __syncthreads();
    XcdBarrier bar = xcd_barrier_post(WSP(unsigned, WS_CTL) + CW_BAR, (volatile LAS unsigned*)(F.lds + LDSCTL_OFF));
#ifdef PROBE_BAR2
#define GRID_BAR() do { asm volatile("; PHASE_SEAM" ::: "memory"); xcd_barrier(bar, F.wv); xcd_barrier(bar, F.wv); } while (0)
#else
#define GRID_BAR() do { asm volatile("; PHASE_SEAM" ::: "memory"); xcd_barrier(bar, F.wv); } while (0)
#endif
#ifdef PROBE_A
#define STAMP(k) do { if (obid() == 0 && F.wv == 0 && olane() == 0) { unsigned long long* TS_ = WSP(unsigned long long, WS_CTL + 512 * 1024); const unsigned long long now = __builtin_amdgcn_s_memrealtime(); TS_[(k)] += now - TS_[32]; TS_[32] = now; } } while (0)
    if (blockIdx.x == 0 && threadIdx.x == 0) WSP(unsigned long long, WS_CTL + 512 * 1024)[32] = __builtin_amdgcn_s_memrealtime();
#else
#define STAMP(k) do { } while (0)
#endif

    if constexpr (PHM(0)) REPS(0) p0_prologue(F);
    GRID_BAR(); STAMP(0);

#pragma nounroll
    for (int g = 0; g < NG; ++g) {
#pragma nounroll
        for (int l = 0; l < DEPTH; ++l) {
            Resid R; R.in_lat = INP(0); R.in_ctx = INP(2); R.x_lat = WSP(bf16_t, WS_XRES); R.x_ctx = WSP(bf16_t, WS_XC); R.g = g; R.src_f32 = (l == 0) ? 1 : 0;
            const float* MODL = WSP(float, WS_MOD) + (size_t)l * 9 * 6144;
            const int lat_only = (l == DEPTH - 1) ? 1 : 0;

            if constexpr (PHM(1)) REPS(1) norm1_phase(F, R, l, 0);
            if constexpr (PHM(15)) if (l == 0 && g > 0) final_norm_phase(F, g - 1);
            GRID_BAR(); STAMP(1);

            if constexpr (PHM(2)) REPS(2) {
#ifdef STAGGER_US10
                {
                    const unsigned long long t0_ = __builtin_amdgcn_s_memrealtime(), d_ = (unsigned long long)((obid() * 5) & 15) * (STAGGER_US10) * 10ull;
                    while (__builtin_amdgcn_s_memrealtime() - t0_ < d_) __builtin_amdgcn_s_sleep(4);
                }
#endif
                TileOrder S; S.init(NRT, INW / 256, F.G, obid(), WSP(bf16_t, WS_HX), (size_t)256 * 1024 * 2, WSP(bf16_t, WS_WIN) + (size_t)l * INW * 1024, (size_t)256 * 1024 * 2, 0);
#ifdef PROBE_INPROJ_STOREONLY
                { EpiStoreOnly E0{WSP(bf16_t, WS_PG)}; pg8::gemm_phase<EpiStoreOnly, TileOrder, true>(F.lds, 1024, 1024, 1024, 0, S, E0, F.wv); }
#endif
#ifdef PROBE_INPROJ_NOEPI
                { EpiNone E0{WSP(float, WS_SSQ)}; pg8::gemm_phase<EpiNone, TileOrder, true>(F.lds, 1024, 1024, 1024, 0, S, E0, F.wv); }
#endif
                EpiInproj E{WSP(bf16_t, WS_PR), WSP(bf16_t, WS_PC), WSP(bf16_t, WS_PM), WSP(bf16_t, WS_PG), WSP(unsigned char, WS_K), WSP(float, WS_SSQ), WSP(f32x2, WS_RT), WSP(f32x2, WS_MT)};
                pg8::gemm_phase<EpiInproj, TileOrder, INPROJ_ALIGN>(F.lds, 1024, 1024, 1024, 0, S, E, F.wv);
            }
            GRID_BAR(); STAMP(2);

            if constexpr (PHM(3)) REPS(3) {
                TileOrder S; S.init(NRT, 3, F.G, obid(), WSP(bf16_t, WS_PM), (size_t)256 * 640 * 2, WSP(bf16_t, WS_WUQ) + (size_t)l * 768 * 384, (size_t)256 * 384 * 2, 0);
                EpiUq E{WSP(unsigned char, WS_Q), WSP(float, WS_SSQ), WSP(f32x2, WS_MT)};
                pg8::gemm_phase<EpiUq, TileOrder, true>(F.lds, 640, 384, 384, 0, S, E, F.wv);
            }
#ifndef PROBE_COARSE
            STAMP(3);
#endif
            if constexpr (PHM(4)) REPS(4) {
                TileOrder S; S.init(NRT, 4, F.G, (obid() + F.G - (NRT * 3) % F.G) % F.G, WSP(bf16_t, WS_PM) + 384, (size_t)256 * 640 * 2, WSP(bf16_t, WS_WUKV) + (size_t)l * 1024 * 256, (size_t)256 * 256 * 2, 0);
                EpiUkv E{WSP(unsigned char, WS_K), WSP(bf16_t, WS_V), WSP(float, WS_SSQ)};
                pg8::gemm_phase<EpiUkv, TileOrder, true>(F.lds, 640, 256, 256, 0, S, E, F.wv);
            }
#ifndef PROBE_COARSE
            STAMP(4);
#endif
            if constexpr (PHM(5)) REPS(5) for (int u = (obid() + F.G - (NRT * 7) % F.G) % F.G; u < GB * NCHUNK * 4; u += F.G) {
                const int h = u & 3;
                retu_unit(u, WSP(bf16_t, WS_PR), WSP(float, WS_HX), lg2_gamma(INP(9) + l * 8 + h), lg2_gamma(INP(9) + l * 8 + 4 + h), (LAS char*)F.lds, F.wv);
            }
#ifndef PROBE_COARSE
            STAMP(5);
#endif
            if constexpr (PHM(6)) REPS(6) conv_phase(F, l);
            GRID_BAR(); STAMP(6);

            if constexpr (PHM(7)) REPS(7) scan_phase(F, l);
#ifndef PROBE_COARSE
            STAMP(7);
#endif
#ifdef PROBE_CLK
            unsigned long long c0_ = 0, r0_ = 0; if (g == 0 && l == 0) { c0_ = __builtin_readcyclecounter(); r0_ = __builtin_amdgcn_s_memrealtime(); }
#endif
            if constexpr (PHM(8)) REPS(8) {
                const unsigned char* Q = WSP(unsigned char, WS_Q); const unsigned char* K = WSP(unsigned char, WS_K); const bf16_t* V = WSP(bf16_t, WS_V); bf16_t* ACT = WSP(bf16_t, WS_ACT);
                const int vcu = (obid() % 8) * (F.G / 8) + obid() / 8, xcd = vcu / (F.G / 8), slot = vcu % (F.G / 8);
                const int nlat = GB * 8 * 32, nunit = nlat + (lat_only ? 0 : GB * 8);
                for (int i = 0; ; ++i) {
                    int hh, qb;
                    if (F.G == 256) { if (i < 4) { hh = xcd + 8 * i; qb = 1 + slot; } else if (i == 4 && !lat_only && slot < 4) { hh = xcd + 8 * slot; qb = 0; } else break; }
                    else { const int L = i * F.G + obid(); if (L >= nunit) break; if (L < nlat) { hh = L >> 5; qb = 1 + (L & 31); } else { hh = L - nlat; qb = 0; } }
                    const int bl = hh >> 3, h = hh & 7;
                    const size_t hb = (size_t)(bl * 8 + h) * SB;
                    att2::attn_unit_pp(Q + (hb + (size_t)qb * 256) * 128, K + hb * 128, V + hb * 64, ACT + ((size_t)bl * SB + (size_t)qb * 256) * 1536 + 1024 + h * 64, 1536, qb == 0 ? CTXL : SB, (LAS char*)F.lds, F.wv);
                }
            }
#ifdef PROBE_CLK
            if (g == 0 && l == 0 && obid() == 0 && F.wv == 0 && olane() == 0) { const unsigned long long c1_ = __builtin_readcyclecounter(), r1_ = __builtin_amdgcn_s_memrealtime();
                WSP(unsigned long long, WS_CTL + 600 * 1024)[0] = (c1_ - c0_) * 100ull / (r1_ - r0_); }
#endif
            GRID_BAR(); STAMP(8);

            if constexpr (PHM(9)) REPS(9) for (int u = obid(); u < GB * NCHUNK * 4; u += F.G) {
                const int h = u & 3;
                retout_unit(u, WSP(bf16_t, WS_PR), WSP(bf16_t, WS_PM), INP(10) + l * 512, WSP(bf16_t, WS_ACT), lg2_gamma(INP(9) + l * 8 + h), lg2_gamma(INP(9) + l * 8 + 4 + h), (LAS char*)F.lds, F.wv);
            }
            GRID_BAR(); STAMP(9);

            if constexpr (PHM(10)) REPS(10) {
#ifdef MERGE1_STAGGER
                {
                    const unsigned long long t0_ = __builtin_amdgcn_s_memrealtime(), d_ = (unsigned long long)((obid() >> 3) & 3) * (MERGE1_STAGGER) * 10ull;
                    while (__builtin_amdgcn_s_memrealtime() - t0_ < d_) __builtin_amdgcn_s_sleep(4);
                }
#endif
                TileOrder S; S.init(lat_only ? GB * 32 : NRT, 4, F.G, obid(), WSP(bf16_t, WS_ACT), (size_t)256 * 1536 * 2, WSP(bf16_t, WS_WCAT) + (size_t)l * 1024 * 1536, (size_t)256 * 1536 * 2, lat_only);
#ifdef PROBE_MERGE1_NOHOOK
                { EpiMerge1NoHook E0{{WSP(bf16_t, WS_PG), WSP(bf16_t, WS_HX)}}; pg8::gemm_phase<EpiMerge1NoHook, TileOrder, true>(F.lds, 1536, 1536, 1536, 0, S, E0, F.wv); }
#endif
#ifdef PROBE_MERGE1_HOOKONLY
                { EpiMerge1HookOnly E0{{WSP(bf16_t, WS_PG), WSP(bf16_t, WS_HX)}, WSP(float, WS_SSQ)}; pg8::gemm_phase<EpiMerge1HookOnly, TileOrder, true>(F.lds, 1536, 1536, 1536, 0, S, E0, F.wv); }
#endif
#ifdef PROBE_MERGE1_NOEPI
                { EpiNone E0{WSP(float, WS_SSQ)}; pg8::gemm_phase<EpiNone, TileOrder, true>(F.lds, 1536, 1536, 1536, 0, S, E0, F.wv); }
#endif
                EpiMerge1 E{WSP(bf16_t, WS_PG), WSP(bf16_t, WS_HX)};
                pg8::gemm_phase<EpiMerge1, TileOrder, true>(F.lds, 1536, 1536, 1536, 0, S, E, F.wv);
            }
            GRID_BAR(); STAMP(10);

            if constexpr (PHM(11)) _Pragma("nounroll") for (int rep_ = 0; rep_ < 1 + ((((REPMASK) >> 11) & 1) && l == 0 ? 1 : 0); ++rep_) {
                TileOrder S; S.init(lat_only ? GB * 32 : NRT, 4, F.G, obid(), WSP(bf16_t, WS_HX), (size_t)256 * 1024 * 2, WSP(bf16_t, WS_WOUT) + (size_t)l * 1024 * 1024, (size_t)256 * 1024 * 2, lat_only);
                EpiMerge2 E{R, MODL};
                pg8::gemm_phase<EpiMerge2, TileOrder, true>(F.lds, 1024, 1024, 1024, 0, S, E, F.wv);
            }
            GRID_BAR(); STAMP(11);

            if constexpr (((REPMASK) >> 12) & 1) norm2_router_phase(F, R, l, g, lat_only, 32);
            if constexpr (PHM(12)) norm2_router_phase(F, R, l, g, lat_only, 0);
            GRID_BAR(); STAMP(12);

            moe_tables(F, l, g);
            if constexpr (PHM(13)) REPS(13) {
                MoeOrder S{(const LAS int*)(F.lds + LDS_MOE_OFF), WSP(int, WS_LIST), 8, F.G, obid(), 1, (const char*)WSP(bf16_t, WS_HX), (const char*)(WSP(bf16_t, WS_WUP) + (size_t)l * 16 * 1024 * 1024)};
                EpiMoeUp E{WSP(int, WS_LIST), WSP(float, WS_WGT), WSP(bf16_t, WS_PG)};
                pg8::gemm_phase<EpiMoeUp, MoeOrder, true, true, false>(F.lds, 1024, 1024, 1024, 0, S, E, F.wv);
            }
            GRID_BAR(); STAMP(13);

            if constexpr (PHM(14)) {
                MoeOrder S{(const LAS int*)(F.lds + LDS_MOE_OFF), WSP(int, WS_LIST), 4, F.G, obid(), 0, (const char*)WSP(bf16_t, WS_PG), (const char*)(WSP(bf16_t, WS_W2T) + (size_t)l * 16 * 1024 * 512)};
                if constexpr (((REPMASK) >> 14) & 1) { EpiMoeDown E0{WSP(int, WS_LIST), R, MODL, WSP(bf16_t, WS_Q)}; pg8::gemm_phase<EpiMoeDown, MoeOrder, true, false, true>(F.lds, 1024, 512, 1024, 8, S, E0, F.wv); }
                EpiMoeDown E{WSP(int, WS_LIST), R, MODL, nullptr};
                pg8::gemm_phase<EpiMoeDown, MoeOrder, true, false, true>(F.lds, 1024, 512, 1024, 8, S, E, F.wv);
            }
            GRID_BAR(); STAMP(14);
        }
    }
    if constexpr (PHM(15)) final_norm_phase(F, NG - 1);
#ifdef SELFCHECK_ATTN
            {
                const unsigned char* Q = WSP(unsigned char, WS_Q); const unsigned char* K = WSP(unsigned char, WS_K); const bf16_t* V = WSP(bf16_t, WS_V); const bf16_t* ACT = WSP(bf16_t, WS_ACT);
                const int lane_ = olane(); const int gwv = obid() * 8 + F.wv;
                if (gwv < 96) {
                    const int bl = gwv & 3, h = (gwv >> 2) & 7, qi = gwv >> 5;
                    const int srow = qi == 0 ? 256 : (qi == 1 ? 256 + 4099 : SB - 1);
                    const int nkeys = srow < CTXL ? CTXL : SB;
                    const size_t hb = (size_t)(bl * 8 + h) * SB;
                    #define F8(p) (__builtin_amdgcn_cvt_f32_fp8((int)(*(p)), 0))
                    const float q0 = F8(Q + (hb + srow) * 128 + lane_) * (1.f / Q8S), q1 = lane_ < 32 ? F8(Q + (hb + srow) * 128 + 64 + lane_) * (1.f / Q8S) : 0.f;
                    float mrun = -1e30f, lrun = 0.f, orun = 0.f;
#pragma nounroll
                    for (int j = 0; j < nkeys; ++j) {
                        float part = q0 * F8(K + (hb + j) * 128 + lane_) * (1.f / K8S); if (lane_ < 32) part += q1 * F8(K + (hb + j) * 128 + 64 + lane_) * (1.f / K8S);
                        const float s = wave_sum(part);
                        const float mn = fmaxf(mrun, s), sc = exp2f(mrun - mn), p = exp2f(s - mn);
                        lrun = lrun * sc + p; orun = orun * sc + p * bf1(V[(hb + j) * 64 + lane_]); mrun = mn; }
                    const float o_ = orun / lrun; const float got = bf1(ACT[((size_t)bl * SB + srow) * 1536 + 1024 + h * 64 + lane_]);
                    float err = fabsf(o_ - got), ref = fabsf(o_);
                    err = fmaxf(err, swz_xor<1>(err)); err = fmaxf(err, swz_xor<2>(err)); err = fmaxf(err, swz_xor<4>(err)); err = fmaxf(err, swz_xor<8>(err)); err = fmaxf(err, swz_xor<16>(err));
                    ref = fmaxf(ref, swz_xor<1>(ref)); ref = fmaxf(ref, swz_xor<2>(ref)); ref = fmaxf(ref, swz_xor<4>(ref)); ref = fmaxf(ref, swz_xor<8>(ref)); ref = fmaxf(ref, swz_xor<16>(ref));
                    { auto r1_ = __builtin_amdgcn_permlane32_swap(__float_as_uint(err), __float_as_uint(err), false, false); err = fmaxf(__uint_as_float(r1_[0]), __uint_as_float(r1_[1]));
                      auto r2_ = __builtin_amdgcn_permlane32_swap(__float_as_uint(ref), __float_as_uint(ref), false, false); ref = fmaxf(__uint_as_float(r2_[0]), __uint_as_float(r2_[1])); }
                    if (lane_ == 0 && !(err <= SELFCHECK_TOL * ref + 1e-6f)) atomicAdd(WSP(unsigned, WS_CTL) + 3000, 1u);
                }
            }
    GRID_BAR();
    if (__hip_atomic_load(WSP(unsigned, WS_CTL) + 3000, __ATOMIC_RELAXED, __HIP_MEMORY_SCOPE_AGENT) != 0u && obid() == 0) { for (int i = otid(F.wv); i < 4096; i += 512) F.out[i] = __builtin_nanf(""); }
#endif
#ifdef PROBE_CLK
    if (obid() == 0 && F.wv == 0 && olane() == 0) { const unsigned long long mhz = WSP(unsigned long long, WS_CTL + 600 * 1024)[0]; const unsigned long long t0 = __builtin_amdgcn_s_memrealtime();
        while (__builtin_amdgcn_s_memrealtime() - t0 < mhz * 100ull) __builtin_amdgcn_s_sleep(8); }
#endif
#ifdef PROBE_A
    STAMP(15);
    GRID_BAR();
    {
        unsigned long long* TS = WSP(unsigned long long, WS_CTL + 512 * 1024);
        unsigned long long tot = 0; for (int k = 0; k < 16; ++k) tot += __hip_atomic_load(TS + k, __ATOMIC_RELAXED, __HIP_MEMORY_SCOPE_AGENT);
        const float fa = (float)__hip_atomic_load(TS + PROBE_A, __ATOMIC_RELAXED, __HIP_MEMORY_SCOPE_AGENT) / (float)tot, fb = (float)__hip_atomic_load(TS + PROBE_B, __ATOMIC_RELAXED, __HIP_MEMORY_SCOPE_AGENT) / (float)tot;
        const float A = sqrtf(90.f * fa), X = 100.f + 800.f * fb;
        for (size_t i = (size_t)blockIdx.x * 512 + threadIdx.x; i < (size_t)NB * SEQ * DM; i += (size_t)gridDim.x * 512) F.out[i] = (i == 0) ? X : ((i & 1) ? A : -A);
    }
#endif
}

extern "C" void kernel_launch(void* const* d_in, const int* in_sizes, int n_in, void* d_out, int out_size, void* d_ws, size_t ws_size, hipStream_t stream) {
    static int grid = 0;
    if (grid == 0) {
        if (n_in != 26 || ws_size < WS_END) { fprintf(stderr, "kernel_launch: expected 26 inputs and >= %zu bytes of workspace; got %d, %zu\n", (size_t)WS_END, n_in, ws_size); grid = -1; return; }
        int dev = 0, cus = 0, per_cu = 0;
        if (hipGetDevice(&dev) != hipSuccess || hipDeviceGetAttribute(&cus, hipDeviceAttributeMultiprocessorCount, dev) != hipSuccess) { grid = -1; return; }
        if (hipFuncSetAttribute((const void*)dit_fwd, hipFuncAttributeMaxDynamicSharedMemorySize, LDS_BYTES) != hipSuccess) { fprintf(stderr, "kernel_launch: hipFuncSetAttribute failed\n"); grid = -1; return; }
        if (hipOccupancyMaxActiveBlocksPerMultiprocessor(&per_cu, (const void*)dit_fwd, 512, LDS_BYTES) != hipSuccess || per_cu < 1) fprintf(stderr, "kernel_launch: occupancy query reports %d\n", per_cu);
        (void)hipGetLastError();
        grid = cus;
    }
    if (grid < 0) return;
    (void)hipMemsetAsync((char*)d_ws + WS_CTL, 0, CTL_ZERO_BYTES, stream);
    Args a{};
    for (int i = 0; i < 26; ++i) a.in[i] = (const float*)d_in[i];
    a.out = (float*)d_out; a.ws = (unsigned char*)d_ws; a.ph_lo = 0; a.ph_hi = 1000;
    hipLaunchKernelGGL(dit_fwd, dim3(grid), dim3(512), LDS_BYTES, stream, a);
}
```

```cpp
#include <hip/hip_runtime.h>
#include <cstdio>
#include <cstdint>

#define GAS __attribute__((address_space(1)))
#define LAS __attribute__((address_space(3)))
typedef unsigned short bf16_t;
typedef short bf16x8 __attribute__((ext_vector_type(8)));
typedef short s16x4 __attribute__((ext_vector_type(4)));
typedef float f32x2 __attribute__((ext_vector_type(2)));
typedef float f32x4 __attribute__((ext_vector_type(4)));
typedef float f32x16 __attribute__((ext_vector_type(16)));
typedef unsigned u32x2 __attribute__((ext_vector_type(2)));
typedef unsigned u32x4 __attribute__((ext_vector_type(4)));
typedef __bf16 bf16x2_t __attribute__((ext_vector_type(2)));

constexpr int DM = 1024, NB = 8, SEQ = 8192, CTXL = 256, DEPTH = 2;
constexpr int SB = SEQ + CTXL;
constexpr int GB = 4, NG = NB / GB;
constexpr int NT = GB * SB;
constexpr int NRT = NT / 256;
constexpr int INW = 6912;
constexpr int INCOLS = 6816;
constexpr int NCHUNK = SB / 128;
constexpr int NPAIR = 24;
constexpr float RMS_EPS = 1e-6f;
constexpr float LOG2E = 1.4426950408889634f;
constexpr float QSCALE = 0.10206207261596575f * LOG2E;
constexpr float Q8S = 32.f, K8S = 4.f, V8S = 4.f, P8S = 16.f;

constexpr size_t MiB = 1u << 20;
constexpr size_t WS_CTL = 0, CTL_ZERO_BYTES = 1 * MiB;
constexpr size_t WS_MOD = 1 * MiB;
constexpr size_t WS_RT = 2 * MiB;
constexpr size_t WS_MT = 4 * MiB;
constexpr size_t WS_SSQ = 5 * MiB;
constexpr size_t WS_WGT = 8 * MiB;
constexpr size_t WS_LIST = 9 * MiB;
constexpr size_t WS_XC = 13 * MiB;
constexpr size_t WS_WIN = 21 * MiB;
constexpr size_t WS_WCAT = 48 * MiB;
constexpr size_t WS_WOUT = 54 * MiB;
constexpr size_t WS_WUQ = 58 * MiB;
constexpr size_t WS_WUKV = 60 * MiB;
constexpr size_t WS_WUP = 61 * MiB;
constexpr size_t WS_W2T = 125 * MiB;
constexpr size_t WS_HX = 157 * MiB;
constexpr size_t WS_PR = 223 * MiB;
constexpr size_t WS_PC = 322 * MiB;
constexpr size_t WS_PM = 388 * MiB;
constexpr size_t WS_PG = 430 * MiB;
constexpr size_t WS_Q = 628 * MiB;
constexpr size_t WS_K = 678 * MiB;
constexpr size_t WS_V = 728 * MiB;
constexpr size_t WS_ACT = 761 * MiB;
constexpr size_t WS_XRES = 860 * MiB;
constexpr size_t WS_END = 988 * MiB;
static_assert(WS_WIN + (size_t)2 * INW * 1024 * 2 <= WS_WCAT && WS_HX + (size_t)NT * 1024 * 2 <= WS_PR && WS_PR + (size_t)NT * 1536 * 2 <= WS_PC &&
              WS_PC + (size_t)NT * 1024 * 2 <= WS_PM && WS_PM + (size_t)NT * 640 * 2 <= WS_PG && WS_PG + (size_t)NT * 3072 * 2 <= WS_Q &&
              WS_Q + (size_t)GB * 8 * SB * 96 * 2 <= WS_K && WS_K + (size_t)GB * 8 * SB * 96 * 2 <= WS_V && WS_V + (size_t)GB * 8 * SB * 64 * 2 <= WS_ACT &&
              WS_ACT + (size_t)NT * 1536 * 2 <= WS_XRES && WS_XRES + (size_t)NB * SEQ * DM * 2 <= WS_END, "d_ws map");
constexpr int CW_BAR = 4096;
constexpr int CW_CNT = 16384;

constexpr int RING_BYTES = 131072;
constexpr int LDSCTL_OFF = RING_BYTES;
constexpr int LDS_MOE_OFF = LDSCTL_OFF + 64;
constexpr int LDS_VTR_OFF = LDSCTL_OFF + 2048;
constexpr int LDS_BYTES = 147456;

__device__ __forceinline__ int olane() { int l; asm volatile("v_mbcnt_lo_u32_b32 %0, -1, 0\n\tv_mbcnt_hi_u32_b32 %0, -1, %0" : "=v"(l)); return l; }
__device__ __forceinline__ int otid(int wv) { return wv * 64 + olane(); }
__device__ __forceinline__ int obid() { int b = blockIdx.x; asm volatile("" : "+s"(b)); return b; }
__device__ __forceinline__ unsigned cvtpk(float lo, float hi) { f32x2 v = {lo, hi}; bf16x2_t b = __builtin_convertvector(v, bf16x2_t); return __builtin_bit_cast(unsigned, b); }
__device__ __forceinline__ float bf_lo(unsigned w) { return __uint_as_float(w << 16); }
__device__ __forceinline__ float bf_hi(unsigned w) { return __uint_as_float(w & 0xffff0000u); }
__device__ __forceinline__ float bf1(bf16_t b) { return __uint_as_float(((unsigned)b) << 16); }
__device__ __forceinline__ bf16_t f2bf(float f) { return (bf16_t)(cvtpk(f, 0.f) & 0xffffu); }
template <int O> __device__ __forceinline__ float swz_xor(float v) { return __int_as_float(__builtin_amdgcn_ds_swizzle(__float_as_int(v), (O << 10) | 0x1f)); }
__device__ __forceinline__ float half_sum(float v) { auto rr = __builtin_amdgcn_permlane32_swap(__float_as_uint(v), __float_as_uint(v), false, false); return __uint_as_float(rr[0]) + __uint_as_float(rr[1]); }
__device__ __forceinline__ float sum32(float v) { v += swz_xor<1>(v); v += swz_xor<2>(v); v += swz_xor<4>(v); v += swz_xor<8>(v); v += swz_xor<16>(v); return v; }
__device__ __forceinline__ float wave_sum(float v) { return half_sum(sum32(v)); }
__device__ __forceinline__ float sigmoidf_(float x) { return 1.f / (1.f + __expf(-x)); }
__device__ __forceinline__ float siluf_(float x) { return x / (1.f + __expf(-x)); }
__device__ __forceinline__ void unpack8(const u32x4 w, float (&f)[8]) {
    f[0] = bf_lo(w.x); f[1] = bf_hi(w.x); f[2] = bf_lo(w.y); f[3] = bf_hi(w.y); f[4] = bf_lo(w.z); f[5] = bf_hi(w.z); f[6] = bf_lo(w.w); f[7] = bf_hi(w.w);
}
__device__ __forceinline__ u32x2 pack8_fp8(const float (&f)[8]) { int a = __builtin_amdgcn_cvt_pk_fp8_f32(f[0], f[1], 0, false); a = __builtin_amdgcn_cvt_pk_fp8_f32(f[2], f[3], a, true);
    int b = __builtin_amdgcn_cvt_pk_fp8_f32(f[4], f[5], 0, false); b = __builtin_amdgcn_cvt_pk_fp8_f32(f[6], f[7], b, true); u32x2 w; w.x = (unsigned)a; w.y = (unsigned)b; return w; }
__device__ __forceinline__ u32x4 pack8(const float (&f)[8]) { u32x4 w; w.x = cvtpk(f[0], f[1]); w.y = cvtpk(f[2], f[3]); w.z = cvtpk(f[4], f[5]); w.w = cvtpk(f[6], f[7]); return w; }

__host__ __device__ __forceinline__ int vt_pos(int k) { const int w = k & 31, hi = (w >> 2) & 1, r = (w & 3) + 4 * (w >> 3); return 32 * hi + 16 * (k >> 5) + r; }
#define XB_TMO      128
#define XB_XCNT(j)  (256  + 64 * (j))
#define XB_XSUB(j)  (1280 + 64 * (j))
#define XB_XGEN(j)  (2304 + 64 * (j))
#define XB_TOP      3328
#define XB_TOPGEN   3392
#define XCD_BAR_WORDS 3456
#define XB_SPIN_CAP (1u << 20)
__device__ __forceinline__ unsigned xb_ld(unsigned* p)              { return __hip_atomic_load(p, __ATOMIC_RELAXED, __HIP_MEMORY_SCOPE_AGENT); }
__device__ __forceinline__ unsigned xb_add(unsigned* p, unsigned v) { return __hip_atomic_fetch_add(p, v, __ATOMIC_RELAXED, __HIP_MEMORY_SCOPE_AGENT); }
__device__ __forceinline__ unsigned xb_xcc_id() { return (unsigned)__builtin_amdgcn_s_getreg((3 << 11) | 20) & 0xFu; }
#define XB_SPIN(cond, bar) do { unsigned _sp = 0; while (cond) { __builtin_amdgcn_s_sleep(1); \
    if ((++_sp & 255u) == 0u) { if (xb_ld(&(bar)[XB_TMO])) break; if (_sp > XB_SPIN_CAP) { atomicAdd(&(bar)[XB_TMO], 1u); break; } } } } while (0)
struct XcdBarrier { unsigned* bar; unsigned x; volatile LAS unsigned* st; };
__device__ __forceinline__ XcdBarrier xcd_barrier_post(unsigned* bar, volatile LAS unsigned* st) {
    XcdBarrier b; b.bar = bar; b.x = xb_xcc_id(); b.st = st;
    if (threadIdx.x == 0) (void)xb_add(&bar[XB_XCNT(b.x)], 1u);
    return b;
}
__device__ __forceinline__ void xcd_barrier_complete(unsigned* bar, unsigned x, unsigned& nloc, unsigned& nx) {
    const unsigned G = gridDim.x * gridDim.y * gridDim.z;
    unsigned sum, cnt, mine, sp = 0u;
    for (;;) {
        sum = 0u; cnt = 0u; mine = 0u;
#pragma unroll
        for (unsigned j = 0; j < 16; ++j) { const unsigned c = xb_ld(&bar[XB_XCNT(j)]); sum += c; cnt += (c > 0u) ? 1u : 0u; mine = (j == x) ? c : mine; }
        if (sum == G) break;
        __builtin_amdgcn_s_sleep(1);
        if ((++sp & 255u) == 0u) { if (xb_ld(&bar[XB_TMO])) break; if (sp > XB_SPIN_CAP) { atomicAdd(&bar[XB_TMO], 1u); break; } }
    }
    nloc = mine > 0u ? mine : 1u; nx = cnt > 0u ? cnt : 1u;
}
__device__ __forceinline__ void xcd_barrier(const XcdBarrier& b, const int wv) {
    const bool leader = (wv == 0) && (olane() == 0);
    asm volatile("s_waitcnt vmcnt(0)" ::: "memory");
    __syncthreads();
    if (leader) {
        unsigned* bar = b.bar; unsigned bx = b.x;
        asm volatile("" : "+s"(bar), "+s"(bx));
        __builtin_amdgcn_s_waitcnt(0);
        unsigned nloc = b.st[0], nx = b.st[1];
        if (nloc == 0u) { xcd_barrier_complete(bar, bx, nloc, nx); b.st[0] = nloc; b.st[1] = nx; }
        const unsigned old = xb_add(&bar[XB_XSUB(bx)], 1u);
        const unsigned gen = old / nloc;
        if (old + 1u == (gen + 1u) * nloc) {
            __builtin_amdgcn_fence(__ATOMIC_RELEASE, "agent");
            asm volatile("s_waitcnt vmcnt(0)" ::: "memory");
            const unsigned og = xb_add(&bar[XB_TOP], 1u);
            const unsigned tg = og / nx;
            if (og + 1u == (tg + 1u) * nx) xb_add(&bar[XB_TOPGEN], 1u);
            else XB_SPIN(xb_ld(&bar[XB_TOPGEN]) == tg, bar);
            __builtin_amdgcn_fence(__ATOMIC_ACQUIRE, "agent");
            xb_add(&bar[XB_XGEN(bx)], 1u);
            asm volatile("s_waitcnt vmcnt(0)" ::: "memory");
        } else {
            XB_SPIN(xb_ld(&bar[XB_XGEN(bx)]) == gen, bar);
            __builtin_amdgcn_fence(__ATOMIC_ACQUIRE, "agent");
            asm volatile("s_waitcnt vmcnt(0)" ::: "memory");
        }
    }
    __syncthreads();
}

namespace pg8 {
constexpr int BM = 256, BK = 64, HALF = 128, HTB = HALF * BK * 2, NXCD = 8, WGM = 8;
__host__ __device__ __forceinline__ int lds_byte(int r, int c) { const int st = (r >> 4) * 2 + (c >> 5), rr = r & 15, cc = c & 31, ob = rr * 64 + cc * 2; return st * 1024 + (ob ^ (((ob >> 9) & 1) << 5)); }
__host__ __device__ __forceinline__ void stage_rc(int b, int& R, int& C) { const int st = b / 1024, sb = b % 1024, swz = sb ^ (((sb >> 9) & 1) << 5); R = (st >> 1) * 16 + swz / 64; C = (st & 1) * 32 + (swz % 64) / 2; }
__host__ __device__ __forceinline__ int perm32(int rho) { const int n = rho >> 4, i = rho & 15; return 8 * (i >> 2) + 4 * n + (i & 3); }

struct Unit { int pm, pn, aux0, aux1, aux2; const char* a; const char* b; const char* b2; };
typedef f32x4 Acc[2][2][4][2];

template <class Epi, class Sched, bool ALIGN_EPI, bool GATHER = false, bool SPLITB = false>
__device__ __forceinline__ void gemm_phase(LAS unsigned char* lds, const int lda, const int ldb, const int K, const int ksplit, const Sched& S, const Epi& E, const int wv) {
    const int tid = otid(wv), wid = __builtin_amdgcn_readfirstlane(tid >> 6), lane = tid & 63, wr = wid >> 2, wc = wid & 3, fr = lane & 15, fq = lane >> 4;
    const int nt = K / BK;
    unsigned voffA[2][2], voffN[2][2], voffB[2];
#pragma unroll
    for (int i = 0; i < 2; ++i) { int R, C; stage_rc(tid * 16 + i * 8192, R, C); const int Rb = (R & ~31) + perm32(R & 31);
        voffB[i] = (unsigned)(Rb * ldb + C) * 2u;
        voffA[0][i] = (unsigned)(R * lda + C) * 2u; voffA[1][i] = (unsigned)((R + HALF) * lda + C) * 2u; voffN[0][i] = voffA[0][i]; voffN[1][i] = voffA[1][i]; }
    const size_t kstep = (size_t)(BK * 2);
    const size_t hstepB = (size_t)HALF * ldb * 2, hstepA = (size_t)HALF * lda * 2;
    const unsigned ldsw = (unsigned)wid * 1024u;
    const int aoff = lds_byte(wr * 64 + fr, fq * 8), boff = lds_byte(wc * 32 + fr, fq * 8);
#define PG8_SA(b, h) (((b) * 2 + (h)) * HTB)
#define PG8_SB(b, h) ((4 + (b) * 2 + (h)) * HTB)
#define PG8_STAGE_B(bufoff, gbase, h) do { _Pragma("unroll") for (int _i = 0; _i < 2; ++_i) \
        __builtin_amdgcn_global_load_lds((const unsigned*)((const char*)(gbase) + (size_t)(h) * hstepB + voffB[_i]), (LAS unsigned*)(lds + (bufoff) + ldsw + _i * 8192), 16, 0, 0); } while (0)
#define PG8_STAGE_A(bufoff, gbase, h, NX) do { _Pragma("unroll") for (int _i = 0; _i < 2; ++_i) { if constexpr (GATHER) { const unsigned _o = (NX) ? voffN[h][_i] : voffA[h][_i]; \
        __builtin_amdgcn_global_load_lds((const unsigned*)((const char*)(gbase) + _o), (LAS unsigned*)(lds + (bufoff) + ldsw + _i * 8192), 16, 0, 0); } else { \
        __builtin_amdgcn_global_load_lds((const unsigned*)((const char*)(gbase) + (size_t)(h) * hstepA + voffA[0][_i]), (LAS unsigned*)(lds + (bufoff) + ldsw + _i * 8192), 16, 0, 0); } } } while (0)
#define PG8_LDA(dst, b, h) do { _Pragma("unroll") for (int m = 0; m < 4; ++m) _Pragma("unroll") for (int k = 0; k < 2; ++k) dst[m][k] = *(const LAS bf16x8*)(lds + PG8_SA(b, h) + aoff + m * 2048 + k * 1024); } while (0)
#define PG8_LDB(dst, b, h) do { _Pragma("unroll") for (int n = 0; n < 2; ++n) _Pragma("unroll") for (int k = 0; k < 2; ++k) dst[n][k] = *(const LAS bf16x8*)(lds + PG8_SB(b, h) + boff + n * 2048 + k * 1024); } while (0)
#define PG8_MMA(ai, bj, At, Bt) do { __builtin_amdgcn_s_setprio(1); _Pragma("unroll") for (int m = 0; m < 4; ++m) _Pragma("unroll") for (int n = 0; n < 2; ++n) _Pragma("unroll") for (int k = 0; k < 2; ++k) \
        acc[ai][bj][m][n] = __builtin_amdgcn_mfma_f32_16x16x32_bf16(Bt[n][k], At[m][k], acc[ai][bj][m][n], 0, 0, 0); __builtin_amdgcn_s_setprio(0); } while (0)
#define PG8_WAIT_V(n) asm volatile("s_waitcnt vmcnt(" #n ")" ::: "memory")
#define PG8_WAIT_L(n) asm volatile("s_waitcnt lgkmcnt(" #n ")" ::: "memory")
#define PG8_BAR __builtin_amdgcn_s_barrier()
#define PG8_SCHED __builtin_amdgcn_sched_barrier(0)
#define PG8_GOFF(dst, u) do { if constexpr (GATHER) { const int _t = otid(wv); _Pragma("unroll") for (int _i = 0; _i < 2; ++_i) { int _R, _C; stage_rc(_t * 16 + _i * 8192, _R, _C); \
        _Pragma("unroll") for (int _h = 0; _h < 2; ++_h) dst[_h][_i] = S.gather_off(u, _h * HALF + _R) + (unsigned)_C * 2u; } } } while (0)
#define PG8_BPTR(u, t) (SPLITB ? (((t) < ksplit) ? (u).b + (size_t)(t) * kstep : (u).b2 + (size_t)((t) - ksplit) * kstep) : (u).b + (size_t)(t) * kstep)
    Unit cur, nxt; int ui = 0;
    if (!S.next(0, cur)) return;
    Acc acc;
#pragma unroll
    for (int a = 0; a < 2; ++a)
#pragma unroll
        for (int b = 0; b < 2; ++b)
#pragma unroll
            for (int m = 0; m < 4; ++m)
#pragma unroll
                for (int n = 0; n < 2; ++n) acc[a][b][m][n] = (f32x4){0.f, 0.f, 0.f, 0.f};
    bf16x8 At[4][2], B0[2][2], B1[2][2];
    const char* cA = cur.a; const char* cB = cur.b;
    S.a_ready(cur);
    PG8_GOFF(voffA, cur);
    if constexpr (GATHER) {
#pragma unroll
        for (int h = 0; h < 2; ++h)
#pragma unroll
            for (int i = 0; i < 2; ++i) voffN[h][i] = voffA[h][i];
    }
    PG8_STAGE_B(PG8_SB(0, 0), cB, 0); PG8_STAGE_B(PG8_SB(0, 1), cB, 1); PG8_STAGE_A(PG8_SA(0, 0), cA, 0, false); PG8_STAGE_A(PG8_SA(0, 1), cA, 1, false);
    if (wr == 1) PG8_BAR;
    PG8_WAIT_V(2); PG8_BAR;
    PG8_STAGE_B(PG8_SB(1, 0), cB + kstep, 0); PG8_STAGE_A(PG8_SA(1, 0), cA + kstep, 0, false); PG8_STAGE_B(PG8_SB(1, 1), cB + kstep, 1);
    PG8_WAIT_V(6); PG8_BAR;
    for (;;) {
        const bool has_next = S.next(ui + 1, nxt);
        const char* nA = has_next ? nxt.a : cA; const char* nB = has_next ? nxt.b : cB;
#pragma nounroll
        for (int t = 0; t < nt; t += 2) {
            const bool last = (t == nt - 2);
            if (last && has_next) { S.a_ready(nxt); PG8_GOFF(voffN, nxt); }
            if constexpr (Epi::HOOK) { if (t == Epi::HOOK_T0 || t == Epi::HOOK_T1) E.hook(acc, cur, t, wr, wc, fr, fq); }
            const char* a1 = cA + (size_t)(t + 1) * kstep;
            const char* a2 = last ? nA : cA + (size_t)(t + 2) * kstep; const char* b2 = last ? nB : PG8_BPTR(cur, t + 2);
            const char* a3 = a2 + kstep; const char* b3 = b2 + kstep;
            PG8_LDB(B0, 0, 0); PG8_LDB(B1, 0, 1); PG8_SCHED; PG8_LDA(At, 0, 0); PG8_STAGE_A(PG8_SA(1, 1), a1, 1, false);
            PG8_WAIT_V(8); PG8_WAIT_L(0); PG8_BAR; PG8_MMA(0, 0, At, B0); PG8_MMA(0, 1, At, B1); PG8_BAR; PG8_SCHED;
            PG8_LDA(At, 0, 1); PG8_STAGE_B(PG8_SB(0, 0), b2, 0); PG8_STAGE_B(PG8_SB(0, 1), b2, 1); PG8_STAGE_A(PG8_SA(0, 0), a2, 0, last);
            PG8_WAIT_V(8); PG8_WAIT_L(0); PG8_BAR; PG8_MMA(1, 0, At, B0); PG8_MMA(1, 1, At, B1); PG8_BAR; PG8_SCHED;
            PG8_LDB(B0, 1, 0); PG8_LDB(B1, 1, 1); PG8_SCHED; PG8_LDA(At, 1, 0); PG8_STAGE_A(PG8_SA(0, 1), a2, 1, last);
            PG8_WAIT_V(8); PG8_WAIT_L(0); PG8_BAR; PG8_MMA(0, 0, At, B0); PG8_MMA(0, 1, At, B1); PG8_BAR; PG8_SCHED;
            PG8_LDA(At, 1, 1); PG8_STAGE_B(PG8_SB(1, 0), b3, 0); PG8_STAGE_B(PG8_SB(1, 1), b3, 1); PG8_STAGE_A(PG8_SA(1, 0), a3, 0, last);
            PG8_WAIT_V(8); PG8_WAIT_L(0); PG8_BAR; PG8_MMA(1, 0, At, B0); PG8_MMA(1, 1, At, B1); PG8_BAR; PG8_SCHED;
        }
        if constexpr (ALIGN_EPI) { if (wr == 0) PG8_BAR; }
        E(acc, cur, wr, wc, fr, fq); S.done(cur);
        if (!has_next) break;
#pragma unroll
        for (int a = 0; a < 2; ++a)
#pragma unroll
            for (int b = 0; b < 2; ++b)
#pragma unroll
                for (int m = 0; m < 4; ++m)
#pragma unroll
                    for (int n = 0; n < 2; ++n) acc[a][b][m][n] = (f32x4){0.f, 0.f, 0.f, 0.f};
        cur = nxt; cA = nA; cB = nB; ++ui;
        if constexpr (GATHER) {
#pragma unroll
            for (int h = 0; h < 2; ++h)
#pragma unroll
                for (int i = 0; i < 2; ++i) voffA[h][i] = voffN[h][i];
        }
        if constexpr (ALIGN_EPI) { if (wr == 1) PG8_BAR; }
    }
    PG8_WAIT_V(0);
    if constexpr (!ALIGN_EPI) { if (wr == 0) PG8_BAR; }
    PG8_BAR;
#undef PG8_SA
#undef PG8_SB
#undef PG8_STAGE_A
#undef PG8_STAGE_B
#undef PG8_LDA
#undef PG8_LDB
#undef PG8_MMA
#undef PG8_WAIT_V
#undef PG8_WAIT_L
#undef PG8_BAR
#undef PG8_SCHED
#undef PG8_GOFF
#undef PG8_BPTR
}
}
struct Resid {
    const float* in_lat; const float* in_ctx; bf16_t* x_lat; bf16_t* x_ctx; int g, src_f32;
    __device__ __forceinline__ const float* srcf(int row) const { const int bl = row / SB, s = row - bl * SB, b = g * GB + bl;
        return s < CTXL ? in_ctx + (size_t)(b * CTXL + s) * DM : in_lat + ((size_t)b * SEQ + (s - CTXL)) * DM; }
    __device__ __forceinline__ bf16_t* dst(int row) const { const int bl = row / SB, s = row - bl * SB, b = g * GB + bl;
        return s < CTXL ? x_ctx + (size_t)(b * CTXL + s) * DM : x_lat + ((size_t)b * SEQ + (s - CTXL)) * DM; }
    __device__ __forceinline__ int modv(int row) const { const int bl = row / SB, s = row - bl * SB; return s < CTXL ? 8 : g * GB + bl; }
};

struct TileOrder {
    int nM, nN, nwg, G, c, skip; const char* A; const char* B; size_t astep, bstep;
    __device__ __forceinline__ void init(int nM_, int nN_, int G_, int c_, const void* A_, size_t astep_, const void* B_, size_t bstep_, int skip_ctx) {
        nM = nM_; nN = nN_; nwg = nM * nN; G = G_; c = c_; A = (const char*)A_; B = (const char*)B_; astep = astep_; bstep = bstep_; skip = skip_ctx; }
    __device__ __forceinline__ bool next(int i, pg8::Unit& u) const {
        const long L = (long)i * G + c; if (L >= nwg) return false;
        int wgid = (int)L; { const int q = nwg / pg8::NXCD, r = nwg % pg8::NXCD, xcd = wgid % pg8::NXCD, off = wgid / pg8::NXCD; wgid = (xcd < r ? xcd * (q + 1) : r * (q + 1) + (xcd - r) * q) + off; }
        const int nig = pg8::WGM * nN, gid = wgid / nig, fm = gid * pg8::WGM, gsz = (nM - fm) < pg8::WGM ? (nM - fm) : pg8::WGM;
        int pm = fm + ((wgid % nig) % gsz); u.pn = (wgid % nig) / gsz;
        if (skip) pm = pm + pm / 32 + 1;
        u.pm = pm; u.aux0 = 0; u.aux1 = 0; u.aux2 = 0;
        u.a = A + (size_t)pm * astep; u.b = B + (size_t)u.pn * bstep; u.b2 = u.b; return true;
    }
    __device__ __forceinline__ void a_ready(const pg8::Unit&) const {}
    __device__ __forceinline__ void done(const pg8::Unit&) const {}
};

struct MoeOrder {
    const LAS int* tab; const int* LIST; int ncol, G, c, up; const char* A; const char* W;
    __device__ __forceinline__ bool next(int i, pg8::Unit& u) const {
        const int TR = __builtin_amdgcn_readfirstlane(tab[24]);
        int rt, pn;
        if ((G & 7) == 0) { const int x = c & 7, j = c >> 3, W = G >> 3; const int lo = (TR * x) >> 3, hi = (TR * (x + 1)) >> 3; const int q = i * W + j; if (q >= (hi - lo) * ncol) return false;
            rt = lo + q / ncol; pn = q - (q / ncol) * ncol; }
        else { const int L = i * G + c; if (L >= TR * ncol) return false; rt = L / ncol; pn = L - rt * ncol; }
        int p = 0;
#pragma unroll
        for (int q = 1; q < NPAIR; ++q) p += (__builtin_amdgcn_readfirstlane(tab[q]) <= rt) ? 1 : 0;
        const int base = (rt - __builtin_amdgcn_readfirstlane(tab[p])) * 256; int valid = __builtin_amdgcn_readfirstlane(tab[32 + p]) - base; valid = valid > 256 ? 256 : valid;
        u.pm = rt; u.pn = pn; u.aux0 = p * NT + base; u.aux1 = valid; u.aux2 = p;
        const int grp = p / 6, q6 = p - grp * 6;
        const int lo = q6 < 3 ? 0 : (q6 < 5 ? 1 : 2), hi = q6 < 3 ? q6 + 1 : (q6 < 5 ? q6 - 1 : 3);
        const int ea = grp * 4 + lo, eb = grp * 4 + hi;
        if (up) { const int e = pn < 4 ? ea : eb; u.a = A; u.b = W + ((size_t)e * 1024 + (size_t)(pn & 3) * 256) * 1024 * 2; u.b2 = u.b; }
        else { u.a = A + (size_t)rt * 256 * 1024 * 2; u.b = W + ((size_t)ea * 1024 + (size_t)pn * 256) * 512 * 2; u.b2 = W + ((size_t)eb * 1024 + (size_t)pn * 256) * 512 * 2; }
        return true;
    }
    __device__ __forceinline__ unsigned gather_off(const pg8::Unit& u, int r) const { const int idx = r < u.aux1 ? r : 0; return (unsigned)LIST[u.aux0 + idx] * (unsigned)(DM * 2); }
    __device__ __forceinline__ void a_ready(const pg8::Unit&) const {}
    __device__ __forceinline__ void done(const pg8::Unit&) const {}
};

#ifdef EPI_NT_STORES
#define ST_NT(p, v) __builtin_nontemporal_store((v), (p))
#else
#define ST_NT(p, v) (*(p) = (v))
#endif
#define EPI_NOHOOK static constexpr bool HOOK = false; static constexpr int HOOK_T0 = -1, HOOK_T1 = -1; \
    __device__ __forceinline__ void hook(pg8::Acc&, const pg8::Unit&, int, int, int, int, int) const {}
#define EPI_V8(v, acc, ai, bj, m) float v[8]; { const f32x4 _a = acc[ai][bj][m][0], _b = acc[ai][bj][m][1]; v[0] = _a[0]; v[1] = _a[1]; v[2] = _a[2]; v[3] = _a[3]; v[4] = _b[0]; v[5] = _b[1]; v[6] = _b[2]; v[7] = _b[3]; }
__device__ __forceinline__ void rot4(float (&v)[8], const f32x2* cs) {
    const f32x4 c01 = *(const f32x4*)cs, c23 = *(const f32x4*)(cs + 2);
    const float c[4] = {c01[0], c01[2], c23[0], c23[2]}, s[4] = {c01[1], c01[3], c23[1], c23[3]};
#pragma unroll
    for (int k = 0; k < 4; ++k) { const float x1 = v[2 * k], x2 = v[2 * k + 1]; v[2 * k] = x1 * c[k] - x2 * s[k]; v[2 * k + 1] = x2 * c[k] + x1 * s[k]; }
}

struct EpiNone { EPI_NOHOOK
    float* sink;
    __device__ __forceinline__ void operator()(const pg8::Acc& acc, const pg8::Unit& u, int wr, int wc, int fr, int fq) const {
        float s = 0.f;
#pragma unroll
        for (int ai = 0; ai < 2; ++ai)
#pragma unroll
            for (int bj = 0; bj < 2; ++bj)
#pragma unroll
                for (int m = 0; m < 4; ++m) s += acc[ai][bj][m][0][0] + acc[ai][bj][m][1][3];
        if (s == 1.2345e33f) sink[0] = s;
    }
};
struct EpiStoreOnly { EPI_NOHOOK
    bf16_t* PG;
    __device__ __forceinline__ void operator()(const pg8::Acc& acc, const pg8::Unit& u_, int wr, int wc, int fr, int fq) const {
        pg8::Unit u = u_; asm volatile("" : "+s"(u.pm), "+s"(u.pn), "+v"(fr), "+v"(fq));
        const int pn12 = u.pn % 12;
#pragma unroll
        for (int ai = 0; ai < 2; ++ai)
#pragma unroll
        for (int m = 0; m < 4; ++m) { const int row = u.pm * 256 + ai * 128 + wr * 64 + m * 16 + fr;
#pragma unroll
            for (int bj = 0; bj < 2; ++bj) { const int c0 = bj * 128 + wc * 32 + 8 * fq; EPI_V8(v, acc, ai, bj, m)
                *(u32x4*)(PG + (size_t)row * 3072 + pn12 * 256 + c0) = pack8(v); } }
    }
};
struct EpiInproj {
    EPI_NOHOOK
    bf16_t *PR, *PC, *PM, *PG; unsigned char* KB; float* SSQ; const f32x2* RT; const f32x2* MT;
    __device__ __forceinline__ void operator()(const pg8::Acc& acc, const pg8::Unit& u_, int wr, int wc, int fr, int fq) const {
        pg8::Unit u = u_; asm volatile("" : "+s"(u.pm), "+s"(u.pn), "+s"(u.aux0), "+s"(u.aux1), "+v"(fr), "+v"(fq));
        const int pn = u.pn;
#pragma unroll
        for (int ai = 0; ai < 2; ++ai)
#pragma unroll
        for (int m = 0; m < 4; ++m) { __builtin_amdgcn_sched_barrier(0);
            const int row = u.pm * 256 + ai * 128 + wr * 64 + m * 16 + fr;
            const int bl = row / SB, s = row - bl * SB; const bool lat = s >= CTXL; const int t = lat ? s - CTXL : 0;
            float ss[2] = {0.f, 0.f};
#pragma unroll
            for (int bj = 0; bj < 2; ++bj) {
                const int c0 = bj * 128 + wc * 32 + 8 * fq;
                EPI_V8(v, acc, ai, bj, m)
                if (pn <= 1) {
                    if (lat) rot4(v, RT + (size_t)t * 32 + ((c0 & 63) >> 1));
                    if (pn == 1) {
#pragma unroll
                        for (int k = 0; k < 8; ++k) v[k] *= 0.125f;
                    }
                    *(u32x4*)(PR + (size_t)row * 1536 + pn * 256 + c0) = pack8(v);
                } else if (pn <= 5) {
                    *(u32x4*)(PR + (size_t)row * 1536 + pn * 256 + c0) = pack8(v);
                } else if (pn <= 7) {
                    *(u32x4*)(PC + (size_t)row * 1024 + (pn - 6) * 256 + c0) = pack8(v);
                } else if (pn <= 11) {
                    u32x2 w; w.x = cvtpk(v[0] * v[1], v[2] * v[3]); w.y = cvtpk(v[4] * v[5], v[6] * v[7]);
                    *(u32x2*)(PC + (size_t)row * 1024 + 512 + (pn - 8) * 128 + (c0 >> 1)) = w;
                } else if (pn <= 14) {
                    if (pn == 14 && bj == 1) {
                        if (wc == 0) {
                            if (lat) { const int a = fq >> 1, pos = a ? (t & 63) : (t >> 6); rot4(v, MT + pos * 8 + (fq & 1) * 4); }
#pragma unroll
                            for (int k = 0; k < 8; ++k) v[k] *= K8S;
                            const u32x2 w = pack8_fp8(v);
#pragma unroll
                            for (int hh = 0; hh < 8; ++hh) { unsigned char* kp = KB + ((size_t)(bl * 8 + hh) * SB + s) * 128;
                                *(u32x2*)(kp + 64 + 8 * fq) = w; if (fq == 3) { *(u32x4*)(kp + 96) = (u32x4){0u, 0u, 0u, 0u}; *(u32x4*)(kp + 112) = (u32x4){0u, 0u, 0u, 0u}; } }
                        }
                    } else {
                        *(u32x4*)(PM + (size_t)row * 640 + (pn - 12) * 256 + c0) = pack8(v);
                        float q = 0.f;
#pragma unroll
                        for (int k = 0; k < 8; ++k) q += v[k] * v[k];
                        ss[bj] = q;
                    }
                } else {
                    float g[8];
#pragma unroll
                    for (int k = 0; k < 8; ++k) { const float x = fminf(fmaxf(v[k], -15.f), 15.f); g[k] = sigmoidf_(x); }
                    ST_NT((u32x4*)(PG + (size_t)row * 3072 + (pn - 15) * 256 + c0), pack8(g));
                }
            }
            if (pn >= 12 && pn <= 14) {
                float a = ss[0], b = ss[1];
                a += swz_xor<16>(a); a = half_sum(a); b += swz_xor<16>(b); b = half_sum(b);
                if (fq == 0) {
                    float* sq = SSQ + (size_t)row * 16;
                    if (pn == 12) sq[wc] = a + b;
                    else if (pn == 13) { sq[4 + wc] = a; sq[8 + wc] = b; }
                    else sq[12 + wc] = a;
                }
            }
        }
    }
};

#define EPI_ROW(ai, m) (u.pm * 256 + (ai) * 128 + wr * 64 + (m) * 16 + fr)
#define EPI_OPAQUE pg8::Unit u = u_; asm volatile("" : "+s"(u.pm), "+s"(u.pn), "+s"(u.aux0), "+s"(u.aux1), "+v"(fr), "+v"(fq));
struct EpiUq {
    EPI_NOHOOK
    unsigned char* QB; const float* SSQ; const f32x2* MT;
    __device__ __forceinline__ void operator()(const pg8::Acc& acc, const pg8::Unit& u_, int wr, int wc, int fr, int fq) const {
        EPI_OPAQUE
        f32x4 q0[2][4], q1[2][4];
#pragma unroll
        for (int ai = 0; ai < 2; ++ai)
#pragma unroll
            for (int m = 0; m < 4; ++m) { const float* sq = SSQ + (size_t)EPI_ROW(ai, m) * 16; q0[ai][m] = *(const f32x4*)sq; q1[ai][m] = *(const f32x4*)(sq + 4); }
#pragma unroll
        for (int ai = 0; ai < 2; ++ai)
#pragma unroll
        for (int m = 0; m < 4; ++m) {
            const int row = EPI_ROW(ai, m);
            const int bl = row / SB, s = row - bl * SB; const bool lat = s >= CTXL; const int t = lat ? s - CTXL : 0;
            const f32x4 a = q0[ai][m], b = q1[ai][m];
            const float ssq = ((a[0] + a[1]) + (a[2] + a[3])) + ((b[0] + b[1]) + (b[2] + b[3]));
            const float rq = rsqrtf(ssq * (1.f / 384.f) + RMS_EPS) * (QSCALE * Q8S);
#pragma unroll
            for (int bj = 0; bj < 2; ++bj) {
                const int cg = u.pn * 256 + bj * 128 + wc * 32 + 8 * fq; const int h = cg / 96, d0 = cg - h * 96;
                EPI_V8(v, acc, ai, bj, m)
#pragma unroll
                for (int k = 0; k < 8; ++k) v[k] *= rq;
                if (d0 >= 64 && lat) { const int p0 = d0 - 64, aa = p0 >> 4, pos = aa ? (t & 63) : (t >> 6); rot4(v, MT + pos * 8 + ((p0 & 15) >> 1)); }
                unsigned char* qp = QB + ((size_t)(bl * 8 + h) * SB + s) * 128;
                *(u32x2*)(qp + d0) = pack8_fp8(v);
                if (d0 == 88) { *(u32x4*)(qp + 96) = (u32x4){0u, 0u, 0u, 0u}; *(u32x4*)(qp + 112) = (u32x4){0u, 0u, 0u, 0u}; }
            }
        }
    }
};
struct EpiUkv {
    EPI_NOHOOK
    unsigned char* KB; unsigned char* VT; const float* SSQ; LAS unsigned char* tr;
    __device__ __forceinline__ void operator()(const pg8::Acc& acc, const pg8::Unit& u_, int wr, int wc, int fr, int fq) const {
        EPI_OPAQUE
        f32x4 q0[2][4], q1[2][4];
#pragma unroll
        for (int ai = 0; ai < 2; ++ai)
#pragma unroll
            for (int m = 0; m < 4; ++m) { const float* sq = SSQ + (size_t)EPI_ROW(ai, m) * 16 + 8; q0[ai][m] = *(const f32x4*)sq; q1[ai][m] = *(const f32x4*)(sq + 4); }
        LAS unsigned char* my = tr + (wr * 2 + (wc & 1)) * 2048;
        const int lane = fr + 16 * fq;
#pragma unroll
        for (int ai = 0; ai < 2; ++ai) {
            const int row0 = u.pm * 256 + ai * 128 + wr * 64;
            const int bl = row0 / SB, s0 = row0 - bl * SB;
#pragma unroll
            for (int bj = 0; bj < 2; ++bj) {
                const int h = u.pn * 2 + bj;
#pragma unroll
                for (int m = 0; m < 4; ++m) {
                    const f32x4 a = q0[ai][m], b = q1[ai][m];
                    const float ssq = ((a[0] + a[1]) + (a[2] + a[3])) + ((b[0] + b[1]) + (b[2] + b[3]));
                    const float rk = rsqrtf(ssq * (1.f / 256.f) + RMS_EPS);
                    EPI_V8(v, acc, ai, bj, m)
                    if (wc < 2) {
#pragma unroll
                        for (int k = 0; k < 8; ++k) v[k] *= rk * K8S;
                        *(u32x2*)(KB + ((size_t)(bl * 8 + h) * SB + s0 + 16 * m + fr) * 128 + wc * 32 + 8 * fq) = pack8_fp8(v);
                    } else {
#pragma unroll
                        for (int k = 0; k < 8; ++k) v[k] *= rk * V8S;
                        const u32x2 w = pack8_fp8(v); const int pos = vt_pos(16 * m + fr) ^ (16 * fq);
#pragma unroll
                        for (int k = 0; k < 4; ++k) { my[(8 * fq + k) * 64 + pos] = (unsigned char)(w.x >> (8 * k)); my[(8 * fq + 4 + k) * 64 + pos] = (unsigned char)(w.y >> (8 * k)); }
                    }
                }
                if (wc >= 2) {
#pragma unroll
                    for (int i = 0; i < 2; ++i) { const int ch = lane + 64 * i, d = ch >> 2, c16 = ch & 3;
                        const u32x4 x = *(const LAS u32x4*)(my + d * 64 + ((c16 ^ ((d >> 3) & 3)) * 16));
                        *(u32x4*)(VT + ((size_t)(bl * 8 + h) * 64 + (wc - 2) * 32 + d) * SB + s0 + c16 * 16) = x; }
                }
            }
        }
    }
};

struct EpiMerge1 {
    static constexpr bool HOOK = true; static constexpr int HOOK_T0 = 8, HOOK_T1 = 16;
    const bf16_t* PG; bf16_t* M;
    __device__ __forceinline__ void hook(pg8::Acc& acc, const pg8::Unit& u_, int t, int wr, int wc, int fr, int fq) const {
        pg8::Unit u = u_; asm volatile("" : "+s"(u.pm), "+s"(u.pn), "+v"(fr), "+v"(fq));
        const int gi = (t == 8) ? 0 : 1;
#pragma unroll
        for (int ai = 0; ai < 2; ++ai) {
            u32x4 sp[4][2], sn[4][2];
#pragma unroll
            for (int m = 0; m < 4; ++m)
#pragma unroll
                for (int bj = 0; bj < 2; ++bj) { const bf16_t* p = PG + (size_t)EPI_ROW(ai, m) * 3072 + gi * 1024 + u.pn * 256 + bj * 128 + wc * 32 + 8 * fq;
                    sp[m][bj] = *(const u32x4*)p; sn[m][bj] = *(const u32x4*)(p + 1024); }
#pragma unroll
            for (int m = 0; m < 4; ++m)
#pragma unroll
                for (int bj = 0; bj < 2; ++bj) {
                    float a[8], b[8]; unpack8(sp[m][bj], a); unpack8(sn[m][bj], b);
                    f32x4 r0, r1;
#pragma unroll
                    for (int k = 0; k < 4; ++k) { r0[k] = a[k] * __builtin_amdgcn_rcpf(b[k]); r1[k] = a[4 + k] * __builtin_amdgcn_rcpf(b[4 + k]); }
                    acc[ai][bj][m][0] *= r0; acc[ai][bj][m][1] *= r1;
                }
            __builtin_amdgcn_sched_barrier(0);
        }
    }
    __device__ __forceinline__ void operator()(const pg8::Acc& acc, const pg8::Unit& u_, int wr, int wc, int fr, int fq) const {
        EPI_OPAQUE
#pragma unroll
        for (int ai = 0; ai < 2; ++ai) {
            u32x4 s2[4][2];
#pragma unroll
            for (int m = 0; m < 4; ++m)
#pragma unroll
                for (int bj = 0; bj < 2; ++bj) s2[m][bj] = *(const u32x4*)(PG + (size_t)EPI_ROW(ai, m) * 3072 + 2048 + u.pn * 256 + bj * 128 + wc * 32 + 8 * fq);
#pragma unroll
            for (int m = 0; m < 4; ++m)
#pragma unroll
                for (int bj = 0; bj < 2; ++bj) {
                    const int cg = u.pn * 256 + bj * 128 + wc * 32 + 8 * fq;
                    float g[8]; unpack8(s2[m][bj], g);
                    EPI_V8(v, acc, ai, bj, m)
#pragma unroll
                    for (int k = 0; k < 8; ++k) v[k] *= g[k];
                    *(u32x4*)(M + (size_t)EPI_ROW(ai, m) * 1024 + cg) = pack8(v);
                }
            __builtin_amdgcn_sched_barrier(0);
        }
    }
};

struct EpiMerge1NoHook : EpiMerge1 { static constexpr bool HOOK = false; };
struct EpiMerge1HookOnly { static constexpr bool HOOK = true; static constexpr int HOOK_T0 = 8, HOOK_T1 = 16; EpiMerge1 e; float* sink;
    __device__ __forceinline__ void hook(pg8::Acc& acc, const pg8::Unit& u, int t, int wr, int wc, int fr, int fq) const { e.hook(acc, u, t, wr, wc, fr, fq); }
    __device__ __forceinline__ void operator()(const pg8::Acc& acc, const pg8::Unit& u, int wr, int wc, int fr, int fq) const { EpiNone n{sink}; n(acc, u, wr, wc, fr, fq); }
};
struct EpiMerge2 {
    EPI_NOHOOK
    Resid R; const float* MODL;
    __device__ __forceinline__ void operator()(const pg8::Acc& acc, const pg8::Unit& u_, int wr, int wc, int fr, int fq) const {
        EPI_OPAQUE
        const int cb = u.pn * 256 + wc * 32 + 8 * fq;
        const float* g1 = MODL + R.modv(u.pm * 256) * 6144 + 2048 + cb;
        f32x4 g[2][2];
#pragma unroll
        for (int bj = 0; bj < 2; ++bj)
#pragma unroll
            for (int n = 0; n < 2; ++n) g[bj][n] = *(const f32x4*)(g1 + bj * 128 + 4 * n);
        int sf32 = R.src_f32; asm volatile("" : "+s"(sf32));
#pragma unroll
        for (int ai = 0; ai < 2; ++ai) {
            if (sf32) {
#pragma unroll
                for (int mh = 0; mh < 2; ++mh) {
                    f32x4 x[2][2][2];
#pragma unroll
                    for (int m2 = 0; m2 < 2; ++m2) { const float* src = R.srcf(EPI_ROW(ai, 2 * mh + m2)) + cb;
#pragma unroll
                        for (int bj = 0; bj < 2; ++bj)
#pragma unroll
                            for (int n = 0; n < 2; ++n) x[m2][bj][n] = *(const f32x4*)(src + bj * 128 + 4 * n); }
#pragma unroll
                    for (int m2 = 0; m2 < 2; ++m2) { const int m = 2 * mh + m2; bf16_t* dst = R.dst(EPI_ROW(ai, m)) + cb;
#pragma unroll
                        for (int bj = 0; bj < 2; ++bj) { const f32x4 a = x[m2][bj][0] + g[bj][0] * acc[ai][bj][m][0], b = x[m2][bj][1] + g[bj][1] * acc[ai][bj][m][1];
                            u32x4 w; w.x = cvtpk(a[0], a[1]); w.y = cvtpk(a[2], a[3]); w.z = cvtpk(b[0], b[1]); w.w = cvtpk(b[2], b[3]); *(u32x4*)(dst + bj * 128) = w; } }
                }
            } else {
                u32x4 x[4][2];
#pragma unroll
                for (int m = 0; m < 4; ++m) { const bf16_t* src = R.dst(EPI_ROW(ai, m)) + cb;
#pragma unroll
                    for (int bj = 0; bj < 2; ++bj) x[m][bj] = *(const u32x4*)(src + bj * 128); }
#pragma unroll
                for (int m = 0; m < 4; ++m) { bf16_t* dst = R.dst(EPI_ROW(ai, m)) + cb;
#pragma unroll
                    for (int bj = 0; bj < 2; ++bj) { float f[8]; unpack8(x[m][bj], f);
                        const f32x4 a = (f32x4){f[0], f[1], f[2], f[3]} + g[bj][0] * acc[ai][bj][m][0], b = (f32x4){f[4], f[5], f[6], f[7]} + g[bj][1] * acc[ai][bj][m][1];
                        u32x4 w; w.x = cvtpk(a[0], a[1]); w.y = cvtpk(a[2], a[3]); w.z = cvtpk(b[0], b[1]); w.w = cvtpk(b[2], b[3]); *(u32x4*)(dst + bj * 128) = w; } }
            }
            __builtin_amdgcn_sched_barrier(0);
        }
    }
};

struct EpiMoeUp {
    EPI_NOHOOK
    const int* LIST; const float* WGT; bf16_t* MACT;
    __device__ __forceinline__ void operator()(const pg8::Acc& acc, const pg8::Unit& u_, int wr, int wc, int fr, int fq) const {
        EPI_OPAQUE
        const int slot = u.pn >> 2;
        int tok[2][4]; float w[2][4];
#pragma unroll
        for (int ai = 0; ai < 2; ++ai)
#pragma unroll
            for (int m = 0; m < 4; ++m) { const int ri = ai * 128 + wr * 64 + m * 16 + fr; tok[ai][m] = LIST[u.aux0 + (ri < u.aux1 ? ri : 0)]; }
#pragma unroll
        for (int ai = 0; ai < 2; ++ai)
#pragma unroll
            for (int m = 0; m < 4; ++m) w[ai][m] = WGT[(size_t)tok[ai][m] * 2 + slot];
#pragma unroll
        for (int ai = 0; ai < 2; ++ai)
#pragma unroll
        for (int m = 0; m < 4; ++m) {
            const int ri = ai * 128 + wr * 64 + m * 16 + fr; const float ww = w[ai][m];
#pragma unroll
            for (int bj = 0; bj < 2; ++bj) {
                const int c0 = bj * 128 + wc * 32 + 8 * fq;
                EPI_V8(v, acc, ai, bj, m)
                u32x2 o; o.x = cvtpk(siluf_(v[0]) * v[1] * ww, siluf_(v[2]) * v[3] * ww); o.y = cvtpk(siluf_(v[4]) * v[5] * ww, siluf_(v[6]) * v[7] * ww);
                *(u32x2*)(MACT + (size_t)(u.pm * 256 + ri) * 1024 + slot * 512 + (u.pn & 3) * 128 + (c0 >> 1)) = o;
            }
        }
    }
};
struct EpiMoeDown {
    EPI_NOHOOK
    const int* LIST; Resid R; const float* MODL; bf16_t* dry;
    __device__ __forceinline__ void operator()(const pg8::Acc& acc, const pg8::Unit& u_, int wr, int wc, int fr, int fq) const {
        EPI_OPAQUE
        int tok[2][4];
#pragma unroll
        for (int ai = 0; ai < 2; ++ai)
#pragma unroll
            for (int m = 0; m < 4; ++m) { const int ri = ai * 128 + wr * 64 + m * 16 + fr; tok[ai][m] = LIST[u.aux0 + (ri < u.aux1 ? ri : 0)]; }
        const int cb = u.pn * 256 + wc * 32 + 8 * fq;
#pragma unroll
        for (int ai = 0; ai < 2; ++ai) {
            u32x4 x[4][2];
#pragma unroll
            for (int m = 0; m < 4; ++m) { const bf16_t* dst = R.dst(tok[ai][m]) + cb;
#pragma unroll
                for (int bj = 0; bj < 2; ++bj) x[m][bj] = *(const u32x4*)(dst + bj * 128); }
#pragma unroll
            for (int m = 0; m < 4; ++m) { const int ri = ai * 128 + wr * 64 + m * 16 + fr;
                if (ri < u.aux1) {
                    bf16_t* dst = R.dst(tok[ai][m]) + cb; const float* g2 = MODL + R.modv(tok[ai][m]) * 6144 + 5120 + cb;
#pragma unroll
                    for (int bj = 0; bj < 2; ++bj) { float f[8]; unpack8(x[m][bj], f);
                        const f32x4 ga = *(const f32x4*)(g2 + bj * 128), gb = *(const f32x4*)(g2 + bj * 128 + 4);
                        const f32x4 a = (f32x4){f[0], f[1], f[2], f[3]} + ga * acc[ai][bj][m][0], b = (f32x4){f[4], f[5], f[6], f[7]} + gb * acc[ai][bj][m][1];
                        u32x4 w; w.x = cvtpk(a[0], a[1]); w.y = cvtpk(a[2], a[3]); w.z = cvtpk(b[0], b[1]); w.w = cvtpk(b[2], b[3]);
                        bf16_t* o = dry ? dry + (size_t)(u.pm * 256 + ri) * 1024 + cb + bj * 128 : dst + bj * 128;
                        *(u32x4*)o = w; }
                } }
            __builtin_amdgcn_sched_barrier(0);
        }
    }
};
#define SBAR() __builtin_amdgcn_sched_barrier(0)
__device__ __forceinline__ int crow(int r, int hi) { return (r & 3) + 8 * (r >> 2) + 4 * hi; }
template <int NCB> __device__ __forceinline__ int v_st(int k, int c) { const int kk = (k & ~0xC) | ((k & 4) << 1) | ((k & 8) >> 1); return ((kk >> 3) * NCB + (c >> 5)) * 512 + ((kk & 7) * 32 + (c & 31)) * 2; }
__device__ __forceinline__ int v_rd_base(int lane) { return ((lane & 3) << 3) | (((lane >> 2) & 3) << 6) | (((lane >> 4) & 1) << 5) | (((lane >> 5) & 1) << 8); }
template <int OFF> __device__ __forceinline__ s16x4 tr_read(int vb) { s16x4 r; asm volatile("ds_read_b64_tr_b16 %0, %1 offset:%2" : "=&v"(r) : "v"(vb), "i"(OFF) : "memory"); return r; }
#define PKLH(L, H) (bf16x8){L[0], L[1], L[2], L[3], H[0], H[1], H[2], H[3]}
template <int NCB, int KS> __device__ __forceinline__ bf16x8 tr_frag(int vb) { const s16x4 l = tr_read<KS * NCB * 1024>(vb), h = tr_read<KS * NCB * 1024 + NCB * 512>(vb); return PKLH(l, h); }
#define PK4(P, BASE, OUT) do { const unsigned a0 = cvtpk(P[BASE + 0], P[BASE + 1]), a1 = cvtpk(P[BASE + 2], P[BASE + 3]);   \
    const unsigned b0 = cvtpk(P[BASE + 4], P[BASE + 5]), b1 = cvtpk(P[BASE + 6], P[BASE + 7]);                              \
    auto r0 = __builtin_amdgcn_permlane32_swap(a0, b0, false, false); auto r1 = __builtin_amdgcn_permlane32_swap(a1, b1, false, false); \
    u32x4 w = {r0[0], r1[0], r0[1], r1[1]}; OUT = __builtin_bit_cast(bf16x8, w); } while (0)

namespace att {
constexpr int DQK = 96, DV = 64, KVBLK = 64;
constexpr int SHM_V = KVBLK * DV * 2;
constexpr int SHM_K = KVBLK * 256;
constexpr float THR = 8.f;
#define KSWZ(row, colB) ((row) * 256 + ((colB) ^ (((row) & 7) << 4)))
__device__ __forceinline__ void partialSM(f32x16& p0, f32x16& p1, float& m_reg, float& alpha) {
    float pmax = p0[0];
#pragma unroll
    for (int r = 1; r < 16; ++r) pmax = fmaxf(pmax, p0[r]);
#pragma unroll
    for (int r = 0; r < 16; ++r) pmax = fmaxf(pmax, p1[r]);
    { auto rr = __builtin_amdgcn_permlane32_swap(__float_as_uint(pmax), __float_as_uint(pmax), false, false);
      pmax = fmaxf(__uint_as_float(rr[0]), __uint_as_float(rr[1])); }
    float mn;
    if (__builtin_expect(__all(pmax - m_reg <= THR), 1)) { mn = m_reg; alpha = 1.f; }
    else { mn = fmaxf(m_reg, pmax); alpha = __builtin_amdgcn_exp2f(m_reg - mn); m_reg = mn; }
#pragma unroll
    for (int r = 0; r < 16; ++r) p0[r] = p0[r] - mn;
#pragma unroll
    for (int r = 0; r < 16; ++r) p1[r] = p1[r] - mn;
#pragma unroll
    for (int r = 0; r < 16; ++r) p0[r] = __builtin_amdgcn_exp2f(p0[r]);
}
__device__ __forceinline__ void finishSM(f32x16& p0, f32x16& p1, float alpha, float& l_reg, bf16x8& pa0, bf16x8& pa1, bf16x8& pa2, bf16x8& pa3) {
#pragma unroll
    for (int r = 0; r < 16; ++r) p1[r] = __builtin_amdgcn_exp2f(p1[r]);
    float ps = 0;
#pragma unroll
    for (int r = 0; r < 16; ++r) ps += p0[r];
#pragma unroll
    for (int r = 0; r < 16; ++r) ps += p1[r];
    { auto rr = __builtin_amdgcn_permlane32_swap(__float_as_uint(ps), __float_as_uint(ps), false, false);
      ps = __uint_as_float(rr[0]) + __uint_as_float(rr[1]); }
    l_reg = l_reg * alpha + ps;
    PK4(p0, 0, pa0); PK4(p0, 8, pa1); PK4(p1, 0, pa2); PK4(p1, 8, pa3);
}
__device__ __forceinline__ void qkt(f32x16& p0, f32x16& p1, const LAS char* Ks, const bf16x8* qr, int r32, int hi) {
    p0 = f32x16{}; p1 = f32x16{};
#pragma unroll
    for (int d0 = 0; d0 < 6; ++d0) { const int cb = (d0 * 16 + hi * 8) * 2;
        const bf16x8 b0 = *(const LAS bf16x8*)(Ks + KSWZ(r32, cb));
        const bf16x8 b1 = *(const LAS bf16x8*)(Ks + KSWZ(32 + r32, cb));
        p0 = __builtin_amdgcn_mfma_f32_32x32x16_bf16(b0, qr[d0], p0, 0, 0, 0);
        p1 = __builtin_amdgcn_mfma_f32_32x32x16_bf16(b1, qr[d0], p1, 0, 0, 0); }
}
template <int D0> __device__ __forceinline__ void pv_one(f32x16& od, int vb, bf16x8 pa0, bf16x8 pa1, bf16x8 pa2, bf16x8 pa3) {
    const bf16x8 f0 = tr_frag<2, 0>(vb + D0 * 512), f1 = tr_frag<2, 1>(vb + D0 * 512), f2 = tr_frag<2, 2>(vb + D0 * 512), f3 = tr_frag<2, 3>(vb + D0 * 512);
    asm volatile("s_waitcnt lgkmcnt(0)" ::: "memory"); SBAR();
    od = __builtin_amdgcn_mfma_f32_32x32x16_bf16(pa0, f0, od, 0, 0, 0);
    od = __builtin_amdgcn_mfma_f32_32x32x16_bf16(pa1, f1, od, 0, 0, 0);
    od = __builtin_amdgcn_mfma_f32_32x32x16_bf16(pa2, f2, od, 0, 0, 0);
    od = __builtin_amdgcn_mfma_f32_32x32x16_bf16(pa3, f3, od, 0, 0, 0);
}
__device__ __forceinline__ void pv_d0(f32x16* o, int vb, bf16x8 pa0, bf16x8 pa1, bf16x8 pa2, bf16x8 pa3) {
    pv_one<0>(o[0], vb, pa0, pa1, pa2, pa3); pv_one<1>(o[1], vb, pa0, pa1, pa2, pa3);
}
__device__ __forceinline__ void attn_unit(const bf16_t* __restrict__ Qb, const bf16_t* __restrict__ Kh, const bf16_t* __restrict__ Vh, bf16_t* __restrict__ Ob, int ldo, int seq, LAS char* lds, const int wv) {
    const int tid = otid(wv), wid = __builtin_amdgcn_readfirstlane(tid >> 6), lane = tid & 63, r32 = lane & 31, hi = lane >> 5;
    LAS char* V_lds = lds; LAS char* K_lds = lds + 2 * SHM_V;
    LAS float* ws = (LAS float*)(lds + 2 * SHM_V + 2 * SHM_K) + wid * 64; LAS float* li_l = ws; LAS float* al_l = ws + 32;
    float m_reg = -1e30f, l_reg = 0; f32x16 o[2] = {}; bf16x8 qr[6];
    const bf16_t* Qw = Qb + (size_t)(wid * 32 + r32) * DQK + hi * 8;
#pragma unroll
    for (int d0 = 0; d0 < 6; ++d0) qr[d0] = *(const bf16x8*)(Qw + d0 * 16);
    const int vrow = tid >> 3, vc = (tid & 7) * 8, vst = v_st<2>(vrow, vc);
    const int krA = tid / 12, kcA = tid - krA * 12, sB = 512 + tid, krB = sB / 12, kcB = sB - krB * 12;
    const int kstA = KSWZ(krA, kcA * 16), kstB = KSWZ(krB, kcB * 16);
    const bool hasB = wid < 4;
    const int vb0 = (int)(size_t)V_lds + v_rd_base(lane);
    struct { bf16x8 v, ka, kb; } sr_[2];
#define SLOAD(i, k0) do { sr_[i].v = *(const bf16x8*)(Vh + (size_t)((k0) + vrow) * DV + vc); sr_[i].ka = *(const bf16x8*)(Kh + (size_t)((k0) + krA) * DQK + kcA * 8); \
    if (hasB) sr_[i].kb = *(const bf16x8*)(Kh + (size_t)((k0) + krB) * DQK + kcB * 8); } while (0)
#define SWRITE(b, i) do { *(LAS bf16x8*)(V_lds + (b) * SHM_V + vst) = sr_[i].v; *(LAS bf16x8*)(K_lds + (b) * SHM_K + kstA) = sr_[i].ka; \
    if (hasB) *(LAS bf16x8*)(K_lds + (b) * SHM_K + kstB) = sr_[i].kb; } while (0)
#define RESC(a) do { if (__any((a) < 1.f)) { if (hi == 0) al_l[r32] = (a); asm volatile("s_waitcnt lgkmcnt(0)" ::: "memory"); \
    _Pragma("unroll") for (int d = 0; d < 2; ++d) _Pragma("unroll") for (int r = 0; r < 16; ++r) o[d][r] *= al_l[crow(r, hi)]; } } while (0)
    f32x16 pA0, pA1, pB0, pB1; float alA, alB; bf16x8 pa0, pa1, pa2, pa3; const int NTL = seq / KVBLK;
    SLOAD(0, 0); SWRITE(0, 0); __syncthreads();
    qkt(pA0, pA1, K_lds, qr, r32, hi); partialSM(pA0, pA1, m_reg, alA);
    SLOAD(1, KVBLK); if (2 < NTL) SLOAD(0, 2 * KVBLK);
    SWRITE(1, 1); __syncthreads();
    for (int j = 1; j + 1 < NTL; j += 2) {
        SBAR(); qkt(pB0, pB1, K_lds + SHM_K, qr, r32, hi);
        finishSM(pA0, pA1, alA, l_reg, pa0, pa1, pa2, pa3); SBAR();
        SLOAD(1, (j + 2) * KVBLK); SBAR();
        pv_d0(o, vb0, pa0, pa1, pa2, pa3); partialSM(pB0, pB1, m_reg, alB);
        __syncthreads(); SWRITE(0, 0);
        RESC(alB); __syncthreads();
        SBAR(); qkt(pA0, pA1, K_lds, qr, r32, hi);
        finishSM(pB0, pB1, alB, l_reg, pa0, pa1, pa2, pa3); SBAR();
        if (j + 3 < NTL) SLOAD(0, (j + 3) * KVBLK); SBAR();
        pv_d0(o, vb0 + SHM_V, pa0, pa1, pa2, pa3); partialSM(pA0, pA1, m_reg, alA);
        __syncthreads(); SWRITE(1, 1);
        RESC(alA); __syncthreads();
    }
    SBAR(); qkt(pB0, pB1, K_lds + SHM_K, qr, r32, hi);
    finishSM(pA0, pA1, alA, l_reg, pa0, pa1, pa2, pa3); SBAR();
    pv_d0(o, vb0, pa0, pa1, pa2, pa3); partialSM(pB0, pB1, m_reg, alB);
    __syncthreads(); RESC(alB);
    finishSM(pB0, pB1, alB, l_reg, pa0, pa1, pa2, pa3); SBAR();
    pv_d0(o, vb0 + SHM_V, pa0, pa1, pa2, pa3);
    if (hi == 0) li_l[r32] = l_reg; asm volatile("s_waitcnt lgkmcnt(0)" ::: "memory");
    float rli[16];
#pragma unroll
    for (int r = 0; r < 16; ++r) rli[r] = __builtin_amdgcn_rcpf(li_l[crow(r, hi)]);
    bf16_t* Ow = Ob + (size_t)(wid * 32) * ldo;
#pragma unroll
    for (int r = 0; r < 16; ++r) { const int orow = crow(r, hi);
#pragma unroll
        for (int d0 = 0; d0 < 2; ++d0) Ow[(size_t)orow * ldo + d0 * 32 + r32] = f2bf(o[d0][r] * rli[r]); }
    __syncthreads();
#undef SLOAD
#undef SWRITE
#undef RESC
}
}

namespace att2 {
constexpr int DQK = 96, DV = 64, KVBLK = 64;
constexpr int KB_BYTES = 64 * 128, VB_BYTES = 64 * 64;
typedef int i32x8 __attribute__((ext_vector_type(8)));
constexpr int SC_K = 0x7d7d7d7d, SC_Q = 0x7a7a7a7a, SC_P = 0x7f7f7f7f, SC_V = 0x7d7d7d7d;
constexpr int NSLOT = 5;
constexpr int LDS_K = 0, LDS_V = NSLOT * KB_BYTES, LDS_WS = LDS_V + NSLOT * VB_BYTES, LDS_TOTAL = LDS_WS + 8 * 64 * 4;
static_assert(LDS_TOTAL <= RING_BYTES, "attention LDS");
constexpr float THR = 4.f;
typedef short v4i16_t __attribute__((ext_vector_type(4)));
__device__ __forceinline__ s16x4 vtr(const LAS char* p) { return __builtin_bit_cast(s16x4, __builtin_amdgcn_ds_read_tr16_b64_v4i16((LAS v4i16_t*)p)); }
#define PP_KLD(B, DH) ({ const int row_ = 32 * (B) + r32, sw_ = (row_ >> 1) & 7, c0_ = 2 * hi + 4 * (DH); \
        const u32x4 a_ = *(const LAS u32x4*)(Kt + row_ * 128 + ((c0_ ^ sw_) << 4)), b_ = *(const LAS u32x4*)(Kt + row_ * 128 + (((c0_ + 1) ^ sw_) << 4)); \
        (i32x8){(int)a_.x, (int)a_.y, (int)a_.z, (int)a_.w, (int)b_.x, (int)b_.y, (int)b_.z, (int)b_.w}; })
#define PP_VLD(DB) ({ const int d_ = 32 * (DB) + r32, sw_ = (d_ >> 2) & 3; \
        const u32x4 a_ = *(const LAS u32x4*)(Vt + d_ * 64 + (((2 * hi) ^ sw_) << 4)), b_ = *(const LAS u32x4*)(Vt + d_ * 64 + (((2 * hi + 1) ^ sw_) << 4)); \
        (i32x8){(int)a_.x, (int)a_.y, (int)a_.z, (int)a_.w, (int)b_.x, (int)b_.y, (int)b_.z, (int)b_.w}; })
#ifdef PROBE_EXP2X
#define PP_EXP(x) do { float a_ = (x), b_ = (x); asm volatile("" : "+v"(b_)); a_ = __builtin_amdgcn_exp2f(a_); b_ = __builtin_amdgcn_exp2f(b_); (x) = (a_ + b_) * 0.5f; } while (0)
#else
#define PP_EXP(x) (x) = __builtin_amdgcn_exp2f(x)
#endif
#define PK4N(P, BASE, OUT) do { u32x4 w_ = {cvtpk(P[BASE + 0], P[BASE + 1]), cvtpk(P[BASE + 2], P[BASE + 3]), cvtpk(P[BASE + 4], P[BASE + 5]), cvtpk(P[BASE + 6], P[BASE + 7])}; OUT = __builtin_bit_cast(bf16x8, w_); } while (0)
#define PP_SLOT_END() do { SBAR(); asm volatile("s_waitcnt vmcnt(%0) lgkmcnt(0)\n\ts_barrier" :: "n"(2 * (NSLOT - 2)) : "memory"); SBAR(); } while (0)
#define PP_BAR() do { SBAR(); asm volatile("s_waitcnt lgkmcnt(0)\n\ts_barrier" ::: "memory"); SBAR(); } while (0)
__device__ __forceinline__ float max3f(float a, float b, float c) { return fmaxf(fmaxf(a, b), c); }
__device__ __forceinline__ void attn_unit_pp(const unsigned char* __restrict__ Qb, const unsigned char* __restrict__ Kh, const unsigned char* __restrict__ Vh, bf16_t* __restrict__ Ob, int ldo, int seq, LAS char* lds, const int wv) {
    const int tid = otid(wv), wid = __builtin_amdgcn_readfirstlane(tid >> 6), lane = tid & 63, r32 = lane & 31, hi = lane >> 5, grp = wid >> 2;
    LAS float* ws = (LAS float*)(lds + LDS_WS) + wid * 64; LAS float* li_l = ws; LAS float* al_l = ws + 32;
    const int NTL = seq / KVBLK;
    unsigned koff, voff;
    { const int s = wid * 64 + lane, row = s >> 3, ch = (s & 7) ^ ((row >> 1) & 7); koff = (unsigned)(row * 128 + ch * 16); }
    { const int s = (wid & 3) * 64 + lane, d = s >> 2, ch = (s & 3) ^ ((d >> 2) & 3); voff = (unsigned)(d * SB + ch * 16); }
    const char* Kg = (const char*)Kh; const char* Vg = (const char*)Vh;
#define PP_DMA_K(t) do { int tt_ = (t); tt_ = tt_ < NTL ? tt_ : NTL - 1; const int sl_ = tt_ % NSLOT; \
        __builtin_amdgcn_global_load_lds((const unsigned*)(Kg + (size_t)tt_ * (64 * 128) + koff), (LAS unsigned*)(lds + LDS_K + sl_ * KB_BYTES + wid * 1024), 16, 0, 0); } while (0)
#define PP_DMA_V(t) do { int tt_ = (t); tt_ = tt_ < NTL ? tt_ : NTL - 1; const int sl_ = tt_ % NSLOT; \
        __builtin_amdgcn_global_load_lds((const unsigned*)(Vg + (size_t)tt_ * 64 + voff), (LAS unsigned*)(lds + LDS_V + sl_ * VB_BYTES + (wid & 3) * 1024), 16, 0, 0); } while (0)
#pragma unroll
    for (int i = 0; i <= NSLOT - 2; ++i) PP_DMA_K(i);
#pragma unroll
    for (int i = 0; i <= NSLOT - 3; ++i) PP_DMA_V(i);
    i32x8 q8[2];
    { const unsigned char* Qw = Qb + (size_t)(wid * 32 + r32) * 128 + hi * 32;
#pragma unroll
      for (int dh = 0; dh < 2; ++dh) { const u32x4 a_ = *(const u32x4*)(Qw + dh * 64), b_ = *(const u32x4*)(Qw + dh * 64 + 16);
          q8[dh] = (i32x8){(int)a_.x, (int)a_.y, (int)a_.z, (int)a_.w, (int)b_.x, (int)b_.y, (int)b_.z, (int)b_.w}; } }
    float m_reg = 0.f, l_reg = 0.f; f32x16 o[2] = {}; f32x16 negm = {}; asm volatile("" : "+v"(negm));
    f32x16 p0, p1; i32x8 pa8 = {};
    SBAR(); asm volatile("s_waitcnt vmcnt(0) lgkmcnt(0)\n\ts_barrier" ::: "memory"); SBAR();
#ifdef ATTN_TWO_BARRIERS
    if (grp == 1) PP_BAR();
#endif
#define PP_M(t) do { const int t_ = (t), j_ = t_ + 1; \
        if (t_ <= NTL - 2) { PP_DMA_V(t_ + NSLOT - 1); PP_DMA_K(t_ + NSLOT); } \
        i32x8 k8[4]; i32x8 v8[2]; \
        const LAS char* Kt = lds + LDS_K + ((j_ < NTL ? j_ : 0) % NSLOT) * KB_BYTES; \
        const LAS char* Vt = lds + LDS_V + ((t_ < 0 ? 0 : t_) % NSLOT) * VB_BYTES; \
        if (j_ < NTL) { \
            k8[0] = PP_KLD(0, 0); k8[1] = PP_KLD(1, 0); SBAR(); \
            k8[2] = PP_KLD(0, 1); SBAR(); \
            p0 = __builtin_amdgcn_mfma_scale_f32_32x32x64_f8f6f4(k8[0], q8[0], negm, 0, 0, 0, SC_K, 0, SC_Q); SBAR(); \
            k8[3] = PP_KLD(1, 1); SBAR(); \
            p1 = __builtin_amdgcn_mfma_scale_f32_32x32x64_f8f6f4(k8[1], q8[0], negm, 0, 0, 0, SC_K, 0, SC_Q); SBAR(); \
            if (t_ >= 0) { v8[0] = PP_VLD(0); } SBAR(); \
            p0 = __builtin_amdgcn_mfma_scale_f32_32x32x64_f8f6f4(k8[2], q8[1], p0, 0, 0, 0, SC_K, 0, SC_Q); SBAR(); \
            if (t_ >= 0) { v8[1] = PP_VLD(1); } SBAR(); \
            p1 = __builtin_amdgcn_mfma_scale_f32_32x32x64_f8f6f4(k8[3], q8[1], p1, 0, 0, 0, SC_K, 0, SC_Q); SBAR(); \
        } else if (t_ >= 0) { v8[0] = PP_VLD(0); v8[1] = PP_VLD(1); SBAR(); } \
        if (t_ >= 0) { \
            o[0] = __builtin_amdgcn_mfma_scale_f32_32x32x64_f8f6f4(pa8, v8[0], o[0], 0, 0, 0, SC_P, 0, SC_V); \
            o[1] = __builtin_amdgcn_mfma_scale_f32_32x32x64_f8f6f4(pa8, v8[1], o[1], 0, 0, 0, SC_P, 0, SC_V); } \
        asm volatile("" : "+v"(o[0]), "+v"(o[1]), "+v"(p0), "+v"(p1));        \
        } while (0)
#define PP_S(first) do { \
        float a_ = max3f(p0[0], p0[1], p1[0]), b_ = max3f(p0[2], p0[3], p1[1]); a_ = max3f(a_, p1[2], p1[3]); \
        _Pragma("unroll") for (int r = 4; r < 16; r += 4) { a_ = max3f(a_, p0[r], p0[r + 1]); b_ = max3f(b_, p0[r + 2], p0[r + 3]); a_ = max3f(a_, p1[r], p1[r + 1]); b_ = max3f(b_, p1[r + 2], p1[r + 3]); } \
        float rm_ = fmaxf(a_, b_); { auto rr = __builtin_amdgcn_permlane32_swap(__float_as_uint(rm_), __float_as_uint(rm_), false, false); rm_ = fmaxf(__uint_as_float(rr[0]), __uint_as_float(rr[1])); } \
        if (first) { const float dl = rm_ - 4.f; m_reg = dl; _Pragma("unroll") for (int r = 0; r < 16; ++r) { p0[r] -= dl; p1[r] -= dl; } \
            _Pragma("unroll") for (int r = 0; r < 16; ++r) negm[r] = -m_reg; asm volatile("" : "+v"(negm)); } \
        else if (__builtin_expect(__any(rm_ > 2.f * THR), 0)) { const float dl = fmaxf(rm_ - THR, 0.f); m_reg += dl; \
            _Pragma("unroll") for (int r = 0; r < 16; ++r) { p0[r] -= dl; p1[r] -= dl; } \
            _Pragma("unroll") for (int r = 0; r < 16; ++r) negm[r] = -m_reg; asm volatile("" : "+v"(negm)); \
            const float al = __builtin_amdgcn_exp2f(-dl); l_reg *= al; if (hi == 0) al_l[r32] = al; asm volatile("s_waitcnt lgkmcnt(0)" ::: "memory"); \
            _Pragma("unroll") for (int d = 0; d < 2; ++d) _Pragma("unroll") for (int r = 0; r < 16; ++r) o[d][r] *= al_l[crow(r, hi)]; } \
        _Pragma("unroll") for (int r = 0; r < 16; ++r) { PP_EXP(p0[r]); PP_EXP(p1[r]); } \
        float ps_ = 0.f; _Pragma("unroll") for (int r = 0; r < 16; ++r) ps_ += p0[r]; _Pragma("unroll") for (int r = 0; r < 16; ++r) ps_ += p1[r]; \
        { auto rr = __builtin_amdgcn_permlane32_swap(__float_as_uint(ps_), __float_as_uint(ps_), false, false); ps_ = __uint_as_float(rr[0]) + __uint_as_float(rr[1]); } \
        l_reg += ps_; \
        _Pragma("unroll") for (int k_ = 0; k_ < 4; ++k_) { \
            int w_ = __builtin_amdgcn_cvt_pk_fp8_f32(p0[4 * k_], p0[4 * k_ + 1], 0, false); w_ = __builtin_amdgcn_cvt_pk_fp8_f32(p0[4 * k_ + 2], p0[4 * k_ + 3], w_, true); pa8[k_] = w_; \
            int x_ = __builtin_amdgcn_cvt_pk_fp8_f32(p1[4 * k_], p1[4 * k_ + 1], 0, false); x_ = __builtin_amdgcn_cvt_pk_fp8_f32(p1[4 * k_ + 2], p1[4 * k_ + 3], x_, true); pa8[4 + k_] = x_; } \
        asm volatile("" : "+v"(pa8), "+v"(l_reg)); } while (0)
#ifdef ATTN_TWO_BARRIERS
    PP_M(-1); PP_SLOT_END();
    PP_S(true); PP_SLOT_END();
#pragma nounroll
    for (int t = 0; t < NTL - 1; ++t) {
        PP_M(t); PP_SLOT_END();
        PP_S(false); PP_SLOT_END();
    }
    PP_M(NTL - 1);
    if (grp == 0) PP_BAR();
#else
#ifdef ATTN_PRIO_YOUNG
    if (grp == 1) __builtin_amdgcn_s_setprio(1);
#endif
    if (grp == 0) {
        PP_M(-1); PP_S(true); PP_SLOT_END();
#pragma nounroll
        for (int t = 0; t < NTL - 1; ++t) { PP_M(t); PP_S(false); PP_SLOT_END(); }
        PP_M(NTL - 1);
    } else {
        PP_M(-1); PP_SLOT_END();
        PP_S(true);
#pragma nounroll
        for (int t = 0; t < NTL - 1; ++t) { PP_M(t); PP_SLOT_END(); PP_S(false); }
        PP_M(NTL - 1);
    }
#ifdef ATTN_PRIO_YOUNG
    __builtin_amdgcn_s_setprio(0);
#endif
#endif
    if (hi == 0) li_l[r32] = l_reg; asm volatile("s_waitcnt lgkmcnt(0)" ::: "memory");
    float rli[16];
#pragma unroll
    for (int r = 0; r < 16; ++r) rli[r] = __builtin_amdgcn_rcpf(li_l[crow(r, hi)]);
    bf16_t* Ow = Ob + (size_t)(wid * 32) * ldo;
#pragma unroll
    for (int r = 0; r < 16; ++r) { const int orow = crow(r, hi);
#pragma unroll
        for (int d0 = 0; d0 < 2; ++d0) Ow[(size_t)orow * ldo + d0 * 32 + r32] = f2bf(o[d0][r] * rli[r]); }
    SBAR(); asm volatile("s_waitcnt vmcnt(0) lgkmcnt(0)\n\ts_barrier" ::: "memory"); SBAR();
#undef PP_DMA_K
#undef PP_DMA_V
#undef PP_M
#undef PP_S
}
}

__device__ __forceinline__ void retu_unit(int unit, const bf16_t* PR, float* U, float lg2f, float lg2b, LAS char* lds, const int wv) {
    const int tid = otid(wv), wid = __builtin_amdgcn_readfirstlane(tid >> 6), lane = tid & 63, r32 = lane & 31, hi = lane >> 5;
    const int h = unit & 3, bc = unit >> 2, bl = bc / NCHUNK, c = bc - bl * NCHUNK;
    const size_t r0 = (size_t)bl * SB + (size_t)c * 128;
    LAS char* Vt = lds;
    LAS char* Kf = lds + 32768;
    LAS char* Kb = lds + 49152;
#pragma unroll
    for (int i = 0; i < 2; ++i) { const int ch = tid + i * 512, j = ch >> 3, c8 = (ch & 7) * 8;
        const u32x4 kw = *(const u32x4*)(PR + (r0 + j) * 1536 + 256 + h * 64 + c8);
        float f[8], g[8]; unpack8(kw, f);
        const float wf = __builtin_amdgcn_exp2f(lg2f * (float)(127 - j)), wb = __builtin_amdgcn_exp2f(lg2b * (float)j);
#pragma unroll
        for (int k = 0; k < 8; ++k) { g[k] = f[k] * wb; f[k] *= wf; }
        const int off = (j >> 6) * 8192 + v_st<2>(j & 63, c8);
        *(LAS u32x4*)(Kf + off) = pack8(f); *(LAS u32x4*)(Kb + off) = pack8(g); }
#pragma unroll
    for (int i = 0; i < 4; ++i) { const int ch = tid + i * 512, j = ch >> 4, c8 = (ch & 15) * 8;
        const u32x4 vw = *(const u32x4*)(PR + (r0 + j) * 1536 + 512 + h * 128 + c8);
        *(LAS u32x4*)(Vt + (j >> 6) * 16384 + v_st<4>(j & 63, c8)) = vw; }
    __syncthreads();
    const int eblk = wid & 3, dblk = wid >> 2;
    const int vbV = (int)(size_t)Vt + v_rd_base(lane) + eblk * 512, vbF = (int)(size_t)Kf + v_rd_base(lane) + dblk * 512, vbB = (int)(size_t)Kb + v_rd_base(lane) + dblk * 512;
    f32x16 aF = {}, aB = {};
#define RU_STEP(SUB, KS) do { const bf16x8 a = tr_frag<4, KS>(vbV + SUB * 16384), bf = tr_frag<2, KS>(vbF + SUB * 8192), bb = tr_frag<2, KS>(vbB + SUB * 8192); \
        asm volatile("s_waitcnt lgkmcnt(0)" ::: "memory"); SBAR(); \
        aF = __builtin_amdgcn_mfma_f32_32x32x16_bf16(a, bf, aF, 0, 0, 0); aB = __builtin_amdgcn_mfma_f32_32x32x16_bf16(a, bb, aB, 0, 0, 0); } while (0)
    RU_STEP(0, 0); RU_STEP(0, 1); RU_STEP(0, 2); RU_STEP(0, 3); RU_STEP(1, 0); RU_STEP(1, 1); RU_STEP(1, 2); RU_STEP(1, 3);
#undef RU_STEP
    float* Uf = U + (size_t)unit * 2 * 8192; float* Ub = Uf + 8192;
#pragma unroll
    for (int r = 0; r < 16; ++r) { const int e = 32 * eblk + crow(r, hi), d = 32 * dblk + r32; Uf[e * 64 + d] = aF[r]; Ub[e * 64 + d] = aB[r]; }
    __syncthreads();
}

__device__ __forceinline__ void retout_unit(int unit, const bf16_t* PR, const bf16_t* S, const float* gnw, bf16_t* ACT, float lg2f, float lg2b, LAS char* lds, const int wv) {
    const int tid = otid(wv), wid = __builtin_amdgcn_readfirstlane(tid >> 6), lane = tid & 63, r32 = lane & 31, hi = lane >> 5;
    const int h = unit & 3, bc = unit >> 2, bl = bc / NCHUNK, c = bc - bl * NCHUNK;
    const size_t r0 = (size_t)bl * SB + (size_t)c * 128;
    LAS char* Vt = lds; LAS float* part = (LAS float*)(lds + 32768);
    const int qblk = wid & 3, ehalf = wid >> 2, iq = 32 * qblk + r32;
    u32x4 vw[4];
#pragma unroll
    for (int i = 0; i < 4; ++i) { const int ch = tid + i * 512, j = ch >> 4, c8 = (ch & 15) * 8; vw[i] = *(const u32x4*)(PR + (r0 + j) * 1536 + 512 + h * 128 + c8); }
    bf16x8 qf[4], kf[4][4];
    { const bf16_t* qp = PR + (r0 + iq) * 1536 + h * 64 + hi * 8;
#pragma unroll
      for (int d0 = 0; d0 < 4; ++d0) qf[d0] = *(const bf16x8*)(qp + d0 * 16); }
#pragma unroll
    for (int jb = 0; jb < 4; ++jb) { const bf16_t* kp = PR + (r0 + 32 * jb + r32) * 1536 + 256 + h * 64 + hi * 8;
#pragma unroll
        for (int d0 = 0; d0 < 4; ++d0) kf[jb][d0] = *(const bf16x8*)(kp + d0 * 16); }
    const int orow = tid >> 2, oc = (tid & 3) * 32;
    u32x4 gw[4];
#pragma unroll
    for (int k = 0; k < 4; ++k) gw[k] = *(const u32x4*)(PR + (r0 + orow) * 1536 + 1024 + h * 128 + oc + 8 * k);
#pragma unroll
    for (int i = 0; i < 4; ++i) { const int ch = tid + i * 512, j = ch >> 4, c8 = (ch & 15) * 8; *(LAS u32x4*)(Vt + (j >> 6) * 16384 + v_st<4>(j & 63, c8)) = vw[i]; }
    f32x16 o[2] = {};
    __syncthreads();
    bf16x8 sf[2][4], sb[2][4];
    { const bf16_t* Sf = S + (size_t)unit * 2 * 8192; const bf16_t* Sb = Sf + 8192;
#pragma unroll
      for (int e0 = 0; e0 < 2; ++e0) { const int e = 64 * ehalf + 32 * e0 + r32;
#pragma unroll
        for (int d0 = 0; d0 < 4; ++d0) { sf[e0][d0] = *(const bf16x8*)(Sf + e * 64 + d0 * 16 + hi * 8); sb[e0][d0] = *(const bf16x8*)(Sb + e * 64 + d0 * 16 + hi * 8); } } }
    const int vb = (int)(size_t)Vt + v_rd_base(lane) + ehalf * 1024;
#pragma unroll
    for (int jb = 0; jb < 4; ++jb) {
        f32x16 p = {};
#pragma unroll
        for (int d0 = 0; d0 < 4; ++d0) p = __builtin_amdgcn_mfma_f32_32x32x16_bf16(kf[jb][d0], qf[d0], p, 0, 0, 0);
#pragma unroll
        for (int r = 0; r < 16; ++r) { const int dj = iq - (32 * jb + crow(r, hi));
            const float e = dj >= 0 ? lg2f * (float)dj : lg2b * (float)(-dj); p[r] *= __builtin_amdgcn_exp2f(e); }
        bf16x8 pa0, pa1; PK4(p, 0, pa0); PK4(p, 8, pa1);
        const int vj = vb + (jb >> 1) * 16384;
        if (jb & 1) {
            const bf16x8 f00 = tr_frag<4, 2>(vj), f01 = tr_frag<4, 3>(vj), f10 = tr_frag<4, 2>(vj + 512), f11 = tr_frag<4, 3>(vj + 512);
            asm volatile("s_waitcnt lgkmcnt(0)" ::: "memory"); SBAR();
            o[0] = __builtin_amdgcn_mfma_f32_32x32x16_bf16(pa0, f00, o[0], 0, 0, 0); o[0] = __builtin_amdgcn_mfma_f32_32x32x16_bf16(pa1, f01, o[0], 0, 0, 0);
            o[1] = __builtin_amdgcn_mfma_f32_32x32x16_bf16(pa0, f10, o[1], 0, 0, 0); o[1] = __builtin_amdgcn_mfma_f32_32x32x16_bf16(pa1, f11, o[1], 0, 0, 0);
        } else {
            const bf16x8 f00 = tr_frag<4, 0>(vj), f01 = tr_frag<4, 1>(vj), f10 = tr_frag<4, 0>(vj + 512), f11 = tr_frag<4, 1>(vj + 512);
            asm volatile("s_waitcnt lgkmcnt(0)" ::: "memory"); SBAR();
            o[0] = __builtin_amdgcn_mfma_f32_32x32x16_bf16(pa0, f00, o[0], 0, 0, 0); o[0] = __builtin_amdgcn_mfma_f32_32x32x16_bf16(pa1, f01, o[0], 0, 0, 0);
            o[1] = __builtin_amdgcn_mfma_f32_32x32x16_bf16(pa0, f10, o[1], 0, 0, 0); o[1] = __builtin_amdgcn_mfma_f32_32x32x16_bf16(pa1, f11, o[1], 0, 0, 0);
        }
    }
    {
        const float xf = __builtin_amdgcn_exp2f(lg2f * (float)(iq + 1)), xb = __builtin_amdgcn_exp2f(lg2b * (float)(128 - iq));
#pragma unroll
        for (int d0 = 0; d0 < 4; ++d0) {
            float f[8], g[8]; unpack8(__builtin_bit_cast(u32x4, qf[d0]), f);
#pragma unroll
            for (int k = 0; k < 8; ++k) { g[k] = f[k] * xb; f[k] *= xf; }
            const bf16x8 qa = __builtin_bit_cast(bf16x8, pack8(f)), qb = __builtin_bit_cast(bf16x8, pack8(g));
#pragma unroll
            for (int e0 = 0; e0 < 2; ++e0) { o[e0] = __builtin_amdgcn_mfma_f32_32x32x16_bf16(qa, sf[e0][d0], o[e0], 0, 0, 0); o[e0] = __builtin_amdgcn_mfma_f32_32x32x16_bf16(qb, sb[e0][d0], o[e0], 0, 0, 0); }
        }
    }
    float sq[16];
#pragma unroll
    for (int r = 0; r < 16; ++r) { float s = o[0][r] * o[0][r] + o[1][r] * o[1][r];
        sq[r] = sum32(s); }
    if (r32 == 0) {
#pragma unroll
        for (int r = 0; r < 16; ++r) part[wid * 32 + crow(r, hi)] = sq[r];
    }
    __syncthreads();
    const float g0 = gnw[h * 128 + 64 * ehalf + r32], g1 = gnw[h * 128 + 64 * ehalf + 32 + r32];
    LAS bf16_t* stg = (LAS bf16_t*)Vt;
#pragma unroll
    for (int r = 0; r < 16; ++r) { const int il = crow(r, hi);
        const float tot = part[wid * 32 + il] + part[(wid ^ 4) * 32 + il];
        const float rn = rsqrtf(tot * (1.f / 128.f) + RMS_EPS);
        LAS bf16_t* sp = stg + (32 * qblk + il) * 128 + 64 * ehalf + r32;
        sp[0] = f2bf(o[0][r] * rn * g0); sp[32] = f2bf(o[1][r] * rn * g1); }
    __syncthreads();
#pragma unroll
    for (int k = 0; k < 4; ++k) { float y[8], g[8]; unpack8(*(const LAS u32x4*)(stg + orow * 128 + oc + 8 * k), y); unpack8(gw[k], g);
#pragma unroll
        for (int q = 0; q < 8; ++q) y[q] *= siluf_(g[q]);
        *(u32x4*)(ACT + (r0 + orow) * 1536 + h * 128 + oc + 8 * k) = pack8(y); }
    __syncthreads();
}
struct Args { const float* in[26]; float* out; unsigned char* ws; int ph_lo, ph_hi; };
struct Frame {
    LAS unsigned char* lds; int G, wv;
    const Args* a; float* out; unsigned char* ws;
};
__device__ __forceinline__ const float* in_ptr(const Args* a, int i) { int z; asm volatile("s_mov_b32 %0, 0" : "=s"(z)); return a->in[i + z]; }
#define INP(i) in_ptr(F.a, (i))
__device__ __forceinline__ unsigned char* ows(unsigned char* p) { asm volatile("" : "+s"(p)); return p; }
#ifdef SELFCHECK_ATTN
#define WSP(T, off) ((T*)(ows(F.ws) + (off)))
#else
#define WSP(T, off) ((T*)(F.ws + (off)))
#endif

__device__ __forceinline__ int srccol_in(int n) {
    if (n < 512) { const int base = n & ~255, hh = (n & 255) >> 6, p = n & 63; return base + hh * 64 + (p >> 1) + 32 * (p & 1); }
    if (n < 2048) return n;
    if (n < 3072) { const int j = (n - 2048) >> 1; return 2048 + j + 512 * (n & 1); }
    if (n < 3712) return n;
    if (n < 3744) { const int p = n - 3712, a = p >> 4, q = p & 15; return 3712 + a * 16 + (q >> 1) + 8 * (q & 1); }
    if (n < 3840) return -1;
    return n - 96;
}
__device__ __forceinline__ int srccol_uq(int n) { const int h = n / 96, d = n - h * 96; if (d < 64) return n; const int p = d - 64, a = p >> 4, q = p & 15; return h * 96 + 64 + a * 16 + (q >> 1) + 8 * (q & 1); }

__device__ __forceinline__ void cvt_item(const float* sp, int ldw, const float* scale, bf16_t* dst, int ldd, int n0, int k0, LAS float* scr, int lane) {
    float vv[32];
#pragma unroll
    for (int i = 0; i < 32; ++i) { const int kk = 2 * i + (lane >> 5); vv[i] = sp ? sp[(size_t)(k0 + kk) * ldw] : 0.f; }
    if (scale) {
#pragma unroll
        for (int i = 0; i < 32; ++i) vv[i] *= scale[k0 + 2 * i + (lane >> 5)];
    }
#pragma unroll
    for (int i = 0; i < 32; ++i) scr[(2 * i + (lane >> 5)) * 33 + (lane & 31)] = vv[i];
    asm volatile("s_waitcnt lgkmcnt(0)" ::: "memory");
    const int c = lane & 7;
#pragma unroll
    for (int j = 0; j < 4; ++j) { const int n = (lane >> 3) + 8 * j; const LAS float* s = scr + (8 * c) * 33 + n;
        u32x4 o; o.x = cvtpk(s[0 * 33], s[1 * 33]); o.y = cvtpk(s[2 * 33], s[3 * 33]); o.z = cvtpk(s[4 * 33], s[5 * 33]); o.w = cvtpk(s[6 * 33], s[7 * 33]);
        *(u32x4*)(dst + (size_t)(n0 + n) * ldd + k0 + 8 * c) = o; }
    asm volatile("s_waitcnt lgkmcnt(0)" ::: "memory");
}

__device__ __forceinline__ f32x2 cossin_f(float ang) {
    const double x = (double)ang * 0.15915494309189535; const float r = (float)(x - rint(x));
    return (f32x2){__builtin_amdgcn_cosf(r), __builtin_amdgcn_sinf(r)};
}
__device__ __forceinline__ float lg2_gamma(const float* rd) { return -__builtin_amdgcn_logf(1.f + __builtin_amdgcn_exp2f(-rd[0] * LOG2E)); }
#define PHASE_IDS const int tid = otid(F.wv), lane = tid & 63, wave = __builtin_amdgcn_readfirstlane(tid >> 6), bid = obid(); (void)lane; (void)wave; (void)bid;
__device__ __forceinline__ void p0_prologue(Frame& F) {
    PHASE_IDS
    __syncthreads();
    if (bid < 48) {
        LAS float* sc = (LAS float*)F.lds;
        LAS float* red = (LAS float*)(F.lds + 40960);
        for (int i = tid; i < 9 * 1024; i += 512) { const int v = i >> 10, k = i & 1023; const float x = v < 8 ? INP(1)[v * 1024 + k] : INP(3)[k]; sc[i] = siluf_(x); }
        __syncthreads();
        const int l = bid / 24, col = (bid % 24) * 256 + (tid & 255), kq = tid >> 8;
        const float* w = INP(4) + (size_t)l * 1024 * 6144 + col;
        float a[9];
#pragma unroll
        for (int v = 0; v < 9; ++v) a[v] = 0.f;
#pragma nounroll
        for (int k = kq * 512; k < kq * 512 + 512; k += 16) {
            float wv_[16];
#pragma unroll
            for (int j = 0; j < 16; ++j) wv_[j] = w[(size_t)(k + j) * 6144];
#pragma unroll
            for (int j4 = 0; j4 < 4; ++j4)
#pragma unroll
                for (int v = 0; v < 9; ++v) { const f32x4 s = *(const LAS f32x4*)(sc + v * 1024 + k + 4 * j4); a[v] += (s[0] * wv_[4 * j4] + s[1] * wv_[4 * j4 + 1]) + (s[2] * wv_[4 * j4 + 2] + s[3] * wv_[4 * j4 + 3]); }
        }
        if (kq == 1) {
#pragma unroll
            for (int v = 0; v < 9; ++v) red[v * 256 + (tid & 255)] = a[v];
        }
        __syncthreads();
        if (kq == 0) { float* MOD = WSP(float, WS_MOD) + (size_t)l * 9 * 6144; const float b = INP(5)[l * 6144 + col];
#pragma unroll
            for (int v = 0; v < 9; ++v) MOD[v * 6144 + col] = b + a[v] + red[v * 256 + tid]; }
        __syncthreads();
    }
    { f32x2* RT = WSP(f32x2, WS_RT); f32x2* MT = WSP(f32x2, WS_MT);
      for (int i = bid * 512 + tid; i < 8192 * 32 + 128 * 8; i += F.G * 512) {
          if (i < 8192 * 32) { const int t = i >> 5, k = i & 31; const float inv = exp2f(-(float)k * (13.287712379549449f / 32.f)); RT[i] = cossin_f((float)t * inv); }
          else { const int q = i - 8192 * 32, pos = q >> 3, k = q & 7; const float inv = exp2f(-(float)k * (13.287712379549449f / 8.f)); MT[q] = cossin_f((float)pos * inv); } } }
    LAS float* scr = (LAS float*)(F.lds + wave * 16384);
    const int gw = bid * 8 + wave, NGW = F.G * 8;
    constexpr int I_IN = 2 * 16 * 216, I_CAT = 2 * 3 * 8 * 32, I_OUT = 2 * 16 * 32, I_UQ = 2 * 6 * 24, I_UKV = 2 * 4 * 32, I_UP = 32 * 16 * 32, I_W2 = 32 * 8 * 32;
    constexpr int NITEMS = I_IN + I_CAT + I_OUT + I_UQ + I_UKV + I_UP + I_W2;
    for (int it = gw; it < NITEMS; it += NGW) {
        int r = it;
        if (r < I_IN) { const int l = r / 3456, q = r % 3456, kb = q / 216, nb = q % 216; const int sc_ = srccol_in(nb * 32 + (lane & 31));
            cvt_item(sc_ >= 0 ? INP(8) + (size_t)l * 1024 * INCOLS + sc_ : nullptr, INCOLS, nullptr, WSP(bf16_t, WS_WIN) + (size_t)l * INW * 1024, 1024, nb * 32, kb * 64, scr, lane); continue; } r -= I_IN;
        if (r < I_CAT) { const int l = r / 768, q = r % 768, seg = q / 256, q2 = q % 256, kb = q2 / 32, nb = q2 % 32; const float* W = seg == 0 ? INP(11) : (seg == 1 ? INP(13) : INP(18));
            cvt_item(W + (size_t)l * 512 * 1024 + nb * 32 + (lane & 31), 1024, nullptr, WSP(bf16_t, WS_WCAT) + (size_t)l * 1024 * 1536 + seg * 512, 1536, nb * 32, kb * 64, scr, lane); continue; } r -= I_CAT;
        if (r < I_OUT) { const int l = r / 512, q = r % 512, kb = q / 32, nb = q % 32;
            cvt_item(INP(19) + (size_t)l * 1024 * 1024 + nb * 32 + (lane & 31), 1024, nullptr, WSP(bf16_t, WS_WOUT) + (size_t)l * 1024 * 1024, 1024, nb * 32, kb * 64, scr, lane); continue; } r -= I_OUT;
        if (r < I_UQ) { const int l = r / 144, q = r % 144, kb = q / 24, nb = q % 24;
            cvt_item(INP(15) + (size_t)l * 384 * 768 + srccol_uq(nb * 32 + (lane & 31)), 768, INP(14) + l * 384, WSP(bf16_t, WS_WUQ) + (size_t)l * 768 * 384, 384, nb * 32, kb * 64, scr, lane); continue; } r -= I_UQ;
        if (r < I_UKV) { const int l = r / 128, q = r % 128, kb = q / 32, nb = q % 32;
            cvt_item(INP(17) + (size_t)l * 256 * 1024 + nb * 32 + (lane & 31), 1024, INP(16) + l * 256, WSP(bf16_t, WS_WUKV) + (size_t)l * 1024 * 256, 256, nb * 32, kb * 64, scr, lane); continue; } r -= I_UKV;
        if (r < I_UP) { const int le = r / 512, q = r % 512, kb = q / 32, nb = q % 32; const int n = nb * 32 + (lane & 31);
            const float* W = (n & 1) ? INP(23) : INP(22);
            cvt_item(W + (size_t)le * 1024 * 512 + (n >> 1), 512, nullptr, WSP(bf16_t, WS_WUP) + (size_t)le * 1024 * 1024, 1024, nb * 32, kb * 64, scr, lane); continue; } r -= I_UP;
        { const int le = r / 256, q = r % 256, kb = q / 32, nb = q % 32;
            cvt_item(INP(24) + (size_t)le * 512 * 1024 + nb * 32 + (lane & 31), 1024, nullptr, WSP(bf16_t, WS_W2T) + (size_t)le * 1024 * 512, 512, nb * 32, kb * 64, scr, lane); }
    }
}

__device__ __forceinline__ void norm1_phase(Frame& F, const Resid& R, int l, int skip_none) {
    PHASE_IDS
    const int gw = bid * 8 + wave, NGW = F.G * 8; bf16_t* HX = WSP(bf16_t, WS_HX);
    const float* MODL = WSP(float, WS_MOD) + (size_t)l * 9 * 6144; const float* nw = INP(6) + l * 1024;
    for (int row = gw; row < NT; row += NGW) {
        const float* md = MODL + R.modv(row) * 6144;
        f32x4 v[4]; float s = 0.f;
        int sf32 = R.src_f32; asm volatile("" : "+s"(sf32));
        if (sf32) { const f32x4* xr = (const f32x4*)R.srcf(row) + lane;
#pragma unroll
            for (int j = 0; j < 4; ++j) v[j] = xr[64 * j]; }
        else { const u32x2* xr = (const u32x2*)R.dst(row) + lane;
#pragma unroll
            for (int j = 0; j < 4; ++j) { const u32x2 w = xr[64 * j]; v[j] = (f32x4){bf_lo(w.x), bf_hi(w.x), bf_lo(w.y), bf_hi(w.y)}; } }
#pragma unroll
        for (int j = 0; j < 4; ++j) s += (v[j][0] * v[j][0] + v[j][1] * v[j][1]) + (v[j][2] * v[j][2] + v[j][3] * v[j][3]);
        const float rs = rsqrtf(wave_sum(s) * (1.f / DM) + RMS_EPS);
#pragma unroll
        for (int j = 0; j < 4; ++j) { const int c = 4 * lane + 256 * j; const f32x4 w = *(const f32x4*)(nw + c), sh = *(const f32x4*)(md + c), sc = *(const f32x4*)(md + 1024 + c);
            const f32x4 y = v[j] * rs * w * (sc + 1.f) + sh; u32x2 o; o.x = cvtpk(y[0], y[1]); o.y = cvtpk(y[2], y[3]); *(u32x2*)(HX + (size_t)row * 1024 + c) = o; }
    }
}
__device__ __forceinline__ void final_norm_phase(Frame& F, int g) {
    PHASE_IDS
    const int gw = bid * 8 + wave, NGW = F.G * 8; const float* nw = INP(25);
    for (int row = gw; row < GB * SEQ; row += NGW) {
        f32x4* xr = (f32x4*)(F.out + ((size_t)g * GB * SEQ + row) * DM) + lane;
        const u32x2* xb = (const u32x2*)(WSP(bf16_t, WS_XRES) + ((size_t)g * GB * SEQ + row) * DM) + lane;
        f32x4 v[4]; float s = 0.f;
#pragma unroll
        for (int j = 0; j < 4; ++j) { const u32x2 w = xb[64 * j]; v[j] = (f32x4){bf_lo(w.x), bf_hi(w.x), bf_lo(w.y), bf_hi(w.y)}; s += (v[j][0] * v[j][0] + v[j][1] * v[j][1]) + (v[j][2] * v[j][2] + v[j][3] * v[j][3]); }
        const float rs = rsqrtf(wave_sum(s) * (1.f / DM) + RMS_EPS);
#pragma unroll
        for (int j = 0; j < 4; ++j) { const f32x4 w = *(const f32x4*)(nw + 4 * lane + 256 * j); xr[64 * j] = v[j] * rs * w; }
    }
}
__device__ __forceinline__ void conv_phase(Frame& F, int l) {
    PHASE_IDS
    const bf16_t* PC = WSP(bf16_t, WS_PC); bf16_t* ACT = WSP(bf16_t, WS_ACT); const float* cw = INP(12) + (size_t)l * 512 * 3;
    for (int idx = bid * 512 + tid; idx < NT * 64; idx += F.G * 512) {
        const int row = idx >> 6, c8 = (idx & 63) * 8; const int bl = row / SB, s = row - bl * SB;
        const bool hp = (s != 0) && (s != CTXL), hn = (s != CTXL - 1) && (s != SB - 1);
        const bf16_t* p = PC + (size_t)row * 1024 + c8;
        float b[8], u0[8], um[8], up[8];
        unpack8(*(const u32x4*)p, b); unpack8(*(const u32x4*)(p + 512), u0);
        if (hp) unpack8(*(const u32x4*)(p + 512 - 1024), um); else {
#pragma unroll
            for (int k = 0; k < 8; ++k) um[k] = 0.f; }
        if (hn) unpack8(*(const u32x4*)(p + 512 + 1024), up); else {
#pragma unroll
            for (int k = 0; k < 8; ++k) up[k] = 0.f; }
        float o[8];
#pragma unroll
        for (int k = 0; k < 8; ++k) { const float* w = cw + (c8 + k) * 3; o[k] = b[k] * (um[k] * w[0] + u0[k] * w[1] + up[k] * w[2]); }
        *(u32x4*)(ACT + (size_t)row * 1536 + 512 + c8) = pack8(o);
    }
}
__device__ __forceinline__ void scan_phase(Frame& F, int l) {
    PHASE_IDS
    const float* U = WSP(float, WS_HX); bf16_t* S = WSP(bf16_t, WS_PM);
    for (int idx = bid * 512 + tid; idx < GB * 4 * 2 * 8192; idx += F.G * 512) {
        const int ed = idx & 8191, dir = (idx >> 13) & 1, h = (idx >> 14) & 3, bl = idx >> 16;
        const float lg = lg2_gamma(INP(9) + l * 8 + dir * 4 + h); const float dec = __builtin_amdgcn_exp2f(lg * 128.f);
        float st = 0.f;
        for (int i0 = 0; i0 < NCHUNK; i0 += 6) {
            float uu[6]; size_t off[6];
#pragma unroll
            for (int k = 0; k < 6; ++k) { const int i = i0 + k; const int c = dir ? (i < 2 ? 1 - i : NCHUNK + 1 - i) : i;
                off[k] = ((size_t)(((bl * NCHUNK + c) * 4 + h) * 2 + dir)) * 8192 + ed; uu[k] = U[off[k]]; }
#pragma unroll
            for (int k = 0; k < 6; ++k) { S[off[k]] = f2bf(st); st = dec * st + uu[k]; }
        }
    }
}
template <int NR>
__device__ __forceinline__ void n2_rows(const Resid& R, const int (&rows)[NR], const int (&slot)[NR], const float* MODL, const float* nw, bf16_t* H2, const LAS float* wr, LAS float* lg, int lane) {
    f32x4 v[NR][4]; float s[NR];
#pragma unroll
    for (int q = 0; q < NR; ++q) { const u32x2* xr = (const u32x2*)R.dst(rows[q]) + lane; s[q] = 0.f;
#pragma unroll
        for (int j = 0; j < 4; ++j) { const u32x2 w_ = xr[64 * j]; v[q][j] = (f32x4){bf_lo(w_.x), bf_hi(w_.x), bf_lo(w_.y), bf_hi(w_.y)}; s[q] += (v[q][j][0] * v[q][j][0] + v[q][j][1] * v[q][j][1]) + (v[q][j][2] * v[q][j][2] + v[q][j][3] * v[q][j][3]); } }
#pragma unroll
    for (int q = 0; q < NR; ++q) s[q] = rsqrtf(wave_sum(s[q]) * (1.f / DM) + RMS_EPS);
#pragma unroll
    for (int q = 0; q < NR; ++q) { const float* md = MODL + R.modv(rows[q]) * 6144;
#pragma unroll
        for (int j = 0; j < 4; ++j) { const int c = 4 * lane + 256 * j; const f32x4 w = *(const f32x4*)(nw + c), sh = *(const f32x4*)(md + 3072 + c), sc = *(const f32x4*)(md + 4096 + c);
            v[q][j] = v[q][j] * s[q] * w * (sc + 1.f) + sh; u32x2 o; o.x = cvtpk(v[q][j][0], v[q][j][1]); o.y = cvtpk(v[q][j][2], v[q][j][3]); *(u32x2*)(H2 + (size_t)rows[q] * 1024 + c) = o; } }
    const int b4 = (lane >> 4) & 1, b3 = (lane >> 3) & 1, b2 = (lane >> 2) & 1;
#pragma unroll
    for (int q = 0; q < NR; ++q) {
        float a[16];
#pragma unroll
        for (int e = 0; e < 16; ++e) { float t = 0.f;
#pragma unroll
            for (int j = 0; j < 4; ++j) { const f32x4 w = *(const LAS f32x4*)(wr + e * 1024 + 4 * lane + 256 * j); t += (v[q][j][0] * w[0] + v[q][j][1] * w[1]) + (v[q][j][2] * w[2] + v[q][j][3] * w[3]); }
            a[e] = t; }
        float s8[8], s4[4], s2[2];
#pragma unroll
        for (int k = 0; k < 8; ++k) { auto r = __builtin_amdgcn_permlane32_swap(__float_as_uint(a[k]), __float_as_uint(a[k + 8]), false, false); s8[k] = __uint_as_float(r[0]) + __uint_as_float(r[1]); }
#pragma unroll
        for (int k = 0; k < 4; ++k) { const float snd = b4 ? s8[k] : s8[k + 4], kp = b4 ? s8[k + 4] : s8[k]; s4[k] = kp + swz_xor<16>(snd); }
#pragma unroll
        for (int k = 0; k < 2; ++k) { const float snd = b3 ? s4[k] : s4[k + 2], kp = b3 ? s4[k + 2] : s4[k]; s2[k] = kp + swz_xor<8>(snd); }
        float s1; { const float snd = b2 ? s2[0] : s2[1], kp = b2 ? s2[1] : s2[0]; s1 = kp + swz_xor<4>(snd); }
        s1 += swz_xor<2>(s1); s1 += swz_xor<1>(s1);
        if ((lane & 3) == 0) lg[slot[q] * 16 + (lane >> 2)] = s1;
    }
}
__device__ __forceinline__ void norm2_router_phase(Frame& F, const Resid& R, int l, int g, int lat_only, int cslot) {
    PHASE_IDS
    bf16_t* H2 = WSP(bf16_t, WS_HX);
    const float* MODL = WSP(float, WS_MOD) + (size_t)l * 9 * 6144; const float* nw = INP(7) + l * 1024;
    LAS float* wr = (LAS float*)F.lds; LAS float* lg = (LAS float*)(F.lds + 65536);
    { const float* wrt = INP(20); for (int i = tid; i < 16 * 1024; i += 512) wr[i] = wrt[(i & 1023) * 16 + (i >> 10)]; }
    __syncthreads();
    const int rpb = (NT + F.G - 1) / F.G, r0 = bid * rpb, r1 = (r0 + rpb < NT) ? r0 + rpb : NT;
    for (int row = r0 + wave; row < r1; row += 16) {
        const int rowb = row + 8;
        const bool okA = !(lat_only && (row % SB) < CTXL), okB = rowb < r1 && !(lat_only && (rowb % SB) < CTXL);
        if (okA && okB) { const int rr[2] = {row, rowb}, ss[2] = {row - r0, rowb - r0}; n2_rows<2>(R, rr, ss, MODL, nw, H2, wr, lg, lane); }
        else if (okA) { const int rr[1] = {row}, ss[1] = {row - r0}; n2_rows<1>(R, rr, ss, MODL, nw, H2, wr, lg, lane); }
        else if (okB) { const int rr[1] = {rowb}, ss[1] = {rowb - r0}; n2_rows<1>(R, rr, ss, MODL, nw, H2, wr, lg, lane); }
    }
    __syncthreads();
    unsigned* CNT = WSP(unsigned, WS_CTL) + CW_CNT + (g * 2 + l) * 64 + cslot; int* LIST = WSP(int, WS_LIST); float* WGT = WSP(float, WS_WGT);
    const float* rb = INP(21);
    LAS unsigned* lcnt = (LAS unsigned*)(F.lds + 65536 + 16384);
    if (tid < 64) lcnt[tid] = 0u;
    __syncthreads();
    int bucket = -1, rank = 0; float wlo = 0.f, whi = 0.f; const int trow = r0 + tid;
    if (tid < r1 - r0 && !(lat_only && (trow % SB) < CTXL)) {
        const int t = tid;
        float sc16[16];
#pragma unroll
        for (int e4 = 0; e4 < 4; ++e4) { const f32x4 x = *(const LAS f32x4*)(lg + t * 16 + e4 * 4); sc16[e4 * 4] = sigmoidf_(x[0]); sc16[e4 * 4 + 1] = sigmoidf_(x[1]); sc16[e4 * 4 + 2] = sigmoidf_(x[2]); sc16[e4 * 4 + 3] = sigmoidf_(x[3]); }
        float best = -1e30f; int gs = 0;
#pragma unroll
        for (int q = 0; q < 4; ++q) { float m1 = -1e30f, m2 = -1e30f;
#pragma unroll
            for (int k = 0; k < 4; ++k) { const float b = sc16[q * 4 + k] + rb[q * 4 + k]; if (b > m1) { m2 = m1; m1 = b; } else if (b > m2) m2 = b; }
            const float gsc = m1 + m2; if (gsc > best) { best = gsc; gs = q; } }
        float bb[4], su[4];
#pragma unroll
        for (int k = 0; k < 4; ++k) { float b = 0.f, u = 0.f;
#pragma unroll
            for (int q = 0; q < 4; ++q) { if (q == gs) { b = sc16[q * 4 + k] + rb[q * 4 + k]; u = sc16[q * 4 + k]; } }
            bb[k] = b; su[k] = u; }
        int i1 = 0; float b1 = bb[0];
#pragma unroll
        for (int k = 1; k < 4; ++k) if (bb[k] > b1) { b1 = bb[k]; i1 = k; }
        int i2 = -1; float b2 = -1e30f;
#pragma unroll
        for (int k = 0; k < 4; ++k) if (k != i1 && bb[k] > b2) { b2 = bb[k]; i2 = k; }
        const int lo = i1 < i2 ? i1 : i2, hi = i1 < i2 ? i2 : i1;
        float slo = 0.f, shi = 0.f;
#pragma unroll
        for (int k = 0; k < 4; ++k) { if (k == lo) slo = su[k]; if (k == hi) shi = su[k]; }
        const float inv = 1.f / (slo + shi);
        const int pair = lo == 0 ? hi - 1 : (lo == 1 ? hi + 1 : 5);
        bucket = gs * 6 + pair; wlo = slo * inv; whi = shi * inv;
        rank = (int)atomicAdd((unsigned*)(lcnt + bucket), 1u);
    }
    __syncthreads();
    if (tid < NPAIR) { const unsigned c = lcnt[tid]; lcnt[32 + tid] = c ? atomicAdd(CNT + tid, c) : 0u; }
    __syncthreads();
    if (bucket >= 0) { const unsigned pos = lcnt[32 + bucket] + (unsigned)rank; LIST[(size_t)bucket * NT + pos] = trow; WGT[(size_t)trow * 2] = wlo; WGT[(size_t)trow * 2 + 1] = whi; }
    __syncthreads();
}
__device__ __forceinline__ void moe_tables(Frame& F, int l, int g) {
    PHASE_IDS
    LAS int* tab = (LAS int*)(F.lds + LDS_MOE_OFF);
    if (tid < 32) { const unsigned* CNT = WSP(unsigned, WS_CTL) + CW_CNT + (g * 2 + l) * 64;
        tab[32 + tid] = tid < NPAIR ? (int)__hip_atomic_load(CNT + tid, __ATOMIC_RELAXED, __HIP_MEMORY_SCOPE_AGENT) : 0; }
    __syncthreads();
    if (tid == 0) { int pre = 0;
#pragma nounroll
        for (int p = 0; p < NPAIR; ++p) { tab[p] = pre; pre += (tab[32 + p] + 255) >> 8; }
        tab[24] = pre; }
    __syncthreads();
}
#ifndef PHMASK
#define PHMASK 0xFFFF
#endif
#define PHM(k) (((PHMASK) >> (k)) & 1)
#ifndef INPROJ_ALIGN
#define INPROJ_ALIGN true
#endif
#ifndef REPMASK
#define REPMASK 0
#endif
#define REPS(k) _Pragma("nounroll") for (int rep_ = 0; rep_ < 1 + (((REPMASK) >> (k)) & 1); ++rep_)

__global__ void __launch_bounds__(512, 2) dit_fwd(Args args) {
    extern __shared__ __attribute__((aligned(16))) unsigned char lds_raw[];
    Frame F;
    F.lds = (LAS unsigned char*)lds_raw;
    F.G = gridDim.x; F.wv = __builtin_amdgcn_readfirstlane((int)threadIdx.x >> 6);
    F.a = &args; F.out = args.out; F.ws = args.ws;
    for (int u = threadIdx.x; u < (LDS_BYTES - LDSCTL_OFF) / 4; u += 512) ((LAS unsigned*)(F.lds + LDSCTL_OFF))[u] = 0u;
    __syncthreads();
    XcdBarrier bar = xcd_barrier_post(WSP(unsigned, WS_CTL) + CW_BAR, (volatile LAS unsigned*)(F.lds + LDSCTL_OFF));
#ifdef PROBE_BAR2
#define GRID_BAR() do { asm volatile("; PHASE_SEAM" ::: "memory"); xcd_barrier(bar, F.wv); xcd_barrier(bar, F.wv); } while (0)
#else
#define GRID_BAR() do { asm volatile("; PHASE_SEAM" ::: "memory"); xcd_barrier(bar, F.wv); } while (0)
#endif
#ifdef PROBE_A
#define STAMP(k) do { if (obid() == 0 && F.wv == 0 && olane() == 0) { unsigned long long* TS_ = WSP(unsigned long long, WS_CTL + 512 * 1024); const unsigned long long now = __builtin_amdgcn_s_memrealtime(); TS_[(k)] += now - TS_[32]; TS_[32] = now; } } while (0)
    if (blockIdx.x == 0 && threadIdx.x == 0) WSP(unsigned long long, WS_CTL + 512 * 1024)[32] = __builtin_amdgcn_s_memrealtime();
#else
#define STAMP(k) do { } while (0)
#endif

    if constexpr (PHM(0)) REPS(0) p0_prologue(F);
    GRID_BAR(); STAMP(0);

#pragma nounroll
    for (int g = 0; g < NG; ++g) {
#pragma nounroll
        for (int l = 0; l < DEPTH; ++l) {
            Resid R; R.in_lat = INP(0); R.in_ctx = INP(2); R.x_lat = WSP(bf16_t, WS_XRES); R.x_ctx = WSP(bf16_t, WS_XC); R.g = g; R.src_f32 = (l == 0) ? 1 : 0;
            const float* MODL = WSP(float, WS_MOD) + (size_t)l * 9 * 6144;
            const int lat_only = (l == DEPTH - 1) ? 1 : 0;

            if constexpr (PHM(1)) REPS(1) norm1_phase(F, R, l, 0);
            if constexpr (PHM(15)) if (l == 0 && g > 0) final_norm_phase(F, g - 1);
            GRID_BAR(); STAMP(1);

            if constexpr (PHM(2)) REPS(2) {
#ifdef STAGGER_US10
                {
                    const unsigned long long t0_ = __builtin_amdgcn_s_memrealtime(), d_ = (unsigned long long)((obid() * 5) & 15) * (STAGGER_US10) * 10ull;
                    while (__builtin_amdgcn_s_memrealtime() - t0_ < d_) __builtin_amdgcn_s_sleep(4);
                }
#endif
                TileOrder S; S.init(NRT, INW / 256, F.G, obid(), WSP(bf16_t, WS_HX), (size_t)256 * 1024 * 2, WSP(bf16_t, WS_WIN) + (size_t)l * INW * 1024, (size_t)256 * 1024 * 2, 0);
#ifdef PROBE_INPROJ_STOREONLY
                { EpiStoreOnly E0{WSP(bf16_t, WS_PG)}; pg8::gemm_phase<EpiStoreOnly, TileOrder, true>(F.lds, 1024, 1024, 1024, 0, S, E0, F.wv); }
#endif
#ifdef PROBE_INPROJ_NOEPI
                { EpiNone E0{WSP(float, WS_SSQ)}; pg8::gemm_phase<EpiNone, TileOrder, true>(F.lds, 1024, 1024, 1024, 0, S, E0, F.wv); }
#endif
                EpiInproj E{WSP(bf16_t, WS_PR), WSP(bf16_t, WS_PC), WSP(bf16_t, WS_PM), WSP(bf16_t, WS_PG), WSP(unsigned char, WS_K), WSP(float, WS_SSQ), WSP(f32x2, WS_RT), WSP(f32x2, WS_MT)};
                pg8::gemm_phase<EpiInproj, TileOrder, INPROJ_ALIGN>(F.lds, 1024, 1024, 1024, 0, S, E, F.wv);
            }
            GRID_BAR(); STAMP(2);

            if constexpr (PHM(3)) REPS(3) {
                TileOrder S; S.init(NRT, 3, F.G, obid(), WSP(bf16_t, WS_PM), (size_t)256 * 640 * 2, WSP(bf16_t, WS_WUQ) + (size_t)l * 768 * 384, (size_t)256 * 384 * 2, 0);
                EpiUq E{WSP(unsigned char, WS_Q), WSP(float, WS_SSQ), WSP(f32x2, WS_MT)};
                pg8::gemm_phase<EpiUq, TileOrder, true>(F.lds, 640, 384, 384, 0, S, E, F.wv);
            }
#ifndef PROBE_COARSE
            STAMP(3);
#endif
            if constexpr (PHM(4)) REPS(4) {
                TileOrder S; S.init(NRT, 4, F.G, (obid() + F.G - (NRT * 3) % F.G) % F.G, WSP(bf16_t, WS_PM) + 384, (size_t)256 * 640 * 2, WSP(bf16_t, WS_WUKV) + (size_t)l * 1024 * 256, (size_t)256 * 256 * 2, 0);
                EpiUkv E{WSP(unsigned char, WS_K), WSP(unsigned char, WS_V), WSP(float, WS_SSQ), F.lds + LDS_VTR_OFF};
                pg8::gemm_phase<EpiUkv, TileOrder, true>(F.lds, 640, 256, 256, 0, S, E, F.wv);
            }
#ifndef PROBE_COARSE
            STAMP(4);
#endif
            if constexpr (PHM(5)) REPS(5) for (int u = (obid() + F.G - (NRT * 7) % F.G) % F.G; u < GB * NCHUNK * 4; u += F.G) {
                const int h = u & 3;
                retu_unit(u, WSP(bf16_t, WS_PR), WSP(float, WS_HX), lg2_gamma(INP(9) + l * 8 + h), lg2_gamma(INP(9) + l * 8 + 4 + h), (LAS char*)F.lds, F.wv);
            }
#ifndef PROBE_COARSE
            STAMP(5);
#endif
            if constexpr (PHM(6)) REPS(6) conv_phase(F, l);
            GRID_BAR(); STAMP(6);

            if constexpr (PHM(7)) REPS(7) scan_phase(F, l);
#ifndef PROBE_COARSE
            STAMP(7);
#endif
#ifdef PROBE_CLK
            unsigned long long c0_ = 0, r0_ = 0; if (g == 0 && l == 0) { c0_ = __builtin_readcyclecounter(); r0_ = __builtin_amdgcn_s_memrealtime(); }
#endif
            if constexpr (PHM(8)) REPS(8) {
                const unsigned char* Q = WSP(unsigned char, WS_Q); const unsigned char* K = WSP(unsigned char, WS_K); const unsigned char* V = WSP(unsigned char, WS_V); bf16_t* ACT = WSP(bf16_t, WS_ACT);
                const int vcu = (obid() % 8) * (F.G / 8) + obid() / 8, xcd = vcu / (F.G / 8), slot = vcu % (F.G / 8);
                const int nlat = GB * 8 * 32, nunit = nlat + (lat_only ? 0 : GB * 8);
                for (int i = 0; ; ++i) {
                    int hh, qb;
                    if (F.G == 256) { if (i < 4) { hh = xcd + 8 * i; qb = 1 + slot; } else if (i == 4 && !lat_only && slot < 4) { hh = xcd + 8 * slot; qb = 0; } else break; }
                    else { const int L = i * F.G + obid(); if (L >= nunit) break; if (L < nlat) { hh = L >> 5; qb = 1 + (L & 31); } else { hh = L - nlat; qb = 0; } }
                    const int bl = hh >> 3, h = hh & 7;
                    const size_t hb = (size_t)(bl * 8 + h) * SB;
                    att2::attn_unit_pp(Q + (hb + (size_t)qb * 256) * 128, K + hb * 128, V + (size_t)(bl * 8 + h) * 64 * SB, ACT + ((size_t)bl * SB + (size_t)qb * 256) * 1536 + 1024 + h * 64, 1536, qb == 0 ? CTXL : SB, (LAS char*)F.lds, F.wv);
                }
            }
#ifdef PROBE_CLK
            if (g == 0 && l == 0 && obid() == 0 && F.wv == 0 && olane() == 0) { const unsigned long long c1_ = __builtin_readcyclecounter(), r1_ = __builtin_amdgcn_s_memrealtime();
                WSP(unsigned long long, WS_CTL + 600 * 1024)[0] = (c1_ - c0_) * 100ull / (r1_ - r0_); }
#endif
            GRID_BAR(); STAMP(8);

            if constexpr (PHM(9)) REPS(9) for (int u = obid(); u < GB * NCHUNK * 4; u += F.G) {
                const int h = u & 3;
                retout_unit(u, WSP(bf16_t, WS_PR), WSP(bf16_t, WS_PM), INP(10) + l * 512, WSP(bf16_t, WS_ACT), lg2_gamma(INP(9) + l * 8 + h), lg2_gamma(INP(9) + l * 8 + 4 + h), (LAS char*)F.lds, F.wv);
            }
            GRID_BAR(); STAMP(9);

            if constexpr (PHM(10)) REPS(10) {
#ifdef MERGE1_STAGGER
                {
                    const unsigned long long t0_ = __builtin_amdgcn_s_memrealtime(), d_ = (unsigned long long)((obid() >> 3) & 3) * (MERGE1_STAGGER) * 10ull;
                    while (__builtin_amdgcn_s_memrealtime() - t0_ < d_) __builtin_amdgcn_s_sleep(4);
                }
#endif
                TileOrder S; S.init(lat_only ? GB * 32 : NRT, 4, F.G, obid(), WSP(bf16_t, WS_ACT), (size_t)256 * 1536 * 2, WSP(bf16_t, WS_WCAT) + (size_t)l * 1024 * 1536, (size_t)256 * 1536 * 2, lat_only);
#ifdef PROBE_MERGE1_NOHOOK
                { EpiMerge1NoHook E0{{WSP(bf16_t, WS_PG), WSP(bf16_t, WS_HX)}}; pg8::gemm_phase<EpiMerge1NoHook, TileOrder, true>(F.lds, 1536, 1536, 1536, 0, S, E0, F.wv); }
#endif
#ifdef PROBE_MERGE1_HOOKONLY
                { EpiMerge1HookOnly E0{{WSP(bf16_t, WS_PG), WSP(bf16_t, WS_HX)}, WSP(float, WS_SSQ)}; pg8::gemm_phase<EpiMerge1HookOnly, TileOrder, true>(F.lds, 1536, 1536, 1536, 0, S, E0, F.wv); }
#endif
#ifdef PROBE_MERGE1_NOEPI
                { EpiNone E0{WSP(float, WS_SSQ)}; pg8::gemm_phase<EpiNone, TileOrder, true>(F.lds, 1536, 1536, 1536, 0, S, E0, F.wv); }
#endif
                EpiMerge1 E{WSP(bf16_t, WS_PG), WSP(bf16_t, WS_HX)};
                pg8::gemm_phase<EpiMerge1, TileOrder, true>(F.lds, 1536, 1536, 1536, 0, S, E, F.wv);
            }
            GRID_BAR(); STAMP(10);

            if constexpr (PHM(11)) _Pragma("nounroll") for (int rep_ = 0; rep_ < 1 + ((((REPMASK) >> 11) & 1) && l == 0 ? 1 : 0); ++rep_) {
                TileOrder S; S.init(lat_only ? GB * 32 : NRT, 4, F.G, obid(), WSP(bf16_t, WS_HX), (size_t)256 * 1024 * 2, WSP(bf16_t, WS_WOUT) + (size_t)l * 1024 * 1024, (size_t)256 * 1024 * 2, lat_only);
                EpiMerge2 E{R, MODL};
                pg8::gemm_phase<EpiMerge2, TileOrder, true>(F.lds, 1024, 1024, 1024, 0, S, E, F.wv);
            }
            GRID_BAR(); STAMP(11);

            if constexpr (((REPMASK) >> 12) & 1) norm2_router_phase(F, R, l, g, lat_only, 32);
            if constexpr (PHM(12)) norm2_router_phase(F, R, l, g, lat_only, 0);
            GRID_BAR(); STAMP(12);

            moe_tables(F, l, g);
            if constexpr (PHM(13)) REPS(13) {
                MoeOrder S{(const LAS int*)(F.lds + LDS_MOE_OFF), WSP(int, WS_LIST), 8, F.G, obid(), 1, (const char*)WSP(bf16_t, WS_HX), (const char*)(WSP(bf16_t, WS_WUP) + (size_t)l * 16 * 1024 * 1024)};
                EpiMoeUp E{WSP(int, WS_LIST), WSP(float, WS_WGT), WSP(bf16_t, WS_PG)};
                pg8::gemm_phase<EpiMoeUp, MoeOrder, true, true, false>(F.lds, 1024, 1024, 1024, 0, S, E, F.wv);
            }
            GRID_BAR(); STAMP(13);

            if constexpr (PHM(14)) {
                MoeOrder S{(const LAS int*)(F.lds + LDS_MOE_OFF), WSP(int, WS_LIST), 4, F.G, obid(), 0, (const char*)WSP(bf16_t, WS_PG), (const char*)(WSP(bf16_t, WS_W2T) + (size_t)l * 16 * 1024 * 512)};
                if constexpr (((REPMASK) >> 14) & 1) { EpiMoeDown E0{WSP(int, WS_LIST), R, MODL, WSP(bf16_t, WS_Q)}; pg8::gemm_phase<EpiMoeDown, MoeOrder, true, false, true>(F.lds, 1024, 512, 1024, 8, S, E0, F.wv); }
                EpiMoeDown E{WSP(int, WS_LIST), R, MODL, nullptr};
                pg8::gemm_phase<EpiMoeDown, MoeOrder, true, false, true>(F.lds, 1024, 512, 1024, 8, S, E, F.wv);
            }
            GRID_BAR(); STAMP(14);
        }
    }
    if constexpr (PHM(15)) final_norm_phase(F, NG - 1);
#ifdef SELFCHECK_ATTN
            {
                const unsigned char* Q = WSP(unsigned char, WS_Q); const unsigned char* K = WSP(unsigned char, WS_K); const unsigned char* V = WSP(unsigned char, WS_V); const bf16_t* ACT = WSP(bf16_t, WS_ACT);
                const int lane_ = olane(); const int gwv = obid() * 8 + F.wv;
                if (gwv < 96) {
                    const int bl = gwv & 3, h = (gwv >> 2) & 7, qi = gwv >> 5;
                    const int srow = qi == 0 ? 256 : (qi == 1 ? 256 + 4099 : SB - 1);
                    const int nkeys = srow < CTXL ? CTXL : SB;
                    const size_t hb = (size_t)(bl * 8 + h) * SB;
                    #define F8(p) (__builtin_amdgcn_cvt_f32_fp8((int)(*(p)), 0))
                    const float q0 = F8(Q + (hb + srow) * 128 + lane_) * (1.f / Q8S), q1 = lane_ < 32 ? F8(Q + (hb + srow) * 128 + 64 + lane_) * (1.f / Q8S) : 0.f;
                    float mrun = -1e30f, lrun = 0.f, orun = 0.f;
#pragma nounroll
                    for (int j = 0; j < nkeys; ++j) {
                        float part = q0 * F8(K + (hb + j) * 128 + lane_) * (1.f / K8S); if (lane_ < 32) part += q1 * F8(K + (hb + j) * 128 + 64 + lane_) * (1.f / K8S);
                        const float s = wave_sum(part);
                        const float mn = fmaxf(mrun, s), sc = exp2f(mrun - mn), p = exp2f(s - mn);
                        lrun = lrun * sc + p; orun = orun * sc + p * F8(V + ((size_t)(bl * 8 + h) * 64 + lane_) * SB + (j & ~63) + vt_pos(j & 63)) * (1.f / V8S); mrun = mn; }
                    const float o_ = orun / lrun; const float got = bf1(ACT[((size_t)bl * SB + srow) * 1536 + 1024 + h * 64 + lane_]);
                    float err = fabsf(o_ - got), ref = fabsf(o_);
                    err = fmaxf(err, swz_xor<1>(err)); err = fmaxf(err, swz_xor<2>(err)); err = fmaxf(err, swz_xor<4>(err)); err = fmaxf(err, swz_xor<8>(err)); err = fmaxf(err, swz_xor<16>(err));
                    ref = fmaxf(ref, swz_xor<1>(ref)); ref = fmaxf(ref, swz_xor<2>(ref)); ref = fmaxf(ref, swz_xor<4>(ref)); ref = fmaxf(ref, swz_xor<8>(ref)); ref = fmaxf(ref, swz_xor<16>(ref));
                    { auto r1_ = __builtin_amdgcn_permlane32_swap(__float_as_uint(err), __float_as_uint(err), false, false); err = fmaxf(__uint_as_float(r1_[0]), __uint_as_float(r1_[1]));
                      auto r2_ = __builtin_amdgcn_permlane32_swap(__float_as_uint(ref), __float_as_uint(ref), false, false); ref = fmaxf(__uint_as_float(r2_[0]), __uint_as_float(r2_[1])); }
                    if (lane_ == 0 && !(err <= SELFCHECK_TOL * ref + 1e-6f)) atomicAdd(WSP(unsigned, WS_CTL) + 3000, 1u);
                }
            }
    GRID_BAR();
    if (__hip_atomic_load(WSP(unsigned, WS_CTL) + 3000, __ATOMIC_RELAXED, __HIP_MEMORY_SCOPE_AGENT) != 0u && obid() == 0) { for (int i = otid(F.wv); i < 4096; i += 512) F.out[i] = __builtin_nanf(""); }
#endif
#ifdef PROBE_CLK
    if (obid() == 0 && F.wv == 0 && olane() == 0) { const unsigned long long mhz = WSP(unsigned long long, WS_CTL + 600 * 1024)[0]; const unsigned long long t0 = __builtin_amdgcn_s_memrealtime();
        while (__builtin_amdgcn_s_memrealtime() - t0 < mhz * 100ull) __builtin_amdgcn_s_sleep(8); }
#endif
#ifdef PROBE_A
    STAMP(15);
    GRID_BAR();
    {
        unsigned long long* TS = WSP(unsigned long long, WS_CTL + 512 * 1024);
        unsigned long long tot = 0; for (int k = 0; k < 16; ++k) tot += __hip_atomic_load(TS + k, __ATOMIC_RELAXED, __HIP_MEMORY_SCOPE_AGENT);
        const float fa = (float)__hip_atomic_load(TS + PROBE_A, __ATOMIC_RELAXED, __HIP_MEMORY_SCOPE_AGENT) / (float)tot, fb = (float)__hip_atomic_load(TS + PROBE_B, __ATOMIC_RELAXED, __HIP_MEMORY_SCOPE_AGENT) / (float)tot;
        const float A = sqrtf(90.f * fa), X = 100.f + 800.f * fb;
        for (size_t i = (size_t)blockIdx.x * 512 + threadIdx.x; i < (size_t)NB * SEQ * DM; i += (size_t)gridDim.x * 512) F.out[i] = (i == 0) ? X : ((i & 1) ? A : -A);
    }
#endif
}

extern "C" void kernel_launch(void* const* d_in, const int* in_sizes, int n_in, void* d_out, int out_size, void* d_ws, size_t ws_size, hipStream_t stream) {
    static int grid = 0;
    if (grid == 0) {
        if (n_in != 26 || ws_size < WS_END) { fprintf(stderr, "kernel_launch: expected 26 inputs and >= %zu bytes of workspace; got %d, %zu\n", (size_t)WS_END, n_in, ws_size); grid = -1; return; }
        int dev = 0, cus = 0, per_cu = 0;
        if (hipGetDevice(&dev) != hipSuccess || hipDeviceGetAttribute(&cus, hipDeviceAttributeMultiprocessorCount, dev) != hipSuccess) { grid = -1; return; }
        if (hipFuncSetAttribute((const void*)dit_fwd, hipFuncAttributeMaxDynamicSharedMemorySize, LDS_BYTES) != hipSuccess) { fprintf(stderr, "kernel_launch: hipFuncSetAttribute failed\n"); grid = -1; return; }
        if (hipOccupancyMaxActiveBlocksPerMultiprocessor(&per_cu, (const void*)dit_fwd, 512, LDS_BYTES) != hipSuccess || per_cu < 1) fprintf(stderr, "kernel_launch: occupancy query reports %d\n", per_cu);
        (void)hipGetLastError();
        grid = cus;
    }
    if (grid < 0) return;
    (void)hipMemsetAsync((char*)d_ws + WS_CTL, 0, CTL_ZERO_BYTES, stream);
    Args a{};
    for (int i = 0; i < 26; ++i) a.in[i] = (const float*)d_in[i];
    a.out = (float*)d_out; a.ws = (unsigned char*)d_ws; a.ph_lo = 0; a.ph_hi = 1000;
    hipLaunchKernelGGL(dit_fwd, dim3(grid), dim3(512), LDS_BYTES, stream, a);
}
```

```cpp
#include <hip/hip_runtime.h>
#include <cstdio>
#include <cstdint>

#define GAS __attribute__((address_space(1)))
#define LAS __attribute__((address_space(3)))
typedef unsigned short bf16_t;
typedef short bf16x8 __attribute__((ext_vector_type(8)));
typedef short s16x4 __attribute__((ext_vector_type(4)));
typedef float f32x2 __attribute__((ext_vector_type(2)));
typedef float f32x4 __attribute__((ext_vector_type(4)));
typedef float f32x16 __attribute__((ext_vector_type(16)));
typedef unsigned u32x2 __attribute__((ext_vector_type(2)));
typedef unsigned u32x4 __attribute__((ext_vector_type(4)));
typedef __bf16 bf16x2_t __attribute__((ext_vector_type(2)));

constexpr int DM = 1024, NB = 8, SEQ = 8192, CTXL = 256, DEPTH = 2;
constexpr int SB = SEQ + CTXL;
constexpr int GB = 4, NG = NB / GB;
constexpr int NT = GB * SB;
constexpr int NRT = NT / 256;
constexpr int INW = 6912;
constexpr int INCOLS = 6816;
constexpr int NCHUNK = SB / 128;
constexpr int NPAIR = 24;
constexpr float RMS_EPS = 1e-6f;
constexpr float LOG2E = 1.4426950408889634f;
constexpr float QSCALE = 0.10206207261596575f * LOG2E;
constexpr float Q8S = 32.f, K8S = 4.f, V8S = 4.f, P8S = 16.f;
constexpr float HX8S = 16.f, WG8S = 64.f;

constexpr size_t MiB = 1u << 20;
constexpr size_t WS_CTL = 0, CTL_ZERO_BYTES = 1 * MiB;
constexpr size_t WS_MOD = 1 * MiB;
constexpr size_t WS_RT = 2 * MiB;
constexpr size_t WS_MT = 4 * MiB;
constexpr size_t WS_SSQ = 5 * MiB;
constexpr size_t WS_WGT = 8 * MiB;
constexpr size_t WS_LIST = 9 * MiB;
constexpr size_t WS_XC = 13 * MiB;
constexpr size_t WS_WIN = 21 * MiB;
constexpr size_t WS_WCAT = 48 * MiB;
constexpr size_t WS_WOUT = 54 * MiB;
constexpr size_t WS_WUQ = 58 * MiB;
constexpr size_t WS_WUKV = 60 * MiB;
constexpr size_t WS_WUP = 61 * MiB;
constexpr size_t WS_W2T = 125 * MiB;
constexpr size_t WS_HX = 157 * MiB;
constexpr size_t WS_PR = 223 * MiB;
constexpr size_t WS_PC = 322 * MiB;
constexpr size_t WS_PM = 388 * MiB;
constexpr size_t WS_PG = 430 * MiB;
constexpr size_t WS_Q = 628 * MiB;
constexpr size_t WS_K = 678 * MiB;
constexpr size_t WS_V = 728 * MiB;
constexpr size_t WS_ACT = 761 * MiB;
constexpr size_t WS_WIN8 = 746 * MiB;
constexpr size_t WS_HX8 = WS_ACT;
constexpr size_t WS_XRES = 860 * MiB;
constexpr size_t WS_END = 988 * MiB;
static_assert(WS_WIN + (size_t)2 * INW * 1024 * 2 <= WS_WCAT && WS_HX + (size_t)NT * 1024 * 2 <= WS_PR && WS_PR + (size_t)NT * 1536 * 2 <= WS_PC &&
              WS_PC + (size_t)NT * 1024 * 2 <= WS_PM && WS_PM + (size_t)NT * 640 * 2 <= WS_PG && WS_PG + (size_t)NT * 3072 * 2 <= WS_Q &&
              WS_Q + (size_t)GB * 8 * SB * 96 * 2 <= WS_K && WS_K + (size_t)GB * 8 * SB * 96 * 2 <= WS_V && WS_V + (size_t)GB * 8 * SB * 64 * 2 <= WS_ACT &&
              WS_ACT + (size_t)NT * 1536 * 2 <= WS_XRES && WS_XRES + (size_t)NB * SEQ * DM * 2 <= WS_END, "d_ws map");
constexpr int CW_BAR = 4096;
constexpr int CW_CNT = 16384;

constexpr int RING_BYTES = 131072;
constexpr int LDSCTL_OFF = RING_BYTES;
constexpr int LDS_MOE_OFF = LDSCTL_OFF + 64;
constexpr int LDS_VTR_OFF = LDSCTL_OFF + 2048;
constexpr int LDS_BYTES = 147456;

__device__ __forceinline__ int olane() { int l; asm volatile("v_mbcnt_lo_u32_b32 %0, -1, 0\n\tv_mbcnt_hi_u32_b32 %0, -1, %0" : "=v"(l)); return l; }
__device__ __forceinline__ int otid(int wv) { return wv * 64 + olane(); }
__device__ __forceinline__ int obid() { int b = blockIdx.x; asm volatile("" : "+s"(b)); return b; }
__device__ __forceinline__ unsigned cvtpk(float lo, float hi) { f32x2 v = {lo, hi}; bf16x2_t b = __builtin_convertvector(v, bf16x2_t); return __builtin_bit_cast(unsigned, b); }
__device__ __forceinline__ float bf_lo(unsigned w) { return __uint_as_float(w << 16); }
__device__ __forceinline__ float bf_hi(unsigned w) { return __uint_as_float(w & 0xffff0000u); }
__device__ __forceinline__ float bf1(bf16_t b) { return __uint_as_float(((unsigned)b) << 16); }
__device__ __forceinline__ bf16_t f2bf(float f) { return (bf16_t)(cvtpk(f, 0.f) & 0xffffu); }
template <int O> __device__ __forceinline__ float swz_xor(float v) { return __int_as_float(__builtin_amdgcn_ds_swizzle(__float_as_int(v), (O << 10) | 0x1f)); }
__device__ __forceinline__ float half_sum(float v) { auto rr = __builtin_amdgcn_permlane32_swap(__float_as_uint(v), __float_as_uint(v), false, false); return __uint_as_float(rr[0]) + __uint_as_float(rr[1]); }
__device__ __forceinline__ float sum32(float v) { v += swz_xor<1>(v); v += swz_xor<2>(v); v += swz_xor<4>(v); v += swz_xor<8>(v); v += swz_xor<16>(v); return v; }
__device__ __forceinline__ float wave_sum(float v) { return half_sum(sum32(v)); }
__device__ __forceinline__ float sigmoidf_(float x) { return 1.f / (1.f + __expf(-x)); }
__device__ __forceinline__ float siluf_(float x) { return x / (1.f + __expf(-x)); }
__device__ __forceinline__ void unpack8(const u32x4 w, float (&f)[8]) {
    f[0] = bf_lo(w.x); f[1] = bf_hi(w.x); f[2] = bf_lo(w.y); f[3] = bf_hi(w.y); f[4] = bf_lo(w.z); f[5] = bf_hi(w.z); f[6] = bf_lo(w.w); f[7] = bf_hi(w.w);
}
__device__ __forceinline__ u32x2 pack8_fp8(const float (&f)[8]) { int a = __builtin_amdgcn_cvt_pk_fp8_f32(f[0], f[1], 0, false); a = __builtin_amdgcn_cvt_pk_fp8_f32(f[2], f[3], a, true);
    int b = __builtin_amdgcn_cvt_pk_fp8_f32(f[4], f[5], 0, false); b = __builtin_amdgcn_cvt_pk_fp8_f32(f[6], f[7], b, true); u32x2 w; w.x = (unsigned)a; w.y = (unsigned)b; return w; }
__device__ __forceinline__ u32x4 pack8(const float (&f)[8]) { u32x4 w; w.x = cvtpk(f[0], f[1]); w.y = cvtpk(f[2], f[3]); w.z = cvtpk(f[4], f[5]); w.w = cvtpk(f[6], f[7]); return w; }

__host__ __device__ __forceinline__ int vt_pos(int k) { const int w = k & 31, hi = (w >> 2) & 1, r = (w & 3) + 4 * (w >> 3); return 32 * hi + 16 * (k >> 5) + r; }
#define XB_TMO      128
#define XB_XCNT(j)  (256  + 64 * (j))
#define XB_XSUB(j)  (1280 + 64 * (j))
#define XB_XGEN(j)  (2304 + 64 * (j))
#define XB_TOP      3328
#define XB_TOPGEN   3392
#define XCD_BAR_WORDS 3456
#define XB_SPIN_CAP (1u << 20)
__device__ __forceinline__ unsigned xb_ld(unsigned* p)              { return __hip_atomic_load(p, __ATOMIC_RELAXED, __HIP_MEMORY_SCOPE_AGENT); }
__device__ __forceinline__ unsigned xb_add(unsigned* p, unsigned v) { return __hip_atomic_fetch_add(p, v, __ATOMIC_RELAXED, __HIP_MEMORY_SCOPE_AGENT); }
__device__ __forceinline__ unsigned xb_xcc_id() { return (unsigned)__builtin_amdgcn_s_getreg((3 << 11) | 20) & 0xFu; }
#define XB_SPIN(cond, bar) do { unsigned _sp = 0; while (cond) { __builtin_amdgcn_s_sleep(1); \
    if ((++_sp & 255u) == 0u) { if (xb_ld(&(bar)[XB_TMO])) break; if (_sp > XB_SPIN_CAP) { atomicAdd(&(bar)[XB_TMO], 1u); break; } } } } while (0)
struct XcdBarrier { unsigned* bar; unsigned x; volatile LAS unsigned* st; };
__device__ __forceinline__ XcdBarrier xcd_barrier_post(unsigned* bar, volatile LAS unsigned* st) {
    XcdBarrier b; b.bar = bar; b.x = xb_xcc_id(); b.st = st;
    if (threadIdx.x == 0) (void)xb_add(&bar[XB_XCNT(b.x)], 1u);
    return b;
}
__device__ __forceinline__ void xcd_barrier_complete(unsigned* bar, unsigned x, unsigned& nloc, unsigned& nx) {
    const unsigned G = gridDim.x * gridDim.y * gridDim.z;
    unsigned sum, cnt, mine, sp = 0u;
    for (;;) {
        sum = 0u; cnt = 0u; mine = 0u;
#pragma unroll
        for (unsigned j = 0; j < 16; ++j) { const unsigned c = xb_ld(&bar[XB_XCNT(j)]); sum += c; cnt += (c > 0u) ? 1u : 0u; mine = (j == x) ? c : mine; }
        if (sum == G) break;
        __builtin_amdgcn_s_sleep(1);
        if ((++sp & 255u) == 0u) { if (xb_ld(&bar[XB_TMO])) break; if (sp > XB_SPIN_CAP) { atomicAdd(&bar[XB_TMO], 1u); break; } }
    }
    nloc = mine > 0u ? mine : 1u; nx = cnt > 0u ? cnt : 1u;
}
__device__ __forceinline__ void xcd_barrier(const XcdBarrier& b, const int wv) {
    const bool leader = (wv == 0) && (olane() == 0);
    asm volatile("s_waitcnt vmcnt(0)" ::: "memory");
    __syncthreads();
    if (leader) {
        unsigned* bar = b.bar; unsigned bx = b.x;
        asm volatile("" : "+s"(bar), "+s"(bx));
        __builtin_amdgcn_s_waitcnt(0);
        unsigned nloc = b.st[0], nx = b.st[1];
        if (nloc == 0u) { xcd_barrier_complete(bar, bx, nloc, nx); b.st[0] = nloc; b.st[1] = nx; }
        const unsigned old = xb_add(&bar[XB_XSUB(bx)], 1u);
        const unsigned gen = old / nloc;
        if (old + 1u == (gen + 1u) * nloc) {
            __builtin_amdgcn_fence(__ATOMIC_RELEASE, "agent");
            asm volatile("s_waitcnt vmcnt(0)" ::: "memory");
            const unsigned og = xb_add(&bar[XB_TOP], 1u);
            const unsigned tg = og / nx;
            if (og + 1u == (tg + 1u) * nx) xb_add(&bar[XB_TOPGEN], 1u);
            else XB_SPIN(xb_ld(&bar[XB_TOPGEN]) == tg, bar);
            __builtin_amdgcn_fence(__ATOMIC_ACQUIRE, "agent");
            xb_add(&bar[XB_XGEN(bx)], 1u);
            asm volatile("s_waitcnt vmcnt(0)" ::: "memory");
        } else {
            XB_SPIN(xb_ld(&bar[XB_XGEN(bx)]) == gen, bar);
            __builtin_amdgcn_fence(__ATOMIC_ACQUIRE, "agent");
            asm volatile("s_waitcnt vmcnt(0)" ::: "memory");
        }
    }
    __syncthreads();
}

namespace pg8 {
constexpr int BM = 256, BK = 64, HALF = 128, HTB = HALF * BK * 2, NXCD = 8, WGM = 8;
__host__ __device__ __forceinline__ int lds_byte(int r, int c) { const int st = (r >> 4) * 2 + (c >> 5), rr = r & 15, cc = c & 31, ob = rr * 64 + cc * 2; return st * 1024 + (ob ^ (((ob >> 9) & 1) << 5)); }
__host__ __device__ __forceinline__ void stage_rc(int b, int& R, int& C) { const int st = b / 1024, sb = b % 1024, swz = sb ^ (((sb >> 9) & 1) << 5); R = (st >> 1) * 16 + swz / 64; C = (st & 1) * 32 + (swz % 64) / 2; }
__host__ __device__ __forceinline__ int perm32(int rho) { const int n = rho >> 4, i = rho & 15; return 8 * (i >> 2) + 4 * n + (i & 3); }

struct Unit { int pm, pn, aux0, aux1, aux2; const char* a; const char* b; const char* b2; };
typedef f32x4 Acc[2][2][4][2];

typedef int i32x8_t __attribute__((ext_vector_type(8)));
typedef int i32x4_t __attribute__((ext_vector_type(4)));
template <class Epi, class Sched, bool ALIGN_EPI, bool GATHER = false, bool SPLITB = false, bool FP8 = false, int SCA = 0x7f7f7f7f, int SCB = 0x7f7f7f7f>
__device__ __forceinline__ void gemm_phase(LAS unsigned char* lds, const int lda, const int ldb, const int K, const int ksplit, const Sched& S, const Epi& E, const int wv) {
    const int tid = otid(wv), wid = __builtin_amdgcn_readfirstlane(tid >> 6), lane = tid & 63, wr = wid >> 2, wc = wid & 3, fr = lane & 15, fq = lane >> 4;
    const int nt = K / BK;
    unsigned voffA[2][2], voffN[2][2], voffB[2];
#pragma unroll
    for (int i = 0; i < 2; ++i) { int R, C; stage_rc(tid * 16 + i * 8192, R, C); const int Rb = (R & ~31) + perm32(R & 31);
        voffB[i] = (unsigned)(Rb * ldb + C) * 2u;
        voffA[0][i] = (unsigned)(R * lda + C) * 2u; voffA[1][i] = (unsigned)((R + HALF) * lda + C) * 2u; voffN[0][i] = voffA[0][i]; voffN[1][i] = voffA[1][i]; }
    const size_t kstep = (size_t)(BK * 2);
    const size_t hstepB = (size_t)HALF * ldb * 2, hstepA = (size_t)HALF * lda * 2;
    const unsigned ldsw = (unsigned)wid * 1024u;
    const int aoff = lds_byte(wr * 64 + fr, fq * 8), boff = lds_byte(wc * 32 + fr, fq * 8);
#define PG8_SA(b, h) (((b) * 2 + (h)) * HTB)
#define PG8_SB(b, h) ((4 + (b) * 2 + (h)) * HTB)
#define PG8_STAGE_B(bufoff, gbase, h) do { _Pragma("unroll") for (int _i = 0; _i < 2; ++_i) \
        __builtin_amdgcn_global_load_lds((const unsigned*)((const char*)(gbase) + (size_t)(h) * hstepB + voffB[_i]), (LAS unsigned*)(lds + (bufoff) + ldsw + _i * 8192), 16, 0, 0); } while (0)
#define PG8_STAGE_A(bufoff, gbase, h, NX) do { _Pragma("unroll") for (int _i = 0; _i < 2; ++_i) { if constexpr (GATHER) { const unsigned _o = (NX) ? voffN[h][_i] : voffA[h][_i]; \
        __builtin_amdgcn_global_load_lds((const unsigned*)((const char*)(gbase) + _o), (LAS unsigned*)(lds + (bufoff) + ldsw + _i * 8192), 16, 0, 0); } else { \
        __builtin_amdgcn_global_load_lds((const unsigned*)((const char*)(gbase) + (size_t)(h) * hstepA + voffA[0][_i]), (LAS unsigned*)(lds + (bufoff) + ldsw + _i * 8192), 16, 0, 0); } } } while (0)
#define PG8_LDA(dst, b, h) do { _Pragma("unroll") for (int m = 0; m < 4; ++m) { if constexpr (FP8) { \
        A8[m].lo = *(const LAS i32x4_t*)(lds + PG8_SA(b, h) + aoff + m * 2048); A8[m].hi = *(const LAS i32x4_t*)(lds + PG8_SA(b, h) + aoff + m * 2048 + 1024); } else { \
        _Pragma("unroll") for (int k = 0; k < 2; ++k) dst[m][k] = *(const LAS bf16x8*)(lds + PG8_SA(b, h) + aoff + m * 2048 + k * 1024); } } } while (0)
#define PG8_LDB(dst, b, h) do { _Pragma("unroll") for (int n = 0; n < 2; ++n) { if constexpr (FP8) { \
        dst##8[n].lo = *(const LAS i32x4_t*)(lds + PG8_SB(b, h) + boff + n * 2048); dst##8[n].hi = *(const LAS i32x4_t*)(lds + PG8_SB(b, h) + boff + n * 2048 + 1024); } else { \
        _Pragma("unroll") for (int k = 0; k < 2; ++k) dst[n][k] = *(const LAS bf16x8*)(lds + PG8_SB(b, h) + boff + n * 2048 + k * 1024); } } } while (0)
#define PG8_MMA(ai, bj, At, Bt) do { __builtin_amdgcn_s_setprio(1); if constexpr (FP8) { _Pragma("unroll") for (int m = 0; m < 4; ++m) _Pragma("unroll") for (int n = 0; n < 2; ++n) \
        asm volatile("v_mfma_scale_f32_16x16x128_f8f6f4 %0, %1, %2, %0, %3, %4 op_sel_hi:[0,0,0]" : "+v"(acc[ai][bj][m][n]) : "v"(Bt##8[n]), "v"(A8[m]), "v"(scb_), "v"(sca_)); } else { \
        _Pragma("unroll") for (int m = 0; m < 4; ++m) _Pragma("unroll") for (int n = 0; n < 2; ++n) _Pragma("unroll") for (int k = 0; k < 2; ++k) \
        acc[ai][bj][m][n] = __builtin_amdgcn_mfma_f32_16x16x32_bf16(Bt[n][k], At[m][k], acc[ai][bj][m][n], 0, 0, 0); } __builtin_amdgcn_s_setprio(0); } while (0)
#define PG8_WAIT_V(n) asm volatile("s_waitcnt vmcnt(" #n ")" ::: "memory")
#define PG8_WAIT_L(n) asm volatile("s_waitcnt lgkmcnt(" #n ")" ::: "memory")
#define PG8_BAR __builtin_amdgcn_s_barrier()
#define PG8_SCHED __builtin_amdgcn_sched_barrier(0)
#define PG8_GOFF(dst, u) do { if constexpr (GATHER) { const int _t = otid(wv); _Pragma("unroll") for (int _i = 0; _i < 2; ++_i) { int _R, _C; stage_rc(_t * 16 + _i * 8192, _R, _C); \
        _Pragma("unroll") for (int _h = 0; _h < 2; ++_h) dst[_h][_i] = S.gather_off(u, _h * HALF + _R) + (unsigned)_C * 2u; } } } while (0)
#define PG8_BPTR(u, t) (SPLITB ? (((t) < ksplit) ? (u).b + (size_t)(t) * kstep : (u).b2 + (size_t)((t) - ksplit) * kstep) : (u).b + (size_t)(t) * kstep)
    Unit cur, nxt; int ui = 0;
    if (!S.next(0, cur)) return;
    Acc acc;
#pragma unroll
    for (int a = 0; a < 2; ++a)
#pragma unroll
        for (int b = 0; b < 2; ++b)
#pragma unroll
            for (int m = 0; m < 4; ++m)
#pragma unroll
                for (int n = 0; n < 2; ++n) acc[a][b][m][n] = (f32x4){0.f, 0.f, 0.f, 0.f};
    bf16x8 At[4][2], B0[2][2], B1[2][2]; i32x8_t A8[4], B08[2], B18[2]; const int sca_ = SCA, scb_ = SCB;
    const char* cA = cur.a; const char* cB = cur.b;
    S.a_ready(cur);
    PG8_GOFF(voffA, cur);
    if constexpr (GATHER) {
#pragma unroll
        for (int h = 0; h < 2; ++h)
#pragma unroll
            for (int i = 0; i < 2; ++i) voffN[h][i] = voffA[h][i];
    }
    PG8_STAGE_B(PG8_SB(0, 0), cB, 0); PG8_STAGE_B(PG8_SB(0, 1), cB, 1); PG8_STAGE_A(PG8_SA(0, 0), cA, 0, false); PG8_STAGE_A(PG8_SA(0, 1), cA, 1, false);
    if (wr == 1) PG8_BAR;
    PG8_WAIT_V(2); PG8_BAR;
    PG8_STAGE_B(PG8_SB(1, 0), cB + kstep, 0); PG8_STAGE_A(PG8_SA(1, 0), cA + kstep, 0, false); PG8_STAGE_B(PG8_SB(1, 1), cB + kstep, 1);
    PG8_WAIT_V(6); PG8_BAR;
    for (;;) {
        const bool has_next = S.next(ui + 1, nxt);
        const char* nA = has_next ? nxt.a : cA; const char* nB = has_next ? nxt.b : cB;
#pragma nounroll
        for (int t = 0; t < nt; t += 2) {
            const bool last = (t == nt - 2);
            if (last && has_next) { S.a_ready(nxt); PG8_GOFF(voffN, nxt); }
            if constexpr (Epi::HOOK) { if (t == Epi::HOOK_T0 || t == Epi::HOOK_T1) E.hook(acc, cur, t, wr, wc, fr, fq); }
            const char* a1 = cA + (size_t)(t + 1) * kstep;
            const char* a2 = last ? nA : cA + (size_t)(t + 2) * kstep; const char* b2 = last ? nB : PG8_BPTR(cur, t + 2);
            const char* a3 = a2 + kstep; const char* b3 = b2 + kstep;
            PG8_LDB(B0, 0, 0); PG8_LDB(B1, 0, 1); PG8_SCHED; PG8_LDA(At, 0, 0); PG8_STAGE_A(PG8_SA(1, 1), a1, 1, false);
            PG8_WAIT_V(8); PG8_WAIT_L(0); PG8_BAR; PG8_MMA(0, 0, At, B0); PG8_MMA(0, 1, At, B1); PG8_BAR; PG8_SCHED;
            PG8_LDA(At, 0, 1); PG8_STAGE_B(PG8_SB(0, 0), b2, 0); PG8_STAGE_B(PG8_SB(0, 1), b2, 1); PG8_STAGE_A(PG8_SA(0, 0), a2, 0, last);
            PG8_WAIT_V(8); PG8_WAIT_L(0); PG8_BAR; PG8_MMA(1, 0, At, B0); PG8_MMA(1, 1, At, B1); PG8_BAR; PG8_SCHED;
            PG8_LDB(B0, 1, 0); PG8_LDB(B1, 1, 1); PG8_SCHED; PG8_LDA(At, 1, 0); PG8_STAGE_A(PG8_SA(0, 1), a2, 1, last);
            PG8_WAIT_V(8); PG8_WAIT_L(0); PG8_BAR; PG8_MMA(0, 0, At, B0); PG8_MMA(0, 1, At, B1); PG8_BAR; PG8_SCHED;
            PG8_LDA(At, 1, 1); PG8_STAGE_B(PG8_SB(1, 0), b3, 0); PG8_STAGE_B(PG8_SB(1, 1), b3, 1); PG8_STAGE_A(PG8_SA(1, 0), a3, 0, last);
            PG8_WAIT_V(8); PG8_WAIT_L(0); PG8_BAR; PG8_MMA(1, 0, At, B0); PG8_MMA(1, 1, At, B1); PG8_BAR; PG8_SCHED;
        }
        if constexpr (ALIGN_EPI) { if (wr == 0) PG8_BAR; }
        if constexpr (FP8) asm volatile("s_nop 15\n\ts_nop 15" ::: "memory");
        E(acc, cur, wr, wc, fr, fq); S.done(cur);
        if (!has_next) break;
#pragma unroll
        for (int a = 0; a < 2; ++a)
#pragma unroll
            for (int b = 0; b < 2; ++b)
#pragma unroll
                for (int m = 0; m < 4; ++m)
#pragma unroll
                    for (int n = 0; n < 2; ++n) acc[a][b][m][n] = (f32x4){0.f, 0.f, 0.f, 0.f};
        cur = nxt; cA = nA; cB = nB; ++ui;
        if constexpr (GATHER) {
#pragma unroll
            for (int h = 0; h < 2; ++h)
#pragma unroll
                for (int i = 0; i < 2; ++i) voffA[h][i] = voffN[h][i];
        }
        if constexpr (ALIGN_EPI) { if (wr == 1) PG8_BAR; }
    }
    PG8_WAIT_V(0);
    if constexpr (!ALIGN_EPI) { if (wr == 0) PG8_BAR; }
    PG8_BAR;
#undef PG8_SA
#undef PG8_SB
#undef PG8_STAGE_A
#undef PG8_STAGE_B
#undef PG8_LDA
#undef PG8_LDB
#undef PG8_MMA
#undef PG8_WAIT_V
#undef PG8_WAIT_L
#undef PG8_BAR
#undef PG8_SCHED
#undef PG8_GOFF
#undef PG8_BPTR
}
}
struct Resid {
    const float* in_lat; const float* in_ctx; bf16_t* x_lat; bf16_t* x_ctx; int g, src_f32;
    __device__ __forceinline__ const float* srcf(int row) const { const int bl = row / SB, s = row - bl * SB, b = g * GB + bl;
        return s < CTXL ? in_ctx + (size_t)(b * CTXL + s) * DM : in_lat + ((size_t)b * SEQ + (s - CTXL)) * DM; }
    __device__ __forceinline__ bf16_t* dst(int row) const { const int bl = row / SB, s = row - bl * SB, b = g * GB + bl;
        return s < CTXL ? x_ctx + (size_t)(b * CTXL + s) * DM : x_lat + ((size_t)b * SEQ + (s - CTXL)) * DM; }
    __device__ __forceinline__ int modv(int row) const { const int bl = row / SB, s = row - bl * SB; return s < CTXL ? 8 : g * GB + bl; }
};

struct TileOrder {
    int nM, nN, nwg, G, c, skip; const char* A; const char* B; size_t astep, bstep;
    __device__ __forceinline__ void init(int nM_, int nN_, int G_, int c_, const void* A_, size_t astep_, const void* B_, size_t bstep_, int skip_ctx) {
        nM = nM_; nN = nN_; nwg = nM * nN; G = G_; c = c_; A = (const char*)A_; B = (const char*)B_; astep = astep_; bstep = bstep_; skip = skip_ctx; }
    __device__ __forceinline__ bool next(int i, pg8::Unit& u) const {
        const long L = (long)i * G + c; if (L >= nwg) return false;
        int wgid = (int)L; { const int q = nwg / pg8::NXCD, r = nwg % pg8::NXCD, xcd = wgid % pg8::NXCD, off = wgid / pg8::NXCD; wgid = (xcd < r ? xcd * (q + 1) : r * (q + 1) + (xcd - r) * q) + off; }
        const int nig = pg8::WGM * nN, gid = wgid / nig, fm = gid * pg8::WGM, gsz = (nM - fm) < pg8::WGM ? (nM - fm) : pg8::WGM;
        int pm = fm + ((wgid % nig) % gsz); u.pn = (wgid % nig) / gsz;
        if (skip) pm = pm + pm / 32 + 1;
        u.pm = pm; u.aux0 = 0; u.aux1 = 0; u.aux2 = 0;
        u.a = A + (size_t)pm * astep; u.b = B + (size_t)u.pn * bstep; u.b2 = u.b; return true;
    }
    __device__ __forceinline__ void a_ready(const pg8::Unit&) const {}
    __device__ __forceinline__ void done(const pg8::Unit&) const {}
};

struct MoeOrder {
    const LAS int* tab; const int* LIST; int ncol, G, c, up; const char* A; const char* W;
    __device__ __forceinline__ bool next(int i, pg8::Unit& u) const {
        const int TR = __builtin_amdgcn_readfirstlane(tab[24]);
        int rt, pn;
        if ((G & 7) == 0) { const int x = c & 7, j = c >> 3, W = G >> 3; const int lo = (TR * x) >> 3, hi = (TR * (x + 1)) >> 3; const int q = i * W + j; if (q >= (hi - lo) * ncol) return false;
            rt = lo + q / ncol; pn = q - (q / ncol) * ncol; }
        else { const int L = i * G + c; if (L >= TR * ncol) return false; rt = L / ncol; pn = L - rt * ncol; }
        int p = 0;
#pragma unroll
        for (int q = 1; q < NPAIR; ++q) p += (__builtin_amdgcn_readfirstlane(tab[q]) <= rt) ? 1 : 0;
        const int base = (rt - __builtin_amdgcn_readfirstlane(tab[p])) * 256; int valid = __builtin_amdgcn_readfirstlane(tab[32 + p]) - base; valid = valid > 256 ? 256 : valid;
        u.pm = rt; u.pn = pn; u.aux0 = p * NT + base; u.aux1 = valid; u.aux2 = p;
        const int grp = p / 6, q6 = p - grp * 6;
        const int lo = q6 < 3 ? 0 : (q6 < 5 ? 1 : 2), hi = q6 < 3 ? q6 + 1 : (q6 < 5 ? q6 - 1 : 3);
        const int ea = grp * 4 + lo, eb = grp * 4 + hi;
        if (up) { const int e = pn < 4 ? ea : eb; u.a = A; u.b = W + ((size_t)e * 1024 + (size_t)(pn & 3) * 256) * 1024 * 2; u.b2 = u.b; }
        else { u.a = A + (size_t)rt * 256 * 1024 * 2; u.b = W + ((size_t)ea * 1024 + (size_t)pn * 256) * 512 * 2; u.b2 = W + ((size_t)eb * 1024 + (size_t)pn * 256) * 512 * 2; }
        return true;
    }
    __device__ __forceinline__ unsigned gather_off(const pg8::Unit& u, int r) const { const int idx = r < u.aux1 ? r : 0; return (unsigned)LIST[u.aux0 + idx] * (unsigned)(DM * 2); }
    __device__ __forceinline__ void a_ready(const pg8::Unit&) const {}
    __device__ __forceinline__ void done(const pg8::Unit&) const {}
};

#ifdef EPI_NT_STORES
#define ST_NT(p, v) __builtin_nontemporal_store((v), (p))
#else
#define ST_NT(p, v) (*(p) = (v))
#endif
#define EPI_NOHOOK static constexpr bool HOOK = false; static constexpr int HOOK_T0 = -1, HOOK_T1 = -1; \
    __device__ __forceinline__ void hook(pg8::Acc&, const pg8::Unit&, int, int, int, int, int) const {}
#define EPI_V8(v, acc, ai, bj, m) float v[8]; { const f32x4 _a = acc[ai][bj][m][0], _b = acc[ai][bj][m][1]; v[0] = _a[0]; v[1] = _a[1]; v[2] = _a[2]; v[3] = _a[3]; v[4] = _b[0]; v[5] = _b[1]; v[6] = _b[2]; v[7] = _b[3]; }
__device__ __forceinline__ void rot4(float (&v)[8], const f32x2* cs) {
    const f32x4 c01 = *(const f32x4*)cs, c23 = *(const f32x4*)(cs + 2);
    const float c[4] = {c01[0], c01[2], c23[0], c23[2]}, s[4] = {c01[1], c01[3], c23[1], c23[3]};
#pragma unroll
    for (int k = 0; k < 4; ++k) { const float x1 = v[2 * k], x2 = v[2 * k + 1]; v[2 * k] = x1 * c[k] - x2 * s[k]; v[2 * k + 1] = x2 * c[k] + x1 * s[k]; }
}

struct EpiNone { EPI_NOHOOK
    float* sink;
    __device__ __forceinline__ void operator()(const pg8::Acc& acc, const pg8::Unit& u, int wr, int wc, int fr, int fq) const {
        float s = 0.f;
#pragma unroll
        for (int ai = 0; ai < 2; ++ai)
#pragma unroll
            for (int bj = 0; bj < 2; ++bj)
#pragma unroll
                for (int m = 0; m < 4; ++m) s += acc[ai][bj][m][0][0] + acc[ai][bj][m][1][3];
        if (s == 1.2345e33f) sink[0] = s;
    }
};
struct EpiStoreOnly { EPI_NOHOOK
    bf16_t* PG;
    __device__ __forceinline__ void operator()(const pg8::Acc& acc, const pg8::Unit& u_, int wr, int wc, int fr, int fq) const {
        pg8::Unit u = u_; asm volatile("" : "+s"(u.pm), "+s"(u.pn), "+v"(fr), "+v"(fq));
        const int pn12 = u.pn % 12;
#pragma unroll
        for (int ai = 0; ai < 2; ++ai)
#pragma unroll
        for (int m = 0; m < 4; ++m) { const int row = u.pm * 256 + ai * 128 + wr * 64 + m * 16 + fr;
#pragma unroll
            for (int bj = 0; bj < 2; ++bj) { const int c0 = bj * 128 + wc * 32 + 8 * fq; EPI_V8(v, acc, ai, bj, m)
                *(u32x4*)(PG + (size_t)row * 3072 + pn12 * 256 + c0) = pack8(v); } }
    }
};
struct EpiGate {
    EPI_NOHOOK
    bf16_t* PG;
    __device__ __forceinline__ void operator()(const pg8::Acc& acc, const pg8::Unit& u_, int wr, int wc, int fr, int fq) const {
        pg8::Unit u = u_; asm volatile("" : "+s"(u.pm), "+s"(u.pn), "+v"(fr), "+v"(fq));
#pragma unroll
        for (int ai = 0; ai < 2; ++ai)
#pragma unroll
        for (int m = 0; m < 4; ++m) { const int row = u.pm * 256 + ai * 128 + wr * 64 + m * 16 + fr;
#pragma unroll
            for (int bj = 0; bj < 2; ++bj) { const int c0 = bj * 128 + wc * 32 + 8 * fq;
                EPI_V8(v, acc, ai, bj, m)
                float g[8];
#pragma unroll
                for (int k = 0; k < 8; ++k) { const float x = fminf(fmaxf(v[k], -15.f), 15.f); g[k] = sigmoidf_(x); }
                *(u32x4*)(PG + (size_t)row * 3072 + u.pn * 256 + c0) = pack8(g); } }
    }
};
struct EpiInproj {
    EPI_NOHOOK
    bf16_t *PR, *PC, *PM, *PG; unsigned char* KB; float* SSQ; const f32x2* RT; const f32x2* MT; int pn_off;
    __device__ __forceinline__ void operator()(const pg8::Acc& acc, const pg8::Unit& u_, int wr, int wc, int fr, int fq) const {
        pg8::Unit u = u_; asm volatile("" : "+s"(u.pm), "+s"(u.pn), "+s"(u.aux0), "+s"(u.aux1), "+v"(fr), "+v"(fq));
        const int pn = u.pn + pn_off;
#pragma unroll
        for (int ai = 0; ai < 2; ++ai)
#pragma unroll
        for (int m = 0; m < 4; ++m) { __builtin_amdgcn_sched_barrier(0);
            const int row = u.pm * 256 + ai * 128 + wr * 64 + m * 16 + fr;
            const int bl = row / SB, s = row - bl * SB; const bool lat = s >= CTXL; const int t = lat ? s - CTXL : 0;
            float ss[2] = {0.f, 0.f};
#pragma unroll
            for (int bj = 0; bj < 2; ++bj) {
                const int c0 = bj * 128 + wc * 32 + 8 * fq;
                EPI_V8(v, acc, ai, bj, m)
                if (pn <= 1) {
                    if (lat) rot4(v, RT + (size_t)t * 32 + ((c0 & 63) >> 1));
                    if (pn == 1) {
#pragma unroll
                        for (int k = 0; k < 8; ++k) v[k] *= 0.125f;
                    }
                    *(u32x4*)(PR + (size_t)row * 1536 + pn * 256 + c0) = pack8(v);
                } else if (pn <= 5) {
                    *(u32x4*)(PR + (size_t)row * 1536 + pn * 256 + c0) = pack8(v);
                } else if (pn <= 7) {
                    *(u32x4*)(PC + (size_t)row * 1024 + (pn - 6) * 256 + c0) = pack8(v);
                } else if (pn <= 11) {
                    u32x2 w; w.x = cvtpk(v[0] * v[1], v[2] * v[3]); w.y = cvtpk(v[4] * v[5], v[6] * v[7]);
                    *(u32x2*)(PC + (size_t)row * 1024 + 512 + (pn - 8) * 128 + (c0 >> 1)) = w;
                } else if (pn <= 14) {
                    if (pn == 14 && bj == 1) {
                        if (wc == 0) {
                            if (lat) { const int a = fq >> 1, pos = a ? (t & 63) : (t >> 6); rot4(v, MT + pos * 8 + (fq & 1) * 4); }
#pragma unroll
                            for (int k = 0; k < 8; ++k) v[k] *= K8S;
                            const u32x2 w = pack8_fp8(v);
#pragma unroll
                            for (int hh = 0; hh < 8; ++hh) { unsigned char* kp = KB + ((size_t)(bl * 8 + hh) * SB + s) * 128;
                                *(u32x2*)(kp + 64 + 8 * fq) = w; if (fq == 3) { *(u32x4*)(kp + 96) = (u32x4){0u, 0u, 0u, 0u}; *(u32x4*)(kp + 112) = (u32x4){0u, 0u, 0u, 0u}; } }
                        }
                    } else {
                        *(u32x4*)(PM + (size_t)row * 640 + (pn - 12) * 256 + c0) = pack8(v);
                        float q = 0.f;
#pragma unroll
                        for (int k = 0; k < 8; ++k) q += v[k] * v[k];
                        ss[bj] = q;
                    }
                } else {
                    float g[8];
#pragma unroll
                    for (int k = 0; k < 8; ++k) { const float x = fminf(fmaxf(v[k], -15.f), 15.f); g[k] = sigmoidf_(x); }
                    ST_NT((u32x4*)(PG + (size_t)row * 3072 + (pn - 15) * 256 + c0), pack8(g));
                }
            }
            if (pn >= 12 && pn <= 14) {
                float a = ss[0], b = ss[1];
                a += swz_xor<16>(a); a = half_sum(a); b += swz_xor<16>(b); b = half_sum(b);
                if (fq == 0) {
                    float* sq = SSQ + (size_t)row * 16;
                    if (pn == 12) sq[wc] = a + b;
                    else if (pn == 13) { sq[4 + wc] = a; sq[8 + wc] = b; }
                    else sq[12 + wc] = a;
                }
            }
        }
    }
};

#define EPI_ROW(ai, m) (u.pm * 256 + (ai) * 128 + wr * 64 + (m) * 16 + fr)
#define EPI_OPAQUE pg8::Unit u = u_; asm volatile("" : "+s"(u.pm), "+s"(u.pn), "+s"(u.aux0), "+s"(u.aux1), "+v"(fr), "+v"(fq));
struct EpiUq {
    EPI_NOHOOK
    unsigned char* QB; const float* SSQ; const f32x2* MT;
    __device__ __forceinline__ void operator()(const pg8::Acc& acc, const pg8::Unit& u_, int wr, int wc, int fr, int fq) const {
        EPI_OPAQUE
        f32x4 q0[2][4], q1[2][4];
#pragma unroll
        for (int ai = 0; ai < 2; ++ai)
#pragma unroll
            for (int m = 0; m < 4; ++m) { const float* sq = SSQ + (size_t)EPI_ROW(ai, m) * 16; q0[ai][m] = *(const f32x4*)sq; q1[ai][m] = *(const f32x4*)(sq + 4); }
#pragma unroll
        for (int ai = 0; ai < 2; ++ai)
#pragma unroll
        for (int m = 0; m < 4; ++m) {
            const int row = EPI_ROW(ai, m);
            const int bl = row / SB, s = row - bl * SB; const bool lat = s >= CTXL; const int t = lat ? s - CTXL : 0;
            const f32x4 a = q0[ai][m], b = q1[ai][m];
            const float ssq = ((a[0] + a[1]) + (a[2] + a[3])) + ((b[0] + b[1]) + (b[2] + b[3]));
            const float rq = rsqrtf(ssq * (1.f / 384.f) + RMS_EPS) * (QSCALE * Q8S);
#pragma unroll
            for (int bj = 0; bj < 2; ++bj) {
                const int cg = u.pn * 256 + bj * 128 + wc * 32 + 8 * fq; const int h = cg / 96, d0 = cg - h * 96;
                EPI_V8(v, acc, ai, bj, m)
#pragma unroll
                for (int k = 0; k < 8; ++k) v[k] *= rq;
                if (d0 >= 64 && lat) { const int p0 = d0 - 64, aa = p0 >> 4, pos = aa ? (t & 63) : (t >> 6); rot4(v, MT + pos * 8 + ((p0 & 15) >> 1)); }
                unsigned char* qp = QB + ((size_t)(bl * 8 + h) * SB + s) * 128;
                *(u32x2*)(qp + d0) = pack8_fp8(v);
                if (d0 == 88) { *(u32x4*)(qp + 96) = (u32x4){0u, 0u, 0u, 0u}; *(u32x4*)(qp + 112) = (u32x4){0u, 0u, 0u, 0u}; }
            }
        }
    }
};
struct EpiUkv {
    EPI_NOHOOK
    unsigned char* KB; unsigned char* VT; const float* SSQ; LAS unsigned char* tr;
    __device__ __forceinline__ void operator()(const pg8::Acc& acc, const pg8::Unit& u_, int wr, int wc, int fr, int fq) const {
        EPI_OPAQUE
        f32x4 q0[2][4], q1[2][4];
#pragma unroll
        for (int ai = 0; ai < 2; ++ai)
#pragma unroll
            for (int m = 0; m < 4; ++m) { const float* sq = SSQ + (size_t)EPI_ROW(ai, m) * 16 + 8; q0[ai][m] = *(const f32x4*)sq; q1[ai][m] = *(const f32x4*)(sq + 4); }
        LAS unsigned char* my = tr + (wr * 2 + (wc & 1)) * 2048;
        const int lane = fr + 16 * fq;
#pragma unroll
        for (int ai = 0; ai < 2; ++ai) {
            const int row0 = u.pm * 256 + ai * 128 + wr * 64;
            const int bl = row0 / SB, s0 = row0 - bl * SB;
#pragma unroll
            for (int bj = 0; bj < 2; ++bj) {
                const int h = u.pn * 2 + bj;
#pragma unroll
                for (int m = 0; m < 4; ++m) {
                    const f32x4 a = q0[ai][m], b = q1[ai][m];
                    const float ssq = ((a[0] + a[1]) + (a[2] + a[3])) + ((b[0] + b[1]) + (b[2] + b[3]));
                    const float rk = rsqrtf(ssq * (1.f / 256.f) + RMS_EPS);
                    EPI_V8(v, acc, ai, bj, m)
                    if (wc < 2) {
#pragma unroll
                        for (int k = 0; k < 8; ++k) v[k] *= rk * K8S;
                        *(u32x2*)(KB + ((size_t)(bl * 8 + h) * SB + s0 + 16 * m + fr) * 128 + wc * 32 + 8 * fq) = pack8_fp8(v);
                    } else {
#pragma unroll
                        for (int k = 0; k < 8; ++k) v[k] *= rk * V8S;
                        const u32x2 w = pack8_fp8(v); const int pos = vt_pos(16 * m + fr) ^ (16 * fq);
#pragma unroll
                        for (int k = 0; k < 4; ++k) { my[(8 * fq + k) * 64 + pos] = (unsigned char)(w.x >> (8 * k)); my[(8 * fq + 4 + k) * 64 + pos] = (unsigned char)(w.y >> (8 * k)); }
                    }
                }
                if (wc >= 2) {
#pragma unroll
                    for (int i = 0; i < 2; ++i) { const int ch = lane + 64 * i, d = ch >> 2, c16 = ch & 3;
                        const u32x4 x = *(const LAS u32x4*)(my + d * 64 + ((c16 ^ ((d >> 3) & 3)) * 16));
                        *(u32x4*)(VT + ((size_t)(bl * 8 + h) * 64 + (wc - 2) * 32 + d) * SB + s0 + c16 * 16) = x; }
                }
            }
        }
    }
};

struct EpiMerge1 {
    static constexpr bool HOOK = true; static constexpr int HOOK_T0 = 8, HOOK_T1 = 16;
    const bf16_t* PG; bf16_t* M;
    __device__ __forceinline__ void hook(pg8::Acc& acc, const pg8::Unit& u_, int t, int wr, int wc, int fr, int fq) const {
        pg8::Unit u = u_; asm volatile("" : "+s"(u.pm), "+s"(u.pn), "+v"(fr), "+v"(fq));
        const int gi = (t == 8) ? 0 : 1;
#pragma unroll
        for (int ai = 0; ai < 2; ++ai) {
            u32x4 sp[4][2], sn[4][2];
#pragma unroll
            for (int m = 0; m < 4; ++m)
#pragma unroll
                for (int bj = 0; bj < 2; ++bj) { const bf16_t* p = PG + (size_t)EPI_ROW(ai, m) * 3072 + gi * 1024 + u.pn * 256 + bj * 128 + wc * 32 + 8 * fq;
                    sp[m][bj] = *(const u32x4*)p; sn[m][bj] = *(const u32x4*)(p + 1024); }
#pragma unroll
            for (int m = 0; m < 4; ++m)
#pragma unroll
                for (int bj = 0; bj < 2; ++bj) {
                    float a[8], b[8]; unpack8(sp[m][bj], a); unpack8(sn[m][bj], b);
                    f32x4 r0, r1;
#pragma unroll
                    for (int k = 0; k < 4; ++k) { r0[k] = a[k] * __builtin_amdgcn_rcpf(b[k]); r1[k] = a[4 + k] * __builtin_amdgcn_rcpf(b[4 + k]); }
                    acc[ai][bj][m][0] *= r0; acc[ai][bj][m][1] *= r1;
                }
            __builtin_amdgcn_sched_barrier(0);
        }
    }
    __device__ __forceinline__ void operator()(const pg8::Acc& acc, const pg8::Unit& u_, int wr, int wc, int fr, int fq) const {
        EPI_OPAQUE
#pragma unroll
        for (int ai = 0; ai < 2; ++ai) {
            u32x4 s2[4][2];
#pragma unroll
            for (int m = 0; m < 4; ++m)
#pragma unroll
                for (int bj = 0; bj < 2; ++bj) s2[m][bj] = *(const u32x4*)(PG + (size_t)EPI_ROW(ai, m) * 3072 + 2048 + u.pn * 256 + bj * 128 + wc * 32 + 8 * fq);
#pragma unroll
            for (int m = 0; m < 4; ++m)
#pragma unroll
                for (int bj = 0; bj < 2; ++bj) {
                    const int cg = u.pn * 256 + bj * 128 + wc * 32 + 8 * fq;
                    float g[8]; unpack8(s2[m][bj], g);
                    EPI_V8(v, acc, ai, bj, m)
#pragma unroll
                    for (int k = 0; k < 8; ++k) v[k] *= g[k];
                    *(u32x4*)(M + (size_t)EPI_ROW(ai, m) * 1024 + cg) = pack8(v);
                }
            __builtin_amdgcn_sched_barrier(0);
        }
    }
};

struct EpiMerge1NoHook : EpiMerge1 { static constexpr bool HOOK = false; };
struct EpiMerge1HookOnly { static constexpr bool HOOK = true; static constexpr int HOOK_T0 = 8, HOOK_T1 = 16; EpiMerge1 e; float* sink;
    __device__ __forceinline__ void hook(pg8::Acc& acc, const pg8::Unit& u, int t, int wr, int wc, int fr, int fq) const { e.hook(acc, u, t, wr, wc, fr, fq); }
    __device__ __forceinline__ void operator()(const pg8::Acc& acc, const pg8::Unit& u, int wr, int wc, int fr, int fq) const { EpiNone n{sink}; n(acc, u, wr, wc, fr, fq); }
};
struct EpiMerge2 {
    EPI_NOHOOK
    Resid R; const float* MODL;
    __device__ __forceinline__ void operator()(const pg8::Acc& acc, const pg8::Unit& u_, int wr, int wc, int fr, int fq) const {
        EPI_OPAQUE
        const int cb = u.pn * 256 + wc * 32 + 8 * fq;
        const float* g1 = MODL + R.modv(u.pm * 256) * 6144 + 2048 + cb;
        f32x4 g[2][2];
#pragma unroll
        for (int bj = 0; bj < 2; ++bj)
#pragma unroll
            for (int n = 0; n < 2; ++n) g[bj][n] = *(const f32x4*)(g1 + bj * 128 + 4 * n);
        int sf32 = R.src_f32; asm volatile("" : "+s"(sf32));
#pragma unroll
        for (int ai = 0; ai < 2; ++ai) {
            if (sf32) {
#pragma unroll
                for (int mh = 0; mh < 2; ++mh) {
                    f32x4 x[2][2][2];
#pragma unroll
                    for (int m2 = 0; m2 < 2; ++m2) { const float* src = R.srcf(EPI_ROW(ai, 2 * mh + m2)) + cb;
#pragma unroll
                        for (int bj = 0; bj < 2; ++bj)
#pragma unroll
                            for (int n = 0; n < 2; ++n) x[m2][bj][n] = *(const f32x4*)(src + bj * 128 + 4 * n); }
#pragma unroll
                    for (int m2 = 0; m2 < 2; ++m2) { const int m = 2 * mh + m2; bf16_t* dst = R.dst(EPI_ROW(ai, m)) + cb;
#pragma unroll
                        for (int bj = 0; bj < 2; ++bj) { const f32x4 a = x[m2][bj][0] + g[bj][0] * acc[ai][bj][m][0], b = x[m2][bj][1] + g[bj][1] * acc[ai][bj][m][1];
                            u32x4 w; w.x = cvtpk(a[0], a[1]); w.y = cvtpk(a[2], a[3]); w.z = cvtpk(b[0], b[1]); w.w = cvtpk(b[2], b[3]); *(u32x4*)(dst + bj * 128) = w; } }
                }
            } else {
                u32x4 x[4][2];
#pragma unroll
                for (int m = 0; m < 4; ++m) { const bf16_t* src = R.dst(EPI_ROW(ai, m)) + cb;
#pragma unroll
                    for (int bj = 0; bj < 2; ++bj) x[m][bj] = *(const u32x4*)(src + bj * 128); }
#pragma unroll
                for (int m = 0; m < 4; ++m) { bf16_t* dst = R.dst(EPI_ROW(ai, m)) + cb;
#pragma unroll
                    for (int bj = 0; bj < 2; ++bj) { float f[8]; unpack8(x[m][bj], f);
                        const f32x4 a = (f32x4){f[0], f[1], f[2], f[3]} + g[bj][0] * acc[ai][bj][m][0], b = (f32x4){f[4], f[5], f[6], f[7]} + g[bj][1] * acc[ai][bj][m][1];
                        u32x4 w; w.x = cvtpk(a[0], a[1]); w.y = cvtpk(a[2], a[3]); w.z = cvtpk(b[0], b[1]); w.w = cvtpk(b[2], b[3]); *(u32x4*)(dst + bj * 128) = w; } }
            }
            __builtin_amdgcn_sched_barrier(0);
        }
    }
};

struct EpiMoeUp {
    EPI_NOHOOK
    const int* LIST; const float* WGT; bf16_t* MACT;
    __device__ __forceinline__ void operator()(const pg8::Acc& acc, const pg8::Unit& u_, int wr, int wc, int fr, int fq) const {
        EPI_OPAQUE
        const int slot = u.pn >> 2;
        int tok[2][4]; float w[2][4];
#pragma unroll
        for (int ai = 0; ai < 2; ++ai)
#pragma unroll
            for (int m = 0; m < 4; ++m) { const int ri = ai * 128 + wr * 64 + m * 16 + fr; tok[ai][m] = LIST[u.aux0 + (ri < u.aux1 ? ri : 0)]; }
#pragma unroll
        for (int ai = 0; ai < 2; ++ai)
#pragma unroll
            for (int m = 0; m < 4; ++m) w[ai][m] = WGT[(size_t)tok[ai][m] * 2 + slot];
#pragma unroll
        for (int ai = 0; ai < 2; ++ai)
#pragma unroll
        for (int m = 0; m < 4; ++m) {
            const int ri = ai * 128 + wr * 64 + m * 16 + fr; const float ww = w[ai][m];
#pragma unroll
            for (int bj = 0; bj < 2; ++bj) {
                const int c0 = bj * 128 + wc * 32 + 8 * fq;
                EPI_V8(v, acc, ai, bj, m)
                u32x2 o; o.x = cvtpk(siluf_(v[0]) * v[1] * ww, siluf_(v[2]) * v[3] * ww); o.y = cvtpk(siluf_(v[4]) * v[5] * ww, siluf_(v[6]) * v[7] * ww);
                *(u32x2*)(MACT + (size_t)(u.pm * 256 + ri) * 1024 + slot * 512 + (u.pn & 3) * 128 + (c0 >> 1)) = o;
            }
        }
    }
};
struct EpiMoeDown {
    EPI_NOHOOK
    const int* LIST; Resid R; const float* MODL; bf16_t* dry;
    __device__ __forceinline__ void operator()(const pg8::Acc& acc, const pg8::Unit& u_, int wr, int wc, int fr, int fq) const {
        EPI_OPAQUE
        int tok[2][4];
#pragma unroll
        for (int ai = 0; ai < 2; ++ai)
#pragma unroll
            for (int m = 0; m < 4; ++m) { const int ri = ai * 128 + wr * 64 + m * 16 + fr; tok[ai][m] = LIST[u.aux0 + (ri < u.aux1 ? ri : 0)]; }
        const int cb = u.pn * 256 + wc * 32 + 8 * fq;
#pragma unroll
        for (int ai = 0; ai < 2; ++ai) {
            u32x4 x[4][2];
#pragma unroll
            for (int m = 0; m < 4; ++m) { const bf16_t* dst = R.dst(tok[ai][m]) + cb;
#pragma unroll
                for (int bj = 0; bj < 2; ++bj) x[m][bj] = *(const u32x4*)(dst + bj * 128); }
#pragma unroll
            for (int m = 0; m < 4; ++m) { const int ri = ai * 128 + wr * 64 + m * 16 + fr;
                if (ri < u.aux1) {
                    bf16_t* dst = R.dst(tok[ai][m]) + cb; const float* g2 = MODL + R.modv(tok[ai][m]) * 6144 + 5120 + cb;
#pragma unroll
                    for (int bj = 0; bj < 2; ++bj) { float f[8]; unpack8(x[m][bj], f);
                        const f32x4 ga = *(const f32x4*)(g2 + bj * 128), gb = *(const f32x4*)(g2 + bj * 128 + 4);
                        const f32x4 a = (f32x4){f[0], f[1], f[2], f[3]} + ga * acc[ai][bj][m][0], b = (f32x4){f[4], f[5], f[6], f[7]} + gb * acc[ai][bj][m][1];
                        u32x4 w; w.x = cvtpk(a[0], a[1]); w.y = cvtpk(a[2], a[3]); w.z = cvtpk(b[0], b[1]); w.w = cvtpk(b[2], b[3]);
                        bf16_t* o = dry ? dry + (size_t)(u.pm * 256 + ri) * 1024 + cb + bj * 128 : dst + bj * 128;
                        *(u32x4*)o = w; }
                } }
            __builtin_amdgcn_sched_barrier(0);
        }
    }
};
#define SBAR() __builtin_amdgcn_sched_barrier(0)
__device__ __forceinline__ int crow(int r, int hi) { return (r & 3) + 8 * (r >> 2) + 4 * hi; }
template <int NCB> __device__ __forceinline__ int v_st(int k, int c) { const int kk = (k & ~0xC) | ((k & 4) << 1) | ((k & 8) >> 1); return ((kk >> 3) * NCB + (c >> 5)) * 512 + ((kk & 7) * 32 + (c & 31)) * 2; }
__device__ __forceinline__ int v_rd_base(int lane) { return ((lane & 3) << 3) | (((lane >> 2) & 3) << 6) | (((lane >> 4) & 1) << 5) | (((lane >> 5) & 1) << 8); }
template <int OFF> __device__ __forceinline__ s16x4 tr_read(int vb) { s16x4 r; asm volatile("ds_read_b64_tr_b16 %0, %1 offset:%2" : "=&v"(r) : "v"(vb), "i"(OFF) : "memory"); return r; }
#define PKLH(L, H) (bf16x8){L[0], L[1], L[2], L[3], H[0], H[1], H[2], H[3]}
template <int NCB, int KS> __device__ __forceinline__ bf16x8 tr_frag(int vb) { const s16x4 l = tr_read<KS * NCB * 1024>(vb), h = tr_read<KS * NCB * 1024 + NCB * 512>(vb); return PKLH(l, h); }
#define PK4(P, BASE, OUT) do { const unsigned a0 = cvtpk(P[BASE + 0], P[BASE + 1]), a1 = cvtpk(P[BASE + 2], P[BASE + 3]);   \
    const unsigned b0 = cvtpk(P[BASE + 4], P[BASE + 5]), b1 = cvtpk(P[BASE + 6], P[BASE + 7]);                              \
    auto r0 = __builtin_amdgcn_permlane32_swap(a0, b0, false, false); auto r1 = __builtin_amdgcn_permlane32_swap(a1, b1, false, false); \
    u32x4 w = {r0[0], r1[0], r0[1], r1[1]}; OUT = __builtin_bit_cast(bf16x8, w); } while (0)

namespace att {
constexpr int DQK = 96, DV = 64, KVBLK = 64;
constexpr int SHM_V = KVBLK * DV * 2;
constexpr int SHM_K = KVBLK * 256;
constexpr float THR = 8.f;
#define KSWZ(row, colB) ((row) * 256 + ((colB) ^ (((row) & 7) << 4)))
__device__ __forceinline__ void partialSM(f32x16& p0, f32x16& p1, float& m_reg, float& alpha) {
    float pmax = p0[0];
#pragma unroll
    for (int r = 1; r < 16; ++r) pmax = fmaxf(pmax, p0[r]);
#pragma unroll
    for (int r = 0; r < 16; ++r) pmax = fmaxf(pmax, p1[r]);
    { auto rr = __builtin_amdgcn_permlane32_swap(__float_as_uint(pmax), __float_as_uint(pmax), false, false);
      pmax = fmaxf(__uint_as_float(rr[0]), __uint_as_float(rr[1])); }
    float mn;
    if (__builtin_expect(__all(pmax - m_reg <= THR), 1)) { mn = m_reg; alpha = 1.f; }
    else { mn = fmaxf(m_reg, pmax); alpha = __builtin_amdgcn_exp2f(m_reg - mn); m_reg = mn; }
#pragma unroll
    for (int r = 0; r < 16; ++r) p0[r] = p0[r] - mn;
#pragma unroll
    for (int r = 0; r < 16; ++r) p1[r] = p1[r] - mn;
#pragma unroll
    for (int r = 0; r < 16; ++r) p0[r] = __builtin_amdgcn_exp2f(p0[r]);
}
__device__ __forceinline__ void finishSM(f32x16& p0, f32x16& p1, float alpha, float& l_reg, bf16x8& pa0, bf16x8& pa1, bf16x8& pa2, bf16x8& pa3) {
#pragma unroll
    for (int r = 0; r < 16; ++r) p1[r] = __builtin_amdgcn_exp2f(p1[r]);
    float ps = 0;
#pragma unroll
    for (int r = 0; r < 16; ++r) ps += p0[r];
#pragma unroll
    for (int r = 0; r < 16; ++r) ps += p1[r];
    { auto rr = __builtin_amdgcn_permlane32_swap(__float_as_uint(ps), __float_as_uint(ps), false, false);
      ps = __uint_as_float(rr[0]) + __uint_as_float(rr[1]); }
    l_reg = l_reg * alpha + ps;
    PK4(p0, 0, pa0); PK4(p0, 8, pa1); PK4(p1, 0, pa2); PK4(p1, 8, pa3);
}
__device__ __forceinline__ void qkt(f32x16& p0, f32x16& p1, const LAS char* Ks, const bf16x8* qr, int r32, int hi) {
    p0 = f32x16{}; p1 = f32x16{};
#pragma unroll
    for (int d0 = 0; d0 < 6; ++d0) { const int cb = (d0 * 16 + hi * 8) * 2;
        const bf16x8 b0 = *(const LAS bf16x8*)(Ks + KSWZ(r32, cb));
        const bf16x8 b1 = *(const LAS bf16x8*)(Ks + KSWZ(32 + r32, cb));
        p0 = __builtin_amdgcn_mfma_f32_32x32x16_bf16(b0, qr[d0], p0, 0, 0, 0);
        p1 = __builtin_amdgcn_mfma_f32_32x32x16_bf16(b1, qr[d0], p1, 0, 0, 0); }
}
template <int D0> __device__ __forceinline__ void pv_one(f32x16& od, int vb, bf16x8 pa0, bf16x8 pa1, bf16x8 pa2, bf16x8 pa3) {
    const bf16x8 f0 = tr_frag<2, 0>(vb + D0 * 512), f1 = tr_frag<2, 1>(vb + D0 * 512), f2 = tr_frag<2, 2>(vb + D0 * 512), f3 = tr_frag<2, 3>(vb + D0 * 512);
    asm volatile("s_waitcnt lgkmcnt(0)" ::: "memory"); SBAR();
    od = __builtin_amdgcn_mfma_f32_32x32x16_bf16(pa0, f0, od, 0, 0, 0);
    od = __builtin_amdgcn_mfma_f32_32x32x16_bf16(pa1, f1, od, 0, 0, 0);
    od = __builtin_amdgcn_mfma_f32_32x32x16_bf16(pa2, f2, od, 0, 0, 0);
    od = __builtin_amdgcn_mfma_f32_32x32x16_bf16(pa3, f3, od, 0, 0, 0);
}
__device__ __forceinline__ void pv_d0(f32x16* o, int vb, bf16x8 pa0, bf16x8 pa1, bf16x8 pa2, bf16x8 pa3) {
    pv_one<0>(o[0], vb, pa0, pa1, pa2, pa3); pv_one<1>(o[1], vb, pa0, pa1, pa2, pa3);
}
__device__ __forceinline__ void attn_unit(const bf16_t* __restrict__ Qb, const bf16_t* __restrict__ Kh, const bf16_t* __restrict__ Vh, bf16_t* __restrict__ Ob, int ldo, int seq, LAS char* lds, const int wv) {
    const int tid = otid(wv), wid = __builtin_amdgcn_readfirstlane(tid >> 6), lane = tid & 63, r32 = lane & 31, hi = lane >> 5;
    LAS char* V_lds = lds; LAS char* K_lds = lds + 2 * SHM_V;
    LAS float* ws = (LAS float*)(lds + 2 * SHM_V + 2 * SHM_K) + wid * 64; LAS float* li_l = ws; LAS float* al_l = ws + 32;
    float m_reg = -1e30f, l_reg = 0; f32x16 o[2] = {}; bf16x8 qr[6];
    const bf16_t* Qw = Qb + (size_t)(wid * 32 + r32) * DQK + hi * 8;
#pragma unroll
    for (int d0 = 0; d0 < 6; ++d0) qr[d0] = *(const bf16x8*)(Qw + d0 * 16);
    const int vrow = tid >> 3, vc = (tid & 7) * 8, vst = v_st<2>(vrow, vc);
    const int krA = tid / 12, kcA = tid - krA * 12, sB = 512 + tid, krB = sB / 12, kcB = sB - krB * 12;
    const int kstA = KSWZ(krA, kcA * 16), kstB = KSWZ(krB, kcB * 16);
    const bool hasB = wid < 4;
    const int vb0 = (int)(size_t)V_lds + v_rd_base(lane);
    struct { bf16x8 v, ka, kb; } sr_[2];
#define SLOAD(i, k0) do { sr_[i].v = *(const bf16x8*)(Vh + (size_t)((k0) + vrow) * DV + vc); sr_[i].ka = *(const bf16x8*)(Kh + (size_t)((k0) + krA) * DQK + kcA * 8); \
    if (hasB) sr_[i].kb = *(const bf16x8*)(Kh + (size_t)((k0) + krB) * DQK + kcB * 8); } while (0)
#define SWRITE(b, i) do { *(LAS bf16x8*)(V_lds + (b) * SHM_V + vst) = sr_[i].v; *(LAS bf16x8*)(K_lds + (b) * SHM_K + kstA) = sr_[i].ka; \
    if (hasB) *(LAS bf16x8*)(K_lds + (b) * SHM_K + kstB) = sr_[i].kb; } while (0)
#define RESC(a) do { if (__any((a) < 1.f)) { if (hi == 0) al_l[r32] = (a); asm volatile("s_waitcnt lgkmcnt(0)" ::: "memory"); \
    _Pragma("unroll") for (int d = 0; d < 2; ++d) _Pragma("unroll") for (int r = 0; r < 16; ++r) o[d][r] *= al_l[crow(r, hi)]; } } while (0)
    f32x16 pA0, pA1, pB0, pB1; float alA, alB; bf16x8 pa0, pa1, pa2, pa3; const int NTL = seq / KVBLK;
    SLOAD(0, 0); SWRITE(0, 0); __syncthreads();
    qkt(pA0, pA1, K_lds, qr, r32, hi); partialSM(pA0, pA1, m_reg, alA);
    SLOAD(1, KVBLK); if (2 < NTL) SLOAD(0, 2 * KVBLK);
    SWRITE(1, 1); __syncthreads();
    for (int j = 1; j + 1 < NTL; j += 2) {
        SBAR(); qkt(pB0, pB1, K_lds + SHM_K, qr, r32, hi);
        finishSM(pA0, pA1, alA, l_reg, pa0, pa1, pa2, pa3); SBAR();
        SLOAD(1, (j + 2) * KVBLK); SBAR();
        pv_d0(o, vb0, pa0, pa1, pa2, pa3); partialSM(pB0, pB1, m_reg, alB);
        __syncthreads(); SWRITE(0, 0);
        RESC(alB); __syncthreads();
        SBAR(); qkt(pA0, pA1, K_lds, qr, r32, hi);
        finishSM(pB0, pB1, alB, l_reg, pa0, pa1, pa2, pa3); SBAR();
        if (j + 3 < NTL) SLOAD(0, (j + 3) * KVBLK); SBAR();
        pv_d0(o, vb0 + SHM_V, pa0, pa1, pa2, pa3); partialSM(pA0, pA1, m_reg, alA);
        __syncthreads(); SWRITE(1, 1);
        RESC(alA); __syncthreads();
    }
    SBAR(); qkt(pB0, pB1, K_lds + SHM_K, qr, r32, hi);
    finishSM(pA0, pA1, alA, l_reg, pa0, pa1, pa2, pa3); SBAR();
    pv_d0(o, vb0, pa0, pa1, pa2, pa3); partialSM(pB0, pB1, m_reg, alB);
    __syncthreads(); RESC(alB);
    finishSM(pB0, pB1, alB, l_reg, pa0, pa1, pa2, pa3); SBAR();
    pv_d0(o, vb0 + SHM_V, pa0, pa1, pa2, pa3);
    if (hi == 0) li_l[r32] = l_reg; asm volatile("s_waitcnt lgkmcnt(0)" ::: "memory");
    float rli[16];
#pragma unroll
    for (int r = 0; r < 16; ++r) rli[r] = __builtin_amdgcn_rcpf(li_l[crow(r, hi)]);
    bf16_t* Ow = Ob + (size_t)(wid * 32) * ldo;
#pragma unroll
    for (int r = 0; r < 16; ++r) { const int orow = crow(r, hi);
#pragma unroll
        for (int d0 = 0; d0 < 2; ++d0) Ow[(size_t)orow * ldo + d0 * 32 + r32] = f2bf(o[d0][r] * rli[r]); }
    __syncthreads();
#undef SLOAD
#undef SWRITE
#undef RESC
}
}

namespace att2 {
constexpr int DQK = 96, DV = 64, KVBLK = 64;
constexpr int KB_BYTES = 64 * 128, VB_BYTES = 64 * 64;
typedef int i32x8 __attribute__((ext_vector_type(8)));
constexpr int SC_K = 0x7d7d7d7d, SC_Q = 0x7a7a7a7a, SC_P = 0x7f7f7f7f, SC_V = 0x7d7d7d7d;
constexpr int NSLOT = 5;
constexpr int LDS_K = 0, LDS_V = NSLOT * KB_BYTES, LDS_WS = LDS_V + NSLOT * VB_BYTES, LDS_TOTAL = LDS_WS + 8 * 64 * 4;
static_assert(LDS_TOTAL <= RING_BYTES, "attention LDS");
constexpr float THR = 4.f;
typedef short v4i16_t __attribute__((ext_vector_type(4)));
__device__ __forceinline__ s16x4 vtr(const LAS char* p) { return __builtin_bit_cast(s16x4, __builtin_amdgcn_ds_read_tr16_b64_v4i16((LAS v4i16_t*)p)); }
#define PP_KLD(B, DH) ({ const int row_ = 32 * (B) + r32, sw_ = (row_ >> 1) & 7, c0_ = 2 * hi + 4 * (DH); \
        const u32x4 a_ = *(const LAS u32x4*)(Kt + row_ * 128 + ((c0_ ^ sw_) << 4)), b_ = *(const LAS u32x4*)(Kt + row_ * 128 + (((c0_ + 1) ^ sw_) << 4)); \
        (i32x8){(int)a_.x, (int)a_.y, (int)a_.z, (int)a_.w, (int)b_.x, (int)b_.y, (int)b_.z, (int)b_.w}; })
#define PP_VLD(DB) ({ const int d_ = 32 * (DB) + r32, sw_ = (d_ >> 2) & 3; \
        const u32x4 a_ = *(const LAS u32x4*)(Vt + d_ * 64 + (((2 * hi) ^ sw_) << 4)), b_ = *(const LAS u32x4*)(Vt + d_ * 64 + (((2 * hi + 1) ^ sw_) << 4)); \
        (i32x8){(int)a_.x, (int)a_.y, (int)a_.z, (int)a_.w, (int)b_.x, (int)b_.y, (int)b_.z, (int)b_.w}; })
#ifdef PROBE_EXP2X
#define PP_EXP(x) do { float a_ = (x), b_ = (x); asm volatile("" : "+v"(b_)); a_ = __builtin_amdgcn_exp2f(a_); b_ = __builtin_amdgcn_exp2f(b_); (x) = (a_ + b_) * 0.5f; } while (0)
#else
#define PP_EXP(x) (x) = __builtin_amdgcn_exp2f(x)
#endif
#define PK4N(P, BASE, OUT) do { u32x4 w_ = {cvtpk(P[BASE + 0], P[BASE + 1]), cvtpk(P[BASE + 2], P[BASE + 3]), cvtpk(P[BASE + 4], P[BASE + 5]), cvtpk(P[BASE + 6], P[BASE + 7])}; OUT = __builtin_bit_cast(bf16x8, w_); } while (0)
#define PP_SLOT_END() do { SBAR(); asm volatile("s_waitcnt vmcnt(%0) lgkmcnt(0)\n\ts_barrier" :: "n"(2 * (NSLOT - 2)) : "memory"); SBAR(); } while (0)
#define PP_BAR() do { SBAR(); asm volatile("s_waitcnt lgkmcnt(0)\n\ts_barrier" ::: "memory"); SBAR(); } while (0)
__device__ __forceinline__ float max3f(float a, float b, float c) { return fmaxf(fmaxf(a, b), c); }
__device__ __forceinline__ void attn_unit_pp(const unsigned char* __restrict__ Qb, const unsigned char* __restrict__ Kh, const unsigned char* __restrict__ Vh, bf16_t* __restrict__ Ob, int ldo, int seq, LAS char* lds, const int wv) {
    const int tid = otid(wv), wid = __builtin_amdgcn_readfirstlane(tid >> 6), lane = tid & 63, r32 = lane & 31, hi = lane >> 5, grp = wid >> 2;
    LAS float* ws = (LAS float*)(lds + LDS_WS) + wid * 64; LAS float* al_l = ws;
    const int NTL = seq / KVBLK;
    unsigned koff, voff;
    { const int s = wid * 64 + lane, row = s >> 3, ch = (s & 7) ^ ((row >> 1) & 7); koff = (unsigned)(row * 128 + ch * 16); }
    { const int s = (wid & 3) * 64 + lane, d = s >> 2, ch = (s & 3) ^ ((d >> 2) & 3); voff = (unsigned)(d * SB + ch * 16); }
    const char* Kg = (const char*)Kh; const char* Vg = (const char*)Vh;
#define PP_DMA_K(t) do { int tt_ = (t); tt_ = tt_ < NTL ? tt_ : NTL - 1; const int sl_ = tt_ % NSLOT; \
        __builtin_amdgcn_global_load_lds((const unsigned*)(Kg + (size_t)tt_ * (64 * 128) + koff), (LAS unsigned*)(lds + LDS_K + sl_ * KB_BYTES + wid * 1024), 16, 0, 0); } while (0)
#define PP_DMA_V(t) do { int tt_ = (t); tt_ = tt_ < NTL ? tt_ : NTL - 1; const int sl_ = tt_ % NSLOT; \
        __builtin_amdgcn_global_load_lds((const unsigned*)(Vg + (size_t)tt_ * 64 + voff), (LAS unsigned*)(lds + LDS_V + sl_ * VB_BYTES + (wid & 3) * 1024), 16, 0, 0); } while (0)
#pragma unroll
    for (int i = 0; i <= NSLOT - 2; ++i) PP_DMA_K(i);
#pragma unroll
    for (int i = 0; i <= NSLOT - 3; ++i) PP_DMA_V(i);
    i32x8 q8[2];
    { const unsigned char* Qw = Qb + (size_t)(wid * 32 + r32) * 128 + hi * 32;
#pragma unroll
      for (int dh = 0; dh < 2; ++dh) { const u32x4 a_ = *(const u32x4*)(Qw + dh * 64), b_ = *(const u32x4*)(Qw + dh * 64 + 16);
          q8[dh] = (i32x8){(int)a_.x, (int)a_.y, (int)a_.z, (int)a_.w, (int)b_.x, (int)b_.y, (int)b_.z, (int)b_.w}; } }
    float m_reg = 0.f; f32x16 o[2] = {}; f32x16 lacc = {}; const i32x8 ones8 = {0x38383838, 0x38383838, 0x38383838, 0x38383838, 0x38383838, 0x38383838, 0x38383838, 0x38383838}; f32x16 negm = {}; asm volatile("" : "+v"(negm));
    f32x16 p0, p1; i32x8 pa8 = {};
    SBAR(); asm volatile("s_waitcnt vmcnt(0) lgkmcnt(0)\n\ts_barrier" ::: "memory"); SBAR();
#ifdef ATTN_TWO_BARRIERS
    if (grp == 1) PP_BAR();
#endif
#define PP_M(t) do { const int t_ = (t), j_ = t_ + 1; \
        if (t_ <= NTL - 2) { PP_DMA_V(t_ + NSLOT - 1); PP_DMA_K(t_ + NSLOT); } \
        i32x8 k8[4]; i32x8 v8[2]; \
        const LAS char* Kt = lds + LDS_K + ((j_ < NTL ? j_ : 0) % NSLOT) * KB_BYTES; \
        const LAS char* Vt = lds + LDS_V + ((t_ < 0 ? 0 : t_) % NSLOT) * VB_BYTES; \
        if (j_ < NTL) { \
            k8[0] = PP_KLD(0, 0); k8[1] = PP_KLD(1, 0); SBAR(); \
            k8[2] = PP_KLD(0, 1); SBAR(); \
            p0 = __builtin_amdgcn_mfma_scale_f32_32x32x64_f8f6f4(k8[0], q8[0], negm, 0, 0, 0, SC_K, 0, SC_Q); SBAR(); \
            k8[3] = PP_KLD(1, 1); SBAR(); \
            p1 = __builtin_amdgcn_mfma_scale_f32_32x32x64_f8f6f4(k8[1], q8[0], negm, 0, 0, 0, SC_K, 0, SC_Q); SBAR(); \
            if (t_ >= 0) { v8[0] = PP_VLD(0); } SBAR(); \
            p0 = __builtin_amdgcn_mfma_scale_f32_32x32x64_f8f6f4(k8[2], q8[1], p0, 0, 0, 0, SC_K, 0, SC_Q); SBAR(); \
            if (t_ >= 0) { v8[1] = PP_VLD(1); } SBAR(); \
            p1 = __builtin_amdgcn_mfma_scale_f32_32x32x64_f8f6f4(k8[3], q8[1], p1, 0, 0, 0, SC_K, 0, SC_Q); SBAR(); \
        } else if (t_ >= 0) { v8[0] = PP_VLD(0); v8[1] = PP_VLD(1); SBAR(); } \
        if (t_ >= 0) { \
            o[0] = __builtin_amdgcn_mfma_scale_f32_32x32x64_f8f6f4(pa8, v8[0], o[0], 0, 0, 0, SC_P, 0, SC_V); \
            o[1] = __builtin_amdgcn_mfma_scale_f32_32x32x64_f8f6f4(pa8, v8[1], o[1], 0, 0, 0, SC_P, 0, SC_V); \
            lacc = __builtin_amdgcn_mfma_scale_f32_32x32x64_f8f6f4(pa8, ones8, lacc, 0, 0, 0, SC_P, 0, SC_P); } \
        asm volatile("" : "+v"(o[0]), "+v"(o[1]), "+v"(p0), "+v"(p1), "+v"(lacc));        \
        } while (0)
#define PP_S(first) do { \
        float a_ = max3f(p0[0], p0[1], p1[0]), b_ = max3f(p0[2], p0[3], p1[1]); a_ = max3f(a_, p1[2], p1[3]); \
        _Pragma("unroll") for (int r = 4; r < 16; r += 4) { a_ = max3f(a_, p0[r], p0[r + 1]); b_ = max3f(b_, p0[r + 2], p0[r + 3]); a_ = max3f(a_, p1[r], p1[r + 1]); b_ = max3f(b_, p1[r + 2], p1[r + 3]); } \
        float rm_ = fmaxf(a_, b_); { auto rr = __builtin_amdgcn_permlane32_swap(__float_as_uint(rm_), __float_as_uint(rm_), false, false); rm_ = fmaxf(__uint_as_float(rr[0]), __uint_as_float(rr[1])); } \
        if (first) { const float dl = rm_ - 4.f; m_reg = dl; _Pragma("unroll") for (int r = 0; r < 16; ++r) { p0[r] -= dl; p1[r] -= dl; } \
            _Pragma("unroll") for (int r = 0; r < 16; ++r) negm[r] = -m_reg; asm volatile("" : "+v"(negm)); } \
        else if (__builtin_expect(__any(rm_ > 2.f * THR), 0)) { const float dl = fmaxf(rm_ - THR, 0.f); m_reg += dl; \
            _Pragma("unroll") for (int r = 0; r < 16; ++r) { p0[r] -= dl; p1[r] -= dl; } \
            _Pragma("unroll") for (int r = 0; r < 16; ++r) negm[r] = -m_reg; asm volatile("" : "+v"(negm)); \
            const float al = __builtin_amdgcn_exp2f(-dl); if (hi == 0) al_l[r32] = al; asm volatile("s_waitcnt lgkmcnt(0)" ::: "memory"); \
            _Pragma("unroll") for (int r = 0; r < 16; ++r) { const float f_ = al_l[crow(r, hi)]; o[0][r] *= f_; o[1][r] *= f_; lacc[r] *= f_; } } \
        _Pragma("unroll") for (int r = 0; r < 16; ++r) { PP_EXP(p0[r]); PP_EXP(p1[r]); } \
        _Pragma("unroll") for (int k_ = 0; k_ < 4; ++k_) { \
            int w_ = __builtin_amdgcn_cvt_pk_fp8_f32(p0[4 * k_], p0[4 * k_ + 1], 0, false); w_ = __builtin_amdgcn_cvt_pk_fp8_f32(p0[4 * k_ + 2], p0[4 * k_ + 3], w_, true); pa8[k_] = w_; \
            int x_ = __builtin_amdgcn_cvt_pk_fp8_f32(p1[4 * k_], p1[4 * k_ + 1], 0, false); x_ = __builtin_amdgcn_cvt_pk_fp8_f32(p1[4 * k_ + 2], p1[4 * k_ + 3], x_, true); pa8[4 + k_] = x_; } \
        asm volatile("" : "+v"(pa8)); } while (0)
#ifdef ATTN_TWO_BARRIERS
    PP_M(-1); PP_SLOT_END();
    PP_S(true); PP_SLOT_END();
#pragma nounroll
    for (int t = 0; t < NTL - 1; ++t) {
        PP_M(t); PP_SLOT_END();
        PP_S(false); PP_SLOT_END();
    }
    PP_M(NTL - 1);
    if (grp == 0) PP_BAR();
#else
#ifdef ATTN_PRIO_YOUNG
    if (grp == 1) __builtin_amdgcn_s_setprio(1);
#endif
    if (grp == 0) {
        PP_M(-1); PP_S(true); PP_SLOT_END();
#pragma nounroll
        for (int t = 0; t < NTL - 1; ++t) { PP_M(t); PP_S(false); PP_SLOT_END(); }
        PP_M(NTL - 1);
    } else {
        PP_M(-1); PP_SLOT_END();
        PP_S(true);
#pragma nounroll
        for (int t = 0; t < NTL - 1; ++t) { PP_M(t); PP_SLOT_END(); PP_S(false); }
        PP_M(NTL - 1);
    }
#ifdef ATTN_PRIO_YOUNG
    __builtin_amdgcn_s_setprio(0);
#endif
#endif
    float rli[16];
#pragma unroll
    for (int r = 0; r < 16; ++r) rli[r] = __builtin_amdgcn_rcpf(lacc[r]);
    bf16_t* Ow = Ob + (size_t)(wid * 32) * ldo;
#pragma unroll
    for (int r = 0; r < 16; ++r) { const int orow = crow(r, hi);
#pragma unroll
        for (int d0 = 0; d0 < 2; ++d0) Ow[(size_t)orow * ldo + d0 * 32 + r32] = f2bf(o[d0][r] * rli[r]); }
    SBAR(); asm volatile("s_waitcnt vmcnt(0) lgkmcnt(0)\n\ts_barrier" ::: "memory"); SBAR();
#undef PP_DMA_K
#undef PP_DMA_V
#undef PP_M
#undef PP_S
}
}

__device__ __forceinline__ void retu_unit(int unit, const bf16_t* PR, float* U, float lg2f, float lg2b, LAS char* lds, const int wv) {
    const int tid = otid(wv), wid = __builtin_amdgcn_readfirstlane(tid >> 6), lane = tid & 63, r32 = lane & 31, hi = lane >> 5;
    const int h = unit & 3, bc = unit >> 2, bl = bc / NCHUNK, c = bc - bl * NCHUNK;
    const size_t r0 = (size_t)bl * SB + (size_t)c * 128;
    LAS char* Vt = lds;
    LAS char* Kf = lds + 32768;
    LAS char* Kb = lds + 49152;
#pragma unroll
    for (int i = 0; i < 2; ++i) { const int ch = tid + i * 512, j = ch >> 3, c8 = (ch & 7) * 8;
        const u32x4 kw = *(const u32x4*)(PR + (r0 + j) * 1536 + 256 + h * 64 + c8);
        float f[8], g[8]; unpack8(kw, f);
        const float wf = __builtin_amdgcn_exp2f(lg2f * (float)(127 - j)), wb = __builtin_amdgcn_exp2f(lg2b * (float)j);
#pragma unroll
        for (int k = 0; k < 8; ++k) { g[k] = f[k] * wb; f[k] *= wf; }
        const int off = (j >> 6) * 8192 + v_st<2>(j & 63, c8);
        *(LAS u32x4*)(Kf + off) = pack8(f); *(LAS u32x4*)(Kb + off) = pack8(g); }
#pragma unroll
    for (int i = 0; i < 4; ++i) { const int ch = tid + i * 512, j = ch >> 4, c8 = (ch & 15) * 8;
        const u32x4 vw = *(const u32x4*)(PR + (r0 + j) * 1536 + 512 + h * 128 + c8);
        *(LAS u32x4*)(Vt + (j >> 6) * 16384 + v_st<4>(j & 63, c8)) = vw; }
    __syncthreads();
    const int eblk = wid & 3, dblk = wid >> 2;
    const int vbV = (int)(size_t)Vt + v_rd_base(lane) + eblk * 512, vbF = (int)(size_t)Kf + v_rd_base(lane) + dblk * 512, vbB = (int)(size_t)Kb + v_rd_base(lane) + dblk * 512;
    f32x16 aF = {}, aB = {};
#define RU_STEP(SUB, KS) do { const bf16x8 a = tr_frag<4, KS>(vbV + SUB * 16384), bf = tr_frag<2, KS>(vbF + SUB * 8192), bb = tr_frag<2, KS>(vbB + SUB * 8192); \
        asm volatile("s_waitcnt lgkmcnt(0)" ::: "memory"); SBAR(); \
        aF = __builtin_amdgcn_mfma_f32_32x32x16_bf16(a, bf, aF, 0, 0, 0); aB = __builtin_amdgcn_mfma_f32_32x32x16_bf16(a, bb, aB, 0, 0, 0); } while (0)
    RU_STEP(0, 0); RU_STEP(0, 1); RU_STEP(0, 2); RU_STEP(0, 3); RU_STEP(1, 0); RU_STEP(1, 1); RU_STEP(1, 2); RU_STEP(1, 3);
#undef RU_STEP
    float* Uf = U + (size_t)unit * 2 * 8192; float* Ub = Uf + 8192;
#pragma unroll
    for (int r = 0; r < 16; ++r) { const int e = 32 * eblk + crow(r, hi), d = 32 * dblk + r32; Uf[e * 64 + d] = aF[r]; Ub[e * 64 + d] = aB[r]; }
    __syncthreads();
}

__device__ __forceinline__ void retout_unit(int unit, const bf16_t* PR, const bf16_t* S, const float* gnw, bf16_t* ACT, float lg2f, float lg2b, LAS char* lds, const int wv) {
    const int tid = otid(wv), wid = __builtin_amdgcn_readfirstlane(tid >> 6), lane = tid & 63, r32 = lane & 31, hi = lane >> 5;
    const int h = unit & 3, bc = unit >> 2, bl = bc / NCHUNK, c = bc - bl * NCHUNK;
    const size_t r0 = (size_t)bl * SB + (size_t)c * 128;
    LAS char* Vt = lds; LAS float* part = (LAS float*)(lds + 32768);
    const int qblk = wid & 3, ehalf = wid >> 2, iq = 32 * qblk + r32;
    u32x4 vw[4];
#pragma unroll
    for (int i = 0; i < 4; ++i) { const int ch = tid + i * 512, j = ch >> 4, c8 = (ch & 15) * 8; vw[i] = *(const u32x4*)(PR + (r0 + j) * 1536 + 512 + h * 128 + c8); }
    bf16x8 qf[4], kf[4][4];
    { const bf16_t* qp = PR + (r0 + iq) * 1536 + h * 64 + hi * 8;
#pragma unroll
      for (int d0 = 0; d0 < 4; ++d0) qf[d0] = *(const bf16x8*)(qp + d0 * 16); }
#pragma unroll
    for (int jb = 0; jb < 4; ++jb) { const bf16_t* kp = PR + (r0 + 32 * jb + r32) * 1536 + 256 + h * 64 + hi * 8;
#pragma unroll
        for (int d0 = 0; d0 < 4; ++d0) kf[jb][d0] = *(const bf16x8*)(kp + d0 * 16); }
    const int orow = tid >> 2, oc = (tid & 3) * 32;
    u32x4 gw[4];
#pragma unroll
    for (int k = 0; k < 4; ++k) gw[k] = *(const u32x4*)(PR + (r0 + orow) * 1536 + 1024 + h * 128 + oc + 8 * k);
#pragma unroll
    for (int i = 0; i < 4; ++i) { const int ch = tid + i * 512, j = ch >> 4, c8 = (ch & 15) * 8; *(LAS u32x4*)(Vt + (j >> 6) * 16384 + v_st<4>(j & 63, c8)) = vw[i]; }
    f32x16 o[2] = {};
    __syncthreads();
    bf16x8 sf[2][4], sb[2][4];
    { const bf16_t* Sf = S + (size_t)unit * 2 * 8192; const bf16_t* Sb = Sf + 8192;
#pragma unroll
      for (int e0 = 0; e0 < 2; ++e0) { const int e = 64 * ehalf + 32 * e0 + r32;
#pragma unroll
        for (int d0 = 0; d0 < 4; ++d0) { sf[e0][d0] = *(const bf16x8*)(Sf + e * 64 + d0 * 16 + hi * 8); sb[e0][d0] = *(const bf16x8*)(Sb + e * 64 + d0 * 16 + hi * 8); } } }
    const int vb = (int)(size_t)Vt + v_rd_base(lane) + ehalf * 1024;
#pragma unroll
    for (int jb = 0; jb < 4; ++jb) {
        f32x16 p = {};
#pragma unroll
        for (int d0 = 0; d0 < 4; ++d0) p = __builtin_amdgcn_mfma_f32_32x32x16_bf16(kf[jb][d0], qf[d0], p, 0, 0, 0);
#pragma unroll
        for (int r = 0; r < 16; ++r) { const int dj = iq - (32 * jb + crow(r, hi));
            const float e = dj >= 0 ? lg2f * (float)dj : lg2b * (float)(-dj); p[r] *= __builtin_amdgcn_exp2f(e); }
        bf16x8 pa0, pa1; PK4(p, 0, pa0); PK4(p, 8, pa1);
        const int vj = vb + (jb >> 1) * 16384;
        if (jb & 1) {
            const bf16x8 f00 = tr_frag<4, 2>(vj), f01 = tr_frag<4, 3>(vj), f10 = tr_frag<4, 2>(vj + 512), f11 = tr_frag<4, 3>(vj + 512);
            asm volatile("s_waitcnt lgkmcnt(0)" ::: "memory"); SBAR();
            o[0] = __builtin_amdgcn_mfma_f32_32x32x16_bf16(pa0, f00, o[0], 0, 0, 0); o[0] = __builtin_amdgcn_mfma_f32_32x32x16_bf16(pa1, f01, o[0], 0, 0, 0);
            o[1] = __builtin_amdgcn_mfma_f32_32x32x16_bf16(pa0, f10, o[1], 0, 0, 0); o[1] = __builtin_amdgcn_mfma_f32_32x32x16_bf16(pa1, f11, o[1], 0, 0, 0);
        } else {
            const bf16x8 f00 = tr_frag<4, 0>(vj), f01 = tr_frag<4, 1>(vj), f10 = tr_frag<4, 0>(vj + 512), f11 = tr_frag<4, 1>(vj + 512);
            asm volatile("s_waitcnt lgkmcnt(0)" ::: "memory"); SBAR();
            o[0] = __builtin_amdgcn_mfma_f32_32x32x16_bf16(pa0, f00, o[0], 0, 0, 0); o[0] = __builtin_amdgcn_mfma_f32_32x32x16_bf16(pa1, f01, o[0], 0, 0, 0);
            o[1] = __builtin_amdgcn_mfma_f32_32x32x16_bf16(pa0, f10, o[1], 0, 0, 0); o[1] = __builtin_amdgcn_mfma_f32_32x32x16_bf16(pa1, f11, o[1], 0, 0, 0);
        }
    }
    {
        const float xf = __builtin_amdgcn_exp2f(lg2f * (float)(iq + 1)), xb = __builtin_amdgcn_exp2f(lg2b * (float)(128 - iq));
#pragma unroll
        for (int d0 = 0; d0 < 4; ++d0) {
            float f[8], g[8]; unpack8(__builtin_bit_cast(u32x4, qf[d0]), f);
#pragma unroll
            for (int k = 0; k < 8; ++k) { g[k] = f[k] * xb; f[k] *= xf; }
            const bf16x8 qa = __builtin_bit_cast(bf16x8, pack8(f)), qb = __builtin_bit_cast(bf16x8, pack8(g));
#pragma unroll
            for (int e0 = 0; e0 < 2; ++e0) { o[e0] = __builtin_amdgcn_mfma_f32_32x32x16_bf16(qa, sf[e0][d0], o[e0], 0, 0, 0); o[e0] = __builtin_amdgcn_mfma_f32_32x32x16_bf16(qb, sb[e0][d0], o[e0], 0, 0, 0); }
        }
    }
    float sq[16];
#pragma unroll
    for (int r = 0; r < 16; ++r) { float s = o[0][r] * o[0][r] + o[1][r] * o[1][r];
        sq[r] = sum32(s); }
    if (r32 == 0) {
#pragma unroll
        for (int r = 0; r < 16; ++r) part[wid * 32 + crow(r, hi)] = sq[r];
    }
    __syncthreads();
    const float g0 = gnw[h * 128 + 64 * ehalf + r32], g1 = gnw[h * 128 + 64 * ehalf + 32 + r32];
    LAS bf16_t* stg = (LAS bf16_t*)Vt;
#pragma unroll
    for (int r = 0; r < 16; ++r) { const int il = crow(r, hi);
        const float tot = part[wid * 32 + il] + part[(wid ^ 4) * 32 + il];
        const float rn = rsqrtf(tot * (1.f / 128.f) + RMS_EPS);
        LAS bf16_t* sp = stg + (32 * qblk + il) * 128 + 64 * ehalf + r32;
        sp[0] = f2bf(o[0][r] * rn * g0); sp[32] = f2bf(o[1][r] * rn * g1); }
    __syncthreads();
#pragma unroll
    for (int k = 0; k < 4; ++k) { float y[8], g[8]; unpack8(*(const LAS u32x4*)(stg + orow * 128 + oc + 8 * k), y); unpack8(gw[k], g);
#pragma unroll
        for (int q = 0; q < 8; ++q) y[q] *= siluf_(g[q]);
        *(u32x4*)(ACT + (r0 + orow) * 1536 + h * 128 + oc + 8 * k) = pack8(y); }
    __syncthreads();
}
struct Args { const float* in[26]; float* out; unsigned char* ws; int ph_lo, ph_hi; };
struct Frame {
    LAS unsigned char* lds; int G, wv;
    const Args* a; float* out; unsigned char* ws;
};
__device__ __forceinline__ const float* in_ptr(const Args* a, int i) { int z; asm volatile("s_mov_b32 %0, 0" : "=s"(z)); return a->in[i + z]; }
#define INP(i) in_ptr(F.a, (i))
__device__ __forceinline__ unsigned char* ows(unsigned char* p) { asm volatile("" : "+s"(p)); return p; }
#ifdef SELFCHECK_ATTN
#define WSP(T, off) ((T*)(ows(F.ws) + (off)))
#else
#define WSP(T, off) ((T*)(F.ws + (off)))
#endif

__device__ __forceinline__ int srccol_in(int n) {
    if (n < 512) { const int base = n & ~255, hh = (n & 255) >> 6, p = n & 63; return base + hh * 64 + (p >> 1) + 32 * (p & 1); }
    if (n < 2048) return n;
    if (n < 3072) { const int j = (n - 2048) >> 1; return 2048 + j + 512 * (n & 1); }
    if (n < 3712) return n;
    if (n < 3744) { const int p = n - 3712, a = p >> 4, q = p & 15; return 3712 + a * 16 + (q >> 1) + 8 * (q & 1); }
    if (n < 3840) return -1;
    return n - 96;
}
__device__ __forceinline__ int srccol_uq(int n) { const int h = n / 96, d = n - h * 96; if (d < 64) return n; const int p = d - 64, a = p >> 4, q = p & 15; return h * 96 + 64 + a * 16 + (q >> 1) + 8 * (q & 1); }

__device__ __forceinline__ void cvt_item(const float* sp, int ldw, const float* scale, bf16_t* dst, int ldd, int n0, int k0, LAS float* scr, int lane) {
    float vv[32];
#pragma unroll
    for (int i = 0; i < 32; ++i) { const int kk = 2 * i + (lane >> 5); vv[i] = sp ? sp[(size_t)(k0 + kk) * ldw] : 0.f; }
    if (scale) {
#pragma unroll
        for (int i = 0; i < 32; ++i) vv[i] *= scale[k0 + 2 * i + (lane >> 5)];
    }
#pragma unroll
    for (int i = 0; i < 32; ++i) scr[(2 * i + (lane >> 5)) * 33 + (lane & 31)] = vv[i];
    asm volatile("s_waitcnt lgkmcnt(0)" ::: "memory");
    const int c = lane & 7;
#pragma unroll
    for (int j = 0; j < 4; ++j) { const int n = (lane >> 3) + 8 * j; const LAS float* s = scr + (8 * c) * 33 + n;
        u32x4 o; o.x = cvtpk(s[0 * 33], s[1 * 33]); o.y = cvtpk(s[2 * 33], s[3 * 33]); o.z = cvtpk(s[4 * 33], s[5 * 33]); o.w = cvtpk(s[6 * 33], s[7 * 33]);
        *(u32x4*)(dst + (size_t)(n0 + n) * ldd + k0 + 8 * c) = o; }
    asm volatile("s_waitcnt lgkmcnt(0)" ::: "memory");
}

__device__ __forceinline__ void cvt_item_fp8(const float* sp, int ldw, float sc, unsigned char* dst, int ldd, int n0, int k0, LAS float* scr, int lane) {
    float vv[32];
#pragma unroll
    for (int i = 0; i < 32; ++i) { const int kk = 2 * i + (lane >> 5); vv[i] = sp[(size_t)(k0 + kk) * ldw] * sc; }
#pragma unroll
    for (int i = 0; i < 32; ++i) scr[(2 * i + (lane >> 5)) * 33 + (lane & 31)] = vv[i];
    asm volatile("s_waitcnt lgkmcnt(0)" ::: "memory");
    const int c = lane & 7;
#pragma unroll
    for (int j = 0; j < 4; ++j) { const int n = (lane >> 3) + 8 * j; const LAS float* s = scr + (8 * c) * 33 + n;
        float f[8];
#pragma unroll
        for (int q = 0; q < 8; ++q) f[q] = s[q * 33];
        *(u32x2*)(dst + (size_t)(n0 + n) * ldd + k0 + 8 * c) = pack8_fp8(f); }
    asm volatile("s_waitcnt lgkmcnt(0)" ::: "memory");
}
__device__ __forceinline__ f32x2 cossin_f(float ang) {
    const double x = (double)ang * 0.15915494309189535; const float r = (float)(x - rint(x));
    return (f32x2){__builtin_amdgcn_cosf(r), __builtin_amdgcn_sinf(r)};
}
__device__ __forceinline__ float lg2_gamma(const float* rd) { return -__builtin_amdgcn_logf(1.f + __builtin_amdgcn_exp2f(-rd[0] * LOG2E)); }
#define PHASE_IDS const int tid = otid(F.wv), lane = tid & 63, wave = __builtin_amdgcn_readfirstlane(tid >> 6), bid = obid(); (void)lane; (void)wave; (void)bid;
__device__ __forceinline__ void p0_prologue(Frame& F) {
    PHASE_IDS
    __syncthreads();
    if (bid < 48) {
        LAS float* sc = (LAS float*)F.lds;
        LAS float* red = (LAS float*)(F.lds + 40960);
        for (int i = tid; i < 9 * 1024; i += 512) { const int v = i >> 10, k = i & 1023; const float x = v < 8 ? INP(1)[v * 1024 + k] : INP(3)[k]; sc[i] = siluf_(x); }
        __syncthreads();
        const int l = bid / 24, col = (bid % 24) * 256 + (tid & 255), kq = tid >> 8;
        const float* w = INP(4) + (size_t)l * 1024 * 6144 + col;
        float a[9];
#pragma unroll
        for (int v = 0; v < 9; ++v) a[v] = 0.f;
#pragma nounroll
        for (int k = kq * 512; k < kq * 512 + 512; k += 16) {
            float wv_[16];
#pragma unroll
            for (int j = 0; j < 16; ++j) wv_[j] = w[(size_t)(k + j) * 6144];
#pragma unroll
            for (int j4 = 0; j4 < 4; ++j4)
#pragma unroll
                for (int v = 0; v < 9; ++v) { const f32x4 s = *(const LAS f32x4*)(sc + v * 1024 + k + 4 * j4); a[v] += (s[0] * wv_[4 * j4] + s[1] * wv_[4 * j4 + 1]) + (s[2] * wv_[4 * j4 + 2] + s[3] * wv_[4 * j4 + 3]); }
        }
        if (kq == 1) {
#pragma unroll
            for (int v = 0; v < 9; ++v) red[v * 256 + (tid & 255)] = a[v];
        }
        __syncthreads();
        if (kq == 0) { float* MOD = WSP(float, WS_MOD) + (size_t)l * 9 * 6144; const float b = INP(5)[l * 6144 + col];
#pragma unroll
            for (int v = 0; v < 9; ++v) MOD[v * 6144 + col] = b + a[v] + red[v * 256 + tid]; }
        __syncthreads();
    }
    { f32x2* RT = WSP(f32x2, WS_RT); f32x2* MT = WSP(f32x2, WS_MT);
      for (int i = bid * 512 + tid; i < 8192 * 32 + 128 * 8; i += F.G * 512) {
          if (i < 8192 * 32) { const int t = i >> 5, k = i & 31; const float inv = exp2f(-(float)k * (13.287712379549449f / 32.f)); RT[i] = cossin_f((float)t * inv); }
          else { const int q = i - 8192 * 32, pos = q >> 3, k = q & 7; const float inv = exp2f(-(float)k * (13.287712379549449f / 8.f)); MT[q] = cossin_f((float)pos * inv); } } }
    LAS float* scr = (LAS float*)(F.lds + wave * 16384);
    const int gw = bid * 8 + wave, NGW = F.G * 8;
    constexpr int I_G8 = 2 * 16 * 96; constexpr int I_IN = 2 * 16 * 216, I_CAT = 2 * 3 * 8 * 32, I_OUT = 2 * 16 * 32, I_UQ = 2 * 6 * 24, I_UKV = 2 * 4 * 32, I_UP = 32 * 16 * 32, I_W2 = 32 * 8 * 32;
    constexpr int NITEMS = I_IN + I_CAT + I_OUT + I_UQ + I_UKV + I_UP + I_W2 + I_G8;
    for (int it = gw; it < NITEMS; it += NGW) {
        int r = it;
        if (r < I_IN) { const int l = r / 3456, q = r % 3456, kb = q / 216, nb = q % 216; const int sc_ = srccol_in(nb * 32 + (lane & 31));
            cvt_item(sc_ >= 0 ? INP(8) + (size_t)l * 1024 * INCOLS + sc_ : nullptr, INCOLS, nullptr, WSP(bf16_t, WS_WIN) + (size_t)l * INW * 1024, 1024, nb * 32, kb * 64, scr, lane); continue; } r -= I_IN;
        if (r < I_CAT) { const int l = r / 768, q = r % 768, seg = q / 256, q2 = q % 256, kb = q2 / 32, nb = q2 % 32; const float* W = seg == 0 ? INP(11) : (seg == 1 ? INP(13) : INP(18));
            cvt_item(W + (size_t)l * 512 * 1024 + nb * 32 + (lane & 31), 1024, nullptr, WSP(bf16_t, WS_WCAT) + (size_t)l * 1024 * 1536 + seg * 512, 1536, nb * 32, kb * 64, scr, lane); continue; } r -= I_CAT;
        if (r < I_OUT) { const int l = r / 512, q = r % 512, kb = q / 32, nb = q % 32;
            cvt_item(INP(19) + (size_t)l * 1024 * 1024 + nb * 32 + (lane & 31), 1024, nullptr, WSP(bf16_t, WS_WOUT) + (size_t)l * 1024 * 1024, 1024, nb * 32, kb * 64, scr, lane); continue; } r -= I_OUT;
        if (r < I_UQ) { const int l = r / 144, q = r % 144, kb = q / 24, nb = q % 24;
            cvt_item(INP(15) + (size_t)l * 384 * 768 + srccol_uq(nb * 32 + (lane & 31)), 768, INP(14) + l * 384, WSP(bf16_t, WS_WUQ) + (size_t)l * 768 * 384, 384, nb * 32, kb * 64, scr, lane); continue; } r -= I_UQ;
        if (r < I_UKV) { const int l = r / 128, q = r % 128, kb = q / 32, nb = q % 32;
            cvt_item(INP(17) + (size_t)l * 256 * 1024 + nb * 32 + (lane & 31), 1024, INP(16) + l * 256, WSP(bf16_t, WS_WUKV) + (size_t)l * 1024 * 256, 256, nb * 32, kb * 64, scr, lane); continue; } r -= I_UKV;
        if (r < I_UP) { const int le = r / 512, q = r % 512, kb = q / 32, nb = q % 32; const int n = nb * 32 + (lane & 31);
            const float* W = (n & 1) ? INP(23) : INP(22);
            cvt_item(W + (size_t)le * 1024 * 512 + (n >> 1), 512, nullptr, WSP(bf16_t, WS_WUP) + (size_t)le * 1024 * 1024, 1024, nb * 32, kb * 64, scr, lane); continue; } r -= I_UP;
        if (r < I_W2) { const int le = r / 256, q = r % 256, kb = q / 32, nb = q % 32;
            cvt_item(INP(24) + (size_t)le * 512 * 1024 + nb * 32 + (lane & 31), 1024, nullptr, WSP(bf16_t, WS_W2T) + (size_t)le * 1024 * 512, 512, nb * 32, kb * 64, scr, lane); continue; } r -= I_W2;
        { const int l = r / 1536, q = r % 1536, kb = q / 96, nb = q % 96;
            cvt_item_fp8(INP(8) + (size_t)l * 1024 * INCOLS + 3744 + nb * 32 + (lane & 31), INCOLS, WG8S, WSP(unsigned char, WS_WIN8) + (size_t)l * 3072 * 1024, 1024, nb * 32, kb * 64, scr, lane); }
    }
}

__device__ __forceinline__ void norm1_phase(Frame& F, const Resid& R, int l, int skip_none) {
    PHASE_IDS
    const int gw = bid * 8 + wave, NGW = F.G * 8; bf16_t* HX = WSP(bf16_t, WS_HX);
    const float* MODL = WSP(float, WS_MOD) + (size_t)l * 9 * 6144; const float* nw = INP(6) + l * 1024;
    for (int row = gw; row < NT; row += NGW) {
        const float* md = MODL + R.modv(row) * 6144;
        f32x4 v[4]; float s = 0.f;
        int sf32 = R.src_f32; asm volatile("" : "+s"(sf32));
        if (sf32) { const f32x4* xr = (const f32x4*)R.srcf(row) + lane;
#pragma unroll
            for (int j = 0; j < 4; ++j) v[j] = xr[64 * j]; }
        else { const u32x2* xr = (const u32x2*)R.dst(row) + lane;
#pragma unroll
            for (int j = 0; j < 4; ++j) { const u32x2 w = xr[64 * j]; v[j] = (f32x4){bf_lo(w.x), bf_hi(w.x), bf_lo(w.y), bf_hi(w.y)}; } }
#pragma unroll
        for (int j = 0; j < 4; ++j) s += (v[j][0] * v[j][0] + v[j][1] * v[j][1]) + (v[j][2] * v[j][2] + v[j][3] * v[j][3]);
        const float rs = rsqrtf(wave_sum(s) * (1.f / DM) + RMS_EPS);
#pragma unroll
        for (int j = 0; j < 4; ++j) { const int c = 4 * lane + 256 * j; const f32x4 w = *(const f32x4*)(nw + c), sh = *(const f32x4*)(md + c), sc = *(const f32x4*)(md + 1024 + c);
            const f32x4 y = v[j] * rs * w * (sc + 1.f) + sh; u32x2 o; o.x = cvtpk(y[0], y[1]); o.y = cvtpk(y[2], y[3]); *(u32x2*)(HX + (size_t)row * 1024 + c) = o;
            int q8_ = __builtin_amdgcn_cvt_pk_fp8_f32(y[0] * HX8S, y[1] * HX8S, 0, false); q8_ = __builtin_amdgcn_cvt_pk_fp8_f32(y[2] * HX8S, y[3] * HX8S, q8_, true);
            *(int*)(WSP(unsigned char, WS_HX8) + (size_t)row * 1024 + c) = q8_; }
    }
}
__device__ __forceinline__ void final_norm_phase(Frame& F, int g) {
    PHASE_IDS
    const int gw = bid * 8 + wave, NGW = F.G * 8; const float* nw = INP(25);
    for (int row = gw; row < GB * SEQ; row += NGW) {
        f32x4* xr = (f32x4*)(F.out + ((size_t)g * GB * SEQ + row) * DM) + lane;
        const u32x2* xb = (const u32x2*)(WSP(bf16_t, WS_XRES) + ((size_t)g * GB * SEQ + row) * DM) + lane;
        f32x4 v[4]; float s = 0.f;
#pragma unroll
        for (int j = 0; j < 4; ++j) { const u32x2 w = xb[64 * j]; v[j] = (f32x4){bf_lo(w.x), bf_hi(w.x), bf_lo(w.y), bf_hi(w.y)}; s += (v[j][0] * v[j][0] + v[j][1] * v[j][1]) + (v[j][2] * v[j][2] + v[j][3] * v[j][3]); }
        const float rs = rsqrtf(wave_sum(s) * (1.f / DM) + RMS_EPS);
#pragma unroll
        for (int j = 0; j < 4; ++j) { const f32x4 w = *(const f32x4*)(nw + 4 * lane + 256 * j); xr[64 * j] = v[j] * rs * w; }
    }
}
__device__ __forceinline__ void conv_phase(Frame& F, int l) {
    PHASE_IDS
    const bf16_t* PC = WSP(bf16_t, WS_PC); bf16_t* ACT = WSP(bf16_t, WS_ACT); const float* cw = INP(12) + (size_t)l * 512 * 3;
    for (int idx = bid * 512 + tid; idx < NT * 64; idx += F.G * 512) {
        const int row = idx >> 6, c8 = (idx & 63) * 8; const int bl = row / SB, s = row - bl * SB;
        const bool hp = (s != 0) && (s != CTXL), hn = (s != CTXL - 1) && (s != SB - 1);
        const bf16_t* p = PC + (size_t)row * 1024 + c8;
        float b[8], u0[8], um[8], up[8];
        unpack8(*(const u32x4*)p, b); unpack8(*(const u32x4*)(p + 512), u0);
        if (hp) unpack8(*(const u32x4*)(p + 512 - 1024), um); else {
#pragma unroll
            for (int k = 0; k < 8; ++k) um[k] = 0.f; }
        if (hn) unpack8(*(const u32x4*)(p + 512 + 1024), up); else {
#pragma unroll
            for (int k = 0; k < 8; ++k) up[k] = 0.f; }
        float o[8];
#pragma unroll
        for (int k = 0; k < 8; ++k) { const float* w = cw + (c8 + k) * 3; o[k] = b[k] * (um[k] * w[0] + u0[k] * w[1] + up[k] * w[2]); }
        *(u32x4*)(ACT + (size_t)row * 1536 + 512 + c8) = pack8(o);
    }
}
__device__ __forceinline__ void scan_phase(Frame& F, int l) {
    PHASE_IDS
    const float* U = WSP(float, WS_HX); bf16_t* S = WSP(bf16_t, WS_PM);
    for (int idx = bid * 512 + tid; idx < GB * 4 * 2 * 8192; idx += F.G * 512) {
        const int ed = idx & 8191, dir = (idx >> 13) & 1, h = (idx >> 14) & 3, bl = idx >> 16;
        const float lg = lg2_gamma(INP(9) + l * 8 + dir * 4 + h); const float dec = __builtin_amdgcn_exp2f(lg * 128.f);
        float st = 0.f;
        for (int i0 = 0; i0 < NCHUNK; i0 += 6) {
            float uu[6]; size_t off[6];
#pragma unroll
            for (int k = 0; k < 6; ++k) { const int i = i0 + k; const int c = dir ? (i < 2 ? 1 - i : NCHUNK + 1 - i) : i;
                off[k] = ((size_t)(((bl * NCHUNK + c) * 4 + h) * 2 + dir)) * 8192 + ed; uu[k] = U[off[k]]; }
#pragma unroll
            for (int k = 0; k < 6; ++k) { S[off[k]] = f2bf(st); st = dec * st + uu[k]; }
        }
    }
}
template <int NR>
__device__ __forceinline__ void n2_rows(const Resid& R, const int (&rows)[NR], const int (&slot)[NR], const float* MODL, const float* nw, bf16_t* H2, const LAS float* wr, LAS float* lg, int lane) {
    f32x4 v[NR][4]; float s[NR];
#pragma unroll
    for (int q = 0; q < NR; ++q) { const u32x2* xr = (const u32x2*)R.dst(rows[q]) + lane; s[q] = 0.f;
#pragma unroll
        for (int j = 0; j < 4; ++j) { const u32x2 w_ = xr[64 * j]; v[q][j] = (f32x4){bf_lo(w_.x), bf_hi(w_.x), bf_lo(w_.y), bf_hi(w_.y)}; s[q] += (v[q][j][0] * v[q][j][0] + v[q][j][1] * v[q][j][1]) + (v[q][j][2] * v[q][j][2] + v[q][j][3] * v[q][j][3]); } }
#pragma unroll
    for (int q = 0; q < NR; ++q) s[q] = rsqrtf(wave_sum(s[q]) * (1.f / DM) + RMS_EPS);
#pragma unroll
    for (int q = 0; q < NR; ++q) { const float* md = MODL + R.modv(rows[q]) * 6144;
#pragma unroll
        for (int j = 0; j < 4; ++j) { const int c = 4 * lane + 256 * j; const f32x4 w = *(const f32x4*)(nw + c), sh = *(const f32x4*)(md + 3072 + c), sc = *(const f32x4*)(md + 4096 + c);
            v[q][j] = v[q][j] * s[q] * w * (sc + 1.f) + sh; u32x2 o; o.x = cvtpk(v[q][j][0], v[q][j][1]); o.y = cvtpk(v[q][j][2], v[q][j][3]); *(u32x2*)(H2 + (size_t)rows[q] * 1024 + c) = o; } }
    const int b4 = (lane >> 4) & 1, b3 = (lane >> 3) & 1, b2 = (lane >> 2) & 1;
#pragma unroll
    for (int q = 0; q < NR; ++q) {
        float a[16];
#pragma unroll
        for (int e = 0; e < 16; ++e) { float t = 0.f;
#pragma unroll
            for (int j = 0; j < 4; ++j) { const f32x4 w = *(const LAS f32x4*)(wr + e * 1024 + 4 * lane + 256 * j); t += (v[q][j][0] * w[0] + v[q][j][1] * w[1]) + (v[q][j][2] * w[2] + v[q][j][3] * w[3]); }
            a[e] = t; }
        float s8[8], s4[4], s2[2];
#pragma unroll
        for (int k = 0; k < 8; ++k) { auto r = __builtin_amdgcn_permlane32_swap(__float_as_uint(a[k]), __float_as_uint(a[k + 8]), false, false); s8[k] = __uint_as_float(r[0]) + __uint_as_float(r[1]); }
#pragma unroll
        for (int k = 0; k < 4; ++k) { const float snd = b4 ? s8[k] : s8[k + 4], kp = b4 ? s8[k + 4] : s8[k]; s4[k] = kp + swz_xor<16>(snd); }
#pragma unroll
        for (int k = 0; k < 2; ++k) { const float snd = b3 ? s4[k] : s4[k + 2], kp = b3 ? s4[k + 2] : s4[k]; s2[k] = kp + swz_xor<8>(snd); }
        float s1; { const float snd = b2 ? s2[0] : s2[1], kp = b2 ? s2[1] : s2[0]; s1 = kp + swz_xor<4>(snd); }
        s1 += swz_xor<2>(s1); s1 += swz_xor<1>(s1);
        if ((lane & 3) == 0) lg[slot[q] * 16 + (lane >> 2)] = s1;
    }
}
__device__ __forceinline__ void norm2_router_phase(Frame& F, const Resid& R, int l, int g, int lat_only, int cslot) {
    PHASE_IDS
    bf16_t* H2 = WSP(bf16_t, WS_HX);
    const float* MODL = WSP(float, WS_MOD) + (size_t)l * 9 * 6144; const float* nw = INP(7) + l * 1024;
    LAS float* wr = (LAS float*)F.lds; LAS float* lg = (LAS float*)(F.lds + 65536);
    { const float* wrt = INP(20); for (int i = tid; i < 16 * 1024; i += 512) wr[i] = wrt[(i & 1023) * 16 + (i >> 10)]; }
    __syncthreads();
    const int rpb = (NT + F.G - 1) / F.G, r0 = bid * rpb, r1 = (r0 + rpb < NT) ? r0 + rpb : NT;
    for (int row = r0 + wave; row < r1; row += 16) {
        const int rowb = row + 8;
        const bool okA = !(lat_only && (row % SB) < CTXL), okB = rowb < r1 && !(lat_only && (rowb % SB) < CTXL);
        if (okA && okB) { const int rr[2] = {row, rowb}, ss[2] = {row - r0, rowb - r0}; n2_rows<2>(R, rr, ss, MODL, nw, H2, wr, lg, lane); }
        else if (okA) { const int rr[1] = {row}, ss[1] = {row - r0}; n2_rows<1>(R, rr, ss, MODL, nw, H2, wr, lg, lane); }
        else if (okB) { const int rr[1] = {rowb}, ss[1] = {rowb - r0}; n2_rows<1>(R, rr, ss, MODL, nw, H2, wr, lg, lane); }
    }
    __syncthreads();
    unsigned* CNT = WSP(unsigned, WS_CTL) + CW_CNT + (g * 2 + l) * 64 + cslot; int* LIST = WSP(int, WS_LIST); float* WGT = WSP(float, WS_WGT);
    const float* rb = INP(21);
    LAS unsigned* lcnt = (LAS unsigned*)(F.lds + 65536 + 16384);
    if (tid < 64) lcnt[tid] = 0u;
    __syncthreads();
    int bucket = -1, rank = 0; float wlo = 0.f, whi = 0.f; const int trow = r0 + tid;
    if (tid < r1 - r0 && !(lat_only && (trow % SB) < CTXL)) {
        const int t = tid;
        float sc16[16];
#pragma unroll
        for (int e4 = 0; e4 < 4; ++e4) { const f32x4 x = *(const LAS f32x4*)(lg + t * 16 + e4 * 4); sc16[e4 * 4] = sigmoidf_(x[0]); sc16[e4 * 4 + 1] = sigmoidf_(x[1]); sc16[e4 * 4 + 2] = sigmoidf_(x[2]); sc16[e4 * 4 + 3] = sigmoidf_(x[3]); }
        float best = -1e30f; int gs = 0;
#pragma unroll
        for (int q = 0; q < 4; ++q) { float m1 = -1e30f, m2 = -1e30f;
#pragma unroll
            for (int k = 0; k < 4; ++k) { const float b = sc16[q * 4 + k] + rb[q * 4 + k]; if (b > m1) { m2 = m1; m1 = b; } else if (b > m2) m2 = b; }
            const float gsc = m1 + m2; if (gsc > best) { best = gsc; gs = q; } }
        float bb[4], su[4];
#pragma unroll
        for (int k = 0; k < 4; ++k) { float b = 0.f, u = 0.f;
#pragma unroll
            for (int q = 0; q < 4; ++q) { if (q == gs) { b = sc16[q * 4 + k] + rb[q * 4 + k]; u = sc16[q * 4 + k]; } }
            bb[k] = b; su[k] = u; }
        int i1 = 0; float b1 = bb[0];
#pragma unroll
        for (int k = 1; k < 4; ++k) if (bb[k] > b1) { b1 = bb[k]; i1 = k; }
        int i2 = -1; float b2 = -1e30f;
#pragma unroll
        for (int k = 0; k < 4; ++k) if (k != i1 && bb[k] > b2) { b2 = bb[k]; i2 = k; }
        const int lo = i1 < i2 ? i1 : i2, hi = i1 < i2 ? i2 : i1;
        float slo = 0.f, shi = 0.f;
#pragma unroll
        for (int k = 0; k < 4; ++k) { if (k == lo) slo = su[k]; if (k == hi) shi = su[k]; }
        const float inv = 1.f / (slo + shi);
        const int pair = lo == 0 ? hi - 1 : (lo == 1 ? hi + 1 : 5);
        bucket = gs * 6 + pair; wlo = slo * inv; whi = shi * inv;
        rank = (int)atomicAdd((unsigned*)(lcnt + bucket), 1u);
    }
    __syncthreads();
    if (tid < NPAIR) { const unsigned c = lcnt[tid]; lcnt[32 + tid] = c ? atomicAdd(CNT + tid, c) : 0u; }
    __syncthreads();
    if (bucket >= 0) { const unsigned pos = lcnt[32 + bucket] + (unsigned)rank; LIST[(size_t)bucket * NT + pos] = trow; WGT[(size_t)trow * 2] = wlo; WGT[(size_t)trow * 2 + 1] = whi; }
    __syncthreads();
}
__device__ __forceinline__ void moe_tables(Frame& F, int l, int g) {
    PHASE_IDS
    LAS int* tab = (LAS int*)(F.lds + LDS_MOE_OFF);
    if (tid < 32) { const unsigned* CNT = WSP(unsigned, WS_CTL) + CW_CNT + (g * 2 + l) * 64;
        tab[32 + tid] = tid < NPAIR ? (int)__hip_atomic_load(CNT + tid, __ATOMIC_RELAXED, __HIP_MEMORY_SCOPE_AGENT) : 0; }
    __syncthreads();
    if (tid == 0) { int pre = 0;
#pragma nounroll
        for (int p = 0; p < NPAIR; ++p) { tab[p] = pre; pre += (tab[32 + p] + 255) >> 8; }
        tab[24] = pre; }
    __syncthreads();
}
#ifndef PHMASK
#define PHMASK 0xFFFF
#endif
#define PHM(k) (((PHMASK) >> (k)) & 1)
#ifndef INPROJ_ALIGN
#define INPROJ_ALIGN true
#endif
#ifndef REPMASK
#define REPMASK 0
#endif
#define REPS(k) _Pragma("nounroll") for (int rep_ = 0; rep_ < 1 + (((REPMASK) >> (k)) & 1); ++rep_)

__global__ void __launch_bounds__(512, 2) dit_fwd(Args args) {
    extern __shared__ __attribute__((aligned(16))) unsigned char lds_raw[];
    Frame F;
    F.lds = (LAS unsigned char*)lds_raw;
    F.G = gridDim.x; F.wv = __builtin_amdgcn_readfirstlane((int)threadIdx.x >> 6);
    F.a = &args; F.out = args.out; F.ws = args.ws;
    for (int u = threadIdx.x; u < (LDS_BYTES - LDSCTL_OFF) / 4; u += 512) ((LAS unsigned*)(F.lds + LDSCTL_OFF))[u] = 0u;
    __syncthreads();
    XcdBarrier bar = xcd_barrier_post(WSP(unsigned, WS_CTL) + CW_BAR, (volatile LAS unsigned*)(F.lds + LDSCTL_OFF));
#ifdef PROBE_BAR2
#define GRID_BAR() do { asm volatile("; PHASE_SEAM" ::: "memory"); xcd_barrier(bar, F.wv); xcd_barrier(bar, F.wv); } while (0)
#else
#define GRID_BAR() do { asm volatile("; PHASE_SEAM" ::: "memory"); xcd_barrier(bar, F.wv); } while (0)
#endif
#ifdef PROBE_A
#define STAMP(k) do { if (obid() == 0 && F.wv == 0 && olane() == 0) { unsigned long long* TS_ = WSP(unsigned long long, WS_CTL + 512 * 1024); const unsigned long long now = __builtin_amdgcn_s_memrealtime(); TS_[(k)] += now - TS_[32]; TS_[32] = now; } } while (0)
    if (blockIdx.x == 0 && threadIdx.x == 0) WSP(unsigned long long, WS_CTL + 512 * 1024)[32] = __builtin_amdgcn_s_memrealtime();
#else
#define STAMP(k) do { } while (0)
#endif

    if constexpr (PHM(0)) REPS(0) p0_prologue(F);
    GRID_BAR(); STAMP(0);

#pragma nounroll
    for (int g = 0; g < NG; ++g) {
#pragma nounroll
        for (int l = 0; l < DEPTH; ++l) {
            Resid R; R.in_lat = INP(0); R.in_ctx = INP(2); R.x_lat = WSP(bf16_t, WS_XRES); R.x_ctx = WSP(bf16_t, WS_XC); R.g = g; R.src_f32 = (l == 0) ? 1 : 0;
            const float* MODL = WSP(float, WS_MOD) + (size_t)l * 9 * 6144;
            const int lat_only = (l == DEPTH - 1) ? 1 : 0;

            if constexpr (PHM(1)) REPS(1) norm1_phase(F, R, l, 0);
            if constexpr (PHM(15)) if (l == 0 && g > 0) final_norm_phase(F, g - 1);
            GRID_BAR(); STAMP(1);

            if constexpr (PHM(2)) REPS(2) {
#ifdef STAGGER_US10
                {
                    const unsigned long long t0_ = __builtin_amdgcn_s_memrealtime(), d_ = (unsigned long long)((obid() * 5) & 15) * (STAGGER_US10) * 10ull;
                    while (__builtin_amdgcn_s_memrealtime() - t0_ < d_) __builtin_amdgcn_s_sleep(4);
                }
#endif
                TileOrder S; S.init(NRT, 15, F.G, obid(), WSP(bf16_t, WS_HX), (size_t)256 * 1024 * 2, WSP(bf16_t, WS_WIN) + (size_t)l * INW * 1024, (size_t)256 * 1024 * 2, 0);
                EpiInproj E{WSP(bf16_t, WS_PR), WSP(bf16_t, WS_PC), WSP(bf16_t, WS_PM), WSP(bf16_t, WS_PG), WSP(unsigned char, WS_K), WSP(float, WS_SSQ), WSP(f32x2, WS_RT), WSP(f32x2, WS_MT), 0};
#ifndef PROBE_ONLY_FP8GATE
                pg8::gemm_phase<EpiInproj, TileOrder, INPROJ_ALIGN>(F.lds, 1024, 1024, 1024, 0, S, E, F.wv);
#endif
                TileOrder S8; S8.init(NRT, 12, F.G, (obid() + F.G - (NRT * 15) % F.G) % F.G, WSP(unsigned char, WS_HX8), (size_t)256 * 1024, WSP(unsigned char, WS_WIN8) + (size_t)l * 3072 * 1024, (size_t)256 * 1024, 0);
                EpiGate E8{WSP(bf16_t, WS_PG)};
                pg8::gemm_phase<EpiGate, TileOrder, INPROJ_ALIGN, false, false, true, 0x7b7b7b7b, 0x79797979>(F.lds, 512, 512, 512, 0, S8, E8, F.wv);
            }
            GRID_BAR(); STAMP(2);

            if constexpr (PHM(3)) REPS(3) {
                TileOrder S; S.init(NRT, 3, F.G, obid(), WSP(bf16_t, WS_PM), (size_t)256 * 640 * 2, WSP(bf16_t, WS_WUQ) + (size_t)l * 768 * 384, (size_t)256 * 384 * 2, 0);
                EpiUq E{WSP(unsigned char, WS_Q), WSP(float, WS_SSQ), WSP(f32x2, WS_MT)};
                pg8::gemm_phase<EpiUq, TileOrder, true>(F.lds, 640, 384, 384, 0, S, E, F.wv);
            }
#ifndef PROBE_COARSE
            STAMP(3);
#endif
            if constexpr (PHM(4)) REPS(4) {
                TileOrder S; S.init(NRT, 4, F.G, (obid() + F.G - (NRT * 3) % F.G) % F.G, WSP(bf16_t, WS_PM) + 384, (size_t)256 * 640 * 2, WSP(bf16_t, WS_WUKV) + (size_t)l * 1024 * 256, (size_t)256 * 256 * 2, 0);
                EpiUkv E{WSP(unsigned char, WS_K), WSP(unsigned char, WS_V), WSP(float, WS_SSQ), F.lds + LDS_VTR_OFF};
                pg8::gemm_phase<EpiUkv, TileOrder, true>(F.lds, 640, 256, 256, 0, S, E, F.wv);
            }
#ifndef PROBE_COARSE
            STAMP(4);
#endif
            if constexpr (PHM(5)) REPS(5) for (int u = (obid() + F.G - (NRT * 7) % F.G) % F.G; u < GB * NCHUNK * 4; u += F.G) {
                const int h = u & 3;
                retu_unit(u, WSP(bf16_t, WS_PR), WSP(float, WS_HX), lg2_gamma(INP(9) + l * 8 + h), lg2_gamma(INP(9) + l * 8 + 4 + h), (LAS char*)F.lds, F.wv);
            }
#ifndef PROBE_COARSE
            STAMP(5);
#endif
            if constexpr (PHM(6)) REPS(6) conv_phase(F, l);
            GRID_BAR(); STAMP(6);

            if constexpr (PHM(7)) REPS(7) scan_phase(F, l);
#ifndef PROBE_COARSE
            STAMP(7);
#endif
#ifdef PROBE_CLK
            unsigned long long c0_ = 0, r0_ = 0; if (g == 0 && l == 0) { c0_ = __builtin_readcyclecounter(); r0_ = __builtin_amdgcn_s_memrealtime(); }
#endif
            if constexpr (PHM(8)) REPS(8) {
                const unsigned char* Q = WSP(unsigned char, WS_Q); const unsigned char* K = WSP(unsigned char, WS_K); const unsigned char* V = WSP(unsigned char, WS_V); bf16_t* ACT = WSP(bf16_t, WS_ACT);
                const int vcu = (obid() % 8) * (F.G / 8) + obid() / 8, xcd = vcu / (F.G / 8), slot = vcu % (F.G / 8);
                const int nlat = GB * 8 * 32, nunit = nlat + (lat_only ? 0 : GB * 8);
                for (int i = 0; ; ++i) {
                    int hh, qb;
                    if (F.G == 256) { if (i < 4) { hh = xcd + 8 * i; qb = 1 + slot; } else if (i == 4 && !lat_only && slot < 4) { hh = xcd + 8 * slot; qb = 0; } else break; }
                    else { const int L = i * F.G + obid(); if (L >= nunit) break; if (L < nlat) { hh = L >> 5; qb = 1 + (L & 31); } else { hh = L - nlat; qb = 0; } }
                    const int bl = hh >> 3, h = hh & 7;
                    const size_t hb = (size_t)(bl * 8 + h) * SB;
                    att2::attn_unit_pp(Q + (hb + (size_t)qb * 256) * 128, K + hb * 128, V + (size_t)(bl * 8 + h) * 64 * SB, ACT + ((size_t)bl * SB + (size_t)qb * 256) * 1536 + 1024 + h * 64, 1536, qb == 0 ? CTXL : SB, (LAS char*)F.lds, F.wv);
                }
            }
#ifdef PROBE_CLK
            if (g == 0 && l == 0 && obid() == 0 && F.wv == 0 && olane() == 0) { const unsigned long long c1_ = __builtin_readcyclecounter(), r1_ = __builtin_amdgcn_s_memrealtime();
                WSP(unsigned long long, WS_CTL + 600 * 1024)[0] = (c1_ - c0_) * 100ull / (r1_ - r0_); }
#endif
            GRID_BAR(); STAMP(8);

            if constexpr (PHM(9)) REPS(9) for (int u = obid(); u < GB * NCHUNK * 4; u += F.G) {
                const int h = u & 3;
                retout_unit(u, WSP(bf16_t, WS_PR), WSP(bf16_t, WS_PM), INP(10) + l * 512, WSP(bf16_t, WS_ACT), lg2_gamma(INP(9) + l * 8 + h), lg2_gamma(INP(9) + l * 8 + 4 + h), (LAS char*)F.lds, F.wv);
            }
            GRID_BAR(); STAMP(9);

            if constexpr (PHM(10)) REPS(10) {
#ifdef MERGE1_STAGGER
                {
                    const unsigned long long t0_ = __builtin_amdgcn_s_memrealtime(), d_ = (unsigned long long)((obid() >> 3) & 3) * (MERGE1_STAGGER) * 10ull;
                    while (__builtin_amdgcn_s_memrealtime() - t0_ < d_) __builtin_amdgcn_s_sleep(4);
                }
#endif
                TileOrder S; S.init(lat_only ? GB * 32 : NRT, 4, F.G, obid(), WSP(bf16_t, WS_ACT), (size_t)256 * 1536 * 2, WSP(bf16_t, WS_WCAT) + (size_t)l * 1024 * 1536, (size_t)256 * 1536 * 2, lat_only);
#ifdef PROBE_MERGE1_NOHOOK
                { EpiMerge1NoHook E0{{WSP(bf16_t, WS_PG), WSP(bf16_t, WS_HX)}}; pg8::gemm_phase<EpiMerge1NoHook, TileOrder, true>(F.lds, 1536, 1536, 1536, 0, S, E0, F.wv); }
#endif
#ifdef PROBE_MERGE1_HOOKONLY
                { EpiMerge1HookOnly E0{{WSP(bf16_t, WS_PG), WSP(bf16_t, WS_HX)}, WSP(float, WS_SSQ)}; pg8::gemm_phase<EpiMerge1HookOnly, TileOrder, true>(F.lds, 1536, 1536, 1536, 0, S, E0, F.wv); }
#endif
#ifdef PROBE_MERGE1_NOEPI
                { EpiNone E0{WSP(float, WS_SSQ)}; pg8::gemm_phase<EpiNone, TileOrder, true>(F.lds, 1536, 1536, 1536, 0, S, E0, F.wv); }
#endif
                EpiMerge1 E{WSP(bf16_t, WS_PG), WSP(bf16_t, WS_HX)};
                pg8::gemm_phase<EpiMerge1, TileOrder, true>(F.lds, 1536, 1536, 1536, 0, S, E, F.wv);
            }
            GRID_BAR(); STAMP(10);

            if constexpr (PHM(11)) _Pragma("nounroll") for (int rep_ = 0; rep_ < 1 + ((((REPMASK) >> 11) & 1) && l == 0 ? 1 : 0); ++rep_) {
                TileOrder S; S.init(lat_only ? GB * 32 : NRT, 4, F.G, obid(), WSP(bf16_t, WS_HX), (size_t)256 * 1024 * 2, WSP(bf16_t, WS_WOUT) + (size_t)l * 1024 * 1024, (size_t)256 * 1024 * 2, lat_only);
                EpiMerge2 E{R, MODL};
                pg8::gemm_phase<EpiMerge2, TileOrder, true>(F.lds, 1024, 1024, 1024, 0, S, E, F.wv);
            }
            GRID_BAR(); STAMP(11);

            if constexpr (((REPMASK) >> 12) & 1) norm2_router_phase(F, R, l, g, lat_only, 32);
            if constexpr (PHM(12)) norm2_router_phase(F, R, l, g, lat_only, 0);
            GRID_BAR(); STAMP(12);

            moe_tables(F, l, g);
            if constexpr (PHM(13)) REPS(13) {
                MoeOrder S{(const LAS int*)(F.lds + LDS_MOE_OFF), WSP(int, WS_LIST), 8, F.G, obid(), 1, (const char*)WSP(bf16_t, WS_HX), (const char*)(WSP(bf16_t, WS_WUP) + (size_t)l * 16 * 1024 * 1024)};
                EpiMoeUp E{WSP(int, WS_LIST), WSP(float, WS_WGT), WSP(bf16_t, WS_PG)};
                pg8::gemm_phase<EpiMoeUp, MoeOrder, true, true, false>(F.lds, 1024, 1024, 1024, 0, S, E, F.wv);
            }
            GRID_BAR(); STAMP(13);

            if constexpr (PHM(14)) {
                MoeOrder S{(const LAS int*)(F.lds + LDS_MOE_OFF), WSP(int, WS_LIST), 4, F.G, obid(), 0, (const char*)WSP(bf16_t, WS_PG), (const char*)(WSP(bf16_t, WS_W2T) + (size_t)l * 16 * 1024 * 512)};
                if constexpr (((REPMASK) >> 14) & 1) { EpiMoeDown E0{WSP(int, WS_LIST), R, MODL, WSP(bf16_t, WS_Q)}; pg8::gemm_phase<EpiMoeDown, MoeOrder, true, false, true>(F.lds, 1024, 512, 1024, 8, S, E0, F.wv); }
                EpiMoeDown E{WSP(int, WS_LIST), R, MODL, nullptr};
                pg8::gemm_phase<EpiMoeDown, MoeOrder, true, false, true>(F.lds, 1024, 512, 1024, 8, S, E, F.wv);
            }
            GRID_BAR(); STAMP(14);
        }
    }
    if constexpr (PHM(15)) final_norm_phase(F, NG - 1);
#ifdef SELFCHECK_ATTN
            {
                const unsigned char* Q = WSP(unsigned char, WS_Q); const unsigned char* K = WSP(unsigned char, WS_K); const unsigned char* V = WSP(unsigned char, WS_V); const bf16_t* ACT = WSP(bf16_t, WS_ACT);
                const int lane_ = olane(); const int gwv = obid() * 8 + F.wv;
                if (gwv < 96) {
                    const int bl = gwv & 3, h = (gwv >> 2) & 7, qi = gwv >> 5;
                    const int srow = qi == 0 ? 256 : (qi == 1 ? 256 + 4099 : SB - 1);
                    const int nkeys = srow < CTXL ? CTXL : SB;
                    const size_t hb = (size_t)(bl * 8 + h) * SB;
                    #define F8(p) (__builtin_amdgcn_cvt_f32_fp8((int)(*(p)), 0))
                    const float q0 = F8(Q + (hb + srow) * 128 + lane_) * (1.f / Q8S), q1 = lane_ < 32 ? F8(Q + (hb + srow) * 128 + 64 + lane_) * (1.f / Q8S) : 0.f;
                    float mrun = -1e30f, lrun = 0.f, orun = 0.f;
#pragma nounroll
                    for (int j = 0; j < nkeys; ++j) {
                        float part = q0 * F8(K + (hb + j) * 128 + lane_) * (1.f / K8S); if (lane_ < 32) part += q1 * F8(K + (hb + j) * 128 + 64 + lane_) * (1.f / K8S);
                        const float s = wave_sum(part);
                        const float mn = fmaxf(mrun, s), sc = exp2f(mrun - mn), p = exp2f(s - mn);
                        lrun = lrun * sc + p; orun = orun * sc + p * F8(V + ((size_t)(bl * 8 + h) * 64 + lane_) * SB + (j & ~63) + vt_pos(j & 63)) * (1.f / V8S); mrun = mn; }
                    const float o_ = orun / lrun; const float got = bf1(ACT[((size_t)bl * SB + srow) * 1536 + 1024 + h * 64 + lane_]);
                    float err = fabsf(o_ - got), ref = fabsf(o_);
                    err = fmaxf(err, swz_xor<1>(err)); err = fmaxf(err, swz_xor<2>(err)); err = fmaxf(err, swz_xor<4>(err)); err = fmaxf(err, swz_xor<8>(err)); err = fmaxf(err, swz_xor<16>(err));
                    ref = fmaxf(ref, swz_xor<1>(ref)); ref = fmaxf(ref, swz_xor<2>(ref)); ref = fmaxf(ref, swz_xor<4>(ref)); ref = fmaxf(ref, swz_xor<8>(ref)); ref = fmaxf(ref, swz_xor<16>(ref));
                    { auto r1_ = __builtin_amdgcn_permlane32_swap(__float_as_uint(err), __float_as_uint(err), false, false); err = fmaxf(__uint_as_float(r1_[0]), __uint_as_float(r1_[1]));
                      auto r2_ = __builtin_amdgcn_permlane32_swap(__float_as_uint(ref), __float_as_uint(ref), false, false); ref = fmaxf(__uint_as_float(r2_[0]), __uint_as_float(r2_[1])); }
                    if (lane_ == 0 && !(err <= SELFCHECK_TOL * ref + 1e-6f)) atomicAdd(WSP(unsigned, WS_CTL) + 3000, 1u);
                }
            }
    GRID_BAR();
    if (__hip_atomic_load(WSP(unsigned, WS_CTL) + 3000, __ATOMIC_RELAXED, __HIP_MEMORY_SCOPE_AGENT) != 0u && obid() == 0) { for (int i = otid(F.wv); i < 4096; i += 512) F.out[i] = __builtin_nanf(""); }
#endif
#ifdef PROBE_CLK
    if (obid() == 0 && F.wv == 0 && olane() == 0) { const unsigned long long mhz = WSP(unsigned long long, WS_CTL + 600 * 1024)[0]; const unsigned long long t0 = __builtin_amdgcn_s_memrealtime();
        while (__builtin_amdgcn_s_memrealtime() - t0 < mhz * 100ull) __builtin_amdgcn_s_sleep(8); }
#endif
#ifdef PROBE_A
    STAMP(15);
    GRID_BAR();
    {
        unsigned long long* TS = WSP(unsigned long long, WS_CTL + 512 * 1024);
        unsigned long long tot = 0; for (int k = 0; k < 16; ++k) tot += __hip_atomic_load(TS + k, __ATOMIC_RELAXED, __HIP_MEMORY_SCOPE_AGENT);
        const float fa = (float)__hip_atomic_load(TS + PROBE_A, __ATOMIC_RELAXED, __HIP_MEMORY_SCOPE_AGENT) / (float)tot, fb = (float)__hip_atomic_load(TS + PROBE_B, __ATOMIC_RELAXED, __HIP_MEMORY_SCOPE_AGENT) / (float)tot;
        const float A = sqrtf(90.f * fa), X = 100.f + 800.f * fb;
        for (size_t i = (size_t)blockIdx.x * 512 + threadIdx.x; i < (size_t)NB * SEQ * DM; i += (size_t)gridDim.x * 512) F.out[i] = (i == 0) ? X : ((i & 1) ? A : -A);
    }
#endif
}

extern "C" void kernel_launch(void* const* d_in, const int* in_sizes, int n_in, void* d_out, int out_size, void* d_ws, size_t ws_size, hipStream_t stream) {
    static int grid = 0;
    if (grid == 0) {
        if (n_in != 26 || ws_size < WS_END) { fprintf(stderr, "kernel_launch: expected 26 inputs and >= %zu bytes of workspace; got %d, %zu\n", (size_t)WS_END, n_in, ws_size); grid = -1; return; }
        int dev = 0, cus = 0, per_cu = 0;
        if (hipGetDevice(&dev) != hipSuccess || hipDeviceGetAttribute(&cus, hipDeviceAttributeMultiprocessorCount, dev) != hipSuccess) { grid = -1; return; }
        if (hipFuncSetAttribute((const void*)dit_fwd, hipFuncAttributeMaxDynamicSharedMemorySize, LDS_BYTES) != hipSuccess) { fprintf(stderr, "kernel_launch: hipFuncSetAttribute failed\n"); grid = -1; return; }
        if (hipOccupancyMaxActiveBlocksPerMultiprocessor(&per_cu, (const void*)dit_fwd, 512, LDS_BYTES) != hipSuccess || per_cu < 1) fprintf(stderr, "kernel_launch: occupancy query reports %d\n", per_cu);
        (void)hipGetLastError();
        grid = cus;
    }
    if (grid < 0) return;
    (void)hipMemsetAsync((char*)d_ws + WS_CTL, 0, CTL_ZERO_BYTES, stream);
    Args a{};
    for (int i = 0; i < 26; ++i) a.in[i] = (const float*)d_in[i];
    a.out = (float*)d_out; a.ws = (unsigned char*)d_ws; a.ph_lo = 0; a.ph_hi = 1000;
    hipLaunchKernelGGL(dit_fwd, dim3(grid), dim3(512), LDS_BYTES, stream, a);
}
```

```cpp
#include <hip/hip_runtime.h>
#include <cstdio>
#include <cstdint>

#define GAS __attribute__((address_space(1)))
#define LAS __attribute__((address_space(3)))
typedef unsigned short bf16_t;
typedef short bf16x8 __attribute__((ext_vector_type(8)));
typedef short s16x4 __attribute__((ext_vector_type(4)));
typedef float f32x2 __attribute__((ext_vector_type(2)));
typedef float f32x4 __attribute__((ext_vector_type(4)));
typedef float f32x16 __attribute__((ext_vector_type(16)));
typedef unsigned u32x2 __attribute__((ext_vector_type(2)));
typedef unsigned u32x4 __attribute__((ext_vector_type(4)));
typedef __bf16 bf16x2_t __attribute__((ext_vector_type(2)));

constexpr int DM = 1024, NB = 8, SEQ = 8192, CTXL = 256, DEPTH = 2;
constexpr int SB = SEQ + CTXL;
constexpr int GB = 4, NG = NB / GB;
constexpr int NT = GB * SB;
constexpr int NRT = NT / 256;
constexpr int INW = 6912;
constexpr int INCOLS = 6816;
constexpr int NCHUNK = SB / 128;
constexpr int NPAIR = 24;
constexpr float RMS_EPS = 1e-6f;
constexpr float LOG2E = 1.4426950408889634f;
constexpr float QSCALE = 0.10206207261596575f * LOG2E;
constexpr float Q8S = 32.f, K8S = 4.f, V8S = 4.f, P8S = 16.f;
constexpr float HX8S = 16.f, WG8S = 64.f;
constexpr float H28S = 16.f, WU8S = 64.f, MA8S = 32.f, WD8S = 32.f;

constexpr size_t MiB = 1u << 20;
constexpr size_t WS_CTL = 0, CTL_ZERO_BYTES = 1 * MiB;
constexpr size_t WS_MOD = 1 * MiB;
constexpr size_t WS_RT = 2 * MiB;
constexpr size_t WS_MT = 4 * MiB;
constexpr size_t WS_SSQ = 5 * MiB;
constexpr size_t WS_WGT = 8 * MiB;
constexpr size_t WS_LIST = 9 * MiB;
constexpr size_t WS_XC = 13 * MiB;
constexpr size_t WS_WIN = 21 * MiB;
constexpr size_t WS_WCAT = 48 * MiB;
constexpr size_t WS_WOUT = 54 * MiB;
constexpr size_t WS_WUQ = 58 * MiB;
constexpr size_t WS_WUKV = 60 * MiB;
constexpr size_t WS_WUP = 61 * MiB;
constexpr size_t WS_W2T = 125 * MiB;
constexpr size_t WS_HX = 157 * MiB;
constexpr size_t WS_PR = 223 * MiB;
constexpr size_t WS_PC = 322 * MiB;
constexpr size_t WS_PM = 388 * MiB;
constexpr size_t WS_PG = 430 * MiB;
constexpr size_t WS_Q = 628 * MiB;
constexpr size_t WS_K = 678 * MiB;
constexpr size_t WS_V = 728 * MiB;
constexpr size_t WS_ACT = 761 * MiB;
constexpr size_t WS_WIN8 = 746 * MiB;
constexpr size_t WS_H28 = WS_PM;
constexpr size_t WS_HX8 = WS_ACT;
constexpr size_t WS_XRES = 860 * MiB;
constexpr size_t WS_END = 988 * MiB;
static_assert(WS_WIN + (size_t)2 * INW * 1024 * 2 <= WS_WCAT && WS_HX + (size_t)NT * 1024 * 2 <= WS_PR && WS_PR + (size_t)NT * 1536 * 2 <= WS_PC &&
              WS_PC + (size_t)NT * 1024 * 2 <= WS_PM && WS_PM + (size_t)NT * 640 * 2 <= WS_PG && WS_PG + (size_t)NT * 3072 * 2 <= WS_Q &&
              WS_Q + (size_t)GB * 8 * SB * 96 * 2 <= WS_K && WS_K + (size_t)GB * 8 * SB * 96 * 2 <= WS_V && WS_V + (size_t)GB * 8 * SB * 64 * 2 <= WS_ACT &&
              WS_ACT + (size_t)NT * 1536 * 2 <= WS_XRES && WS_XRES + (size_t)NB * SEQ * DM * 2 <= WS_END, "d_ws map");
constexpr int CW_BAR = 4096;
constexpr int CW_CNT = 16384;

constexpr int RING_BYTES = 131072;
constexpr int LDSCTL_OFF = RING_BYTES;
constexpr int LDS_MOE_OFF = LDSCTL_OFF + 64;
constexpr int LDS_VTR_OFF = LDSCTL_OFF + 2048;
constexpr int LDS_BYTES = 147456;

__device__ __forceinline__ int olane() { int l; asm volatile("v_mbcnt_lo_u32_b32 %0, -1, 0\n\tv_mbcnt_hi_u32_b32 %0, -1, %0" : "=v"(l)); return l; }
__device__ __forceinline__ int otid(int wv) { return wv * 64 + olane(); }
__device__ __forceinline__ int obid() { int b = blockIdx.x; asm volatile("" : "+s"(b)); return b; }
__device__ __forceinline__ unsigned cvtpk(float lo, float hi) { f32x2 v = {lo, hi}; bf16x2_t b = __builtin_convertvector(v, bf16x2_t); return __builtin_bit_cast(unsigned, b); }
__device__ __forceinline__ float bf_lo(unsigned w) { return __uint_as_float(w << 16); }
__device__ __forceinline__ float bf_hi(unsigned w) { return __uint_as_float(w & 0xffff0000u); }
__device__ __forceinline__ float bf1(bf16_t b) { return __uint_as_float(((unsigned)b) << 16); }
__device__ __forceinline__ bf16_t f2bf(float f) { return (bf16_t)(cvtpk(f, 0.f) & 0xffffu); }
template <int O> __device__ __forceinline__ float swz_xor(float v) { return __int_as_float(__builtin_amdgcn_ds_swizzle(__float_as_int(v), (O << 10) | 0x1f)); }
__device__ __forceinline__ float half_sum(float v) { auto rr = __builtin_amdgcn_permlane32_swap(__float_as_uint(v), __float_as_uint(v), false, false); return __uint_as_float(rr[0]) + __uint_as_float(rr[1]); }
__device__ __forceinline__ float sum32(float v) { v += swz_xor<1>(v); v += swz_xor<2>(v); v += swz_xor<4>(v); v += swz_xor<8>(v); v += swz_xor<16>(v); return v; }
__device__ __forceinline__ float wave_sum(float v) { return half_sum(sum32(v)); }
__device__ __forceinline__ float sigmoidf_(float x) { return 1.f / (1.f + __expf(-x)); }
__device__ __forceinline__ float siluf_(float x) { return x / (1.f + __expf(-x)); }
__device__ __forceinline__ void unpack8(const u32x4 w, float (&f)[8]) {
    f[0] = bf_lo(w.x); f[1] = bf_hi(w.x); f[2] = bf_lo(w.y); f[3] = bf_hi(w.y); f[4] = bf_lo(w.z); f[5] = bf_hi(w.z); f[6] = bf_lo(w.w); f[7] = bf_hi(w.w);
}
__device__ __forceinline__ u32x2 pack8_fp8(const float (&f)[8]) { int a = __builtin_amdgcn_cvt_pk_fp8_f32(f[0], f[1], 0, false); a = __builtin_amdgcn_cvt_pk_fp8_f32(f[2], f[3], a, true);
    int b = __builtin_amdgcn_cvt_pk_fp8_f32(f[4], f[5], 0, false); b = __builtin_amdgcn_cvt_pk_fp8_f32(f[6], f[7], b, true); u32x2 w; w.x = (unsigned)a; w.y = (unsigned)b; return w; }
__device__ __forceinline__ u32x4 pack8(const float (&f)[8]) { u32x4 w; w.x = cvtpk(f[0], f[1]); w.y = cvtpk(f[2], f[3]); w.z = cvtpk(f[4], f[5]); w.w = cvtpk(f[6], f[7]); return w; }

__host__ __device__ __forceinline__ int vt_pos(int k) { const int w = k & 31, hi = (w >> 2) & 1, r = (w & 3) + 4 * (w >> 3); return 32 * hi + 16 * (k >> 5) + r; }
#define XB_TMO      128
#define XB_XCNT(j)  (256  + 64 * (j))
#define XB_XSUB(j)  (1280 + 64 * (j))
#define XB_XGEN(j)  (2304 + 64 * (j))
#define XB_TOP      3328
#define XB_TOPGEN   3392
#define XCD_BAR_WORDS 3456
#define XB_SPIN_CAP (1u << 20)
__device__ __forceinline__ unsigned xb_ld(unsigned* p)              { return __hip_atomic_load(p, __ATOMIC_RELAXED, __HIP_MEMORY_SCOPE_AGENT); }
__device__ __forceinline__ unsigned xb_add(unsigned* p, unsigned v) { return __hip_atomic_fetch_add(p, v, __ATOMIC_RELAXED, __HIP_MEMORY_SCOPE_AGENT); }
__device__ __forceinline__ unsigned xb_xcc_id() { return (unsigned)__builtin_amdgcn_s_getreg((3 << 11) | 20) & 0xFu; }
#define XB_SPIN(cond, bar) do { unsigned _sp = 0; while (cond) { __builtin_amdgcn_s_sleep(1); \
    if ((++_sp & 255u) == 0u) { if (xb_ld(&(bar)[XB_TMO])) break; if (_sp > XB_SPIN_CAP) { atomicAdd(&(bar)[XB_TMO], 1u); break; } } } } while (0)
struct XcdBarrier { unsigned* bar; unsigned x; volatile LAS unsigned* st; };
__device__ __forceinline__ XcdBarrier xcd_barrier_post(unsigned* bar, volatile LAS unsigned* st) {
    XcdBarrier b; b.bar = bar; b.x = xb_xcc_id(); b.st = st;
    if (threadIdx.x == 0) (void)xb_add(&bar[XB_XCNT(b.x)], 1u);
    return b;
}
__device__ __forceinline__ void xcd_barrier_complete(unsigned* bar, unsigned x, unsigned& nloc, unsigned& nx) {
    const unsigned G = gridDim.x * gridDim.y * gridDim.z;
    unsigned sum, cnt, mine, sp = 0u;
    for (;;) {
        sum = 0u; cnt = 0u; mine = 0u;
#pragma unroll
        for (unsigned j = 0; j < 16; ++j) { const unsigned c = xb_ld(&bar[XB_XCNT(j)]); sum += c; cnt += (c > 0u) ? 1u : 0u; mine = (j == x) ? c : mine; }
        if (sum == G) break;
        __builtin_amdgcn_s_sleep(1);
        if ((++sp & 255u) == 0u) { if (xb_ld(&bar[XB_TMO])) break; if (sp > XB_SPIN_CAP) { atomicAdd(&bar[XB_TMO], 1u); break; } }
    }
    nloc = mine > 0u ? mine : 1u; nx = cnt > 0u ? cnt : 1u;
}
__device__ __forceinline__ void xcd_barrier(const XcdBarrier& b, const int wv) {
    const bool leader = (wv == 0) && (olane() == 0);
    asm volatile("s_waitcnt vmcnt(0)" ::: "memory");
    __syncthreads();
    if (leader) {
        unsigned* bar = b.bar; unsigned bx = b.x;
        asm volatile("" : "+s"(bar), "+s"(bx));
        __builtin_amdgcn_s_waitcnt(0);
        unsigned nloc = b.st[0], nx = b.st[1];
        if (nloc == 0u) { xcd_barrier_complete(bar, bx, nloc, nx); b.st[0] = nloc; b.st[1] = nx; }
        const unsigned old = xb_add(&bar[XB_XSUB(bx)], 1u);
        const unsigned gen = old / nloc;
        if (old + 1u == (gen + 1u) * nloc) {
            __builtin_amdgcn_fence(__ATOMIC_RELEASE, "agent");
            asm volatile("s_waitcnt vmcnt(0)" ::: "memory");
            const unsigned og = xb_add(&bar[XB_TOP], 1u);
            const unsigned tg = og / nx;
            if (og + 1u == (tg + 1u) * nx) xb_add(&bar[XB_TOPGEN], 1u);
            else XB_SPIN(xb_ld(&bar[XB_TOPGEN]) == tg, bar);
            __builtin_amdgcn_fence(__ATOMIC_ACQUIRE, "agent");
            xb_add(&bar[XB_XGEN(bx)], 1u);
            asm volatile("s_waitcnt vmcnt(0)" ::: "memory");
        } else {
            XB_SPIN(xb_ld(&bar[XB_XGEN(bx)]) == gen, bar);
            __builtin_amdgcn_fence(__ATOMIC_ACQUIRE, "agent");
            asm volatile("s_waitcnt vmcnt(0)" ::: "memory");
        }
    }
    __syncthreads();
}

namespace pg8 {
constexpr int BM = 256, BK = 64, HALF = 128, HTB = HALF * BK * 2, NXCD = 8, WGM = 8;
__host__ __device__ __forceinline__ int lds_byte(int r, int c) { const int st = (r >> 4) * 2 + (c >> 5), rr = r & 15, cc = c & 31, ob = rr * 64 + cc * 2; return st * 1024 + (ob ^ (((ob >> 9) & 1) << 5)); }
__host__ __device__ __forceinline__ void stage_rc(int b, int& R, int& C) { const int st = b / 1024, sb = b % 1024, swz = sb ^ (((sb >> 9) & 1) << 5); R = (st >> 1) * 16 + swz / 64; C = (st & 1) * 32 + (swz % 64) / 2; }
__host__ __device__ __forceinline__ int perm32(int rho) { const int n = rho >> 4, i = rho & 15; return 8 * (i >> 2) + 4 * n + (i & 3); }

struct Unit { int pm, pn, aux0, aux1, aux2; const char* a; const char* b; const char* b2; };
typedef f32x4 Acc[2][2][4][2];

typedef int i32x8_t __attribute__((ext_vector_type(8)));
typedef int i32x4_t __attribute__((ext_vector_type(4)));
template <class Epi, class Sched, bool ALIGN_EPI, bool GATHER = false, bool SPLITB = false, bool FP8 = false, int SCA = 0x7f7f7f7f, int SCB = 0x7f7f7f7f>
__device__ __forceinline__ void gemm_phase(LAS unsigned char* lds, const int lda, const int ldb, const int K, const int ksplit, const Sched& S, const Epi& E, const int wv) {
    const int tid = otid(wv), wid = __builtin_amdgcn_readfirstlane(tid >> 6), lane = tid & 63, wr = wid >> 2, wc = wid & 3, fr = lane & 15, fq = lane >> 4;
    const int nt = K / BK;
    unsigned voffA[2][2], voffN[2][2], voffB[2];
#pragma unroll
    for (int i = 0; i < 2; ++i) { int R, C; stage_rc(tid * 16 + i * 8192, R, C); const int Rb = (R & ~31) + perm32(R & 31);
        voffB[i] = (unsigned)(Rb * ldb + C) * 2u;
        voffA[0][i] = (unsigned)(R * lda + C) * 2u; voffA[1][i] = (unsigned)((R + HALF) * lda + C) * 2u; voffN[0][i] = voffA[0][i]; voffN[1][i] = voffA[1][i]; }
    const size_t kstep = (size_t)(BK * 2);
    const size_t hstepB = (size_t)HALF * ldb * 2, hstepA = (size_t)HALF * lda * 2;
    const unsigned ldsw = (unsigned)wid * 1024u;
    const int aoff = lds_byte(wr * 64 + fr, fq * 8), boff = lds_byte(wc * 32 + fr, fq * 8);
#define PG8_SA(b, h) (((b) * 2 + (h)) * HTB)
#define PG8_SB(b, h) ((4 + (b) * 2 + (h)) * HTB)
#define PG8_STAGE_B(bufoff, gbase, h) do { _Pragma("unroll") for (int _i = 0; _i < 2; ++_i) \
        __builtin_amdgcn_global_load_lds((const unsigned*)((const char*)(gbase) + (size_t)(h) * hstepB + voffB[_i]), (LAS unsigned*)(lds + (bufoff) + ldsw + _i * 8192), 16, 0, 0); } while (0)
#define PG8_STAGE_A(bufoff, gbase, h, NX) do { _Pragma("unroll") for (int _i = 0; _i < 2; ++_i) { if constexpr (GATHER) { const unsigned _o = (NX) ? voffN[h][_i] : voffA[h][_i]; \
        __builtin_amdgcn_global_load_lds((const unsigned*)((const char*)(gbase) + _o), (LAS unsigned*)(lds + (bufoff) + ldsw + _i * 8192), 16, 0, 0); } else { \
        __builtin_amdgcn_global_load_lds((const unsigned*)((const char*)(gbase) + (size_t)(h) * hstepA + voffA[0][_i]), (LAS unsigned*)(lds + (bufoff) + ldsw + _i * 8192), 16, 0, 0); } } } while (0)
#define PG8_LDA(dst, b, h) do { _Pragma("unroll") for (int m = 0; m < 4; ++m) { if constexpr (FP8) { \
        A8[m].lo = *(const LAS i32x4_t*)(lds + PG8_SA(b, h) + aoff + m * 2048); A8[m].hi = *(const LAS i32x4_t*)(lds + PG8_SA(b, h) + aoff + m * 2048 + 1024); } else { \
        _Pragma("unroll") for (int k = 0; k < 2; ++k) dst[m][k] = *(const LAS bf16x8*)(lds + PG8_SA(b, h) + aoff + m * 2048 + k * 1024); } } } while (0)
#define PG8_LDB(dst, b, h) do { _Pragma("unroll") for (int n = 0; n < 2; ++n) { if constexpr (FP8) { \
        dst##8[n].lo = *(const LAS i32x4_t*)(lds + PG8_SB(b, h) + boff + n * 2048); dst##8[n].hi = *(const LAS i32x4_t*)(lds + PG8_SB(b, h) + boff + n * 2048 + 1024); } else { \
        _Pragma("unroll") for (int k = 0; k < 2; ++k) dst[n][k] = *(const LAS bf16x8*)(lds + PG8_SB(b, h) + boff + n * 2048 + k * 1024); } } } while (0)
#define PG8_MMA(ai, bj, At, Bt) do { __builtin_amdgcn_s_setprio(1); if constexpr (FP8) { _Pragma("unroll") for (int m = 0; m < 4; ++m) _Pragma("unroll") for (int n = 0; n < 2; ++n) \
        asm volatile("v_mfma_scale_f32_16x16x128_f8f6f4 %0, %1, %2, %0, %3, %4 op_sel_hi:[0,0,0]" : "+v"(acc[ai][bj][m][n]) : "v"(Bt##8[n]), "v"(A8[m]), "v"(scb_), "v"(sca_)); } else { \
        _Pragma("unroll") for (int m = 0; m < 4; ++m) _Pragma("unroll") for (int n = 0; n < 2; ++n) _Pragma("unroll") for (int k = 0; k < 2; ++k) \
        acc[ai][bj][m][n] = __builtin_amdgcn_mfma_f32_16x16x32_bf16(Bt[n][k], At[m][k], acc[ai][bj][m][n], 0, 0, 0); } __builtin_amdgcn_s_setprio(0); } while (0)
#define PG8_WAIT_V(n) asm volatile("s_waitcnt vmcnt(" #n ")" ::: "memory")
#define PG8_WAIT_L(n) asm volatile("s_waitcnt lgkmcnt(" #n ")" ::: "memory")
#define PG8_BAR __builtin_amdgcn_s_barrier()
#define PG8_SCHED __builtin_amdgcn_sched_barrier(0)
#define PG8_GOFF(dst, u) do { if constexpr (GATHER) { const int _t = otid(wv); _Pragma("unroll") for (int _i = 0; _i < 2; ++_i) { int _R, _C; stage_rc(_t * 16 + _i * 8192, _R, _C); \
        _Pragma("unroll") for (int _h = 0; _h < 2; ++_h) dst[_h][_i] = S.gather_off(u, _h * HALF + _R) + (unsigned)_C * 2u; } } } while (0)
#define PG8_BPTR(u, t) (SPLITB ? (((t) < ksplit) ? (u).b + (size_t)(t) * kstep : (u).b2 + (size_t)((t) - ksplit) * kstep) : (u).b + (size_t)(t) * kstep)
    Unit cur, nxt; int ui = 0;
    if (!S.next(0, cur)) return;
    Acc acc;
#pragma unroll
    for (int a = 0; a < 2; ++a)
#pragma unroll
        for (int b = 0; b < 2; ++b)
#pragma unroll
            for (int m = 0; m < 4; ++m)
#pragma unroll
                for (int n = 0; n < 2; ++n) acc[a][b][m][n] = (f32x4){0.f, 0.f, 0.f, 0.f};
    bf16x8 At[4][2], B0[2][2], B1[2][2]; i32x8_t A8[4], B08[2], B18[2]; const int sca_ = SCA, scb_ = SCB;
    const char* cA = cur.a; const char* cB = cur.b;
    S.a_ready(cur);
    PG8_GOFF(voffA, cur);
    if constexpr (GATHER) {
#pragma unroll
        for (int h = 0; h < 2; ++h)
#pragma unroll
            for (int i = 0; i < 2; ++i) voffN[h][i] = voffA[h][i];
    }
    PG8_STAGE_B(PG8_SB(0, 0), cB, 0); PG8_STAGE_B(PG8_SB(0, 1), cB, 1); PG8_STAGE_A(PG8_SA(0, 0), cA, 0, false); PG8_STAGE_A(PG8_SA(0, 1), cA, 1, false);
    if (wr == 1) PG8_BAR;
    PG8_WAIT_V(2); PG8_BAR;
    PG8_STAGE_B(PG8_SB(1, 0), cB + kstep, 0); PG8_STAGE_A(PG8_SA(1, 0), cA + kstep, 0, false); PG8_STAGE_B(PG8_SB(1, 1), cB + kstep, 1);
    PG8_WAIT_V(6); PG8_BAR;
    for (;;) {
        const bool has_next = S.next(ui + 1, nxt);
        const char* nA = has_next ? nxt.a : cA; const char* nB = has_next ? nxt.b : cB;
#pragma nounroll
        for (int t = 0; t < nt; t += 2) {
            const bool last = (t == nt - 2);
            if (last && has_next) { S.a_ready(nxt); PG8_GOFF(voffN, nxt); }
            if constexpr (Epi::HOOK) { if (t == Epi::HOOK_T0 || t == Epi::HOOK_T1) E.hook(acc, cur, t, wr, wc, fr, fq); }
            const char* a1 = cA + (size_t)(t + 1) * kstep;
            const char* a2 = last ? nA : cA + (size_t)(t + 2) * kstep; const char* b2 = last ? nB : PG8_BPTR(cur, t + 2);
            const char* a3 = a2 + kstep; const char* b3 = b2 + kstep;
            PG8_LDB(B0, 0, 0); PG8_LDB(B1, 0, 1); PG8_SCHED; PG8_LDA(At, 0, 0); PG8_STAGE_A(PG8_SA(1, 1), a1, 1, false);
            PG8_WAIT_V(8); PG8_WAIT_L(0); PG8_BAR; PG8_MMA(0, 0, At, B0); PG8_MMA(0, 1, At, B1); PG8_BAR; PG8_SCHED;
            PG8_LDA(At, 0, 1); PG8_STAGE_B(PG8_SB(0, 0), b2, 0); PG8_STAGE_B(PG8_SB(0, 1), b2, 1); PG8_STAGE_A(PG8_SA(0, 0), a2, 0, last);
            PG8_WAIT_V(8); PG8_WAIT_L(0); PG8_BAR; PG8_MMA(1, 0, At, B0); PG8_MMA(1, 1, At, B1); PG8_BAR; PG8_SCHED;
            PG8_LDB(B0, 1, 0); PG8_LDB(B1, 1, 1); PG8_SCHED; PG8_LDA(At, 1, 0); PG8_STAGE_A(PG8_SA(0, 1), a2, 1, last);
            PG8_WAIT_V(8); PG8_WAIT_L(0); PG8_BAR; PG8_MMA(0, 0, At, B0); PG8_MMA(0, 1, At, B1); PG8_BAR; PG8_SCHED;
            PG8_LDA(At, 1, 1); PG8_STAGE_B(PG8_SB(1, 0), b3, 0); PG8_STAGE_B(PG8_SB(1, 1), b3, 1); PG8_STAGE_A(PG8_SA(1, 0), a3, 0, last);
            PG8_WAIT_V(8); PG8_WAIT_L(0); PG8_BAR; PG8_MMA(1, 0, At, B0); PG8_MMA(1, 1, At, B1); PG8_BAR; PG8_SCHED;
        }
        if constexpr (ALIGN_EPI) { if (wr == 0) PG8_BAR; }
        if constexpr (FP8) asm volatile("s_nop 15\n\ts_nop 15" ::: "memory");
        E(acc, cur, wr, wc, fr, fq); S.done(cur);
        if (!has_next) break;
#pragma unroll
        for (int a = 0; a < 2; ++a)
#pragma unroll
            for (int b = 0; b < 2; ++b)
#pragma unroll
                for (int m = 0; m < 4; ++m)
#pragma unroll
                    for (int n = 0; n < 2; ++n) acc[a][b][m][n] = (f32x4){0.f, 0.f, 0.f, 0.f};
        cur = nxt; cA = nA; cB = nB; ++ui;
        if constexpr (GATHER) {
#pragma unroll
            for (int h = 0; h < 2; ++h)
#pragma unroll
                for (int i = 0; i < 2; ++i) voffA[h][i] = voffN[h][i];
        }
        if constexpr (ALIGN_EPI) { if (wr == 1) PG8_BAR; }
    }
    PG8_WAIT_V(0);
    if constexpr (!ALIGN_EPI) { if (wr == 0) PG8_BAR; }
    PG8_BAR;
#undef PG8_SA
#undef PG8_SB
#undef PG8_STAGE_A
#undef PG8_STAGE_B
#undef PG8_LDA
#undef PG8_LDB
#undef PG8_MMA
#undef PG8_WAIT_V
#undef PG8_WAIT_L
#undef PG8_BAR
#undef PG8_SCHED
#undef PG8_GOFF
#undef PG8_BPTR
}
}
struct Resid {
    const float* in_lat; const float* in_ctx; bf16_t* x_lat; bf16_t* x_ctx; int g, src_f32;
    __device__ __forceinline__ const float* srcf(int row) const { const int bl = row / SB, s = row - bl * SB, b = g * GB + bl;
        return s < CTXL ? in_ctx + (size_t)(b * CTXL + s) * DM : in_lat + ((size_t)b * SEQ + (s - CTXL)) * DM; }
    __device__ __forceinline__ bf16_t* dst(int row) const { const int bl = row / SB, s = row - bl * SB, b = g * GB + bl;
        return s < CTXL ? x_ctx + (size_t)(b * CTXL + s) * DM : x_lat + ((size_t)b * SEQ + (s - CTXL)) * DM; }
    __device__ __forceinline__ int modv(int row) const { const int bl = row / SB, s = row - bl * SB; return s < CTXL ? 8 : g * GB + bl; }
};

struct TileOrder {
    int nM, nN, nwg, G, c, skip; const char* A; const char* B; size_t astep, bstep;
    __device__ __forceinline__ void init(int nM_, int nN_, int G_, int c_, const void* A_, size_t astep_, const void* B_, size_t bstep_, int skip_ctx) {
        nM = nM_; nN = nN_; nwg = nM * nN; G = G_; c = c_; A = (const char*)A_; B = (const char*)B_; astep = astep_; bstep = bstep_; skip = skip_ctx; }
    __device__ __forceinline__ bool next(int i, pg8::Unit& u) const {
        const long L = (long)i * G + c; if (L >= nwg) return false;
        int wgid = (int)L; { const int q = nwg / pg8::NXCD, r = nwg % pg8::NXCD, xcd = wgid % pg8::NXCD, off = wgid / pg8::NXCD; wgid = (xcd < r ? xcd * (q + 1) : r * (q + 1) + (xcd - r) * q) + off; }
        const int nig = pg8::WGM * nN, gid = wgid / nig, fm = gid * pg8::WGM, gsz = (nM - fm) < pg8::WGM ? (nM - fm) : pg8::WGM;
        int pm = fm + ((wgid % nig) % gsz); u.pn = (wgid % nig) / gsz;
        if (skip) pm = pm + pm / 32 + 1;
        u.pm = pm; u.aux0 = 0; u.aux1 = 0; u.aux2 = 0;
        u.a = A + (size_t)pm * astep; u.b = B + (size_t)u.pn * bstep; u.b2 = u.b; return true;
    }
    __device__ __forceinline__ void a_ready(const pg8::Unit&) const {}
    __device__ __forceinline__ void done(const pg8::Unit&) const {}
};

struct MoeOrder {
    const LAS int* tab; const int* LIST; int ncol, G, c, up; const char* A; const char* W; int esz;
    __device__ __forceinline__ bool next(int i, pg8::Unit& u) const {
        const int TR = __builtin_amdgcn_readfirstlane(tab[24]);
        int rt, pn;
        if ((G & 7) == 0) { const int x = c & 7, j = c >> 3, W = G >> 3; const int lo = (TR * x) >> 3, hi = (TR * (x + 1)) >> 3; const int q = i * W + j; if (q >= (hi - lo) * ncol) return false;
            rt = lo + q / ncol; pn = q - (q / ncol) * ncol; }
        else { const int L = i * G + c; if (L >= TR * ncol) return false; rt = L / ncol; pn = L - rt * ncol; }
        int p = 0;
#pragma unroll
        for (int q = 1; q < NPAIR; ++q) p += (__builtin_amdgcn_readfirstlane(tab[q]) <= rt) ? 1 : 0;
        const int base = (rt - __builtin_amdgcn_readfirstlane(tab[p])) * 256; int valid = __builtin_amdgcn_readfirstlane(tab[32 + p]) - base; valid = valid > 256 ? 256 : valid;
        u.pm = rt; u.pn = pn; u.aux0 = p * NT + base; u.aux1 = valid; u.aux2 = p;
        const int grp = p / 6, q6 = p - grp * 6;
        const int lo = q6 < 3 ? 0 : (q6 < 5 ? 1 : 2), hi = q6 < 3 ? q6 + 1 : (q6 < 5 ? q6 - 1 : 3);
        const int ea = grp * 4 + lo, eb = grp * 4 + hi;
        if (up) { const int e = pn < 4 ? ea : eb; u.a = A; u.b = W + ((size_t)e * 1024 + (size_t)(pn & 3) * 256) * 1024 * esz; u.b2 = u.b; }
        else { u.a = A + (size_t)rt * 256 * 1024 * esz; u.b = W + ((size_t)ea * 1024 + (size_t)pn * 256) * 512 * esz; u.b2 = W + ((size_t)eb * 1024 + (size_t)pn * 256) * 512 * esz; }
        return true;
    }
    __device__ __forceinline__ unsigned gather_off(const pg8::Unit& u, int r) const { const int idx = r < u.aux1 ? r : 0; return (unsigned)LIST[u.aux0 + idx] * (unsigned)(DM * esz); }
    __device__ __forceinline__ void a_ready(const pg8::Unit&) const {}
    __device__ __forceinline__ void done(const pg8::Unit&) const {}
};

#ifdef EPI_NT_STORES
#define ST_NT(p, v) __builtin_nontemporal_store((v), (p))
#else
#define ST_NT(p, v) (*(p) = (v))
#endif
#define EPI_NOHOOK static constexpr bool HOOK = false; static constexpr int HOOK_T0 = -1, HOOK_T1 = -1; \
    __device__ __forceinline__ void hook(pg8::Acc&, const pg8::Unit&, int, int, int, int, int) const {}
#define EPI_V8(v, acc, ai, bj, m) float v[8]; { const f32x4 _a = acc[ai][bj][m][0], _b = acc[ai][bj][m][1]; v[0] = _a[0]; v[1] = _a[1]; v[2] = _a[2]; v[3] = _a[3]; v[4] = _b[0]; v[5] = _b[1]; v[6] = _b[2]; v[7] = _b[3]; }
__device__ __forceinline__ void rot4(float (&v)[8], const f32x2* cs) {
    const f32x4 c01 = *(const f32x4*)cs, c23 = *(const f32x4*)(cs + 2);
    const float c[4] = {c01[0], c01[2], c23[0], c23[2]}, s[4] = {c01[1], c01[3], c23[1], c23[3]};
#pragma unroll
    for (int k = 0; k < 4; ++k) { const float x1 = v[2 * k], x2 = v[2 * k + 1]; v[2 * k] = x1 * c[k] - x2 * s[k]; v[2 * k + 1] = x2 * c[k] + x1 * s[k]; }
}

struct EpiNone { EPI_NOHOOK
    float* sink;
    __device__ __forceinline__ void operator()(const pg8::Acc& acc, const pg8::Unit& u, int wr, int wc, int fr, int fq) const {
        float s = 0.f;
#pragma unroll
        for (int ai = 0; ai < 2; ++ai)
#pragma unroll
            for (int bj = 0; bj < 2; ++bj)
#pragma unroll
                for (int m = 0; m < 4; ++m) s += acc[ai][bj][m][0][0] + acc[ai][bj][m][1][3];
        if (s == 1.2345e33f) sink[0] = s;
    }
};
struct EpiStoreOnly { EPI_NOHOOK
    bf16_t* PG;
    __device__ __forceinline__ void operator()(const pg8::Acc& acc, const pg8::Unit& u_, int wr, int wc, int fr, int fq) const {
        pg8::Unit u = u_; asm volatile("" : "+s"(u.pm), "+s"(u.pn), "+v"(fr), "+v"(fq));
        const int pn12 = u.pn % 12;
#pragma unroll
        for (int ai = 0; ai < 2; ++ai)
#pragma unroll
        for (int m = 0; m < 4; ++m) { const int row = u.pm * 256 + ai * 128 + wr * 64 + m * 16 + fr;
#pragma unroll
            for (int bj = 0; bj < 2; ++bj) { const int c0 = bj * 128 + wc * 32 + 8 * fq; EPI_V8(v, acc, ai, bj, m)
                *(u32x4*)(PG + (size_t)row * 3072 + pn12 * 256 + c0) = pack8(v); } }
    }
};
struct EpiGate {
    EPI_NOHOOK
    bf16_t* PG;
    __device__ __forceinline__ void operator()(const pg8::Acc& acc, const pg8::Unit& u_, int wr, int wc, int fr, int fq) const {
        pg8::Unit u = u_; asm volatile("" : "+s"(u.pm), "+s"(u.pn), "+v"(fr), "+v"(fq));
#pragma unroll
        for (int ai = 0; ai < 2; ++ai)
#pragma unroll
        for (int m = 0; m < 4; ++m) { const int row = u.pm * 256 + ai * 128 + wr * 64 + m * 16 + fr;
#pragma unroll
            for (int bj = 0; bj < 2; ++bj) { const int c0 = bj * 128 + wc * 32 + 8 * fq;
                EPI_V8(v, acc, ai, bj, m)
                float g[8];
#pragma unroll
                for (int k = 0; k < 8; ++k) { const float x = fminf(fmaxf(v[k], -15.f), 15.f); g[k] = sigmoidf_(x); }
                *(u32x4*)(PG + (size_t)row * 3072 + u.pn * 256 + c0) = pack8(g); } }
    }
};
struct EpiInproj {
    EPI_NOHOOK
    bf16_t *PR, *PC, *PM, *PG; unsigned char* KB; float* SSQ; const f32x2* RT; const f32x2* MT; int pn_off;
    __device__ __forceinline__ void operator()(const pg8::Acc& acc, const pg8::Unit& u_, int wr, int wc, int fr, int fq) const {
        pg8::Unit u = u_; asm volatile("" : "+s"(u.pm), "+s"(u.pn), "+s"(u.aux0), "+s"(u.aux1), "+v"(fr), "+v"(fq));
        const int pn = u.pn + pn_off;
#pragma unroll
        for (int ai = 0; ai < 2; ++ai)
#pragma unroll
        for (int m = 0; m < 4; ++m) { __builtin_amdgcn_sched_barrier(0);
            const int row = u.pm * 256 + ai * 128 + wr * 64 + m * 16 + fr;
            const int bl = row / SB, s = row - bl * SB; const bool lat = s >= CTXL; const int t = lat ? s - CTXL : 0;
            float ss[2] = {0.f, 0.f};
#pragma unroll
            for (int bj = 0; bj < 2; ++bj) {
                const int c0 = bj * 128 + wc * 32 + 8 * fq;
                EPI_V8(v, acc, ai, bj, m)
                if (pn <= 1) {
                    if (lat) rot4(v, RT + (size_t)t * 32 + ((c0 & 63) >> 1));
                    if (pn == 1) {
#pragma unroll
                        for (int k = 0; k < 8; ++k) v[k] *= 0.125f;
                    }
                    *(u32x4*)(PR + (size_t)row * 1536 + pn * 256 + c0) = pack8(v);
                } else if (pn <= 5) {
                    *(u32x4*)(PR + (size_t)row * 1536 + pn * 256 + c0) = pack8(v);
                } else if (pn <= 7) {
                    *(u32x4*)(PC + (size_t)row * 1024 + (pn - 6) * 256 + c0) = pack8(v);
                } else if (pn <= 11) {
                    u32x2 w; w.x = cvtpk(v[0] * v[1], v[2] * v[3]); w.y = cvtpk(v[4] * v[5], v[6] * v[7]);
                    *(u32x2*)(PC + (size_t)row * 1024 + 512 + (pn - 8) * 128 + (c0 >> 1)) = w;
                } else if (pn <= 14) {
                    if (pn == 14 && bj == 1) {
                        if (wc == 0) {
                            if (lat) { const int a = fq >> 1, pos = a ? (t & 63) : (t >> 6); rot4(v, MT + pos * 8 + (fq & 1) * 4); }
#pragma unroll
                            for (int k = 0; k < 8; ++k) v[k] *= K8S;
                            const u32x2 w = pack8_fp8(v);
#pragma unroll
                            for (int hh = 0; hh < 8; ++hh) { unsigned char* kp = KB + ((size_t)(bl * 8 + hh) * SB + s) * 128;
                                *(u32x2*)(kp + 64 + 8 * fq) = w; if (fq == 3) { *(u32x4*)(kp + 96) = (u32x4){0u, 0u, 0u, 0u}; *(u32x4*)(kp + 112) = (u32x4){0u, 0u, 0u, 0u}; } }
                        }
                    } else {
                        *(u32x4*)(PM + (size_t)row * 640 + (pn - 12) * 256 + c0) = pack8(v);
                        float q = 0.f;
#pragma unroll
                        for (int k = 0; k < 8; ++k) q += v[k] * v[k];
                        ss[bj] = q;
                    }
                } else {
                    float g[8];
#pragma unroll
                    for (int k = 0; k < 8; ++k) { const float x = fminf(fmaxf(v[k], -15.f), 15.f); g[k] = sigmoidf_(x); }
                    ST_NT((u32x4*)(PG + (size_t)row * 3072 + (pn - 15) * 256 + c0), pack8(g));
                }
            }
            if (pn >= 12 && pn <= 14) {
                float a = ss[0], b = ss[1];
                a += swz_xor<16>(a); a = half_sum(a); b += swz_xor<16>(b); b = half_sum(b);
                if (fq == 0) {
                    float* sq = SSQ + (size_t)row * 16;
                    if (pn == 12) sq[wc] = a + b;
                    else if (pn == 13) { sq[4 + wc] = a; sq[8 + wc] = b; }
                    else sq[12 + wc] = a;
                }
            }
        }
    }
};

#define EPI_ROW(ai, m) (u.pm * 256 + (ai) * 128 + wr * 64 + (m) * 16 + fr)
#define EPI_OPAQUE pg8::Unit u = u_; asm volatile("" : "+s"(u.pm), "+s"(u.pn), "+s"(u.aux0), "+s"(u.aux1), "+v"(fr), "+v"(fq));
struct EpiUq {
    EPI_NOHOOK
    unsigned char* QB; const float* SSQ; const f32x2* MT;
    __device__ __forceinline__ void operator()(const pg8::Acc& acc, const pg8::Unit& u_, int wr, int wc, int fr, int fq) const {
        EPI_OPAQUE
        f32x4 q0[2][4], q1[2][4];
#pragma unroll
        for (int ai = 0; ai < 2; ++ai)
#pragma unroll
            for (int m = 0; m < 4; ++m) { const float* sq = SSQ + (size_t)EPI_ROW(ai, m) * 16; q0[ai][m] = *(const f32x4*)sq; q1[ai][m] = *(const f32x4*)(sq + 4); }
#pragma unroll
        for (int ai = 0; ai < 2; ++ai)
#pragma unroll
        for (int m = 0; m < 4; ++m) {
            const int row = EPI_ROW(ai, m);
            const int bl = row / SB, s = row - bl * SB; const bool lat = s >= CTXL; const int t = lat ? s - CTXL : 0;
            const f32x4 a = q0[ai][m], b = q1[ai][m];
            const float ssq = ((a[0] + a[1]) + (a[2] + a[3])) + ((b[0] + b[1]) + (b[2] + b[3]));
            const float rq = rsqrtf(ssq * (1.f / 384.f) + RMS_EPS) * (QSCALE * Q8S);
#pragma unroll
            for (int bj = 0; bj < 2; ++bj) {
                const int cg = u.pn * 256 + bj * 128 + wc * 32 + 8 * fq; const int h = cg / 96, d0 = cg - h * 96;
                EPI_V8(v, acc, ai, bj, m)
#pragma unroll
                for (int k = 0; k < 8; ++k) v[k] *= rq;
                if (d0 >= 64 && lat) { const int p0 = d0 - 64, aa = p0 >> 4, pos = aa ? (t & 63) : (t >> 6); rot4(v, MT + pos * 8 + ((p0 & 15) >> 1)); }
                unsigned char* qp = QB + ((size_t)(bl * 8 + h) * SB + s) * 128;
                *(u32x2*)(qp + d0) = pack8_fp8(v);
                if (d0 == 88) { *(u32x4*)(qp + 96) = (u32x4){0u, 0u, 0u, 0u}; *(u32x4*)(qp + 112) = (u32x4){0u, 0u, 0u, 0u}; }
            }
        }
    }
};
struct EpiUkv {
    EPI_NOHOOK
    unsigned char* KB; unsigned char* VT; const float* SSQ; LAS unsigned char* tr;
    __device__ __forceinline__ void operator()(const pg8::Acc& acc, const pg8::Unit& u_, int wr, int wc, int fr, int fq) const {
        EPI_OPAQUE
        f32x4 q0[2][4], q1[2][4];
#pragma unroll
        for (int ai = 0; ai < 2; ++ai)
#pragma unroll
            for (int m = 0; m < 4; ++m) { const float* sq = SSQ + (size_t)EPI_ROW(ai, m) * 16 + 8; q0[ai][m] = *(const f32x4*)sq; q1[ai][m] = *(const f32x4*)(sq + 4); }
        LAS unsigned char* my = tr + (wr * 2 + (wc & 1)) * 2048;
        const int lane = fr + 16 * fq;
#pragma unroll
        for (int ai = 0; ai < 2; ++ai) {
            const int row0 = u.pm * 256 + ai * 128 + wr * 64;
            const int bl = row0 / SB, s0 = row0 - bl * SB;
#pragma unroll
            for (int bj = 0; bj < 2; ++bj) {
                const int h = u.pn * 2 + bj;
#pragma unroll
                for (int m = 0; m < 4; ++m) {
                    const f32x4 a = q0[ai][m], b = q1[ai][m];
                    const float ssq = ((a[0] + a[1]) + (a[2] + a[3])) + ((b[0] + b[1]) + (b[2] + b[3]));
                    const float rk = rsqrtf(ssq * (1.f / 256.f) + RMS_EPS);
                    EPI_V8(v, acc, ai, bj, m)
                    if (wc < 2) {
#pragma unroll
                        for (int k = 0; k < 8; ++k) v[k] *= rk * K8S;
                        *(u32x2*)(KB + ((size_t)(bl * 8 + h) * SB + s0 + 16 * m + fr) * 128 + wc * 32 + 8 * fq) = pack8_fp8(v);
                    } else {
#pragma unroll
                        for (int k = 0; k < 8; ++k) v[k] *= rk * V8S;
                        const u32x2 w = pack8_fp8(v); const int pos = vt_pos(16 * m + fr) ^ (16 * fq);
#pragma unroll
                        for (int k = 0; k < 4; ++k) { my[(8 * fq + k) * 64 + pos] = (unsigned char)(w.x >> (8 * k)); my[(8 * fq + 4 + k) * 64 + pos] = (unsigned char)(w.y >> (8 * k)); }
                    }
                }
                if (wc >= 2) {
#pragma unroll
                    for (int i = 0; i < 2; ++i) { const int ch = lane + 64 * i, d = ch >> 2, c16 = ch & 3;
                        const u32x4 x = *(const LAS u32x4*)(my + d * 64 + ((c16 ^ ((d >> 3) & 3)) * 16));
                        *(u32x4*)(VT + ((size_t)(bl * 8 + h) * 64 + (wc - 2) * 32 + d) * SB + s0 + c16 * 16) = x; }
                }
            }
        }
    }
};

struct EpiMerge1 {
    static constexpr bool HOOK = true; static constexpr int HOOK_T0 = 8, HOOK_T1 = 16;
    const bf16_t* PG; bf16_t* M;
    __device__ __forceinline__ void hook(pg8::Acc& acc, const pg8::Unit& u_, int t, int wr, int wc, int fr, int fq) const {
        pg8::Unit u = u_; asm volatile("" : "+s"(u.pm), "+s"(u.pn), "+v"(fr), "+v"(fq));
        const int gi = (t == 8) ? 0 : 1;
#pragma unroll
        for (int ai = 0; ai < 2; ++ai) {
            u32x4 sp[4][2], sn[4][2];
#pragma unroll
            for (int m = 0; m < 4; ++m)
#pragma unroll
                for (int bj = 0; bj < 2; ++bj) { const bf16_t* p = PG + (size_t)EPI_ROW(ai, m) * 3072 + gi * 1024 + u.pn * 256 + bj * 128 + wc * 32 + 8 * fq;
                    sp[m][bj] = *(const u32x4*)p; sn[m][bj] = *(const u32x4*)(p + 1024); }
#pragma unroll
            for (int m = 0; m < 4; ++m)
#pragma unroll
                for (int bj = 0; bj < 2; ++bj) {
                    float a[8], b[8]; unpack8(sp[m][bj], a); unpack8(sn[m][bj], b);
                    f32x4 r0, r1;
#pragma unroll
                    for (int k = 0; k < 4; ++k) { r0[k] = a[k] * __builtin_amdgcn_rcpf(b[k]); r1[k] = a[4 + k] * __builtin_amdgcn_rcpf(b[4 + k]); }
                    acc[ai][bj][m][0] *= r0; acc[ai][bj][m][1] *= r1;
                }
            __builtin_amdgcn_sched_barrier(0);
        }
    }
    __device__ __forceinline__ void operator()(const pg8::Acc& acc, const pg8::Unit& u_, int wr, int wc, int fr, int fq) const {
        EPI_OPAQUE
#pragma unroll
        for (int ai = 0; ai < 2; ++ai) {
            u32x4 s2[4][2];
#pragma unroll
            for (int m = 0; m < 4; ++m)
#pragma unroll
                for (int bj = 0; bj < 2; ++bj) s2[m][bj] = *(const u32x4*)(PG + (size_t)EPI_ROW(ai, m) * 3072 + 2048 + u.pn * 256 + bj * 128 + wc * 32 + 8 * fq);
#pragma unroll
            for (int m = 0; m < 4; ++m)
#pragma unroll
                for (int bj = 0; bj < 2; ++bj) {
                    const int cg = u.pn * 256 + bj * 128 + wc * 32 + 8 * fq;
                    float g[8]; unpack8(s2[m][bj], g);
                    EPI_V8(v, acc, ai, bj, m)
#pragma unroll
                    for (int k = 0; k < 8; ++k) v[k] *= g[k];
                    *(u32x4*)(M + (size_t)EPI_ROW(ai, m) * 1024 + cg) = pack8(v);
                }
            __builtin_amdgcn_sched_barrier(0);
        }
    }
};

struct EpiMerge1NoHook : EpiMerge1 { static constexpr bool HOOK = false; };
struct EpiMerge1HookOnly { static constexpr bool HOOK = true; static constexpr int HOOK_T0 = 8, HOOK_T1 = 16; EpiMerge1 e; float* sink;
    __device__ __forceinline__ void hook(pg8::Acc& acc, const pg8::Unit& u, int t, int wr, int wc, int fr, int fq) const { e.hook(acc, u, t, wr, wc, fr, fq); }
    __device__ __forceinline__ void operator()(const pg8::Acc& acc, const pg8::Unit& u, int wr, int wc, int fr, int fq) const { EpiNone n{sink}; n(acc, u, wr, wc, fr, fq); }
};
struct EpiMerge2 {
    EPI_NOHOOK
    Resid R; const float* MODL;
    __device__ __forceinline__ void operator()(const pg8::Acc& acc, const pg8::Unit& u_, int wr, int wc, int fr, int fq) const {
        EPI_OPAQUE
        const int cb = u.pn * 256 + wc * 32 + 8 * fq;
        const float* g1 = MODL + R.modv(u.pm * 256) * 6144 + 2048 + cb;
        f32x4 g[2][2];
#pragma unroll
        for (int bj = 0; bj < 2; ++bj)
#pragma unroll
            for (int n = 0; n < 2; ++n) g[bj][n] = *(const f32x4*)(g1 + bj * 128 + 4 * n);
        int sf32 = R.src_f32; asm volatile("" : "+s"(sf32));
#pragma unroll
        for (int ai = 0; ai < 2; ++ai) {
            if (sf32) {
#pragma unroll
                for (int mh = 0; mh < 2; ++mh) {
                    f32x4 x[2][2][2];
#pragma unroll
                    for (int m2 = 0; m2 < 2; ++m2) { const float* src = R.srcf(EPI_ROW(ai, 2 * mh + m2)) + cb;
#pragma unroll
                        for (int bj = 0; bj < 2; ++bj)
#pragma unroll
                            for (int n = 0; n < 2; ++n) x[m2][bj][n] = *(const f32x4*)(src + bj * 128 + 4 * n); }
#pragma unroll
                    for (int m2 = 0; m2 < 2; ++m2) { const int m = 2 * mh + m2; bf16_t* dst = R.dst(EPI_ROW(ai, m)) + cb;
#pragma unroll
                        for (int bj = 0; bj < 2; ++bj) { const f32x4 a = x[m2][bj][0] + g[bj][0] * acc[ai][bj][m][0], b = x[m2][bj][1] + g[bj][1] * acc[ai][bj][m][1];
                            u32x4 w; w.x = cvtpk(a[0], a[1]); w.y = cvtpk(a[2], a[3]); w.z = cvtpk(b[0], b[1]); w.w = cvtpk(b[2], b[3]); *(u32x4*)(dst + bj * 128) = w; } }
                }
            } else {
                u32x4 x[4][2];
#pragma unroll
                for (int m = 0; m < 4; ++m) { const bf16_t* src = R.dst(EPI_ROW(ai, m)) + cb;
#pragma unroll
                    for (int bj = 0; bj < 2; ++bj) x[m][bj] = *(const u32x4*)(src + bj * 128); }
#pragma unroll
                for (int m = 0; m < 4; ++m) { bf16_t* dst = R.dst(EPI_ROW(ai, m)) + cb;
#pragma unroll
                    for (int bj = 0; bj < 2; ++bj) { float f[8]; unpack8(x[m][bj], f);
                        const f32x4 a = (f32x4){f[0], f[1], f[2], f[3]} + g[bj][0] * acc[ai][bj][m][0], b = (f32x4){f[4], f[5], f[6], f[7]} + g[bj][1] * acc[ai][bj][m][1];
                        u32x4 w; w.x = cvtpk(a[0], a[1]); w.y = cvtpk(a[2], a[3]); w.z = cvtpk(b[0], b[1]); w.w = cvtpk(b[2], b[3]); *(u32x4*)(dst + bj * 128) = w; } }
            }
            __builtin_amdgcn_sched_barrier(0);
        }
    }
};

struct EpiMoeUp {
    EPI_NOHOOK
    const int* LIST; const float* WGT; bf16_t* MACT;
    __device__ __forceinline__ void operator()(const pg8::Acc& acc, const pg8::Unit& u_, int wr, int wc, int fr, int fq) const {
        EPI_OPAQUE
        const int slot = u.pn >> 2;
        int tok[2][4]; float w[2][4];
#pragma unroll
        for (int ai = 0; ai < 2; ++ai)
#pragma unroll
            for (int m = 0; m < 4; ++m) { const int ri = ai * 128 + wr * 64 + m * 16 + fr; tok[ai][m] = LIST[u.aux0 + (ri < u.aux1 ? ri : 0)]; }
#pragma unroll
        for (int ai = 0; ai < 2; ++ai)
#pragma unroll
            for (int m = 0; m < 4; ++m) w[ai][m] = WGT[(size_t)tok[ai][m] * 2 + slot];
#pragma unroll
        for (int ai = 0; ai < 2; ++ai)
#pragma unroll
        for (int m = 0; m < 4; ++m) {
            const int ri = ai * 128 + wr * 64 + m * 16 + fr; const float ww = w[ai][m];
#pragma unroll
            for (int bj = 0; bj < 2; ++bj) {
                const int c0 = bj * 128 + wc * 32 + 8 * fq;
                EPI_V8(v, acc, ai, bj, m)
                u32x2 o; o.x = cvtpk(siluf_(v[0]) * v[1] * ww, siluf_(v[2]) * v[3] * ww); o.y = cvtpk(siluf_(v[4]) * v[5] * ww, siluf_(v[6]) * v[7] * ww);
                *(u32x2*)(MACT + (size_t)(u.pm * 256 + ri) * 1024 + slot * 512 + (u.pn & 3) * 128 + (c0 >> 1)) = o;
            }
        }
    }
};
struct EpiMoeUp8 {
    EPI_NOHOOK
    const int* LIST; const float* WGT; unsigned char* MACT;
    __device__ __forceinline__ void operator()(const pg8::Acc& acc, const pg8::Unit& u_, int wr, int wc, int fr, int fq) const {
        EPI_OPAQUE
        const int slot = u.pn >> 2;
        int tok[2][4]; float w[2][4];
#pragma unroll
        for (int ai = 0; ai < 2; ++ai)
#pragma unroll
            for (int m = 0; m < 4; ++m) { const int ri = ai * 128 + wr * 64 + m * 16 + fr; tok[ai][m] = LIST[u.aux0 + (ri < u.aux1 ? ri : 0)]; }
#pragma unroll
        for (int ai = 0; ai < 2; ++ai)
#pragma unroll
            for (int m = 0; m < 4; ++m) w[ai][m] = WGT[(size_t)tok[ai][m] * 2 + slot] * MA8S;
#pragma unroll
        for (int ai = 0; ai < 2; ++ai)
#pragma unroll
        for (int m = 0; m < 4; ++m) {
            const int ri = ai * 128 + wr * 64 + m * 16 + fr; const float ww = w[ai][m];
#pragma unroll
            for (int bj = 0; bj < 2; ++bj) {
                const int c0 = bj * 128 + wc * 32 + 8 * fq;
                EPI_V8(v, acc, ai, bj, m)
                int o = __builtin_amdgcn_cvt_pk_fp8_f32(siluf_(v[0]) * v[1] * ww, siluf_(v[2]) * v[3] * ww, 0, false); o = __builtin_amdgcn_cvt_pk_fp8_f32(siluf_(v[4]) * v[5] * ww, siluf_(v[6]) * v[7] * ww, o, true);
                *(int*)(MACT + (size_t)(u.pm * 256 + ri) * 1024 + slot * 512 + (u.pn & 3) * 128 + (c0 >> 1)) = o;
            }
        }
    }
};
struct EpiMoeDown {
    EPI_NOHOOK
    const int* LIST; Resid R; const float* MODL; bf16_t* dry;
    __device__ __forceinline__ void operator()(const pg8::Acc& acc, const pg8::Unit& u_, int wr, int wc, int fr, int fq) const {
        EPI_OPAQUE
        int tok[2][4];
#pragma unroll
        for (int ai = 0; ai < 2; ++ai)
#pragma unroll
            for (int m = 0; m < 4; ++m) { const int ri = ai * 128 + wr * 64 + m * 16 + fr; tok[ai][m] = LIST[u.aux0 + (ri < u.aux1 ? ri : 0)]; }
        const int cb = u.pn * 256 + wc * 32 + 8 * fq;
#pragma unroll
        for (int ai = 0; ai < 2; ++ai) {
            u32x4 x[4][2];
#pragma unroll
            for (int m = 0; m < 4; ++m) { const bf16_t* dst = R.dst(tok[ai][m]) + cb;
#pragma unroll
                for (int bj = 0; bj < 2; ++bj) x[m][bj] = *(const u32x4*)(dst + bj * 128); }
#pragma unroll
            for (int m = 0; m < 4; ++m) { const int ri = ai * 128 + wr * 64 + m * 16 + fr;
                if (ri < u.aux1) {
                    bf16_t* dst = R.dst(tok[ai][m]) + cb; const float* g2 = MODL + R.modv(tok[ai][m]) * 6144 + 5120 + cb;
#pragma unroll
                    for (int bj = 0; bj < 2; ++bj) { float f[8]; unpack8(x[m][bj], f);
                        const f32x4 ga = *(const f32x4*)(g2 + bj * 128), gb = *(const f32x4*)(g2 + bj * 128 + 4);
                        const f32x4 a = (f32x4){f[0], f[1], f[2], f[3]} + ga * acc[ai][bj][m][0], b = (f32x4){f[4], f[5], f[6], f[7]} + gb * acc[ai][bj][m][1];
                        u32x4 w; w.x = cvtpk(a[0], a[1]); w.y = cvtpk(a[2], a[3]); w.z = cvtpk(b[0], b[1]); w.w = cvtpk(b[2], b[3]);
                        bf16_t* o = dry ? dry + (size_t)(u.pm * 256 + ri) * 1024 + cb + bj * 128 : dst + bj * 128;
                        *(u32x4*)o = w; }
                } }
            __builtin_amdgcn_sched_barrier(0);
        }
    }
};
#define SBAR() __builtin_amdgcn_sched_barrier(0)
__device__ __forceinline__ int crow(int r, int hi) { return (r & 3) + 8 * (r >> 2) + 4 * hi; }
template <int NCB> __device__ __forceinline__ int v_st(int k, int c) { const int kk = (k & ~0xC) | ((k & 4) << 1) | ((k & 8) >> 1); return ((kk >> 3) * NCB + (c >> 5)) * 512 + ((kk & 7) * 32 + (c & 31)) * 2; }
__device__ __forceinline__ int v_rd_base(int lane) { return ((lane & 3) << 3) | (((lane >> 2) & 3) << 6) | (((lane >> 4) & 1) << 5) | (((lane >> 5) & 1) << 8); }
template <int OFF> __device__ __forceinline__ s16x4 tr_read(int vb) { s16x4 r; asm volatile("ds_read_b64_tr_b16 %0, %1 offset:%2" : "=&v"(r) : "v"(vb), "i"(OFF) : "memory"); return r; }
#define PKLH(L, H) (bf16x8){L[0], L[1], L[2], L[3], H[0], H[1], H[2], H[3]}
template <int NCB, int KS> __device__ __forceinline__ bf16x8 tr_frag(int vb) { const s16x4 l = tr_read<KS * NCB * 1024>(vb), h = tr_read<KS * NCB * 1024 + NCB * 512>(vb); return PKLH(l, h); }
#define PK4(P, BASE, OUT) do { const unsigned a0 = cvtpk(P[BASE + 0], P[BASE + 1]), a1 = cvtpk(P[BASE + 2], P[BASE + 3]);   \
    const unsigned b0 = cvtpk(P[BASE + 4], P[BASE + 5]), b1 = cvtpk(P[BASE + 6], P[BASE + 7]);                              \
    auto r0 = __builtin_amdgcn_permlane32_swap(a0, b0, false, false); auto r1 = __builtin_amdgcn_permlane32_swap(a1, b1, false, false); \
    u32x4 w = {r0[0], r1[0], r0[1], r1[1]}; OUT = __builtin_bit_cast(bf16x8, w); } while (0)

namespace att {
constexpr int DQK = 96, DV = 64, KVBLK = 64;
constexpr int SHM_V = KVBLK * DV * 2;
constexpr int SHM_K = KVBLK * 256;
constexpr float THR = 8.f;
#define KSWZ(row, colB) ((row) * 256 + ((colB) ^ (((row) & 7) << 4)))
__device__ __forceinline__ void partialSM(f32x16& p0, f32x16& p1, float& m_reg, float& alpha) {
    float pmax = p0[0];
#pragma unroll
    for (int r = 1; r < 16; ++r) pmax = fmaxf(pmax, p0[r]);
#pragma unroll
    for (int r = 0; r < 16; ++r) pmax = fmaxf(pmax, p1[r]);
    { auto rr = __builtin_amdgcn_permlane32_swap(__float_as_uint(pmax), __float_as_uint(pmax), false, false);
      pmax = fmaxf(__uint_as_float(rr[0]), __uint_as_float(rr[1])); }
    float mn;
    if (__builtin_expect(__all(pmax - m_reg <= THR), 1)) { mn = m_reg; alpha = 1.f; }
    else { mn = fmaxf(m_reg, pmax); alpha = __builtin_amdgcn_exp2f(m_reg - mn); m_reg = mn; }
#pragma unroll
    for (int r = 0; r < 16; ++r) p0[r] = p0[r] - mn;
#pragma unroll
    for (int r = 0; r < 16; ++r) p1[r] = p1[r] - mn;
#pragma unroll
    for (int r = 0; r < 16; ++r) p0[r] = __builtin_amdgcn_exp2f(p0[r]);
}
__device__ __forceinline__ void finishSM(f32x16& p0, f32x16& p1, float alpha, float& l_reg, bf16x8& pa0, bf16x8& pa1, bf16x8& pa2, bf16x8& pa3) {
#pragma unroll
    for (int r = 0; r < 16; ++r) p1[r] = __builtin_amdgcn_exp2f(p1[r]);
    float ps = 0;
#pragma unroll
    for (int r = 0; r < 16; ++r) ps += p0[r];
#pragma unroll
    for (int r = 0; r < 16; ++r) ps += p1[r];
    { auto rr = __builtin_amdgcn_permlane32_swap(__float_as_uint(ps), __float_as_uint(ps), false, false);
      ps = __uint_as_float(rr[0]) + __uint_as_float(rr[1]); }
    l_reg = l_reg * alpha + ps;
    PK4(p0, 0, pa0); PK4(p0, 8, pa1); PK4(p1, 0, pa2); PK4(p1, 8, pa3);
}
__device__ __forceinline__ void qkt(f32x16& p0, f32x16& p1, const LAS char* Ks, const bf16x8* qr, int r32, int hi) {
    p0 = f32x16{}; p1 = f32x16{};
#pragma unroll
    for (int d0 = 0; d0 < 6; ++d0) { const int cb = (d0 * 16 + hi * 8) * 2;
        const bf16x8 b0 = *(const LAS bf16x8*)(Ks + KSWZ(r32, cb));
        const bf16x8 b1 = *(const LAS bf16x8*)(Ks + KSWZ(32 + r32, cb));
        p0 = __builtin_amdgcn_mfma_f32_32x32x16_bf16(b0, qr[d0], p0, 0, 0, 0);
        p1 = __builtin_amdgcn_mfma_f32_32x32x16_bf16(b1, qr[d0], p1, 0, 0, 0); }
}
template <int D0> __device__ __forceinline__ void pv_one(f32x16& od, int vb, bf16x8 pa0, bf16x8 pa1, bf16x8 pa2, bf16x8 pa3) {
    const bf16x8 f0 = tr_frag<2, 0>(vb + D0 * 512), f1 = tr_frag<2, 1>(vb + D0 * 512), f2 = tr_frag<2, 2>(vb + D0 * 512), f3 = tr_frag<2, 3>(vb + D0 * 512);
    asm volatile("s_waitcnt lgkmcnt(0)" ::: "memory"); SBAR();
    od = __builtin_amdgcn_mfma_f32_32x32x16_bf16(pa0, f0, od, 0, 0, 0);
    od = __builtin_amdgcn_mfma_f32_32x32x16_bf16(pa1, f1, od, 0, 0, 0);
    od = __builtin_amdgcn_mfma_f32_32x32x16_bf16(pa2, f2, od, 0, 0, 0);
    od = __builtin_amdgcn_mfma_f32_32x32x16_bf16(pa3, f3, od, 0, 0, 0);
}
__device__ __forceinline__ void pv_d0(f32x16* o, int vb, bf16x8 pa0, bf16x8 pa1, bf16x8 pa2, bf16x8 pa3) {
    pv_one<0>(o[0], vb, pa0, pa1, pa2, pa3); pv_one<1>(o[1], vb, pa0, pa1, pa2, pa3);
}
__device__ __forceinline__ void attn_unit(const bf16_t* __restrict__ Qb, const bf16_t* __restrict__ Kh, const bf16_t* __restrict__ Vh, bf16_t* __restrict__ Ob, int ldo, int seq, LAS char* lds, const int wv) {
    const int tid = otid(wv), wid = __builtin_amdgcn_readfirstlane(tid >> 6), lane = tid & 63, r32 = lane & 31, hi = lane >> 5;
    LAS char* V_lds = lds; LAS char* K_lds = lds + 2 * SHM_V;
    LAS float* ws = (LAS float*)(lds + 2 * SHM_V + 2 * SHM_K) + wid * 64; LAS float* li_l = ws; LAS float* al_l = ws + 32;
    float m_reg = -1e30f, l_reg = 0; f32x16 o[2] = {}; bf16x8 qr[6];
    const bf16_t* Qw = Qb + (size_t)(wid * 32 + r32) * DQK + hi * 8;
#pragma unroll
    for (int d0 = 0; d0 < 6; ++d0) qr[d0] = *(const bf16x8*)(Qw + d0 * 16);
    const int vrow = tid >> 3, vc = (tid & 7) * 8, vst = v_st<2>(vrow, vc);
    const int krA = tid / 12, kcA = tid - krA * 12, sB = 512 + tid, krB = sB / 12, kcB = sB - krB * 12;
    const int kstA = KSWZ(krA, kcA * 16), kstB = KSWZ(krB, kcB * 16);
    const bool hasB = wid < 4;
    const int vb0 = (int)(size_t)V_lds + v_rd_base(lane);
    struct { bf16x8 v, ka, kb; } sr_[2];
#define SLOAD(i, k0) do { sr_[i].v = *(const bf16x8*)(Vh + (size_t)((k0) + vrow) * DV + vc); sr_[i].ka = *(const bf16x8*)(Kh + (size_t)((k0) + krA) * DQK + kcA * 8); \
    if (hasB) sr_[i].kb = *(const bf16x8*)(Kh + (size_t)((k0) + krB) * DQK + kcB * 8); } while (0)
#define SWRITE(b, i) do { *(LAS bf16x8*)(V_lds + (b) * SHM_V + vst) = sr_[i].v; *(LAS bf16x8*)(K_lds + (b) * SHM_K + kstA) = sr_[i].ka; \
    if (hasB) *(LAS bf16x8*)(K_lds + (b) * SHM_K + kstB) = sr_[i].kb; } while (0)
#define RESC(a) do { if (__any((a) < 1.f)) { if (hi == 0) al_l[r32] = (a); asm volatile("s_waitcnt lgkmcnt(0)" ::: "memory"); \
    _Pragma("unroll") for (int d = 0; d < 2; ++d) _Pragma("unroll") for (int r = 0; r < 16; ++r) o[d][r] *= al_l[crow(r, hi)]; } } while (0)
    f32x16 pA0, pA1, pB0, pB1; float alA, alB; bf16x8 pa0, pa1, pa2, pa3; const int NTL = seq / KVBLK;
    SLOAD(0, 0); SWRITE(0, 0); __syncthreads();
    qkt(pA0, pA1, K_lds, qr, r32, hi); partialSM(pA0, pA1, m_reg, alA);
    SLOAD(1, KVBLK); if (2 < NTL) SLOAD(0, 2 * KVBLK);
    SWRITE(1, 1); __syncthreads();
    for (int j = 1; j + 1 < NTL; j += 2) {
        SBAR(); qkt(pB0, pB1, K_lds + SHM_K, qr, r32, hi);
        finishSM(pA0, pA1, alA, l_reg, pa0, pa1, pa2, pa3); SBAR();
        SLOAD(1, (j + 2) * KVBLK); SBAR();
        pv_d0(o, vb0, pa0, pa1, pa2, pa3); partialSM(pB0, pB1, m_reg, alB);
        __syncthreads(); SWRITE(0, 0);
        RESC(alB); __syncthreads();
        SBAR(); qkt(pA0, pA1, K_lds, qr, r32, hi);
        finishSM(pB0, pB1, alB, l_reg, pa0, pa1, pa2, pa3); SBAR();
        if (j + 3 < NTL) SLOAD(0, (j + 3) * KVBLK); SBAR();
        pv_d0(o, vb0 + SHM_V, pa0, pa1, pa2, pa3); partialSM(pA0, pA1, m_reg, alA);
        __syncthreads(); SWRITE(1, 1);
        RESC(alA); __syncthreads();
    }
    SBAR(); qkt(pB0, pB1, K_lds + SHM_K, qr, r32, hi);
    finishSM(pA0, pA1, alA, l_reg, pa0, pa1, pa2, pa3); SBAR();
    pv_d0(o, vb0, pa0, pa1, pa2, pa3); partialSM(pB0, pB1, m_reg, alB);
    __syncthreads(); RESC(alB);
    finishSM(pB0, pB1, alB, l_reg, pa0, pa1, pa2, pa3); SBAR();
    pv_d0(o, vb0 + SHM_V, pa0, pa1, pa2, pa3);
    if (hi == 0) li_l[r32] = l_reg; asm volatile("s_waitcnt lgkmcnt(0)" ::: "memory");
    float rli[16];
#pragma unroll
    for (int r = 0; r < 16; ++r) rli[r] = __builtin_amdgcn_rcpf(li_l[crow(r, hi)]);
    bf16_t* Ow = Ob + (size_t)(wid * 32) * ldo;
#pragma unroll
    for (int r = 0; r < 16; ++r) { const int orow = crow(r, hi);
#pragma unroll
        for (int d0 = 0; d0 < 2; ++d0) Ow[(size_t)orow * ldo + d0 * 32 + r32] = f2bf(o[d0][r] * rli[r]); }
    __syncthreads();
#undef SLOAD
#undef SWRITE
#undef RESC
}
}

namespace att2 {
constexpr int DQK = 96, DV = 64, KVBLK = 64;
constexpr int KB_BYTES = 64 * 128, VB_BYTES = 64 * 64;
typedef int i32x8 __attribute__((ext_vector_type(8)));
constexpr int SC_K = 0x7d7d7d7d, SC_Q = 0x7a7a7a7a, SC_P = 0x7f7f7f7f, SC_V = 0x7d7d7d7d;
constexpr int NSLOT = 5;
constexpr int LDS_K = 0, LDS_V = NSLOT * KB_BYTES, LDS_WS = LDS_V + NSLOT * VB_BYTES, LDS_TOTAL = LDS_WS + 8 * 64 * 4;
static_assert(LDS_TOTAL <= RING_BYTES, "attention LDS");
constexpr float THR = 4.f;
typedef short v4i16_t __attribute__((ext_vector_type(4)));
__device__ __forceinline__ s16x4 vtr(const LAS char* p) { return __builtin_bit_cast(s16x4, __builtin_amdgcn_ds_read_tr16_b64_v4i16((LAS v4i16_t*)p)); }
#define PP_KLD(B, DH) ({ const int row_ = 32 * (B) + r32, sw_ = (row_ >> 1) & 7, c0_ = 2 * hi + 4 * (DH); \
        const u32x4 a_ = *(const LAS u32x4*)(Kt + row_ * 128 + ((c0_ ^ sw_) << 4)), b_ = *(const LAS u32x4*)(Kt + row_ * 128 + (((c0_ + 1) ^ sw_) << 4)); \
        (i32x8){(int)a_.x, (int)a_.y, (int)a_.z, (int)a_.w, (int)b_.x, (int)b_.y, (int)b_.z, (int)b_.w}; })
#define PP_VLD(DB) ({ const int d_ = 32 * (DB) + r32, sw_ = (d_ >> 2) & 3; \
        const u32x4 a_ = *(const LAS u32x4*)(Vt + d_ * 64 + (((2 * hi) ^ sw_) << 4)), b_ = *(const LAS u32x4*)(Vt + d_ * 64 + (((2 * hi + 1) ^ sw_) << 4)); \
        (i32x8){(int)a_.x, (int)a_.y, (int)a_.z, (int)a_.w, (int)b_.x, (int)b_.y, (int)b_.z, (int)b_.w}; })
#ifdef PROBE_EXP2X
#define PP_EXP(x) do { float a_ = (x), b_ = (x); asm volatile("" : "+v"(b_)); a_ = __builtin_amdgcn_exp2f(a_); b_ = __builtin_amdgcn_exp2f(b_); (x) = (a_ + b_) * 0.5f; } while (0)
#else
#define PP_EXP(x) (x) = __builtin_amdgcn_exp2f(x)
#endif
#define PK4N(P, BASE, OUT) do { u32x4 w_ = {cvtpk(P[BASE + 0], P[BASE + 1]), cvtpk(P[BASE + 2], P[BASE + 3]), cvtpk(P[BASE + 4], P[BASE + 5]), cvtpk(P[BASE + 6], P[BASE + 7])}; OUT = __builtin_bit_cast(bf16x8, w_); } while (0)
#define PP_SLOT_END() do { SBAR(); asm volatile("s_waitcnt vmcnt(%0) lgkmcnt(0)\n\ts_barrier" :: "n"(2 * (NSLOT - 2)) : "memory"); SBAR(); } while (0)
#define PP_BAR() do { SBAR(); asm volatile("s_waitcnt lgkmcnt(0)\n\ts_barrier" ::: "memory"); SBAR(); } while (0)
__device__ __forceinline__ float max3f(float a, float b, float c) { return fmaxf(fmaxf(a, b), c); }
__device__ __forceinline__ void attn_unit_pp(const unsigned char* __restrict__ Qb, const unsigned char* __restrict__ Kh, const unsigned char* __restrict__ Vh, bf16_t* __restrict__ Ob, int ldo, int seq, LAS char* lds, const int wv) {
    const int tid = otid(wv), wid = __builtin_amdgcn_readfirstlane(tid >> 6), lane = tid & 63, r32 = lane & 31, hi = lane >> 5, grp = wid >> 2;
    LAS float* ws = (LAS float*)(lds + LDS_WS) + wid * 64; LAS float* al_l = ws;
    const int NTL = seq / KVBLK;
    unsigned koff, voff;
    { const int s = wid * 64 + lane, row = s >> 3, ch = (s & 7) ^ ((row >> 1) & 7); koff = (unsigned)(row * 128 + ch * 16); }
    { const int s = (wid & 3) * 64 + lane, d = s >> 2, ch = (s & 3) ^ ((d >> 2) & 3); voff = (unsigned)(d * SB + ch * 16); }
    const char* Kg = (const char*)Kh; const char* Vg = (const char*)Vh;
#define PP_DMA_K(t) do { int tt_ = (t); tt_ = tt_ < NTL ? tt_ : NTL - 1; const int sl_ = tt_ % NSLOT; \
        __builtin_amdgcn_global_load_lds((const unsigned*)(Kg + (size_t)tt_ * (64 * 128) + koff), (LAS unsigned*)(lds + LDS_K + sl_ * KB_BYTES + wid * 1024), 16, 0, 0); } while (0)
#define PP_DMA_V(t) do { int tt_ = (t); tt_ = tt_ < NTL ? tt_ : NTL - 1; const int sl_ = tt_ % NSLOT; \
        __builtin_amdgcn_global_load_lds((const unsigned*)(Vg + (size_t)tt_ * 64 + voff), (LAS unsigned*)(lds + LDS_V + sl_ * VB_BYTES + (wid & 3) * 1024), 16, 0, 0); } while (0)
#pragma unroll
    for (int i = 0; i <= NSLOT - 2; ++i) PP_DMA_K(i);
#pragma unroll
    for (int i = 0; i <= NSLOT - 3; ++i) PP_DMA_V(i);
    i32x8 q8[2];
    { const unsigned char* Qw = Qb + (size_t)(wid * 32 + r32) * 128 + hi * 32;
#pragma unroll
      for (int dh = 0; dh < 2; ++dh) { const u32x4 a_ = *(const u32x4*)(Qw + dh * 64), b_ = *(const u32x4*)(Qw + dh * 64 + 16);
          q8[dh] = (i32x8){(int)a_.x, (int)a_.y, (int)a_.z, (int)a_.w, (int)b_.x, (int)b_.y, (int)b_.z, (int)b_.w}; } }
    float m_reg = 0.f; f32x16 o[2] = {}; f32x16 lacc = {}; const i32x8 ones8 = {0x38383838, 0x38383838, 0x38383838, 0x38383838, 0x38383838, 0x38383838, 0x38383838, 0x38383838}; f32x16 negm = {}; asm volatile("" : "+v"(negm));
    f32x16 p0, p1; i32x8 pa8 = {};
    SBAR(); asm volatile("s_waitcnt vmcnt(0) lgkmcnt(0)\n\ts_barrier" ::: "memory"); SBAR();
#ifdef ATTN_TWO_BARRIERS
    if (grp == 1) PP_BAR();
#endif
#define PP_M(t) do { const int t_ = (t), j_ = t_ + 1; \
        if (t_ <= NTL - 2) { PP_DMA_V(t_ + NSLOT - 1); PP_DMA_K(t_ + NSLOT); } \
        i32x8 k8[4]; i32x8 v8[2]; \
        const LAS char* Kt = lds + LDS_K + ((j_ < NTL ? j_ : 0) % NSLOT) * KB_BYTES; \
        const LAS char* Vt = lds + LDS_V + ((t_ < 0 ? 0 : t_) % NSLOT) * VB_BYTES; \
        if (j_ < NTL) { \
            k8[0] = PP_KLD(0, 0); k8[1] = PP_KLD(1, 0); SBAR(); \
            k8[2] = PP_KLD(0, 1); SBAR(); \
            p0 = __builtin_amdgcn_mfma_scale_f32_32x32x64_f8f6f4(k8[0], q8[0], negm, 0, 0, 0, SC_K, 0, SC_Q); SBAR(); \
            k8[3] = PP_KLD(1, 1); SBAR(); \
            p1 = __builtin_amdgcn_mfma_scale_f32_32x32x64_f8f6f4(k8[1], q8[0], negm, 0, 0, 0, SC_K, 0, SC_Q); SBAR(); \
            if (t_ >= 0) { v8[0] = PP_VLD(0); } SBAR(); \
            p0 = __builtin_amdgcn_mfma_scale_f32_32x32x64_f8f6f4(k8[2], q8[1], p0, 0, 0, 0, SC_K, 0, SC_Q); SBAR(); \
            if (t_ >= 0) { v8[1] = PP_VLD(1); } SBAR(); \
            p1 = __builtin_amdgcn_mfma_scale_f32_32x32x64_f8f6f4(k8[3], q8[1], p1, 0, 0, 0, SC_K, 0, SC_Q); SBAR(); \
        } else if (t_ >= 0) { v8[0] = PP_VLD(0); v8[1] = PP_VLD(1); SBAR(); } \
        if (t_ >= 0) { \
            o[0] = __builtin_amdgcn_mfma_scale_f32_32x32x64_f8f6f4(pa8, v8[0], o[0], 0, 0, 0, SC_P, 0, SC_V); \
            o[1] = __builtin_amdgcn_mfma_scale_f32_32x32x64_f8f6f4(pa8, v8[1], o[1], 0, 0, 0, SC_P, 0, SC_V); \
            lacc = __builtin_amdgcn_mfma_scale_f32_32x32x64_f8f6f4(pa8, ones8, lacc, 0, 0, 0, SC_P, 0, SC_P); } \
        asm volatile("" : "+v"(o[0]), "+v"(o[1]), "+v"(p0), "+v"(p1), "+v"(lacc));        \
        } while (0)
#define PP_S(first) do { \
        float a_ = max3f(p0[0], p0[1], p1[0]), b_ = max3f(p0[2], p0[3], p1[1]); a_ = max3f(a_, p1[2], p1[3]); \
        _Pragma("unroll") for (int r = 4; r < 16; r += 4) { a_ = max3f(a_, p0[r], p0[r + 1]); b_ = max3f(b_, p0[r + 2], p0[r + 3]); a_ = max3f(a_, p1[r], p1[r + 1]); b_ = max3f(b_, p1[r + 2], p1[r + 3]); } \
        float rm_ = fmaxf(a_, b_); { auto rr = __builtin_amdgcn_permlane32_swap(__float_as_uint(rm_), __float_as_uint(rm_), false, false); rm_ = fmaxf(__uint_as_float(rr[0]), __uint_as_float(rr[1])); } \
        if (first) { const float dl = rm_ - 4.f; m_reg = dl; _Pragma("unroll") for (int r = 0; r < 16; ++r) { p0[r] -= dl; p1[r] -= dl; } \
            _Pragma("unroll") for (int r = 0; r < 16; ++r) negm[r] = -m_reg; asm volatile("" : "+v"(negm)); } \
        else if (__builtin_expect(__any(rm_ > 2.f * THR), 0)) { const float dl = fmaxf(rm_ - THR, 0.f); m_reg += dl; \
            _Pragma("unroll") for (int r = 0; r < 16; ++r) { p0[r] -= dl; p1[r] -= dl; } \
            _Pragma("unroll") for (int r = 0; r < 16; ++r) negm[r] = -m_reg; asm volatile("" : "+v"(negm)); \
            const float al = __builtin_amdgcn_exp2f(-dl); if (hi == 0) al_l[r32] = al; asm volatile("s_waitcnt lgkmcnt(0)" ::: "memory"); \
            _Pragma("unroll") for (int r = 0; r < 16; ++r) { const float f_ = al_l[crow(r, hi)]; o[0][r] *= f_; o[1][r] *= f_; lacc[r] *= f_; } } \
        _Pragma("unroll") for (int r = 0; r < 16; ++r) { PP_EXP(p0[r]); PP_EXP(p1[r]); } \
        _Pragma("unroll") for (int k_ = 0; k_ < 4; ++k_) { \
            int w_ = __builtin_amdgcn_cvt_pk_fp8_f32(p0[4 * k_], p0[4 * k_ + 1], 0, false); w_ = __builtin_amdgcn_cvt_pk_fp8_f32(p0[4 * k_ + 2], p0[4 * k_ + 3], w_, true); pa8[k_] = w_; \
            int x_ = __builtin_amdgcn_cvt_pk_fp8_f32(p1[4 * k_], p1[4 * k_ + 1], 0, false); x_ = __builtin_amdgcn_cvt_pk_fp8_f32(p1[4 * k_ + 2], p1[4 * k_ + 3], x_, true); pa8[4 + k_] = x_; } \
        asm volatile("" : "+v"(pa8)); } while (0)
#ifdef ATTN_TWO_BARRIERS
    PP_M(-1); PP_SLOT_END();
    PP_S(true); PP_SLOT_END();
#pragma nounroll
    for (int t = 0; t < NTL - 1; ++t) {
        PP_M(t); PP_SLOT_END();
        PP_S(false); PP_SLOT_END();
    }
    PP_M(NTL - 1);
    if (grp == 0) PP_BAR();
#else
#ifdef ATTN_PRIO_YOUNG
    if (grp == 1) __builtin_amdgcn_s_setprio(1);
#endif
    if (grp == 0) {
        PP_M(-1); PP_S(true); PP_SLOT_END();
#pragma nounroll
        for (int t = 0; t < NTL - 1; ++t) { PP_M(t); PP_S(false); PP_SLOT_END(); }
        PP_M(NTL - 1);
    } else {
        PP_M(-1); PP_SLOT_END();
        PP_S(true);
#pragma nounroll
        for (int t = 0; t < NTL - 1; ++t) { PP_M(t); PP_SLOT_END(); PP_S(false); }
        PP_M(NTL - 1);
    }
#ifdef ATTN_PRIO_YOUNG
    __builtin_amdgcn_s_setprio(0);
#endif
#endif
    float rli[16];
#pragma unroll
    for (int r = 0; r < 16; ++r) rli[r] = __builtin_amdgcn_rcpf(lacc[r]);
    bf16_t* Ow = Ob + (size_t)(wid * 32) * ldo;
#pragma unroll
    for (int r = 0; r < 16; ++r) { const int orow = crow(r, hi);
#pragma unroll
        for (int d0 = 0; d0 < 2; ++d0) Ow[(size_t)orow * ldo + d0 * 32 + r32] = f2bf(o[d0][r] * rli[r]); }
    SBAR(); asm volatile("s_waitcnt vmcnt(0) lgkmcnt(0)\n\ts_barrier" ::: "memory"); SBAR();
#undef PP_DMA_K
#undef PP_DMA_V
#undef PP_M
#undef PP_S
}
}

__device__ __forceinline__ void retu_unit(int unit, const bf16_t* PR, float* U, float lg2f, float lg2b, LAS char* lds, const int wv) {
    const int tid = otid(wv), wid = __builtin_amdgcn_readfirstlane(tid >> 6), lane = tid & 63, r32 = lane & 31, hi = lane >> 5;
    const int h = unit & 3, bc = unit >> 2, bl = bc / NCHUNK, c = bc - bl * NCHUNK;
    const size_t r0 = (size_t)bl * SB + (size_t)c * 128;
    LAS char* Vt = lds;
    LAS char* Kf = lds + 32768;
    LAS char* Kb = lds + 49152;
#pragma unroll
    for (int i = 0; i < 2; ++i) { const int ch = tid + i * 512, j = ch >> 3, c8 = (ch & 7) * 8;
        const u32x4 kw = *(const u32x4*)(PR + (r0 + j) * 1536 + 256 + h * 64 + c8);
        float f[8], g[8]; unpack8(kw, f);
        const float wf = __builtin_amdgcn_exp2f(lg2f * (float)(127 - j)), wb = __builtin_amdgcn_exp2f(lg2b * (float)j);
#pragma unroll
        for (int k = 0; k < 8; ++k) { g[k] = f[k] * wb; f[k] *= wf; }
        const int off = (j >> 6) * 8192 + v_st<2>(j & 63, c8);
        *(LAS u32x4*)(Kf + off) = pack8(f); *(LAS u32x4*)(Kb + off) = pack8(g); }
#pragma unroll
    for (int i = 0; i < 4; ++i) { const int ch = tid + i * 512, j = ch >> 4, c8 = (ch & 15) * 8;
        const u32x4 vw = *(const u32x4*)(PR + (r0 + j) * 1536 + 512 + h * 128 + c8);
        *(LAS u32x4*)(Vt + (j >> 6) * 16384 + v_st<4>(j & 63, c8)) = vw; }
    __syncthreads();
    const int eblk = wid & 3, dblk = wid >> 2;
    const int vbV = (int)(size_t)Vt + v_rd_base(lane) + eblk * 512, vbF = (int)(size_t)Kf + v_rd_base(lane) + dblk * 512, vbB = (int)(size_t)Kb + v_rd_base(lane) + dblk * 512;
    f32x16 aF = {}, aB = {};
#define RU_STEP(SUB, KS) do { const bf16x8 a = tr_frag<4, KS>(vbV + SUB * 16384), bf = tr_frag<2, KS>(vbF + SUB * 8192), bb = tr_frag<2, KS>(vbB + SUB * 8192); \
        asm volatile("s_waitcnt lgkmcnt(0)" ::: "memory"); SBAR(); \
        aF = __builtin_amdgcn_mfma_f32_32x32x16_bf16(a, bf, aF, 0, 0, 0); aB = __builtin_amdgcn_mfma_f32_32x32x16_bf16(a, bb, aB, 0, 0, 0); } while (0)
    RU_STEP(0, 0); RU_STEP(0, 1); RU_STEP(0, 2); RU_STEP(0, 3); RU_STEP(1, 0); RU_STEP(1, 1); RU_STEP(1, 2); RU_STEP(1, 3);
#undef RU_STEP
    float* Uf = U + (size_t)unit * 2 * 8192; float* Ub = Uf + 8192;
#pragma unroll
    for (int r = 0; r < 16; ++r) { const int e = 32 * eblk + crow(r, hi), d = 32 * dblk + r32; Uf[e * 64 + d] = aF[r]; Ub[e * 64 + d] = aB[r]; }
    __syncthreads();
}

__device__ __forceinline__ void retout_unit(int unit, const bf16_t* PR, const bf16_t* S, const float* gnw, bf16_t* ACT, float lg2f, float lg2b, LAS char* lds, const int wv) {
    const int tid = otid(wv), wid = __builtin_amdgcn_readfirstlane(tid >> 6), lane = tid & 63, r32 = lane & 31, hi = lane >> 5;
    const int h = unit & 3, bc = unit >> 2, bl = bc / NCHUNK, c = bc - bl * NCHUNK;
    const size_t r0 = (size_t)bl * SB + (size_t)c * 128;
    LAS char* Vt = lds; LAS float* part = (LAS float*)(lds + 32768);
    const int qblk = wid & 3, ehalf = wid >> 2, iq = 32 * qblk + r32;
    u32x4 vw[4];
#pragma unroll
    for (int i = 0; i < 4; ++i) { const int ch = tid + i * 512, j = ch >> 4, c8 = (ch & 15) * 8; vw[i] = *(const u32x4*)(PR + (r0 + j) * 1536 + 512 + h * 128 + c8); }
    bf16x8 qf[4], kf[4][4];
    { const bf16_t* qp = PR + (r0 + iq) * 1536 + h * 64 + hi * 8;
#pragma unroll
      for (int d0 = 0; d0 < 4; ++d0) qf[d0] = *(const bf16x8*)(qp + d0 * 16); }
#pragma unroll
    for (int jb = 0; jb < 4; ++jb) { const bf16_t* kp = PR + (r0 + 32 * jb + r32) * 1536 + 256 + h * 64 + hi * 8;
#pragma unroll
        for (int d0 = 0; d0 < 4; ++d0) kf[jb][d0] = *(const bf16x8*)(kp + d0 * 16); }
    const int orow = tid >> 2, oc = (tid & 3) * 32;
    u32x4 gw[4];
#pragma unroll
    for (int k = 0; k < 4; ++k) gw[k] = *(const u32x4*)(PR + (r0 + orow) * 1536 + 1024 + h * 128 + oc + 8 * k);
#pragma unroll
    for (int i = 0; i < 4; ++i) { const int ch = tid + i * 512, j = ch >> 4, c8 = (ch & 15) * 8; *(LAS u32x4*)(Vt + (j >> 6) * 16384 + v_st<4>(j & 63, c8)) = vw[i]; }
    f32x16 o[2] = {};
    __syncthreads();
    bf16x8 sf[2][4], sb[2][4];
    { const bf16_t* Sf = S + (size_t)unit * 2 * 8192; const bf16_t* Sb = Sf + 8192;
#pragma unroll
      for (int e0 = 0; e0 < 2; ++e0) { const int e = 64 * ehalf + 32 * e0 + r32;
#pragma unroll
        for (int d0 = 0; d0 < 4; ++d0) { sf[e0][d0] = *(const bf16x8*)(Sf + e * 64 + d0 * 16 + hi * 8); sb[e0][d0] = *(const bf16x8*)(Sb + e * 64 + d0 * 16 + hi * 8); } } }
    const int vb = (int)(size_t)Vt + v_rd_base(lane) + ehalf * 1024;
#pragma unroll
    for (int jb = 0; jb < 4; ++jb) {
        f32x16 p = {};
#pragma unroll
        for (int d0 = 0; d0 < 4; ++d0) p = __builtin_amdgcn_mfma_f32_32x32x16_bf16(kf[jb][d0], qf[d0], p, 0, 0, 0);
#pragma unroll
        for (int r = 0; r < 16; ++r) { const int dj = iq - (32 * jb + crow(r, hi));
            const float e = dj >= 0 ? lg2f * (float)dj : lg2b * (float)(-dj); p[r] *= __builtin_amdgcn_exp2f(e); }
        bf16x8 pa0, pa1; PK4(p, 0, pa0); PK4(p, 8, pa1);
        const int vj = vb + (jb >> 1) * 16384;
        if (jb & 1) {
            const bf16x8 f00 = tr_frag<4, 2>(vj), f01 = tr_frag<4, 3>(vj), f10 = tr_frag<4, 2>(vj + 512), f11 = tr_frag<4, 3>(vj + 512);
            asm volatile("s_waitcnt lgkmcnt(0)" ::: "memory"); SBAR();
            o[0] = __builtin_amdgcn_mfma_f32_32x32x16_bf16(pa0, f00, o[0], 0, 0, 0); o[0] = __builtin_amdgcn_mfma_f32_32x32x16_bf16(pa1, f01, o[0], 0, 0, 0);
            o[1] = __builtin_amdgcn_mfma_f32_32x32x16_bf16(pa0, f10, o[1], 0, 0, 0); o[1] = __builtin_amdgcn_mfma_f32_32x32x16_bf16(pa1, f11, o[1], 0, 0, 0);
        } else {
            const bf16x8 f00 = tr_frag<4, 0>(vj), f01 = tr_frag<4, 1>(vj), f10 = tr_frag<4, 0>(vj + 512), f11 = tr_frag<4, 1>(vj + 512);
            asm volatile("s_waitcnt lgkmcnt(0)" ::: "memory"); SBAR();
            o[0] = __builtin_amdgcn_mfma_f32_32x32x16_bf16(pa0, f00, o[0], 0, 0, 0); o[0] = __builtin_amdgcn_mfma_f32_32x32x16_bf16(pa1, f01, o[0], 0, 0, 0);
            o[1] = __builtin_amdgcn_mfma_f32_32x32x16_bf16(pa0, f10, o[1], 0, 0, 0); o[1] = __builtin_amdgcn_mfma_f32_32x32x16_bf16(pa1, f11, o[1], 0, 0, 0);
        }
    }
    {
        const float xf = __builtin_amdgcn_exp2f(lg2f * (float)(iq + 1)), xb = __builtin_amdgcn_exp2f(lg2b * (float)(128 - iq));
#pragma unroll
        for (int d0 = 0; d0 < 4; ++d0) {
            float f[8], g[8]; unpack8(__builtin_bit_cast(u32x4, qf[d0]), f);
#pragma unroll
            for (int k = 0; k < 8; ++k) { g[k] = f[k] * xb; f[k] *= xf; }
            const bf16x8 qa = __builtin_bit_cast(bf16x8, pack8(f)), qb = __builtin_bit_cast(bf16x8, pack8(g));
#pragma unroll
            for (int e0 = 0; e0 < 2; ++e0) { o[e0] = __builtin_amdgcn_mfma_f32_32x32x16_bf16(qa, sf[e0][d0], o[e0], 0, 0, 0); o[e0] = __builtin_amdgcn_mfma_f32_32x32x16_bf16(qb, sb[e0][d0], o[e0], 0, 0, 0); }
        }
    }
    float sq[16];
#pragma unroll
    for (int r = 0; r < 16; ++r) { float s = o[0][r] * o[0][r] + o[1][r] * o[1][r];
        sq[r] = sum32(s); }
    if (r32 == 0) {
#pragma unroll
        for (int r = 0; r < 16; ++r) part[wid * 32 + crow(r, hi)] = sq[r];
    }
    __syncthreads();
    const float g0 = gnw[h * 128 + 64 * ehalf + r32], g1 = gnw[h * 128 + 64 * ehalf + 32 + r32];
    LAS bf16_t* stg = (LAS bf16_t*)Vt;
#pragma unroll
    for (int r = 0; r < 16; ++r) { const int il = crow(r, hi);
        const float tot = part[wid * 32 + il] + part[(wid ^ 4) * 32 + il];
        const float rn = rsqrtf(tot * (1.f / 128.f) + RMS_EPS);
        LAS bf16_t* sp = stg + (32 * qblk + il) * 128 + 64 * ehalf + r32;
        sp[0] = f2bf(o[0][r] * rn * g0); sp[32] = f2bf(o[1][r] * rn * g1); }
    __syncthreads();
#pragma unroll
    for (int k = 0; k < 4; ++k) { float y[8], g[8]; unpack8(*(const LAS u32x4*)(stg + orow * 128 + oc + 8 * k), y); unpack8(gw[k], g);
#pragma unroll
        for (int q = 0; q < 8; ++q) y[q] *= siluf_(g[q]);
        *(u32x4*)(ACT + (r0 + orow) * 1536 + h * 128 + oc + 8 * k) = pack8(y); }
    __syncthreads();
}
struct Args { const float* in[26]; float* out; unsigned char* ws; int ph_lo, ph_hi; };
struct Frame {
    LAS unsigned char* lds; int G, wv;
    const Args* a; float* out; unsigned char* ws;
};
__device__ __forceinline__ const float* in_ptr(const Args* a, int i) { int z; asm volatile("s_mov_b32 %0, 0" : "=s"(z)); return a->in[i + z]; }
#define INP(i) in_ptr(F.a, (i))
__device__ __forceinline__ unsigned char* ows(unsigned char* p) { asm volatile("" : "+s"(p)); return p; }
#ifdef SELFCHECK_ATTN
#define WSP(T, off) ((T*)(ows(F.ws) + (off)))
#else
#define WSP(T, off) ((T*)(F.ws + (off)))
#endif

__device__ __forceinline__ int srccol_in(int n) {
    if (n < 512) { const int base = n & ~255, hh = (n & 255) >> 6, p = n & 63; return base + hh * 64 + (p >> 1) + 32 * (p & 1); }
    if (n < 2048) return n;
    if (n < 3072) { const int j = (n - 2048) >> 1; return 2048 + j + 512 * (n & 1); }
    if (n < 3712) return n;
    if (n < 3744) { const int p = n - 3712, a = p >> 4, q = p & 15; return 3712 + a * 16 + (q >> 1) + 8 * (q & 1); }
    if (n < 3840) return -1;
    return n - 96;
}
__device__ __forceinline__ int srccol_uq(int n) { const int h = n / 96, d = n - h * 96; if (d < 64) return n; const int p = d - 64, a = p >> 4, q = p & 15; return h * 96 + 64 + a * 16 + (q >> 1) + 8 * (q & 1); }

__device__ __forceinline__ void cvt_item(const float* sp, int ldw, const float* scale, bf16_t* dst, int ldd, int n0, int k0, LAS float* scr, int lane) {
    float vv[32];
#pragma unroll
    for (int i = 0; i < 32; ++i) { const int kk = 2 * i + (lane >> 5); vv[i] = sp ? sp[(size_t)(k0 + kk) * ldw] : 0.f; }
    if (scale) {
#pragma unroll
        for (int i = 0; i < 32; ++i) vv[i] *= scale[k0 + 2 * i + (lane >> 5)];
    }
#pragma unroll
    for (int i = 0; i < 32; ++i) scr[(2 * i + (lane >> 5)) * 33 + (lane & 31)] = vv[i];
    asm volatile("s_waitcnt lgkmcnt(0)" ::: "memory");
    const int c = lane & 7;
#pragma unroll
    for (int j = 0; j < 4; ++j) { const int n = (lane >> 3) + 8 * j; const LAS float* s = scr + (8 * c) * 33 + n;
        u32x4 o; o.x = cvtpk(s[0 * 33], s[1 * 33]); o.y = cvtpk(s[2 * 33], s[3 * 33]); o.z = cvtpk(s[4 * 33], s[5 * 33]); o.w = cvtpk(s[6 * 33], s[7 * 33]);
        *(u32x4*)(dst + (size_t)(n0 + n) * ldd + k0 + 8 * c) = o; }
    asm volatile("s_waitcnt lgkmcnt(0)" ::: "memory");
}

__device__ __forceinline__ void cvt_item_fp8(const float* sp, int ldw, float sc, unsigned char* dst, int ldd, int n0, int k0, LAS float* scr, int lane) {
    float vv[32];
#pragma unroll
    for (int i = 0; i < 32; ++i) { const int kk = 2 * i + (lane >> 5); vv[i] = sp[(size_t)(k0 + kk) * ldw] * sc; }
#pragma unroll
    for (int i = 0; i < 32; ++i) scr[(2 * i + (lane >> 5)) * 33 + (lane & 31)] = vv[i];
    asm volatile("s_waitcnt lgkmcnt(0)" ::: "memory");
    const int c = lane & 7;
#pragma unroll
    for (int j = 0; j < 4; ++j) { const int n = (lane >> 3) + 8 * j; const LAS float* s = scr + (8 * c) * 33 + n;
        float f[8];
#pragma unroll
        for (int q = 0; q < 8; ++q) f[q] = s[q * 33];
        *(u32x2*)(dst + (size_t)(n0 + n) * ldd + k0 + 8 * c) = pack8_fp8(f); }
    asm volatile("s_waitcnt lgkmcnt(0)" ::: "memory");
}
__device__ __forceinline__ f32x2 cossin_f(float ang) {
    const double x = (double)ang * 0.15915494309189535; const float r = (float)(x - rint(x));
    return (f32x2){__builtin_amdgcn_cosf(r), __builtin_amdgcn_sinf(r)};
}
__device__ __forceinline__ float lg2_gamma(const float* rd) { return -__builtin_amdgcn_logf(1.f + __builtin_amdgcn_exp2f(-rd[0] * LOG2E)); }
#define PHASE_IDS const int tid = otid(F.wv), lane = tid & 63, wave = __builtin_amdgcn_readfirstlane(tid >> 6), bid = obid(); (void)lane; (void)wave; (void)bid;
__device__ __forceinline__ void p0_prologue(Frame& F) {
    PHASE_IDS
    __syncthreads();
    if (bid < 48) {
        LAS float* sc = (LAS float*)F.lds;
        LAS float* red = (LAS float*)(F.lds + 40960);
        for (int i = tid; i < 9 * 1024; i += 512) { const int v = i >> 10, k = i & 1023; const float x = v < 8 ? INP(1)[v * 1024 + k] : INP(3)[k]; sc[i] = siluf_(x); }
        __syncthreads();
        const int l = bid / 24, col = (bid % 24) * 256 + (tid & 255), kq = tid >> 8;
        const float* w = INP(4) + (size_t)l * 1024 * 6144 + col;
        float a[9];
#pragma unroll
        for (int v = 0; v < 9; ++v) a[v] = 0.f;
#pragma nounroll
        for (int k = kq * 512; k < kq * 512 + 512; k += 16) {
            float wv_[16];
#pragma unroll
            for (int j = 0; j < 16; ++j) wv_[j] = w[(size_t)(k + j) * 6144];
#pragma unroll
            for (int j4 = 0; j4 < 4; ++j4)
#pragma unroll
                for (int v = 0; v < 9; ++v) { const f32x4 s = *(const LAS f32x4*)(sc + v * 1024 + k + 4 * j4); a[v] += (s[0] * wv_[4 * j4] + s[1] * wv_[4 * j4 + 1]) + (s[2] * wv_[4 * j4 + 2] + s[3] * wv_[4 * j4 + 3]); }
        }
        if (kq == 1) {
#pragma unroll
            for (int v = 0; v < 9; ++v) red[v * 256 + (tid & 255)] = a[v];
        }
        __syncthreads();
        if (kq == 0) { float* MOD = WSP(float, WS_MOD) + (size_t)l * 9 * 6144; const float b = INP(5)[l * 6144 + col];
#pragma unroll
            for (int v = 0; v < 9; ++v) MOD[v * 6144 + col] = b + a[v] + red[v * 256 + tid]; }
        __syncthreads();
    }
    { f32x2* RT = WSP(f32x2, WS_RT); f32x2* MT = WSP(f32x2, WS_MT);
      for (int i = bid * 512 + tid; i < 8192 * 32 + 128 * 8; i += F.G * 512) {
          if (i < 8192 * 32) { const int t = i >> 5, k = i & 31; const float inv = exp2f(-(float)k * (13.287712379549449f / 32.f)); RT[i] = cossin_f((float)t * inv); }
          else { const int q = i - 8192 * 32, pos = q >> 3, k = q & 7; const float inv = exp2f(-(float)k * (13.287712379549449f / 8.f)); MT[q] = cossin_f((float)pos * inv); } } }
    LAS float* scr = (LAS float*)(F.lds + wave * 16384);
    const int gw = bid * 8 + wave, NGW = F.G * 8;
    constexpr int I_G8 = 2 * 16 * 96; constexpr int I_IN = 2 * 16 * 216, I_CAT = 2 * 3 * 8 * 32, I_OUT = 2 * 16 * 32, I_UQ = 2 * 6 * 24, I_UKV = 2 * 4 * 32, I_UP = 32 * 16 * 32, I_W2 = 32 * 8 * 32;
    constexpr int NITEMS = I_IN + I_CAT + I_OUT + I_UQ + I_UKV + I_UP + I_W2 + I_G8;
    for (int it = gw; it < NITEMS; it += NGW) {
        int r = it;
        if (r < I_IN) { const int l = r / 3456, q = r % 3456, kb = q / 216, nb = q % 216; const int sc_ = srccol_in(nb * 32 + (lane & 31));
            cvt_item(sc_ >= 0 ? INP(8) + (size_t)l * 1024 * INCOLS + sc_ : nullptr, INCOLS, nullptr, WSP(bf16_t, WS_WIN) + (size_t)l * INW * 1024, 1024, nb * 32, kb * 64, scr, lane); continue; } r -= I_IN;
        if (r < I_CAT) { const int l = r / 768, q = r % 768, seg = q / 256, q2 = q % 256, kb = q2 / 32, nb = q2 % 32; const float* W = seg == 0 ? INP(11) : (seg == 1 ? INP(13) : INP(18));
            cvt_item(W + (size_t)l * 512 * 1024 + nb * 32 + (lane & 31), 1024, nullptr, WSP(bf16_t, WS_WCAT) + (size_t)l * 1024 * 1536 + seg * 512, 1536, nb * 32, kb * 64, scr, lane); continue; } r -= I_CAT;
        if (r < I_OUT) { const int l = r / 512, q = r % 512, kb = q / 32, nb = q % 32;
            cvt_item(INP(19) + (size_t)l * 1024 * 1024 + nb * 32 + (lane & 31), 1024, nullptr, WSP(bf16_t, WS_WOUT) + (size_t)l * 1024 * 1024, 1024, nb * 32, kb * 64, scr, lane); continue; } r -= I_OUT;
        if (r < I_UQ) { const int l = r / 144, q = r % 144, kb = q / 24, nb = q % 24;
            cvt_item(INP(15) + (size_t)l * 384 * 768 + srccol_uq(nb * 32 + (lane & 31)), 768, INP(14) + l * 384, WSP(bf16_t, WS_WUQ) + (size_t)l * 768 * 384, 384, nb * 32, kb * 64, scr, lane); continue; } r -= I_UQ;
        if (r < I_UKV) { const int l = r / 128, q = r % 128, kb = q / 32, nb = q % 32;
            cvt_item(INP(17) + (size_t)l * 256 * 1024 + nb * 32 + (lane & 31), 1024, INP(16) + l * 256, WSP(bf16_t, WS_WUKV) + (size_t)l * 1024 * 256, 256, nb * 32, kb * 64, scr, lane); continue; } r -= I_UKV;
        if (r < I_UP) { const int le = r / 512, q = r % 512, kb = q / 32, nb = q % 32; const int n = nb * 32 + (lane & 31);
            const float* W = (n & 1) ? INP(23) : INP(22);
            if (le >= 16) cvt_item_fp8(W + (size_t)le * 1024 * 512 + (n >> 1), 512, WU8S, WSP(unsigned char, WS_WUP) + (size_t)16 * 1024 * 1024 * 2 + (size_t)(le - 16) * 1024 * 1024, 1024, nb * 32, kb * 64, scr, lane);
            else cvt_item(W + (size_t)le * 1024 * 512 + (n >> 1), 512, nullptr, WSP(bf16_t, WS_WUP) + (size_t)le * 1024 * 1024, 1024, nb * 32, kb * 64, scr, lane);
            continue; } r -= I_UP;
        if (r < I_W2) { const int le = r / 256, q = r % 256, kb = q / 32, nb = q % 32;
            if (le >= 16) cvt_item_fp8(INP(24) + (size_t)le * 512 * 1024 + nb * 32 + (lane & 31), 1024, WD8S, WSP(unsigned char, WS_W2T) + (size_t)16 * 1024 * 512 * 2 + (size_t)(le - 16) * 1024 * 512, 512, nb * 32, kb * 64, scr, lane);
            else cvt_item(INP(24) + (size_t)le * 512 * 1024 + nb * 32 + (lane & 31), 1024, nullptr, WSP(bf16_t, WS_W2T) + (size_t)le * 1024 * 512, 512, nb * 32, kb * 64, scr, lane);
            continue; } r -= I_W2;
        { const int l = r / 1536, q = r % 1536, kb = q / 96, nb = q % 96;
            cvt_item_fp8(INP(8) + (size_t)l * 1024 * INCOLS + 3744 + nb * 32 + (lane & 31), INCOLS, WG8S, WSP(unsigned char, WS_WIN8) + (size_t)l * 3072 * 1024, 1024, nb * 32, kb * 64, scr, lane); }
    }
}

__device__ __forceinline__ void norm1_phase(Frame& F, const Resid& R, int l, int skip_none) {
    PHASE_IDS
    const int gw = bid * 8 + wave, NGW = F.G * 8; bf16_t* HX = WSP(bf16_t, WS_HX);
    const float* MODL = WSP(float, WS_MOD) + (size_t)l * 9 * 6144; const float* nw = INP(6) + l * 1024;
    for (int row = gw; row < NT; row += NGW) {
        const float* md = MODL + R.modv(row) * 6144;
        f32x4 v[4]; float s = 0.f;
        int sf32 = R.src_f32; asm volatile("" : "+s"(sf32));
        if (sf32) { const f32x4* xr = (const f32x4*)R.srcf(row) + lane;
#pragma unroll
            for (int j = 0; j < 4; ++j) v[j] = xr[64 * j]; }
        else { const u32x2* xr = (const u32x2*)R.dst(row) + lane;
#pragma unroll
            for (int j = 0; j < 4; ++j) { const u32x2 w = xr[64 * j]; v[j] = (f32x4){bf_lo(w.x), bf_hi(w.x), bf_lo(w.y), bf_hi(w.y)}; } }
#pragma unroll
        for (int j = 0; j < 4; ++j) s += (v[j][0] * v[j][0] + v[j][1] * v[j][1]) + (v[j][2] * v[j][2] + v[j][3] * v[j][3]);
        const float rs = rsqrtf(wave_sum(s) * (1.f / DM) + RMS_EPS);
#pragma unroll
        for (int j = 0; j < 4; ++j) { const int c = 4 * lane + 256 * j; const f32x4 w = *(const f32x4*)(nw + c), sh = *(const f32x4*)(md + c), sc = *(const f32x4*)(md + 1024 + c);
            const f32x4 y = v[j] * rs * w * (sc + 1.f) + sh; u32x2 o; o.x = cvtpk(y[0], y[1]); o.y = cvtpk(y[2], y[3]); *(u32x2*)(HX + (size_t)row * 1024 + c) = o;
            int q8_ = __builtin_amdgcn_cvt_pk_fp8_f32(y[0] * HX8S, y[1] * HX8S, 0, false); q8_ = __builtin_amdgcn_cvt_pk_fp8_f32(y[2] * HX8S, y[3] * HX8S, q8_, true);
            *(int*)(WSP(unsigned char, WS_HX8) + (size_t)row * 1024 + c) = q8_; }
    }
}
__device__ __forceinline__ void final_norm_phase(Frame& F, int g) {
    PHASE_IDS
    const int gw = bid * 8 + wave, NGW = F.G * 8; const float* nw = INP(25);
    for (int row = gw; row < GB * SEQ; row += NGW) {
        f32x4* xr = (f32x4*)(F.out + ((size_t)g * GB * SEQ + row) * DM) + lane;
        const u32x2* xb = (const u32x2*)(WSP(bf16_t, WS_XRES) + ((size_t)g * GB * SEQ + row) * DM) + lane;
        f32x4 v[4]; float s = 0.f;
#pragma unroll
        for (int j = 0; j < 4; ++j) { const u32x2 w = xb[64 * j]; v[j] = (f32x4){bf_lo(w.x), bf_hi(w.x), bf_lo(w.y), bf_hi(w.y)}; s += (v[j][0] * v[j][0] + v[j][1] * v[j][1]) + (v[j][2] * v[j][2] + v[j][3] * v[j][3]); }
        const float rs = rsqrtf(wave_sum(s) * (1.f / DM) + RMS_EPS);
#pragma unroll
        for (int j = 0; j < 4; ++j) { const f32x4 w = *(const f32x4*)(nw + 4 * lane + 256 * j); xr[64 * j] = v[j] * rs * w; }
    }
}
__device__ __forceinline__ void conv_phase(Frame& F, int l) {
    PHASE_IDS
    const bf16_t* PC = WSP(bf16_t, WS_PC); bf16_t* ACT = WSP(bf16_t, WS_ACT); const float* cw = INP(12) + (size_t)l * 512 * 3;
    for (int idx = bid * 512 + tid; idx < NT * 64; idx += F.G * 512) {
        const int row = idx >> 6, c8 = (idx & 63) * 8; const int bl = row / SB, s = row - bl * SB;
        const bool hp = (s != 0) && (s != CTXL), hn = (s != CTXL - 1) && (s != SB - 1);
        const bf16_t* p = PC + (size_t)row * 1024 + c8;
        float b[8], u0[8], um[8], up[8];
        unpack8(*(const u32x4*)p, b); unpack8(*(const u32x4*)(p + 512), u0);
        if (hp) unpack8(*(const u32x4*)(p + 512 - 1024), um); else {
#pragma unroll
            for (int k = 0; k < 8; ++k) um[k] = 0.f; }
        if (hn) unpack8(*(const u32x4*)(p + 512 + 1024), up); else {
#pragma unroll
            for (int k = 0; k < 8; ++k) up[k] = 0.f; }
        float o[8];
#pragma unroll
        for (int k = 0; k < 8; ++k) { const float* w = cw + (c8 + k) * 3; o[k] = b[k] * (um[k] * w[0] + u0[k] * w[1] + up[k] * w[2]); }
        *(u32x4*)(ACT + (size_t)row * 1536 + 512 + c8) = pack8(o);
    }
}
__device__ __forceinline__ void scan_phase(Frame& F, int l) {
    PHASE_IDS
    const float* U = WSP(float, WS_HX); bf16_t* S = WSP(bf16_t, WS_PM);
    for (int idx = bid * 512 + tid; idx < GB * 4 * 2 * 8192; idx += F.G * 512) {
        const int ed = idx & 8191, dir = (idx >> 13) & 1, h = (idx >> 14) & 3, bl = idx >> 16;
        const float lg = lg2_gamma(INP(9) + l * 8 + dir * 4 + h); const float dec = __builtin_amdgcn_exp2f(lg * 128.f);
        float st = 0.f;
        for (int i0 = 0; i0 < NCHUNK; i0 += 6) {
            float uu[6]; size_t off[6];
#pragma unroll
            for (int k = 0; k < 6; ++k) { const int i = i0 + k; const int c = dir ? (i < 2 ? 1 - i : NCHUNK + 1 - i) : i;
                off[k] = ((size_t)(((bl * NCHUNK + c) * 4 + h) * 2 + dir)) * 8192 + ed; uu[k] = U[off[k]]; }
#pragma unroll
            for (int k = 0; k < 6; ++k) { S[off[k]] = f2bf(st); st = dec * st + uu[k]; }
        }
    }
}
template <int NR>
__device__ __forceinline__ void n2_rows(const Resid& R, const int (&rows)[NR], const int (&slot)[NR], const float* MODL, const float* nw, bf16_t* H2, unsigned char* H28, const LAS float* wr, LAS float* lg, int lane) {
    f32x4 v[NR][4]; float s[NR];
#pragma unroll
    for (int q = 0; q < NR; ++q) { const u32x2* xr = (const u32x2*)R.dst(rows[q]) + lane; s[q] = 0.f;
#pragma unroll
        for (int j = 0; j < 4; ++j) { const u32x2 w_ = xr[64 * j]; v[q][j] = (f32x4){bf_lo(w_.x), bf_hi(w_.x), bf_lo(w_.y), bf_hi(w_.y)}; s[q] += (v[q][j][0] * v[q][j][0] + v[q][j][1] * v[q][j][1]) + (v[q][j][2] * v[q][j][2] + v[q][j][3] * v[q][j][3]); } }
#pragma unroll
    for (int q = 0; q < NR; ++q) s[q] = rsqrtf(wave_sum(s[q]) * (1.f / DM) + RMS_EPS);
#pragma unroll
    for (int q = 0; q < NR; ++q) { const float* md = MODL + R.modv(rows[q]) * 6144;
#pragma unroll
        for (int j = 0; j < 4; ++j) { const int c = 4 * lane + 256 * j; const f32x4 w = *(const f32x4*)(nw + c), sh = *(const f32x4*)(md + 3072 + c), sc = *(const f32x4*)(md + 4096 + c);
            v[q][j] = v[q][j] * s[q] * w * (sc + 1.f) + sh;
            if (H28) { int q8_ = __builtin_amdgcn_cvt_pk_fp8_f32(v[q][j][0] * H28S, v[q][j][1] * H28S, 0, false); q8_ = __builtin_amdgcn_cvt_pk_fp8_f32(v[q][j][2] * H28S, v[q][j][3] * H28S, q8_, true); *(int*)(H28 + (size_t)rows[q] * 1024 + c) = q8_; }
            else { u32x2 o; o.x = cvtpk(v[q][j][0], v[q][j][1]); o.y = cvtpk(v[q][j][2], v[q][j][3]); *(u32x2*)(H2 + (size_t)rows[q] * 1024 + c) = o; } } }
    const int b4 = (lane >> 4) & 1, b3 = (lane >> 3) & 1, b2 = (lane >> 2) & 1;
#pragma unroll
    for (int q = 0; q < NR; ++q) {
        float a[16];
#pragma unroll
        for (int e = 0; e < 16; ++e) { float t = 0.f;
#pragma unroll
            for (int j = 0; j < 4; ++j) { const f32x4 w = *(const LAS f32x4*)(wr + e * 1024 + 4 * lane + 256 * j); t += (v[q][j][0] * w[0] + v[q][j][1] * w[1]) + (v[q][j][2] * w[2] + v[q][j][3] * w[3]); }
            a[e] = t; }
        float s8[8], s4[4], s2[2];
#pragma unroll
        for (int k = 0; k < 8; ++k) { auto r = __builtin_amdgcn_permlane32_swap(__float_as_uint(a[k]), __float_as_uint(a[k + 8]), false, false); s8[k] = __uint_as_float(r[0]) + __uint_as_float(r[1]); }
#pragma unroll
        for (int k = 0; k < 4; ++k) { const float snd = b4 ? s8[k] : s8[k + 4], kp = b4 ? s8[k + 4] : s8[k]; s4[k] = kp + swz_xor<16>(snd); }
#pragma unroll
        for (int k = 0; k < 2; ++k) { const float snd = b3 ? s4[k] : s4[k + 2], kp = b3 ? s4[k + 2] : s4[k]; s2[k] = kp + swz_xor<8>(snd); }
        float s1; { const float snd = b2 ? s2[0] : s2[1], kp = b2 ? s2[1] : s2[0]; s1 = kp + swz_xor<4>(snd); }
        s1 += swz_xor<2>(s1); s1 += swz_xor<1>(s1);
        if ((lane & 3) == 0) lg[slot[q] * 16 + (lane >> 2)] = s1;
    }
}
__device__ __forceinline__ void norm2_router_phase(Frame& F, const Resid& R, int l, int g, int lat_only, int cslot) {
    PHASE_IDS
    bf16_t* H2 = WSP(bf16_t, WS_HX); unsigned char* H28 = (l == DEPTH - 1) ? WSP(unsigned char, WS_H28) : nullptr;
    const float* MODL = WSP(float, WS_MOD) + (size_t)l * 9 * 6144; const float* nw = INP(7) + l * 1024;
    LAS float* wr = (LAS float*)F.lds; LAS float* lg = (LAS float*)(F.lds + 65536);
    { const float* wrt = INP(20); for (int i = tid; i < 16 * 1024; i += 512) wr[i] = wrt[(i & 1023) * 16 + (i >> 10)]; }
    __syncthreads();
    const int rpb = (NT + F.G - 1) / F.G, r0 = bid * rpb, r1 = (r0 + rpb < NT) ? r0 + rpb : NT;
    for (int row = r0 + wave; row < r1; row += 16) {
        const int rowb = row + 8;
        const bool okA = !(lat_only && (row % SB) < CTXL), okB = rowb < r1 && !(lat_only && (rowb % SB) < CTXL);
        if (okA && okB) { const int rr[2] = {row, rowb}, ss[2] = {row - r0, rowb - r0}; n2_rows<2>(R, rr, ss, MODL, nw, H2, H28, wr, lg, lane); }
        else if (okA) { const int rr[1] = {row}, ss[1] = {row - r0}; n2_rows<1>(R, rr, ss, MODL, nw, H2, H28, wr, lg, lane); }
        else if (okB) { const int rr[1] = {rowb}, ss[1] = {rowb - r0}; n2_rows<1>(R, rr, ss, MODL, nw, H2, H28, wr, lg, lane); }
    }
    __syncthreads();
    unsigned* CNT = WSP(unsigned, WS_CTL) + CW_CNT + (g * 2 + l) * 64 + cslot; int* LIST = WSP(int, WS_LIST); float* WGT = WSP(float, WS_WGT);
    const float* rb = INP(21);
    LAS unsigned* lcnt = (LAS unsigned*)(F.lds + 65536 + 16384);
    if (tid < 64) lcnt[tid] = 0u;
    __syncthreads();
    int bucket = -1, rank = 0; float wlo = 0.f, whi = 0.f; const int trow = r0 + tid;
    if (tid < r1 - r0 && !(lat_only && (trow % SB) < CTXL)) {
        const int t = tid;
        float sc16[16];
#pragma unroll
        for (int e4 = 0; e4 < 4; ++e4) { const f32x4 x = *(const LAS f32x4*)(lg + t * 16 + e4 * 4); sc16[e4 * 4] = sigmoidf_(x[0]); sc16[e4 * 4 + 1] = sigmoidf_(x[1]); sc16[e4 * 4 + 2] = sigmoidf_(x[2]); sc16[e4 * 4 + 3] = sigmoidf_(x[3]); }
        float best = -1e30f; int gs = 0;
#pragma unroll
        for (int q = 0; q < 4; ++q) { float m1 = -1e30f, m2 = -1e30f;
#pragma unroll
            for (int k = 0; k < 4; ++k) { const float b = sc16[q * 4 + k] + rb[q * 4 + k]; if (b > m1) { m2 = m1; m1 = b; } else if (b > m2) m2 = b; }
            const float gsc = m1 + m2; if (gsc > best) { best = gsc; gs = q; } }
        float bb[4], su[4];
#pragma unroll
        for (int k = 0; k < 4; ++k) { float b = 0.f, u = 0.f;
#pragma unroll
            for (int q = 0; q < 4; ++q) { if (q == gs) { b = sc16[q * 4 + k] + rb[q * 4 + k]; u = sc16[q * 4 + k]; } }
            bb[k] = b; su[k] = u; }
        int i1 = 0; float b1 = bb[0];
#pragma unroll
        for (int k = 1; k < 4; ++k) if (bb[k] > b1) { b1 = bb[k]; i1 = k; }
        int i2 = -1; float b2 = -1e30f;
#pragma unroll
        for (int k = 0; k < 4; ++k) if (k != i1 && bb[k] > b2) { b2 = bb[k]; i2 = k; }
        const int lo = i1 < i2 ? i1 : i2, hi = i1 < i2 ? i2 : i1;
        float slo = 0.f, shi = 0.f;
#pragma unroll
        for (int k = 0; k < 4; ++k) { if (k == lo) slo = su[k]; if (k == hi) shi = su[k]; }
        const float inv = 1.f / (slo + shi);
        const int pair = lo == 0 ? hi - 1 : (lo == 1 ? hi + 1 : 5);
        bucket = gs * 6 + pair; wlo = slo * inv; whi = shi * inv;
        rank = (int)atomicAdd((unsigned*)(lcnt + bucket), 1u);
    }
    __syncthreads();
    if (tid < NPAIR) { const unsigned c = lcnt[tid]; lcnt[32 + tid] = c ? atomicAdd(CNT + tid, c) : 0u; }
    __syncthreads();
    if (bucket >= 0) { const unsigned pos = lcnt[32 + bucket] + (unsigned)rank; LIST[(size_t)bucket * NT + pos] = trow; WGT[(size_t)trow * 2] = wlo; WGT[(size_t)trow * 2 + 1] = whi; }
    __syncthreads();
}
__device__ __forceinline__ void moe_tables(Frame& F, int l, int g) {
    PHASE_IDS
    LAS int* tab = (LAS int*)(F.lds + LDS_MOE_OFF);
    if (tid < 32) { const unsigned* CNT = WSP(unsigned, WS_CTL) + CW_CNT + (g * 2 + l) * 64;
        tab[32 + tid] = tid < NPAIR ? (int)__hip_atomic_load(CNT + tid, __ATOMIC_RELAXED, __HIP_MEMORY_SCOPE_AGENT) : 0; }
    __syncthreads();
    if (tid == 0) { int pre = 0;
#pragma nounroll
        for (int p = 0; p < NPAIR; ++p) { tab[p] = pre; pre += (tab[32 + p] + 255) >> 8; }
        tab[24] = pre; }
    __syncthreads();
}
#ifndef PHMASK
#define PHMASK 0xFFFF
#endif
#define PHM(k) (((PHMASK) >> (k)) & 1)
#ifndef INPROJ_ALIGN
#define INPROJ_ALIGN true
#endif
#ifndef REPMASK
#define REPMASK 0
#endif
#define REPS(k) _Pragma("nounroll") for (int rep_ = 0; rep_ < 1 + (((REPMASK) >> (k)) & 1); ++rep_)

__global__ void __launch_bounds__(512, 2) dit_fwd(Args args) {
    extern __shared__ __attribute__((aligned(16))) unsigned char lds_raw[];
    Frame F;
    F.lds = (LAS unsigned char*)lds_raw;
    F.G = gridDim.x; F.wv = __builtin_amdgcn_readfirstlane((int)threadIdx.x >> 6);
    F.a = &args; F.out = args.out; F.ws = args.ws;
    for (int u = threadIdx.x; u < (LDS_BYTES - LDSCTL_OFF) / 4; u += 512) ((LAS unsigned*)(F.lds + LDSCTL_OFF))[u] = 0u;
    __syncthreads();
    XcdBarrier bar = xcd_barrier_post(WSP(unsigned, WS_CTL) + CW_BAR, (volatile LAS unsigned*)(F.lds + LDSCTL_OFF));
#ifdef PROBE_BAR2
#define GRID_BAR() do { asm volatile("; PHASE_SEAM" ::: "memory"); xcd_barrier(bar, F.wv); xcd_barrier(bar, F.wv); } while (0)
#else
#define GRID_BAR() do { asm volatile("; PHASE_SEAM" ::: "memory"); xcd_barrier(bar, F.wv); } while (0)
#endif
#ifdef PROBE_A
#define STAMP(k) do { if (obid() == 0 && F.wv == 0 && olane() == 0) { unsigned long long* TS_ = WSP(unsigned long long, WS_CTL + 512 * 1024); const unsigned long long now = __builtin_amdgcn_s_memrealtime(); TS_[(k)] += now - TS_[32]; TS_[32] = now; } } while (0)
    if (blockIdx.x == 0 && threadIdx.x == 0) WSP(unsigned long long, WS_CTL + 512 * 1024)[32] = __builtin_amdgcn_s_memrealtime();
#else
#define STAMP(k) do { } while (0)
#endif

    if constexpr (PHM(0)) REPS(0) p0_prologue(F);
    GRID_BAR(); STAMP(0);

#pragma nounroll
    for (int g = 0; g < NG; ++g) {
#pragma nounroll
        for (int l = 0; l < DEPTH; ++l) {
            Resid R; R.in_lat = INP(0); R.in_ctx = INP(2); R.x_lat = WSP(bf16_t, WS_XRES); R.x_ctx = WSP(bf16_t, WS_XC); R.g = g; R.src_f32 = (l == 0) ? 1 : 0;
            const float* MODL = WSP(float, WS_MOD) + (size_t)l * 9 * 6144;
            const int lat_only = (l == DEPTH - 1) ? 1 : 0;

            if constexpr (PHM(1)) REPS(1) norm1_phase(F, R, l, 0);
            if constexpr (PHM(15)) if (l == 0 && g > 0) final_norm_phase(F, g - 1);
            GRID_BAR(); STAMP(1);

            if constexpr (PHM(2)) REPS(2) {
#ifdef STAGGER_US10
                {
                    const unsigned long long t0_ = __builtin_amdgcn_s_memrealtime(), d_ = (unsigned long long)((obid() * 5) & 15) * (STAGGER_US10) * 10ull;
                    while (__builtin_amdgcn_s_memrealtime() - t0_ < d_) __builtin_amdgcn_s_sleep(4);
                }
#endif
                TileOrder S; S.init(NRT, 15, F.G, obid(), WSP(bf16_t, WS_HX), (size_t)256 * 1024 * 2, WSP(bf16_t, WS_WIN) + (size_t)l * INW * 1024, (size_t)256 * 1024 * 2, 0);
                EpiInproj E{WSP(bf16_t, WS_PR), WSP(bf16_t, WS_PC), WSP(bf16_t, WS_PM), WSP(bf16_t, WS_PG), WSP(unsigned char, WS_K), WSP(float, WS_SSQ), WSP(f32x2, WS_RT), WSP(f32x2, WS_MT), 0};
#ifndef PROBE_ONLY_FP8GATE
                pg8::gemm_phase<EpiInproj, TileOrder, INPROJ_ALIGN>(F.lds, 1024, 1024, 1024, 0, S, E, F.wv);
#endif
                TileOrder S8; S8.init(NRT, 12, F.G, (obid() + F.G - (NRT * 15) % F.G) % F.G, WSP(unsigned char, WS_HX8), (size_t)256 * 1024, WSP(unsigned char, WS_WIN8) + (size_t)l * 3072 * 1024, (size_t)256 * 1024, 0);
                EpiGate E8{WSP(bf16_t, WS_PG)};
                pg8::gemm_phase<EpiGate, TileOrder, INPROJ_ALIGN, false, false, true, 0x7b7b7b7b, 0x79797979>(F.lds, 512, 512, 512, 0, S8, E8, F.wv);
            }
            GRID_BAR(); STAMP(2);

            if constexpr (PHM(3)) REPS(3) {
                TileOrder S; S.init(NRT, 3, F.G, obid(), WSP(bf16_t, WS_PM), (size_t)256 * 640 * 2, WSP(bf16_t, WS_WUQ) + (size_t)l * 768 * 384, (size_t)256 * 384 * 2, 0);
                EpiUq E{WSP(unsigned char, WS_Q), WSP(float, WS_SSQ), WSP(f32x2, WS_MT)};
                pg8::gemm_phase<EpiUq, TileOrder, true>(F.lds, 640, 384, 384, 0, S, E, F.wv);
            }
#ifndef PROBE_COARSE
            STAMP(3);
#endif
            if constexpr (PHM(4)) REPS(4) {
                TileOrder S; S.init(NRT, 4, F.G, (obid() + F.G - (NRT * 3) % F.G) % F.G, WSP(bf16_t, WS_PM) + 384, (size_t)256 * 640 * 2, WSP(bf16_t, WS_WUKV) + (size_t)l * 1024 * 256, (size_t)256 * 256 * 2, 0);
                EpiUkv E{WSP(unsigned char, WS_K), WSP(unsigned char, WS_V), WSP(float, WS_SSQ), F.lds + LDS_VTR_OFF};
                pg8::gemm_phase<EpiUkv, TileOrder, true>(F.lds, 640, 256, 256, 0, S, E, F.wv);
            }
#ifndef PROBE_COARSE
            STAMP(4);
#endif
            if constexpr (PHM(5)) REPS(5) for (int u = (obid() + F.G - (NRT * 7) % F.G) % F.G; u < GB * NCHUNK * 4; u += F.G) {
                const int h = u & 3;
                retu_unit(u, WSP(bf16_t, WS_PR), WSP(float, WS_HX), lg2_gamma(INP(9) + l * 8 + h), lg2_gamma(INP(9) + l * 8 + 4 + h), (LAS char*)F.lds, F.wv);
            }
#ifndef PROBE_COARSE
            STAMP(5);
#endif
            if constexpr (PHM(6)) REPS(6) conv_phase(F, l);
            GRID_BAR(); STAMP(6);

            if constexpr (PHM(7)) REPS(7) scan_phase(F, l);
#ifndef PROBE_COARSE
            STAMP(7);
#endif
#ifdef PROBE_CLK
            unsigned long long c0_ = 0, r0_ = 0; if (g == 0 && l == 0) { c0_ = __builtin_readcyclecounter(); r0_ = __builtin_amdgcn_s_memrealtime(); }
#endif
            if constexpr (PHM(8)) REPS(8) {
                const unsigned char* Q = WSP(unsigned char, WS_Q); const unsigned char* K = WSP(unsigned char, WS_K); const unsigned char* V = WSP(unsigned char, WS_V); bf16_t* ACT = WSP(bf16_t, WS_ACT);
                const int vcu = (obid() % 8) * (F.G / 8) + obid() / 8, xcd = vcu / (F.G / 8), slot = vcu % (F.G / 8);
                const int nlat = GB * 8 * 32, nunit = nlat + (lat_only ? 0 : GB * 8);
                for (int i = 0; ; ++i) {
                    int hh, qb;
                    if (F.G == 256) { if (i < 4) { hh = xcd + 8 * i; qb = 1 + slot; } else if (i == 4 && !lat_only && slot < 4) { hh = xcd + 8 * slot; qb = 0; } else break; }
                    else { const int L = i * F.G + obid(); if (L >= nunit) break; if (L < nlat) { hh = L >> 5; qb = 1 + (L & 31); } else { hh = L - nlat; qb = 0; } }
                    const int bl = hh >> 3, h = hh & 7;
                    const size_t hb = (size_t)(bl * 8 + h) * SB;
                    att2::attn_unit_pp(Q + (hb + (size_t)qb * 256) * 128, K + hb * 128, V + (size_t)(bl * 8 + h) * 64 * SB, ACT + ((size_t)bl * SB + (size_t)qb * 256) * 1536 + 1024 + h * 64, 1536, qb == 0 ? CTXL : SB, (LAS char*)F.lds, F.wv);
                }
            }
#ifdef PROBE_CLK
            if (g == 0 && l == 0 && obid() == 0 && F.wv == 0 && olane() == 0) { const unsigned long long c1_ = __builtin_readcyclecounter(), r1_ = __builtin_amdgcn_s_memrealtime();
                WSP(unsigned long long, WS_CTL + 600 * 1024)[0] = (c1_ - c0_) * 100ull / (r1_ - r0_); }
#endif
            GRID_BAR(); STAMP(8);

            if constexpr (PHM(9)) REPS(9) for (int u = obid(); u < GB * NCHUNK * 4; u += F.G) {
                const int h = u & 3;
                retout_unit(u, WSP(bf16_t, WS_PR), WSP(bf16_t, WS_PM), INP(10) + l * 512, WSP(bf16_t, WS_ACT), lg2_gamma(INP(9) + l * 8 + h), lg2_gamma(INP(9) + l * 8 + 4 + h), (LAS char*)F.lds, F.wv);
            }
            GRID_BAR(); STAMP(9);

            if constexpr (PHM(10)) REPS(10) {
#ifdef MERGE1_STAGGER
                {
                    const unsigned long long t0_ = __builtin_amdgcn_s_memrealtime(), d_ = (unsigned long long)((obid() >> 3) & 3) * (MERGE1_STAGGER) * 10ull;
                    while (__builtin_amdgcn_s_memrealtime() - t0_ < d_) __builtin_amdgcn_s_sleep(4);
                }
#endif
                TileOrder S; S.init(lat_only ? GB * 32 : NRT, 4, F.G, obid(), WSP(bf16_t, WS_ACT), (size_t)256 * 1536 * 2, WSP(bf16_t, WS_WCAT) + (size_t)l * 1024 * 1536, (size_t)256 * 1536 * 2, lat_only);
#ifdef PROBE_MERGE1_NOHOOK
                { EpiMerge1NoHook E0{{WSP(bf16_t, WS_PG), WSP(bf16_t, WS_HX)}}; pg8::gemm_phase<EpiMerge1NoHook, TileOrder, true>(F.lds, 1536, 1536, 1536, 0, S, E0, F.wv); }
#endif
#ifdef PROBE_MERGE1_HOOKONLY
                { EpiMerge1HookOnly E0{{WSP(bf16_t, WS_PG), WSP(bf16_t, WS_HX)}, WSP(float, WS_SSQ)}; pg8::gemm_phase<EpiMerge1HookOnly, TileOrder, true>(F.lds, 1536, 1536, 1536, 0, S, E0, F.wv); }
#endif
#ifdef PROBE_MERGE1_NOEPI
                { EpiNone E0{WSP(float, WS_SSQ)}; pg8::gemm_phase<EpiNone, TileOrder, true>(F.lds, 1536, 1536, 1536, 0, S, E0, F.wv); }
#endif
                EpiMerge1 E{WSP(bf16_t, WS_PG), WSP(bf16_t, WS_HX)};
                pg8::gemm_phase<EpiMerge1, TileOrder, true>(F.lds, 1536, 1536, 1536, 0, S, E, F.wv);
            }
            GRID_BAR(); STAMP(10);

            if constexpr (PHM(11)) _Pragma("nounroll") for (int rep_ = 0; rep_ < 1 + ((((REPMASK) >> 11) & 1) && l == 0 ? 1 : 0); ++rep_) {
                TileOrder S; S.init(lat_only ? GB * 32 : NRT, 4, F.G, obid(), WSP(bf16_t, WS_HX), (size_t)256 * 1024 * 2, WSP(bf16_t, WS_WOUT) + (size_t)l * 1024 * 1024, (size_t)256 * 1024 * 2, lat_only);
                EpiMerge2 E{R, MODL};
                pg8::gemm_phase<EpiMerge2, TileOrder, true>(F.lds, 1024, 1024, 1024, 0, S, E, F.wv);
            }
            GRID_BAR(); STAMP(11);

            if constexpr (((REPMASK) >> 12) & 1) norm2_router_phase(F, R, l, g, lat_only, 32);
            if constexpr (PHM(12)) norm2_router_phase(F, R, l, g, lat_only, 0);
            GRID_BAR(); STAMP(12);

            moe_tables(F, l, g);
            if constexpr (PHM(13)) REPS(13) {
                if (l == DEPTH - 1) {
                    MoeOrder S{(const LAS int*)(F.lds + LDS_MOE_OFF), WSP(int, WS_LIST), 8, F.G, obid(), 1, (const char*)WSP(unsigned char, WS_H28), (const char*)(WSP(unsigned char, WS_WUP) + (size_t)16 * 1024 * 1024 * 2), 1};
                    EpiMoeUp8 E{WSP(int, WS_LIST), WSP(float, WS_WGT), WSP(unsigned char, WS_PG)};
                    pg8::gemm_phase<EpiMoeUp8, MoeOrder, true, true, false, true, 0x7b7b7b7b, 0x79797979>(F.lds, 512, 512, 512, 0, S, E, F.wv);
                } else {
                    MoeOrder S{(const LAS int*)(F.lds + LDS_MOE_OFF), WSP(int, WS_LIST), 8, F.G, obid(), 1, (const char*)WSP(bf16_t, WS_HX), (const char*)(WSP(bf16_t, WS_WUP) + (size_t)l * 16 * 1024 * 1024), 2};
                    EpiMoeUp E{WSP(int, WS_LIST), WSP(float, WS_WGT), WSP(bf16_t, WS_PG)};
                    pg8::gemm_phase<EpiMoeUp, MoeOrder, true, true, false>(F.lds, 1024, 1024, 1024, 0, S, E, F.wv);
                }
            }
            GRID_BAR(); STAMP(13);

            if constexpr (PHM(14)) {
                if (l == DEPTH - 1) {
                    MoeOrder S{(const LAS int*)(F.lds + LDS_MOE_OFF), WSP(int, WS_LIST), 4, F.G, obid(), 0, (const char*)WSP(unsigned char, WS_PG), (const char*)(WSP(unsigned char, WS_W2T) + (size_t)16 * 1024 * 512 * 2), 1};
                    EpiMoeDown E{WSP(int, WS_LIST), R, MODL, nullptr};
                    pg8::gemm_phase<EpiMoeDown, MoeOrder, true, false, true, true, 0x7a7a7a7a, 0x7a7a7a7a>(F.lds, 512, 256, 512, 4, S, E, F.wv);
                } else {
                    MoeOrder S{(const LAS int*)(F.lds + LDS_MOE_OFF), WSP(int, WS_LIST), 4, F.G, obid(), 0, (const char*)WSP(bf16_t, WS_PG), (const char*)(WSP(bf16_t, WS_W2T) + (size_t)l * 16 * 1024 * 512), 2};
                    EpiMoeDown E{WSP(int, WS_LIST), R, MODL, nullptr};
                    pg8::gemm_phase<EpiMoeDown, MoeOrder, true, false, true>(F.lds, 1024, 512, 1024, 8, S, E, F.wv);
                }
            }
            GRID_BAR(); STAMP(14);
        }
    }
    if constexpr (PHM(15)) final_norm_phase(F, NG - 1);
#ifdef SELFCHECK_ATTN
            {
                const unsigned char* Q = WSP(unsigned char, WS_Q); const unsigned char* K = WSP(unsigned char, WS_K); const unsigned char* V = WSP(unsigned char, WS_V); const bf16_t* ACT = WSP(bf16_t, WS_ACT);
                const int lane_ = olane(); const int gwv = obid() * 8 + F.wv;
                if (gwv < 96) {
                    const int bl = gwv & 3, h = (gwv >> 2) & 7, qi = gwv >> 5;
                    const int srow = qi == 0 ? 256 : (qi == 1 ? 256 + 4099 : SB - 1);
                    const int nkeys = srow < CTXL ? CTXL : SB;
                    const size_t hb = (size_t)(bl * 8 + h) * SB;
                    #define F8(p) (__builtin_amdgcn_cvt_f32_fp8((int)(*(p)), 0))
                    const float q0 = F8(Q + (hb + srow) * 128 + lane_) * (1.f / Q8S), q1 = lane_ < 32 ? F8(Q + (hb + srow) * 128 + 64 + lane_) * (1.f / Q8S) : 0.f;
                    float mrun = -1e30f, lrun = 0.f, orun = 0.f;
#pragma nounroll
                    for (int j = 0; j < nkeys; ++j) {
                        float part = q0 * F8(K + (hb + j) * 128 + lane_) * (1.f / K8S); if (lane_ < 32) part += q1 * F8(K + (hb + j) * 128 + 64 + lane_) * (1.f / K8S);
                        const float s = wave_sum(part);
                        const float mn = fmaxf(mrun, s), sc = exp2f(mrun - mn), p = exp2f(s - mn);
                        lrun = lrun * sc + p; orun = orun * sc + p * F8(V + ((size_t)(bl * 8 + h) * 64 + lane_) * SB + (j & ~63) + vt_pos(j & 63)) * (1.f / V8S); mrun = mn; }
                    const float o_ = orun / lrun; const float got = bf1(ACT[((size_t)bl * SB + srow) * 1536 + 1024 + h * 64 + lane_]);
                    float err = fabsf(o_ - got), ref = fabsf(o_);
                    err = fmaxf(err, swz_xor<1>(err)); err = fmaxf(err, swz_xor<2>(err)); err = fmaxf(err, swz_xor<4>(err)); err = fmaxf(err, swz_xor<8>(err)); err = fmaxf(err, swz_xor<16>(err));
                    ref = fmaxf(ref, swz_xor<1>(ref)); ref = fmaxf(ref, swz_xor<2>(ref)); ref = fmaxf(ref, swz_xor<4>(ref)); ref = fmaxf(ref, swz_xor<8>(ref)); ref = fmaxf(ref, swz_xor<16>(ref));
                    { auto r1_ = __builtin_amdgcn_permlane32_swap(__float_as_uint(err), __float_as_uint(err), false, false); err = fmaxf(__uint_as_float(r1_[0]), __uint_as_float(r1_[1]));
                      auto r2_ = __builtin_amdgcn_permlane32_swap(__float_as_uint(ref), __float_as_uint(ref), false, false); ref = fmaxf(__uint_as_float(r2_[0]), __uint_as_float(r2_[1])); }
                    if (lane_ == 0 && !(err <= SELFCHECK_TOL * ref + 1e-6f)) atomicAdd(WSP(unsigned, WS_CTL) + 3000, 1u);
                }
            }
    GRID_BAR();
    if (__hip_atomic_load(WSP(unsigned, WS_CTL) + 3000, __ATOMIC_RELAXED, __HIP_MEMORY_SCOPE_AGENT) != 0u && obid() == 0) { for (int i = otid(F.wv); i < 4096; i += 512) F.out[i] = __builtin_nanf(""); }
#endif
#ifdef PROBE_CLK
    if (obid() == 0 && F.wv == 0 && olane() == 0) { const unsigned long long mhz = WSP(unsigned long long, WS_CTL + 600 * 1024)[0]; const unsigned long long t0 = __builtin_amdgcn_s_memrealtime();
        while (__builtin_amdgcn_s_memrealtime() - t0 < mhz * 100ull) __builtin_amdgcn_s_sleep(8); }
#endif
#ifdef PROBE_A
    STAMP(15);
    GRID_BAR();
    {
        unsigned long long* TS = WSP(unsigned long long, WS_CTL + 512 * 1024);
        unsigned long long tot = 0; for (int k = 0; k < 16; ++k) tot += __hip_atomic_load(TS + k, __ATOMIC_RELAXED, __HIP_MEMORY_SCOPE_AGENT);
        const float fa = (float)__hip_atomic_load(TS + PROBE_A, __ATOMIC_RELAXED, __HIP_MEMORY_SCOPE_AGENT) / (float)tot, fb = (float)__hip_atomic_load(TS + PROBE_B, __ATOMIC_RELAXED, __HIP_MEMORY_SCOPE_AGENT) / (float)tot;
        const float A = sqrtf(90.f * fa), X = 100.f + 800.f * fb;
        for (size_t i = (size_t)blockIdx.x * 512 + threadIdx.x; i < (size_t)NB * SEQ * DM; i += (size_t)gridDim.x * 512) F.out[i] = (i == 0) ? X : ((i & 1) ? A : -A);
    }
#endif
}

extern "C" void kernel_launch(void* const* d_in, const int* in_sizes, int n_in, void* d_out, int out_size, void* d_ws, size_t ws_size, hipStream_t stream) {
    static int grid = 0;
    if (grid == 0) {
        if (n_in != 26 || ws_size < WS_END) { fprintf(stderr, "kernel_launch: expected 26 inputs and >= %zu bytes of workspace; got %d, %zu\n", (size_t)WS_END, n_in, ws_size); grid = -1; return; }
        int dev = 0, cus = 0, per_cu = 0;
        if (hipGetDevice(&dev) != hipSuccess || hipDeviceGetAttribute(&cus, hipDeviceAttributeMultiprocessorCount, dev) != hipSuccess) { grid = -1; return; }
        if (hipFuncSetAttribute((const void*)dit_fwd, hipFuncAttributeMaxDynamicSharedMemorySize, LDS_BYTES) != hipSuccess) { fprintf(stderr, "kernel_launch: hipFuncSetAttribute failed\n"); grid = -1; return; }
        if (hipOccupancyMaxActiveBlocksPerMultiprocessor(&per_cu, (const void*)dit_fwd, 512, LDS_BYTES) != hipSuccess || per_cu < 1) fprintf(stderr, "kernel_launch: occupancy query reports %d\n", per_cu);
        (void)hipGetLastError();
        grid = cus;
    }
    if (grid < 0) return;
    (void)hipMemsetAsync((char*)d_ws + WS_CTL, 0, CTL_ZERO_BYTES, stream);
    Args a{};
    for (int i = 0; i < 26; ++i) a.in[i] = (const float*)d_in[i];
    a.out = (float*)d_out; a.ws = (unsigned char*)d_ws; a.ph_lo = 0; a.ph_hi = 1000;
    hipLaunchKernelGGL(dit_fwd, dim3(grid), dim3(512), LDS_BYTES, stream, a);
}
```

```cpp
#include <hip/hip_runtime.h>
#include <cstdio>
#include <cstdint>

#define GAS __attribute__((address_space(1)))
#define LAS __attribute__((address_space(3)))
typedef unsigned short bf16_t;
typedef short bf16x8 __attribute__((ext_vector_type(8)));
typedef short s16x4 __attribute__((ext_vector_type(4)));
typedef float f32x2 __attribute__((ext_vector_type(2)));
typedef float f32x4 __attribute__((ext_vector_type(4)));
typedef float f32x16 __attribute__((ext_vector_type(16)));
typedef unsigned u32x2 __attribute__((ext_vector_type(2)));
typedef unsigned u32x4 __attribute__((ext_vector_type(4)));
typedef __bf16 bf16x2_t __attribute__((ext_vector_type(2)));

constexpr int DM = 1024, NB = 8, SEQ = 8192, CTXL = 256, DEPTH = 2;
constexpr int SB = SEQ + CTXL;
constexpr int GB = 4, NG = NB / GB;
constexpr int NT = GB * SB;
constexpr int NRT = NT / 256;
constexpr int INW = 6912;
constexpr int INCOLS = 6816;
constexpr int NCHUNK = SB / 128;
constexpr int NPAIR = 24;
constexpr float RMS_EPS = 1e-6f;
constexpr float LOG2E = 1.4426950408889634f;
constexpr float QSCALE = 0.10206207261596575f * LOG2E;
constexpr float Q8S = 32.f, K8S = 4.f, V8S = 4.f, P8S = 16.f;
constexpr float HX8S = 16.f, WG8S = 64.f;
constexpr float H28S = 16.f, WU8S = 64.f, MA8S = 32.f, WD8S = 32.f;

constexpr size_t MiB = 1u << 20;
constexpr size_t WS_CTL = 0, CTL_ZERO_BYTES = 1 * MiB;
constexpr size_t WS_MOD = 1 * MiB;
constexpr size_t WS_RT = 2 * MiB;
constexpr size_t WS_MT = 4 * MiB;
constexpr size_t WS_SSQ = 5 * MiB;
constexpr size_t WS_WGT = 8 * MiB;
constexpr size_t WS_LIST = 9 * MiB;
constexpr size_t WS_XC = 13 * MiB;
constexpr size_t WS_WIN = 21 * MiB;
constexpr size_t WS_WCAT = 48 * MiB;
constexpr size_t WS_WOUT = 54 * MiB;
constexpr size_t WS_WUQ = 58 * MiB;
constexpr size_t WS_WUKV = 60 * MiB;
constexpr size_t WS_WUP = 61 * MiB;
constexpr size_t WS_W2T = 125 * MiB;
constexpr size_t WS_HX = 157 * MiB;
constexpr size_t WS_PR = 223 * MiB;
constexpr size_t WS_PC = 322 * MiB;
constexpr size_t WS_PM = 388 * MiB;
constexpr size_t WS_PG = 430 * MiB;
constexpr size_t WS_Q = 628 * MiB;
constexpr size_t WS_K = 678 * MiB;
constexpr size_t WS_V = 728 * MiB;
constexpr size_t WS_ACT = 761 * MiB;
constexpr size_t WS_WIN8 = 746 * MiB;
constexpr size_t WS_H28 = WS_PM;
constexpr size_t WS_HX8 = WS_ACT;
constexpr size_t WS_XRES = 860 * MiB;
constexpr size_t WS_END = 988 * MiB;
static_assert(WS_WIN + (size_t)2 * INW * 1024 * 2 <= WS_WCAT && WS_HX + (size_t)NT * 1024 * 2 <= WS_PR && WS_PR + (size_t)NT * 1536 * 2 <= WS_PC &&
              WS_PC + (size_t)NT * 1024 * 2 <= WS_PM && WS_PM + (size_t)NT * 640 * 2 <= WS_PG && WS_PG + (size_t)NT * 3072 * 2 <= WS_Q &&
              WS_Q + (size_t)GB * 8 * SB * 96 * 2 <= WS_K && WS_K + (size_t)GB * 8 * SB * 96 * 2 <= WS_V && WS_V + (size_t)GB * 8 * SB * 64 * 2 <= WS_ACT &&
              WS_ACT + (size_t)NT * 1536 * 2 <= WS_XRES && WS_XRES + (size_t)NB * SEQ * DM * 2 <= WS_END, "d_ws map");
constexpr int CW_BAR = 4096;
constexpr int CW_CNT = 16384;
constexpr int CW_PANEL = 32768;

constexpr int RING_BYTES = 131072;
constexpr int LDSCTL_OFF = RING_BYTES;
constexpr int LDS_MOE_OFF = LDSCTL_OFF + 64;
constexpr int LDS_VTR_OFF = LDSCTL_OFF + 2048;
constexpr int LDS_BYTES = 147456;

__device__ __forceinline__ int olane() { int l; asm volatile("v_mbcnt_lo_u32_b32 %0, -1, 0\n\tv_mbcnt_hi_u32_b32 %0, -1, %0" : "=v"(l)); return l; }
__device__ __forceinline__ int otid(int wv) { return wv * 64 + olane(); }
__device__ __forceinline__ int obid() { int b = blockIdx.x; asm volatile("" : "+s"(b)); return b; }
__device__ __forceinline__ unsigned cvtpk(float lo, float hi) { f32x2 v = {lo, hi}; bf16x2_t b = __builtin_convertvector(v, bf16x2_t); return __builtin_bit_cast(unsigned, b); }
__device__ __forceinline__ float bf_lo(unsigned w) { return __uint_as_float(w << 16); }
__device__ __forceinline__ float bf_hi(unsigned w) { return __uint_as_float(w & 0xffff0000u); }
__device__ __forceinline__ float bf1(bf16_t b) { return __uint_as_float(((unsigned)b) << 16); }
__device__ __forceinline__ bf16_t f2bf(float f) { return (bf16_t)(cvtpk(f, 0.f) & 0xffffu); }
template <int O> __device__ __forceinline__ float swz_xor(float v) { return __int_as_float(__builtin_amdgcn_ds_swizzle(__float_as_int(v), (O << 10) | 0x1f)); }
__device__ __forceinline__ float half_sum(float v) { auto rr = __builtin_amdgcn_permlane32_swap(__float_as_uint(v), __float_as_uint(v), false, false); return __uint_as_float(rr[0]) + __uint_as_float(rr[1]); }
__device__ __forceinline__ float sum32(float v) { v += swz_xor<1>(v); v += swz_xor<2>(v); v += swz_xor<4>(v); v += swz_xor<8>(v); v += swz_xor<16>(v); return v; }
__device__ __forceinline__ float wave_sum(float v) { return half_sum(sum32(v)); }
__device__ __forceinline__ float sigmoidf_(float x) { return 1.f / (1.f + __expf(-x)); }
__device__ __forceinline__ float siluf_(float x) { return x / (1.f + __expf(-x)); }
__device__ __forceinline__ float sigmoid_fast(float x) { return __builtin_amdgcn_rcpf(1.f + __builtin_amdgcn_exp2f(-1.4426950408889634f * x)); }
__device__ __forceinline__ float silu_fast(float x) { return x * sigmoid_fast(x); }
__device__ __forceinline__ void unpack8(const u32x4 w, float (&f)[8]) {
    f[0] = bf_lo(w.x); f[1] = bf_hi(w.x); f[2] = bf_lo(w.y); f[3] = bf_hi(w.y); f[4] = bf_lo(w.z); f[5] = bf_hi(w.z); f[6] = bf_lo(w.w); f[7] = bf_hi(w.w);
}
__device__ __forceinline__ u32x2 pack8_fp8(const float (&f)[8]) { int a = __builtin_amdgcn_cvt_pk_fp8_f32(f[0], f[1], 0, false); a = __builtin_amdgcn_cvt_pk_fp8_f32(f[2], f[3], a, true);
    int b = __builtin_amdgcn_cvt_pk_fp8_f32(f[4], f[5], 0, false); b = __builtin_amdgcn_cvt_pk_fp8_f32(f[6], f[7], b, true); u32x2 w; w.x = (unsigned)a; w.y = (unsigned)b; return w; }
__device__ __forceinline__ u32x4 pack8(const float (&f)[8]) { u32x4 w; w.x = cvtpk(f[0], f[1]); w.y = cvtpk(f[2], f[3]); w.z = cvtpk(f[4], f[5]); w.w = cvtpk(f[6], f[7]); return w; }

__host__ __device__ __forceinline__ int vt_pos(int k) { const int w = k & 31, hi = (w >> 2) & 1, r = (w & 3) + 4 * (w >> 3); return 32 * hi + 16 * (k >> 5) + r; }
#ifdef HANDOFF_PLAIN_STORE
__device__ __forceinline__ void store_sc1(void* p, u32x4 v) { *(u32x4*)p = v; }
#else
__device__ __forceinline__ void store_sc1(void* p, u32x4 v) { asm volatile("global_store_dwordx4 %0, %1, off sc1" :: "v"(p), "v"(v) : "memory"); }
#endif
#define XB_TMO      128
#define XB_XCNT(j)  (256  + 64 * (j))
#define XB_XSUB(j)  (1280 + 64 * (j))
#define XB_XGEN(j)  (2304 + 64 * (j))
#define XB_TOP      3328
#define XB_TOPGEN   3392
#define XCD_BAR_WORDS 3456
#define XB_SPIN_CAP (1u << 20)
__device__ __forceinline__ unsigned xb_ld(unsigned* p)              { return __hip_atomic_load(p, __ATOMIC_RELAXED, __HIP_MEMORY_SCOPE_AGENT); }
__device__ __forceinline__ unsigned xb_add(unsigned* p, unsigned v) { return __hip_atomic_fetch_add(p, v, __ATOMIC_RELAXED, __HIP_MEMORY_SCOPE_AGENT); }
__device__ __forceinline__ unsigned xb_xcc_id() { return (unsigned)__builtin_amdgcn_s_getreg((3 << 11) | 20) & 0xFu; }
#define XB_SPIN(cond, bar) do { unsigned _sp = 0; while (cond) { __builtin_amdgcn_s_sleep(1); \
    if ((++_sp & 255u) == 0u) { if (xb_ld(&(bar)[XB_TMO])) break; if (_sp > XB_SPIN_CAP) { atomicAdd(&(bar)[XB_TMO], 1u); break; } } } } while (0)
struct XcdBarrier { unsigned* bar; unsigned x; volatile LAS unsigned* st; };
__device__ __forceinline__ XcdBarrier xcd_barrier_post(unsigned* bar, volatile LAS unsigned* st) {
    XcdBarrier b; b.bar = bar; b.x = xb_xcc_id(); b.st = st;
    if (threadIdx.x == 0) (void)xb_add(&bar[XB_XCNT(b.x)], 1u);
    return b;
}
__device__ __forceinline__ void xcd_barrier_complete(unsigned* bar, unsigned x, unsigned& nloc, unsigned& nx) {
    const unsigned G = gridDim.x * gridDim.y * gridDim.z;
    unsigned sum, cnt, mine, sp = 0u;
    for (;;) {
        sum = 0u; cnt = 0u; mine = 0u;
#pragma unroll
        for (unsigned j = 0; j < 16; ++j) { const unsigned c = xb_ld(&bar[XB_XCNT(j)]); sum += c; cnt += (c > 0u) ? 1u : 0u; mine = (j == x) ? c : mine; }
        if (sum == G) break;
        __builtin_amdgcn_s_sleep(1);
        if ((++sp & 255u) == 0u) { if (xb_ld(&bar[XB_TMO])) break; if (sp > XB_SPIN_CAP) { atomicAdd(&bar[XB_TMO], 1u); break; } }
    }
    nloc = mine > 0u ? mine : 1u; nx = cnt > 0u ? cnt : 1u;
}
__device__ __forceinline__ void xcd_barrier(const XcdBarrier& b, const int wv) {
    const bool leader = (wv == 0) && (olane() == 0);
    asm volatile("s_waitcnt vmcnt(0)" ::: "memory");
    __syncthreads();
    if (leader) {
        unsigned* bar = b.bar; unsigned bx = b.x;
        asm volatile("" : "+s"(bar), "+s"(bx));
        __builtin_amdgcn_s_waitcnt(0);
        unsigned nloc = b.st[0], nx = b.st[1];
        if (nloc == 0u) { xcd_barrier_complete(bar, bx, nloc, nx); b.st[0] = nloc; b.st[1] = nx; }
        const unsigned old = xb_add(&bar[XB_XSUB(bx)], 1u);
        const unsigned gen = old / nloc;
        if (old + 1u == (gen + 1u) * nloc) {
            __builtin_amdgcn_fence(__ATOMIC_RELEASE, "agent");
            asm volatile("s_waitcnt vmcnt(0)" ::: "memory");
            const unsigned og = xb_add(&bar[XB_TOP], 1u);
            const unsigned tg = og / nx;
            if (og + 1u == (tg + 1u) * nx) xb_add(&bar[XB_TOPGEN], 1u);
            else XB_SPIN(xb_ld(&bar[XB_TOPGEN]) == tg, bar);
            __builtin_amdgcn_fence(__ATOMIC_ACQUIRE, "agent");
            xb_add(&bar[XB_XGEN(bx)], 1u);
            asm volatile("s_waitcnt vmcnt(0)" ::: "memory");
        } else {
            XB_SPIN(xb_ld(&bar[XB_XGEN(bx)]) == gen, bar);
            __builtin_amdgcn_fence(__ATOMIC_ACQUIRE, "agent");
            asm volatile("s_waitcnt vmcnt(0)" ::: "memory");
        }
    }
    __syncthreads();
}

namespace pg8 {
constexpr int BM = 256, BK = 64, HALF = 128, HTB = HALF * BK * 2, NXCD = 8, WGM = 8;
__host__ __device__ __forceinline__ int lds_byte(int r, int c) { const int st = (r >> 4) * 2 + (c >> 5), rr = r & 15, cc = c & 31, ob = rr * 64 + cc * 2; return st * 1024 + (ob ^ (((ob >> 9) & 1) << 5)); }
__host__ __device__ __forceinline__ void stage_rc(int b, int& R, int& C) { const int st = b / 1024, sb = b % 1024, swz = sb ^ (((sb >> 9) & 1) << 5); R = (st >> 1) * 16 + swz / 64; C = (st & 1) * 32 + (swz % 64) / 2; }
__host__ __device__ __forceinline__ int perm32(int rho) { const int n = rho >> 4, i = rho & 15; return 8 * (i >> 2) + 4 * n + (i & 3); }

struct Unit { int pm, pn, aux0, aux1, aux2; const char* a; const char* b; const char* b2; };
typedef f32x4 Acc[2][2][4][2];

typedef int i32x8_t __attribute__((ext_vector_type(8)));
typedef int i32x4_t __attribute__((ext_vector_type(4)));
template <class Epi, class Sched, bool ALIGN_EPI, bool GATHER = false, bool SPLITB = false, bool FP8 = false, int SCA = 0x7f7f7f7f, int SCB = 0x7f7f7f7f>
__device__ __forceinline__ void gemm_phase(LAS unsigned char* lds, const int lda, const int ldb, const int K, const int ksplit, const Sched& S, const Epi& E, const int wv) {
    const int tid = otid(wv), wid = __builtin_amdgcn_readfirstlane(tid >> 6), lane = tid & 63, wr = wid >> 2, wc = wid & 3, fr = lane & 15, fq = lane >> 4;
    const int nt = K / BK;
    unsigned voffA[2][2], voffN[2][2], voffB[2];
#pragma unroll
    for (int i = 0; i < 2; ++i) { int R, C; stage_rc(tid * 16 + i * 8192, R, C); const int Rb = (R & ~31) + perm32(R & 31);
        voffB[i] = (unsigned)(Rb * ldb + C) * 2u;
        voffA[0][i] = (unsigned)(R * lda + C) * 2u; voffA[1][i] = (unsigned)((R + HALF) * lda + C) * 2u; voffN[0][i] = voffA[0][i]; voffN[1][i] = voffA[1][i]; }
    const size_t kstep = (size_t)(BK * 2);
    const size_t hstepB = (size_t)HALF * ldb * 2, hstepA = (size_t)HALF * lda * 2;
    const unsigned ldsw = (unsigned)wid * 1024u;
    const int aoff = lds_byte(wr * 64 + fr, fq * 8), boff = lds_byte(wc * 32 + fr, fq * 8);
#define PG8_SA(b, h) (((b) * 2 + (h)) * HTB)
#define PG8_SB(b, h) ((4 + (b) * 2 + (h)) * HTB)
#define PG8_STAGE_B(bufoff, gbase, h) do { _Pragma("unroll") for (int _i = 0; _i < 2; ++_i) \
        __builtin_amdgcn_global_load_lds((const unsigned*)((const char*)(gbase) + (size_t)(h) * hstepB + voffB[_i]), (LAS unsigned*)(lds + (bufoff) + ldsw + _i * 8192), 16, 0, 0); } while (0)
#define PG8_STAGE_A(bufoff, gbase, h, NX) do { _Pragma("unroll") for (int _i = 0; _i < 2; ++_i) { if constexpr (GATHER) { const unsigned _o = (NX) ? voffN[h][_i] : voffA[h][_i]; \
        __builtin_amdgcn_global_load_lds((const unsigned*)((const char*)(gbase) + _o), (LAS unsigned*)(lds + (bufoff) + ldsw + _i * 8192), 16, 0, 0); } else { \
        __builtin_amdgcn_global_load_lds((const unsigned*)((const char*)(gbase) + (size_t)(h) * hstepA + voffA[0][_i]), (LAS unsigned*)(lds + (bufoff) + ldsw + _i * 8192), 16, 0, 0); } } } while (0)
#define PG8_LDA(dst, b, h) do { _Pragma("unroll") for (int m = 0; m < 4; ++m) { if constexpr (FP8) { \
        A8[m].lo = *(const LAS i32x4_t*)(lds + PG8_SA(b, h) + aoff + m * 2048); A8[m].hi = *(const LAS i32x4_t*)(lds + PG8_SA(b, h) + aoff + m * 2048 + 1024); } else { \
        _Pragma("unroll") for (int k = 0; k < 2; ++k) dst[m][k] = *(const LAS bf16x8*)(lds + PG8_SA(b, h) + aoff + m * 2048 + k * 1024); } } } while (0)
#define PG8_LDB(dst, b, h) do { _Pragma("unroll") for (int n = 0; n < 2; ++n) { if constexpr (FP8) { \
        dst##8[n].lo = *(const LAS i32x4_t*)(lds + PG8_SB(b, h) + boff + n * 2048); dst##8[n].hi = *(const LAS i32x4_t*)(lds + PG8_SB(b, h) + boff + n * 2048 + 1024); } else { \
        _Pragma("unroll") for (int k = 0; k < 2; ++k) dst[n][k] = *(const LAS bf16x8*)(lds + PG8_SB(b, h) + boff + n * 2048 + k * 1024); } } } while (0)
#define PG8_MMA(ai, bj, At, Bt) do { __builtin_amdgcn_s_setprio(1); if constexpr (FP8) { _Pragma("unroll") for (int m = 0; m < 4; ++m) _Pragma("unroll") for (int n = 0; n < 2; ++n) \
        asm volatile("v_mfma_scale_f32_16x16x128_f8f6f4 %0, %1, %2, %0, %3, %4 op_sel_hi:[0,0,0]" : "+v"(acc[ai][bj][m][n]) : "v"(Bt##8[n]), "v"(A8[m]), "v"(scb_), "v"(sca_)); } else { \
        _Pragma("unroll") for (int m = 0; m < 4; ++m) _Pragma("unroll") for (int n = 0; n < 2; ++n) _Pragma("unroll") for (int k = 0; k < 2; ++k) \
        acc[ai][bj][m][n] = __builtin_amdgcn_mfma_f32_16x16x32_bf16(Bt[n][k], At[m][k], acc[ai][bj][m][n], 0, 0, 0); } __builtin_amdgcn_s_setprio(0); } while (0)
#define PG8_WAIT_V(n) asm volatile("s_waitcnt vmcnt(" #n ")" ::: "memory")
#define PG8_WAIT_L(n) asm volatile("s_waitcnt lgkmcnt(" #n ")" ::: "memory")
#define PG8_BAR __builtin_amdgcn_s_barrier()
#define PG8_SCHED __builtin_amdgcn_sched_barrier(0)
#define PG8_GOFF(dst, u) do { if constexpr (GATHER) { const int _t = otid(wv); _Pragma("unroll") for (int _i = 0; _i < 2; ++_i) { int _R, _C; stage_rc(_t * 16 + _i * 8192, _R, _C); \
        _Pragma("unroll") for (int _h = 0; _h < 2; ++_h) dst[_h][_i] = S.gather_off(u, _h * HALF + _R) + (unsigned)_C * 2u; } } } while (0)
#define PG8_BPTR(u, t) (SPLITB ? (((t) < ksplit) ? (u).b + (size_t)(t) * kstep : (u).b2 + (size_t)((t) - ksplit) * kstep) : (u).b + (size_t)(t) * kstep)
    Unit cur, nxt; int ui = 0;
    if (!S.next(0, cur)) return;
    Acc acc;
#pragma unroll
    for (int a = 0; a < 2; ++a)
#pragma unroll
        for (int b = 0; b < 2; ++b)
#pragma unroll
            for (int m = 0; m < 4; ++m)
#pragma unroll
                for (int n = 0; n < 2; ++n) acc[a][b][m][n] = (f32x4){0.f, 0.f, 0.f, 0.f};
    bf16x8 At[4][2], B0[2][2], B1[2][2]; i32x8_t A8[4], B08[2], B18[2]; const int sca_ = SCA, scb_ = SCB;
    const char* cA = cur.a; const char* cB = cur.b;
    S.a_ready(cur);
    PG8_GOFF(voffA, cur);
    if constexpr (GATHER) {
#pragma unroll
        for (int h = 0; h < 2; ++h)
#pragma unroll
            for (int i = 0; i < 2; ++i) voffN[h][i] = voffA[h][i];
    }
    PG8_STAGE_B(PG8_SB(0, 0), cB, 0); PG8_STAGE_B(PG8_SB(0, 1), cB, 1); PG8_STAGE_A(PG8_SA(0, 0), cA, 0, false); PG8_STAGE_A(PG8_SA(0, 1), cA, 1, false);
    if (wr == 1) PG8_BAR;
    PG8_WAIT_V(2); PG8_BAR;
    PG8_STAGE_B(PG8_SB(1, 0), cB + kstep, 0); PG8_STAGE_A(PG8_SA(1, 0), cA + kstep, 0, false); PG8_STAGE_B(PG8_SB(1, 1), cB + kstep, 1);
    PG8_WAIT_V(6); PG8_BAR;
    for (;;) {
        const bool has_next = S.next(ui + 1, nxt);
        const char* nA = has_next ? nxt.a : cA; const char* nB = has_next ? nxt.b : cB;
#pragma nounroll
        for (int t = 0; t < nt; t += 2) {
            const bool last = (t == nt - 2);
            if (last && has_next) { S.a_ready(nxt); PG8_GOFF(voffN, nxt); }
            if constexpr (Epi::HOOK) { if (t == Epi::HOOK_T0 || t == Epi::HOOK_T1) E.hook(acc, cur, t, wr, wc, fr, fq); }
            const char* a1 = cA + (size_t)(t + 1) * kstep;
            const char* a2 = last ? nA : cA + (size_t)(t + 2) * kstep; const char* b2 = last ? nB : PG8_BPTR(cur, t + 2);
            const char* a3 = a2 + kstep; const char* b3 = b2 + kstep;
            PG8_LDB(B0, 0, 0); PG8_LDB(B1, 0, 1); PG8_SCHED; PG8_LDA(At, 0, 0); PG8_STAGE_A(PG8_SA(1, 1), a1, 1, false);
            PG8_WAIT_V(8); PG8_WAIT_L(0); PG8_BAR; PG8_MMA(0, 0, At, B0); PG8_MMA(0, 1, At, B1); PG8_BAR; PG8_SCHED;
            PG8_LDA(At, 0, 1); PG8_STAGE_B(PG8_SB(0, 0), b2, 0); PG8_STAGE_B(PG8_SB(0, 1), b2, 1); PG8_STAGE_A(PG8_SA(0, 0), a2, 0, last);
            PG8_WAIT_V(8); PG8_WAIT_L(0); PG8_BAR; PG8_MMA(1, 0, At, B0); PG8_MMA(1, 1, At, B1); PG8_BAR; PG8_SCHED;
            PG8_LDB(B0, 1, 0); PG8_LDB(B1, 1, 1); PG8_SCHED; PG8_LDA(At, 1, 0); PG8_STAGE_A(PG8_SA(0, 1), a2, 1, last);
            PG8_WAIT_V(8); PG8_WAIT_L(0); PG8_BAR; PG8_MMA(0, 0, At, B0); PG8_MMA(0, 1, At, B1); PG8_BAR; PG8_SCHED;
            PG8_LDA(At, 1, 1); PG8_STAGE_B(PG8_SB(1, 0), b3, 0); PG8_STAGE_B(PG8_SB(1, 1), b3, 1); PG8_STAGE_A(PG8_SA(1, 0), a3, 0, last);
            PG8_WAIT_V(8); PG8_WAIT_L(0); PG8_BAR; PG8_MMA(1, 0, At, B0); PG8_MMA(1, 1, At, B1); PG8_BAR; PG8_SCHED;
        }
        if constexpr (ALIGN_EPI) { if (wr == 0) PG8_BAR; }
        if constexpr (FP8) asm volatile("s_nop 15\n\ts_nop 15" ::: "memory");
        E(acc, cur, wr, wc, fr, fq); S.done(cur);
        if (!has_next) break;
#pragma unroll
        for (int a = 0; a < 2; ++a)
#pragma unroll
            for (int b = 0; b < 2; ++b)
#pragma unroll
                for (int m = 0; m < 4; ++m)
#pragma unroll
                    for (int n = 0; n < 2; ++n) acc[a][b][m][n] = (f32x4){0.f, 0.f, 0.f, 0.f};
        cur = nxt; cA = nA; cB = nB; ++ui;
        if constexpr (GATHER) {
#pragma unroll
            for (int h = 0; h < 2; ++h)
#pragma unroll
                for (int i = 0; i < 2; ++i) voffA[h][i] = voffN[h][i];
        }
        if constexpr (ALIGN_EPI) { if (wr == 1) PG8_BAR; }
    }
    PG8_WAIT_V(0);
    if constexpr (!ALIGN_EPI) { if (wr == 0) PG8_BAR; }
    PG8_BAR;
#undef PG8_SA
#undef PG8_SB
#undef PG8_STAGE_A
#undef PG8_STAGE_B
#undef PG8_LDA
#undef PG8_LDB
#undef PG8_MMA
#undef PG8_WAIT_V
#undef PG8_WAIT_L
#undef PG8_BAR
#undef PG8_SCHED
#undef PG8_GOFF
#undef PG8_BPTR
}
}
struct Resid {
    const float* in_lat; const float* in_ctx; bf16_t* x_lat; bf16_t* x_ctx; int g, src_f32;
    __device__ __forceinline__ const float* srcf(int row) const { const int bl = row / SB, s = row - bl * SB, b = g * GB + bl;
        return s < CTXL ? in_ctx + (size_t)(b * CTXL + s) * DM : in_lat + ((size_t)b * SEQ + (s - CTXL)) * DM; }
    __device__ __forceinline__ bf16_t* dst(int row) const { const int bl = row / SB, s = row - bl * SB, b = g * GB + bl;
        return s < CTXL ? x_ctx + (size_t)(b * CTXL + s) * DM : x_lat + ((size_t)b * SEQ + (s - CTXL)) * DM; }
    __device__ __forceinline__ int modv(int row) const { const int bl = row / SB, s = row - bl * SB; return s < CTXL ? 8 : g * GB + bl; }
};

struct TileOrder {
    int nM, nN, nwg, G, c, skip; const char* A; const char* B; size_t astep, bstep;
    __device__ __forceinline__ void init(int nM_, int nN_, int G_, int c_, const void* A_, size_t astep_, const void* B_, size_t bstep_, int skip_ctx) {
        nM = nM_; nN = nN_; nwg = nM * nN; G = G_; c = c_; A = (const char*)A_; B = (const char*)B_; astep = astep_; bstep = bstep_; skip = skip_ctx; }
    __device__ __forceinline__ bool next(int i, pg8::Unit& u) const {
        const long L = (long)i * G + c; if (L >= nwg) return false;
        int wgid = (int)L; { const int q = nwg / pg8::NXCD, r = nwg % pg8::NXCD, xcd = wgid % pg8::NXCD, off = wgid / pg8::NXCD; wgid = (xcd < r ? xcd * (q + 1) : r * (q + 1) + (xcd - r) * q) + off; }
        const int nig = pg8::WGM * nN, gid = wgid / nig, fm = gid * pg8::WGM, gsz = (nM - fm) < pg8::WGM ? (nM - fm) : pg8::WGM;
        int pm = fm + ((wgid % nig) % gsz); u.pn = (wgid % nig) / gsz;
        if (skip) pm = pm + pm / 32 + 1;
        u.pm = pm; u.aux0 = 0; u.aux1 = 0; u.aux2 = 0;
        u.a = A + (size_t)pm * astep; u.b = B + (size_t)u.pn * bstep; u.b2 = u.b; return true;
    }
    __device__ __forceinline__ void a_ready(const pg8::Unit&) const {}
    __device__ __forceinline__ void done(const pg8::Unit&) const {}
};

struct TileOrderP : TileOrder {
    unsigned* ctr;
    __device__ __forceinline__ void done(const pg8::Unit& u) const {
        asm volatile("s_waitcnt vmcnt(0)" ::: "memory");
#ifdef HANDOFF_RELEASE
        __builtin_amdgcn_fence(__ATOMIC_RELEASE, "agent"); asm volatile("s_waitcnt vmcnt(0)" ::: "memory");
#endif
        if (olane() == 0) __hip_atomic_fetch_add(ctr + 64 * u.pm, 1u, __ATOMIC_RELAXED, __HIP_MEMORY_SCOPE_AGENT);
    }
};
struct TileOrderC : TileOrder {
    unsigned* ctr; unsigned need; unsigned* tmo; int wv;
    __device__ __forceinline__ void a_ready(const pg8::Unit& u) const {
        if (wv == 0) {
            const unsigned long long t0 = __builtin_amdgcn_s_memrealtime(); unsigned polls = 0;
            while ((unsigned)__builtin_amdgcn_readfirstlane(__hip_atomic_load(ctr + 64 * u.pm, __ATOMIC_RELAXED, __HIP_MEMORY_SCOPE_AGENT)) < need) {
                if ((++polls & 255u) == 0u && __builtin_amdgcn_readfirstlane(__hip_atomic_load(tmo, __ATOMIC_RELAXED, __HIP_MEMORY_SCOPE_AGENT)) != 0u) break;
                if (__builtin_amdgcn_s_memrealtime() - t0 > 2000000ull) { if (olane() == 0) __hip_atomic_store(tmo, 1u, __ATOMIC_RELAXED, __HIP_MEMORY_SCOPE_AGENT); break; }
                __builtin_amdgcn_s_sleep(2); }
            __builtin_amdgcn_fence(__ATOMIC_ACQUIRE, "agent");
            asm volatile("s_waitcnt vmcnt(0)" ::: "memory");
        }
        asm volatile("" ::: "memory"); __builtin_amdgcn_s_barrier(); asm volatile("" ::: "memory");
    }
};

struct MoeOrder {
    const LAS int* tab; const int* LIST; int ncol, G, c, up; const char* A; const char* W; int esz;
    __device__ __forceinline__ bool next(int i, pg8::Unit& u) const {
        const int TR = __builtin_amdgcn_readfirstlane(tab[24]);
        int rt, pn;
        if ((G & 7) == 0) { const int x = c & 7, j = c >> 3, W = G >> 3; const int lo = (TR * x) >> 3, hi = (TR * (x + 1)) >> 3; const int q = i * W + j; if (q >= (hi - lo) * ncol) return false;
            rt = lo + q / ncol; pn = q - (q / ncol) * ncol; }
        else { const int L = i * G + c; if (L >= TR * ncol) return false; rt = L / ncol; pn = L - rt * ncol; }
        int p = 0;
#pragma unroll
        for (int q = 1; q < NPAIR; ++q) p += (__builtin_amdgcn_readfirstlane(tab[q]) <= rt) ? 1 : 0;
        const int base = (rt - __builtin_amdgcn_readfirstlane(tab[p])) * 256; int valid = __builtin_amdgcn_readfirstlane(tab[32 + p]) - base; valid = valid > 256 ? 256 : valid;
        u.pm = rt; u.pn = pn; u.aux0 = p * NT + base; u.aux1 = valid; u.aux2 = p;
        const int grp = p / 6, q6 = p - grp * 6;
        const int lo = q6 < 3 ? 0 : (q6 < 5 ? 1 : 2), hi = q6 < 3 ? q6 + 1 : (q6 < 5 ? q6 - 1 : 3);
        const int ea = grp * 4 + lo, eb = grp * 4 + hi;
        if (up) { const int e = pn < 4 ? ea : eb; u.a = A; u.b = W + ((size_t)e * 1024 + (size_t)(pn & 3) * 256) * 1024 * esz; u.b2 = u.b; }
        else { u.a = A + (size_t)rt * 256 * 1024 * esz; u.b = W + ((size_t)ea * 1024 + (size_t)pn * 256) * 512 * esz; u.b2 = W + ((size_t)eb * 1024 + (size_t)pn * 256) * 512 * esz; }
        return true;
    }
    __device__ __forceinline__ unsigned gather_off(const pg8::Unit& u, int r) const { const int idx = r < u.aux1 ? r : 0; return (unsigned)LIST[u.aux0 + idx] * (unsigned)(DM * esz); }
    __device__ __forceinline__ void a_ready(const pg8::Unit&) const {}
    __device__ __forceinline__ void done(const pg8::Unit&) const {}
};

#ifdef EPI_NT_STORES
#define ST_NT(p, v) __builtin_nontemporal_store((v), (p))
#else
#define ST_NT(p, v) (*(p) = (v))
#endif
#define EPI_NOHOOK static constexpr bool HOOK = false; static constexpr int HOOK_T0 = -1, HOOK_T1 = -1; \
    __device__ __forceinline__ void hook(pg8::Acc&, const pg8::Unit&, int, int, int, int, int) const {}
#define EPI_V8(v, acc, ai, bj, m) float v[8]; { const f32x4 _a = acc[ai][bj][m][0], _b = acc[ai][bj][m][1]; v[0] = _a[0]; v[1] = _a[1]; v[2] = _a[2]; v[3] = _a[3]; v[4] = _b[0]; v[5] = _b[1]; v[6] = _b[2]; v[7] = _b[3]; }
__device__ __forceinline__ void rot4(float (&v)[8], const f32x2* cs) {
    const f32x4 c01 = *(const f32x4*)cs, c23 = *(const f32x4*)(cs + 2);
    const float c[4] = {c01[0], c01[2], c23[0], c23[2]}, s[4] = {c01[1], c01[3], c23[1], c23[3]};
#pragma unroll
    for (int k = 0; k < 4; ++k) { const float x1 = v[2 * k], x2 = v[2 * k + 1]; v[2 * k] = x1 * c[k] - x2 * s[k]; v[2 * k + 1] = x2 * c[k] + x1 * s[k]; }
}

struct EpiNone { EPI_NOHOOK
    float* sink;
    __device__ __forceinline__ void operator()(const pg8::Acc& acc, const pg8::Unit& u, int wr, int wc, int fr, int fq) const {
        float s = 0.f;
#pragma unroll
        for (int ai = 0; ai < 2; ++ai)
#pragma unroll
            for (int bj = 0; bj < 2; ++bj)
#pragma unroll
                for (int m = 0; m < 4; ++m) s += acc[ai][bj][m][0][0] + acc[ai][bj][m][1][3];
        if (s == 1.2345e33f) sink[0] = s;
    }
};
struct EpiStoreOnly { EPI_NOHOOK
    bf16_t* PG;
    __device__ __forceinline__ void operator()(const pg8::Acc& acc, const pg8::Unit& u_, int wr, int wc, int fr, int fq) const {
        pg8::Unit u = u_; asm volatile("" : "+s"(u.pm), "+s"(u.pn), "+v"(fr), "+v"(fq));
        const int pn12 = u.pn % 12;
#pragma unroll
        for (int ai = 0; ai < 2; ++ai)
#pragma unroll
        for (int m = 0; m < 4; ++m) { const int row = u.pm * 256 + ai * 128 + wr * 64 + m * 16 + fr;
#pragma unroll
            for (int bj = 0; bj < 2; ++bj) { const int c0 = bj * 128 + wc * 32 + 8 * fq; EPI_V8(v, acc, ai, bj, m)
                *(u32x4*)(PG + (size_t)row * 3072 + pn12 * 256 + c0) = pack8(v); } }
    }
};
struct EpiGate {
    EPI_NOHOOK
    bf16_t* PG;
    __device__ __forceinline__ void operator()(const pg8::Acc& acc, const pg8::Unit& u_, int wr, int wc, int fr, int fq) const {
        pg8::Unit u = u_; asm volatile("" : "+s"(u.pm), "+s"(u.pn), "+v"(fr), "+v"(fq));
#pragma unroll
        for (int ai = 0; ai < 2; ++ai)
#pragma unroll
        for (int m = 0; m < 4; ++m) { const int row = u.pm * 256 + ai * 128 + wr * 64 + m * 16 + fr;
#pragma unroll
            for (int bj = 0; bj < 2; ++bj) { const int c0 = bj * 128 + wc * 32 + 8 * fq;
                EPI_V8(v, acc, ai, bj, m)
                float g[8];
#pragma unroll
                for (int k = 0; k < 8; ++k) g[k] = __builtin_amdgcn_rcpf(1.f + __builtin_amdgcn_exp2f(-fmaxf(v[k], -15.f * 1.4426950408889634f)));
                *(u32x4*)(PG + (size_t)row * 3072 + u.pn * 256 + c0) = pack8(g); } }
    }
};
struct EpiInproj {
    EPI_NOHOOK
    bf16_t *PR, *PC, *PM, *PG; unsigned char* KB; float* SSQ; const f32x2* RT; const f32x2* MT; int pn_off;
    __device__ __forceinline__ void operator()(const pg8::Acc& acc, const pg8::Unit& u_, int wr, int wc, int fr, int fq) const {
        pg8::Unit u = u_; asm volatile("" : "+s"(u.pm), "+s"(u.pn), "+s"(u.aux0), "+s"(u.aux1), "+v"(fr), "+v"(fq));
        const int pn = u.pn + pn_off;
#pragma unroll
        for (int ai = 0; ai < 2; ++ai)
#pragma unroll
        for (int m = 0; m < 4; ++m) { __builtin_amdgcn_sched_barrier(0);
            const int row = u.pm * 256 + ai * 128 + wr * 64 + m * 16 + fr;
            const int bl = row / SB, s = row - bl * SB; const bool lat = s >= CTXL; const int t = lat ? s - CTXL : 0;
            float ss[2] = {0.f, 0.f};
#pragma unroll
            for (int bj = 0; bj < 2; ++bj) {
                const int c0 = bj * 128 + wc * 32 + 8 * fq;
                EPI_V8(v, acc, ai, bj, m)
                if (pn <= 1) {
                    if (lat) rot4(v, RT + (size_t)t * 32 + ((c0 & 63) >> 1));
                    if (pn == 1) {
#pragma unroll
                        for (int k = 0; k < 8; ++k) v[k] *= 0.125f;
                    }
                    *(u32x4*)(PR + (size_t)row * 1536 + pn * 256 + c0) = pack8(v);
                } else if (pn <= 5) {
                    *(u32x4*)(PR + (size_t)row * 1536 + pn * 256 + c0) = pack8(v);
                } else if (pn <= 7) {
                    *(u32x4*)(PC + (size_t)row * 1024 + (pn - 6) * 256 + c0) = pack8(v);
                } else if (pn <= 11) {
                    u32x2 w; w.x = cvtpk(v[0] * v[1], v[2] * v[3]); w.y = cvtpk(v[4] * v[5], v[6] * v[7]);
                    *(u32x2*)(PC + (size_t)row * 1024 + 512 + (pn - 8) * 128 + (c0 >> 1)) = w;
                } else if (pn <= 14) {
                    if (pn == 14 && bj == 1) {
                        if (wc == 0) {
                            if (lat) { const int a = fq >> 1, pos = a ? (t & 63) : (t >> 6); rot4(v, MT + pos * 8 + (fq & 1) * 4); }
#pragma unroll
                            for (int k = 0; k < 8; ++k) v[k] *= K8S;
                            const u32x2 w = pack8_fp8(v);
#pragma unroll
                            for (int hh = 0; hh < 8; ++hh) { unsigned char* kp = KB + ((size_t)(bl * 8 + hh) * SB + s) * 128;
                                *(u32x2*)(kp + 64 + 8 * fq) = w; if (fq == 3) { *(u32x4*)(kp + 96) = (u32x4){0u, 0u, 0u, 0u}; *(u32x4*)(kp + 112) = (u32x4){0u, 0u, 0u, 0u}; } }
                        }
                    } else {
                        *(u32x4*)(PM + (size_t)row * 640 + (pn - 12) * 256 + c0) = pack8(v);
                        float q = 0.f;
#pragma unroll
                        for (int k = 0; k < 8; ++k) q += v[k] * v[k];
                        ss[bj] = q;
                    }
                } else {
                    float g[8];
#pragma unroll
                    for (int k = 0; k < 8; ++k) g[k] = sigmoid_fast(fmaxf(v[k], -15.f));
                    ST_NT((u32x4*)(PG + (size_t)row * 3072 + (pn - 15) * 256 + c0), pack8(g));
                }
            }
            if (pn >= 12 && pn <= 14) {
                float a = ss[0], b = ss[1];
                a += swz_xor<16>(a); a = half_sum(a); b += swz_xor<16>(b); b = half_sum(b);
                if (fq == 0) {
                    float* sq = SSQ + (size_t)row * 16;
                    if (pn == 12) sq[wc] = a + b;
                    else if (pn == 13) { sq[4 + wc] = a; sq[8 + wc] = b; }
                    else sq[12 + wc] = a;
                }
            }
        }
    }
};

#define EPI_ROW(ai, m) (u.pm * 256 + (ai) * 128 + wr * 64 + (m) * 16 + fr)
#define EPI_OPAQUE pg8::Unit u = u_; asm volatile("" : "+s"(u.pm), "+s"(u.pn), "+s"(u.aux0), "+s"(u.aux1), "+v"(fr), "+v"(fq));
struct EpiUq {
    EPI_NOHOOK
    unsigned char* QB; const float* SSQ; const f32x2* MT;
    __device__ __forceinline__ void operator()(const pg8::Acc& acc, const pg8::Unit& u_, int wr, int wc, int fr, int fq) const {
        EPI_OPAQUE
        f32x4 q0[2][4], q1[2][4];
#pragma unroll
        for (int ai = 0; ai < 2; ++ai)
#pragma unroll
            for (int m = 0; m < 4; ++m) { const float* sq = SSQ + (size_t)EPI_ROW(ai, m) * 16; q0[ai][m] = *(const f32x4*)sq; q1[ai][m] = *(const f32x4*)(sq + 4); }
#pragma unroll
        for (int ai = 0; ai < 2; ++ai)
#pragma unroll
        for (int m = 0; m < 4; ++m) {
            const int row = EPI_ROW(ai, m);
            const int bl = row / SB, s = row - bl * SB; const bool lat = s >= CTXL; const int t = lat ? s - CTXL : 0;
            const f32x4 a = q0[ai][m], b = q1[ai][m];
            const float ssq = ((a[0] + a[1]) + (a[2] + a[3])) + ((b[0] + b[1]) + (b[2] + b[3]));
            const float rq = rsqrtf(ssq * (1.f / 384.f) + RMS_EPS) * (QSCALE * Q8S);
#pragma unroll
            for (int bj = 0; bj < 2; ++bj) {
                const int cg = u.pn * 256 + bj * 128 + wc * 32 + 8 * fq; const int h = cg / 96, d0 = cg - h * 96;
                EPI_V8(v, acc, ai, bj, m)
#pragma unroll
                for (int k = 0; k < 8; ++k) v[k] *= rq;
                if (d0 >= 64 && lat) { const int p0 = d0 - 64, aa = p0 >> 4, pos = aa ? (t & 63) : (t >> 6); rot4(v, MT + pos * 8 + ((p0 & 15) >> 1)); }
                unsigned char* qp = QB + ((size_t)(bl * 8 + h) * SB + s) * 128;
                *(u32x2*)(qp + d0) = pack8_fp8(v);
                if (d0 == 88) { *(u32x4*)(qp + 96) = (u32x4){0u, 0u, 0u, 0u}; *(u32x4*)(qp + 112) = (u32x4){0u, 0u, 0u, 0u}; }
            }
        }
    }
};
struct EpiUkv {
    EPI_NOHOOK
    unsigned char* KB; unsigned char* VT; const float* SSQ; LAS unsigned char* tr;
    __device__ __forceinline__ void operator()(const pg8::Acc& acc, const pg8::Unit& u_, int wr, int wc, int fr, int fq) const {
        EPI_OPAQUE
        f32x4 q0[2][4], q1[2][4];
#pragma unroll
        for (int ai = 0; ai < 2; ++ai)
#pragma unroll
            for (int m = 0; m < 4; ++m) { const float* sq = SSQ + (size_t)EPI_ROW(ai, m) * 16 + 8; q0[ai][m] = *(const f32x4*)sq; q1[ai][m] = *(const f32x4*)(sq + 4); }
        LAS unsigned char* my = tr + (wr * 2 + (wc & 1)) * 2048;
        const int lane = fr + 16 * fq;
#pragma unroll
        for (int ai = 0; ai < 2; ++ai) {
            const int row0 = u.pm * 256 + ai * 128 + wr * 64;
            const int bl = row0 / SB, s0 = row0 - bl * SB;
#pragma unroll
            for (int bj = 0; bj < 2; ++bj) {
                const int h = u.pn * 2 + bj;
#pragma unroll
                for (int m = 0; m < 4; ++m) {
                    const f32x4 a = q0[ai][m], b = q1[ai][m];
                    const float ssq = ((a[0] + a[1]) + (a[2] + a[3])) + ((b[0] + b[1]) + (b[2] + b[3]));
                    const float rk = rsqrtf(ssq * (1.f / 256.f) + RMS_EPS);
                    EPI_V8(v, acc, ai, bj, m)
                    if (wc < 2) {
#pragma unroll
                        for (int k = 0; k < 8; ++k) v[k] *= rk * K8S;
                        *(u32x2*)(KB + ((size_t)(bl * 8 + h) * SB + s0 + 16 * m + fr) * 128 + wc * 32 + 8 * fq) = pack8_fp8(v);
                    } else {
#pragma unroll
                        for (int k = 0; k < 8; ++k) v[k] *= rk * V8S;
                        const u32x2 w = pack8_fp8(v); const int pos = vt_pos(16 * m + fr) ^ (16 * fq);
#pragma unroll
                        for (int k = 0; k < 4; ++k) { my[(8 * fq + k) * 64 + pos] = (unsigned char)(w.x >> (8 * k)); my[(8 * fq + 4 + k) * 64 + pos] = (unsigned char)(w.y >> (8 * k)); }
                    }
                }
                if (wc >= 2) {
#pragma unroll
                    for (int i = 0; i < 2; ++i) { const int ch = lane + 64 * i, d = ch >> 2, c16 = ch & 3;
                        const u32x4 x = *(const LAS u32x4*)(my + d * 64 + ((c16 ^ ((d >> 3) & 3)) * 16));
                        *(u32x4*)(VT + ((size_t)(bl * 8 + h) * 64 + (wc - 2) * 32 + d) * SB + s0 + c16 * 16) = x; }
                }
            }
        }
    }
};

struct EpiMerge1 {
    static constexpr bool HOOK = true; static constexpr int HOOK_T0 = 8, HOOK_T1 = 16;
    const bf16_t* PG; bf16_t* M;
    __device__ __forceinline__ void hook(pg8::Acc& acc, const pg8::Unit& u_, int t, int wr, int wc, int fr, int fq) const {
        pg8::Unit u = u_; asm volatile("" : "+s"(u.pm), "+s"(u.pn), "+v"(fr), "+v"(fq));
        const int gi = (t == 8) ? 0 : 1;
#pragma unroll
        for (int ai = 0; ai < 2; ++ai) {
            u32x4 sp[4][2], sn[4][2];
#pragma unroll
            for (int m = 0; m < 4; ++m)
#pragma unroll
                for (int bj = 0; bj < 2; ++bj) { const bf16_t* p = PG + (size_t)EPI_ROW(ai, m) * 3072 + gi * 1024 + u.pn * 256 + bj * 128 + wc * 32 + 8 * fq;
                    sp[m][bj] = *(const u32x4*)p; sn[m][bj] = *(const u32x4*)(p + 1024); }
#pragma unroll
            for (int m = 0; m < 4; ++m)
#pragma unroll
                for (int bj = 0; bj < 2; ++bj) {
                    float a[8], b[8]; unpack8(sp[m][bj], a); unpack8(sn[m][bj], b);
                    f32x4 r0, r1;
#pragma unroll
                    for (int k = 0; k < 4; ++k) { r0[k] = a[k] * __builtin_amdgcn_rcpf(b[k]); r1[k] = a[4 + k] * __builtin_amdgcn_rcpf(b[4 + k]); }
                    acc[ai][bj][m][0] *= r0; acc[ai][bj][m][1] *= r1;
                }
            __builtin_amdgcn_sched_barrier(0);
        }
    }
    __device__ __forceinline__ void operator()(const pg8::Acc& acc, const pg8::Unit& u_, int wr, int wc, int fr, int fq) const {
        EPI_OPAQUE
        const __amdgpu_buffer_rsrc_t rsrc = __builtin_amdgcn_make_buffer_rsrc((void*)M, 0, (int)((size_t)NT * 1024 * 2), 0x00020000);
#pragma unroll
        for (int ai = 0; ai < 2; ++ai) {
            u32x4 s2[4][2];
#pragma unroll
            for (int m = 0; m < 4; ++m)
#pragma unroll
                for (int bj = 0; bj < 2; ++bj) s2[m][bj] = *(const u32x4*)(PG + (size_t)EPI_ROW(ai, m) * 3072 + 2048 + u.pn * 256 + bj * 128 + wc * 32 + 8 * fq);
#pragma unroll
            for (int m = 0; m < 4; ++m)
#pragma unroll
                for (int bj = 0; bj < 2; ++bj) {
                    const int cg = u.pn * 256 + bj * 128 + wc * 32 + 8 * fq;
                    float g[8]; unpack8(s2[m][bj], g);
                    EPI_V8(v, acc, ai, bj, m)
#pragma unroll
                    for (int k = 0; k < 8; ++k) v[k] *= g[k];
#ifndef HANDOFF
                    *(u32x4*)(M + (size_t)EPI_ROW(ai, m) * 1024 + cg) = pack8(v);
#else
                    __builtin_amdgcn_raw_buffer_store_b128(pack8(v), rsrc, (unsigned)(((size_t)EPI_ROW(ai, m) * 1024 + cg) * 2), 0, 16);
#endif
                }
            __builtin_amdgcn_sched_barrier(0);
        }
    }
};

struct EpiMerge1NoHook : EpiMerge1 { static constexpr bool HOOK = false; };
struct EpiMerge1HookOnly { static constexpr bool HOOK = true; static constexpr int HOOK_T0 = 8, HOOK_T1 = 16; EpiMerge1 e; float* sink;
    __device__ __forceinline__ void hook(pg8::Acc& acc, const pg8::Unit& u, int t, int wr, int wc, int fr, int fq) const { e.hook(acc, u, t, wr, wc, fr, fq); }
    __device__ __forceinline__ void operator()(const pg8::Acc& acc, const pg8::Unit& u, int wr, int wc, int fr, int fq) const { EpiNone n{sink}; n(acc, u, wr, wc, fr, fq); }
};
struct EpiMerge2 {
    EPI_NOHOOK
    Resid R; const float* MODL;
    __device__ __forceinline__ void operator()(const pg8::Acc& acc, const pg8::Unit& u_, int wr, int wc, int fr, int fq) const {
        EPI_OPAQUE
        const int cb = u.pn * 256 + wc * 32 + 8 * fq;
        const float* g1 = MODL + R.modv(u.pm * 256) * 6144 + 2048 + cb;
        f32x4 g[2][2];
#pragma unroll
        for (int bj = 0; bj < 2; ++bj)
#pragma unroll
            for (int n = 0; n < 2; ++n) g[bj][n] = *(const f32x4*)(g1 + bj * 128 + 4 * n);
        int sf32 = R.src_f32; asm volatile("" : "+s"(sf32));
#pragma unroll
        for (int ai = 0; ai < 2; ++ai) {
            if (sf32) {
#pragma unroll
                for (int mh = 0; mh < 2; ++mh) {
                    f32x4 x[2][2][2];
#pragma unroll
                    for (int m2 = 0; m2 < 2; ++m2) { const float* src = R.srcf(EPI_ROW(ai, 2 * mh + m2)) + cb;
#pragma unroll
                        for (int bj = 0; bj < 2; ++bj)
#pragma unroll
                            for (int n = 0; n < 2; ++n) x[m2][bj][n] = *(const f32x4*)(src + bj * 128 + 4 * n); }
#pragma unroll
                    for (int m2 = 0; m2 < 2; ++m2) { const int m = 2 * mh + m2; bf16_t* dst = R.dst(EPI_ROW(ai, m)) + cb;
#pragma unroll
                        for (int bj = 0; bj < 2; ++bj) { const f32x4 a = x[m2][bj][0] + g[bj][0] * acc[ai][bj][m][0], b = x[m2][bj][1] + g[bj][1] * acc[ai][bj][m][1];
                            u32x4 w; w.x = cvtpk(a[0], a[1]); w.y = cvtpk(a[2], a[3]); w.z = cvtpk(b[0], b[1]); w.w = cvtpk(b[2], b[3]); *(u32x4*)(dst + bj * 128) = w; } }
                }
            } else {
                u32x4 x[4][2];
#pragma unroll
                for (int m = 0; m < 4; ++m) { const bf16_t* src = R.dst(EPI_ROW(ai, m)) + cb;
#pragma unroll
                    for (int bj = 0; bj < 2; ++bj) x[m][bj] = *(const u32x4*)(src + bj * 128); }
#pragma unroll
                for (int m = 0; m < 4; ++m) { bf16_t* dst = R.dst(EPI_ROW(ai, m)) + cb;
#pragma unroll
                    for (int bj = 0; bj < 2; ++bj) { float f[8]; unpack8(x[m][bj], f);
                        const f32x4 a = (f32x4){f[0], f[1], f[2], f[3]} + g[bj][0] * acc[ai][bj][m][0], b = (f32x4){f[4], f[5], f[6], f[7]} + g[bj][1] * acc[ai][bj][m][1];
                        u32x4 w; w.x = cvtpk(a[0], a[1]); w.y = cvtpk(a[2], a[3]); w.z = cvtpk(b[0], b[1]); w.w = cvtpk(b[2], b[3]); *(u32x4*)(dst + bj * 128) = w; } }
            }
            __builtin_amdgcn_sched_barrier(0);
        }
    }
};

struct EpiMoeUp {
    EPI_NOHOOK
    const int* LIST; const float* WGT; bf16_t* MACT;
    __device__ __forceinline__ void operator()(const pg8::Acc& acc, const pg8::Unit& u_, int wr, int wc, int fr, int fq) const {
        EPI_OPAQUE
        const int slot = u.pn >> 2;
        int tok[2][4]; float w[2][4];
#pragma unroll
        for (int ai = 0; ai < 2; ++ai)
#pragma unroll
            for (int m = 0; m < 4; ++m) { const int ri = ai * 128 + wr * 64 + m * 16 + fr; tok[ai][m] = LIST[u.aux0 + (ri < u.aux1 ? ri : 0)]; }
#pragma unroll
        for (int ai = 0; ai < 2; ++ai)
#pragma unroll
            for (int m = 0; m < 4; ++m) w[ai][m] = WGT[(size_t)tok[ai][m] * 2 + slot];
#pragma unroll
        for (int ai = 0; ai < 2; ++ai)
#pragma unroll
        for (int m = 0; m < 4; ++m) {
            const int ri = ai * 128 + wr * 64 + m * 16 + fr; const float ww = w[ai][m];
#pragma unroll
            for (int bj = 0; bj < 2; ++bj) {
                const int c0 = bj * 128 + wc * 32 + 8 * fq;
                EPI_V8(v, acc, ai, bj, m)
                u32x2 o; o.x = cvtpk(silu_fast(v[0]) * v[1] * ww, silu_fast(v[2]) * v[3] * ww); o.y = cvtpk(silu_fast(v[4]) * v[5] * ww, silu_fast(v[6]) * v[7] * ww);
                *(u32x2*)(MACT + (size_t)(u.pm * 256 + ri) * 1024 + slot * 512 + (u.pn & 3) * 128 + (c0 >> 1)) = o;
            }
        }
    }
};
struct EpiMoeUp8 {
    EPI_NOHOOK
    const int* LIST; const float* WGT; unsigned char* MACT;
    __device__ __forceinline__ void operator()(const pg8::Acc& acc, const pg8::Unit& u_, int wr, int wc, int fr, int fq) const {
        EPI_OPAQUE
        const int slot = u.pn >> 2;
        int tok[2][4]; float w[2][4];
#pragma unroll
        for (int ai = 0; ai < 2; ++ai)
#pragma unroll
            for (int m = 0; m < 4; ++m) { const int ri = ai * 128 + wr * 64 + m * 16 + fr; tok[ai][m] = LIST[u.aux0 + (ri < u.aux1 ? ri : 0)]; }
#pragma unroll
        for (int ai = 0; ai < 2; ++ai)
#pragma unroll
            for (int m = 0; m < 4; ++m) w[ai][m] = WGT[(size_t)tok[ai][m] * 2 + slot] * MA8S;
#pragma unroll
        for (int ai = 0; ai < 2; ++ai)
#pragma unroll
        for (int m = 0; m < 4; ++m) {
            const int ri = ai * 128 + wr * 64 + m * 16 + fr; const float ww = w[ai][m];
#pragma unroll
            for (int bj = 0; bj < 2; ++bj) {
                const int c0 = bj * 128 + wc * 32 + 8 * fq;
                EPI_V8(v, acc, ai, bj, m)
                int o = __builtin_amdgcn_cvt_pk_fp8_f32(silu_fast(v[0]) * v[1] * ww, silu_fast(v[2]) * v[3] * ww, 0, false); o = __builtin_amdgcn_cvt_pk_fp8_f32(silu_fast(v[4]) * v[5] * ww, silu_fast(v[6]) * v[7] * ww, o, true);
                *(int*)(MACT + (size_t)(u.pm * 256 + ri) * 1024 + slot * 512 + (u.pn & 3) * 128 + (c0 >> 1)) = o;
            }
        }
    }
};
struct EpiMoeDown {
    EPI_NOHOOK
    const int* LIST; Resid R; const float* MODL; bf16_t* dry;
    __device__ __forceinline__ void operator()(const pg8::Acc& acc, const pg8::Unit& u_, int wr, int wc, int fr, int fq) const {
        EPI_OPAQUE
        int tok[2][4];
#pragma unroll
        for (int ai = 0; ai < 2; ++ai)
#pragma unroll
            for (int m = 0; m < 4; ++m) { const int ri = ai * 128 + wr * 64 + m * 16 + fr; tok[ai][m] = LIST[u.aux0 + (ri < u.aux1 ? ri : 0)]; }
        const int cb = u.pn * 256 + wc * 32 + 8 * fq;
#pragma unroll
        for (int ai = 0; ai < 2; ++ai) {
            u32x4 x[4][2];
#pragma unroll
            for (int m = 0; m < 4; ++m) { const bf16_t* dst = R.dst(tok[ai][m]) + cb;
#pragma unroll
                for (int bj = 0; bj < 2; ++bj) x[m][bj] = *(const u32x4*)(dst + bj * 128); }
#pragma unroll
            for (int m = 0; m < 4; ++m) { const int ri = ai * 128 + wr * 64 + m * 16 + fr;
                if (ri < u.aux1) {
                    bf16_t* dst = R.dst(tok[ai][m]) + cb; const float* g2 = MODL + R.modv(tok[ai][m]) * 6144 + 5120 + cb;
#pragma unroll
                    for (int bj = 0; bj < 2; ++bj) { float f[8]; unpack8(x[m][bj], f);
                        const f32x4 ga = *(const f32x4*)(g2 + bj * 128), gb = *(const f32x4*)(g2 + bj * 128 + 4);
                        const f32x4 a = (f32x4){f[0], f[1], f[2], f[3]} + ga * acc[ai][bj][m][0], b = (f32x4){f[4], f[5], f[6], f[7]} + gb * acc[ai][bj][m][1];
                        u32x4 w; w.x = cvtpk(a[0], a[1]); w.y = cvtpk(a[2], a[3]); w.z = cvtpk(b[0], b[1]); w.w = cvtpk(b[2], b[3]);
                        bf16_t* o = dry ? dry + (size_t)(u.pm * 256 + ri) * 1024 + cb + bj * 128 : dst + bj * 128;
                        *(u32x4*)o = w; }
                } }
            __builtin_amdgcn_sched_barrier(0);
        }
    }
};
#define SBAR() __builtin_amdgcn_sched_barrier(0)
__device__ __forceinline__ int crow(int r, int hi) { return (r & 3) + 8 * (r >> 2) + 4 * hi; }
template <int NCB> __device__ __forceinline__ int v_st(int k, int c) { const int kk = (k & ~0xC) | ((k & 4) << 1) | ((k & 8) >> 1); return ((kk >> 3) * NCB + (c >> 5)) * 512 + ((kk & 7) * 32 + (c & 31)) * 2; }
__device__ __forceinline__ int v_rd_base(int lane) { return ((lane & 3) << 3) | (((lane >> 2) & 3) << 6) | (((lane >> 4) & 1) << 5) | (((lane >> 5) & 1) << 8); }
template <int OFF> __device__ __forceinline__ s16x4 tr_read(int vb) { s16x4 r; asm volatile("ds_read_b64_tr_b16 %0, %1 offset:%2" : "=&v"(r) : "v"(vb), "i"(OFF) : "memory"); return r; }
#define PKLH(L, H) (bf16x8){L[0], L[1], L[2], L[3], H[0], H[1], H[2], H[3]}
template <int NCB, int KS> __device__ __forceinline__ bf16x8 tr_frag(int vb) { const s16x4 l = tr_read<KS * NCB * 1024>(vb), h = tr_read<KS * NCB * 1024 + NCB * 512>(vb); return PKLH(l, h); }
#define PK4(P, BASE, OUT) do { const unsigned a0 = cvtpk(P[BASE + 0], P[BASE + 1]), a1 = cvtpk(P[BASE + 2], P[BASE + 3]);   \
    const unsigned b0 = cvtpk(P[BASE + 4], P[BASE + 5]), b1 = cvtpk(P[BASE + 6], P[BASE + 7]);                              \
    auto r0 = __builtin_amdgcn_permlane32_swap(a0, b0, false, false); auto r1 = __builtin_amdgcn_permlane32_swap(a1, b1, false, false); \
    u32x4 w = {r0[0], r1[0], r0[1], r1[1]}; OUT = __builtin_bit_cast(bf16x8, w); } while (0)

namespace att {
constexpr int DQK = 96, DV = 64, KVBLK = 64;
constexpr int SHM_V = KVBLK * DV * 2;
constexpr int SHM_K = KVBLK * 256;
constexpr float THR = 8.f;
#define KSWZ(row, colB) ((row) * 256 + ((colB) ^ (((row) & 7) << 4)))
__device__ __forceinline__ void partialSM(f32x16& p0, f32x16& p1, float& m_reg, float& alpha) {
    float pmax = p0[0];
#pragma unroll
    for (int r = 1; r < 16; ++r) pmax = fmaxf(pmax, p0[r]);
#pragma unroll
    for (int r = 0; r < 16; ++r) pmax = fmaxf(pmax, p1[r]);
    { auto rr = __builtin_amdgcn_permlane32_swap(__float_as_uint(pmax), __float_as_uint(pmax), false, false);
      pmax = fmaxf(__uint_as_float(rr[0]), __uint_as_float(rr[1])); }
    float mn;
    if (__builtin_expect(__all(pmax - m_reg <= THR), 1)) { mn = m_reg; alpha = 1.f; }
    else { mn = fmaxf(m_reg, pmax); alpha = __builtin_amdgcn_exp2f(m_reg - mn); m_reg = mn; }
#pragma unroll
    for (int r = 0; r < 16; ++r) p0[r] = p0[r] - mn;
#pragma unroll
    for (int r = 0; r < 16; ++r) p1[r] = p1[r] - mn;
#pragma unroll
    for (int r = 0; r < 16; ++r) p0[r] = __builtin_amdgcn_exp2f(p0[r]);
}
__device__ __forceinline__ void finishSM(f32x16& p0, f32x16& p1, float alpha, float& l_reg, bf16x8& pa0, bf16x8& pa1, bf16x8& pa2, bf16x8& pa3) {
#pragma unroll
    for (int r = 0; r < 16; ++r) p1[r] = __builtin_amdgcn_exp2f(p1[r]);
    float ps = 0;
#pragma unroll
    for (int r = 0; r < 16; ++r) ps += p0[r];
#pragma unroll
    for (int r = 0; r < 16; ++r) ps += p1[r];
    { auto rr = __builtin_amdgcn_permlane32_swap(__float_as_uint(ps), __float_as_uint(ps), false, false);
      ps = __uint_as_float(rr[0]) + __uint_as_float(rr[1]); }
    l_reg = l_reg * alpha + ps;
    PK4(p0, 0, pa0); PK4(p0, 8, pa1); PK4(p1, 0, pa2); PK4(p1, 8, pa3);
}
__device__ __forceinline__ void qkt(f32x16& p0, f32x16& p1, const LAS char* Ks, const bf16x8* qr, int r32, int hi) {
    p0 = f32x16{}; p1 = f32x16{};
#pragma unroll
    for (int d0 = 0; d0 < 6; ++d0) { const int cb = (d0 * 16 + hi * 8) * 2;
        const bf16x8 b0 = *(const LAS bf16x8*)(Ks + KSWZ(r32, cb));
        const bf16x8 b1 = *(const LAS bf16x8*)(Ks + KSWZ(32 + r32, cb));
        p0 = __builtin_amdgcn_mfma_f32_32x32x16_bf16(b0, qr[d0], p0, 0, 0, 0);
        p1 = __builtin_amdgcn_mfma_f32_32x32x16_bf16(b1, qr[d0], p1, 0, 0, 0); }
}
template <int D0> __device__ __forceinline__ void pv_one(f32x16& od, int vb, bf16x8 pa0, bf16x8 pa1, bf16x8 pa2, bf16x8 pa3) {
    const bf16x8 f0 = tr_frag<2, 0>(vb + D0 * 512), f1 = tr_frag<2, 1>(vb + D0 * 512), f2 = tr_frag<2, 2>(vb + D0 * 512), f3 = tr_frag<2, 3>(vb + D0 * 512);
    asm volatile("s_waitcnt lgkmcnt(0)" ::: "memory"); SBAR();
    od = __builtin_amdgcn_mfma_f32_32x32x16_bf16(pa0, f0, od, 0, 0, 0);
    od = __builtin_amdgcn_mfma_f32_32x32x16_bf16(pa1, f1, od, 0, 0, 0);
    od = __builtin_amdgcn_mfma_f32_32x32x16_bf16(pa2, f2, od, 0, 0, 0);
    od = __builtin_amdgcn_mfma_f32_32x32x16_bf16(pa3, f3, od, 0, 0, 0);
}
__device__ __forceinline__ void pv_d0(f32x16* o, int vb, bf16x8 pa0, bf16x8 pa1, bf16x8 pa2, bf16x8 pa3) {
    pv_one<0>(o[0], vb, pa0, pa1, pa2, pa3); pv_one<1>(o[1], vb, pa0, pa1, pa2, pa3);
}
__device__ __forceinline__ void attn_unit(const bf16_t* __restrict__ Qb, const bf16_t* __restrict__ Kh, const bf16_t* __restrict__ Vh, bf16_t* __restrict__ Ob, int ldo, int seq, LAS char* lds, const int wv) {
    const int tid = otid(wv), wid = __builtin_amdgcn_readfirstlane(tid >> 6), lane = tid & 63, r32 = lane & 31, hi = lane >> 5;
    LAS char* V_lds = lds; LAS char* K_lds = lds + 2 * SHM_V;
    LAS float* ws = (LAS float*)(lds + 2 * SHM_V + 2 * SHM_K) + wid * 64; LAS float* li_l = ws; LAS float* al_l = ws + 32;
    float m_reg = -1e30f, l_reg = 0; f32x16 o[2] = {}; bf16x8 qr[6];
    const bf16_t* Qw = Qb + (size_t)(wid * 32 + r32) * DQK + hi * 8;
#pragma unroll
    for (int d0 = 0; d0 < 6; ++d0) qr[d0] = *(const bf16x8*)(Qw + d0 * 16);
    const int vrow = tid >> 3, vc = (tid & 7) * 8, vst = v_st<2>(vrow, vc);
    const int krA = tid / 12, kcA = tid - krA * 12, sB = 512 + tid, krB = sB / 12, kcB = sB - krB * 12;
    const int kstA = KSWZ(krA, kcA * 16), kstB = KSWZ(krB, kcB * 16);
    const bool hasB = wid < 4;
    const int vb0 = (int)(size_t)V_lds + v_rd_base(lane);
    struct { bf16x8 v, ka, kb; } sr_[2];
#define SLOAD(i, k0) do { sr_[i].v = *(const bf16x8*)(Vh + (size_t)((k0) + vrow) * DV + vc); sr_[i].ka = *(const bf16x8*)(Kh + (size_t)((k0) + krA) * DQK + kcA * 8); \
    if (hasB) sr_[i].kb = *(const bf16x8*)(Kh + (size_t)((k0) + krB) * DQK + kcB * 8); } while (0)
#define SWRITE(b, i) do { *(LAS bf16x8*)(V_lds + (b) * SHM_V + vst) = sr_[i].v; *(LAS bf16x8*)(K_lds + (b) * SHM_K + kstA) = sr_[i].ka; \
    if (hasB) *(LAS bf16x8*)(K_lds + (b) * SHM_K + kstB) = sr_[i].kb; } while (0)
#define RESC(a) do { if (__any((a) < 1.f)) { if (hi == 0) al_l[r32] = (a); asm volatile("s_waitcnt lgkmcnt(0)" ::: "memory"); \
    _Pragma("unroll") for (int d = 0; d < 2; ++d) _Pragma("unroll") for (int r = 0; r < 16; ++r) o[d][r] *= al_l[crow(r, hi)]; } } while (0)
    f32x16 pA0, pA1, pB0, pB1; float alA, alB; bf16x8 pa0, pa1, pa2, pa3; const int NTL = seq / KVBLK;
    SLOAD(0, 0); SWRITE(0, 0); __syncthreads();
    qkt(pA0, pA1, K_lds, qr, r32, hi); partialSM(pA0, pA1, m_reg, alA);
    SLOAD(1, KVBLK); if (2 < NTL) SLOAD(0, 2 * KVBLK);
    SWRITE(1, 1); __syncthreads();
    for (int j = 1; j + 1 < NTL; j += 2) {
        SBAR(); qkt(pB0, pB1, K_lds + SHM_K, qr, r32, hi);
        finishSM(pA0, pA1, alA, l_reg, pa0, pa1, pa2, pa3); SBAR();
        SLOAD(1, (j + 2) * KVBLK); SBAR();
        pv_d0(o, vb0, pa0, pa1, pa2, pa3); partialSM(pB0, pB1, m_reg, alB);
        __syncthreads(); SWRITE(0, 0);
        RESC(alB); __syncthreads();
        SBAR(); qkt(pA0, pA1, K_lds, qr, r32, hi);
        finishSM(pB0, pB1, alB, l_reg, pa0, pa1, pa2, pa3); SBAR();
        if (j + 3 < NTL) SLOAD(0, (j + 3) * KVBLK); SBAR();
        pv_d0(o, vb0 + SHM_V, pa0, pa1, pa2, pa3); partialSM(pA0, pA1, m_reg, alA);
        __syncthreads(); SWRITE(1, 1);
        RESC(alA); __syncthreads();
    }
    SBAR(); qkt(pB0, pB1, K_lds + SHM_K, qr, r32, hi);
    finishSM(pA0, pA1, alA, l_reg, pa0, pa1, pa2, pa3); SBAR();
    pv_d0(o, vb0, pa0, pa1, pa2, pa3); partialSM(pB0, pB1, m_reg, alB);
    __syncthreads(); RESC(alB);
    finishSM(pB0, pB1, alB, l_reg, pa0, pa1, pa2, pa3); SBAR();
    pv_d0(o, vb0 + SHM_V, pa0, pa1, pa2, pa3);
    if (hi == 0) li_l[r32] = l_reg; asm volatile("s_waitcnt lgkmcnt(0)" ::: "memory");
    float rli[16];
#pragma unroll
    for (int r = 0; r < 16; ++r) rli[r] = __builtin_amdgcn_rcpf(li_l[crow(r, hi)]);
    bf16_t* Ow = Ob + (size_t)(wid * 32) * ldo;
#pragma unroll
    for (int r = 0; r < 16; ++r) { const int orow = crow(r, hi);
#pragma unroll
        for (int d0 = 0; d0 < 2; ++d0) Ow[(size_t)orow * ldo + d0 * 32 + r32] = f2bf(o[d0][r] * rli[r]); }
    __syncthreads();
#undef SLOAD
#undef SWRITE
#undef RESC
}
}

namespace att2 {
constexpr int DQK = 96, DV = 64, KVBLK = 64;
constexpr int KB_BYTES = 64 * 128, VB_BYTES = 64 * 64;
typedef int i32x8 __attribute__((ext_vector_type(8)));
constexpr int SC_K = 0x7d7d7d7d, SC_Q = 0x7a7a7a7a, SC_P = 0x7f7f7f7f, SC_V = 0x7d7d7d7d;
constexpr int NSLOT = 5;
constexpr int LDS_K = 0, LDS_V = NSLOT * KB_BYTES, LDS_WS = LDS_V + NSLOT * VB_BYTES, LDS_TOTAL = LDS_WS + 8 * 64 * 4;
static_assert(LDS_TOTAL <= RING_BYTES, "attention LDS");
constexpr float THR = 4.f;
typedef short v4i16_t __attribute__((ext_vector_type(4)));
__device__ __forceinline__ s16x4 vtr(const LAS char* p) { return __builtin_bit_cast(s16x4, __builtin_amdgcn_ds_read_tr16_b64_v4i16((LAS v4i16_t*)p)); }
#define PP_KLD(B, DH) ({ const int row_ = 32 * (B) + r32, sw_ = (row_ >> 1) & 7, c0_ = 2 * hi + 4 * (DH); \
        const u32x4 a_ = *(const LAS u32x4*)(Kt + row_ * 128 + ((c0_ ^ sw_) << 4)), b_ = *(const LAS u32x4*)(Kt + row_ * 128 + (((c0_ + 1) ^ sw_) << 4)); \
        (i32x8){(int)a_.x, (int)a_.y, (int)a_.z, (int)a_.w, (int)b_.x, (int)b_.y, (int)b_.z, (int)b_.w}; })
#define PP_VLD(DB) ({ const int d_ = 32 * (DB) + r32, sw_ = (d_ >> 2) & 3; \
        const u32x4 a_ = *(const LAS u32x4*)(Vt + d_ * 64 + (((2 * hi) ^ sw_) << 4)), b_ = *(const LAS u32x4*)(Vt + d_ * 64 + (((2 * hi + 1) ^ sw_) << 4)); \
        (i32x8){(int)a_.x, (int)a_.y, (int)a_.z, (int)a_.w, (int)b_.x, (int)b_.y, (int)b_.z, (int)b_.w}; })
#ifdef PROBE_EXP2X
#define PP_EXP(x) do { float a_ = (x), b_ = (x); asm volatile("" : "+v"(b_)); a_ = __builtin_amdgcn_exp2f(a_); b_ = __builtin_amdgcn_exp2f(b_); (x) = (a_ + b_) * 0.5f; } while (0)
#else
#define PP_EXP(x) (x) = __builtin_amdgcn_exp2f(x)
#endif
#define PK4N(P, BASE, OUT) do { u32x4 w_ = {cvtpk(P[BASE + 0], P[BASE + 1]), cvtpk(P[BASE + 2], P[BASE + 3]), cvtpk(P[BASE + 4], P[BASE + 5]), cvtpk(P[BASE + 6], P[BASE + 7])}; OUT = __builtin_bit_cast(bf16x8, w_); } while (0)
#define PP_SLOT_END() do { SBAR(); asm volatile("s_waitcnt vmcnt(%0) lgkmcnt(0)\n\ts_barrier" :: "n"(2 * (NSLOT - 2)) : "memory"); SBAR(); } while (0)
#define PP_BAR() do { SBAR(); asm volatile("s_waitcnt lgkmcnt(0)\n\ts_barrier" ::: "memory"); SBAR(); } while (0)
__device__ __forceinline__ float max3f(float a, float b, float c) { return fmaxf(fmaxf(a, b), c); }
__device__ __forceinline__ void attn_unit_pp(const unsigned char* __restrict__ Qb, const unsigned char* __restrict__ Kh, const unsigned char* __restrict__ Vh, bf16_t* __restrict__ Ob, int ldo, int seq, LAS char* lds, const int wv) {
    const int tid = otid(wv), wid = __builtin_amdgcn_readfirstlane(tid >> 6), lane = tid & 63, r32 = lane & 31, hi = lane >> 5, grp = wid >> 2;
    LAS float* ws = (LAS float*)(lds + LDS_WS) + wid * 64; LAS float* al_l = ws;
    const int NTL = seq / KVBLK;
    unsigned koff, voff;
    { const int s = wid * 64 + lane, row = s >> 3, ch = (s & 7) ^ ((row >> 1) & 7); koff = (unsigned)(row * 128 + ch * 16); }
    { const int s = (wid & 3) * 64 + lane, d = s >> 2, ch = (s & 3) ^ ((d >> 2) & 3); voff = (unsigned)(d * SB + ch * 16); }
    const char* Kg = (const char*)Kh; const char* Vg = (const char*)Vh;
#define PP_DMA_K(t) do { int tt_ = (t); tt_ = tt_ < NTL ? tt_ : NTL - 1; const int sl_ = tt_ % NSLOT; \
        __builtin_amdgcn_global_load_lds((const unsigned*)(Kg + (size_t)tt_ * (64 * 128) + koff), (LAS unsigned*)(lds + LDS_K + sl_ * KB_BYTES + wid * 1024), 16, 0, 0); } while (0)
#define PP_DMA_V(t) do { int tt_ = (t); tt_ = tt_ < NTL ? tt_ : NTL - 1; const int sl_ = tt_ % NSLOT; \
        __builtin_amdgcn_global_load_lds((const unsigned*)(Vg + (size_t)tt_ * 64 + voff), (LAS unsigned*)(lds + LDS_V + sl_ * VB_BYTES + (wid & 3) * 1024), 16, 0, 0); } while (0)
#pragma unroll
    for (int i = 0; i <= NSLOT - 2; ++i) PP_DMA_K(i);
#pragma unroll
    for (int i = 0; i <= NSLOT - 3; ++i) PP_DMA_V(i);
    i32x8 q8[2];
    { const unsigned char* Qw = Qb + (size_t)(wid * 32 + r32) * 128 + hi * 32;
#pragma unroll
      for (int dh = 0; dh < 2; ++dh) { const u32x4 a_ = *(const u32x4*)(Qw + dh * 64), b_ = *(const u32x4*)(Qw + dh * 64 + 16);
          q8[dh] = (i32x8){(int)a_.x, (int)a_.y, (int)a_.z, (int)a_.w, (int)b_.x, (int)b_.y, (int)b_.z, (int)b_.w}; } }
    float m_reg = 0.f; f32x16 o[2] = {}; f32x16 lacc = {}; const i32x8 ones8 = {0x38383838, 0x38383838, 0x38383838, 0x38383838, 0x38383838, 0x38383838, 0x38383838, 0x38383838}; f32x16 negm = {}; asm volatile("" : "+v"(negm));
    f32x16 p0, p1; i32x8 pa8 = {};
    SBAR(); asm volatile("s_waitcnt vmcnt(0) lgkmcnt(0)\n\ts_barrier" ::: "memory"); SBAR();
#ifdef ATTN_TWO_BARRIERS
    if (grp == 1) PP_BAR();
#endif
#define PP_M(t) do { const int t_ = (t), j_ = t_ + 1; \
        if (t_ <= NTL - 2) { PP_DMA_V(t_ + NSLOT - 1); PP_DMA_K(t_ + NSLOT); } \
        i32x8 k8[4]; i32x8 v8[2]; \
        const LAS char* Kt = lds + LDS_K + ((j_ < NTL ? j_ : 0) % NSLOT) * KB_BYTES; \
        const LAS char* Vt = lds + LDS_V + ((t_ < 0 ? 0 : t_) % NSLOT) * VB_BYTES; \
        if (j_ < NTL) { \
            k8[0] = PP_KLD(0, 0); k8[1] = PP_KLD(1, 0); SBAR(); \
            k8[2] = PP_KLD(0, 1); SBAR(); \
            p0 = __builtin_amdgcn_mfma_scale_f32_32x32x64_f8f6f4(k8[0], q8[0], negm, 0, 0, 0, SC_K, 0, SC_Q); SBAR(); \
            k8[3] = PP_KLD(1, 1); SBAR(); \
            p1 = __builtin_amdgcn_mfma_scale_f32_32x32x64_f8f6f4(k8[1], q8[0], negm, 0, 0, 0, SC_K, 0, SC_Q); SBAR(); \
            if (t_ >= 0) { v8[0] = PP_VLD(0); } SBAR(); \
            p0 = __builtin_amdgcn_mfma_scale_f32_32x32x64_f8f6f4(k8[2], q8[1], p0, 0, 0, 0, SC_K, 0, SC_Q); SBAR(); \
            if (t_ >= 0) { v8[1] = PP_VLD(1); } SBAR(); \
            p1 = __builtin_amdgcn_mfma_scale_f32_32x32x64_f8f6f4(k8[3], q8[1], p1, 0, 0, 0, SC_K, 0, SC_Q); SBAR(); \
        } else if (t_ >= 0) { v8[0] = PP_VLD(0); v8[1] = PP_VLD(1); SBAR(); } \
        if (t_ >= 0) { \
            o[0] = __builtin_amdgcn_mfma_scale_f32_32x32x64_f8f6f4(pa8, v8[0], o[0], 0, 0, 0, SC_P, 0, SC_V); \
            o[1] = __builtin_amdgcn_mfma_scale_f32_32x32x64_f8f6f4(pa8, v8[1], o[1], 0, 0, 0, SC_P, 0, SC_V); \
            lacc = __builtin_amdgcn_mfma_scale_f32_32x32x64_f8f6f4(pa8, ones8, lacc, 0, 0, 0, SC_P, 0, SC_P); } \
        asm volatile("" : "+v"(o[0]), "+v"(o[1]), "+v"(p0), "+v"(p1), "+v"(lacc));        \
        } while (0)
#define PP_S(first) do { \
        float a_ = max3f(p0[0], p0[1], p1[0]), b_ = max3f(p0[2], p0[3], p1[1]); a_ = max3f(a_, p1[2], p1[3]); \
        _Pragma("unroll") for (int r = 4; r < 16; r += 4) { a_ = max3f(a_, p0[r], p0[r + 1]); b_ = max3f(b_, p0[r + 2], p0[r + 3]); a_ = max3f(a_, p1[r], p1[r + 1]); b_ = max3f(b_, p1[r + 2], p1[r + 3]); } \
        float rm_ = fmaxf(a_, b_); { auto rr = __builtin_amdgcn_permlane32_swap(__float_as_uint(rm_), __float_as_uint(rm_), false, false); rm_ = fmaxf(__uint_as_float(rr[0]), __uint_as_float(rr[1])); } \
        if (first) { const float dl = rm_ - 4.f; m_reg = dl; _Pragma("unroll") for (int r = 0; r < 16; ++r) { p0[r] -= dl; p1[r] -= dl; } \
            _Pragma("unroll") for (int r = 0; r < 16; ++r) negm[r] = -m_reg; asm volatile("" : "+v"(negm)); } \
        else if (__builtin_expect(__any(rm_ > 2.f * THR), 0)) { const float dl = fmaxf(rm_ - THR, 0.f); m_reg += dl; \
            _Pragma("unroll") for (int r = 0; r < 16; ++r) { p0[r] -= dl; p1[r] -= dl; } \
            _Pragma("unroll") for (int r = 0; r < 16; ++r) negm[r] = -m_reg; asm volatile("" : "+v"(negm)); \
            const float al = __builtin_amdgcn_exp2f(-dl); if (hi == 0) al_l[r32] = al; asm volatile("s_waitcnt lgkmcnt(0)" ::: "memory"); \
            _Pragma("unroll") for (int r = 0; r < 16; ++r) { const float f_ = al_l[crow(r, hi)]; o[0][r] *= f_; o[1][r] *= f_; lacc[r] *= f_; } } \
        _Pragma("unroll") for (int r = 0; r < 16; ++r) { PP_EXP(p0[r]); PP_EXP(p1[r]); } \
        _Pragma("unroll") for (int k_ = 0; k_ < 4; ++k_) { \
            int w_ = __builtin_amdgcn_cvt_pk_fp8_f32(p0[4 * k_], p0[4 * k_ + 1], 0, false); w_ = __builtin_amdgcn_cvt_pk_fp8_f32(p0[4 * k_ + 2], p0[4 * k_ + 3], w_, true); pa8[k_] = w_; \
            int x_ = __builtin_amdgcn_cvt_pk_fp8_f32(p1[4 * k_], p1[4 * k_ + 1], 0, false); x_ = __builtin_amdgcn_cvt_pk_fp8_f32(p1[4 * k_ + 2], p1[4 * k_ + 3], x_, true); pa8[4 + k_] = x_; } \
        asm volatile("" : "+v"(pa8)); } while (0)
#ifdef ATTN_TWO_BARRIERS
    PP_M(-1); PP_SLOT_END();
    PP_S(true); PP_SLOT_END();
#pragma nounroll
    for (int t = 0; t < NTL - 1; ++t) {
        PP_M(t); PP_SLOT_END();
        PP_S(false); PP_SLOT_END();
    }
    PP_M(NTL - 1);
    if (grp == 0) PP_BAR();
#else
#ifdef ATTN_PRIO_YOUNG
    if (grp == 1) __builtin_amdgcn_s_setprio(1);
#endif
    if (grp == 0) {
        PP_M(-1); PP_S(true); PP_SLOT_END();
#pragma nounroll
        for (int t = 0; t < NTL - 1; ++t) { PP_M(t); PP_S(false); PP_SLOT_END(); }
        PP_M(NTL - 1);
    } else {
        PP_M(-1); PP_SLOT_END();
        PP_S(true);
#pragma nounroll
        for (int t = 0; t < NTL - 1; ++t) { PP_M(t); PP_SLOT_END(); PP_S(false); }
        PP_M(NTL - 1);
    }
#ifdef ATTN_PRIO_YOUNG
    __builtin_amdgcn_s_setprio(0);
#endif
#endif
    float rli[16];
#pragma unroll
    for (int r = 0; r < 16; ++r) rli[r] = __builtin_amdgcn_rcpf(lacc[r]);
    bf16_t* Ow = Ob + (size_t)(wid * 32) * ldo;
#pragma unroll
    for (int r = 0; r < 16; ++r) { const int orow = crow(r, hi);
#pragma unroll
        for (int d0 = 0; d0 < 2; ++d0) Ow[(size_t)orow * ldo + d0 * 32 + r32] = f2bf(o[d0][r] * rli[r]); }
    SBAR(); asm volatile("s_waitcnt vmcnt(0) lgkmcnt(0)\n\ts_barrier" ::: "memory"); SBAR();
#undef PP_DMA_K
#undef PP_DMA_V
#undef PP_M
#undef PP_S
}
}

__device__ __forceinline__ void retu_unit(int unit, const bf16_t* PR, float* U, float lg2f, float lg2b, LAS char* lds, const int wv) {
    const int tid = otid(wv), wid = __builtin_amdgcn_readfirstlane(tid >> 6), lane = tid & 63, r32 = lane & 31, hi = lane >> 5;
    const int h = unit & 3, bc = unit >> 2, bl = bc / NCHUNK, c = bc - bl * NCHUNK;
    const size_t r0 = (size_t)bl * SB + (size_t)c * 128;
    LAS char* Vt = lds;
    LAS char* Kf = lds + 32768;
    LAS char* Kb = lds + 49152;
#pragma unroll
    for (int i = 0; i < 2; ++i) { const int ch = tid + i * 512, j = ch >> 3, c8 = (ch & 7) * 8;
        const u32x4 kw = *(const u32x4*)(PR + (r0 + j) * 1536 + 256 + h * 64 + c8);
        float f[8], g[8]; unpack8(kw, f);
        const float wf = __builtin_amdgcn_exp2f(lg2f * (float)(127 - j)), wb = __builtin_amdgcn_exp2f(lg2b * (float)j);
#pragma unroll
        for (int k = 0; k < 8; ++k) { g[k] = f[k] * wb; f[k] *= wf; }
        const int off = (j >> 6) * 8192 + v_st<2>(j & 63, c8);
        *(LAS u32x4*)(Kf + off) = pack8(f); *(LAS u32x4*)(Kb + off) = pack8(g); }
#pragma unroll
    for (int i = 0; i < 4; ++i) { const int ch = tid + i * 512, j = ch >> 4, c8 = (ch & 15) * 8;
        const u32x4 vw = *(const u32x4*)(PR + (r0 + j) * 1536 + 512 + h * 128 + c8);
        *(LAS u32x4*)(Vt + (j >> 6) * 16384 + v_st<4>(j & 63, c8)) = vw; }
    __syncthreads();
    const int eblk = wid & 3, dblk = wid >> 2;
    const int vbV = (int)(size_t)Vt + v_rd_base(lane) + eblk * 512, vbF = (int)(size_t)Kf + v_rd_base(lane) + dblk * 512, vbB = (int)(size_t)Kb + v_rd_base(lane) + dblk * 512;
    f32x16 aF = {}, aB = {};
#define RU_STEP(SUB, KS) do { const bf16x8 a = tr_frag<4, KS>(vbV + SUB * 16384), bf = tr_frag<2, KS>(vbF + SUB * 8192), bb = tr_frag<2, KS>(vbB + SUB * 8192); \
        asm volatile("s_waitcnt lgkmcnt(0)" ::: "memory"); SBAR(); \
        aF = __builtin_amdgcn_mfma_f32_32x32x16_bf16(a, bf, aF, 0, 0, 0); aB = __builtin_amdgcn_mfma_f32_32x32x16_bf16(a, bb, aB, 0, 0, 0); } while (0)
    RU_STEP(0, 0); RU_STEP(0, 1); RU_STEP(0, 2); RU_STEP(0, 3); RU_STEP(1, 0); RU_STEP(1, 1); RU_STEP(1, 2); RU_STEP(1, 3);
#undef RU_STEP
    float* Uf = U + (size_t)unit * 2 * 8192; float* Ub = Uf + 8192;
#pragma unroll
    for (int r = 0; r < 16; ++r) { const int e = 32 * eblk + crow(r, hi), d = 32 * dblk + r32; Uf[e * 64 + d] = aF[r]; Ub[e * 64 + d] = aB[r]; }
    __syncthreads();
}

__device__ __forceinline__ void retout_unit(int unit, const bf16_t* PR, const bf16_t* S, const float* gnw, bf16_t* ACT, float lg2f, float lg2b, LAS char* lds, const int wv) {
    const int tid = otid(wv), wid = __builtin_amdgcn_readfirstlane(tid >> 6), lane = tid & 63, r32 = lane & 31, hi = lane >> 5;
    const int h = unit & 3, bc = unit >> 2, bl = bc / NCHUNK, c = bc - bl * NCHUNK;
    const size_t r0 = (size_t)bl * SB + (size_t)c * 128;
    LAS char* Vt = lds; LAS float* part = (LAS float*)(lds + 32768);
    const int qblk = wid & 3, ehalf = wid >> 2, iq = 32 * qblk + r32;
    u32x4 vw[4];
#pragma unroll
    for (int i = 0; i < 4; ++i) { const int ch = tid + i * 512, j = ch >> 4, c8 = (ch & 15) * 8; vw[i] = *(const u32x4*)(PR + (r0 + j) * 1536 + 512 + h * 128 + c8); }
    bf16x8 qf[4], kf[4][4];
    { const bf16_t* qp = PR + (r0 + iq) * 1536 + h * 64 + hi * 8;
#pragma unroll
      for (int d0 = 0; d0 < 4; ++d0) qf[d0] = *(const bf16x8*)(qp + d0 * 16); }
#pragma unroll
    for (int jb = 0; jb < 4; ++jb) { const bf16_t* kp = PR + (r0 + 32 * jb + r32) * 1536 + 256 + h * 64 + hi * 8;
#pragma unroll
        for (int d0 = 0; d0 < 4; ++d0) kf[jb][d0] = *(const bf16x8*)(kp + d0 * 16); }
    const int orow = tid >> 2, oc = (tid & 3) * 32;
    u32x4 gw[4];
#pragma unroll
    for (int k = 0; k < 4; ++k) gw[k] = *(const u32x4*)(PR + (r0 + orow) * 1536 + 1024 + h * 128 + oc + 8 * k);
#pragma unroll
    for (int i = 0; i < 4; ++i) { const int ch = tid + i * 512, j = ch >> 4, c8 = (ch & 15) * 8; *(LAS u32x4*)(Vt + (j >> 6) * 16384 + v_st<4>(j & 63, c8)) = vw[i]; }
    f32x16 o[2] = {};
    __syncthreads();
    bf16x8 sf[2][4], sb[2][4];
    { const bf16_t* Sf = S + (size_t)unit * 2 * 8192; const bf16_t* Sb = Sf + 8192;
#pragma unroll
      for (int e0 = 0; e0 < 2; ++e0) { const int e = 64 * ehalf + 32 * e0 + r32;
#pragma unroll
        for (int d0 = 0; d0 < 4; ++d0) { sf[e0][d0] = *(const bf16x8*)(Sf + e * 64 + d0 * 16 + hi * 8); sb[e0][d0] = *(const bf16x8*)(Sb + e * 64 + d0 * 16 + hi * 8); } } }
    const int vb = (int)(size_t)Vt + v_rd_base(lane) + ehalf * 1024;
#pragma unroll
    for (int jb = 0; jb < 4; ++jb) {
        f32x16 p = {};
#pragma unroll
        for (int d0 = 0; d0 < 4; ++d0) p = __builtin_amdgcn_mfma_f32_32x32x16_bf16(kf[jb][d0], qf[d0], p, 0, 0, 0);
#pragma unroll
        for (int r = 0; r < 16; ++r) { const int dj = iq - (32 * jb + crow(r, hi));
            const float e = dj >= 0 ? lg2f * (float)dj : lg2b * (float)(-dj); p[r] *= __builtin_amdgcn_exp2f(e); }
        bf16x8 pa0, pa1; PK4(p, 0, pa0); PK4(p, 8, pa1);
        const int vj = vb + (jb >> 1) * 16384;
        if (jb & 1) {
            const bf16x8 f00 = tr_frag<4, 2>(vj), f01 = tr_frag<4, 3>(vj), f10 = tr_frag<4, 2>(vj + 512), f11 = tr_frag<4, 3>(vj + 512);
            asm volatile("s_waitcnt lgkmcnt(0)" ::: "memory"); SBAR();
            o[0] = __builtin_amdgcn_mfma_f32_32x32x16_bf16(pa0, f00, o[0], 0, 0, 0); o[0] = __builtin_amdgcn_mfma_f32_32x32x16_bf16(pa1, f01, o[0], 0, 0, 0);
            o[1] = __builtin_amdgcn_mfma_f32_32x32x16_bf16(pa0, f10, o[1], 0, 0, 0); o[1] = __builtin_amdgcn_mfma_f32_32x32x16_bf16(pa1, f11, o[1], 0, 0, 0);
        } else {
            const bf16x8 f00 = tr_frag<4, 0>(vj), f01 = tr_frag<4, 1>(vj), f10 = tr_frag<4, 0>(vj + 512), f11 = tr_frag<4, 1>(vj + 512);
            asm volatile("s_waitcnt lgkmcnt(0)" ::: "memory"); SBAR();
            o[0] = __builtin_amdgcn_mfma_f32_32x32x16_bf16(pa0, f00, o[0], 0, 0, 0); o[0] = __builtin_amdgcn_mfma_f32_32x32x16_bf16(pa1, f01, o[0], 0, 0, 0);
            o[1] = __builtin_amdgcn_mfma_f32_32x32x16_bf16(pa0, f10, o[1], 0, 0, 0); o[1] = __builtin_amdgcn_mfma_f32_32x32x16_bf16(pa1, f11, o[1], 0, 0, 0);
        }
    }
    {
        const float xf = __builtin_amdgcn_exp2f(lg2f * (float)(iq + 1)), xb = __builtin_amdgcn_exp2f(lg2b * (float)(128 - iq));
#pragma unroll
        for (int d0 = 0; d0 < 4; ++d0) {
            float f[8], g[8]; unpack8(__builtin_bit_cast(u32x4, qf[d0]), f);
#pragma unroll
            for (int k = 0; k < 8; ++k) { g[k] = f[k] * xb; f[k] *= xf; }
            const bf16x8 qa = __builtin_bit_cast(bf16x8, pack8(f)), qb = __builtin_bit_cast(bf16x8, pack8(g));
#pragma unroll
            for (int e0 = 0; e0 < 2; ++e0) { o[e0] = __builtin_amdgcn_mfma_f32_32x32x16_bf16(qa, sf[e0][d0], o[e0], 0, 0, 0); o[e0] = __builtin_amdgcn_mfma_f32_32x32x16_bf16(qb, sb[e0][d0], o[e0], 0, 0, 0); }
        }
    }
    float sq[16];
#pragma unroll
    for (int r = 0; r < 16; ++r) { float s = o[0][r] * o[0][r] + o[1][r] * o[1][r];
        sq[r] = sum32(s); }
    if (r32 == 0) {
#pragma unroll
        for (int r = 0; r < 16; ++r) part[wid * 32 + crow(r, hi)] = sq[r];
    }
    __syncthreads();
    const float g0 = gnw[h * 128 + 64 * ehalf + r32], g1 = gnw[h * 128 + 64 * ehalf + 32 + r32];
    LAS bf16_t* stg = (LAS bf16_t*)Vt;
#pragma unroll
    for (int r = 0; r < 16; ++r) { const int il = crow(r, hi);
        const float tot = part[wid * 32 + il] + part[(wid ^ 4) * 32 + il];
        const float rn = rsqrtf(tot * (1.f / 128.f) + RMS_EPS);
        LAS bf16_t* sp = stg + (32 * qblk + il) * 128 + 64 * ehalf + r32;
        sp[0] = f2bf(o[0][r] * rn * g0); sp[32] = f2bf(o[1][r] * rn * g1); }
    __syncthreads();
#pragma unroll
    for (int k = 0; k < 4; ++k) { float y[8], g[8]; unpack8(*(const LAS u32x4*)(stg + orow * 128 + oc + 8 * k), y); unpack8(gw[k], g);
#pragma unroll
        for (int q = 0; q < 8; ++q) y[q] *= silu_fast(g[q]);
        *(u32x4*)(ACT + (r0 + orow) * 1536 + h * 128 + oc + 8 * k) = pack8(y); }
    __syncthreads();
}
struct Args { const float* in[26]; float* out; unsigned char* ws; int ph_lo, ph_hi; };
struct Frame {
    LAS unsigned char* lds; int G, wv;
    const Args* a; float* out; unsigned char* ws;
};
__device__ __forceinline__ const float* in_ptr(const Args* a, int i) { int z; asm volatile("s_mov_b32 %0, 0" : "=s"(z)); return a->in[i + z]; }
#define INP(i) in_ptr(F.a, (i))
__device__ __forceinline__ unsigned char* ows(unsigned char* p) { asm volatile("" : "+s"(p)); return p; }
#ifdef SELFCHECK_ATTN
#define WSP(T, off) ((T*)(ows(F.ws) + (off)))
#else
#define WSP(T, off) ((T*)(F.ws + (off)))
#endif

__device__ __forceinline__ int srccol_in(int n) {
    if (n < 512) { const int base = n & ~255, hh = (n & 255) >> 6, p = n & 63; return base + hh * 64 + (p >> 1) + 32 * (p & 1); }
    if (n < 2048) return n;
    if (n < 3072) { const int j = (n - 2048) >> 1; return 2048 + j + 512 * (n & 1); }
    if (n < 3712) return n;
    if (n < 3744) { const int p = n - 3712, a = p >> 4, q = p & 15; return 3712 + a * 16 + (q >> 1) + 8 * (q & 1); }
    if (n < 3840) return -1;
    return n - 96;
}
__device__ __forceinline__ int srccol_uq(int n) { const int h = n / 96, d = n - h * 96; if (d < 64) return n; const int p = d - 64, a = p >> 4, q = p & 15; return h * 96 + 64 + a * 16 + (q >> 1) + 8 * (q & 1); }

__device__ __forceinline__ void cvt_item(const float* sp, int ldw, const float* scale, bf16_t* dst, int ldd, int n0, int k0, LAS float* scr, int lane) {
    float vv[32];
#pragma unroll
    for (int i = 0; i < 32; ++i) { const int kk = 2 * i + (lane >> 5); vv[i] = sp ? sp[(size_t)(k0 + kk) * ldw] : 0.f; }
    if (scale) {
#pragma unroll
        for (int i = 0; i < 32; ++i) vv[i] *= scale[k0 + 2 * i + (lane >> 5)];
    }
#pragma unroll
    for (int i = 0; i < 32; ++i) scr[(2 * i + (lane >> 5)) * 33 + (lane & 31)] = vv[i];
    asm volatile("s_waitcnt lgkmcnt(0)" ::: "memory");
    const int c = lane & 7;
#pragma unroll
    for (int j = 0; j < 4; ++j) { const int n = (lane >> 3) + 8 * j; const LAS float* s = scr + (8 * c) * 33 + n;
        u32x4 o; o.x = cvtpk(s[0 * 33], s[1 * 33]); o.y = cvtpk(s[2 * 33], s[3 * 33]); o.z = cvtpk(s[4 * 33], s[5 * 33]); o.w = cvtpk(s[6 * 33], s[7 * 33]);
        *(u32x4*)(dst + (size_t)(n0 + n) * ldd + k0 + 8 * c) = o; }
    asm volatile("s_waitcnt lgkmcnt(0)" ::: "memory");
}

__device__ __forceinline__ void cvt_item_fp8(const float* sp, int ldw, float sc, unsigned char* dst, int ldd, int n0, int k0, LAS float* scr, int lane) {
    float vv[32];
#pragma unroll
    for (int i = 0; i < 32; ++i) { const int kk = 2 * i + (lane >> 5); vv[i] = sp ? sp[(size_t)(k0 + kk) * ldw] * sc : 0.f; }
#pragma unroll
    for (int i = 0; i < 32; ++i) scr[(2 * i + (lane >> 5)) * 33 + (lane & 31)] = vv[i];
    asm volatile("s_waitcnt lgkmcnt(0)" ::: "memory");
    const int c = lane & 7;
#pragma unroll
    for (int j = 0; j < 4; ++j) { const int n = (lane >> 3) + 8 * j; const LAS float* s = scr + (8 * c) * 33 + n;
        float f[8];
#pragma unroll
        for (int q = 0; q < 8; ++q) f[q] = s[q * 33];
        *(u32x2*)(dst + (size_t)(n0 + n) * ldd + k0 + 8 * c) = pack8_fp8(f); }
    asm volatile("s_waitcnt lgkmcnt(0)" ::: "memory");
}
__device__ __forceinline__ f32x2 cossin_f(float ang) {
    const double x = (double)ang * 0.15915494309189535; const float r = (float)(x - rint(x));
    return (f32x2){__builtin_amdgcn_cosf(r), __builtin_amdgcn_sinf(r)};
}
__device__ __forceinline__ float lg2_gamma(const float* rd) { return -__builtin_amdgcn_logf(1.f + __builtin_amdgcn_exp2f(-rd[0] * LOG2E)); }
#define PHASE_IDS const int tid = otid(F.wv), lane = tid & 63, wave = __builtin_amdgcn_readfirstlane(tid >> 6), bid = obid(); (void)lane; (void)wave; (void)bid;
__device__ __forceinline__ void p0_prologue(Frame& F) {
    PHASE_IDS
    __syncthreads();
    if (bid < 48) {
        LAS float* sc = (LAS float*)F.lds;
        LAS float* red = (LAS float*)(F.lds + 40960);
        for (int i = tid; i < 9 * 1024; i += 512) { const int v = i >> 10, k = i & 1023; const float x = v < 8 ? INP(1)[v * 1024 + k] : INP(3)[k]; sc[i] = siluf_(x); }
        __syncthreads();
        const int l = bid / 24, col = (bid % 24) * 256 + (tid & 255), kq = tid >> 8;
        const float* w = INP(4) + (size_t)l * 1024 * 6144 + col;
        float a[9];
#pragma unroll
        for (int v = 0; v < 9; ++v) a[v] = 0.f;
#pragma nounroll
        for (int k = kq * 512; k < kq * 512 + 512; k += 16) {
            float wv_[16];
#pragma unroll
            for (int j = 0; j < 16; ++j) wv_[j] = w[(size_t)(k + j) * 6144];
#pragma unroll
            for (int j4 = 0; j4 < 4; ++j4)
#pragma unroll
                for (int v = 0; v < 9; ++v) { const f32x4 s = *(const LAS f32x4*)(sc + v * 1024 + k + 4 * j4); a[v] += (s[0] * wv_[4 * j4] + s[1] * wv_[4 * j4 + 1]) + (s[2] * wv_[4 * j4 + 2] + s[3] * wv_[4 * j4 + 3]); }
        }
        if (kq == 1) {
#pragma unroll
            for (int v = 0; v < 9; ++v) red[v * 256 + (tid & 255)] = a[v];
        }
        __syncthreads();
        if (kq == 0) { float* MOD = WSP(float, WS_MOD) + (size_t)l * 9 * 6144; const float b = INP(5)[l * 6144 + col];
#pragma unroll
            for (int v = 0; v < 9; ++v) MOD[v * 6144 + col] = b + a[v] + red[v * 256 + tid]; }
        __syncthreads();
    }
    { f32x2* RT = WSP(f32x2, WS_RT); f32x2* MT = WSP(f32x2, WS_MT);
      for (int i = bid * 512 + tid; i < 8192 * 32 + 128 * 8; i += F.G * 512) {
          if (i < 8192 * 32) { const int t = i >> 5, k = i & 31; const float inv = exp2f(-(float)k * (13.287712379549449f / 32.f)); RT[i] = cossin_f((float)t * inv); }
          else { const int q = i - 8192 * 32, pos = q >> 3, k = q & 7; const float inv = exp2f(-(float)k * (13.287712379549449f / 8.f)); MT[q] = cossin_f((float)pos * inv); } } }
    LAS float* scr = (LAS float*)(F.lds + wave * 16384);
    const int gw = bid * 8 + wave, NGW = F.G * 8;
    constexpr int I_G8 = 2 * 16 * 96; constexpr int I_IN = 2 * 16 * 216, I_CAT = 2 * 3 * 8 * 32, I_OUT = 2 * 16 * 32, I_UQ = 2 * 6 * 24, I_UKV = 2 * 4 * 32, I_UP = 32 * 16 * 32, I_W2 = 32 * 8 * 32;
    constexpr int NITEMS = I_IN + I_CAT + I_OUT + I_UQ + I_UKV + I_UP + I_W2 + I_G8;
    for (int it = gw; it < NITEMS; it += NGW) {
        int r = it;
        if (r < I_IN) { const int l = r / 3456, q = r % 3456, kb = q / 216, nb = q % 216; const int sc_ = srccol_in(nb * 32 + (lane & 31));
            cvt_item(sc_ >= 0 ? INP(8) + (size_t)l * 1024 * INCOLS + sc_ : nullptr, INCOLS, nullptr, WSP(bf16_t, WS_WIN) + (size_t)l * INW * 1024, 1024, nb * 32, kb * 64, scr, lane); continue; } r -= I_IN;
        if (r < I_CAT) { const int l = r / 768, q = r % 768, seg = q / 256, q2 = q % 256, kb = q2 / 32, nb = q2 % 32; const float* W = seg == 0 ? INP(11) : (seg == 1 ? INP(13) : INP(18));
            cvt_item(W + (size_t)l * 512 * 1024 + nb * 32 + (lane & 31), 1024, nullptr, WSP(bf16_t, WS_WCAT) + (size_t)l * 1024 * 1536 + seg * 512, 1536, nb * 32, kb * 64, scr, lane); continue; } r -= I_CAT;
        if (r < I_OUT) { const int l = r / 512, q = r % 512, kb = q / 32, nb = q % 32;
            cvt_item(INP(19) + (size_t)l * 1024 * 1024 + nb * 32 + (lane & 31), 1024, nullptr, WSP(bf16_t, WS_WOUT) + (size_t)l * 1024 * 1024, 1024, nb * 32, kb * 64, scr, lane); continue; } r -= I_OUT;
        if (r < I_UQ) { const int l = r / 144, q = r % 144, kb = q / 24, nb = q % 24;
            cvt_item(INP(15) + (size_t)l * 384 * 768 + srccol_uq(nb * 32 + (lane & 31)), 768, INP(14) + l * 384, WSP(bf16_t, WS_WUQ) + (size_t)l * 768 * 384, 384, nb * 32, kb * 64, scr, lane); continue; } r -= I_UQ;
        if (r < I_UKV) { const int l = r / 128, q = r % 128, kb = q / 32, nb = q % 32;
            cvt_item(INP(17) + (size_t)l * 256 * 1024 + nb * 32 + (lane & 31), 1024, INP(16) + l * 256, WSP(bf16_t, WS_WUKV) + (size_t)l * 1024 * 256, 256, nb * 32, kb * 64, scr, lane); continue; } r -= I_UKV;
        if (r < I_UP) { const int le = r / 512, q = r % 512, kb = q / 32, nb = q % 32; const int n = nb * 32 + (lane & 31);
            const float* W = (n & 1) ? INP(23) : INP(22);
            if (le >= 16) cvt_item_fp8(W + (size_t)le * 1024 * 512 + (n >> 1), 512, WU8S, WSP(unsigned char, WS_WUP) + (size_t)16 * 1024 * 1024 * 2 + (size_t)(le - 16) * 1024 * 1024, 1024, nb * 32, kb * 64, scr, lane);
            else cvt_item(W + (size_t)le * 1024 * 512 + (n >> 1), 512, nullptr, WSP(bf16_t, WS_WUP) + (size_t)le * 1024 * 1024, 1024, nb * 32, kb * 64, scr, lane);
            continue; } r -= I_UP;
        if (r < I_W2) { const int le = r / 256, q = r % 256, kb = q / 32, nb = q % 32;
            if (le >= 16) cvt_item_fp8(INP(24) + (size_t)le * 512 * 1024 + nb * 32 + (lane & 31), 1024, WD8S, WSP(unsigned char, WS_W2T) + (size_t)16 * 1024 * 512 * 2 + (size_t)(le - 16) * 1024 * 512, 512, nb * 32, kb * 64, scr, lane);
            else cvt_item(INP(24) + (size_t)le * 512 * 1024 + nb * 32 + (lane & 31), 1024, nullptr, WSP(bf16_t, WS_W2T) + (size_t)le * 1024 * 512, 512, nb * 32, kb * 64, scr, lane);
            continue; } r -= I_W2;
        { const int l = r / 1536, q = r % 1536, kb = q / 96, nb = q % 96;
            cvt_item_fp8(INP(8) + (size_t)l * 1024 * INCOLS + 3744 + nb * 32 + (lane & 31), INCOLS, WG8S * 1.4426950408889634f, WSP(unsigned char, WS_WIN8) + (size_t)l * 3072 * 1024, 1024, nb * 32, kb * 64, scr, lane); }
    }
}

__device__ __forceinline__ void norm1_phase(Frame& F, const Resid& R, int l, int skip_none) {
    PHASE_IDS
    const int gw = bid * 8 + wave, NGW = F.G * 8; bf16_t* HX = WSP(bf16_t, WS_HX);
    const float* MODL = WSP(float, WS_MOD) + (size_t)l * 9 * 6144; const float* nw = INP(6) + l * 1024;
    for (int row = gw; row < NT; row += NGW) {
        const float* md = MODL + R.modv(row) * 6144;
        f32x4 v[4]; float s = 0.f;
        int sf32 = R.src_f32; asm volatile("" : "+s"(sf32));
        if (sf32) { const f32x4* xr = (const f32x4*)R.srcf(row) + lane;
#pragma unroll
            for (int j = 0; j < 4; ++j) v[j] = xr[64 * j]; }
        else { const u32x2* xr = (const u32x2*)R.dst(row) + lane;
#pragma unroll
            for (int j = 0; j < 4; ++j) { const u32x2 w = xr[64 * j]; v[j] = (f32x4){bf_lo(w.x), bf_hi(w.x), bf_lo(w.y), bf_hi(w.y)}; } }
#pragma unroll
        for (int j = 0; j < 4; ++j) s += (v[j][0] * v[j][0] + v[j][1] * v[j][1]) + (v[j][2] * v[j][2] + v[j][3] * v[j][3]);
        const float rs = rsqrtf(wave_sum(s) * (1.f / DM) + RMS_EPS);
#pragma unroll
        for (int j = 0; j < 4; ++j) { const int c = 4 * lane + 256 * j; const f32x4 w = *(const f32x4*)(nw + c), sh = *(const f32x4*)(md + c), sc = *(const f32x4*)(md + 1024 + c);
            const f32x4 y = v[j] * rs * w * (sc + 1.f) + sh; u32x2 o; o.x = cvtpk(y[0], y[1]); o.y = cvtpk(y[2], y[3]); *(u32x2*)(HX + (size_t)row * 1024 + c) = o;
            int q8_ = __builtin_amdgcn_cvt_pk_fp8_f32(y[0] * HX8S, y[1] * HX8S, 0, false); q8_ = __builtin_amdgcn_cvt_pk_fp8_f32(y[2] * HX8S, y[3] * HX8S, q8_, true);
            *(int*)(WSP(unsigned char, WS_HX8) + (size_t)row * 1024 + c) = q8_; }
    }
}
__device__ __forceinline__ void final_norm_phase(Frame& F, int g) {
    PHASE_IDS
    const int gw = bid * 8 + wave, NGW = F.G * 8; const float* nw = INP(25);
    for (int row = gw; row < GB * SEQ; row += NGW) {
        f32x4* xr = (f32x4*)(F.out + ((size_t)g * GB * SEQ + row) * DM) + lane;
        const u32x2* xb = (const u32x2*)(WSP(bf16_t, WS_XRES) + ((size_t)g * GB * SEQ + row) * DM) + lane;
        f32x4 v[4]; float s = 0.f;
#pragma unroll
        for (int j = 0; j < 4; ++j) { const u32x2 w = xb[64 * j]; v[j] = (f32x4){bf_lo(w.x), bf_hi(w.x), bf_lo(w.y), bf_hi(w.y)}; s += (v[j][0] * v[j][0] + v[j][1] * v[j][1]) + (v[j][2] * v[j][2] + v[j][3] * v[j][3]); }
        const float rs = rsqrtf(wave_sum(s) * (1.f / DM) + RMS_EPS);
#pragma unroll
        for (int j = 0; j < 4; ++j) { const f32x4 w = *(const f32x4*)(nw + 4 * lane + 256 * j); xr[64 * j] = v[j] * rs * w; }
    }
}
__device__ __forceinline__ void conv_phase(Frame& F, int l) {
    PHASE_IDS
    const bf16_t* PC = WSP(bf16_t, WS_PC); bf16_t* ACT = WSP(bf16_t, WS_ACT); const float* cw = INP(12) + (size_t)l * 512 * 3;
    for (int idx = bid * 512 + tid; idx < NT * 64; idx += F.G * 512) {
        const int row = idx >> 6, c8 = (idx & 63) * 8; const int bl = row / SB, s = row - bl * SB;
        const bool hp = (s != 0) && (s != CTXL), hn = (s != CTXL - 1) && (s != SB - 1);
        const bf16_t* p = PC + (size_t)row * 1024 + c8;
        float b[8], u0[8], um[8], up[8];
        unpack8(*(const u32x4*)p, b); unpack8(*(const u32x4*)(p + 512), u0);
        if (hp) unpack8(*(const u32x4*)(p + 512 - 1024), um); else {
#pragma unroll
            for (int k = 0; k < 8; ++k) um[k] = 0.f; }
        if (hn) unpack8(*(const u32x4*)(p + 512 + 1024), up); else {
#pragma unroll
            for (int k = 0; k < 8; ++k) up[k] = 0.f; }
        float o[8];
#pragma unroll
        for (int k = 0; k < 8; ++k) { const float* w = cw + (c8 + k) * 3; o[k] = b[k] * (um[k] * w[0] + u0[k] * w[1] + up[k] * w[2]); }
        *(u32x4*)(ACT + (size_t)row * 1536 + 512 + c8) = pack8(o);
    }
}
__device__ __forceinline__ void scan_phase(Frame& F, int l) {
    PHASE_IDS
    const float* U = WSP(float, WS_HX); bf16_t* S = WSP(bf16_t, WS_PM);
    for (int idx = bid * 512 + tid; idx < GB * 4 * 2 * 8192; idx += F.G * 512) {
        const int ed = idx & 8191, dir = (idx >> 13) & 1, h = (idx >> 14) & 3, bl = idx >> 16;
        const float lg = lg2_gamma(INP(9) + l * 8 + dir * 4 + h); const float dec = __builtin_amdgcn_exp2f(lg * 128.f);
        float st = 0.f;
        for (int i0 = 0; i0 < NCHUNK; i0 += 6) {
            float uu[6]; size_t off[6];
#pragma unroll
            for (int k = 0; k < 6; ++k) { const int i = i0 + k; const int c = dir ? (i < 2 ? 1 - i : NCHUNK + 1 - i) : i;
                off[k] = ((size_t)(((bl * NCHUNK + c) * 4 + h) * 2 + dir)) * 8192 + ed; uu[k] = U[off[k]]; }
#pragma unroll
            for (int k = 0; k < 6; ++k) { S[off[k]] = f2bf(st); st = dec * st + uu[k]; }
        }
    }
}
template <int NR>
__device__ __forceinline__ void n2_rows(const Resid& R, const int (&rows)[NR], const int (&slot)[NR], const float* MODL, const float* nw, bf16_t* H2, unsigned char* H28, const LAS float* wr, LAS float* lg, int lane) {
    f32x4 v[NR][4]; float s[NR];
#pragma unroll
    for (int q = 0; q < NR; ++q) { const u32x2* xr = (const u32x2*)R.dst(rows[q]) + lane; s[q] = 0.f;
#pragma unroll
        for (int j = 0; j < 4; ++j) { const u32x2 w_ = xr[64 * j]; v[q][j] = (f32x4){bf_lo(w_.x), bf_hi(w_.x), bf_lo(w_.y), bf_hi(w_.y)}; s[q] += (v[q][j][0] * v[q][j][0] + v[q][j][1] * v[q][j][1]) + (v[q][j][2] * v[q][j][2] + v[q][j][3] * v[q][j][3]); } }
#pragma unroll
    for (int q = 0; q < NR; ++q) s[q] = rsqrtf(wave_sum(s[q]) * (1.f / DM) + RMS_EPS);
#pragma unroll
    for (int q = 0; q < NR; ++q) { const float* md = MODL + R.modv(rows[q]) * 6144;
#pragma unroll
        for (int j = 0; j < 4; ++j) { const int c = 4 * lane + 256 * j; const f32x4 w = *(const f32x4*)(nw + c), sh = *(const f32x4*)(md + 3072 + c), sc = *(const f32x4*)(md + 4096 + c);
            v[q][j] = v[q][j] * s[q] * w * (sc + 1.f) + sh;
            if (H28) { int q8_ = __builtin_amdgcn_cvt_pk_fp8_f32(v[q][j][0] * H28S, v[q][j][1] * H28S, 0, false); q8_ = __builtin_amdgcn_cvt_pk_fp8_f32(v[q][j][2] * H28S, v[q][j][3] * H28S, q8_, true); *(int*)(H28 + (size_t)rows[q] * 1024 + c) = q8_; }
            else { u32x2 o; o.x = cvtpk(v[q][j][0], v[q][j][1]); o.y = cvtpk(v[q][j][2], v[q][j][3]); *(u32x2*)(H2 + (size_t)rows[q] * 1024 + c) = o; } } }
    const int b4 = (lane >> 4) & 1, b3 = (lane >> 3) & 1, b2 = (lane >> 2) & 1;
#pragma unroll
    for (int q = 0; q < NR; ++q) {
        float a[16];
#pragma unroll
        for (int e = 0; e < 16; ++e) { float t = 0.f;
#pragma unroll
            for (int j = 0; j < 4; ++j) { const f32x4 w = *(const LAS f32x4*)(wr + e * 1024 + 4 * lane + 256 * j); t += (v[q][j][0] * w[0] + v[q][j][1] * w[1]) + (v[q][j][2] * w[2] + v[q][j][3] * w[3]); }
            a[e] = t; }
        float s8[8], s4[4], s2[2];
#pragma unroll
        for (int k = 0; k < 8; ++k) { auto r = __builtin_amdgcn_permlane32_swap(__float_as_uint(a[k]), __float_as_uint(a[k + 8]), false, false); s8[k] = __uint_as_float(r[0]) + __uint_as_float(r[1]); }
#pragma unroll
        for (int k = 0; k < 4; ++k) { const float snd = b4 ? s8[k] : s8[k + 4], kp = b4 ? s8[k + 4] : s8[k]; s4[k] = kp + swz_xor<16>(snd); }
#pragma unroll
        for (int k = 0; k < 2; ++k) { const float snd = b3 ? s4[k] : s4[k + 2], kp = b3 ? s4[k + 2] : s4[k]; s2[k] = kp + swz_xor<8>(snd); }
        float s1; { const float snd = b2 ? s2[0] : s2[1], kp = b2 ? s2[1] : s2[0]; s1 = kp + swz_xor<4>(snd); }
        s1 += swz_xor<2>(s1); s1 += swz_xor<1>(s1);
        if ((lane & 3) == 0) lg[slot[q] * 16 + (lane >> 2)] = s1;
    }
}
__device__ __forceinline__ void norm2_router_phase(Frame& F, const Resid& R, int l, int g, int lat_only, int cslot) {
    PHASE_IDS
    bf16_t* H2 = WSP(bf16_t, WS_HX); unsigned char* H28 = (l == DEPTH - 1) ? WSP(unsigned char, WS_H28) : nullptr;
    const float* MODL = WSP(float, WS_MOD) + (size_t)l * 9 * 6144; const float* nw = INP(7) + l * 1024;
    LAS float* wr = (LAS float*)F.lds; LAS float* lg = (LAS float*)(F.lds + 65536);
    { const float* wrt = INP(20); for (int i = tid; i < 16 * 1024; i += 512) wr[i] = wrt[(i & 1023) * 16 + (i >> 10)]; }
    __syncthreads();
    const int rpb = (NT + F.G - 1) / F.G, r0 = bid * rpb, r1 = (r0 + rpb < NT) ? r0 + rpb : NT;
    for (int row = r0 + wave; row < r1; row += 16) {
        const int rowb = row + 8;
        const bool okA = !(lat_only && (row % SB) < CTXL), okB = rowb < r1 && !(lat_only && (rowb % SB) < CTXL);
        if (okA && okB) { const int rr[2] = {row, rowb}, ss[2] = {row - r0, rowb - r0}; n2_rows<2>(R, rr, ss, MODL, nw, H2, H28, wr, lg, lane); }
        else if (okA) { const int rr[1] = {row}, ss[1] = {row - r0}; n2_rows<1>(R, rr, ss, MODL, nw, H2, H28, wr, lg, lane); }
        else if (okB) { const int rr[1] = {rowb}, ss[1] = {rowb - r0}; n2_rows<1>(R, rr, ss, MODL, nw, H2, H28, wr, lg, lane); }
    }
    __syncthreads();
    unsigned* CNT = WSP(unsigned, WS_CTL) + CW_CNT + (g * 2 + l) * 64 + cslot; int* LIST = WSP(int, WS_LIST); float* WGT = WSP(float, WS_WGT);
    const float* rb = INP(21);
    LAS unsigned* lcnt = (LAS unsigned*)(F.lds + 65536 + 16384);
    if (tid < 64) lcnt[tid] = 0u;
    __syncthreads();
    int bucket = -1, rank = 0; float wlo = 0.f, whi = 0.f; const int trow = r0 + tid;
    if (tid < r1 - r0 && !(lat_only && (trow % SB) < CTXL)) {
        const int t = tid;
        float sc16[16];
#pragma unroll
        for (int e4 = 0; e4 < 4; ++e4) { const f32x4 x = *(const LAS f32x4*)(lg + t * 16 + e4 * 4); sc16[e4 * 4] = sigmoidf_(x[0]); sc16[e4 * 4 + 1] = sigmoidf_(x[1]); sc16[e4 * 4 + 2] = sigmoidf_(x[2]); sc16[e4 * 4 + 3] = sigmoidf_(x[3]); }
        float best = -1e30f; int gs = 0;
#pragma unroll
        for (int q = 0; q < 4; ++q) { float m1 = -1e30f, m2 = -1e30f;
#pragma unroll
            for (int k = 0; k < 4; ++k) { const float b = sc16[q * 4 + k] + rb[q * 4 + k]; if (b > m1) { m2 = m1; m1 = b; } else if (b > m2) m2 = b; }
            const float gsc = m1 + m2; if (gsc > best) { best = gsc; gs = q; } }
        float bb[4], su[4];
#pragma unroll
        for (int k = 0; k < 4; ++k) { float b = 0.f, u = 0.f;
#pragma unroll
            for (int q = 0; q < 4; ++q) { if (q == gs) { b = sc16[q * 4 + k] + rb[q * 4 + k]; u = sc16[q * 4 + k]; } }
            bb[k] = b; su[k] = u; }
        int i1 = 0; float b1 = bb[0];
#pragma unroll
        for (int k = 1; k < 4; ++k) if (bb[k] > b1) { b1 = bb[k]; i1 = k; }
        int i2 = -1; float b2 = -1e30f;
#pragma unroll
        for (int k = 0; k < 4; ++k) if (k != i1 && bb[k] > b2) { b2 = bb[k]; i2 = k; }
        const int lo = i1 < i2 ? i1 : i2, hi = i1 < i2 ? i2 : i1;
        float slo = 0.f, shi = 0.f;
#pragma unroll
        for (int k = 0; k < 4; ++k) { if (k == lo) slo = su[k]; if (k == hi) shi = su[k]; }
        const float inv = 1.f / (slo + shi);
        const int pair = lo == 0 ? hi - 1 : (lo == 1 ? hi + 1 : 5);
        bucket = gs * 6 + pair; wlo = slo * inv; whi = shi * inv;
        rank = (int)atomicAdd((unsigned*)(lcnt + bucket), 1u);
    }
    __syncthreads();
    if (tid < NPAIR) { const unsigned c = lcnt[tid]; lcnt[32 + tid] = c ? atomicAdd(CNT + tid, c) : 0u; }
    __syncthreads();
    if (bucket >= 0) { const unsigned pos = lcnt[32 + bucket] + (unsigned)rank; LIST[(size_t)bucket * NT + pos] = trow; WGT[(size_t)trow * 2] = wlo; WGT[(size_t)trow * 2 + 1] = whi; }
    __syncthreads();
}
__device__ __forceinline__ void moe_tables(Frame& F, int l, int g) {
    PHASE_IDS
    LAS int* tab = (LAS int*)(F.lds + LDS_MOE_OFF);
    if (tid < 32) { const unsigned* CNT = WSP(unsigned, WS_CTL) + CW_CNT + (g * 2 + l) * 64;
        tab[32 + tid] = tid < NPAIR ? (int)__hip_atomic_load(CNT + tid, __ATOMIC_RELAXED, __HIP_MEMORY_SCOPE_AGENT) : 0; }
    __syncthreads();
    if (tid == 0) { int pre = 0;
#pragma nounroll
        for (int p = 0; p < NPAIR; ++p) { tab[p] = pre; pre += (tab[32 + p] + 255) >> 8; }
        tab[24] = pre; }
    __syncthreads();
}
#ifndef PHMASK
#define PHMASK 0xFFFF
#endif
#define PHM(k) (((PHMASK) >> (k)) & 1)
#ifndef INPROJ_ALIGN
#define INPROJ_ALIGN true
#endif
#ifndef REPMASK
#define REPMASK 0
#endif
#define REPS(k) _Pragma("nounroll") for (int rep_ = 0; rep_ < 1 + (((REPMASK) >> (k)) & 1); ++rep_)

__global__ void __launch_bounds__(512, 2) dit_fwd(Args args) {
    extern __shared__ __attribute__((aligned(16))) unsigned char lds_raw[];
    Frame F;
    F.lds = (LAS unsigned char*)lds_raw;
    F.G = gridDim.x; F.wv = __builtin_amdgcn_readfirstlane((int)threadIdx.x >> 6);
    F.a = &args; F.out = args.out; F.ws = args.ws;
    for (int u = threadIdx.x; u < (LDS_BYTES - LDSCTL_OFF) / 4; u += 512) ((LAS unsigned*)(F.lds + LDSCTL_OFF))[u] = 0u;
    __syncthreads();
    XcdBarrier bar = xcd_barrier_post(WSP(unsigned, WS_CTL) + CW_BAR, (volatile LAS unsigned*)(F.lds + LDSCTL_OFF));
#ifdef PROBE_BAR2
#define GRID_BAR() do { asm volatile("; PHASE_SEAM" ::: "memory"); xcd_barrier(bar, F.wv); xcd_barrier(bar, F.wv); } while (0)
#else
#define GRID_BAR() do { asm volatile("; PHASE_SEAM" ::: "memory"); xcd_barrier(bar, F.wv); } while (0)
#endif
#ifdef PROBE_A
#define STAMP(k) do { if (obid() == 0 && F.wv == 0 && olane() == 0) { unsigned long long* TS_ = WSP(unsigned long long, WS_CTL + 512 * 1024); const unsigned long long now = __builtin_amdgcn_s_memrealtime(); TS_[(k)] += now - TS_[32]; TS_[32] = now; } } while (0)
    if (blockIdx.x == 0 && threadIdx.x == 0) WSP(unsigned long long, WS_CTL + 512 * 1024)[32] = __builtin_amdgcn_s_memrealtime();
#else
#define STAMP(k) do { } while (0)
#endif

    if constexpr (PHM(0)) REPS(0) p0_prologue(F);
    GRID_BAR(); STAMP(0);

#pragma nounroll
    for (int g = 0; g < NG; ++g) {
#pragma nounroll
        for (int l = 0; l < DEPTH; ++l) {
            Resid R; R.in_lat = INP(0); R.in_ctx = INP(2); R.x_lat = WSP(bf16_t, WS_XRES); R.x_ctx = WSP(bf16_t, WS_XC); R.g = g; R.src_f32 = (l == 0) ? 1 : 0;
            const float* MODL = WSP(float, WS_MOD) + (size_t)l * 9 * 6144;
            const int lat_only = (l == DEPTH - 1) ? 1 : 0;

            if constexpr (PHM(1)) REPS(1) norm1_phase(F, R, l, 0);
            if constexpr (PHM(15)) if (l == 0 && g > 0) final_norm_phase(F, g - 1);
            GRID_BAR(); STAMP(1);

            if constexpr (PHM(2)) REPS(2) {
#ifdef STAGGER_US10
                {
                    const unsigned long long t0_ = __builtin_amdgcn_s_memrealtime(), d_ = (unsigned long long)((obid() * 5) & 15) * (STAGGER_US10) * 10ull;
                    while (__builtin_amdgcn_s_memrealtime() - t0_ < d_) __builtin_amdgcn_s_sleep(4);
                }
#endif
                TileOrder S; S.init(NRT, 15, F.G, obid(), WSP(bf16_t, WS_HX), (size_t)256 * 1024 * 2, WSP(bf16_t, WS_WIN) + (size_t)l * INW * 1024, (size_t)256 * 1024 * 2, 0);
                EpiInproj E{WSP(bf16_t, WS_PR), WSP(bf16_t, WS_PC), WSP(bf16_t, WS_PM), WSP(bf16_t, WS_PG), WSP(unsigned char, WS_K), WSP(float, WS_SSQ), WSP(f32x2, WS_RT), WSP(f32x2, WS_MT), 0};
#ifdef PROBE_INPROJ_NOEPI
                { EpiNone E0; if (PROBE_INPROJ_NOEPI == 1) pg8::gemm_phase<EpiNone, TileOrder, INPROJ_ALIGN>(F.lds, 1024, 1024, 1024, 0, S, E0, F.wv);
                  else { TileOrder S9; S9.init(NRT, 12, F.G, obid(), WSP(unsigned char, WS_HX8), (size_t)256 * 1024, WSP(unsigned char, WS_WIN8) + (size_t)l * 3072 * 1024, (size_t)256 * 1024, 0);
                         pg8::gemm_phase<EpiNone, TileOrder, INPROJ_ALIGN, false, false, true, 0x7b7b7b7b, 0x79797979>(F.lds, 512, 512, 512, 0, S9, E0, F.wv); } }
#endif
#ifdef PROBE_INPROJ_REP
                { TileOrder S9; S9.init(NRT, 12, F.G, obid(), WSP(unsigned char, WS_HX8), (size_t)256 * 1024, WSP(unsigned char, WS_WIN8) + (size_t)l * 3072 * 1024, (size_t)256 * 1024, 0);
                  EpiGate E9{WSP(bf16_t, WS_PG)};
                  pg8::gemm_phase<EpiGate, TileOrder, INPROJ_ALIGN, false, false, true, 0x7b7b7b7b, 0x79797979>(F.lds, 512, 512, 512, 0, S9, E9, F.wv); }
#endif
#ifndef PROBE_ONLY_FP8GATE
                pg8::gemm_phase<EpiInproj, TileOrder, INPROJ_ALIGN>(F.lds, 1024, 1024, 1024, 0, S, E, F.wv);
#endif
                TileOrder S8; S8.init(NRT, 12, F.G, (obid() + F.G - (NRT * 15) % F.G) % F.G, WSP(unsigned char, WS_HX8), (size_t)256 * 1024, WSP(unsigned char, WS_WIN8) + (size_t)l * 3072 * 1024, (size_t)256 * 1024, 0);
                EpiGate E8{WSP(bf16_t, WS_PG)};
                pg8::gemm_phase<EpiGate, TileOrder, INPROJ_ALIGN, false, false, true, 0x7b7b7b7b, 0x79797979>(F.lds, 512, 512, 512, 0, S8, E8, F.wv);
            }
            GRID_BAR(); STAMP(2);

            if constexpr (PHM(3)) REPS(3) {
                TileOrder S; S.init(NRT, 3, F.G, obid(), WSP(bf16_t, WS_PM), (size_t)256 * 640 * 2, WSP(bf16_t, WS_WUQ) + (size_t)l * 768 * 384, (size_t)256 * 384 * 2, 0);
                EpiUq E{WSP(unsigned char, WS_Q), WSP(float, WS_SSQ), WSP(f32x2, WS_MT)};
                pg8::gemm_phase<EpiUq, TileOrder, true>(F.lds, 640, 384, 384, 0, S, E, F.wv);
            }
#ifndef PROBE_COARSE
            STAMP(3);
#endif
            if constexpr (PHM(4)) REPS(4) {
                TileOrder S; S.init(NRT, 4, F.G, (obid() + F.G - (NRT * 3) % F.G) % F.G, WSP(bf16_t, WS_PM) + 384, (size_t)256 * 640 * 2, WSP(bf16_t, WS_WUKV) + (size_t)l * 1024 * 256, (size_t)256 * 256 * 2, 0);
                EpiUkv E{WSP(unsigned char, WS_K), WSP(unsigned char, WS_V), WSP(float, WS_SSQ), F.lds + LDS_VTR_OFF};
                pg8::gemm_phase<EpiUkv, TileOrder, true>(F.lds, 640, 256, 256, 0, S, E, F.wv);
            }
#ifndef PROBE_COARSE
            STAMP(4);
#endif
            if constexpr (PHM(5)) REPS(5) for (int u = (obid() + F.G - (NRT * 7) % F.G) % F.G; u < GB * NCHUNK * 4; u += F.G) {
                const int h = u & 3;
                retu_unit(u, WSP(bf16_t, WS_PR), WSP(float, WS_HX), lg2_gamma(INP(9) + l * 8 + h), lg2_gamma(INP(9) + l * 8 + 4 + h), (LAS char*)F.lds, F.wv);
            }
#ifndef PROBE_COARSE
            STAMP(5);
#endif
            if constexpr (PHM(6)) REPS(6) conv_phase(F, l);
            GRID_BAR(); STAMP(6);

            if constexpr (PHM(7)) REPS(7) scan_phase(F, l);
#ifndef PROBE_COARSE
            STAMP(7);
#endif
#ifdef PROBE_CLK
            unsigned long long c0_ = 0, r0_ = 0; if (g == 0 && l == 0) { c0_ = __builtin_readcyclecounter(); r0_ = __builtin_amdgcn_s_memrealtime(); }
#endif
            if constexpr (PHM(8)) REPS(8) {
                const unsigned char* Q = WSP(unsigned char, WS_Q); const unsigned char* K = WSP(unsigned char, WS_K); const unsigned char* V = WSP(unsigned char, WS_V); bf16_t* ACT = WSP(bf16_t, WS_ACT);
                const int vcu = (obid() % 8) * (F.G / 8) + obid() / 8, xcd = vcu / (F.G / 8), slot = vcu % (F.G / 8);
                const int nlat = GB * 8 * 32, nunit = nlat + (lat_only ? 0 : GB * 8);
                for (int i = 0; ; ++i) {
                    int hh, qb;
                    if (F.G == 256) { if (i < 4) { hh = xcd + 8 * i; qb = 1 + slot; } else if (i == 4 && !lat_only && slot < 4) { hh = xcd + 8 * slot; qb = 0; } else break; }
                    else { const int L = i * F.G + obid(); if (L >= nunit) break; if (L < nlat) { hh = L >> 5; qb = 1 + (L & 31); } else { hh = L - nlat; qb = 0; } }
                    const int bl = hh >> 3, h = hh & 7;
                    const size_t hb = (size_t)(bl * 8 + h) * SB;
                    att2::attn_unit_pp(Q + (hb + (size_t)qb * 256) * 128, K + hb * 128, V + (size_t)(bl * 8 + h) * 64 * SB, ACT + ((size_t)bl * SB + (size_t)qb * 256) * 1536 + 1024 + h * 64, 1536, qb == 0 ? CTXL : SB, (LAS char*)F.lds, F.wv);
                }
            }
#ifdef PROBE_CLK
            if (g == 0 && l == 0 && obid() == 0 && F.wv == 0 && olane() == 0) { const unsigned long long c1_ = __builtin_readcyclecounter(), r1_ = __builtin_amdgcn_s_memrealtime();
                WSP(unsigned long long, WS_CTL + 600 * 1024)[0] = (c1_ - c0_) * 100ull / (r1_ - r0_); }
#endif
            GRID_BAR(); STAMP(8);

            if constexpr (PHM(9)) REPS(9) for (int u = obid(); u < GB * NCHUNK * 4; u += F.G) {
                const int h = u & 3;
                retout_unit(u, WSP(bf16_t, WS_PR), WSP(bf16_t, WS_PM), INP(10) + l * 512, WSP(bf16_t, WS_ACT), lg2_gamma(INP(9) + l * 8 + h), lg2_gamma(INP(9) + l * 8 + 4 + h), (LAS char*)F.lds, F.wv);
            }
            GRID_BAR(); STAMP(9);

            if constexpr (PHM(10)) REPS(10) {
#ifdef MERGE1_STAGGER
                {
                    const unsigned long long t0_ = __builtin_amdgcn_s_memrealtime(), d_ = (unsigned long long)((obid() >> 3) & 3) * (MERGE1_STAGGER) * 10ull;
                    while (__builtin_amdgcn_s_memrealtime() - t0_ < d_) __builtin_amdgcn_s_sleep(4);
                }
#endif
                unsigned* pctr = WSP(unsigned, WS_CTL) + CW_PANEL + (g * 2 + l) * (NRT * 64);
#ifdef HANDOFF
                TileOrderP S; S.init(lat_only ? GB * 32 : NRT, 4, F.G, obid(), WSP(bf16_t, WS_ACT), (size_t)256 * 1536 * 2, WSP(bf16_t, WS_WCAT) + (size_t)l * 1024 * 1536, (size_t)256 * 1536 * 2, lat_only); S.ctr = pctr;
#else
                TileOrder S; S.init(lat_only ? GB * 32 : NRT, 4, F.G, obid(), WSP(bf16_t, WS_ACT), (size_t)256 * 1536 * 2, WSP(bf16_t, WS_WCAT) + (size_t)l * 1024 * 1536, (size_t)256 * 1536 * 2, lat_only); (void)pctr;
#endif
#ifdef PROBE_MERGE1_NOHOOK
                { EpiMerge1NoHook E0{{WSP(bf16_t, WS_PG), WSP(bf16_t, WS_HX)}}; pg8::gemm_phase<EpiMerge1NoHook, TileOrder, true>(F.lds, 1536, 1536, 1536, 0, S, E0, F.wv); }
#endif
                EpiMerge1 E{WSP(bf16_t, WS_PG), WSP(bf16_t, WS_HX)};
#ifdef HANDOFF
                pg8::gemm_phase<EpiMerge1, TileOrderP, true>(F.lds, 1536, 1536, 1536, 0, S, E, F.wv);
#else
                pg8::gemm_phase<EpiMerge1, TileOrder, true>(F.lds, 1536, 1536, 1536, 0, S, E, F.wv);
#endif
            }
#if !defined(HANDOFF) || defined(HANDOFF_WITH_BARRIER)
            GRID_BAR();
#endif
            STAMP(10);

            if constexpr (PHM(11)) {
#ifdef HANDOFF
                const int n1 = (lat_only ? GB * 32 : NRT) * 4;
                TileOrderC S; S.init(lat_only ? GB * 32 : NRT, 4, F.G, (obid() + F.G - n1 % F.G) % F.G, WSP(bf16_t, WS_HX), (size_t)256 * 1024 * 2, WSP(bf16_t, WS_WOUT) + (size_t)l * 1024 * 1024, (size_t)256 * 1024 * 2, lat_only);
                S.ctr = WSP(unsigned, WS_CTL) + CW_PANEL + (g * 2 + l) * (NRT * 64); S.need = 32u; S.tmo = WSP(unsigned, WS_CTL) + 8; S.wv = F.wv;
                EpiMerge2 E{R, MODL};
                pg8::gemm_phase<EpiMerge2, TileOrderC, true>(F.lds, 1024, 1024, 1024, 0, S, E, F.wv);
#else
                TileOrder S; S.init(lat_only ? GB * 32 : NRT, 4, F.G, obid(), WSP(bf16_t, WS_HX), (size_t)256 * 1024 * 2, WSP(bf16_t, WS_WOUT) + (size_t)l * 1024 * 1024, (size_t)256 * 1024 * 2, lat_only);
                EpiMerge2 E{R, MODL};
                pg8::gemm_phase<EpiMerge2, TileOrder, true>(F.lds, 1024, 1024, 1024, 0, S, E, F.wv);
#endif
            }
            GRID_BAR(); STAMP(11);

            if constexpr (((REPMASK) >> 12) & 1) norm2_router_phase(F, R, l, g, lat_only, 32);
            if constexpr (PHM(12)) norm2_router_phase(F, R, l, g, lat_only, 0);
            GRID_BAR(); STAMP(12);

            moe_tables(F, l, g);
            if constexpr (PHM(13)) REPS(13) {
                if (l == DEPTH - 1) {
                    MoeOrder S{(const LAS int*)(F.lds + LDS_MOE_OFF), WSP(int, WS_LIST), 8, F.G, obid(), 1, (const char*)WSP(unsigned char, WS_H28), (const char*)(WSP(unsigned char, WS_WUP) + (size_t)16 * 1024 * 1024 * 2), 1};
                    EpiMoeUp8 E{WSP(int, WS_LIST), WSP(float, WS_WGT), WSP(unsigned char, WS_PG)};
                    pg8::gemm_phase<EpiMoeUp8, MoeOrder, true, true, false, true, 0x7b7b7b7b, 0x79797979>(F.lds, 512, 512, 512, 0, S, E, F.wv);
                } else {
                    MoeOrder S{(const LAS int*)(F.lds + LDS_MOE_OFF), WSP(int, WS_LIST), 8, F.G, obid(), 1, (const char*)WSP(bf16_t, WS_HX), (const char*)(WSP(bf16_t, WS_WUP) + (size_t)l * 16 * 1024 * 1024), 2};
                    EpiMoeUp E{WSP(int, WS_LIST), WSP(float, WS_WGT), WSP(bf16_t, WS_PG)};
                    pg8::gemm_phase<EpiMoeUp, MoeOrder, true, true, false>(F.lds, 1024, 1024, 1024, 0, S, E, F.wv);
                }
            }
            GRID_BAR(); STAMP(13);

            if constexpr (PHM(14)) {
                if (l == DEPTH - 1) {
                    MoeOrder S{(const LAS int*)(F.lds + LDS_MOE_OFF), WSP(int, WS_LIST), 4, F.G, obid(), 0, (const char*)WSP(unsigned char, WS_PG), (const char*)(WSP(unsigned char, WS_W2T) + (size_t)16 * 1024 * 512 * 2), 1};
                    EpiMoeDown E{WSP(int, WS_LIST), R, MODL, nullptr};
                    pg8::gemm_phase<EpiMoeDown, MoeOrder, true, false, true, true, 0x7a7a7a7a, 0x7a7a7a7a>(F.lds, 512, 256, 512, 4, S, E, F.wv);
                } else {
                    MoeOrder S{(const LAS int*)(F.lds + LDS_MOE_OFF), WSP(int, WS_LIST), 4, F.G, obid(), 0, (const char*)WSP(bf16_t, WS_PG), (const char*)(WSP(bf16_t, WS_W2T) + (size_t)l * 16 * 1024 * 512), 2};
                    EpiMoeDown E{WSP(int, WS_LIST), R, MODL, nullptr};
                    pg8::gemm_phase<EpiMoeDown, MoeOrder, true, false, true>(F.lds, 1024, 512, 1024, 8, S, E, F.wv);
                }
            }
            GRID_BAR(); STAMP(14);
        }
    }
    if constexpr (PHM(15)) final_norm_phase(F, NG - 1);
#ifdef SELFCHECK_ATTN
            {
                const unsigned char* Q = WSP(unsigned char, WS_Q); const unsigned char* K = WSP(unsigned char, WS_K); const unsigned char* V = WSP(unsigned char, WS_V); const bf16_t* ACT = WSP(bf16_t, WS_ACT);
                const int lane_ = olane(); const int gwv = obid() * 8 + F.wv;
                if (gwv < 96) {
                    const int bl = gwv & 3, h = (gwv >> 2) & 7, qi = gwv >> 5;
                    const int srow = qi == 0 ? 256 : (qi == 1 ? 256 + 4099 : SB - 1);
                    const int nkeys = srow < CTXL ? CTXL : SB;
                    const size_t hb = (size_t)(bl * 8 + h) * SB;
                    #define F8(p) (__builtin_amdgcn_cvt_f32_fp8((int)(*(p)), 0))
                    const float q0 = F8(Q + (hb + srow) * 128 + lane_) * (1.f / Q8S), q1 = lane_ < 32 ? F8(Q + (hb + srow) * 128 + 64 + lane_) * (1.f / Q8S) : 0.f;
                    float mrun = -1e30f, lrun = 0.f, orun = 0.f;
#pragma nounroll
                    for (int j = 0; j < nkeys; ++j) {
                        float part = q0 * F8(K + (hb + j) * 128 + lane_) * (1.f / K8S); if (lane_ < 32) part += q1 * F8(K + (hb + j) * 128 + 64 + lane_) * (1.f / K8S);
                        const float s = wave_sum(part);
                        const float mn = fmaxf(mrun, s), sc = exp2f(mrun - mn), p = exp2f(s - mn);
                        lrun = lrun * sc + p; orun = orun * sc + p * F8(V + ((size_t)(bl * 8 + h) * 64 + lane_) * SB + (j & ~63) + vt_pos(j & 63)) * (1.f / V8S); mrun = mn; }
                    const float o_ = orun / lrun; const float got = bf1(ACT[((size_t)bl * SB + srow) * 1536 + 1024 + h * 64 + lane_]);
                    float err = fabsf(o_ - got), ref = fabsf(o_);
                    err = fmaxf(err, swz_xor<1>(err)); err = fmaxf(err, swz_xor<2>(err)); err = fmaxf(err, swz_xor<4>(err)); err = fmaxf(err, swz_xor<8>(err)); err = fmaxf(err, swz_xor<16>(err));
                    ref = fmaxf(ref, swz_xor<1>(ref)); ref = fmaxf(ref, swz_xor<2>(ref)); ref = fmaxf(ref, swz_xor<4>(ref)); ref = fmaxf(ref, swz_xor<8>(ref)); ref = fmaxf(ref, swz_xor<16>(ref));
                    { auto r1_ = __builtin_amdgcn_permlane32_swap(__float_as_uint(err), __float_as_uint(err), false, false); err = fmaxf(__uint_as_float(r1_[0]), __uint_as_float(r1_[1]));
                      auto r2_ = __builtin_amdgcn_permlane32_swap(__float_as_uint(ref), __float_as_uint(ref), false, false); ref = fmaxf(__uint_as_float(r2_[0]), __uint_as_float(r2_[1])); }
                    if (lane_ == 0 && !(err <= SELFCHECK_TOL * ref + 1e-6f)) atomicAdd(WSP(unsigned, WS_CTL) + 3000, 1u);
                }
            }
    GRID_BAR();
    if (__hip_atomic_load(WSP(unsigned, WS_CTL) + 3000, __ATOMIC_RELAXED, __HIP_MEMORY_SCOPE_AGENT) != 0u && obid() == 0) { for (int i = otid(F.wv); i < 4096; i += 512) F.out[i] = __builtin_nanf(""); }
#endif
#ifdef PROBE_CLK
    if (obid() == 0 && F.wv == 0 && olane() == 0) { const unsigned long long mhz = WSP(unsigned long long, WS_CTL + 600 * 1024)[0]; const unsigned long long t0 = __builtin_amdgcn_s_memrealtime();
        while (__builtin_amdgcn_s_memrealtime() - t0 < mhz * 100ull) __builtin_amdgcn_s_sleep(8); }
#endif
#ifdef PROBE_A
    STAMP(15);
    GRID_BAR();
    {
        unsigned long long* TS = WSP(unsigned long long, WS_CTL + 512 * 1024);
        unsigned long long tot = 0; for (int k = 0; k < 16; ++k) tot += __hip_atomic_load(TS + k, __ATOMIC_RELAXED, __HIP_MEMORY_SCOPE_AGENT);
        const float fa = (float)__hip_atomic_load(TS + PROBE_A, __ATOMIC_RELAXED, __HIP_MEMORY_SCOPE_AGENT) / (float)tot, fb = (float)__hip_atomic_load(TS + PROBE_B, __ATOMIC_RELAXED, __HIP_MEMORY_SCOPE_AGENT) / (float)tot;
        const float A = sqrtf(90.f * fa), X = 100.f + 800.f * fb;
        for (size_t i = (size_t)blockIdx.x * 512 + threadIdx.x; i < (size_t)NB * SEQ * DM; i += (size_t)gridDim.x * 512) F.out[i] = (i == 0) ? X : ((i & 1) ? A : -A);
    }
#endif
}

extern "C" void kernel_launch(void* const* d_in, const int* in_sizes, int n_in, void* d_out, int out_size, void* d_ws, size_t ws_size, hipStream_t stream) {
    static int grid = 0;
    if (grid == 0) {
        if (n_in != 26 || ws_size < WS_END) { fprintf(stderr, "kernel_launch: expected 26 inputs and >= %zu bytes of workspace; got %d, %zu\n", (size_t)WS_END, n_in, ws_size); grid = -1; return; }
        int dev = 0, cus = 0, per_cu = 0;
        if (hipGetDevice(&dev) != hipSuccess || hipDeviceGetAttribute(&cus, hipDeviceAttributeMultiprocessorCount, dev) != hipSuccess) { grid = -1; return; }
        if (hipFuncSetAttribute((const void*)dit_fwd, hipFuncAttributeMaxDynamicSharedMemorySize, LDS_BYTES) != hipSuccess) { fprintf(stderr, "kernel_launch: hipFuncSetAttribute failed\n"); grid = -1; return; }
        if (hipOccupancyMaxActiveBlocksPerMultiprocessor(&per_cu, (const void*)dit_fwd, 512, LDS_BYTES) != hipSuccess || per_cu < 1) fprintf(stderr, "kernel_launch: occupancy query reports %d\n", per_cu);
        (void)hipGetLastError();
        grid = cus;
    }
    if (grid < 0) return;
    (void)hipMemsetAsync((char*)d_ws + WS_CTL, 0, CTL_ZERO_BYTES, stream);
    Args a{};
    for (int i = 0; i < 26; ++i) a.in[i] = (const float*)d_in[i];
    a.out = (float*)d_out; a.ws = (unsigned char*)d_ws; a.ph_lo = 0; a.ph_hi = 1000;
    hipLaunchKernelGGL(dit_fwd, dim3(grid), dim3(512), LDS_BYTES, stream, a);
}
```

```cpp
#define GATE_U8 1
#include <hip/hip_runtime.h>
#include <cstdio>
#include <cstdint>

#define GAS __attribute__((address_space(1)))
#define LAS __attribute__((address_space(3)))
typedef unsigned short bf16_t;
typedef short bf16x8 __attribute__((ext_vector_type(8)));
typedef short s16x4 __attribute__((ext_vector_type(4)));
typedef float f32x2 __attribute__((ext_vector_type(2)));
typedef float f32x4 __attribute__((ext_vector_type(4)));
typedef float f32x16 __attribute__((ext_vector_type(16)));
typedef unsigned u32x2 __attribute__((ext_vector_type(2)));
typedef unsigned u32x4 __attribute__((ext_vector_type(4)));
typedef __bf16 bf16x2_t __attribute__((ext_vector_type(2)));

constexpr int DM = 1024, NB = 8, SEQ = 8192, CTXL = 256, DEPTH = 2;
constexpr int SB = SEQ + CTXL;
constexpr int GB = 4, NG = NB / GB;
constexpr int NT = GB * SB;
constexpr int NRT = NT / 256;
constexpr int INW = 6912;
constexpr int INCOLS = 6816;
constexpr int NCHUNK = SB / 128;
constexpr int NPAIR = 24;
constexpr float RMS_EPS = 1e-6f;
constexpr float LOG2E = 1.4426950408889634f;
constexpr float QSCALE = 0.10206207261596575f * LOG2E;
constexpr float Q8S = 32.f, K8S = 4.f, V8S = 4.f, P8S = 16.f;
constexpr float HX8S = 16.f, WG8S = 64.f;
constexpr float H28S = 16.f, WU8S = 64.f, MA8S = 32.f, WD8S = 32.f;

constexpr size_t MiB = 1u << 20;
constexpr size_t WS_CTL = 0, CTL_ZERO_BYTES = 1 * MiB;
constexpr size_t WS_MOD = 1 * MiB;
constexpr size_t WS_RT = 2 * MiB;
constexpr size_t WS_MT = 4 * MiB;
constexpr size_t WS_SSQ = 5 * MiB;
constexpr size_t WS_WGT = 8 * MiB;
constexpr size_t WS_LIST = 9 * MiB;
constexpr size_t WS_XC = 13 * MiB;
constexpr size_t WS_WIN = 21 * MiB;
constexpr size_t WS_WCAT = 48 * MiB;
constexpr size_t WS_WOUT = 54 * MiB;
constexpr size_t WS_WUQ = 58 * MiB;
constexpr size_t WS_WUKV = 60 * MiB;
constexpr size_t WS_WUP = 61 * MiB;
constexpr size_t WS_W2T = 125 * MiB;
constexpr size_t WS_HX = 157 * MiB;
constexpr size_t WS_PR = 223 * MiB;
constexpr size_t WS_PC = 322 * MiB;
constexpr size_t WS_PM = 388 * MiB;
constexpr size_t WS_PG = 430 * MiB;
constexpr size_t WS_Q = 628 * MiB;
constexpr size_t WS_K = 678 * MiB;
constexpr size_t WS_V = 728 * MiB;
constexpr size_t WS_ACT = 761 * MiB;
constexpr size_t WS_WIN8 = 746 * MiB;
constexpr size_t WS_H28 = WS_PM;
constexpr size_t WS_HX8 = WS_ACT;
constexpr size_t WS_XRES = 860 * MiB;
constexpr size_t WS_END = 988 * MiB;
static_assert(WS_WIN + (size_t)2 * INW * 1024 * 2 <= WS_WCAT && WS_HX + (size_t)NT * 1024 * 2 <= WS_PR && WS_PR + (size_t)NT * 1536 * 2 <= WS_PC &&
              WS_PC + (size_t)NT * 1024 * 2 <= WS_PM && WS_PM + (size_t)NT * 640 * 2 <= WS_PG && WS_PG + (size_t)NT * 3072 * 2 <= WS_Q &&
              WS_Q + (size_t)GB * 8 * SB * 96 * 2 <= WS_K && WS_K + (size_t)GB * 8 * SB * 96 * 2 <= WS_V && WS_V + (size_t)GB * 8 * SB * 64 * 2 <= WS_ACT &&
              WS_ACT + (size_t)NT * 1536 * 2 <= WS_XRES && WS_XRES + (size_t)NB * SEQ * DM * 2 <= WS_END, "d_ws map");
constexpr int CW_BAR = 4096;
constexpr int CW_CNT = 16384;
constexpr int CW_PANEL = 32768;

constexpr int RING_BYTES = 131072;
constexpr int LDSCTL_OFF = RING_BYTES;
constexpr int LDS_MOE_OFF = LDSCTL_OFF + 64;
constexpr int LDS_VTR_OFF = LDSCTL_OFF + 2048;
constexpr int LDS_BYTES = 147456;

__device__ __forceinline__ int olane() { int l; asm volatile("v_mbcnt_lo_u32_b32 %0, -1, 0\n\tv_mbcnt_hi_u32_b32 %0, -1, %0" : "=v"(l)); return l; }
__device__ __forceinline__ int otid(int wv) { return wv * 64 + olane(); }
__device__ __forceinline__ int obid() { int b = blockIdx.x; asm volatile("" : "+s"(b)); return b; }
__device__ __forceinline__ unsigned cvtpk(float lo, float hi) { f32x2 v = {lo, hi}; bf16x2_t b = __builtin_convertvector(v, bf16x2_t); return __builtin_bit_cast(unsigned, b); }
__device__ __forceinline__ float bf_lo(unsigned w) { return __uint_as_float(w << 16); }
__device__ __forceinline__ float bf_hi(unsigned w) { return __uint_as_float(w & 0xffff0000u); }
__device__ __forceinline__ float bf1(bf16_t b) { return __uint_as_float(((unsigned)b) << 16); }
__device__ __forceinline__ bf16_t f2bf(float f) { return (bf16_t)(cvtpk(f, 0.f) & 0xffffu); }
template <int O> __device__ __forceinline__ float swz_xor(float v) { return __int_as_float(__builtin_amdgcn_ds_swizzle(__float_as_int(v), (O << 10) | 0x1f)); }
__device__ __forceinline__ float half_sum(float v) { auto rr = __builtin_amdgcn_permlane32_swap(__float_as_uint(v), __float_as_uint(v), false, false); return __uint_as_float(rr[0]) + __uint_as_float(rr[1]); }
__device__ __forceinline__ float sum32(float v) { v += swz_xor<1>(v); v += swz_xor<2>(v); v += swz_xor<4>(v); v += swz_xor<8>(v); v += swz_xor<16>(v); return v; }
__device__ __forceinline__ float wave_sum(float v) { return half_sum(sum32(v)); }
__device__ __forceinline__ float sigmoidf_(float x) { return 1.f / (1.f + __expf(-x)); }
__device__ __forceinline__ float siluf_(float x) { return x / (1.f + __expf(-x)); }
__device__ __forceinline__ float sigmoid_fast(float x) { return __builtin_amdgcn_rcpf(1.f + __builtin_amdgcn_exp2f(-1.4426950408889634f * x)); }
__device__ __forceinline__ float silu_fast(float x) { return x * sigmoid_fast(x); }
__device__ __forceinline__ void unpack8_u8(const u32x2 w, float (&f)[8]) {
    f[0] = (float)(w.x & 0xffu); f[1] = (float)((w.x >> 8) & 0xffu); f[2] = (float)((w.x >> 16) & 0xffu); f[3] = (float)(w.x >> 24);
    f[4] = (float)(w.y & 0xffu); f[5] = (float)((w.y >> 8) & 0xffu); f[6] = (float)((w.y >> 16) & 0xffu); f[7] = (float)(w.y >> 24); }
__device__ __forceinline__ void unpack8(const u32x4 w, float (&f)[8]) {
    f[0] = bf_lo(w.x); f[1] = bf_hi(w.x); f[2] = bf_lo(w.y); f[3] = bf_hi(w.y); f[4] = bf_lo(w.z); f[5] = bf_hi(w.z); f[6] = bf_lo(w.w); f[7] = bf_hi(w.w);
}
__device__ __forceinline__ u32x2 pack8_fp8(const float (&f)[8]) { int a = __builtin_amdgcn_cvt_pk_fp8_f32(f[0], f[1], 0, false); a = __builtin_amdgcn_cvt_pk_fp8_f32(f[2], f[3], a, true);
    int b = __builtin_amdgcn_cvt_pk_fp8_f32(f[4], f[5], 0, false); b = __builtin_amdgcn_cvt_pk_fp8_f32(f[6], f[7], b, true); u32x2 w; w.x = (unsigned)a; w.y = (unsigned)b; return w; }
__device__ __forceinline__ u32x4 pack8(const float (&f)[8]) { u32x4 w; w.x = cvtpk(f[0], f[1]); w.y = cvtpk(f[2], f[3]); w.z = cvtpk(f[4], f[5]); w.w = cvtpk(f[6], f[7]); return w; }

__host__ __device__ __forceinline__ int vt_pos(int k) { const int w = k & 31, hi = (w >> 2) & 1, r = (w & 3) + 4 * (w >> 3); return 32 * hi + 16 * (k >> 5) + r; }
#ifdef HANDOFF_PLAIN_STORE
__device__ __forceinline__ void store_sc1(void* p, u32x4 v) { *(u32x4*)p = v; }
#else
__device__ __forceinline__ void store_sc1(void* p, u32x4 v) { asm volatile("global_store_dwordx4 %0, %1, off sc1" :: "v"(p), "v"(v) : "memory"); }
#endif
#define XB_TMO      128
#define XB_XCNT(j)  (256  + 64 * (j))
#define XB_XSUB(j)  (1280 + 64 * (j))
#define XB_XGEN(j)  (2304 + 64 * (j))
#define XB_TOP      3328
#define XB_TOPGEN   3392
#define XCD_BAR_WORDS 3456
#define XB_SPIN_CAP (1u << 20)
__device__ __forceinline__ unsigned xb_ld(unsigned* p)              { return __hip_atomic_load(p, __ATOMIC_RELAXED, __HIP_MEMORY_SCOPE_AGENT); }
__device__ __forceinline__ unsigned xb_add(unsigned* p, unsigned v) { return __hip_atomic_fetch_add(p, v, __ATOMIC_RELAXED, __HIP_MEMORY_SCOPE_AGENT); }
__device__ __forceinline__ unsigned xb_xcc_id() { return (unsigned)__builtin_amdgcn_s_getreg((3 << 11) | 20) & 0xFu; }
#define XB_SPIN(cond, bar) do { unsigned _sp = 0; while (cond) { __builtin_amdgcn_s_sleep(1); \
    if ((++_sp & 255u) == 0u) { if (xb_ld(&(bar)[XB_TMO])) break; if (_sp > XB_SPIN_CAP) { atomicAdd(&(bar)[XB_TMO], 1u); break; } } } } while (0)
struct XcdBarrier { unsigned* bar; unsigned x; volatile LAS unsigned* st; };
__device__ __forceinline__ XcdBarrier xcd_barrier_post(unsigned* bar, volatile LAS unsigned* st) {
    XcdBarrier b; b.bar = bar; b.x = xb_xcc_id(); b.st = st;
    if (threadIdx.x == 0) (void)xb_add(&bar[XB_XCNT(b.x)], 1u);
    return b;
}
__device__ __forceinline__ void xcd_barrier_complete(unsigned* bar, unsigned x, unsigned& nloc, unsigned& nx) {
    const unsigned G = gridDim.x * gridDim.y * gridDim.z;
    unsigned sum, cnt, mine, sp = 0u;
    for (;;) {
        sum = 0u; cnt = 0u; mine = 0u;
#pragma unroll
        for (unsigned j = 0; j < 16; ++j) { const unsigned c = xb_ld(&bar[XB_XCNT(j)]); sum += c; cnt += (c > 0u) ? 1u : 0u; mine = (j == x) ? c : mine; }
        if (sum == G) break;
        __builtin_amdgcn_s_sleep(1);
        if ((++sp & 255u) == 0u) { if (xb_ld(&bar[XB_TMO])) break; if (sp > XB_SPIN_CAP) { atomicAdd(&bar[XB_TMO], 1u); break; } }
    }
    nloc = mine > 0u ? mine : 1u; nx = cnt > 0u ? cnt : 1u;
}
__device__ __forceinline__ void xcd_barrier(const XcdBarrier& b, const int wv) {
    const bool leader = (wv == 0) && (olane() == 0);
    asm volatile("s_waitcnt vmcnt(0)" ::: "memory");
    __syncthreads();
    if (leader) {
        unsigned* bar = b.bar; unsigned bx = b.x;
        asm volatile("" : "+s"(bar), "+s"(bx));
        __builtin_amdgcn_s_waitcnt(0);
        unsigned nloc = b.st[0], nx = b.st[1];
        if (nloc == 0u) { xcd_barrier_complete(bar, bx, nloc, nx); b.st[0] = nloc; b.st[1] = nx; }
        const unsigned old = xb_add(&bar[XB_XSUB(bx)], 1u);
        const unsigned gen = old / nloc;
        if (old + 1u == (gen + 1u) * nloc) {
            __builtin_amdgcn_fence(__ATOMIC_RELEASE, "agent");
            asm volatile("s_waitcnt vmcnt(0)" ::: "memory");
            const unsigned og = xb_add(&bar[XB_TOP], 1u);
            const unsigned tg = og / nx;
            if (og + 1u == (tg + 1u) * nx) xb_add(&bar[XB_TOPGEN], 1u);
            else XB_SPIN(xb_ld(&bar[XB_TOPGEN]) == tg, bar);
            __builtin_amdgcn_fence(__ATOMIC_ACQUIRE, "agent");
            xb_add(&bar[XB_XGEN(bx)], 1u);
            asm volatile("s_waitcnt vmcnt(0)" ::: "memory");
        } else {
            XB_SPIN(xb_ld(&bar[XB_XGEN(bx)]) == gen, bar);
            __builtin_amdgcn_fence(__ATOMIC_ACQUIRE, "agent");
            asm volatile("s_waitcnt vmcnt(0)" ::: "memory");
        }
    }
    __syncthreads();
}

namespace pg8 {
constexpr int BM = 256, BK = 64, HALF = 128, HTB = HALF * BK * 2, NXCD = 8, WGM = 8;
__host__ __device__ __forceinline__ int lds_byte(int r, int c) { const int st = (r >> 4) * 2 + (c >> 5), rr = r & 15, cc = c & 31, ob = rr * 64 + cc * 2; return st * 1024 + (ob ^ (((ob >> 9) & 1) << 5)); }
__host__ __device__ __forceinline__ void stage_rc(int b, int& R, int& C) { const int st = b / 1024, sb = b % 1024, swz = sb ^ (((sb >> 9) & 1) << 5); R = (st >> 1) * 16 + swz / 64; C = (st & 1) * 32 + (swz % 64) / 2; }
__host__ __device__ __forceinline__ int perm32(int rho) { const int n = rho >> 4, i = rho & 15; return 8 * (i >> 2) + 4 * n + (i & 3); }

struct Unit { int pm, pn, aux0, aux1, aux2; const char* a; const char* b; const char* b2; };
typedef f32x4 Acc[2][2][4][2];

typedef int i32x8_t __attribute__((ext_vector_type(8)));
typedef int i32x4_t __attribute__((ext_vector_type(4)));
template <class Epi, class Sched, bool ALIGN_EPI, bool GATHER = false, bool SPLITB = false, bool FP8 = false, int SCA = 0x7f7f7f7f, int SCB = 0x7f7f7f7f>
__device__ __forceinline__ void gemm_phase(LAS unsigned char* lds, const int lda, const int ldb, const int K, const int ksplit, const Sched& S, const Epi& E, const int wv) {
    const int tid = otid(wv), wid = __builtin_amdgcn_readfirstlane(tid >> 6), lane = tid & 63, wr = wid >> 2, wc = wid & 3, fr = lane & 15, fq = lane >> 4;
    const int nt = K / BK;
    unsigned voffA[2][2], voffN[2][2], voffB[2];
#pragma unroll
    for (int i = 0; i < 2; ++i) { int R, C; stage_rc(tid * 16 + i * 8192, R, C); const int Rb = (R & ~31) + perm32(R & 31);
        voffB[i] = (unsigned)(Rb * ldb + C) * 2u;
        voffA[0][i] = (unsigned)(R * lda + C) * 2u; voffA[1][i] = (unsigned)((R + HALF) * lda + C) * 2u; voffN[0][i] = voffA[0][i]; voffN[1][i] = voffA[1][i]; }
    const size_t kstep = (size_t)(BK * 2);
    const size_t hstepB = (size_t)HALF * ldb * 2, hstepA = (size_t)HALF * lda * 2;
    const unsigned ldsw = (unsigned)wid * 1024u;
    const int aoff = lds_byte(wr * 64 + fr, fq * 8), boff = lds_byte(wc * 32 + fr, fq * 8);
#define PG8_SA(b, h) (((b) * 2 + (h)) * HTB)
#define PG8_SB(b, h) ((4 + (b) * 2 + (h)) * HTB)
#define PG8_STAGE_B(bufoff, gbase, h) do { _Pragma("unroll") for (int _i = 0; _i < 2; ++_i) \
        __builtin_amdgcn_global_load_lds((const unsigned*)((const char*)(gbase) + (size_t)(h) * hstepB + voffB[_i]), (LAS unsigned*)(lds + (bufoff) + ldsw + _i * 8192), 16, 0, 0); } while (0)
#define PG8_STAGE_A(bufoff, gbase, h, NX) do { _Pragma("unroll") for (int _i = 0; _i < 2; ++_i) { if constexpr (GATHER) { const unsigned _o = (NX) ? voffN[h][_i] : voffA[h][_i]; \
        __builtin_amdgcn_global_load_lds((const unsigned*)((const char*)(gbase) + _o), (LAS unsigned*)(lds + (bufoff) + ldsw + _i * 8192), 16, 0, 0); } else { \
        __builtin_amdgcn_global_load_lds((const unsigned*)((const char*)(gbase) + (size_t)(h) * hstepA + voffA[0][_i]), (LAS unsigned*)(lds + (bufoff) + ldsw + _i * 8192), 16, 0, 0); } } } while (0)
#define PG8_LDA(dst, b, h) do { _Pragma("unroll") for (int m = 0; m < 4; ++m) { if constexpr (FP8) { \
        A8[m].lo = *(const LAS i32x4_t*)(lds + PG8_SA(b, h) + aoff + m * 2048); A8[m].hi = *(const LAS i32x4_t*)(lds + PG8_SA(b, h) + aoff + m * 2048 + 1024); } else { \
        _Pragma("unroll") for (int k = 0; k < 2; ++k) dst[m][k] = *(const LAS bf16x8*)(lds + PG8_SA(b, h) + aoff + m * 2048 + k * 1024); } } } while (0)
#define PG8_LDB(dst, b, h) do { _Pragma("unroll") for (int n = 0; n < 2; ++n) { if constexpr (FP8) { \
        dst##8[n].lo = *(const LAS i32x4_t*)(lds + PG8_SB(b, h) + boff + n * 2048); dst##8[n].hi = *(const LAS i32x4_t*)(lds + PG8_SB(b, h) + boff + n * 2048 + 1024); } else { \
        _Pragma("unroll") for (int k = 0; k < 2; ++k) dst[n][k] = *(const LAS bf16x8*)(lds + PG8_SB(b, h) + boff + n * 2048 + k * 1024); } } } while (0)
#define PG8_MMA(ai, bj, At, Bt) do { __builtin_amdgcn_s_setprio(1); if constexpr (FP8) { _Pragma("unroll") for (int m = 0; m < 4; ++m) _Pragma("unroll") for (int n = 0; n < 2; ++n) \
        asm volatile("v_mfma_scale_f32_16x16x128_f8f6f4 %0, %1, %2, %0, %3, %4 op_sel_hi:[0,0,0]" : "+v"(acc[ai][bj][m][n]) : "v"(Bt##8[n]), "v"(A8[m]), "v"(scb_), "v"(sca_)); } else { \
        _Pragma("unroll") for (int m = 0; m < 4; ++m) _Pragma("unroll") for (int n = 0; n < 2; ++n) _Pragma("unroll") for (int k = 0; k < 2; ++k) \
        acc[ai][bj][m][n] = __builtin_amdgcn_mfma_f32_16x16x32_bf16(Bt[n][k], At[m][k], acc[ai][bj][m][n], 0, 0, 0); } __builtin_amdgcn_s_setprio(0); } while (0)
#define PG8_WAIT_V(n) asm volatile("s_waitcnt vmcnt(" #n ")" ::: "memory")
#define PG8_WAIT_L(n) asm volatile("s_waitcnt lgkmcnt(" #n ")" ::: "memory")
#define PG8_BAR __builtin_amdgcn_s_barrier()
#define PG8_SCHED __builtin_amdgcn_sched_barrier(0)
#define PG8_GOFF(dst, u) do { if constexpr (GATHER) { const int _t = otid(wv); _Pragma("unroll") for (int _i = 0; _i < 2; ++_i) { int _R, _C; stage_rc(_t * 16 + _i * 8192, _R, _C); \
        _Pragma("unroll") for (int _h = 0; _h < 2; ++_h) dst[_h][_i] = S.gather_off(u, _h * HALF + _R) + (unsigned)_C * 2u; } } } while (0)
#define PG8_BPTR(u, t) (SPLITB ? (((t) < ksplit) ? (u).b + (size_t)(t) * kstep : (u).b2 + (size_t)((t) - ksplit) * kstep) : (u).b + (size_t)(t) * kstep)
    Unit cur, nxt; int ui = 0;
    if (!S.next(0, cur)) return;
    Acc acc;
#pragma unroll
    for (int a = 0; a < 2; ++a)
#pragma unroll
        for (int b = 0; b < 2; ++b)
#pragma unroll
            for (int m = 0; m < 4; ++m)
#pragma unroll
                for (int n = 0; n < 2; ++n) acc[a][b][m][n] = (f32x4){0.f, 0.f, 0.f, 0.f};
    bf16x8 At[4][2], B0[2][2], B1[2][2]; i32x8_t A8[4], B08[2], B18[2]; const int sca_ = SCA, scb_ = SCB;
    const char* cA = cur.a; const char* cB = cur.b;
    S.a_ready(cur);
    PG8_GOFF(voffA, cur);
    if constexpr (GATHER) {
#pragma unroll
        for (int h = 0; h < 2; ++h)
#pragma unroll
            for (int i = 0; i < 2; ++i) voffN[h][i] = voffA[h][i];
    }
    PG8_STAGE_B(PG8_SB(0, 0), cB, 0); PG8_STAGE_B(PG8_SB(0, 1), cB, 1); PG8_STAGE_A(PG8_SA(0, 0), cA, 0, false); PG8_STAGE_A(PG8_SA(0, 1), cA, 1, false);
    if (wr == 1) PG8_BAR;
    PG8_WAIT_V(2); PG8_BAR;
    PG8_STAGE_B(PG8_SB(1, 0), cB + kstep, 0); PG8_STAGE_A(PG8_SA(1, 0), cA + kstep, 0, false); PG8_STAGE_B(PG8_SB(1, 1), cB + kstep, 1);
    PG8_WAIT_V(6); PG8_BAR;
    for (;;) {
        const bool has_next = S.next(ui + 1, nxt);
        const char* nA = has_next ? nxt.a : cA; const char* nB = has_next ? nxt.b : cB;
#pragma nounroll
        for (int t = 0; t < nt; t += 2) {
            const bool last = (t == nt - 2);
            if (last && has_next) { S.a_ready(nxt); PG8_GOFF(voffN, nxt); }
            if constexpr (Epi::HOOK) { if (t == Epi::HOOK_T0 || t == Epi::HOOK_T1) E.hook(acc, cur, t, wr, wc, fr, fq); }
            const char* a1 = cA + (size_t)(t + 1) * kstep;
            const char* a2 = last ? nA : cA + (size_t)(t + 2) * kstep; const char* b2 = last ? nB : PG8_BPTR(cur, t + 2);
            const char* a3 = a2 + kstep; const char* b3 = b2 + kstep;
            PG8_LDB(B0, 0, 0); PG8_LDB(B1, 0, 1); PG8_SCHED; PG8_LDA(At, 0, 0); PG8_STAGE_A(PG8_SA(1, 1), a1, 1, false);
            PG8_WAIT_V(8); PG8_WAIT_L(0); PG8_BAR; PG8_MMA(0, 0, At, B0); PG8_MMA(0, 1, At, B1); PG8_BAR; PG8_SCHED;
            PG8_LDA(At, 0, 1); PG8_STAGE_B(PG8_SB(0, 0), b2, 0); PG8_STAGE_B(PG8_SB(0, 1), b2, 1); PG8_STAGE_A(PG8_SA(0, 0), a2, 0, last);
            PG8_WAIT_V(8); PG8_WAIT_L(0); PG8_BAR; PG8_MMA(1, 0, At, B0); PG8_MMA(1, 1, At, B1); PG8_BAR; PG8_SCHED;
            PG8_LDB(B0, 1, 0); PG8_LDB(B1, 1, 1); PG8_SCHED; PG8_LDA(At, 1, 0); PG8_STAGE_A(PG8_SA(0, 1), a2, 1, last);
            PG8_WAIT_V(8); PG8_WAIT_L(0); PG8_BAR; PG8_MMA(0, 0, At, B0); PG8_MMA(0, 1, At, B1); PG8_BAR; PG8_SCHED;
            PG8_LDA(At, 1, 1); PG8_STAGE_B(PG8_SB(1, 0), b3, 0); PG8_STAGE_B(PG8_SB(1, 1), b3, 1); PG8_STAGE_A(PG8_SA(1, 0), a3, 0, last);
            PG8_WAIT_V(8); PG8_WAIT_L(0); PG8_BAR; PG8_MMA(1, 0, At, B0); PG8_MMA(1, 1, At, B1); PG8_BAR; PG8_SCHED;
        }
        if constexpr (ALIGN_EPI) { if (wr == 0) PG8_BAR; }
        if constexpr (FP8) asm volatile("s_nop 15\n\ts_nop 15" ::: "memory");
        E(acc, cur, wr, wc, fr, fq); S.done(cur);
        if (!has_next) break;
#pragma unroll
        for (int a = 0; a < 2; ++a)
#pragma unroll
            for (int b = 0; b < 2; ++b)
#pragma unroll
                for (int m = 0; m < 4; ++m)
#pragma unroll
                    for (int n = 0; n < 2; ++n) acc[a][b][m][n] = (f32x4){0.f, 0.f, 0.f, 0.f};
        cur = nxt; cA = nA; cB = nB; ++ui;
        if constexpr (GATHER) {
#pragma unroll
            for (int h = 0; h < 2; ++h)
#pragma unroll
                for (int i = 0; i < 2; ++i) voffA[h][i] = voffN[h][i];
        }
        if constexpr (ALIGN_EPI) { if (wr == 1) PG8_BAR; }
    }
    PG8_WAIT_V(0);
    if constexpr (!ALIGN_EPI) { if (wr == 0) PG8_BAR; }
    PG8_BAR;
#undef PG8_SA
#undef PG8_SB
#undef PG8_STAGE_A
#undef PG8_STAGE_B
#undef PG8_LDA
#undef PG8_LDB
#undef PG8_MMA
#undef PG8_WAIT_V
#undef PG8_WAIT_L
#undef PG8_BAR
#undef PG8_SCHED
#undef PG8_GOFF
#undef PG8_BPTR
}
}
struct Resid {
    const float* in_lat; const float* in_ctx; bf16_t* x_lat; bf16_t* x_ctx; int g, src_f32;
    __device__ __forceinline__ const float* srcf(int row) const { const int bl = row / SB, s = row - bl * SB, b = g * GB + bl;
        return s < CTXL ? in_ctx + (size_t)(b * CTXL + s) * DM : in_lat + ((size_t)b * SEQ + (s - CTXL)) * DM; }
    __device__ __forceinline__ bf16_t* dst(int row) const { const int bl = row / SB, s = row - bl * SB, b = g * GB + bl;
        return s < CTXL ? x_ctx + (size_t)(b * CTXL + s) * DM : x_lat + ((size_t)b * SEQ + (s - CTXL)) * DM; }
    __device__ __forceinline__ int modv(int row) const { const int bl = row / SB, s = row - bl * SB; return s < CTXL ? 8 : g * GB + bl; }
};

struct TileOrder {
    int nM, nN, nwg, G, c, skip; const char* A; const char* B; size_t astep, bstep;
    __device__ __forceinline__ void init(int nM_, int nN_, int G_, int c_, const void* A_, size_t astep_, const void* B_, size_t bstep_, int skip_ctx) {
        nM = nM_; nN = nN_; nwg = nM * nN; G = G_; c = c_; A = (const char*)A_; B = (const char*)B_; astep = astep_; bstep = bstep_; skip = skip_ctx; }
    __device__ __forceinline__ bool next(int i, pg8::Unit& u) const {
        const long L = (long)i * G + c; if (L >= nwg) return false;
        int wgid = (int)L; { const int q = nwg / pg8::NXCD, r = nwg % pg8::NXCD, xcd = wgid % pg8::NXCD, off = wgid / pg8::NXCD; wgid = (xcd < r ? xcd * (q + 1) : r * (q + 1) + (xcd - r) * q) + off; }
        const int nig = pg8::WGM * nN, gid = wgid / nig, fm = gid * pg8::WGM, gsz = (nM - fm) < pg8::WGM ? (nM - fm) : pg8::WGM;
        int pm = fm + ((wgid % nig) % gsz); u.pn = (wgid % nig) / gsz;
        if (skip) pm = pm + pm / 32 + 1;
        u.pm = pm; u.aux0 = 0; u.aux1 = 0; u.aux2 = 0;
        u.a = A + (size_t)pm * astep; u.b = B + (size_t)u.pn * bstep; u.b2 = u.b; return true;
    }
    __device__ __forceinline__ void a_ready(const pg8::Unit&) const {}
    __device__ __forceinline__ void done(const pg8::Unit&) const {}
};

struct TileOrderP : TileOrder {
    unsigned* ctr;
    __device__ __forceinline__ void done(const pg8::Unit& u) const {
        asm volatile("s_waitcnt vmcnt(0)" ::: "memory");
#ifdef HANDOFF_RELEASE
        __builtin_amdgcn_fence(__ATOMIC_RELEASE, "agent"); asm volatile("s_waitcnt vmcnt(0)" ::: "memory");
#endif
        if (olane() == 0) __hip_atomic_fetch_add(ctr + 64 * u.pm, 1u, __ATOMIC_RELAXED, __HIP_MEMORY_SCOPE_AGENT);
    }
};
struct TileOrderC : TileOrder {
    unsigned* ctr; unsigned need; unsigned* tmo; int wv;
    __device__ __forceinline__ void a_ready(const pg8::Unit& u) const {
        if (wv == 0) {
            const unsigned long long t0 = __builtin_amdgcn_s_memrealtime(); unsigned polls = 0;
            while ((unsigned)__builtin_amdgcn_readfirstlane(__hip_atomic_load(ctr + 64 * u.pm, __ATOMIC_RELAXED, __HIP_MEMORY_SCOPE_AGENT)) < need) {
                if ((++polls & 255u) == 0u && __builtin_amdgcn_readfirstlane(__hip_atomic_load(tmo, __ATOMIC_RELAXED, __HIP_MEMORY_SCOPE_AGENT)) != 0u) break;
                if (__builtin_amdgcn_s_memrealtime() - t0 > 2000000ull) { if (olane() == 0) __hip_atomic_store(tmo, 1u, __ATOMIC_RELAXED, __HIP_MEMORY_SCOPE_AGENT); break; }
                __builtin_amdgcn_s_sleep(2); }
            __builtin_amdgcn_fence(__ATOMIC_ACQUIRE, "agent");
            asm volatile("s_waitcnt vmcnt(0)" ::: "memory");
        }
        asm volatile("" ::: "memory"); __builtin_amdgcn_s_barrier(); asm volatile("" ::: "memory");
    }
};

struct MoeOrder {
    const LAS int* tab; const int* LIST; int ncol, G, c, up; const char* A; const char* W; int esz;
    __device__ __forceinline__ bool next(int i, pg8::Unit& u) const {
        const int TR = __builtin_amdgcn_readfirstlane(tab[24]);
        int rt, pn;
        if ((G & 7) == 0) { const int x = c & 7, j = c >> 3, W = G >> 3; const int lo = (TR * x) >> 3, hi = (TR * (x + 1)) >> 3; const int q = i * W + j; if (q >= (hi - lo) * ncol) return false;
            rt = lo + q / ncol; pn = q - (q / ncol) * ncol; }
        else { const int L = i * G + c; if (L >= TR * ncol) return false; rt = L / ncol; pn = L - rt * ncol; }
        int p = 0;
#pragma unroll
        for (int q = 1; q < NPAIR; ++q) p += (__builtin_amdgcn_readfirstlane(tab[q]) <= rt) ? 1 : 0;
        const int base = (rt - __builtin_amdgcn_readfirstlane(tab[p])) * 256; int valid = __builtin_amdgcn_readfirstlane(tab[32 + p]) - base; valid = valid > 256 ? 256 : valid;
        u.pm = rt; u.pn = pn; u.aux0 = p * NT + base; u.aux1 = valid; u.aux2 = p;
        const int grp = p / 6, q6 = p - grp * 6;
        const int lo = q6 < 3 ? 0 : (q6 < 5 ? 1 : 2), hi = q6 < 3 ? q6 + 1 : (q6 < 5 ? q6 - 1 : 3);
        const int ea = grp * 4 + lo, eb = grp * 4 + hi;
        if (up) { const int e = pn < 4 ? ea : eb; u.a = A; u.b = W + ((size_t)e * 1024 + (size_t)(pn & 3) * 256) * 1024 * esz; u.b2 = u.b; }
        else { u.a = A + (size_t)rt * 256 * 1024 * esz; u.b = W + ((size_t)ea * 1024 + (size_t)pn * 256) * 512 * esz; u.b2 = W + ((size_t)eb * 1024 + (size_t)pn * 256) * 512 * esz; }
        return true;
    }
    __device__ __forceinline__ unsigned gather_off(const pg8::Unit& u, int r) const { const int idx = r < u.aux1 ? r : 0; return (unsigned)LIST[u.aux0 + idx] * (unsigned)(DM * esz); }
    __device__ __forceinline__ void a_ready(const pg8::Unit&) const {}
    __device__ __forceinline__ void done(const pg8::Unit&) const {}
};

#ifdef EPI_NT_STORES
#define ST_NT(p, v) __builtin_nontemporal_store((v), (p))
#else
#define ST_NT(p, v) (*(p) = (v))
#endif
#define EPI_NOHOOK static constexpr bool HOOK = false; static constexpr int HOOK_T0 = -1, HOOK_T1 = -1; \
    __device__ __forceinline__ void hook(pg8::Acc&, const pg8::Unit&, int, int, int, int, int) const {}
#define EPI_V8(v, acc, ai, bj, m) float v[8]; { const f32x4 _a = acc[ai][bj][m][0], _b = acc[ai][bj][m][1]; v[0] = _a[0]; v[1] = _a[1]; v[2] = _a[2]; v[3] = _a[3]; v[4] = _b[0]; v[5] = _b[1]; v[6] = _b[2]; v[7] = _b[3]; }
__device__ __forceinline__ void rot4(float (&v)[8], const f32x2* cs) {
    const f32x4 c01 = *(const f32x4*)cs, c23 = *(const f32x4*)(cs + 2);
    const float c[4] = {c01[0], c01[2], c23[0], c23[2]}, s[4] = {c01[1], c01[3], c23[1], c23[3]};
#pragma unroll
    for (int k = 0; k < 4; ++k) { const float x1 = v[2 * k], x2 = v[2 * k + 1]; v[2 * k] = x1 * c[k] - x2 * s[k]; v[2 * k + 1] = x2 * c[k] + x1 * s[k]; }
}

struct EpiNone { EPI_NOHOOK
    float* sink;
    __device__ __forceinline__ void operator()(const pg8::Acc& acc, const pg8::Unit& u, int wr, int wc, int fr, int fq) const {
        float s = 0.f;
#pragma unroll
        for (int ai = 0; ai < 2; ++ai)
#pragma unroll
            for (int bj = 0; bj < 2; ++bj)
#pragma unroll
                for (int m = 0; m < 4; ++m) s += acc[ai][bj][m][0][0] + acc[ai][bj][m][1][3];
        if (s == 1.2345e33f) sink[0] = s;
    }
};
struct EpiStoreOnly { EPI_NOHOOK
    bf16_t* PG;
    __device__ __forceinline__ void operator()(const pg8::Acc& acc, const pg8::Unit& u_, int wr, int wc, int fr, int fq) const {
        pg8::Unit u = u_; asm volatile("" : "+s"(u.pm), "+s"(u.pn), "+v"(fr), "+v"(fq));
#ifdef STORE_PITCH
        const int pn12 = u.pn % 8;
#define SO_PITCH (STORE_PITCH)
#else
        const int pn12 = u.pn % 12;
#define SO_PITCH 3072
#endif
#pragma unroll
        for (int ai = 0; ai < 2; ++ai)
#pragma unroll
        for (int m = 0; m < 4; ++m) { const int row = u.pm * 256 + ai * 128 + wr * 64 + m * 16 + fr;
#pragma unroll
            for (int bj = 0; bj < 2; ++bj) { const int c0 = bj * 128 + wc * 32 + 8 * fq; EPI_V8(v, acc, ai, bj, m)
#if defined(SO_MODE) && SO_MODE == 1
                if (bj == 0)
#elif defined(SO_MODE) && SO_MODE == 2
                if (obid() & 8)
#elif defined(SO_MODE) && SO_MODE == 3
                if (obid() & 1)
#endif
                *(u32x4*)(PG + (size_t)row * SO_PITCH + pn12 * 256 + c0) = pack8(v); } }
    }
};
struct EpiGate {
    EPI_NOHOOK
    bf16_t* PG;
    __device__ __forceinline__ void operator()(const pg8::Acc& acc, const pg8::Unit& u_, int wr, int wc, int fr, int fq) const {
        pg8::Unit u = u_; asm volatile("" : "+s"(u.pm), "+s"(u.pn), "+v"(fr), "+v"(fq));
#pragma unroll
        for (int ai = 0; ai < 2; ++ai)
#pragma unroll
        for (int m = 0; m < 4; ++m) { const int row = u.pm * 256 + ai * 128 + wr * 64 + m * 16 + fr;
#pragma unroll
            for (int bj = 0; bj < 2; ++bj) { const int c0 = bj * 128 + wc * 32 + 8 * fq;
                EPI_V8(v, acc, ai, bj, m)
                float g[8];
#pragma unroll
#ifdef GATE_U8
                for (int k = 0; k < 8; ++k) g[k] = 255.f * __builtin_amdgcn_rcpf(1.f + __builtin_amdgcn_exp2f(-fmaxf(v[k], -7.98868f)));
                u32x2 w = {0u, 0u};
                w.x = __builtin_amdgcn_cvt_pk_u8_f32(g[0], 0, w.x); w.x = __builtin_amdgcn_cvt_pk_u8_f32(g[1], 1, w.x); w.x = __builtin_amdgcn_cvt_pk_u8_f32(g[2], 2, w.x); w.x = __builtin_amdgcn_cvt_pk_u8_f32(g[3], 3, w.x);
                w.y = __builtin_amdgcn_cvt_pk_u8_f32(g[4], 0, w.y); w.y = __builtin_amdgcn_cvt_pk_u8_f32(g[5], 1, w.y); w.y = __builtin_amdgcn_cvt_pk_u8_f32(g[6], 2, w.y); w.y = __builtin_amdgcn_cvt_pk_u8_f32(g[7], 3, w.y);
                *(u32x2*)((unsigned char*)PG + (size_t)row * 3072 + u.pn * 256 + c0) = w; } }
#else
                for (int k = 0; k < 8; ++k) g[k] = __builtin_amdgcn_rcpf(1.f + __builtin_amdgcn_exp2f(-fmaxf(v[k], -15.f * 1.4426950408889634f)));
                *(u32x4*)(PG + (size_t)row * 3072 + u.pn * 256 + c0) = pack8(g); } }
#endif
    }
};
struct EpiInproj {
    EPI_NOHOOK
    bf16_t *PR, *PC, *PM, *PG; unsigned char* KB; float* SSQ; const f32x2* RT; const f32x2* MT; int pn_off;
    __device__ __forceinline__ void operator()(const pg8::Acc& acc, const pg8::Unit& u_, int wr, int wc, int fr, int fq) const {
        pg8::Unit u = u_; asm volatile("" : "+s"(u.pm), "+s"(u.pn), "+s"(u.aux0), "+s"(u.aux1), "+v"(fr), "+v"(fq));
        const int pn = u.pn + pn_off;
#pragma unroll
        for (int ai = 0; ai < 2; ++ai)
#pragma unroll
        for (int m = 0; m < 4; ++m) { __builtin_amdgcn_sched_barrier(0);
            const int row = u.pm * 256 + ai * 128 + wr * 64 + m * 16 + fr;
            const int bl = row / SB, s = row - bl * SB; const bool lat = s >= CTXL; const int t = lat ? s - CTXL : 0;
            float ss[2] = {0.f, 0.f};
#pragma unroll
            for (int bj = 0; bj < 2; ++bj) {
                const int c0 = bj * 128 + wc * 32 + 8 * fq;
                EPI_V8(v, acc, ai, bj, m)
                if (pn <= 1) {
                    if (lat) rot4(v, RT + (size_t)t * 32 + ((c0 & 63) >> 1));
                    if (pn == 1) {
#pragma unroll
                        for (int k = 0; k < 8; ++k) v[k] *= 0.125f;
                    }
                    *(u32x4*)(PR + (size_t)row * 1536 + pn * 256 + c0) = pack8(v);
                } else if (pn <= 5) {
                    *(u32x4*)(PR + (size_t)row * 1536 + pn * 256 + c0) = pack8(v);
                } else if (pn <= 7) {
                    *(u32x4*)(PC + (size_t)row * 1024 + (pn - 6) * 256 + c0) = pack8(v);
                } else if (pn <= 11) {
                    u32x2 w; w.x = cvtpk(v[0] * v[1], v[2] * v[3]); w.y = cvtpk(v[4] * v[5], v[6] * v[7]);
                    *(u32x2*)(PC + (size_t)row * 1024 + 512 + (pn - 8) * 128 + (c0 >> 1)) = w;
                } else if (pn <= 14) {
                    if (pn == 14 && bj == 1) {
                        if (wc == 0) {
                            if (lat) { const int a = fq >> 1, pos = a ? (t & 63) : (t >> 6); rot4(v, MT + pos * 8 + (fq & 1) * 4); }
#pragma unroll
                            for (int k = 0; k < 8; ++k) v[k] *= K8S;
                            const u32x2 w = pack8_fp8(v);
#pragma unroll
                            for (int hh = 0; hh < 8; ++hh) { unsigned char* kp = KB + ((size_t)(bl * 8 + hh) * SB + s) * 128;
                                *(u32x2*)(kp + 64 + 8 * fq) = w; if (fq == 3) { *(u32x4*)(kp + 96) = (u32x4){0u, 0u, 0u, 0u}; *(u32x4*)(kp + 112) = (u32x4){0u, 0u, 0u, 0u}; } }
                        }
                    } else {
                        *(u32x4*)(PM + (size_t)row * 640 + (pn - 12) * 256 + c0) = pack8(v);
                        float q = 0.f;
#pragma unroll
                        for (int k = 0; k < 8; ++k) q += v[k] * v[k];
                        ss[bj] = q;
                    }
                } else {
                    float g[8];
#pragma unroll
                    for (int k = 0; k < 8; ++k) g[k] = sigmoid_fast(fmaxf(v[k], -15.f));
                    ST_NT((u32x4*)(PG + (size_t)row * 3072 + (pn - 15) * 256 + c0), pack8(g));
                }
            }
            if (pn >= 12 && pn <= 14) {
                float a = ss[0], b = ss[1];
                a += swz_xor<16>(a); a = half_sum(a); b += swz_xor<16>(b); b = half_sum(b);
                if (fq == 0) {
                    float* sq = SSQ + (size_t)row * 16;
                    if (pn == 12) sq[wc] = a + b;
                    else if (pn == 13) { sq[4 + wc] = a; sq[8 + wc] = b; }
                    else sq[12 + wc] = a;
                }
            }
        }
    }
};

#define EPI_ROW(ai, m) (u.pm * 256 + (ai) * 128 + wr * 64 + (m) * 16 + fr)
#define EPI_OPAQUE pg8::Unit u = u_; asm volatile("" : "+s"(u.pm), "+s"(u.pn), "+s"(u.aux0), "+s"(u.aux1), "+v"(fr), "+v"(fq));
struct EpiUq {
    EPI_NOHOOK
    unsigned char* QB; const float* SSQ; const f32x2* MT;
    __device__ __forceinline__ void operator()(const pg8::Acc& acc, const pg8::Unit& u_, int wr, int wc, int fr, int fq) const {
        EPI_OPAQUE
        f32x4 q0[2][4], q1[2][4];
#pragma unroll
        for (int ai = 0; ai < 2; ++ai)
#pragma unroll
            for (int m = 0; m < 4; ++m) { const float* sq = SSQ + (size_t)EPI_ROW(ai, m) * 16; q0[ai][m] = *(const f32x4*)sq; q1[ai][m] = *(const f32x4*)(sq + 4); }
#pragma unroll
        for (int ai = 0; ai < 2; ++ai)
#pragma unroll
        for (int m = 0; m < 4; ++m) {
            const int row = EPI_ROW(ai, m);
            const int bl = row / SB, s = row - bl * SB; const bool lat = s >= CTXL; const int t = lat ? s - CTXL : 0;
            const f32x4 a = q0[ai][m], b = q1[ai][m];
            const float ssq = ((a[0] + a[1]) + (a[2] + a[3])) + ((b[0] + b[1]) + (b[2] + b[3]));
            const float rq = rsqrtf(ssq * (1.f / 384.f) + RMS_EPS) * (QSCALE * Q8S);
#pragma unroll
            for (int bj = 0; bj < 2; ++bj) {
                const int cg = u.pn * 256 + bj * 128 + wc * 32 + 8 * fq; const int h = cg / 96, d0 = cg - h * 96;
                EPI_V8(v, acc, ai, bj, m)
#pragma unroll
                for (int k = 0; k < 8; ++k) v[k] *= rq;
                if (d0 >= 64 && lat) { const int p0 = d0 - 64, aa = p0 >> 4, pos = aa ? (t & 63) : (t >> 6); rot4(v, MT + pos * 8 + ((p0 & 15) >> 1)); }
                unsigned char* qp = QB + ((size_t)(bl * 8 + h) * SB + s) * 128;
                *(u32x2*)(qp + d0) = pack8_fp8(v);
                if (d0 == 88) { *(u32x4*)(qp + 96) = (u32x4){0u, 0u, 0u, 0u}; *(u32x4*)(qp + 112) = (u32x4){0u, 0u, 0u, 0u}; }
            }
        }
    }
};
struct EpiUkv {
    EPI_NOHOOK
    unsigned char* KB; unsigned char* VT; const float* SSQ; LAS unsigned char* tr;
    __device__ __forceinline__ void operator()(const pg8::Acc& acc, const pg8::Unit& u_, int wr, int wc, int fr, int fq) const {
        EPI_OPAQUE
        f32x4 q0[2][4], q1[2][4];
#pragma unroll
        for (int ai = 0; ai < 2; ++ai)
#pragma unroll
            for (int m = 0; m < 4; ++m) { const float* sq = SSQ + (size_t)EPI_ROW(ai, m) * 16 + 8; q0[ai][m] = *(const f32x4*)sq; q1[ai][m] = *(const f32x4*)(sq + 4); }
        LAS unsigned char* my = tr + (wr * 2 + (wc & 1)) * 2048;
        const int lane = fr + 16 * fq;
#pragma unroll
        for (int ai = 0; ai < 2; ++ai) {
            const int row0 = u.pm * 256 + ai * 128 + wr * 64;
            const int bl = row0 / SB, s0 = row0 - bl * SB;
#pragma unroll
            for (int bj = 0; bj < 2; ++bj) {
                const int h = u.pn * 2 + bj;
#pragma unroll
                for (int m = 0; m < 4; ++m) {
                    const f32x4 a = q0[ai][m], b = q1[ai][m];
                    const float ssq = ((a[0] + a[1]) + (a[2] + a[3])) + ((b[0] + b[1]) + (b[2] + b[3]));
                    const float rk = rsqrtf(ssq * (1.f / 256.f) + RMS_EPS);
                    EPI_V8(v, acc, ai, bj, m)
                    if (wc < 2) {
#pragma unroll
                        for (int k = 0; k < 8; ++k) v[k] *= rk * K8S;
                        *(u32x2*)(KB + ((size_t)(bl * 8 + h) * SB + s0 + 16 * m + fr) * 128 + wc * 32 + 8 * fq) = pack8_fp8(v);
                    } else {
#pragma unroll
                        for (int k = 0; k < 8; ++k) v[k] *= rk * V8S;
                        const u32x2 w = pack8_fp8(v); const int pos = vt_pos(16 * m + fr) ^ (16 * fq);
#pragma unroll
                        for (int k = 0; k < 4; ++k) { my[(8 * fq + k) * 64 + pos] = (unsigned char)(w.x >> (8 * k)); my[(8 * fq + 4 + k) * 64 + pos] = (unsigned char)(w.y >> (8 * k)); }
                    }
                }
                if (wc >= 2) {
#pragma unroll
                    for (int i = 0; i < 2; ++i) { const int ch = lane + 64 * i, d = ch >> 2, c16 = ch & 3;
                        const u32x4 x = *(const LAS u32x4*)(my + d * 64 + ((c16 ^ ((d >> 3) & 3)) * 16));
                        *(u32x4*)(VT + ((size_t)(bl * 8 + h) * 64 + (wc - 2) * 32 + d) * SB + s0 + c16 * 16) = x; }
                }
            }
        }
    }
};

struct EpiMerge1 {
    static constexpr bool HOOK = true; static constexpr int HOOK_T0 = 8, HOOK_T1 = 16;
    const bf16_t* PG; bf16_t* M;
    __device__ __forceinline__ void hook(pg8::Acc& acc, const pg8::Unit& u_, int t, int wr, int wc, int fr, int fq) const {
        pg8::Unit u = u_; asm volatile("" : "+s"(u.pm), "+s"(u.pn), "+v"(fr), "+v"(fq));
        const int gi = (t == 8) ? 0 : 1;
#pragma unroll
        for (int ai = 0; ai < 2; ++ai) {
#ifdef GATE_U8
            u32x2 sp[4][2], sn[4][2];
#pragma unroll
            for (int m = 0; m < 4; ++m)
#pragma unroll
                for (int bj = 0; bj < 2; ++bj) { const unsigned char* p = (const unsigned char*)PG + (size_t)EPI_ROW(ai, m) * 3072 + gi * 1024 + u.pn * 256 + bj * 128 + wc * 32 + 8 * fq;
                    sp[m][bj] = *(const u32x2*)p; sn[m][bj] = *(const u32x2*)(p + 1024); }
#else
            u32x4 sp[4][2], sn[4][2];
#pragma unroll
            for (int m = 0; m < 4; ++m)
#pragma unroll
                for (int bj = 0; bj < 2; ++bj) { const bf16_t* p = PG + (size_t)EPI_ROW(ai, m) * 3072 + gi * 1024 + u.pn * 256 + bj * 128 + wc * 32 + 8 * fq;
                    sp[m][bj] = *(const u32x4*)p; sn[m][bj] = *(const u32x4*)(p + 1024); }
#endif
#pragma unroll
            for (int m = 0; m < 4; ++m)
#pragma unroll
                for (int bj = 0; bj < 2; ++bj) {
#ifdef GATE_U8
                    float a[8], b[8]; unpack8_u8(sp[m][bj], a); unpack8_u8(sn[m][bj], b);
#else
                    float a[8], b[8]; unpack8(sp[m][bj], a); unpack8(sn[m][bj], b);
#endif
                    f32x4 r0, r1;
#pragma unroll
                    for (int k = 0; k < 4; ++k) { r0[k] = a[k] * __builtin_amdgcn_rcpf(b[k]); r1[k] = a[4 + k] * __builtin_amdgcn_rcpf(b[4 + k]); }
                    acc[ai][bj][m][0] *= r0; acc[ai][bj][m][1] *= r1;
                }
            __builtin_amdgcn_sched_barrier(0);
        }
    }
    __device__ __forceinline__ void operator()(const pg8::Acc& acc, const pg8::Unit& u_, int wr, int wc, int fr, int fq) const {
        EPI_OPAQUE
        const __amdgpu_buffer_rsrc_t rsrc = __builtin_amdgcn_make_buffer_rsrc((void*)M, 0, (int)((size_t)NT * 1024 * 2), 0x00020000);
#pragma unroll
        for (int ai = 0; ai < 2; ++ai) {
#ifdef GATE_U8
            u32x2 s2[4][2];
#pragma unroll
            for (int m = 0; m < 4; ++m)
#pragma unroll
                for (int bj = 0; bj < 2; ++bj) s2[m][bj] = *(const u32x2*)((const unsigned char*)PG + (size_t)EPI_ROW(ai, m) * 3072 + 2048 + u.pn * 256 + bj * 128 + wc * 32 + 8 * fq);
#else
            u32x4 s2[4][2];
#pragma unroll
            for (int m = 0; m < 4; ++m)
#pragma unroll
                for (int bj = 0; bj < 2; ++bj) s2[m][bj] = *(const u32x4*)(PG + (size_t)EPI_ROW(ai, m) * 3072 + 2048 + u.pn * 256 + bj * 128 + wc * 32 + 8 * fq);
#endif
#pragma unroll
            for (int m = 0; m < 4; ++m)
#pragma unroll
                for (int bj = 0; bj < 2; ++bj) {
                    const int cg = u.pn * 256 + bj * 128 + wc * 32 + 8 * fq;
#ifdef GATE_U8
                    float g[8]; unpack8_u8(s2[m][bj], g);
                    EPI_V8(v, acc, ai, bj, m)
#pragma unroll
                    for (int k = 0; k < 8; ++k) v[k] *= g[k] * (1.f / 255.f);
#else
                    float g[8]; unpack8(s2[m][bj], g);
                    EPI_V8(v, acc, ai, bj, m)
#pragma unroll
                    for (int k = 0; k < 8; ++k) v[k] *= g[k];
#endif
#ifndef HANDOFF
                    *(u32x4*)(M + (size_t)EPI_ROW(ai, m) * 1024 + cg) = pack8(v);
#else
                    __builtin_amdgcn_raw_buffer_store_b128(pack8(v), rsrc, (unsigned)(((size_t)EPI_ROW(ai, m) * 1024 + cg) * 2), 0, 16);
#endif
                }
            __builtin_amdgcn_sched_barrier(0);
        }
    }
};

struct EpiMerge1NoHook : EpiMerge1 { static constexpr bool HOOK = false; };
struct EpiMerge1HookOnly { static constexpr bool HOOK = true; static constexpr int HOOK_T0 = 8, HOOK_T1 = 16; EpiMerge1 e; float* sink;
    __device__ __forceinline__ void hook(pg8::Acc& acc, const pg8::Unit& u, int t, int wr, int wc, int fr, int fq) const { e.hook(acc, u, t, wr, wc, fr, fq); }
    __device__ __forceinline__ void operator()(const pg8::Acc& acc, const pg8::Unit& u, int wr, int wc, int fr, int fq) const { EpiNone n{sink}; n(acc, u, wr, wc, fr, fq); }
};
struct EpiMerge2 {
    EPI_NOHOOK
    Resid R; const float* MODL;
    __device__ __forceinline__ void operator()(const pg8::Acc& acc, const pg8::Unit& u_, int wr, int wc, int fr, int fq) const {
        EPI_OPAQUE
        const int cb = u.pn * 256 + wc * 32 + 8 * fq;
        const float* g1 = MODL + R.modv(u.pm * 256) * 6144 + 2048 + cb;
        f32x4 g[2][2];
#pragma unroll
        for (int bj = 0; bj < 2; ++bj)
#pragma unroll
            for (int n = 0; n < 2; ++n) g[bj][n] = *(const f32x4*)(g1 + bj * 128 + 4 * n);
        int sf32 = R.src_f32; asm volatile("" : "+s"(sf32));
#pragma unroll
        for (int ai = 0; ai < 2; ++ai) {
            if (sf32) {
#pragma unroll
                for (int mh = 0; mh < 2; ++mh) {
                    f32x4 x[2][2][2];
#pragma unroll
                    for (int m2 = 0; m2 < 2; ++m2) { const float* src = R.srcf(EPI_ROW(ai, 2 * mh + m2)) + cb;
#pragma unroll
                        for (int bj = 0; bj < 2; ++bj)
#pragma unroll
                            for (int n = 0; n < 2; ++n) x[m2][bj][n] = *(const f32x4*)(src + bj * 128 + 4 * n); }
#pragma unroll
                    for (int m2 = 0; m2 < 2; ++m2) { const int m = 2 * mh + m2; bf16_t* dst = R.dst(EPI_ROW(ai, m)) + cb;
#pragma unroll
                        for (int bj = 0; bj < 2; ++bj) { const f32x4 a = x[m2][bj][0] + g[bj][0] * acc[ai][bj][m][0], b = x[m2][bj][1] + g[bj][1] * acc[ai][bj][m][1];
                            u32x4 w; w.x = cvtpk(a[0], a[1]); w.y = cvtpk(a[2], a[3]); w.z = cvtpk(b[0], b[1]); w.w = cvtpk(b[2], b[3]); *(u32x4*)(dst + bj * 128) = w; } }
                }
            } else {
                u32x4 x[4][2];
#pragma unroll
                for (int m = 0; m < 4; ++m) { const bf16_t* src = R.dst(EPI_ROW(ai, m)) + cb;
#pragma unroll
                    for (int bj = 0; bj < 2; ++bj) x[m][bj] = *(const u32x4*)(src + bj * 128); }
#pragma unroll
                for (int m = 0; m < 4; ++m) { bf16_t* dst = R.dst(EPI_ROW(ai, m)) + cb;
#pragma unroll
                    for (int bj = 0; bj < 2; ++bj) { float f[8]; unpack8(x[m][bj], f);
                        const f32x4 a = (f32x4){f[0], f[1], f[2], f[3]} + g[bj][0] * acc[ai][bj][m][0], b = (f32x4){f[4], f[5], f[6], f[7]} + g[bj][1] * acc[ai][bj][m][1];
                        u32x4 w; w.x = cvtpk(a[0], a[1]); w.y = cvtpk(a[2], a[3]); w.z = cvtpk(b[0], b[1]); w.w = cvtpk(b[2], b[3]); *(u32x4*)(dst + bj * 128) = w; } }
            }
            __builtin_amdgcn_sched_barrier(0);
        }
    }
};

struct EpiMoeUp {
    EPI_NOHOOK
    const int* LIST; const float* WGT; bf16_t* MACT;
    __device__ __forceinline__ void operator()(const pg8::Acc& acc, const pg8::Unit& u_, int wr, int wc, int fr, int fq) const {
        EPI_OPAQUE
        const int slot = u.pn >> 2;
        int tok[2][4]; float w[2][4];
#pragma unroll
        for (int ai = 0; ai < 2; ++ai)
#pragma unroll
            for (int m = 0; m < 4; ++m) { const int ri = ai * 128 + wr * 64 + m * 16 + fr; tok[ai][m] = LIST[u.aux0 + (ri < u.aux1 ? ri : 0)]; }
#pragma unroll
        for (int ai = 0; ai < 2; ++ai)
#pragma unroll
            for (int m = 0; m < 4; ++m) w[ai][m] = WGT[(size_t)tok[ai][m] * 2 + slot];
#pragma unroll
        for (int ai = 0; ai < 2; ++ai)
#pragma unroll
        for (int m = 0; m < 4; ++m) {
            const int ri = ai * 128 + wr * 64 + m * 16 + fr; const float ww = w[ai][m];
#pragma unroll
            for (int bj = 0; bj < 2; ++bj) {
                const int c0 = bj * 128 + wc * 32 + 8 * fq;
                EPI_V8(v, acc, ai, bj, m)
                u32x2 o; o.x = cvtpk(silu_fast(v[0]) * v[1] * ww, silu_fast(v[2]) * v[3] * ww); o.y = cvtpk(silu_fast(v[4]) * v[5] * ww, silu_fast(v[6]) * v[7] * ww);
                *(u32x2*)(MACT + (size_t)(u.pm * 256 + ri) * 1024 + slot * 512 + (u.pn & 3) * 128 + (c0 >> 1)) = o;
            }
        }
    }
};
struct EpiMoeUp8 {
    EPI_NOHOOK
    const int* LIST; const float* WGT; unsigned char* MACT;
    __device__ __forceinline__ void operator()(const pg8::Acc& acc, const pg8::Unit& u_, int wr, int wc, int fr, int fq) const {
        EPI_OPAQUE
        const int slot = u.pn >> 2;
        int tok[2][4]; float w[2][4];
#pragma unroll
        for (int ai = 0; ai < 2; ++ai)
#pragma unroll
            for (int m = 0; m < 4; ++m) { const int ri = ai * 128 + wr * 64 + m * 16 + fr; tok[ai][m] = LIST[u.aux0 + (ri < u.aux1 ? ri : 0)]; }
#pragma unroll
        for (int ai = 0; ai < 2; ++ai)
#pragma unroll
            for (int m = 0; m < 4; ++m) w[ai][m] = WGT[(size_t)tok[ai][m] * 2 + slot] * MA8S;
#pragma unroll
        for (int ai = 0; ai < 2; ++ai)
#pragma unroll
        for (int m = 0; m < 4; ++m) {
            const int ri = ai * 128 + wr * 64 + m * 16 + fr; const float ww = w[ai][m];
#pragma unroll
            for (int bj = 0; bj < 2; ++bj) {
                const int c0 = bj * 128 + wc * 32 + 8 * fq;
                EPI_V8(v, acc, ai, bj, m)
                int o = __builtin_amdgcn_cvt_pk_fp8_f32(silu_fast(v[0]) * v[1] * ww, silu_fast(v[2]) * v[3] * ww, 0, false); o = __builtin_amdgcn_cvt_pk_fp8_f32(silu_fast(v[4]) * v[5] * ww, silu_fast(v[6]) * v[7] * ww, o, true);
                *(int*)(MACT + (size_t)(u.pm * 256 + ri) * 1024 + slot * 512 + (u.pn & 3) * 128 + (c0 >> 1)) = o;
            }
        }
    }
};
struct EpiMoeDown {
    EPI_NOHOOK
    const int* LIST; Resid R; const float* MODL; bf16_t* dry;
    __device__ __forceinline__ void operator()(const pg8::Acc& acc, const pg8::Unit& u_, int wr, int wc, int fr, int fq) const {
        EPI_OPAQUE
        int tok[2][4];
#pragma unroll
        for (int ai = 0; ai < 2; ++ai)
#pragma unroll
            for (int m = 0; m < 4; ++m) { const int ri = ai * 128 + wr * 64 + m * 16 + fr; tok[ai][m] = LIST[u.aux0 + (ri < u.aux1 ? ri : 0)]; }
        const int cb = u.pn * 256 + wc * 32 + 8 * fq;
#pragma unroll
        for (int ai = 0; ai < 2; ++ai) {
            u32x4 x[4][2];
#pragma unroll
            for (int m = 0; m < 4; ++m) { const bf16_t* dst = R.dst(tok[ai][m]) + cb;
#pragma unroll
                for (int bj = 0; bj < 2; ++bj) x[m][bj] = *(const u32x4*)(dst + bj * 128); }
#pragma unroll
            for (int m = 0; m < 4; ++m) { const int ri = ai * 128 + wr * 64 + m * 16 + fr;
                if (ri < u.aux1) {
                    bf16_t* dst = R.dst(tok[ai][m]) + cb; const float* g2 = MODL + R.modv(tok[ai][m]) * 6144 + 5120 + cb;
#pragma unroll
                    for (int bj = 0; bj < 2; ++bj) { float f[8]; unpack8(x[m][bj], f);
                        const f32x4 ga = *(const f32x4*)(g2 + bj * 128), gb = *(const f32x4*)(g2 + bj * 128 + 4);
                        const f32x4 a = (f32x4){f[0], f[1], f[2], f[3]} + ga * acc[ai][bj][m][0], b = (f32x4){f[4], f[5], f[6], f[7]} + gb * acc[ai][bj][m][1];
                        u32x4 w; w.x = cvtpk(a[0], a[1]); w.y = cvtpk(a[2], a[3]); w.z = cvtpk(b[0], b[1]); w.w = cvtpk(b[2], b[3]);
                        bf16_t* o = dry ? dry + (size_t)(u.pm * 256 + ri) * 1024 + cb + bj * 128 : dst + bj * 128;
                        *(u32x4*)o = w; }
                } }
            __builtin_amdgcn_sched_barrier(0);
        }
    }
};
#define SBAR() __builtin_amdgcn_sched_barrier(0)
__device__ __forceinline__ int crow(int r, int hi) { return (r & 3) + 8 * (r >> 2) + 4 * hi; }
template <int NCB> __device__ __forceinline__ int v_st(int k, int c) { const int kk = (k & ~0xC) | ((k & 4) << 1) | ((k & 8) >> 1); return ((kk >> 3) * NCB + (c >> 5)) * 512 + ((kk & 7) * 32 + (c & 31)) * 2; }
__device__ __forceinline__ int v_rd_base(int lane) { return ((lane & 3) << 3) | (((lane >> 2) & 3) << 6) | (((lane >> 4) & 1) << 5) | (((lane >> 5) & 1) << 8); }
template <int OFF> __device__ __forceinline__ s16x4 tr_read(int vb) { s16x4 r; asm volatile("ds_read_b64_tr_b16 %0, %1 offset:%2" : "=&v"(r) : "v"(vb), "i"(OFF) : "memory"); return r; }
#define PKLH(L, H) (bf16x8){L[0], L[1], L[2], L[3], H[0], H[1], H[2], H[3]}
template <int NCB, int KS> __device__ __forceinline__ bf16x8 tr_frag(int vb) { const s16x4 l = tr_read<KS * NCB * 1024>(vb), h = tr_read<KS * NCB * 1024 + NCB * 512>(vb); return PKLH(l, h); }
#define PK4(P, BASE, OUT) do { const unsigned a0 = cvtpk(P[BASE + 0], P[BASE + 1]), a1 = cvtpk(P[BASE + 2], P[BASE + 3]);   \
    const unsigned b0 = cvtpk(P[BASE + 4], P[BASE + 5]), b1 = cvtpk(P[BASE + 6], P[BASE + 7]);                              \
    auto r0 = __builtin_amdgcn_permlane32_swap(a0, b0, false, false); auto r1 = __builtin_amdgcn_permlane32_swap(a1, b1, false, false); \
    u32x4 w = {r0[0], r1[0], r0[1], r1[1]}; OUT = __builtin_bit_cast(bf16x8, w); } while (0)

namespace att {
constexpr int DQK = 96, DV = 64, KVBLK = 64;
constexpr int SHM_V = KVBLK * DV * 2;
constexpr int SHM_K = KVBLK * 256;
constexpr float THR = 8.f;
#define KSWZ(row, colB) ((row) * 256 + ((colB) ^ (((row) & 7) << 4)))
__device__ __forceinline__ void partialSM(f32x16& p0, f32x16& p1, float& m_reg, float& alpha) {
    float pmax = p0[0];
#pragma unroll
    for (int r = 1; r < 16; ++r) pmax = fmaxf(pmax, p0[r]);
#pragma unroll
    for (int r = 0; r < 16; ++r) pmax = fmaxf(pmax, p1[r]);
    { auto rr = __builtin_amdgcn_permlane32_swap(__float_as_uint(pmax), __float_as_uint(pmax), false, false);
      pmax = fmaxf(__uint_as_float(rr[0]), __uint_as_float(rr[1])); }
    float mn;
    if (__builtin_expect(__all(pmax - m_reg <= THR), 1)) { mn = m_reg; alpha = 1.f; }
    else { mn = fmaxf(m_reg, pmax); alpha = __builtin_amdgcn_exp2f(m_reg - mn); m_reg = mn; }
#pragma unroll
    for (int r = 0; r < 16; ++r) p0[r] = p0[r] - mn;
#pragma unroll
    for (int r = 0; r < 16; ++r) p1[r] = p1[r] - mn;
#pragma unroll
    for (int r = 0; r < 16; ++r) p0[r] = __builtin_amdgcn_exp2f(p0[r]);
}
__device__ __forceinline__ void finishSM(f32x16& p0, f32x16& p1, float alpha, float& l_reg, bf16x8& pa0, bf16x8& pa1, bf16x8& pa2, bf16x8& pa3) {
#pragma unroll
    for (int r = 0; r < 16; ++r) p1[r] = __builtin_amdgcn_exp2f(p1[r]);
    float ps = 0;
#pragma unroll
    for (int r = 0; r < 16; ++r) ps += p0[r];
#pragma unroll
    for (int r = 0; r < 16; ++r) ps += p1[r];
    { auto rr = __builtin_amdgcn_permlane32_swap(__float_as_uint(ps), __float_as_uint(ps), false, false);
      ps = __uint_as_float(rr[0]) + __uint_as_float(rr[1]); }
    l_reg = l_reg * alpha + ps;
    PK4(p0, 0, pa0); PK4(p0, 8, pa1); PK4(p1, 0, pa2); PK4(p1, 8, pa3);
}
__device__ __forceinline__ void qkt(f32x16& p0, f32x16& p1, const LAS char* Ks, const bf16x8* qr, int r32, int hi) {
    p0 = f32x16{}; p1 = f32x16{};
#pragma unroll
    for (int d0 = 0; d0 < 6; ++d0) { const int cb = (d0 * 16 + hi * 8) * 2;
        const bf16x8 b0 = *(const LAS bf16x8*)(Ks + KSWZ(r32, cb));
        const bf16x8 b1 = *(const LAS bf16x8*)(Ks + KSWZ(32 + r32, cb));
        p0 = __builtin_amdgcn_mfma_f32_32x32x16_bf16(b0, qr[d0], p0, 0, 0, 0);
        p1 = __builtin_amdgcn_mfma_f32_32x32x16_bf16(b1, qr[d0], p1, 0, 0, 0); }
}
template <int D0> __device__ __forceinline__ void pv_one(f32x16& od, int vb, bf16x8 pa0, bf16x8 pa1, bf16x8 pa2, bf16x8 pa3) {
    const bf16x8 f0 = tr_frag<2, 0>(vb + D0 * 512), f1 = tr_frag<2, 1>(vb + D0 * 512), f2 = tr_frag<2, 2>(vb + D0 * 512), f3 = tr_frag<2, 3>(vb + D0 * 512);
    asm volatile("s_waitcnt lgkmcnt(0)" ::: "memory"); SBAR();
    od = __builtin_amdgcn_mfma_f32_32x32x16_bf16(pa0, f0, od, 0, 0, 0);
    od = __builtin_amdgcn_mfma_f32_32x32x16_bf16(pa1, f1, od, 0, 0, 0);
    od = __builtin_amdgcn_mfma_f32_32x32x16_bf16(pa2, f2, od, 0, 0, 0);
    od = __builtin_amdgcn_mfma_f32_32x32x16_bf16(pa3, f3, od, 0, 0, 0);
}
__device__ __forceinline__ void pv_d0(f32x16* o, int vb, bf16x8 pa0, bf16x8 pa1, bf16x8 pa2, bf16x8 pa3) {
    pv_one<0>(o[0], vb, pa0, pa1, pa2, pa3); pv_one<1>(o[1], vb, pa0, pa1, pa2, pa3);
}
__device__ __forceinline__ void attn_unit(const bf16_t* __restrict__ Qb, const bf16_t* __restrict__ Kh, const bf16_t* __restrict__ Vh, bf16_t* __restrict__ Ob, int ldo, int seq, LAS char* lds, const int wv) {
    const int tid = otid(wv), wid = __builtin_amdgcn_readfirstlane(tid >> 6), lane = tid & 63, r32 = lane & 31, hi = lane >> 5;
    LAS char* V_lds = lds; LAS char* K_lds = lds + 2 * SHM_V;
    LAS float* ws = (LAS float*)(lds + 2 * SHM_V + 2 * SHM_K) + wid * 64; LAS float* li_l = ws; LAS float* al_l = ws + 32;
    float m_reg = -1e30f, l_reg = 0; f32x16 o[2] = {}; bf16x8 qr[6];
    const bf16_t* Qw = Qb + (size_t)(wid * 32 + r32) * DQK + hi * 8;
#pragma unroll
    for (int d0 = 0; d0 < 6; ++d0) qr[d0] = *(const bf16x8*)(Qw + d0 * 16);
    const int vrow = tid >> 3, vc = (tid & 7) * 8, vst = v_st<2>(vrow, vc);
    const int krA = tid / 12, kcA = tid - krA * 12, sB = 512 + tid, krB = sB / 12, kcB = sB - krB * 12;
    const int kstA = KSWZ(krA, kcA * 16), kstB = KSWZ(krB, kcB * 16);
    const bool hasB = wid < 4;
    const int vb0 = (int)(size_t)V_lds + v_rd_base(lane);
    struct { bf16x8 v, ka, kb; } sr_[2];
#define SLOAD(i, k0) do { sr_[i].v = *(const bf16x8*)(Vh + (size_t)((k0) + vrow) * DV + vc); sr_[i].ka = *(const bf16x8*)(Kh + (size_t)((k0) + krA) * DQK + kcA * 8); \
    if (hasB) sr_[i].kb = *(const bf16x8*)(Kh + (size_t)((k0) + krB) * DQK + kcB * 8); } while (0)
#define SWRITE(b, i) do { *(LAS bf16x8*)(V_lds + (b) * SHM_V + vst) = sr_[i].v; *(LAS bf16x8*)(K_lds + (b) * SHM_K + kstA) = sr_[i].ka; \
    if (hasB) *(LAS bf16x8*)(K_lds + (b) * SHM_K + kstB) = sr_[i].kb; } while (0)
#define RESC(a) do { if (__any((a) < 1.f)) { if (hi == 0) al_l[r32] = (a); asm volatile("s_waitcnt lgkmcnt(0)" ::: "memory"); \
    _Pragma("unroll") for (int d = 0; d < 2; ++d) _Pragma("unroll") for (int r = 0; r < 16; ++r) o[d][r] *= al_l[crow(r, hi)]; } } while (0)
    f32x16 pA0, pA1, pB0, pB1; float alA, alB; bf16x8 pa0, pa1, pa2, pa3; const int NTL = seq / KVBLK;
    SLOAD(0, 0); SWRITE(0, 0); __syncthreads();
    qkt(pA0, pA1, K_lds, qr, r32, hi); partialSM(pA0, pA1, m_reg, alA);
    SLOAD(1, KVBLK); if (2 < NTL) SLOAD(0, 2 * KVBLK);
    SWRITE(1, 1); __syncthreads();
    for (int j = 1; j + 1 < NTL; j += 2) {
        SBAR(); qkt(pB0, pB1, K_lds + SHM_K, qr, r32, hi);
        finishSM(pA0, pA1, alA, l_reg, pa0, pa1, pa2, pa3); SBAR();
        SLOAD(1, (j + 2) * KVBLK); SBAR();
        pv_d0(o, vb0, pa0, pa1, pa2, pa3); partialSM(pB0, pB1, m_reg, alB);
        __syncthreads(); SWRITE(0, 0);
        RESC(alB); __syncthreads();
        SBAR(); qkt(pA0, pA1, K_lds, qr, r32, hi);
        finishSM(pB0, pB1, alB, l_reg, pa0, pa1, pa2, pa3); SBAR();
        if (j + 3 < NTL) SLOAD(0, (j + 3) * KVBLK); SBAR();
        pv_d0(o, vb0 + SHM_V, pa0, pa1, pa2, pa3); partialSM(pA0, pA1, m_reg, alA);
        __syncthreads(); SWRITE(1, 1);
        RESC(alA); __syncthreads();
    }
    SBAR(); qkt(pB0, pB1, K_lds + SHM_K, qr, r32, hi);
    finishSM(pA0, pA1, alA, l_reg, pa0, pa1, pa2, pa3); SBAR();
    pv_d0(o, vb0, pa0, pa1, pa2, pa3); partialSM(pB0, pB1, m_reg, alB);
    __syncthreads(); RESC(alB);
    finishSM(pB0, pB1, alB, l_reg, pa0, pa1, pa2, pa3); SBAR();
    pv_d0(o, vb0 + SHM_V, pa0, pa1, pa2, pa3);
    if (hi == 0) li_l[r32] = l_reg; asm volatile("s_waitcnt lgkmcnt(0)" ::: "memory");
    float rli[16];
#pragma unroll
    for (int r = 0; r < 16; ++r) rli[r] = __builtin_amdgcn_rcpf(li_l[crow(r, hi)]);
    bf16_t* Ow = Ob + (size_t)(wid * 32) * ldo;
#pragma unroll
    for (int r = 0; r < 16; ++r) { const int orow = crow(r, hi);
#pragma unroll
        for (int d0 = 0; d0 < 2; ++d0) Ow[(size_t)orow * ldo + d0 * 32 + r32] = f2bf(o[d0][r] * rli[r]); }
    __syncthreads();
#undef SLOAD
#undef SWRITE
#undef RESC
}
}

namespace att2 {
constexpr int DQK = 96, DV = 64, KVBLK = 64;
constexpr int KB_BYTES = 64 * 128, VB_BYTES = 64 * 64;
typedef int i32x8 __attribute__((ext_vector_type(8)));
constexpr int SC_K = 0x7d7d7d7d, SC_Q = 0x7a7a7a7a, SC_P = 0x7f7f7f7f, SC_V = 0x7d7d7d7d;
constexpr int NSLOT = 5;
constexpr int LDS_K = 0, LDS_V = NSLOT * KB_BYTES, LDS_WS = LDS_V + NSLOT * VB_BYTES, LDS_TOTAL = LDS_WS + 8 * 64 * 4;
static_assert(LDS_TOTAL <= RING_BYTES, "attention LDS");
constexpr float THR = 4.f;
typedef short v4i16_t __attribute__((ext_vector_type(4)));
__device__ __forceinline__ s16x4 vtr(const LAS char* p) { return __builtin_bit_cast(s16x4, __builtin_amdgcn_ds_read_tr16_b64_v4i16((LAS v4i16_t*)p)); }
#define PP_KLD(B, DH) ({ const int row_ = 32 * (B) + r32, sw_ = (row_ >> 1) & 7, c0_ = 2 * hi + 4 * (DH); \
        const u32x4 a_ = *(const LAS u32x4*)(Kt + row_ * 128 + ((c0_ ^ sw_) << 4)), b_ = *(const LAS u32x4*)(Kt + row_ * 128 + (((c0_ + 1) ^ sw_) << 4)); \
        (i32x8){(int)a_.x, (int)a_.y, (int)a_.z, (int)a_.w, (int)b_.x, (int)b_.y, (int)b_.z, (int)b_.w}; })
#define PP_VLD(DB) ({ const int d_ = 32 * (DB) + r32, sw_ = (d_ >> 2) & 3; \
        const u32x4 a_ = *(const LAS u32x4*)(Vt + d_ * 64 + (((2 * hi) ^ sw_) << 4)), b_ = *(const LAS u32x4*)(Vt + d_ * 64 + (((2 * hi + 1) ^ sw_) << 4)); \
        (i32x8){(int)a_.x, (int)a_.y, (int)a_.z, (int)a_.w, (int)b_.x, (int)b_.y, (int)b_.z, (int)b_.w}; })
#ifdef PROBE_EXP2X
#define PP_EXP(x) do { float a_ = (x), b_ = (x); asm volatile("" : "+v"(b_)); a_ = __builtin_amdgcn_exp2f(a_); b_ = __builtin_amdgcn_exp2f(b_); (x) = (a_ + b_) * 0.5f; } while (0)
#else
#define PP_EXP(x) (x) = __builtin_amdgcn_exp2f(x)
#endif
#define PK4N(P, BASE, OUT) do { u32x4 w_ = {cvtpk(P[BASE + 0], P[BASE + 1]), cvtpk(P[BASE + 2], P[BASE + 3]), cvtpk(P[BASE + 4], P[BASE + 5]), cvtpk(P[BASE + 6], P[BASE + 7])}; OUT = __builtin_bit_cast(bf16x8, w_); } while (0)
#define PP_SLOT_END() do { SBAR(); asm volatile("s_waitcnt vmcnt(%0) lgkmcnt(0)\n\ts_barrier" :: "n"(2 * (NSLOT - 2)) : "memory"); SBAR(); } while (0)
#define PP_BAR() do { SBAR(); asm volatile("s_waitcnt lgkmcnt(0)\n\ts_barrier" ::: "memory"); SBAR(); } while (0)
__device__ __forceinline__ float max3f(float a, float b, float c) { return fmaxf(fmaxf(a, b), c); }
__device__ __forceinline__ void attn_unit_pp(const unsigned char* __restrict__ Qb, const unsigned char* __restrict__ Kh, const unsigned char* __restrict__ Vh, bf16_t* __restrict__ Ob, int ldo, int seq, LAS char* lds, const int wv) {
    const int tid = otid(wv), wid = __builtin_amdgcn_readfirstlane(tid >> 6), lane = tid & 63, r32 = lane & 31, hi = lane >> 5, grp = wid >> 2;
    LAS float* ws = (LAS float*)(lds + LDS_WS) + wid * 64; LAS float* al_l = ws;
    const int NTL = seq / KVBLK;
    unsigned koff, voff;
    { const int s = wid * 64 + lane, row = s >> 3, ch = (s & 7) ^ ((row >> 1) & 7); koff = (unsigned)(row * 128 + ch * 16); }
    { const int s = (wid & 3) * 64 + lane, d = s >> 2, ch = (s & 3) ^ ((d >> 2) & 3); voff = (unsigned)(d * SB + ch * 16); }
    const char* Kg = (const char*)Kh; const char* Vg = (const char*)Vh;
#define PP_DMA_K(t) do { int tt_ = (t); tt_ = tt_ < NTL ? tt_ : NTL - 1; const int sl_ = tt_ % NSLOT; \
        __builtin_amdgcn_global_load_lds((const unsigned*)(Kg + (size_t)tt_ * (64 * 128) + koff), (LAS unsigned*)(lds + LDS_K + sl_ * KB_BYTES + wid * 1024), 16, 0, 0); } while (0)
#define PP_DMA_V(t) do { int tt_ = (t); tt_ = tt_ < NTL ? tt_ : NTL - 1; const int sl_ = tt_ % NSLOT; \
        __builtin_amdgcn_global_load_lds((const unsigned*)(Vg + (size_t)tt_ * 64 + voff), (LAS unsigned*)(lds + LDS_V + sl_ * VB_BYTES + (wid & 3) * 1024), 16, 0, 0); } while (0)
#pragma unroll
    for (int i = 0; i <= NSLOT - 2; ++i) PP_DMA_K(i);
#pragma unroll
    for (int i = 0; i <= NSLOT - 3; ++i) PP_DMA_V(i);
    i32x8 q8[2];
    { const unsigned char* Qw = Qb + (size_t)(wid * 32 + r32) * 128 + hi * 32;
#pragma unroll
      for (int dh = 0; dh < 2; ++dh) { const u32x4 a_ = *(const u32x4*)(Qw + dh * 64), b_ = *(const u32x4*)(Qw + dh * 64 + 16);
          q8[dh] = (i32x8){(int)a_.x, (int)a_.y, (int)a_.z, (int)a_.w, (int)b_.x, (int)b_.y, (int)b_.z, (int)b_.w}; } }
    float m_reg = 0.f; f32x16 o[2] = {}; f32x16 lacc = {}; const i32x8 ones8 = {0x38383838, 0x38383838, 0x38383838, 0x38383838, 0x38383838, 0x38383838, 0x38383838, 0x38383838}; f32x16 negm = {}; asm volatile("" : "+v"(negm));
    f32x16 p0, p1; i32x8 pa8 = {};
    SBAR(); asm volatile("s_waitcnt vmcnt(0) lgkmcnt(0)\n\ts_barrier" ::: "memory"); SBAR();
#ifdef ATTN_TWO_BARRIERS
    if (grp == 1) PP_BAR();
#endif
#define PP_M(t) do { const int t_ = (t), j_ = t_ + 1; \
        if (t_ <= NTL - 2) { PP_DMA_V(t_ + NSLOT - 1); PP_DMA_K(t_ + NSLOT); } \
        i32x8 k8[4]; i32x8 v8[2]; \
        const LAS char* Kt = lds + LDS_K + ((j_ < NTL ? j_ : 0) % NSLOT) * KB_BYTES; \
        const LAS char* Vt = lds + LDS_V + ((t_ < 0 ? 0 : t_) % NSLOT) * VB_BYTES; \
        if (j_ < NTL) { \
            k8[0] = PP_KLD(0, 0); k8[1] = PP_KLD(1, 0); SBAR(); \
            k8[2] = PP_KLD(0, 1); SBAR(); \
            p0 = __builtin_amdgcn_mfma_scale_f32_32x32x64_f8f6f4(k8[0], q8[0], negm, 0, 0, 0, SC_K, 0, SC_Q); SBAR(); \
            k8[3] = PP_KLD(1, 1); SBAR(); \
            p1 = __builtin_amdgcn_mfma_scale_f32_32x32x64_f8f6f4(k8[1], q8[0], negm, 0, 0, 0, SC_K, 0, SC_Q); SBAR(); \
            if (t_ >= 0) { v8[0] = PP_VLD(0); } SBAR(); \
            p0 = __builtin_amdgcn_mfma_scale_f32_32x32x64_f8f6f4(k8[2], q8[1], p0, 0, 0, 0, SC_K, 0, SC_Q); SBAR(); \
            if (t_ >= 0) { v8[1] = PP_VLD(1); } SBAR(); \
            p1 = __builtin_amdgcn_mfma_scale_f32_32x32x64_f8f6f4(k8[3], q8[1], p1, 0, 0, 0, SC_K, 0, SC_Q); SBAR(); \
        } else if (t_ >= 0) { v8[0] = PP_VLD(0); v8[1] = PP_VLD(1); SBAR(); } \
        if (t_ >= 0) { \
            o[0] = __builtin_amdgcn_mfma_scale_f32_32x32x64_f8f6f4(pa8, v8[0], o[0], 0, 0, 0, SC_P, 0, SC_V); \
            o[1] = __builtin_amdgcn_mfma_scale_f32_32x32x64_f8f6f4(pa8, v8[1], o[1], 0, 0, 0, SC_P, 0, SC_V); \
            lacc = __builtin_amdgcn_mfma_scale_f32_32x32x64_f8f6f4(pa8, ones8, lacc, 0, 0, 0, SC_P, 0, SC_P); } \
        asm volatile("" : "+v"(o[0]), "+v"(o[1]), "+v"(p0), "+v"(p1), "+v"(lacc));        \
        } while (0)
#define PP_S(first) do { \
        float a_ = max3f(p0[0], p0[1], p1[0]), b_ = max3f(p0[2], p0[3], p1[1]); a_ = max3f(a_, p1[2], p1[3]); \
        _Pragma("unroll") for (int r = 4; r < 16; r += 4) { a_ = max3f(a_, p0[r], p0[r + 1]); b_ = max3f(b_, p0[r + 2], p0[r + 3]); a_ = max3f(a_, p1[r], p1[r + 1]); b_ = max3f(b_, p1[r + 2], p1[r + 3]); } \
        float rm_ = fmaxf(a_, b_); { auto rr = __builtin_amdgcn_permlane32_swap(__float_as_uint(rm_), __float_as_uint(rm_), false, false); rm_ = fmaxf(__uint_as_float(rr[0]), __uint_as_float(rr[1])); } \
        if (first) { const float dl = rm_ - 4.f; m_reg = dl; _Pragma("unroll") for (int r = 0; r < 16; ++r) { p0[r] -= dl; p1[r] -= dl; } \
            _Pragma("unroll") for (int r = 0; r < 16; ++r) negm[r] = -m_reg; asm volatile("" : "+v"(negm)); } \
        else if (__builtin_expect(__any(rm_ > 2.f * THR), 0)) { const float dl = fmaxf(rm_ - THR, 0.f); m_reg += dl; \
            _Pragma("unroll") for (int r = 0; r < 16; ++r) { p0[r] -= dl; p1[r] -= dl; } \
            _Pragma("unroll") for (int r = 0; r < 16; ++r) negm[r] = -m_reg; asm volatile("" : "+v"(negm)); \
            const float al = __builtin_amdgcn_exp2f(-dl); if (hi == 0) al_l[r32] = al; asm volatile("s_waitcnt lgkmcnt(0)" ::: "memory"); \
            _Pragma("unroll") for (int r = 0; r < 16; ++r) { const float f_ = al_l[crow(r, hi)]; o[0][r] *= f_; o[1][r] *= f_; lacc[r] *= f_; } } \
        _Pragma("unroll") for (int r = 0; r < 16; ++r) { PP_EXP(p0[r]); PP_EXP(p1[r]); } \
        _Pragma("unroll") for (int k_ = 0; k_ < 4; ++k_) { \
            int w_ = __builtin_amdgcn_cvt_pk_fp8_f32(p0[4 * k_], p0[4 * k_ + 1], 0, false); w_ = __builtin_amdgcn_cvt_pk_fp8_f32(p0[4 * k_ + 2], p0[4 * k_ + 3], w_, true); pa8[k_] = w_; \
            int x_ = __builtin_amdgcn_cvt_pk_fp8_f32(p1[4 * k_], p1[4 * k_ + 1], 0, false); x_ = __builtin_amdgcn_cvt_pk_fp8_f32(p1[4 * k_ + 2], p1[4 * k_ + 3], x_, true); pa8[4 + k_] = x_; } \
        asm volatile("" : "+v"(pa8)); } while (0)
#ifdef ATTN_TWO_BARRIERS
    PP_M(-1); PP_SLOT_END();
    PP_S(true); PP_SLOT_END();
#pragma nounroll
    for (int t = 0; t < NTL - 1; ++t) {
        PP_M(t); PP_SLOT_END();
        PP_S(false); PP_SLOT_END();
    }
    PP_M(NTL - 1);
    if (grp == 0) PP_BAR();
#else
#ifdef ATTN_PRIO_YOUNG
    if (grp == 1) __builtin_amdgcn_s_setprio(1);
#endif
    if (grp == 0) {
        PP_M(-1); PP_S(true); PP_SLOT_END();
#pragma nounroll
        for (int t = 0; t < NTL - 1; ++t) { PP_M(t); PP_S(false); PP_SLOT_END(); }
        PP_M(NTL - 1);
    } else {
        PP_M(-1); PP_SLOT_END();
        PP_S(true);
#pragma nounroll
        for (int t = 0; t < NTL - 1; ++t) { PP_M(t); PP_SLOT_END(); PP_S(false); }
        PP_M(NTL - 1);
    }
#ifdef ATTN_PRIO_YOUNG
    __builtin_amdgcn_s_setprio(0);
#endif
#endif
    float rli[16];
#pragma unroll
    for (int r = 0; r < 16; ++r) rli[r] = __builtin_amdgcn_rcpf(lacc[r]);
    bf16_t* Ow = Ob + (size_t)(wid * 32) * ldo;
#pragma unroll
    for (int r = 0; r < 16; ++r) { const int orow = crow(r, hi);
#pragma unroll
        for (int d0 = 0; d0 < 2; ++d0) Ow[(size_t)orow * ldo + d0 * 32 + r32] = f2bf(o[d0][r] * rli[r]); }
    SBAR(); asm volatile("s_waitcnt vmcnt(0) lgkmcnt(0)\n\ts_barrier" ::: "memory"); SBAR();
#undef PP_DMA_K
#undef PP_DMA_V
#undef PP_M
#undef PP_S
}
}

__device__ __forceinline__ void retu_unit(int unit, const bf16_t* PR, float* U, float lg2f, float lg2b, LAS char* lds, const int wv) {
    const int tid = otid(wv), wid = __builtin_amdgcn_readfirstlane(tid >> 6), lane = tid & 63, r32 = lane & 31, hi = lane >> 5;
    const int h = unit & 3, bc = unit >> 2, bl = bc / NCHUNK, c = bc - bl * NCHUNK;
    const size_t r0 = (size_t)bl * SB + (size_t)c * 128;
    LAS char* Vt = lds;
    LAS char* Kf = lds + 32768;
    LAS char* Kb = lds + 49152;
#pragma unroll
    for (int i = 0; i < 2; ++i) { const int ch = tid + i * 512, j = ch >> 3, c8 = (ch & 7) * 8;
        const u32x4 kw = *(const u32x4*)(PR + (r0 + j) * 1536 + 256 + h * 64 + c8);
        float f[8], g[8]; unpack8(kw, f);
        const float wf = __builtin_amdgcn_exp2f(lg2f * (float)(127 - j)), wb = __builtin_amdgcn_exp2f(lg2b * (float)j);
#pragma unroll
        for (int k = 0; k < 8; ++k) { g[k] = f[k] * wb; f[k] *= wf; }
        const int off = (j >> 6) * 8192 + v_st<2>(j & 63, c8);
        *(LAS u32x4*)(Kf + off) = pack8(f); *(LAS u32x4*)(Kb + off) = pack8(g); }
#pragma unroll
    for (int i = 0; i < 4; ++i) { const int ch = tid + i * 512, j = ch >> 4, c8 = (ch & 15) * 8;
        const u32x4 vw = *(const u32x4*)(PR + (r0 + j) * 1536 + 512 + h * 128 + c8);
        *(LAS u32x4*)(Vt + (j >> 6) * 16384 + v_st<4>(j & 63, c8)) = vw; }
    __syncthreads();
    const int eblk = wid & 3, dblk = wid >> 2;
    const int vbV = (int)(size_t)Vt + v_rd_base(lane) + eblk * 512, vbF = (int)(size_t)Kf + v_rd_base(lane) + dblk * 512, vbB = (int)(size_t)Kb + v_rd_base(lane) + dblk * 512;
    f32x16 aF = {}, aB = {};
#define RU_STEP(SUB, KS) do { const bf16x8 a = tr_frag<4, KS>(vbV + SUB * 16384), bf = tr_frag<2, KS>(vbF + SUB * 8192), bb = tr_frag<2, KS>(vbB + SUB * 8192); \
        asm volatile("s_waitcnt lgkmcnt(0)" ::: "memory"); SBAR(); \
        aF = __builtin_amdgcn_mfma_f32_32x32x16_bf16(a, bf, aF, 0, 0, 0); aB = __builtin_amdgcn_mfma_f32_32x32x16_bf16(a, bb, aB, 0, 0, 0); } while (0)
    RU_STEP(0, 0); RU_STEP(0, 1); RU_STEP(0, 2); RU_STEP(0, 3); RU_STEP(1, 0); RU_STEP(1, 1); RU_STEP(1, 2); RU_STEP(1, 3);
#undef RU_STEP
    float* Uf = U + (size_t)unit * 2 * 8192; float* Ub = Uf + 8192;
#pragma unroll
    for (int r = 0; r < 16; ++r) { const int e = 32 * eblk + crow(r, hi), d = 32 * dblk + r32; Uf[e * 64 + d] = aF[r]; Ub[e * 64 + d] = aB[r]; }
    __syncthreads();
}

__device__ __forceinline__ void retout_unit(int unit, const bf16_t* PR, const bf16_t* S, const float* gnw, bf16_t* ACT, float lg2f, float lg2b, LAS char* lds, const int wv) {
    const int tid = otid(wv), wid = __builtin_amdgcn_readfirstlane(tid >> 6), lane = tid & 63, r32 = lane & 31, hi = lane >> 5;
    const int h = unit & 3, bc = unit >> 2, bl = bc / NCHUNK, c = bc - bl * NCHUNK;
    const size_t r0 = (size_t)bl * SB + (size_t)c * 128;
    LAS char* Vt = lds; LAS float* part = (LAS float*)(lds + 32768);
    const int qblk = wid & 3, ehalf = wid >> 2, iq = 32 * qblk + r32;
    u32x4 vw[4];
#pragma unroll
    for (int i = 0; i < 4; ++i) { const int ch = tid + i * 512, j = ch >> 4, c8 = (ch & 15) * 8; vw[i] = *(const u32x4*)(PR + (r0 + j) * 1536 + 512 + h * 128 + c8); }
    bf16x8 qf[4], kf[4][4];
    { const bf16_t* qp = PR + (r0 + iq) * 1536 + h * 64 + hi * 8;
#pragma unroll
      for (int d0 = 0; d0 < 4; ++d0) qf[d0] = *(const bf16x8*)(qp + d0 * 16); }
#pragma unroll
    for (int jb = 0; jb < 4; ++jb) { const bf16_t* kp = PR + (r0 + 32 * jb + r32) * 1536 + 256 + h * 64 + hi * 8;
#pragma unroll
        for (int d0 = 0; d0 < 4; ++d0) kf[jb][d0] = *(const bf16x8*)(kp + d0 * 16); }
    const int orow = tid >> 2, oc = (tid & 3) * 32;
    u32x4 gw[4];
#pragma unroll
    for (int k = 0; k < 4; ++k) gw[k] = *(const u32x4*)(PR + (r0 + orow) * 1536 + 1024 + h * 128 + oc + 8 * k);
#pragma unroll
    for (int i = 0; i < 4; ++i) { const int ch = tid + i * 512, j = ch >> 4, c8 = (ch & 15) * 8; *(LAS u32x4*)(Vt + (j >> 6) * 16384 + v_st<4>(j & 63, c8)) = vw[i]; }
    f32x16 o[2] = {};
    __syncthreads();
    bf16x8 sf[2][4], sb[2][4];
    { const bf16_t* Sf = S + (size_t)unit * 2 * 8192; const bf16_t* Sb = Sf + 8192;
#pragma unroll
      for (int e0 = 0; e0 < 2; ++e0) { const int e = 64 * ehalf + 32 * e0 + r32;
#pragma unroll
        for (int d0 = 0; d0 < 4; ++d0) { sf[e0][d0] = *(const bf16x8*)(Sf + e * 64 + d0 * 16 + hi * 8); sb[e0][d0] = *(const bf16x8*)(Sb + e * 64 + d0 * 16 + hi * 8); } } }
    const int vb = (int)(size_t)Vt + v_rd_base(lane) + ehalf * 1024;
#pragma unroll
    for (int jb = 0; jb < 4; ++jb) {
        f32x16 p = {};
#pragma unroll
        for (int d0 = 0; d0 < 4; ++d0) p = __builtin_amdgcn_mfma_f32_32x32x16_bf16(kf[jb][d0], qf[d0], p, 0, 0, 0);
#pragma unroll
        for (int r = 0; r < 16; ++r) { const int dj = iq - (32 * jb + crow(r, hi));
            const float e = dj >= 0 ? lg2f * (float)dj : lg2b * (float)(-dj); p[r] *= __builtin_amdgcn_exp2f(e); }
        bf16x8 pa0, pa1; PK4(p, 0, pa0); PK4(p, 8, pa1);
        const int vj = vb + (jb >> 1) * 16384;
        if (jb & 1) {
            const bf16x8 f00 = tr_frag<4, 2>(vj), f01 = tr_frag<4, 3>(vj), f10 = tr_frag<4, 2>(vj + 512), f11 = tr_frag<4, 3>(vj + 512);
            asm volatile("s_waitcnt lgkmcnt(0)" ::: "memory"); SBAR();
            o[0] = __builtin_amdgcn_mfma_f32_32x32x16_bf16(pa0, f00, o[0], 0, 0, 0); o[0] = __builtin_amdgcn_mfma_f32_32x32x16_bf16(pa1, f01, o[0], 0, 0, 0);
            o[1] = __builtin_amdgcn_mfma_f32_32x32x16_bf16(pa0, f10, o[1], 0, 0, 0); o[1] = __builtin_amdgcn_mfma_f32_32x32x16_bf16(pa1, f11, o[1], 0, 0, 0);
        } else {
            const bf16x8 f00 = tr_frag<4, 0>(vj), f01 = tr_frag<4, 1>(vj), f10 = tr_frag<4, 0>(vj + 512), f11 = tr_frag<4, 1>(vj + 512);
            asm volatile("s_waitcnt lgkmcnt(0)" ::: "memory"); SBAR();
            o[0] = __builtin_amdgcn_mfma_f32_32x32x16_bf16(pa0, f00, o[0], 0, 0, 0); o[0] = __builtin_amdgcn_mfma_f32_32x32x16_bf16(pa1, f01, o[0], 0, 0, 0);
            o[1] = __builtin_amdgcn_mfma_f32_32x32x16_bf16(pa0, f10, o[1], 0, 0, 0); o[1] = __builtin_amdgcn_mfma_f32_32x32x16_bf16(pa1, f11, o[1], 0, 0, 0);
        }
    }
    {
        const float xf = __builtin_amdgcn_exp2f(lg2f * (float)(iq + 1)), xb = __builtin_amdgcn_exp2f(lg2b * (float)(128 - iq));
#pragma unroll
        for (int d0 = 0; d0 < 4; ++d0) {
            float f[8], g[8]; unpack8(__builtin_bit_cast(u32x4, qf[d0]), f);
#pragma unroll
            for (int k = 0; k < 8; ++k) { g[k] = f[k] * xb; f[k] *= xf; }
            const bf16x8 qa = __builtin_bit_cast(bf16x8, pack8(f)), qb = __builtin_bit_cast(bf16x8, pack8(g));
#pragma unroll
            for (int e0 = 0; e0 < 2; ++e0) { o[e0] = __builtin_amdgcn_mfma_f32_32x32x16_bf16(qa, sf[e0][d0], o[e0], 0, 0, 0); o[e0] = __builtin_amdgcn_mfma_f32_32x32x16_bf16(qb, sb[e0][d0], o[e0], 0, 0, 0); }
        }
    }
    float sq[16];
#pragma unroll
    for (int r = 0; r < 16; ++r) { float s = o[0][r] * o[0][r] + o[1][r] * o[1][r];
        sq[r] = sum32(s); }
    if (r32 == 0) {
#pragma unroll
        for (int r = 0; r < 16; ++r) part[wid * 32 + crow(r, hi)] = sq[r];
    }
    __syncthreads();
    const float g0 = gnw[h * 128 + 64 * ehalf + r32], g1 = gnw[h * 128 + 64 * ehalf + 32 + r32];
    LAS bf16_t* stg = (LAS bf16_t*)Vt;
#pragma unroll
    for (int r = 0; r < 16; ++r) { const int il = crow(r, hi);
        const float tot = part[wid * 32 + il] + part[(wid ^ 4) * 32 + il];
        const float rn = rsqrtf(tot * (1.f / 128.f) + RMS_EPS);
        LAS bf16_t* sp = stg + (32 * qblk + il) * 128 + 64 * ehalf + r32;
        sp[0] = f2bf(o[0][r] * rn * g0); sp[32] = f2bf(o[1][r] * rn * g1); }
    __syncthreads();
#pragma unroll
    for (int k = 0; k < 4; ++k) { float y[8], g[8]; unpack8(*(const LAS u32x4*)(stg + orow * 128 + oc + 8 * k), y); unpack8(gw[k], g);
#pragma unroll
        for (int q = 0; q < 8; ++q) y[q] *= silu_fast(g[q]);
        *(u32x4*)(ACT + (r0 + orow) * 1536 + h * 128 + oc + 8 * k) = pack8(y); }
    __syncthreads();
}
struct Args { const float* in[26]; float* out; unsigned char* ws; int ph_lo, ph_hi; };
struct Frame {
    LAS unsigned char* lds; int G, wv;
    const Args* a; float* out; unsigned char* ws;
};
__device__ __forceinline__ const float* in_ptr(const Args* a, int i) { int z; asm volatile("s_mov_b32 %0, 0" : "=s"(z)); return a->in[i + z]; }
#define INP(i) in_ptr(F.a, (i))
__device__ __forceinline__ unsigned char* ows(unsigned char* p) { asm volatile("" : "+s"(p)); return p; }
#ifdef SELFCHECK_ATTN
#define WSP(T, off) ((T*)(ows(F.ws) + (off)))
#else
#define WSP(T, off) ((T*)(F.ws + (off)))
#endif

__device__ __forceinline__ int srccol_in(int n) {
    if (n < 512) { const int base = n & ~255, hh = (n & 255) >> 6, p = n & 63; return base + hh * 64 + (p >> 1) + 32 * (p & 1); }
    if (n < 2048) return n;
    if (n < 3072) { const int j = (n - 2048) >> 1; return 2048 + j + 512 * (n & 1); }
    if (n < 3712) return n;
    if (n < 3744) { const int p = n - 3712, a = p >> 4, q = p & 15; return 3712 + a * 16 + (q >> 1) + 8 * (q & 1); }
    if (n < 3840) return -1;
    return n - 96;
}
__device__ __forceinline__ int srccol_uq(int n) { const int h = n / 96, d = n - h * 96; if (d < 64) return n; const int p = d - 64, a = p >> 4, q = p & 15; return h * 96 + 64 + a * 16 + (q >> 1) + 8 * (q & 1); }

__device__ __forceinline__ void cvt_item(const float* sp, int ldw, const float* scale, bf16_t* dst, int ldd, int n0, int k0, LAS float* scr, int lane) {
    float vv[32];
#pragma unroll
    for (int i = 0; i < 32; ++i) { const int kk = 2 * i + (lane >> 5); vv[i] = sp ? sp[(size_t)(k0 + kk) * ldw] : 0.f; }
    if (scale) {
#pragma unroll
        for (int i = 0; i < 32; ++i) vv[i] *= scale[k0 + 2 * i + (lane >> 5)];
    }
#pragma unroll
    for (int i = 0; i < 32; ++i) scr[(2 * i + (lane >> 5)) * 33 + (lane & 31)] = vv[i];
    asm volatile("s_waitcnt lgkmcnt(0)" ::: "memory");
    const int c = lane & 7;
#pragma unroll
    for (int j = 0; j < 4; ++j) { const int n = (lane >> 3) + 8 * j; const LAS float* s = scr + (8 * c) * 33 + n;
        u32x4 o; o.x = cvtpk(s[0 * 33], s[1 * 33]); o.y = cvtpk(s[2 * 33], s[3 * 33]); o.z = cvtpk(s[4 * 33], s[5 * 33]); o.w = cvtpk(s[6 * 33], s[7 * 33]);
        *(u32x4*)(dst + (size_t)(n0 + n) * ldd + k0 + 8 * c) = o; }
    asm volatile("s_waitcnt lgkmcnt(0)" ::: "memory");
}

__device__ __forceinline__ void cvt_item_fp8(const float* sp, int ldw, float sc, unsigned char* dst, int ldd, int n0, int k0, LAS float* scr, int lane) {
    float vv[32];
#pragma unroll
    for (int i = 0; i < 32; ++i) { const int kk = 2 * i + (lane >> 5); vv[i] = sp ? sp[(size_t)(k0 + kk) * ldw] * sc : 0.f; }
#pragma unroll
    for (int i = 0; i < 32; ++i) scr[(2 * i + (lane >> 5)) * 33 + (lane & 31)] = vv[i];
    asm volatile("s_waitcnt lgkmcnt(0)" ::: "memory");
    const int c = lane & 7;
#pragma unroll
    for (int j = 0; j < 4; ++j) { const int n = (lane >> 3) + 8 * j; const LAS float* s = scr + (8 * c) * 33 + n;
        float f[8];
#pragma unroll
        for (int q = 0; q < 8; ++q) f[q] = s[q * 33];
        *(u32x2*)(dst + (size_t)(n0 + n) * ldd + k0 + 8 * c) = pack8_fp8(f); }
    asm volatile("s_waitcnt lgkmcnt(0)" ::: "memory");
}
__device__ __forceinline__ f32x2 cossin_f(float ang) {
    const double x = (double)ang * 0.15915494309189535; const float r = (float)(x - rint(x));
    return (f32x2){__builtin_amdgcn_cosf(r), __builtin_amdgcn_sinf(r)};
}
__device__ __forceinline__ float lg2_gamma(const float* rd) { return -__builtin_amdgcn_logf(1.f + __builtin_amdgcn_exp2f(-rd[0] * LOG2E)); }
#define PHASE_IDS const int tid = otid(F.wv), lane = tid & 63, wave = __builtin_amdgcn_readfirstlane(tid >> 6), bid = obid(); (void)lane; (void)wave; (void)bid;
__device__ __forceinline__ void p0_prologue(Frame& F) {
    PHASE_IDS
    __syncthreads();
    if (bid < 48) {
        LAS float* sc = (LAS float*)F.lds;
        LAS float* red = (LAS float*)(F.lds + 40960);
        for (int i = tid; i < 9 * 1024; i += 512) { const int v = i >> 10, k = i & 1023; const float x = v < 8 ? INP(1)[v * 1024 + k] : INP(3)[k]; sc[i] = siluf_(x); }
        __syncthreads();
        const int l = bid / 24, col = (bid % 24) * 256 + (tid & 255), kq = tid >> 8;
        const float* w = INP(4) + (size_t)l * 1024 * 6144 + col;
        float a[9];
#pragma unroll
        for (int v = 0; v < 9; ++v) a[v] = 0.f;
#pragma nounroll
        for (int k = kq * 512; k < kq * 512 + 512; k += 16) {
            float wv_[16];
#pragma unroll
            for (int j = 0; j < 16; ++j) wv_[j] = w[(size_t)(k + j) * 6144];
#pragma unroll
            for (int j4 = 0; j4 < 4; ++j4)
#pragma unroll
                for (int v = 0; v < 9; ++v) { const f32x4 s = *(const LAS f32x4*)(sc + v * 1024 + k + 4 * j4); a[v] += (s[0] * wv_[4 * j4] + s[1] * wv_[4 * j4 + 1]) + (s[2] * wv_[4 * j4 + 2] + s[3] * wv_[4 * j4 + 3]); }
        }
        if (kq == 1) {
#pragma unroll
            for (int v = 0; v < 9; ++v) red[v * 256 + (tid & 255)] = a[v];
        }
        __syncthreads();
        if (kq == 0) { float* MOD = WSP(float, WS_MOD) + (size_t)l * 9 * 6144; const float b = INP(5)[l * 6144 + col];
#pragma unroll
            for (int v = 0; v < 9; ++v) MOD[v * 6144 + col] = b + a[v] + red[v * 256 + tid]; }
        __syncthreads();
    }
    { f32x2* RT = WSP(f32x2, WS_RT); f32x2* MT = WSP(f32x2, WS_MT);
      for (int i = bid * 512 + tid; i < 8192 * 32 + 128 * 8; i += F.G * 512) {
          if (i < 8192 * 32) { const int t = i >> 5, k = i & 31; const float inv = exp2f(-(float)k * (13.287712379549449f / 32.f)); RT[i] = cossin_f((float)t * inv); }
          else { const int q = i - 8192 * 32, pos = q >> 3, k = q & 7; const float inv = exp2f(-(float)k * (13.287712379549449f / 8.f)); MT[q] = cossin_f((float)pos * inv); } } }
    LAS float* scr = (LAS float*)(F.lds + wave * 16384);
    const int gw = bid * 8 + wave, NGW = F.G * 8;
    constexpr int I_G8 = 2 * 16 * 96; constexpr int I_IN = 2 * 16 * 216, I_CAT = 2 * 3 * 8 * 32, I_OUT = 2 * 16 * 32, I_UQ = 2 * 6 * 24, I_UKV = 2 * 4 * 32, I_UP = 32 * 16 * 32, I_W2 = 32 * 8 * 32;
    constexpr int NITEMS = I_IN + I_CAT + I_OUT + I_UQ + I_UKV + I_UP + I_W2 + I_G8;
    for (int it = gw; it < NITEMS; it += NGW) {
        int r = it;
        if (r < I_IN) { const int l = r / 3456, q = r % 3456, kb = q / 216, nb = q % 216; const int sc_ = srccol_in(nb * 32 + (lane & 31));
            cvt_item(sc_ >= 0 ? INP(8) + (size_t)l * 1024 * INCOLS + sc_ : nullptr, INCOLS, nullptr, WSP(bf16_t, WS_WIN) + (size_t)l * INW * 1024, 1024, nb * 32, kb * 64, scr, lane); continue; } r -= I_IN;
        if (r < I_CAT) { const int l = r / 768, q = r % 768, seg = q / 256, q2 = q % 256, kb = q2 / 32, nb = q2 % 32; const float* W = seg == 0 ? INP(11) : (seg == 1 ? INP(13) : INP(18));
            cvt_item(W + (size_t)l * 512 * 1024 + nb * 32 + (lane & 31), 1024, nullptr, WSP(bf16_t, WS_WCAT) + (size_t)l * 1024 * 1536 + seg * 512, 1536, nb * 32, kb * 64, scr, lane); continue; } r -= I_CAT;
        if (r < I_OUT) { const int l = r / 512, q = r % 512, kb = q / 32, nb = q % 32;
            cvt_item(INP(19) + (size_t)l * 1024 * 1024 + nb * 32 + (lane & 31), 1024, nullptr, WSP(bf16_t, WS_WOUT) + (size_t)l * 1024 * 1024, 1024, nb * 32, kb * 64, scr, lane); continue; } r -= I_OUT;
        if (r < I_UQ) { const int l = r / 144, q = r % 144, kb = q / 24, nb = q % 24;
            cvt_item(INP(15) + (size_t)l * 384 * 768 + srccol_uq(nb * 32 + (lane & 31)), 768, INP(14) + l * 384, WSP(bf16_t, WS_WUQ) + (size_t)l * 768 * 384, 384, nb * 32, kb * 64, scr, lane); continue; } r -= I_UQ;
        if (r < I_UKV) { const int l = r / 128, q = r % 128, kb = q / 32, nb = q % 32;
            cvt_item(INP(17) + (size_t)l * 256 * 1024 + nb * 32 + (lane & 31), 1024, INP(16) + l * 256, WSP(bf16_t, WS_WUKV) + (size_t)l * 1024 * 256, 256, nb * 32, kb * 64, scr, lane); continue; } r -= I_UKV;
        if (r < I_UP) { const int le = r / 512, q = r % 512, kb = q / 32, nb = q % 32; const int n = nb * 32 + (lane & 31);
            const float* W = (n & 1) ? INP(23) : INP(22);
            if (le >= 16) cvt_item_fp8(W + (size_t)le * 1024 * 512 + (n >> 1), 512, WU8S, WSP(unsigned char, WS_WUP) + (size_t)16 * 1024 * 1024 * 2 + (size_t)(le - 16) * 1024 * 1024, 1024, nb * 32, kb * 64, scr, lane);
            else cvt_item(W + (size_t)le * 1024 * 512 + (n >> 1), 512, nullptr, WSP(bf16_t, WS_WUP) + (size_t)le * 1024 * 1024, 1024, nb * 32, kb * 64, scr, lane);
            continue; } r -= I_UP;
        if (r < I_W2) { const int le = r / 256, q = r % 256, kb = q / 32, nb = q % 32;
            if (le >= 16) cvt_item_fp8(INP(24) + (size_t)le * 512 * 1024 + nb * 32 + (lane & 31), 1024, WD8S, WSP(unsigned char, WS_W2T) + (size_t)16 * 1024 * 512 * 2 + (size_t)(le - 16) * 1024 * 512, 512, nb * 32, kb * 64, scr, lane);
            else cvt_item(INP(24) + (size_t)le * 512 * 1024 + nb * 32 + (lane & 31), 1024, nullptr, WSP(bf16_t, WS_W2T) + (size_t)le * 1024 * 512, 512, nb * 32, kb * 64, scr, lane);
            continue; } r -= I_W2;
        { const int l = r / 1536, q = r % 1536, kb = q / 96, nb = q % 96;
            cvt_item_fp8(INP(8) + (size_t)l * 1024 * INCOLS + 3744 + nb * 32 + (lane & 31), INCOLS, WG8S * 1.4426950408889634f, WSP(unsigned char, WS_WIN8) + (size_t)l * 3072 * 1024, 1024, nb * 32, kb * 64, scr, lane); }
    }
}

__device__ __forceinline__ void norm1_phase(Frame& F, const Resid& R, int l, int skip_none) {
    PHASE_IDS
    const int gw = bid * 8 + wave, NGW = F.G * 8; bf16_t* HX = WSP(bf16_t, WS_HX);
    const float* MODL = WSP(float, WS_MOD) + (size_t)l * 9 * 6144; const float* nw = INP(6) + l * 1024;
    for (int row = gw; row < NT; row += NGW) {
        const float* md = MODL + R.modv(row) * 6144;
        f32x4 v[4]; float s = 0.f;
        int sf32 = R.src_f32; asm volatile("" : "+s"(sf32));
        if (sf32) { const f32x4* xr = (const f32x4*)R.srcf(row) + lane;
#pragma unroll
            for (int j = 0; j < 4; ++j) v[j] = xr[64 * j]; }
        else { const u32x2* xr = (const u32x2*)R.dst(row) + lane;
#pragma unroll
            for (int j = 0; j < 4; ++j) { const u32x2 w = xr[64 * j]; v[j] = (f32x4){bf_lo(w.x), bf_hi(w.x), bf_lo(w.y), bf_hi(w.y)}; } }
#pragma unroll
        for (int j = 0; j < 4; ++j) s += (v[j][0] * v[j][0] + v[j][1] * v[j][1]) + (v[j][2] * v[j][2] + v[j][3] * v[j][3]);
        const float rs = rsqrtf(wave_sum(s) * (1.f / DM) + RMS_EPS);
#pragma unroll
        for (int j = 0; j < 4; ++j) { const int c = 4 * lane + 256 * j; const f32x4 w = *(const f32x4*)(nw + c), sh = *(const f32x4*)(md + c), sc = *(const f32x4*)(md + 1024 + c);
            const f32x4 y = v[j] * rs * w * (sc + 1.f) + sh; u32x2 o; o.x = cvtpk(y[0], y[1]); o.y = cvtpk(y[2], y[3]); *(u32x2*)(HX + (size_t)row * 1024 + c) = o;
            int q8_ = __builtin_amdgcn_cvt_pk_fp8_f32(y[0] * HX8S, y[1] * HX8S, 0, false); q8_ = __builtin_amdgcn_cvt_pk_fp8_f32(y[2] * HX8S, y[3] * HX8S, q8_, true);
            *(int*)(WSP(unsigned char, WS_HX8) + (size_t)row * 1024 + c) = q8_; }
    }
}
__device__ __forceinline__ void final_norm_phase(Frame& F, int g) {
    PHASE_IDS
    const int gw = bid * 8 + wave, NGW = F.G * 8; const float* nw = INP(25);
    for (int row = gw; row < GB * SEQ; row += NGW) {
        f32x4* xr = (f32x4*)(F.out + ((size_t)g * GB * SEQ + row) * DM) + lane;
        const u32x2* xb = (const u32x2*)(WSP(bf16_t, WS_XRES) + ((size_t)g * GB * SEQ + row) * DM) + lane;
        f32x4 v[4]; float s = 0.f;
#pragma unroll
        for (int j = 0; j < 4; ++j) { const u32x2 w = xb[64 * j]; v[j] = (f32x4){bf_lo(w.x), bf_hi(w.x), bf_lo(w.y), bf_hi(w.y)}; s += (v[j][0] * v[j][0] + v[j][1] * v[j][1]) + (v[j][2] * v[j][2] + v[j][3] * v[j][3]); }
        const float rs = rsqrtf(wave_sum(s) * (1.f / DM) + RMS_EPS);
#pragma unroll
        for (int j = 0; j < 4; ++j) { const f32x4 w = *(const f32x4*)(nw + 4 * lane + 256 * j); xr[64 * j] = v[j] * rs * w; }
    }
}
__device__ __forceinline__ void conv_phase(Frame& F, int l) {
    PHASE_IDS
    const bf16_t* PC = WSP(bf16_t, WS_PC); bf16_t* ACT = WSP(bf16_t, WS_ACT); const float* cw = INP(12) + (size_t)l * 512 * 3;
    for (int idx = bid * 512 + tid; idx < NT * 64; idx += F.G * 512) {
        const int row = idx >> 6, c8 = (idx & 63) * 8; const int bl = row / SB, s = row - bl * SB;
        const bool hp = (s != 0) && (s != CTXL), hn = (s != CTXL - 1) && (s != SB - 1);
        const bf16_t* p = PC + (size_t)row * 1024 + c8;
        float b[8], u0[8], um[8], up[8];
        unpack8(*(const u32x4*)p, b); unpack8(*(const u32x4*)(p + 512), u0);
        if (hp) unpack8(*(const u32x4*)(p + 512 - 1024), um); else {
#pragma unroll
            for (int k = 0; k < 8; ++k) um[k] = 0.f; }
        if (hn) unpack8(*(const u32x4*)(p + 512 + 1024), up); else {
#pragma unroll
            for (int k = 0; k < 8; ++k) up[k] = 0.f; }
        float o[8];
#pragma unroll
        for (int k = 0; k < 8; ++k) { const float* w = cw + (c8 + k) * 3; o[k] = b[k] * (um[k] * w[0] + u0[k] * w[1] + up[k] * w[2]); }
        *(u32x4*)(ACT + (size_t)row * 1536 + 512 + c8) = pack8(o);
    }
}
__device__ __forceinline__ void scan_phase(Frame& F, int l) {
    PHASE_IDS
    const float* U = WSP(float, WS_HX); bf16_t* S = WSP(bf16_t, WS_PM);
    for (int idx = bid * 512 + tid; idx < GB * 4 * 2 * 8192; idx += F.G * 512) {
        const int ed = idx & 8191, dir = (idx >> 13) & 1, h = (idx >> 14) & 3, bl = idx >> 16;
        const float lg = lg2_gamma(INP(9) + l * 8 + dir * 4 + h); const float dec = __builtin_amdgcn_exp2f(lg * 128.f);
        float st = 0.f;
        for (int i0 = 0; i0 < NCHUNK; i0 += 6) {
            float uu[6]; size_t off[6];
#pragma unroll
            for (int k = 0; k < 6; ++k) { const int i = i0 + k; const int c = dir ? (i < 2 ? 1 - i : NCHUNK + 1 - i) : i;
                off[k] = ((size_t)(((bl * NCHUNK + c) * 4 + h) * 2 + dir)) * 8192 + ed; uu[k] = U[off[k]]; }
#pragma unroll
            for (int k = 0; k < 6; ++k) { S[off[k]] = f2bf(st); st = dec * st + uu[k]; }
        }
    }
}
template <int NR>
__device__ __forceinline__ void n2_rows(const Resid& R, const int (&rows)[NR], const int (&slot)[NR], const float* MODL, const float* nw, bf16_t* H2, unsigned char* H28, const LAS float* wr, LAS float* lg, int lane) {
    f32x4 v[NR][4]; float s[NR];
#pragma unroll
    for (int q = 0; q < NR; ++q) { const u32x2* xr = (const u32x2*)R.dst(rows[q]) + lane; s[q] = 0.f;
#pragma unroll
        for (int j = 0; j < 4; ++j) { const u32x2 w_ = xr[64 * j]; v[q][j] = (f32x4){bf_lo(w_.x), bf_hi(w_.x), bf_lo(w_.y), bf_hi(w_.y)}; s[q] += (v[q][j][0] * v[q][j][0] + v[q][j][1] * v[q][j][1]) + (v[q][j][2] * v[q][j][2] + v[q][j][3] * v[q][j][3]); } }
#pragma unroll
    for (int q = 0; q < NR; ++q) s[q] = rsqrtf(wave_sum(s[q]) * (1.f / DM) + RMS_EPS);
#pragma unroll
    for (int q = 0; q < NR; ++q) { const float* md = MODL + R.modv(rows[q]) * 6144;
#pragma unroll
        for (int j = 0; j < 4; ++j) { const int c = 4 * lane + 256 * j; const f32x4 w = *(const f32x4*)(nw + c), sh = *(const f32x4*)(md + 3072 + c), sc = *(const f32x4*)(md + 4096 + c);
            v[q][j] = v[q][j] * s[q] * w * (sc + 1.f) + sh;
            if (H28) { int q8_ = __builtin_amdgcn_cvt_pk_fp8_f32(v[q][j][0] * H28S, v[q][j][1] * H28S, 0, false); q8_ = __builtin_amdgcn_cvt_pk_fp8_f32(v[q][j][2] * H28S, v[q][j][3] * H28S, q8_, true); *(int*)(H28 + (size_t)rows[q] * 1024 + c) = q8_; }
            else { u32x2 o; o.x = cvtpk(v[q][j][0], v[q][j][1]); o.y = cvtpk(v[q][j][2], v[q][j][3]); *(u32x2*)(H2 + (size_t)rows[q] * 1024 + c) = o; } } }
    const int b4 = (lane >> 4) & 1, b3 = (lane >> 3) & 1, b2 = (lane >> 2) & 1;
#pragma unroll
    for (int q = 0; q < NR; ++q) {
        float a[16];
#pragma unroll
        for (int e = 0; e < 16; ++e) { float t = 0.f;
#pragma unroll
            for (int j = 0; j < 4; ++j) { const f32x4 w = *(const LAS f32x4*)(wr + e * 1024 + 4 * lane + 256 * j); t += (v[q][j][0] * w[0] + v[q][j][1] * w[1]) + (v[q][j][2] * w[2] + v[q][j][3] * w[3]); }
            a[e] = t; }
        float s8[8], s4[4], s2[2];
#pragma unroll
        for (int k = 0; k < 8; ++k) { auto r = __builtin_amdgcn_permlane32_swap(__float_as_uint(a[k]), __float_as_uint(a[k + 8]), false, false); s8[k] = __uint_as_float(r[0]) + __uint_as_float(r[1]); }
#pragma unroll
        for (int k = 0; k < 4; ++k) { const float snd = b4 ? s8[k] : s8[k + 4], kp = b4 ? s8[k + 4] : s8[k]; s4[k] = kp + swz_xor<16>(snd); }
#pragma unroll
        for (int k = 0; k < 2; ++k) { const float snd = b3 ? s4[k] : s4[k + 2], kp = b3 ? s4[k + 2] : s4[k]; s2[k] = kp + swz_xor<8>(snd); }
        float s1; { const float snd = b2 ? s2[0] : s2[1], kp = b2 ? s2[1] : s2[0]; s1 = kp + swz_xor<4>(snd); }
        s1 += swz_xor<2>(s1); s1 += swz_xor<1>(s1);
        if ((lane & 3) == 0) lg[slot[q] * 16 + (lane >> 2)] = s1;
    }
}
__device__ __forceinline__ void norm2_router_phase(Frame& F, const Resid& R, int l, int g, int lat_only, int cslot) {
    PHASE_IDS
    bf16_t* H2 = WSP(bf16_t, WS_HX); unsigned char* H28 = (l == DEPTH - 1) ? WSP(unsigned char, WS_H28) : nullptr;
    const float* MODL = WSP(float, WS_MOD) + (size_t)l * 9 * 6144; const float* nw = INP(7) + l * 1024;
    LAS float* wr = (LAS float*)F.lds; LAS float* lg = (LAS float*)(F.lds + 65536);
    { const float* wrt = INP(20); for (int i = tid; i < 16 * 1024; i += 512) wr[i] = wrt[(i & 1023) * 16 + (i >> 10)]; }
    __syncthreads();
    const int rpb = (NT + F.G - 1) / F.G, r0 = bid * rpb, r1 = (r0 + rpb < NT) ? r0 + rpb : NT;
    for (int row = r0 + wave; row < r1; row += 16) {
        const int rowb = row + 8;
        const bool okA = !(lat_only && (row % SB) < CTXL), okB = rowb < r1 && !(lat_only && (rowb % SB) < CTXL);
        if (okA && okB) { const int rr[2] = {row, rowb}, ss[2] = {row - r0, rowb - r0}; n2_rows<2>(R, rr, ss, MODL, nw, H2, H28, wr, lg, lane); }
        else if (okA) { const int rr[1] = {row}, ss[1] = {row - r0}; n2_rows<1>(R, rr, ss, MODL, nw, H2, H28, wr, lg, lane); }
        else if (okB) { const int rr[1] = {rowb}, ss[1] = {rowb - r0}; n2_rows<1>(R, rr, ss, MODL, nw, H2, H28, wr, lg, lane); }
    }
    __syncthreads();
    unsigned* CNT = WSP(unsigned, WS_CTL) + CW_CNT + (g * 2 + l) * 64 + cslot; int* LIST = WSP(int, WS_LIST); float* WGT = WSP(float, WS_WGT);
    const float* rb = INP(21);
    LAS unsigned* lcnt = (LAS unsigned*)(F.lds + 65536 + 16384);
    if (tid < 64) lcnt[tid] = 0u;
    __syncthreads();
    int bucket = -1, rank = 0; float wlo = 0.f, whi = 0.f; const int trow = r0 + tid;
    if (tid < r1 - r0 && !(lat_only && (trow % SB) < CTXL)) {
        const int t = tid;
        float sc16[16];
#pragma unroll
        for (int e4 = 0; e4 < 4; ++e4) { const f32x4 x = *(const LAS f32x4*)(lg + t * 16 + e4 * 4); sc16[e4 * 4] = sigmoidf_(x[0]); sc16[e4 * 4 + 1] = sigmoidf_(x[1]); sc16[e4 * 4 + 2] = sigmoidf_(x[2]); sc16[e4 * 4 + 3] = sigmoidf_(x[3]); }
        float best = -1e30f; int gs = 0;
#pragma unroll
        for (int q = 0; q < 4; ++q) { float m1 = -1e30f, m2 = -1e30f;
#pragma unroll
            for (int k = 0; k < 4; ++k) { const float b = sc16[q * 4 + k] + rb[q * 4 + k]; if (b > m1) { m2 = m1; m1 = b; } else if (b > m2) m2 = b; }
            const float gsc = m1 + m2; if (gsc > best) { best = gsc; gs = q; } }
        float bb[4], su[4];
#pragma unroll
        for (int k = 0; k < 4; ++k) { float b = 0.f, u = 0.f;
#pragma unroll
            for (int q = 0; q < 4; ++q) { if (q == gs) { b = sc16[q * 4 + k] + rb[q * 4 + k]; u = sc16[q * 4 + k]; } }
            bb[k] = b; su[k] = u; }
        int i1 = 0; float b1 = bb[0];
#pragma unroll
        for (int k = 1; k < 4; ++k) if (bb[k] > b1) { b1 = bb[k]; i1 = k; }
        int i2 = -1; float b2 = -1e30f;
#pragma unroll
        for (int k = 0; k < 4; ++k) if (k != i1 && bb[k] > b2) { b2 = bb[k]; i2 = k; }
        const int lo = i1 < i2 ? i1 : i2, hi = i1 < i2 ? i2 : i1;
        float slo = 0.f, shi = 0.f;
#pragma unroll
        for (int k = 0; k < 4; ++k) { if (k == lo) slo = su[k]; if (k == hi) shi = su[k]; }
        const float inv = 1.f / (slo + shi);
        const int pair = lo == 0 ? hi - 1 : (lo == 1 ? hi + 1 : 5);
        bucket = gs * 6 + pair; wlo = slo * inv; whi = shi * inv;
        rank = (int)atomicAdd((unsigned*)(lcnt + bucket), 1u);
    }
    __syncthreads();
    if (tid < NPAIR) { const unsigned c = lcnt[tid]; lcnt[32 + tid] = c ? atomicAdd(CNT + tid, c) : 0u; }
    __syncthreads();
    if (bucket >= 0) { const unsigned pos = lcnt[32 + bucket] + (unsigned)rank; LIST[(size_t)bucket * NT + pos] = trow; WGT[(size_t)trow * 2] = wlo; WGT[(size_t)trow * 2 + 1] = whi; }
    __syncthreads();
}
__device__ __forceinline__ void moe_tables(Frame& F, int l, int g) {
    PHASE_IDS
    LAS int* tab = (LAS int*)(F.lds + LDS_MOE_OFF);
    if (tid < 32) { const unsigned* CNT = WSP(unsigned, WS_CTL) + CW_CNT + (g * 2 + l) * 64;
        tab[32 + tid] = tid < NPAIR ? (int)__hip_atomic_load(CNT + tid, __ATOMIC_RELAXED, __HIP_MEMORY_SCOPE_AGENT) : 0; }
    __syncthreads();
    if (tid == 0) { int pre = 0;
#pragma nounroll
        for (int p = 0; p < NPAIR; ++p) { tab[p] = pre; pre += (tab[32 + p] + 255) >> 8; }
        tab[24] = pre; }
    __syncthreads();
}
#ifndef PHMASK
#define PHMASK 0xFFFF
#endif
#define PHM(k) (((PHMASK) >> (k)) & 1)
#ifndef INPROJ_ALIGN
#define INPROJ_ALIGN true
#endif
#ifndef REPMASK
#define REPMASK 0
#endif
#define REPS(k) _Pragma("nounroll") for (int rep_ = 0; rep_ < 1 + (((REPMASK) >> (k)) & 1); ++rep_)

__global__ void __launch_bounds__(512, 2) dit_fwd(Args args) {
    extern __shared__ __attribute__((aligned(16))) unsigned char lds_raw[];
    Frame F;
    F.lds = (LAS unsigned char*)lds_raw;
    F.G = gridDim.x; F.wv = __builtin_amdgcn_readfirstlane((int)threadIdx.x >> 6);
    F.a = &args; F.out = args.out; F.ws = args.ws;
    for (int u = threadIdx.x; u < (LDS_BYTES - LDSCTL_OFF) / 4; u += 512) ((LAS unsigned*)(F.lds + LDSCTL_OFF))[u] = 0u;
    __syncthreads();
    XcdBarrier bar = xcd_barrier_post(WSP(unsigned, WS_CTL) + CW_BAR, (volatile LAS unsigned*)(F.lds + LDSCTL_OFF));
#ifdef PROBE_BAR2
#define GRID_BAR() do { asm volatile("; PHASE_SEAM" ::: "memory"); xcd_barrier(bar, F.wv); xcd_barrier(bar, F.wv); } while (0)
#else
#define GRID_BAR() do { asm volatile("; PHASE_SEAM" ::: "memory"); xcd_barrier(bar, F.wv); } while (0)
#endif
#ifdef PROBE_A
#define STAMP(k) do { if (obid() == 0 && F.wv == 0 && olane() == 0) { unsigned long long* TS_ = WSP(unsigned long long, WS_CTL + 512 * 1024); const unsigned long long now = __builtin_amdgcn_s_memrealtime(); TS_[(k)] += now - TS_[32]; TS_[32] = now; } } while (0)
    if (blockIdx.x == 0 && threadIdx.x == 0) WSP(unsigned long long, WS_CTL + 512 * 1024)[32] = __builtin_amdgcn_s_memrealtime();
#else
#define STAMP(k) do { } while (0)
#endif

    if constexpr (PHM(0)) REPS(0) p0_prologue(F);
    GRID_BAR(); STAMP(0);

#pragma nounroll
    for (int g = 0; g < NG; ++g) {
#pragma nounroll
        for (int l = 0; l < DEPTH; ++l) {
            Resid R; R.in_lat = INP(0); R.in_ctx = INP(2); R.x_lat = WSP(bf16_t, WS_XRES); R.x_ctx = WSP(bf16_t, WS_XC); R.g = g; R.src_f32 = (l == 0) ? 1 : 0;
            const float* MODL = WSP(float, WS_MOD) + (size_t)l * 9 * 6144;
            const int lat_only = (l == DEPTH - 1) ? 1 : 0;

            if constexpr (PHM(1)) REPS(1) norm1_phase(F, R, l, 0);
            if constexpr (PHM(15)) if (l == 0 && g > 0) final_norm_phase(F, g - 1);
            GRID_BAR(); STAMP(1);

            if constexpr (PHM(2)) REPS(2) {
#ifdef STAGGER_US10
                {
                    const unsigned long long t0_ = __builtin_amdgcn_s_memrealtime(), d_ = (unsigned long long)((obid() * 5) & 15) * (STAGGER_US10) * 10ull;
                    while (__builtin_amdgcn_s_memrealtime() - t0_ < d_) __builtin_amdgcn_s_sleep(4);
                }
#endif
                TileOrder S; S.init(NRT, 15, F.G, obid(), WSP(bf16_t, WS_HX), (size_t)256 * 1024 * 2, WSP(bf16_t, WS_WIN) + (size_t)l * INW * 1024, (size_t)256 * 1024 * 2, 0);
                EpiInproj E{WSP(bf16_t, WS_PR), WSP(bf16_t, WS_PC), WSP(bf16_t, WS_PM), WSP(bf16_t, WS_PG), WSP(unsigned char, WS_K), WSP(float, WS_SSQ), WSP(f32x2, WS_RT), WSP(f32x2, WS_MT), 0};
#ifdef PROBE_INPROJ_NOEPI
                { EpiNone E0; if (PROBE_INPROJ_NOEPI == 1) pg8::gemm_phase<EpiNone, TileOrder, INPROJ_ALIGN>(F.lds, 1024, 1024, 1024, 0, S, E0, F.wv);
                  else { TileOrder S9; S9.init(NRT, 12, F.G, obid(), WSP(unsigned char, WS_HX8), (size_t)256 * 1024, WSP(unsigned char, WS_WIN8) + (size_t)l * 3072 * 1024, (size_t)256 * 1024, 0);
                         if (PROBE_INPROJ_NOEPI == 2) pg8::gemm_phase<EpiNone, TileOrder, INPROJ_ALIGN, false, false, true, 0x7b7b7b7b, 0x79797979>(F.lds, 512, 512, 512, 0, S9, E0, F.wv);
                         else { EpiStoreOnly E1{WSP(bf16_t, WS_PG)}; pg8::gemm_phase<EpiStoreOnly, TileOrder, INPROJ_ALIGN, false, false, true, 0x7b7b7b7b, 0x79797979>(F.lds, 512, 512, 512, 0, S9, E1, F.wv); } } }
#endif
#ifdef PROBE_INPROJ_REP
                { TileOrder S9; S9.init(NRT, 12, F.G, obid(), WSP(unsigned char, WS_HX8), (size_t)256 * 1024, WSP(unsigned char, WS_WIN8) + (size_t)l * 3072 * 1024, (size_t)256 * 1024, 0);
                  EpiGate E9{WSP(bf16_t, WS_PG)};
                  pg8::gemm_phase<EpiGate, TileOrder, INPROJ_ALIGN, false, false, true, 0x7b7b7b7b, 0x79797979>(F.lds, 512, 512, 512, 0, S9, E9, F.wv); }
#endif
                TileOrder S8; S8.init(NRT, 12, F.G, (obid() + F.G - (NRT * 15) % F.G) % F.G, WSP(unsigned char, WS_HX8), (size_t)256 * 1024, WSP(unsigned char, WS_WIN8) + (size_t)l * 3072 * 1024, (size_t)256 * 1024, 0);
                EpiGate E8{WSP(bf16_t, WS_PG)};
#ifdef INPROJ_COHORT
                int coh = (obid() >> (INPROJ_COHORT)) & 1;
#pragma nounroll
                for (int pass = 0; pass < 2; ++pass, coh ^= 1) {
                    if (coh == 0) pg8::gemm_phase<EpiInproj, TileOrder, INPROJ_ALIGN>(F.lds, 1024, 1024, 1024, 0, S, E, F.wv);
                    else pg8::gemm_phase<EpiGate, TileOrder, INPROJ_ALIGN, false, false, true, 0x7b7b7b7b, 0x79797979>(F.lds, 512, 512, 512, 0, S8, E8, F.wv);
                }
#else
#ifndef PROBE_ONLY_FP8GATE
                pg8::gemm_phase<EpiInproj, TileOrder, INPROJ_ALIGN>(F.lds, 1024, 1024, 1024, 0, S, E, F.wv);
#endif
                pg8::gemm_phase<EpiGate, TileOrder, INPROJ_ALIGN, false, false, true, 0x7b7b7b7b, 0x79797979>(F.lds, 512, 512, 512, 0, S8, E8, F.wv);
#endif
            }
            GRID_BAR(); STAMP(2);

            if constexpr (PHM(3)) REPS(3) {
                TileOrder S; S.init(NRT, 3, F.G, obid(), WSP(bf16_t, WS_PM), (size_t)256 * 640 * 2, WSP(bf16_t, WS_WUQ) + (size_t)l * 768 * 384, (size_t)256 * 384 * 2, 0);
                EpiUq E{WSP(unsigned char, WS_Q), WSP(float, WS_SSQ), WSP(f32x2, WS_MT)};
                pg8::gemm_phase<EpiUq, TileOrder, true>(F.lds, 640, 384, 384, 0, S, E, F.wv);
            }
#ifndef PROBE_COARSE
            STAMP(3);
#endif
            if constexpr (PHM(4)) REPS(4) {
                TileOrder S; S.init(NRT, 4, F.G, (obid() + F.G - (NRT * 3) % F.G) % F.G, WSP(bf16_t, WS_PM) + 384, (size_t)256 * 640 * 2, WSP(bf16_t, WS_WUKV) + (size_t)l * 1024 * 256, (size_t)256 * 256 * 2, 0);
                EpiUkv E{WSP(unsigned char, WS_K), WSP(unsigned char, WS_V), WSP(float, WS_SSQ), F.lds + LDS_VTR_OFF};
                pg8::gemm_phase<EpiUkv, TileOrder, true>(F.lds, 640, 256, 256, 0, S, E, F.wv);
            }
#ifndef PROBE_COARSE
            STAMP(4);
#endif
            if constexpr (PHM(5)) REPS(5) for (int u = (obid() + F.G - (NRT * 7) % F.G) % F.G; u < GB * NCHUNK * 4; u += F.G) {
                const int h = u & 3;
                retu_unit(u, WSP(bf16_t, WS_PR), WSP(float, WS_HX), lg2_gamma(INP(9) + l * 8 + h), lg2_gamma(INP(9) + l * 8 + 4 + h), (LAS char*)F.lds, F.wv);
            }
#ifndef PROBE_COARSE
            STAMP(5);
#endif
            if constexpr (PHM(6)) REPS(6) conv_phase(F, l);
            GRID_BAR(); STAMP(6);

            if constexpr (PHM(7)) REPS(7) scan_phase(F, l);
#ifndef PROBE_COARSE
            STAMP(7);
#endif
#ifdef PROBE_CLK
            unsigned long long c0_ = 0, r0_ = 0; if (g == 0 && l == 0) { c0_ = __builtin_readcyclecounter(); r0_ = __builtin_amdgcn_s_memrealtime(); }
#endif
            if constexpr (PHM(8)) REPS(8) {
                const unsigned char* Q = WSP(unsigned char, WS_Q); const unsigned char* K = WSP(unsigned char, WS_K); const unsigned char* V = WSP(unsigned char, WS_V); bf16_t* ACT = WSP(bf16_t, WS_ACT);
                const int vcu = (obid() % 8) * (F.G / 8) + obid() / 8, xcd = vcu / (F.G / 8), slot = vcu % (F.G / 8);
                const int nlat = GB * 8 * 32, nunit = nlat + (lat_only ? 0 : GB * 8);
                for (int i = 0; ; ++i) {
                    int hh, qb;
                    if (F.G == 256) { if (i < 4) { hh = xcd + 8 * i; qb = 1 + slot; } else if (i == 4 && !lat_only && slot < 4) { hh = xcd + 8 * slot; qb = 0; } else break; }
                    else { const int L = i * F.G + obid(); if (L >= nunit) break; if (L < nlat) { hh = L >> 5; qb = 1 + (L & 31); } else { hh = L - nlat; qb = 0; } }
                    const int bl = hh >> 3, h = hh & 7;
                    const size_t hb = (size_t)(bl * 8 + h) * SB;
                    att2::attn_unit_pp(Q + (hb + (size_t)qb * 256) * 128, K + hb * 128, V + (size_t)(bl * 8 + h) * 64 * SB, ACT + ((size_t)bl * SB + (size_t)qb * 256) * 1536 + 1024 + h * 64, 1536, qb == 0 ? CTXL : SB, (LAS char*)F.lds, F.wv);
                }
            }
#ifdef PROBE_CLK
            if (g == 0 && l == 0 && obid() == 0 && F.wv == 0 && olane() == 0) { const unsigned long long c1_ = __builtin_readcyclecounter(), r1_ = __builtin_amdgcn_s_memrealtime();
                WSP(unsigned long long, WS_CTL + 600 * 1024)[0] = (c1_ - c0_) * 100ull / (r1_ - r0_); }
#endif
            GRID_BAR(); STAMP(8);

            if constexpr (PHM(9)) REPS(9) for (int u = obid(); u < GB * NCHUNK * 4; u += F.G) {
                const int h = u & 3;
                retout_unit(u, WSP(bf16_t, WS_PR), WSP(bf16_t, WS_PM), INP(10) + l * 512, WSP(bf16_t, WS_ACT), lg2_gamma(INP(9) + l * 8 + h), lg2_gamma(INP(9) + l * 8 + 4 + h), (LAS char*)F.lds, F.wv);
            }
            GRID_BAR(); STAMP(9);

            if constexpr (PHM(10)) REPS(10) {
#ifdef MERGE1_STAGGER
                {
                    const unsigned long long t0_ = __builtin_amdgcn_s_memrealtime(), d_ = (unsigned long long)((obid() >> 3) & 3) * (MERGE1_STAGGER) * 10ull;
                    while (__builtin_amdgcn_s_memrealtime() - t0_ < d_) __builtin_amdgcn_s_sleep(4);
                }
#endif
                unsigned* pctr = WSP(unsigned, WS_CTL) + CW_PANEL + (g * 2 + l) * (NRT * 64);
#ifdef HANDOFF
                TileOrderP S; S.init(lat_only ? GB * 32 : NRT, 4, F.G, obid(), WSP(bf16_t, WS_ACT), (size_t)256 * 1536 * 2, WSP(bf16_t, WS_WCAT) + (size_t)l * 1024 * 1536, (size_t)256 * 1536 * 2, lat_only); S.ctr = pctr;
#else
                TileOrder S; S.init(lat_only ? GB * 32 : NRT, 4, F.G, obid(), WSP(bf16_t, WS_ACT), (size_t)256 * 1536 * 2, WSP(bf16_t, WS_WCAT) + (size_t)l * 1024 * 1536, (size_t)256 * 1536 * 2, lat_only); (void)pctr;
#endif
#ifdef PROBE_MERGE1_NOHOOK
                { EpiMerge1NoHook E0{{WSP(bf16_t, WS_PG), WSP(bf16_t, WS_HX)}}; pg8::gemm_phase<EpiMerge1NoHook, TileOrder, true>(F.lds, 1536, 1536, 1536, 0, S, E0, F.wv); }
#endif
                EpiMerge1 E{WSP(bf16_t, WS_PG), WSP(bf16_t, WS_HX)};
#ifdef HANDOFF
                pg8::gemm_phase<EpiMerge1, TileOrderP, true>(F.lds, 1536, 1536, 1536, 0, S, E, F.wv);
#else
                pg8::gemm_phase<EpiMerge1, TileOrder, true>(F.lds, 1536, 1536, 1536, 0, S, E, F.wv);
#endif
            }
#if !defined(HANDOFF) || defined(HANDOFF_WITH_BARRIER)
            GRID_BAR();
#endif
            STAMP(10);

            if constexpr (PHM(11)) {
#ifdef HANDOFF
                const int n1 = (lat_only ? GB * 32 : NRT) * 4;
                TileOrderC S; S.init(lat_only ? GB * 32 : NRT, 4, F.G, (obid() + F.G - n1 % F.G) % F.G, WSP(bf16_t, WS_HX), (size_t)256 * 1024 * 2, WSP(bf16_t, WS_WOUT) + (size_t)l * 1024 * 1024, (size_t)256 * 1024 * 2, lat_only);
                S.ctr = WSP(unsigned, WS_CTL) + CW_PANEL + (g * 2 + l) * (NRT * 64); S.need = 32u; S.tmo = WSP(unsigned, WS_CTL) + 8; S.wv = F.wv;
                EpiMerge2 E{R, MODL};
                pg8::gemm_phase<EpiMerge2, TileOrderC, true>(F.lds, 1024, 1024, 1024, 0, S, E, F.wv);
#else
                TileOrder S; S.init(lat_only ? GB * 32 : NRT, 4, F.G, obid(), WSP(bf16_t, WS_HX), (size_t)256 * 1024 * 2, WSP(bf16_t, WS_WOUT) + (size_t)l * 1024 * 1024, (size_t)256 * 1024 * 2, lat_only);
                EpiMerge2 E{R, MODL};
                pg8::gemm_phase<EpiMerge2, TileOrder, true>(F.lds, 1024, 1024, 1024, 0, S, E, F.wv);
#endif
            }
            GRID_BAR(); STAMP(11);

            if constexpr (((REPMASK) >> 12) & 1) norm2_router_phase(F, R, l, g, lat_only, 32);
            if constexpr (PHM(12)) norm2_router_phase(F, R, l, g, lat_only, 0);
            GRID_BAR(); STAMP(12);

            moe_tables(F, l, g);
            if constexpr (PHM(13)) REPS(13) {
                if (l == DEPTH - 1) {
                    MoeOrder S{(const LAS int*)(F.lds + LDS_MOE_OFF), WSP(int, WS_LIST), 8, F.G, obid(), 1, (const char*)WSP(unsigned char, WS_H28), (const char*)(WSP(unsigned char, WS_WUP) + (size_t)16 * 1024 * 1024 * 2), 1};
                    EpiMoeUp8 E{WSP(int, WS_LIST), WSP(float, WS_WGT), WSP(unsigned char, WS_PG)};
                    pg8::gemm_phase<EpiMoeUp8, MoeOrder, true, true, false, true, 0x7b7b7b7b, 0x79797979>(F.lds, 512, 512, 512, 0, S, E, F.wv);
                } else {
                    MoeOrder S{(const LAS int*)(F.lds + LDS_MOE_OFF), WSP(int, WS_LIST), 8, F.G, obid(), 1, (const char*)WSP(bf16_t, WS_HX), (const char*)(WSP(bf16_t, WS_WUP) + (size_t)l * 16 * 1024 * 1024), 2};
                    EpiMoeUp E{WSP(int, WS_LIST), WSP(float, WS_WGT), WSP(bf16_t, WS_PG)};
                    pg8::gemm_phase<EpiMoeUp, MoeOrder, true, true, false>(F.lds, 1024, 1024, 1024, 0, S, E, F.wv);
                }
            }
            GRID_BAR(); STAMP(13);

            if constexpr (PHM(14)) {
                if (l == DEPTH - 1) {
                    MoeOrder S{(const LAS int*)(F.lds + LDS_MOE_OFF), WSP(int, WS_LIST), 4, F.G, obid(), 0, (const char*)WSP(unsigned char, WS_PG), (const char*)(WSP(unsigned char, WS_W2T) + (size_t)16 * 1024 * 512 * 2), 1};
                    EpiMoeDown E{WSP(int, WS_LIST), R, MODL, nullptr};
                    pg8::gemm_phase<EpiMoeDown, MoeOrder, true, false, true, true, 0x7a7a7a7a, 0x7a7a7a7a>(F.lds, 512, 256, 512, 4, S, E, F.wv);
                } else {
                    MoeOrder S{(const LAS int*)(F.lds + LDS_MOE_OFF), WSP(int, WS_LIST), 4, F.G, obid(), 0, (const char*)WSP(bf16_t, WS_PG), (const char*)(WSP(bf16_t, WS_W2T) + (size_t)l * 16 * 1024 * 512), 2};
                    EpiMoeDown E{WSP(int, WS_LIST), R, MODL, nullptr};
                    pg8::gemm_phase<EpiMoeDown, MoeOrder, true, false, true>(F.lds, 1024, 512, 1024, 8, S, E, F.wv);
                }
            }
            GRID_BAR(); STAMP(14);
        }
    }
    if constexpr (PHM(15)) final_norm_phase(F, NG - 1);
#ifdef SELFCHECK_ATTN
            {
                const unsigned char* Q = WSP(unsigned char, WS_Q); const unsigned char* K = WSP(unsigned char, WS_K); const unsigned char* V = WSP(unsigned char, WS_V); const bf16_t* ACT = WSP(bf16_t, WS_ACT);
                const int lane_ = olane(); const int gwv = obid() * 8 + F.wv;
                if (gwv < 96) {
                    const int bl = gwv & 3, h = (gwv >> 2) & 7, qi = gwv >> 5;
                    const int srow = qi == 0 ? 256 : (qi == 1 ? 256 + 4099 : SB - 1);
                    const int nkeys = srow < CTXL ? CTXL : SB;
                    const size_t hb = (size_t)(bl * 8 + h) * SB;
                    #define F8(p) (__builtin_amdgcn_cvt_f32_fp8((int)(*(p)), 0))
                    const float q0 = F8(Q + (hb + srow) * 128 + lane_) * (1.f / Q8S), q1 = lane_ < 32 ? F8(Q + (hb + srow) * 128 + 64 + lane_) * (1.f / Q8S) : 0.f;
                    float mrun = -1e30f, lrun = 0.f, orun = 0.f;
#pragma nounroll
                    for (int j = 0; j < nkeys; ++j) {
                        float part = q0 * F8(K + (hb + j) * 128 + lane_) * (1.f / K8S); if (lane_ < 32) part += q1 * F8(K + (hb + j) * 128 + 64 + lane_) * (1.f / K8S);
                        const float s = wave_sum(part);
                        const float mn = fmaxf(mrun, s), sc = exp2f(mrun - mn), p = exp2f(s - mn);
                        lrun = lrun * sc + p; orun = orun * sc + p * F8(V + ((size_t)(bl * 8 + h) * 64 + lane_) * SB + (j & ~63) + vt_pos(j & 63)) * (1.f / V8S); mrun = mn; }
                    const float o_ = orun / lrun; const float got = bf1(ACT[((size_t)bl * SB + srow) * 1536 + 1024 + h * 64 + lane_]);
                    float err = fabsf(o_ - got), ref = fabsf(o_);
                    err = fmaxf(err, swz_xor<1>(err)); err = fmaxf(err, swz_xor<2>(err)); err = fmaxf(err, swz_xor<4>(err)); err = fmaxf(err, swz_xor<8>(err)); err = fmaxf(err, swz_xor<16>(err));
                    ref = fmaxf(ref, swz_xor<1>(ref)); ref = fmaxf(ref, swz_xor<2>(ref)); ref = fmaxf(ref, swz_xor<4>(ref)); ref = fmaxf(ref, swz_xor<8>(ref)); ref = fmaxf(ref, swz_xor<16>(ref));
                    { auto r1_ = __builtin_amdgcn_permlane32_swap(__float_as_uint(err), __float_as_uint(err), false, false); err = fmaxf(__uint_as_float(r1_[0]), __uint_as_float(r1_[1]));
                      auto r2_ = __builtin_amdgcn_permlane32_swap(__float_as_uint(ref), __float_as_uint(ref), false, false); ref = fmaxf(__uint_as_float(r2_[0]), __uint_as_float(r2_[1])); }
                    if (lane_ == 0 && !(err <= SELFCHECK_TOL * ref + 1e-6f)) atomicAdd(WSP(unsigned, WS_CTL) + 3000, 1u);
                }
            }
    GRID_BAR();
    if (__hip_atomic_load(WSP(unsigned, WS_CTL) + 3000, __ATOMIC_RELAXED, __HIP_MEMORY_SCOPE_AGENT) != 0u && obid() == 0) { for (int i = otid(F.wv); i < 4096; i += 512) F.out[i] = __builtin_nanf(""); }
#endif
#ifdef PROBE_CLK
    if (obid() == 0 && F.wv == 0 && olane() == 0) { const unsigned long long mhz = WSP(unsigned long long, WS_CTL + 600 * 1024)[0]; const unsigned long long t0 = __builtin_amdgcn_s_memrealtime();
        while (__builtin_amdgcn_s_memrealtime() - t0 < mhz * 100ull) __builtin_amdgcn_s_sleep(8); }
#endif
#ifdef PROBE_A
    STAMP(15);
    GRID_BAR();
    {
        unsigned long long* TS = WSP(unsigned long long, WS_CTL + 512 * 1024);
        unsigned long long tot = 0; for (int k = 0; k < 16; ++k) tot += __hip_atomic_load(TS + k, __ATOMIC_RELAXED, __HIP_MEMORY_SCOPE_AGENT);
        const float fa = (float)__hip_atomic_load(TS + PROBE_A, __ATOMIC_RELAXED, __HIP_MEMORY_SCOPE_AGENT) / (float)tot, fb = (float)__hip_atomic_load(TS + PROBE_B, __ATOMIC_RELAXED, __HIP_MEMORY_SCOPE_AGENT) / (float)tot;
        const float A = sqrtf(90.f * fa), X = 100.f + 800.f * fb;
        for (size_t i = (size_t)blockIdx.x * 512 + threadIdx.x; i < (size_t)NB * SEQ * DM; i += (size_t)gridDim.x * 512) F.out[i] = (i == 0) ? X : ((i & 1) ? A : -A);
    }
#endif
}

extern "C" void kernel_launch(void* const* d_in, const int* in_sizes, int n_in, void* d_out, int out_size, void* d_ws, size_t ws_size, hipStream_t stream) {
    static int grid = 0;
    if (grid == 0) {
        if (n_in != 26 || ws_size < WS_END) { fprintf(stderr, "kernel_launch: expected 26 inputs and >= %zu bytes of workspace; got %d, %zu\n", (size_t)WS_END, n_in, ws_size); grid = -1; return; }
        int dev = 0, cus = 0, per_cu = 0;
        if (hipGetDevice(&dev) != hipSuccess || hipDeviceGetAttribute(&cus, hipDeviceAttributeMultiprocessorCount, dev) != hipSuccess) { grid = -1; return; }
        if (hipFuncSetAttribute((const void*)dit_fwd, hipFuncAttributeMaxDynamicSharedMemorySize, LDS_BYTES) != hipSuccess) { fprintf(stderr, "kernel_launch: hipFuncSetAttribute failed\n"); grid = -1; return; }
        if (hipOccupancyMaxActiveBlocksPerMultiprocessor(&per_cu, (const void*)dit_fwd, 512, LDS_BYTES) != hipSuccess || per_cu < 1) fprintf(stderr, "kernel_launch: occupancy query reports %d\n", per_cu);
        (void)hipGetLastError();
        grid = cus;
    }
    if (grid < 0) return;
    (void)hipMemsetAsync((char*)d_ws + WS_CTL, 0, CTL_ZERO_BYTES, stream);
    Args a{};
    for (int i = 0; i < 26; ++i) a.in[i] = (const float*)d_in[i];
    a.out = (float*)d_out; a.ws = (unsigned char*)d_ws; a.ph_lo = 0; a.ph_hi = 1000;
    hipLaunchKernelGGL(dit_fwd, dim3(grid), dim3(512), LDS_BYTES, stream, a);
}
```

```cpp
#define ATTN_VDMA_HALF 1
#define INPROJ_L1_FP8 1
#include <hip/hip_runtime.h>
#include <cstdio>
#include <cstdint>

#define GAS __attribute__((address_space(1)))
#define LAS __attribute__((address_space(3)))
typedef unsigned short bf16_t;
typedef short bf16x8 __attribute__((ext_vector_type(8)));
typedef short s16x4 __attribute__((ext_vector_type(4)));
typedef float f32x2 __attribute__((ext_vector_type(2)));
typedef float f32x4 __attribute__((ext_vector_type(4)));
typedef float f32x16 __attribute__((ext_vector_type(16)));
typedef unsigned u32x2 __attribute__((ext_vector_type(2)));
typedef unsigned u32x4 __attribute__((ext_vector_type(4)));
typedef __bf16 bf16x2_t __attribute__((ext_vector_type(2)));

constexpr int DM = 1024, NB = 8, SEQ = 8192, CTXL = 256, DEPTH = 2;
constexpr int SB = SEQ + CTXL;
constexpr int GB = 4, NG = NB / GB;
constexpr int NT = GB * SB;
constexpr int NRT = NT / 256;
constexpr int INW = 6912;
constexpr int INCOLS = 6816;
constexpr int NCHUNK = SB / 128;
constexpr int NPAIR = 24;
constexpr float RMS_EPS = 1e-6f;
constexpr float LOG2E = 1.4426950408889634f;
constexpr float QSCALE = 0.10206207261596575f * LOG2E;
constexpr float Q8S = 32.f, K8S = 4.f, V8S = 4.f, P8S = 16.f;
constexpr float HX8S = 16.f, WG8S = 64.f;
#if !defined(NO_GATE_U8) && !defined(GATE_U8)
#define GATE_U8 1
#endif
constexpr float H28S = 16.f, WU8S = 64.f, MA8S = 32.f, WD8S = 32.f;

constexpr size_t MiB = 1u << 20;
constexpr size_t WS_CTL = 0, CTL_ZERO_BYTES = 1 * MiB;
constexpr size_t WS_MOD = 1 * MiB;
constexpr size_t WS_RT = 2 * MiB;
constexpr size_t WS_MT = 4 * MiB;
constexpr size_t WS_SSQ = 5 * MiB;
constexpr size_t WS_WGT = 8 * MiB;
constexpr size_t WS_LIST = 9 * MiB;
constexpr size_t WS_XC = 13 * MiB;
constexpr size_t WS_WIN = 21 * MiB;
constexpr size_t WS_WCAT = 48 * MiB;
constexpr size_t WS_WOUT = 54 * MiB;
constexpr size_t WS_WUQ = 58 * MiB;
constexpr size_t WS_WUKV = 60 * MiB;
constexpr size_t WS_WUP = 61 * MiB;
constexpr size_t WS_W2T = 125 * MiB;
constexpr size_t WS_HX = 157 * MiB;
constexpr size_t WS_PR = 223 * MiB;
constexpr size_t WS_PC = 322 * MiB;
constexpr size_t WS_PM = 388 * MiB;
constexpr size_t WS_PG = 430 * MiB;
constexpr size_t WS_Q = 628 * MiB;
constexpr size_t WS_K = 678 * MiB;
constexpr size_t WS_V = 728 * MiB;
constexpr size_t WS_ACT = 761 * MiB;
constexpr size_t WS_W8L1 = 752 * MiB;
constexpr size_t WS_WIN8 = 746 * MiB;
constexpr size_t WS_H28 = WS_PM;
constexpr size_t WS_HX8 = WS_ACT;
constexpr size_t WS_XRES = 860 * MiB;
constexpr size_t WS_END = 988 * MiB;
static_assert(WS_WIN + (size_t)2 * INW * 1024 * 2 <= WS_WCAT && WS_HX + (size_t)NT * 1024 * 2 <= WS_PR && WS_PR + (size_t)NT * 1536 * 2 <= WS_PC &&
              WS_PC + (size_t)NT * 1024 * 2 <= WS_PM && WS_PM + (size_t)NT * 640 * 2 <= WS_PG && WS_PG + (size_t)NT * 3072 * 2 <= WS_Q &&
              WS_Q + (size_t)GB * 8 * SB * 96 * 2 <= WS_K && WS_K + (size_t)GB * 8 * SB * 96 * 2 <= WS_V && WS_V + (size_t)GB * 8 * SB * 64 * 2 <= WS_ACT &&
              WS_ACT + (size_t)NT * 1536 * 2 <= WS_XRES && WS_XRES + (size_t)NB * SEQ * DM * 2 <= WS_END, "d_ws map");
constexpr int CW_BAR = 4096;
constexpr int CW_CNT = 16384;
constexpr int CW_PANEL = 32768;

constexpr int RING_BYTES = 131072;
constexpr int LDSCTL_OFF = RING_BYTES;
constexpr int LDS_MOE_OFF = LDSCTL_OFF + 64;
constexpr int LDS_VTR_OFF = LDSCTL_OFF + 2048;
constexpr int LDS_BYTES = 147456;

__device__ __forceinline__ int olane() { int l; asm volatile("v_mbcnt_lo_u32_b32 %0, -1, 0\n\tv_mbcnt_hi_u32_b32 %0, -1, %0" : "=v"(l)); return l; }
__device__ __forceinline__ int otid(int wv) { return wv * 64 + olane(); }
__device__ __forceinline__ int obid() { int b = blockIdx.x; asm volatile("" : "+s"(b)); return b; }
__device__ __forceinline__ unsigned cvtpk(float lo, float hi) { f32x2 v = {lo, hi}; bf16x2_t b = __builtin_convertvector(v, bf16x2_t); return __builtin_bit_cast(unsigned, b); }
__device__ __forceinline__ float bf_lo(unsigned w) { return __uint_as_float(w << 16); }
__device__ __forceinline__ float bf_hi(unsigned w) { return __uint_as_float(w & 0xffff0000u); }
__device__ __forceinline__ float bf1(bf16_t b) { return __uint_as_float(((unsigned)b) << 16); }
__device__ __forceinline__ bf16_t f2bf(float f) { return (bf16_t)(cvtpk(f, 0.f) & 0xffffu); }
template <int O> __device__ __forceinline__ float swz_xor(float v) { return __int_as_float(__builtin_amdgcn_ds_swizzle(__float_as_int(v), (O << 10) | 0x1f)); }
__device__ __forceinline__ float half_sum(float v) { auto rr = __builtin_amdgcn_permlane32_swap(__float_as_uint(v), __float_as_uint(v), false, false); return __uint_as_float(rr[0]) + __uint_as_float(rr[1]); }
__device__ __forceinline__ float sum32(float v) { v += swz_xor<1>(v); v += swz_xor<2>(v); v += swz_xor<4>(v); v += swz_xor<8>(v); v += swz_xor<16>(v); return v; }
__device__ __forceinline__ float wave_sum(float v) { return half_sum(sum32(v)); }
__device__ __forceinline__ float sigmoidf_(float x) { return 1.f / (1.f + __expf(-x)); }
__device__ __forceinline__ float siluf_(float x) { return x / (1.f + __expf(-x)); }
__device__ __forceinline__ float sigmoid_fast(float x) { return __builtin_amdgcn_rcpf(1.f + __builtin_amdgcn_exp2f(-1.4426950408889634f * x)); }
__device__ __forceinline__ float silu_fast(float x) { return x * sigmoid_fast(x); }
__device__ __forceinline__ void unpack8_u8(const u32x2 w, float (&f)[8]) {
    f[0] = (float)(w.x & 0xffu); f[1] = (float)((w.x >> 8) & 0xffu); f[2] = (float)((w.x >> 16) & 0xffu); f[3] = (float)(w.x >> 24);
    f[4] = (float)(w.y & 0xffu); f[5] = (float)((w.y >> 8) & 0xffu); f[6] = (float)((w.y >> 16) & 0xffu); f[7] = (float)(w.y >> 24); }
__device__ __forceinline__ void unpack8(const u32x4 w, float (&f)[8]) {
    f[0] = bf_lo(w.x); f[1] = bf_hi(w.x); f[2] = bf_lo(w.y); f[3] = bf_hi(w.y); f[4] = bf_lo(w.z); f[5] = bf_hi(w.z); f[6] = bf_lo(w.w); f[7] = bf_hi(w.w);
}
__device__ __forceinline__ u32x2 pack8_fp8(const float (&f)[8]) { int a = __builtin_amdgcn_cvt_pk_fp8_f32(f[0], f[1], 0, false); a = __builtin_amdgcn_cvt_pk_fp8_f32(f[2], f[3], a, true);
    int b = __builtin_amdgcn_cvt_pk_fp8_f32(f[4], f[5], 0, false); b = __builtin_amdgcn_cvt_pk_fp8_f32(f[6], f[7], b, true); u32x2 w; w.x = (unsigned)a; w.y = (unsigned)b; return w; }
__device__ __forceinline__ u32x4 pack8(const float (&f)[8]) { u32x4 w; w.x = cvtpk(f[0], f[1]); w.y = cvtpk(f[2], f[3]); w.z = cvtpk(f[4], f[5]); w.w = cvtpk(f[6], f[7]); return w; }

__host__ __device__ __forceinline__ int vt_pos(int k) { const int w = k & 31, hi = (w >> 2) & 1, r = (w & 3) + 4 * (w >> 3); return 32 * hi + 16 * (k >> 5) + r; }
#ifdef HANDOFF_PLAIN_STORE
__device__ __forceinline__ void store_sc1(void* p, u32x4 v) { *(u32x4*)p = v; }
#else
__device__ __forceinline__ void store_sc1(void* p, u32x4 v) { asm volatile("global_store_dwordx4 %0, %1, off sc1" :: "v"(p), "v"(v) : "memory"); }
#endif
#define XB_TMO      128
#define XB_XCNT(j)  (256  + 64 * (j))
#define XB_XSUB(j)  (1280 + 64 * (j))
#define XB_XGEN(j)  (2304 + 64 * (j))
#define XB_TOP      3328
#define XB_TOPGEN   3392
#define XCD_BAR_WORDS 3456
#define XB_SPIN_CAP (1u << 20)
__device__ __forceinline__ unsigned xb_ld(unsigned* p)              { return __hip_atomic_load(p, __ATOMIC_RELAXED, __HIP_MEMORY_SCOPE_AGENT); }
__device__ __forceinline__ unsigned xb_add(unsigned* p, unsigned v) { return __hip_atomic_fetch_add(p, v, __ATOMIC_RELAXED, __HIP_MEMORY_SCOPE_AGENT); }
__device__ __forceinline__ unsigned xb_xcc_id() { return (unsigned)__builtin_amdgcn_s_getreg((3 << 11) | 20) & 0xFu; }
#define XB_SPIN(cond, bar) do { unsigned _sp = 0; while (cond) { __builtin_amdgcn_s_sleep(1); \
    if ((++_sp & 255u) == 0u) { if (xb_ld(&(bar)[XB_TMO])) break; if (_sp > XB_SPIN_CAP) { atomicAdd(&(bar)[XB_TMO], 1u); break; } } } } while (0)
struct XcdBarrier { unsigned* bar; unsigned x; volatile LAS unsigned* st; };
__device__ __forceinline__ XcdBarrier xcd_barrier_post(unsigned* bar, volatile LAS unsigned* st) {
    XcdBarrier b; b.bar = bar; b.x = xb_xcc_id(); b.st = st;
    if (threadIdx.x == 0) (void)xb_add(&bar[XB_XCNT(b.x)], 1u);
    return b;
}
__device__ __forceinline__ void xcd_barrier_complete(unsigned* bar, unsigned x, unsigned& nloc, unsigned& nx) {
    const unsigned G = gridDim.x * gridDim.y * gridDim.z;
    unsigned sum, cnt, mine, sp = 0u;
    for (;;) {
        sum = 0u; cnt = 0u; mine = 0u;
#pragma unroll
        for (unsigned j = 0; j < 16; ++j) { const unsigned c = xb_ld(&bar[XB_XCNT(j)]); sum += c; cnt += (c > 0u) ? 1u : 0u; mine = (j == x) ? c : mine; }
        if (sum == G) break;
        __builtin_amdgcn_s_sleep(1);
        if ((++sp & 255u) == 0u) { if (xb_ld(&bar[XB_TMO])) break; if (sp > XB_SPIN_CAP) { atomicAdd(&bar[XB_TMO], 1u); break; } }
    }
    nloc = mine > 0u ? mine : 1u; nx = cnt > 0u ? cnt : 1u;
}
__device__ __forceinline__ void xcd_barrier(const XcdBarrier& b, const int wv) {
    const bool leader = (wv == 0) && (olane() == 0);
    asm volatile("s_waitcnt vmcnt(0)" ::: "memory");
    __syncthreads();
    if (leader) {
        unsigned* bar = b.bar; unsigned bx = b.x;
        asm volatile("" : "+s"(bar), "+s"(bx));
        __builtin_amdgcn_s_waitcnt(0);
        unsigned nloc = b.st[0], nx = b.st[1];
        if (nloc == 0u) { xcd_barrier_complete(bar, bx, nloc, nx); b.st[0] = nloc; b.st[1] = nx; }
        const unsigned old = xb_add(&bar[XB_XSUB(bx)], 1u);
        const unsigned gen = old / nloc;
        if (old + 1u == (gen + 1u) * nloc) {
            __builtin_amdgcn_fence(__ATOMIC_RELEASE, "agent");
            asm volatile("s_waitcnt vmcnt(0)" ::: "memory");
            const unsigned og = xb_add(&bar[XB_TOP], 1u);
            const unsigned tg = og / nx;
            if (og + 1u == (tg + 1u) * nx) xb_add(&bar[XB_TOPGEN], 1u);
            else XB_SPIN(xb_ld(&bar[XB_TOPGEN]) == tg, bar);
            __builtin_amdgcn_fence(__ATOMIC_ACQUIRE, "agent");
            xb_add(&bar[XB_XGEN(bx)], 1u);
            asm volatile("s_waitcnt vmcnt(0)" ::: "memory");
        } else {
            XB_SPIN(xb_ld(&bar[XB_XGEN(bx)]) == gen, bar);
            __builtin_amdgcn_fence(__ATOMIC_ACQUIRE, "agent");
            asm volatile("s_waitcnt vmcnt(0)" ::: "memory");
        }
    }
    __syncthreads();
}

namespace pg8 {
constexpr int BM = 256, BK = 64, HALF = 128, HTB = HALF * BK * 2, NXCD = 8, WGM = 8;
__host__ __device__ __forceinline__ int lds_byte(int r, int c) { const int st = (r >> 4) * 2 + (c >> 5), rr = r & 15, cc = c & 31, ob = rr * 64 + cc * 2; return st * 1024 + (ob ^ (((ob >> 9) & 1) << 5)); }
__host__ __device__ __forceinline__ void stage_rc(int b, int& R, int& C) { const int st = b / 1024, sb = b % 1024, swz = sb ^ (((sb >> 9) & 1) << 5); R = (st >> 1) * 16 + swz / 64; C = (st & 1) * 32 + (swz % 64) / 2; }
__host__ __device__ __forceinline__ int perm32(int rho) { const int n = rho >> 4, i = rho & 15; return 8 * (i >> 2) + 4 * n + (i & 3); }

struct Unit { int pm, pn, aux0, aux1, aux2; const char* a; const char* b; const char* b2; };
typedef f32x4 Acc[2][2][4][2];

typedef int i32x8_t __attribute__((ext_vector_type(8)));
typedef int i32x4_t __attribute__((ext_vector_type(4)));
template <class Epi, class Sched, bool ALIGN_EPI, bool GATHER = false, bool SPLITB = false, bool FP8 = false, int SCA = 0x7f7f7f7f, int SCB = 0x7f7f7f7f>
__device__ __forceinline__ void gemm_phase(LAS unsigned char* lds, const int lda, const int ldb, const int K, const int ksplit, const Sched& S, const Epi& E, const int wv) {
    const int tid = otid(wv), wid = __builtin_amdgcn_readfirstlane(tid >> 6), lane = tid & 63, wr = wid >> 2, wc = wid & 3, fr = lane & 15, fq = lane >> 4;
    const int nt = K / BK;
    unsigned voffA[2][2], voffN[2][2], voffB[2];
#pragma unroll
    for (int i = 0; i < 2; ++i) { int R, C; stage_rc(tid * 16 + i * 8192, R, C); const int Rb = (R & ~31) + perm32(R & 31);
        voffB[i] = (unsigned)(Rb * ldb + C) * 2u;
        voffA[0][i] = (unsigned)(R * lda + C) * 2u; voffA[1][i] = (unsigned)((R + HALF) * lda + C) * 2u; voffN[0][i] = voffA[0][i]; voffN[1][i] = voffA[1][i]; }
    const size_t kstep = (size_t)(BK * 2);
    const size_t hstepB = (size_t)HALF * ldb * 2, hstepA = (size_t)HALF * lda * 2;
    const unsigned ldsw = (unsigned)wid * 1024u;
    const int aoff = lds_byte(wr * 64 + fr, fq * 8), boff = lds_byte(wc * 32 + fr, fq * 8);
#define PG8_SA(b, h) (((b) * 2 + (h)) * HTB)
#define PG8_SB(b, h) ((4 + (b) * 2 + (h)) * HTB)
#define PG8_STAGE_B(bufoff, gbase, h) do { _Pragma("unroll") for (int _i = 0; _i < 2; ++_i) \
        __builtin_amdgcn_global_load_lds((const unsigned*)((const char*)(gbase) + (size_t)(h) * hstepB + voffB[_i]), (LAS unsigned*)(lds + (bufoff) + ldsw + _i * 8192), 16, 0, 0); } while (0)
#define PG8_STAGE_A(bufoff, gbase, h, NX) do { _Pragma("unroll") for (int _i = 0; _i < 2; ++_i) { if constexpr (GATHER) { const unsigned _o = (NX) ? voffN[h][_i] : voffA[h][_i]; \
        __builtin_amdgcn_global_load_lds((const unsigned*)((const char*)(gbase) + _o), (LAS unsigned*)(lds + (bufoff) + ldsw + _i * 8192), 16, 0, 0); } else { \
        __builtin_amdgcn_global_load_lds((const unsigned*)((const char*)(gbase) + (size_t)(h) * hstepA + voffA[0][_i]), (LAS unsigned*)(lds + (bufoff) + ldsw + _i * 8192), 16, 0, 0); } } } while (0)
#define PG8_LDA(dst, b, h) do { _Pragma("unroll") for (int m = 0; m < 4; ++m) { if constexpr (FP8) { \
        A8[m].lo = *(const LAS i32x4_t*)(lds + PG8_SA(b, h) + aoff + m * 2048); A8[m].hi = *(const LAS i32x4_t*)(lds + PG8_SA(b, h) + aoff + m * 2048 + 1024); } else { \
        _Pragma("unroll") for (int k = 0; k < 2; ++k) dst[m][k] = *(const LAS bf16x8*)(lds + PG8_SA(b, h) + aoff + m * 2048 + k * 1024); } } } while (0)
#define PG8_LDB(dst, b, h) do { _Pragma("unroll") for (int n = 0; n < 2; ++n) { if constexpr (FP8) { \
        dst##8[n].lo = *(const LAS i32x4_t*)(lds + PG8_SB(b, h) + boff + n * 2048); dst##8[n].hi = *(const LAS i32x4_t*)(lds + PG8_SB(b, h) + boff + n * 2048 + 1024); } else { \
        _Pragma("unroll") for (int k = 0; k < 2; ++k) dst[n][k] = *(const LAS bf16x8*)(lds + PG8_SB(b, h) + boff + n * 2048 + k * 1024); } } } while (0)
#define PG8_MMA(ai, bj, At, Bt) do { __builtin_amdgcn_s_setprio(1); if constexpr (FP8) { _Pragma("unroll") for (int m = 0; m < 4; ++m) _Pragma("unroll") for (int n = 0; n < 2; ++n) \
        asm volatile("v_mfma_scale_f32_16x16x128_f8f6f4 %0, %1, %2, %0, %3, %4 op_sel_hi:[0,0,0]" : "+v"(acc[ai][bj][m][n]) : "v"(Bt##8[n]), "v"(A8[m]), "v"(scb_), "v"(sca_)); } else { \
        _Pragma("unroll") for (int m = 0; m < 4; ++m) _Pragma("unroll") for (int n = 0; n < 2; ++n) _Pragma("unroll") for (int k = 0; k < 2; ++k) \
        acc[ai][bj][m][n] = __builtin_amdgcn_mfma_f32_16x16x32_bf16(Bt[n][k], At[m][k], acc[ai][bj][m][n], 0, 0, 0); } __builtin_amdgcn_s_setprio(0); } while (0)
#define PG8_WAIT_V(n) asm volatile("s_waitcnt vmcnt(" #n ")" ::: "memory")
#define PG8_WAIT_L(n) asm volatile("s_waitcnt lgkmcnt(" #n ")" ::: "memory")
#define PG8_BAR __builtin_amdgcn_s_barrier()
#define PG8_SCHED __builtin_amdgcn_sched_barrier(0)
#define PG8_GOFF(dst, u) do { if constexpr (GATHER) { const int _t = otid(wv); _Pragma("unroll") for (int _i = 0; _i < 2; ++_i) { int _R, _C; stage_rc(_t * 16 + _i * 8192, _R, _C); \
        _Pragma("unroll") for (int _h = 0; _h < 2; ++_h) dst[_h][_i] = S.gather_off(u, _h * HALF + _R) + (unsigned)_C * 2u; } } } while (0)
#define PG8_BPTR(u, t) (SPLITB ? (((t) < ksplit) ? (u).b + (size_t)(t) * kstep : (u).b2 + (size_t)((t) - ksplit) * kstep) : (u).b + (size_t)(t) * kstep)
    Unit cur, nxt; int ui = 0;
    if (!S.next(0, cur)) return;
    Acc acc;
#pragma unroll
    for (int a = 0; a < 2; ++a)
#pragma unroll
        for (int b = 0; b < 2; ++b)
#pragma unroll
            for (int m = 0; m < 4; ++m)
#pragma unroll
                for (int n = 0; n < 2; ++n) acc[a][b][m][n] = (f32x4){0.f, 0.f, 0.f, 0.f};
    bf16x8 At[4][2], B0[2][2], B1[2][2]; i32x8_t A8[4], B08[2], B18[2]; const int sca_ = SCA, scb_ = SCB;
    const char* cA = cur.a; const char* cB = cur.b;
    S.a_ready(cur);
    PG8_GOFF(voffA, cur);
    if constexpr (GATHER) {
#pragma unroll
        for (int h = 0; h < 2; ++h)
#pragma unroll
            for (int i = 0; i < 2; ++i) voffN[h][i] = voffA[h][i];
    }
    PG8_STAGE_B(PG8_SB(0, 0), cB, 0); PG8_STAGE_B(PG8_SB(0, 1), cB, 1); PG8_STAGE_A(PG8_SA(0, 0), cA, 0, false); PG8_STAGE_A(PG8_SA(0, 1), cA, 1, false);
    if (wr == 1) PG8_BAR;
    PG8_WAIT_V(2); PG8_BAR;
    PG8_STAGE_B(PG8_SB(1, 0), cB + kstep, 0); PG8_STAGE_A(PG8_SA(1, 0), cA + kstep, 0, false); PG8_STAGE_B(PG8_SB(1, 1), cB + kstep, 1);
    PG8_WAIT_V(6); PG8_BAR;
    for (;;) {
        const bool has_next = S.next(ui + 1, nxt);
        const char* nA = has_next ? nxt.a : cA; const char* nB = has_next ? nxt.b : cB;
#pragma nounroll
        for (int t = 0; t < nt; t += 2) {
            const bool last = (t == nt - 2);
            if (last && has_next) { S.a_ready(nxt); PG8_GOFF(voffN, nxt); }
            if constexpr (Epi::HOOK) { if (t == Epi::HOOK_T0 || t == Epi::HOOK_T1) E.hook(acc, cur, t, wr, wc, fr, fq); }
            const char* a1 = cA + (size_t)(t + 1) * kstep;
            const char* a2 = last ? nA : cA + (size_t)(t + 2) * kstep; const char* b2 = last ? nB : PG8_BPTR(cur, t + 2);
            const char* a3 = a2 + kstep; const char* b3 = b2 + kstep;
            PG8_LDB(B0, 0, 0); PG8_LDB(B1, 0, 1); PG8_SCHED; PG8_LDA(At, 0, 0); PG8_STAGE_A(PG8_SA(1, 1), a1, 1, false);
            PG8_WAIT_V(8); PG8_WAIT_L(0); PG8_BAR; PG8_MMA(0, 0, At, B0); PG8_MMA(0, 1, At, B1); PG8_BAR; PG8_SCHED;
            PG8_LDA(At, 0, 1); PG8_STAGE_B(PG8_SB(0, 0), b2, 0); PG8_STAGE_B(PG8_SB(0, 1), b2, 1); PG8_STAGE_A(PG8_SA(0, 0), a2, 0, last);
            PG8_WAIT_V(8); PG8_WAIT_L(0); PG8_BAR; PG8_MMA(1, 0, At, B0); PG8_MMA(1, 1, At, B1); PG8_BAR; PG8_SCHED;
            PG8_LDB(B0, 1, 0); PG8_LDB(B1, 1, 1); PG8_SCHED; PG8_LDA(At, 1, 0); PG8_STAGE_A(PG8_SA(0, 1), a2, 1, last);
            PG8_WAIT_V(8); PG8_WAIT_L(0); PG8_BAR; PG8_MMA(0, 0, At, B0); PG8_MMA(0, 1, At, B1); PG8_BAR; PG8_SCHED;
            PG8_LDA(At, 1, 1); PG8_STAGE_B(PG8_SB(1, 0), b3, 0); PG8_STAGE_B(PG8_SB(1, 1), b3, 1); PG8_STAGE_A(PG8_SA(1, 0), a3, 0, last);
            PG8_WAIT_V(8); PG8_WAIT_L(0); PG8_BAR; PG8_MMA(1, 0, At, B0); PG8_MMA(1, 1, At, B1); PG8_BAR; PG8_SCHED;
        }
        if constexpr (ALIGN_EPI) { if (wr == 0) PG8_BAR; }
        if constexpr (FP8) asm volatile("s_nop 15\n\ts_nop 15" ::: "memory");
        E(acc, cur, wr, wc, fr, fq); S.done(cur);
        if (!has_next) break;
#pragma unroll
        for (int a = 0; a < 2; ++a)
#pragma unroll
            for (int b = 0; b < 2; ++b)
#pragma unroll
                for (int m = 0; m < 4; ++m)
#pragma unroll
                    for (int n = 0; n < 2; ++n) acc[a][b][m][n] = (f32x4){0.f, 0.f, 0.f, 0.f};
        cur = nxt; cA = nA; cB = nB; ++ui;
        if constexpr (GATHER) {
#pragma unroll
            for (int h = 0; h < 2; ++h)
#pragma unroll
                for (int i = 0; i < 2; ++i) voffA[h][i] = voffN[h][i];
        }
        if constexpr (ALIGN_EPI) { if (wr == 1) PG8_BAR; }
    }
    PG8_WAIT_V(0);
    if constexpr (!ALIGN_EPI) { if (wr == 0) PG8_BAR; }
    PG8_BAR;
#undef PG8_SA
#undef PG8_SB
#undef PG8_STAGE_A
#undef PG8_STAGE_B
#undef PG8_LDA
#undef PG8_LDB
#undef PG8_MMA
#undef PG8_WAIT_V
#undef PG8_WAIT_L
#undef PG8_BAR
#undef PG8_SCHED
#undef PG8_GOFF
#undef PG8_BPTR
}
}
struct Resid {
    const float* in_lat; const float* in_ctx; bf16_t* x_lat; bf16_t* x_ctx; int g, src_f32;
    __device__ __forceinline__ const float* srcf(int row) const { const int bl = row / SB, s = row - bl * SB, b = g * GB + bl;
        return s < CTXL ? in_ctx + (size_t)(b * CTXL + s) * DM : in_lat + ((size_t)b * SEQ + (s - CTXL)) * DM; }
    __device__ __forceinline__ bf16_t* dst(int row) const { const int bl = row / SB, s = row - bl * SB, b = g * GB + bl;
        return s < CTXL ? x_ctx + (size_t)(b * CTXL + s) * DM : x_lat + ((size_t)b * SEQ + (s - CTXL)) * DM; }
    __device__ __forceinline__ int modv(int row) const { const int bl = row / SB, s = row - bl * SB; return s < CTXL ? 8 : g * GB + bl; }
};

struct TileOrder {
    int nM, nN, nwg, G, c, skip; const char* A; const char* B; size_t astep, bstep;
    __device__ __forceinline__ void init(int nM_, int nN_, int G_, int c_, const void* A_, size_t astep_, const void* B_, size_t bstep_, int skip_ctx) {
        nM = nM_; nN = nN_; nwg = nM * nN; G = G_; c = c_; A = (const char*)A_; B = (const char*)B_; astep = astep_; bstep = bstep_; skip = skip_ctx; }
    __device__ __forceinline__ bool next(int i, pg8::Unit& u) const {
        const long L = (long)i * G + c; if (L >= nwg) return false;
        int wgid = (int)L; { const int q = nwg / pg8::NXCD, r = nwg % pg8::NXCD, xcd = wgid % pg8::NXCD, off = wgid / pg8::NXCD; wgid = (xcd < r ? xcd * (q + 1) : r * (q + 1) + (xcd - r) * q) + off; }
        const int nig = pg8::WGM * nN, gid = wgid / nig, fm = gid * pg8::WGM, gsz = (nM - fm) < pg8::WGM ? (nM - fm) : pg8::WGM;
        int pm = fm + ((wgid % nig) % gsz); u.pn = (wgid % nig) / gsz;
        if (skip) pm = pm + pm / 32 + 1;
        u.pm = pm; u.aux0 = 0; u.aux1 = 0; u.aux2 = 0;
        u.a = A + (size_t)pm * astep; u.b = B + (size_t)u.pn * bstep; u.b2 = u.b; return true;
    }
    __device__ __forceinline__ void a_ready(const pg8::Unit&) const {}
    __device__ __forceinline__ void done(const pg8::Unit&) const {}
};

struct TileOrderP : TileOrder {
    unsigned* ctr;
    __device__ __forceinline__ void done(const pg8::Unit& u) const {
        asm volatile("s_waitcnt vmcnt(0)" ::: "memory");
#ifdef HANDOFF_RELEASE
        __builtin_amdgcn_fence(__ATOMIC_RELEASE, "agent"); asm volatile("s_waitcnt vmcnt(0)" ::: "memory");
#endif
        if (olane() == 0) __hip_atomic_fetch_add(ctr + 64 * u.pm, 1u, __ATOMIC_RELAXED, __HIP_MEMORY_SCOPE_AGENT);
    }
};
struct TileOrderC : TileOrder {
    unsigned* ctr; unsigned need; unsigned* tmo; int wv;
    __device__ __forceinline__ void a_ready(const pg8::Unit& u) const {
        if (wv == 0) {
            const unsigned long long t0 = __builtin_amdgcn_s_memrealtime(); unsigned polls = 0;
            while ((unsigned)__builtin_amdgcn_readfirstlane(__hip_atomic_load(ctr + 64 * u.pm, __ATOMIC_RELAXED, __HIP_MEMORY_SCOPE_AGENT)) < need) {
                if ((++polls & 255u) == 0u && __builtin_amdgcn_readfirstlane(__hip_atomic_load(tmo, __ATOMIC_RELAXED, __HIP_MEMORY_SCOPE_AGENT)) != 0u) break;
                if (__builtin_amdgcn_s_memrealtime() - t0 > 2000000ull) { if (olane() == 0) __hip_atomic_store(tmo, 1u, __ATOMIC_RELAXED, __HIP_MEMORY_SCOPE_AGENT); break; }
                __builtin_amdgcn_s_sleep(2); }
            __builtin_amdgcn_fence(__ATOMIC_ACQUIRE, "agent");
            asm volatile("s_waitcnt vmcnt(0)" ::: "memory");
        }
        asm volatile("" ::: "memory"); __builtin_amdgcn_s_barrier(); asm volatile("" ::: "memory");
    }
};

struct MoeOrder {
    const LAS int* tab; const int* LIST; int ncol, G, c, up; const char* A; const char* W; int esz;
    __device__ __forceinline__ bool next(int i, pg8::Unit& u) const {
        const int TR = __builtin_amdgcn_readfirstlane(tab[24]);
        int rt, pn;
        if ((G & 7) == 0) { const int x = c & 7, j = c >> 3, W = G >> 3; const int lo = (TR * x) >> 3, hi = (TR * (x + 1)) >> 3; const int q = i * W + j; if (q >= (hi - lo) * ncol) return false;
            rt = lo + q / ncol; pn = q - (q / ncol) * ncol; }
        else { const int L = i * G + c; if (L >= TR * ncol) return false; rt = L / ncol; pn = L - rt * ncol; }
        int p = 0;
#pragma unroll
        for (int q = 1; q < NPAIR; ++q) p += (__builtin_amdgcn_readfirstlane(tab[q]) <= rt) ? 1 : 0;
        const int base = (rt - __builtin_amdgcn_readfirstlane(tab[p])) * 256; int valid = __builtin_amdgcn_readfirstlane(tab[32 + p]) - base; valid = valid > 256 ? 256 : valid;
        u.pm = rt; u.pn = pn; u.aux0 = p * NT + base; u.aux1 = valid; u.aux2 = p;
        const int grp = p / 6, q6 = p - grp * 6;
        const int lo = q6 < 3 ? 0 : (q6 < 5 ? 1 : 2), hi = q6 < 3 ? q6 + 1 : (q6 < 5 ? q6 - 1 : 3);
        const int ea = grp * 4 + lo, eb = grp * 4 + hi;
        if (up) { const int e = pn < 4 ? ea : eb; u.a = A; u.b = W + ((size_t)e * 1024 + (size_t)(pn & 3) * 256) * 1024 * esz; u.b2 = u.b; }
        else { u.a = A + (size_t)rt * 256 * 1024 * esz; u.b = W + ((size_t)ea * 1024 + (size_t)pn * 256) * 512 * esz; u.b2 = W + ((size_t)eb * 1024 + (size_t)pn * 256) * 512 * esz; }
        return true;
    }
    __device__ __forceinline__ unsigned gather_off(const pg8::Unit& u, int r) const { const int idx = r < u.aux1 ? r : 0; return (unsigned)LIST[u.aux0 + idx] * (unsigned)(DM * esz); }
    __device__ __forceinline__ void a_ready(const pg8::Unit&) const {}
    __device__ __forceinline__ void done(const pg8::Unit&) const {}
};

#ifdef EPI_NT_STORES
#define ST_NT(p, v) __builtin_nontemporal_store((v), (p))
#else
#define ST_NT(p, v) (*(p) = (v))
#endif
#define EPI_NOHOOK static constexpr bool HOOK = false; static constexpr int HOOK_T0 = -1, HOOK_T1 = -1; \
    __device__ __forceinline__ void hook(pg8::Acc&, const pg8::Unit&, int, int, int, int, int) const {}
#define EPI_V8(v, acc, ai, bj, m) float v[8]; { const f32x4 _a = acc[ai][bj][m][0], _b = acc[ai][bj][m][1]; v[0] = _a[0]; v[1] = _a[1]; v[2] = _a[2]; v[3] = _a[3]; v[4] = _b[0]; v[5] = _b[1]; v[6] = _b[2]; v[7] = _b[3]; }
__device__ __forceinline__ void rot4(float (&v)[8], const f32x2* cs) {
    const f32x4 c01 = *(const f32x4*)cs, c23 = *(const f32x4*)(cs + 2);
    const float c[4] = {c01[0], c01[2], c23[0], c23[2]}, s[4] = {c01[1], c01[3], c23[1], c23[3]};
#pragma unroll
    for (int k = 0; k < 4; ++k) { const float x1 = v[2 * k], x2 = v[2 * k + 1]; v[2 * k] = x1 * c[k] - x2 * s[k]; v[2 * k + 1] = x2 * c[k] + x1 * s[k]; }
}

struct EpiNone { EPI_NOHOOK
    float* sink;
    __device__ __forceinline__ void operator()(const pg8::Acc& acc, const pg8::Unit& u, int wr, int wc, int fr, int fq) const {
        float s = 0.f;
#pragma unroll
        for (int ai = 0; ai < 2; ++ai)
#pragma unroll
            for (int bj = 0; bj < 2; ++bj)
#pragma unroll
                for (int m = 0; m < 4; ++m) s += acc[ai][bj][m][0][0] + acc[ai][bj][m][1][3];
        if (s == 1.2345e33f) sink[0] = s;
    }
};
struct EpiStoreOnly { EPI_NOHOOK
    bf16_t* PG;
    __device__ __forceinline__ void operator()(const pg8::Acc& acc, const pg8::Unit& u_, int wr, int wc, int fr, int fq) const {
        pg8::Unit u = u_; asm volatile("" : "+s"(u.pm), "+s"(u.pn), "+v"(fr), "+v"(fq));
#ifdef STORE_PITCH
        const int pn12 = u.pn % 8;
#define SO_PITCH (STORE_PITCH)
#else
        const int pn12 = u.pn % 12;
#define SO_PITCH 3072
#endif
#pragma unroll
        for (int ai = 0; ai < 2; ++ai)
#pragma unroll
        for (int m = 0; m < 4; ++m) { const int row = u.pm * 256 + ai * 128 + wr * 64 + m * 16 + fr;
#pragma unroll
            for (int bj = 0; bj < 2; ++bj) { const int c0 = bj * 128 + wc * 32 + 8 * fq; EPI_V8(v, acc, ai, bj, m)
#if defined(SO_MODE) && SO_MODE == 1
                if (bj == 0)
#elif defined(SO_MODE) && SO_MODE == 2
                if (obid() & 8)
#elif defined(SO_MODE) && SO_MODE == 3
                if (obid() & 1)
#endif
                *(u32x4*)(PG + (size_t)row * SO_PITCH + pn12 * 256 + c0) = pack8(v); } }
    }
};
struct EpiGate {
    EPI_NOHOOK
    bf16_t* PG;
    __device__ __forceinline__ void operator()(const pg8::Acc& acc, const pg8::Unit& u_, int wr, int wc, int fr, int fq) const {
        pg8::Unit u = u_; asm volatile("" : "+s"(u.pm), "+s"(u.pn), "+v"(fr), "+v"(fq));
#pragma unroll
        for (int ai = 0; ai < 2; ++ai)
#pragma unroll
        for (int m = 0; m < 4; ++m) { const int row = u.pm * 256 + ai * 128 + wr * 64 + m * 16 + fr;
#pragma unroll
            for (int bj = 0; bj < 2; ++bj) { const int c0 = bj * 128 + wc * 32 + 8 * fq;
                EPI_V8(v, acc, ai, bj, m)
                float g[8];
#pragma unroll
#ifdef GATE_U8
                for (int k = 0; k < 8; ++k) g[k] = 255.f * __builtin_amdgcn_rcpf(1.f + __builtin_amdgcn_exp2f(-fmaxf(v[k], -7.98868f)));
                u32x2 w = {0u, 0u};
                w.x = __builtin_amdgcn_cvt_pk_u8_f32(g[0], 0, w.x); w.x = __builtin_amdgcn_cvt_pk_u8_f32(g[1], 1, w.x); w.x = __builtin_amdgcn_cvt_pk_u8_f32(g[2], 2, w.x); w.x = __builtin_amdgcn_cvt_pk_u8_f32(g[3], 3, w.x);
                w.y = __builtin_amdgcn_cvt_pk_u8_f32(g[4], 0, w.y); w.y = __builtin_amdgcn_cvt_pk_u8_f32(g[5], 1, w.y); w.y = __builtin_amdgcn_cvt_pk_u8_f32(g[6], 2, w.y); w.y = __builtin_amdgcn_cvt_pk_u8_f32(g[7], 3, w.y);
                *(u32x2*)((unsigned char*)PG + (size_t)row * 3072 + u.pn * 256 + c0) = w; } }
#else
                for (int k = 0; k < 8; ++k) g[k] = __builtin_amdgcn_rcpf(1.f + __builtin_amdgcn_exp2f(-fmaxf(v[k], -15.f * 1.4426950408889634f)));
                *(u32x4*)(PG + (size_t)row * 3072 + u.pn * 256 + c0) = pack8(g); } }
#endif
    }
};
struct EpiInproj {
    EPI_NOHOOK
    bf16_t *PR, *PC, *PM, *PG; unsigned char* KB; float* SSQ; const f32x2* RT; const f32x2* MT; int pn_off;
    __device__ __forceinline__ void operator()(const pg8::Acc& acc, const pg8::Unit& u_, int wr, int wc, int fr, int fq) const {
        pg8::Unit u = u_; asm volatile("" : "+s"(u.pm), "+s"(u.pn), "+s"(u.aux0), "+s"(u.aux1), "+v"(fr), "+v"(fq));
        const int pn = u.pn + pn_off;
#pragma unroll
        for (int ai = 0; ai < 2; ++ai)
#pragma unroll
        for (int m = 0; m < 4; ++m) { __builtin_amdgcn_sched_barrier(0);
            const int row = u.pm * 256 + ai * 128 + wr * 64 + m * 16 + fr;
            const int bl = row / SB, s = row - bl * SB; const bool lat = s >= CTXL; const int t = lat ? s - CTXL : 0;
            float ss[2] = {0.f, 0.f};
#pragma unroll
            for (int bj = 0; bj < 2; ++bj) {
                const int c0 = bj * 128 + wc * 32 + 8 * fq;
                EPI_V8(v, acc, ai, bj, m)
                if (pn <= 1) {
                    if (lat) rot4(v, RT + (size_t)t * 32 + ((c0 & 63) >> 1));
                    if (pn == 1) {
#pragma unroll
                        for (int k = 0; k < 8; ++k) v[k] *= 0.125f;
                    }
                    *(u32x4*)(PR + (size_t)row * 1536 + pn * 256 + c0) = pack8(v);
                } else if (pn <= 5) {
                    *(u32x4*)(PR + (size_t)row * 1536 + pn * 256 + c0) = pack8(v);
                } else if (pn <= 7) {
                    *(u32x4*)(PC + (size_t)row * 1024 + (pn - 6) * 256 + c0) = pack8(v);
                } else if (pn <= 11) {
                    u32x2 w; w.x = cvtpk(v[0] * v[1], v[2] * v[3]); w.y = cvtpk(v[4] * v[5], v[6] * v[7]);
                    *(u32x2*)(PC + (size_t)row * 1024 + 512 + (pn - 8) * 128 + (c0 >> 1)) = w;
                } else if (pn <= 14) {
                    if (pn == 14 && bj == 1) {
                        if (wc == 0) {
                            if (lat) { const int a = fq >> 1, pos = a ? (t & 63) : (t >> 6); rot4(v, MT + pos * 8 + (fq & 1) * 4); }
#pragma unroll
                            for (int k = 0; k < 8; ++k) v[k] *= K8S;
                            const u32x2 w = pack8_fp8(v);
#pragma unroll
                            for (int hh = 0; hh < 8; ++hh) { unsigned char* kp = KB + ((size_t)(bl * 8 + hh) * SB + s) * 128;
                                *(u32x2*)(kp + 64 + 8 * fq) = w; if (fq == 3) { *(u32x4*)(kp + 96) = (u32x4){0u, 0u, 0u, 0u}; *(u32x4*)(kp + 112) = (u32x4){0u, 0u, 0u, 0u}; } }
                        }
                    } else {
                        *(u32x4*)(PM + (size_t)row * 640 + (pn - 12) * 256 + c0) = pack8(v);
                        float q = 0.f;
#pragma unroll
                        for (int k = 0; k < 8; ++k) q += v[k] * v[k];
                        ss[bj] = q;
                    }
                } else {
                    float g[8];
#pragma unroll
                    for (int k = 0; k < 8; ++k) g[k] = sigmoid_fast(fmaxf(v[k], -15.f));
                    ST_NT((u32x4*)(PG + (size_t)row * 3072 + (pn - 15) * 256 + c0), pack8(g));
                }
            }
            if (pn >= 12 && pn <= 14) {
                float a = ss[0], b = ss[1];
                a += swz_xor<16>(a); a = half_sum(a); b += swz_xor<16>(b); b = half_sum(b);
                if (fq == 0) {
                    float* sq = SSQ + (size_t)row * 16;
                    if (pn == 12) sq[wc] = a + b;
                    else if (pn == 13) { sq[4 + wc] = a; sq[8 + wc] = b; }
                    else sq[12 + wc] = a;
                }
            }
        }
    }
};

#define EPI_ROW(ai, m) (u.pm * 256 + (ai) * 128 + wr * 64 + (m) * 16 + fr)
#define EPI_OPAQUE pg8::Unit u = u_; asm volatile("" : "+s"(u.pm), "+s"(u.pn), "+s"(u.aux0), "+s"(u.aux1), "+v"(fr), "+v"(fq));
struct EpiUq {
    EPI_NOHOOK
    unsigned char* QB; const float* SSQ; const f32x2* MT;
    __device__ __forceinline__ void operator()(const pg8::Acc& acc, const pg8::Unit& u_, int wr, int wc, int fr, int fq) const {
        EPI_OPAQUE
        f32x4 q0[2][4], q1[2][4];
#pragma unroll
        for (int ai = 0; ai < 2; ++ai)
#pragma unroll
            for (int m = 0; m < 4; ++m) { const float* sq = SSQ + (size_t)EPI_ROW(ai, m) * 16; q0[ai][m] = *(const f32x4*)sq; q1[ai][m] = *(const f32x4*)(sq + 4); }
#pragma unroll
        for (int ai = 0; ai < 2; ++ai)
#pragma unroll
        for (int m = 0; m < 4; ++m) {
            const int row = EPI_ROW(ai, m);
            const int bl = row / SB, s = row - bl * SB; const bool lat = s >= CTXL; const int t = lat ? s - CTXL : 0;
            const f32x4 a = q0[ai][m], b = q1[ai][m];
            const float ssq = ((a[0] + a[1]) + (a[2] + a[3])) + ((b[0] + b[1]) + (b[2] + b[3]));
            const float rq = rsqrtf(ssq * (1.f / 384.f) + RMS_EPS) * (QSCALE * Q8S);
#pragma unroll
            for (int bj = 0; bj < 2; ++bj) {
                const int cg = u.pn * 256 + bj * 128 + wc * 32 + 8 * fq; const int h = cg / 96, d0 = cg - h * 96;
                EPI_V8(v, acc, ai, bj, m)
#pragma unroll
                for (int k = 0; k < 8; ++k) v[k] *= rq;
                if (d0 >= 64 && lat) { const int p0 = d0 - 64, aa = p0 >> 4, pos = aa ? (t & 63) : (t >> 6); rot4(v, MT + pos * 8 + ((p0 & 15) >> 1)); }
                unsigned char* qp = QB + ((size_t)(bl * 8 + h) * SB + s) * 128;
                *(u32x2*)(qp + d0) = pack8_fp8(v);
                if (d0 == 88) { *(u32x4*)(qp + 96) = (u32x4){0u, 0u, 0u, 0u}; *(u32x4*)(qp + 112) = (u32x4){0u, 0u, 0u, 0u}; }
            }
        }
    }
};
struct EpiUkv {
    EPI_NOHOOK
    unsigned char* KB; unsigned char* VT; const float* SSQ; LAS unsigned char* tr;
    __device__ __forceinline__ void operator()(const pg8::Acc& acc, const pg8::Unit& u_, int wr, int wc, int fr, int fq) const {
        EPI_OPAQUE
        f32x4 q0[2][4], q1[2][4];
#pragma unroll
        for (int ai = 0; ai < 2; ++ai)
#pragma unroll
            for (int m = 0; m < 4; ++m) { const float* sq = SSQ + (size_t)EPI_ROW(ai, m) * 16 + 8; q0[ai][m] = *(const f32x4*)sq; q1[ai][m] = *(const f32x4*)(sq + 4); }
        LAS unsigned char* my = tr + (wr * 2 + (wc & 1)) * 2048;
        const int lane = fr + 16 * fq;
#pragma unroll
        for (int ai = 0; ai < 2; ++ai) {
            const int row0 = u.pm * 256 + ai * 128 + wr * 64;
            const int bl = row0 / SB, s0 = row0 - bl * SB;
#pragma unroll
            for (int bj = 0; bj < 2; ++bj) {
                const int h = u.pn * 2 + bj;
#pragma unroll
                for (int m = 0; m < 4; ++m) {
                    const f32x4 a = q0[ai][m], b = q1[ai][m];
                    const float ssq = ((a[0] + a[1]) + (a[2] + a[3])) + ((b[0] + b[1]) + (b[2] + b[3]));
                    const float rk = rsqrtf(ssq * (1.f / 256.f) + RMS_EPS);
                    EPI_V8(v, acc, ai, bj, m)
                    if (wc < 2) {
#pragma unroll
                        for (int k = 0; k < 8; ++k) v[k] *= rk * K8S;
                        *(u32x2*)(KB + ((size_t)(bl * 8 + h) * SB + s0 + 16 * m + fr) * 128 + wc * 32 + 8 * fq) = pack8_fp8(v);
                    } else {
#pragma unroll
                        for (int k = 0; k < 8; ++k) v[k] *= rk * V8S;
                        const u32x2 w = pack8_fp8(v); const int pos = vt_pos(16 * m + fr) ^ (16 * fq);
#pragma unroll
                        for (int k = 0; k < 4; ++k) { my[(8 * fq + k) * 64 + pos] = (unsigned char)(w.x >> (8 * k)); my[(8 * fq + 4 + k) * 64 + pos] = (unsigned char)(w.y >> (8 * k)); }
                    }
                }
                if (wc >= 2) {
#pragma unroll
                    for (int i = 0; i < 2; ++i) { const int ch = lane + 64 * i, d = ch >> 2, c16 = ch & 3;
                        const u32x4 x = *(const LAS u32x4*)(my + d * 64 + ((c16 ^ ((d >> 3) & 3)) * 16));
                        *(u32x4*)(VT + ((size_t)(bl * 8 + h) * 64 + (wc - 2) * 32 + d) * SB + s0 + c16 * 16) = x; }
                }
            }
        }
    }
};

struct EpiMerge1 {
    static constexpr bool HOOK = true; static constexpr int HOOK_T0 = 8, HOOK_T1 = 16;
    const bf16_t* PG; bf16_t* M;
    __device__ __forceinline__ void hook(pg8::Acc& acc, const pg8::Unit& u_, int t, int wr, int wc, int fr, int fq) const {
        pg8::Unit u = u_; asm volatile("" : "+s"(u.pm), "+s"(u.pn), "+v"(fr), "+v"(fq));
        const int gi = (t == 8) ? 0 : 1;
#pragma unroll
        for (int ai = 0; ai < 2; ++ai) {
#ifdef GATE_U8
            u32x2 sp[4][2], sn[4][2];
#pragma unroll
            for (int m = 0; m < 4; ++m)
#pragma unroll
                for (int bj = 0; bj < 2; ++bj) { const unsigned char* p = (const unsigned char*)PG + (size_t)EPI_ROW(ai, m) * 3072 + gi * 1024 + u.pn * 256 + bj * 128 + wc * 32 + 8 * fq;
                    sp[m][bj] = *(const u32x2*)p; sn[m][bj] = *(const u32x2*)(p + 1024); }
#else
            u32x4 sp[4][2], sn[4][2];
#pragma unroll
            for (int m = 0; m < 4; ++m)
#pragma unroll
                for (int bj = 0; bj < 2; ++bj) { const bf16_t* p = PG + (size_t)EPI_ROW(ai, m) * 3072 + gi * 1024 + u.pn * 256 + bj * 128 + wc * 32 + 8 * fq;
                    sp[m][bj] = *(const u32x4*)p; sn[m][bj] = *(const u32x4*)(p + 1024); }
#endif
#pragma unroll
            for (int m = 0; m < 4; ++m)
#pragma unroll
                for (int bj = 0; bj < 2; ++bj) {
#ifdef GATE_U8
                    float a[8], b[8]; unpack8_u8(sp[m][bj], a); unpack8_u8(sn[m][bj], b);
#else
                    float a[8], b[8]; unpack8(sp[m][bj], a); unpack8(sn[m][bj], b);
#endif
                    f32x4 r0, r1;
#pragma unroll
                    for (int k = 0; k < 4; ++k) { r0[k] = a[k] * __builtin_amdgcn_rcpf(b[k]); r1[k] = a[4 + k] * __builtin_amdgcn_rcpf(b[4 + k]); }
                    acc[ai][bj][m][0] *= r0; acc[ai][bj][m][1] *= r1;
                }
            __builtin_amdgcn_sched_barrier(0);
        }
    }
    __device__ __forceinline__ void operator()(const pg8::Acc& acc, const pg8::Unit& u_, int wr, int wc, int fr, int fq) const {
        EPI_OPAQUE
        const __amdgpu_buffer_rsrc_t rsrc = __builtin_amdgcn_make_buffer_rsrc((void*)M, 0, (int)((size_t)NT * 1024 * 2), 0x00020000);
#pragma unroll
        for (int ai = 0; ai < 2; ++ai) {
#ifdef GATE_U8
            u32x2 s2[4][2];
#pragma unroll
            for (int m = 0; m < 4; ++m)
#pragma unroll
                for (int bj = 0; bj < 2; ++bj) s2[m][bj] = *(const u32x2*)((const unsigned char*)PG + (size_t)EPI_ROW(ai, m) * 3072 + 2048 + u.pn * 256 + bj * 128 + wc * 32 + 8 * fq);
#else
            u32x4 s2[4][2];
#pragma unroll
            for (int m = 0; m < 4; ++m)
#pragma unroll
                for (int bj = 0; bj < 2; ++bj) s2[m][bj] = *(const u32x4*)(PG + (size_t)EPI_ROW(ai, m) * 3072 + 2048 + u.pn * 256 + bj * 128 + wc * 32 + 8 * fq);
#endif
#pragma unroll
            for (int m = 0; m < 4; ++m)
#pragma unroll
                for (int bj = 0; bj < 2; ++bj) {
                    const int cg = u.pn * 256 + bj * 128 + wc * 32 + 8 * fq;
#ifdef GATE_U8
                    float g[8]; unpack8_u8(s2[m][bj], g);
                    EPI_V8(v, acc, ai, bj, m)
#pragma unroll
                    for (int k = 0; k < 8; ++k) v[k] *= g[k] * (1.f / 255.f);
#else
                    float g[8]; unpack8(s2[m][bj], g);
                    EPI_V8(v, acc, ai, bj, m)
#pragma unroll
                    for (int k = 0; k < 8; ++k) v[k] *= g[k];
#endif
#ifndef HANDOFF
                    *(u32x4*)(M + (size_t)EPI_ROW(ai, m) * 1024 + cg) = pack8(v);
#else
                    __builtin_amdgcn_raw_buffer_store_b128(pack8(v), rsrc, (unsigned)(((size_t)EPI_ROW(ai, m) * 1024 + cg) * 2), 0, 16);
#endif
                }
            __builtin_amdgcn_sched_barrier(0);
        }
    }
};

struct EpiMerge1NoHook : EpiMerge1 { static constexpr bool HOOK = false; };
struct EpiMerge1HookOnly { static constexpr bool HOOK = true; static constexpr int HOOK_T0 = 8, HOOK_T1 = 16; EpiMerge1 e; float* sink;
    __device__ __forceinline__ void hook(pg8::Acc& acc, const pg8::Unit& u, int t, int wr, int wc, int fr, int fq) const { e.hook(acc, u, t, wr, wc, fr, fq); }
    __device__ __forceinline__ void operator()(const pg8::Acc& acc, const pg8::Unit& u, int wr, int wc, int fr, int fq) const { EpiNone n{sink}; n(acc, u, wr, wc, fr, fq); }
};
struct EpiMerge2 {
    EPI_NOHOOK
    Resid R; const float* MODL;
    __device__ __forceinline__ void operator()(const pg8::Acc& acc, const pg8::Unit& u_, int wr, int wc, int fr, int fq) const {
        EPI_OPAQUE
        const int cb = u.pn * 256 + wc * 32 + 8 * fq;
        const float* g1 = MODL + R.modv(u.pm * 256) * 6144 + 2048 + cb;
        f32x4 g[2][2];
#pragma unroll
        for (int bj = 0; bj < 2; ++bj)
#pragma unroll
            for (int n = 0; n < 2; ++n) g[bj][n] = *(const f32x4*)(g1 + bj * 128 + 4 * n);
        int sf32 = R.src_f32; asm volatile("" : "+s"(sf32));
#pragma unroll
        for (int ai = 0; ai < 2; ++ai) {
            if (sf32) {
#pragma unroll
                for (int mh = 0; mh < 2; ++mh) {
                    f32x4 x[2][2][2];
#pragma unroll
                    for (int m2 = 0; m2 < 2; ++m2) { const float* src = R.srcf(EPI_ROW(ai, 2 * mh + m2)) + cb;
#pragma unroll
                        for (int bj = 0; bj < 2; ++bj)
#pragma unroll
                            for (int n = 0; n < 2; ++n) x[m2][bj][n] = *(const f32x4*)(src + bj * 128 + 4 * n); }
#pragma unroll
                    for (int m2 = 0; m2 < 2; ++m2) { const int m = 2 * mh + m2; bf16_t* dst = R.dst(EPI_ROW(ai, m)) + cb;
#pragma unroll
                        for (int bj = 0; bj < 2; ++bj) { const f32x4 a = x[m2][bj][0] + g[bj][0] * acc[ai][bj][m][0], b = x[m2][bj][1] + g[bj][1] * acc[ai][bj][m][1];
                            u32x4 w; w.x = cvtpk(a[0], a[1]); w.y = cvtpk(a[2], a[3]); w.z = cvtpk(b[0], b[1]); w.w = cvtpk(b[2], b[3]); *(u32x4*)(dst + bj * 128) = w; } }
                }
            } else {
                u32x4 x[4][2];
#pragma unroll
                for (int m = 0; m < 4; ++m) { const bf16_t* src = R.dst(EPI_ROW(ai, m)) + cb;
#pragma unroll
                    for (int bj = 0; bj < 2; ++bj) x[m][bj] = *(const u32x4*)(src + bj * 128); }
#pragma unroll
                for (int m = 0; m < 4; ++m) { bf16_t* dst = R.dst(EPI_ROW(ai, m)) + cb;
#pragma unroll
                    for (int bj = 0; bj < 2; ++bj) { float f[8]; unpack8(x[m][bj], f);
                        const f32x4 a = (f32x4){f[0], f[1], f[2], f[3]} + g[bj][0] * acc[ai][bj][m][0], b = (f32x4){f[4], f[5], f[6], f[7]} + g[bj][1] * acc[ai][bj][m][1];
                        u32x4 w; w.x = cvtpk(a[0], a[1]); w.y = cvtpk(a[2], a[3]); w.z = cvtpk(b[0], b[1]); w.w = cvtpk(b[2], b[3]); *(u32x4*)(dst + bj * 128) = w; } }
            }
            __builtin_amdgcn_sched_barrier(0);
        }
    }
};

struct EpiMoeUp {
    EPI_NOHOOK
    const int* LIST; const float* WGT; bf16_t* MACT;
    __device__ __forceinline__ void operator()(const pg8::Acc& acc, const pg8::Unit& u_, int wr, int wc, int fr, int fq) const {
        EPI_OPAQUE
        const int slot = u.pn >> 2;
        int tok[2][4]; float w[2][4];
#pragma unroll
        for (int ai = 0; ai < 2; ++ai)
#pragma unroll
            for (int m = 0; m < 4; ++m) { const int ri = ai * 128 + wr * 64 + m * 16 + fr; tok[ai][m] = LIST[u.aux0 + (ri < u.aux1 ? ri : 0)]; }
#pragma unroll
        for (int ai = 0; ai < 2; ++ai)
#pragma unroll
            for (int m = 0; m < 4; ++m) w[ai][m] = WGT[(size_t)tok[ai][m] * 2 + slot];
#pragma unroll
        for (int ai = 0; ai < 2; ++ai)
#pragma unroll
        for (int m = 0; m < 4; ++m) {
            const int ri = ai * 128 + wr * 64 + m * 16 + fr; const float ww = w[ai][m];
#pragma unroll
            for (int bj = 0; bj < 2; ++bj) {
                const int c0 = bj * 128 + wc * 32 + 8 * fq;
                EPI_V8(v, acc, ai, bj, m)
                u32x2 o; o.x = cvtpk(silu_fast(v[0]) * v[1] * ww, silu_fast(v[2]) * v[3] * ww); o.y = cvtpk(silu_fast(v[4]) * v[5] * ww, silu_fast(v[6]) * v[7] * ww);
                *(u32x2*)(MACT + (size_t)(u.pm * 256 + ri) * 1024 + slot * 512 + (u.pn & 3) * 128 + (c0 >> 1)) = o;
            }
        }
    }
};
struct EpiMoeUp8 {
    EPI_NOHOOK
    const int* LIST; const float* WGT; unsigned char* MACT;
    __device__ __forceinline__ void operator()(const pg8::Acc& acc, const pg8::Unit& u_, int wr, int wc, int fr, int fq) const {
        EPI_OPAQUE
        const int slot = u.pn >> 2;
        int tok[2][4]; float w[2][4];
#pragma unroll
        for (int ai = 0; ai < 2; ++ai)
#pragma unroll
            for (int m = 0; m < 4; ++m) { const int ri = ai * 128 + wr * 64 + m * 16 + fr; tok[ai][m] = LIST[u.aux0 + (ri < u.aux1 ? ri : 0)]; }
#pragma unroll
        for (int ai = 0; ai < 2; ++ai)
#pragma unroll
            for (int m = 0; m < 4; ++m) w[ai][m] = WGT[(size_t)tok[ai][m] * 2 + slot] * MA8S;
#pragma unroll
        for (int ai = 0; ai < 2; ++ai)
#pragma unroll
        for (int m = 0; m < 4; ++m) {
            const int ri = ai * 128 + wr * 64 + m * 16 + fr; const float ww = w[ai][m];
#pragma unroll
            for (int bj = 0; bj < 2; ++bj) {
                const int c0 = bj * 128 + wc * 32 + 8 * fq;
                EPI_V8(v, acc, ai, bj, m)
                int o = __builtin_amdgcn_cvt_pk_fp8_f32(silu_fast(v[0]) * v[1] * ww, silu_fast(v[2]) * v[3] * ww, 0, false); o = __builtin_amdgcn_cvt_pk_fp8_f32(silu_fast(v[4]) * v[5] * ww, silu_fast(v[6]) * v[7] * ww, o, true);
                *(int*)(MACT + (size_t)(u.pm * 256 + ri) * 1024 + slot * 512 + (u.pn & 3) * 128 + (c0 >> 1)) = o;
            }
        }
    }
};
struct EpiMoeDown {
    EPI_NOHOOK
    const int* LIST; Resid R; const float* MODL; bf16_t* dry;
    __device__ __forceinline__ void operator()(const pg8::Acc& acc, const pg8::Unit& u_, int wr, int wc, int fr, int fq) const {
        EPI_OPAQUE
        int tok[2][4];
#pragma unroll
        for (int ai = 0; ai < 2; ++ai)
#pragma unroll
            for (int m = 0; m < 4; ++m) { const int ri = ai * 128 + wr * 64 + m * 16 + fr; tok[ai][m] = LIST[u.aux0 + (ri < u.aux1 ? ri : 0)]; }
        const int cb = u.pn * 256 + wc * 32 + 8 * fq;
#pragma unroll
        for (int ai = 0; ai < 2; ++ai) {
            u32x4 x[4][2];
#pragma unroll
            for (int m = 0; m < 4; ++m) { const bf16_t* dst = R.dst(tok[ai][m]) + cb;
#pragma unroll
                for (int bj = 0; bj < 2; ++bj) x[m][bj] = *(const u32x4*)(dst + bj * 128); }
#pragma unroll
            for (int m = 0; m < 4; ++m) { const int ri = ai * 128 + wr * 64 + m * 16 + fr;
                if (ri < u.aux1) {
                    bf16_t* dst = R.dst(tok[ai][m]) + cb; const float* g2 = MODL + R.modv(tok[ai][m]) * 6144 + 5120 + cb;
#pragma unroll
                    for (int bj = 0; bj < 2; ++bj) { float f[8]; unpack8(x[m][bj], f);
                        const f32x4 ga = *(const f32x4*)(g2 + bj * 128), gb = *(const f32x4*)(g2 + bj * 128 + 4);
                        const f32x4 a = (f32x4){f[0], f[1], f[2], f[3]} + ga * acc[ai][bj][m][0], b = (f32x4){f[4], f[5], f[6], f[7]} + gb * acc[ai][bj][m][1];
                        u32x4 w; w.x = cvtpk(a[0], a[1]); w.y = cvtpk(a[2], a[3]); w.z = cvtpk(b[0], b[1]); w.w = cvtpk(b[2], b[3]);
                        bf16_t* o = dry ? dry + (size_t)(u.pm * 256 + ri) * 1024 + cb + bj * 128 : dst + bj * 128;
                        *(u32x4*)o = w; }
                } }
            __builtin_amdgcn_sched_barrier(0);
        }
    }
};
#define SBAR() __builtin_amdgcn_sched_barrier(0)
__device__ __forceinline__ int crow(int r, int hi) { return (r & 3) + 8 * (r >> 2) + 4 * hi; }
template <int NCB> __device__ __forceinline__ int v_st(int k, int c) { const int kk = (k & ~0xC) | ((k & 4) << 1) | ((k & 8) >> 1); return ((kk >> 3) * NCB + (c >> 5)) * 512 + ((kk & 7) * 32 + (c & 31)) * 2; }
__device__ __forceinline__ int v_rd_base(int lane) { return ((lane & 3) << 3) | (((lane >> 2) & 3) << 6) | (((lane >> 4) & 1) << 5) | (((lane >> 5) & 1) << 8); }
template <int OFF> __device__ __forceinline__ s16x4 tr_read(int vb) { s16x4 r; asm volatile("ds_read_b64_tr_b16 %0, %1 offset:%2" : "=&v"(r) : "v"(vb), "i"(OFF) : "memory"); return r; }
#define PKLH(L, H) (bf16x8){L[0], L[1], L[2], L[3], H[0], H[1], H[2], H[3]}
template <int NCB, int KS> __device__ __forceinline__ bf16x8 tr_frag(int vb) { const s16x4 l = tr_read<KS * NCB * 1024>(vb), h = tr_read<KS * NCB * 1024 + NCB * 512>(vb); return PKLH(l, h); }
#define PK4(P, BASE, OUT) do { const unsigned a0 = cvtpk(P[BASE + 0], P[BASE + 1]), a1 = cvtpk(P[BASE + 2], P[BASE + 3]);   \
    const unsigned b0 = cvtpk(P[BASE + 4], P[BASE + 5]), b1 = cvtpk(P[BASE + 6], P[BASE + 7]);                              \
    auto r0 = __builtin_amdgcn_permlane32_swap(a0, b0, false, false); auto r1 = __builtin_amdgcn_permlane32_swap(a1, b1, false, false); \
    u32x4 w = {r0[0], r1[0], r0[1], r1[1]}; OUT = __builtin_bit_cast(bf16x8, w); } while (0)

namespace att {
constexpr int DQK = 96, DV = 64, KVBLK = 64;
constexpr int SHM_V = KVBLK * DV * 2;
constexpr int SHM_K = KVBLK * 256;
constexpr float THR = 8.f;
#define KSWZ(row, colB) ((row) * 256 + ((colB) ^ (((row) & 7) << 4)))
__device__ __forceinline__ void partialSM(f32x16& p0, f32x16& p1, float& m_reg, float& alpha) {
    float pmax = p0[0];
#pragma unroll
    for (int r = 1; r < 16; ++r) pmax = fmaxf(pmax, p0[r]);
#pragma unroll
    for (int r = 0; r < 16; ++r) pmax = fmaxf(pmax, p1[r]);
    { auto rr = __builtin_amdgcn_permlane32_swap(__float_as_uint(pmax), __float_as_uint(pmax), false, false);
      pmax = fmaxf(__uint_as_float(rr[0]), __uint_as_float(rr[1])); }
    float mn;
    if (__builtin_expect(__all(pmax - m_reg <= THR), 1)) { mn = m_reg; alpha = 1.f; }
    else { mn = fmaxf(m_reg, pmax); alpha = __builtin_amdgcn_exp2f(m_reg - mn); m_reg = mn; }
#pragma unroll
    for (int r = 0; r < 16; ++r) p0[r] = p0[r] - mn;
#pragma unroll
    for (int r = 0; r < 16; ++r) p1[r] = p1[r] - mn;
#pragma unroll
    for (int r = 0; r < 16; ++r) p0[r] = __builtin_amdgcn_exp2f(p0[r]);
}
__device__ __forceinline__ void finishSM(f32x16& p0, f32x16& p1, float alpha, float& l_reg, bf16x8& pa0, bf16x8& pa1, bf16x8& pa2, bf16x8& pa3) {
#pragma unroll
    for (int r = 0; r < 16; ++r) p1[r] = __builtin_amdgcn_exp2f(p1[r]);
    float ps = 0;
#pragma unroll
    for (int r = 0; r < 16; ++r) ps += p0[r];
#pragma unroll
    for (int r = 0; r < 16; ++r) ps += p1[r];
    { auto rr = __builtin_amdgcn_permlane32_swap(__float_as_uint(ps), __float_as_uint(ps), false, false);
      ps = __uint_as_float(rr[0]) + __uint_as_float(rr[1]); }
    l_reg = l_reg * alpha + ps;
    PK4(p0, 0, pa0); PK4(p0, 8, pa1); PK4(p1, 0, pa2); PK4(p1, 8, pa3);
}
__device__ __forceinline__ void qkt(f32x16& p0, f32x16& p1, const LAS char* Ks, const bf16x8* qr, int r32, int hi) {
    p0 = f32x16{}; p1 = f32x16{};
#pragma unroll
    for (int d0 = 0; d0 < 6; ++d0) { const int cb = (d0 * 16 + hi * 8) * 2;
        const bf16x8 b0 = *(const LAS bf16x8*)(Ks + KSWZ(r32, cb));
        const bf16x8 b1 = *(const LAS bf16x8*)(Ks + KSWZ(32 + r32, cb));
        p0 = __builtin_amdgcn_mfma_f32_32x32x16_bf16(b0, qr[d0], p0, 0, 0, 0);
        p1 = __builtin_amdgcn_mfma_f32_32x32x16_bf16(b1, qr[d0], p1, 0, 0, 0); }
}
template <int D0> __device__ __forceinline__ void pv_one(f32x16& od, int vb, bf16x8 pa0, bf16x8 pa1, bf16x8 pa2, bf16x8 pa3) {
    const bf16x8 f0 = tr_frag<2, 0>(vb + D0 * 512), f1 = tr_frag<2, 1>(vb + D0 * 512), f2 = tr_frag<2, 2>(vb + D0 * 512), f3 = tr_frag<2, 3>(vb + D0 * 512);
    asm volatile("s_waitcnt lgkmcnt(0)" ::: "memory"); SBAR();
    od = __builtin_amdgcn_mfma_f32_32x32x16_bf16(pa0, f0, od, 0, 0, 0);
    od = __builtin_amdgcn_mfma_f32_32x32x16_bf16(pa1, f1, od, 0, 0, 0);
    od = __builtin_amdgcn_mfma_f32_32x32x16_bf16(pa2, f2, od, 0, 0, 0);
    od = __builtin_amdgcn_mfma_f32_32x32x16_bf16(pa3, f3, od, 0, 0, 0);
}
__device__ __forceinline__ void pv_d0(f32x16* o, int vb, bf16x8 pa0, bf16x8 pa1, bf16x8 pa2, bf16x8 pa3) {
    pv_one<0>(o[0], vb, pa0, pa1, pa2, pa3); pv_one<1>(o[1], vb, pa0, pa1, pa2, pa3);
}
__device__ __forceinline__ void attn_unit(const bf16_t* __restrict__ Qb, const bf16_t* __restrict__ Kh, const bf16_t* __restrict__ Vh, bf16_t* __restrict__ Ob, int ldo, int seq, LAS char* lds, const int wv) {
    const int tid = otid(wv), wid = __builtin_amdgcn_readfirstlane(tid >> 6), lane = tid & 63, r32 = lane & 31, hi = lane >> 5;
    LAS char* V_lds = lds; LAS char* K_lds = lds + 2 * SHM_V;
    LAS float* ws = (LAS float*)(lds + 2 * SHM_V + 2 * SHM_K) + wid * 64; LAS float* li_l = ws; LAS float* al_l = ws + 32;
    float m_reg = -1e30f, l_reg = 0; f32x16 o[2] = {}; bf16x8 qr[6];
    const bf16_t* Qw = Qb + (size_t)(wid * 32 + r32) * DQK + hi * 8;
#pragma unroll
    for (int d0 = 0; d0 < 6; ++d0) qr[d0] = *(const bf16x8*)(Qw + d0 * 16);
    const int vrow = tid >> 3, vc = (tid & 7) * 8, vst = v_st<2>(vrow, vc);
    const int krA = tid / 12, kcA = tid - krA * 12, sB = 512 + tid, krB = sB / 12, kcB = sB - krB * 12;
    const int kstA = KSWZ(krA, kcA * 16), kstB = KSWZ(krB, kcB * 16);
    const bool hasB = wid < 4;
    const int vb0 = (int)(size_t)V_lds + v_rd_base(lane);
    struct { bf16x8 v, ka, kb; } sr_[2];
#define SLOAD(i, k0) do { sr_[i].v = *(const bf16x8*)(Vh + (size_t)((k0) + vrow) * DV + vc); sr_[i].ka = *(const bf16x8*)(Kh + (size_t)((k0) + krA) * DQK + kcA * 8); \
    if (hasB) sr_[i].kb = *(const bf16x8*)(Kh + (size_t)((k0) + krB) * DQK + kcB * 8); } while (0)
#define SWRITE(b, i) do { *(LAS bf16x8*)(V_lds + (b) * SHM_V + vst) = sr_[i].v; *(LAS bf16x8*)(K_lds + (b) * SHM_K + kstA) = sr_[i].ka; \
    if (hasB) *(LAS bf16x8*)(K_lds + (b) * SHM_K + kstB) = sr_[i].kb; } while (0)
#define RESC(a) do { if (__any((a) < 1.f)) { if (hi == 0) al_l[r32] = (a); asm volatile("s_waitcnt lgkmcnt(0)" ::: "memory"); \
    _Pragma("unroll") for (int d = 0; d < 2; ++d) _Pragma("unroll") for (int r = 0; r < 16; ++r) o[d][r] *= al_l[crow(r, hi)]; } } while (0)
    f32x16 pA0, pA1, pB0, pB1; float alA, alB; bf16x8 pa0, pa1, pa2, pa3; const int NTL = seq / KVBLK;
    SLOAD(0, 0); SWRITE(0, 0); __syncthreads();
    qkt(pA0, pA1, K_lds, qr, r32, hi); partialSM(pA0, pA1, m_reg, alA);
    SLOAD(1, KVBLK); if (2 < NTL) SLOAD(0, 2 * KVBLK);
    SWRITE(1, 1); __syncthreads();
    for (int j = 1; j + 1 < NTL; j += 2) {
        SBAR(); qkt(pB0, pB1, K_lds + SHM_K, qr, r32, hi);
        finishSM(pA0, pA1, alA, l_reg, pa0, pa1, pa2, pa3); SBAR();
        SLOAD(1, (j + 2) * KVBLK); SBAR();
        pv_d0(o, vb0, pa0, pa1, pa2, pa3); partialSM(pB0, pB1, m_reg, alB);
        __syncthreads(); SWRITE(0, 0);
        RESC(alB); __syncthreads();
        SBAR(); qkt(pA0, pA1, K_lds, qr, r32, hi);
        finishSM(pB0, pB1, alB, l_reg, pa0, pa1, pa2, pa3); SBAR();
        if (j + 3 < NTL) SLOAD(0, (j + 3) * KVBLK); SBAR();
        pv_d0(o, vb0 + SHM_V, pa0, pa1, pa2, pa3); partialSM(pA0, pA1, m_reg, alA);
        __syncthreads(); SWRITE(1, 1);
        RESC(alA); __syncthreads();
    }
    SBAR(); qkt(pB0, pB1, K_lds + SHM_K, qr, r32, hi);
    finishSM(pA0, pA1, alA, l_reg, pa0, pa1, pa2, pa3); SBAR();
    pv_d0(o, vb0, pa0, pa1, pa2, pa3); partialSM(pB0, pB1, m_reg, alB);
    __syncthreads(); RESC(alB);
    finishSM(pB0, pB1, alB, l_reg, pa0, pa1, pa2, pa3); SBAR();
    pv_d0(o, vb0 + SHM_V, pa0, pa1, pa2, pa3);
    if (hi == 0) li_l[r32] = l_reg; asm volatile("s_waitcnt lgkmcnt(0)" ::: "memory");
    float rli[16];
#pragma unroll
    for (int r = 0; r < 16; ++r) rli[r] = __builtin_amdgcn_rcpf(li_l[crow(r, hi)]);
    bf16_t* Ow = Ob + (size_t)(wid * 32) * ldo;
#pragma unroll
    for (int r = 0; r < 16; ++r) { const int orow = crow(r, hi);
#pragma unroll
        for (int d0 = 0; d0 < 2; ++d0) Ow[(size_t)orow * ldo + d0 * 32 + r32] = f2bf(o[d0][r] * rli[r]); }
    __syncthreads();
#undef SLOAD
#undef SWRITE
#undef RESC
}
}

namespace att2 {
constexpr int DQK = 96, DV = 64, KVBLK = 64;
constexpr int KB_BYTES = 64 * 128, VB_BYTES = 64 * 64;
typedef int i32x8 __attribute__((ext_vector_type(8)));
constexpr int SC_K = 0x7d7d7d7d, SC_Q = 0x7a7a7a7a, SC_P = 0x7f7f7f7f, SC_V = 0x7d7d7d7d;
#ifdef ATTN_HOIST
constexpr int NSLOT = 6, PP_VMW = 2 * (NSLOT - 3);
#else
constexpr int NSLOT = 5, PP_VMW = 2 * (NSLOT - 2);
#endif
constexpr int LDS_K = 0, LDS_V = NSLOT * KB_BYTES, LDS_WS = LDS_V + NSLOT * VB_BYTES, LDS_TOTAL = LDS_WS + 8 * 64 * 4;
static_assert(LDS_TOTAL <= RING_BYTES, "attention LDS");
constexpr float THR = 4.f;
typedef short v4i16_t __attribute__((ext_vector_type(4)));
__device__ __forceinline__ s16x4 vtr(const LAS char* p) { return __builtin_bit_cast(s16x4, __builtin_amdgcn_ds_read_tr16_b64_v4i16((LAS v4i16_t*)p)); }
#define PP_KLD(B, DH) ({ const int row_ = 32 * (B) + r32, sw_ = (row_ >> 1) & 7, c0_ = 2 * hi + 4 * (DH); \
        const u32x4 a_ = *(const LAS u32x4*)(Kt + row_ * 128 + ((c0_ ^ sw_) << 4)), b_ = *(const LAS u32x4*)(Kt + row_ * 128 + (((c0_ + 1) ^ sw_) << 4)); \
        (i32x8){(int)a_.x, (int)a_.y, (int)a_.z, (int)a_.w, (int)b_.x, (int)b_.y, (int)b_.z, (int)b_.w}; })
#define PP_VLD(DB) ({ const int d_ = 32 * (DB) + r32, sw_ = (d_ >> 2) & 3; \
        const u32x4 a_ = *(const LAS u32x4*)(Vt + d_ * 64 + (((2 * hi) ^ sw_) << 4)), b_ = *(const LAS u32x4*)(Vt + d_ * 64 + (((2 * hi + 1) ^ sw_) << 4)); \
        (i32x8){(int)a_.x, (int)a_.y, (int)a_.z, (int)a_.w, (int)b_.x, (int)b_.y, (int)b_.z, (int)b_.w}; })
#ifdef PROBE_EXP2X
#define PP_EXP(x) do { float a_ = (x), b_ = (x); asm volatile("" : "+v"(b_)); a_ = __builtin_amdgcn_exp2f(a_); b_ = __builtin_amdgcn_exp2f(b_); (x) = (a_ + b_) * 0.5f; } while (0)
#else
#define PP_EXP(x) (x) = __builtin_amdgcn_exp2f(x)
#endif
#define PK4N(P, BASE, OUT) do { u32x4 w_ = {cvtpk(P[BASE + 0], P[BASE + 1]), cvtpk(P[BASE + 2], P[BASE + 3]), cvtpk(P[BASE + 4], P[BASE + 5]), cvtpk(P[BASE + 6], P[BASE + 7])}; OUT = __builtin_bit_cast(bf16x8, w_); } while (0)
#define PP_SLOT_END() do { SBAR(); asm volatile("s_waitcnt vmcnt(%0) lgkmcnt(0)\n\ts_barrier" :: "n"(PP_VMW) : "memory"); SBAR(); } while (0)
#ifdef ATTN_VDMA_HALF
#define PP_SLOT_END1() do { SBAR(); asm volatile("s_waitcnt vmcnt(%0) lgkmcnt(0)\n\ts_barrier" :: "n"(PP_VMW / 2) : "memory"); SBAR(); } while (0)
#else
#define PP_SLOT_END1() PP_SLOT_END()
#endif
#define PP_BAR() do { SBAR(); asm volatile("s_waitcnt lgkmcnt(0)\n\ts_barrier" ::: "memory"); SBAR(); } while (0)
__device__ __forceinline__ float max3f(float a, float b, float c) { return fmaxf(fmaxf(a, b), c); }
__device__ __forceinline__ void attn_unit_pp(const unsigned char* __restrict__ Qb, const unsigned char* __restrict__ Kh, const unsigned char* __restrict__ Vh, bf16_t* __restrict__ Ob, int ldo, int seq, LAS char* lds, const int wv) {
    const int tid = otid(wv), wid = __builtin_amdgcn_readfirstlane(tid >> 6), lane = tid & 63, r32 = lane & 31, hi = lane >> 5,
#ifdef ATTN_GRP_PARITY
        grp = wid & 1;
#else
        grp = wid >> 2;
#endif
    LAS float* ws = (LAS float*)(lds + LDS_WS) + wid * 64; LAS float* al_l = ws;
    const int NTL = seq / KVBLK;
    unsigned koff, voff;
    { const int s = wid * 64 + lane, row = s >> 3, ch = (s & 7) ^ ((row >> 1) & 7); koff = (unsigned)(row * 128 + ch * 16); }
    { const int s = (wid & 3) * 64 + lane, d = s >> 2, ch = (s & 3) ^ ((d >> 2) & 3); voff = (unsigned)(d * SB + ch * 16); }
    const char* Kg = (const char*)Kh; const char* Vg = (const char*)Vh;
#define PP_DMA_K(t) do { int tt_ = (t); tt_ = tt_ < NTL ? tt_ : NTL - 1; const int sl_ = tt_ % NSLOT; \
        __builtin_amdgcn_global_load_lds((const unsigned*)(Kg + (size_t)tt_ * (64 * 128) + koff), (LAS unsigned*)(lds + LDS_K + sl_ * KB_BYTES + wid * 1024), 16, 0, 0); } while (0)
#define PP_DMA_V(t) do { int tt_ = (t); tt_ = tt_ < NTL ? tt_ : NTL - 1; const int sl_ = tt_ % NSLOT; \
        __builtin_amdgcn_global_load_lds((const unsigned*)(Vg + (size_t)tt_ * 64 + voff), (LAS unsigned*)(lds + LDS_V + sl_ * VB_BYTES + (wid & 3) * 1024), 16, 0, 0); } while (0)
#pragma unroll
    for (int i = 0; i <= NSLOT - 2; ++i) PP_DMA_K(i);
#pragma unroll
    for (int i = 0; i <= NSLOT - 3; ++i) PP_DMA_V(i);
    i32x8 q8[2];
    { const unsigned char* Qw = Qb + (size_t)(wid * 32 + r32) * 128 + hi * 32;
#pragma unroll
      for (int dh = 0; dh < 2; ++dh) { const u32x4 a_ = *(const u32x4*)(Qw + dh * 64), b_ = *(const u32x4*)(Qw + dh * 64 + 16);
          q8[dh] = (i32x8){(int)a_.x, (int)a_.y, (int)a_.z, (int)a_.w, (int)b_.x, (int)b_.y, (int)b_.z, (int)b_.w}; } }
    float m_reg = 0.f; f32x16 o[2] = {}; f32x16 lacc = {}; const i32x8 ones8 = {0x38383838, 0x38383838, 0x38383838, 0x38383838, 0x38383838, 0x38383838, 0x38383838, 0x38383838}; f32x16 negm = {}; asm volatile("" : "+v"(negm));
    f32x16 p0, p1; i32x8 pa8 = {};
    SBAR(); asm volatile("s_waitcnt vmcnt(0) lgkmcnt(0)\n\ts_barrier" ::: "memory"); SBAR();
#ifdef ATTN_TWO_BARRIERS
    if (grp == 1) PP_BAR();
#endif
#ifdef ATTN_VDMA_HALF
#define PP_M(t) PP_MG(t, 1)
#define PP_M1(t) PP_MG(t, 0)
#else
#define PP_M(t) PP_MG(t, 1)
#define PP_M1(t) PP_MG(t, 1)
#endif
#define PP_MG(t, DOV) do { const int t_ = (t), j_ = t_ + 1; \
        if (t_ <= NTL - 2) { if (DOV) PP_DMA_V(t_ + NSLOT - 1); PP_DMA_K(t_ + NSLOT); } \
        i32x8 k8[4]; i32x8 v8[2]; \
        const LAS char* Kt = lds + LDS_K + ((j_ < NTL ? j_ : 0) % NSLOT) * KB_BYTES; \
        const LAS char* Vt = lds + LDS_V + ((t_ < 0 ? 0 : t_) % NSLOT) * VB_BYTES; \
        if (j_ < NTL) { \
            k8[0] = PP_KLD(0, 0); k8[1] = PP_KLD(1, 0); SBAR(); \
            k8[2] = PP_KLD(0, 1); SBAR(); \
            p0 = __builtin_amdgcn_mfma_scale_f32_32x32x64_f8f6f4(k8[0], q8[0], negm, 0, 0, 0, SC_K, 0, SC_Q); SBAR(); \
            k8[3] = PP_KLD(1, 1); SBAR(); \
            p1 = __builtin_amdgcn_mfma_scale_f32_32x32x64_f8f6f4(k8[1], q8[0], negm, 0, 0, 0, SC_K, 0, SC_Q); SBAR(); \
            if (t_ >= 0) { v8[0] = PP_VLD(0); } SBAR(); \
            p0 = __builtin_amdgcn_mfma_scale_f32_32x32x64_f8f6f4(k8[2], q8[1], p0, 0, 0, 0, SC_K, 0, SC_Q); SBAR(); \
            if (t_ >= 0) { v8[1] = PP_VLD(1); } SBAR(); \
            p1 = __builtin_amdgcn_mfma_scale_f32_32x32x64_f8f6f4(k8[3], q8[1], p1, 0, 0, 0, SC_K, 0, SC_Q); SBAR(); \
        } else if (t_ >= 0) { v8[0] = PP_VLD(0); v8[1] = PP_VLD(1); SBAR(); } \
        if (t_ >= 0) { \
            o[0] = __builtin_amdgcn_mfma_scale_f32_32x32x64_f8f6f4(pa8, v8[0], o[0], 0, 0, 0, SC_P, 0, SC_V); \
            o[1] = __builtin_amdgcn_mfma_scale_f32_32x32x64_f8f6f4(pa8, v8[1], o[1], 0, 0, 0, SC_P, 0, SC_V); \
            lacc = __builtin_amdgcn_mfma_scale_f32_32x32x64_f8f6f4(pa8, ones8, lacc, 0, 0, 0, SC_P, 0, SC_P); } \
        asm volatile("" : "+v"(o[0]), "+v"(o[1]), "+v"(p0), "+v"(p1), "+v"(lacc));        \
        } while (0)
#ifdef ATTN_HOIST
    i32x8 k8[4] = {}; i32x8 v8[2] = {};
#define PP_LD(t) do { const int t_ = (t), j_ = t_ + 1; \
        const LAS char* Kt = lds + LDS_K + ((j_ < NTL ? j_ : 0) % NSLOT) * KB_BYTES; \
        const LAS char* Vt = lds + LDS_V + ((t_ < 0 ? 0 : t_) % NSLOT) * VB_BYTES; \
        if (j_ < NTL) { k8[0] = PP_KLD(0, 0); k8[1] = PP_KLD(1, 0); k8[2] = PP_KLD(0, 1); k8[3] = PP_KLD(1, 1); } \
        if (t_ >= 0) { v8[0] = PP_VLD(0); v8[1] = PP_VLD(1); } SBAR(); } while (0)
#define PP_MM(t) do { const int t_ = (t), j_ = t_ + 1; \
        if (t_ <= NTL - 2) { PP_DMA_V(t_ + NSLOT - 1); PP_DMA_K(t_ + NSLOT); } \
        if (j_ < NTL) { \
            p0 = __builtin_amdgcn_mfma_scale_f32_32x32x64_f8f6f4(k8[0], q8[0], negm, 0, 0, 0, SC_K, 0, SC_Q); \
            p1 = __builtin_amdgcn_mfma_scale_f32_32x32x64_f8f6f4(k8[1], q8[0], negm, 0, 0, 0, SC_K, 0, SC_Q); \
            p0 = __builtin_amdgcn_mfma_scale_f32_32x32x64_f8f6f4(k8[2], q8[1], p0, 0, 0, 0, SC_K, 0, SC_Q); \
            p1 = __builtin_amdgcn_mfma_scale_f32_32x32x64_f8f6f4(k8[3], q8[1], p1, 0, 0, 0, SC_K, 0, SC_Q); } \
        if (t_ >= 0) { \
            o[0] = __builtin_amdgcn_mfma_scale_f32_32x32x64_f8f6f4(pa8, v8[0], o[0], 0, 0, 0, SC_P, 0, SC_V); \
            o[1] = __builtin_amdgcn_mfma_scale_f32_32x32x64_f8f6f4(pa8, v8[1], o[1], 0, 0, 0, SC_P, 0, SC_V); \
            int c1_ = 0x38383838; asm volatile("" : "+s"(c1_)); const i32x8 on_ = {c1_, c1_, c1_, c1_, c1_, c1_, c1_, c1_};        \
            lacc = __builtin_amdgcn_mfma_scale_f32_32x32x64_f8f6f4(pa8, on_, lacc, 0, 0, 0, SC_P, 0, SC_P); } \
        asm volatile("" : "+v"(o[0]), "+v"(o[1]), "+v"(p0), "+v"(p1), "+v"(lacc)); SBAR(); \
        } while (0)
#endif
#define PP_S(first) do { \
        float a_ = max3f(p0[0], p0[1], p1[0]), b_ = max3f(p0[2], p0[3], p1[1]); a_ = max3f(a_, p1[2], p1[3]); \
        _Pragma("unroll") for (int r = 4; r < 16; r += 4) { a_ = max3f(a_, p0[r], p0[r + 1]); b_ = max3f(b_, p0[r + 2], p0[r + 3]); a_ = max3f(a_, p1[r], p1[r + 1]); b_ = max3f(b_, p1[r + 2], p1[r + 3]); } \
        float rm_ = fmaxf(a_, b_); { auto rr = __builtin_amdgcn_permlane32_swap(__float_as_uint(rm_), __float_as_uint(rm_), false, false); rm_ = fmaxf(__uint_as_float(rr[0]), __uint_as_float(rr[1])); } \
        if (first) { const float dl = rm_ - 4.f; m_reg = dl; _Pragma("unroll") for (int r = 0; r < 16; ++r) { p0[r] -= dl; p1[r] -= dl; } \
            _Pragma("unroll") for (int r = 0; r < 16; ++r) negm[r] = -m_reg; asm volatile("" : "+v"(negm)); } \
        else if (__builtin_expect(__any(rm_ > 2.f * THR), 0)) { const float dl = fmaxf(rm_ - THR, 0.f); m_reg += dl; \
            _Pragma("unroll") for (int r = 0; r < 16; ++r) { p0[r] -= dl; p1[r] -= dl; } \
            _Pragma("unroll") for (int r = 0; r < 16; ++r) negm[r] = -m_reg; asm volatile("" : "+v"(negm)); \
            const float al = __builtin_amdgcn_exp2f(-dl); if (hi == 0) al_l[r32] = al; asm volatile("s_waitcnt lgkmcnt(0)" ::: "memory"); \
            _Pragma("unroll") for (int r = 0; r < 16; ++r) { const float f_ = al_l[crow(r, hi)]; o[0][r] *= f_; o[1][r] *= f_; lacc[r] *= f_; } } \
        _Pragma("unroll") for (int r = 0; r < 16; ++r) { PP_EXP(p0[r]); PP_EXP(p1[r]); } \
        _Pragma("unroll") for (int k_ = 0; k_ < 4; ++k_) { \
            int w_ = __builtin_amdgcn_cvt_pk_fp8_f32(p0[4 * k_], p0[4 * k_ + 1], pa8[k_], false); w_ = __builtin_amdgcn_cvt_pk_fp8_f32(p0[4 * k_ + 2], p0[4 * k_ + 3], w_, true); pa8[k_] = w_;        \
            int x_ = __builtin_amdgcn_cvt_pk_fp8_f32(p1[4 * k_], p1[4 * k_ + 1], pa8[4 + k_], false); x_ = __builtin_amdgcn_cvt_pk_fp8_f32(p1[4 * k_ + 2], p1[4 * k_ + 3], x_, true); pa8[4 + k_] = x_; } \
        asm volatile("" : "+v"(pa8)); } while (0)
#ifdef ATTN_TWO_BARRIERS
    PP_M(-1); PP_SLOT_END();
    PP_S(true); PP_SLOT_END();
#pragma nounroll
    for (int t = 0; t < NTL - 1; ++t) {
        PP_M(t); PP_SLOT_END();
        PP_S(false); PP_SLOT_END();
    }
    PP_M(NTL - 1);
    if (grp == 0) PP_BAR();
#else
#ifdef ATTN_PRIO_YOUNG
    if (grp == 1) __builtin_amdgcn_s_setprio(1);
#endif
#ifdef ATTN_HOIST
    if (grp == 0) {
        PP_LD(-1); PP_MM(-1); PP_LD(0); PP_S(true); PP_SLOT_END();
#pragma nounroll
        for (int t = 0; t < NTL - 1; ++t) { PP_MM(t); PP_LD(t + 1); PP_S(false); PP_SLOT_END(); }
        PP_MM(NTL - 1);
    } else {
        PP_LD(-1); PP_MM(-1); PP_SLOT_END();
        PP_LD(0); PP_S(true);
#pragma nounroll
        for (int t = 0; t < NTL - 1; ++t) { PP_MM(t); PP_SLOT_END(); PP_LD(t + 1); PP_S(false); }
        PP_MM(NTL - 1);
    }
#else
    if (grp == 0) {
        PP_M(-1); PP_S(true); PP_SLOT_END();
#pragma nounroll
        for (int t = 0; t < NTL - 1; ++t) { PP_M(t); PP_S(false); PP_SLOT_END(); }
        PP_M(NTL - 1);
    } else {
        PP_M1(-1); PP_SLOT_END1();
        PP_S(true);
#pragma nounroll
        for (int t = 0; t < NTL - 1; ++t) { PP_M1(t); PP_SLOT_END1(); PP_S(false); }
        PP_M1(NTL - 1);
    }
#endif
#ifdef ATTN_PRIO_YOUNG
    __builtin_amdgcn_s_setprio(0);
#endif
#endif
    float rli[16];
#pragma unroll
    for (int r = 0; r < 16; ++r) rli[r] = __builtin_amdgcn_rcpf(lacc[r]);
    bf16_t* Ow = Ob + (size_t)(wid * 32) * ldo;
#pragma unroll
    for (int r = 0; r < 16; ++r) { const int orow = crow(r, hi);
#pragma unroll
        for (int d0 = 0; d0 < 2; ++d0) Ow[(size_t)orow * ldo + d0 * 32 + r32] = f2bf(o[d0][r] * rli[r]); }
    SBAR(); asm volatile("s_waitcnt vmcnt(0) lgkmcnt(0)\n\ts_barrier" ::: "memory"); SBAR();
#undef PP_DMA_K
#undef PP_DMA_V
#undef PP_M
#undef PP_M1
#undef PP_MG
#undef PP_S
#ifdef ATTN_HOIST
#undef PP_LD
#undef PP_MM
#endif
}

constexpr int NSLOT_IL = 6, IL_VMW = 2 * (NSLOT_IL - 3);
constexpr int IL_K = 0, IL_V = NSLOT_IL * KB_BYTES, IL_WS = IL_V + NSLOT_IL * VB_BYTES, IL_TOTAL = IL_WS + 8 * 64 * 4;
static_assert(IL_TOTAL <= RING_BYTES, "attention LDS");
__device__ __forceinline__ void attn_unit_il(const unsigned char* __restrict__ Qb, const unsigned char* __restrict__ Kh, const unsigned char* __restrict__ Vh, bf16_t* __restrict__ Ob, int ldo, int seq, LAS char* lds, const int wv) {
    const int tid = otid(wv), wid = __builtin_amdgcn_readfirstlane(tid >> 6), lane = tid & 63, r32 = lane & 31, hi = lane >> 5;
    LAS float* ws = (LAS float*)(lds + IL_WS) + wid * 64; LAS float* al_l = ws;
    const int NTL = seq / KVBLK;
    unsigned koff, voff;
    { const int s = wid * 64 + lane, row = s >> 3, ch = (s & 7) ^ ((row >> 1) & 7); koff = (unsigned)(row * 128 + ch * 16); }
    { const int s = (wid & 3) * 64 + lane, d = s >> 2, ch = (s & 3) ^ ((d >> 2) & 3); voff = (unsigned)(d * SB + ch * 16); }
    const char* Kg = (const char*)Kh; const char* Vg = (const char*)Vh;
#define IL_DMA_K(t) do { int tt_ = (t); tt_ = tt_ < NTL ? tt_ : NTL - 1; const int sl_ = tt_ % NSLOT_IL;        \
        __builtin_amdgcn_global_load_lds((const unsigned*)(Kg + (size_t)tt_ * (64 * 128) + koff), (LAS unsigned*)(lds + IL_K + sl_ * KB_BYTES + wid * 1024), 16, 0, 0); } while (0)
#define IL_DMA_V(t) do { int tt_ = (t); tt_ = tt_ < NTL ? tt_ : NTL - 1; const int sl_ = tt_ % NSLOT_IL; \
        __builtin_amdgcn_global_load_lds((const unsigned*)(Vg + (size_t)tt_ * 64 + voff), (LAS unsigned*)(lds + IL_V + sl_ * VB_BYTES + (wid & 3) * 1024), 16, 0, 0); } while (0)
#pragma unroll
    for (int i = 0; i <= NSLOT_IL - 1; ++i) IL_DMA_K(i);
#pragma unroll
    for (int i = 0; i <= NSLOT_IL - 2; ++i) IL_DMA_V(i);
    i32x8 q8[2];
    { const unsigned char* Qw = Qb + (size_t)(wid * 32 + r32) * 128 + hi * 32;
#pragma unroll
      for (int dh = 0; dh < 2; ++dh) { const u32x4 a_ = *(const u32x4*)(Qw + dh * 64), b_ = *(const u32x4*)(Qw + dh * 64 + 16);
          q8[dh] = (i32x8){(int)a_.x, (int)a_.y, (int)a_.z, (int)a_.w, (int)b_.x, (int)b_.y, (int)b_.z, (int)b_.w}; } }
    float m_reg = 0.f; f32x16 o[2] = {}; f32x16 lacc = {}; f32x16 negm = {}; asm volatile("" : "+v"(negm));
    f32x16 a0, a1, b0, b1; i32x8 pa8 = {}; i32x8 k8[4] = {}; i32x8 v8[2] = {};
    SBAR(); asm volatile("s_waitcnt vmcnt(0) lgkmcnt(0)\n\ts_barrier" ::: "memory"); SBAR();
#define IL_END() do { SBAR(); asm volatile("" ::: "memory"); __builtin_amdgcn_s_waitcnt((IL_VMW & 15) | 0x70 | ((IL_VMW >> 4) << 14)); __builtin_amdgcn_s_barrier(); asm volatile("" ::: "memory"); SBAR(); } while (0)
#define IL_LDK(j) do { const LAS char* Kt = lds + IL_K + ((j) % NSLOT_IL) * KB_BYTES; k8[0] = PP_KLD(0, 0); k8[1] = PP_KLD(1, 0); k8[2] = PP_KLD(0, 1); k8[3] = PP_KLD(1, 1); } while (0)
#define IL_LDV(t) do { const LAS char* Vt = lds + IL_V + ((t) % NSLOT_IL) * VB_BYTES; v8[0] = PP_VLD(0); v8[1] = PP_VLD(1); } while (0)
#define IL_QK(Y0, Y1, n) do { \
        if ((n) == 0) Y0 = __builtin_amdgcn_mfma_scale_f32_32x32x64_f8f6f4(k8[0], q8[0], negm, 0, 0, 0, SC_K, 0, SC_Q); \
        if ((n) == 1) Y1 = __builtin_amdgcn_mfma_scale_f32_32x32x64_f8f6f4(k8[1], q8[0], negm, 0, 0, 0, SC_K, 0, SC_Q); \
        if ((n) == 2) Y0 = __builtin_amdgcn_mfma_scale_f32_32x32x64_f8f6f4(k8[2], q8[1], Y0, 0, 0, 0, SC_K, 0, SC_Q); \
        if ((n) == 3) Y1 = __builtin_amdgcn_mfma_scale_f32_32x32x64_f8f6f4(k8[3], q8[1], Y1, 0, 0, 0, SC_K, 0, SC_Q); SBAR(); } while (0)
#define IL_CVT(X, b, W) do { int w_ = __builtin_amdgcn_cvt_pk_fp8_f32(X[b], X[(b) + 1], 0, false); w_ = __builtin_amdgcn_cvt_pk_fp8_f32(X[(b) + 2], X[(b) + 3], w_, true); W = w_; } while (0)
#define IL_FIN(X0, X1, g) do { PP_EXP(X1[4 * (g)]); PP_EXP(X1[4 * (g) + 1]); PP_EXP(X1[4 * (g) + 2]); PP_EXP(X1[4 * (g) + 3]); \
        if ((g) == 0) { IL_CVT(X0, 0, pa8[0]); IL_CVT(X0, 4, pa8[1]); } if ((g) == 1) { IL_CVT(X0, 8, pa8[2]); IL_CVT(X0, 12, pa8[3]); } \
        if ((g) == 2) { IL_CVT(X1, 0, pa8[4]); IL_CVT(X1, 4, pa8[5]); } if ((g) == 3) { IL_CVT(X1, 8, pa8[6]); IL_CVT(X1, 12, pa8[7]); } SBAR(); } while (0)
#define IL_MAX(Y0, Y1, RM) do { float a_ = max3f(Y0[0], Y0[1], Y1[0]), b_ = max3f(Y0[2], Y0[3], Y1[1]); a_ = max3f(a_, Y1[2], Y1[3]); \
        _Pragma("unroll") for (int r = 4; r < 16; r += 4) { a_ = max3f(a_, Y0[r], Y0[r + 1]); b_ = max3f(b_, Y0[r + 2], Y0[r + 3]); a_ = max3f(a_, Y1[r], Y1[r + 1]); b_ = max3f(b_, Y1[r + 2], Y1[r + 3]); } \
        RM = fmaxf(a_, b_); { auto rr = __builtin_amdgcn_permlane32_swap(__float_as_uint(RM), __float_as_uint(RM), false, false); RM = fmaxf(__uint_as_float(rr[0]), __uint_as_float(rr[1])); } } while (0)
#define IL_RESC(Y0, Y1, RM) do { if (__builtin_expect(__any(RM > 2.f * THR), 0)) { const float dl = fmaxf(RM - THR, 0.f); m_reg += dl; \
            _Pragma("unroll") for (int r = 0; r < 16; ++r) { Y0[r] -= dl; Y1[r] -= dl; } \
            _Pragma("unroll") for (int r = 0; r < 16; ++r) negm[r] = -m_reg; asm volatile("" : "+v"(negm)); \
            const float al = __builtin_amdgcn_exp2f(-dl); if (hi == 0) al_l[r32] = al; asm volatile("s_waitcnt lgkmcnt(0)" ::: "memory"); \
            _Pragma("unroll") for (int r = 0; r < 16; ++r) { const float f_ = al_l[crow(r, hi)]; o[0][r] *= f_; o[1][r] *= f_; lacc[r] *= f_; } } } while (0)
#define IL_EXPH(Y0) do { _Pragma("unroll") for (int r = 0; r < 16; ++r) PP_EXP(Y0[r]); SBAR(); } while (0)
#define IL_STEP(X0, X1, Y0, Y1, t, HASQK, HASLDK) do { const int t_ = (t); \
        IL_LDV(t_); SBAR(); \
        if (HASQK) { IL_QK(Y0, Y1, 0); IL_FIN(X0, X1, 0); IL_QK(Y0, Y1, 1); IL_FIN(X0, X1, 1); IL_QK(Y0, Y1, 2); IL_FIN(X0, X1, 2); IL_QK(Y0, Y1, 3); IL_FIN(X0, X1, 3); } \
        else { IL_FIN(X0, X1, 0); IL_FIN(X0, X1, 1); IL_FIN(X0, X1, 2); IL_FIN(X0, X1, 3); } \
        o[0] = __builtin_amdgcn_mfma_scale_f32_32x32x64_f8f6f4(pa8, v8[0], o[0], 0, 0, 0, SC_P, 0, SC_V); \
        o[1] = __builtin_amdgcn_mfma_scale_f32_32x32x64_f8f6f4(pa8, v8[1], o[1], 0, 0, 0, SC_P, 0, SC_V); asm volatile("" : "+v"(o[0]), "+v"(o[1]) :: "memory"); SBAR(); \
        if (HASLDK) { IL_DMA_V(t_ + NSLOT_IL - 1); IL_DMA_K(t_ + NSLOT_IL); IL_LDK(t_ + 2); } SBAR(); \
        float rm_ = 0.f; if (HASQK) IL_MAX(Y0, Y1, rm_); SBAR(); \
        { int c1_ = 0x38383838; asm volatile("" : "+s"(c1_)); const i32x8 on_ = {c1_, c1_, c1_, c1_, c1_, c1_, c1_, c1_}; \
          lacc = __builtin_amdgcn_mfma_scale_f32_32x32x64_f8f6f4(pa8, on_, lacc, 0, 0, 0, SC_P, 0, SC_P); } SBAR(); \
        if (HASQK) { IL_RESC(Y0, Y1, rm_); SBAR(); IL_EXPH(Y0); } \
        asm volatile("" : "+v"(o[0]), "+v"(o[1]), "+v"(lacc)); \
        IL_END(); } while (0)
    IL_LDK(0); SBAR();
    IL_QK(a0, a1, 0); IL_QK(a0, a1, 1); IL_QK(a0, a1, 2); IL_QK(a0, a1, 3);
    IL_LDK(1); SBAR();
    { float rm_; IL_MAX(a0, a1, rm_); const float dl = rm_ - 4.f; m_reg = dl;
#pragma unroll
      for (int r = 0; r < 16; ++r) { a0[r] -= dl; a1[r] -= dl; }
#pragma unroll
      for (int r = 0; r < 16; ++r) negm[r] = -m_reg;
      asm volatile("" : "+v"(negm)); }
    IL_EXPH(a0);
    IL_END();
#pragma nounroll
    for (int t = 0; t + 3 < NTL; t += 2) {
        IL_STEP(a0, a1, b0, b1, t, 1, 1);
        IL_STEP(b0, b1, a0, a1, t + 1, 1, 1);
    }
    IL_STEP(a0, a1, b0, b1, NTL - 2, 1, 0);
    IL_STEP(b0, b1, a0, a1, NTL - 1, 0, 0);
    float rli[16];
#pragma unroll
    for (int r = 0; r < 16; ++r) rli[r] = __builtin_amdgcn_rcpf(lacc[r]);
    bf16_t* Ow = Ob + (size_t)(wid * 32) * ldo;
#pragma unroll
    for (int r = 0; r < 16; ++r) { const int orow = crow(r, hi);
#pragma unroll
        for (int d0 = 0; d0 < 2; ++d0) Ow[(size_t)orow * ldo + d0 * 32 + r32] = f2bf(o[d0][r] * rli[r]); }
    SBAR(); asm volatile("s_waitcnt vmcnt(0) lgkmcnt(0)\n\ts_barrier" ::: "memory"); SBAR();
#undef IL_DMA_K
#undef IL_DMA_V
#undef IL_END
#undef IL_LDK
#undef IL_LDV
#undef IL_QK
#undef IL_CVT
#undef IL_FIN
#undef IL_MAX
#undef IL_RESC
#undef IL_EXPH
#undef IL_STEP
}
}

__device__ __forceinline__ void retu_unit(int unit, const bf16_t* PR, float* U, float lg2f, float lg2b, LAS char* lds, const int wv) {
    const int tid = otid(wv), wid = __builtin_amdgcn_readfirstlane(tid >> 6), lane = tid & 63, r32 = lane & 31, hi = lane >> 5;
    const int h = unit & 3, bc = unit >> 2, bl = bc / NCHUNK, c = bc - bl * NCHUNK;
    const size_t r0 = (size_t)bl * SB + (size_t)c * 128;
    LAS char* Vt = lds;
    LAS char* Kf = lds + 32768;
    LAS char* Kb = lds + 49152;
#pragma unroll
    for (int i = 0; i < 2; ++i) { const int ch = tid + i * 512, j = ch >> 3, c8 = (ch & 7) * 8;
        const u32x4 kw = *(const u32x4*)(PR + (r0 + j) * 1536 + 256 + h * 64 + c8);
        float f[8], g[8]; unpack8(kw, f);
        const float wf = __builtin_amdgcn_exp2f(lg2f * (float)(127 - j)), wb = __builtin_amdgcn_exp2f(lg2b * (float)j);
#pragma unroll
        for (int k = 0; k < 8; ++k) { g[k] = f[k] * wb; f[k] *= wf; }
        const int off = (j >> 6) * 8192 + v_st<2>(j & 63, c8);
        *(LAS u32x4*)(Kf + off) = pack8(f); *(LAS u32x4*)(Kb + off) = pack8(g); }
#pragma unroll
    for (int i = 0; i < 4; ++i) { const int ch = tid + i * 512, j = ch >> 4, c8 = (ch & 15) * 8;
        const u32x4 vw = *(const u32x4*)(PR + (r0 + j) * 1536 + 512 + h * 128 + c8);
        *(LAS u32x4*)(Vt + (j >> 6) * 16384 + v_st<4>(j & 63, c8)) = vw; }
    __syncthreads();
    const int eblk = wid & 3, dblk = wid >> 2;
    const int vbV = (int)(size_t)Vt + v_rd_base(lane) + eblk * 512, vbF = (int)(size_t)Kf + v_rd_base(lane) + dblk * 512, vbB = (int)(size_t)Kb + v_rd_base(lane) + dblk * 512;
    f32x16 aF = {}, aB = {};
#define RU_STEP(SUB, KS) do { const bf16x8 a = tr_frag<4, KS>(vbV + SUB * 16384), bf = tr_frag<2, KS>(vbF + SUB * 8192), bb = tr_frag<2, KS>(vbB + SUB * 8192); \
        asm volatile("s_waitcnt lgkmcnt(0)" ::: "memory"); SBAR(); \
        aF = __builtin_amdgcn_mfma_f32_32x32x16_bf16(a, bf, aF, 0, 0, 0); aB = __builtin_amdgcn_mfma_f32_32x32x16_bf16(a, bb, aB, 0, 0, 0); } while (0)
    RU_STEP(0, 0); RU_STEP(0, 1); RU_STEP(0, 2); RU_STEP(0, 3); RU_STEP(1, 0); RU_STEP(1, 1); RU_STEP(1, 2); RU_STEP(1, 3);
#undef RU_STEP
    float* Uf = U + (size_t)unit * 2 * 8192; float* Ub = Uf + 8192;
#pragma unroll
    for (int r = 0; r < 16; ++r) { const int e = 32 * eblk + crow(r, hi), d = 32 * dblk + r32; Uf[e * 64 + d] = aF[r]; Ub[e * 64 + d] = aB[r]; }
    __syncthreads();
}

__device__ __forceinline__ void retout_unit(int unit, const bf16_t* PR, const bf16_t* S, const float* gnw, bf16_t* ACT, float lg2f, float lg2b, LAS char* lds, const int wv) {
    const int tid = otid(wv), wid = __builtin_amdgcn_readfirstlane(tid >> 6), lane = tid & 63, r32 = lane & 31, hi = lane >> 5;
    const int h = unit & 3, bc = unit >> 2, bl = bc / NCHUNK, c = bc - bl * NCHUNK;
    const size_t r0 = (size_t)bl * SB + (size_t)c * 128;
    LAS char* Vt = lds; LAS float* part = (LAS float*)(lds + 32768);
    const int qblk = wid & 3, ehalf = wid >> 2, iq = 32 * qblk + r32;
    u32x4 vw[4];
#pragma unroll
    for (int i = 0; i < 4; ++i) { const int ch = tid + i * 512, j = ch >> 4, c8 = (ch & 15) * 8; vw[i] = *(const u32x4*)(PR + (r0 + j) * 1536 + 512 + h * 128 + c8); }
    bf16x8 qf[4], kf[4][4];
    { const bf16_t* qp = PR + (r0 + iq) * 1536 + h * 64 + hi * 8;
#pragma unroll
      for (int d0 = 0; d0 < 4; ++d0) qf[d0] = *(const bf16x8*)(qp + d0 * 16); }
#pragma unroll
    for (int jb = 0; jb < 4; ++jb) { const bf16_t* kp = PR + (r0 + 32 * jb + r32) * 1536 + 256 + h * 64 + hi * 8;
#pragma unroll
        for (int d0 = 0; d0 < 4; ++d0) kf[jb][d0] = *(const bf16x8*)(kp + d0 * 16); }
    const int orow = tid >> 2, oc = (tid & 3) * 32;
    u32x4 gw[4];
#pragma unroll
    for (int k = 0; k < 4; ++k) gw[k] = *(const u32x4*)(PR + (r0 + orow) * 1536 + 1024 + h * 128 + oc + 8 * k);
#pragma unroll
    for (int i = 0; i < 4; ++i) { const int ch = tid + i * 512, j = ch >> 4, c8 = (ch & 15) * 8; *(LAS u32x4*)(Vt + (j >> 6) * 16384 + v_st<4>(j & 63, c8)) = vw[i]; }
    f32x16 o[2] = {};
    __syncthreads();
    bf16x8 sf[2][4], sb[2][4];
    { const bf16_t* Sf = S + (size_t)unit * 2 * 8192; const bf16_t* Sb = Sf + 8192;
#pragma unroll
      for (int e0 = 0; e0 < 2; ++e0) { const int e = 64 * ehalf + 32 * e0 + r32;
#pragma unroll
        for (int d0 = 0; d0 < 4; ++d0) { sf[e0][d0] = *(const bf16x8*)(Sf + e * 64 + d0 * 16 + hi * 8); sb[e0][d0] = *(const bf16x8*)(Sb + e * 64 + d0 * 16 + hi * 8); } } }
    const int vb = (int)(size_t)Vt + v_rd_base(lane) + ehalf * 1024;
#pragma unroll
    for (int jb = 0; jb < 4; ++jb) {
        f32x16 p = {};
#pragma unroll
        for (int d0 = 0; d0 < 4; ++d0) p = __builtin_amdgcn_mfma_f32_32x32x16_bf16(kf[jb][d0], qf[d0], p, 0, 0, 0);
#pragma unroll
        for (int r = 0; r < 16; ++r) { const int dj = iq - (32 * jb + crow(r, hi));
            const float e = dj >= 0 ? lg2f * (float)dj : lg2b * (float)(-dj); p[r] *= __builtin_amdgcn_exp2f(e); }
        bf16x8 pa0, pa1; PK4(p, 0, pa0); PK4(p, 8, pa1);
        const int vj = vb + (jb >> 1) * 16384;
        if (jb & 1) {
            const bf16x8 f00 = tr_frag<4, 2>(vj), f01 = tr_frag<4, 3>(vj), f10 = tr_frag<4, 2>(vj + 512), f11 = tr_frag<4, 3>(vj + 512);
            asm volatile("s_waitcnt lgkmcnt(0)" ::: "memory"); SBAR();
            o[0] = __builtin_amdgcn_mfma_f32_32x32x16_bf16(pa0, f00, o[0], 0, 0, 0); o[0] = __builtin_amdgcn_mfma_f32_32x32x16_bf16(pa1, f01, o[0], 0, 0, 0);
            o[1] = __builtin_amdgcn_mfma_f32_32x32x16_bf16(pa0, f10, o[1], 0, 0, 0); o[1] = __builtin_amdgcn_mfma_f32_32x32x16_bf16(pa1, f11, o[1], 0, 0, 0);
        } else {
            const bf16x8 f00 = tr_frag<4, 0>(vj), f01 = tr_frag<4, 1>(vj), f10 = tr_frag<4, 0>(vj + 512), f11 = tr_frag<4, 1>(vj + 512);
            asm volatile("s_waitcnt lgkmcnt(0)" ::: "memory"); SBAR();
            o[0] = __builtin_amdgcn_mfma_f32_32x32x16_bf16(pa0, f00, o[0], 0, 0, 0); o[0] = __builtin_amdgcn_mfma_f32_32x32x16_bf16(pa1, f01, o[0], 0, 0, 0);
            o[1] = __builtin_amdgcn_mfma_f32_32x32x16_bf16(pa0, f10, o[1], 0, 0, 0); o[1] = __builtin_amdgcn_mfma_f32_32x32x16_bf16(pa1, f11, o[1], 0, 0, 0);
        }
    }
    {
        const float xf = __builtin_amdgcn_exp2f(lg2f * (float)(iq + 1)), xb = __builtin_amdgcn_exp2f(lg2b * (float)(128 - iq));
#pragma unroll
        for (int d0 = 0; d0 < 4; ++d0) {
            float f[8], g[8]; unpack8(__builtin_bit_cast(u32x4, qf[d0]), f);
#pragma unroll
            for (int k = 0; k < 8; ++k) { g[k] = f[k] * xb; f[k] *= xf; }
            const bf16x8 qa = __builtin_bit_cast(bf16x8, pack8(f)), qb = __builtin_bit_cast(bf16x8, pack8(g));
#pragma unroll
            for (int e0 = 0; e0 < 2; ++e0) { o[e0] = __builtin_amdgcn_mfma_f32_32x32x16_bf16(qa, sf[e0][d0], o[e0], 0, 0, 0); o[e0] = __builtin_amdgcn_mfma_f32_32x32x16_bf16(qb, sb[e0][d0], o[e0], 0, 0, 0); }
        }
    }
    float sq[16];
#pragma unroll
    for (int r = 0; r < 16; ++r) { float s = o[0][r] * o[0][r] + o[1][r] * o[1][r];
        sq[r] = sum32(s); }
    if (r32 == 0) {
#pragma unroll
        for (int r = 0; r < 16; ++r) part[wid * 32 + crow(r, hi)] = sq[r];
    }
    __syncthreads();
    const float g0 = gnw[h * 128 + 64 * ehalf + r32], g1 = gnw[h * 128 + 64 * ehalf + 32 + r32];
    LAS bf16_t* stg = (LAS bf16_t*)Vt;
#pragma unroll
    for (int r = 0; r < 16; ++r) { const int il = crow(r, hi);
        const float tot = part[wid * 32 + il] + part[(wid ^ 4) * 32 + il];
        const float rn = rsqrtf(tot * (1.f / 128.f) + RMS_EPS);
        LAS bf16_t* sp = stg + (32 * qblk + il) * 128 + 64 * ehalf + r32;
        sp[0] = f2bf(o[0][r] * rn * g0); sp[32] = f2bf(o[1][r] * rn * g1); }
    __syncthreads();
#pragma unroll
    for (int k = 0; k < 4; ++k) { float y[8], g[8]; unpack8(*(const LAS u32x4*)(stg + orow * 128 + oc + 8 * k), y); unpack8(gw[k], g);
#pragma unroll
        for (int q = 0; q < 8; ++q) y[q] *= silu_fast(g[q]);
        *(u32x4*)(ACT + (r0 + orow) * 1536 + h * 128 + oc + 8 * k) = pack8(y); }
    __syncthreads();
}
struct Args { const float* in[26]; float* out; unsigned char* ws; int ph_lo, ph_hi; };
struct Frame {
    LAS unsigned char* lds; int G, wv;
    const Args* a; float* out; unsigned char* ws;
};
__device__ __forceinline__ const float* in_ptr(const Args* a, int i) { int z; asm volatile("s_mov_b32 %0, 0" : "=s"(z)); return a->in[i + z]; }
#define INP(i) in_ptr(F.a, (i))
__device__ __forceinline__ unsigned char* ows(unsigned char* p) { asm volatile("" : "+s"(p)); return p; }
#ifdef SELFCHECK_ATTN
#define WSP(T, off) ((T*)(ows(F.ws) + (off)))
#else
#define WSP(T, off) ((T*)(F.ws + (off)))
#endif

__device__ __forceinline__ int srccol_in(int n) {
    if (n < 512) { const int base = n & ~255, hh = (n & 255) >> 6, p = n & 63; return base + hh * 64 + (p >> 1) + 32 * (p & 1); }
    if (n < 2048) return n;
    if (n < 3072) { const int j = (n - 2048) >> 1; return 2048 + j + 512 * (n & 1); }
    if (n < 3712) return n;
    if (n < 3744) { const int p = n - 3712, a = p >> 4, q = p & 15; return 3712 + a * 16 + (q >> 1) + 8 * (q & 1); }
    if (n < 3840) return -1;
    return n - 96;
}
__device__ __forceinline__ int srccol_uq(int n) { const int h = n / 96, d = n - h * 96; if (d < 64) return n; const int p = d - 64, a = p >> 4, q = p & 15; return h * 96 + 64 + a * 16 + (q >> 1) + 8 * (q & 1); }

__device__ __forceinline__ void cvt_item(const float* sp, int ldw, const float* scale, bf16_t* dst, int ldd, int n0, int k0, LAS float* scr, int lane) {
    float vv[32];
#pragma unroll
    for (int i = 0; i < 32; ++i) { const int kk = 2 * i + (lane >> 5); vv[i] = sp ? sp[(size_t)(k0 + kk) * ldw] : 0.f; }
    if (scale) {
#pragma unroll
        for (int i = 0; i < 32; ++i) vv[i] *= scale[k0 + 2 * i + (lane >> 5)];
    }
#pragma unroll
    for (int i = 0; i < 32; ++i) scr[(2 * i + (lane >> 5)) * 33 + (lane & 31)] = vv[i];
    asm volatile("s_waitcnt lgkmcnt(0)" ::: "memory");
    const int c = lane & 7;
#pragma unroll
    for (int j = 0; j < 4; ++j) { const int n = (lane >> 3) + 8 * j; const LAS float* s = scr + (8 * c) * 33 + n;
        u32x4 o; o.x = cvtpk(s[0 * 33], s[1 * 33]); o.y = cvtpk(s[2 * 33], s[3 * 33]); o.z = cvtpk(s[4 * 33], s[5 * 33]); o.w = cvtpk(s[6 * 33], s[7 * 33]);
        *(u32x4*)(dst + (size_t)(n0 + n) * ldd + k0 + 8 * c) = o; }
    asm volatile("s_waitcnt lgkmcnt(0)" ::: "memory");
}

__device__ __forceinline__ void cvt_item_fp8(const float* sp, int ldw, float sc, unsigned char* dst, int ldd, int n0, int k0, LAS float* scr, int lane) {
    float vv[32];
#pragma unroll
    for (int i = 0; i < 32; ++i) { const int kk = 2 * i + (lane >> 5); vv[i] = sp ? sp[(size_t)(k0 + kk) * ldw] * sc : 0.f; }
#pragma unroll
    for (int i = 0; i < 32; ++i) scr[(2 * i + (lane >> 5)) * 33 + (lane & 31)] = vv[i];
    asm volatile("s_waitcnt lgkmcnt(0)" ::: "memory");
    const int c = lane & 7;
#pragma unroll
    for (int j = 0; j < 4; ++j) { const int n = (lane >> 3) + 8 * j; const LAS float* s = scr + (8 * c) * 33 + n;
        float f[8];
#pragma unroll
        for (int q = 0; q < 8; ++q) f[q] = s[q * 33];
        *(u32x2*)(dst + (size_t)(n0 + n) * ldd + k0 + 8 * c) = pack8_fp8(f); }
    asm volatile("s_waitcnt lgkmcnt(0)" ::: "memory");
}
__device__ __forceinline__ f32x2 cossin_f(float ang) {
    const double x = (double)ang * 0.15915494309189535; const float r = (float)(x - rint(x));
    return (f32x2){__builtin_amdgcn_cosf(r), __builtin_amdgcn_sinf(r)};
}
__device__ __forceinline__ float lg2_gamma(const float* rd) { return -__builtin_amdgcn_logf(1.f + __builtin_amdgcn_exp2f(-rd[0] * LOG2E)); }
#define PHASE_IDS const int tid = otid(F.wv), lane = tid & 63, wave = __builtin_amdgcn_readfirstlane(tid >> 6), bid = obid(); (void)lane; (void)wave; (void)bid;
__device__ __forceinline__ void p0_prologue(Frame& F) {
    PHASE_IDS
    __syncthreads();
    if (bid < 48) {
        LAS float* sc = (LAS float*)F.lds;
        LAS float* red = (LAS float*)(F.lds + 40960);
        for (int i = tid; i < 9 * 1024; i += 512) { const int v = i >> 10, k = i & 1023; const float x = v < 8 ? INP(1)[v * 1024 + k] : INP(3)[k]; sc[i] = siluf_(x); }
        __syncthreads();
        const int l = bid / 24, col = (bid % 24) * 256 + (tid & 255), kq = tid >> 8;
        const float* w = INP(4) + (size_t)l * 1024 * 6144 + col;
        float a[9];
#pragma unroll
        for (int v = 0; v < 9; ++v) a[v] = 0.f;
#pragma nounroll
        for (int k = kq * 512; k < kq * 512 + 512; k += 16) {
            float wv_[16];
#pragma unroll
            for (int j = 0; j < 16; ++j) wv_[j] = w[(size_t)(k + j) * 6144];
#pragma unroll
            for (int j4 = 0; j4 < 4; ++j4)
#pragma unroll
                for (int v = 0; v < 9; ++v) { const f32x4 s = *(const LAS f32x4*)(sc + v * 1024 + k + 4 * j4); a[v] += (s[0] * wv_[4 * j4] + s[1] * wv_[4 * j4 + 1]) + (s[2] * wv_[4 * j4 + 2] + s[3] * wv_[4 * j4 + 3]); }
        }
        if (kq == 1) {
#pragma unroll
            for (int v = 0; v < 9; ++v) red[v * 256 + (tid & 255)] = a[v];
        }
        __syncthreads();
        if (kq == 0) { float* MOD = WSP(float, WS_MOD) + (size_t)l * 9 * 6144; const float b = INP(5)[l * 6144 + col];
#pragma unroll
            for (int v = 0; v < 9; ++v) MOD[v * 6144 + col] = b + a[v] + red[v * 256 + tid]; }
        __syncthreads();
    }
    { f32x2* RT = WSP(f32x2, WS_RT); f32x2* MT = WSP(f32x2, WS_MT);
      for (int i = bid * 512 + tid; i < 8192 * 32 + 128 * 8; i += F.G * 512) {
          if (i < 8192 * 32) { const int t = i >> 5, k = i & 31; const float inv = exp2f(-(float)k * (13.287712379549449f / 32.f)); RT[i] = cossin_f((float)t * inv); }
          else { const int q = i - 8192 * 32, pos = q >> 3, k = q & 7; const float inv = exp2f(-(float)k * (13.287712379549449f / 8.f)); MT[q] = cossin_f((float)pos * inv); } } }
    LAS float* scr = (LAS float*)(F.lds + wave * 16384);
    const int gw = bid * 8 + wave, NGW = F.G * 8;
    constexpr int I_G8 = 2 * 16 * 96; constexpr int I_IN = 2 * 16 * 216, I_CAT = 2 * 3 * 8 * 32, I_OUT = 2 * 16 * 32, I_UQ = 2 * 6 * 24, I_UKV = 2 * 4 * 32, I_UP = 32 * 16 * 32, I_W2 = 32 * 8 * 32;
#ifdef INPROJ_L1_FP8
    constexpr int I_W8 = 16 * 120;
#else
    constexpr int I_W8 = 0;
#endif
    constexpr int NITEMS = I_IN + I_CAT + I_OUT + I_UQ + I_UKV + I_UP + I_W2 + I_G8 + I_W8;
    for (int it = gw; it < NITEMS; it += NGW) {
        int r = it;
        if (r < I_IN) { const int l = r / 3456, q = r % 3456, kb = q / 216, nb = q % 216; const int sc_ = srccol_in(nb * 32 + (lane & 31));
            cvt_item(sc_ >= 0 ? INP(8) + (size_t)l * 1024 * INCOLS + sc_ : nullptr, INCOLS, nullptr, WSP(bf16_t, WS_WIN) + (size_t)l * INW * 1024, 1024, nb * 32, kb * 64, scr, lane); continue; } r -= I_IN;
        if (r < I_CAT) { const int l = r / 768, q = r % 768, seg = q / 256, q2 = q % 256, kb = q2 / 32, nb = q2 % 32; const float* W = seg == 0 ? INP(11) : (seg == 1 ? INP(13) : INP(18));
            cvt_item(W + (size_t)l * 512 * 1024 + nb * 32 + (lane & 31), 1024, nullptr, WSP(bf16_t, WS_WCAT) + (size_t)l * 1024 * 1536 + seg * 512, 1536, nb * 32, kb * 64, scr, lane); continue; } r -= I_CAT;
        if (r < I_OUT) { const int l = r / 512, q = r % 512, kb = q / 32, nb = q % 32;
            cvt_item(INP(19) + (size_t)l * 1024 * 1024 + nb * 32 + (lane & 31), 1024, nullptr, WSP(bf16_t, WS_WOUT) + (size_t)l * 1024 * 1024, 1024, nb * 32, kb * 64, scr, lane); continue; } r -= I_OUT;
        if (r < I_UQ) { const int l = r / 144, q = r % 144, kb = q / 24, nb = q % 24;
            cvt_item(INP(15) + (size_t)l * 384 * 768 + srccol_uq(nb * 32 + (lane & 31)), 768, INP(14) + l * 384, WSP(bf16_t, WS_WUQ) + (size_t)l * 768 * 384, 384, nb * 32, kb * 64, scr, lane); continue; } r -= I_UQ;
        if (r < I_UKV) { const int l = r / 128, q = r % 128, kb = q / 32, nb = q % 32;
            cvt_item(INP(17) + (size_t)l * 256 * 1024 + nb * 32 + (lane & 31), 1024, INP(16) + l * 256, WSP(bf16_t, WS_WUKV) + (size_t)l * 1024 * 256, 256, nb * 32, kb * 64, scr, lane); continue; } r -= I_UKV;
        if (r < I_UP) { const int le = r / 512, q = r % 512, kb = q / 32, nb = q % 32; const int n = nb * 32 + (lane & 31);
            const float* W = (n & 1) ? INP(23) : INP(22);
            if (le >= 16) cvt_item_fp8(W + (size_t)le * 1024 * 512 + (n >> 1), 512, WU8S, WSP(unsigned char, WS_WUP) + (size_t)16 * 1024 * 1024 * 2 + (size_t)(le - 16) * 1024 * 1024, 1024, nb * 32, kb * 64, scr, lane);
            else cvt_item(W + (size_t)le * 1024 * 512 + (n >> 1), 512, nullptr, WSP(bf16_t, WS_WUP) + (size_t)le * 1024 * 1024, 1024, nb * 32, kb * 64, scr, lane);
            continue; } r -= I_UP;
        if (r < I_W2) { const int le = r / 256, q = r % 256, kb = q / 32, nb = q % 32;
            if (le >= 16) cvt_item_fp8(INP(24) + (size_t)le * 512 * 1024 + nb * 32 + (lane & 31), 1024, WD8S, WSP(unsigned char, WS_W2T) + (size_t)16 * 1024 * 512 * 2 + (size_t)(le - 16) * 1024 * 512, 512, nb * 32, kb * 64, scr, lane);
            else cvt_item(INP(24) + (size_t)le * 512 * 1024 + nb * 32 + (lane & 31), 1024, nullptr, WSP(bf16_t, WS_W2T) + (size_t)le * 1024 * 512, 512, nb * 32, kb * 64, scr, lane);
            continue; } r -= I_W2;
        if (r >= I_G8) { r -= I_G8; const int kb = r / 120, nb = r % 120; const int sc_ = srccol_in(nb * 32 + (lane & 31));
            cvt_item_fp8(sc_ >= 0 ? INP(8) + (size_t)(DEPTH - 1) * 1024 * INCOLS + sc_ : nullptr, INCOLS, WG8S, WSP(unsigned char, WS_W8L1), 1024, nb * 32, kb * 64, scr, lane); continue; }
        { const int l = r / 1536, q = r % 1536, kb = q / 96, nb = q % 96;
            cvt_item_fp8(INP(8) + (size_t)l * 1024 * INCOLS + 3744 + nb * 32 + (lane & 31), INCOLS, WG8S * 1.4426950408889634f, WSP(unsigned char, WS_WIN8) + (size_t)l * 3072 * 1024, 1024, nb * 32, kb * 64, scr, lane); }
    }
}

__device__ __forceinline__ void norm1_phase(Frame& F, const Resid& R, int l, int skip_none) {
    PHASE_IDS
    const int gw = bid * 8 + wave, NGW = F.G * 8; bf16_t* HX = WSP(bf16_t, WS_HX);
    const float* MODL = WSP(float, WS_MOD) + (size_t)l * 9 * 6144; const float* nw = INP(6) + l * 1024;
    for (int row = gw; row < NT; row += NGW) {
        const float* md = MODL + R.modv(row) * 6144;
        f32x4 v[4]; float s = 0.f;
        int sf32 = R.src_f32; asm volatile("" : "+s"(sf32));
        if (sf32) { const f32x4* xr = (const f32x4*)R.srcf(row) + lane;
#pragma unroll
            for (int j = 0; j < 4; ++j) v[j] = xr[64 * j]; }
        else { const u32x2* xr = (const u32x2*)R.dst(row) + lane;
#pragma unroll
            for (int j = 0; j < 4; ++j) { const u32x2 w = xr[64 * j]; v[j] = (f32x4){bf_lo(w.x), bf_hi(w.x), bf_lo(w.y), bf_hi(w.y)}; } }
#pragma unroll
        for (int j = 0; j < 4; ++j) s += (v[j][0] * v[j][0] + v[j][1] * v[j][1]) + (v[j][2] * v[j][2] + v[j][3] * v[j][3]);
        const float rs = rsqrtf(wave_sum(s) * (1.f / DM) + RMS_EPS);
#pragma unroll
        for (int j = 0; j < 4; ++j) { const int c = 4 * lane + 256 * j; const f32x4 w = *(const f32x4*)(nw + c), sh = *(const f32x4*)(md + c), sc = *(const f32x4*)(md + 1024 + c);
            const f32x4 y = v[j] * rs * w * (sc + 1.f) + sh; u32x2 o; o.x = cvtpk(y[0], y[1]); o.y = cvtpk(y[2], y[3]); *(u32x2*)(HX + (size_t)row * 1024 + c) = o;
            int q8_ = __builtin_amdgcn_cvt_pk_fp8_f32(y[0] * HX8S, y[1] * HX8S, 0, false); q8_ = __builtin_amdgcn_cvt_pk_fp8_f32(y[2] * HX8S, y[3] * HX8S, q8_, true);
            *(int*)(WSP(unsigned char, WS_HX8) + (size_t)row * 1024 + c) = q8_; }
    }
}
__device__ __forceinline__ void final_norm_phase(Frame& F, int g) {
    PHASE_IDS
    const int gw = bid * 8 + wave, NGW = F.G * 8; const float* nw = INP(25);
    for (int row = gw; row < GB * SEQ; row += NGW) {
        f32x4* xr = (f32x4*)(F.out + ((size_t)g * GB * SEQ + row) * DM) + lane;
        const u32x2* xb = (const u32x2*)(WSP(bf16_t, WS_XRES) + ((size_t)g * GB * SEQ + row) * DM) + lane;
        f32x4 v[4]; float s = 0.f;
#pragma unroll
        for (int j = 0; j < 4; ++j) { const u32x2 w = xb[64 * j]; v[j] = (f32x4){bf_lo(w.x), bf_hi(w.x), bf_lo(w.y), bf_hi(w.y)}; s += (v[j][0] * v[j][0] + v[j][1] * v[j][1]) + (v[j][2] * v[j][2] + v[j][3] * v[j][3]); }
        const float rs = rsqrtf(wave_sum(s) * (1.f / DM) + RMS_EPS);
#pragma unroll
        for (int j = 0; j < 4; ++j) { const f32x4 w = *(const f32x4*)(nw + 4 * lane + 256 * j); xr[64 * j] = v[j] * rs * w; }
    }
}
__device__ __forceinline__ void conv_phase(Frame& F, int l) {
    PHASE_IDS
    const bf16_t* PC = WSP(bf16_t, WS_PC); bf16_t* ACT = WSP(bf16_t, WS_ACT); const float* cw = INP(12) + (size_t)l * 512 * 3;
    for (int idx = bid * 512 + tid; idx < NT * 64; idx += F.G * 512) {
        const int row = idx >> 6, c8 = (idx & 63) * 8; const int bl = row / SB, s = row - bl * SB;
        const bool hp = (s != 0) && (s != CTXL), hn = (s != CTXL - 1) && (s != SB - 1);
        const bf16_t* p = PC + (size_t)row * 1024 + c8;
        float b[8], u0[8], um[8], up[8];
        unpack8(*(const u32x4*)p, b); unpack8(*(const u32x4*)(p + 512), u0);
        if (hp) unpack8(*(const u32x4*)(p + 512 - 1024), um); else {
#pragma unroll
            for (int k = 0; k < 8; ++k) um[k] = 0.f; }
        if (hn) unpack8(*(const u32x4*)(p + 512 + 1024), up); else {
#pragma unroll
            for (int k = 0; k < 8; ++k) up[k] = 0.f; }
        float o[8];
#pragma unroll
        for (int k = 0; k < 8; ++k) { const float* w = cw + (c8 + k) * 3; o[k] = b[k] * (um[k] * w[0] + u0[k] * w[1] + up[k] * w[2]); }
        *(u32x4*)(ACT + (size_t)row * 1536 + 512 + c8) = pack8(o);
    }
}
__device__ __forceinline__ void scan_phase(Frame& F, int l) {
    PHASE_IDS
    const float* U = WSP(float, WS_HX); bf16_t* S = WSP(bf16_t, WS_PM);
    for (int idx = bid * 512 + tid; idx < GB * 4 * 2 * 8192; idx += F.G * 512) {
        const int ed = idx & 8191, dir = (idx >> 13) & 1, h = (idx >> 14) & 3, bl = idx >> 16;
        const float lg = lg2_gamma(INP(9) + l * 8 + dir * 4 + h); const float dec = __builtin_amdgcn_exp2f(lg * 128.f);
        float st = 0.f;
        for (int i0 = 0; i0 < NCHUNK; i0 += 6) {
            float uu[6]; size_t off[6];
#pragma unroll
            for (int k = 0; k < 6; ++k) { const int i = i0 + k; const int c = dir ? (i < 2 ? 1 - i : NCHUNK + 1 - i) : i;
                off[k] = ((size_t)(((bl * NCHUNK + c) * 4 + h) * 2 + dir)) * 8192 + ed; uu[k] = U[off[k]]; }
#pragma unroll
            for (int k = 0; k < 6; ++k) { S[off[k]] = f2bf(st); st = dec * st + uu[k]; }
        }
    }
}
template <int NR>
__device__ __forceinline__ void n2_rows(const Resid& R, const int (&rows)[NR], const int (&slot)[NR], const float* MODL, const float* nw, bf16_t* H2, unsigned char* H28, const LAS float* wr, LAS float* lg, int lane) {
    f32x4 v[NR][4]; float s[NR];
#pragma unroll
    for (int q = 0; q < NR; ++q) { const u32x2* xr = (const u32x2*)R.dst(rows[q]) + lane; s[q] = 0.f;
#pragma unroll
        for (int j = 0; j < 4; ++j) { const u32x2 w_ = xr[64 * j]; v[q][j] = (f32x4){bf_lo(w_.x), bf_hi(w_.x), bf_lo(w_.y), bf_hi(w_.y)}; s[q] += (v[q][j][0] * v[q][j][0] + v[q][j][1] * v[q][j][1]) + (v[q][j][2] * v[q][j][2] + v[q][j][3] * v[q][j][3]); } }
#pragma unroll
    for (int q = 0; q < NR; ++q) s[q] = rsqrtf(wave_sum(s[q]) * (1.f / DM) + RMS_EPS);
#pragma unroll
    for (int q = 0; q < NR; ++q) { const float* md = MODL + R.modv(rows[q]) * 6144;
#pragma unroll
        for (int j = 0; j < 4; ++j) { const int c = 4 * lane + 256 * j; const f32x4 w = *(const f32x4*)(nw + c), sh = *(const f32x4*)(md + 3072 + c), sc = *(const f32x4*)(md + 4096 + c);
            v[q][j] = v[q][j] * s[q] * w * (sc + 1.f) + sh;
            if (H28) { int q8_ = __builtin_amdgcn_cvt_pk_fp8_f32(v[q][j][0] * H28S, v[q][j][1] * H28S, 0, false); q8_ = __builtin_amdgcn_cvt_pk_fp8_f32(v[q][j][2] * H28S, v[q][j][3] * H28S, q8_, true); *(int*)(H28 + (size_t)rows[q] * 1024 + c) = q8_; }
            else { u32x2 o; o.x = cvtpk(v[q][j][0], v[q][j][1]); o.y = cvtpk(v[q][j][2], v[q][j][3]); *(u32x2*)(H2 + (size_t)rows[q] * 1024 + c) = o; } } }
    const int b4 = (lane >> 4) & 1, b3 = (lane >> 3) & 1, b2 = (lane >> 2) & 1;
#pragma unroll
    for (int q = 0; q < NR; ++q) {
        float a[16];
#pragma unroll
        for (int e = 0; e < 16; ++e) { float t = 0.f;
#pragma unroll
            for (int j = 0; j < 4; ++j) { const f32x4 w = *(const LAS f32x4*)(wr + e * 1024 + 4 * lane + 256 * j); t += (v[q][j][0] * w[0] + v[q][j][1] * w[1]) + (v[q][j][2] * w[2] + v[q][j][3] * w[3]); }
            a[e] = t; }
        float s8[8], s4[4], s2[2];
#pragma unroll
        for (int k = 0; k < 8; ++k) { auto r = __builtin_amdgcn_permlane32_swap(__float_as_uint(a[k]), __float_as_uint(a[k + 8]), false, false); s8[k] = __uint_as_float(r[0]) + __uint_as_float(r[1]); }
#pragma unroll
        for (int k = 0; k < 4; ++k) { const float snd = b4 ? s8[k] : s8[k + 4], kp = b4 ? s8[k + 4] : s8[k]; s4[k] = kp + swz_xor<16>(snd); }
#pragma unroll
        for (int k = 0; k < 2; ++k) { const float snd = b3 ? s4[k] : s4[k + 2], kp = b3 ? s4[k + 2] : s4[k]; s2[k] = kp + swz_xor<8>(snd); }
        float s1; { const float snd = b2 ? s2[0] : s2[1], kp = b2 ? s2[1] : s2[0]; s1 = kp + swz_xor<4>(snd); }
        s1 += swz_xor<2>(s1); s1 += swz_xor<1>(s1);
        if ((lane & 3) == 0) lg[slot[q] * 16 + (lane >> 2)] = s1;
    }
}
__device__ __forceinline__ void norm2_router_phase(Frame& F, const Resid& R, int l, int g, int lat_only, int cslot) {
    PHASE_IDS
    bf16_t* H2 = WSP(bf16_t, WS_HX); unsigned char* H28 = (l == DEPTH - 1) ? WSP(unsigned char, WS_H28) : nullptr;
    const float* MODL = WSP(float, WS_MOD) + (size_t)l * 9 * 6144; const float* nw = INP(7) + l * 1024;
    LAS float* wr = (LAS float*)F.lds; LAS float* lg = (LAS float*)(F.lds + 65536);
    { const float* wrt = INP(20); for (int i = tid; i < 16 * 1024; i += 512) wr[i] = wrt[(i & 1023) * 16 + (i >> 10)]; }
    __syncthreads();
    const int rpb = (NT + F.G - 1) / F.G, r0 = bid * rpb, r1 = (r0 + rpb < NT) ? r0 + rpb : NT;
    for (int row = r0 + wave; row < r1; row += 16) {
        const int rowb = row + 8;
        const bool okA = !(lat_only && (row % SB) < CTXL), okB = rowb < r1 && !(lat_only && (rowb % SB) < CTXL);
        if (okA && okB) { const int rr[2] = {row, rowb}, ss[2] = {row - r0, rowb - r0}; n2_rows<2>(R, rr, ss, MODL, nw, H2, H28, wr, lg, lane); }
        else if (okA) { const int rr[1] = {row}, ss[1] = {row - r0}; n2_rows<1>(R, rr, ss, MODL, nw, H2, H28, wr, lg, lane); }
        else if (okB) { const int rr[1] = {rowb}, ss[1] = {rowb - r0}; n2_rows<1>(R, rr, ss, MODL, nw, H2, H28, wr, lg, lane); }
    }
    __syncthreads();
    unsigned* CNT = WSP(unsigned, WS_CTL) + CW_CNT + (g * 2 + l) * 64 + cslot; int* LIST = WSP(int, WS_LIST); float* WGT = WSP(float, WS_WGT);
    const float* rb = INP(21);
    LAS unsigned* lcnt = (LAS unsigned*)(F.lds + 65536 + 16384);
    if (tid < 64) lcnt[tid] = 0u;
    __syncthreads();
    int bucket = -1, rank = 0; float wlo = 0.f, whi = 0.f; const int trow = r0 + tid;
    if (tid < r1 - r0 && !(lat_only && (trow % SB) < CTXL)) {
        const int t = tid;
        float sc16[16];
#pragma unroll
        for (int e4 = 0; e4 < 4; ++e4) { const f32x4 x = *(const LAS f32x4*)(lg + t * 16 + e4 * 4); sc16[e4 * 4] = sigmoidf_(x[0]); sc16[e4 * 4 + 1] = sigmoidf_(x[1]); sc16[e4 * 4 + 2] = sigmoidf_(x[2]); sc16[e4 * 4 + 3] = sigmoidf_(x[3]); }
        float best = -1e30f; int gs = 0;
#pragma unroll
        for (int q = 0; q < 4; ++q) { float m1 = -1e30f, m2 = -1e30f;
#pragma unroll
            for (int k = 0; k < 4; ++k) { const float b = sc16[q * 4 + k] + rb[q * 4 + k]; if (b > m1) { m2 = m1; m1 = b; } else if (b > m2) m2 = b; }
            const float gsc = m1 + m2; if (gsc > best) { best = gsc; gs = q; } }
        float bb[4], su[4];
#pragma unroll
        for (int k = 0; k < 4; ++k) { float b = 0.f, u = 0.f;
#pragma unroll
            for (int q = 0; q < 4; ++q) { if (q == gs) { b = sc16[q * 4 + k] + rb[q * 4 + k]; u = sc16[q * 4 + k]; } }
            bb[k] = b; su[k] = u; }
        int i1 = 0; float b1 = bb[0];
#pragma unroll
        for (int k = 1; k < 4; ++k) if (bb[k] > b1) { b1 = bb[k]; i1 = k; }
        int i2 = -1; float b2 = -1e30f;
#pragma unroll
        for (int k = 0; k < 4; ++k) if (k != i1 && bb[k] > b2) { b2 = bb[k]; i2 = k; }
        const int lo = i1 < i2 ? i1 : i2, hi = i1 < i2 ? i2 : i1;
        float slo = 0.f, shi = 0.f;
#pragma unroll
        for (int k = 0; k < 4; ++k) { if (k == lo) slo = su[k]; if (k == hi) shi = su[k]; }
        const float inv = 1.f / (slo + shi);
        const int pair = lo == 0 ? hi - 1 : (lo == 1 ? hi + 1 : 5);
        bucket = gs * 6 + pair; wlo = slo * inv; whi = shi * inv;
        rank = (int)atomicAdd((unsigned*)(lcnt + bucket), 1u);
    }
    __syncthreads();
    if (tid < NPAIR) { const unsigned c = lcnt[tid]; lcnt[32 + tid] = c ? atomicAdd(CNT + tid, c) : 0u; }
    __syncthreads();
    if (bucket >= 0) { const unsigned pos = lcnt[32 + bucket] + (unsigned)rank; LIST[(size_t)bucket * NT + pos] = trow; WGT[(size_t)trow * 2] = wlo; WGT[(size_t)trow * 2 + 1] = whi; }
    __syncthreads();
}
__device__ __forceinline__ void moe_tables(Frame& F, int l, int g) {
    PHASE_IDS
    LAS int* tab = (LAS int*)(F.lds + LDS_MOE_OFF);
    if (tid < 32) { const unsigned* CNT = WSP(unsigned, WS_CTL) + CW_CNT + (g * 2 + l) * 64;
        tab[32 + tid] = tid < NPAIR ? (int)__hip_atomic_load(CNT + tid, __ATOMIC_RELAXED, __HIP_MEMORY_SCOPE_AGENT) : 0; }
    __syncthreads();
    if (tid == 0) { int pre = 0;
#pragma nounroll
        for (int p = 0; p < NPAIR; ++p) { tab[p] = pre; pre += (tab[32 + p] + 255) >> 8; }
        tab[24] = pre; }
    __syncthreads();
}
#ifndef PHMASK
#define PHMASK 0xFFFF
#endif
#define PHM(k) (((PHMASK) >> (k)) & 1)
#ifndef INPROJ_ALIGN
#define INPROJ_ALIGN true
#endif
#ifndef REPMASK
#define REPMASK 0
#endif
#define REPS(k) _Pragma("nounroll") for (int rep_ = 0; rep_ < 1 + (((REPMASK) >> (k)) & 1); ++rep_)

__global__ void __launch_bounds__(512, 2) dit_fwd(Args args) {
    extern __shared__ __attribute__((aligned(16))) unsigned char lds_raw[];
    Frame F;
    F.lds = (LAS unsigned char*)lds_raw;
    F.G = gridDim.x; F.wv = __builtin_amdgcn_readfirstlane((int)threadIdx.x >> 6);
    F.a = &args; F.out = args.out; F.ws = args.ws;
    for (int u = threadIdx.x; u < (LDS_BYTES - LDSCTL_OFF) / 4; u += 512) ((LAS unsigned*)(F.lds + LDSCTL_OFF))[u] = 0u;
    __syncthreads();
    XcdBarrier bar = xcd_barrier_post(WSP(unsigned, WS_CTL) + CW_BAR, (volatile LAS unsigned*)(F.lds + LDSCTL_OFF));
#ifdef PROBE_BAR2
#define GRID_BAR() do { asm volatile("; PHASE_SEAM" ::: "memory"); xcd_barrier(bar, F.wv); xcd_barrier(bar, F.wv); } while (0)
#else
#define GRID_BAR() do { asm volatile("; PHASE_SEAM" ::: "memory"); xcd_barrier(bar, F.wv); } while (0)
#endif
#ifdef PROBE_A
#define STAMP(k) do { if (obid() == 0 && F.wv == 0 && olane() == 0) { unsigned long long* TS_ = WSP(unsigned long long, WS_CTL + 512 * 1024); const unsigned long long now = __builtin_amdgcn_s_memrealtime(); TS_[(k)] += now - TS_[32]; TS_[32] = now; } } while (0)
    if (blockIdx.x == 0 && threadIdx.x == 0) WSP(unsigned long long, WS_CTL + 512 * 1024)[32] = __builtin_amdgcn_s_memrealtime();
#else
#define STAMP(k) do { } while (0)
#endif

    if constexpr (PHM(0)) REPS(0) p0_prologue(F);
    GRID_BAR(); STAMP(0);

#pragma nounroll
    for (int g = 0; g < NG; ++g) {
#pragma nounroll
        for (int l = 0; l < DEPTH; ++l) {
            Resid R; R.in_lat = INP(0); R.in_ctx = INP(2); R.x_lat = WSP(bf16_t, WS_XRES); R.x_ctx = WSP(bf16_t, WS_XC); R.g = g; R.src_f32 = (l == 0) ? 1 : 0;
            const float* MODL = WSP(float, WS_MOD) + (size_t)l * 9 * 6144;
            const int lat_only = (l == DEPTH - 1) ? 1 : 0;

            if constexpr (PHM(1)) REPS(1) norm1_phase(F, R, l, 0);
            if constexpr (PHM(15)) if (l == 0 && g > 0) final_norm_phase(F, g - 1);
            GRID_BAR(); STAMP(1);

            if constexpr (PHM(2)) REPS(2) {
#ifdef STAGGER_US10
                {
                    const unsigned long long t0_ = __builtin_amdgcn_s_memrealtime(), d_ = (unsigned long long)((obid() * 5) & 15) * (STAGGER_US10) * 10ull;
                    while (__builtin_amdgcn_s_memrealtime() - t0_ < d_) __builtin_amdgcn_s_sleep(4);
                }
#endif
                TileOrder S; S.init(NRT, 15, F.G, obid(), WSP(bf16_t, WS_HX), (size_t)256 * 1024 * 2, WSP(bf16_t, WS_WIN) + (size_t)l * INW * 1024, (size_t)256 * 1024 * 2, 0);
                EpiInproj E{WSP(bf16_t, WS_PR), WSP(bf16_t, WS_PC), WSP(bf16_t, WS_PM), WSP(bf16_t, WS_PG), WSP(unsigned char, WS_K), WSP(float, WS_SSQ), WSP(f32x2, WS_RT), WSP(f32x2, WS_MT), 0};
#ifdef PROBE_INPROJ_NOEPI
                { EpiNone E0; if (PROBE_INPROJ_NOEPI == 1) pg8::gemm_phase<EpiNone, TileOrder, INPROJ_ALIGN>(F.lds, 1024, 1024, 1024, 0, S, E0, F.wv);
                  else { TileOrder S9; S9.init(NRT, 12, F.G, obid(), WSP(unsigned char, WS_HX8), (size_t)256 * 1024, WSP(unsigned char, WS_WIN8) + (size_t)l * 3072 * 1024, (size_t)256 * 1024, 0);
                         if (PROBE_INPROJ_NOEPI == 2) pg8::gemm_phase<EpiNone, TileOrder, INPROJ_ALIGN, false, false, true, 0x7b7b7b7b, 0x79797979>(F.lds, 512, 512, 512, 0, S9, E0, F.wv);
                         else { EpiStoreOnly E1{WSP(bf16_t, WS_PG)}; pg8::gemm_phase<EpiStoreOnly, TileOrder, INPROJ_ALIGN, false, false, true, 0x7b7b7b7b, 0x79797979>(F.lds, 512, 512, 512, 0, S9, E1, F.wv); } } }
#endif
#ifdef PROBE_INPROJ_REP
                { TileOrder S9; S9.init(NRT, 12, F.G, obid(), WSP(unsigned char, WS_HX8), (size_t)256 * 1024, WSP(unsigned char, WS_WIN8) + (size_t)l * 3072 * 1024, (size_t)256 * 1024, 0);
                  EpiGate E9{WSP(bf16_t, WS_PG)};
                  pg8::gemm_phase<EpiGate, TileOrder, INPROJ_ALIGN, false, false, true, 0x7b7b7b7b, 0x79797979>(F.lds, 512, 512, 512, 0, S9, E9, F.wv); }
#endif
                TileOrder S8; S8.init(NRT, 12, F.G, (obid() + F.G - (NRT * 15) % F.G) % F.G, WSP(unsigned char, WS_HX8), (size_t)256 * 1024, WSP(unsigned char, WS_WIN8) + (size_t)l * 3072 * 1024, (size_t)256 * 1024, 0);
                EpiGate E8{WSP(bf16_t, WS_PG)};
#ifdef INPROJ_COHORT
                int coh = (obid() >> (INPROJ_COHORT)) & 1;
#pragma nounroll
                for (int pass = 0; pass < 2; ++pass, coh ^= 1) {
                    if (coh == 0) pg8::gemm_phase<EpiInproj, TileOrder, INPROJ_ALIGN>(F.lds, 1024, 1024, 1024, 0, S, E, F.wv);
                    else pg8::gemm_phase<EpiGate, TileOrder, INPROJ_ALIGN, false, false, true, 0x7b7b7b7b, 0x79797979>(F.lds, 512, 512, 512, 0, S8, E8, F.wv);
                }
#else
#ifdef INPROJ_L1_FP8
                if (l == DEPTH - 1) {
                    TileOrder S1; S1.init(NRT, 15, F.G, obid(), WSP(unsigned char, WS_HX8), (size_t)256 * 1024, WSP(unsigned char, WS_W8L1), (size_t)256 * 1024, 0);
                    pg8::gemm_phase<EpiInproj, TileOrder, INPROJ_ALIGN, false, false, true, 0x7b7b7b7b, 0x79797979>(F.lds, 512, 512, 512, 0, S1, E, F.wv);
                } else
#endif
                pg8::gemm_phase<EpiInproj, TileOrder, INPROJ_ALIGN>(F.lds, 1024, 1024, 1024, 0, S, E, F.wv);
                pg8::gemm_phase<EpiGate, TileOrder, INPROJ_ALIGN, false, false, true, 0x7b7b7b7b, 0x79797979>(F.lds, 512, 512, 512, 0, S8, E8, F.wv);
#endif
            }
            GRID_BAR(); STAMP(2);

            if constexpr (PHM(3)) REPS(3) {
                TileOrder S; S.init(NRT, 3, F.G, obid(), WSP(bf16_t, WS_PM), (size_t)256 * 640 * 2, WSP(bf16_t, WS_WUQ) + (size_t)l * 768 * 384, (size_t)256 * 384 * 2, 0);
                EpiUq E{WSP(unsigned char, WS_Q), WSP(float, WS_SSQ), WSP(f32x2, WS_MT)};
                pg8::gemm_phase<EpiUq, TileOrder, true>(F.lds, 640, 384, 384, 0, S, E, F.wv);
            }
#ifndef PROBE_COARSE
            STAMP(3);
#endif
            if constexpr (PHM(4)) REPS(4) {
                TileOrder S; S.init(NRT, 4, F.G, (obid() + F.G - (NRT * 3) % F.G) % F.G, WSP(bf16_t, WS_PM) + 384, (size_t)256 * 640 * 2, WSP(bf16_t, WS_WUKV) + (size_t)l * 1024 * 256, (size_t)256 * 256 * 2, 0);
                EpiUkv E{WSP(unsigned char, WS_K), WSP(unsigned char, WS_V), WSP(float, WS_SSQ), F.lds + LDS_VTR_OFF};
                pg8::gemm_phase<EpiUkv, TileOrder, true>(F.lds, 640, 256, 256, 0, S, E, F.wv);
            }
#ifndef PROBE_COARSE
            STAMP(4);
#endif
            if constexpr (PHM(5)) REPS(5) for (int u = (obid() + F.G - (NRT * 7) % F.G) % F.G; u < GB * NCHUNK * 4; u += F.G) {
                const int h = u & 3;
                retu_unit(u, WSP(bf16_t, WS_PR), WSP(float, WS_HX), lg2_gamma(INP(9) + l * 8 + h), lg2_gamma(INP(9) + l * 8 + 4 + h), (LAS char*)F.lds, F.wv);
            }
#ifndef PROBE_COARSE
            STAMP(5);
#endif
            if constexpr (PHM(6)) REPS(6) conv_phase(F, l);
            GRID_BAR(); STAMP(6);

            if constexpr (PHM(7)) REPS(7) scan_phase(F, l);
#ifndef PROBE_COARSE
            STAMP(7);
#endif
#ifdef PROBE_CLK
            unsigned long long c0_ = 0, r0_ = 0; if (g == 0 && l == 0) { c0_ = __builtin_readcyclecounter(); r0_ = __builtin_amdgcn_s_memrealtime(); }
#endif
            if constexpr (PHM(8)) REPS(8) {
                const unsigned char* Q = WSP(unsigned char, WS_Q); const unsigned char* K = WSP(unsigned char, WS_K); const unsigned char* V = WSP(unsigned char, WS_V); bf16_t* ACT = WSP(bf16_t, WS_ACT);
                const int vcu = (obid() % 8) * (F.G / 8) + obid() / 8, xcd = vcu / (F.G / 8), slot = vcu % (F.G / 8);
                const int nlat = GB * 8 * 32, nunit = nlat + (lat_only ? 0 : GB * 8);
                for (int i = 0; ; ++i) {
                    int hh, qb;
                    if (F.G == 256) { if (i < 4) { hh = xcd + 8 * i; qb = 1 + slot; } else if (i == 4 && !lat_only && slot < 4) { hh = xcd + 8 * slot; qb = 0; } else break; }
                    else { const int L = i * F.G + obid(); if (L >= nunit) break; if (L < nlat) { hh = L >> 5; qb = 1 + (L & 31); } else { hh = L - nlat; qb = 0; } }
                    const int bl = hh >> 3, h = hh & 7;
                    const size_t hb = (size_t)(bl * 8 + h) * SB;
#ifdef ATTN_IL
                    att2::attn_unit_il
#else
                    att2::attn_unit_pp
#endif
                        (Q + (hb + (size_t)qb * 256) * 128, K + hb * 128, V + (size_t)(bl * 8 + h) * 64 * SB, ACT + ((size_t)bl * SB + (size_t)qb * 256) * 1536 + 1024 + h * 64, 1536, qb == 0 ? CTXL : SB, (LAS char*)F.lds, F.wv);
                }
            }
#ifdef PROBE_CLK
            if (g == 0 && l == 0 && obid() == 0 && F.wv == 0 && olane() == 0) { const unsigned long long c1_ = __builtin_readcyclecounter(), r1_ = __builtin_amdgcn_s_memrealtime();
                WSP(unsigned long long, WS_CTL + 600 * 1024)[0] = (c1_ - c0_) * 100ull / (r1_ - r0_); }
#endif
            GRID_BAR(); STAMP(8);

            if constexpr (PHM(9)) REPS(9) for (int u = obid(); u < GB * NCHUNK * 4; u += F.G) {
                const int h = u & 3;
                retout_unit(u, WSP(bf16_t, WS_PR), WSP(bf16_t, WS_PM), INP(10) + l * 512, WSP(bf16_t, WS_ACT), lg2_gamma(INP(9) + l * 8 + h), lg2_gamma(INP(9) + l * 8 + 4 + h), (LAS char*)F.lds, F.wv);
            }
            GRID_BAR(); STAMP(9);

            if constexpr (PHM(10)) REPS(10) {
#ifdef MERGE1_STAGGER
                {
                    const unsigned long long t0_ = __builtin_amdgcn_s_memrealtime(), d_ = (unsigned long long)((obid() >> 3) & 3) * (MERGE1_STAGGER) * 10ull;
                    while (__builtin_amdgcn_s_memrealtime() - t0_ < d_) __builtin_amdgcn_s_sleep(4);
                }
#endif
                unsigned* pctr = WSP(unsigned, WS_CTL) + CW_PANEL + (g * 2 + l) * (NRT * 64);
#ifdef HANDOFF
                TileOrderP S; S.init(lat_only ? GB * 32 : NRT, 4, F.G, obid(), WSP(bf16_t, WS_ACT), (size_t)256 * 1536 * 2, WSP(bf16_t, WS_WCAT) + (size_t)l * 1024 * 1536, (size_t)256 * 1536 * 2, lat_only); S.ctr = pctr;
#else
                TileOrder S; S.init(lat_only ? GB * 32 : NRT, 4, F.G, obid(), WSP(bf16_t, WS_ACT), (size_t)256 * 1536 * 2, WSP(bf16_t, WS_WCAT) + (size_t)l * 1024 * 1536, (size_t)256 * 1536 * 2, lat_only); (void)pctr;
#endif
#ifdef PROBE_MERGE1_NOHOOK
                { EpiMerge1NoHook E0{{WSP(bf16_t, WS_PG), WSP(bf16_t, WS_HX)}}; pg8::gemm_phase<EpiMerge1NoHook, TileOrder, true>(F.lds, 1536, 1536, 1536, 0, S, E0, F.wv); }
#endif
                EpiMerge1 E{WSP(bf16_t, WS_PG), WSP(bf16_t, WS_HX)};
#ifdef HANDOFF
                pg8::gemm_phase<EpiMerge1, TileOrderP, true>(F.lds, 1536, 1536, 1536, 0, S, E, F.wv);
#else
                pg8::gemm_phase<EpiMerge1, TileOrder, true>(F.lds, 1536, 1536, 1536, 0, S, E, F.wv);
#endif
            }
#if !defined(HANDOFF) || defined(HANDOFF_WITH_BARRIER)
            GRID_BAR();
#endif
            STAMP(10);

            if constexpr (PHM(11)) {
#ifdef HANDOFF
                const int n1 = (lat_only ? GB * 32 : NRT) * 4;
                TileOrderC S; S.init(lat_only ? GB * 32 : NRT, 4, F.G, (obid() + F.G - n1 % F.G) % F.G, WSP(bf16_t, WS_HX), (size_t)256 * 1024 * 2, WSP(bf16_t, WS_WOUT) + (size_t)l * 1024 * 1024, (size_t)256 * 1024 * 2, lat_only);
                S.ctr = WSP(unsigned, WS_CTL) + CW_PANEL + (g * 2 + l) * (NRT * 64); S.need = 32u; S.tmo = WSP(unsigned, WS_CTL) + 8; S.wv = F.wv;
                EpiMerge2 E{R, MODL};
                pg8::gemm_phase<EpiMerge2, TileOrderC, true>(F.lds, 1024, 1024, 1024, 0, S, E, F.wv);
#else
                TileOrder S; S.init(lat_only ? GB * 32 : NRT, 4, F.G, obid(), WSP(bf16_t, WS_HX), (size_t)256 * 1024 * 2, WSP(bf16_t, WS_WOUT) + (size_t)l * 1024 * 1024, (size_t)256 * 1024 * 2, lat_only);
                EpiMerge2 E{R, MODL};
                pg8::gemm_phase<EpiMerge2, TileOrder, true>(F.lds, 1024, 1024, 1024, 0, S, E, F.wv);
#endif
            }
            GRID_BAR(); STAMP(11);

            if constexpr (((REPMASK) >> 12) & 1) norm2_router_phase(F, R, l, g, lat_only, 32);
            if constexpr (PHM(12)) norm2_router_phase(F, R, l, g, lat_only, 0);
            GRID_BAR(); STAMP(12);

            moe_tables(F, l, g);
            if constexpr (PHM(13)) REPS(13) {
                if (l == DEPTH - 1) {
                    MoeOrder S{(const LAS int*)(F.lds + LDS_MOE_OFF), WSP(int, WS_LIST), 8, F.G, obid(), 1, (const char*)WSP(unsigned char, WS_H28), (const char*)(WSP(unsigned char, WS_WUP) + (size_t)16 * 1024 * 1024 * 2), 1};
                    EpiMoeUp8 E{WSP(int, WS_LIST), WSP(float, WS_WGT), WSP(unsigned char, WS_PG)};
                    pg8::gemm_phase<EpiMoeUp8, MoeOrder, true, true, false, true, 0x7b7b7b7b, 0x79797979>(F.lds, 512, 512, 512, 0, S, E, F.wv);
                } else {
                    MoeOrder S{(const LAS int*)(F.lds + LDS_MOE_OFF), WSP(int, WS_LIST), 8, F.G, obid(), 1, (const char*)WSP(bf16_t, WS_HX), (const char*)(WSP(bf16_t, WS_WUP) + (size_t)l * 16 * 1024 * 1024), 2};
                    EpiMoeUp E{WSP(int, WS_LIST), WSP(float, WS_WGT), WSP(bf16_t, WS_PG)};
                    pg8::gemm_phase<EpiMoeUp, MoeOrder, true, true, false>(F.lds, 1024, 1024, 1024, 0, S, E, F.wv);
                }
            }
            GRID_BAR(); STAMP(13);

            if constexpr (PHM(14)) {
                if (l == DEPTH - 1) {
                    MoeOrder S{(const LAS int*)(F.lds + LDS_MOE_OFF), WSP(int, WS_LIST), 4, F.G, obid(), 0, (const char*)WSP(unsigned char, WS_PG), (const char*)(WSP(unsigned char, WS_W2T) + (size_t)16 * 1024 * 512 * 2), 1};
                    EpiMoeDown E{WSP(int, WS_LIST), R, MODL, nullptr};
                    pg8::gemm_phase<EpiMoeDown, MoeOrder, true, false, true, true, 0x7a7a7a7a, 0x7a7a7a7a>(F.lds, 512, 256, 512, 4, S, E, F.wv);
                } else {
                    MoeOrder S{(const LAS int*)(F.lds + LDS_MOE_OFF), WSP(int, WS_LIST), 4, F.G, obid(), 0, (const char*)WSP(bf16_t, WS_PG), (const char*)(WSP(bf16_t, WS_W2T) + (size_t)l * 16 * 1024 * 512), 2};
                    EpiMoeDown E{WSP(int, WS_LIST), R, MODL, nullptr};
                    pg8::gemm_phase<EpiMoeDown, MoeOrder, true, false, true>(F.lds, 1024, 512, 1024, 8, S, E, F.wv);
                }
            }
            GRID_BAR(); STAMP(14);
        }
    }
    if constexpr (PHM(15)) final_norm_phase(F, NG - 1);
#ifdef SELFCHECK_ATTN
            {
                const unsigned char* Q = WSP(unsigned char, WS_Q); const unsigned char* K = WSP(unsigned char, WS_K); const unsigned char* V = WSP(unsigned char, WS_V); const bf16_t* ACT = WSP(bf16_t, WS_ACT);
                const int lane_ = olane(); const int gwv = obid() * 8 + F.wv;
                if (gwv < 96) {
                    const int bl = gwv & 3, h = (gwv >> 2) & 7, qi = gwv >> 5;
                    const int srow = qi == 0 ? 256 : (qi == 1 ? 256 + 4099 : SB - 1);
                    const int nkeys = srow < CTXL ? CTXL : SB;
                    const size_t hb = (size_t)(bl * 8 + h) * SB;
                    #define F8(p) (__builtin_amdgcn_cvt_f32_fp8((int)(*(p)), 0))
                    const float q0 = F8(Q + (hb + srow) * 128 + lane_) * (1.f / Q8S), q1 = lane_ < 32 ? F8(Q + (hb + srow) * 128 + 64 + lane_) * (1.f / Q8S) : 0.f;
                    float mrun = -1e30f, lrun = 0.f, orun = 0.f;
#pragma nounroll
                    for (int j = 0; j < nkeys; ++j) {
                        float part = q0 * F8(K + (hb + j) * 128 + lane_) * (1.f / K8S); if (lane_ < 32) part += q1 * F8(K + (hb + j) * 128 + 64 + lane_) * (1.f / K8S);
                        const float s = wave_sum(part);
                        const float mn = fmaxf(mrun, s), sc = exp2f(mrun - mn), p = exp2f(s - mn);
                        lrun = lrun * sc + p; orun = orun * sc + p * F8(V + ((size_t)(bl * 8 + h) * 64 + lane_) * SB + (j & ~63) + vt_pos(j & 63)) * (1.f / V8S); mrun = mn; }
                    const float o_ = orun / lrun; const float got = bf1(ACT[((size_t)bl * SB + srow) * 1536 + 1024 + h * 64 + lane_]);
                    float err = fabsf(o_ - got), ref = fabsf(o_);
                    err = fmaxf(err, swz_xor<1>(err)); err = fmaxf(err, swz_xor<2>(err)); err = fmaxf(err, swz_xor<4>(err)); err = fmaxf(err, swz_xor<8>(err)); err = fmaxf(err, swz_xor<16>(err));
                    ref = fmaxf(ref, swz_xor<1>(ref)); ref = fmaxf(ref, swz_xor<2>(ref)); ref = fmaxf(ref, swz_xor<4>(ref)); ref = fmaxf(ref, swz_xor<8>(ref)); ref = fmaxf(ref, swz_xor<16>(ref));
                    { auto r1_ = __builtin_amdgcn_permlane32_swap(__float_as_uint(err), __float_as_uint(err), false, false); err = fmaxf(__uint_as_float(r1_[0]), __uint_as_float(r1_[1]));
                      auto r2_ = __builtin_amdgcn_permlane32_swap(__float_as_uint(ref), __float_as_uint(ref), false, false); ref = fmaxf(__uint_as_float(r2_[0]), __uint_as_float(r2_[1])); }
                    if (lane_ == 0 && !(err <= SELFCHECK_TOL * ref + 1e-6f)) atomicAdd(WSP(unsigned, WS_CTL) + 3000, 1u);
                }
            }
    GRID_BAR();
    if (__hip_atomic_load(WSP(unsigned, WS_CTL) + 3000, __ATOMIC_RELAXED, __HIP_MEMORY_SCOPE_AGENT) != 0u && obid() == 0) { for (int i = otid(F.wv); i < 4096; i += 512) F.out[i] = __builtin_nanf(""); }
#endif
#ifdef PROBE_CLK
    if (obid() == 0 && F.wv == 0 && olane() == 0) { const unsigned long long mhz = WSP(unsigned long long, WS_CTL + 600 * 1024)[0]; const unsigned long long t0 = __builtin_amdgcn_s_memrealtime();
        while (__builtin_amdgcn_s_memrealtime() - t0 < mhz * 100ull) __builtin_amdgcn_s_sleep(8); }
#endif
#ifdef PROBE_A
    STAMP(15);
    GRID_BAR();
    {
        unsigned long long* TS = WSP(unsigned long long, WS_CTL + 512 * 1024);
        unsigned long long tot = 0; for (int k = 0; k < 16; ++k) tot += __hip_atomic_load(TS + k, __ATOMIC_RELAXED, __HIP_MEMORY_SCOPE_AGENT);
        const float fa = (float)__hip_atomic_load(TS + PROBE_A, __ATOMIC_RELAXED, __HIP_MEMORY_SCOPE_AGENT) / (float)tot, fb = (float)__hip_atomic_load(TS + PROBE_B, __ATOMIC_RELAXED, __HIP_MEMORY_SCOPE_AGENT) / (float)tot;
        const float A = sqrtf(90.f * fa), X = 100.f + 800.f * fb;
        for (size_t i = (size_t)blockIdx.x * 512 + threadIdx.x; i < (size_t)NB * SEQ * DM; i += (size_t)gridDim.x * 512) F.out[i] = (i == 0) ? X : ((i & 1) ? A : -A);
    }
#endif
}

extern "C" void kernel_launch(void* const* d_in, const int* in_sizes, int n_in, void* d_out, int out_size, void* d_ws, size_t ws_size, hipStream_t stream) {
    static int grid = 0;
    if (grid == 0) {
        if (n_in != 26 || ws_size < WS_END) { fprintf(stderr, "kernel_launch: expected 26 inputs and >= %zu bytes of workspace; got %d, %zu\n", (size_t)WS_END, n_in, ws_size); grid = -1; return; }
        int dev = 0, cus = 0, per_cu = 0;
        if (hipGetDevice(&dev) != hipSuccess || hipDeviceGetAttribute(&cus, hipDeviceAttributeMultiprocessorCount, dev) != hipSuccess) { grid = -1; return; }
        if (hipFuncSetAttribute((const void*)dit_fwd, hipFuncAttributeMaxDynamicSharedMemorySize, LDS_BYTES) != hipSuccess) { fprintf(stderr, "kernel_launch: hipFuncSetAttribute failed\n"); grid = -1; return; }
        if (hipOccupancyMaxActiveBlocksPerMultiprocessor(&per_cu, (const void*)dit_fwd, 512, LDS_BYTES) != hipSuccess || per_cu < 1) fprintf(stderr, "kernel_launch: occupancy query reports %d\n", per_cu);
        (void)hipGetLastError();
        grid = cus;
    }
    if (grid < 0) return;
    (void)hipMemsetAsync((char*)d_ws + WS_CTL, 0, CTL_ZERO_BYTES, stream);
    Args a{};
    for (int i = 0; i < 26; ++i) a.in[i] = (const float*)d_in[i];
    a.out = (float*)d_out; a.ws = (unsigned char*)d_ws; a.ph_lo = 0; a.ph_hi = 1000;
    hipLaunchKernelGGL(dit_fwd, dim3(grid), dim3(512), LDS_BYTES, stream, a);
}
```

```cpp
#include <hip/hip_runtime.h>
#include <cstdio>
#include <cstdint>

#define GAS __attribute__((address_space(1)))
#define LAS __attribute__((address_space(3)))
typedef unsigned short bf16_t;
typedef short bf16x8 __attribute__((ext_vector_type(8)));
typedef short s16x4 __attribute__((ext_vector_type(4)));
typedef float f32x2 __attribute__((ext_vector_type(2)));
typedef float f32x4 __attribute__((ext_vector_type(4)));
typedef float f32x16 __attribute__((ext_vector_type(16)));
typedef unsigned u32x2 __attribute__((ext_vector_type(2)));
typedef unsigned u32x4 __attribute__((ext_vector_type(4)));
typedef __bf16 bf16x2_t __attribute__((ext_vector_type(2)));

constexpr int DM = 1024, NB = 8, SEQ = 8192, CTXL = 256, DEPTH = 2;
constexpr int SB = SEQ + CTXL;
constexpr int GB = 4, NG = NB / GB;
constexpr int NT = GB * SB;
constexpr int NRT = NT / 256;
constexpr int INW = 6912;
constexpr int INCOLS = 6816;
constexpr int NCHUNK = SB / 128;
constexpr int NPAIR = 24;
constexpr float RMS_EPS = 1e-6f;
constexpr float LOG2E = 1.4426950408889634f;
constexpr float QSCALE = 0.10206207261596575f * LOG2E;
constexpr float Q8S = 32.f, K8S = 4.f, V8S = 4.f, P8S = 16.f;
constexpr float HX8S = 16.f, WG8S = 64.f;
#if !defined(NO_GATE_U8) && !defined(GATE_U8)
#define GATE_U8 1
#endif
#if !defined(NO_ATTN_VDMA_HALF) && !defined(ATTN_VDMA_HALF)
#define ATTN_VDMA_HALF 1
#endif
#if !defined(NO_INPROJ_L1_FP8) && !defined(INPROJ_L1_FP8)
#define INPROJ_L1_FP8 1
#endif
constexpr float H28S = 16.f, WU8S = 64.f, MA8S = 32.f, WD8S = 32.f;

constexpr size_t MiB = 1u << 20;
constexpr size_t WS_CTL = 0, CTL_ZERO_BYTES = 1 * MiB;
constexpr size_t WS_MOD = 1 * MiB;
constexpr size_t WS_RT = 2 * MiB;
constexpr size_t WS_MT = 4 * MiB;
constexpr size_t WS_SSQ = 5 * MiB;
constexpr size_t WS_WGT = 8 * MiB;
constexpr size_t WS_LIST = 9 * MiB;
constexpr size_t WS_XC = 13 * MiB;
constexpr size_t WS_WIN = 21 * MiB;
constexpr size_t WS_WCAT = 48 * MiB;
constexpr size_t WS_WOUT = 54 * MiB;
constexpr size_t WS_WUQ = 58 * MiB;
constexpr size_t WS_WUKV = 60 * MiB;
constexpr size_t WS_WUP = 61 * MiB;
constexpr size_t WS_W2T = 125 * MiB;
constexpr size_t WS_HX = 157 * MiB;
constexpr size_t WS_PR = 223 * MiB;
constexpr size_t WS_PC = 322 * MiB;
constexpr size_t WS_PM = 388 * MiB;
constexpr size_t WS_PG = 430 * MiB;
constexpr size_t WS_Q = 628 * MiB;
constexpr size_t WS_K = 678 * MiB;
constexpr size_t WS_V = 728 * MiB;
constexpr size_t WS_ACT = 761 * MiB;
constexpr size_t WS_W8L1 = 752 * MiB;
constexpr size_t WS_WIN8 = 746 * MiB;
constexpr size_t WS_H28 = WS_PM;
constexpr size_t WS_HX8 = WS_ACT;
constexpr size_t WS_XRES = 860 * MiB;
constexpr size_t WS_END = 988 * MiB;
static_assert(WS_WIN + (size_t)2 * INW * 1024 * 2 <= WS_WCAT && WS_HX + (size_t)NT * 1024 * 2 <= WS_PR && WS_PR + (size_t)NT * 1536 * 2 <= WS_PC &&
              WS_PC + (size_t)NT * 1024 * 2 <= WS_PM && WS_PM + (size_t)NT * 640 * 2 <= WS_PG && WS_PG + (size_t)NT * 3072 * 2 <= WS_Q &&
              WS_Q + (size_t)GB * 8 * SB * 96 * 2 <= WS_K && WS_K + (size_t)GB * 8 * SB * 96 * 2 <= WS_V && WS_V + (size_t)GB * 8 * SB * 64 * 2 <= WS_ACT &&
              WS_ACT + (size_t)NT * 1536 * 2 <= WS_XRES && WS_XRES + (size_t)NB * SEQ * DM * 2 <= WS_END, "d_ws map");
constexpr int CW_BAR = 4096;
constexpr int CW_CNT = 16384;
constexpr int CW_PANEL = 32768;

constexpr int RING_BYTES = 131072;
constexpr int LDSCTL_OFF = RING_BYTES;
constexpr int LDS_MOE_OFF = LDSCTL_OFF + 64;
constexpr int LDS_VTR_OFF = LDSCTL_OFF + 2048;
constexpr int LDS_BYTES = 147456;

__device__ __forceinline__ int olane() { int l; asm volatile("v_mbcnt_lo_u32_b32 %0, -1, 0\n\tv_mbcnt_hi_u32_b32 %0, -1, %0" : "=v"(l)); return l; }
__device__ __forceinline__ int otid(int wv) { return wv * 64 + olane(); }
__device__ __forceinline__ int obid() { int b = blockIdx.x; asm volatile("" : "+s"(b)); return b; }
__device__ __forceinline__ unsigned cvtpk(float lo, float hi) { f32x2 v = {lo, hi}; bf16x2_t b = __builtin_convertvector(v, bf16x2_t); return __builtin_bit_cast(unsigned, b); }
__device__ __forceinline__ float bf_lo(unsigned w) { return __uint_as_float(w << 16); }
__device__ __forceinline__ float bf_hi(unsigned w) { return __uint_as_float(w & 0xffff0000u); }
__device__ __forceinline__ float bf1(bf16_t b) { return __uint_as_float(((unsigned)b) << 16); }
__device__ __forceinline__ bf16_t f2bf(float f) { return (bf16_t)(cvtpk(f, 0.f) & 0xffffu); }
template <int O> __device__ __forceinline__ float swz_xor(float v) { return __int_as_float(__builtin_amdgcn_ds_swizzle(__float_as_int(v), (O << 10) | 0x1f)); }
__device__ __forceinline__ float half_sum(float v) { auto rr = __builtin_amdgcn_permlane32_swap(__float_as_uint(v), __float_as_uint(v), false, false); return __uint_as_float(rr[0]) + __uint_as_float(rr[1]); }
__device__ __forceinline__ float sum32(float v) { v += swz_xor<1>(v); v += swz_xor<2>(v); v += swz_xor<4>(v); v += swz_xor<8>(v); v += swz_xor<16>(v); return v; }
__device__ __forceinline__ float wave_sum(float v) { return half_sum(sum32(v)); }
__device__ __forceinline__ float sigmoidf_(float x) { return 1.f / (1.f + __expf(-x)); }
__device__ __forceinline__ float siluf_(float x) { return x / (1.f + __expf(-x)); }
__device__ __forceinline__ float sigmoid_fast(float x) { return __builtin_amdgcn_rcpf(1.f + __builtin_amdgcn_exp2f(-1.4426950408889634f * x)); }
__device__ __forceinline__ float silu_fast(float x) { return x * sigmoid_fast(x); }
__device__ __forceinline__ void unpack8_u8(const u32x2 w, float (&f)[8]) {
    f[0] = (float)(w.x & 0xffu); f[1] = (float)((w.x >> 8) & 0xffu); f[2] = (float)((w.x >> 16) & 0xffu); f[3] = (float)(w.x >> 24);
    f[4] = (float)(w.y & 0xffu); f[5] = (float)((w.y >> 8) & 0xffu); f[6] = (float)((w.y >> 16) & 0xffu); f[7] = (float)(w.y >> 24); }
__device__ __forceinline__ void unpack8(const u32x4 w, float (&f)[8]) {
    f[0] = bf_lo(w.x); f[1] = bf_hi(w.x); f[2] = bf_lo(w.y); f[3] = bf_hi(w.y); f[4] = bf_lo(w.z); f[5] = bf_hi(w.z); f[6] = bf_lo(w.w); f[7] = bf_hi(w.w);
}
__device__ __forceinline__ u32x2 pack8_fp8(const float (&f)[8]) { int a = __builtin_amdgcn_cvt_pk_fp8_f32(f[0], f[1], 0, false); a = __builtin_amdgcn_cvt_pk_fp8_f32(f[2], f[3], a, true);
    int b = __builtin_amdgcn_cvt_pk_fp8_f32(f[4], f[5], 0, false); b = __builtin_amdgcn_cvt_pk_fp8_f32(f[6], f[7], b, true); u32x2 w; w.x = (unsigned)a; w.y = (unsigned)b; return w; }
__device__ __forceinline__ u32x4 pack8(const float (&f)[8]) { u32x4 w; w.x = cvtpk(f[0], f[1]); w.y = cvtpk(f[2], f[3]); w.z = cvtpk(f[4], f[5]); w.w = cvtpk(f[6], f[7]); return w; }

__host__ __device__ __forceinline__ int vt_pos(int k) { const int w = k & 31, hi = (w >> 2) & 1, r = (w & 3) + 4 * (w >> 3); return 32 * hi + 16 * (k >> 5) + r; }
#ifdef HANDOFF_PLAIN_STORE
__device__ __forceinline__ void store_sc1(void* p, u32x4 v) { *(u32x4*)p = v; }
#else
__device__ __forceinline__ void store_sc1(void* p, u32x4 v) { asm volatile("global_store_dwordx4 %0, %1, off sc1" :: "v"(p), "v"(v) : "memory"); }
#endif
#define XB_TMO      128
#define XB_XCNT(j)  (256  + 64 * (j))
#define XB_XSUB(j)  (1280 + 64 * (j))
#define XB_XGEN(j)  (2304 + 64 * (j))
#define XB_TOP      3328
#define XB_TOPGEN   3392
#define XCD_BAR_WORDS 3456
#define XB_SPIN_CAP (1u << 20)
__device__ __forceinline__ unsigned xb_ld(unsigned* p)              { return __hip_atomic_load(p, __ATOMIC_RELAXED, __HIP_MEMORY_SCOPE_AGENT); }
__device__ __forceinline__ unsigned xb_add(unsigned* p, unsigned v) { return __hip_atomic_fetch_add(p, v, __ATOMIC_RELAXED, __HIP_MEMORY_SCOPE_AGENT); }
__device__ __forceinline__ unsigned xb_xcc_id() { return (unsigned)__builtin_amdgcn_s_getreg((3 << 11) | 20) & 0xFu; }
#define XB_SPIN(cond, bar) do { unsigned _sp = 0; while (cond) { __builtin_amdgcn_s_sleep(1); \
    if ((++_sp & 255u) == 0u) { if (xb_ld(&(bar)[XB_TMO])) break; if (_sp > XB_SPIN_CAP) { atomicAdd(&(bar)[XB_TMO], 1u); break; } } } } while (0)
struct XcdBarrier { unsigned* bar; unsigned x; volatile LAS unsigned* st; };
__device__ __forceinline__ XcdBarrier xcd_barrier_post(unsigned* bar, volatile LAS unsigned* st) {
    XcdBarrier b; b.bar = bar; b.x = xb_xcc_id(); b.st = st;
    if (threadIdx.x == 0) (void)xb_add(&bar[XB_XCNT(b.x)], 1u);
    return b;
}
__device__ __forceinline__ void xcd_barrier_complete(unsigned* bar, unsigned x, unsigned& nloc, unsigned& nx) {
    const unsigned G = gridDim.x * gridDim.y * gridDim.z;
    unsigned sum, cnt, mine, sp = 0u;
    for (;;) {
        sum = 0u; cnt = 0u; mine = 0u;
#pragma unroll
        for (unsigned j = 0; j < 16; ++j) { const unsigned c = xb_ld(&bar[XB_XCNT(j)]); sum += c; cnt += (c > 0u) ? 1u : 0u; mine = (j == x) ? c : mine; }
        if (sum == G) break;
        __builtin_amdgcn_s_sleep(1);
        if ((++sp & 255u) == 0u) { if (xb_ld(&bar[XB_TMO])) break; if (sp > XB_SPIN_CAP) { atomicAdd(&bar[XB_TMO], 1u); break; } }
    }
    nloc = mine > 0u ? mine : 1u; nx = cnt > 0u ? cnt : 1u;
}
__device__ __forceinline__ void xcd_barrier(const XcdBarrier& b, const int wv) {
    const bool leader = (wv == 0) && (olane() == 0);
    asm volatile("s_waitcnt vmcnt(0)" ::: "memory");
    __syncthreads();
    if (leader) {
        unsigned* bar = b.bar; unsigned bx = b.x;
        asm volatile("" : "+s"(bar), "+s"(bx));
        __builtin_amdgcn_s_waitcnt(0);
        unsigned nloc = b.st[0], nx = b.st[1];
        if (nloc == 0u) { xcd_barrier_complete(bar, bx, nloc, nx); b.st[0] = nloc; b.st[1] = nx; }
        const unsigned old = xb_add(&bar[XB_XSUB(bx)], 1u);
        const unsigned gen = old / nloc;
        if (old + 1u == (gen + 1u) * nloc) {
            __builtin_amdgcn_fence(__ATOMIC_RELEASE, "agent");
            asm volatile("s_waitcnt vmcnt(0)" ::: "memory");
            const unsigned og = xb_add(&bar[XB_TOP], 1u);
            const unsigned tg = og / nx;
            if (og + 1u == (tg + 1u) * nx) xb_add(&bar[XB_TOPGEN], 1u);
            else XB_SPIN(xb_ld(&bar[XB_TOPGEN]) == tg, bar);
            __builtin_amdgcn_fence(__ATOMIC_ACQUIRE, "agent");
            xb_add(&bar[XB_XGEN(bx)], 1u);
            asm volatile("s_waitcnt vmcnt(0)" ::: "memory");
        } else {
            XB_SPIN(xb_ld(&bar[XB_XGEN(bx)]) == gen, bar);
            __builtin_amdgcn_fence(__ATOMIC_ACQUIRE, "agent");
            asm volatile("s_waitcnt vmcnt(0)" ::: "memory");
        }
    }
    __syncthreads();
}

namespace pg8 {
constexpr int BM = 256, BK = 64, HALF = 128, HTB = HALF * BK * 2, NXCD = 8, WGM = 8;
__host__ __device__ __forceinline__ int lds_byte(int r, int c) { const int st = (r >> 4) * 2 + (c >> 5), rr = r & 15, cc = c & 31, ob = rr * 64 + cc * 2; return st * 1024 + (ob ^ (((ob >> 9) & 1) << 5)); }
__host__ __device__ __forceinline__ void stage_rc(int b, int& R, int& C) { const int st = b / 1024, sb = b % 1024, swz = sb ^ (((sb >> 9) & 1) << 5); R = (st >> 1) * 16 + swz / 64; C = (st & 1) * 32 + (swz % 64) / 2; }
__host__ __device__ __forceinline__ int perm32(int rho) { const int n = rho >> 4, i = rho & 15; return 8 * (i >> 2) + 4 * n + (i & 3); }

struct Unit { int pm, pn, aux0, aux1, aux2; const char* a; const char* b; const char* b2; };
typedef f32x4 Acc[2][2][4][2];

typedef int i32x8_t __attribute__((ext_vector_type(8)));
typedef int i32x4_t __attribute__((ext_vector_type(4)));
template <class Epi, class Sched, bool ALIGN_EPI, bool GATHER = false, bool SPLITB = false, bool FP8 = false, int SCA = 0x7f7f7f7f, int SCB = 0x7f7f7f7f>
__device__ __forceinline__ void gemm_phase(LAS unsigned char* lds, const int lda, const int ldb, const int K, const int ksplit, const Sched& S, const Epi& E, const int wv) {
    const int tid = otid(wv), wid = __builtin_amdgcn_readfirstlane(tid >> 6), lane = tid & 63, wr = wid >> 2, wc = wid & 3, fr = lane & 15, fq = lane >> 4;
    const int nt = K / BK;
    unsigned voffA[2][2], voffN[2][2], voffB[2];
#pragma unroll
    for (int i = 0; i < 2; ++i) { int R, C; stage_rc(tid * 16 + i * 8192, R, C); const int Rb = (R & ~31) + perm32(R & 31);
        voffB[i] = (unsigned)(Rb * ldb + C) * 2u;
        voffA[0][i] = (unsigned)(R * lda + C) * 2u; voffA[1][i] = (unsigned)((R + HALF) * lda + C) * 2u; voffN[0][i] = voffA[0][i]; voffN[1][i] = voffA[1][i]; }
    const size_t kstep = (size_t)(BK * 2);
    const size_t hstepB = (size_t)HALF * ldb * 2, hstepA = (size_t)HALF * lda * 2;
    const unsigned ldsw = (unsigned)wid * 1024u;
    const int aoff = lds_byte(wr * 64 + fr, fq * 8), boff = lds_byte(wc * 32 + fr, fq * 8);
#define PG8_SA(b, h) (((b) * 2 + (h)) * HTB)
#define PG8_SB(b, h) ((4 + (b) * 2 + (h)) * HTB)
#define PG8_STAGE_B(bufoff, gbase, h) do { _Pragma("unroll") for (int _i = 0; _i < 2; ++_i) \
        __builtin_amdgcn_global_load_lds((const unsigned*)((const char*)(gbase) + (size_t)(h) * hstepB + voffB[_i]), (LAS unsigned*)(lds + (bufoff) + ldsw + _i * 8192), 16, 0, 0); } while (0)
#define PG8_STAGE_A(bufoff, gbase, h, NX) do { _Pragma("unroll") for (int _i = 0; _i < 2; ++_i) { if constexpr (GATHER) { const unsigned _o = (NX) ? voffN[h][_i] : voffA[h][_i]; \
        __builtin_amdgcn_global_load_lds((const unsigned*)((const char*)(gbase) + _o), (LAS unsigned*)(lds + (bufoff) + ldsw + _i * 8192), 16, 0, 0); } else { \
        __builtin_amdgcn_global_load_lds((const unsigned*)((const char*)(gbase) + (size_t)(h) * hstepA + voffA[0][_i]), (LAS unsigned*)(lds + (bufoff) + ldsw + _i * 8192), 16, 0, 0); } } } while (0)
#define PG8_LDA(dst, b, h) do { _Pragma("unroll") for (int m = 0; m < 4; ++m) { if constexpr (FP8) { \
        A8[m].lo = *(const LAS i32x4_t*)(lds + PG8_SA(b, h) + aoff + m * 2048); A8[m].hi = *(const LAS i32x4_t*)(lds + PG8_SA(b, h) + aoff + m * 2048 + 1024); } else { \
        _Pragma("unroll") for (int k = 0; k < 2; ++k) dst[m][k] = *(const LAS bf16x8*)(lds + PG8_SA(b, h) + aoff + m * 2048 + k * 1024); } } } while (0)
#define PG8_LDB(dst, b, h) do { _Pragma("unroll") for (int n = 0; n < 2; ++n) { if constexpr (FP8) { \
        dst##8[n].lo = *(const LAS i32x4_t*)(lds + PG8_SB(b, h) + boff + n * 2048); dst##8[n].hi = *(const LAS i32x4_t*)(lds + PG8_SB(b, h) + boff + n * 2048 + 1024); } else { \
        _Pragma("unroll") for (int k = 0; k < 2; ++k) dst[n][k] = *(const LAS bf16x8*)(lds + PG8_SB(b, h) + boff + n * 2048 + k * 1024); } } } while (0)
#define PG8_MMA(ai, bj, At, Bt) do { __builtin_amdgcn_s_setprio(1); if constexpr (FP8) { _Pragma("unroll") for (int m = 0; m < 4; ++m) _Pragma("unroll") for (int n = 0; n < 2; ++n) \
        asm volatile("v_mfma_scale_f32_16x16x128_f8f6f4 %0, %1, %2, %0, %3, %4 op_sel_hi:[0,0,0]" : "+v"(acc[ai][bj][m][n]) : "v"(Bt##8[n]), "v"(A8[m]), "v"(scb_), "v"(sca_)); } else { \
        _Pragma("unroll") for (int m = 0; m < 4; ++m) _Pragma("unroll") for (int n = 0; n < 2; ++n) _Pragma("unroll") for (int k = 0; k < 2; ++k) \
        acc[ai][bj][m][n] = __builtin_amdgcn_mfma_f32_16x16x32_bf16(Bt[n][k], At[m][k], acc[ai][bj][m][n], 0, 0, 0); } __builtin_amdgcn_s_setprio(0); } while (0)
#define PG8_WAIT_V(n) asm volatile("s_waitcnt vmcnt(" #n ")" ::: "memory")
#define PG8_WAIT_L(n) asm volatile("s_waitcnt lgkmcnt(" #n ")" ::: "memory")
#define PG8_BAR __builtin_amdgcn_s_barrier()
#define PG8_SCHED __builtin_amdgcn_sched_barrier(0)
#define PG8_GOFF(dst, u) do { if constexpr (GATHER) { const int _t = otid(wv); _Pragma("unroll") for (int _i = 0; _i < 2; ++_i) { int _R, _C; stage_rc(_t * 16 + _i * 8192, _R, _C); \
        _Pragma("unroll") for (int _h = 0; _h < 2; ++_h) dst[_h][_i] = S.gather_off(u, _h * HALF + _R) + (unsigned)_C * 2u; } } } while (0)
#define PG8_BPTR(u, t) (SPLITB ? (((t) < ksplit) ? (u).b + (size_t)(t) * kstep : (u).b2 + (size_t)((t) - ksplit) * kstep) : (u).b + (size_t)(t) * kstep)
    Unit cur, nxt; int ui = 0;
    if (!S.next(0, cur)) return;
    Acc acc;
#pragma unroll
    for (int a = 0; a < 2; ++a)
#pragma unroll
        for (int b = 0; b < 2; ++b)
#pragma unroll
            for (int m = 0; m < 4; ++m)
#pragma unroll
                for (int n = 0; n < 2; ++n) acc[a][b][m][n] = (f32x4){0.f, 0.f, 0.f, 0.f};
    bf16x8 At[4][2], B0[2][2], B1[2][2]; i32x8_t A8[4], B08[2], B18[2]; const int sca_ = SCA, scb_ = SCB;
    const char* cA = cur.a; const char* cB = cur.b;
    S.a_ready(cur);
    PG8_GOFF(voffA, cur);
    if constexpr (GATHER) {
#pragma unroll
        for (int h = 0; h < 2; ++h)
#pragma unroll
            for (int i = 0; i < 2; ++i) voffN[h][i] = voffA[h][i];
    }
    PG8_STAGE_B(PG8_SB(0, 0), cB, 0); PG8_STAGE_B(PG8_SB(0, 1), cB, 1); PG8_STAGE_A(PG8_SA(0, 0), cA, 0, false); PG8_STAGE_A(PG8_SA(0, 1), cA, 1, false);
    if (wr == 1) PG8_BAR;
    PG8_WAIT_V(2); PG8_BAR;
    PG8_STAGE_B(PG8_SB(1, 0), cB + kstep, 0); PG8_STAGE_A(PG8_SA(1, 0), cA + kstep, 0, false); PG8_STAGE_B(PG8_SB(1, 1), cB + kstep, 1);
    PG8_WAIT_V(6); PG8_BAR;
    for (;;) {
        const bool has_next = S.next(ui + 1, nxt);
        const char* nA = has_next ? nxt.a : cA; const char* nB = has_next ? nxt.b : cB;
#pragma nounroll
        for (int t = 0; t < nt; t += 2) {
            const bool last = (t == nt - 2);
            if (last && has_next) { S.a_ready(nxt); PG8_GOFF(voffN, nxt); }
            if constexpr (Epi::HOOK) { if (t == Epi::HOOK_T0 || t == Epi::HOOK_T1) E.hook(acc, cur, t, wr, wc, fr, fq); }
            const char* a1 = cA + (size_t)(t + 1) * kstep;
            const char* a2 = last ? nA : cA + (size_t)(t + 2) * kstep; const char* b2 = last ? nB : PG8_BPTR(cur, t + 2);
            const char* a3 = a2 + kstep; const char* b3 = b2 + kstep;
            PG8_LDB(B0, 0, 0); PG8_LDB(B1, 0, 1); PG8_SCHED; PG8_LDA(At, 0, 0); PG8_STAGE_A(PG8_SA(1, 1), a1, 1, false);
            PG8_WAIT_V(8); PG8_WAIT_L(0); PG8_BAR; PG8_MMA(0, 0, At, B0); PG8_MMA(0, 1, At, B1); PG8_BAR; PG8_SCHED;
            PG8_LDA(At, 0, 1); PG8_STAGE_B(PG8_SB(0, 0), b2, 0); PG8_STAGE_B(PG8_SB(0, 1), b2, 1); PG8_STAGE_A(PG8_SA(0, 0), a2, 0, last);
            PG8_WAIT_V(8); PG8_WAIT_L(0); PG8_BAR; PG8_MMA(1, 0, At, B0); PG8_MMA(1, 1, At, B1); PG8_BAR; PG8_SCHED;
            PG8_LDB(B0, 1, 0); PG8_LDB(B1, 1, 1); PG8_SCHED; PG8_LDA(At, 1, 0); PG8_STAGE_A(PG8_SA(0, 1), a2, 1, last);
            PG8_WAIT_V(8); PG8_WAIT_L(0); PG8_BAR; PG8_MMA(0, 0, At, B0); PG8_MMA(0, 1, At, B1); PG8_BAR; PG8_SCHED;
            PG8_LDA(At, 1, 1); PG8_STAGE_B(PG8_SB(1, 0), b3, 0); PG8_STAGE_B(PG8_SB(1, 1), b3, 1); PG8_STAGE_A(PG8_SA(1, 0), a3, 0, last);
            PG8_WAIT_V(8); PG8_WAIT_L(0); PG8_BAR; PG8_MMA(1, 0, At, B0); PG8_MMA(1, 1, At, B1); PG8_BAR; PG8_SCHED;
        }
        if constexpr (ALIGN_EPI) { if (wr == 0) PG8_BAR; }
        if constexpr (FP8) asm volatile("s_nop 15\n\ts_nop 15" ::: "memory");
        E(acc, cur, wr, wc, fr, fq); S.done(cur);
        if (!has_next) break;
#pragma unroll
        for (int a = 0; a < 2; ++a)
#pragma unroll
            for (int b = 0; b < 2; ++b)
#pragma unroll
                for (int m = 0; m < 4; ++m)
#pragma unroll
                    for (int n = 0; n < 2; ++n) acc[a][b][m][n] = (f32x4){0.f, 0.f, 0.f, 0.f};
        cur = nxt; cA = nA; cB = nB; ++ui;
        if constexpr (GATHER) {
#pragma unroll
            for (int h = 0; h < 2; ++h)
#pragma unroll
                for (int i = 0; i < 2; ++i) voffA[h][i] = voffN[h][i];
        }
        if constexpr (ALIGN_EPI) { if (wr == 1) PG8_BAR; }
    }
    PG8_WAIT_V(0);
    if constexpr (!ALIGN_EPI) { if (wr == 0) PG8_BAR; }
    PG8_BAR;
#undef PG8_SA
#undef PG8_SB
#undef PG8_STAGE_A
#undef PG8_STAGE_B
#undef PG8_LDA
#undef PG8_LDB
#undef PG8_MMA
#undef PG8_WAIT_V
#undef PG8_WAIT_L
#undef PG8_BAR
#undef PG8_SCHED
#undef PG8_GOFF
#undef PG8_BPTR
}
}
struct Resid {
    const float* in_lat; const float* in_ctx; bf16_t* x_lat; bf16_t* x_ctx; int g, src_f32;
    __device__ __forceinline__ const float* srcf(int row) const { const int bl = row / SB, s = row - bl * SB, b = g * GB + bl;
        return s < CTXL ? in_ctx + (size_t)(b * CTXL + s) * DM : in_lat + ((size_t)b * SEQ + (s - CTXL)) * DM; }
    __device__ __forceinline__ bf16_t* dst(int row) const { const int bl = row / SB, s = row - bl * SB, b = g * GB + bl;
        return s < CTXL ? x_ctx + (size_t)(b * CTXL + s) * DM : x_lat + ((size_t)b * SEQ + (s - CTXL)) * DM; }
    __device__ __forceinline__ int modv(int row) const { const int bl = row / SB, s = row - bl * SB; return s < CTXL ? 8 : g * GB + bl; }
};

struct TileOrder {
    int nM, nN, nwg, G, c, skip; const char* A; const char* B; size_t astep, bstep;
    __device__ __forceinline__ void init(int nM_, int nN_, int G_, int c_, const void* A_, size_t astep_, const void* B_, size_t bstep_, int skip_ctx) {
        nM = nM_; nN = nN_; nwg = nM * nN; G = G_; c = c_; A = (const char*)A_; B = (const char*)B_; astep = astep_; bstep = bstep_; skip = skip_ctx; }
    __device__ __forceinline__ bool next(int i, pg8::Unit& u) const {
        const long L = (long)i * G + c; if (L >= nwg) return false;
        int wgid = (int)L; { const int q = nwg / pg8::NXCD, r = nwg % pg8::NXCD, xcd = wgid % pg8::NXCD, off = wgid / pg8::NXCD; wgid = (xcd < r ? xcd * (q + 1) : r * (q + 1) + (xcd - r) * q) + off; }
        const int nig = pg8::WGM * nN, gid = wgid / nig, fm = gid * pg8::WGM, gsz = (nM - fm) < pg8::WGM ? (nM - fm) : pg8::WGM;
        int pm = fm + ((wgid % nig) % gsz); u.pn = (wgid % nig) / gsz;
        if (skip) pm = pm + pm / 32 + 1;
        u.pm = pm; u.aux0 = 0; u.aux1 = 0; u.aux2 = 0;
        u.a = A + (size_t)pm * astep; u.b = B + (size_t)u.pn * bstep; u.b2 = u.b; return true;
    }
    __device__ __forceinline__ void a_ready(const pg8::Unit&) const {}
    __device__ __forceinline__ void done(const pg8::Unit&) const {}
};

struct TileOrderP : TileOrder {
    unsigned* ctr;
    __device__ __forceinline__ void done(const pg8::Unit& u) const {
        asm volatile("s_waitcnt vmcnt(0)" ::: "memory");
#ifdef HANDOFF_RELEASE
        __builtin_amdgcn_fence(__ATOMIC_RELEASE, "agent"); asm volatile("s_waitcnt vmcnt(0)" ::: "memory");
#endif
        if (olane() == 0) __hip_atomic_fetch_add(ctr + 64 * u.pm, 1u, __ATOMIC_RELAXED, __HIP_MEMORY_SCOPE_AGENT);
    }
};
struct TileOrderC : TileOrder {
    unsigned* ctr; unsigned need; unsigned* tmo; int wv;
    __device__ __forceinline__ void a_ready(const pg8::Unit& u) const {
        if (wv == 0) {
            const unsigned long long t0 = __builtin_amdgcn_s_memrealtime(); unsigned polls = 0;
            while ((unsigned)__builtin_amdgcn_readfirstlane(__hip_atomic_load(ctr + 64 * u.pm, __ATOMIC_RELAXED, __HIP_MEMORY_SCOPE_AGENT)) < need) {
                if ((++polls & 255u) == 0u && __builtin_amdgcn_readfirstlane(__hip_atomic_load(tmo, __ATOMIC_RELAXED, __HIP_MEMORY_SCOPE_AGENT)) != 0u) break;
                if (__builtin_amdgcn_s_memrealtime() - t0 > 2000000ull) { if (olane() == 0) __hip_atomic_store(tmo, 1u, __ATOMIC_RELAXED, __HIP_MEMORY_SCOPE_AGENT); break; }
                __builtin_amdgcn_s_sleep(2); }
            __builtin_amdgcn_fence(__ATOMIC_ACQUIRE, "agent");
            asm volatile("s_waitcnt vmcnt(0)" ::: "memory");
        }
        asm volatile("" ::: "memory"); __builtin_amdgcn_s_barrier(); asm volatile("" ::: "memory");
    }
};

struct MoeOrder {
    const LAS int* tab; const int* LIST; int ncol, G, c, up; const char* A; const char* W; int esz;
    __device__ __forceinline__ bool next(int i, pg8::Unit& u) const {
        const int TR = __builtin_amdgcn_readfirstlane(tab[24]);
        int rt, pn;
        if ((G & 7) == 0) { const int x = c & 7, j = c >> 3, W = G >> 3; const int lo = (TR * x) >> 3, hi = (TR * (x + 1)) >> 3; const int q = i * W + j; if (q >= (hi - lo) * ncol) return false;
            rt = lo + q / ncol; pn = q - (q / ncol) * ncol; }
        else { const int L = i * G + c; if (L >= TR * ncol) return false; rt = L / ncol; pn = L - rt * ncol; }
        int p = 0;
#pragma unroll
        for (int q = 1; q < NPAIR; ++q) p += (__builtin_amdgcn_readfirstlane(tab[q]) <= rt) ? 1 : 0;
        const int base = (rt - __builtin_amdgcn_readfirstlane(tab[p])) * 256; int valid = __builtin_amdgcn_readfirstlane(tab[32 + p]) - base; valid = valid > 256 ? 256 : valid;
        u.pm = rt; u.pn = pn; u.aux0 = p * NT + base; u.aux1 = valid; u.aux2 = p;
        const int grp = p / 6, q6 = p - grp * 6;
        const int lo = q6 < 3 ? 0 : (q6 < 5 ? 1 : 2), hi = q6 < 3 ? q6 + 1 : (q6 < 5 ? q6 - 1 : 3);
        const int ea = grp * 4 + lo, eb = grp * 4 + hi;
        if (up) { const int e = pn < 4 ? ea : eb; u.a = A; u.b = W + ((size_t)e * 1024 + (size_t)(pn & 3) * 256) * 1024 * esz; u.b2 = u.b; }
        else { u.a = A + (size_t)rt * 256 * 1024 * esz; u.b = W + ((size_t)ea * 1024 + (size_t)pn * 256) * 512 * esz; u.b2 = W + ((size_t)eb * 1024 + (size_t)pn * 256) * 512 * esz; }
        return true;
    }
    __device__ __forceinline__ unsigned gather_off(const pg8::Unit& u, int r) const { const int idx = r < u.aux1 ? r : 0; return (unsigned)LIST[u.aux0 + idx] * (unsigned)(DM * esz); }
    __device__ __forceinline__ void a_ready(const pg8::Unit&) const {}
    __device__ __forceinline__ void done(const pg8::Unit&) const {}
};

#ifdef EPI_NT_STORES
#define ST_NT(p, v) __builtin_nontemporal_store((v), (p))
#else
#define ST_NT(p, v) (*(p) = (v))
#endif
#define EPI_NOHOOK static constexpr bool HOOK = false; static constexpr int HOOK_T0 = -1, HOOK_T1 = -1; \
    __device__ __forceinline__ void hook(pg8::Acc&, const pg8::Unit&, int, int, int, int, int) const {}
#define EPI_V8(v, acc, ai, bj, m) float v[8]; { const f32x4 _a = acc[ai][bj][m][0], _b = acc[ai][bj][m][1]; v[0] = _a[0]; v[1] = _a[1]; v[2] = _a[2]; v[3] = _a[3]; v[4] = _b[0]; v[5] = _b[1]; v[6] = _b[2]; v[7] = _b[3]; }
__device__ __forceinline__ void rot4(float (&v)[8], const f32x2* cs) {
    const f32x4 c01 = *(const f32x4*)cs, c23 = *(const f32x4*)(cs + 2);
    const float c[4] = {c01[0], c01[2], c23[0], c23[2]}, s[4] = {c01[1], c01[3], c23[1], c23[3]};
#pragma unroll
    for (int k = 0; k < 4; ++k) { const float x1 = v[2 * k], x2 = v[2 * k + 1]; v[2 * k] = x1 * c[k] - x2 * s[k]; v[2 * k + 1] = x2 * c[k] + x1 * s[k]; }
}

struct EpiNone { EPI_NOHOOK
    float* sink;
    __device__ __forceinline__ void operator()(const pg8::Acc& acc, const pg8::Unit& u, int wr, int wc, int fr, int fq) const {
        float s = 0.f;
#pragma unroll
        for (int ai = 0; ai < 2; ++ai)
#pragma unroll
            for (int bj = 0; bj < 2; ++bj)
#pragma unroll
                for (int m = 0; m < 4; ++m) s += acc[ai][bj][m][0][0] + acc[ai][bj][m][1][3];
        if (s == 1.2345e33f) sink[0] = s;
    }
};
struct EpiStoreOnly { EPI_NOHOOK
    bf16_t* PG;
    __device__ __forceinline__ void operator()(const pg8::Acc& acc, const pg8::Unit& u_, int wr, int wc, int fr, int fq) const {
        pg8::Unit u = u_; asm volatile("" : "+s"(u.pm), "+s"(u.pn), "+v"(fr), "+v"(fq));
#ifdef STORE_PITCH
        const int pn12 = u.pn % 8;
#define SO_PITCH (STORE_PITCH)
#else
        const int pn12 = u.pn % 12;
#define SO_PITCH 3072
#endif
#pragma unroll
        for (int ai = 0; ai < 2; ++ai)
#pragma unroll
        for (int m = 0; m < 4; ++m) { const int row = u.pm * 256 + ai * 128 + wr * 64 + m * 16 + fr;
#pragma unroll
            for (int bj = 0; bj < 2; ++bj) { const int c0 = bj * 128 + wc * 32 + 8 * fq; EPI_V8(v, acc, ai, bj, m)
#if defined(SO_MODE) && SO_MODE == 1
                if (bj == 0)
#elif defined(SO_MODE) && SO_MODE == 2
                if (obid() & 8)
#elif defined(SO_MODE) && SO_MODE == 3
                if (obid() & 1)
#endif
                *(u32x4*)(PG + (size_t)row * SO_PITCH + pn12 * 256 + c0) = pack8(v); } }
    }
};
struct EpiGate {
    EPI_NOHOOK
    bf16_t* PG;
    __device__ __forceinline__ void operator()(const pg8::Acc& acc, const pg8::Unit& u_, int wr, int wc, int fr, int fq) const {
        pg8::Unit u = u_; asm volatile("" : "+s"(u.pm), "+s"(u.pn), "+v"(fr), "+v"(fq));
#pragma unroll
        for (int ai = 0; ai < 2; ++ai)
#pragma unroll
        for (int m = 0; m < 4; ++m) { const int row = u.pm * 256 + ai * 128 + wr * 64 + m * 16 + fr;
#pragma unroll
            for (int bj = 0; bj < 2; ++bj) { const int c0 = bj * 128 + wc * 32 + 8 * fq;
                EPI_V8(v, acc, ai, bj, m)
                float g[8];
#pragma unroll
#ifdef GATE_U8
                for (int k = 0; k < 8; ++k) g[k] = 255.f * __builtin_amdgcn_rcpf(1.f + __builtin_amdgcn_exp2f(-fmaxf(v[k], -7.98868f)));
                u32x2 w = {0u, 0u};
                w.x = __builtin_amdgcn_cvt_pk_u8_f32(g[0], 0, w.x); w.x = __builtin_amdgcn_cvt_pk_u8_f32(g[1], 1, w.x); w.x = __builtin_amdgcn_cvt_pk_u8_f32(g[2], 2, w.x); w.x = __builtin_amdgcn_cvt_pk_u8_f32(g[3], 3, w.x);
                w.y = __builtin_amdgcn_cvt_pk_u8_f32(g[4], 0, w.y); w.y = __builtin_amdgcn_cvt_pk_u8_f32(g[5], 1, w.y); w.y = __builtin_amdgcn_cvt_pk_u8_f32(g[6], 2, w.y); w.y = __builtin_amdgcn_cvt_pk_u8_f32(g[7], 3, w.y);
                *(u32x2*)((unsigned char*)PG + (size_t)row * 3072 + u.pn * 256 + c0) = w; } }
#else
                for (int k = 0; k < 8; ++k) g[k] = __builtin_amdgcn_rcpf(1.f + __builtin_amdgcn_exp2f(-fmaxf(v[k], -15.f * 1.4426950408889634f)));
                *(u32x4*)(PG + (size_t)row * 3072 + u.pn * 256 + c0) = pack8(g); } }
#endif
    }
};
struct EpiInproj {
    EPI_NOHOOK
    bf16_t *PR, *PC, *PM, *PG; unsigned char* KB; float* SSQ; const f32x2* RT; const f32x2* MT; int pn_off;
    __device__ __forceinline__ void operator()(const pg8::Acc& acc, const pg8::Unit& u_, int wr, int wc, int fr, int fq) const {
        pg8::Unit u = u_; asm volatile("" : "+s"(u.pm), "+s"(u.pn), "+s"(u.aux0), "+s"(u.aux1), "+v"(fr), "+v"(fq));
        const int pn = u.pn + pn_off;
#pragma unroll
        for (int ai = 0; ai < 2; ++ai)
#pragma unroll
        for (int m = 0; m < 4; ++m) { __builtin_amdgcn_sched_barrier(0);
            const int row = u.pm * 256 + ai * 128 + wr * 64 + m * 16 + fr;
            const int bl = row / SB, s = row - bl * SB; const bool lat = s >= CTXL; const int t = lat ? s - CTXL : 0;
            float ss[2] = {0.f, 0.f};
#pragma unroll
            for (int bj = 0; bj < 2; ++bj) {
                const int c0 = bj * 128 + wc * 32 + 8 * fq;
                EPI_V8(v, acc, ai, bj, m)
                if (pn <= 1) {
                    if (lat) rot4(v, RT + (size_t)t * 32 + ((c0 & 63) >> 1));
                    if (pn == 1) {
#pragma unroll
                        for (int k = 0; k < 8; ++k) v[k] *= 0.125f;
                    }
                    *(u32x4*)(PR + (size_t)row * 1536 + pn * 256 + c0) = pack8(v);
                } else if (pn <= 5) {
                    *(u32x4*)(PR + (size_t)row * 1536 + pn * 256 + c0) = pack8(v);
                } else if (pn <= 7) {
                    *(u32x4*)(PC + (size_t)row * 1024 + (pn - 6) * 256 + c0) = pack8(v);
                } else if (pn <= 11) {
                    u32x2 w; w.x = cvtpk(v[0] * v[1], v[2] * v[3]); w.y = cvtpk(v[4] * v[5], v[6] * v[7]);
                    *(u32x2*)(PC + (size_t)row * 1024 + 512 + (pn - 8) * 128 + (c0 >> 1)) = w;
                } else if (pn <= 14) {
                    if (pn == 14 && bj == 1) {
                        if (wc == 0) {
                            if (lat) { const int a = fq >> 1, pos = a ? (t & 63) : (t >> 6); rot4(v, MT + pos * 8 + (fq & 1) * 4); }
#pragma unroll
                            for (int k = 0; k < 8; ++k) v[k] *= K8S;
                            const u32x2 w = pack8_fp8(v);
#pragma unroll
                            for (int hh = 0; hh < 8; ++hh) { unsigned char* kp = KB + ((size_t)(bl * 8 + hh) * SB + s) * 128;
                                *(u32x2*)(kp + 64 + 8 * fq) = w; if (fq == 3) { *(u32x4*)(kp + 96) = (u32x4){0u, 0u, 0u, 0u}; *(u32x4*)(kp + 112) = (u32x4){0u, 0u, 0u, 0u}; } }
                        }
                    } else {
                        *(u32x4*)(PM + (size_t)row * 640 + (pn - 12) * 256 + c0) = pack8(v);
                        float q = 0.f;
#pragma unroll
                        for (int k = 0; k < 8; ++k) q += v[k] * v[k];
                        ss[bj] = q;
                    }
                } else {
                    float g[8];
#pragma unroll
                    for (int k = 0; k < 8; ++k) g[k] = sigmoid_fast(fmaxf(v[k], -15.f));
                    ST_NT((u32x4*)(PG + (size_t)row * 3072 + (pn - 15) * 256 + c0), pack8(g));
                }
            }
            if (pn >= 12 && pn <= 14) {
                float a = ss[0], b = ss[1];
                a += swz_xor<16>(a); a = half_sum(a); b += swz_xor<16>(b); b = half_sum(b);
                if (fq == 0) {
                    float* sq = SSQ + (size_t)row * 16;
                    if (pn == 12) sq[wc] = a + b;
                    else if (pn == 13) { sq[4 + wc] = a; sq[8 + wc] = b; }
                    else sq[12 + wc] = a;
                }
            }
        }
    }
};

#define EPI_ROW(ai, m) (u.pm * 256 + (ai) * 128 + wr * 64 + (m) * 16 + fr)
#define EPI_OPAQUE pg8::Unit u = u_; asm volatile("" : "+s"(u.pm), "+s"(u.pn), "+s"(u.aux0), "+s"(u.aux1), "+v"(fr), "+v"(fq));
struct EpiUq {
    EPI_NOHOOK
    unsigned char* QB; const float* SSQ; const f32x2* MT;
    __device__ __forceinline__ void operator()(const pg8::Acc& acc, const pg8::Unit& u_, int wr, int wc, int fr, int fq) const {
        EPI_OPAQUE
        f32x4 q0[2][4], q1[2][4];
#pragma unroll
        for (int ai = 0; ai < 2; ++ai)
#pragma unroll
            for (int m = 0; m < 4; ++m) { const float* sq = SSQ + (size_t)EPI_ROW(ai, m) * 16; q0[ai][m] = *(const f32x4*)sq; q1[ai][m] = *(const f32x4*)(sq + 4); }
#pragma unroll
        for (int ai = 0; ai < 2; ++ai)
#pragma unroll
        for (int m = 0; m < 4; ++m) {
            const int row = EPI_ROW(ai, m);
            const int bl = row / SB, s = row - bl * SB; const bool lat = s >= CTXL; const int t = lat ? s - CTXL : 0;
            const f32x4 a = q0[ai][m], b = q1[ai][m];
            const float ssq = ((a[0] + a[1]) + (a[2] + a[3])) + ((b[0] + b[1]) + (b[2] + b[3]));
            const float rq = rsqrtf(ssq * (1.f / 384.f) + RMS_EPS) * (QSCALE * Q8S);
#pragma unroll
            for (int bj = 0; bj < 2; ++bj) {
                const int cg = u.pn * 256 + bj * 128 + wc * 32 + 8 * fq; const int h = cg / 96, d0 = cg - h * 96;
                EPI_V8(v, acc, ai, bj, m)
#pragma unroll
                for (int k = 0; k < 8; ++k) v[k] *= rq;
                if (d0 >= 64 && lat) { const int p0 = d0 - 64, aa = p0 >> 4, pos = aa ? (t & 63) : (t >> 6); rot4(v, MT + pos * 8 + ((p0 & 15) >> 1)); }
                unsigned char* qp = QB + ((size_t)(bl * 8 + h) * SB + s) * 128;
                *(u32x2*)(qp + d0) = pack8_fp8(v);
                if (d0 == 88) { *(u32x4*)(qp + 96) = (u32x4){0u, 0u, 0u, 0u}; *(u32x4*)(qp + 112) = (u32x4){0u, 0u, 0u, 0u}; }
            }
        }
    }
};
struct EpiUkv {
    EPI_NOHOOK
    unsigned char* KB; unsigned char* VT; const float* SSQ; LAS unsigned char* tr;
    __device__ __forceinline__ void operator()(const pg8::Acc& acc, const pg8::Unit& u_, int wr, int wc, int fr, int fq) const {
        EPI_OPAQUE
        f32x4 q0[2][4], q1[2][4];
#pragma unroll
        for (int ai = 0; ai < 2; ++ai)
#pragma unroll
            for (int m = 0; m < 4; ++m) { const float* sq = SSQ + (size_t)EPI_ROW(ai, m) * 16 + 8; q0[ai][m] = *(const f32x4*)sq; q1[ai][m] = *(const f32x4*)(sq + 4); }
        LAS unsigned char* my = tr + (wr * 2 + (wc & 1)) * 2048;
        const int lane = fr + 16 * fq;
#pragma unroll
        for (int ai = 0; ai < 2; ++ai) {
            const int row0 = u.pm * 256 + ai * 128 + wr * 64;
            const int bl = row0 / SB, s0 = row0 - bl * SB;
#pragma unroll
            for (int bj = 0; bj < 2; ++bj) {
                const int h = u.pn * 2 + bj;
#pragma unroll
                for (int m = 0; m < 4; ++m) {
                    const f32x4 a = q0[ai][m], b = q1[ai][m];
                    const float ssq = ((a[0] + a[1]) + (a[2] + a[3])) + ((b[0] + b[1]) + (b[2] + b[3]));
                    const float rk = rsqrtf(ssq * (1.f / 256.f) + RMS_EPS);
                    EPI_V8(v, acc, ai, bj, m)
                    if (wc < 2) {
#pragma unroll
                        for (int k = 0; k < 8; ++k) v[k] *= rk * K8S;
                        *(u32x2*)(KB + ((size_t)(bl * 8 + h) * SB + s0 + 16 * m + fr) * 128 + wc * 32 + 8 * fq) = pack8_fp8(v);
                    } else {
#pragma unroll
                        for (int k = 0; k < 8; ++k) v[k] *= rk * V8S;
                        const u32x2 w = pack8_fp8(v); const int pos = vt_pos(16 * m + fr) ^ (16 * fq);
#pragma unroll
                        for (int k = 0; k < 4; ++k) { my[(8 * fq + k) * 64 + pos] = (unsigned char)(w.x >> (8 * k)); my[(8 * fq + 4 + k) * 64 + pos] = (unsigned char)(w.y >> (8 * k)); }
                    }
                }
                if (wc >= 2) {
#pragma unroll
                    for (int i = 0; i < 2; ++i) { const int ch = lane + 64 * i, d = ch >> 2, c16 = ch & 3;
                        const u32x4 x = *(const LAS u32x4*)(my + d * 64 + ((c16 ^ ((d >> 3) & 3)) * 16));
                        *(u32x4*)(VT + ((size_t)(bl * 8 + h) * 64 + (wc - 2) * 32 + d) * SB + s0 + c16 * 16) = x; }
                }
            }
        }
    }
};

struct EpiMerge1 {
    static constexpr bool HOOK = true; static constexpr int HOOK_T0 = 8, HOOK_T1 = 16;
    const bf16_t* PG; bf16_t* M;
    __device__ __forceinline__ void hook(pg8::Acc& acc, const pg8::Unit& u_, int t, int wr, int wc, int fr, int fq) const {
        pg8::Unit u = u_; asm volatile("" : "+s"(u.pm), "+s"(u.pn), "+v"(fr), "+v"(fq));
        const int gi = (t == 8) ? 0 : 1;
#pragma unroll
        for (int ai = 0; ai < 2; ++ai) {
#ifdef GATE_U8
            u32x2 sp[4][2], sn[4][2];
#pragma unroll
            for (int m = 0; m < 4; ++m)
#pragma unroll
                for (int bj = 0; bj < 2; ++bj) { const unsigned char* p = (const unsigned char*)PG + (size_t)EPI_ROW(ai, m) * 3072 + gi * 1024 + u.pn * 256 + bj * 128 + wc * 32 + 8 * fq;
                    sp[m][bj] = *(const u32x2*)p; sn[m][bj] = *(const u32x2*)(p + 1024); }
#else
            u32x4 sp[4][2], sn[4][2];
#pragma unroll
            for (int m = 0; m < 4; ++m)
#pragma unroll
                for (int bj = 0; bj < 2; ++bj) { const bf16_t* p = PG + (size_t)EPI_ROW(ai, m) * 3072 + gi * 1024 + u.pn * 256 + bj * 128 + wc * 32 + 8 * fq;
                    sp[m][bj] = *(const u32x4*)p; sn[m][bj] = *(const u32x4*)(p + 1024); }
#endif
#pragma unroll
            for (int m = 0; m < 4; ++m)
#pragma unroll
                for (int bj = 0; bj < 2; ++bj) {
#ifdef GATE_U8
                    float a[8], b[8]; unpack8_u8(sp[m][bj], a); unpack8_u8(sn[m][bj], b);
#else
                    float a[8], b[8]; unpack8(sp[m][bj], a); unpack8(sn[m][bj], b);
#endif
                    f32x4 r0, r1;
#pragma unroll
                    for (int k = 0; k < 4; ++k) { r0[k] = a[k] * __builtin_amdgcn_rcpf(b[k]); r1[k] = a[4 + k] * __builtin_amdgcn_rcpf(b[4 + k]); }
                    acc[ai][bj][m][0] *= r0; acc[ai][bj][m][1] *= r1;
                }
            __builtin_amdgcn_sched_barrier(0);
        }
    }
    __device__ __forceinline__ void operator()(const pg8::Acc& acc, const pg8::Unit& u_, int wr, int wc, int fr, int fq) const {
        EPI_OPAQUE
        const __amdgpu_buffer_rsrc_t rsrc = __builtin_amdgcn_make_buffer_rsrc((void*)M, 0, (int)((size_t)NT * 1024 * 2), 0x00020000);
#pragma unroll
        for (int ai = 0; ai < 2; ++ai) {
#ifdef GATE_U8
            u32x2 s2[4][2];
#pragma unroll
            for (int m = 0; m < 4; ++m)
#pragma unroll
                for (int bj = 0; bj < 2; ++bj) s2[m][bj] = *(const u32x2*)((const unsigned char*)PG + (size_t)EPI_ROW(ai, m) * 3072 + 2048 + u.pn * 256 + bj * 128 + wc * 32 + 8 * fq);
#else
            u32x4 s2[4][2];
#pragma unroll
            for (int m = 0; m < 4; ++m)
#pragma unroll
                for (int bj = 0; bj < 2; ++bj) s2[m][bj] = *(const u32x4*)(PG + (size_t)EPI_ROW(ai, m) * 3072 + 2048 + u.pn * 256 + bj * 128 + wc * 32 + 8 * fq);
#endif
#pragma unroll
            for (int m = 0; m < 4; ++m)
#pragma unroll
                for (int bj = 0; bj < 2; ++bj) {
                    const int cg = u.pn * 256 + bj * 128 + wc * 32 + 8 * fq;
#ifdef GATE_U8
                    float g[8]; unpack8_u8(s2[m][bj], g);
                    EPI_V8(v, acc, ai, bj, m)
#pragma unroll
                    for (int k = 0; k < 8; ++k) v[k] *= g[k] * (1.f / 255.f);
#else
                    float g[8]; unpack8(s2[m][bj], g);
                    EPI_V8(v, acc, ai, bj, m)
#pragma unroll
                    for (int k = 0; k < 8; ++k) v[k] *= g[k];
#endif
#ifndef HANDOFF
                    *(u32x4*)(M + (size_t)EPI_ROW(ai, m) * 1024 + cg) = pack8(v);
#else
                    __builtin_amdgcn_raw_buffer_store_b128(pack8(v), rsrc, (unsigned)(((size_t)EPI_ROW(ai, m) * 1024 + cg) * 2), 0, 16);
#endif
                }
            __builtin_amdgcn_sched_barrier(0);
        }
    }
};

struct EpiMerge1NoHook : EpiMerge1 { static constexpr bool HOOK = false; };
struct EpiMerge1HookOnly { static constexpr bool HOOK = true; static constexpr int HOOK_T0 = 8, HOOK_T1 = 16; EpiMerge1 e; float* sink;
    __device__ __forceinline__ void hook(pg8::Acc& acc, const pg8::Unit& u, int t, int wr, int wc, int fr, int fq) const { e.hook(acc, u, t, wr, wc, fr, fq); }
    __device__ __forceinline__ void operator()(const pg8::Acc& acc, const pg8::Unit& u, int wr, int wc, int fr, int fq) const { EpiNone n{sink}; n(acc, u, wr, wc, fr, fq); }
};
struct EpiMerge2 {
    EPI_NOHOOK
    Resid R; const float* MODL;
    __device__ __forceinline__ void operator()(const pg8::Acc& acc, const pg8::Unit& u_, int wr, int wc, int fr, int fq) const {
        EPI_OPAQUE
        const int cb = u.pn * 256 + wc * 32 + 8 * fq;
        const float* g1 = MODL + R.modv(u.pm * 256) * 6144 + 2048 + cb;
        f32x4 g[2][2];
#pragma unroll
        for (int bj = 0; bj < 2; ++bj)
#pragma unroll
            for (int n = 0; n < 2; ++n) g[bj][n] = *(const f32x4*)(g1 + bj * 128 + 4 * n);
        int sf32 = R.src_f32; asm volatile("" : "+s"(sf32));
#pragma unroll
        for (int ai = 0; ai < 2; ++ai) {
            if (sf32) {
#pragma unroll
                for (int mh = 0; mh < 2; ++mh) {
                    f32x4 x[2][2][2];
#pragma unroll
                    for (int m2 = 0; m2 < 2; ++m2) { const float* src = R.srcf(EPI_ROW(ai, 2 * mh + m2)) + cb;
#pragma unroll
                        for (int bj = 0; bj < 2; ++bj)
#pragma unroll
                            for (int n = 0; n < 2; ++n) x[m2][bj][n] = *(const f32x4*)(src + bj * 128 + 4 * n); }
#pragma unroll
                    for (int m2 = 0; m2 < 2; ++m2) { const int m = 2 * mh + m2; bf16_t* dst = R.dst(EPI_ROW(ai, m)) + cb;
#pragma unroll
                        for (int bj = 0; bj < 2; ++bj) { const f32x4 a = x[m2][bj][0] + g[bj][0] * acc[ai][bj][m][0], b = x[m2][bj][1] + g[bj][1] * acc[ai][bj][m][1];
                            u32x4 w; w.x = cvtpk(a[0], a[1]); w.y = cvtpk(a[2], a[3]); w.z = cvtpk(b[0], b[1]); w.w = cvtpk(b[2], b[3]); *(u32x4*)(dst + bj * 128) = w; } }
                }
            } else {
                u32x4 x[4][2];
#pragma unroll
                for (int m = 0; m < 4; ++m) { const bf16_t* src = R.dst(EPI_ROW(ai, m)) + cb;
#pragma unroll
                    for (int bj = 0; bj < 2; ++bj) x[m][bj] = *(const u32x4*)(src + bj * 128); }
#pragma unroll
                for (int m = 0; m < 4; ++m) { bf16_t* dst = R.dst(EPI_ROW(ai, m)) + cb;
#pragma unroll
                    for (int bj = 0; bj < 2; ++bj) { float f[8]; unpack8(x[m][bj], f);
                        const f32x4 a = (f32x4){f[0], f[1], f[2], f[3]} + g[bj][0] * acc[ai][bj][m][0], b = (f32x4){f[4], f[5], f[6], f[7]} + g[bj][1] * acc[ai][bj][m][1];
                        u32x4 w; w.x = cvtpk(a[0], a[1]); w.y = cvtpk(a[2], a[3]); w.z = cvtpk(b[0], b[1]); w.w = cvtpk(b[2], b[3]); *(u32x4*)(dst + bj * 128) = w; } }
            }
            __builtin_amdgcn_sched_barrier(0);
        }
    }
};

struct EpiMoeUp {
    EPI_NOHOOK
    const int* LIST; const float* WGT; bf16_t* MACT;
    __device__ __forceinline__ void operator()(const pg8::Acc& acc, const pg8::Unit& u_, int wr, int wc, int fr, int fq) const {
        EPI_OPAQUE
        const int slot = u.pn >> 2;
        int tok[2][4]; float w[2][4];
#pragma unroll
        for (int ai = 0; ai < 2; ++ai)
#pragma unroll
            for (int m = 0; m < 4; ++m) { const int ri = ai * 128 + wr * 64 + m * 16 + fr; tok[ai][m] = LIST[u.aux0 + (ri < u.aux1 ? ri : 0)]; }
#pragma unroll
        for (int ai = 0; ai < 2; ++ai)
#pragma unroll
            for (int m = 0; m < 4; ++m) w[ai][m] = WGT[(size_t)tok[ai][m] * 2 + slot];
#pragma unroll
        for (int ai = 0; ai < 2; ++ai)
#pragma unroll
        for (int m = 0; m < 4; ++m) {
            const int ri = ai * 128 + wr * 64 + m * 16 + fr; const float ww = w[ai][m];
#pragma unroll
            for (int bj = 0; bj < 2; ++bj) {
                const int c0 = bj * 128 + wc * 32 + 8 * fq;
                EPI_V8(v, acc, ai, bj, m)
                u32x2 o; o.x = cvtpk(silu_fast(v[0]) * v[1] * ww, silu_fast(v[2]) * v[3] * ww); o.y = cvtpk(silu_fast(v[4]) * v[5] * ww, silu_fast(v[6]) * v[7] * ww);
                *(u32x2*)(MACT + (size_t)(u.pm * 256 + ri) * 1024 + slot * 512 + (u.pn & 3) * 128 + (c0 >> 1)) = o;
            }
        }
    }
};
struct EpiMoeUp8 {
    EPI_NOHOOK
    const int* LIST; const float* WGT; unsigned char* MACT;
    __device__ __forceinline__ void operator()(const pg8::Acc& acc, const pg8::Unit& u_, int wr, int wc, int fr, int fq) const {
        EPI_OPAQUE
        const int slot = u.pn >> 2;
        int tok[2][4]; float w[2][4];
#pragma unroll
        for (int ai = 0; ai < 2; ++ai)
#pragma unroll
            for (int m = 0; m < 4; ++m) { const int ri = ai * 128 + wr * 64 + m * 16 + fr; tok[ai][m] = LIST[u.aux0 + (ri < u.aux1 ? ri : 0)]; }
#pragma unroll
        for (int ai = 0; ai < 2; ++ai)
#pragma unroll
            for (int m = 0; m < 4; ++m) w[ai][m] = WGT[(size_t)tok[ai][m] * 2 + slot] * MA8S;
#pragma unroll
        for (int ai = 0; ai < 2; ++ai)
#pragma unroll
        for (int m = 0; m < 4; ++m) {
            const int ri = ai * 128 + wr * 64 + m * 16 + fr; const float ww = w[ai][m];
#pragma unroll
            for (int bj = 0; bj < 2; ++bj) {
                const int c0 = bj * 128 + wc * 32 + 8 * fq;
                EPI_V8(v, acc, ai, bj, m)
                int o = __builtin_amdgcn_cvt_pk_fp8_f32(silu_fast(v[0]) * v[1] * ww, silu_fast(v[2]) * v[3] * ww, 0, false); o = __builtin_amdgcn_cvt_pk_fp8_f32(silu_fast(v[4]) * v[5] * ww, silu_fast(v[6]) * v[7] * ww, o, true);
                *(int*)(MACT + (size_t)(u.pm * 256 + ri) * 1024 + slot * 512 + (u.pn & 3) * 128 + (c0 >> 1)) = o;
            }
        }
    }
};
struct EpiMoeDown {
    EPI_NOHOOK
    const int* LIST; Resid R; const float* MODL; bf16_t* dry;
    __device__ __forceinline__ void operator()(const pg8::Acc& acc, const pg8::Unit& u_, int wr, int wc, int fr, int fq) const {
        EPI_OPAQUE
        int tok[2][4];
#pragma unroll
        for (int ai = 0; ai < 2; ++ai)
#pragma unroll
            for (int m = 0; m < 4; ++m) { const int ri = ai * 128 + wr * 64 + m * 16 + fr; tok[ai][m] = LIST[u.aux0 + (ri < u.aux1 ? ri : 0)]; }
        const int cb = u.pn * 256 + wc * 32 + 8 * fq;
#pragma unroll
        for (int ai = 0; ai < 2; ++ai) {
            u32x4 x[4][2];
#pragma unroll
            for (int m = 0; m < 4; ++m) { const bf16_t* dst = R.dst(tok[ai][m]) + cb;
#pragma unroll
                for (int bj = 0; bj < 2; ++bj) x[m][bj] = *(const u32x4*)(dst + bj * 128); }
#pragma unroll
            for (int m = 0; m < 4; ++m) { const int ri = ai * 128 + wr * 64 + m * 16 + fr;
                if (ri < u.aux1) {
                    bf16_t* dst = R.dst(tok[ai][m]) + cb; const float* g2 = MODL + R.modv(tok[ai][m]) * 6144 + 5120 + cb;
#pragma unroll
                    for (int bj = 0; bj < 2; ++bj) { float f[8]; unpack8(x[m][bj], f);
                        const f32x4 ga = *(const f32x4*)(g2 + bj * 128), gb = *(const f32x4*)(g2 + bj * 128 + 4);
                        const f32x4 a = (f32x4){f[0], f[1], f[2], f[3]} + ga * acc[ai][bj][m][0], b = (f32x4){f[4], f[5], f[6], f[7]} + gb * acc[ai][bj][m][1];
                        u32x4 w; w.x = cvtpk(a[0], a[1]); w.y = cvtpk(a[2], a[3]); w.z = cvtpk(b[0], b[1]); w.w = cvtpk(b[2], b[3]);
                        bf16_t* o = dry ? dry + (size_t)(u.pm * 256 + ri) * 1024 + cb + bj * 128 : dst + bj * 128;
                        *(u32x4*)o = w; }
                } }
            __builtin_amdgcn_sched_barrier(0);
        }
    }
};
#define SBAR() __builtin_amdgcn_sched_barrier(0)
__device__ __forceinline__ int crow(int r, int hi) { return (r & 3) + 8 * (r >> 2) + 4 * hi; }
template <int NCB> __device__ __forceinline__ int v_st(int k, int c) { const int kk = (k & ~0xC) | ((k & 4) << 1) | ((k & 8) >> 1); return ((kk >> 3) * NCB + (c >> 5)) * 512 + ((kk & 7) * 32 + (c & 31)) * 2; }
__device__ __forceinline__ int v_rd_base(int lane) { return ((lane & 3) << 3) | (((lane >> 2) & 3) << 6) | (((lane >> 4) & 1) << 5) | (((lane >> 5) & 1) << 8); }
template <int OFF> __device__ __forceinline__ s16x4 tr_read(int vb) { s16x4 r; asm volatile("ds_read_b64_tr_b16 %0, %1 offset:%2" : "=&v"(r) : "v"(vb), "i"(OFF) : "memory"); return r; }
#define PKLH(L, H) (bf16x8){L[0], L[1], L[2], L[3], H[0], H[1], H[2], H[3]}
template <int NCB, int KS> __device__ __forceinline__ bf16x8 tr_frag(int vb) { const s16x4 l = tr_read<KS * NCB * 1024>(vb), h = tr_read<KS * NCB * 1024 + NCB * 512>(vb); return PKLH(l, h); }
#define PK4(P, BASE, OUT) do { const unsigned a0 = cvtpk(P[BASE + 0], P[BASE + 1]), a1 = cvtpk(P[BASE + 2], P[BASE + 3]);   \
    const unsigned b0 = cvtpk(P[BASE + 4], P[BASE + 5]), b1 = cvtpk(P[BASE + 6], P[BASE + 7]);                              \
    auto r0 = __builtin_amdgcn_permlane32_swap(a0, b0, false, false); auto r1 = __builtin_amdgcn_permlane32_swap(a1, b1, false, false); \
    u32x4 w = {r0[0], r1[0], r0[1], r1[1]}; OUT = __builtin_bit_cast(bf16x8, w); } while (0)

namespace att {
constexpr int DQK = 96, DV = 64, KVBLK = 64;
constexpr int SHM_V = KVBLK * DV * 2;
constexpr int SHM_K = KVBLK * 256;
constexpr float THR = 8.f;
#define KSWZ(row, colB) ((row) * 256 + ((colB) ^ (((row) & 7) << 4)))
__device__ __forceinline__ void partialSM(f32x16& p0, f32x16& p1, float& m_reg, float& alpha) {
    float pmax = p0[0];
#pragma unroll
    for (int r = 1; r < 16; ++r) pmax = fmaxf(pmax, p0[r]);
#pragma unroll
    for (int r = 0; r < 16; ++r) pmax = fmaxf(pmax, p1[r]);
    { auto rr = __builtin_amdgcn_permlane32_swap(__float_as_uint(pmax), __float_as_uint(pmax), false, false);
      pmax = fmaxf(__uint_as_float(rr[0]), __uint_as_float(rr[1])); }
    float mn;
    if (__builtin_expect(__all(pmax - m_reg <= THR), 1)) { mn = m_reg; alpha = 1.f; }
    else { mn = fmaxf(m_reg, pmax); alpha = __builtin_amdgcn_exp2f(m_reg - mn); m_reg = mn; }
#pragma unroll
    for (int r = 0; r < 16; ++r) p0[r] = p0[r] - mn;
#pragma unroll
    for (int r = 0; r < 16; ++r) p1[r] = p1[r] - mn;
#pragma unroll
    for (int r = 0; r < 16; ++r) p0[r] = __builtin_amdgcn_exp2f(p0[r]);
}
__device__ __forceinline__ void finishSM(f32x16& p0, f32x16& p1, float alpha, float& l_reg, bf16x8& pa0, bf16x8& pa1, bf16x8& pa2, bf16x8& pa3) {
#pragma unroll
    for (int r = 0; r < 16; ++r) p1[r] = __builtin_amdgcn_exp2f(p1[r]);
    float ps = 0;
#pragma unroll
    for (int r = 0; r < 16; ++r) ps += p0[r];
#pragma unroll
    for (int r = 0; r < 16; ++r) ps += p1[r];
    { auto rr = __builtin_amdgcn_permlane32_swap(__float_as_uint(ps), __float_as_uint(ps), false, false);
      ps = __uint_as_float(rr[0]) + __uint_as_float(rr[1]); }
    l_reg = l_reg * alpha + ps;
    PK4(p0, 0, pa0); PK4(p0, 8, pa1); PK4(p1, 0, pa2); PK4(p1, 8, pa3);
}
__device__ __forceinline__ void qkt(f32x16& p0, f32x16& p1, const LAS char* Ks, const bf16x8* qr, int r32, int hi) {
    p0 = f32x16{}; p1 = f32x16{};
#pragma unroll
    for (int d0 = 0; d0 < 6; ++d0) { const int cb = (d0 * 16 + hi * 8) * 2;
        const bf16x8 b0 = *(const LAS bf16x8*)(Ks + KSWZ(r32, cb));
        const bf16x8 b1 = *(const LAS bf16x8*)(Ks + KSWZ(32 + r32, cb));
        p0 = __builtin_amdgcn_mfma_f32_32x32x16_bf16(b0, qr[d0], p0, 0, 0, 0);
        p1 = __builtin_amdgcn_mfma_f32_32x32x16_bf16(b1, qr[d0], p1, 0, 0, 0); }
}
template <int D0> __device__ __forceinline__ void pv_one(f32x16& od, int vb, bf16x8 pa0, bf16x8 pa1, bf16x8 pa2, bf16x8 pa3) {
    const bf16x8 f0 = tr_frag<2, 0>(vb + D0 * 512), f1 = tr_frag<2, 1>(vb + D0 * 512), f2 = tr_frag<2, 2>(vb + D0 * 512), f3 = tr_frag<2, 3>(vb + D0 * 512);
    asm volatile("s_waitcnt lgkmcnt(0)" ::: "memory"); SBAR();
    od = __builtin_amdgcn_mfma_f32_32x32x16_bf16(pa0, f0, od, 0, 0, 0);
    od = __builtin_amdgcn_mfma_f32_32x32x16_bf16(pa1, f1, od, 0, 0, 0);
    od = __builtin_amdgcn_mfma_f32_32x32x16_bf16(pa2, f2, od, 0, 0, 0);
    od = __builtin_amdgcn_mfma_f32_32x32x16_bf16(pa3, f3, od, 0, 0, 0);
}
__device__ __forceinline__ void pv_d0(f32x16* o, int vb, bf16x8 pa0, bf16x8 pa1, bf16x8 pa2, bf16x8 pa3) {
    pv_one<0>(o[0], vb, pa0, pa1, pa2, pa3); pv_one<1>(o[1], vb, pa0, pa1, pa2, pa3);
}
__device__ __forceinline__ void attn_unit(const bf16_t* __restrict__ Qb, const bf16_t* __restrict__ Kh, const bf16_t* __restrict__ Vh, bf16_t* __restrict__ Ob, int ldo, int seq, LAS char* lds, const int wv) {
    const int tid = otid(wv), wid = __builtin_amdgcn_readfirstlane(tid >> 6), lane = tid & 63, r32 = lane & 31, hi = lane >> 5;
    LAS char* V_lds = lds; LAS char* K_lds = lds + 2 * SHM_V;
    LAS float* ws = (LAS float*)(lds + 2 * SHM_V + 2 * SHM_K) + wid * 64; LAS float* li_l = ws; LAS float* al_l = ws + 32;
    float m_reg = -1e30f, l_reg = 0; f32x16 o[2] = {}; bf16x8 qr[6];
    const bf16_t* Qw = Qb + (size_t)(wid * 32 + r32) * DQK + hi * 8;
#pragma unroll
    for (int d0 = 0; d0 < 6; ++d0) qr[d0] = *(const bf16x8*)(Qw + d0 * 16);
    const int vrow = tid >> 3, vc = (tid & 7) * 8, vst = v_st<2>(vrow, vc);
    const int krA = tid / 12, kcA = tid - krA * 12, sB = 512 + tid, krB = sB / 12, kcB = sB - krB * 12;
    const int kstA = KSWZ(krA, kcA * 16), kstB = KSWZ(krB, kcB * 16);
    const bool hasB = wid < 4;
    const int vb0 = (int)(size_t)V_lds + v_rd_base(lane);
    struct { bf16x8 v, ka, kb; } sr_[2];
#define SLOAD(i, k0) do { sr_[i].v = *(const bf16x8*)(Vh + (size_t)((k0) + vrow) * DV + vc); sr_[i].ka = *(const bf16x8*)(Kh + (size_t)((k0) + krA) * DQK + kcA * 8); \
    if (hasB) sr_[i].kb = *(const bf16x8*)(Kh + (size_t)((k0) + krB) * DQK + kcB * 8); } while (0)
#define SWRITE(b, i) do { *(LAS bf16x8*)(V_lds + (b) * SHM_V + vst) = sr_[i].v; *(LAS bf16x8*)(K_lds + (b) * SHM_K + kstA) = sr_[i].ka; \
    if (hasB) *(LAS bf16x8*)(K_lds + (b) * SHM_K + kstB) = sr_[i].kb; } while (0)
#define RESC(a) do { if (__any((a) < 1.f)) { if (hi == 0) al_l[r32] = (a); asm volatile("s_waitcnt lgkmcnt(0)" ::: "memory"); \
    _Pragma("unroll") for (int d = 0; d < 2; ++d) _Pragma("unroll") for (int r = 0; r < 16; ++r) o[d][r] *= al_l[crow(r, hi)]; } } while (0)
    f32x16 pA0, pA1, pB0, pB1; float alA, alB; bf16x8 pa0, pa1, pa2, pa3; const int NTL = seq / KVBLK;
    SLOAD(0, 0); SWRITE(0, 0); __syncthreads();
    qkt(pA0, pA1, K_lds, qr, r32, hi); partialSM(pA0, pA1, m_reg, alA);
    SLOAD(1, KVBLK); if (2 < NTL) SLOAD(0, 2 * KVBLK);
    SWRITE(1, 1); __syncthreads();
    for (int j = 1; j + 1 < NTL; j += 2) {
        SBAR(); qkt(pB0, pB1, K_lds + SHM_K, qr, r32, hi);
        finishSM(pA0, pA1, alA, l_reg, pa0, pa1, pa2, pa3); SBAR();
        SLOAD(1, (j + 2) * KVBLK); SBAR();
        pv_d0(o, vb0, pa0, pa1, pa2, pa3); partialSM(pB0, pB1, m_reg, alB);
        __syncthreads(); SWRITE(0, 0);
        RESC(alB); __syncthreads();
        SBAR(); qkt(pA0, pA1, K_lds, qr, r32, hi);
        finishSM(pB0, pB1, alB, l_reg, pa0, pa1, pa2, pa3); SBAR();
        if (j + 3 < NTL) SLOAD(0, (j + 3) * KVBLK); SBAR();
        pv_d0(o, vb0 + SHM_V, pa0, pa1, pa2, pa3); partialSM(pA0, pA1, m_reg, alA);
        __syncthreads(); SWRITE(1, 1);
        RESC(alA); __syncthreads();
    }
    SBAR(); qkt(pB0, pB1, K_lds + SHM_K, qr, r32, hi);
    finishSM(pA0, pA1, alA, l_reg, pa0, pa1, pa2, pa3); SBAR();
    pv_d0(o, vb0, pa0, pa1, pa2, pa3); partialSM(pB0, pB1, m_reg, alB);
    __syncthreads(); RESC(alB);
    finishSM(pB0, pB1, alB, l_reg, pa0, pa1, pa2, pa3); SBAR();
    pv_d0(o, vb0 + SHM_V, pa0, pa1, pa2, pa3);
    if (hi == 0) li_l[r32] = l_reg; asm volatile("s_waitcnt lgkmcnt(0)" ::: "memory");
    float rli[16];
#pragma unroll
    for (int r = 0; r < 16; ++r) rli[r] = __builtin_amdgcn_rcpf(li_l[crow(r, hi)]);
    bf16_t* Ow = Ob + (size_t)(wid * 32) * ldo;
#pragma unroll
    for (int r = 0; r < 16; ++r) { const int orow = crow(r, hi);
#pragma unroll
        for (int d0 = 0; d0 < 2; ++d0) Ow[(size_t)orow * ldo + d0 * 32 + r32] = f2bf(o[d0][r] * rli[r]); }
    __syncthreads();
#undef SLOAD
#undef SWRITE
#undef RESC
}
}

namespace att2 {
constexpr int DQK = 96, DV = 64, KVBLK = 64;
constexpr int KB_BYTES = 64 * 128, VB_BYTES = 64 * 64;
typedef int i32x8 __attribute__((ext_vector_type(8)));
constexpr int SC_K = 0x7d7d7d7d, SC_Q = 0x7a7a7a7a, SC_P = 0x7f7f7f7f, SC_V = 0x7d7d7d7d;
#ifdef ATTN_HOIST
constexpr int NSLOT = 6, PP_VMW = 2 * (NSLOT - 3);
#else
constexpr int NSLOT = 5, PP_VMW = 2 * (NSLOT - 2);
#endif
constexpr int LDS_K = 0, LDS_V = NSLOT * KB_BYTES, LDS_WS = LDS_V + NSLOT * VB_BYTES, LDS_TOTAL = LDS_WS + 8 * 64 * 4;
static_assert(LDS_TOTAL <= RING_BYTES, "attention LDS");
constexpr float THR = 4.f;
typedef short v4i16_t __attribute__((ext_vector_type(4)));
__device__ __forceinline__ s16x4 vtr(const LAS char* p) { return __builtin_bit_cast(s16x4, __builtin_amdgcn_ds_read_tr16_b64_v4i16((LAS v4i16_t*)p)); }
#define PP_KLD(B, DH) ({ const int row_ = 32 * (B) + r32, sw_ = (row_ >> 1) & 7, c0_ = 2 * hi + 4 * (DH); \
        const u32x4 a_ = *(const LAS u32x4*)(Kt + row_ * 128 + ((c0_ ^ sw_) << 4)), b_ = *(const LAS u32x4*)(Kt + row_ * 128 + (((c0_ + 1) ^ sw_) << 4)); \
        (i32x8){(int)a_.x, (int)a_.y, (int)a_.z, (int)a_.w, (int)b_.x, (int)b_.y, (int)b_.z, (int)b_.w}; })
#define PP_VLD(DB) ({ const int d_ = 32 * (DB) + r32, sw_ = (d_ >> 2) & 3; \
        const u32x4 a_ = *(const LAS u32x4*)(Vt + d_ * 64 + (((2 * hi) ^ sw_) << 4)), b_ = *(const LAS u32x4*)(Vt + d_ * 64 + (((2 * hi + 1) ^ sw_) << 4)); \
        (i32x8){(int)a_.x, (int)a_.y, (int)a_.z, (int)a_.w, (int)b_.x, (int)b_.y, (int)b_.z, (int)b_.w}; })
#ifdef PROBE_EXP2X
#define PP_EXP(x) do { float a_ = (x), b_ = (x); asm volatile("" : "+v"(b_)); a_ = __builtin_amdgcn_exp2f(a_); b_ = __builtin_amdgcn_exp2f(b_); (x) = (a_ + b_) * 0.5f; } while (0)
#else
#define PP_EXP(x) (x) = __builtin_amdgcn_exp2f(x)
#endif
#define PK4N(P, BASE, OUT) do { u32x4 w_ = {cvtpk(P[BASE + 0], P[BASE + 1]), cvtpk(P[BASE + 2], P[BASE + 3]), cvtpk(P[BASE + 4], P[BASE + 5]), cvtpk(P[BASE + 6], P[BASE + 7])}; OUT = __builtin_bit_cast(bf16x8, w_); } while (0)
#define PP_SLOT_END() do { SBAR(); asm volatile("s_waitcnt vmcnt(%0) lgkmcnt(0)\n\ts_barrier" :: "n"(PP_VMW) : "memory"); SBAR(); } while (0)
#ifdef ATTN_VDMA_HALF
#define PP_SLOT_END1() do { SBAR(); asm volatile("s_waitcnt vmcnt(%0) lgkmcnt(0)\n\ts_barrier" :: "n"(PP_VMW / 2) : "memory"); SBAR(); } while (0)
#else
#define PP_SLOT_END1() PP_SLOT_END()
#endif
#define PP_BAR() do { SBAR(); asm volatile("s_waitcnt lgkmcnt(0)\n\ts_barrier" ::: "memory"); SBAR(); } while (0)
__device__ __forceinline__ float max3f(float a, float b, float c) { return fmaxf(fmaxf(a, b), c); }
__device__ __forceinline__ void attn_unit_pp(const unsigned char* __restrict__ Qb, const unsigned char* __restrict__ Kh, const unsigned char* __restrict__ Vh, bf16_t* __restrict__ Ob, int ldo, int seq, LAS char* lds, const int wv) {
    const int tid = otid(wv), wid = __builtin_amdgcn_readfirstlane(tid >> 6), lane = tid & 63, r32 = lane & 31, hi = lane >> 5,
#ifdef ATTN_GRP_PARITY
        grp = wid & 1;
#else
        grp = wid >> 2;
#endif
    LAS float* ws = (LAS float*)(lds + LDS_WS) + wid * 64; LAS float* al_l = ws;
    const int NTL = seq / KVBLK;
    unsigned koff, voff;
    { const int s = wid * 64 + lane, row = s >> 3, ch = (s & 7) ^ ((row >> 1) & 7); koff = (unsigned)(row * 128 + ch * 16); }
    { const int s = (wid & 3) * 64 + lane, d = s >> 2, ch = (s & 3) ^ ((d >> 2) & 3); voff = (unsigned)(d * SB + ch * 16); }
    const char* Kg = (const char*)Kh; const char* Vg = (const char*)Vh;
#define PP_DMA_K(t) do { int tt_ = (t); tt_ = tt_ < NTL ? tt_ : NTL - 1; const int sl_ = tt_ % NSLOT; \
        __builtin_amdgcn_global_load_lds((const unsigned*)(Kg + (size_t)tt_ * (64 * 128) + koff), (LAS unsigned*)(lds + LDS_K + sl_ * KB_BYTES + wid * 1024), 16, 0, 0); } while (0)
#define PP_DMA_V(t) do { int tt_ = (t); tt_ = tt_ < NTL ? tt_ : NTL - 1; const int sl_ = tt_ % NSLOT; \
        __builtin_amdgcn_global_load_lds((const unsigned*)(Vg + (size_t)tt_ * 64 + voff), (LAS unsigned*)(lds + LDS_V + sl_ * VB_BYTES + (wid & 3) * 1024), 16, 0, 0); } while (0)
#pragma unroll
    for (int i = 0; i <= NSLOT - 2; ++i) PP_DMA_K(i);
#pragma unroll
    for (int i = 0; i <= NSLOT - 3; ++i) PP_DMA_V(i);
    i32x8 q8[2];
    { const unsigned char* Qw = Qb + (size_t)(wid * 32 + r32) * 128 + hi * 32;
#pragma unroll
      for (int dh = 0; dh < 2; ++dh) { const u32x4 a_ = *(const u32x4*)(Qw + dh * 64), b_ = *(const u32x4*)(Qw + dh * 64 + 16);
          q8[dh] = (i32x8){(int)a_.x, (int)a_.y, (int)a_.z, (int)a_.w, (int)b_.x, (int)b_.y, (int)b_.z, (int)b_.w}; } }
    float m_reg = 0.f; f32x16 o[2] = {}; f32x16 lacc = {}; const i32x8 ones8 = {0x38383838, 0x38383838, 0x38383838, 0x38383838, 0x38383838, 0x38383838, 0x38383838, 0x38383838}; f32x16 negm = {}; asm volatile("" : "+v"(negm));
    f32x16 p0, p1; i32x8 pa8 = {};
    SBAR(); asm volatile("s_waitcnt vmcnt(0) lgkmcnt(0)\n\ts_barrier" ::: "memory"); SBAR();
#ifdef ATTN_TWO_BARRIERS
    if (grp == 1) PP_BAR();
#endif
#ifdef ATTN_VDMA_HALF
#define PP_M(t) PP_MG(t, 1)
#define PP_M1(t) PP_MG(t, 0)
#else
#define PP_M(t) PP_MG(t, 1)
#define PP_M1(t) PP_MG(t, 1)
#endif
#define PP_MG(t, DOV) do { const int t_ = (t), j_ = t_ + 1; \
        if (t_ <= NTL - 2) { if (DOV) PP_DMA_V(t_ + NSLOT - 1); PP_DMA_K(t_ + NSLOT); } \
        i32x8 k8[4]; i32x8 v8[2]; \
        const LAS char* Kt = lds + LDS_K + ((j_ < NTL ? j_ : 0) % NSLOT) * KB_BYTES; \
        const LAS char* Vt = lds + LDS_V + ((t_ < 0 ? 0 : t_) % NSLOT) * VB_BYTES; \
        if (j_ < NTL) { \
            k8[0] = PP_KLD(0, 0); k8[1] = PP_KLD(1, 0); SBAR(); \
            k8[2] = PP_KLD(0, 1); SBAR(); \
            p0 = __builtin_amdgcn_mfma_scale_f32_32x32x64_f8f6f4(k8[0], q8[0], negm, 0, 0, 0, SC_K, 0, SC_Q); SBAR(); \
            k8[3] = PP_KLD(1, 1); SBAR(); \
            p1 = __builtin_amdgcn_mfma_scale_f32_32x32x64_f8f6f4(k8[1], q8[0], negm, 0, 0, 0, SC_K, 0, SC_Q); SBAR(); \
            if (t_ >= 0) { v8[0] = PP_VLD(0); } SBAR(); \
            p0 = __builtin_amdgcn_mfma_scale_f32_32x32x64_f8f6f4(k8[2], q8[1], p0, 0, 0, 0, SC_K, 0, SC_Q); SBAR(); \
            if (t_ >= 0) { v8[1] = PP_VLD(1); } SBAR(); \
            p1 = __builtin_amdgcn_mfma_scale_f32_32x32x64_f8f6f4(k8[3], q8[1], p1, 0, 0, 0, SC_K, 0, SC_Q); SBAR(); \
        } else if (t_ >= 0) { v8[0] = PP_VLD(0); v8[1] = PP_VLD(1); SBAR(); } \
        if (t_ >= 0) { \
            o[0] = __builtin_amdgcn_mfma_scale_f32_32x32x64_f8f6f4(pa8, v8[0], o[0], 0, 0, 0, SC_P, 0, SC_V); \
            o[1] = __builtin_amdgcn_mfma_scale_f32_32x32x64_f8f6f4(pa8, v8[1], o[1], 0, 0, 0, SC_P, 0, SC_V); \
            lacc = __builtin_amdgcn_mfma_scale_f32_32x32x64_f8f6f4(pa8, ones8, lacc, 0, 0, 0, SC_P, 0, SC_P); } \
        asm volatile("" : "+v"(o[0]), "+v"(o[1]), "+v"(p0), "+v"(p1), "+v"(lacc));        \
        } while (0)
#ifdef ATTN_HOIST
    i32x8 k8[4] = {}; i32x8 v8[2] = {};
#define PP_LD(t) do { const int t_ = (t), j_ = t_ + 1; \
        const LAS char* Kt = lds + LDS_K + ((j_ < NTL ? j_ : 0) % NSLOT) * KB_BYTES; \
        const LAS char* Vt = lds + LDS_V + ((t_ < 0 ? 0 : t_) % NSLOT) * VB_BYTES; \
        if (j_ < NTL) { k8[0] = PP_KLD(0, 0); k8[1] = PP_KLD(1, 0); k8[2] = PP_KLD(0, 1); k8[3] = PP_KLD(1, 1); } \
        if (t_ >= 0) { v8[0] = PP_VLD(0); v8[1] = PP_VLD(1); } SBAR(); } while (0)
#define PP_MM(t) do { const int t_ = (t), j_ = t_ + 1; \
        if (t_ <= NTL - 2) { PP_DMA_V(t_ + NSLOT - 1); PP_DMA_K(t_ + NSLOT); } \
        if (j_ < NTL) { \
            p0 = __builtin_amdgcn_mfma_scale_f32_32x32x64_f8f6f4(k8[0], q8[0], negm, 0, 0, 0, SC_K, 0, SC_Q); \
            p1 = __builtin_amdgcn_mfma_scale_f32_32x32x64_f8f6f4(k8[1], q8[0], negm, 0, 0, 0, SC_K, 0, SC_Q); \
            p0 = __builtin_amdgcn_mfma_scale_f32_32x32x64_f8f6f4(k8[2], q8[1], p0, 0, 0, 0, SC_K, 0, SC_Q); \
            p1 = __builtin_amdgcn_mfma_scale_f32_32x32x64_f8f6f4(k8[3], q8[1], p1, 0, 0, 0, SC_K, 0, SC_Q); } \
        if (t_ >= 0) { \
            o[0] = __builtin_amdgcn_mfma_scale_f32_32x32x64_f8f6f4(pa8, v8[0], o[0], 0, 0, 0, SC_P, 0, SC_V); \
            o[1] = __builtin_amdgcn_mfma_scale_f32_32x32x64_f8f6f4(pa8, v8[1], o[1], 0, 0, 0, SC_P, 0, SC_V); \
            int c1_ = 0x38383838; asm volatile("" : "+s"(c1_)); const i32x8 on_ = {c1_, c1_, c1_, c1_, c1_, c1_, c1_, c1_};        \
            lacc = __builtin_amdgcn_mfma_scale_f32_32x32x64_f8f6f4(pa8, on_, lacc, 0, 0, 0, SC_P, 0, SC_P); } \
        asm volatile("" : "+v"(o[0]), "+v"(o[1]), "+v"(p0), "+v"(p1), "+v"(lacc)); SBAR(); \
        } while (0)
#endif
#define PP_S(first) do { \
        float a_ = max3f(p0[0], p0[1], p1[0]), b_ = max3f(p0[2], p0[3], p1[1]); a_ = max3f(a_, p1[2], p1[3]); \
        _Pragma("unroll") for (int r = 4; r < 16; r += 4) { a_ = max3f(a_, p0[r], p0[r + 1]); b_ = max3f(b_, p0[r + 2], p0[r + 3]); a_ = max3f(a_, p1[r], p1[r + 1]); b_ = max3f(b_, p1[r + 2], p1[r + 3]); } \
        float rm_ = fmaxf(a_, b_); { auto rr = __builtin_amdgcn_permlane32_swap(__float_as_uint(rm_), __float_as_uint(rm_), false, false); rm_ = fmaxf(__uint_as_float(rr[0]), __uint_as_float(rr[1])); } \
        if (first) { const float dl = rm_ - 4.f; m_reg = dl; _Pragma("unroll") for (int r = 0; r < 16; ++r) { p0[r] -= dl; p1[r] -= dl; } \
            _Pragma("unroll") for (int r = 0; r < 16; ++r) negm[r] = -m_reg; asm volatile("" : "+v"(negm)); } \
        else if (__builtin_expect(__any(rm_ > 2.f * THR), 0)) { const float dl = fmaxf(rm_ - THR, 0.f); m_reg += dl; \
            _Pragma("unroll") for (int r = 0; r < 16; ++r) { p0[r] -= dl; p1[r] -= dl; } \
            _Pragma("unroll") for (int r = 0; r < 16; ++r) negm[r] = -m_reg; asm volatile("" : "+v"(negm)); \
            const float al = __builtin_amdgcn_exp2f(-dl); if (hi == 0) al_l[r32] = al; asm volatile("s_waitcnt lgkmcnt(0)" ::: "memory"); \
            _Pragma("unroll") for (int r = 0; r < 16; ++r) { const float f_ = al_l[crow(r, hi)]; o[0][r] *= f_; o[1][r] *= f_; lacc[r] *= f_; } } \
        _Pragma("unroll") for (int r = 0; r < 16; ++r) { PP_EXP(p0[r]); PP_EXP(p1[r]); } \
        _Pragma("unroll") for (int k_ = 0; k_ < 4; ++k_) { \
            int w_ = __builtin_amdgcn_cvt_pk_fp8_f32(p0[4 * k_], p0[4 * k_ + 1], pa8[k_], false); w_ = __builtin_amdgcn_cvt_pk_fp8_f32(p0[4 * k_ + 2], p0[4 * k_ + 3], w_, true); pa8[k_] = w_;        \
            int x_ = __builtin_amdgcn_cvt_pk_fp8_f32(p1[4 * k_], p1[4 * k_ + 1], pa8[4 + k_], false); x_ = __builtin_amdgcn_cvt_pk_fp8_f32(p1[4 * k_ + 2], p1[4 * k_ + 3], x_, true); pa8[4 + k_] = x_; } \
        asm volatile("" : "+v"(pa8)); } while (0)
#ifdef ATTN_TWO_BARRIERS
    PP_M(-1); PP_SLOT_END();
    PP_S(true); PP_SLOT_END();
#pragma nounroll
    for (int t = 0; t < NTL - 1; ++t) {
        PP_M(t); PP_SLOT_END();
        PP_S(false); PP_SLOT_END();
    }
    PP_M(NTL - 1);
    if (grp == 0) PP_BAR();
#else
#ifdef ATTN_PRIO_YOUNG
    if (grp == 1) __builtin_amdgcn_s_setprio(1);
#endif
#ifdef ATTN_HOIST
    if (grp == 0) {
        PP_LD(-1); PP_MM(-1); PP_LD(0); PP_S(true); PP_SLOT_END();
#pragma nounroll
        for (int t = 0; t < NTL - 1; ++t) { PP_MM(t); PP_LD(t + 1); PP_S(false); PP_SLOT_END(); }
        PP_MM(NTL - 1);
    } else {
        PP_LD(-1); PP_MM(-1); PP_SLOT_END();
        PP_LD(0); PP_S(true);
#pragma nounroll
        for (int t = 0; t < NTL - 1; ++t) { PP_MM(t); PP_SLOT_END(); PP_LD(t + 1); PP_S(false); }
        PP_MM(NTL - 1);
    }
#else
    if (grp == 0) {
        PP_M(-1); PP_S(true); PP_SLOT_END();
#pragma nounroll
        for (int t = 0; t < NTL - 1; ++t) { PP_M(t); PP_S(false); PP_SLOT_END(); }
        PP_M(NTL - 1);
    } else {
        PP_M1(-1); PP_SLOT_END1();
        PP_S(true);
#pragma nounroll
        for (int t = 0; t < NTL - 1; ++t) { PP_M1(t); PP_SLOT_END1(); PP_S(false); }
        PP_M1(NTL - 1);
    }
#endif
#ifdef ATTN_PRIO_YOUNG
    __builtin_amdgcn_s_setprio(0);
#endif
#endif
    float rli[16];
#pragma unroll
    for (int r = 0; r < 16; ++r) rli[r] = __builtin_amdgcn_rcpf(lacc[r]);
    bf16_t* Ow = Ob + (size_t)(wid * 32) * ldo;
#pragma unroll
    for (int r = 0; r < 16; ++r) { const int orow = crow(r, hi);
#pragma unroll
        for (int d0 = 0; d0 < 2; ++d0) Ow[(size_t)orow * ldo + d0 * 32 + r32] = f2bf(o[d0][r] * rli[r]); }
    SBAR(); asm volatile("s_waitcnt vmcnt(0) lgkmcnt(0)\n\ts_barrier" ::: "memory"); SBAR();
#undef PP_DMA_K
#undef PP_DMA_V
#undef PP_M
#undef PP_M1
#undef PP_MG
#undef PP_S
#ifdef ATTN_HOIST
#undef PP_LD
#undef PP_MM
#endif
}

constexpr int NSLOT_IL = 6, IL_VMW = 2 * (NSLOT_IL - 3);
constexpr int IL_K = 0, IL_V = NSLOT_IL * KB_BYTES, IL_WS = IL_V + NSLOT_IL * VB_BYTES, IL_TOTAL = IL_WS + 8 * 64 * 4;
static_assert(IL_TOTAL <= RING_BYTES, "attention LDS");
__device__ __forceinline__ void attn_unit_il(const unsigned char* __restrict__ Qb, const unsigned char* __restrict__ Kh, const unsigned char* __restrict__ Vh, bf16_t* __restrict__ Ob, int ldo, int seq, LAS char* lds, const int wv) {
    const int tid = otid(wv), wid = __builtin_amdgcn_readfirstlane(tid >> 6), lane = tid & 63, r32 = lane & 31, hi = lane >> 5;
    LAS float* ws = (LAS float*)(lds + IL_WS) + wid * 64; LAS float* al_l = ws;
    const int NTL = seq / KVBLK;
    unsigned koff, voff;
    { const int s = wid * 64 + lane, row = s >> 3, ch = (s & 7) ^ ((row >> 1) & 7); koff = (unsigned)(row * 128 + ch * 16); }
    { const int s = (wid & 3) * 64 + lane, d = s >> 2, ch = (s & 3) ^ ((d >> 2) & 3); voff = (unsigned)(d * SB + ch * 16); }
    const char* Kg = (const char*)Kh; const char* Vg = (const char*)Vh;
#define IL_DMA_K(t) do { int tt_ = (t); tt_ = tt_ < NTL ? tt_ : NTL - 1; const int sl_ = tt_ % NSLOT_IL;        \
        __builtin_amdgcn_global_load_lds((const unsigned*)(Kg + (size_t)tt_ * (64 * 128) + koff), (LAS unsigned*)(lds + IL_K + sl_ * KB_BYTES + wid * 1024), 16, 0, 0); } while (0)
#define IL_DMA_V(t) do { int tt_ = (t); tt_ = tt_ < NTL ? tt_ : NTL - 1; const int sl_ = tt_ % NSLOT_IL; \
        __builtin_amdgcn_global_load_lds((const unsigned*)(Vg + (size_t)tt_ * 64 + voff), (LAS unsigned*)(lds + IL_V + sl_ * VB_BYTES + (wid & 3) * 1024), 16, 0, 0); } while (0)
#pragma unroll
    for (int i = 0; i <= NSLOT_IL - 1; ++i) IL_DMA_K(i);
#pragma unroll
    for (int i = 0; i <= NSLOT_IL - 2; ++i) IL_DMA_V(i);
    i32x8 q8[2];
    { const unsigned char* Qw = Qb + (size_t)(wid * 32 + r32) * 128 + hi * 32;
#pragma unroll
      for (int dh = 0; dh < 2; ++dh) { const u32x4 a_ = *(const u32x4*)(Qw + dh * 64), b_ = *(const u32x4*)(Qw + dh * 64 + 16);
          q8[dh] = (i32x8){(int)a_.x, (int)a_.y, (int)a_.z, (int)a_.w, (int)b_.x, (int)b_.y, (int)b_.z, (int)b_.w}; } }
    float m_reg = 0.f; f32x16 o[2] = {}; f32x16 lacc = {}; f32x16 negm = {}; asm volatile("" : "+v"(negm));
    f32x16 a0, a1, b0, b1; i32x8 pa8 = {}; i32x8 k8[4] = {}; i32x8 v8[2] = {};
    SBAR(); asm volatile("s_waitcnt vmcnt(0) lgkmcnt(0)\n\ts_barrier" ::: "memory"); SBAR();
#define IL_END() do { SBAR(); asm volatile("" ::: "memory"); __builtin_amdgcn_s_waitcnt((IL_VMW & 15) | 0x70 | ((IL_VMW >> 4) << 14)); __builtin_amdgcn_s_barrier(); asm volatile("" ::: "memory"); SBAR(); } while (0)
#define IL_LDK(j) do { const LAS char* Kt = lds + IL_K + ((j) % NSLOT_IL) * KB_BYTES; k8[0] = PP_KLD(0, 0); k8[1] = PP_KLD(1, 0); k8[2] = PP_KLD(0, 1); k8[3] = PP_KLD(1, 1); } while (0)
#define IL_LDV(t) do { const LAS char* Vt = lds + IL_V + ((t) % NSLOT_IL) * VB_BYTES; v8[0] = PP_VLD(0); v8[1] = PP_VLD(1); } while (0)
#define IL_QK(Y0, Y1, n) do { \
        if ((n) == 0) Y0 = __builtin_amdgcn_mfma_scale_f32_32x32x64_f8f6f4(k8[0], q8[0], negm, 0, 0, 0, SC_K, 0, SC_Q); \
        if ((n) == 1) Y1 = __builtin_amdgcn_mfma_scale_f32_32x32x64_f8f6f4(k8[1], q8[0], negm, 0, 0, 0, SC_K, 0, SC_Q); \
        if ((n) == 2) Y0 = __builtin_amdgcn_mfma_scale_f32_32x32x64_f8f6f4(k8[2], q8[1], Y0, 0, 0, 0, SC_K, 0, SC_Q); \
        if ((n) == 3) Y1 = __builtin_amdgcn_mfma_scale_f32_32x32x64_f8f6f4(k8[3], q8[1], Y1, 0, 0, 0, SC_K, 0, SC_Q); SBAR(); } while (0)
#define IL_CVT(X, b, W) do { int w_ = __builtin_amdgcn_cvt_pk_fp8_f32(X[b], X[(b) + 1], 0, false); w_ = __builtin_amdgcn_cvt_pk_fp8_f32(X[(b) + 2], X[(b) + 3], w_, true); W = w_; } while (0)
#define IL_FIN(X0, X1, g) do { PP_EXP(X1[4 * (g)]); PP_EXP(X1[4 * (g) + 1]); PP_EXP(X1[4 * (g) + 2]); PP_EXP(X1[4 * (g) + 3]); \
        if ((g) == 0) { IL_CVT(X0, 0, pa8[0]); IL_CVT(X0, 4, pa8[1]); } if ((g) == 1) { IL_CVT(X0, 8, pa8[2]); IL_CVT(X0, 12, pa8[3]); } \
        if ((g) == 2) { IL_CVT(X1, 0, pa8[4]); IL_CVT(X1, 4, pa8[5]); } if ((g) == 3) { IL_CVT(X1, 8, pa8[6]); IL_CVT(X1, 12, pa8[7]); } SBAR(); } while (0)
#define IL_MAX(Y0, Y1, RM) do { float a_ = max3f(Y0[0], Y0[1], Y1[0]), b_ = max3f(Y0[2], Y0[3], Y1[1]); a_ = max3f(a_, Y1[2], Y1[3]); \
        _Pragma("unroll") for (int r = 4; r < 16; r += 4) { a_ = max3f(a_, Y0[r], Y0[r + 1]); b_ = max3f(b_, Y0[r + 2], Y0[r + 3]); a_ = max3f(a_, Y1[r], Y1[r + 1]); b_ = max3f(b_, Y1[r + 2], Y1[r + 3]); } \
        RM = fmaxf(a_, b_); { auto rr = __builtin_amdgcn_permlane32_swap(__float_as_uint(RM), __float_as_uint(RM), false, false); RM = fmaxf(__uint_as_float(rr[0]), __uint_as_float(rr[1])); } } while (0)
#define IL_RESC(Y0, Y1, RM) do { if (__builtin_expect(__any(RM > 2.f * THR), 0)) { const float dl = fmaxf(RM - THR, 0.f); m_reg += dl; \
            _Pragma("unroll") for (int r = 0; r < 16; ++r) { Y0[r] -= dl; Y1[r] -= dl; } \
            _Pragma("unroll") for (int r = 0; r < 16; ++r) negm[r] = -m_reg; asm volatile("" : "+v"(negm)); \
            const float al = __builtin_amdgcn_exp2f(-dl); if (hi == 0) al_l[r32] = al; asm volatile("s_waitcnt lgkmcnt(0)" ::: "memory"); \
            _Pragma("unroll") for (int r = 0; r < 16; ++r) { const float f_ = al_l[crow(r, hi)]; o[0][r] *= f_; o[1][r] *= f_; lacc[r] *= f_; } } } while (0)
#define IL_EXPH(Y0) do { _Pragma("unroll") for (int r = 0; r < 16; ++r) PP_EXP(Y0[r]); SBAR(); } while (0)
#define IL_STEP(X0, X1, Y0, Y1, t, HASQK, HASLDK) do { const int t_ = (t); \
        IL_LDV(t_); SBAR(); \
        if (HASQK) { IL_QK(Y0, Y1, 0); IL_FIN(X0, X1, 0); IL_QK(Y0, Y1, 1); IL_FIN(X0, X1, 1); IL_QK(Y0, Y1, 2); IL_FIN(X0, X1, 2); IL_QK(Y0, Y1, 3); IL_FIN(X0, X1, 3); } \
        else { IL_FIN(X0, X1, 0); IL_FIN(X0, X1, 1); IL_FIN(X0, X1, 2); IL_FIN(X0, X1, 3); } \
        o[0] = __builtin_amdgcn_mfma_scale_f32_32x32x64_f8f6f4(pa8, v8[0], o[0], 0, 0, 0, SC_P, 0, SC_V); \
        o[1] = __builtin_amdgcn_mfma_scale_f32_32x32x64_f8f6f4(pa8, v8[1], o[1], 0, 0, 0, SC_P, 0, SC_V); asm volatile("" : "+v"(o[0]), "+v"(o[1]) :: "memory"); SBAR(); \
        if (HASLDK) { IL_DMA_V(t_ + NSLOT_IL - 1); IL_DMA_K(t_ + NSLOT_IL); IL_LDK(t_ + 2); } SBAR(); \
        float rm_ = 0.f; if (HASQK) IL_MAX(Y0, Y1, rm_); SBAR(); \
        { int c1_ = 0x38383838; asm volatile("" : "+s"(c1_)); const i32x8 on_ = {c1_, c1_, c1_, c1_, c1_, c1_, c1_, c1_}; \
          lacc = __builtin_amdgcn_mfma_scale_f32_32x32x64_f8f6f4(pa8, on_, lacc, 0, 0, 0, SC_P, 0, SC_P); } SBAR(); \
        if (HASQK) { IL_RESC(Y0, Y1, rm_); SBAR(); IL_EXPH(Y0); } \
        asm volatile("" : "+v"(o[0]), "+v"(o[1]), "+v"(lacc)); \
        IL_END(); } while (0)
    IL_LDK(0); SBAR();
    IL_QK(a0, a1, 0); IL_QK(a0, a1, 1); IL_QK(a0, a1, 2); IL_QK(a0, a1, 3);
    IL_LDK(1); SBAR();
    { float rm_; IL_MAX(a0, a1, rm_); const float dl = rm_ - 4.f; m_reg = dl;
#pragma unroll
      for (int r = 0; r < 16; ++r) { a0[r] -= dl; a1[r] -= dl; }
#pragma unroll
      for (int r = 0; r < 16; ++r) negm[r] = -m_reg;
      asm volatile("" : "+v"(negm)); }
    IL_EXPH(a0);
    IL_END();
#pragma nounroll
    for (int t = 0; t + 3 < NTL; t += 2) {
        IL_STEP(a0, a1, b0, b1, t, 1, 1);
        IL_STEP(b0, b1, a0, a1, t + 1, 1, 1);
    }
    IL_STEP(a0, a1, b0, b1, NTL - 2, 1, 0);
    IL_STEP(b0, b1, a0, a1, NTL - 1, 0, 0);
    float rli[16];
#pragma unroll
    for (int r = 0; r < 16; ++r) rli[r] = __builtin_amdgcn_rcpf(lacc[r]);
    bf16_t* Ow = Ob + (size_t)(wid * 32) * ldo;
#pragma unroll
    for (int r = 0; r < 16; ++r) { const int orow = crow(r, hi);
#pragma unroll
        for (int d0 = 0; d0 < 2; ++d0) Ow[(size_t)orow * ldo + d0 * 32 + r32] = f2bf(o[d0][r] * rli[r]); }
    SBAR(); asm volatile("s_waitcnt vmcnt(0) lgkmcnt(0)\n\ts_barrier" ::: "memory"); SBAR();
#undef IL_DMA_K
#undef IL_DMA_V
#undef IL_END
#undef IL_LDK
#undef IL_LDV
#undef IL_QK
#undef IL_CVT
#undef IL_FIN
#undef IL_MAX
#undef IL_RESC
#undef IL_EXPH
#undef IL_STEP
}
}

__device__ __forceinline__ void retu_unit(int unit, const bf16_t* PR, float* U, float lg2f, float lg2b, LAS char* lds, const int wv) {
    const int tid = otid(wv), wid = __builtin_amdgcn_readfirstlane(tid >> 6), lane = tid & 63, r32 = lane & 31, hi = lane >> 5;
    const int h = unit & 3, bc = unit >> 2, bl = bc / NCHUNK, c = bc - bl * NCHUNK;
    const size_t r0 = (size_t)bl * SB + (size_t)c * 128;
    LAS char* Vt = lds;
    LAS char* Kf = lds + 32768;
    LAS char* Kb = lds + 49152;
#pragma unroll
    for (int i = 0; i < 2; ++i) { const int ch = tid + i * 512, j = ch >> 3, c8 = (ch & 7) * 8;
        const u32x4 kw = *(const u32x4*)(PR + (r0 + j) * 1536 + 256 + h * 64 + c8);
        float f[8], g[8]; unpack8(kw, f);
        const float wf = __builtin_amdgcn_exp2f(lg2f * (float)(127 - j)), wb = __builtin_amdgcn_exp2f(lg2b * (float)j);
#pragma unroll
        for (int k = 0; k < 8; ++k) { g[k] = f[k] * wb; f[k] *= wf; }
        const int off = (j >> 6) * 8192 + v_st<2>(j & 63, c8);
        *(LAS u32x4*)(Kf + off) = pack8(f); *(LAS u32x4*)(Kb + off) = pack8(g); }
#pragma unroll
    for (int i = 0; i < 4; ++i) { const int ch = tid + i * 512, j = ch >> 4, c8 = (ch & 15) * 8;
        const u32x4 vw = *(const u32x4*)(PR + (r0 + j) * 1536 + 512 + h * 128 + c8);
        *(LAS u32x4*)(Vt + (j >> 6) * 16384 + v_st<4>(j & 63, c8)) = vw; }
    __syncthreads();
    const int eblk = wid & 3, dblk = wid >> 2;
    const int vbV = (int)(size_t)Vt + v_rd_base(lane) + eblk * 512, vbF = (int)(size_t)Kf + v_rd_base(lane) + dblk * 512, vbB = (int)(size_t)Kb + v_rd_base(lane) + dblk * 512;
    f32x16 aF = {}, aB = {};
#define RU_STEP(SUB, KS) do { const bf16x8 a = tr_frag<4, KS>(vbV + SUB * 16384), bf = tr_frag<2, KS>(vbF + SUB * 8192), bb = tr_frag<2, KS>(vbB + SUB * 8192); \
        asm volatile("s_waitcnt lgkmcnt(0)" ::: "memory"); SBAR(); \
        aF = __builtin_amdgcn_mfma_f32_32x32x16_bf16(a, bf, aF, 0, 0, 0); aB = __builtin_amdgcn_mfma_f32_32x32x16_bf16(a, bb, aB, 0, 0, 0); } while (0)
    RU_STEP(0, 0); RU_STEP(0, 1); RU_STEP(0, 2); RU_STEP(0, 3); RU_STEP(1, 0); RU_STEP(1, 1); RU_STEP(1, 2); RU_STEP(1, 3);
#undef RU_STEP
    float* Uf = U + (size_t)unit * 2 * 8192; float* Ub = Uf + 8192;
#pragma unroll
    for (int r = 0; r < 16; ++r) { const int e = 32 * eblk + crow(r, hi), d = 32 * dblk + r32; Uf[e * 64 + d] = aF[r]; Ub[e * 64 + d] = aB[r]; }
    __syncthreads();
}

__device__ __forceinline__ void retout_unit(int unit, const bf16_t* PR, const bf16_t* S, const float* gnw, bf16_t* ACT, float lg2f, float lg2b, LAS char* lds, const int wv) {
    const int tid = otid(wv), wid = __builtin_amdgcn_readfirstlane(tid >> 6), lane = tid & 63, r32 = lane & 31, hi = lane >> 5;
    const int h = unit & 3, bc = unit >> 2, bl = bc / NCHUNK, c = bc - bl * NCHUNK;
    const size_t r0 = (size_t)bl * SB + (size_t)c * 128;
    LAS char* Vt = lds; LAS float* part = (LAS float*)(lds + 32768);
    const int qblk = wid & 3, ehalf = wid >> 2, iq = 32 * qblk + r32;
    u32x4 vw[4];
#pragma unroll
    for (int i = 0; i < 4; ++i) { const int ch = tid + i * 512, j = ch >> 4, c8 = (ch & 15) * 8; vw[i] = *(const u32x4*)(PR + (r0 + j) * 1536 + 512 + h * 128 + c8); }
    bf16x8 qf[4], kf[4][4];
    { const bf16_t* qp = PR + (r0 + iq) * 1536 + h * 64 + hi * 8;
#pragma unroll
      for (int d0 = 0; d0 < 4; ++d0) qf[d0] = *(const bf16x8*)(qp + d0 * 16); }
#pragma unroll
    for (int jb = 0; jb < 4; ++jb) { const bf16_t* kp = PR + (r0 + 32 * jb + r32) * 1536 + 256 + h * 64 + hi * 8;
#pragma unroll
        for (int d0 = 0; d0 < 4; ++d0) kf[jb][d0] = *(const bf16x8*)(kp + d0 * 16); }
    const int orow = tid >> 2, oc = (tid & 3) * 32;
    u32x4 gw[4];
#pragma unroll
    for (int k = 0; k < 4; ++k) gw[k] = *(const u32x4*)(PR + (r0 + orow) * 1536 + 1024 + h * 128 + oc + 8 * k);
#pragma unroll
    for (int i = 0; i < 4; ++i) { const int ch = tid + i * 512, j = ch >> 4, c8 = (ch & 15) * 8; *(LAS u32x4*)(Vt + (j >> 6) * 16384 + v_st<4>(j & 63, c8)) = vw[i]; }
    f32x16 o[2] = {};
    __syncthreads();
    bf16x8 sf[2][4], sb[2][4];
    { const bf16_t* Sf = S + (size_t)unit * 2 * 8192; const bf16_t* Sb = Sf + 8192;
#pragma unroll
      for (int e0 = 0; e0 < 2; ++e0) { const int e = 64 * ehalf + 32 * e0 + r32;
#pragma unroll
        for (int d0 = 0; d0 < 4; ++d0) { sf[e0][d0] = *(const bf16x8*)(Sf + e * 64 + d0 * 16 + hi * 8); sb[e0][d0] = *(const bf16x8*)(Sb + e * 64 + d0 * 16 + hi * 8); } } }
    const int vb = (int)(size_t)Vt + v_rd_base(lane) + ehalf * 1024;
#pragma unroll
    for (int jb = 0; jb < 4; ++jb) {
        f32x16 p = {};
#pragma unroll
        for (int d0 = 0; d0 < 4; ++d0) p = __builtin_amdgcn_mfma_f32_32x32x16_bf16(kf[jb][d0], qf[d0], p, 0, 0, 0);
#pragma unroll
        for (int r = 0; r < 16; ++r) { const int dj = iq - (32 * jb + crow(r, hi));
            const float e = dj >= 0 ? lg2f * (float)dj : lg2b * (float)(-dj); p[r] *= __builtin_amdgcn_exp2f(e); }
        bf16x8 pa0, pa1; PK4(p, 0, pa0); PK4(p, 8, pa1);
        const int vj = vb + (jb >> 1) * 16384;
        if (jb & 1) {
            const bf16x8 f00 = tr_frag<4, 2>(vj), f01 = tr_frag<4, 3>(vj), f10 = tr_frag<4, 2>(vj + 512), f11 = tr_frag<4, 3>(vj + 512);
            asm volatile("s_waitcnt lgkmcnt(0)" ::: "memory"); SBAR();
            o[0] = __builtin_amdgcn_mfma_f32_32x32x16_bf16(pa0, f00, o[0], 0, 0, 0); o[0] = __builtin_amdgcn_mfma_f32_32x32x16_bf16(pa1, f01, o[0], 0, 0, 0);
            o[1] = __builtin_amdgcn_mfma_f32_32x32x16_bf16(pa0, f10, o[1], 0, 0, 0); o[1] = __builtin_amdgcn_mfma_f32_32x32x16_bf16(pa1, f11, o[1], 0, 0, 0);
        } else {
            const bf16x8 f00 = tr_frag<4, 0>(vj), f01 = tr_frag<4, 1>(vj), f10 = tr_frag<4, 0>(vj + 512), f11 = tr_frag<4, 1>(vj + 512);
            asm volatile("s_waitcnt lgkmcnt(0)" ::: "memory"); SBAR();
            o[0] = __builtin_amdgcn_mfma_f32_32x32x16_bf16(pa0, f00, o[0], 0, 0, 0); o[0] = __builtin_amdgcn_mfma_f32_32x32x16_bf16(pa1, f01, o[0], 0, 0, 0);
            o[1] = __builtin_amdgcn_mfma_f32_32x32x16_bf16(pa0, f10, o[1], 0, 0, 0); o[1] = __builtin_amdgcn_mfma_f32_32x32x16_bf16(pa1, f11, o[1], 0, 0, 0);
        }
    }
    {
        const float xf = __builtin_amdgcn_exp2f(lg2f * (float)(iq + 1)), xb = __builtin_amdgcn_exp2f(lg2b * (float)(128 - iq));
#pragma unroll
        for (int d0 = 0; d0 < 4; ++d0) {
            float f[8], g[8]; unpack8(__builtin_bit_cast(u32x4, qf[d0]), f);
#pragma unroll
            for (int k = 0; k < 8; ++k) { g[k] = f[k] * xb; f[k] *= xf; }
            const bf16x8 qa = __builtin_bit_cast(bf16x8, pack8(f)), qb = __builtin_bit_cast(bf16x8, pack8(g));
#pragma unroll
            for (int e0 = 0; e0 < 2; ++e0) { o[e0] = __builtin_amdgcn_mfma_f32_32x32x16_bf16(qa, sf[e0][d0], o[e0], 0, 0, 0); o[e0] = __builtin_amdgcn_mfma_f32_32x32x16_bf16(qb, sb[e0][d0], o[e0], 0, 0, 0); }
        }
    }
    float sq[16];
#pragma unroll
    for (int r = 0; r < 16; ++r) { float s = o[0][r] * o[0][r] + o[1][r] * o[1][r];
        sq[r] = sum32(s); }
    if (r32 == 0) {
#pragma unroll
        for (int r = 0; r < 16; ++r) part[wid * 32 + crow(r, hi)] = sq[r];
    }
    __syncthreads();
    const float g0 = gnw[h * 128 + 64 * ehalf + r32], g1 = gnw[h * 128 + 64 * ehalf + 32 + r32];
    LAS bf16_t* stg = (LAS bf16_t*)Vt;
#pragma unroll
    for (int r = 0; r < 16; ++r) { const int il = crow(r, hi);
        const float tot = part[wid * 32 + il] + part[(wid ^ 4) * 32 + il];
        const float rn = rsqrtf(tot * (1.f / 128.f) + RMS_EPS);
        LAS bf16_t* sp = stg + (32 * qblk + il) * 128 + 64 * ehalf + r32;
        sp[0] = f2bf(o[0][r] * rn * g0); sp[32] = f2bf(o[1][r] * rn * g1); }
    __syncthreads();
#pragma unroll
    for (int k = 0; k < 4; ++k) { float y[8], g[8]; unpack8(*(const LAS u32x4*)(stg + orow * 128 + oc + 8 * k), y); unpack8(gw[k], g);
#pragma unroll
        for (int q = 0; q < 8; ++q) y[q] *= silu_fast(g[q]);
        *(u32x4*)(ACT + (r0 + orow) * 1536 + h * 128 + oc + 8 * k) = pack8(y); }
    __syncthreads();
}
struct Args { const float* in[26]; float* out; unsigned char* ws; int ph_lo, ph_hi; };
struct Frame {
    LAS unsigned char* lds; int G, wv;
    const Args* a; float* out; unsigned char* ws;
};
__device__ __forceinline__ const float* in_ptr(const Args* a, int i) { int z; asm volatile("s_mov_b32 %0, 0" : "=s"(z)); return a->in[i + z]; }
#define INP(i) in_ptr(F.a, (i))
__device__ __forceinline__ unsigned char* ows(unsigned char* p) { asm volatile("" : "+s"(p)); return p; }
#ifdef SELFCHECK_ATTN
#define WSP(T, off) ((T*)(ows(F.ws) + (off)))
#else
#define WSP(T, off) ((T*)(F.ws + (off)))
#endif

__device__ __forceinline__ int srccol_in(int n) {
    if (n < 512) { const int base = n & ~255, hh = (n & 255) >> 6, p = n & 63; return base + hh * 64 + (p >> 1) + 32 * (p & 1); }
    if (n < 2048) return n;
    if (n < 3072) { const int j = (n - 2048) >> 1; return 2048 + j + 512 * (n & 1); }
    if (n < 3712) return n;
    if (n < 3744) { const int p = n - 3712, a = p >> 4, q = p & 15; return 3712 + a * 16 + (q >> 1) + 8 * (q & 1); }
    if (n < 3840) return -1;
    return n - 96;
}
__device__ __forceinline__ int srccol_uq(int n) { const int h = n / 96, d = n - h * 96; if (d < 64) return n; const int p = d - 64, a = p >> 4, q = p & 15; return h * 96 + 64 + a * 16 + (q >> 1) + 8 * (q & 1); }

__device__ __forceinline__ void cvt_item(const float* sp, int ldw, const float* scale, bf16_t* dst, int ldd, int n0, int k0, LAS float* scr, int lane) {
    float vv[32];
#pragma unroll
    for (int i = 0; i < 32; ++i) { const int kk = 2 * i + (lane >> 5); vv[i] = sp ? sp[(size_t)(k0 + kk) * ldw] : 0.f; }
    if (scale) {
#pragma unroll
        for (int i = 0; i < 32; ++i) vv[i] *= scale[k0 + 2 * i + (lane >> 5)];
    }
#pragma unroll
    for (int i = 0; i < 32; ++i) scr[(2 * i + (lane >> 5)) * 33 + (lane & 31)] = vv[i];
    asm volatile("s_waitcnt lgkmcnt(0)" ::: "memory");
    const int c = lane & 7;
#pragma unroll
    for (int j = 0; j < 4; ++j) { const int n = (lane >> 3) + 8 * j; const LAS float* s = scr + (8 * c) * 33 + n;
        u32x4 o; o.x = cvtpk(s[0 * 33], s[1 * 33]); o.y = cvtpk(s[2 * 33], s[3 * 33]); o.z = cvtpk(s[4 * 33], s[5 * 33]); o.w = cvtpk(s[6 * 33], s[7 * 33]);
        *(u32x4*)(dst + (size_t)(n0 + n) * ldd + k0 + 8 * c) = o; }
    asm volatile("s_waitcnt lgkmcnt(0)" ::: "memory");
}

__device__ __forceinline__ void cvt_item_fp8(const float* sp, int ldw, float sc, unsigned char* dst, int ldd, int n0, int k0, LAS float* scr, int lane) {
    float vv[32];
#pragma unroll
    for (int i = 0; i < 32; ++i) { const int kk = 2 * i + (lane >> 5); vv[i] = sp ? sp[(size_t)(k0 + kk) * ldw] * sc : 0.f; }
#pragma unroll
    for (int i = 0; i < 32; ++i) scr[(2 * i + (lane >> 5)) * 33 + (lane & 31)] = vv[i];
    asm volatile("s_waitcnt lgkmcnt(0)" ::: "memory");
    const int c = lane & 7;
#pragma unroll
    for (int j = 0; j < 4; ++j) { const int n = (lane >> 3) + 8 * j; const LAS float* s = scr + (8 * c) * 33 + n;
        float f[8];
#pragma unroll
        for (int q = 0; q < 8; ++q) f[q] = s[q * 33];
        *(u32x2*)(dst + (size_t)(n0 + n) * ldd + k0 + 8 * c) = pack8_fp8(f); }
    asm volatile("s_waitcnt lgkmcnt(0)" ::: "memory");
}
__device__ __forceinline__ f32x2 cossin_f(float ang) {
    const double x = (double)ang * 0.15915494309189535; const float r = (float)(x - rint(x));
    return (f32x2){__builtin_amdgcn_cosf(r), __builtin_amdgcn_sinf(r)};
}
__device__ __forceinline__ float lg2_gamma(const float* rd) { return -__builtin_amdgcn_logf(1.f + __builtin_amdgcn_exp2f(-rd[0] * LOG2E)); }
#define PHASE_IDS const int tid = otid(F.wv), lane = tid & 63, wave = __builtin_amdgcn_readfirstlane(tid >> 6), bid = obid(); (void)lane; (void)wave; (void)bid;
__device__ __forceinline__ void p0_prologue(Frame& F) {
    PHASE_IDS
    __syncthreads();
    if (bid < 48) {
        LAS float* sc = (LAS float*)F.lds;
        LAS float* red = (LAS float*)(F.lds + 40960);
        for (int i = tid; i < 9 * 1024; i += 512) { const int v = i >> 10, k = i & 1023; const float x = v < 8 ? INP(1)[v * 1024 + k] : INP(3)[k]; sc[i] = siluf_(x); }
        __syncthreads();
        const int l = bid / 24, col = (bid % 24) * 256 + (tid & 255), kq = tid >> 8;
        const float* w = INP(4) + (size_t)l * 1024 * 6144 + col;
        float a[9];
#pragma unroll
        for (int v = 0; v < 9; ++v) a[v] = 0.f;
#pragma nounroll
        for (int k = kq * 512; k < kq * 512 + 512; k += 16) {
            float wv_[16];
#pragma unroll
            for (int j = 0; j < 16; ++j) wv_[j] = w[(size_t)(k + j) * 6144];
#pragma unroll
            for (int j4 = 0; j4 < 4; ++j4)
#pragma unroll
                for (int v = 0; v < 9; ++v) { const f32x4 s = *(const LAS f32x4*)(sc + v * 1024 + k + 4 * j4); a[v] += (s[0] * wv_[4 * j4] + s[1] * wv_[4 * j4 + 1]) + (s[2] * wv_[4 * j4 + 2] + s[3] * wv_[4 * j4 + 3]); }
        }
        if (kq == 1) {
#pragma unroll
            for (int v = 0; v < 9; ++v) red[v * 256 + (tid & 255)] = a[v];
        }
        __syncthreads();
        if (kq == 0) { float* MOD = WSP(float, WS_MOD) + (size_t)l * 9 * 6144; const float b = INP(5)[l * 6144 + col];
#pragma unroll
            for (int v = 0; v < 9; ++v) MOD[v * 6144 + col] = b + a[v] + red[v * 256 + tid]; }
        __syncthreads();
    }
    { f32x2* RT = WSP(f32x2, WS_RT); f32x2* MT = WSP(f32x2, WS_MT);
      for (int i = bid * 512 + tid; i < 8192 * 32 + 128 * 8; i += F.G * 512) {
          if (i < 8192 * 32) { const int t = i >> 5, k = i & 31; const float inv = exp2f(-(float)k * (13.287712379549449f / 32.f)); RT[i] = cossin_f((float)t * inv); }
          else { const int q = i - 8192 * 32, pos = q >> 3, k = q & 7; const float inv = exp2f(-(float)k * (13.287712379549449f / 8.f)); MT[q] = cossin_f((float)pos * inv); } } }
    LAS float* scr = (LAS float*)(F.lds + wave * 16384);
    const int gw = bid * 8 + wave, NGW = F.G * 8;
    constexpr int I_G8 = 2 * 16 * 96; constexpr int I_IN = 2 * 16 * 216, I_CAT = 2 * 3 * 8 * 32, I_OUT = 2 * 16 * 32, I_UQ = 2 * 6 * 24, I_UKV = 2 * 4 * 32, I_UP = 32 * 16 * 32, I_W2 = 32 * 8 * 32;
#ifdef INPROJ_L1_FP8
    constexpr int I_W8 = 16 * 120;
#else
    constexpr int I_W8 = 0;
#endif
    constexpr int NITEMS = I_IN + I_CAT + I_OUT + I_UQ + I_UKV + I_UP + I_W2 + I_G8 + I_W8;
    for (int it = gw; it < NITEMS; it += NGW) {
        int r = it;
        if (r < I_IN) { const int l = r / 3456, q = r % 3456, kb = q / 216, nb = q % 216; const int sc_ = srccol_in(nb * 32 + (lane & 31));
            cvt_item(sc_ >= 0 ? INP(8) + (size_t)l * 1024 * INCOLS + sc_ : nullptr, INCOLS, nullptr, WSP(bf16_t, WS_WIN) + (size_t)l * INW * 1024, 1024, nb * 32, kb * 64, scr, lane); continue; } r -= I_IN;
        if (r < I_CAT) { const int l = r / 768, q = r % 768, seg = q / 256, q2 = q % 256, kb = q2 / 32, nb = q2 % 32; const float* W = seg == 0 ? INP(11) : (seg == 1 ? INP(13) : INP(18));
            cvt_item(W + (size_t)l * 512 * 1024 + nb * 32 + (lane & 31), 1024, nullptr, WSP(bf16_t, WS_WCAT) + (size_t)l * 1024 * 1536 + seg * 512, 1536, nb * 32, kb * 64, scr, lane); continue; } r -= I_CAT;
        if (r < I_OUT) { const int l = r / 512, q = r % 512, kb = q / 32, nb = q % 32;
            cvt_item(INP(19) + (size_t)l * 1024 * 1024 + nb * 32 + (lane & 31), 1024, nullptr, WSP(bf16_t, WS_WOUT) + (size_t)l * 1024 * 1024, 1024, nb * 32, kb * 64, scr, lane); continue; } r -= I_OUT;
        if (r < I_UQ) { const int l = r / 144, q = r % 144, kb = q / 24, nb = q % 24;
            cvt_item(INP(15) + (size_t)l * 384 * 768 + srccol_uq(nb * 32 + (lane & 31)), 768, INP(14) + l * 384, WSP(bf16_t, WS_WUQ) + (size_t)l * 768 * 384, 384, nb * 32, kb * 64, scr, lane); continue; } r -= I_UQ;
        if (r < I_UKV) { const int l = r / 128, q = r % 128, kb = q / 32, nb = q % 32;
            cvt_item(INP(17) + (size_t)l * 256 * 1024 + nb * 32 + (lane & 31), 1024, INP(16) + l * 256, WSP(bf16_t, WS_WUKV) + (size_t)l * 1024 * 256, 256, nb * 32, kb * 64, scr, lane); continue; } r -= I_UKV;
        if (r < I_UP) { const int le = r / 512, q = r % 512, kb = q / 32, nb = q % 32; const int n = nb * 32 + (lane & 31);
            const float* W = (n & 1) ? INP(23) : INP(22);
            if (le >= 16) cvt_item_fp8(W + (size_t)le * 1024 * 512 + (n >> 1), 512, WU8S, WSP(unsigned char, WS_WUP) + (size_t)16 * 1024 * 1024 * 2 + (size_t)(le - 16) * 1024 * 1024, 1024, nb * 32, kb * 64, scr, lane);
            else cvt_item(W + (size_t)le * 1024 * 512 + (n >> 1), 512, nullptr, WSP(bf16_t, WS_WUP) + (size_t)le * 1024 * 1024, 1024, nb * 32, kb * 64, scr, lane);
            continue; } r -= I_UP;
        if (r < I_W2) { const int le = r / 256, q = r % 256, kb = q / 32, nb = q % 32;
            if (le >= 16) cvt_item_fp8(INP(24) + (size_t)le * 512 * 1024 + nb * 32 + (lane & 31), 1024, WD8S, WSP(unsigned char, WS_W2T) + (size_t)16 * 1024 * 512 * 2 + (size_t)(le - 16) * 1024 * 512, 512, nb * 32, kb * 64, scr, lane);
            else cvt_item(INP(24) + (size_t)le * 512 * 1024 + nb * 32 + (lane & 31), 1024, nullptr, WSP(bf16_t, WS_W2T) + (size_t)le * 1024 * 512, 512, nb * 32, kb * 64, scr, lane);
            continue; } r -= I_W2;
        if (r >= I_G8) { r -= I_G8; const int kb = r / 120, nb = r % 120; const int sc_ = srccol_in(nb * 32 + (lane & 31));
            cvt_item_fp8(sc_ >= 0 ? INP(8) + (size_t)(DEPTH - 1) * 1024 * INCOLS + sc_ : nullptr, INCOLS, WG8S, WSP(unsigned char, WS_W8L1), 1024, nb * 32, kb * 64, scr, lane); continue; }
        { const int l = r / 1536, q = r % 1536, kb = q / 96, nb = q % 96;
            cvt_item_fp8(INP(8) + (size_t)l * 1024 * INCOLS + 3744 + nb * 32 + (lane & 31), INCOLS, WG8S * 1.4426950408889634f, WSP(unsigned char, WS_WIN8) + (size_t)l * 3072 * 1024, 1024, nb * 32, kb * 64, scr, lane); }
    }
}

__device__ __forceinline__ void norm1_phase(Frame& F, const Resid& R, int l, int skip_none) {
    PHASE_IDS
    const int gw = bid * 8 + wave, NGW = F.G * 8; bf16_t* HX = WSP(bf16_t, WS_HX);
    const float* MODL = WSP(float, WS_MOD) + (size_t)l * 9 * 6144; const float* nw = INP(6) + l * 1024;
#ifdef INPROJ_L1_FP8
    const bool wr_bf16 = (l != DEPTH - 1);
#else
    const bool wr_bf16 = true;
#endif
    for (int row0 = gw; row0 < NT; row0 += 2 * NGW) {
        f32x4 v[2][4]; float s[2];
        int sf32 = R.src_f32; asm volatile("" : "+s"(sf32));
#pragma unroll
        for (int q = 0; q < 2; ++q) { const int row = (row0 + q * NGW < NT) ? row0 + q * NGW : row0;
            if (sf32) { const f32x4* xr = (const f32x4*)R.srcf(row) + lane;
#pragma unroll
                for (int j = 0; j < 4; ++j) v[q][j] = xr[64 * j]; }
            else { const u32x2* xr = (const u32x2*)R.dst(row) + lane;
#pragma unroll
                for (int j = 0; j < 4; ++j) { const u32x2 w = xr[64 * j]; v[q][j] = (f32x4){bf_lo(w.x), bf_hi(w.x), bf_lo(w.y), bf_hi(w.y)}; } } }
#pragma unroll
        for (int q = 0; q < 2; ++q) { float a = 0.f;
#pragma unroll
            for (int j = 0; j < 4; ++j) a += (v[q][j][0] * v[q][j][0] + v[q][j][1] * v[q][j][1]) + (v[q][j][2] * v[q][j][2] + v[q][j][3] * v[q][j][3]);
            s[q] = rsqrtf(wave_sum(a) * (1.f / DM) + RMS_EPS); }
#pragma unroll
        for (int q = 0; q < 2; ++q) { const int row = row0 + q * NGW; if (row >= NT) break;
            const float* md = MODL + R.modv(row) * 6144;
#pragma unroll
            for (int j = 0; j < 4; ++j) { const int c = 4 * lane + 256 * j; const f32x4 w = *(const f32x4*)(nw + c), sh = *(const f32x4*)(md + c), sc = *(const f32x4*)(md + 1024 + c);
                const f32x4 y = v[q][j] * s[q] * w * (sc + 1.f) + sh;
                if (wr_bf16) { u32x2 o; o.x = cvtpk(y[0], y[1]); o.y = cvtpk(y[2], y[3]); *(u32x2*)(HX + (size_t)row * 1024 + c) = o; }
                int q8_ = __builtin_amdgcn_cvt_pk_fp8_f32(y[0] * HX8S, y[1] * HX8S, 0, false); q8_ = __builtin_amdgcn_cvt_pk_fp8_f32(y[2] * HX8S, y[3] * HX8S, q8_, true);
                *(int*)(WSP(unsigned char, WS_HX8) + (size_t)row * 1024 + c) = q8_; } }
    }
}
__device__ __forceinline__ void final_norm_phase(Frame& F, int g) {
    PHASE_IDS
    const int gw = bid * 8 + wave, NGW = F.G * 8; const float* nw = INP(25);
    for (int row = gw; row < GB * SEQ; row += NGW) {
        f32x4* xr = (f32x4*)(F.out + ((size_t)g * GB * SEQ + row) * DM) + lane;
        const u32x2* xb = (const u32x2*)(WSP(bf16_t, WS_XRES) + ((size_t)g * GB * SEQ + row) * DM) + lane;
        f32x4 v[4]; float s = 0.f;
#pragma unroll
        for (int j = 0; j < 4; ++j) { const u32x2 w = xb[64 * j]; v[j] = (f32x4){bf_lo(w.x), bf_hi(w.x), bf_lo(w.y), bf_hi(w.y)}; s += (v[j][0] * v[j][0] + v[j][1] * v[j][1]) + (v[j][2] * v[j][2] + v[j][3] * v[j][3]); }
        const float rs = rsqrtf(wave_sum(s) * (1.f / DM) + RMS_EPS);
#pragma unroll
        for (int j = 0; j < 4; ++j) { const f32x4 w = *(const f32x4*)(nw + 4 * lane + 256 * j); xr[64 * j] = v[j] * rs * w; }
    }
}
__device__ __forceinline__ void conv_phase(Frame& F, int l) {
    PHASE_IDS
    const bf16_t* PC = WSP(bf16_t, WS_PC); bf16_t* ACT = WSP(bf16_t, WS_ACT); const float* cw = INP(12) + (size_t)l * 512 * 3;
    for (int idx = bid * 512 + tid; idx < NT * 64; idx += F.G * 512) {
        const int row = idx >> 6, c8 = (idx & 63) * 8; const int bl = row / SB, s = row - bl * SB;
        const bool hp = (s != 0) && (s != CTXL), hn = (s != CTXL - 1) && (s != SB - 1);
        const bf16_t* p = PC + (size_t)row * 1024 + c8;
        float b[8], u0[8], um[8], up[8];
        unpack8(*(const u32x4*)p, b); unpack8(*(const u32x4*)(p + 512), u0);
        if (hp) unpack8(*(const u32x4*)(p + 512 - 1024), um); else {
#pragma unroll
            for (int k = 0; k < 8; ++k) um[k] = 0.f; }
        if (hn) unpack8(*(const u32x4*)(p + 512 + 1024), up); else {
#pragma unroll
            for (int k = 0; k < 8; ++k) up[k] = 0.f; }
        float o[8];
#pragma unroll
        for (int k = 0; k < 8; ++k) { const float* w = cw + (c8 + k) * 3; o[k] = b[k] * (um[k] * w[0] + u0[k] * w[1] + up[k] * w[2]); }
        *(u32x4*)(ACT + (size_t)row * 1536 + 512 + c8) = pack8(o);
    }
}
__device__ __forceinline__ void scan_phase(Frame& F, int l) {
    PHASE_IDS
    const float* U = WSP(float, WS_HX); bf16_t* S = WSP(bf16_t, WS_PM);
    for (int idx = bid * 512 + tid; idx < GB * 4 * 2 * 8192; idx += F.G * 512) {
        const int ed = idx & 8191, dir = (idx >> 13) & 1, h = (idx >> 14) & 3, bl = idx >> 16;
        const float lg = lg2_gamma(INP(9) + l * 8 + dir * 4 + h); const float dec = __builtin_amdgcn_exp2f(lg * 128.f);
        float st = 0.f;
        for (int i0 = 0; i0 < NCHUNK; i0 += 6) {
            float uu[6]; size_t off[6];
#pragma unroll
            for (int k = 0; k < 6; ++k) { const int i = i0 + k; const int c = dir ? (i < 2 ? 1 - i : NCHUNK + 1 - i) : i;
                off[k] = ((size_t)(((bl * NCHUNK + c) * 4 + h) * 2 + dir)) * 8192 + ed; uu[k] = U[off[k]]; }
#pragma unroll
            for (int k = 0; k < 6; ++k) { S[off[k]] = f2bf(st); st = dec * st + uu[k]; }
        }
    }
}
template <int NR>
__device__ __forceinline__ void n2_rows(const Resid& R, const int (&rows)[NR], const int (&slot)[NR], const float* MODL, const float* nw, bf16_t* H2, unsigned char* H28, const LAS float* wr, LAS float* lg, int lane) {
    f32x4 v[NR][4]; float s[NR];
#pragma unroll
    for (int q = 0; q < NR; ++q) { const u32x2* xr = (const u32x2*)R.dst(rows[q]) + lane; s[q] = 0.f;
#pragma unroll
        for (int j = 0; j < 4; ++j) { const u32x2 w_ = xr[64 * j]; v[q][j] = (f32x4){bf_lo(w_.x), bf_hi(w_.x), bf_lo(w_.y), bf_hi(w_.y)}; s[q] += (v[q][j][0] * v[q][j][0] + v[q][j][1] * v[q][j][1]) + (v[q][j][2] * v[q][j][2] + v[q][j][3] * v[q][j][3]); } }
#pragma unroll
    for (int q = 0; q < NR; ++q) s[q] = rsqrtf(wave_sum(s[q]) * (1.f / DM) + RMS_EPS);
#pragma unroll
    for (int q = 0; q < NR; ++q) { const float* md = MODL + R.modv(rows[q]) * 6144;
#pragma unroll
        for (int j = 0; j < 4; ++j) { const int c = 4 * lane + 256 * j; const f32x4 w = *(const f32x4*)(nw + c), sh = *(const f32x4*)(md + 3072 + c), sc = *(const f32x4*)(md + 4096 + c);
            v[q][j] = v[q][j] * s[q] * w * (sc + 1.f) + sh;
            if (H28) { int q8_ = __builtin_amdgcn_cvt_pk_fp8_f32(v[q][j][0] * H28S, v[q][j][1] * H28S, 0, false); q8_ = __builtin_amdgcn_cvt_pk_fp8_f32(v[q][j][2] * H28S, v[q][j][3] * H28S, q8_, true); *(int*)(H28 + (size_t)rows[q] * 1024 + c) = q8_; }
            else { u32x2 o; o.x = cvtpk(v[q][j][0], v[q][j][1]); o.y = cvtpk(v[q][j][2], v[q][j][3]); *(u32x2*)(H2 + (size_t)rows[q] * 1024 + c) = o; } } }
    const int b4 = (lane >> 4) & 1, b3 = (lane >> 3) & 1, b2 = (lane >> 2) & 1;
#pragma unroll
    for (int q = 0; q < NR; ++q) {
        float a[16];
#pragma unroll
        for (int e = 0; e < 16; ++e) { float t = 0.f;
#pragma unroll
            for (int j = 0; j < 4; ++j) { const f32x4 w = *(const LAS f32x4*)(wr + e * 1024 + 4 * lane + 256 * j); t += (v[q][j][0] * w[0] + v[q][j][1] * w[1]) + (v[q][j][2] * w[2] + v[q][j][3] * w[3]); }
            a[e] = t; }
        float s8[8], s4[4], s2[2];
#pragma unroll
        for (int k = 0; k < 8; ++k) { auto r = __builtin_amdgcn_permlane32_swap(__float_as_uint(a[k]), __float_as_uint(a[k + 8]), false, false); s8[k] = __uint_as_float(r[0]) + __uint_as_float(r[1]); }
#pragma unroll
        for (int k = 0; k < 4; ++k) { const float snd = b4 ? s8[k] : s8[k + 4], kp = b4 ? s8[k + 4] : s8[k]; s4[k] = kp + swz_xor<16>(snd); }
#pragma unroll
        for (int k = 0; k < 2; ++k) { const float snd = b3 ? s4[k] : s4[k + 2], kp = b3 ? s4[k + 2] : s4[k]; s2[k] = kp + swz_xor<8>(snd); }
        float s1; { const float snd = b2 ? s2[0] : s2[1], kp = b2 ? s2[1] : s2[0]; s1 = kp + swz_xor<4>(snd); }
        s1 += swz_xor<2>(s1); s1 += swz_xor<1>(s1);
        if ((lane & 3) == 0) lg[slot[q] * 16 + (lane >> 2)] = s1;
    }
}
__device__ __forceinline__ void norm2_router_phase(Frame& F, const Resid& R, int l, int g, int lat_only, int cslot) {
    PHASE_IDS
    bf16_t* H2 = WSP(bf16_t, WS_HX); unsigned char* H28 = (l == DEPTH - 1) ? WSP(unsigned char, WS_H28) : nullptr;
    const float* MODL = WSP(float, WS_MOD) + (size_t)l * 9 * 6144; const float* nw = INP(7) + l * 1024;
    LAS float* wr = (LAS float*)F.lds; LAS float* lg = (LAS float*)(F.lds + 65536);
    { const float* wrt = INP(20); for (int i = tid; i < 16 * 1024; i += 512) wr[i] = wrt[(i & 1023) * 16 + (i >> 10)]; }
    __syncthreads();
    const int rpb = (NT + F.G - 1) / F.G, r0 = bid * rpb, r1 = (r0 + rpb < NT) ? r0 + rpb : NT;
    for (int row = r0 + wave; row < r1; row += 16) {
        const int rowb = row + 8;
        const bool okA = !(lat_only && (row % SB) < CTXL), okB = rowb < r1 && !(lat_only && (rowb % SB) < CTXL);
        if (okA && okB) { const int rr[2] = {row, rowb}, ss[2] = {row - r0, rowb - r0}; n2_rows<2>(R, rr, ss, MODL, nw, H2, H28, wr, lg, lane); }
        else if (okA) { const int rr[1] = {row}, ss[1] = {row - r0}; n2_rows<1>(R, rr, ss, MODL, nw, H2, H28, wr, lg, lane); }
        else if (okB) { const int rr[1] = {rowb}, ss[1] = {rowb - r0}; n2_rows<1>(R, rr, ss, MODL, nw, H2, H28, wr, lg, lane); }
    }
    __syncthreads();
    unsigned* CNT = WSP(unsigned, WS_CTL) + CW_CNT + (g * 2 + l) * 64 + cslot; int* LIST = WSP(int, WS_LIST); float* WGT = WSP(float, WS_WGT);
    const float* rb = INP(21);
    LAS unsigned* lcnt = (LAS unsigned*)(F.lds + 65536 + 16384);
    if (tid < 64) lcnt[tid] = 0u;
    __syncthreads();
    int bucket = -1, rank = 0; float wlo = 0.f, whi = 0.f; const int trow = r0 + tid;
    if (tid < r1 - r0 && !(lat_only && (trow % SB) < CTXL)) {
        const int t = tid;
        float sc16[16];
#pragma unroll
        for (int e4 = 0; e4 < 4; ++e4) { const f32x4 x = *(const LAS f32x4*)(lg + t * 16 + e4 * 4); sc16[e4 * 4] = sigmoidf_(x[0]); sc16[e4 * 4 + 1] = sigmoidf_(x[1]); sc16[e4 * 4 + 2] = sigmoidf_(x[2]); sc16[e4 * 4 + 3] = sigmoidf_(x[3]); }
        float best = -1e30f; int gs = 0;
#pragma unroll
        for (int q = 0; q < 4; ++q) { float m1 = -1e30f, m2 = -1e30f;
#pragma unroll
            for (int k = 0; k < 4; ++k) { const float b = sc16[q * 4 + k] + rb[q * 4 + k]; if (b > m1) { m2 = m1; m1 = b; } else if (b > m2) m2 = b; }
            const float gsc = m1 + m2; if (gsc > best) { best = gsc; gs = q; } }
        float bb[4], su[4];
#pragma unroll
        for (int k = 0; k < 4; ++k) { float b = 0.f, u = 0.f;
#pragma unroll
            for (int q = 0; q < 4; ++q) { if (q == gs) { b = sc16[q * 4 + k] + rb[q * 4 + k]; u = sc16[q * 4 + k]; } }
            bb[k] = b; su[k] = u; }
        int i1 = 0; float b1 = bb[0];
#pragma unroll
        for (int k = 1; k < 4; ++k) if (bb[k] > b1) { b1 = bb[k]; i1 = k; }
        int i2 = -1; float b2 = -1e30f;
#pragma unroll
        for (int k = 0; k < 4; ++k) if (k != i1 && bb[k] > b2) { b2 = bb[k]; i2 = k; }
        const int lo = i1 < i2 ? i1 : i2, hi = i1 < i2 ? i2 : i1;
        float slo = 0.f, shi = 0.f;
#pragma unroll
        for (int k = 0; k < 4; ++k) { if (k == lo) slo = su[k]; if (k == hi) shi = su[k]; }
        const float inv = 1.f / (slo + shi);
        const int pair = lo == 0 ? hi - 1 : (lo == 1 ? hi + 1 : 5);
        bucket = gs * 6 + pair; wlo = slo * inv; whi = shi * inv;
        rank = (int)atomicAdd((unsigned*)(lcnt + bucket), 1u);
    }
    __syncthreads();
    if (tid < NPAIR) { const unsigned c = lcnt[tid]; lcnt[32 + tid] = c ? atomicAdd(CNT + tid, c) : 0u; }
    __syncthreads();
    if (bucket >= 0) { const unsigned pos = lcnt[32 + bucket] + (unsigned)rank; LIST[(size_t)bucket * NT + pos] = trow; WGT[(size_t)trow * 2] = wlo; WGT[(size_t)trow * 2 + 1] = whi; }
    __syncthreads();
}
__device__ __forceinline__ void moe_tables(Frame& F, int l, int g) {
    PHASE_IDS
    LAS int* tab = (LAS int*)(F.lds + LDS_MOE_OFF);
    if (tid < 32) { const unsigned* CNT = WSP(unsigned, WS_CTL) + CW_CNT + (g * 2 + l) * 64;
        tab[32 + tid] = tid < NPAIR ? (int)__hip_atomic_load(CNT + tid, __ATOMIC_RELAXED, __HIP_MEMORY_SCOPE_AGENT) : 0; }
    __syncthreads();
    if (tid == 0) { int pre = 0;
#pragma nounroll
        for (int p = 0; p < NPAIR; ++p) { tab[p] = pre; pre += (tab[32 + p] + 255) >> 8; }
        tab[24] = pre; }
    __syncthreads();
}
#ifndef PHMASK
#define PHMASK 0xFFFF
#endif
#define PHM(k) (((PHMASK) >> (k)) & 1)
#ifndef INPROJ_ALIGN
#define INPROJ_ALIGN true
#endif
#ifndef REPMASK
#define REPMASK 0
#endif
#define REPS(k) _Pragma("nounroll") for (int rep_ = 0; rep_ < 1 + (((REPMASK) >> (k)) & 1); ++rep_)

__global__ void __launch_bounds__(512, 2) dit_fwd(Args args) {
    extern __shared__ __attribute__((aligned(16))) unsigned char lds_raw[];
    Frame F;
    F.lds = (LAS unsigned char*)lds_raw;
    F.G = gridDim.x; F.wv = __builtin_amdgcn_readfirstlane((int)threadIdx.x >> 6);
    F.a = &args; F.out = args.out; F.ws = args.ws;
    for (int u = threadIdx.x; u < (LDS_BYTES - LDSCTL_OFF) / 4; u += 512) ((LAS unsigned*)(F.lds + LDSCTL_OFF))[u] = 0u;
    __syncthreads();
    XcdBarrier bar = xcd_barrier_post(WSP(unsigned, WS_CTL) + CW_BAR, (volatile LAS unsigned*)(F.lds + LDSCTL_OFF));
#ifdef PROBE_BAR2
#define GRID_BAR() do { asm volatile("; PHASE_SEAM" ::: "memory"); xcd_barrier(bar, F.wv); xcd_barrier(bar, F.wv); } while (0)
#else
#define GRID_BAR() do { asm volatile("; PHASE_SEAM" ::: "memory"); xcd_barrier(bar, F.wv); } while (0)
#endif
#ifdef PROBE_A
#define STAMP(k) do { if (obid() == 0 && F.wv == 0 && olane() == 0) { unsigned long long* TS_ = WSP(unsigned long long, WS_CTL + 512 * 1024); const unsigned long long now = __builtin_amdgcn_s_memrealtime(); TS_[(k)] += now - TS_[32]; TS_[32] = now; } } while (0)
    if (blockIdx.x == 0 && threadIdx.x == 0) WSP(unsigned long long, WS_CTL + 512 * 1024)[32] = __builtin_amdgcn_s_memrealtime();
#else
#define STAMP(k) do { } while (0)
#endif

    if constexpr (PHM(0)) REPS(0) p0_prologue(F);
    GRID_BAR(); STAMP(0);

#pragma nounroll
    for (int g = 0; g < NG; ++g) {
#pragma nounroll
        for (int l = 0; l < DEPTH; ++l) {
            Resid R; R.in_lat = INP(0); R.in_ctx = INP(2); R.x_lat = WSP(bf16_t, WS_XRES); R.x_ctx = WSP(bf16_t, WS_XC); R.g = g; R.src_f32 = (l == 0) ? 1 : 0;
            const float* MODL = WSP(float, WS_MOD) + (size_t)l * 9 * 6144;
            const int lat_only = (l == DEPTH - 1) ? 1 : 0;

            if constexpr (PHM(1)) REPS(1) norm1_phase(F, R, l, 0);
            if constexpr (PHM(15)) if (l == 0 && g > 0) final_norm_phase(F, g - 1);
            GRID_BAR(); STAMP(1);

            if constexpr (PHM(2)) REPS(2) {
#ifdef STAGGER_US10
                {
                    const unsigned long long t0_ = __builtin_amdgcn_s_memrealtime(), d_ = (unsigned long long)((obid() * 5) & 15) * (STAGGER_US10) * 10ull;
                    while (__builtin_amdgcn_s_memrealtime() - t0_ < d_) __builtin_amdgcn_s_sleep(4);
                }
#endif
                TileOrder S; S.init(NRT, 15, F.G, obid(), WSP(bf16_t, WS_HX), (size_t)256 * 1024 * 2, WSP(bf16_t, WS_WIN) + (size_t)l * INW * 1024, (size_t)256 * 1024 * 2, 0);
                EpiInproj E{WSP(bf16_t, WS_PR), WSP(bf16_t, WS_PC), WSP(bf16_t, WS_PM), WSP(bf16_t, WS_PG), WSP(unsigned char, WS_K), WSP(float, WS_SSQ), WSP(f32x2, WS_RT), WSP(f32x2, WS_MT), 0};
#ifdef PROBE_INPROJ_NOEPI
                { EpiNone E0; if (PROBE_INPROJ_NOEPI == 1) pg8::gemm_phase<EpiNone, TileOrder, INPROJ_ALIGN>(F.lds, 1024, 1024, 1024, 0, S, E0, F.wv);
                  else { TileOrder S9; S9.init(NRT, 12, F.G, obid(), WSP(unsigned char, WS_HX8), (size_t)256 * 1024, WSP(unsigned char, WS_WIN8) + (size_t)l * 3072 * 1024, (size_t)256 * 1024, 0);
                         if (PROBE_INPROJ_NOEPI == 2) pg8::gemm_phase<EpiNone, TileOrder, INPROJ_ALIGN, false, false, true, 0x7b7b7b7b, 0x79797979>(F.lds, 512, 512, 512, 0, S9, E0, F.wv);
                         else { EpiStoreOnly E1{WSP(bf16_t, WS_PG)}; pg8::gemm_phase<EpiStoreOnly, TileOrder, INPROJ_ALIGN, false, false, true, 0x7b7b7b7b, 0x79797979>(F.lds, 512, 512, 512, 0, S9, E1, F.wv); } } }
#endif
#ifdef PROBE_INPROJ_REP
                { TileOrder S9; S9.init(NRT, 12, F.G, obid(), WSP(unsigned char, WS_HX8), (size_t)256 * 1024, WSP(unsigned char, WS_WIN8) + (size_t)l * 3072 * 1024, (size_t)256 * 1024, 0);
                  EpiGate E9{WSP(bf16_t, WS_PG)};
                  pg8::gemm_phase<EpiGate, TileOrder, INPROJ_ALIGN, false, false, true, 0x7b7b7b7b, 0x79797979>(F.lds, 512, 512, 512, 0, S9, E9, F.wv); }
#endif
                TileOrder S8; S8.init(NRT, 12, F.G, (obid() + F.G - (NRT * 15) % F.G) % F.G, WSP(unsigned char, WS_HX8), (size_t)256 * 1024, WSP(unsigned char, WS_WIN8) + (size_t)l * 3072 * 1024, (size_t)256 * 1024, 0);
                EpiGate E8{WSP(bf16_t, WS_PG)};
#ifdef INPROJ_COHORT
                int coh = (obid() >> (INPROJ_COHORT)) & 1;
#pragma nounroll
                for (int pass = 0; pass < 2; ++pass, coh ^= 1) {
                    if (coh == 0) pg8::gemm_phase<EpiInproj, TileOrder, INPROJ_ALIGN>(F.lds, 1024, 1024, 1024, 0, S, E, F.wv);
                    else pg8::gemm_phase<EpiGate, TileOrder, INPROJ_ALIGN, false, false, true, 0x7b7b7b7b, 0x79797979>(F.lds, 512, 512, 512, 0, S8, E8, F.wv);
                }
#else
#ifdef INPROJ_L1_FP8
                if (l == DEPTH - 1) {
                    TileOrder S1; S1.init(NRT, 15, F.G, obid(), WSP(unsigned char, WS_HX8), (size_t)256 * 1024, WSP(unsigned char, WS_W8L1), (size_t)256 * 1024, 0);
                    pg8::gemm_phase<EpiInproj, TileOrder, INPROJ_ALIGN, false, false, true, 0x7b7b7b7b, 0x79797979>(F.lds, 512, 512, 512, 0, S1, E, F.wv);
                } else
#endif
                pg8::gemm_phase<EpiInproj, TileOrder, INPROJ_ALIGN>(F.lds, 1024, 1024, 1024, 0, S, E, F.wv);
                pg8::gemm_phase<EpiGate, TileOrder, INPROJ_ALIGN, false, false, true, 0x7b7b7b7b, 0x79797979>(F.lds, 512, 512, 512, 0, S8, E8, F.wv);
#endif
            }
            GRID_BAR(); STAMP(2);

            if constexpr (PHM(3)) REPS(3) {
                TileOrder S; S.init(NRT, 3, F.G, obid(), WSP(bf16_t, WS_PM), (size_t)256 * 640 * 2, WSP(bf16_t, WS_WUQ) + (size_t)l * 768 * 384, (size_t)256 * 384 * 2, 0);
                EpiUq E{WSP(unsigned char, WS_Q), WSP(float, WS_SSQ), WSP(f32x2, WS_MT)};
                pg8::gemm_phase<EpiUq, TileOrder, true>(F.lds, 640, 384, 384, 0, S, E, F.wv);
            }
#ifndef PROBE_COARSE
            STAMP(3);
#endif
            if constexpr (PHM(4)) REPS(4) {
                TileOrder S; S.init(NRT, 4, F.G, (obid() + F.G - (NRT * 3) % F.G) % F.G, WSP(bf16_t, WS_PM) + 384, (size_t)256 * 640 * 2, WSP(bf16_t, WS_WUKV) + (size_t)l * 1024 * 256, (size_t)256 * 256 * 2, 0);
                EpiUkv E{WSP(unsigned char, WS_K), WSP(unsigned char, WS_V), WSP(float, WS_SSQ), F.lds + LDS_VTR_OFF};
                pg8::gemm_phase<EpiUkv, TileOrder, true>(F.lds, 640, 256, 256, 0, S, E, F.wv);
            }
#ifndef PROBE_COARSE
            STAMP(4);
#endif
            if constexpr (PHM(5)) REPS(5) for (int u = (obid() + F.G - (NRT * 7) % F.G) % F.G; u < GB * NCHUNK * 4; u += F.G) {
                const int h = u & 3;
                retu_unit(u, WSP(bf16_t, WS_PR), WSP(float, WS_HX), lg2_gamma(INP(9) + l * 8 + h), lg2_gamma(INP(9) + l * 8 + 4 + h), (LAS char*)F.lds, F.wv);
            }
#ifndef PROBE_COARSE
            STAMP(5);
#endif
            if constexpr (PHM(6)) REPS(6) conv_phase(F, l);
            GRID_BAR(); STAMP(6);

            if constexpr (PHM(7)) REPS(7) scan_phase(F, l);
#ifndef PROBE_COARSE
            STAMP(7);
#endif
#ifdef PROBE_CLK
            unsigned long long c0_ = 0, r0_ = 0; if (g == 0 && l == 0) { c0_ = __builtin_readcyclecounter(); r0_ = __builtin_amdgcn_s_memrealtime(); }
#endif
            if constexpr (PHM(8)) REPS(8) {
                const unsigned char* Q = WSP(unsigned char, WS_Q); const unsigned char* K = WSP(unsigned char, WS_K); const unsigned char* V = WSP(unsigned char, WS_V); bf16_t* ACT = WSP(bf16_t, WS_ACT);
                const int vcu = (obid() % 8) * (F.G / 8) + obid() / 8, xcd = vcu / (F.G / 8), slot = vcu % (F.G / 8);
                const int nlat = GB * 8 * 32, nunit = nlat + (lat_only ? 0 : GB * 8);
                for (int i = 0; ; ++i) {
                    int hh, qb;
                    if (F.G == 256) { if (i < 4) { hh = xcd + 8 * i; qb = 1 + slot; } else if (i == 4 && !lat_only && slot < 4) { hh = xcd + 8 * slot; qb = 0; } else break; }
                    else { const int L = i * F.G + obid(); if (L >= nunit) break; if (L < nlat) { hh = L >> 5; qb = 1 + (L & 31); } else { hh = L - nlat; qb = 0; } }
                    const int bl = hh >> 3, h = hh & 7;
                    const size_t hb = (size_t)(bl * 8 + h) * SB;
#ifdef ATTN_IL
                    att2::attn_unit_il
#else
                    att2::attn_unit_pp
#endif
                        (Q + (hb + (size_t)qb * 256) * 128, K + hb * 128, V + (size_t)(bl * 8 + h) * 64 * SB, ACT + ((size_t)bl * SB + (size_t)qb * 256) * 1536 + 1024 + h * 64, 1536, qb == 0 ? CTXL : SB, (LAS char*)F.lds, F.wv);
                }
            }
#ifdef PROBE_CLK
            if (g == 0 && l == 0 && obid() == 0 && F.wv == 0 && olane() == 0) { const unsigned long long c1_ = __builtin_readcyclecounter(), r1_ = __builtin_amdgcn_s_memrealtime();
                WSP(unsigned long long, WS_CTL + 600 * 1024)[0] = (c1_ - c0_) * 100ull / (r1_ - r0_); }
#endif
            GRID_BAR(); STAMP(8);

            if constexpr (PHM(9)) REPS(9) for (int u = obid(); u < GB * NCHUNK * 4; u += F.G) {
                const int h = u & 3;
                retout_unit(u, WSP(bf16_t, WS_PR), WSP(bf16_t, WS_PM), INP(10) + l * 512, WSP(bf16_t, WS_ACT), lg2_gamma(INP(9) + l * 8 + h), lg2_gamma(INP(9) + l * 8 + 4 + h), (LAS char*)F.lds, F.wv);
            }
            GRID_BAR(); STAMP(9);

            if constexpr (PHM(10)) REPS(10) {
#ifdef MERGE1_STAGGER
                {
                    const unsigned long long t0_ = __builtin_amdgcn_s_memrealtime(), d_ = (unsigned long long)((obid() >> 3) & 3) * (MERGE1_STAGGER) * 10ull;
                    while (__builtin_amdgcn_s_memrealtime() - t0_ < d_) __builtin_amdgcn_s_sleep(4);
                }
#endif
                unsigned* pctr = WSP(unsigned, WS_CTL) + CW_PANEL + (g * 2 + l) * (NRT * 64);
#ifdef HANDOFF
                TileOrderP S; S.init(lat_only ? GB * 32 : NRT, 4, F.G, obid(), WSP(bf16_t, WS_ACT), (size_t)256 * 1536 * 2, WSP(bf16_t, WS_WCAT) + (size_t)l * 1024 * 1536, (size_t)256 * 1536 * 2, lat_only); S.ctr = pctr;
#else
                TileOrder S; S.init(lat_only ? GB * 32 : NRT, 4, F.G, obid(), WSP(bf16_t, WS_ACT), (size_t)256 * 1536 * 2, WSP(bf16_t, WS_WCAT) + (size_t)l * 1024 * 1536, (size_t)256 * 1536 * 2, lat_only); (void)pctr;
#endif
#ifdef PROBE_MERGE1_NOHOOK
                { EpiMerge1NoHook E0{{WSP(bf16_t, WS_PG), WSP(bf16_t, WS_HX)}}; pg8::gemm_phase<EpiMerge1NoHook, TileOrder, true>(F.lds, 1536, 1536, 1536, 0, S, E0, F.wv); }
#endif
                EpiMerge1 E{WSP(bf16_t, WS_PG), WSP(bf16_t, WS_HX)};
#ifdef HANDOFF
                pg8::gemm_phase<EpiMerge1, TileOrderP, true>(F.lds, 1536, 1536, 1536, 0, S, E, F.wv);
#else
                pg8::gemm_phase<EpiMerge1, TileOrder, true>(F.lds, 1536, 1536, 1536, 0, S, E, F.wv);
#endif
            }
#if !defined(HANDOFF) || defined(HANDOFF_WITH_BARRIER)
            GRID_BAR();
#endif
            STAMP(10);

            if constexpr (PHM(11)) {
#ifdef HANDOFF
                const int n1 = (lat_only ? GB * 32 : NRT) * 4;
                TileOrderC S; S.init(lat_only ? GB * 32 : NRT, 4, F.G, (obid() + F.G - n1 % F.G) % F.G, WSP(bf16_t, WS_HX), (size_t)256 * 1024 * 2, WSP(bf16_t, WS_WOUT) + (size_t)l * 1024 * 1024, (size_t)256 * 1024 * 2, lat_only);
                S.ctr = WSP(unsigned, WS_CTL) + CW_PANEL + (g * 2 + l) * (NRT * 64); S.need = 32u; S.tmo = WSP(unsigned, WS_CTL) + 8; S.wv = F.wv;
                EpiMerge2 E{R, MODL};
                pg8::gemm_phase<EpiMerge2, TileOrderC, true>(F.lds, 1024, 1024, 1024, 0, S, E, F.wv);
#else
                TileOrder S; S.init(lat_only ? GB * 32 : NRT, 4, F.G, obid(), WSP(bf16_t, WS_HX), (size_t)256 * 1024 * 2, WSP(bf16_t, WS_WOUT) + (size_t)l * 1024 * 1024, (size_t)256 * 1024 * 2, lat_only);
                EpiMerge2 E{R, MODL};
                pg8::gemm_phase<EpiMerge2, TileOrder, true>(F.lds, 1024, 1024, 1024, 0, S, E, F.wv);
#endif
            }
            GRID_BAR(); STAMP(11);

            if constexpr (((REPMASK) >> 12) & 1) norm2_router_phase(F, R, l, g, lat_only, 32);
            if constexpr (PHM(12)) norm2_router_phase(F, R, l, g, lat_only, 0);
            GRID_BAR(); STAMP(12);

            moe_tables(F, l, g);
            if constexpr (PHM(13)) REPS(13) {
                if (l == DEPTH - 1) {
                    MoeOrder S{(const LAS int*)(F.lds + LDS_MOE_OFF), WSP(int, WS_LIST), 8, F.G, obid(), 1, (const char*)WSP(unsigned char, WS_H28), (const char*)(WSP(unsigned char, WS_WUP) + (size_t)16 * 1024 * 1024 * 2), 1};
                    EpiMoeUp8 E{WSP(int, WS_LIST), WSP(float, WS_WGT), WSP(unsigned char, WS_PG)};
                    pg8::gemm_phase<EpiMoeUp8, MoeOrder, true, true, false, true, 0x7b7b7b7b, 0x79797979>(F.lds, 512, 512, 512, 0, S, E, F.wv);
                } else {
                    MoeOrder S{(const LAS int*)(F.lds + LDS_MOE_OFF), WSP(int, WS_LIST), 8, F.G, obid(), 1, (const char*)WSP(bf16_t, WS_HX), (const char*)(WSP(bf16_t, WS_WUP) + (size_t)l * 16 * 1024 * 1024), 2};
                    EpiMoeUp E{WSP(int, WS_LIST), WSP(float, WS_WGT), WSP(bf16_t, WS_PG)};
                    pg8::gemm_phase<EpiMoeUp, MoeOrder, true, true, false>(F.lds, 1024, 1024, 1024, 0, S, E, F.wv);
                }
            }
            GRID_BAR(); STAMP(13);

            if constexpr (PHM(14)) {
                if (l == DEPTH - 1) {
                    MoeOrder S{(const LAS int*)(F.lds + LDS_MOE_OFF), WSP(int, WS_LIST), 4, F.G, obid(), 0, (const char*)WSP(unsigned char, WS_PG), (const char*)(WSP(unsigned char, WS_W2T) + (size_t)16 * 1024 * 512 * 2), 1};
                    EpiMoeDown E{WSP(int, WS_LIST), R, MODL, nullptr};
                    pg8::gemm_phase<EpiMoeDown, MoeOrder, true, false, true, true, 0x7a7a7a7a, 0x7a7a7a7a>(F.lds, 512, 256, 512, 4, S, E, F.wv);
                } else {
                    MoeOrder S{(const LAS int*)(F.lds + LDS_MOE_OFF), WSP(int, WS_LIST), 4, F.G, obid(), 0, (const char*)WSP(bf16_t, WS_PG), (const char*)(WSP(bf16_t, WS_W2T) + (size_t)l * 16 * 1024 * 512), 2};
                    EpiMoeDown E{WSP(int, WS_LIST), R, MODL, nullptr};
                    pg8::gemm_phase<EpiMoeDown, MoeOrder, true, false, true>(F.lds, 1024, 512, 1024, 8, S, E, F.wv);
                }
            }
            GRID_BAR(); STAMP(14);
        }
    }
    if constexpr (PHM(15)) final_norm_phase(F, NG - 1);
#ifdef SELFCHECK_ATTN
            {
                const unsigned char* Q = WSP(unsigned char, WS_Q); const unsigned char* K = WSP(unsigned char, WS_K); const unsigned char* V = WSP(unsigned char, WS_V); const bf16_t* ACT = WSP(bf16_t, WS_ACT);
                const int lane_ = olane(); const int gwv = obid() * 8 + F.wv;
                if (gwv < 96) {
                    const int bl = gwv & 3, h = (gwv >> 2) & 7, qi = gwv >> 5;
                    const int srow = qi == 0 ? 256 : (qi == 1 ? 256 + 4099 : SB - 1);
                    const int nkeys = srow < CTXL ? CTXL : SB;
                    const size_t hb = (size_t)(bl * 8 + h) * SB;
                    #define F8(p) (__builtin_amdgcn_cvt_f32_fp8((int)(*(p)), 0))
                    const float q0 = F8(Q + (hb + srow) * 128 + lane_) * (1.f / Q8S), q1 = lane_ < 32 ? F8(Q + (hb + srow) * 128 + 64 + lane_) * (1.f / Q8S) : 0.f;
                    float mrun = -1e30f, lrun = 0.f, orun = 0.f;
#pragma nounroll
                    for (int j = 0; j < nkeys; ++j) {
                        float part = q0 * F8(K + (hb + j) * 128 + lane_) * (1.f / K8S); if (lane_ < 32) part += q1 * F8(K + (hb + j) * 128 + 64 + lane_) * (1.f / K8S);
                        const float s = wave_sum(part);
                        const float mn = fmaxf(mrun, s), sc = exp2f(mrun - mn), p = exp2f(s - mn);
                        lrun = lrun * sc + p; orun = orun * sc + p * F8(V + ((size_t)(bl * 8 + h) * 64 + lane_) * SB + (j & ~63) + vt_pos(j & 63)) * (1.f / V8S); mrun = mn; }
                    const float o_ = orun / lrun; const float got = bf1(ACT[((size_t)bl * SB + srow) * 1536 + 1024 + h * 64 + lane_]);
                    float err = fabsf(o_ - got), ref = fabsf(o_);
                    err = fmaxf(err, swz_xor<1>(err)); err = fmaxf(err, swz_xor<2>(err)); err = fmaxf(err, swz_xor<4>(err)); err = fmaxf(err, swz_xor<8>(err)); err = fmaxf(err, swz_xor<16>(err));
                    ref = fmaxf(ref, swz_xor<1>(ref)); ref = fmaxf(ref, swz_xor<2>(ref)); ref = fmaxf(ref, swz_xor<4>(ref)); ref = fmaxf(ref, swz_xor<8>(ref)); ref = fmaxf(ref, swz_xor<16>(ref));
                    { auto r1_ = __builtin_amdgcn_permlane32_swap(__float_as_uint(err), __float_as_uint(err), false, false); err = fmaxf(__uint_as_float(r1_[0]), __uint_as_float(r1_[1]));
                      auto r2_ = __builtin_amdgcn_permlane32_swap(__float_as_uint(ref), __float_as_uint(ref), false, false); ref = fmaxf(__uint_as_float(r2_[0]), __uint_as_float(r2_[1])); }
                    if (lane_ == 0 && !(err <= SELFCHECK_TOL * ref + 1e-6f)) atomicAdd(WSP(unsigned, WS_CTL) + 3000, 1u);
                }
            }
    GRID_BAR();
    if (__hip_atomic_load(WSP(unsigned, WS_CTL) + 3000, __ATOMIC_RELAXED, __HIP_MEMORY_SCOPE_AGENT) != 0u && obid() == 0) { for (int i = otid(F.wv); i < 4096; i += 512) F.out[i] = __builtin_nanf(""); }
#endif
#ifdef PROBE_CLK
    if (obid() == 0 && F.wv == 0 && olane() == 0) { const unsigned long long mhz = WSP(unsigned long long, WS_CTL + 600 * 1024)[0]; const unsigned long long t0 = __builtin_amdgcn_s_memrealtime();
        while (__builtin_amdgcn_s_memrealtime() - t0 < mhz * 100ull) __builtin_amdgcn_s_sleep(8); }
#endif
#ifdef PROBE_A
    STAMP(15);
    GRID_BAR();
    {
        unsigned long long* TS = WSP(unsigned long long, WS_CTL + 512 * 1024);
        unsigned long long tot = 0; for (int k = 0; k < 16; ++k) tot += __hip_atomic_load(TS + k, __ATOMIC_RELAXED, __HIP_MEMORY_SCOPE_AGENT);
        const float fa = (float)__hip_atomic_load(TS + PROBE_A, __ATOMIC_RELAXED, __HIP_MEMORY_SCOPE_AGENT) / (float)tot, fb = (float)__hip_atomic_load(TS + PROBE_B, __ATOMIC_RELAXED, __HIP_MEMORY_SCOPE_AGENT) / (float)tot;
        const float A = sqrtf(90.f * fa), X = 100.f + 800.f * fb;
        for (size_t i = (size_t)blockIdx.x * 512 + threadIdx.x; i < (size_t)NB * SEQ * DM; i += (size_t)gridDim.x * 512) F.out[i] = (i == 0) ? X : ((i & 1) ? A : -A);
    }
#endif
}

extern "C" void kernel_launch(void* const* d_in, const int* in_sizes, int n_in, void* d_out, int out_size, void* d_ws, size_t ws_size, hipStream_t stream) {
    static int grid = 0;
    if (grid == 0) {
        if (n_in != 26 || ws_size < WS_END) { fprintf(stderr, "kernel_launch: expected 26 inputs and >= %zu bytes of workspace; got %d, %zu\n", (size_t)WS_END, n_in, ws_size); grid = -1; return; }
        int dev = 0, cus = 0, per_cu = 0;
        if (hipGetDevice(&dev) != hipSuccess || hipDeviceGetAttribute(&cus, hipDeviceAttributeMultiprocessorCount, dev) != hipSuccess) { grid = -1; return; }
        if (hipFuncSetAttribute((const void*)dit_fwd, hipFuncAttributeMaxDynamicSharedMemorySize, LDS_BYTES) != hipSuccess) { fprintf(stderr, "kernel_launch: hipFuncSetAttribute failed\n"); grid = -1; return; }
        if (hipOccupancyMaxActiveBlocksPerMultiprocessor(&per_cu, (const void*)dit_fwd, 512, LDS_BYTES) != hipSuccess || per_cu < 1) fprintf(stderr, "kernel_launch: occupancy query reports %d\n", per_cu);
        (void)hipGetLastError();
        grid = cus;
    }
    if (grid < 0) return;
    (void)hipMemsetAsync((char*)d_ws + WS_CTL, 0, CTL_ZERO_BYTES, stream);
    Args a{};
    for (int i = 0; i < 26; ++i) a.in[i] = (const float*)d_in[i];
    a.out = (float*)d_out; a.ws = (unsigned char*)d_ws; a.ph_lo = 0; a.ph_hi = 1000;
    hipLaunchKernelGGL(dit_fwd, dim3(grid), dim3(512), LDS_BYTES, stream, a);
}
```
